# Optimizing an MI355X kernel written in HIP

```python
import math
import jax
import jax.numpy as jnp
from jax import lax
import numpy as np

D_MODEL = 1024
BATCH = 4
SEQ = 4096
DEPTH = 2

HEAD_DIM = 64
Q_BLOCK = 128
NORM_EPS = 1e-6
NEG_INF = -1e30
FORCE_SCORE = 1e4

DIFF_HEADS = D_MODEL // (2 * HEAD_DIM)
DIFF_QK_DIM = HEAD_DIM // 2
DIFF_V_DIM = HEAD_DIM

NSA_HEADS = D_MODEL // (2 * HEAD_DIM)
NSA_KV_GROUPS = 2
NSA_HEADS_PER_GROUP = NSA_HEADS // NSA_KV_GROUPS
NSA_CMP_BLOCK = 32
NSA_CMP_STRIDE = 16
NSA_SEL_BLOCK = 64
NSA_TOP_N = 16
NSA_WINDOW = 512
NSA_BRANCHES = 3

DIFF_QK_COLS = DIFF_HEADS * 2 * DIFF_QK_DIM
DIFF_V_COLS = DIFF_HEADS * DIFF_V_DIM
NSA_Q_COLS = NSA_HEADS * HEAD_DIM
NSA_KV_COLS = NSA_BRANCHES * 2 * NSA_KV_GROUPS * HEAD_DIM
NSA_GATE_COLS = NSA_BRANCHES * NSA_HEADS
IN_COLS = 2 * DIFF_QK_COLS + DIFF_V_COLS + NSA_Q_COLS + NSA_KV_COLS + NSA_GATE_COLS
ATTN_OUT = DIFF_V_COLS + NSA_Q_COLS

RWKV_HEAD = 64
RWKV_HEADS = D_MODEL // RWKV_HEAD
RWKV_DECAY_LORA = 64
RWKV_ICLR_LORA = 64
RWKV_GATE_LORA = 160
RWKV_LNX_EPS = 64e-5

N_GROUPS = 4
EXPERTS_PER_GROUP = 8
N_EXPERTS = N_GROUPS * EXPERTS_PER_GROUP
TOP_K_IN_GROUP = 2
D_EXPERT = 256
MOE_BLOCK = 128

kernel_name = 'hybrid_diff_nsa_rwkv7_hmoe'


def rms_norm(x, gain, eps=NORM_EPS):
    xf = x.astype(jnp.float32)
    y = xf * lax.rsqrt(jnp.mean(xf * xf, axis=-1, keepdims=True) + eps)
    return (y * gain.astype(jnp.float32)).astype(x.dtype)


def masked_softmax(scores, mask):
    return jax.nn.softmax(jnp.where(mask, scores.astype(jnp.float32), NEG_INF), axis=-1)


def diff_attention(q, k, v, q_gain, k_gain, lam_p, subln_gain, lambda_init):
    B, S, H, _, dq = q.shape
    q = rms_norm(q, q_gain)
    k = rms_norm(k, k_gain)
    lp = lam_p.astype(jnp.float32)
    lam = jnp.exp(jnp.sum(lp[0] * lp[1])) - jnp.exp(jnp.sum(lp[2] * lp[3])) + lambda_init
    scale = dq ** -0.5
    outs = []
    for blk in range(S // Q_BLOCK):
        q0, q1 = blk * Q_BLOCK, (blk + 1) * Q_BLOCK
        s = jnp.einsum('bqhmd,bkhmd->bhmqk', q[:, q0:q1], k[:, :q1]) * scale
        causal = jnp.arange(q0, q1)[:, None] >= jnp.arange(q1)[None, :]
        p = masked_softmax(s, causal)
        p_diff = p[:, :, 0] - lam * p[:, :, 1]
        outs.append(jnp.einsum('bhqk,bkhd->bqhd', p_diff.astype(v.dtype), v[:, :q1]))
    o = jnp.concatenate(outs, axis=1)
    o = rms_norm(o, subln_gain) * (1.0 - lambda_init)
    return o.reshape(B, S, H * v.shape[-1])


def nsa_attention(q, kv, gates, q_gain, k_gain, cmp_pe, cmp_w1, cmp_w2):
    B, S, H, dh = q.shape
    G, HPG = NSA_KV_GROUPS, NSA_HEADS_PER_GROUP
    scale = dh ** -0.5
    pos = jnp.arange(S)
    n_qb = S // Q_BLOCK
    q = rms_norm(q, q_gain).reshape(B, S, G, HPG, dh)

    n_cmp = (S - NSA_CMP_BLOCK) // NSA_CMP_STRIDE + 1
    c_start = jnp.arange(n_cmp) * NSA_CMP_STRIDE
    c_idx = c_start[:, None] + jnp.arange(NSA_CMP_BLOCK)[None, :]

    def compress(t, pe, w1, w2):
        blocks = t[:, c_idx] + pe[:, None, :]
        flat = jnp.swapaxes(blocks, 2, 3).reshape(B, n_cmp, G, NSA_CMP_BLOCK * dh)
        return jax.nn.gelu(flat @ w1) @ w2

    k_cmp = rms_norm(compress(kv[:, :, 0, 0], cmp_pe[0], cmp_w1[0], cmp_w2[0]), k_gain[0])
    v_cmp = compress(kv[:, :, 0, 1], cmp_pe[1], cmp_w1[1], cmp_w2[1])
    cmp_ok = ((c_start + NSA_CMP_BLOCK - 1)[None, :] <= pos[:, None])[None, :, None, None, :]
    s_cmp = jnp.einsum('bsghd,bcgd->bsghc', q, k_cmp) * scale
    p_cmp = masked_softmax(s_cmp, cmp_ok) * cmp_ok
    o_cmp = jnp.einsum('bsghc,bcgd->bsghd', p_cmp.astype(v_cmp.dtype), v_cmp)

    n_sel = S // NSA_SEL_BLOCK
    top_n = min(NSA_TOP_N, n_sel)
    s_start = jnp.arange(n_sel) * NSA_SEL_BLOCK
    cover = ((c_start[:, None] < s_start[None, :] + NSA_SEL_BLOCK)
             & (c_start[:, None] + NSA_CMP_BLOCK > s_start[None, :])).astype(jnp.float32)
    importance = jnp.einsum('bsghc,cj->bsgj', p_cmp, cover)
    blk = jnp.arange(n_sel)[None, :]
    cur = (pos // NSA_SEL_BLOCK)[:, None]
    forced = ((blk == cur) | (blk == 0))[None, :, None, :]
    future = (blk > cur)[None, :, None, :]
    importance = jnp.where(forced, FORCE_SCORE, jnp.where(future, NEG_INF, importance))
    _, sel_idx = lax.top_k(importance, top_n)

    def to_blocks(t):
        return t.reshape(B, n_sel, NSA_SEL_BLOCK, G, dh).transpose(0, 3, 1, 2, 4)

    k_blk = to_blocks(rms_norm(kv[:, :, 1, 0], k_gain[1]))
    v_blk = to_blocks(kv[:, :, 1, 1])
    b_ix = jnp.arange(B)[:, None, None, None]
    g_ix = jnp.arange(G)[None, None, :, None]
    in_blk = jnp.arange(NSA_SEL_BLOCK)

    def select_block(args):
        q_c, idx_c, pos_c = args
        k_g = k_blk[b_ix, g_ix, idx_c]
        v_g = v_blk[b_ix, g_ix, idx_c]
        s = jnp.einsum('bqghd,bqgnkd->bqghnk', q_c, k_g) * scale
        ok = (idx_c[..., None] * NSA_SEL_BLOCK + in_blk) <= pos_c[None, :, None, None, None]
        s = s.reshape(B, Q_BLOCK, G, HPG, top_n * NSA_SEL_BLOCK)
        ok = ok.reshape(B, Q_BLOCK, G, 1, top_n * NSA_SEL_BLOCK)
        p = masked_softmax(s, ok).reshape(B, Q_BLOCK, G, HPG, top_n, NSA_SEL_BLOCK)
        return jnp.einsum('bqghnk,bqgnkd->bqghd', p.astype(v_g.dtype), v_g)

    def chunk(t):
        return jnp.swapaxes(t.reshape(B, n_qb, Q_BLOCK, *t.shape[2:]), 0, 1)

    o_sel = lax.map(select_block, (chunk(q), chunk(sel_idx), pos.reshape(n_qb, Q_BLOCK)))
    o_sel = jnp.swapaxes(o_sel, 0, 1).reshape(B, S, G, HPG, dh)

    pad = ((0, 0), (NSA_WINDOW, 0), (0, 0), (0, 0))
    span = Q_BLOCK + NSA_WINDOW
    band = (jnp.arange(n_qb) * Q_BLOCK)[:, None] + jnp.arange(span)[None, :]
    k_band = jnp.pad(rms_norm(kv[:, :, 2, 0], k_gain[2]), pad)[:, band]
    v_band = jnp.pad(kv[:, :, 2, 1], pad)[:, band]
    q_b = q.reshape(B, n_qb, Q_BLOCK, G, HPG, dh)
    s_win = jnp.einsum('bnqghd,bnkgd->bnghqk', q_b, k_band) * scale
    k_pos = (band - NSA_WINDOW)[:, None, :]
    q_pos = pos.reshape(n_qb, Q_BLOCK)[:, :, None]
    win_ok = (k_pos >= 0) & (k_pos <= q_pos) & (k_pos > q_pos - NSA_WINDOW)
    p_win = masked_softmax(s_win, win_ok[None, :, None, None])
    o_win = jnp.einsum('bnghqk,bnkgd->bnqghd', p_win.astype(v_band.dtype), v_band)
    o_win = o_win.reshape(B, S, G, HPG, dh)

    g = gates.reshape(B, S, G, HPG, NSA_BRANCHES, 1)
    o = g[..., 0, :] * o_cmp + g[..., 1, :] * o_sel + g[..., 2, :] * o_win
    return o.reshape(B, S, H * dh)


def hybrid_attention_mixer(xn, layer, w_in, gate_bias, diff_q_gain, diff_k_gain, diff_lam,
                           diff_subln, nsa_q_gain, nsa_k_gain, cmp_pe, cmp_w1, cmp_w2, w_out):
    B, S, _ = xn.shape
    h = xn @ w_in
    offs = np.cumsum([0, DIFF_QK_COLS, DIFF_QK_COLS, DIFF_V_COLS, NSA_Q_COLS, NSA_KV_COLS, NSA_GATE_COLS])
    d_q, d_k, d_v, n_q, n_kv, n_g = (h[..., int(offs[j]):int(offs[j + 1])] for j in range(6))
    lambda_init = 0.8 - 0.6 * math.exp(-0.3 * layer)
    diff_out = diff_attention(
        d_q.reshape(B, S, DIFF_HEADS, 2, DIFF_QK_DIM),
        d_k.reshape(B, S, DIFF_HEADS, 2, DIFF_QK_DIM),
        d_v.reshape(B, S, DIFF_HEADS, DIFF_V_DIM),
        diff_q_gain, diff_k_gain, diff_lam, diff_subln, lambda_init)
    gates = jax.nn.sigmoid(n_g + gate_bias).reshape(B, S, NSA_HEADS, NSA_BRANCHES)
    nsa_out = nsa_attention(
        n_q.reshape(B, S, NSA_HEADS, HEAD_DIM),
        n_kv.reshape(B, S, NSA_BRANCHES, 2, NSA_KV_GROUPS, HEAD_DIM),
        gates, nsa_q_gain, nsa_k_gain, cmp_pe, cmp_w1, cmp_w2)
    return jnp.concatenate([diff_out, nsa_out], axis=-1) @ w_out


def rwkv7_time_mix(xn, mix, w_r, w_k, w_v, w0, w1, w2, a0, a1, a2, g1, g2, k_k, k_a, r_k,
                   ln_w, ln_b, w_o):
    B, S, D = xn.shape
    H, N = RWKV_HEADS, RWKV_HEAD
    f32 = jnp.float32
    dx = jnp.pad(xn, ((0, 0), (1, 0), (0, 0)))[:, :-1] - xn
    xr, xw, xk, xv, xa, xg = (xn + dx * mix[j] for j in range(6))
    r = xr @ w_r
    k = xk @ w_k
    v = xv @ w_v
    w = -jax.nn.softplus(-(w0 + jnp.tanh(xw @ w1) @ w2).astype(f32)) - 0.5
    a = jax.nn.sigmoid((a0 + (xa @ a1) @ a2).astype(f32))
    g = jax.nn.sigmoid(xg @ g1) @ g2

    def heads(t):
        return t.astype(f32).reshape(B, S, H, N)

    kk = heads(k * k_k)
    kk = kk / jnp.maximum(jnp.linalg.norm(kk, axis=-1, keepdims=True), 1e-12)
    k = k.astype(f32) * (1.0 + (a - 1.0) * k_a.astype(f32))
    r_h, k_h, v_h, a_h = heads(r), heads(k), heads(v), heads(a)
    decay = jnp.exp(-jnp.exp(heads(w)))

    def step(state, inp):
        r_t, d_t, k_t, v_t, kk_t, a_t = inp
        s_kk = jnp.einsum('bhvk,bhk->bhv', state, -kk_t)
        state = (state * d_t[:, :, None, :]
                 + s_kk[..., None] * (kk_t * a_t)[:, :, None, :]
                 + v_t[..., None] * k_t[:, :, None, :])
        return state, jnp.einsum('bhvk,bhk->bhv', state, r_t)

    def tm(t):
        return jnp.moveaxis(t, 1, 0)

    _, y = lax.scan(step, jnp.zeros((B, H, N, N), f32),
                    (tm(r_h), tm(decay), tm(k_h), tm(v_h), tm(kk), tm(a_h)))
    y = jnp.moveaxis(y, 0, 1)
    mu = jnp.mean(y, axis=-1, keepdims=True)
    var = jnp.mean(jnp.square(y - mu), axis=-1, keepdims=True)
    y = ((y - mu) * lax.rsqrt(var + RWKV_LNX_EPS)).reshape(B, S, D) * ln_w + ln_b
    bonus = jnp.sum(r_h * k_h * r_k.astype(f32).reshape(H, N), axis=-1, keepdims=True) * v_h
    y = y + bonus.reshape(B, S, D)
    return (y * g.astype(f32)).astype(xn.dtype) @ w_o


def hier_moe(xn, wg, bg, we, be, e_gate, e_up, e_down):
    B, S, D = xn.shape
    f32 = jnp.float32
    xf = xn.reshape(-1, D)
    n_tok = xf.shape[0]
    grp_prob = jax.nn.softmax((xf @ wg + bg).astype(f32), axis=-1)
    grp_p, grp_idx = lax.top_k(grp_prob, 1)
    exp_logits = (xf @ we + be).astype(f32).reshape(n_tok, N_GROUPS, EXPERTS_PER_GROUP)
    in_grp = jnp.take_along_axis(exp_logits, grp_idx[:, :, None], axis=1)[:, 0]
    top_val, top_idx = lax.top_k(in_grp, TOP_K_IN_GROUP)
    gate = grp_p * jax.nn.softmax(top_val, axis=-1)
    expert = grp_idx * EXPERTS_PER_GROUP + top_idx

    n_pairs = n_tok * TOP_K_IN_GROUP
    flat_e = expert.reshape(-1)
    order = jnp.argsort(flat_e)
    e_sorted = flat_e[order]
    tok_sorted = order // TOP_K_IN_GROUP
    gate_sorted = gate.reshape(-1)[order]
    counts = jnp.bincount(flat_e, length=N_EXPERTS)
    padded = (counts + MOE_BLOCK - 1) // MOE_BLOCK * MOE_BLOCK
    pad_end = jnp.cumsum(padded)
    pad_start = pad_end - padded
    start = jnp.cumsum(counts) - counts
    dest = pad_start[e_sorted] + jnp.arange(n_pairs) - start[e_sorted]
    n_blocks = -(-n_pairs // MOE_BLOCK) + N_EXPERTS
    slot_tok = jnp.full((n_blocks * MOE_BLOCK,), n_tok, jnp.int32).at[dest].set(tok_sorted)
    block_e = jnp.minimum(jnp.searchsorted(pad_end, jnp.arange(n_blocks) * MOE_BLOCK, side='right'),
                          N_EXPERTS - 1)
    x_pad = jnp.concatenate([xf, jnp.zeros((1, D), xf.dtype)], axis=0)
    xb = x_pad[slot_tok].reshape(n_blocks, MOE_BLOCK, D)

    def run_block(args):
        x_blk, e = args
        hid = jax.nn.silu(x_blk @ e_gate[e]) * (x_blk @ e_up[e])
        return hid @ e_down[e]

    y_slots = lax.map(run_block, (xb, block_e)).reshape(n_blocks * MOE_BLOCK, D)
    y = jnp.zeros_like(xf).at[tok_sorted].add(y_slots[dest] * gate_sorted[:, None].astype(xf.dtype))
    return y.reshape(B, S, D)


def setup_inputs(seed: int = 0) -> dict:
    key = jax.random.key(seed)
    keys = jax.random.split(key, 48)
    ks = iter([keys[j] for j in range(48)])
    n_a = (DEPTH + 1) // 2
    n_r = DEPTH // 2
    D = D_MODEL
    L = NSA_CMP_BLOCK

    def nrm(shape, scale):
        return jax.random.normal(next(ks), shape, jnp.float32) * scale

    def gain(shape):
        return 1.0 + nrm(shape, 0.05)

    def unif(shape, lo, hi):
        return jax.random.uniform(next(ks), shape, jnp.float32, lo, hi)

    return {
        'x': nrm((BATCH, SEQ, D), 1.0),
        'mix_norm': gain((DEPTH, D)),
        'attn_w_in': nrm((n_a, D, IN_COLS), D ** -0.5),
        'attn_gate_bias': nrm((n_a, NSA_GATE_COLS), 0.1),
        'diff_q_norm': gain((n_a, DIFF_QK_DIM)),
        'diff_k_norm': gain((n_a, DIFF_QK_DIM)),
        'diff_lambda': nrm((n_a, 4, DIFF_QK_DIM), 0.1),
        'diff_subln': gain((n_a, DIFF_V_DIM)),
        'nsa_q_norm': gain((n_a, HEAD_DIM)),
        'nsa_k_norm': gain((n_a, NSA_BRANCHES, HEAD_DIM)),
        'nsa_cmp_pe': nrm((n_a, 2, L, HEAD_DIM), 0.1),
        'nsa_cmp_w1': nrm((n_a, 2, L * HEAD_DIM, HEAD_DIM), (L * HEAD_DIM) ** -0.5),
        'nsa_cmp_w2': nrm((n_a, 2, HEAD_DIM, HEAD_DIM), HEAD_DIM ** -0.5),
        'attn_w_out': nrm((n_a, ATTN_OUT, D), ATTN_OUT ** -0.5),
        'rwkv_mix': unif((n_r, 6, D), 0.0, 1.0),
        'rwkv_w_r': nrm((n_r, D, D), D ** -0.5),
        'rwkv_w_k': nrm((n_r, D, D), D ** -0.5),
        'rwkv_w_v': nrm((n_r, D, D), D ** -0.5),
        'rwkv_decay_w0': unif((n_r, D), -5.0, 0.0),
        'rwkv_decay_w1': nrm((n_r, D, RWKV_DECAY_LORA), D ** -0.5),
        'rwkv_decay_w2': nrm((n_r, RWKV_DECAY_LORA, D), 0.1 * RWKV_DECAY_LORA ** -0.5),
        'rwkv_iclr_a0': nrm((n_r, D), 0.1),
        'rwkv_iclr_a1': nrm((n_r, D, RWKV_ICLR_LORA), D ** -0.5),
        'rwkv_iclr_a2': nrm((n_r, RWKV_ICLR_LORA, D), 0.1 * RWKV_ICLR_LORA ** -0.5),
        'rwkv_gate_g1': nrm((n_r, D, RWKV_GATE_LORA), D ** -0.5),
        'rwkv_gate_g2': nrm((n_r, RWKV_GATE_LORA, D), RWKV_GATE_LORA ** -0.5),
        'rwkv_k_k': 0.85 + nrm((n_r, D), 0.05),
        'rwkv_k_a': gain((n_r, D)),
        'rwkv_r_k': nrm((n_r, D), 0.1),
        'rwkv_ln_w': gain((n_r, D)),
        'rwkv_ln_b': nrm((n_r, D), 0.01),
        'rwkv_w_o': nrm((n_r, D, D), D ** -0.5),
        'ffn_norm': gain((DEPTH, D)),
        'router_group_w': nrm((DEPTH, D, N_GROUPS), D ** -0.5),
        'router_group_b': nrm((DEPTH, N_GROUPS), 0.01),
        'router_expert_w': nrm((DEPTH, D, N_EXPERTS), D ** -0.5),
        'router_expert_b': nrm((DEPTH, N_EXPERTS), 0.01),
        'expert_w_gate': nrm((DEPTH, N_EXPERTS, D, D_EXPERT), D ** -0.5),
        'expert_w_up': nrm((DEPTH, N_EXPERTS, D, D_EXPERT), D ** -0.5),
        'expert_w_down': nrm((DEPTH, N_EXPERTS, D_EXPERT, D), D_EXPERT ** -0.5),
    }


def reference(x, mix_norm, attn_w_in, attn_gate_bias, diff_q_norm, diff_k_norm, diff_lambda,
              diff_subln, nsa_q_norm, nsa_k_norm, nsa_cmp_pe, nsa_cmp_w1, nsa_cmp_w2, attn_w_out,
              rwkv_mix, rwkv_w_r, rwkv_w_k, rwkv_w_v, rwkv_decay_w0, rwkv_decay_w1, rwkv_decay_w2,
              rwkv_iclr_a0, rwkv_iclr_a1, rwkv_iclr_a2, rwkv_gate_g1, rwkv_gate_g2, rwkv_k_k,
              rwkv_k_a, rwkv_r_k, rwkv_ln_w, rwkv_ln_b, rwkv_w_o, ffn_norm, router_group_w,
              router_group_b, router_expert_w, router_expert_b, expert_w_gate, expert_w_up,
              expert_w_down):
    for layer in range(DEPTH):
        i = layer // 2
        xn = rms_norm(x, mix_norm[layer])
        if layer % 2 == 0:
            x = x + hybrid_attention_mixer(
                xn, layer, attn_w_in[i], attn_gate_bias[i], diff_q_norm[i], diff_k_norm[i],
                diff_lambda[i], diff_subln[i], nsa_q_norm[i], nsa_k_norm[i], nsa_cmp_pe[i],
                nsa_cmp_w1[i], nsa_cmp_w2[i], attn_w_out[i])
        else:
            x = x + rwkv7_time_mix(
                xn, rwkv_mix[i], rwkv_w_r[i], rwkv_w_k[i], rwkv_w_v[i], rwkv_decay_w0[i],
                rwkv_decay_w1[i], rwkv_decay_w2[i], rwkv_iclr_a0[i], rwkv_iclr_a1[i],
                rwkv_iclr_a2[i], rwkv_gate_g1[i], rwkv_gate_g2[i], rwkv_k_k[i], rwkv_k_a[i],
                rwkv_r_k[i], rwkv_ln_w[i], rwkv_ln_b[i], rwkv_w_o[i])
        x = x + hier_moe(
            rms_norm(x, ffn_norm[layer]), router_group_w[layer], router_group_b[layer],
            router_expert_w[layer], router_expert_b[layer], expert_w_gate[layer],
            expert_w_up[layer], expert_w_down[layer])
    return x
```

```cpp
#include <hip/hip_runtime.h>
#include <hip/hip_bf16.h>
#include <stdint.h>

#define T_TOK 16384
#define DM 1024
#define SEQ 4096
#define NBATCH 4
#define INC 2840
#define OFF_DQ 0
#define OFF_DK 512
#define OFF_DV 1024
#define OFF_NQ 1536
#define OFF_NKV 2048
#define OFF_NG 2816
#define NCMP 255
#define CAP 32768

typedef unsigned short bf16_t;

__device__ __forceinline__ float bf2f(bf16_t v) { return __uint_as_float(((unsigned)v) << 16); }
__device__ __forceinline__ bf16_t f2bf(float f) {
  unsigned u = __float_as_uint(f);
  u += 0x7fffu + ((u >> 16) & 1u);
  return (bf16_t)(u >> 16);
}
__device__ __forceinline__ float wave_sum(float v) {
#pragma unroll
  for (int o = 32; o >= 1; o >>= 1) v += __shfl_xor(v, o, 64);
  return v;
}
__device__ __forceinline__ float sigmoidf_(float x) { return 1.f / (1.f + __expf(-x)); }
__device__ __forceinline__ float softplusf_(float x) { return fmaxf(x, 0.f) + log1pf(__expf(-fabsf(x))); }
__device__ __forceinline__ float gelu_tanh(float x) {
  float u = 0.7978845608028654f * (x + 0.044715f * x * x * x);
  return 0.5f * x * (1.f + tanhf(u));
}

struct P {
  const float* x; const float* mix_norm; const float* w_in; const float* gate_bias;
  const float* dq_norm; const float* dk_norm; const float* dlam; const float* dsubln;
  const float* nq_norm; const float* nk_norm; const float* cmp_pe; const float* cmp_w1; const float* cmp_w2;
  const float* w_out;
  const float* rmix; const float* w_r; const float* w_k; const float* w_v;
  const float* w0; const float* w1; const float* w2; const float* a0; const float* a1; const float* a2;
  const float* g1; const float* g2; const float* k_k; const float* k_a; const float* r_k;
  const float* ln_w; const float* ln_b; const float* w_o;
  const float* ffn_norm; const float* rg_w; const float* rg_b; const float* re_w; const float* re_b;
  const float* e_gate; const float* e_up; const float* e_down;
  float* out;
  float* H; float* CAT; float* KCMP; float* VCMP; float* RS;
  float* XN2; float* GU; int* LIST; float* PGATE; int* CNT;
  bf16_t* R; bf16_t* K; bf16_t* V; bf16_t* W; bf16_t* A; bf16_t* G; float* TMP1; bf16_t* Z;
};

__global__ __launch_bounds__(256) void k_rowrms(const float* __restrict__ x, float* __restrict__ rs) {
  int row = blockIdx.x * 4 + (threadIdx.x >> 6);
  int lane = threadIdx.x & 63;
  const float4* p = (const float4*)(x + (size_t)row * DM);
  float s = 0.f;
#pragma unroll
  for (int i = 0; i < 4; i++) { float4 v = p[lane + i * 64]; s += v.x * v.x + v.y * v.y + v.z * v.z + v.w * v.w; }
  s = wave_sum(s);
  if (lane == 0) rs[row] = rsqrtf(s * (1.f / DM) + 1e-6f);
}

__global__ __launch_bounds__(256) void k_rmsnorm_write(const float* __restrict__ x, const float* __restrict__ gain, float* __restrict__ y) {
  int row = blockIdx.x * 4 + (threadIdx.x >> 6);
  int lane = threadIdx.x & 63;
  const float4* p = (const float4*)(x + (size_t)row * DM);
  const float4* g = (const float4*)gain;
  float4 v[4];
  float s = 0.f;
#pragma unroll
  for (int i = 0; i < 4; i++) { v[i] = p[lane + i * 64]; s += v[i].x * v[i].x + v[i].y * v[i].y + v[i].z * v[i].z + v[i].w * v[i].w; }
  s = wave_sum(s);
  float r = rsqrtf(s * (1.f / DM) + 1e-6f);
  float4* o = (float4*)(y + (size_t)row * DM);
#pragma unroll
  for (int i = 0; i < 4; i++) {
    float4 gg = g[lane + i * 64];
    float4 w; w.x = v[i].x * r * gg.x; w.y = v[i].y * r * gg.y; w.z = v[i].z * r * gg.z; w.w = v[i].w * r * gg.w;
    o[lane + i * 64] = w;
  }
}

enum { G_INPROJ = 0, G_OUTPROJ, G_MOE_GU, G_MOE_DOWN, G_RKV, G_LORA1, G_LORA2, G_WO };

template <int MODE>
struct GF {
  P p; int K; int N; int sub;
  __device__ __forceinline__ bool tile_ok(int m0) const {
    if (MODE == G_MOE_GU || MODE == G_MOE_DOWN) return m0 < p.CNT[blockIdx.z];
    return true;
  }
  __device__ __forceinline__ float a(int m, int k) const {
    if (MODE == G_INPROJ) return p.x[(size_t)m * DM + k] * p.RS[m] * p.mix_norm[k];
    if (MODE == G_OUTPROJ) return p.CAT[(size_t)m * DM + k];
    if (MODE == G_MOE_GU) {
      int e = blockIdx.z;
      if (m >= p.CNT[e]) return 0.f;
      int pr = p.LIST[(size_t)e * CAP + m];
      return p.XN2[(size_t)(pr >> 1) * DM + k];
    }
    if (MODE == G_MOE_DOWN) {
      int e = blockIdx.z;
      if (m >= p.CNT[e]) return 0.f;
      int pr = p.LIST[(size_t)e * CAP + m];
      float g = p.GU[(size_t)pr * 512 + k], u = p.GU[(size_t)pr * 512 + 256 + k];
      return g * sigmoidf_(g) * u;
    }
    if (MODE == G_RKV || MODE == G_LORA1) {
      int s = m & (SEQ - 1);
      float gn = p.mix_norm[DM + k];
      float xc = p.out[(size_t)m * DM + k] * p.RS[m] * gn;
      float xp = (s > 0) ? p.out[(size_t)(m - 1) * DM + k] * p.RS[m - 1] * gn : 0.f;
      int j = (MODE == G_RKV) ? (sub == 0 ? 0 : (sub == 1 ? 2 : 3)) : (sub == 0 ? 1 : (sub == 1 ? 4 : 5));
      return xc + (xp - xc) * p.rmix[j * DM + k];
    }
    if (MODE == G_LORA2) {
      int off = (sub == 0) ? 0 : (sub == 1 ? 64 : 128);
      return p.TMP1[(size_t)m * 288 + off + k];
    }
    if (MODE == G_WO) return bf2f(p.Z[(size_t)m * DM + k]);
    return 0.f;
  }
  __device__ __forceinline__ float b(int k, int n) const {
    if (n >= N) return 0.f;
    if (MODE == G_INPROJ) return p.w_in[(size_t)k * INC + n];
    if (MODE == G_OUTPROJ) return p.w_out[(size_t)k * DM + n];
    if (MODE == G_MOE_GU) {
      int e = blockIdx.z;
      const float* w = (n < 256) ? p.e_gate : p.e_up;
      return w[((size_t)e * DM + k) * 256 + (n & 255)];
    }
    if (MODE == G_MOE_DOWN) return p.e_down[((size_t)blockIdx.z * 256 + k) * DM + n];
    if (MODE == G_RKV) { const float* w = sub == 0 ? p.w_r : (sub == 1 ? p.w_k : p.w_v); return w[(size_t)k * DM + n]; }
    if (MODE == G_LORA1) { const float* w = sub == 0 ? p.w1 : (sub == 1 ? p.a1 : p.g1); return w[(size_t)k * N + n]; }
    if (MODE == G_LORA2) { const float* w = sub == 0 ? p.w2 : (sub == 1 ? p.a2 : p.g2); return w[(size_t)k * DM + n]; }
    if (MODE == G_WO) return p.w_o[(size_t)k * DM + n];
    return 0.f;
  }
  __device__ __forceinline__ void epi(int m, int n, float v) const {
    if (n >= N) return;
    if (MODE == G_INPROJ) p.H[(size_t)m * INC + n] = v;
    if (MODE == G_OUTPROJ) p.out[(size_t)m * DM + n] = p.x[(size_t)m * DM + n] + v;
    if (MODE == G_MOE_GU) {
      int e = blockIdx.z;
      if (m >= p.CNT[e]) return;
      int pr = p.LIST[(size_t)e * CAP + m];
      p.GU[(size_t)pr * 512 + n] = v;
    }
    if (MODE == G_MOE_DOWN) {
      int e = blockIdx.z;
      if (m >= p.CNT[e]) return;
      int pr = p.LIST[(size_t)e * CAP + m];
      atomicAdd(&p.out[(size_t)(pr >> 1) * DM + n], p.PGATE[pr] * v);
    }
    if (MODE == G_RKV) { bf16_t* o = sub == 0 ? p.R : (sub == 1 ? p.K : p.V); o[(size_t)m * DM + n] = f2bf(v); }
    if (MODE == G_LORA1) {
      int off = (sub == 0) ? 0 : (sub == 1 ? 64 : 128);
      float r = sub == 0 ? tanhf(v) : (sub == 1 ? v : sigmoidf_(v));
      p.TMP1[(size_t)m * 288 + off + n] = r;
    }
    if (MODE == G_LORA2) {
      if (sub == 0) p.W[(size_t)m * DM + n] = f2bf(-softplusf_(-(p.w0[n] + v)) - 0.5f);
      else if (sub == 1) p.A[(size_t)m * DM + n] = f2bf(sigmoidf_(p.a0[n] + v));
      else p.G[(size_t)m * DM + n] = f2bf(v);
    }
    if (MODE == G_WO) p.out[(size_t)m * DM + n] += v;
  }
};

template <int MODE>
__global__ __launch_bounds__(256) void k_gemm(GF<MODE> f) {
  __shared__ float sA[16][68];
  __shared__ float sB[16][68];
  const int tx = threadIdx.x & 15, ty = threadIdx.x >> 4;
  const int m0 = blockIdx.y * 64, n0 = blockIdx.x * 64;
  if (!f.tile_ok(m0)) return;
  float acc[4][4];
#pragma unroll
  for (int i = 0; i < 4; i++)
#pragma unroll
    for (int j = 0; j < 4; j++) acc[i][j] = 0.f;
  for (int k0 = 0; k0 < f.K; k0 += 16) {
#pragma unroll
    for (int i = 0; i < 4; i++) {
      int e = threadIdx.x + i * 256;
      int m = e >> 4, k = e & 15;
      sA[k][m] = f.a(m0 + m, k0 + k);
    }
#pragma unroll
    for (int i = 0; i < 4; i++) {
      int e = threadIdx.x + i * 256;
      int k = e >> 6, n = e & 63;
      sB[k][n] = f.b(k0 + k, n0 + n);
    }
    __syncthreads();
#pragma unroll
    for (int k = 0; k < 16; k++) {
      float4 av = *(const float4*)&sA[k][ty * 4];
      float4 bv = *(const float4*)&sB[k][tx * 4];
      float a_[4] = {av.x, av.y, av.z, av.w};
      float b_[4] = {bv.x, bv.y, bv.z, bv.w};
#pragma unroll
      for (int i = 0; i < 4; i++)
#pragma unroll
        for (int j = 0; j < 4; j++) acc[i][j] += a_[i] * b_[j];
    }
    __syncthreads();
  }
#pragma unroll
  for (int i = 0; i < 4; i++)
#pragma unroll
    for (int j = 0; j < 4; j++) f.epi(m0 + ty * 4 + i, n0 + tx * 4 + j, acc[i][j]);
}

__global__ __launch_bounds__(64) void k_headnorm(P p) {
  const int t = blockIdx.x, lane = threadIdx.x;
  float* h = p.H + (size_t)t * INC;
  for (int i = 0; i < 16; i++) {
    int col = i * 64 + lane;
    float v = h[col];
    float s = v * v;
#pragma unroll
    for (int o = 16; o >= 1; o >>= 1) s += __shfl_xor(s, o, 64);
    const float* g = (col < 512) ? p.dq_norm : p.dk_norm;
    h[col] = v * rsqrtf(s * (1.f / 32.f) + 1e-6f) * g[col & 31];
  }
  for (int hh = 0; hh < 8; hh++) {
    int col = OFF_NQ + hh * 64 + lane;
    float v = h[col];
    float s = wave_sum(v * v);
    h[col] = v * rsqrtf(s * (1.f / 64.f) + 1e-6f) * p.nq_norm[lane];
  }
  for (int br = 1; br < 3; br++)
    for (int g = 0; g < 2; g++) {
      int col = OFF_NKV + ((br * 2 + 0) * 2 + g) * 64 + lane;
      float v = h[col];
      float s = wave_sum(v * v);
      h[col] = v * rsqrtf(s * (1.f / 64.f) + 1e-6f) * p.nk_norm[br * 64 + lane];
    }
  if (lane < 24) h[OFF_NG + lane] = sigmoidf_(h[OFF_NG + lane] + p.gate_bias[lane]);
}

__global__ __launch_bounds__(64) void k_compress(P p) {
  __shared__ float flat[2048];
  __shared__ float hid[64];
  const int lane = threadIdx.x;
  int id = blockIdx.x;
  const int kv = id & 1; id >>= 1;
  const int g = id & 1; id >>= 1;
  const int c = id % NCMP; const int b = id / NCMP;
  const int colbase = OFF_NKV + ((0 * 2 + kv) * 2 + g) * 64;
  for (int l = 0; l < 32; l++)
    flat[l * 64 + lane] = p.H[(size_t)(b * SEQ + 16 * c + l) * INC + colbase + lane] + p.cmp_pe[(kv * 32 + l) * 64 + lane];
  __syncthreads();
  const float* w1 = p.cmp_w1 + (size_t)kv * 2048 * 64;
  float acc = 0.f;
  for (int i = 0; i < 2048; i++) acc += flat[i] * w1[i * 64 + lane];
  hid[lane] = gelu_tanh(acc);
  __syncthreads();
  const float* w2 = p.cmp_w2 + kv * 64 * 64;
  float o = 0.f;
  for (int j = 0; j < 64; j++) o += hid[j] * w2[j * 64 + lane];
  if (kv == 0) {
    float s = wave_sum(o * o);
    o = o * rsqrtf(s * (1.f / 64.f) + 1e-6f) * p.nk_norm[lane];
    p.KCMP[((size_t)(b * NCMP + c) * 2 + g) * 64 + lane] = o;
  } else {
    p.VCMP[((size_t)(b * NCMP + c) * 2 + g) * 64 + lane] = o;
  }
}

__global__ __launch_bounds__(64) void k_diffattn(P p) {
  const int lane = threadIdx.x;
  const int s = blockIdx.x * 64 + lane;
  const int b = blockIdx.y >> 3, hd = blockIdx.y & 7;
  const int t = b * SEQ + s;
  float mq = 0.f, mk = 0.f, l0 = 0.f, l1 = 0.f;
  for (int i = 0; i < 32; i++) {
    mq = fmaxf(mq, fabsf(p.dq_norm[i])); mk = fmaxf(mk, fabsf(p.dk_norm[i]));
    l0 += p.dlam[i] * p.dlam[32 + i]; l1 += p.dlam[64 + i] * p.dlam[96 + i];
  }
  const float scale = 0.17677669529663687f;
  const float bound = 32.f * mq * mk * scale;
  const float lam = __expf(l0) - __expf(l1) + 0.2f;
  float q1[32], q2[32], o1[64], o2[64];
  const float* hq = p.H + (size_t)t * INC + OFF_DQ + hd * 64;
#pragma unroll
  for (int d = 0; d < 32; d++) { q1[d] = hq[d] * scale; q2[d] = hq[32 + d] * scale; }
#pragma unroll
  for (int d = 0; d < 64; d++) { o1[d] = 0.f; o2[d] = 0.f; }
  float s1 = 0.f, s2 = 0.f;
  const int jmax = blockIdx.x * 64 + 63;
  for (int j = 0; j <= jmax; j++) {
    const float* kr = p.H + (size_t)(b * SEQ + j) * INC + OFF_DK + hd * 64;
    const float* vr = p.H + (size_t)(b * SEQ + j) * INC + OFF_DV + hd * 64;
    float a1 = 0.f, a2 = 0.f;
#pragma unroll
    for (int d = 0; d < 32; d++) { a1 += q1[d] * kr[d]; a2 += q2[d] * kr[32 + d]; }
    float p1 = (j <= s) ? __expf(a1 - bound) : 0.f;
    float p2 = (j <= s) ? __expf(a2 - bound) : 0.f;
    s1 += p1; s2 += p2;
#pragma unroll
    for (int d = 0; d < 64; d++) { float v = vr[d]; o1[d] += p1 * v; o2[d] += p2 * v; }
  }
  const float i1 = 1.f / s1, i2 = lam / s2;
  float ss = 0.f;
#pragma unroll
  for (int d = 0; d < 64; d++) { o1[d] = o1[d] * i1 - o2[d] * i2; ss += o1[d] * o1[d]; }
  const float r = rsqrtf(ss * (1.f / 64.f) + 1e-6f) * 0.8f;
  float* oc = p.CAT + (size_t)t * DM + hd * 64;
#pragma unroll
  for (int d = 0; d < 64; d++) oc[d] = o1[d] * r * p.dsubln[d];
}

__device__ __forceinline__ void nsa_dense_block(const P& p, int b, int s, int key0, int kcol, int vcol, float bound,
                                                const float (*q)[64], float (*ps)[64], float* lsum, float* oacc, int lane) {
  const int key = key0 + lane;
  const bool valid = (key >= 0) && (key <= s);
  float pj[4] = {0.f, 0.f, 0.f, 0.f};
  if (valid) {
    const float4* kr = (const float4*)(p.H + (size_t)(b * SEQ + key) * INC + kcol);
    float d0 = 0.f, d1 = 0.f, d2 = 0.f, d3 = 0.f;
#pragma unroll
    for (int i = 0; i < 16; i++) {
      float4 kk = kr[i];
      const float4 q0 = *(const float4*)&q[0][i * 4];
      const float4 q1 = *(const float4*)&q[1][i * 4];
      const float4 q2 = *(const float4*)&q[2][i * 4];
      const float4 q3 = *(const float4*)&q[3][i * 4];
      d0 += kk.x * q0.x + kk.y * q0.y + kk.z * q0.z + kk.w * q0.w;
      d1 += kk.x * q1.x + kk.y * q1.y + kk.z * q1.z + kk.w * q1.w;
      d2 += kk.x * q2.x + kk.y * q2.y + kk.z * q2.z + kk.w * q2.w;
      d3 += kk.x * q3.x + kk.y * q3.y + kk.z * q3.z + kk.w * q3.w;
    }
    pj[0] = __expf(d0 * 0.125f - bound); pj[1] = __expf(d1 * 0.125f - bound);
    pj[2] = __expf(d2 * 0.125f - bound); pj[3] = __expf(d3 * 0.125f - bound);
  }
#pragma unroll
  for (int j = 0; j < 4; j++) { lsum[j] += pj[j]; ps[j][lane] = pj[j]; }
  __syncthreads();
  int klo = key0 < 0 ? -key0 : 0;
  int khi = (s - key0) < 63 ? (s - key0) : 63;
  for (int kk = klo; kk <= khi; kk++) {
    float v = p.H[(size_t)(b * SEQ + key0 + kk) * INC + vcol + lane];
#pragma unroll
    for (int j = 0; j < 4; j++) oacc[j] += ps[j][kk] * v;
  }
  __syncthreads();
}

__global__ __launch_bounds__(64) void k_nsa(P p) {
  __shared__ float q[4][64];
  __shared__ float pc[4][256];
  __shared__ float ps[4][64];
  const int lane = threadIdx.x;
  const int t = blockIdx.x, g = blockIdx.y;
  const int b = t >> 12, s = t & (SEQ - 1);
  const float* hrow = p.H + (size_t)t * INC;
  float mq = 0.f, mk0 = 0.f, mk1 = 0.f, mk2 = 0.f;
  for (int i = 0; i < 64; i++) {
    mq = fmaxf(mq, fabsf(p.nq_norm[i]));
    mk0 = fmaxf(mk0, fabsf(p.nk_norm[i])); mk1 = fmaxf(mk1, fabsf(p.nk_norm[64 + i])); mk2 = fmaxf(mk2, fabsf(p.nk_norm[128 + i]));
  }
  const float bound0 = 8.f * mq * mk0, bound1 = 8.f * mq * mk1, bound2 = 8.f * mq * mk2;
#pragma unroll
  for (int j = 0; j < 4; j++) q[j][lane] = hrow[OFF_NQ + (g * 4 + j) * 64 + lane];
  __syncthreads();
  int nvalid = (s >= 31) ? ((s - 31) / 16 + 1) : 0;
  if (nvalid > NCMP) nvalid = NCMP;
  float lc[4] = {0.f, 0.f, 0.f, 0.f};
  for (int cb = 0; cb < 256; cb += 64) {
    int c = cb + lane;
    float pj[4] = {0.f, 0.f, 0.f, 0.f};
    if (c < nvalid) {
      const float4* kr = (const float4*)(p.KCMP + ((size_t)(b * NCMP + c) * 2 + g) * 64);
      float d0 = 0.f, d1 = 0.f, d2 = 0.f, d3 = 0.f;
#pragma unroll
      for (int i = 0; i < 16; i++) {
        float4 kk = kr[i];
        const float4 q0 = *(const float4*)&q[0][i * 4];
        const float4 q1 = *(const float4*)&q[1][i * 4];
        const float4 q2 = *(const float4*)&q[2][i * 4];
        const float4 q3 = *(const float4*)&q[3][i * 4];
        d0 += kk.x * q0.x + kk.y * q0.y + kk.z * q0.z + kk.w * q0.w;
        d1 += kk.x * q1.x + kk.y * q1.y + kk.z * q1.z + kk.w * q1.w;
        d2 += kk.x * q2.x + kk.y * q2.y + kk.z * q2.z + kk.w * q2.w;
        d3 += kk.x * q3.x + kk.y * q3.y + kk.z * q3.z + kk.w * q3.w;
      }
      pj[0] = __expf(d0 * 0.125f - bound0); pj[1] = __expf(d1 * 0.125f - bound0);
      pj[2] = __expf(d2 * 0.125f - bound0); pj[3] = __expf(d3 * 0.125f - bound0);
    }
#pragma unroll
    for (int j = 0; j < 4; j++) { lc[j] += pj[j]; pc[j][c] = pj[j]; }
  }
#pragma unroll
  for (int j = 0; j < 4; j++) { lc[j] = wave_sum(lc[j]); lc[j] = (nvalid > 0) ? 1.f / lc[j] : 0.f; }
  __syncthreads();
  for (int cb = 0; cb < 256; cb += 64) {
#pragma unroll
    for (int j = 0; j < 4; j++) pc[j][cb + lane] *= lc[j];
  }
  __syncthreads();
  float ocmp[4] = {0.f, 0.f, 0.f, 0.f};
  for (int c = 0; c < nvalid; c++) {
    float v = p.VCMP[((size_t)(b * NCMP + c) * 2 + g) * 64 + lane];
#pragma unroll
    for (int j = 0; j < 4; j++) ocmp[j] += pc[j][c] * v;
  }
  const int cur = s >> 6;
  float imp = 0.f;
  {
    int clo = 4 * lane - 1; if (clo < 0) clo = 0;
    int chi = 4 * lane + 3; if (chi > NCMP - 1) chi = NCMP - 1;
    for (int c = clo; c <= chi; c++) imp += pc[0][c] + pc[1][c] + pc[2][c] + pc[3][c];
  }
  if (lane == cur || lane == 0) imp = 1e4f;
  else if (lane > cur) imp = -1e30f;
  int rank = 0;
  for (int i = 0; i < 64; i++) {
    float vi = __shfl(imp, i, 64);
    rank += (vi > imp || (vi == imp && i < lane)) ? 1 : 0;
  }
  unsigned long long selmask = __ballot(rank < 16);
  float lsel[4] = {0.f, 0.f, 0.f, 0.f}, osel[4] = {0.f, 0.f, 0.f, 0.f};
  const int kcol1 = OFF_NKV + ((1 * 2 + 0) * 2 + g) * 64, vcol1 = OFF_NKV + ((1 * 2 + 1) * 2 + g) * 64;
  for (int blk = 0; blk <= cur; blk++) {
    if (!((selmask >> blk) & 1ull)) continue;
    nsa_dense_block(p, b, s, blk * 64, kcol1, vcol1, bound1, q, ps, lsel, osel, lane);
  }
  float lwin[4] = {0.f, 0.f, 0.f, 0.f}, owin[4] = {0.f, 0.f, 0.f, 0.f};
  const int kcol2 = OFF_NKV + ((2 * 2 + 0) * 2 + g) * 64, vcol2 = OFF_NKV + ((2 * 2 + 1) * 2 + g) * 64;
  for (int key0 = s - 511; key0 <= s; key0 += 64) {
    if (key0 + 63 < 0) continue;
    nsa_dense_block(p, b, s, key0, kcol2, vcol2, bound2, q, ps, lwin, owin, lane);
  }
#pragma unroll
  for (int j = 0; j < 4; j++) {
    float ls = wave_sum(lsel[j]), lw = wave_sum(lwin[j]);
    int hh = g * 4 + j;
    float g0 = hrow[OFF_NG + hh * 3 + 0], g1 = hrow[OFF_NG + hh * 3 + 1], g2 = hrow[OFF_NG + hh * 3 + 2];
    p.CAT[(size_t)t * DM + 512 + hh * 64 + lane] = g0 * ocmp[j] + g1 * osel[j] / ls + g2 * owin[j] / lw;
  }
}

__global__ __launch_bounds__(256) void k_router(P p, int layer) {
  __shared__ float lg[4][40];
  const int w = threadIdx.x >> 6, lane = threadIdx.x & 63;
  const int t = blockIdx.x * 4 + w;
  const float* xr = p.XN2 + (size_t)t * DM;
  const float* wg = p.rg_w + (size_t)layer * DM * 4;
  const float* we = p.re_w + (size_t)layer * DM * 32;
  float acc[36];
#pragma unroll
  for (int i = 0; i < 36; i++) acc[i] = 0.f;
#pragma unroll 1
  for (int it = 0; it < 16; it++) {
    int k = it * 64 + lane;
    float xv = xr[k];
    float4 g4 = *(const float4*)(wg + k * 4);
    acc[0] += xv * g4.x; acc[1] += xv * g4.y; acc[2] += xv * g4.z; acc[3] += xv * g4.w;
#pragma unroll
    for (int i = 0; i < 8; i++) {
      float4 e4 = *(const float4*)(we + k * 32 + i * 4);
      acc[4 + i * 4 + 0] += xv * e4.x; acc[4 + i * 4 + 1] += xv * e4.y; acc[4 + i * 4 + 2] += xv * e4.z; acc[4 + i * 4 + 3] += xv * e4.w;
    }
  }
#pragma unroll
  for (int i = 0; i < 36; i++) { float v = wave_sum(acc[i]); if (lane == 0) lg[w][i] = v; }
  __syncthreads();
  if (lane == 0) {
    const float* bg = p.rg_b + layer * 4;
    const float* be = p.re_b + layer * 32;
    float gl[4]; int gi = 0; float gm = -3.4e38f;
    for (int i = 0; i < 4; i++) { gl[i] = lg[w][i] + bg[i]; if (gl[i] > gm) { gm = gl[i]; gi = i; } }
    float gs = 0.f;
    for (int i = 0; i < 4; i++) gs += __expf(gl[i] - gm);
    float grp_p = 1.f / gs;
    float v0 = -3.4e38f, v1 = -3.4e38f; int i0 = 0, i1 = 0;
    for (int i = 0; i < 8; i++) {
      float v = lg[w][4 + gi * 8 + i] + be[gi * 8 + i];
      if (v > v0) { v1 = v0; i1 = i0; v0 = v; i0 = i; }
      else if (v > v1) { v1 = v; i1 = i; }
    }
    float e1 = __expf(v1 - v0);
    float ga = grp_p / (1.f + e1), gb = grp_p * e1 / (1.f + e1);
    int ea = gi * 8 + i0, eb = gi * 8 + i1;
    int sa = atomicAdd(&p.CNT[ea], 1);
    p.LIST[(size_t)ea * CAP + sa] = 2 * t; p.PGATE[2 * t] = ga;
    int sb = atomicAdd(&p.CNT[eb], 1);
    p.LIST[(size_t)eb * CAP + sb] = 2 * t + 1; p.PGATE[2 * t + 1] = gb;
  }
}

__global__ __launch_bounds__(64) void k_rwkv(P p) {
  __shared__ float s_r[64], s_d[64], s_k[64], s_kk[64], s_b[64];
  const int lane = threadIdx.x;
  const int b = blockIdx.x >> 4, hd = blockIdx.x & 15;
  const int c = hd * 64 + lane;
  const float kkc = p.k_k[c], kac = p.k_a[c], rkc = p.r_k[c], lnw = p.ln_w[c], lnb = p.ln_b[c];
  float S[64];
#pragma unroll
  for (int i = 0; i < 64; i++) S[i] = 0.f;
  for (int st = 0; st < SEQ; st++) {
    const size_t idx = (size_t)(b * SEQ + st) * DM + c;
    const float r_ = bf2f(p.R[idx]), w_ = bf2f(p.W[idx]), k_ = bf2f(p.K[idx]), v_ = bf2f(p.V[idx]), a_ = bf2f(p.A[idx]), g_ = bf2f(p.G[idx]);
    float kkraw = k_ * kkc;
    float nrm = sqrtf(wave_sum(kkraw * kkraw));
    float kk = kkraw / fmaxf(nrm, 1e-12f);
    float kmod = k_ * (1.f + (a_ - 1.f) * kac);
    float dec = __expf(-__expf(w_));
    float bonus = wave_sum(r_ * kmod * rkc);
    s_r[lane] = r_; s_d[lane] = dec; s_k[lane] = kmod; s_kk[lane] = kk; s_b[lane] = kk * a_;
    __syncthreads();
    float sk = 0.f;
#pragma unroll
    for (int i = 0; i < 64; i++) sk += S[i] * s_kk[i];
    sk = -sk;
    float y = 0.f;
#pragma unroll
    for (int i = 0; i < 64; i++) {
      S[i] = S[i] * s_d[i] + sk * s_b[i] + v_ * s_k[i];
      y += S[i] * s_r[i];
    }
    float mu = wave_sum(y) * (1.f / 64.f);
    float dv = y - mu;
    float var = wave_sum(dv * dv) * (1.f / 64.f);
    float yn = dv * rsqrtf(var + 64e-5f) * lnw + lnb + bonus * v_;
    p.Z[idx] = f2bf(yn * g_);
    __syncthreads();
  }
}

template <int MODE>
static void launch_gemm(const P& p, int M, int N, int K, int sub, int nz, hipStream_t st) {
  GF<MODE> f{}; f.p = p; f.K = K; f.N = N; f.sub = sub;
  dim3 grid((N + 63) / 64, M / 64, nz);
  hipLaunchKernelGGL(k_gemm<MODE>, grid, dim3(256), 0, st, f);
}

static void run_moe(P p, int layer, hipStream_t st) {
  hipLaunchKernelGGL(k_rmsnorm_write, dim3(T_TOK / 4), dim3(256), 0, st, (const float*)p.out, p.ffn_norm + layer * DM, p.XN2);
  (void)hipMemsetAsync(p.CNT, 0, 32 * sizeof(int), st);
  hipLaunchKernelGGL(k_router, dim3(T_TOK / 4), dim3(256), 0, st, p, layer);
  P q = p;
  q.e_gate = p.e_gate + (size_t)layer * 32 * DM * 256;
  q.e_up = p.e_up + (size_t)layer * 32 * DM * 256;
  q.e_down = p.e_down + (size_t)layer * 32 * 256 * DM;
  launch_gemm<G_MOE_GU>(q, CAP, 512, DM, 0, 32, st);
  launch_gemm<G_MOE_DOWN>(q, CAP, DM, 256, 0, 32, st);
}

extern "C" void kernel_launch(void* const* d_in, const int* in_sizes, int n_in, void* d_out, int out_size, void* d_ws,
                              size_t ws_size, hipStream_t stream) {
  P p{};
  const float* const* in = (const float* const*)d_in;
  p.x = in[0]; p.mix_norm = in[1]; p.w_in = in[2]; p.gate_bias = in[3]; p.dq_norm = in[4]; p.dk_norm = in[5];
  p.dlam = in[6]; p.dsubln = in[7]; p.nq_norm = in[8]; p.nk_norm = in[9]; p.cmp_pe = in[10]; p.cmp_w1 = in[11];
  p.cmp_w2 = in[12]; p.w_out = in[13]; p.rmix = in[14]; p.w_r = in[15]; p.w_k = in[16]; p.w_v = in[17];
  p.w0 = in[18]; p.w1 = in[19]; p.w2 = in[20]; p.a0 = in[21]; p.a1 = in[22]; p.a2 = in[23]; p.g1 = in[24]; p.g2 = in[25];
  p.k_k = in[26]; p.k_a = in[27]; p.r_k = in[28]; p.ln_w = in[29]; p.ln_b = in[30]; p.w_o = in[31];
  p.ffn_norm = in[32]; p.rg_w = in[33]; p.rg_b = in[34]; p.re_w = in[35]; p.re_b = in[36];
  p.e_gate = in[37]; p.e_up = in[38]; p.e_down = in[39];
  p.out = (float*)d_out;
  char* ws = (char*)d_ws;
  p.H = (float*)ws;
  p.CAT = (float*)(ws + (size_t)T_TOK * INC * 4);
  char* sm = ws + 256000000;
  p.KCMP = (float*)sm; sm += 4 * NCMP * 2 * 64 * 4;
  p.VCMP = (float*)sm; sm += 4 * NCMP * 2 * 64 * 4;
  p.RS = (float*)sm; sm += T_TOK * 4;
  p.CNT = (int*)sm; sm += 256;
  p.PGATE = (float*)sm; sm += T_TOK * 2 * 4;
  p.LIST = (int*)sm; sm += (size_t)32 * CAP * 4;
  p.XN2 = (float*)ws;
  p.GU = (float*)(ws + (size_t)T_TOK * DM * 4);
  p.R = (bf16_t*)ws;
  p.K = p.R + (size_t)T_TOK * DM; p.V = p.K + (size_t)T_TOK * DM; p.W = p.V + (size_t)T_TOK * DM;
  p.A = p.W + (size_t)T_TOK * DM; p.G = p.A + (size_t)T_TOK * DM;
  p.TMP1 = (float*)(p.G + (size_t)T_TOK * DM);
  p.Z = (bf16_t*)(p.TMP1 + (size_t)T_TOK * 288);

  hipLaunchKernelGGL(k_rowrms, dim3(T_TOK / 4), dim3(256), 0, stream, p.x, p.RS);
  launch_gemm<G_INPROJ>(p, T_TOK, INC, DM, 0, 1, stream);
  hipLaunchKernelGGL(k_headnorm, dim3(T_TOK), dim3(64), 0, stream, p);
  hipLaunchKernelGGL(k_compress, dim3(NBATCH * NCMP * 2 * 2), dim3(64), 0, stream, p);
  hipLaunchKernelGGL(k_diffattn, dim3(SEQ / 64, NBATCH * 8), dim3(64), 0, stream, p);
  hipLaunchKernelGGL(k_nsa, dim3(T_TOK, 2), dim3(64), 0, stream, p);
  launch_gemm<G_OUTPROJ>(p, T_TOK, DM, DM, 0, 1, stream);
  run_moe(p, 0, stream);
  hipLaunchKernelGGL(k_rowrms, dim3(T_TOK / 4), dim3(256), 0, stream, (const float*)p.out, p.RS);
  for (int j = 0; j < 3; j++) launch_gemm<G_RKV>(p, T_TOK, DM, DM, j, 1, stream);
  launch_gemm<G_LORA1>(p, T_TOK, 64, DM, 0, 1, stream);
  launch_gemm<G_LORA1>(p, T_TOK, 64, DM, 1, 1, stream);
  launch_gemm<G_LORA1>(p, T_TOK, 160, DM, 2, 1, stream);
  launch_gemm<G_LORA2>(p, T_TOK, DM, 64, 0, 1, stream);
  launch_gemm<G_LORA2>(p, T_TOK, DM, 64, 1, 1, stream);
  launch_gemm<G_LORA2>(p, T_TOK, DM, 160, 2, 1, stream);
  hipLaunchKernelGGL(k_rwkv, dim3(NBATCH * 16), dim3(64), 0, stream, p);
  launch_gemm<G_WO>(p, T_TOK, DM, DM, 0, 1, stream);
  run_moe(p, 1, stream);
}
```

```cpp
#include <hip/hip_runtime.h>
#include <cstdio>
#include <cstdint>

#define T_TOK 16384
#define DM 1024
#define SEQ 4096
#define NBATCH 4
#define INC 2840
#define HC 2816
#define OFF_DQ 0
#define OFF_DK 512
#define OFF_DV 1024
#define OFF_NQ 1536
#define OFF_NKV 2048
#define OFF_NG 2816
#define NCMP 255
#define CAP 16384

#define GAS __attribute__((address_space(1)))
#define LAS __attribute__((address_space(3)))
typedef unsigned short bf16_t;
typedef unsigned v4u __attribute__((ext_vector_type(4)));
typedef unsigned v2u __attribute__((ext_vector_type(2)));
typedef float f32x4 __attribute__((ext_vector_type(4)));
typedef short bf16x8 __attribute__((ext_vector_type(8)));
typedef GAS unsigned gu32;
#define RLX_AGENT __ATOMIC_RELAXED, __HIP_MEMORY_SCOPE_AGENT
#define LDS_WAIT() asm volatile("s_waitcnt lgkmcnt(0)" ::: "memory")
#define VM_WAIT() asm volatile("s_waitcnt vmcnt(0)" ::: "memory")

__device__ __forceinline__ float bf2f(bf16_t v) { return __uint_as_float(((unsigned)v) << 16); }
__device__ __forceinline__ unsigned f2bf(float f) { unsigned u = __builtin_bit_cast(unsigned, f); return (u + 0x7fffu + ((u >> 16) & 1u)) >> 16; }
__device__ __forceinline__ unsigned pk2(float lo, float hi) { return f2bf(lo) | (f2bf(hi) << 16); }
__device__ __forceinline__ float wave_sum(float v) {
#pragma unroll
  for (int o = 32; o >= 1; o >>= 1) v += __shfl_xor(v, o, 64);
  return v;
}
__device__ __forceinline__ float sigmoidf_(float x) { return 1.f / (1.f + __expf(-x)); }
__device__ __forceinline__ float softplusf_(float x) { return fmaxf(x, 0.f) + __logf(1.f + __expf(-fabsf(x))); }
__device__ __forceinline__ float gelu_tanh(float x) {
  float u = 0.7978845608028654f * (x + 0.044715f * x * x * x);
  return 0.5f * x * (1.f + tanhf(u));
}

constexpr size_t MiB = 1u << 20;
constexpr size_t WS_CTL = 0, CTL_ZERO_BYTES = 1 * MiB;
constexpr size_t WS_WIN = 1 * MiB;
constexpr size_t WS_WOUT = 7 * MiB;
constexpr size_t WS_WRKV = 9 * MiB;
constexpr size_t WS_WO = 15 * MiB;
constexpr size_t WS_WL1 = 17 * MiB;
constexpr size_t WS_WL2 = 19 * MiB;
constexpr size_t WS_EGU = 22 * MiB;
constexpr size_t WS_EDN = 54 * MiB;
constexpr size_t WS_ACT = 70 * MiB;
constexpr size_t WS_XN = WS_ACT;
constexpr size_t WS_H = WS_ACT + 32 * MiB;
constexpr size_t WS_GATES = WS_ACT + 120 * MiB;
constexpr size_t WS_CAT = WS_ACT + 122 * MiB;
constexpr size_t WS_KCMP = WS_ACT + 154 * MiB;
constexpr size_t WS_VCMP = WS_ACT + 155 * MiB;
constexpr size_t WS_XN2 = WS_ACT;
constexpr size_t WS_HID = WS_ACT + 32 * MiB;
constexpr size_t WS_Y = WS_ACT + 52 * MiB;
constexpr size_t WS_LIST = WS_ACT + 156 * MiB;
constexpr size_t WS_PGATE = WS_ACT + 158 * MiB;
constexpr size_t WS_XN2F = WS_ACT;
constexpr size_t WS_GUF = WS_ACT + 64 * MiB;
constexpr size_t WS_S0 = WS_ACT;
constexpr size_t WS_TMP = WS_ACT + 192 * MiB;
constexpr size_t WS_END = WS_ACT + 204 * MiB;
constexpr size_t SLOT = 32 * MiB;
constexpr int CW_BAR = 4096;
constexpr int CW_CNT = 32768;

namespace pg8 {
#define PG8_LAS __attribute__((address_space(3)))
typedef unsigned u32x4 __attribute__((ext_vector_type(4)));
constexpr int BM = 256, BK = 64, HALF = 128, HTB = HALF * BK * 2  , STAGE_BYTES = 8 * HTB, NXCD = 8, WGM = 8;

__host__ __device__ __forceinline__ int lds_byte(int r, int c) { const int st = (r >> 4) * 2 + (c >> 5), rr = r & 15, cc = c & 31, ob = rr * 64 + cc * 2; return st * 1024 + (ob ^ (((ob >> 9) & 1) << 5)); }
__host__ __device__ __forceinline__ void stage_rc(int b, int& R, int& C) { const int st = b / 1024, sb = b % 1024, swz = sb ^ (((sb >> 9) & 1) << 5); R = (st >> 1) * 16 + swz / 64; C = (st & 1) * 32 + (swz % 64) / 2; }
__host__ __device__ __forceinline__ int perm32(int rho) { const int n = rho >> 4, i = rho & 15; return 8 * (i >> 2) + 4 * n + (i & 3); }

struct Unit { int pm, pn, e, nrows; };
struct Gemm { const bf16_t* A; const bf16_t* Bt; int K; };

__device__ __forceinline__ void static_map(int L, int nM, int nN, int& pm, int& pn) {
    const int nwg = nM * nN;
    int wgid = L; { const int q = nwg / NXCD, r = nwg % NXCD, xcd = wgid % NXCD, off = wgid / NXCD; wgid = (xcd < r ? xcd * (q + 1) : r * (q + 1) + (xcd - r) * q) + off; }
    const int nig = WGM * nN, gid = wgid / nig, fm = gid * WGM, gsz = (nM - fm) < WGM ? (nM - fm) : WGM;
    pm = fm + ((wgid % nig) % gsz); pn = (wgid % nig) / gsz;
}
struct StaticOrder {
    int nM, nN, G, c;
    __device__ void init(int M, int N, int G_, int c_) { nM = M / BM; nN = N / BM; G = G_; c = c_; }
    __device__ __forceinline__ bool next(int i, Unit& u) const {
        const int L = i * G + c; if (L >= nM * nN) return false;
        static_map(L, nM, nN, u.pm, u.pn); u.e = 0; u.nrows = 256; return true;
    }
    __device__ __forceinline__ unsigned rowoff(const Unit& u, int r, int C, int K) const { return (unsigned)((u.pm * BM + r) * K + C) * 2u; }
};
struct TallOrder {
    int nM, nN, G, c;
    __device__ void init(int ngemm, int nN_, int G_, int c_) { nM = 64 * ngemm; nN = nN_; G = G_; c = c_; }
    __device__ __forceinline__ bool next(int i, Unit& u) const {
        const int L = i * G + c; if (L >= nM * nN) return false;
        int pn; static_map(L, nM, nN, u.pm, pn); u.pn = (u.pm >> 6) * nN + pn; u.e = 0; u.nrows = 256; return true;
    }
    __device__ __forceinline__ unsigned rowoff(const Unit& u, int r, int C, int K) const { return (unsigned)((u.pm * BM + r) * K + C) * 2u; }
};

__device__ __forceinline__ unsigned cvt_pk_bf16(float lo, float hi) { unsigned r; asm volatile("v_cvt_pk_bf16_f32 %0, %1, %2" : "=v"(r) : "v"(lo), "v"(hi)); return r; }
__device__ __forceinline__ u32x4 pack8(const f32x4& a, const f32x4& b) { u32x4 w; w.x = cvt_pk_bf16(a[0], a[1]); w.y = cvt_pk_bf16(a[2], a[3]); w.z = cvt_pk_bf16(b[0], b[1]); w.w = cvt_pk_bf16(b[2], b[3]); return w; }

template <class Epi, class Sched, bool ALIGN_EPI>
__device__ __forceinline__ void gemm_phase(PG8_LAS unsigned char* lds, const Gemm g, const Sched& S, const Epi& E) {
    const int tid = threadIdx.x, wid = __builtin_amdgcn_readfirstlane(tid >> 6), lane = tid & 63, wr = wid >> 2, wc = wid & 3, fr = lane & 15, fq = lane >> 4;
    const int K = g.K, nt = K / BK;
    int RA[2], CA[2]; unsigned voffB[2];
#pragma unroll
    for (int i = 0; i < 2; ++i) { int R, C; stage_rc(tid * 16 + i * 8192, R, C); const int Rb = Epi::PERM ? ((R & ~31) + perm32(R & 31)) : R;
        RA[i] = R; CA[i] = C; voffB[i] = (unsigned)(Rb * K + C) * 2u; }
    const size_t kstep = (size_t)(BK * 2);
    const size_t hstep = (size_t)HALF * K * 2;
    const size_t tstep = 2 * hstep;
    const unsigned ldsw = (unsigned)wid * 1024u;
    const int aoff = lds_byte(wr * 64 + fr, fq * 8), boff = lds_byte(wc * 32 + fr, fq * 8);
    const char* const Abase = (const char*)g.A;
#define PG8_SA(b, h) (((b) * 2 + (h)) * HTB)
#define PG8_SB(b, h) ((4 + (b) * 2 + (h)) * HTB)
#define PG8_STAGE(bufoff, gbase, voff) do { _Pragma("unroll") for (int _i = 0; _i < 2; ++_i) \
        __builtin_amdgcn_global_load_lds((const unsigned*)((const char*)(gbase) + (voff)[_i]), (PG8_LAS unsigned*)(lds + (bufoff) + ldsw + _i * 8192), 16, 0, 0); } while (0)
#define PG8_STAGEA(bufoff, kbyte, o0, o1) do { \
        __builtin_amdgcn_global_load_lds((const unsigned*)(Abase + (size_t)(kbyte) + (o0)), (PG8_LAS unsigned*)(lds + (bufoff) + ldsw), 16, 0, 0); \
        __builtin_amdgcn_global_load_lds((const unsigned*)(Abase + (size_t)(kbyte) + (o1)), (PG8_LAS unsigned*)(lds + (bufoff) + ldsw + 8192), 16, 0, 0); } while (0)
#define PG8_LDA(dst, b, h) do { _Pragma("unroll") for (int m = 0; m < 4; ++m) _Pragma("unroll") for (int k = 0; k < 2; ++k) dst[m][k] = *(const PG8_LAS bf16x8*)(lds + PG8_SA(b, h) + aoff + m * 2048 + k * 1024); } while (0)
#define PG8_LDB(dst, b, h) do { _Pragma("unroll") for (int n = 0; n < 2; ++n) _Pragma("unroll") for (int k = 0; k < 2; ++k) dst[n][k] = *(const PG8_LAS bf16x8*)(lds + PG8_SB(b, h) + boff + n * 2048 + k * 1024); } while (0)
#define PG8_MMA(ai, bj, At, Bt) do { __builtin_amdgcn_s_setprio(1); _Pragma("unroll") for (int m = 0; m < 4; ++m) _Pragma("unroll") for (int n = 0; n < 2; ++n) _Pragma("unroll") for (int k = 0; k < 2; ++k) \
        acc[ai][bj][m][n] = __builtin_amdgcn_mfma_f32_16x16x32_bf16(Bt[n][k], At[m][k], acc[ai][bj][m][n], 0, 0, 0); __builtin_amdgcn_s_setprio(0); } while (0)
#define PG8_WAIT_V(n) asm volatile("s_waitcnt vmcnt(" #n ")" ::: "memory")
#define PG8_WAIT_L(n) asm volatile("s_waitcnt lgkmcnt(" #n ")" ::: "memory")
#define PG8_BAR __builtin_amdgcn_s_barrier()
#define PG8_SCHED __builtin_amdgcn_sched_barrier(0)
    Unit cur, nxt; int ui = 0;
    if (!S.next(0, cur)) return;
    f32x4 acc[2][2][4][2];
#pragma unroll
    for (int a = 0; a < 2; ++a)
#pragma unroll
        for (int b = 0; b < 2; ++b)
#pragma unroll
            for (int m = 0; m < 4; ++m)
#pragma unroll
                for (int n = 0; n < 2; ++n) acc[a][b][m][n] = (f32x4){0.f, 0.f, 0.f, 0.f};
    bf16x8 At[4][2], B0[2][2], B1[2][2];
    unsigned c00 = S.rowoff(cur, RA[0], CA[0], K), c01 = S.rowoff(cur, RA[1], CA[1], K), c10 = S.rowoff(cur, HALF + RA[0], CA[0], K), c11 = S.rowoff(cur, HALF + RA[1], CA[1], K);
    unsigned n00, n01, n10, n11;
    const char* cB = (const char*)g.Bt + (size_t)cur.pn * tstep;
    PG8_STAGE(PG8_SB(0, 0), cB, voffB); PG8_STAGE(PG8_SB(0, 1), cB + hstep, voffB); PG8_STAGEA(PG8_SA(0, 0), 0, c00, c01); PG8_STAGEA(PG8_SA(0, 1), 0, c10, c11);
    if (wr == 1) PG8_BAR;
    PG8_WAIT_V(2); PG8_BAR;
    PG8_STAGE(PG8_SB(1, 0), cB + kstep, voffB); PG8_STAGEA(PG8_SA(1, 0), kstep, c00, c01); PG8_STAGE(PG8_SB(1, 1), cB + hstep + kstep, voffB);
    PG8_WAIT_V(6); PG8_BAR;
    for (;;) {
        const bool has_next = S.next(ui + 1, nxt);
        const char* nB = has_next ? (const char*)g.Bt + (size_t)nxt.pn * tstep : cB;
        if (has_next) { n00 = S.rowoff(nxt, RA[0], CA[0], K); n01 = S.rowoff(nxt, RA[1], CA[1], K); n10 = S.rowoff(nxt, HALF + RA[0], CA[0], K); n11 = S.rowoff(nxt, HALF + RA[1], CA[1], K); }
        else { n00 = c00; n01 = c01; n10 = c10; n11 = c11; }
        for (int t = 0; t < nt; t += 2) {
            const bool last = (t == nt - 2);
            const size_t k1 = (size_t)(t + 1) * kstep;
            const size_t k2 = last ? 0 : (size_t)(t + 2) * kstep;
            const size_t k3 = k2 + kstep;
            const unsigned a00 = last ? n00 : c00, a01 = last ? n01 : c01, a10 = last ? n10 : c10, a11 = last ? n11 : c11;
            const char* b2 = last ? nB : cB + (size_t)(t + 2) * kstep;
            const char* b3 = b2 + kstep;
            PG8_LDB(B0, 0, 0); PG8_LDB(B1, 0, 1); PG8_SCHED; PG8_LDA(At, 0, 0); PG8_STAGEA(PG8_SA(1, 1), k1, c10, c11);
            PG8_WAIT_V(8); PG8_WAIT_L(0); PG8_BAR; PG8_MMA(0, 0, At, B0); PG8_MMA(0, 1, At, B1); PG8_BAR; PG8_SCHED;
            PG8_LDA(At, 0, 1); PG8_STAGE(PG8_SB(0, 0), b2, voffB); PG8_STAGE(PG8_SB(0, 1), b2 + hstep, voffB); PG8_STAGEA(PG8_SA(0, 0), k2, a00, a01);
            PG8_WAIT_V(8); PG8_WAIT_L(0); PG8_BAR; PG8_MMA(1, 0, At, B0); PG8_MMA(1, 1, At, B1); PG8_BAR; PG8_SCHED;
            PG8_LDB(B0, 1, 0); PG8_LDB(B1, 1, 1); PG8_SCHED; PG8_LDA(At, 1, 0); PG8_STAGEA(PG8_SA(0, 1), k2, a10, a11);
            PG8_WAIT_V(8); PG8_WAIT_L(0); PG8_BAR; PG8_MMA(0, 0, At, B0); PG8_MMA(0, 1, At, B1); PG8_BAR; PG8_SCHED;
            PG8_LDA(At, 1, 1); PG8_STAGE(PG8_SB(1, 0), b3, voffB); PG8_STAGE(PG8_SB(1, 1), b3 + hstep, voffB); PG8_STAGEA(PG8_SA(1, 0), k3, a00, a01);
            PG8_WAIT_V(8); PG8_WAIT_L(0); PG8_BAR; PG8_MMA(1, 0, At, B0); PG8_MMA(1, 1, At, B1); PG8_BAR; PG8_SCHED;
        }
        if constexpr (ALIGN_EPI) { if (wr == 0) PG8_BAR; }
        E(acc, cur, wr, wc, fr, fq);
        if (!has_next) break;
#pragma unroll
        for (int a = 0; a < 2; ++a)
#pragma unroll
            for (int b = 0; b < 2; ++b)
#pragma unroll
                for (int m = 0; m < 4; ++m)
#pragma unroll
                    for (int n = 0; n < 2; ++n) acc[a][b][m][n] = (f32x4){0.f, 0.f, 0.f, 0.f};
        cur = nxt; cB = nB; c00 = n00; c01 = n01; c10 = n10; c11 = n11; ++ui;
        if constexpr (ALIGN_EPI) { if (wr == 1) PG8_BAR; }
    }
    PG8_WAIT_V(0);
    if constexpr (!ALIGN_EPI) { if (wr == 0) PG8_BAR; }
    PG8_BAR;
#undef PG8_SA
#undef PG8_SB
#undef PG8_STAGE
#undef PG8_STAGEA
#undef PG8_LDA
#undef PG8_LDB
#undef PG8_MMA
#undef PG8_WAIT_V
#undef PG8_WAIT_L
#undef PG8_BAR
#undef PG8_SCHED
}
}

#define XB_TMO      128
#define XB_XCNT(j)  (256  + 64 * (j))
#define XB_XSUB(j)  (1280 + 64 * (j))
#define XB_XGEN(j)  (2304 + 64 * (j))
#define XB_TOP      3328
#define XB_TOPGEN   3392
#define XCD_BAR_WORDS 3456
#define XB_SPIN_CAP (1u << 18)

__device__ __forceinline__ unsigned xb_ld(unsigned* p)              { return __hip_atomic_load(p, __ATOMIC_RELAXED, __HIP_MEMORY_SCOPE_AGENT); }
__device__ __forceinline__ unsigned xb_add(unsigned* p, unsigned v) { return __hip_atomic_fetch_add(p, v, __ATOMIC_RELAXED, __HIP_MEMORY_SCOPE_AGENT); }
__device__ __forceinline__ unsigned xb_xcc_id() { return (unsigned)__builtin_amdgcn_s_getreg((3 << 11) | 20) & 0xFu; }
#define XB_SPIN(cond, bar) do { unsigned _sp = 0; while (cond) { __builtin_amdgcn_s_sleep(1); \
    if ((++_sp & 255u) == 0u) { if (xb_ld(&(bar)[XB_TMO])) break; if (_sp > XB_SPIN_CAP) { atomicAdd(&(bar)[XB_TMO], 1u); break; } } } } while (0)

struct XcdBarrier {
    unsigned* bar; unsigned x;
    volatile LAS unsigned* st;
};

__device__ __forceinline__ XcdBarrier xcd_barrier_post(unsigned* bar, volatile LAS unsigned* st) {
    XcdBarrier b; b.bar = bar; b.x = xb_xcc_id(); b.st = st;
    if (threadIdx.x == 0) (void)xb_add(&bar[XB_XCNT(b.x)], 1u);
    return b;
}
__device__ __forceinline__ void xcd_barrier_complete(unsigned* bar, unsigned x, unsigned& nloc, unsigned& nx) {
    const unsigned G = gridDim.x * gridDim.y * gridDim.z;
    unsigned sum, cnt, mine, sp = 0u;
    for (;;) {
        sum = 0u; cnt = 0u; mine = 0u;
#pragma unroll
        for (unsigned j = 0; j < 16; ++j) { const unsigned c = xb_ld(&bar[XB_XCNT(j)]); sum += c; cnt += (c > 0u) ? 1u : 0u; mine = (j == x) ? c : mine; }
        if (sum == G) break;
        __builtin_amdgcn_s_sleep(1);
        if ((++sp & 255u) == 0u) { if (xb_ld(&bar[XB_TMO])) break; if (sp > XB_SPIN_CAP) { atomicAdd(&bar[XB_TMO], 1u); break; } }
    }
    nloc = mine > 0u ? mine : 1u; nx = cnt > 0u ? cnt : 1u;
}

__device__ __forceinline__ void xcd_barrier(const XcdBarrier& b) {
    asm volatile("s_waitcnt vmcnt(0)" ::: "memory");
    __syncthreads();
    if (threadIdx.x == 0) {
        unsigned* bar = b.bar;
        __builtin_amdgcn_s_waitcnt(0);
        unsigned nloc = b.st[0], nx = b.st[1];
        if (nloc == 0u) { xcd_barrier_complete(bar, b.x, nloc, nx); b.st[0] = nloc; b.st[1] = nx; }
        const unsigned old = xb_add(&bar[XB_XSUB(b.x)], 1u);
        const unsigned gen = old / nloc;
        if (old + 1u == (gen + 1u) * nloc) {
            __builtin_amdgcn_fence(__ATOMIC_RELEASE, "agent");
            asm volatile("s_waitcnt vmcnt(0)" ::: "memory");
            const unsigned og = xb_add(&bar[XB_TOP], 1u);
            const unsigned tg = og / nx;
            if (og + 1u == (tg + 1u) * nx) xb_add(&bar[XB_TOPGEN], 1u);
            else XB_SPIN(xb_ld(&bar[XB_TOPGEN]) == tg, bar);
            __builtin_amdgcn_fence(__ATOMIC_ACQUIRE, "agent");
            xb_add(&bar[XB_XGEN(b.x)], 1u);
            asm volatile("s_waitcnt vmcnt(0)" ::: "memory");
        } else {
            XB_SPIN(xb_ld(&bar[XB_XGEN(b.x)]) == gen, bar);
            __builtin_amdgcn_fence(__ATOMIC_ACQUIRE, "agent");
            asm volatile("s_waitcnt vmcnt(0)" ::: "memory");
        }
    }
    __syncthreads();
}
struct P {
  const float* x; const float* mix_norm; const float* w_in; const float* gate_bias;
  const float* dq_norm; const float* dk_norm; const float* dlam; const float* dsubln;
  const float* nq_norm; const float* nk_norm; const float* cmp_pe; const float* cmp_w1; const float* cmp_w2;
  const float* w_out;
  const float* rmix; const float* w_r; const float* w_k; const float* w_v;
  const float* w0; const float* w1; const float* w2; const float* a0; const float* a1; const float* a2;
  const float* g1; const float* g2; const float* k_k; const float* k_a; const float* r_k;
  const float* ln_w; const float* ln_b; const float* w_o;
  const float* ffn_norm; const float* rg_w; const float* rg_b; const float* re_w; const float* re_b;
  const float* e_gate; const float* e_up; const float* e_down;
  float* out;
  unsigned char* ws;
  int ph_lo, ph_hi, layer, pad;
};

constexpr int RING_OFF = 0, RING_BYTES = 131072;
constexpr int LDSCTL_OFF = RING_BYTES, MISC_OFF = LDSCTL_OFF + 320;
constexpr int LDS_BYTES = 147456;
constexpr int NWAVES = 8;

struct Frame {
  LAS unsigned char* lds;
  volatile LAS unsigned* MISC;
  gu32* ctl;
  int tid, lane, wave, vcu, G;
};

__device__ __forceinline__ void transpose_item(const float* W, int ldsrc, int k0, int c0, int ncols, bf16_t* dst, int ldk, int drow0, LAS float* scr, int lane) {
#pragma unroll 8
  for (int i = 0; i < 32; ++i) { const int kk = 2 * i + (lane >> 5); const int j = lane & 31; scr[kk * 33 + j] = (j < ncols) ? W[(size_t)(k0 + kk) * ldsrc + c0 + j] : 0.f; }
  LDS_WAIT(); asm volatile("" ::: "memory");
  const int c = lane & 7;
#pragma unroll
  for (int j = 0; j < 4; ++j) { const int n = (lane >> 3) + 8 * j; const LAS float* s = scr + (8 * c) * 33 + n;
    v4u o; o.x = pk2(s[0 * 33], s[1 * 33]); o.y = pk2(s[2 * 33], s[3 * 33]); o.z = pk2(s[4 * 33], s[5 * 33]); o.w = pk2(s[6 * 33], s[7 * 33]);
    *(GAS v4u*)(dst + (size_t)(drow0 + n) * ldk + k0 + 8 * c) = o; }
  LDS_WAIT(); asm volatile("" ::: "memory");
}
__device__ __forceinline__ void rms_row_to_bf16(const float* xrow, const float* gain, bf16_t* orow, int lane) {
  const GAS f32x4* xr = (const GAS f32x4*)xrow + lane;
  const GAS f32x4* gr = (const GAS f32x4*)gain + lane;
  f32x4 v[4]; float s = 0.f;
#pragma unroll
  for (int j = 0; j < 4; ++j) { v[j] = xr[64 * j]; s += (v[j].x * v[j].x + v[j].y * v[j].y) + (v[j].z * v[j].z + v[j].w * v[j].w); }
  const float r = rsqrtf(wave_sum(s) * (1.f / DM) + 1e-6f);
  GAS unsigned long long* o8 = (GAS unsigned long long*)orow + lane;
#pragma unroll
  for (int j = 0; j < 4; ++j) { const f32x4 g = gr[64 * j];
    o8[64 * j] = (unsigned long long)pk2(v[j].x * r * g.x, v[j].y * r * g.y) | ((unsigned long long)pk2(v[j].z * r * g.z, v[j].w * r * g.w) << 32); }
}

__device__ __forceinline__ void conv_win_item(const P& p, int it, LAS float* scr, int lane) {
  const int vg = it >> 4, kb = it & 15;
  const int pn = vg >> 3, bj = (vg >> 2) & 1, wc = vg & 3, s = pn * 4 + wc;
  int c0 = 0, nc = 0;
  if (s < 44) { c0 = 64 * s + 32 * bj; nc = 32; } else if (s == 44 && bj == 0) { c0 = OFF_NG; nc = 24; }
  transpose_item(p.w_in, INC, kb * 64, c0, nc, (bf16_t*)(p.ws + WS_WIN), DM, vg * 32, scr, lane);
}
__device__ __forceinline__ void conv_sq_item(const float* W, bf16_t* dst, int drow_base, int it, LAS float* scr, int lane) {
  const int cg = it >> 4, kb = it & 15;
  transpose_item(W, DM, kb * 64, cg * 32, 32, dst, DM, drow_base + cg * 32, scr, lane);
}
__device__ __forceinline__ void conv_expert_item(const P& p, int layer, int it, LAS float* scr, int lane) {
  const int e = it / 384, r = it % 384;
  if (r < 256) {
    const int up = r >> 7, q = r & 127, cgp = q >> 4, kb = q & 15;
    const int pn = cgp >> 2, qq = cgp & 3;
    const float* W = (up ? p.e_up : p.e_gate) + ((size_t)layer * 32 + e) * DM * 256;
    transpose_item(W, 256, kb * 64, cgp * 32, 32, (bf16_t*)(p.ws + WS_EGU), DM, e * 512 + pn * 256 + up * 128 + qq * 32, scr, lane);
  } else {
    const int q = r - 256, cg = q >> 2, kb = q & 3;
    const float* W = p.e_down + ((size_t)layer * 32 + e) * 256 * DM;
    transpose_item(W, DM, kb * 64, cg * 32, 32, (bf16_t*)(p.ws + WS_EDN), 256, e * 1024 + cg * 32, scr, lane);
  }
}

using pg8::Unit; using pg8::u32x4; using pg8::pack8;
struct EpiInProj {
  static constexpr bool PERM = true;
  bf16_t* H; float* GATES; const float* dq; const float* dk; const float* nq; const float* nk; const float* gbias;
  __device__ __forceinline__ void operator()(const f32x4 (&acc)[2][2][4][2], const Unit& u, int wr, int wc, int fr, int fq) const {
    const int s = u.pn * 4 + wc;
    if (s > 44) return;
    const int row0 = u.pm * 256 + wr * 64 + fr;
    if (s == 44) {
      if (fq < 3) {
        f32x4 b0 = *(const f32x4*)(gbias + 8 * fq), b1 = *(const f32x4*)(gbias + 8 * fq + 4);
#pragma unroll
        for (int ai = 0; ai < 2; ++ai)
#pragma unroll
          for (int m = 0; m < 4; ++m) { float* gp = GATES + (size_t)(row0 + ai * 128 + m * 16) * 24 + 8 * fq;
            f32x4 v0 = acc[ai][0][m][0] + b0, v1 = acc[ai][0][m][1] + b1;
#pragma unroll
            for (int i = 0; i < 4; ++i) { v0[i] = sigmoidf_(v0[i]); v1[i] = sigmoidf_(v1[i]); }
            *(f32x4*)gp = v0; *(f32x4*)(gp + 4) = v1; }
      }
      return;
    }
    int mode = 0; const float* gain = nullptr;
    if (s < 8) { mode = 1; gain = dq; } else if (s < 16) { mode = 1; gain = dk; }
    else if (s >= 24 && s < 32) { mode = 2; gain = nq; }
    else if (s >= 32) { const int q = s - 32, br = q >> 2, kv = (q >> 1) & 1; if (kv == 0 && br >= 1) { mode = 2; gain = nk + br * 64; } }
    f32x4 g[2][2];
#pragma unroll
    for (int bj = 0; bj < 2; ++bj)
#pragma unroll
      for (int n = 0; n < 2; ++n) {
        if (mode == 1) g[bj][n] = *(const f32x4*)(gain + 8 * fq + 4 * n);
        else if (mode == 2) g[bj][n] = *(const f32x4*)(gain + 32 * bj + 8 * fq + 4 * n);
        else g[bj][n] = (f32x4){1.f, 1.f, 1.f, 1.f};
      }
#pragma unroll
    for (int ai = 0; ai < 2; ++ai)
#pragma unroll
      for (int m = 0; m < 4; ++m) {
        float sc[2] = {1.f, 1.f};
        if (mode != 0) {
          float ss[2];
#pragma unroll
          for (int bj = 0; bj < 2; ++bj) { const f32x4 a = acc[ai][bj][m][0], b = acc[ai][bj][m][1];
            float t = (a[0] * a[0] + a[1] * a[1]) + (a[2] * a[2] + a[3] * a[3]) + (b[0] * b[0] + b[1] * b[1]) + (b[2] * b[2] + b[3] * b[3]);
            t += __shfl_xor(t, 16, 64); t += __shfl_xor(t, 32, 64); ss[bj] = t; }
          if (mode == 1) { sc[0] = rsqrtf(ss[0] * (1.f / 32.f) + 1e-6f); sc[1] = rsqrtf(ss[1] * (1.f / 32.f) + 1e-6f); }
          else { const float r = rsqrtf((ss[0] + ss[1]) * (1.f / 64.f) + 1e-6f); sc[0] = r; sc[1] = r; }
        }
        bf16_t* rowp = H + (size_t)(row0 + ai * 128 + m * 16) * HC + 64 * s + 8 * fq;
#pragma unroll
        for (int bj = 0; bj < 2; ++bj) { const f32x4 v0 = acc[ai][bj][m][0] * sc[bj] * g[bj][0], v1 = acc[ai][bj][m][1] * sc[bj] * g[bj][1];
          *(u32x4*)(rowp + 32 * bj) = pack8(v0, v1); }
      }
  }
};
struct EpiResid {
  static constexpr bool PERM = false;
  const float* base; float* out;
  __device__ __forceinline__ void operator()(const f32x4 (&acc)[2][2][4][2], const Unit& u, int wr, int wc, int fr, int fq) const {
    const int row0 = u.pm * 256 + wr * 64 + fr, col0 = u.pn * 256 + wc * 32 + 4 * fq;
#pragma unroll
    for (int ai = 0; ai < 2; ++ai)
#pragma unroll
      for (int m = 0; m < 4; ++m) { const size_t off = (size_t)(row0 + ai * 128 + m * 16) * DM + col0;
#pragma unroll
        for (int bj = 0; bj < 2; ++bj)
#pragma unroll
          for (int n = 0; n < 2; ++n) { const f32x4 b = *(const f32x4*)(base + off + bj * 128 + n * 16); *(f32x4*)(out + off + bj * 128 + n * 16) = b + acc[ai][bj][m][n]; } }
  }
};
struct EpiRKV {
  static constexpr bool PERM = true;
  unsigned char* ws;
  __device__ __forceinline__ void operator()(const f32x4 (&acc)[2][2][4][2], const Unit& u, int wr, int wc, int fr, int fq) const {
    const int gi = u.pm >> 6;
    bf16_t* O = (bf16_t*)(ws + WS_S0 + (size_t)(3 + gi) * SLOT);
    const int row0 = (u.pm & 63) * 256 + wr * 64 + fr, col0 = (u.pn & 3) * 256 + wc * 32 + 8 * fq;
#pragma unroll
    for (int ai = 0; ai < 2; ++ai)
#pragma unroll
      for (int m = 0; m < 4; ++m) { bf16_t* rowp = O + (size_t)(row0 + ai * 128 + m * 16) * DM + col0;
#pragma unroll
        for (int bj = 0; bj < 2; ++bj) *(u32x4*)(rowp + bj * 128) = pack8(acc[ai][bj][m][0], acc[ai][bj][m][1]); }
  }
};
struct EpiLora1 {
  static constexpr bool PERM = true;
  bf16_t* TMP;
  template <int BJ>
  __device__ __forceinline__ void half(const f32x4 (&acc)[2][2][4][2], int gi, int row0, int wc, int fq) const {
    const int c = BJ * 128 + wc * 32 + 8 * fq;
    const bool skip = (gi < 2) && (c >= 64);
    const int dcol = (gi < 2) ? gi * 64 + c : 128 + c;
    const bool zero = (gi == 2) && (c >= 160);
    if (skip) return;
#pragma unroll
    for (int ai = 0; ai < 2; ++ai)
#pragma unroll
      for (int m = 0; m < 4; ++m) {
        f32x4 v0 = acc[ai][BJ][m][0], v1 = acc[ai][BJ][m][1];
#pragma unroll
        for (int i = 0; i < 4; ++i) {
          if (gi == 0) { v0[i] = tanhf(v0[i]); v1[i] = tanhf(v1[i]); }
          else if (gi == 2) { v0[i] = zero ? 0.f : sigmoidf_(v0[i]); v1[i] = zero ? 0.f : sigmoidf_(v1[i]); }
        }
        *(u32x4*)(TMP + (size_t)(row0 + ai * 128 + m * 16) * 384 + dcol) = pack8(v0, v1);
      }
  }
  __device__ __forceinline__ void operator()(const f32x4 (&acc)[2][2][4][2], const Unit& u, int wr, int wc, int fr, int fq) const {
    const int gi = u.pm >> 6;
    const int row0 = (u.pm & 63) * 256 + wr * 64 + fr;
    half<0>(acc, gi, row0, wc, fq);
    half<1>(acc, gi, row0, wc, fq);
  }
};
struct EpiLora2 {
  static constexpr bool PERM = true;
  unsigned char* ws; const float* w0; const float* a0;
  __device__ __forceinline__ void operator()(const f32x4 (&acc)[2][2][4][2], const Unit& u, int wr, int wc, int fr, int fq) const {
    const int gi = u.pn >> 2;
    bf16_t* O = (bf16_t*)(ws + WS_S0 + (size_t)gi * SLOT);
    const int row0 = u.pm * 256 + wr * 64 + fr, col0 = (u.pn & 3) * 256 + wc * 32 + 8 * fq;
    f32x4 b[2][2];
#pragma unroll
    for (int bj = 0; bj < 2; ++bj)
#pragma unroll
      for (int n = 0; n < 2; ++n) b[bj][n] = (gi == 0) ? *(const f32x4*)(w0 + col0 + bj * 128 + 4 * n) : (gi == 1 ? *(const f32x4*)(a0 + col0 + bj * 128 + 4 * n) : (f32x4){0.f, 0.f, 0.f, 0.f});
#pragma unroll
    for (int ai = 0; ai < 2; ++ai)
#pragma unroll
      for (int m = 0; m < 4; ++m) { bf16_t* rowp = O + (size_t)(row0 + ai * 128 + m * 16) * DM + col0;
#pragma unroll
        for (int bj = 0; bj < 2; ++bj) { f32x4 v0 = acc[ai][bj][m][0] + b[bj][0], v1 = acc[ai][bj][m][1] + b[bj][1];
          if (gi == 0) {
#pragma unroll
            for (int i = 0; i < 4; ++i) { v0[i] = -__expf(-softplusf_(-v0[i]) - 0.5f); v1[i] = -__expf(-softplusf_(-v1[i]) - 0.5f); }
          } else if (gi == 1) {
#pragma unroll
            for (int i = 0; i < 4; ++i) { v0[i] = sigmoidf_(v0[i]); v1[i] = sigmoidf_(v1[i]); }
          }
          *(u32x4*)(rowp + bj * 128) = pack8(v0, v1); } }
  }
};

__device__ __forceinline__ void phase_prologue(const P& p, Frame& F) {
  LAS float* scr = (LAS float*)(F.lds + RING_OFF + F.wave * 16384);
  const int gw = F.vcu * NWAVES + F.wave, NGW = F.G * NWAVES;
  constexpr int I_WIN = 96 * 16, I_SQ = 32 * 16;
  constexpr int NITEMS = I_WIN + 5 * I_SQ;
  for (int it = gw; it < NITEMS; it += NGW) {
    int r = it;
    if (r < I_WIN) { conv_win_item(p, r, scr, F.lane); continue; } r -= I_WIN;
    if (r < I_SQ) { conv_sq_item(p.w_out, (bf16_t*)(p.ws + WS_WOUT), 0, r, scr, F.lane); continue; } r -= I_SQ;
    if (r < I_SQ) { conv_sq_item(p.w_r, (bf16_t*)(p.ws + WS_WRKV), 0, r, scr, F.lane); continue; } r -= I_SQ;
    if (r < I_SQ) { conv_sq_item(p.w_k, (bf16_t*)(p.ws + WS_WRKV), 1024, r, scr, F.lane); continue; } r -= I_SQ;
    if (r < I_SQ) { conv_sq_item(p.w_v, (bf16_t*)(p.ws + WS_WRKV), 2048, r, scr, F.lane); continue; } r -= I_SQ;
    conv_sq_item(p.w_o, (bf16_t*)(p.ws + WS_WO), 0, r, scr, F.lane);
  }
  {
    const int gt = (F.vcu * NWAVES + F.wave) * 64 + F.lane, NGT = NGW * 64;
    bf16_t* WL1 = (bf16_t*)(p.ws + WS_WL1);
    for (int i = gt; i < 768 * 1024; i += NGT) {
      const int n = i >> 10, k = i & 1023, gi = n >> 8, c = n & 255;
      float v = 0.f;
      if (gi == 0) { if (c < 64) v = p.w1[k * 64 + c]; }
      else if (gi == 1) { if (c < 64) v = p.a1[k * 64 + c]; }
      else { if (c < 160) v = p.g1[k * 160 + c]; }
      WL1[i] = (bf16_t)f2bf(v);
    }
    bf16_t* WL2 = (bf16_t*)(p.ws + WS_WL2);
    for (int i = gt; i < 3072 * 384; i += NGT) {
      const int n = i / 384, k = i - n * 384, gi = n >> 10, c = n & 1023;
      float v = 0.f;
      if (gi == 0) { if (k < 64) v = p.w2[k * 1024 + c]; }
      else if (gi == 1) { if (k >= 64 && k < 128) v = p.a2[(k - 64) * 1024 + c]; }
      else { if (k >= 128 && k < 288) v = p.g2[(k - 128) * 1024 + c]; }
      WL2[i] = (bf16_t)f2bf(v);
    }
  }
  bf16_t* XN = (bf16_t*)(p.ws + WS_XN);
  for (int m = gw; m < T_TOK; m += NGW) rms_row_to_bf16(p.x + (size_t)m * DM, p.mix_norm, XN + (size_t)m * DM, F.lane);
}

__device__ __forceinline__ void phase_rwkv_prep(const P& p, Frame& F) {
  const int gw = F.vcu * NWAVES + F.wave, NGW = F.G * NWAVES;
  const int lane = F.lane;
  const float* gain = p.mix_norm + DM;
  f32x4 g[4];
#pragma unroll
  for (int j = 0; j < 4; ++j) g[j] = ((const GAS f32x4*)gain)[lane + 64 * j];
  for (int run = gw; run < T_TOK / 8; run += NGW) {
    const int t0 = run * 8;
    f32x4 prev[4];
    if ((t0 & (SEQ - 1)) == 0) {
#pragma unroll
      for (int j = 0; j < 4; ++j) prev[j] = (f32x4){0.f, 0.f, 0.f, 0.f};
    } else {
      const GAS f32x4* xr = (const GAS f32x4*)(p.out + (size_t)(t0 - 1) * DM) + lane;
      float s = 0.f;
#pragma unroll
      for (int j = 0; j < 4; ++j) { prev[j] = xr[64 * j]; s += (prev[j].x * prev[j].x + prev[j].y * prev[j].y) + (prev[j].z * prev[j].z + prev[j].w * prev[j].w); }
      const float r = rsqrtf(wave_sum(s) * (1.f / DM) + 1e-6f);
#pragma unroll
      for (int j = 0; j < 4; ++j) prev[j] = prev[j] * r * g[j];
    }
    for (int tt = 0; tt < 8; ++tt) {
      const int t = t0 + tt;
      const GAS f32x4* xr = (const GAS f32x4*)(p.out + (size_t)t * DM) + lane;
      f32x4 v[4]; float s = 0.f;
#pragma unroll
      for (int j = 0; j < 4; ++j) { v[j] = xr[64 * j]; s += (v[j].x * v[j].x + v[j].y * v[j].y) + (v[j].z * v[j].z + v[j].w * v[j].w); }
      const float r = rsqrtf(wave_sum(s) * (1.f / DM) + 1e-6f);
#pragma unroll
      for (int j = 0; j < 4; ++j) v[j] = v[j] * r * g[j];
#pragma unroll
      for (int sl = 0; sl < 6; ++sl) {
        const int mj = (sl == 0) ? 0 : (sl == 1) ? 2 : (sl == 2) ? 3 : (sl == 3) ? 1 : (sl == 4) ? 4 : 5;
        GAS v2u* o = (GAS v2u*)(p.ws + WS_S0 + (size_t)sl * SLOT + (size_t)t * DM * 2) + lane;
#pragma unroll
        for (int j = 0; j < 4; ++j) {
          const f32x4 mx = ((const GAS f32x4*)(p.rmix + mj * DM))[lane + 64 * j];
          const f32x4 q = v[j] + (prev[j] - v[j]) * mx;
          v2u w; w.x = pk2(q.x, q.y); w.y = pk2(q.z, q.w);
          o[64 * j] = w;
        }
      }
#pragma unroll
      for (int j = 0; j < 4; ++j) prev[j] = v[j];
    }
  }
}

__global__ void __launch_bounds__(NWAVES * 64, 2) mk_fwd(P p) {
  extern __shared__ __attribute__((aligned(16))) unsigned char lds[];
  Frame F;
  F.lds = (LAS unsigned char*)lds;
  F.MISC = (volatile LAS unsigned*)(F.lds + MISC_OFF);
  F.tid = threadIdx.x; F.lane = F.tid & 63; F.wave = __builtin_amdgcn_readfirstlane(F.tid >> 6);
  F.G = gridDim.x; { const int bx = blockIdx.x; F.vcu = (F.G % 8 == 0) ? (bx % 8) * (F.G / 8) + bx / 8 : bx; }
  F.ctl = (gu32*)(p.ws + WS_CTL);
  for (int u = F.tid; u < (LDS_BYTES - LDSCTL_OFF) / 4; u += NWAVES * 64) ((LAS unsigned*)(F.lds + LDSCTL_OFF))[u] = 0u;
  __syncthreads();
  XcdBarrier bar = xcd_barrier_post((unsigned*)(F.ctl + CW_BAR) + p.pad * XCD_BAR_WORDS, F.MISC + 8);
  const int lo = p.ph_lo, hi = p.ph_hi;
#ifndef PHMASK
#define PHMASK 0xffffffffu
#endif
#define IN(k) (lo <= (k) && (k) < hi && ((PHMASK >> (k)) & 1u))
#define SEAM(k) do { if (IN(k) && IN((k) + 1)) xcd_barrier(bar); } while (0)
  unsigned char* ws = p.ws;

  if (IN(0)) { phase_prologue(p, F); } SEAM(0);
  if (IN(1)) {
    pg8::Gemm g{(const bf16_t*)(ws + WS_XN), (const bf16_t*)(ws + WS_WIN), DM};
    pg8::StaticOrder S; S.init(T_TOK, 3072, F.G, (int)blockIdx.x);
    EpiInProj E{(bf16_t*)(ws + WS_H), (float*)(ws + WS_GATES), p.dq_norm, p.dk_norm, p.nq_norm, p.nk_norm, p.gate_bias};
    pg8::gemm_phase<EpiInProj, pg8::StaticOrder, true>(F.lds + RING_OFF, g, S, E);
  } SEAM(1);
  if (IN(2)) {
    pg8::Gemm g{(const bf16_t*)(ws + WS_CAT), (const bf16_t*)(ws + WS_WOUT), DM};
    pg8::StaticOrder S; S.init(T_TOK, DM, F.G, (int)blockIdx.x);
    EpiResid E{p.x, p.out};
    pg8::gemm_phase<EpiResid, pg8::StaticOrder, false>(F.lds + RING_OFF, g, S, E);
  } SEAM(2);
  if (IN(3)) { phase_rwkv_prep(p, F); } SEAM(3);
  if (IN(4)) {
    pg8::Gemm g{(const bf16_t*)(ws + WS_S0 + 3 * SLOT), (const bf16_t*)(ws + WS_WL1), DM};
    pg8::TallOrder S; S.init(3, 1, F.G, (int)blockIdx.x);
    EpiLora1 E{(bf16_t*)(ws + WS_TMP)};
    pg8::gemm_phase<EpiLora1, pg8::TallOrder, false>(F.lds + RING_OFF, g, S, E);
  } SEAM(4);
  if (IN(5)) {
    pg8::Gemm g{(const bf16_t*)(ws + WS_S0), (const bf16_t*)(ws + WS_WRKV), DM};
    pg8::TallOrder S; S.init(3, 4, F.G, (int)blockIdx.x);
    EpiRKV E{ws};
    pg8::gemm_phase<EpiRKV, pg8::TallOrder, true>(F.lds + RING_OFF, g, S, E);
  } SEAM(5);
  if (IN(6)) {
    int k384 = 384; asm volatile("" : "+s"(k384));
    pg8::Gemm g{(const bf16_t*)(ws + WS_TMP), (const bf16_t*)(ws + WS_WL2), k384};
    pg8::StaticOrder S; S.init(T_TOK, 3072, F.G, (int)blockIdx.x);
    EpiLora2 E{ws, p.w0, p.a0};
    pg8::gemm_phase<EpiLora2, pg8::StaticOrder, true>(F.lds + RING_OFF, g, S, E);
  } SEAM(6);
  if (IN(7)) {
    pg8::Gemm g{(const bf16_t*)(ws + WS_S0 + 3 * SLOT), (const bf16_t*)(ws + WS_WO), DM};
    pg8::StaticOrder S; S.init(T_TOK, DM, F.G, (int)blockIdx.x);
    EpiResid E{p.out, p.out};
    pg8::gemm_phase<EpiResid, pg8::StaticOrder, false>(F.lds + RING_OFF, g, S, E);
  }
#undef IN
#undef SEAM
}

struct NP {
  P p; const bf16_t* H; const float* GATES; bf16_t* CAT; float* KCMP; float* VCMP;
  float* XN2F; float* GUF; int* LIST; float* PGATE; int* CNT;
};

__global__ __launch_bounds__(64) void k_compress(NP q) {
  __shared__ float flat[2048];
  __shared__ float hid[64];
  const P& p = q.p;
  const int lane = threadIdx.x;
  int id = blockIdx.x;
  const int kv = id & 1; id >>= 1;
  const int g = id & 1; id >>= 1;
  const int c = id % NCMP; const int b = id / NCMP;
  const int colbase = OFF_NKV + ((0 * 2 + kv) * 2 + g) * 64;
  for (int l = 0; l < 32; l++)
    flat[l * 64 + lane] = bf2f(q.H[(size_t)(b * SEQ + 16 * c + l) * HC + colbase + lane]) + p.cmp_pe[(kv * 32 + l) * 64 + lane];
  __syncthreads();
  const float* w1 = p.cmp_w1 + (size_t)kv * 2048 * 64;
  float acc = 0.f;
  for (int i = 0; i < 2048; i++) acc += flat[i] * w1[i * 64 + lane];
  hid[lane] = gelu_tanh(acc);
  __syncthreads();
  const float* w2 = p.cmp_w2 + kv * 64 * 64;
  float o = 0.f;
  for (int j = 0; j < 64; j++) o += hid[j] * w2[j * 64 + lane];
  if (kv == 0) {
    float s = wave_sum(o * o);
    o = o * rsqrtf(s * (1.f / 64.f) + 1e-6f) * p.nk_norm[lane];
    q.KCMP[((size_t)(b * NCMP + c) * 2 + g) * 64 + lane] = o;
  } else {
    q.VCMP[((size_t)(b * NCMP + c) * 2 + g) * 64 + lane] = o;
  }
}

__global__ __launch_bounds__(64) void k_diffattn(NP q) {
  const P& p = q.p;
  const int lane = threadIdx.x;
  const int s = blockIdx.x * 64 + lane;
  const int b = blockIdx.y >> 3, hd = blockIdx.y & 7;
  const int t = b * SEQ + s;
  float mq = 0.f, mk = 0.f, l0 = 0.f, l1 = 0.f;
  for (int i = 0; i < 32; i++) {
    mq = fmaxf(mq, fabsf(p.dq_norm[i])); mk = fmaxf(mk, fabsf(p.dk_norm[i]));
    l0 += p.dlam[i] * p.dlam[32 + i]; l1 += p.dlam[64 + i] * p.dlam[96 + i];
  }
  const float scale = 0.17677669529663687f;
  const float bound = 32.f * mq * mk * scale;
  const float lam = __expf(l0) - __expf(l1) + 0.2f;
  float q1[32], q2[32], o1[64], o2[64];
  const bf16_t* hq = q.H + (size_t)t * HC + OFF_DQ + hd * 64;
#pragma unroll
  for (int d = 0; d < 32; d++) { q1[d] = bf2f(hq[d]) * scale; q2[d] = bf2f(hq[32 + d]) * scale; }
#pragma unroll
  for (int d = 0; d < 64; d++) { o1[d] = 0.f; o2[d] = 0.f; }
  float s1 = 0.f, s2 = 0.f;
  const int jmax = blockIdx.x * 64 + 63;
  for (int j = 0; j <= jmax; j++) {
    const bf16_t* kr = q.H + (size_t)(b * SEQ + j) * HC + OFF_DK + hd * 64;
    const bf16_t* vr = q.H + (size_t)(b * SEQ + j) * HC + OFF_DV + hd * 64;
    float a1 = 0.f, a2 = 0.f;
#pragma unroll
    for (int d = 0; d < 32; d++) { a1 += q1[d] * bf2f(kr[d]); a2 += q2[d] * bf2f(kr[32 + d]); }
    float p1 = (j <= s) ? __expf(a1 - bound) : 0.f;
    float p2 = (j <= s) ? __expf(a2 - bound) : 0.f;
    s1 += p1; s2 += p2;
#pragma unroll
    for (int d = 0; d < 64; d++) { float v = bf2f(vr[d]); o1[d] += p1 * v; o2[d] += p2 * v; }
  }
  const float i1 = 1.f / s1, i2 = lam / s2;
  float ss = 0.f;
#pragma unroll
  for (int d = 0; d < 64; d++) { o1[d] = o1[d] * i1 - o2[d] * i2; ss += o1[d] * o1[d]; }
  const float r = rsqrtf(ss * (1.f / 64.f) + 1e-6f) * 0.8f;
  bf16_t* oc = q.CAT + (size_t)t * DM + hd * 64;
#pragma unroll
  for (int d = 0; d < 64; d++) oc[d] = (bf16_t)f2bf(o1[d] * r * p.dsubln[d]);
}

__device__ __forceinline__ void nsa_dense_block(const bf16_t* H, int b, int s, int key0, int kcol, int vcol, float bound,
                                                const float (*q)[64], float (*ps)[64], float* lsum, float* oacc, int lane) {
  const int key = key0 + lane;
  const bool valid = (key >= 0) && (key <= s);
  float pj[4] = {0.f, 0.f, 0.f, 0.f};
  if (valid) {
    const bf16_t* kr = H + (size_t)(b * SEQ + key) * HC + kcol;
    float d0 = 0.f, d1 = 0.f, d2 = 0.f, d3 = 0.f;
#pragma unroll
    for (int i = 0; i < 64; i++) {
      float kk = bf2f(kr[i]);
      d0 += kk * q[0][i]; d1 += kk * q[1][i]; d2 += kk * q[2][i]; d3 += kk * q[3][i];
    }
    pj[0] = __expf(d0 * 0.125f - bound); pj[1] = __expf(d1 * 0.125f - bound);
    pj[2] = __expf(d2 * 0.125f - bound); pj[3] = __expf(d3 * 0.125f - bound);
  }
#pragma unroll
  for (int j = 0; j < 4; j++) { lsum[j] += pj[j]; ps[j][lane] = pj[j]; }
  __syncthreads();
  int klo = key0 < 0 ? -key0 : 0;
  int khi = (s - key0) < 63 ? (s - key0) : 63;
  for (int kk = klo; kk <= khi; kk++) {
    float v = bf2f(H[(size_t)(b * SEQ + key0 + kk) * HC + vcol + lane]);
#pragma unroll
    for (int j = 0; j < 4; j++) oacc[j] += ps[j][kk] * v;
  }
  __syncthreads();
}

__global__ __launch_bounds__(64) void k_nsa(NP qq) {
  __shared__ float q[4][64];
  __shared__ float pc[4][256];
  __shared__ float ps[4][64];
  const P& p = qq.p;
  const int lane = threadIdx.x;
  const int t = blockIdx.x, g = blockIdx.y;
  const int b = t >> 12, s = t & (SEQ - 1);
  const bf16_t* hrow = qq.H + (size_t)t * HC;
  float mq = 0.f, mk0 = 0.f, mk1 = 0.f, mk2 = 0.f;
  for (int i = 0; i < 64; i++) {
    mq = fmaxf(mq, fabsf(p.nq_norm[i]));
    mk0 = fmaxf(mk0, fabsf(p.nk_norm[i])); mk1 = fmaxf(mk1, fabsf(p.nk_norm[64 + i])); mk2 = fmaxf(mk2, fabsf(p.nk_norm[128 + i]));
  }
  const float bound0 = 8.f * mq * mk0, bound1 = 8.f * mq * mk1, bound2 = 8.f * mq * mk2;
#pragma unroll
  for (int j = 0; j < 4; j++) q[j][lane] = bf2f(hrow[OFF_NQ + (g * 4 + j) * 64 + lane]);
  __syncthreads();
  int nvalid = (s >= 31) ? ((s - 31) / 16 + 1) : 0;
  if (nvalid > NCMP) nvalid = NCMP;
  float lc[4] = {0.f, 0.f, 0.f, 0.f};
  for (int cb = 0; cb < 256; cb += 64) {
    int c = cb + lane;
    float pj[4] = {0.f, 0.f, 0.f, 0.f};
    if (c < nvalid) {
      const float4* kr = (const float4*)(qq.KCMP + ((size_t)(b * NCMP + c) * 2 + g) * 64);
      float d0 = 0.f, d1 = 0.f, d2 = 0.f, d3 = 0.f;
#pragma unroll
      for (int i = 0; i < 16; i++) {
        float4 kk = kr[i];
        const float4 q0 = *(const float4*)&q[0][i * 4];
        const float4 q1 = *(const float4*)&q[1][i * 4];
        const float4 q2 = *(const float4*)&q[2][i * 4];
        const float4 q3 = *(const float4*)&q[3][i * 4];
        d0 += kk.x * q0.x + kk.y * q0.y + kk.z * q0.z + kk.w * q0.w;
        d1 += kk.x * q1.x + kk.y * q1.y + kk.z * q1.z + kk.w * q1.w;
        d2 += kk.x * q2.x + kk.y * q2.y + kk.z * q2.z + kk.w * q2.w;
        d3 += kk.x * q3.x + kk.y * q3.y + kk.z * q3.z + kk.w * q3.w;
      }
      pj[0] = __expf(d0 * 0.125f - bound0); pj[1] = __expf(d1 * 0.125f - bound0);
      pj[2] = __expf(d2 * 0.125f - bound0); pj[3] = __expf(d3 * 0.125f - bound0);
    }
#pragma unroll
    for (int j = 0; j < 4; j++) { lc[j] += pj[j]; pc[j][c] = pj[j]; }
  }
#pragma unroll
  for (int j = 0; j < 4; j++) { lc[j] = wave_sum(lc[j]); lc[j] = (nvalid > 0) ? 1.f / lc[j] : 0.f; }
  __syncthreads();
  for (int cb = 0; cb < 256; cb += 64) {
#pragma unroll
    for (int j = 0; j < 4; j++) pc[j][cb + lane] *= lc[j];
  }
  __syncthreads();
  float ocmp[4] = {0.f, 0.f, 0.f, 0.f};
  for (int c = 0; c < nvalid; c++) {
    float v = qq.VCMP[((size_t)(b * NCMP + c) * 2 + g) * 64 + lane];
#pragma unroll
    for (int j = 0; j < 4; j++) ocmp[j] += pc[j][c] * v;
  }
  const int cur = s >> 6;
  float imp = 0.f;
  {
    int clo = 4 * lane - 1; if (clo < 0) clo = 0;
    int chi = 4 * lane + 3; if (chi > NCMP - 1) chi = NCMP - 1;
    for (int c = clo; c <= chi; c++) imp += pc[0][c] + pc[1][c] + pc[2][c] + pc[3][c];
  }
  if (lane == cur || lane == 0) imp = 1e4f;
  else if (lane > cur) imp = -1e30f;
  int rank = 0;
  for (int i = 0; i < 64; i++) {
    float vi = __shfl(imp, i, 64);
    rank += (vi > imp || (vi == imp && i < lane)) ? 1 : 0;
  }
  unsigned long long selmask = __ballot(rank < 16);
  float lsel[4] = {0.f, 0.f, 0.f, 0.f}, osel[4] = {0.f, 0.f, 0.f, 0.f};
  const int kcol1 = OFF_NKV + ((1 * 2 + 0) * 2 + g) * 64, vcol1 = OFF_NKV + ((1 * 2 + 1) * 2 + g) * 64;
  for (int blk = 0; blk <= cur; blk++) {
    if (!((selmask >> blk) & 1ull)) continue;
    nsa_dense_block(qq.H, b, s, blk * 64, kcol1, vcol1, bound1, q, ps, lsel, osel, lane);
  }
  float lwin[4] = {0.f, 0.f, 0.f, 0.f}, owin[4] = {0.f, 0.f, 0.f, 0.f};
  const int kcol2 = OFF_NKV + ((2 * 2 + 0) * 2 + g) * 64, vcol2 = OFF_NKV + ((2 * 2 + 1) * 2 + g) * 64;
  for (int key0 = s - 511; key0 <= s; key0 += 64) {
    if (key0 + 63 < 0) continue;
    nsa_dense_block(qq.H, b, s, key0, kcol2, vcol2, bound2, q, ps, lwin, owin, lane);
  }
#pragma unroll
  for (int j = 0; j < 4; j++) {
    float ls = wave_sum(lsel[j]), lw = wave_sum(lwin[j]);
    int hh = g * 4 + j;
    const float* gr = qq.GATES + (size_t)t * 24 + hh * 3;
    qq.CAT[(size_t)t * DM + 512 + hh * 64 + lane] = (bf16_t)f2bf(gr[0] * ocmp[j] + gr[1] * osel[j] / ls + gr[2] * owin[j] / lw);
  }
}

__global__ __launch_bounds__(256) void k_rmsnorm_write(const float* __restrict__ x, const float* __restrict__ gain, float* __restrict__ y) {
  int row = blockIdx.x * 4 + (threadIdx.x >> 6);
  int lane = threadIdx.x & 63;
  const float4* p = (const float4*)(x + (size_t)row * DM);
  const float4* g = (const float4*)gain;
  float4 v[4];
  float s = 0.f;
#pragma unroll
  for (int i = 0; i < 4; i++) { v[i] = p[lane + i * 64]; s += v[i].x * v[i].x + v[i].y * v[i].y + v[i].z * v[i].z + v[i].w * v[i].w; }
  s = wave_sum(s);
  float r = rsqrtf(s * (1.f / DM) + 1e-6f);
  float4* o = (float4*)(y + (size_t)row * DM);
#pragma unroll
  for (int i = 0; i < 4; i++) {
    float4 gg = g[lane + i * 64];
    float4 w; w.x = v[i].x * r * gg.x; w.y = v[i].y * r * gg.y; w.z = v[i].z * r * gg.z; w.w = v[i].w * r * gg.w;
    o[lane + i * 64] = w;
  }
}

__global__ __launch_bounds__(256) void k_router(NP q, int layer) {
  __shared__ float lg[4][40];
  const P& p = q.p;
  const int w = threadIdx.x >> 6, lane = threadIdx.x & 63;
  const int t = blockIdx.x * 4 + w;
  const float* xr = q.XN2F + (size_t)t * DM;
  const float* wg = p.rg_w + (size_t)layer * DM * 4;
  const float* we = p.re_w + (size_t)layer * DM * 32;
  float acc[36];
#pragma unroll
  for (int i = 0; i < 36; i++) acc[i] = 0.f;
#pragma unroll 1
  for (int it = 0; it < 16; it++) {
    int k = it * 64 + lane;
    float xv = xr[k];
    float4 g4 = *(const float4*)(wg + k * 4);
    acc[0] += xv * g4.x; acc[1] += xv * g4.y; acc[2] += xv * g4.z; acc[3] += xv * g4.w;
#pragma unroll
    for (int i = 0; i < 8; i++) {
      float4 e4 = *(const float4*)(we + k * 32 + i * 4);
      acc[4 + i * 4 + 0] += xv * e4.x; acc[4 + i * 4 + 1] += xv * e4.y; acc[4 + i * 4 + 2] += xv * e4.z; acc[4 + i * 4 + 3] += xv * e4.w;
    }
  }
#pragma unroll
  for (int i = 0; i < 36; i++) { float v = wave_sum(acc[i]); if (lane == 0) lg[w][i] = v; }
  __syncthreads();
  if (lane == 0) {
    const float* bg = p.rg_b + layer * 4;
    const float* be = p.re_b + layer * 32;
    float gl[4]; int gi = 0; float gm = -3.4e38f;
    for (int i = 0; i < 4; i++) { gl[i] = lg[w][i] + bg[i]; if (gl[i] > gm) { gm = gl[i]; gi = i; } }
    float gs = 0.f;
    for (int i = 0; i < 4; i++) gs += __expf(gl[i] - gm);
    float grp_p = 1.f / gs;
    float v0 = -3.4e38f, v1 = -3.4e38f; int i0 = 0, i1 = 0;
    for (int i = 0; i < 8; i++) {
      float v = lg[w][4 + gi * 8 + i] + be[gi * 8 + i];
      if (v > v0) { v1 = v0; i1 = i0; v0 = v; i0 = i; }
      else if (v > v1) { v1 = v; i1 = i; }
    }
    float e1 = __expf(v1 - v0);
    float ga = grp_p / (1.f + e1), gb = grp_p * e1 / (1.f + e1);
    int ea = gi * 8 + i0, eb = gi * 8 + i1;
    int sa = atomicAdd(&q.CNT[ea], 1);
    q.LIST[(size_t)ea * CAP + sa] = 2 * t; q.PGATE[2 * t] = ga;
    int sb = atomicAdd(&q.CNT[eb], 1);
    q.LIST[(size_t)eb * CAP + sb] = 2 * t + 1; q.PGATE[2 * t + 1] = gb;
  }
}

template <int MODE>
__global__ __launch_bounds__(256) void k_moe_gemm(NP q, int layer) {
  __shared__ float sA[16][68];
  __shared__ float sB[16][68];
  const P& p = q.p;
  const int e = blockIdx.z;
  const int cnt = q.CNT[e];
  const int tx = threadIdx.x & 15, ty = threadIdx.x >> 4;
  const int m0 = blockIdx.y * 64, n0 = blockIdx.x * 64;
  if (m0 >= cnt) return;
  const int K = MODE == 0 ? DM : 256;
  const float* eg = p.e_gate + ((size_t)layer * 32 + e) * DM * 256;
  const float* eu = p.e_up + ((size_t)layer * 32 + e) * DM * 256;
  const float* ed = p.e_down + ((size_t)layer * 32 + e) * 256 * DM;
  float acc[4][4];
#pragma unroll
  for (int i = 0; i < 4; i++)
#pragma unroll
    for (int j = 0; j < 4; j++) acc[i][j] = 0.f;
  for (int k0 = 0; k0 < K; k0 += 16) {
#pragma unroll
    for (int i = 0; i < 4; i++) {
      int el = threadIdx.x + i * 256;
      int m = el >> 4, k = el & 15;
      float v = 0.f;
      if (m0 + m < cnt) {
        int pr = q.LIST[(size_t)e * CAP + m0 + m];
        if (MODE == 0) v = q.XN2F[(size_t)(pr >> 1) * DM + k0 + k];
        else { float g = q.GUF[(size_t)pr * 512 + k0 + k], u = q.GUF[(size_t)pr * 512 + 256 + k0 + k]; v = g * sigmoidf_(g) * u; }
      }
      sA[k][m] = v;
    }
#pragma unroll
    for (int i = 0; i < 4; i++) {
      int el = threadIdx.x + i * 256;
      int k = el >> 6, n = el & 63;
      float v;
      if (MODE == 0) { int nn = n0 + n; v = (nn < 256) ? eg[(size_t)(k0 + k) * 256 + nn] : eu[(size_t)(k0 + k) * 256 + nn - 256]; }
      else v = ed[(size_t)(k0 + k) * DM + n0 + n];
      sB[k][n] = v;
    }
    __syncthreads();
#pragma unroll
    for (int k = 0; k < 16; k++) {
      float4 av = *(const float4*)&sA[k][ty * 4];
      float4 bv = *(const float4*)&sB[k][tx * 4];
      float a_[4] = {av.x, av.y, av.z, av.w};
      float b_[4] = {bv.x, bv.y, bv.z, bv.w};
#pragma unroll
      for (int i = 0; i < 4; i++)
#pragma unroll
        for (int j = 0; j < 4; j++) acc[i][j] += a_[i] * b_[j];
    }
    __syncthreads();
  }
#pragma unroll
  for (int i = 0; i < 4; i++) {
    int m = m0 + ty * 4 + i;
    if (m >= cnt) continue;
    int pr = q.LIST[(size_t)e * CAP + m];
#pragma unroll
    for (int j = 0; j < 4; j++) {
      int n = n0 + tx * 4 + j;
      if (MODE == 0) q.GUF[(size_t)pr * 512 + n] = acc[i][j];
      else atomicAdd(&p.out[(size_t)(pr >> 1) * DM + n], q.PGATE[pr] * acc[i][j]);
    }
  }
}

__global__ __launch_bounds__(64) void k_rwkv(NP q) {
  __shared__ float s_r[64], s_d[64], s_k[64], s_kk[64], s_b[64];
  const P& p = q.p;
  const int lane = threadIdx.x;
  const int b = blockIdx.x >> 4, hd = blockIdx.x & 15;
  const int c = hd * 64 + lane;
  const float kkc = p.k_k[c], kac = p.k_a[c], rkc = p.r_k[c], lnw = p.ln_w[c], lnb = p.ln_b[c];
  const bf16_t* LD = (const bf16_t*)(p.ws + WS_S0); const bf16_t* AA = (const bf16_t*)(p.ws + WS_S0 + SLOT); const bf16_t* GG = (const bf16_t*)(p.ws + WS_S0 + 2 * SLOT);
  bf16_t* RR = (bf16_t*)(p.ws + WS_S0 + 3 * SLOT); const bf16_t* KK = (const bf16_t*)(p.ws + WS_S0 + 4 * SLOT); const bf16_t* VV = (const bf16_t*)(p.ws + WS_S0 + 5 * SLOT);
  float S[64];
#pragma unroll
  for (int i = 0; i < 64; i++) S[i] = 0.f;
  for (int st = 0; st < SEQ; st++) {
    const size_t idx = (size_t)(b * SEQ + st) * DM + c;
    const float r_ = bf2f(RR[idx]), ld = bf2f(LD[idx]), k_ = bf2f(KK[idx]), v_ = bf2f(VV[idx]), a_ = bf2f(AA[idx]), g_ = bf2f(GG[idx]);
    float kkraw = k_ * kkc;
    float nrm = sqrtf(wave_sum(kkraw * kkraw));
    float kk = kkraw / fmaxf(nrm, 1e-12f);
    float kmod = k_ * (1.f + (a_ - 1.f) * kac);
    float dec = __expf(ld);
    float bonus = wave_sum(r_ * kmod * rkc);
    s_r[lane] = r_; s_d[lane] = dec; s_k[lane] = kmod; s_kk[lane] = kk; s_b[lane] = kk * a_;
    __syncthreads();
    float sk = 0.f;
#pragma unroll
    for (int i = 0; i < 64; i++) sk += S[i] * s_kk[i];
    sk = -sk;
    float y = 0.f;
#pragma unroll
    for (int i = 0; i < 64; i++) {
      S[i] = S[i] * s_d[i] + sk * s_b[i] + v_ * s_k[i];
      y += S[i] * s_r[i];
    }
    float mu = wave_sum(y) * (1.f / 64.f);
    float dv = y - mu;
    float var = wave_sum(dv * dv) * (1.f / 64.f);
    float yn = dv * rsqrtf(var + 64e-5f) * lnw + lnb + bonus * v_;
    RR[idx] = (bf16_t)f2bf(yn * g_);
    __syncthreads();
  }
}

static void run_moe_naive(const NP& q, int layer, hipStream_t st) {
  hipLaunchKernelGGL(k_rmsnorm_write, dim3(T_TOK / 4), dim3(256), 0, st, (const float*)q.p.out, q.p.ffn_norm + layer * DM, q.XN2F);
  (void)hipMemsetAsync(q.CNT, 0, 32 * sizeof(int), st);
  hipLaunchKernelGGL(k_router, dim3(T_TOK / 4), dim3(256), 0, st, q, layer);
  hipLaunchKernelGGL(k_moe_gemm<0>, dim3(8, CAP / 64, 32), dim3(256), 0, st, q, layer);
  hipLaunchKernelGGL(k_moe_gemm<1>, dim3(16, CAP / 64, 32), dim3(256), 0, st, q, layer);
}

static void launch_mk(P p, int lo, int hi, int li, int grid, hipStream_t st) {
  p.ph_lo = lo; p.ph_hi = hi; p.pad = li;
  hipLaunchKernelGGL(mk_fwd, dim3(grid), dim3(NWAVES * 64), LDS_BYTES, st, p);
}

extern "C" void kernel_launch(void* const* d_in, const int* in_sizes, int n_in, void* d_out, int out_size, void* d_ws,
                              size_t ws_size, hipStream_t stream) {
  static int grid = 0;
  if (grid == 0) {
    if (n_in != 40 || ws_size < WS_END) { fprintf(stderr, "kernel_launch: bad n_in %d or ws_size %zu (< %zu)\n", n_in, ws_size, (size_t)WS_END); grid = -1; return; }
    int dev = 0, cus = 0;
    if (hipGetDevice(&dev) != hipSuccess || hipDeviceGetAttribute(&cus, hipDeviceAttributeMultiprocessorCount, dev) != hipSuccess) { grid = -1; return; }
    if (hipFuncSetAttribute((const void*)mk_fwd, hipFuncAttributeMaxDynamicSharedMemorySize, LDS_BYTES) != hipSuccess) { grid = -1; return; }
    grid = cus;
  }
  if (grid < 0) return;
  P p{};
  const float* const* in = (const float* const*)d_in;
  p.x = in[0]; p.mix_norm = in[1]; p.w_in = in[2]; p.gate_bias = in[3]; p.dq_norm = in[4]; p.dk_norm = in[5];
  p.dlam = in[6]; p.dsubln = in[7]; p.nq_norm = in[8]; p.nk_norm = in[9]; p.cmp_pe = in[10]; p.cmp_w1 = in[11];
  p.cmp_w2 = in[12]; p.w_out = in[13]; p.rmix = in[14]; p.w_r = in[15]; p.w_k = in[16]; p.w_v = in[17];
  p.w0 = in[18]; p.w1 = in[19]; p.w2 = in[20]; p.a0 = in[21]; p.a1 = in[22]; p.a2 = in[23]; p.g1 = in[24]; p.g2 = in[25];
  p.k_k = in[26]; p.k_a = in[27]; p.r_k = in[28]; p.ln_w = in[29]; p.ln_b = in[30]; p.w_o = in[31];
  p.ffn_norm = in[32]; p.rg_w = in[33]; p.rg_b = in[34]; p.re_w = in[35]; p.re_b = in[36];
  p.e_gate = in[37]; p.e_up = in[38]; p.e_down = in[39];
  p.out = (float*)d_out;
  p.ws = (unsigned char*)d_ws;
  unsigned char* ws = p.ws;
  NP q{};
  q.p = p; q.H = (const bf16_t*)(ws + WS_H); q.GATES = (const float*)(ws + WS_GATES); q.CAT = (bf16_t*)(ws + WS_CAT);
  q.KCMP = (float*)(ws + WS_KCMP); q.VCMP = (float*)(ws + WS_VCMP);
  q.XN2F = (float*)(ws + WS_XN2F); q.GUF = (float*)(ws + WS_GUF); q.LIST = (int*)(ws + WS_LIST); q.PGATE = (float*)(ws + WS_PGATE);
  q.CNT = (int*)(ws + WS_CTL) + CW_CNT;

  (void)hipMemsetAsync(ws + WS_CTL, 0, CTL_ZERO_BYTES, stream);
  launch_mk(p, 0, 2, 0, grid, stream);
  hipLaunchKernelGGL(k_compress, dim3(NBATCH * NCMP * 2 * 2), dim3(64), 0, stream, q);
  hipLaunchKernelGGL(k_diffattn, dim3(SEQ / 64, NBATCH * 8), dim3(64), 0, stream, q);
  hipLaunchKernelGGL(k_nsa, dim3(T_TOK, 2), dim3(64), 0, stream, q);
  launch_mk(p, 2, 3, 1, grid, stream);
  run_moe_naive(q, 0, stream);
  launch_mk(p, 3, 7, 2, grid, stream);
  hipLaunchKernelGGL(k_rwkv, dim3(NBATCH * 16), dim3(64), 0, stream, q);
  launch_mk(p, 7, 8, 3, grid, stream);
  run_moe_naive(q, 1, stream);
}
```

```cpp
#include <hip/hip_runtime.h>
#include <cstdio>
#include <cstdint>

#define T_TOK 16384
#define DM 1024
#define SEQ 4096
#define NBATCH 4
#define INC 2840
#define HC 2816
#define OFF_DQ 0
#define OFF_DK 512
#define OFF_DV 1024
#define OFF_NQ 1536
#define OFF_NKV 2048
#define OFF_NG 2816
#define NCMP 255
#define CAP 16384

#define GAS __attribute__((address_space(1)))
#define LAS __attribute__((address_space(3)))
typedef unsigned short bf16_t;
typedef unsigned v4u __attribute__((ext_vector_type(4)));
typedef unsigned v2u __attribute__((ext_vector_type(2)));
typedef float f32x4 __attribute__((ext_vector_type(4)));
typedef short bf16x8 __attribute__((ext_vector_type(8)));
typedef GAS unsigned gu32;
#define RLX_AGENT __ATOMIC_RELAXED, __HIP_MEMORY_SCOPE_AGENT
#define LDS_WAIT() asm volatile("s_waitcnt lgkmcnt(0)" ::: "memory")
#define VM_WAIT() asm volatile("s_waitcnt vmcnt(0)" ::: "memory")

__device__ __forceinline__ float bf2f(bf16_t v) { return __uint_as_float(((unsigned)v) << 16); }
__device__ __forceinline__ unsigned f2bf(float f) { unsigned u = __builtin_bit_cast(unsigned, f); return (u + 0x7fffu + ((u >> 16) & 1u)) >> 16; }
__device__ __forceinline__ unsigned pk2(float lo, float hi) { return f2bf(lo) | (f2bf(hi) << 16); }
__device__ __forceinline__ float wave_sum(float v) {
#pragma unroll
  for (int o = 32; o >= 1; o >>= 1) v += __shfl_xor(v, o, 64);
  return v;
}
__device__ __forceinline__ float wave_sum_dpp(float v) {
  v += __builtin_bit_cast(float, __builtin_amdgcn_update_dpp(0, __builtin_bit_cast(int, v), 0xB1, 0xf, 0xf, false));
  v += __builtin_bit_cast(float, __builtin_amdgcn_update_dpp(0, __builtin_bit_cast(int, v), 0x4E, 0xf, 0xf, false));
  v += __builtin_bit_cast(float, __builtin_amdgcn_update_dpp(0, __builtin_bit_cast(int, v), 0x141, 0xf, 0xf, false));
  v += __builtin_bit_cast(float, __builtin_amdgcn_update_dpp(0, __builtin_bit_cast(int, v), 0x140, 0xf, 0xf, false));
  const int iv = __builtin_bit_cast(int, v);
  return (__builtin_bit_cast(float, __builtin_amdgcn_readlane(iv, 0)) + __builtin_bit_cast(float, __builtin_amdgcn_readlane(iv, 16))) +
         (__builtin_bit_cast(float, __builtin_amdgcn_readlane(iv, 32)) + __builtin_bit_cast(float, __builtin_amdgcn_readlane(iv, 48)));
}
__device__ __forceinline__ float sigmoidf_(float x) { return 1.f / (1.f + __expf(-x)); }
__device__ __forceinline__ float softplusf_(float x) { return fmaxf(x, 0.f) + __logf(1.f + __expf(-fabsf(x))); }
__device__ __forceinline__ float gelu_tanh(float x) {
  float u = 0.7978845608028654f * (x + 0.044715f * x * x * x);
  return 0.5f * x * (1.f + tanhf(u));
}

constexpr size_t MiB = 1u << 20;
constexpr size_t WS_CTL = 0, CTL_ZERO_BYTES = 1 * MiB;
constexpr size_t WS_WIN = 1 * MiB;
constexpr size_t WS_WOUT = 7 * MiB;
constexpr size_t WS_WRKV = 9 * MiB;
constexpr size_t WS_WO = 15 * MiB;
constexpr size_t WS_WL1 = 17 * MiB;
constexpr size_t WS_WL2 = 19 * MiB;
constexpr size_t WS_EGU = 22 * MiB;
constexpr size_t WS_EDN = 54 * MiB;
constexpr size_t WS_ACT = 70 * MiB;
constexpr size_t WS_XN = WS_ACT;
constexpr size_t WS_H = WS_ACT + 32 * MiB;
constexpr size_t WS_GATES = WS_ACT + 120 * MiB;
constexpr size_t WS_CAT = WS_ACT + 122 * MiB;
constexpr size_t WS_KCMP = WS_ACT + 154 * MiB;
constexpr size_t WS_VCMP = WS_ACT + 155 * MiB;
constexpr size_t WS_XN2 = WS_ACT;
constexpr size_t WS_HID = WS_ACT + 32 * MiB;
constexpr size_t WS_Y1 = WS_EGU;
constexpr size_t WS_LIST = WS_ACT + 156 * MiB;
constexpr size_t WS_PGATE = WS_ACT + 158 * MiB;
constexpr size_t WS_XN2F = WS_ACT;
constexpr size_t WS_GUF = WS_ACT + 64 * MiB;
constexpr size_t WS_S0 = WS_ACT;
constexpr size_t WS_TMP = WS_ACT + 192 * MiB;
constexpr size_t WS_END = WS_ACT + 204 * MiB;
constexpr size_t SLOT = 32 * MiB;
constexpr int CW_BAR = 4096;
constexpr int CW_CNT = 32768;

namespace pg8 {
#define PG8_LAS __attribute__((address_space(3)))
typedef unsigned u32x4 __attribute__((ext_vector_type(4)));
constexpr int BM = 256, BK = 64, HALF = 128, HTB = HALF * BK * 2  , STAGE_BYTES = 8 * HTB, NXCD = 8, WGM = 8;

__host__ __device__ __forceinline__ int lds_byte(int r, int c) { const int st = (r >> 4) * 2 + (c >> 5), rr = r & 15, cc = c & 31, ob = rr * 64 + cc * 2; return st * 1024 + (ob ^ (((ob >> 9) & 1) << 5)); }
__host__ __device__ __forceinline__ void stage_rc(int b, int& R, int& C) { const int st = b / 1024, sb = b % 1024, swz = sb ^ (((sb >> 9) & 1) << 5); R = (st >> 1) * 16 + swz / 64; C = (st & 1) * 32 + (swz % 64) / 2; }
__host__ __device__ __forceinline__ int perm32(int rho) { const int n = rho >> 4, i = rho & 15; return 8 * (i >> 2) + 4 * n + (i & 3); }

struct Unit { int pm, pn, e, nrows, rt; };
struct Gemm { const bf16_t* A; const bf16_t* Bt; int K; };

__device__ __forceinline__ void static_map(int L, int nM, int nN, int& pm, int& pn) {
    const int nwg = nM * nN;
    int wgid = L; { const int q = nwg / NXCD, r = nwg % NXCD, xcd = wgid % NXCD, off = wgid / NXCD; wgid = (xcd < r ? xcd * (q + 1) : r * (q + 1) + (xcd - r) * q) + off; }
    const int nig = WGM * nN, gid = wgid / nig, fm = gid * WGM, gsz = (nM - fm) < WGM ? (nM - fm) : WGM;
    pm = fm + ((wgid % nig) % gsz); pn = (wgid % nig) / gsz;
}
struct StaticOrder {
    int nM, nN, G, c;
    __device__ void init(int M, int N, int G_, int c_) { nM = M / BM; nN = N / BM; G = G_; c = c_; }
    __device__ __forceinline__ bool next(int i, Unit& u) const {
        const int L = i * G + c; if (L >= nM * nN) return false;
        static_map(L, nM, nN, u.pm, u.pn); u.e = 0; u.nrows = 256; u.rt = 0; return true;
    }
    __device__ __forceinline__ unsigned rowoff(const Unit& u, int r, int C, int K) const { return (unsigned)((u.pm * BM + r) * K + C) * 2u; }
};
struct TallOrder {
    int nM, nN, G, c;
    __device__ void init(int ngemm, int nN_, int G_, int c_) { nM = 64 * ngemm; nN = nN_; G = G_; c = c_; }
    __device__ __forceinline__ bool next(int i, Unit& u) const {
        const int L = i * G + c; if (L >= nM * nN) return false;
        int pn; static_map(L, nM, nN, u.pm, pn); u.pn = (u.pm >> 6) * nN + pn; u.e = 0; u.nrows = 256; u.rt = 0; return true;
    }
    __device__ __forceinline__ unsigned rowoff(const Unit& u, int r, int C, int K) const { return (unsigned)((u.pm * BM + r) * K + C) * 2u; }
};


template <int NCOL, bool GATHER>
struct MoeOrder {
    const unsigned* cnt; const int* list; int G, c;
    __device__ __forceinline__ bool next(int i, Unit& u) const {
        const int L = i * G + c; const int R = L / NCOL, j = L - R * NCOL;
        int pre = 0;
        for (int e = 0; e < 32; ++e) {
            const int ce = (int)__builtin_amdgcn_readfirstlane(__hip_atomic_load(cnt + e, __ATOMIC_RELAXED, __HIP_MEMORY_SCOPE_AGENT));
            const int nt = (ce + 255) >> 8;
            if (R < pre + nt) { u.pm = R; u.rt = R - pre; u.e = e; u.pn = e * NCOL + j; u.nrows = ce - u.rt * 256; return true; }
            pre += nt;
        }
        return false;
    }
    __device__ __forceinline__ unsigned rowoff(const Unit& u, int r, int C, int K) const {
        if (GATHER) { const int idx = (r < u.nrows) ? u.rt * 256 + r : 0; const int pr = list[(size_t)u.e * CAP + idx]; return (unsigned)((pr >> 1) * K + C) * 2u; }
        return (unsigned)((u.pm * BM + r) * K + C) * 2u;
    }
};

__device__ __forceinline__ unsigned cvt_pk_bf16(float lo, float hi) { unsigned r; asm volatile("v_cvt_pk_bf16_f32 %0, %1, %2" : "=v"(r) : "v"(lo), "v"(hi)); return r; }
__device__ __forceinline__ u32x4 pack8(const f32x4& a, const f32x4& b) { u32x4 w; w.x = cvt_pk_bf16(a[0], a[1]); w.y = cvt_pk_bf16(a[2], a[3]); w.z = cvt_pk_bf16(b[0], b[1]); w.w = cvt_pk_bf16(b[2], b[3]); return w; }

template <class Epi, class Sched, bool ALIGN_EPI>
__device__ __forceinline__ void gemm_phase(PG8_LAS unsigned char* lds, const Gemm g, const Sched& S, const Epi& E) {
    const int tid = threadIdx.x, wid = __builtin_amdgcn_readfirstlane(tid >> 6), lane = tid & 63, wr = wid >> 2, wc = wid & 3, fr = lane & 15, fq = lane >> 4;
    const int K = g.K, nt = K / BK;
    int RA[2], CA[2]; unsigned voffB[2];
#pragma unroll
    for (int i = 0; i < 2; ++i) { int R, C; stage_rc(tid * 16 + i * 8192, R, C); const int Rb = Epi::PERM ? ((R & ~31) + perm32(R & 31)) : R;
        RA[i] = R; CA[i] = C; voffB[i] = (unsigned)(Rb * K + C) * 2u; }
    const size_t kstep = (size_t)(BK * 2);
    const size_t hstep = (size_t)HALF * K * 2;
    const size_t tstep = 2 * hstep;
    const unsigned ldsw = (unsigned)wid * 1024u;
    const int aoff = lds_byte(wr * 64 + fr, fq * 8), boff = lds_byte(wc * 32 + fr, fq * 8);
    const char* const Abase = (const char*)g.A;
#define PG8_SA(b, h) (((b) * 2 + (h)) * HTB)
#define PG8_SB(b, h) ((4 + (b) * 2 + (h)) * HTB)
#define PG8_STAGE(bufoff, gbase, voff) do { _Pragma("unroll") for (int _i = 0; _i < 2; ++_i) \
        __builtin_amdgcn_global_load_lds((const unsigned*)((const char*)(gbase) + (voff)[_i]), (PG8_LAS unsigned*)(lds + (bufoff) + ldsw + _i * 8192), 16, 0, 0); } while (0)
#define PG8_STAGEA(bufoff, kbyte, o0, o1) do { \
        __builtin_amdgcn_global_load_lds((const unsigned*)(Abase + (size_t)(kbyte) + (o0)), (PG8_LAS unsigned*)(lds + (bufoff) + ldsw), 16, 0, 0); \
        __builtin_amdgcn_global_load_lds((const unsigned*)(Abase + (size_t)(kbyte) + (o1)), (PG8_LAS unsigned*)(lds + (bufoff) + ldsw + 8192), 16, 0, 0); } while (0)
#define PG8_LDA(dst, b, h) do { _Pragma("unroll") for (int m = 0; m < 4; ++m) _Pragma("unroll") for (int k = 0; k < 2; ++k) dst[m][k] = *(const PG8_LAS bf16x8*)(lds + PG8_SA(b, h) + aoff + m * 2048 + k * 1024); } while (0)
#define PG8_LDB(dst, b, h) do { _Pragma("unroll") for (int n = 0; n < 2; ++n) _Pragma("unroll") for (int k = 0; k < 2; ++k) dst[n][k] = *(const PG8_LAS bf16x8*)(lds + PG8_SB(b, h) + boff + n * 2048 + k * 1024); } while (0)
#define PG8_MMA(ai, bj, At, Bt) do { __builtin_amdgcn_s_setprio(1); _Pragma("unroll") for (int m = 0; m < 4; ++m) _Pragma("unroll") for (int n = 0; n < 2; ++n) _Pragma("unroll") for (int k = 0; k < 2; ++k) \
        acc[ai][bj][m][n] = __builtin_amdgcn_mfma_f32_16x16x32_bf16(Bt[n][k], At[m][k], acc[ai][bj][m][n], 0, 0, 0); __builtin_amdgcn_s_setprio(0); } while (0)
#define PG8_WAIT_V(n) asm volatile("s_waitcnt vmcnt(" #n ")" ::: "memory")
#define PG8_WAIT_L(n) asm volatile("s_waitcnt lgkmcnt(" #n ")" ::: "memory")
#define PG8_BAR __builtin_amdgcn_s_barrier()
#define PG8_SCHED __builtin_amdgcn_sched_barrier(0)
    Unit cur, nxt; int ui = 0;
    if (!S.next(0, cur)) return;
    f32x4 acc[2][2][4][2];
#pragma unroll
    for (int a = 0; a < 2; ++a)
#pragma unroll
        for (int b = 0; b < 2; ++b)
#pragma unroll
            for (int m = 0; m < 4; ++m)
#pragma unroll
                for (int n = 0; n < 2; ++n) acc[a][b][m][n] = (f32x4){0.f, 0.f, 0.f, 0.f};
    bf16x8 At[4][2], B0[2][2], B1[2][2];
    unsigned c00 = S.rowoff(cur, RA[0], CA[0], K), c01 = S.rowoff(cur, RA[1], CA[1], K), c10 = S.rowoff(cur, HALF + RA[0], CA[0], K), c11 = S.rowoff(cur, HALF + RA[1], CA[1], K);
    unsigned n00, n01, n10, n11;
    const char* cB = (const char*)g.Bt + (size_t)cur.pn * tstep;
    PG8_STAGE(PG8_SB(0, 0), cB, voffB); PG8_STAGE(PG8_SB(0, 1), cB + hstep, voffB); PG8_STAGEA(PG8_SA(0, 0), 0, c00, c01); PG8_STAGEA(PG8_SA(0, 1), 0, c10, c11);
    if (wr == 1) PG8_BAR;
    PG8_WAIT_V(2); PG8_BAR;
    PG8_STAGE(PG8_SB(1, 0), cB + kstep, voffB); PG8_STAGEA(PG8_SA(1, 0), kstep, c00, c01); PG8_STAGE(PG8_SB(1, 1), cB + hstep + kstep, voffB);
    PG8_WAIT_V(6); PG8_BAR;
    for (;;) {
        const bool has_next = S.next(ui + 1, nxt);
        const char* nB = has_next ? (const char*)g.Bt + (size_t)nxt.pn * tstep : cB;
        if (has_next) { n00 = S.rowoff(nxt, RA[0], CA[0], K); n01 = S.rowoff(nxt, RA[1], CA[1], K); n10 = S.rowoff(nxt, HALF + RA[0], CA[0], K); n11 = S.rowoff(nxt, HALF + RA[1], CA[1], K); }
        else { n00 = c00; n01 = c01; n10 = c10; n11 = c11; }
        for (int t = 0; t < nt; t += 2) {
            const bool last = (t == nt - 2);
            const size_t k1 = (size_t)(t + 1) * kstep;
            const size_t k2 = last ? 0 : (size_t)(t + 2) * kstep;
            const size_t k3 = k2 + kstep;
            const unsigned a00 = last ? n00 : c00, a01 = last ? n01 : c01, a10 = last ? n10 : c10, a11 = last ? n11 : c11;
            const char* b2 = last ? nB : cB + (size_t)(t + 2) * kstep;
            const char* b3 = b2 + kstep;
            PG8_LDB(B0, 0, 0); PG8_LDB(B1, 0, 1); PG8_SCHED; PG8_LDA(At, 0, 0); PG8_STAGEA(PG8_SA(1, 1), k1, c10, c11);
            PG8_WAIT_V(8); PG8_WAIT_L(0); PG8_BAR; PG8_MMA(0, 0, At, B0); PG8_MMA(0, 1, At, B1); PG8_BAR; PG8_SCHED;
            PG8_LDA(At, 0, 1); PG8_STAGE(PG8_SB(0, 0), b2, voffB); PG8_STAGE(PG8_SB(0, 1), b2 + hstep, voffB); PG8_STAGEA(PG8_SA(0, 0), k2, a00, a01);
            PG8_WAIT_V(8); PG8_WAIT_L(0); PG8_BAR; PG8_MMA(1, 0, At, B0); PG8_MMA(1, 1, At, B1); PG8_BAR; PG8_SCHED;
            PG8_LDB(B0, 1, 0); PG8_LDB(B1, 1, 1); PG8_SCHED; PG8_LDA(At, 1, 0); PG8_STAGEA(PG8_SA(0, 1), k2, a10, a11);
            PG8_WAIT_V(8); PG8_WAIT_L(0); PG8_BAR; PG8_MMA(0, 0, At, B0); PG8_MMA(0, 1, At, B1); PG8_BAR; PG8_SCHED;
            PG8_LDA(At, 1, 1); PG8_STAGE(PG8_SB(1, 0), b3, voffB); PG8_STAGE(PG8_SB(1, 1), b3 + hstep, voffB); PG8_STAGEA(PG8_SA(1, 0), k3, a00, a01);
            PG8_WAIT_V(8); PG8_WAIT_L(0); PG8_BAR; PG8_MMA(1, 0, At, B0); PG8_MMA(1, 1, At, B1); PG8_BAR; PG8_SCHED;
        }
        if constexpr (ALIGN_EPI) { if (wr == 0) PG8_BAR; }
        E(acc, cur, wr, wc, fr, fq);
        if (!has_next) break;
#pragma unroll
        for (int a = 0; a < 2; ++a)
#pragma unroll
            for (int b = 0; b < 2; ++b)
#pragma unroll
                for (int m = 0; m < 4; ++m)
#pragma unroll
                    for (int n = 0; n < 2; ++n) acc[a][b][m][n] = (f32x4){0.f, 0.f, 0.f, 0.f};
        cur = nxt; cB = nB; c00 = n00; c01 = n01; c10 = n10; c11 = n11; ++ui;
        if constexpr (ALIGN_EPI) { if (wr == 1) PG8_BAR; }
    }
    PG8_WAIT_V(0);
    if constexpr (!ALIGN_EPI) { if (wr == 0) PG8_BAR; }
    PG8_BAR;
#undef PG8_SA
#undef PG8_SB
#undef PG8_STAGE
#undef PG8_STAGEA
#undef PG8_LDA
#undef PG8_LDB
#undef PG8_MMA
#undef PG8_WAIT_V
#undef PG8_WAIT_L
#undef PG8_BAR
#undef PG8_SCHED
}
}

#define XB_TMO      128
#define XB_XCNT(j)  (256  + 64 * (j))
#define XB_XSUB(j)  (1280 + 64 * (j))
#define XB_XGEN(j)  (2304 + 64 * (j))
#define XB_TOP      3328
#define XB_TOPGEN   3392
#define XCD_BAR_WORDS 3456
#define XB_SPIN_CAP (1u << 18)

__device__ __forceinline__ unsigned xb_ld(unsigned* p)              { return __hip_atomic_load(p, __ATOMIC_RELAXED, __HIP_MEMORY_SCOPE_AGENT); }
__device__ __forceinline__ unsigned xb_add(unsigned* p, unsigned v) { return __hip_atomic_fetch_add(p, v, __ATOMIC_RELAXED, __HIP_MEMORY_SCOPE_AGENT); }
__device__ __forceinline__ unsigned xb_xcc_id() { return (unsigned)__builtin_amdgcn_s_getreg((3 << 11) | 20) & 0xFu; }
#define XB_SPIN(cond, bar) do { unsigned _sp = 0; while (cond) { __builtin_amdgcn_s_sleep(1); \
    if ((++_sp & 255u) == 0u) { if (xb_ld(&(bar)[XB_TMO])) break; if (_sp > XB_SPIN_CAP) { atomicAdd(&(bar)[XB_TMO], 1u); break; } } } } while (0)

struct XcdBarrier {
    unsigned* bar; unsigned x;
    volatile LAS unsigned* st;
};

__device__ __forceinline__ XcdBarrier xcd_barrier_post(unsigned* bar, volatile LAS unsigned* st) {
    XcdBarrier b; b.bar = bar; b.x = xb_xcc_id(); b.st = st;
    if (threadIdx.x == 0) (void)xb_add(&bar[XB_XCNT(b.x)], 1u);
    return b;
}
__device__ __forceinline__ void xcd_barrier_complete(unsigned* bar, unsigned x, unsigned& nloc, unsigned& nx) {
    const unsigned G = gridDim.x * gridDim.y * gridDim.z;
    unsigned sum, cnt, mine, sp = 0u;
    for (;;) {
        sum = 0u; cnt = 0u; mine = 0u;
#pragma unroll
        for (unsigned j = 0; j < 16; ++j) { const unsigned c = xb_ld(&bar[XB_XCNT(j)]); sum += c; cnt += (c > 0u) ? 1u : 0u; mine = (j == x) ? c : mine; }
        if (sum == G) break;
        __builtin_amdgcn_s_sleep(1);
        if ((++sp & 255u) == 0u) { if (xb_ld(&bar[XB_TMO])) break; if (sp > XB_SPIN_CAP) { atomicAdd(&bar[XB_TMO], 1u); break; } }
    }
    nloc = mine > 0u ? mine : 1u; nx = cnt > 0u ? cnt : 1u;
}

__device__ __forceinline__ void xcd_barrier(const XcdBarrier& b) {
    asm volatile("s_waitcnt vmcnt(0)" ::: "memory");
    __syncthreads();
    if (threadIdx.x == 0) {
        unsigned* bar = b.bar;
        __builtin_amdgcn_s_waitcnt(0);
        unsigned nloc = b.st[0], nx = b.st[1];
        if (nloc == 0u) { xcd_barrier_complete(bar, b.x, nloc, nx); b.st[0] = nloc; b.st[1] = nx; }
        const unsigned old = xb_add(&bar[XB_XSUB(b.x)], 1u);
        const unsigned gen = old / nloc;
        if (old + 1u == (gen + 1u) * nloc) {
            __builtin_amdgcn_fence(__ATOMIC_RELEASE, "agent");
            asm volatile("s_waitcnt vmcnt(0)" ::: "memory");
            const unsigned og = xb_add(&bar[XB_TOP], 1u);
            const unsigned tg = og / nx;
            if (og + 1u == (tg + 1u) * nx) xb_add(&bar[XB_TOPGEN], 1u);
            else XB_SPIN(xb_ld(&bar[XB_TOPGEN]) == tg, bar);
            __builtin_amdgcn_fence(__ATOMIC_ACQUIRE, "agent");
            xb_add(&bar[XB_XGEN(b.x)], 1u);
            asm volatile("s_waitcnt vmcnt(0)" ::: "memory");
        } else {
            XB_SPIN(xb_ld(&bar[XB_XGEN(b.x)]) == gen, bar);
            __builtin_amdgcn_fence(__ATOMIC_ACQUIRE, "agent");
            asm volatile("s_waitcnt vmcnt(0)" ::: "memory");
        }
    }
    __syncthreads();
}
struct P {
  const float* x; const float* mix_norm; const float* w_in; const float* gate_bias;
  const float* dq_norm; const float* dk_norm; const float* dlam; const float* dsubln;
  const float* nq_norm; const float* nk_norm; const float* cmp_pe; const float* cmp_w1; const float* cmp_w2;
  const float* w_out;
  const float* rmix; const float* w_r; const float* w_k; const float* w_v;
  const float* w0; const float* w1; const float* w2; const float* a0; const float* a1; const float* a2;
  const float* g1; const float* g2; const float* k_k; const float* k_a; const float* r_k;
  const float* ln_w; const float* ln_b; const float* w_o;
  const float* ffn_norm; const float* rg_w; const float* rg_b; const float* re_w; const float* re_b;
  const float* e_gate; const float* e_up; const float* e_down;
  float* out;
  unsigned char* ws;
  int ph_lo, ph_hi, layer, pad;
};

constexpr int RING_OFF = 0, RING_BYTES = 131072;
constexpr int LDSCTL_OFF = RING_BYTES, MISC_OFF = LDSCTL_OFF + 320;
constexpr int LDS_BYTES = 147456;
constexpr int NWAVES = 8;

struct Frame {
  LAS unsigned char* lds;
  volatile LAS unsigned* MISC;
  gu32* ctl;
  int tid, lane, wave, vcu, G;
};

__device__ __forceinline__ void transpose_item(const float* W, int ldsrc, int k0, int c0, int ncols, bf16_t* dst, int ldk, int drow0, LAS float* scr, int lane) {
#pragma unroll 8
  for (int i = 0; i < 32; ++i) { const int kk = 2 * i + (lane >> 5); const int j = lane & 31; scr[kk * 33 + j] = (j < ncols) ? W[(size_t)(k0 + kk) * ldsrc + c0 + j] : 0.f; }
  LDS_WAIT(); asm volatile("" ::: "memory");
  const int c = lane & 7;
#pragma unroll
  for (int j = 0; j < 4; ++j) { const int n = (lane >> 3) + 8 * j; const LAS float* s = scr + (8 * c) * 33 + n;
    v4u o; o.x = pk2(s[0 * 33], s[1 * 33]); o.y = pk2(s[2 * 33], s[3 * 33]); o.z = pk2(s[4 * 33], s[5 * 33]); o.w = pk2(s[6 * 33], s[7 * 33]);
    *(GAS v4u*)(dst + (size_t)(drow0 + n) * ldk + k0 + 8 * c) = o; }
  LDS_WAIT(); asm volatile("" ::: "memory");
}
__device__ __forceinline__ void rms_row_to_bf16(const float* xrow, const float* gain, bf16_t* orow, int lane) {
  const GAS f32x4* xr = (const GAS f32x4*)xrow + lane;
  const GAS f32x4* gr = (const GAS f32x4*)gain + lane;
  f32x4 v[4]; float s = 0.f;
#pragma unroll
  for (int j = 0; j < 4; ++j) { v[j] = xr[64 * j]; s += (v[j].x * v[j].x + v[j].y * v[j].y) + (v[j].z * v[j].z + v[j].w * v[j].w); }
  const float r = rsqrtf(wave_sum(s) * (1.f / DM) + 1e-6f);
  GAS unsigned long long* o8 = (GAS unsigned long long*)orow + lane;
#pragma unroll
  for (int j = 0; j < 4; ++j) { const f32x4 g = gr[64 * j];
    o8[64 * j] = (unsigned long long)pk2(v[j].x * r * g.x, v[j].y * r * g.y) | ((unsigned long long)pk2(v[j].z * r * g.z, v[j].w * r * g.w) << 32); }
}

__device__ __forceinline__ void conv_win_item(const P& p, int it, LAS float* scr, int lane) {
  const int vg = it >> 4, kb = it & 15;
  const int pn = vg >> 3, bj = (vg >> 2) & 1, wc = vg & 3, s = pn * 4 + wc;
  int c0 = 0, nc = 0;
  if (s < 44) { c0 = 64 * s + 32 * bj; nc = 32; } else if (s == 44 && bj == 0) { c0 = OFF_NG; nc = 24; }
  transpose_item(p.w_in, INC, kb * 64, c0, nc, (bf16_t*)(p.ws + WS_WIN), DM, vg * 32, scr, lane);
}
__device__ __forceinline__ void conv_sq_item(const float* W, bf16_t* dst, int drow_base, int it, LAS float* scr, int lane) {
  const int cg = it >> 4, kb = it & 15;
  transpose_item(W, DM, kb * 64, cg * 32, 32, dst, DM, drow_base + cg * 32, scr, lane);
}
__device__ __forceinline__ void conv_expert_item(const P& p, int layer, int it, LAS float* scr, int lane) {
  const int e = it / 384, r = it % 384;
  if (r < 256) {
    const int up = r >> 7, q = r & 127, cgp = q >> 4, kb = q & 15;
    const int pn = cgp >> 2, qq = cgp & 3;
    const float* W = (up ? p.e_up : p.e_gate) + ((size_t)layer * 32 + e) * DM * 256;
    transpose_item(W, 256, kb * 64, cgp * 32, 32, (bf16_t*)(p.ws + WS_EGU), DM, e * 512 + pn * 256 + up * 128 + qq * 32, scr, lane);
  } else {
    const int q = r - 256, cg = q >> 2, kb = q & 3;
    const float* W = p.e_down + ((size_t)layer * 32 + e) * 256 * DM;
    transpose_item(W, DM, kb * 64, cg * 32, 32, (bf16_t*)(p.ws + WS_EDN), 256, e * 1024 + cg * 32, scr, lane);
  }
}

using pg8::Unit; using pg8::u32x4; using pg8::pack8;
struct EpiInProj {
  static constexpr bool PERM = true;
  bf16_t* H; float* GATES; const float* dq; const float* dk; const float* nq; const float* nk; const float* gbias;
  __device__ __forceinline__ void operator()(const f32x4 (&acc)[2][2][4][2], const Unit& u, int wr, int wc, int fr, int fq) const {
    const int s = u.pn * 4 + wc;
    if (s > 44) return;
    const int row0 = u.pm * 256 + wr * 64 + fr;
    if (s == 44) {
      if (fq < 3) {
        f32x4 b0 = *(const f32x4*)(gbias + 8 * fq), b1 = *(const f32x4*)(gbias + 8 * fq + 4);
#pragma unroll
        for (int ai = 0; ai < 2; ++ai)
#pragma unroll
          for (int m = 0; m < 4; ++m) { float* gp = GATES + (size_t)(row0 + ai * 128 + m * 16) * 24 + 8 * fq;
            f32x4 v0 = acc[ai][0][m][0] + b0, v1 = acc[ai][0][m][1] + b1;
#pragma unroll
            for (int i = 0; i < 4; ++i) { v0[i] = sigmoidf_(v0[i]); v1[i] = sigmoidf_(v1[i]); }
            *(f32x4*)gp = v0; *(f32x4*)(gp + 4) = v1; }
      }
      return;
    }
    int mode = 0; const float* gain = nullptr;
    if (s < 8) { mode = 1; gain = dq; } else if (s < 16) { mode = 1; gain = dk; }
    else if (s >= 24 && s < 32) { mode = 2; gain = nq; }
    else if (s >= 32) { const int q = s - 32, br = q >> 2, kv = (q >> 1) & 1; if (kv == 0 && br >= 1) { mode = 2; gain = nk + br * 64; } }
    f32x4 g[2][2];
#pragma unroll
    for (int bj = 0; bj < 2; ++bj)
#pragma unroll
      for (int n = 0; n < 2; ++n) {
        if (mode == 1) g[bj][n] = *(const f32x4*)(gain + 8 * fq + 4 * n);
        else if (mode == 2) g[bj][n] = *(const f32x4*)(gain + 32 * bj + 8 * fq + 4 * n);
        else g[bj][n] = (f32x4){1.f, 1.f, 1.f, 1.f};
      }
#pragma unroll
    for (int ai = 0; ai < 2; ++ai)
#pragma unroll
      for (int m = 0; m < 4; ++m) {
        float sc[2] = {1.f, 1.f};
        if (mode != 0) {
          float ss[2];
#pragma unroll
          for (int bj = 0; bj < 2; ++bj) { const f32x4 a = acc[ai][bj][m][0], b = acc[ai][bj][m][1];
            float t = (a[0] * a[0] + a[1] * a[1]) + (a[2] * a[2] + a[3] * a[3]) + (b[0] * b[0] + b[1] * b[1]) + (b[2] * b[2] + b[3] * b[3]);
            t += __shfl_xor(t, 16, 64); t += __shfl_xor(t, 32, 64); ss[bj] = t; }
          if (mode == 1) { sc[0] = rsqrtf(ss[0] * (1.f / 32.f) + 1e-6f); sc[1] = rsqrtf(ss[1] * (1.f / 32.f) + 1e-6f); }
          else { const float r = rsqrtf((ss[0] + ss[1]) * (1.f / 64.f) + 1e-6f); sc[0] = r; sc[1] = r; }
        }
        bf16_t* rowp = H + (size_t)(row0 + ai * 128 + m * 16) * HC + 64 * s + 8 * fq;
#pragma unroll
        for (int bj = 0; bj < 2; ++bj) { const f32x4 v0 = acc[ai][bj][m][0] * sc[bj] * g[bj][0], v1 = acc[ai][bj][m][1] * sc[bj] * g[bj][1];
          *(u32x4*)(rowp + 32 * bj) = pack8(v0, v1); }
      }
  }
};
struct EpiResid {
  static constexpr bool PERM = false;
  const float* base; float* out; const bf16_t* y1;
  __device__ __forceinline__ void operator()(const f32x4 (&acc)[2][2][4][2], const Unit& u, int wr, int wc, int fr, int fq) const {
    const int row0 = u.pm * 256 + wr * 64 + fr, col0 = u.pn * 256 + wc * 32 + 4 * fq;
#pragma unroll
    for (int ai = 0; ai < 2; ++ai)
#pragma unroll
      for (int m = 0; m < 4; ++m) { const size_t off = (size_t)(row0 + ai * 128 + m * 16) * DM + col0;
#pragma unroll
        for (int bj = 0; bj < 2; ++bj)
#pragma unroll
          for (int n = 0; n < 2; ++n) { f32x4 b = *(const f32x4*)(base + off + bj * 128 + n * 16);
            if (y1) { const v2u y = *(const v2u*)(y1 + off + bj * 128 + n * 16);
              b.x += __uint_as_float(y.x << 16); b.y += __uint_as_float(y.x & 0xffff0000u); b.z += __uint_as_float(y.y << 16); b.w += __uint_as_float(y.y & 0xffff0000u); }
            *(f32x4*)(out + off + bj * 128 + n * 16) = b + acc[ai][bj][m][n]; asm volatile("" ::: "memory"); } }
  }
};
struct EpiRKV {
  static constexpr bool PERM = true;
  unsigned char* ws;
  __device__ __forceinline__ void operator()(const f32x4 (&acc)[2][2][4][2], const Unit& u, int wr, int wc, int fr, int fq) const {
    const int gi = u.pm >> 6;
    bf16_t* O = (bf16_t*)(ws + WS_S0 + (size_t)(3 + gi) * SLOT);
    const int row0 = (u.pm & 63) * 256 + wr * 64 + fr, col0 = (u.pn & 3) * 256 + wc * 32 + 8 * fq;
#pragma unroll
    for (int ai = 0; ai < 2; ++ai)
#pragma unroll
      for (int m = 0; m < 4; ++m) { bf16_t* rowp = O + (size_t)(row0 + ai * 128 + m * 16) * DM + col0;
#pragma unroll
        for (int bj = 0; bj < 2; ++bj) *(u32x4*)(rowp + bj * 128) = pack8(acc[ai][bj][m][0], acc[ai][bj][m][1]); }
  }
};
struct EpiLora1 {
  static constexpr bool PERM = true;
  bf16_t* TMP;
  template <int BJ>
  __device__ __forceinline__ void half(const f32x4 (&acc)[2][2][4][2], int gi, int row0, int wc, int fq) const {
    const int c = BJ * 128 + wc * 32 + 8 * fq;
    const bool skip = (gi < 2) && (c >= 64);
    const int dcol = (gi < 2) ? gi * 64 + c : 128 + c;
    const bool zero = (gi == 2) && (c >= 160);
    if (skip) return;
#pragma unroll
    for (int ai = 0; ai < 2; ++ai)
#pragma unroll
      for (int m = 0; m < 4; ++m) {
        f32x4 v0 = acc[ai][BJ][m][0], v1 = acc[ai][BJ][m][1];
#pragma unroll
        for (int i = 0; i < 4; ++i) {
          if (gi == 0) { v0[i] = tanhf(v0[i]); v1[i] = tanhf(v1[i]); }
          else if (gi == 2) { v0[i] = zero ? 0.f : sigmoidf_(v0[i]); v1[i] = zero ? 0.f : sigmoidf_(v1[i]); }
        }
        *(u32x4*)(TMP + (size_t)(row0 + ai * 128 + m * 16) * 384 + dcol) = pack8(v0, v1);
      }
  }
  __device__ __forceinline__ void operator()(const f32x4 (&acc)[2][2][4][2], const Unit& u, int wr, int wc, int fr, int fq) const {
    const int gi = u.pm >> 6;
    const int row0 = (u.pm & 63) * 256 + wr * 64 + fr;
    half<0>(acc, gi, row0, wc, fq);
    half<1>(acc, gi, row0, wc, fq);
  }
};
struct EpiLora2 {
  static constexpr bool PERM = true;
  unsigned char* ws; const float* w0; const float* a0;
  __device__ __forceinline__ void operator()(const f32x4 (&acc)[2][2][4][2], const Unit& u, int wr, int wc, int fr, int fq) const {
    const int gi = u.pn >> 2;
    bf16_t* O = (bf16_t*)(ws + WS_S0 + (size_t)gi * SLOT);
    const int row0 = u.pm * 256 + wr * 64 + fr, col0 = (u.pn & 3) * 256 + wc * 32 + 8 * fq;
    f32x4 b[2][2];
#pragma unroll
    for (int bj = 0; bj < 2; ++bj)
#pragma unroll
      for (int n = 0; n < 2; ++n) b[bj][n] = (gi == 0) ? *(const f32x4*)(w0 + col0 + bj * 128 + 4 * n) : (gi == 1 ? *(const f32x4*)(a0 + col0 + bj * 128 + 4 * n) : (f32x4){0.f, 0.f, 0.f, 0.f});
#pragma unroll
    for (int ai = 0; ai < 2; ++ai)
#pragma unroll
      for (int m = 0; m < 4; ++m) { bf16_t* rowp = O + (size_t)(row0 + ai * 128 + m * 16) * DM + col0;
#pragma unroll
        for (int bj = 0; bj < 2; ++bj) { f32x4 v0 = acc[ai][bj][m][0] + b[bj][0], v1 = acc[ai][bj][m][1] + b[bj][1];
          if (gi == 0) {
#pragma unroll
            for (int i = 0; i < 4; ++i) { v0[i] = -__expf(-softplusf_(-v0[i]) - 0.5f); v1[i] = -__expf(-softplusf_(-v1[i]) - 0.5f); }
          } else if (gi == 1) {
#pragma unroll
            for (int i = 0; i < 4; ++i) { v0[i] = sigmoidf_(v0[i]); v1[i] = sigmoidf_(v1[i]); }
          }
          *(u32x4*)(rowp + bj * 128) = pack8(v0, v1); } }
  }
};

struct EpiMoeGU {
  static constexpr bool PERM = true;
  bf16_t* HID;
  __device__ __forceinline__ void operator()(const f32x4 (&acc)[2][2][4][2], const Unit& u, int wr, int wc, int fr, int fq) const {
    const int row0 = u.pm * 256 + wr * 64 + fr, col0 = (u.pn & 1) * 128 + wc * 32 + 8 * fq;
#pragma unroll
    for (int ai = 0; ai < 2; ++ai)
#pragma unroll
      for (int m = 0; m < 4; ++m) {
        f32x4 h[2];
#pragma unroll
        for (int n = 0; n < 2; ++n) { const f32x4 g = acc[ai][0][m][n], up = acc[ai][1][m][n];
#pragma unroll
          for (int i = 0; i < 4; ++i) h[n][i] = g[i] * sigmoidf_(g[i]) * up[i]; }
        *(u32x4*)(HID + (size_t)(row0 + ai * 128 + m * 16) * 256 + col0) = pack8(h[0], h[1]);
      }
  }
};
struct EpiMoeDown {
  static constexpr bool PERM = false;
  float* out; bf16_t* Y1; const int* list; const float* pgate;
  __device__ __forceinline__ void operator()(const f32x4 (&acc)[2][2][4][2], const Unit& u, int wr, int wc, int fr, int fq) const {
    const int col0 = (u.pn & 3) * 256 + wc * 32 + 4 * fq;
#pragma unroll
    for (int ai = 0; ai < 2; ++ai)
#pragma unroll
      for (int m = 0; m < 4; ++m) {
        const int r = ai * 128 + wr * 64 + m * 16 + fr;
        if (r < u.nrows) {
          const int pr = list[(size_t)u.e * CAP + u.rt * 256 + r];
          const float gt = pgate[pr];
          const int tok = pr >> 1;
          if ((pr & 1) == 0) {
            float* op = out + (size_t)tok * DM + col0;
#pragma unroll
            for (int bj = 0; bj < 2; ++bj)
#pragma unroll
              for (int n = 0; n < 2; ++n) { f32x4 b = *(const f32x4*)(op + bj * 128 + n * 16); *(f32x4*)(op + bj * 128 + n * 16) = b + acc[ai][bj][m][n] * gt; }
          } else {
            bf16_t* yp = Y1 + (size_t)tok * DM + col0;
#pragma unroll
            for (int bj = 0; bj < 2; ++bj)
#pragma unroll
              for (int n = 0; n < 2; ++n) { const f32x4 v = acc[ai][bj][m][n] * gt; v2u w; w.x = pg8::cvt_pk_bf16(v[0], v[1]); w.y = pg8::cvt_pk_bf16(v[2], v[3]); *(v2u*)(yp + bj * 128 + n * 16) = w; }
          }
        }
      }
  }
};

__device__ __forceinline__ void phase_prologue(const P& p, Frame& F) {
  LAS float* scr = (LAS float*)(F.lds + RING_OFF + F.wave * 16384);
  const int gw = F.vcu * NWAVES + F.wave, NGW = F.G * NWAVES;
  constexpr int I_WIN = 96 * 16, I_SQ = 32 * 16;
  constexpr int NITEMS = I_WIN + 5 * I_SQ;
  for (int it = gw; it < NITEMS; it += NGW) {
    int r = it;
    if (r < I_WIN) { conv_win_item(p, r, scr, F.lane); continue; } r -= I_WIN;
    if (r < I_SQ) { conv_sq_item(p.w_out, (bf16_t*)(p.ws + WS_WOUT), 0, r, scr, F.lane); continue; } r -= I_SQ;
    if (r < I_SQ) { conv_sq_item(p.w_r, (bf16_t*)(p.ws + WS_WRKV), 0, r, scr, F.lane); continue; } r -= I_SQ;
    if (r < I_SQ) { conv_sq_item(p.w_k, (bf16_t*)(p.ws + WS_WRKV), 1024, r, scr, F.lane); continue; } r -= I_SQ;
    if (r < I_SQ) { conv_sq_item(p.w_v, (bf16_t*)(p.ws + WS_WRKV), 2048, r, scr, F.lane); continue; } r -= I_SQ;
    conv_sq_item(p.w_o, (bf16_t*)(p.ws + WS_WO), 0, r, scr, F.lane);
  }
  {
    const int gt = (F.vcu * NWAVES + F.wave) * 64 + F.lane, NGT = NGW * 64;
    bf16_t* WL1 = (bf16_t*)(p.ws + WS_WL1);
    for (int i = gt; i < 768 * 1024; i += NGT) {
      const int n = i >> 10, k = i & 1023, gi = n >> 8, c = n & 255;
      float v = 0.f;
      if (gi == 0) { if (c < 64) v = p.w1[k * 64 + c]; }
      else if (gi == 1) { if (c < 64) v = p.a1[k * 64 + c]; }
      else { if (c < 160) v = p.g1[k * 160 + c]; }
      WL1[i] = (bf16_t)f2bf(v);
    }
    bf16_t* WL2 = (bf16_t*)(p.ws + WS_WL2);
    for (int i = gt; i < 3072 * 384; i += NGT) {
      const int n = i / 384, k = i - n * 384, gi = n >> 10, c = n & 1023;
      float v = 0.f;
      if (gi == 0) { if (k < 64) v = p.w2[k * 1024 + c]; }
      else if (gi == 1) { if (k >= 64 && k < 128) v = p.a2[(k - 64) * 1024 + c]; }
      else { if (k >= 128 && k < 288) v = p.g2[(k - 128) * 1024 + c]; }
      WL2[i] = (bf16_t)f2bf(v);
    }
  }
  bf16_t* XN = (bf16_t*)(p.ws + WS_XN);
  for (int m = gw; m < T_TOK; m += NGW) rms_row_to_bf16(p.x + (size_t)m * DM, p.mix_norm, XN + (size_t)m * DM, F.lane);
}


__device__ __forceinline__ void phase_router(const P& p, Frame& F, int layer) {
  const int gw = F.vcu * NWAVES + F.wave, NGW = F.G * NWAVES;
  const int lane = F.lane;
  {
    LAS float* scr = (LAS float*)(F.lds + RING_OFF + F.wave * 16384);
    for (int it = gw; it < 32 * 384; it += NGW) conv_expert_item(p, layer, it, scr, lane);
  }
  __syncthreads();
  LAS float* WL = (LAS float*)(F.lds);
  LAS float* LG = (LAS float*)(F.lds + 81920) + F.wave * 8 * 36;
  LAS float* RSB = (LAS float*)(F.lds + 81920 + 9216) + F.wave * 8;
  const float* gain = p.ffn_norm + layer * DM;
  const float* wg = p.rg_w + (size_t)layer * DM * 4;
  const float* we = p.re_w + (size_t)layer * DM * 32;
  bf16_t* XN2 = (bf16_t*)(p.ws + WS_XN2);
  f32x4 g[4];
#pragma unroll
  for (int j = 0; j < 4; ++j) g[j] = ((const GAS f32x4*)gain)[lane + 64 * j];
#pragma unroll 1
  for (int tt = 0; tt < 8; ++tt) {
    const int t = gw * 8 + tt;
    const GAS f32x4* xr = (const GAS f32x4*)(p.out + (size_t)t * DM) + lane;
    f32x4 v[4]; float s = 0.f;
#pragma unroll
    for (int j = 0; j < 4; ++j) { v[j] = xr[64 * j]; s += (v[j].x * v[j].x + v[j].y * v[j].y) + (v[j].z * v[j].z + v[j].w * v[j].w); }
    const float r = rsqrtf(wave_sum(s) * (1.f / DM) + 1e-6f);
    if (lane == 0) RSB[tt] = r;
    GAS v2u* o = (GAS v2u*)(XN2 + (size_t)t * DM) + lane;
#pragma unroll
    for (int j = 0; j < 4; ++j) { const f32x4 q = v[j] * r * g[j]; v2u w; w.x = pk2(q.x, q.y); w.y = pk2(q.z, q.w); o[64 * j] = w; }
    if (lane < 36) LG[tt * 36 + lane] = 0.f;
  }
#pragma unroll 1
  for (int half = 0; half < 2; ++half) {
    __syncthreads();
    for (int idx = F.tid; idx < 512 * 9; idx += NWAVES * 64) {
      const int row = idx / 9, c4 = idx - row * 9;
      const int q = row & 63, ij = row >> 6, jj = ij & 1, i = ij >> 1;
      const int k = 4 * q + 256 * (2 * half + jj) + i;
      const f32x4 val = (c4 == 0) ? *(const GAS f32x4*)(wg + k * 4) : *(const GAS f32x4*)(we + k * 32 + (c4 - 1) * 4);
      *(LAS f32x4*)(WL + row * 36 + c4 * 4) = val;
    }
    __syncthreads();
#pragma unroll 1
    for (int tt = 0; tt < 8; ++tt) {
      const int t = gw * 8 + tt;
      const float r = RSB[tt];
      const GAS f32x4* xr = (const GAS f32x4*)(p.out + (size_t)t * DM) + lane;
      f32x4 xv[2];
#pragma unroll
      for (int jj = 0; jj < 2; ++jj) xv[jj] = xr[64 * (2 * half + jj)] * r * g[2 * half + jj];
      f32x4 acc[9];
#pragma unroll
      for (int c = 0; c < 9; ++c) acc[c] = (f32x4){0.f, 0.f, 0.f, 0.f};
#pragma unroll
      for (int i = 0; i < 4; ++i)
#pragma unroll
        for (int jj = 0; jj < 2; ++jj) {
          const float x = xv[jj][i];
          const LAS f32x4* wr = (const LAS f32x4*)(WL + ((i * 2 + jj) * 64 + lane) * 36);
#pragma unroll
          for (int c = 0; c < 9; ++c) acc[c] += wr[c] * x;
          asm volatile("" ::: "memory");
        }
      float mine = 0.f;
#pragma unroll
      for (int c = 0; c < 9; ++c)
#pragma unroll
        for (int e = 0; e < 4; ++e) { const float sum = wave_sum_dpp(acc[c][e]); mine = (lane == c * 4 + e) ? sum : mine; }
      if (lane < 36) LG[tt * 36 + lane] += mine;
    }
  }
  LDS_WAIT();
  if (lane < 8) {
    const int t = gw * 8 + lane;
    const LAS float* lg = LG + lane * 36;
    const float* bg = p.rg_b + layer * 4;
    const float* be = p.re_b + layer * 32;
    float gl[4]; int gi = 0; float gm = -3.4e38f;
#pragma unroll
    for (int i = 0; i < 4; i++) { gl[i] = lg[i] + bg[i]; if (gl[i] > gm) { gm = gl[i]; gi = i; } }
    float gs = 0.f;
#pragma unroll
    for (int i = 0; i < 4; i++) gs += __expf(gl[i] - gm);
    const float grp_p = 1.f / gs;
    float v0 = -3.4e38f, v1 = -3.4e38f; int i0 = 0, i1 = 0;
    for (int i = 0; i < 8; i++) {
      const float v = lg[4 + gi * 8 + i] + be[gi * 8 + i];
      if (v > v0) { v1 = v0; i1 = i0; v0 = v; i0 = i; }
      else if (v > v1) { v1 = v; i1 = i; }
    }
    const float e1 = __expf(v1 - v0);
    const float ga = grp_p / (1.f + e1), gb = grp_p * e1 / (1.f + e1);
    const int ea = gi * 8 + i0, eb = gi * 8 + i1;
    unsigned* cnt = (unsigned*)(p.ws + WS_CTL) + CW_CNT + layer * 32;
    int* list = (int*)(p.ws + WS_LIST); float* pgate = (float*)(p.ws + WS_PGATE);
    const unsigned sa = __hip_atomic_fetch_add(cnt + ea, 1u, __ATOMIC_RELAXED, __HIP_MEMORY_SCOPE_AGENT);
    list[(size_t)ea * CAP + sa] = 2 * t; pgate[2 * t] = ga;
    const unsigned sb = __hip_atomic_fetch_add(cnt + eb, 1u, __ATOMIC_RELAXED, __HIP_MEMORY_SCOPE_AGENT);
    list[(size_t)eb * CAP + sb] = 2 * t + 1; pgate[2 * t + 1] = gb;
  }
}

__device__ __forceinline__ void phase_final(const P& p, Frame& F) {
  const int gw = F.vcu * NWAVES + F.wave, NGW = F.G * NWAVES;
  const bf16_t* Y1 = (const bf16_t*)(p.ws + WS_Y1);
  for (int t = gw; t < T_TOK; t += NGW) {
    GAS f32x4* xr = (GAS f32x4*)(p.out + (size_t)t * DM) + F.lane;
    const GAS v2u* yr = (const GAS v2u*)(Y1 + (size_t)t * DM) + F.lane;
#pragma unroll
    for (int j = 0; j < 4; ++j) { f32x4 v = xr[64 * j]; const v2u y = yr[64 * j];
      v.x += __uint_as_float(y.x << 16); v.y += __uint_as_float(y.x & 0xffff0000u); v.z += __uint_as_float(y.y << 16); v.w += __uint_as_float(y.y & 0xffff0000u);
      xr[64 * j] = v; }
  }
}

__device__ __forceinline__ void phase_rwkv_prep(const P& p, Frame& F) {
  const int gw = F.vcu * NWAVES + F.wave, NGW = F.G * NWAVES;
  const int lane = F.lane;
  const float* gain = p.mix_norm + DM;
  const bf16_t* Y1 = (const bf16_t*)(p.ws + WS_Y1);
  f32x4 g[4];
#pragma unroll
  for (int j = 0; j < 4; ++j) g[j] = ((const GAS f32x4*)gain)[lane + 64 * j];
  for (int run = gw; run < T_TOK / 8; run += NGW) {
    const int t0 = run * 8;
    f32x4 prev[4];
    if ((t0 & (SEQ - 1)) == 0) {
#pragma unroll
      for (int j = 0; j < 4; ++j) prev[j] = (f32x4){0.f, 0.f, 0.f, 0.f};
    } else {
      const GAS f32x4* xr = (const GAS f32x4*)(p.out + (size_t)(t0 - 1) * DM) + lane;
      const GAS v2u* yr = (const GAS v2u*)(Y1 + (size_t)(t0 - 1) * DM) + lane;
      float s = 0.f;
#pragma unroll
      for (int j = 0; j < 4; ++j) { prev[j] = xr[64 * j]; const v2u y = yr[64 * j];
        prev[j].x += __uint_as_float(y.x << 16); prev[j].y += __uint_as_float(y.x & 0xffff0000u); prev[j].z += __uint_as_float(y.y << 16); prev[j].w += __uint_as_float(y.y & 0xffff0000u);
        s += (prev[j].x * prev[j].x + prev[j].y * prev[j].y) + (prev[j].z * prev[j].z + prev[j].w * prev[j].w); }
      const float r = rsqrtf(wave_sum(s) * (1.f / DM) + 1e-6f);
#pragma unroll
      for (int j = 0; j < 4; ++j) prev[j] = prev[j] * r * g[j];
    }
    for (int tt = 0; tt < 8; ++tt) {
      const int t = t0 + tt;
      const GAS f32x4* xr = (const GAS f32x4*)(p.out + (size_t)t * DM) + lane;
      const GAS v2u* yr = (const GAS v2u*)(Y1 + (size_t)t * DM) + lane;
      f32x4 v[4]; float s = 0.f;
#pragma unroll
      for (int j = 0; j < 4; ++j) { v[j] = xr[64 * j]; const v2u y = yr[64 * j];
        v[j].x += __uint_as_float(y.x << 16); v[j].y += __uint_as_float(y.x & 0xffff0000u); v[j].z += __uint_as_float(y.y << 16); v[j].w += __uint_as_float(y.y & 0xffff0000u);
        s += (v[j].x * v[j].x + v[j].y * v[j].y) + (v[j].z * v[j].z + v[j].w * v[j].w); }
      const float r = rsqrtf(wave_sum(s) * (1.f / DM) + 1e-6f);
#pragma unroll
      for (int j = 0; j < 4; ++j) v[j] = v[j] * r * g[j];
#pragma unroll
      for (int sl = 0; sl < 6; ++sl) {
        const int mj = (sl == 0) ? 0 : (sl == 1) ? 2 : (sl == 2) ? 3 : (sl == 3) ? 1 : (sl == 4) ? 4 : 5;
        GAS v2u* o = (GAS v2u*)(p.ws + WS_S0 + (size_t)sl * SLOT + (size_t)t * DM * 2) + lane;
#pragma unroll
        for (int j = 0; j < 4; ++j) {
          const f32x4 mx = ((const GAS f32x4*)(p.rmix + mj * DM))[lane + 64 * j];
          const f32x4 q = v[j] + (prev[j] - v[j]) * mx;
          v2u w; w.x = pk2(q.x, q.y); w.y = pk2(q.z, q.w);
          o[64 * j] = w;
        }
      }
#pragma unroll
      for (int j = 0; j < 4; ++j) prev[j] = v[j];
    }
  }
}


constexpr int RP = 72;
constexpr int RB = 64 * RP * 2;
typedef LAS bf16_t* lbf;

__device__ __forceinline__ f32x4 mm16(f32x4 acc, const LAS bf16_t* A, int arow0, const LAS bf16_t* Bt, int brow0, int lane) {
  const int r = lane & 15, q = lane >> 4;
#pragma unroll
  for (int ks = 0; ks < 2; ++ks) {
    const bf16x8 a = *(const LAS bf16x8*)(A + (arow0 + r) * RP + ks * 32 + q * 8);
    const bf16x8 b = *(const LAS bf16x8*)(Bt + (brow0 + r) * RP + ks * 32 + q * 8);
    acc = __builtin_amdgcn_mfma_f32_16x16x32_bf16(a, b, acc, 0, 0, 0);
  }
  return acc;
}
__device__ __forceinline__ float sum8(float v) {
  v += __shfl_xor(v, 1, 64); v += __shfl_xor(v, 2, 64); v += __shfl_xor(v, 4, 64); return v;
}
__device__ __forceinline__ void ld8bf(const bf16_t* p, float (&o)[8]) {
  const v4u w = *(const GAS v4u*)p;
  o[0] = __uint_as_float(w.x << 16); o[1] = __uint_as_float(w.x & 0xffff0000u); o[2] = __uint_as_float(w.y << 16); o[3] = __uint_as_float(w.y & 0xffff0000u);
  o[4] = __uint_as_float(w.z << 16); o[5] = __uint_as_float(w.z & 0xffff0000u); o[6] = __uint_as_float(w.w << 16); o[7] = __uint_as_float(w.w & 0xffff0000u);
}
__device__ __forceinline__ v4u pk8(const float (&o)[8]) { v4u w; w.x = pk2(o[0], o[1]); w.y = pk2(o[2], o[3]); w.z = pk2(o[4], o[5]); w.w = pk2(o[6], o[7]); return w; }

__device__ __forceinline__ void rwkv_r1_item(const P& p, Frame& F, int item) {
  const int tid = F.tid, lane = F.lane, w = F.wave;
  const int ch = item >> 6, c = item & 63, b = ch >> 4, hd = ch & 15;
  const size_t tile0 = ((size_t)(b * SEQ + c * 64) * DM + hd * 64);
  unsigned char* ws = p.ws;
  bf16_t* SL[6];
#pragma unroll
  for (int s = 0; s < 6; ++s) SL[s] = (bf16_t*)(ws + WS_S0 + (size_t)s * SLOT) + tile0;
  const lbf BtT = (lbf)(F.lds + 0 * RB), KtT = (lbf)(F.lds + 1 * RB), AbT = (lbf)(F.lds + 2 * RB), RbT = (lbf)(F.lds + 3 * RB);
  const lbf Ab = (lbf)(F.lds + 4 * RB), Vc = (lbf)(F.lds + 5 * RB), Bh = (lbf)(F.lds + 6 * RB), Kh = (lbf)(F.lds + 7 * RB);
  const lbf Tk = (lbf)(F.lds + 8 * RB), WbT = (lbf)(F.lds + 9 * RB), WkT = (lbf)(F.lds + 10 * RB);
  const lbf X = BtT, XT = KtT, Pb = AbT;
  const lbf At = X, TNT = XT, U0 = Tk;
  LAS float* Lf = (LAS float*)(F.lds + 11 * RB);
  LAS float* SEG = Lf + 64 * 65;
  LAS float* GC = (LAS float*)(F.lds + 14 * RB);
  const int t = tid >> 3, cg = tid & 7, k0 = cg * 8;
  float r_[8], ld_[8], kx[8], v_[8], a_[8];
  ld8bf(SL[3] + (size_t)t * DM + k0, r_); ld8bf(SL[0] + (size_t)t * DM + k0, ld_); ld8bf(SL[4] + (size_t)t * DM + k0, kx);
  ld8bf(SL[5] + (size_t)t * DM + k0, v_); ld8bf(SL[1] + (size_t)t * DM + k0, a_);
  float kk[8], km[8], be[8];
  {
    float ss = 0.f, bo = 0.f;
#pragma unroll
    for (int i = 0; i < 8; ++i) { const int cc = hd * 64 + k0 + i; kk[i] = kx[i] * p.k_k[cc]; ss += kk[i] * kk[i]; km[i] = kx[i] * (1.f + (a_[i] - 1.f) * p.k_a[cc]); bo += r_[i] * km[i] * p.r_k[cc]; }
    ss = sum8(ss); bo = sum8(bo);
    const float inv = 1.f / fmaxf(sqrtf(ss), 1e-12f);
#pragma unroll
    for (int i = 0; i < 8; ++i) { kk[i] *= inv; be[i] = kk[i] * a_[i]; }
    if (cg == 0) ((float*)(ws + WS_TMP))[(size_t)item * 64 + t] = bo;
  }
#pragma unroll
  for (int i = 0; i < 8; ++i) Lf[t * 65 + k0 + i] = ld_[i];
  __syncthreads();
  {
    const int k = tid & 63, sg = tid >> 6;
    float run = 0.f;
#pragma unroll
    for (int i = 0; i < 8; ++i) { run += Lf[(sg * 8 + i) * 65 + k]; Lf[(sg * 8 + i) * 65 + k] = run; }
    SEG[sg * 64 + k] = run;
    __syncthreads();
    float off = 0.f;
    for (int j = 0; j < sg; ++j) off += SEG[j * 64 + k];
#pragma unroll
    for (int i = 0; i < 8; ++i) Lf[(sg * 8 + i) * 65 + k] += off;
  }
  __syncthreads();
  {
    float ab[8], bt[8], kt[8], rb[8], bh[8], kh[8];
#pragma unroll
    for (int i = 0; i < 8; ++i) {
      const float Lt = Lf[t * 65 + k0 + i], Lp = (t > 0) ? Lf[(t - 1) * 65 + k0 + i] : 0.f, LC = Lf[63 * 65 + k0 + i];
      const float ei = __expf(-Lt), eh = __expf(LC - Lt);
      if (t == 63) GC[k0 + i] = __expf(LC);
      ab[i] = -kk[i] * __expf(Lp); bt[i] = be[i] * ei; kt[i] = km[i] * ei; rb[i] = r_[i] * __expf(Lt); bh[i] = be[i] * eh; kh[i] = km[i] * eh;
    }
    *(LAS v4u*)(BtT + t * RP + k0) = pk8(bt); *(LAS v4u*)(KtT + t * RP + k0) = pk8(kt); *(LAS v4u*)(AbT + t * RP + k0) = pk8(ab); *(LAS v4u*)(RbT + t * RP + k0) = pk8(rb);
#pragma unroll
    for (int i = 0; i < 8; ++i) { Ab[(k0 + i) * RP + t] = (bf16_t)f2bf(ab[i]); Vc[(k0 + i) * RP + t] = (bf16_t)f2bf(v_[i]); Bh[(k0 + i) * RP + t] = (bf16_t)f2bf(bh[i]); Kh[(k0 + i) * RP + t] = (bf16_t)f2bf(kh[i]); }
  }
  __syncthreads();
  const int tr = w >> 1, tc0 = (w & 1) * 2;
  const int cr = lane & 15, q4 = (lane >> 4) * 4;
  f32x4 accP[2], accX[2];
  {
    f32x4 tab[2], tak[2], wbr[2], wkr[2];
#pragma unroll
    for (int j = 0; j < 2; ++j) { const f32x4 z = {0.f, 0.f, 0.f, 0.f};
      tab[j] = mm16(z, BtT, tr * 16, AbT, (tc0 + j) * 16, lane); tak[j] = mm16(z, KtT, tr * 16, AbT, (tc0 + j) * 16, lane);
      wbr[j] = mm16(z, BtT, tr * 16, RbT, (tc0 + j) * 16, lane); wkr[j] = mm16(z, KtT, tr * 16, RbT, (tc0 + j) * 16, lane); }
    __syncthreads();
#pragma unroll
    for (int j = 0; j < 2; ++j)
#pragma unroll
      for (int i = 0; i < 4; ++i) {
        const int s = tr * 16 + q4 + i, tt = (tc0 + j) * 16 + cr;
        const float x = (s < tt) ? tab[j][i] : 0.f;
        accX[j][i] = x; accP[j][i] = x + ((s == tt) ? 1.f : 0.f);
        X[s * RP + tt] = (bf16_t)f2bf(x); XT[tt * RP + s] = (bf16_t)f2bf(x); Pb[s * RP + tt] = (bf16_t)f2bf(accP[j][i]);
        Tk[s * RP + tt] = (bf16_t)f2bf((s < tt) ? tak[j][i] : 0.f);
        WbT[tt * RP + s] = (bf16_t)f2bf((s <= tt) ? wbr[j][i] : 0.f);
        WkT[tt * RP + s] = (bf16_t)f2bf((s <= tt) ? wkr[j][i] : 0.f);
      }
  }
  __syncthreads();
#pragma unroll 1
  for (int st = 0; st < 6; ++st) {
    f32x4 xn[2], pn[2];
#pragma unroll
    for (int j = 0; j < 2; ++j) { const f32x4 z = {0.f, 0.f, 0.f, 0.f};
      xn[j] = mm16(z, X, tr * 16, XT, (tc0 + j) * 16, lane);
      pn[j] = (st > 0) ? mm16(accP[j], Pb, tr * 16, XT, (tc0 + j) * 16, lane) : accP[j]; }
    __syncthreads();
#pragma unroll
    for (int j = 0; j < 2; ++j)
#pragma unroll
      for (int i = 0; i < 4; ++i) {
        const int s = tr * 16 + q4 + i, tt = (tc0 + j) * 16 + cr;
        accP[j][i] = pn[j][i];
        if (st < 5) { X[s * RP + tt] = (bf16_t)f2bf(xn[j][i]); XT[tt * RP + s] = (bf16_t)f2bf(xn[j][i]); Pb[s * RP + tt] = (bf16_t)f2bf(pn[j][i]); }
        else Pb[tt * RP + s] = (bf16_t)f2bf(pn[j][i]);
      }
    __syncthreads();
  }
  const lbf NT = Pb;
  {
    f32x4 at[2], tn[2];
#pragma unroll
    for (int j = 0; j < 2; ++j) { const f32x4 z = {0.f, 0.f, 0.f, 0.f};
      at[j] = mm16(z, Ab, tr * 16, NT, (tc0 + j) * 16, lane); tn[j] = mm16(z, Tk, tr * 16, NT, (tc0 + j) * 16, lane); }
#pragma unroll
    for (int j = 0; j < 2; ++j)
#pragma unroll
      for (int i = 0; i < 4; ++i) { const int rr = tr * 16 + q4 + i, cc = (tc0 + j) * 16 + cr;
        At[rr * RP + cc] = (bf16_t)f2bf(at[j][i]); TNT[cc * RP + rr] = (bf16_t)f2bf(tn[j][i]); }
  }
  __syncthreads();
  const lbf O_RT = (lbf)(F.lds + 11 * RB), O_PM = (lbf)(F.lds + 12 * RB), O_Y0 = (lbf)(F.lds + 13 * RB), O_Q = (lbf)(F.lds + 3 * RB)  ;
  {
    f32x4 u0[2], rt[2], pm[2];
#pragma unroll
    for (int j = 0; j < 2; ++j) { const f32x4 z = {0.f, 0.f, 0.f, 0.f};
      u0[j] = mm16(z, Vc, tr * 16, TNT, (tc0 + j) * 16, lane);
      rt[j] = mm16(z, WbT, tr * 16, At, (tc0 + j) * 16, lane);
      pm[j] = mm16(z, Bh, tr * 16, At, (tc0 + j) * 16, lane); }
    __syncthreads();
#pragma unroll
    for (int j = 0; j < 2; ++j)
#pragma unroll
      for (int i = 0; i < 4; ++i) { const int rr = tr * 16 + q4 + i, cc = (tc0 + j) * 16 + cr;
        U0[rr * RP + cc] = (bf16_t)f2bf(u0[j][i]);
        O_RT[rr * RP + cc] = (bf16_t)f2bf(rt[j][i] + bf2f(RbT[rr * RP + cc]));
        O_PM[rr * RP + cc] = (bf16_t)f2bf(pm[j][i] + ((rr == cc) ? GC[rr] : 0.f)); }
  }
  __syncthreads();
  {
    f32x4 y0[2], qq[2];
#pragma unroll
    for (int j = 0; j < 2; ++j) { const f32x4 z = {0.f, 0.f, 0.f, 0.f};
      y0[j] = mm16(mm16(z, WbT, tr * 16, U0, (tc0 + j) * 16, lane), WkT, tr * 16, Vc, (tc0 + j) * 16, lane);
      qq[j] = mm16(mm16(z, U0, tr * 16, Bh, (tc0 + j) * 16, lane), Vc, tr * 16, Kh, (tc0 + j) * 16, lane); }
#pragma unroll
    for (int j = 0; j < 2; ++j)
#pragma unroll
      for (int i = 0; i < 4; ++i) { const int rr = tr * 16 + q4 + i, cc = (tc0 + j) * 16 + cr;
        O_Y0[rr * RP + cc] = (bf16_t)f2bf(y0[j][i]); O_Q[rr * RP + cc] = (bf16_t)f2bf(qq[j][i]); }
  }
  __syncthreads();
  {
    const int row = tid >> 3, pc = (tid & 7) * 8;
    *(GAS v4u*)(SL[3] + (size_t)row * DM + pc) = *(const LAS v4u*)(O_RT + row * RP + pc);
    *(GAS v4u*)(SL[0] + (size_t)row * DM + pc) = *(const LAS v4u*)(O_PM + row * RP + pc);
    *(GAS v4u*)(SL[4] + (size_t)row * DM + pc) = *(const LAS v4u*)(O_Y0 + row * RP + pc);
    *(GAS v4u*)(SL[1] + (size_t)row * DM + pc) = *(const LAS v4u*)(O_Q + row * RP + pc);
  }
  __syncthreads();
}

__device__ __forceinline__ void phase_rwkv_r1(const P& p, Frame& F) {
  for (int item = F.vcu; item < 4096; item += F.G) rwkv_r1_item(p, F, item);
}

#define R2_BAR() do { asm volatile("s_waitcnt lgkmcnt(0)" ::: "memory"); __builtin_amdgcn_s_barrier(); asm volatile("" ::: "memory"); } while (0)
__device__ __forceinline__ void phase_rwkv_r2(const P& p, Frame& F) {
  const int lane = F.lane, w = F.wave, tid = F.tid;
  const lbf Sh = (lbf)(F.lds), Sl = (lbf)(F.lds + 16 * RP * 2);
  const int cr = lane & 15, q4 = (lane >> 4) * 4, q = lane >> 4;
  for (int task = F.vcu; task < 256; task += F.G) {
    const int ch = task >> 2, jb = task & 3, b = ch >> 4, hd = ch & 15;
    const bf16_t* PM = (const bf16_t*)(p.ws + WS_S0) + ((size_t)(b * SEQ) * DM + hd * 64);
    bf16_t* QS = (bf16_t*)(p.ws + WS_S0 + SLOT) + ((size_t)(b * SEQ) * DM + hd * 64);
    for (int i = tid; i < 16 * RP; i += NWAVES * 64) { Sh[i] = 0; Sl[i] = 0; }
    R2_BAR();
    const int wc = w & 3;
    const bf16_t* pmp = PM + (size_t)(16 * wc + cr) * DM + q * 8;
    const bf16_t* qsp = QS + (size_t)(16 * jb + q4) * DM + 16 * wc + cr;
    bf16x8 nb0[8], nb1[8]; unsigned short nq[8][4];
#pragma unroll
    for (int d = 0; d < 8; ++d) { nb0[d] = *(const GAS bf16x8*)(pmp + (size_t)d * 64 * DM); nb1[d] = *(const GAS bf16x8*)(pmp + (size_t)d * 64 * DM + 32);
#pragma unroll
      for (int i = 0; i < 4; ++i) nq[d][i] = *(const GAS unsigned short*)(qsp + (size_t)(d * 64 + i) * DM); }
#pragma unroll 1
    for (int c8 = 0; c8 < 64; c8 += 8) {
#pragma unroll
      for (int d = 0; d < 8; ++d) {
        const int c = c8 + d;
        f32x4 acc = {0.f, 0.f, 0.f, 0.f};
        const bf16x8 b0 = nb0[d], b1 = nb1[d];
        float qv[4];
#pragma unroll
        for (int i = 0; i < 4; ++i) qv[i] = bf2f(nq[d][i]);
        if (c + 8 < 64) { nb0[d] = *(const GAS bf16x8*)(pmp + (size_t)(c + 8) * 64 * DM); nb1[d] = *(const GAS bf16x8*)(pmp + (size_t)(c + 8) * 64 * DM + 32);
#pragma unroll
          for (int i = 0; i < 4; ++i) nq[d][i] = *(const GAS unsigned short*)(qsp + (size_t)((c + 8) * 64 + i) * DM); }
        const bf16x8 ah0 = *(const LAS bf16x8*)(Sh + cr * RP + q * 8), ah1 = *(const LAS bf16x8*)(Sh + cr * RP + 32 + q * 8);
        const bf16x8 al0 = *(const LAS bf16x8*)(Sl + cr * RP + q * 8), al1 = *(const LAS bf16x8*)(Sl + cr * RP + 32 + q * 8);
        acc = __builtin_amdgcn_mfma_f32_16x16x32_bf16(ah0, b0, acc, 0, 0, 0);
        acc = __builtin_amdgcn_mfma_f32_16x16x32_bf16(ah1, b1, acc, 0, 0, 0);
        acc = __builtin_amdgcn_mfma_f32_16x16x32_bf16(al0, b0, acc, 0, 0, 0);
        acc = __builtin_amdgcn_mfma_f32_16x16x32_bf16(al1, b1, acc, 0, 0, 0);
        R2_BAR();
        if (w < 4) {
#pragma unroll
          for (int i = 0; i < 4; ++i) { const float sv = acc[i] + qv[i]; const unsigned hi = f2bf(sv); const float lo = sv - __uint_as_float(hi << 16);
            Sh[(q4 + i) * RP + 16 * wc + cr] = (bf16_t)hi; Sl[(q4 + i) * RP + 16 * wc + cr] = (bf16_t)f2bf(lo); }
        }
        R2_BAR();
        if (tid >= 256 && tid < 384) {
          const int row = (tid - 256) >> 3, pc = (tid & 7) * 8;
          *(GAS v4u*)(QS + (size_t)(c * 64 + 16 * jb + row) * DM + pc) = *(const LAS v4u*)(Sh + row * RP + pc);
        }
      }
    }
    R2_BAR();
  }
}

__device__ __forceinline__ void phase_rwkv_r3(const P& p, Frame& F) {
  const int lane = F.lane, w = F.wave;
  const int cr = lane & 15, q4 = (lane >> 4) * 4, q = lane >> 4;
  const int half = w >> 2, tb = w & 3;
  LAS bf16_t* stg = (LAS bf16_t*)(F.lds) + w * 16 * RP;
  for (int it2 = F.vcu; it2 < 2048; it2 += F.G) {
    const int item = it2 * 2 + half;
    const int ch = item >> 6, c = item & 63, b = ch >> 4, hd = ch & 15;
    const size_t tile0 = ((size_t)(b * SEQ + c * 64) * DM + hd * 64);
    bf16_t* RT = (bf16_t*)(p.ws + WS_S0 + 3 * SLOT) + tile0;
    const bf16_t* Y0 = (const bf16_t*)(p.ws + WS_S0 + 4 * SLOT) + tile0;
    const bf16_t* VV = (const bf16_t*)(p.ws + WS_S0 + 5 * SLOT) + tile0;
    const bf16_t* GG = (const bf16_t*)(p.ws + WS_S0 + 2 * SLOT) + tile0;
    const bf16_t* SC = (const bf16_t*)(p.ws + WS_S0 + SLOT) + tile0 - (size_t)64 * DM;
    const float* BO = (const float*)(p.ws + WS_TMP) + (size_t)item * 64;
    f32x4 y[4];
#pragma unroll
    for (int j = 0; j < 4; ++j) y[j] = (f32x4){0.f, 0.f, 0.f, 0.f};
    if (c > 0) {
      const bf16_t* ap = RT + (size_t)(16 * tb + cr) * DM + q * 8;
      const bf16x8 a0 = *(const GAS bf16x8*)ap, a1 = *(const GAS bf16x8*)(ap + 32);
#pragma unroll
      for (int j = 0; j < 4; ++j) {
        const bf16_t* bp = SC + (size_t)(16 * j + cr) * DM + q * 8;
        const bf16x8 b0 = *(const GAS bf16x8*)bp, b1 = *(const GAS bf16x8*)(bp + 32);
        y[j] = __builtin_amdgcn_mfma_f32_16x16x32_bf16(a0, b0, y[j], 0, 0, 0);
        y[j] = __builtin_amdgcn_mfma_f32_16x16x32_bf16(a1, b1, y[j], 0, 0, 0);
      }
    }
    float mu[4], rs[4];
#pragma unroll
    for (int i = 0; i < 4; ++i) {
      float s = 0.f;
#pragma unroll
      for (int j = 0; j < 4; ++j) { y[j][i] += bf2f(Y0[(size_t)(16 * tb + q4 + i) * DM + 16 * j + cr]); s += y[j][i]; }
      s += __shfl_xor(s, 1, 64); s += __shfl_xor(s, 2, 64); s += __shfl_xor(s, 4, 64); s += __shfl_xor(s, 8, 64);
      mu[i] = s * (1.f / 64.f);
      float qd = 0.f;
#pragma unroll
      for (int j = 0; j < 4; ++j) { const float d = y[j][i] - mu[i]; qd += d * d; }
      qd += __shfl_xor(qd, 1, 64); qd += __shfl_xor(qd, 2, 64); qd += __shfl_xor(qd, 4, 64); qd += __shfl_xor(qd, 8, 64);
      rs[i] = rsqrtf(qd * (1.f / 64.f) + 64e-5f);
    }
#pragma unroll
    for (int j = 0; j < 4; ++j) {
      const int cc = hd * 64 + 16 * j + cr;
      const float lw = p.ln_w[cc], lb = p.ln_b[cc];
#pragma unroll
      for (int i = 0; i < 4; ++i) {
        const int tt = 16 * tb + q4 + i;
        const float vv = bf2f(VV[(size_t)tt * DM + 16 * j + cr]), gg = bf2f(GG[(size_t)tt * DM + 16 * j + cr]);
        const float z = ((y[j][i] - mu[i]) * rs[i] * lw + lb + BO[tt] * vv) * gg;
        stg[(q4 + i) * RP + 16 * j + cr] = (bf16_t)f2bf(z);
      }
    }
    LDS_WAIT();
#pragma unroll
    for (int i = 0; i < 2; ++i) { const int row = (lane >> 3) + 8 * i, pc = (lane & 7) * 8;
      *(GAS v4u*)(RT + (size_t)(16 * tb + row) * DM + pc) = *(const LAS v4u*)(stg + row * RP + pc); }
    LDS_WAIT();
  }
}

__global__ void __launch_bounds__(NWAVES * 64, 2) mk_fwd(P p) {
  extern __shared__ __attribute__((aligned(16))) unsigned char lds[];
  Frame F;
  F.lds = (LAS unsigned char*)lds;
  F.MISC = (volatile LAS unsigned*)(F.lds + MISC_OFF);
  F.tid = threadIdx.x; F.lane = F.tid & 63; F.wave = __builtin_amdgcn_readfirstlane(F.tid >> 6);
  F.G = gridDim.x; { const int bx = blockIdx.x; F.vcu = (F.G % 8 == 0) ? (bx % 8) * (F.G / 8) + bx / 8 : bx; }
  F.ctl = (gu32*)(p.ws + WS_CTL);
  for (int u = F.tid; u < (LDS_BYTES - LDSCTL_OFF) / 4; u += NWAVES * 64) ((LAS unsigned*)(F.lds + LDSCTL_OFF))[u] = 0u;
  __syncthreads();
  XcdBarrier bar = xcd_barrier_post((unsigned*)(F.ctl + CW_BAR) + p.pad * XCD_BAR_WORDS, F.MISC + 8);
  const int lo = p.ph_lo, hi = p.ph_hi;
#ifndef PHMASK
#define PHMASK 0xffffffffu
#endif
#define IN(k) (lo <= (k) && (k) < hi && ((PHMASK >> (k)) & 1u))
#define SEAM(k) do { if (IN(k) && IN((k) + 1)) xcd_barrier(bar); } while (0)
  unsigned char* ws = p.ws;

  if (IN(0)) { phase_prologue(p, F); } SEAM(0);
  if (IN(1)) {
    pg8::Gemm g{(const bf16_t*)(ws + WS_XN), (const bf16_t*)(ws + WS_WIN), DM};
    pg8::StaticOrder S; S.init(T_TOK, 3072, F.G, (int)blockIdx.x);
    EpiInProj E{(bf16_t*)(ws + WS_H), (float*)(ws + WS_GATES), p.dq_norm, p.dk_norm, p.nq_norm, p.nk_norm, p.gate_bias};
    pg8::gemm_phase<EpiInProj, pg8::StaticOrder, true>(F.lds + RING_OFF, g, S, E);
  } SEAM(1);
  if (IN(2)) {
    pg8::Gemm g{(const bf16_t*)(ws + WS_CAT), (const bf16_t*)(ws + WS_WOUT), DM};
    pg8::StaticOrder S; S.init(T_TOK, DM, F.G, (int)blockIdx.x);
    EpiResid E{p.x, p.out, nullptr};
    pg8::gemm_phase<EpiResid, pg8::StaticOrder, false>(F.lds + RING_OFF, g, S, E);
  } SEAM(2);
#define MOE_PHASES(layer, pb) do { \
    if (IN(pb)) { phase_router(p, F, layer); } SEAM(pb); \
    if (IN(pb + 1)) { \
      pg8::Gemm g{(const bf16_t*)(ws + WS_XN2), (const bf16_t*)(ws + WS_EGU), DM}; \
      pg8::MoeOrder<2, true> S{(const unsigned*)(ws + WS_CTL) + CW_CNT + layer * 32, (const int*)(ws + WS_LIST), F.G, (int)blockIdx.x}; \
      EpiMoeGU E{(bf16_t*)(ws + WS_HID)}; \
      pg8::gemm_phase<EpiMoeGU, pg8::MoeOrder<2, true>, true>(F.lds + RING_OFF, g, S, E); \
    } SEAM(pb + 1); \
    if (IN(pb + 2)) { \
      int k256 = 256; asm volatile("" : "+s"(k256)); \
      pg8::Gemm g{(const bf16_t*)(ws + WS_HID), (const bf16_t*)(ws + WS_EDN), k256}; \
      pg8::MoeOrder<4, false> S{(const unsigned*)(ws + WS_CTL) + CW_CNT + layer * 32, (const int*)(ws + WS_LIST), F.G, (int)blockIdx.x}; \
      EpiMoeDown E{p.out, (bf16_t*)(ws + WS_Y1), (const int*)(ws + WS_LIST), (const float*)(ws + WS_PGATE)}; \
      pg8::gemm_phase<EpiMoeDown, pg8::MoeOrder<4, false>, true>(F.lds + RING_OFF, g, S, E); \
    } SEAM(pb + 2); \
  } while (0)
  MOE_PHASES(0, 3);
  if (IN(6)) { phase_rwkv_prep(p, F); } SEAM(6);
  if (IN(7)) {
    pg8::Gemm g{(const bf16_t*)(ws + WS_S0 + 3 * SLOT), (const bf16_t*)(ws + WS_WL1), DM};
    pg8::TallOrder S; S.init(3, 1, F.G, (int)blockIdx.x);
    EpiLora1 E{(bf16_t*)(ws + WS_TMP)};
    pg8::gemm_phase<EpiLora1, pg8::TallOrder, false>(F.lds + RING_OFF, g, S, E);
  } SEAM(7);
  if (IN(8)) {
    pg8::Gemm g{(const bf16_t*)(ws + WS_S0), (const bf16_t*)(ws + WS_WRKV), DM};
    pg8::TallOrder S; S.init(3, 4, F.G, (int)blockIdx.x);
    EpiRKV E{ws};
    pg8::gemm_phase<EpiRKV, pg8::TallOrder, true>(F.lds + RING_OFF, g, S, E);
  } SEAM(8);
  if (IN(9)) {
    int k384 = 384; asm volatile("" : "+s"(k384));
    pg8::Gemm g{(const bf16_t*)(ws + WS_TMP), (const bf16_t*)(ws + WS_WL2), k384};
    pg8::StaticOrder S; S.init(T_TOK, 3072, F.G, (int)blockIdx.x);
    EpiLora2 E{ws, p.w0, p.a0};
    pg8::gemm_phase<EpiLora2, pg8::StaticOrder, true>(F.lds + RING_OFF, g, S, E);
  } SEAM(9);
  if (IN(10)) { phase_rwkv_r1(p, F); } SEAM(10);
  if (IN(11)) { phase_rwkv_r2(p, F); } SEAM(11);
  if (IN(12)) { phase_rwkv_r3(p, F); } SEAM(12);
  if (IN(13)) {
    pg8::Gemm g{(const bf16_t*)(ws + WS_S0 + 3 * SLOT), (const bf16_t*)(ws + WS_WO), DM};
    pg8::StaticOrder S; S.init(T_TOK, DM, F.G, (int)blockIdx.x);
    EpiResid E{p.out, p.out, (const bf16_t*)(ws + WS_Y1)};
    pg8::gemm_phase<EpiResid, pg8::StaticOrder, false>(F.lds + RING_OFF, g, S, E);
  } SEAM(13);
  MOE_PHASES(1, 14);
#undef MOE_PHASES
  if (IN(17)) { phase_final(p, F); }
#undef IN
#undef SEAM
}

struct NP {
  P p; const bf16_t* H; const float* GATES; bf16_t* CAT; float* KCMP; float* VCMP;
  float* XN2F; float* GUF; int* LIST; float* PGATE; int* CNT;
};

__global__ __launch_bounds__(64) void k_compress(NP q) {
  __shared__ float flat[2048];
  __shared__ float hid[64];
  const P& p = q.p;
  const int lane = threadIdx.x;
  int id = blockIdx.x;
  const int kv = id & 1; id >>= 1;
  const int g = id & 1; id >>= 1;
  const int c = id % NCMP; const int b = id / NCMP;
  const int colbase = OFF_NKV + ((0 * 2 + kv) * 2 + g) * 64;
  for (int l = 0; l < 32; l++)
    flat[l * 64 + lane] = bf2f(q.H[(size_t)(b * SEQ + 16 * c + l) * HC + colbase + lane]) + p.cmp_pe[(kv * 32 + l) * 64 + lane];
  __syncthreads();
  const float* w1 = p.cmp_w1 + (size_t)kv * 2048 * 64;
  float acc = 0.f;
  for (int i = 0; i < 2048; i++) acc += flat[i] * w1[i * 64 + lane];
  hid[lane] = gelu_tanh(acc);
  __syncthreads();
  const float* w2 = p.cmp_w2 + kv * 64 * 64;
  float o = 0.f;
  for (int j = 0; j < 64; j++) o += hid[j] * w2[j * 64 + lane];
  if (kv == 0) {
    float s = wave_sum(o * o);
    o = o * rsqrtf(s * (1.f / 64.f) + 1e-6f) * p.nk_norm[lane];
    q.KCMP[((size_t)(b * NCMP + c) * 2 + g) * 64 + lane] = o;
  } else {
    q.VCMP[((size_t)(b * NCMP + c) * 2 + g) * 64 + lane] = o;
  }
}

__global__ __launch_bounds__(64) void k_diffattn(NP q) {
  const P& p = q.p;
  const int lane = threadIdx.x;
  const int s = blockIdx.x * 64 + lane;
  const int b = blockIdx.y >> 3, hd = blockIdx.y & 7;
  const int t = b * SEQ + s;
  float mq = 0.f, mk = 0.f, l0 = 0.f, l1 = 0.f;
  for (int i = 0; i < 32; i++) {
    mq = fmaxf(mq, fabsf(p.dq_norm[i])); mk = fmaxf(mk, fabsf(p.dk_norm[i]));
    l0 += p.dlam[i] * p.dlam[32 + i]; l1 += p.dlam[64 + i] * p.dlam[96 + i];
  }
  const float scale = 0.17677669529663687f;
  const float bound = 32.f * mq * mk * scale;
  const float lam = __expf(l0) - __expf(l1) + 0.2f;
  float q1[32], q2[32], o1[64], o2[64];
  const bf16_t* hq = q.H + (size_t)t * HC + OFF_DQ + hd * 64;
#pragma unroll
  for (int d = 0; d < 32; d++) { q1[d] = bf2f(hq[d]) * scale; q2[d] = bf2f(hq[32 + d]) * scale; }
#pragma unroll
  for (int d = 0; d < 64; d++) { o1[d] = 0.f; o2[d] = 0.f; }
  float s1 = 0.f, s2 = 0.f;
  const int jmax = blockIdx.x * 64 + 63;
  for (int j = 0; j <= jmax; j++) {
    const bf16_t* kr = q.H + (size_t)(b * SEQ + j) * HC + OFF_DK + hd * 64;
    const bf16_t* vr = q.H + (size_t)(b * SEQ + j) * HC + OFF_DV + hd * 64;
    float a1 = 0.f, a2 = 0.f;
#pragma unroll
    for (int d = 0; d < 32; d++) { a1 += q1[d] * bf2f(kr[d]); a2 += q2[d] * bf2f(kr[32 + d]); }
    float p1 = (j <= s) ? __expf(a1 - bound) : 0.f;
    float p2 = (j <= s) ? __expf(a2 - bound) : 0.f;
    s1 += p1; s2 += p2;
#pragma unroll
    for (int d = 0; d < 64; d++) { float v = bf2f(vr[d]); o1[d] += p1 * v; o2[d] += p2 * v; }
  }
  const float i1 = 1.f / s1, i2 = lam / s2;
  float ss = 0.f;
#pragma unroll
  for (int d = 0; d < 64; d++) { o1[d] = o1[d] * i1 - o2[d] * i2; ss += o1[d] * o1[d]; }
  const float r = rsqrtf(ss * (1.f / 64.f) + 1e-6f) * 0.8f;
  bf16_t* oc = q.CAT + (size_t)t * DM + hd * 64;
#pragma unroll
  for (int d = 0; d < 64; d++) oc[d] = (bf16_t)f2bf(o1[d] * r * p.dsubln[d]);
}

__device__ __forceinline__ void nsa_dense_block(const bf16_t* H, int b, int s, int key0, int kcol, int vcol, float bound,
                                                const float (*q)[64], float (*ps)[64], float* lsum, float* oacc, int lane) {
  const int key = key0 + lane;
  const bool valid = (key >= 0) && (key <= s);
  float pj[4] = {0.f, 0.f, 0.f, 0.f};
  if (valid) {
    const bf16_t* kr = H + (size_t)(b * SEQ + key) * HC + kcol;
    float d0 = 0.f, d1 = 0.f, d2 = 0.f, d3 = 0.f;
#pragma unroll
    for (int i = 0; i < 64; i++) {
      float kk = bf2f(kr[i]);
      d0 += kk * q[0][i]; d1 += kk * q[1][i]; d2 += kk * q[2][i]; d3 += kk * q[3][i];
    }
    pj[0] = __expf(d0 * 0.125f - bound); pj[1] = __expf(d1 * 0.125f - bound);
    pj[2] = __expf(d2 * 0.125f - bound); pj[3] = __expf(d3 * 0.125f - bound);
  }
#pragma unroll
  for (int j = 0; j < 4; j++) { lsum[j] += pj[j]; ps[j][lane] = pj[j]; }
  __syncthreads();
  int klo = key0 < 0 ? -key0 : 0;
  int khi = (s - key0) < 63 ? (s - key0) : 63;
  for (int kk = klo; kk <= khi; kk++) {
    float v = bf2f(H[(size_t)(b * SEQ + key0 + kk) * HC + vcol + lane]);
#pragma unroll
    for (int j = 0; j < 4; j++) oacc[j] += ps[j][kk] * v;
  }
  __syncthreads();
}

__global__ __launch_bounds__(64) void k_nsa(NP qq) {
  __shared__ float q[4][64];
  __shared__ float pc[4][256];
  __shared__ float ps[4][64];
  const P& p = qq.p;
  const int lane = threadIdx.x;
  const int t = blockIdx.x, g = blockIdx.y;
  const int b = t >> 12, s = t & (SEQ - 1);
  const bf16_t* hrow = qq.H + (size_t)t * HC;
  float mq = 0.f, mk0 = 0.f, mk1 = 0.f, mk2 = 0.f;
  for (int i = 0; i < 64; i++) {
    mq = fmaxf(mq, fabsf(p.nq_norm[i]));
    mk0 = fmaxf(mk0, fabsf(p.nk_norm[i])); mk1 = fmaxf(mk1, fabsf(p.nk_norm[64 + i])); mk2 = fmaxf(mk2, fabsf(p.nk_norm[128 + i]));
  }
  const float bound0 = 8.f * mq * mk0, bound1 = 8.f * mq * mk1, bound2 = 8.f * mq * mk2;
#pragma unroll
  for (int j = 0; j < 4; j++) q[j][lane] = bf2f(hrow[OFF_NQ + (g * 4 + j) * 64 + lane]);
  __syncthreads();
  int nvalid = (s >= 31) ? ((s - 31) / 16 + 1) : 0;
  if (nvalid > NCMP) nvalid = NCMP;
  float lc[4] = {0.f, 0.f, 0.f, 0.f};
  for (int cb = 0; cb < 256; cb += 64) {
    int c = cb + lane;
    float pj[4] = {0.f, 0.f, 0.f, 0.f};
    if (c < nvalid) {
      const float4* kr = (const float4*)(qq.KCMP + ((size_t)(b * NCMP + c) * 2 + g) * 64);
      float d0 = 0.f, d1 = 0.f, d2 = 0.f, d3 = 0.f;
#pragma unroll
      for (int i = 0; i < 16; i++) {
        float4 kk = kr[i];
        const float4 q0 = *(const float4*)&q[0][i * 4];
        const float4 q1 = *(const float4*)&q[1][i * 4];
        const float4 q2 = *(const float4*)&q[2][i * 4];
        const float4 q3 = *(const float4*)&q[3][i * 4];
        d0 += kk.x * q0.x + kk.y * q0.y + kk.z * q0.z + kk.w * q0.w;
        d1 += kk.x * q1.x + kk.y * q1.y + kk.z * q1.z + kk.w * q1.w;
        d2 += kk.x * q2.x + kk.y * q2.y + kk.z * q2.z + kk.w * q2.w;
        d3 += kk.x * q3.x + kk.y * q3.y + kk.z * q3.z + kk.w * q3.w;
      }
      pj[0] = __expf(d0 * 0.125f - bound0); pj[1] = __expf(d1 * 0.125f - bound0);
      pj[2] = __expf(d2 * 0.125f - bound0); pj[3] = __expf(d3 * 0.125f - bound0);
    }
#pragma unroll
    for (int j = 0; j < 4; j++) { lc[j] += pj[j]; pc[j][c] = pj[j]; }
  }
#pragma unroll
  for (int j = 0; j < 4; j++) { lc[j] = wave_sum(lc[j]); lc[j] = (nvalid > 0) ? 1.f / lc[j] : 0.f; }
  __syncthreads();
  for (int cb = 0; cb < 256; cb += 64) {
#pragma unroll
    for (int j = 0; j < 4; j++) pc[j][cb + lane] *= lc[j];
  }
  __syncthreads();
  float ocmp[4] = {0.f, 0.f, 0.f, 0.f};
  for (int c = 0; c < nvalid; c++) {
    float v = qq.VCMP[((size_t)(b * NCMP + c) * 2 + g) * 64 + lane];
#pragma unroll
    for (int j = 0; j < 4; j++) ocmp[j] += pc[j][c] * v;
  }
  const int cur = s >> 6;
  float imp = 0.f;
  {
    int clo = 4 * lane - 1; if (clo < 0) clo = 0;
    int chi = 4 * lane + 3; if (chi > NCMP - 1) chi = NCMP - 1;
    for (int c = clo; c <= chi; c++) imp += pc[0][c] + pc[1][c] + pc[2][c] + pc[3][c];
  }
  if (lane == cur || lane == 0) imp = 1e4f;
  else if (lane > cur) imp = -1e30f;
  int rank = 0;
  for (int i = 0; i < 64; i++) {
    float vi = __shfl(imp, i, 64);
    rank += (vi > imp || (vi == imp && i < lane)) ? 1 : 0;
  }
  unsigned long long selmask = __ballot(rank < 16);
  float lsel[4] = {0.f, 0.f, 0.f, 0.f}, osel[4] = {0.f, 0.f, 0.f, 0.f};
  const int kcol1 = OFF_NKV + ((1 * 2 + 0) * 2 + g) * 64, vcol1 = OFF_NKV + ((1 * 2 + 1) * 2 + g) * 64;
  for (int blk = 0; blk <= cur; blk++) {
    if (!((selmask >> blk) & 1ull)) continue;
    nsa_dense_block(qq.H, b, s, blk * 64, kcol1, vcol1, bound1, q, ps, lsel, osel, lane);
  }
  float lwin[4] = {0.f, 0.f, 0.f, 0.f}, owin[4] = {0.f, 0.f, 0.f, 0.f};
  const int kcol2 = OFF_NKV + ((2 * 2 + 0) * 2 + g) * 64, vcol2 = OFF_NKV + ((2 * 2 + 1) * 2 + g) * 64;
  for (int key0 = s - 511; key0 <= s; key0 += 64) {
    if (key0 + 63 < 0) continue;
    nsa_dense_block(qq.H, b, s, key0, kcol2, vcol2, bound2, q, ps, lwin, owin, lane);
  }
#pragma unroll
  for (int j = 0; j < 4; j++) {
    float ls = wave_sum(lsel[j]), lw = wave_sum(lwin[j]);
    int hh = g * 4 + j;
    const float* gr = qq.GATES + (size_t)t * 24 + hh * 3;
    qq.CAT[(size_t)t * DM + 512 + hh * 64 + lane] = (bf16_t)f2bf(gr[0] * ocmp[j] + gr[1] * osel[j] / ls + gr[2] * owin[j] / lw);
  }
}

static void launch_mk(P p, int lo, int hi, int li, int grid, hipStream_t st) {
  p.ph_lo = lo; p.ph_hi = hi; p.pad = li;
  hipLaunchKernelGGL(mk_fwd, dim3(grid), dim3(NWAVES * 64), LDS_BYTES, st, p);
}

extern "C" void kernel_launch(void* const* d_in, const int* in_sizes, int n_in, void* d_out, int out_size, void* d_ws,
                              size_t ws_size, hipStream_t stream) {
  static int grid = 0;
  if (grid == 0) {
    if (n_in != 40 || ws_size < WS_END) { fprintf(stderr, "kernel_launch: bad n_in %d or ws_size %zu (< %zu)\n", n_in, ws_size, (size_t)WS_END); grid = -1; return; }
    int dev = 0, cus = 0;
    if (hipGetDevice(&dev) != hipSuccess || hipDeviceGetAttribute(&cus, hipDeviceAttributeMultiprocessorCount, dev) != hipSuccess) { grid = -1; return; }
    if (hipFuncSetAttribute((const void*)mk_fwd, hipFuncAttributeMaxDynamicSharedMemorySize, LDS_BYTES) != hipSuccess) { grid = -1; return; }
    grid = cus;
  }
  if (grid < 0) return;
  P p{};
  const float* const* in = (const float* const*)d_in;
  p.x = in[0]; p.mix_norm = in[1]; p.w_in = in[2]; p.gate_bias = in[3]; p.dq_norm = in[4]; p.dk_norm = in[5];
  p.dlam = in[6]; p.dsubln = in[7]; p.nq_norm = in[8]; p.nk_norm = in[9]; p.cmp_pe = in[10]; p.cmp_w1 = in[11];
  p.cmp_w2 = in[12]; p.w_out = in[13]; p.rmix = in[14]; p.w_r = in[15]; p.w_k = in[16]; p.w_v = in[17];
  p.w0 = in[18]; p.w1 = in[19]; p.w2 = in[20]; p.a0 = in[21]; p.a1 = in[22]; p.a2 = in[23]; p.g1 = in[24]; p.g2 = in[25];
  p.k_k = in[26]; p.k_a = in[27]; p.r_k = in[28]; p.ln_w = in[29]; p.ln_b = in[30]; p.w_o = in[31];
  p.ffn_norm = in[32]; p.rg_w = in[33]; p.rg_b = in[34]; p.re_w = in[35]; p.re_b = in[36];
  p.e_gate = in[37]; p.e_up = in[38]; p.e_down = in[39];
  p.out = (float*)d_out;
  p.ws = (unsigned char*)d_ws;
  unsigned char* ws = p.ws;
  NP q{};
  q.p = p; q.H = (const bf16_t*)(ws + WS_H); q.GATES = (const float*)(ws + WS_GATES); q.CAT = (bf16_t*)(ws + WS_CAT);
  q.KCMP = (float*)(ws + WS_KCMP); q.VCMP = (float*)(ws + WS_VCMP);
  q.XN2F = (float*)(ws + WS_XN2F); q.GUF = (float*)(ws + WS_GUF); q.LIST = (int*)(ws + WS_LIST); q.PGATE = (float*)(ws + WS_PGATE);
  q.CNT = (int*)(ws + WS_CTL) + CW_CNT;

  (void)hipMemsetAsync(ws + WS_CTL, 0, CTL_ZERO_BYTES, stream);
  launch_mk(p, 0, 2, 0, grid, stream);
  hipLaunchKernelGGL(k_compress, dim3(NBATCH * NCMP * 2 * 2), dim3(64), 0, stream, q);
  hipLaunchKernelGGL(k_diffattn, dim3(SEQ / 64, NBATCH * 8), dim3(64), 0, stream, q);
  hipLaunchKernelGGL(k_nsa, dim3(T_TOK, 2), dim3(64), 0, stream, q);
  launch_mk(p, 2, 18, 1, grid, stream);
}
```

```cpp
#include <hip/hip_runtime.h>
#include <cstdio>
#include <cstdint>

#define T_TOK 16384
#define DM 1024
#define SEQ 4096
#define NBATCH 4
#define INC 2840
#define HC 2816
#define OFF_DQ 0
#define OFF_DK 512
#define OFF_DV 1024
#define OFF_NQ 1536
#define OFF_NKV 2048
#define OFF_NG 2816
#define NCMP 255
#define CAP 16384

#define GAS __attribute__((address_space(1)))
#define LAS __attribute__((address_space(3)))
typedef unsigned short bf16_t;
typedef unsigned v4u __attribute__((ext_vector_type(4)));
typedef unsigned v2u __attribute__((ext_vector_type(2)));
typedef float f32x4 __attribute__((ext_vector_type(4)));
typedef short bf16x8 __attribute__((ext_vector_type(8)));
typedef GAS unsigned gu32;
#define RLX_AGENT __ATOMIC_RELAXED, __HIP_MEMORY_SCOPE_AGENT
#define LDS_WAIT() asm volatile("s_waitcnt lgkmcnt(0)" ::: "memory")
#define VM_WAIT() asm volatile("s_waitcnt vmcnt(0)" ::: "memory")

__device__ __forceinline__ float bf2f(bf16_t v) { return __uint_as_float(((unsigned)v) << 16); }
__device__ __forceinline__ unsigned f2bf(float f) { unsigned u = __builtin_bit_cast(unsigned, f); return (u + 0x7fffu + ((u >> 16) & 1u)) >> 16; }
__device__ __forceinline__ unsigned pk2(float lo, float hi) { return f2bf(lo) | (f2bf(hi) << 16); }
__device__ __forceinline__ float wave_sum(float v) {
#pragma unroll
  for (int o = 32; o >= 1; o >>= 1) v += __shfl_xor(v, o, 64);
  return v;
}
__device__ __forceinline__ float wave_sum_dpp(float v) {
  v += __builtin_bit_cast(float, __builtin_amdgcn_update_dpp(0, __builtin_bit_cast(int, v), 0xB1, 0xf, 0xf, false));
  v += __builtin_bit_cast(float, __builtin_amdgcn_update_dpp(0, __builtin_bit_cast(int, v), 0x4E, 0xf, 0xf, false));
  v += __builtin_bit_cast(float, __builtin_amdgcn_update_dpp(0, __builtin_bit_cast(int, v), 0x141, 0xf, 0xf, false));
  v += __builtin_bit_cast(float, __builtin_amdgcn_update_dpp(0, __builtin_bit_cast(int, v), 0x140, 0xf, 0xf, false));
  const int iv = __builtin_bit_cast(int, v);
  return (__builtin_bit_cast(float, __builtin_amdgcn_readlane(iv, 0)) + __builtin_bit_cast(float, __builtin_amdgcn_readlane(iv, 16))) +
         (__builtin_bit_cast(float, __builtin_amdgcn_readlane(iv, 32)) + __builtin_bit_cast(float, __builtin_amdgcn_readlane(iv, 48)));
}
__device__ __forceinline__ float sigmoidf_(float x) { return 1.f / (1.f + __expf(-x)); }
__device__ __forceinline__ float softplusf_(float x) { return fmaxf(x, 0.f) + __logf(1.f + __expf(-fabsf(x))); }
__device__ __forceinline__ float gelu_tanh(float x) {
  float u = 0.7978845608028654f * (x + 0.044715f * x * x * x);
  return 0.5f * x * (1.f + tanhf(u));
}

constexpr size_t MiB = 1u << 20;
constexpr size_t WS_CTL = 0, CTL_ZERO_BYTES = 1 * MiB;
constexpr size_t WS_WIN = 1 * MiB;
constexpr size_t WS_WOUT = 7 * MiB;
constexpr size_t WS_WRKV = 9 * MiB;
constexpr size_t WS_WO = 15 * MiB;
constexpr size_t WS_WL1 = 17 * MiB;
constexpr size_t WS_WL2 = 19 * MiB;
constexpr size_t WS_EGU = 22 * MiB;
constexpr size_t WS_EDN = 54 * MiB;
constexpr size_t WS_ACT = 70 * MiB;
constexpr size_t WS_XN = WS_ACT;
constexpr size_t WS_H = WS_ACT + 32 * MiB;
constexpr size_t WS_GATES = WS_ACT + 120 * MiB;
constexpr size_t WS_CAT = WS_ACT + 122 * MiB;
constexpr size_t WS_KCMPB = WS_ACT + 154 * MiB;
constexpr size_t WS_VCMPB = WS_ACT + 155 * MiB;
constexpr size_t WS_CW1 = 21 * MiB + 256 * 1024;
constexpr size_t WS_XN2 = WS_ACT;
constexpr size_t WS_HID = WS_ACT + 32 * MiB;
constexpr size_t WS_Y1 = WS_EGU;
constexpr size_t WS_LIST = WS_ACT + 156 * MiB;
constexpr size_t WS_PGATE = WS_ACT + 158 * MiB;
constexpr size_t WS_XN2F = WS_ACT;
constexpr size_t WS_GUF = WS_ACT + 64 * MiB;
constexpr size_t WS_S0 = WS_ACT;
constexpr size_t WS_TMP = WS_ACT + 192 * MiB;
constexpr size_t WS_END = WS_ACT + 204 * MiB;
constexpr size_t SLOT = 32 * MiB;
constexpr int CW_BAR = 4096;
constexpr int CW_CNT = 32768;

namespace pg8 {
#define PG8_LAS __attribute__((address_space(3)))
typedef unsigned u32x4 __attribute__((ext_vector_type(4)));
constexpr int BM = 256, BK = 64, HALF = 128, HTB = HALF * BK * 2  , STAGE_BYTES = 8 * HTB, NXCD = 8, WGM = 8;

__host__ __device__ __forceinline__ int lds_byte(int r, int c) { const int st = (r >> 4) * 2 + (c >> 5), rr = r & 15, cc = c & 31, ob = rr * 64 + cc * 2; return st * 1024 + (ob ^ (((ob >> 9) & 1) << 5)); }
__host__ __device__ __forceinline__ void stage_rc(int b, int& R, int& C) { const int st = b / 1024, sb = b % 1024, swz = sb ^ (((sb >> 9) & 1) << 5); R = (st >> 1) * 16 + swz / 64; C = (st & 1) * 32 + (swz % 64) / 2; }
__host__ __device__ __forceinline__ int perm32(int rho) { const int n = rho >> 4, i = rho & 15; return 8 * (i >> 2) + 4 * n + (i & 3); }

struct Unit { int pm, pn, e, nrows, rt; };
struct Gemm { const bf16_t* A; const bf16_t* Bt; int K; };

__device__ __forceinline__ void static_map(int L, int nM, int nN, int& pm, int& pn) {
    const int nwg = nM * nN;
    int wgid = L; { const int q = nwg / NXCD, r = nwg % NXCD, xcd = wgid % NXCD, off = wgid / NXCD; wgid = (xcd < r ? xcd * (q + 1) : r * (q + 1) + (xcd - r) * q) + off; }
    const int nig = WGM * nN, gid = wgid / nig, fm = gid * WGM, gsz = (nM - fm) < WGM ? (nM - fm) : WGM;
    pm = fm + ((wgid % nig) % gsz); pn = (wgid % nig) / gsz;
}
struct StaticOrder {
    int nM, nN, G, c;
    __device__ void init(int M, int N, int G_, int c_) { nM = M / BM; nN = N / BM; G = G_; c = c_; }
    __device__ __forceinline__ bool next(int i, Unit& u) const {
        const int L = i * G + c; if (L >= nM * nN) return false;
        static_map(L, nM, nN, u.pm, u.pn); u.e = 0; u.nrows = 256; u.rt = 0; return true;
    }
    __device__ __forceinline__ unsigned rowoff(const Unit& u, int r, int C, int K) const { return (unsigned)((u.pm * BM + r) * K + C) * 2u; }
};
struct TallOrder {
    int nM, nN, G, c;
    __device__ void init(int ngemm, int nN_, int G_, int c_) { nM = 64 * ngemm; nN = nN_; G = G_; c = c_; }
    __device__ __forceinline__ bool next(int i, Unit& u) const {
        const int L = i * G + c; if (L >= nM * nN) return false;
        int pn; static_map(L, nM, nN, u.pm, pn); u.pn = (u.pm >> 6) * nN + pn; u.e = 0; u.nrows = 256; u.rt = 0; return true;
    }
    __device__ __forceinline__ unsigned rowoff(const Unit& u, int r, int C, int K) const { return (unsigned)((u.pm * BM + r) * K + C) * 2u; }
};


template <int NCOL, bool GATHER>
struct MoeOrder {
    const unsigned* cnt; const int* list; int G, c;
    __device__ __forceinline__ bool next(int i, Unit& u) const {
        const int L = i * G + c; const int R = L / NCOL, j = L - R * NCOL;
        int pre = 0;
        for (int e = 0; e < 32; ++e) {
            const int ce = (int)__builtin_amdgcn_readfirstlane(__hip_atomic_load(cnt + e, __ATOMIC_RELAXED, __HIP_MEMORY_SCOPE_AGENT));
            const int nt = (ce + 255) >> 8;
            if (R < pre + nt) { u.pm = R; u.rt = R - pre; u.e = e; u.pn = e * NCOL + j; u.nrows = ce - u.rt * 256; return true; }
            pre += nt;
        }
        return false;
    }
    __device__ __forceinline__ unsigned rowoff(const Unit& u, int r, int C, int K) const {
        if (GATHER) { const int idx = (r < u.nrows) ? u.rt * 256 + r : 0; const int pr = list[(size_t)u.e * CAP + idx]; return (unsigned)((pr >> 1) * K + C) * 2u; }
        return (unsigned)((u.pm * BM + r) * K + C) * 2u;
    }
};

__device__ __forceinline__ unsigned cvt_pk_bf16(float lo, float hi) { unsigned r; asm volatile("v_cvt_pk_bf16_f32 %0, %1, %2" : "=v"(r) : "v"(lo), "v"(hi)); return r; }
__device__ __forceinline__ u32x4 pack8(const f32x4& a, const f32x4& b) { u32x4 w; w.x = cvt_pk_bf16(a[0], a[1]); w.y = cvt_pk_bf16(a[2], a[3]); w.z = cvt_pk_bf16(b[0], b[1]); w.w = cvt_pk_bf16(b[2], b[3]); return w; }

template <class Epi, class Sched, bool ALIGN_EPI>
__device__ __forceinline__ void gemm_phase(PG8_LAS unsigned char* lds, const Gemm g, const Sched& S, const Epi& E) {
    const int tid = threadIdx.x, wid = __builtin_amdgcn_readfirstlane(tid >> 6), lane = tid & 63, wr = wid >> 2, wc = wid & 3, fr = lane & 15, fq = lane >> 4;
    const int K = g.K, nt = K / BK;
    int RA[2], CA[2]; unsigned voffB[2];
#pragma unroll
    for (int i = 0; i < 2; ++i) { int R, C; stage_rc(tid * 16 + i * 8192, R, C); const int Rb = Epi::PERM ? ((R & ~31) + perm32(R & 31)) : R;
        RA[i] = R; CA[i] = C; voffB[i] = (unsigned)(Rb * K + C) * 2u; }
    const size_t kstep = (size_t)(BK * 2);
    const size_t hstep = (size_t)HALF * K * 2;
    const size_t tstep = 2 * hstep;
    const unsigned ldsw = (unsigned)wid * 1024u;
    const int aoff = lds_byte(wr * 64 + fr, fq * 8), boff = lds_byte(wc * 32 + fr, fq * 8);
    const char* const Abase = (const char*)g.A;
#define PG8_SA(b, h) (((b) * 2 + (h)) * HTB)
#define PG8_SB(b, h) ((4 + (b) * 2 + (h)) * HTB)
#define PG8_STAGE(bufoff, gbase, voff) do { _Pragma("unroll") for (int _i = 0; _i < 2; ++_i) \
        __builtin_amdgcn_global_load_lds((const unsigned*)((const char*)(gbase) + (voff)[_i]), (PG8_LAS unsigned*)(lds + (bufoff) + ldsw + _i * 8192), 16, 0, 0); } while (0)
#define PG8_STAGEA(bufoff, kbyte, o0, o1) do { \
        __builtin_amdgcn_global_load_lds((const unsigned*)(Abase + (size_t)(kbyte) + (o0)), (PG8_LAS unsigned*)(lds + (bufoff) + ldsw), 16, 0, 0); \
        __builtin_amdgcn_global_load_lds((const unsigned*)(Abase + (size_t)(kbyte) + (o1)), (PG8_LAS unsigned*)(lds + (bufoff) + ldsw + 8192), 16, 0, 0); } while (0)
#define PG8_LDA(dst, b, h) do { _Pragma("unroll") for (int m = 0; m < 4; ++m) _Pragma("unroll") for (int k = 0; k < 2; ++k) dst[m][k] = *(const PG8_LAS bf16x8*)(lds + PG8_SA(b, h) + aoff + m * 2048 + k * 1024); } while (0)
#define PG8_LDB(dst, b, h) do { _Pragma("unroll") for (int n = 0; n < 2; ++n) _Pragma("unroll") for (int k = 0; k < 2; ++k) dst[n][k] = *(const PG8_LAS bf16x8*)(lds + PG8_SB(b, h) + boff + n * 2048 + k * 1024); } while (0)
#define PG8_MMA(ai, bj, At, Bt) do { __builtin_amdgcn_s_setprio(1); _Pragma("unroll") for (int m = 0; m < 4; ++m) _Pragma("unroll") for (int n = 0; n < 2; ++n) _Pragma("unroll") for (int k = 0; k < 2; ++k) \
        acc[ai][bj][m][n] = __builtin_amdgcn_mfma_f32_16x16x32_bf16(Bt[n][k], At[m][k], acc[ai][bj][m][n], 0, 0, 0); __builtin_amdgcn_s_setprio(0); } while (0)
#define PG8_WAIT_V(n) asm volatile("s_waitcnt vmcnt(" #n ")" ::: "memory")
#define PG8_WAIT_L(n) asm volatile("s_waitcnt lgkmcnt(" #n ")" ::: "memory")
#define PG8_BAR __builtin_amdgcn_s_barrier()
#define PG8_SCHED __builtin_amdgcn_sched_barrier(0)
    Unit cur, nxt; int ui = 0;
    if (!S.next(0, cur)) return;
    f32x4 acc[2][2][4][2];
#pragma unroll
    for (int a = 0; a < 2; ++a)
#pragma unroll
        for (int b = 0; b < 2; ++b)
#pragma unroll
            for (int m = 0; m < 4; ++m)
#pragma unroll
                for (int n = 0; n < 2; ++n) acc[a][b][m][n] = (f32x4){0.f, 0.f, 0.f, 0.f};
    bf16x8 At[4][2], B0[2][2], B1[2][2];
    unsigned c00 = S.rowoff(cur, RA[0], CA[0], K), c01 = S.rowoff(cur, RA[1], CA[1], K), c10 = S.rowoff(cur, HALF + RA[0], CA[0], K), c11 = S.rowoff(cur, HALF + RA[1], CA[1], K);
    unsigned n00, n01, n10, n11;
    const char* cB = (const char*)g.Bt + (size_t)cur.pn * tstep;
    PG8_STAGE(PG8_SB(0, 0), cB, voffB); PG8_STAGE(PG8_SB(0, 1), cB + hstep, voffB); PG8_STAGEA(PG8_SA(0, 0), 0, c00, c01); PG8_STAGEA(PG8_SA(0, 1), 0, c10, c11);
    if (wr == 1) PG8_BAR;
    PG8_WAIT_V(2); PG8_BAR;
    PG8_STAGE(PG8_SB(1, 0), cB + kstep, voffB); PG8_STAGEA(PG8_SA(1, 0), kstep, c00, c01); PG8_STAGE(PG8_SB(1, 1), cB + hstep + kstep, voffB);
    PG8_WAIT_V(6); PG8_BAR;
    for (;;) {
        const bool has_next = S.next(ui + 1, nxt);
        const char* nB = has_next ? (const char*)g.Bt + (size_t)nxt.pn * tstep : cB;
        if (has_next) { n00 = S.rowoff(nxt, RA[0], CA[0], K); n01 = S.rowoff(nxt, RA[1], CA[1], K); n10 = S.rowoff(nxt, HALF + RA[0], CA[0], K); n11 = S.rowoff(nxt, HALF + RA[1], CA[1], K); }
        else { n00 = c00; n01 = c01; n10 = c10; n11 = c11; }
        for (int t = 0; t < nt; t += 2) {
            const bool last = (t == nt - 2);
            const size_t k1 = (size_t)(t + 1) * kstep;
            const size_t k2 = last ? 0 : (size_t)(t + 2) * kstep;
            const size_t k3 = k2 + kstep;
            const unsigned a00 = last ? n00 : c00, a01 = last ? n01 : c01, a10 = last ? n10 : c10, a11 = last ? n11 : c11;
            const char* b2 = last ? nB : cB + (size_t)(t + 2) * kstep;
            const char* b3 = b2 + kstep;
            PG8_LDB(B0, 0, 0); PG8_LDB(B1, 0, 1); PG8_SCHED; PG8_LDA(At, 0, 0); PG8_STAGEA(PG8_SA(1, 1), k1, c10, c11);
            PG8_WAIT_V(8); PG8_WAIT_L(0); PG8_BAR; PG8_MMA(0, 0, At, B0); PG8_MMA(0, 1, At, B1); PG8_BAR; PG8_SCHED;
            PG8_LDA(At, 0, 1); PG8_STAGE(PG8_SB(0, 0), b2, voffB); PG8_STAGE(PG8_SB(0, 1), b2 + hstep, voffB); PG8_STAGEA(PG8_SA(0, 0), k2, a00, a01);
            PG8_WAIT_V(8); PG8_WAIT_L(0); PG8_BAR; PG8_MMA(1, 0, At, B0); PG8_MMA(1, 1, At, B1); PG8_BAR; PG8_SCHED;
            PG8_LDB(B0, 1, 0); PG8_LDB(B1, 1, 1); PG8_SCHED; PG8_LDA(At, 1, 0); PG8_STAGEA(PG8_SA(0, 1), k2, a10, a11);
            PG8_WAIT_V(8); PG8_WAIT_L(0); PG8_BAR; PG8_MMA(0, 0, At, B0); PG8_MMA(0, 1, At, B1); PG8_BAR; PG8_SCHED;
            PG8_LDA(At, 1, 1); PG8_STAGE(PG8_SB(1, 0), b3, voffB); PG8_STAGE(PG8_SB(1, 1), b3 + hstep, voffB); PG8_STAGEA(PG8_SA(1, 0), k3, a00, a01);
            PG8_WAIT_V(8); PG8_WAIT_L(0); PG8_BAR; PG8_MMA(1, 0, At, B0); PG8_MMA(1, 1, At, B1); PG8_BAR; PG8_SCHED;
        }
        if constexpr (ALIGN_EPI) { if (wr == 0) PG8_BAR; }
        E(acc, cur, wr, wc, fr, fq);
        if (!has_next) break;
#pragma unroll
        for (int a = 0; a < 2; ++a)
#pragma unroll
            for (int b = 0; b < 2; ++b)
#pragma unroll
                for (int m = 0; m < 4; ++m)
#pragma unroll
                    for (int n = 0; n < 2; ++n) acc[a][b][m][n] = (f32x4){0.f, 0.f, 0.f, 0.f};
        cur = nxt; cB = nB; c00 = n00; c01 = n01; c10 = n10; c11 = n11; ++ui;
        if constexpr (ALIGN_EPI) { if (wr == 1) PG8_BAR; }
    }
    PG8_WAIT_V(0);
    if constexpr (!ALIGN_EPI) { if (wr == 0) PG8_BAR; }
    PG8_BAR;
#undef PG8_SA
#undef PG8_SB
#undef PG8_STAGE
#undef PG8_STAGEA
#undef PG8_LDA
#undef PG8_LDB
#undef PG8_MMA
#undef PG8_WAIT_V
#undef PG8_WAIT_L
#undef PG8_BAR
#undef PG8_SCHED
}
}

#define XB_TMO      128
#define XB_XCNT(j)  (256  + 64 * (j))
#define XB_XSUB(j)  (1280 + 64 * (j))
#define XB_XGEN(j)  (2304 + 64 * (j))
#define XB_TOP      3328
#define XB_TOPGEN   3392
#define XCD_BAR_WORDS 3456
#define XB_SPIN_CAP (1u << 18)

__device__ __forceinline__ unsigned xb_ld(unsigned* p)              { return __hip_atomic_load(p, __ATOMIC_RELAXED, __HIP_MEMORY_SCOPE_AGENT); }
__device__ __forceinline__ unsigned xb_add(unsigned* p, unsigned v) { return __hip_atomic_fetch_add(p, v, __ATOMIC_RELAXED, __HIP_MEMORY_SCOPE_AGENT); }
__device__ __forceinline__ unsigned xb_xcc_id() { return (unsigned)__builtin_amdgcn_s_getreg((3 << 11) | 20) & 0xFu; }
#define XB_SPIN(cond, bar) do { unsigned _sp = 0; while (cond) { __builtin_amdgcn_s_sleep(1); \
    if ((++_sp & 255u) == 0u) { if (xb_ld(&(bar)[XB_TMO])) break; if (_sp > XB_SPIN_CAP) { atomicAdd(&(bar)[XB_TMO], 1u); break; } } } } while (0)

struct XcdBarrier {
    unsigned* bar; unsigned x;
    volatile LAS unsigned* st;
};

__device__ __forceinline__ XcdBarrier xcd_barrier_post(unsigned* bar, volatile LAS unsigned* st) {
    XcdBarrier b; b.bar = bar; b.x = xb_xcc_id(); b.st = st;
    if (threadIdx.x == 0) (void)xb_add(&bar[XB_XCNT(b.x)], 1u);
    return b;
}
__device__ __forceinline__ void xcd_barrier_complete(unsigned* bar, unsigned x, unsigned& nloc, unsigned& nx) {
    const unsigned G = gridDim.x * gridDim.y * gridDim.z;
    unsigned sum, cnt, mine, sp = 0u;
    for (;;) {
        sum = 0u; cnt = 0u; mine = 0u;
#pragma unroll
        for (unsigned j = 0; j < 16; ++j) { const unsigned c = xb_ld(&bar[XB_XCNT(j)]); sum += c; cnt += (c > 0u) ? 1u : 0u; mine = (j == x) ? c : mine; }
        if (sum == G) break;
        __builtin_amdgcn_s_sleep(1);
        if ((++sp & 255u) == 0u) { if (xb_ld(&bar[XB_TMO])) break; if (sp > XB_SPIN_CAP) { atomicAdd(&bar[XB_TMO], 1u); break; } }
    }
    nloc = mine > 0u ? mine : 1u; nx = cnt > 0u ? cnt : 1u;
}

__device__ __forceinline__ void xcd_barrier(const XcdBarrier& b) {
    asm volatile("s_waitcnt vmcnt(0)" ::: "memory");
    __syncthreads();
    if (threadIdx.x == 0) {
        unsigned* bar = b.bar;
        __builtin_amdgcn_s_waitcnt(0);
        unsigned nloc = b.st[0], nx = b.st[1];
        if (nloc == 0u) { xcd_barrier_complete(bar, b.x, nloc, nx); b.st[0] = nloc; b.st[1] = nx; }
        const unsigned old = xb_add(&bar[XB_XSUB(b.x)], 1u);
        const unsigned gen = old / nloc;
        if (old + 1u == (gen + 1u) * nloc) {
            __builtin_amdgcn_fence(__ATOMIC_RELEASE, "agent");
            asm volatile("s_waitcnt vmcnt(0)" ::: "memory");
            const unsigned og = xb_add(&bar[XB_TOP], 1u);
            const unsigned tg = og / nx;
            if (og + 1u == (tg + 1u) * nx) xb_add(&bar[XB_TOPGEN], 1u);
            else XB_SPIN(xb_ld(&bar[XB_TOPGEN]) == tg, bar);
            __builtin_amdgcn_fence(__ATOMIC_ACQUIRE, "agent");
            xb_add(&bar[XB_XGEN(b.x)], 1u);
            asm volatile("s_waitcnt vmcnt(0)" ::: "memory");
        } else {
            XB_SPIN(xb_ld(&bar[XB_XGEN(b.x)]) == gen, bar);
            __builtin_amdgcn_fence(__ATOMIC_ACQUIRE, "agent");
            asm volatile("s_waitcnt vmcnt(0)" ::: "memory");
        }
    }
    __syncthreads();
}
struct P {
  const float* x; const float* mix_norm; const float* w_in; const float* gate_bias;
  const float* dq_norm; const float* dk_norm; const float* dlam; const float* dsubln;
  const float* nq_norm; const float* nk_norm; const float* cmp_pe; const float* cmp_w1; const float* cmp_w2;
  const float* w_out;
  const float* rmix; const float* w_r; const float* w_k; const float* w_v;
  const float* w0; const float* w1; const float* w2; const float* a0; const float* a1; const float* a2;
  const float* g1; const float* g2; const float* k_k; const float* k_a; const float* r_k;
  const float* ln_w; const float* ln_b; const float* w_o;
  const float* ffn_norm; const float* rg_w; const float* rg_b; const float* re_w; const float* re_b;
  const float* e_gate; const float* e_up; const float* e_down;
  float* out;
  unsigned char* ws;
  int ph_lo, ph_hi, layer, pad;
};

constexpr int RING_OFF = 0, RING_BYTES = 131072;
constexpr int LDSCTL_OFF = RING_BYTES, MISC_OFF = LDSCTL_OFF + 320;
constexpr int LDS_BYTES = 147456;
constexpr int NWAVES = 8;

struct Frame {
  LAS unsigned char* lds;
  volatile LAS unsigned* MISC;
  gu32* ctl;
  int tid, lane, wave, vcu, G;
};

__device__ __forceinline__ void transpose_item(const float* W, int ldsrc, int k0, int c0, int ncols, bf16_t* dst, int ldk, int drow0, LAS float* scr, int lane) {
#pragma unroll 8
  for (int i = 0; i < 32; ++i) { const int kk = 2 * i + (lane >> 5); const int j = lane & 31; scr[kk * 33 + j] = (j < ncols) ? W[(size_t)(k0 + kk) * ldsrc + c0 + j] : 0.f; }
  LDS_WAIT(); asm volatile("" ::: "memory");
  const int c = lane & 7;
#pragma unroll
  for (int j = 0; j < 4; ++j) { const int n = (lane >> 3) + 8 * j; const LAS float* s = scr + (8 * c) * 33 + n;
    v4u o; o.x = pk2(s[0 * 33], s[1 * 33]); o.y = pk2(s[2 * 33], s[3 * 33]); o.z = pk2(s[4 * 33], s[5 * 33]); o.w = pk2(s[6 * 33], s[7 * 33]);
    *(GAS v4u*)(dst + (size_t)(drow0 + n) * ldk + k0 + 8 * c) = o; }
  LDS_WAIT(); asm volatile("" ::: "memory");
}
__device__ __forceinline__ void rms_row_to_bf16(const float* xrow, const float* gain, bf16_t* orow, int lane) {
  const GAS f32x4* xr = (const GAS f32x4*)xrow + lane;
  const GAS f32x4* gr = (const GAS f32x4*)gain + lane;
  f32x4 v[4]; float s = 0.f;
#pragma unroll
  for (int j = 0; j < 4; ++j) { v[j] = xr[64 * j]; s += (v[j].x * v[j].x + v[j].y * v[j].y) + (v[j].z * v[j].z + v[j].w * v[j].w); }
  const float r = rsqrtf(wave_sum(s) * (1.f / DM) + 1e-6f);
  GAS unsigned long long* o8 = (GAS unsigned long long*)orow + lane;
#pragma unroll
  for (int j = 0; j < 4; ++j) { const f32x4 g = gr[64 * j];
    o8[64 * j] = (unsigned long long)pk2(v[j].x * r * g.x, v[j].y * r * g.y) | ((unsigned long long)pk2(v[j].z * r * g.z, v[j].w * r * g.w) << 32); }
}

__device__ __forceinline__ void conv_win_item(const P& p, int it, LAS float* scr, int lane) {
  const int vg = it >> 4, kb = it & 15;
  const int pn = vg >> 3, bj = (vg >> 2) & 1, wc = vg & 3, s = pn * 4 + wc;
  int c0 = 0, nc = 0;
  if (s < 44) { c0 = 64 * s + 32 * bj; nc = 32; } else if (s == 44 && bj == 0) { c0 = OFF_NG; nc = 24; }
  transpose_item(p.w_in, INC, kb * 64, c0, nc, (bf16_t*)(p.ws + WS_WIN), DM, vg * 32, scr, lane);
}
__device__ __forceinline__ void conv_sq_item(const float* W, bf16_t* dst, int drow_base, int it, LAS float* scr, int lane) {
  const int cg = it >> 4, kb = it & 15;
  transpose_item(W, DM, kb * 64, cg * 32, 32, dst, DM, drow_base + cg * 32, scr, lane);
}
__device__ __forceinline__ void conv_expert_item(const P& p, int layer, int it, LAS float* scr, int lane) {
  const int e = it / 384, r = it % 384;
  if (r < 256) {
    const int up = r >> 7, q = r & 127, cgp = q >> 4, kb = q & 15;
    const int pn = cgp >> 2, qq = cgp & 3;
    const float* W = (up ? p.e_up : p.e_gate) + ((size_t)layer * 32 + e) * DM * 256;
    transpose_item(W, 256, kb * 64, cgp * 32, 32, (bf16_t*)(p.ws + WS_EGU), DM, e * 512 + pn * 256 + up * 128 + qq * 32, scr, lane);
  } else {
    const int q = r - 256, cg = q >> 2, kb = q & 3;
    const float* W = p.e_down + ((size_t)layer * 32 + e) * 256 * DM;
    transpose_item(W, DM, kb * 64, cg * 32, 32, (bf16_t*)(p.ws + WS_EDN), 256, e * 1024 + cg * 32, scr, lane);
  }
}

using pg8::Unit; using pg8::u32x4; using pg8::pack8;
struct EpiInProj {
  static constexpr bool PERM = true;
  bf16_t* H; float* GATES; const float* dq; const float* dk; const float* nq; const float* nk; const float* gbias;
  __device__ __forceinline__ void operator()(const f32x4 (&acc)[2][2][4][2], const Unit& u, int wr, int wc, int fr, int fq) const {
    const int s = u.pn * 4 + wc;
    if (s > 44) return;
    const int row0 = u.pm * 256 + wr * 64 + fr;
    if (s == 44) {
      if (fq < 3) {
        f32x4 b0 = *(const f32x4*)(gbias + 8 * fq), b1 = *(const f32x4*)(gbias + 8 * fq + 4);
#pragma unroll
        for (int ai = 0; ai < 2; ++ai)
#pragma unroll
          for (int m = 0; m < 4; ++m) { float* gp = GATES + (size_t)(row0 + ai * 128 + m * 16) * 24 + 8 * fq;
            f32x4 v0 = acc[ai][0][m][0] + b0, v1 = acc[ai][0][m][1] + b1;
#pragma unroll
            for (int i = 0; i < 4; ++i) { v0[i] = sigmoidf_(v0[i]); v1[i] = sigmoidf_(v1[i]); }
            *(f32x4*)gp = v0; *(f32x4*)(gp + 4) = v1; }
      }
      return;
    }
    int mode = 0; const float* gain = nullptr;
    if (s < 8) { mode = 1; gain = dq; } else if (s < 16) { mode = 1; gain = dk; }
    else if (s >= 24 && s < 32) { mode = 2; gain = nq; }
    else if (s >= 32) { const int q = s - 32, br = q >> 2, kv = (q >> 1) & 1; if (kv == 0 && br >= 1) { mode = 2; gain = nk + br * 64; } }
    f32x4 g[2][2];
#pragma unroll
    for (int bj = 0; bj < 2; ++bj)
#pragma unroll
      for (int n = 0; n < 2; ++n) {
        if (mode == 1) g[bj][n] = *(const f32x4*)(gain + 8 * fq + 4 * n);
        else if (mode == 2) g[bj][n] = *(const f32x4*)(gain + 32 * bj + 8 * fq + 4 * n);
        else g[bj][n] = (f32x4){1.f, 1.f, 1.f, 1.f};
      }
#pragma unroll
    for (int ai = 0; ai < 2; ++ai)
#pragma unroll
      for (int m = 0; m < 4; ++m) {
        float sc[2] = {1.f, 1.f};
        if (mode != 0) {
          float ss[2];
#pragma unroll
          for (int bj = 0; bj < 2; ++bj) { const f32x4 a = acc[ai][bj][m][0], b = acc[ai][bj][m][1];
            float t = (a[0] * a[0] + a[1] * a[1]) + (a[2] * a[2] + a[3] * a[3]) + (b[0] * b[0] + b[1] * b[1]) + (b[2] * b[2] + b[3] * b[3]);
            t += __shfl_xor(t, 16, 64); t += __shfl_xor(t, 32, 64); ss[bj] = t; }
          if (mode == 1) { sc[0] = rsqrtf(ss[0] * (1.f / 32.f) + 1e-6f); sc[1] = rsqrtf(ss[1] * (1.f / 32.f) + 1e-6f); }
          else { const float r = rsqrtf((ss[0] + ss[1]) * (1.f / 64.f) + 1e-6f); sc[0] = r; sc[1] = r; }
        }
        bf16_t* rowp = H + (size_t)(row0 + ai * 128 + m * 16) * HC + 64 * s + 8 * fq;
#pragma unroll
        for (int bj = 0; bj < 2; ++bj) { const f32x4 v0 = acc[ai][bj][m][0] * sc[bj] * g[bj][0], v1 = acc[ai][bj][m][1] * sc[bj] * g[bj][1];
          *(u32x4*)(rowp + 32 * bj) = pack8(v0, v1); }
      }
  }
};
struct EpiResid {
  static constexpr bool PERM = false;
  const float* base; float* out; const bf16_t* y1;
  __device__ __forceinline__ void operator()(const f32x4 (&acc)[2][2][4][2], const Unit& u, int wr, int wc, int fr, int fq) const {
    const int row0 = u.pm * 256 + wr * 64 + fr, col0 = u.pn * 256 + wc * 32 + 4 * fq;
#pragma unroll
    for (int ai = 0; ai < 2; ++ai)
#pragma unroll
      for (int m = 0; m < 4; ++m) { const size_t off = (size_t)(row0 + ai * 128 + m * 16) * DM + col0;
#pragma unroll
        for (int bj = 0; bj < 2; ++bj)
#pragma unroll
          for (int n = 0; n < 2; ++n) { f32x4 b = *(const f32x4*)(base + off + bj * 128 + n * 16);
            if (y1) { const v2u y = *(const v2u*)(y1 + off + bj * 128 + n * 16);
              b.x += __uint_as_float(y.x << 16); b.y += __uint_as_float(y.x & 0xffff0000u); b.z += __uint_as_float(y.y << 16); b.w += __uint_as_float(y.y & 0xffff0000u); }
            *(f32x4*)(out + off + bj * 128 + n * 16) = b + acc[ai][bj][m][n]; asm volatile("" ::: "memory"); } }
  }
};
struct EpiRKV {
  static constexpr bool PERM = true;
  unsigned char* ws;
  __device__ __forceinline__ void operator()(const f32x4 (&acc)[2][2][4][2], const Unit& u, int wr, int wc, int fr, int fq) const {
    const int gi = u.pm >> 6;
    bf16_t* O = (bf16_t*)(ws + WS_S0 + (size_t)(3 + gi) * SLOT);
    const int row0 = (u.pm & 63) * 256 + wr * 64 + fr, col0 = (u.pn & 3) * 256 + wc * 32 + 8 * fq;
#pragma unroll
    for (int ai = 0; ai < 2; ++ai)
#pragma unroll
      for (int m = 0; m < 4; ++m) { bf16_t* rowp = O + (size_t)(row0 + ai * 128 + m * 16) * DM + col0;
#pragma unroll
        for (int bj = 0; bj < 2; ++bj) *(u32x4*)(rowp + bj * 128) = pack8(acc[ai][bj][m][0], acc[ai][bj][m][1]); }
  }
};
struct EpiLora1 {
  static constexpr bool PERM = true;
  bf16_t* TMP;
  template <int BJ>
  __device__ __forceinline__ void half(const f32x4 (&acc)[2][2][4][2], int gi, int row0, int wc, int fq) const {
    const int c = BJ * 128 + wc * 32 + 8 * fq;
    const bool skip = (gi < 2) && (c >= 64);
    const int dcol = (gi < 2) ? gi * 64 + c : 128 + c;
    const bool zero = (gi == 2) && (c >= 160);
    if (skip) return;
#pragma unroll
    for (int ai = 0; ai < 2; ++ai)
#pragma unroll
      for (int m = 0; m < 4; ++m) {
        f32x4 v0 = acc[ai][BJ][m][0], v1 = acc[ai][BJ][m][1];
#pragma unroll
        for (int i = 0; i < 4; ++i) {
          if (gi == 0) { v0[i] = tanhf(v0[i]); v1[i] = tanhf(v1[i]); }
          else if (gi == 2) { v0[i] = zero ? 0.f : sigmoidf_(v0[i]); v1[i] = zero ? 0.f : sigmoidf_(v1[i]); }
        }
        *(u32x4*)(TMP + (size_t)(row0 + ai * 128 + m * 16) * 384 + dcol) = pack8(v0, v1);
      }
  }
  __device__ __forceinline__ void operator()(const f32x4 (&acc)[2][2][4][2], const Unit& u, int wr, int wc, int fr, int fq) const {
    const int gi = u.pm >> 6;
    const int row0 = (u.pm & 63) * 256 + wr * 64 + fr;
    half<0>(acc, gi, row0, wc, fq);
    half<1>(acc, gi, row0, wc, fq);
  }
};
struct EpiLora2 {
  static constexpr bool PERM = true;
  unsigned char* ws; const float* w0; const float* a0;
  __device__ __forceinline__ void operator()(const f32x4 (&acc)[2][2][4][2], const Unit& u, int wr, int wc, int fr, int fq) const {
    const int gi = u.pn >> 2;
    bf16_t* O = (bf16_t*)(ws + WS_S0 + (size_t)gi * SLOT);
    const int row0 = u.pm * 256 + wr * 64 + fr, col0 = (u.pn & 3) * 256 + wc * 32 + 8 * fq;
    f32x4 b[2][2];
#pragma unroll
    for (int bj = 0; bj < 2; ++bj)
#pragma unroll
      for (int n = 0; n < 2; ++n) b[bj][n] = (gi == 0) ? *(const f32x4*)(w0 + col0 + bj * 128 + 4 * n) : (gi == 1 ? *(const f32x4*)(a0 + col0 + bj * 128 + 4 * n) : (f32x4){0.f, 0.f, 0.f, 0.f});
#pragma unroll
    for (int ai = 0; ai < 2; ++ai)
#pragma unroll
      for (int m = 0; m < 4; ++m) { bf16_t* rowp = O + (size_t)(row0 + ai * 128 + m * 16) * DM + col0;
#pragma unroll
        for (int bj = 0; bj < 2; ++bj) { f32x4 v0 = acc[ai][bj][m][0] + b[bj][0], v1 = acc[ai][bj][m][1] + b[bj][1];
          if (gi == 0) {
#pragma unroll
            for (int i = 0; i < 4; ++i) { v0[i] = -__expf(-softplusf_(-v0[i]) - 0.5f); v1[i] = -__expf(-softplusf_(-v1[i]) - 0.5f); }
          } else if (gi == 1) {
#pragma unroll
            for (int i = 0; i < 4; ++i) { v0[i] = sigmoidf_(v0[i]); v1[i] = sigmoidf_(v1[i]); }
          }
          *(u32x4*)(rowp + bj * 128) = pack8(v0, v1); } }
  }
};

struct EpiMoeGU {
  static constexpr bool PERM = true;
  bf16_t* HID;
  __device__ __forceinline__ void operator()(const f32x4 (&acc)[2][2][4][2], const Unit& u, int wr, int wc, int fr, int fq) const {
    const int row0 = u.pm * 256 + wr * 64 + fr, col0 = (u.pn & 1) * 128 + wc * 32 + 8 * fq;
#pragma unroll
    for (int ai = 0; ai < 2; ++ai)
#pragma unroll
      for (int m = 0; m < 4; ++m) {
        f32x4 h[2];
#pragma unroll
        for (int n = 0; n < 2; ++n) { const f32x4 g = acc[ai][0][m][n], up = acc[ai][1][m][n];
#pragma unroll
          for (int i = 0; i < 4; ++i) h[n][i] = g[i] * sigmoidf_(g[i]) * up[i]; }
        *(u32x4*)(HID + (size_t)(row0 + ai * 128 + m * 16) * 256 + col0) = pack8(h[0], h[1]);
      }
  }
};
struct EpiMoeDown {
  static constexpr bool PERM = false;
  float* out; bf16_t* Y1; const int* list; const float* pgate;
  __device__ __forceinline__ void operator()(const f32x4 (&acc)[2][2][4][2], const Unit& u, int wr, int wc, int fr, int fq) const {
    const int col0 = (u.pn & 3) * 256 + wc * 32 + 4 * fq;
#pragma unroll
    for (int ai = 0; ai < 2; ++ai)
#pragma unroll
      for (int m = 0; m < 4; ++m) {
        const int r = ai * 128 + wr * 64 + m * 16 + fr;
        if (r < u.nrows) {
          const int pr = list[(size_t)u.e * CAP + u.rt * 256 + r];
          const float gt = pgate[pr];
          const int tok = pr >> 1;
          if ((pr & 1) == 0) {
            float* op = out + (size_t)tok * DM + col0;
#pragma unroll
            for (int bj = 0; bj < 2; ++bj)
#pragma unroll
              for (int n = 0; n < 2; ++n) { f32x4 b = *(const f32x4*)(op + bj * 128 + n * 16); *(f32x4*)(op + bj * 128 + n * 16) = b + acc[ai][bj][m][n] * gt; }
          } else {
            bf16_t* yp = Y1 + (size_t)tok * DM + col0;
#pragma unroll
            for (int bj = 0; bj < 2; ++bj)
#pragma unroll
              for (int n = 0; n < 2; ++n) { const f32x4 v = acc[ai][bj][m][n] * gt; v2u w; w.x = pg8::cvt_pk_bf16(v[0], v[1]); w.y = pg8::cvt_pk_bf16(v[2], v[3]); *(v2u*)(yp + bj * 128 + n * 16) = w; }
          }
        }
      }
  }
};

__device__ __forceinline__ void phase_prologue(const P& p, Frame& F) {
  LAS float* scr = (LAS float*)(F.lds + RING_OFF + F.wave * 16384);
  const int gw = F.vcu * NWAVES + F.wave, NGW = F.G * NWAVES;
  constexpr int I_WIN = 96 * 16, I_SQ = 32 * 16;
  constexpr int NITEMS = I_WIN + 5 * I_SQ + 128;
  for (int it = gw; it < NITEMS; it += NGW) {
    int r = it;
    if (r < I_WIN) { conv_win_item(p, r, scr, F.lane); continue; } r -= I_WIN;
    if (r < I_SQ) { conv_sq_item(p.w_out, (bf16_t*)(p.ws + WS_WOUT), 0, r, scr, F.lane); continue; } r -= I_SQ;
    if (r < I_SQ) { conv_sq_item(p.w_r, (bf16_t*)(p.ws + WS_WRKV), 0, r, scr, F.lane); continue; } r -= I_SQ;
    if (r < I_SQ) { conv_sq_item(p.w_k, (bf16_t*)(p.ws + WS_WRKV), 1024, r, scr, F.lane); continue; } r -= I_SQ;
    if (r < I_SQ) { conv_sq_item(p.w_v, (bf16_t*)(p.ws + WS_WRKV), 2048, r, scr, F.lane); continue; } r -= I_SQ;
    if (r < I_SQ) { conv_sq_item(p.w_o, (bf16_t*)(p.ws + WS_WO), 0, r, scr, F.lane); continue; } r -= I_SQ;
    { const int kv = r >> 6, q = r & 63, kb = q >> 1, cg = q & 1;
      transpose_item(p.cmp_w1 + (size_t)kv * 2048 * 64, 64, kb * 64, cg * 32, 32, (bf16_t*)(p.ws + WS_CW1) + (size_t)kv * 64 * 2048, 2048, cg * 32, scr, F.lane); }
  }
  {
    const int gt = (F.vcu * NWAVES + F.wave) * 64 + F.lane, NGT = NGW * 64;
    bf16_t* WL1 = (bf16_t*)(p.ws + WS_WL1);
    for (int i = gt; i < 768 * 1024; i += NGT) {
      const int n = i >> 10, k = i & 1023, gi = n >> 8, c = n & 255;
      float v = 0.f;
      if (gi == 0) { if (c < 64) v = p.w1[k * 64 + c]; }
      else if (gi == 1) { if (c < 64) v = p.a1[k * 64 + c]; }
      else { if (c < 160) v = p.g1[k * 160 + c]; }
      WL1[i] = (bf16_t)f2bf(v);
    }
    bf16_t* WL2 = (bf16_t*)(p.ws + WS_WL2);
    for (int i = gt; i < 3072 * 384; i += NGT) {
      const int n = i / 384, k = i - n * 384, gi = n >> 10, c = n & 1023;
      float v = 0.f;
      if (gi == 0) { if (k < 64) v = p.w2[k * 1024 + c]; }
      else if (gi == 1) { if (k >= 64 && k < 128) v = p.a2[(k - 64) * 1024 + c]; }
      else { if (k >= 128 && k < 288) v = p.g2[(k - 128) * 1024 + c]; }
      WL2[i] = (bf16_t)f2bf(v);
    }
  }
  bf16_t* XN = (bf16_t*)(p.ws + WS_XN);
  for (int m = gw; m < T_TOK; m += NGW) rms_row_to_bf16(p.x + (size_t)m * DM, p.mix_norm, XN + (size_t)m * DM, F.lane);
}


__device__ __forceinline__ void phase_router(const P& p, Frame& F, int layer) {
  const int gw = F.vcu * NWAVES + F.wave, NGW = F.G * NWAVES;
  const int lane = F.lane;
  {
    LAS float* scr = (LAS float*)(F.lds + RING_OFF + F.wave * 16384);
    for (int it = gw; it < 32 * 384; it += NGW) conv_expert_item(p, layer, it, scr, lane);
  }
  __syncthreads();
  LAS float* WL = (LAS float*)(F.lds);
  LAS float* LG = (LAS float*)(F.lds + 81920) + F.wave * 8 * 36;
  LAS float* RSB = (LAS float*)(F.lds + 81920 + 9216) + F.wave * 8;
  const float* gain = p.ffn_norm + layer * DM;
  const float* wg = p.rg_w + (size_t)layer * DM * 4;
  const float* we = p.re_w + (size_t)layer * DM * 32;
  bf16_t* XN2 = (bf16_t*)(p.ws + WS_XN2);
  f32x4 g[4];
#pragma unroll
  for (int j = 0; j < 4; ++j) g[j] = ((const GAS f32x4*)gain)[lane + 64 * j];
#pragma unroll 1
  for (int tt = 0; tt < 8; ++tt) {
    const int t = gw * 8 + tt;
    const GAS f32x4* xr = (const GAS f32x4*)(p.out + (size_t)t * DM) + lane;
    f32x4 v[4]; float s = 0.f;
#pragma unroll
    for (int j = 0; j < 4; ++j) { v[j] = xr[64 * j]; s += (v[j].x * v[j].x + v[j].y * v[j].y) + (v[j].z * v[j].z + v[j].w * v[j].w); }
    const float r = rsqrtf(wave_sum(s) * (1.f / DM) + 1e-6f);
    if (lane == 0) RSB[tt] = r;
    GAS v2u* o = (GAS v2u*)(XN2 + (size_t)t * DM) + lane;
#pragma unroll
    for (int j = 0; j < 4; ++j) { const f32x4 q = v[j] * r * g[j]; v2u w; w.x = pk2(q.x, q.y); w.y = pk2(q.z, q.w); o[64 * j] = w; }
    if (lane < 36) LG[tt * 36 + lane] = 0.f;
  }
#pragma unroll 1
  for (int half = 0; half < 2; ++half) {
    __syncthreads();
    for (int idx = F.tid; idx < 512 * 9; idx += NWAVES * 64) {
      const int row = idx / 9, c4 = idx - row * 9;
      const int q = row & 63, ij = row >> 6, jj = ij & 1, i = ij >> 1;
      const int k = 4 * q + 256 * (2 * half + jj) + i;
      const f32x4 val = (c4 == 0) ? *(const GAS f32x4*)(wg + k * 4) : *(const GAS f32x4*)(we + k * 32 + (c4 - 1) * 4);
      *(LAS f32x4*)(WL + row * 36 + c4 * 4) = val;
    }
    __syncthreads();
#pragma unroll 1
    for (int tt = 0; tt < 8; ++tt) {
      const int t = gw * 8 + tt;
      const float r = RSB[tt];
      const GAS f32x4* xr = (const GAS f32x4*)(p.out + (size_t)t * DM) + lane;
      f32x4 xv[2];
#pragma unroll
      for (int jj = 0; jj < 2; ++jj) xv[jj] = xr[64 * (2 * half + jj)] * r * g[2 * half + jj];
      f32x4 acc[9];
#pragma unroll
      for (int c = 0; c < 9; ++c) acc[c] = (f32x4){0.f, 0.f, 0.f, 0.f};
#pragma unroll
      for (int i = 0; i < 4; ++i)
#pragma unroll
        for (int jj = 0; jj < 2; ++jj) {
          const float x = xv[jj][i];
          const LAS f32x4* wr = (const LAS f32x4*)(WL + ((i * 2 + jj) * 64 + lane) * 36);
#pragma unroll
          for (int c = 0; c < 9; ++c) acc[c] += wr[c] * x;
          asm volatile("" ::: "memory");
        }
      float mine = 0.f;
#pragma unroll
      for (int c = 0; c < 9; ++c)
#pragma unroll
        for (int e = 0; e < 4; ++e) { const float sum = wave_sum_dpp(acc[c][e]); mine = (lane == c * 4 + e) ? sum : mine; }
      if (lane < 36) LG[tt * 36 + lane] += mine;
    }
  }
  LDS_WAIT();
  if (lane < 8) {
    const int t = gw * 8 + lane;
    const LAS float* lg = LG + lane * 36;
    const float* bg = p.rg_b + layer * 4;
    const float* be = p.re_b + layer * 32;
    float gl[4]; int gi = 0; float gm = -3.4e38f;
#pragma unroll
    for (int i = 0; i < 4; i++) { gl[i] = lg[i] + bg[i]; if (gl[i] > gm) { gm = gl[i]; gi = i; } }
    float gs = 0.f;
#pragma unroll
    for (int i = 0; i < 4; i++) gs += __expf(gl[i] - gm);
    const float grp_p = 1.f / gs;
    float v0 = -3.4e38f, v1 = -3.4e38f; int i0 = 0, i1 = 0;
    for (int i = 0; i < 8; i++) {
      const float v = lg[4 + gi * 8 + i] + be[gi * 8 + i];
      if (v > v0) { v1 = v0; i1 = i0; v0 = v; i0 = i; }
      else if (v > v1) { v1 = v; i1 = i; }
    }
    const float e1 = __expf(v1 - v0);
    const float ga = grp_p / (1.f + e1), gb = grp_p * e1 / (1.f + e1);
    const int ea = gi * 8 + i0, eb = gi * 8 + i1;
    unsigned* cnt = (unsigned*)(p.ws + WS_CTL) + CW_CNT + layer * 32;
    int* list = (int*)(p.ws + WS_LIST); float* pgate = (float*)(p.ws + WS_PGATE);
    const unsigned sa = __hip_atomic_fetch_add(cnt + ea, 1u, __ATOMIC_RELAXED, __HIP_MEMORY_SCOPE_AGENT);
    list[(size_t)ea * CAP + sa] = 2 * t; pgate[2 * t] = ga;
    const unsigned sb = __hip_atomic_fetch_add(cnt + eb, 1u, __ATOMIC_RELAXED, __HIP_MEMORY_SCOPE_AGENT);
    list[(size_t)eb * CAP + sb] = 2 * t + 1; pgate[2 * t + 1] = gb;
  }
}

__device__ __forceinline__ void phase_final(const P& p, Frame& F) {
  const int gw = F.vcu * NWAVES + F.wave, NGW = F.G * NWAVES;
  const bf16_t* Y1 = (const bf16_t*)(p.ws + WS_Y1);
  for (int t = gw; t < T_TOK; t += NGW) {
    GAS f32x4* xr = (GAS f32x4*)(p.out + (size_t)t * DM) + F.lane;
    const GAS v2u* yr = (const GAS v2u*)(Y1 + (size_t)t * DM) + F.lane;
#pragma unroll
    for (int j = 0; j < 4; ++j) { f32x4 v = xr[64 * j]; const v2u y = yr[64 * j];
      v.x += __uint_as_float(y.x << 16); v.y += __uint_as_float(y.x & 0xffff0000u); v.z += __uint_as_float(y.y << 16); v.w += __uint_as_float(y.y & 0xffff0000u);
      xr[64 * j] = v; }
  }
}

__device__ __forceinline__ void phase_rwkv_prep(const P& p, Frame& F) {
  const int gw = F.vcu * NWAVES + F.wave, NGW = F.G * NWAVES;
  const int lane = F.lane;
  const float* gain = p.mix_norm + DM;
  const bf16_t* Y1 = (const bf16_t*)(p.ws + WS_Y1);
  f32x4 g[4];
#pragma unroll
  for (int j = 0; j < 4; ++j) g[j] = ((const GAS f32x4*)gain)[lane + 64 * j];
  for (int run = gw; run < T_TOK / 8; run += NGW) {
    const int t0 = run * 8;
    f32x4 prev[4];
    if ((t0 & (SEQ - 1)) == 0) {
#pragma unroll
      for (int j = 0; j < 4; ++j) prev[j] = (f32x4){0.f, 0.f, 0.f, 0.f};
    } else {
      const GAS f32x4* xr = (const GAS f32x4*)(p.out + (size_t)(t0 - 1) * DM) + lane;
      const GAS v2u* yr = (const GAS v2u*)(Y1 + (size_t)(t0 - 1) * DM) + lane;
      float s = 0.f;
#pragma unroll
      for (int j = 0; j < 4; ++j) { prev[j] = xr[64 * j]; const v2u y = yr[64 * j];
        prev[j].x += __uint_as_float(y.x << 16); prev[j].y += __uint_as_float(y.x & 0xffff0000u); prev[j].z += __uint_as_float(y.y << 16); prev[j].w += __uint_as_float(y.y & 0xffff0000u);
        s += (prev[j].x * prev[j].x + prev[j].y * prev[j].y) + (prev[j].z * prev[j].z + prev[j].w * prev[j].w); }
      const float r = rsqrtf(wave_sum(s) * (1.f / DM) + 1e-6f);
#pragma unroll
      for (int j = 0; j < 4; ++j) prev[j] = prev[j] * r * g[j];
    }
    for (int tt = 0; tt < 8; ++tt) {
      const int t = t0 + tt;
      const GAS f32x4* xr = (const GAS f32x4*)(p.out + (size_t)t * DM) + lane;
      const GAS v2u* yr = (const GAS v2u*)(Y1 + (size_t)t * DM) + lane;
      f32x4 v[4]; float s = 0.f;
#pragma unroll
      for (int j = 0; j < 4; ++j) { v[j] = xr[64 * j]; const v2u y = yr[64 * j];
        v[j].x += __uint_as_float(y.x << 16); v[j].y += __uint_as_float(y.x & 0xffff0000u); v[j].z += __uint_as_float(y.y << 16); v[j].w += __uint_as_float(y.y & 0xffff0000u);
        s += (v[j].x * v[j].x + v[j].y * v[j].y) + (v[j].z * v[j].z + v[j].w * v[j].w); }
      const float r = rsqrtf(wave_sum(s) * (1.f / DM) + 1e-6f);
#pragma unroll
      for (int j = 0; j < 4; ++j) v[j] = v[j] * r * g[j];
#pragma unroll
      for (int sl = 0; sl < 6; ++sl) {
        const int mj = (sl == 0) ? 0 : (sl == 1) ? 2 : (sl == 2) ? 3 : (sl == 3) ? 1 : (sl == 4) ? 4 : 5;
        GAS v2u* o = (GAS v2u*)(p.ws + WS_S0 + (size_t)sl * SLOT + (size_t)t * DM * 2) + lane;
#pragma unroll
        for (int j = 0; j < 4; ++j) {
          const f32x4 mx = ((const GAS f32x4*)(p.rmix + mj * DM))[lane + 64 * j];
          const f32x4 q = v[j] + (prev[j] - v[j]) * mx;
          v2u w; w.x = pk2(q.x, q.y); w.y = pk2(q.z, q.w);
          o[64 * j] = w;
        }
      }
#pragma unroll
      for (int j = 0; j < 4; ++j) prev[j] = v[j];
    }
  }
}


constexpr int RP = 72;
constexpr int RB = 64 * RP * 2;
typedef LAS bf16_t* lbf;

__device__ __forceinline__ f32x4 mm16(f32x4 acc, const LAS bf16_t* A, int arow0, const LAS bf16_t* Bt, int brow0, int lane) {
  const int r = lane & 15, q = lane >> 4;
#pragma unroll
  for (int ks = 0; ks < 2; ++ks) {
    const bf16x8 a = *(const LAS bf16x8*)(A + (arow0 + r) * RP + ks * 32 + q * 8);
    const bf16x8 b = *(const LAS bf16x8*)(Bt + (brow0 + r) * RP + ks * 32 + q * 8);
    acc = __builtin_amdgcn_mfma_f32_16x16x32_bf16(a, b, acc, 0, 0, 0);
  }
  return acc;
}
__device__ __forceinline__ float sum8(float v) {
  v += __shfl_xor(v, 1, 64); v += __shfl_xor(v, 2, 64); v += __shfl_xor(v, 4, 64); return v;
}
__device__ __forceinline__ void ld8bf(const bf16_t* p, float (&o)[8]) {
  const v4u w = *(const GAS v4u*)p;
  o[0] = __uint_as_float(w.x << 16); o[1] = __uint_as_float(w.x & 0xffff0000u); o[2] = __uint_as_float(w.y << 16); o[3] = __uint_as_float(w.y & 0xffff0000u);
  o[4] = __uint_as_float(w.z << 16); o[5] = __uint_as_float(w.z & 0xffff0000u); o[6] = __uint_as_float(w.w << 16); o[7] = __uint_as_float(w.w & 0xffff0000u);
}
__device__ __forceinline__ v4u pk8(const float (&o)[8]) { v4u w; w.x = pk2(o[0], o[1]); w.y = pk2(o[2], o[3]); w.z = pk2(o[4], o[5]); w.w = pk2(o[6], o[7]); return w; }

__device__ __forceinline__ void rwkv_r1_item(const P& p, Frame& F, int item) {
  const int tid = F.tid, lane = F.lane, w = F.wave;
  const int ch = item >> 6, c = item & 63, b = ch >> 4, hd = ch & 15;
  const size_t tile0 = ((size_t)(b * SEQ + c * 64) * DM + hd * 64);
  unsigned char* ws = p.ws;
  bf16_t* SL[6];
#pragma unroll
  for (int s = 0; s < 6; ++s) SL[s] = (bf16_t*)(ws + WS_S0 + (size_t)s * SLOT) + tile0;
  const lbf BtT = (lbf)(F.lds + 0 * RB), KtT = (lbf)(F.lds + 1 * RB), AbT = (lbf)(F.lds + 2 * RB), RbT = (lbf)(F.lds + 3 * RB);
  const lbf Ab = (lbf)(F.lds + 4 * RB), Vc = (lbf)(F.lds + 5 * RB), Bh = (lbf)(F.lds + 6 * RB), Kh = (lbf)(F.lds + 7 * RB);
  const lbf Tk = (lbf)(F.lds + 8 * RB), WbT = (lbf)(F.lds + 9 * RB), WkT = (lbf)(F.lds + 10 * RB);
  const lbf X = BtT, XT = KtT, Pb = AbT;
  const lbf At = X, TNT = XT, U0 = Tk;
  LAS float* Lf = (LAS float*)(F.lds + 11 * RB);
  LAS float* SEG = Lf + 64 * 65;
  LAS float* GC = (LAS float*)(F.lds + 14 * RB);
  const int t = tid >> 3, cg = tid & 7, k0 = cg * 8;
  float r_[8], ld_[8], kx[8], v_[8], a_[8];
  ld8bf(SL[3] + (size_t)t * DM + k0, r_); ld8bf(SL[0] + (size_t)t * DM + k0, ld_); ld8bf(SL[4] + (size_t)t * DM + k0, kx);
  ld8bf(SL[5] + (size_t)t * DM + k0, v_); ld8bf(SL[1] + (size_t)t * DM + k0, a_);
  float kk[8], km[8], be[8];
  {
    float ss = 0.f, bo = 0.f;
#pragma unroll
    for (int i = 0; i < 8; ++i) { const int cc = hd * 64 + k0 + i; kk[i] = kx[i] * p.k_k[cc]; ss += kk[i] * kk[i]; km[i] = kx[i] * (1.f + (a_[i] - 1.f) * p.k_a[cc]); bo += r_[i] * km[i] * p.r_k[cc]; }
    ss = sum8(ss); bo = sum8(bo);
    const float inv = 1.f / fmaxf(sqrtf(ss), 1e-12f);
#pragma unroll
    for (int i = 0; i < 8; ++i) { kk[i] *= inv; be[i] = kk[i] * a_[i]; }
    if (cg == 0) ((float*)(ws + WS_TMP))[(size_t)item * 64 + t] = bo;
  }
#pragma unroll
  for (int i = 0; i < 8; ++i) Lf[t * 65 + k0 + i] = ld_[i];
  __syncthreads();
  {
    const int k = tid & 63, sg = tid >> 6;
    float run = 0.f;
#pragma unroll
    for (int i = 0; i < 8; ++i) { run += Lf[(sg * 8 + i) * 65 + k]; Lf[(sg * 8 + i) * 65 + k] = run; }
    SEG[sg * 64 + k] = run;
    __syncthreads();
    float off = 0.f;
    for (int j = 0; j < sg; ++j) off += SEG[j * 64 + k];
#pragma unroll
    for (int i = 0; i < 8; ++i) Lf[(sg * 8 + i) * 65 + k] += off;
  }
  __syncthreads();
  {
    float ab[8], bt[8], kt[8], rb[8], bh[8], kh[8];
#pragma unroll
    for (int i = 0; i < 8; ++i) {
      const float Lt = Lf[t * 65 + k0 + i], Lp = (t > 0) ? Lf[(t - 1) * 65 + k0 + i] : 0.f, LC = Lf[63 * 65 + k0 + i];
      const float ei = __expf(-Lt), eh = __expf(LC - Lt);
      if (t == 63) GC[k0 + i] = __expf(LC);
      ab[i] = -kk[i] * __expf(Lp); bt[i] = be[i] * ei; kt[i] = km[i] * ei; rb[i] = r_[i] * __expf(Lt); bh[i] = be[i] * eh; kh[i] = km[i] * eh;
    }
    *(LAS v4u*)(BtT + t * RP + k0) = pk8(bt); *(LAS v4u*)(KtT + t * RP + k0) = pk8(kt); *(LAS v4u*)(AbT + t * RP + k0) = pk8(ab); *(LAS v4u*)(RbT + t * RP + k0) = pk8(rb);
#pragma unroll
    for (int i = 0; i < 8; ++i) { Ab[(k0 + i) * RP + t] = (bf16_t)f2bf(ab[i]); Vc[(k0 + i) * RP + t] = (bf16_t)f2bf(v_[i]); Bh[(k0 + i) * RP + t] = (bf16_t)f2bf(bh[i]); Kh[(k0 + i) * RP + t] = (bf16_t)f2bf(kh[i]); }
  }
  __syncthreads();
  const int tr = w >> 1, tc0 = (w & 1) * 2;
  const int cr = lane & 15, q4 = (lane >> 4) * 4;
  f32x4 accP[2], accX[2];
  {
    f32x4 tab[2], tak[2], wbr[2], wkr[2];
#pragma unroll
    for (int j = 0; j < 2; ++j) { const f32x4 z = {0.f, 0.f, 0.f, 0.f};
      tab[j] = mm16(z, BtT, tr * 16, AbT, (tc0 + j) * 16, lane); tak[j] = mm16(z, KtT, tr * 16, AbT, (tc0 + j) * 16, lane);
      wbr[j] = mm16(z, BtT, tr * 16, RbT, (tc0 + j) * 16, lane); wkr[j] = mm16(z, KtT, tr * 16, RbT, (tc0 + j) * 16, lane); }
    __syncthreads();
#pragma unroll
    for (int j = 0; j < 2; ++j)
#pragma unroll
      for (int i = 0; i < 4; ++i) {
        const int s = tr * 16 + q4 + i, tt = (tc0 + j) * 16 + cr;
        const float x = (s < tt) ? tab[j][i] : 0.f;
        accX[j][i] = x; accP[j][i] = x + ((s == tt) ? 1.f : 0.f);
        X[s * RP + tt] = (bf16_t)f2bf(x); XT[tt * RP + s] = (bf16_t)f2bf(x); Pb[s * RP + tt] = (bf16_t)f2bf(accP[j][i]);
        Tk[s * RP + tt] = (bf16_t)f2bf((s < tt) ? tak[j][i] : 0.f);
        WbT[tt * RP + s] = (bf16_t)f2bf((s <= tt) ? wbr[j][i] : 0.f);
        WkT[tt * RP + s] = (bf16_t)f2bf((s <= tt) ? wkr[j][i] : 0.f);
      }
  }
  __syncthreads();
#pragma unroll 1
  for (int st = 0; st < 6; ++st) {
    f32x4 xn[2], pn[2];
#pragma unroll
    for (int j = 0; j < 2; ++j) { const f32x4 z = {0.f, 0.f, 0.f, 0.f};
      xn[j] = mm16(z, X, tr * 16, XT, (tc0 + j) * 16, lane);
      pn[j] = (st > 0) ? mm16(accP[j], Pb, tr * 16, XT, (tc0 + j) * 16, lane) : accP[j]; }
    __syncthreads();
#pragma unroll
    for (int j = 0; j < 2; ++j)
#pragma unroll
      for (int i = 0; i < 4; ++i) {
        const int s = tr * 16 + q4 + i, tt = (tc0 + j) * 16 + cr;
        accP[j][i] = pn[j][i];
        if (st < 5) { X[s * RP + tt] = (bf16_t)f2bf(xn[j][i]); XT[tt * RP + s] = (bf16_t)f2bf(xn[j][i]); Pb[s * RP + tt] = (bf16_t)f2bf(pn[j][i]); }
        else Pb[tt * RP + s] = (bf16_t)f2bf(pn[j][i]);
      }
    __syncthreads();
  }
  const lbf NT = Pb;
  {
    f32x4 at[2], tn[2];
#pragma unroll
    for (int j = 0; j < 2; ++j) { const f32x4 z = {0.f, 0.f, 0.f, 0.f};
      at[j] = mm16(z, Ab, tr * 16, NT, (tc0 + j) * 16, lane); tn[j] = mm16(z, Tk, tr * 16, NT, (tc0 + j) * 16, lane); }
#pragma unroll
    for (int j = 0; j < 2; ++j)
#pragma unroll
      for (int i = 0; i < 4; ++i) { const int rr = tr * 16 + q4 + i, cc = (tc0 + j) * 16 + cr;
        At[rr * RP + cc] = (bf16_t)f2bf(at[j][i]); TNT[cc * RP + rr] = (bf16_t)f2bf(tn[j][i]); }
  }
  __syncthreads();
  const lbf O_RT = (lbf)(F.lds + 11 * RB), O_PM = (lbf)(F.lds + 12 * RB), O_Y0 = (lbf)(F.lds + 13 * RB), O_Q = (lbf)(F.lds + 3 * RB)  ;
  {
    f32x4 u0[2], rt[2], pm[2];
#pragma unroll
    for (int j = 0; j < 2; ++j) { const f32x4 z = {0.f, 0.f, 0.f, 0.f};
      u0[j] = mm16(z, Vc, tr * 16, TNT, (tc0 + j) * 16, lane);
      rt[j] = mm16(z, WbT, tr * 16, At, (tc0 + j) * 16, lane);
      pm[j] = mm16(z, Bh, tr * 16, At, (tc0 + j) * 16, lane); }
    __syncthreads();
#pragma unroll
    for (int j = 0; j < 2; ++j)
#pragma unroll
      for (int i = 0; i < 4; ++i) { const int rr = tr * 16 + q4 + i, cc = (tc0 + j) * 16 + cr;
        U0[rr * RP + cc] = (bf16_t)f2bf(u0[j][i]);
        O_RT[rr * RP + cc] = (bf16_t)f2bf(rt[j][i] + bf2f(RbT[rr * RP + cc]));
        O_PM[rr * RP + cc] = (bf16_t)f2bf(pm[j][i] + ((rr == cc) ? GC[rr] : 0.f)); }
  }
  __syncthreads();
  {
    f32x4 y0[2], qq[2];
#pragma unroll
    for (int j = 0; j < 2; ++j) { const f32x4 z = {0.f, 0.f, 0.f, 0.f};
      y0[j] = mm16(mm16(z, WbT, tr * 16, U0, (tc0 + j) * 16, lane), WkT, tr * 16, Vc, (tc0 + j) * 16, lane);
      qq[j] = mm16(mm16(z, U0, tr * 16, Bh, (tc0 + j) * 16, lane), Vc, tr * 16, Kh, (tc0 + j) * 16, lane); }
#pragma unroll
    for (int j = 0; j < 2; ++j)
#pragma unroll
      for (int i = 0; i < 4; ++i) { const int rr = tr * 16 + q4 + i, cc = (tc0 + j) * 16 + cr;
        O_Y0[rr * RP + cc] = (bf16_t)f2bf(y0[j][i]); O_Q[rr * RP + cc] = (bf16_t)f2bf(qq[j][i]); }
  }
  __syncthreads();
  {
    const int row = tid >> 3, pc = (tid & 7) * 8;
    *(GAS v4u*)(SL[3] + (size_t)row * DM + pc) = *(const LAS v4u*)(O_RT + row * RP + pc);
    *(GAS v4u*)(SL[0] + (size_t)row * DM + pc) = *(const LAS v4u*)(O_PM + row * RP + pc);
    *(GAS v4u*)(SL[4] + (size_t)row * DM + pc) = *(const LAS v4u*)(O_Y0 + row * RP + pc);
    *(GAS v4u*)(SL[1] + (size_t)row * DM + pc) = *(const LAS v4u*)(O_Q + row * RP + pc);
  }
  __syncthreads();
}

__device__ __forceinline__ void phase_rwkv_r1(const P& p, Frame& F) {
  for (int item = F.vcu; item < 4096; item += F.G) rwkv_r1_item(p, F, item);
}

#define R2_BAR() do { asm volatile("s_waitcnt lgkmcnt(0)" ::: "memory"); __builtin_amdgcn_s_barrier(); asm volatile("" ::: "memory"); } while (0)
__device__ __forceinline__ void phase_rwkv_r2(const P& p, Frame& F) {
  const int lane = F.lane, w = F.wave, tid = F.tid;
  const lbf Sh = (lbf)(F.lds), Sl = (lbf)(F.lds + 16 * RP * 2);
  const int cr = lane & 15, q4 = (lane >> 4) * 4, q = lane >> 4;
  for (int task = F.vcu; task < 256; task += F.G) {
    const int ch = task >> 2, jb = task & 3, b = ch >> 4, hd = ch & 15;
    const bf16_t* PM = (const bf16_t*)(p.ws + WS_S0) + ((size_t)(b * SEQ) * DM + hd * 64);
    bf16_t* QS = (bf16_t*)(p.ws + WS_S0 + SLOT) + ((size_t)(b * SEQ) * DM + hd * 64);
    for (int i = tid; i < 16 * RP; i += NWAVES * 64) { Sh[i] = 0; Sl[i] = 0; }
    R2_BAR();
    const int wc = w & 3;
    const bf16_t* pmp = PM + (size_t)(16 * wc + cr) * DM + q * 8;
    const bf16_t* qsp = QS + (size_t)(16 * jb + q4) * DM + 16 * wc + cr;
    bf16x8 nb0[8], nb1[8]; unsigned short nq[8][4];
#pragma unroll
    for (int d = 0; d < 8; ++d) { nb0[d] = *(const GAS bf16x8*)(pmp + (size_t)d * 64 * DM); nb1[d] = *(const GAS bf16x8*)(pmp + (size_t)d * 64 * DM + 32);
#pragma unroll
      for (int i = 0; i < 4; ++i) nq[d][i] = *(const GAS unsigned short*)(qsp + (size_t)(d * 64 + i) * DM); }
#pragma unroll 1
    for (int c8 = 0; c8 < 64; c8 += 8) {
#pragma unroll
      for (int d = 0; d < 8; ++d) {
        const int c = c8 + d;
        f32x4 acc = {0.f, 0.f, 0.f, 0.f};
        const bf16x8 b0 = nb0[d], b1 = nb1[d];
        float qv[4];
#pragma unroll
        for (int i = 0; i < 4; ++i) qv[i] = bf2f(nq[d][i]);
        if (c + 8 < 64) { nb0[d] = *(const GAS bf16x8*)(pmp + (size_t)(c + 8) * 64 * DM); nb1[d] = *(const GAS bf16x8*)(pmp + (size_t)(c + 8) * 64 * DM + 32);
#pragma unroll
          for (int i = 0; i < 4; ++i) nq[d][i] = *(const GAS unsigned short*)(qsp + (size_t)((c + 8) * 64 + i) * DM); }
        const bf16x8 ah0 = *(const LAS bf16x8*)(Sh + cr * RP + q * 8), ah1 = *(const LAS bf16x8*)(Sh + cr * RP + 32 + q * 8);
        const bf16x8 al0 = *(const LAS bf16x8*)(Sl + cr * RP + q * 8), al1 = *(const LAS bf16x8*)(Sl + cr * RP + 32 + q * 8);
        acc = __builtin_amdgcn_mfma_f32_16x16x32_bf16(ah0, b0, acc, 0, 0, 0);
        acc = __builtin_amdgcn_mfma_f32_16x16x32_bf16(ah1, b1, acc, 0, 0, 0);
        acc = __builtin_amdgcn_mfma_f32_16x16x32_bf16(al0, b0, acc, 0, 0, 0);
        acc = __builtin_amdgcn_mfma_f32_16x16x32_bf16(al1, b1, acc, 0, 0, 0);
        R2_BAR();
        if (w < 4) {
#pragma unroll
          for (int i = 0; i < 4; ++i) { const float sv = acc[i] + qv[i]; const unsigned hi = f2bf(sv); const float lo = sv - __uint_as_float(hi << 16);
            Sh[(q4 + i) * RP + 16 * wc + cr] = (bf16_t)hi; Sl[(q4 + i) * RP + 16 * wc + cr] = (bf16_t)f2bf(lo); }
        }
        R2_BAR();
        if (tid >= 256 && tid < 384) {
          const int row = (tid - 256) >> 3, pc = (tid & 7) * 8;
          *(GAS v4u*)(QS + (size_t)(c * 64 + 16 * jb + row) * DM + pc) = *(const LAS v4u*)(Sh + row * RP + pc);
        }
      }
    }
    R2_BAR();
  }
}

__device__ __forceinline__ void phase_rwkv_r3(const P& p, Frame& F) {
  const int lane = F.lane, w = F.wave;
  const int cr = lane & 15, q4 = (lane >> 4) * 4, q = lane >> 4;
  const int half = w >> 2, tb = w & 3;
  LAS bf16_t* stg = (LAS bf16_t*)(F.lds) + w * 16 * RP;
  for (int it2 = F.vcu; it2 < 2048; it2 += F.G) {
    const int item = it2 * 2 + half;
    const int ch = item >> 6, c = item & 63, b = ch >> 4, hd = ch & 15;
    const size_t tile0 = ((size_t)(b * SEQ + c * 64) * DM + hd * 64);
    bf16_t* RT = (bf16_t*)(p.ws + WS_S0 + 3 * SLOT) + tile0;
    const bf16_t* Y0 = (const bf16_t*)(p.ws + WS_S0 + 4 * SLOT) + tile0;
    const bf16_t* VV = (const bf16_t*)(p.ws + WS_S0 + 5 * SLOT) + tile0;
    const bf16_t* GG = (const bf16_t*)(p.ws + WS_S0 + 2 * SLOT) + tile0;
    const bf16_t* SC = (const bf16_t*)(p.ws + WS_S0 + SLOT) + tile0 - (size_t)64 * DM;
    const float* BO = (const float*)(p.ws + WS_TMP) + (size_t)item * 64;
    f32x4 y[4];
#pragma unroll
    for (int j = 0; j < 4; ++j) y[j] = (f32x4){0.f, 0.f, 0.f, 0.f};
    if (c > 0) {
      const bf16_t* ap = RT + (size_t)(16 * tb + cr) * DM + q * 8;
      const bf16x8 a0 = *(const GAS bf16x8*)ap, a1 = *(const GAS bf16x8*)(ap + 32);
#pragma unroll
      for (int j = 0; j < 4; ++j) {
        const bf16_t* bp = SC + (size_t)(16 * j + cr) * DM + q * 8;
        const bf16x8 b0 = *(const GAS bf16x8*)bp, b1 = *(const GAS bf16x8*)(bp + 32);
        y[j] = __builtin_amdgcn_mfma_f32_16x16x32_bf16(a0, b0, y[j], 0, 0, 0);
        y[j] = __builtin_amdgcn_mfma_f32_16x16x32_bf16(a1, b1, y[j], 0, 0, 0);
      }
    }
    float mu[4], rs[4];
#pragma unroll
    for (int i = 0; i < 4; ++i) {
      float s = 0.f;
#pragma unroll
      for (int j = 0; j < 4; ++j) { y[j][i] += bf2f(Y0[(size_t)(16 * tb + q4 + i) * DM + 16 * j + cr]); s += y[j][i]; }
      s += __shfl_xor(s, 1, 64); s += __shfl_xor(s, 2, 64); s += __shfl_xor(s, 4, 64); s += __shfl_xor(s, 8, 64);
      mu[i] = s * (1.f / 64.f);
      float qd = 0.f;
#pragma unroll
      for (int j = 0; j < 4; ++j) { const float d = y[j][i] - mu[i]; qd += d * d; }
      qd += __shfl_xor(qd, 1, 64); qd += __shfl_xor(qd, 2, 64); qd += __shfl_xor(qd, 4, 64); qd += __shfl_xor(qd, 8, 64);
      rs[i] = rsqrtf(qd * (1.f / 64.f) + 64e-5f);
    }
#pragma unroll
    for (int j = 0; j < 4; ++j) {
      const int cc = hd * 64 + 16 * j + cr;
      const float lw = p.ln_w[cc], lb = p.ln_b[cc];
#pragma unroll
      for (int i = 0; i < 4; ++i) {
        const int tt = 16 * tb + q4 + i;
        const float vv = bf2f(VV[(size_t)tt * DM + 16 * j + cr]), gg = bf2f(GG[(size_t)tt * DM + 16 * j + cr]);
        const float z = ((y[j][i] - mu[i]) * rs[i] * lw + lb + BO[tt] * vv) * gg;
        stg[(q4 + i) * RP + 16 * j + cr] = (bf16_t)f2bf(z);
      }
    }
    LDS_WAIT();
#pragma unroll
    for (int i = 0; i < 2; ++i) { const int row = (lane >> 3) + 8 * i, pc = (lane & 7) * 8;
      *(GAS v4u*)(RT + (size_t)(16 * tb + row) * DM + pc) = *(const LAS v4u*)(stg + row * RP + pc); }
    LDS_WAIT();
  }
}


typedef short v4i16_t __attribute__((ext_vector_type(4)));
__device__ __forceinline__ v4i16_t tr16(const LAS bf16_t* p) { return __builtin_amdgcn_ds_read_tr16_b64_v4i16((LAS v4i16_t*)p); }

template <int KS>
__device__ __forceinline__ void qk_tile(f32x4 (&st)[4][2], const LAS bf16_t* Kt, int kc0, const bf16x8 (&qf)[2][KS], int lane) {
  const int r = lane & 15, g = lane >> 4;
#pragma unroll
  for (int kt = 0; kt < 4; ++kt)
#pragma unroll
    for (int ks = 0; ks < KS; ++ks) {
      const bf16x8 a = *(const LAS bf16x8*)(Kt + (kt * 16 + r) * RP + kc0 + ks * 32 + g * 8);
#pragma unroll
      for (int qt = 0; qt < 2; ++qt) st[kt][qt] = __builtin_amdgcn_mfma_f32_16x16x32_bf16(a, qf[qt][ks], st[kt][qt], 0, 0, 0);
    }
}
__device__ __forceinline__ void pv_tile(f32x4 (&o)[4][2], const f32x4 (&pr)[4][2], const LAS bf16_t* Vt, int lane) {
  const int g = lane >> 4, qq = (lane & 15) >> 2, pp = lane & 3;
  bf16x8 pb[2][2];
#pragma unroll
  for (int kb = 0; kb < 2; ++kb)
#pragma unroll
    for (int qt = 0; qt < 2; ++qt) {
      const v4u w = {pk2(pr[2 * kb][qt][0], pr[2 * kb][qt][1]), pk2(pr[2 * kb][qt][2], pr[2 * kb][qt][3]), pk2(pr[2 * kb + 1][qt][0], pr[2 * kb + 1][qt][1]), pk2(pr[2 * kb + 1][qt][2], pr[2 * kb + 1][qt][3])};
      pb[kb][qt] = __builtin_bit_cast(bf16x8, w);
    }
#pragma unroll
  for (int dt = 0; dt < 4; ++dt)
#pragma unroll
    for (int kb = 0; kb < 2; ++kb) {
      const v4i16_t lo = tr16(Vt + (32 * kb + 4 * g + qq) * RP + dt * 16 + 4 * pp);
      const v4i16_t hi = tr16(Vt + (32 * kb + 16 + 4 * g + qq) * RP + dt * 16 + 4 * pp);
      const bf16x8 a = {lo[0], lo[1], lo[2], lo[3], hi[0], hi[1], hi[2], hi[3]};
#pragma unroll
      for (int qt = 0; qt < 2; ++qt) o[dt][qt] = __builtin_amdgcn_mfma_f32_16x16x32_bf16(a, pb[kb][qt], o[dt][qt], 0, 0, 0);
    }
}
#define AT_BAR() do { asm volatile("s_waitcnt lgkmcnt(0)" ::: "memory"); __builtin_amdgcn_s_barrier(); asm volatile("" ::: "memory"); } while (0)
__device__ __forceinline__ void zero42(f32x4 (&a)[4][2]) {
#pragma unroll
  for (int i = 0; i < 4; ++i)
#pragma unroll
    for (int j = 0; j < 2; ++j) a[i][j] = (f32x4){0.f, 0.f, 0.f, 0.f};
}

__device__ __forceinline__ void phase_compress(const P& p, Frame& F) {
  const int lane = F.lane, w = F.wave, tid = F.tid;
  const int r = lane & 15, g4 = lane >> 4;
  const bf16_t* H = (const bf16_t*)(p.ws + WS_H);
  const bf16_t* W1T = (const bf16_t*)(p.ws + WS_CW1);
  LAS float* part = (LAS float*)F.lds;
  LAS float* hid = part + 8 * 16 * 64;
  LAS float* outv = hid + 16 * 64;
  for (int task = F.vcu; task < 256; task += F.G) {
    const int kv = task >> 7, rb = task & 127;
    int row = rb * 16 + r; if (row > 2039) row = 2039;
    const int gg = row & 1, cc = (row >> 1) % NCMP, bb = (row >> 1) / NCMP;
    const int colbase = OFF_NKV + ((0 * 2 + kv) * 2 + gg) * 64;
    f32x4 acc[4];
#pragma unroll
    for (int nt = 0; nt < 4; ++nt) acc[nt] = (f32x4){0.f, 0.f, 0.f, 0.f};
#pragma unroll 1
    for (int ks = 0; ks < 8; ++ks) {
      const int k = w * 256 + ks * 32 + g4 * 8, l = k >> 6, d0 = k & 63;
      float hv[8]; ld8bf(H + (size_t)(bb * SEQ + 16 * cc + l) * HC + colbase + d0, hv);
      const float* pe = p.cmp_pe + (kv * 32 + l) * 64 + d0;
#pragma unroll
      for (int i = 0; i < 8; ++i) hv[i] += pe[i];
      const bf16x8 a = __builtin_bit_cast(bf16x8, pk8(hv));
#pragma unroll
      for (int nt = 0; nt < 4; ++nt) {
        const bf16x8 bfr = *(const GAS bf16x8*)(W1T + ((size_t)kv * 64 + nt * 16 + r) * 2048 + k);
        acc[nt] = __builtin_amdgcn_mfma_f32_16x16x32_bf16(a, bfr, acc[nt], 0, 0, 0);
      }
    }
#pragma unroll
    for (int nt = 0; nt < 4; ++nt)
#pragma unroll
      for (int i = 0; i < 4; ++i) part[(w * 16 + g4 * 4 + i) * 64 + nt * 16 + r] = acc[nt][i];
    __syncthreads();
    for (int e = tid; e < 1024; e += NWAVES * 64) { float s = 0.f;
#pragma unroll
      for (int ww = 0; ww < 8; ++ww) s += part[ww * 1024 + e];
      hid[e] = gelu_tanh(s); }
    __syncthreads();
    const float* w2 = p.cmp_w2 + kv * 4096;
    for (int e = tid; e < 1024; e += NWAVES * 64) { const int rr = e >> 6, n = e & 63; float s = 0.f;
      for (int j = 0; j < 64; ++j) s += hid[rr * 64 + j] * w2[j * 64 + n];
      outv[e] = s; }
    __syncthreads();
    for (int e = tid; e < 1024; e += NWAVES * 64) { const int rr = e >> 6, n = e & 63;
      const int orow = rb * 16 + rr;
      if (orow < 2040) {
        float v = outv[e];
        if (kv == 0) { float ss = 0.f; for (int j = 0; j < 64; ++j) ss += outv[rr * 64 + j] * outv[rr * 64 + j]; v = v * rsqrtf(ss * (1.f / 64.f) + 1e-6f) * p.nk_norm[n]; }
        const int g2 = orow & 1, c2 = (orow >> 1) % NCMP, b2 = (orow >> 1) / NCMP;
        ((bf16_t*)(p.ws + (kv ? WS_VCMPB : WS_KCMPB)))[((size_t)(b2 * 2 + g2) * 256 + c2) * 64 + n] = (bf16_t)f2bf(v);
      }
    }
    if (task < 16 && tid < 64) { const int kk2 = task >> 3, bg = task & 7; ((bf16_t*)(p.ws + (kk2 ? WS_VCMPB : WS_KCMPB)))[((size_t)bg * 256 + 255) * 64 + tid] = 0; }
    __syncthreads();
  }
}

__device__ __forceinline__ v4u tile_ld(const bf16_t* base, size_t pitch, int tid) { return *(const GAS v4u*)(base + (size_t)(tid >> 3) * pitch + (tid & 7) * 8); }
__device__ __forceinline__ void tile_st(LAS bf16_t* dst, v4u v, int tid) { *(LAS v4u*)(dst + (tid >> 3) * RP + (tid & 7) * 8) = v; }

__device__ __forceinline__ void phase_diffattn(const P& p, Frame& F) {
  const int lane = F.lane, w = F.wave, tid = F.tid;
  const int r = lane & 15, g = lane >> 4;
  const bf16_t* H = (const bf16_t*)(p.ws + WS_H);
  bf16_t* CAT = (bf16_t*)(p.ws + WS_CAT);
  float mq = 0.f, mk = 0.f, l0 = 0.f, l1 = 0.f;
  for (int i = 0; i < 32; i++) { mq = fmaxf(mq, fabsf(p.dq_norm[i])); mk = fmaxf(mk, fabsf(p.dk_norm[i])); l0 += p.dlam[i] * p.dlam[32 + i]; l1 += p.dlam[64 + i] * p.dlam[96 + i]; }
  const float c2 = 0.17677669529663687f * 1.4426950408889634f;
  const float nb = -(32.f * mq * mk) * c2;
  const float lam = __expf(l0) - __expf(l1) + 0.2f;
  for (int pr = F.vcu; pr < 256; pr += F.G) {
    const int bh = pr >> 3, sp = pr & 7, b = bh >> 3, hd = bh & 7;
#pragma unroll 1
    for (int ui = 0; ui < 2; ++ui) {
      const int qb = ui ? 15 - sp : sp;
      const int NT = 4 * (qb + 1);
      const bf16_t* Kg = H + (size_t)(b * SEQ) * HC + OFF_DK + hd * 64;
      const bf16_t* Vg = H + (size_t)(b * SEQ) * HC + OFF_DV + hd * 64;
      bf16x8 q1[2][1], q2[2][1];
#pragma unroll
      for (int qt = 0; qt < 2; ++qt) { const bf16_t* qp = H + (size_t)(b * SEQ + qb * 256 + w * 32 + qt * 16 + r) * HC + OFF_DQ + hd * 64 + g * 8;
        q1[qt][0] = *(const GAS bf16x8*)qp; q2[qt][0] = *(const GAS bf16x8*)(qp + 32); }
      f32x4 o1[4][2], o2[4][2]; zero42(o1); zero42(o2);
      float ls1[2] = {0.f, 0.f}, ls2[2] = {0.f, 0.f};
      v4u kr = tile_ld(Kg, HC, tid), vr = tile_ld(Vg, HC, tid);
#pragma unroll 1
      for (int t = 0; t < NT; ++t) {
        const lbf KBt = (lbf)(F.lds + (t & 1) * 2 * RB), VBt = KBt + 64 * RP;
        tile_st(KBt, kr, tid); tile_st(VBt, vr, tid);
        AT_BAR();
        if (t + 1 < NT) { kr = tile_ld(Kg + (size_t)(t + 1) * 64 * HC, HC, tid); vr = tile_ld(Vg + (size_t)(t + 1) * 64 * HC, HC, tid); }
        const bool band = (t >= NT - 4);
        const int kbase = t * 64 - (qb * 256 + w * 32);
        {
          f32x4 st[4][2]; zero42(st);
          qk_tile<1>(st, KBt, 0, q1, lane);
#pragma unroll
          for (int kt = 0; kt < 4; ++kt)
#pragma unroll
            for (int qt = 0; qt < 2; ++qt)
#pragma unroll
              for (int i = 0; i < 4; ++i) { float e = __builtin_amdgcn_exp2f(st[kt][qt][i] * c2 + nb);
                if (band && (kbase + kt * 16 + g * 4 + i > qt * 16 + r)) e = 0.f;
                st[kt][qt][i] = e; ls1[qt] += e; }
          pv_tile(o1, st, VBt, lane);
        }
        {
          f32x4 st[4][2]; zero42(st);
          qk_tile<1>(st, KBt, 32, q2, lane);
#pragma unroll
          for (int kt = 0; kt < 4; ++kt)
#pragma unroll
            for (int qt = 0; qt < 2; ++qt)
#pragma unroll
              for (int i = 0; i < 4; ++i) { float e = __builtin_amdgcn_exp2f(st[kt][qt][i] * c2 + nb);
                if (band && (kbase + kt * 16 + g * 4 + i > qt * 16 + r)) e = 0.f;
                st[kt][qt][i] = e; ls2[qt] += e; }
          pv_tile(o2, st, VBt, lane);
        }
      }
#pragma unroll
      for (int qt = 0; qt < 2; ++qt) {
        float s1 = ls1[qt], s2 = ls2[qt];
        s1 += __shfl_xor(s1, 16, 64); s1 += __shfl_xor(s1, 32, 64); s2 += __shfl_xor(s2, 16, 64); s2 += __shfl_xor(s2, 32, 64);
        const float i1 = 1.f / s1, i2 = lam / s2;
        float ss = 0.f;
#pragma unroll
        for (int dt = 0; dt < 4; ++dt)
#pragma unroll
          for (int i = 0; i < 4; ++i) { const float v = o1[dt][qt][i] * i1 - o2[dt][qt][i] * i2; o1[dt][qt][i] = v; ss += v * v; }
        ss += __shfl_xor(ss, 16, 64); ss += __shfl_xor(ss, 32, 64);
        const float rr = rsqrtf(ss * (1.f / 64.f) + 1e-6f) * 0.8f;
        bf16_t* op = CAT + (size_t)(b * SEQ + qb * 256 + w * 32 + qt * 16 + r) * DM + hd * 64;
#pragma unroll
        for (int dt = 0; dt < 4; ++dt) { const int d0 = dt * 16 + g * 4; const f32x4 sg = *(const f32x4*)(p.dsubln + d0);
          v2u wv; wv.x = pk2(o1[dt][qt][0] * rr * sg[0], o1[dt][qt][1] * rr * sg[1]); wv.y = pk2(o1[dt][qt][2] * rr * sg[2], o1[dt][qt][3] * rr * sg[3]);
          *(GAS v2u*)(op + d0) = wv; }
      }
      AT_BAR();
    }
  }
}

__device__ __forceinline__ void nsa_finish(f32x4 (&comb)[4][2], const f32x4 (&o)[4][2], const float (&ls)[2], const float (&gate)[2], bool normalised) {
#pragma unroll
  for (int qt = 0; qt < 2; ++qt) {
    float s = ls[qt]; s += __shfl_xor(s, 16, 64); s += __shfl_xor(s, 32, 64);
    const float f = normalised ? gate[qt] : gate[qt] / s;
#pragma unroll
    for (int dt = 0; dt < 4; ++dt) comb[dt][qt] += o[dt][qt] * f;
  }
}
__device__ __forceinline__ void phase_nsa(const P& p, Frame& F) {
  const int lane = F.lane, w = F.wave, tid = F.tid;
  const int r = lane & 15, g = lane >> 4;
  const bf16_t* H = (const bf16_t*)(p.ws + WS_H);
  const float* GATES = (const float*)(p.ws + WS_GATES);
  bf16_t* CAT = (bf16_t*)(p.ws + WS_CAT);
  float mq = 0.f, mk0 = 0.f, mk1 = 0.f, mk2 = 0.f;
  for (int i = 0; i < 64; i++) { mq = fmaxf(mq, fabsf(p.nq_norm[i])); mk0 = fmaxf(mk0, fabsf(p.nk_norm[i])); mk1 = fmaxf(mk1, fabsf(p.nk_norm[64 + i])); mk2 = fmaxf(mk2, fabsf(p.nk_norm[128 + i])); }
  const float c2 = 0.125f * 1.4426950408889634f;
  const float nb0 = -(64.f * mq * mk0) * c2, nb1 = -(64.f * mq * mk1) * c2, nb2 = -(64.f * mq * mk2) * c2;
  LAS float* IMP = (LAS float*)(F.lds + 12 * RB);
  LAS unsigned char* SELB = (LAS unsigned char*)(F.lds + 12 * RB + 64 * 65 * 4);
  const int hj = w >> 1, th = w & 1;
  for (int pr = F.vcu; pr < 256; pr += F.G) {
    const int bg = pr >> 5, sp = pr & 31, b = bg >> 1, gq = bg & 1;
#pragma unroll 1
    for (int ui = 0; ui < 2; ++ui) {
      const int blk = ui ? 63 - sp : sp;
      const int hh = gq * 4 + hj;
      const int tokw = b * SEQ + blk * 64 + th * 32;
      bf16x8 qf[2][2];
      float gate0[2], gate1[2], gate2[2];
#pragma unroll
      for (int qt = 0; qt < 2; ++qt) { const bf16_t* qp = H + (size_t)(tokw + qt * 16 + r) * HC + OFF_NQ + hh * 64 + g * 8;
        qf[qt][0] = *(const GAS bf16x8*)qp; qf[qt][1] = *(const GAS bf16x8*)(qp + 32);
        const float* gp = GATES + (size_t)(tokw + qt * 16 + r) * 24 + hh * 3; gate0[qt] = gp[0]; gate1[qt] = gp[1]; gate2[qt] = gp[2]; }
      f32x4 comb[4][2]; zero42(comb);
      const int nct = (4 * blk + 3 + 63) >> 6;
      {
        const bf16_t* KC = (const bf16_t*)(p.ws + WS_KCMPB) + (size_t)(b * 2 + gq) * 256 * 64;
        const bf16_t* VC = (const bf16_t*)(p.ws + WS_VCMPB) + (size_t)(b * 2 + gq) * 256 * 64;
        for (int t4 = 0; t4 < nct; ++t4) { tile_st((lbf)(F.lds + t4 * RB), tile_ld(KC + t4 * 4096, 64, tid), tid); tile_st((lbf)(F.lds + (4 + t4) * RB), tile_ld(VC + t4 * 4096, 64, tid), tid); }
        for (int e = tid; e < 64 * 65; e += NWAVES * 64) IMP[e] = 0.f;
        AT_BAR();
        int cmax[2];
#pragma unroll
        for (int qt = 0; qt < 2; ++qt) { const int pos = blk * 64 + th * 32 + qt * 16 + r; cmax[qt] = (pos >= 31) ? ((pos - 31) >> 4) : -1; }
        float lsum[2] = {0.f, 0.f};
        for (int t4 = 0; t4 < nct; ++t4) {
          f32x4 st[4][2]; zero42(st);
          qk_tile<2>(st, (lbf)(F.lds + t4 * RB), 0, qf, lane);
#pragma unroll
          for (int kt = 0; kt < 4; ++kt)
#pragma unroll
            for (int qt = 0; qt < 2; ++qt)
#pragma unroll
              for (int i = 0; i < 4; ++i) { const int c = t4 * 64 + kt * 16 + g * 4 + i; if (c <= cmax[qt]) lsum[qt] += __builtin_amdgcn_exp2f(st[kt][qt][i] * c2 + nb0); }
        }
        float linv[2];
#pragma unroll
        for (int qt = 0; qt < 2; ++qt) { float s = lsum[qt]; s += __shfl_xor(s, 16, 64); s += __shfl_xor(s, 32, 64); linv[qt] = (cmax[qt] >= 0) ? 1.f / s : 0.f; }
        f32x4 o[4][2]; zero42(o);
        for (int t4 = 0; t4 < nct; ++t4) {
          f32x4 st[4][2]; zero42(st);
          qk_tile<2>(st, (lbf)(F.lds + t4 * RB), 0, qf, lane);
#pragma unroll
          for (int kt = 0; kt < 4; ++kt)
#pragma unroll
            for (int qt = 0; qt < 2; ++qt) {
              float gs = 0.f;
#pragma unroll
              for (int i = 0; i < 4; ++i) { const int c = t4 * 64 + kt * 16 + g * 4 + i;
                const float e = (c <= cmax[qt]) ? __builtin_amdgcn_exp2f(st[kt][qt][i] * c2 + nb0) * linv[qt] : 0.f;
                st[kt][qt][i] = e; gs += e; }
              const int ti = th * 32 + qt * 16 + r, j = t4 * 16 + kt * 4 + g;
              if (gs != 0.f) { __hip_atomic_fetch_add(IMP + ti * 65 + j, gs, __ATOMIC_RELAXED, __HIP_MEMORY_SCOPE_WORKGROUP); if (j < 63 && st[kt][qt][3] != 0.f) __hip_atomic_fetch_add(IMP + ti * 65 + j + 1, st[kt][qt][3], __ATOMIC_RELAXED, __HIP_MEMORY_SCOPE_WORKGROUP); }
            }
          pv_tile(o, st, (lbf)(F.lds + (4 + t4) * RB), lane);
        }
        const float one[2] = {1.f, 1.f};
        nsa_finish(comb, o, one, gate0, true);
      }
      AT_BAR();
      {
        const int ti = tid >> 3, jb = (tid & 7) * 8;
        float mine[8]; int rank[8];
#pragma unroll
        for (int u = 0; u < 8; ++u) { const int j = jb + u; float v = IMP[ti * 65 + j]; if (j == blk || j == 0) v = 1e4f; else if (j > blk) v = -1e30f; mine[u] = v; rank[u] = 0; }
        for (int i = 0; i < 64; ++i) { float v = IMP[ti * 65 + i]; if (i == blk || i == 0) v = 1e4f; else if (i > blk) v = -1e30f;
#pragma unroll
          for (int u = 0; u < 8; ++u) rank[u] += (v > mine[u] || (v == mine[u] && i < jb + u)) ? 1 : 0; }
        unsigned bits = 0;
#pragma unroll
        for (int u = 0; u < 8; ++u) bits |= (rank[u] < 16 ? 1u : 0u) << u;
        SELB[ti * 8 + (tid & 7)] = (unsigned char)bits;
      }
      AT_BAR();
      unsigned long long selm[2];
#pragma unroll
      for (int qt = 0; qt < 2; ++qt) { const int ti = th * 32 + qt * 16 + r; const LAS unsigned* sp2 = (const LAS unsigned*)(SELB + ti * 8); selm[qt] = (unsigned long long)sp2[0] | ((unsigned long long)sp2[1] << 32); }
#pragma unroll 1
      for (int br = 1; br < 3; ++br) {
        const int kcol = OFF_NKV + ((br * 2 + 0) * 2 + gq) * 64, vcol = OFF_NKV + ((br * 2 + 1) * 2 + gq) * 64;
        const float nbb = (br == 1) ? nb1 : nb2;
        const int t_lo = (br == 1) ? 0 : (blk > 8 ? blk - 8 : 0);
        const bf16_t* Kg = H + (size_t)(b * SEQ) * HC + kcol;
        const bf16_t* Vg = H + (size_t)(b * SEQ) * HC + vcol;
        f32x4 o[4][2]; zero42(o);
        float ls[2] = {0.f, 0.f};
        v4u kr = tile_ld(Kg + (size_t)t_lo * 64 * HC, HC, tid), vr = tile_ld(Vg + (size_t)t_lo * 64 * HC, HC, tid);
#pragma unroll 1
        for (int t = t_lo; t <= blk; ++t) {
          const lbf KBt = (lbf)(F.lds + (8 + ((t - t_lo) & 1) * 2) * RB), VBt = KBt + 64 * RP;
          tile_st(KBt, kr, tid); tile_st(VBt, vr, tid);
          AT_BAR();
          if (t < blk) { kr = tile_ld(Kg + (size_t)(t + 1) * 64 * HC, HC, tid); vr = tile_ld(Vg + (size_t)(t + 1) * 64 * HC, HC, tid); }
          bool need = true;
          if (br == 1) need = __any((int)(((selm[0] | selm[1]) >> t) & 1ull));
          if (need) {
            f32x4 st[4][2]; zero42(st);
            qk_tile<2>(st, KBt, 0, qf, lane);
#pragma unroll
            for (int kt = 0; kt < 4; ++kt)
#pragma unroll
              for (int qt = 0; qt < 2; ++qt) {
                const bool on = (br == 1) ? (((selm[qt] >> t) & 1ull) != 0ull) : true;
#pragma unroll
                for (int i = 0; i < 4; ++i) { const int kk = kt * 16 + g * 4 + i, qq = th * 32 + qt * 16 + r;
                  float e = __builtin_amdgcn_exp2f(st[kt][qt][i] * c2 + nbb);
                  if (!on) e = 0.f;
                  if (t == blk && kk > qq) e = 0.f;
                  if (br == 2 && t == blk - 8 && kk <= qq) e = 0.f;
                  st[kt][qt][i] = e; ls[qt] += e; }
              }
            pv_tile(o, st, VBt, lane);
          }
        }
        nsa_finish(comb, o, ls, (br == 1) ? gate1 : gate2, false);
        AT_BAR();
      }
#pragma unroll
      for (int qt = 0; qt < 2; ++qt) { bf16_t* op = CAT + (size_t)(tokw + qt * 16 + r) * DM + 512 + hh * 64;
#pragma unroll
        for (int dt = 0; dt < 4; ++dt) { const int d0 = dt * 16 + g * 4; v2u wv; wv.x = pk2(comb[dt][qt][0], comb[dt][qt][1]); wv.y = pk2(comb[dt][qt][2], comb[dt][qt][3]); *(GAS v2u*)(op + d0) = wv; } }
    }
  }
}

__global__ void __launch_bounds__(NWAVES * 64, 2) mk_fwd(P p) {
  extern __shared__ __attribute__((aligned(16))) unsigned char lds[];
  Frame F;
  F.lds = (LAS unsigned char*)lds;
  F.MISC = (volatile LAS unsigned*)(F.lds + MISC_OFF);
  F.tid = threadIdx.x; F.lane = F.tid & 63; F.wave = __builtin_amdgcn_readfirstlane(F.tid >> 6);
  F.G = gridDim.x; { const int bx = blockIdx.x; F.vcu = (F.G % 8 == 0) ? (bx % 8) * (F.G / 8) + bx / 8 : bx; }
  F.ctl = (gu32*)(p.ws + WS_CTL);
  for (int u = F.tid; u < (LDS_BYTES - LDSCTL_OFF) / 4; u += NWAVES * 64) ((LAS unsigned*)(F.lds + LDSCTL_OFF))[u] = 0u;
  __syncthreads();
  XcdBarrier bar = xcd_barrier_post((unsigned*)(F.ctl + CW_BAR) + p.pad * XCD_BAR_WORDS, F.MISC + 8);
  const int lo = p.ph_lo, hi = p.ph_hi;
#ifndef PHMASK
#define PHMASK 0xffffffffu
#endif
#define IN(k) (lo <= (k) && (k) < hi && ((PHMASK >> (k)) & 1u))
#define SEAM(k) do { if (IN(k) && IN((k) + 1)) xcd_barrier(bar); } while (0)
  unsigned char* ws = p.ws;

  if (IN(0)) { phase_prologue(p, F); } SEAM(0);
  if (IN(1)) {
    pg8::Gemm g{(const bf16_t*)(ws + WS_XN), (const bf16_t*)(ws + WS_WIN), DM};
    pg8::StaticOrder S; S.init(T_TOK, 3072, F.G, (int)blockIdx.x);
    EpiInProj E{(bf16_t*)(ws + WS_H), (float*)(ws + WS_GATES), p.dq_norm, p.dk_norm, p.nq_norm, p.nk_norm, p.gate_bias};
    pg8::gemm_phase<EpiInProj, pg8::StaticOrder, true>(F.lds + RING_OFF, g, S, E);
  } SEAM(1);
  if (IN(2)) { phase_compress(p, F); phase_diffattn(p, F); } SEAM(2);
  if (IN(3)) { phase_nsa(p, F); } SEAM(3);
  if (IN(4)) {
    pg8::Gemm g{(const bf16_t*)(ws + WS_CAT), (const bf16_t*)(ws + WS_WOUT), DM};
    pg8::StaticOrder S; S.init(T_TOK, DM, F.G, (int)blockIdx.x);
    EpiResid E{p.x, p.out, nullptr};
    pg8::gemm_phase<EpiResid, pg8::StaticOrder, false>(F.lds + RING_OFF, g, S, E);
  } SEAM(4);
#define MOE_PHASES(layer, pb) do { \
    if (IN(pb)) { phase_router(p, F, layer); } SEAM(pb); \
    if (IN(pb + 1)) { \
      pg8::Gemm g{(const bf16_t*)(ws + WS_XN2), (const bf16_t*)(ws + WS_EGU), DM}; \
      pg8::MoeOrder<2, true> S{(const unsigned*)(ws + WS_CTL) + CW_CNT + layer * 32, (const int*)(ws + WS_LIST), F.G, (int)blockIdx.x}; \
      EpiMoeGU E{(bf16_t*)(ws + WS_HID)}; \
      pg8::gemm_phase<EpiMoeGU, pg8::MoeOrder<2, true>, true>(F.lds + RING_OFF, g, S, E); \
    } SEAM(pb + 1); \
    if (IN(pb + 2)) { \
      int k256 = 256; asm volatile("" : "+s"(k256)); \
      pg8::Gemm g{(const bf16_t*)(ws + WS_HID), (const bf16_t*)(ws + WS_EDN), k256}; \
      pg8::MoeOrder<4, false> S{(const unsigned*)(ws + WS_CTL) + CW_CNT + layer * 32, (const int*)(ws + WS_LIST), F.G, (int)blockIdx.x}; \
      EpiMoeDown E{p.out, (bf16_t*)(ws + WS_Y1), (const int*)(ws + WS_LIST), (const float*)(ws + WS_PGATE)}; \
      pg8::gemm_phase<EpiMoeDown, pg8::MoeOrder<4, false>, true>(F.lds + RING_OFF, g, S, E); \
    } SEAM(pb + 2); \
  } while (0)
  MOE_PHASES(0, 5);
  if (IN(8)) { phase_rwkv_prep(p, F); } SEAM(8);
  if (IN(9)) {
    pg8::Gemm g{(const bf16_t*)(ws + WS_S0 + 3 * SLOT), (const bf16_t*)(ws + WS_WL1), DM};
    pg8::TallOrder S; S.init(3, 1, F.G, (int)blockIdx.x);
    EpiLora1 E{(bf16_t*)(ws + WS_TMP)};
    pg8::gemm_phase<EpiLora1, pg8::TallOrder, false>(F.lds + RING_OFF, g, S, E);
  } SEAM(9);
  if (IN(10)) {
    pg8::Gemm g{(const bf16_t*)(ws + WS_S0), (const bf16_t*)(ws + WS_WRKV), DM};
    pg8::TallOrder S; S.init(3, 4, F.G, (int)blockIdx.x);
    EpiRKV E{ws};
    pg8::gemm_phase<EpiRKV, pg8::TallOrder, true>(F.lds + RING_OFF, g, S, E);
  } SEAM(10);
  if (IN(11)) {
    int k384 = 384; asm volatile("" : "+s"(k384));
    pg8::Gemm g{(const bf16_t*)(ws + WS_TMP), (const bf16_t*)(ws + WS_WL2), k384};
    pg8::StaticOrder S; S.init(T_TOK, 3072, F.G, (int)blockIdx.x);
    EpiLora2 E{ws, p.w0, p.a0};
    pg8::gemm_phase<EpiLora2, pg8::StaticOrder, true>(F.lds + RING_OFF, g, S, E);
  } SEAM(11);
  if (IN(12)) { phase_rwkv_r1(p, F); } SEAM(12);
  if (IN(13)) { phase_rwkv_r2(p, F); } SEAM(13);
  if (IN(14)) { phase_rwkv_r3(p, F); } SEAM(14);
  if (IN(15)) {
    pg8::Gemm g{(const bf16_t*)(ws + WS_S0 + 3 * SLOT), (const bf16_t*)(ws + WS_WO), DM};
    pg8::StaticOrder S; S.init(T_TOK, DM, F.G, (int)blockIdx.x);
    EpiResid E{p.out, p.out, (const bf16_t*)(ws + WS_Y1)};
    pg8::gemm_phase<EpiResid, pg8::StaticOrder, false>(F.lds + RING_OFF, g, S, E);
  } SEAM(15);
  MOE_PHASES(1, 16);
#undef MOE_PHASES
  if (IN(19)) { phase_final(p, F); }
#undef IN
#undef SEAM
}

static void launch_mk(P p, int lo, int hi, int li, int grid, hipStream_t st) {
  p.ph_lo = lo; p.ph_hi = hi; p.pad = li;
  hipLaunchKernelGGL(mk_fwd, dim3(grid), dim3(NWAVES * 64), LDS_BYTES, st, p);
}

extern "C" void kernel_launch(void* const* d_in, const int* in_sizes, int n_in, void* d_out, int out_size, void* d_ws,
                              size_t ws_size, hipStream_t stream) {
  static int grid = 0;
  if (grid == 0) {
    if (n_in != 40 || ws_size < WS_END) { fprintf(stderr, "kernel_launch: bad n_in %d or ws_size %zu (< %zu)\n", n_in, ws_size, (size_t)WS_END); grid = -1; return; }
    int dev = 0, cus = 0;
    if (hipGetDevice(&dev) != hipSuccess || hipDeviceGetAttribute(&cus, hipDeviceAttributeMultiprocessorCount, dev) != hipSuccess) { grid = -1; return; }
    if (hipFuncSetAttribute((const void*)mk_fwd, hipFuncAttributeMaxDynamicSharedMemorySize, LDS_BYTES) != hipSuccess) { grid = -1; return; }
    grid = cus;
  }
  if (grid < 0) return;
  P p{};
  const float* const* in = (const float* const*)d_in;
  p.x = in[0]; p.mix_norm = in[1]; p.w_in = in[2]; p.gate_bias = in[3]; p.dq_norm = in[4]; p.dk_norm = in[5];
  p.dlam = in[6]; p.dsubln = in[7]; p.nq_norm = in[8]; p.nk_norm = in[9]; p.cmp_pe = in[10]; p.cmp_w1 = in[11];
  p.cmp_w2 = in[12]; p.w_out = in[13]; p.rmix = in[14]; p.w_r = in[15]; p.w_k = in[16]; p.w_v = in[17];
  p.w0 = in[18]; p.w1 = in[19]; p.w2 = in[20]; p.a0 = in[21]; p.a1 = in[22]; p.a2 = in[23]; p.g1 = in[24]; p.g2 = in[25];
  p.k_k = in[26]; p.k_a = in[27]; p.r_k = in[28]; p.ln_w = in[29]; p.ln_b = in[30]; p.w_o = in[31];
  p.ffn_norm = in[32]; p.rg_w = in[33]; p.rg_b = in[34]; p.re_w = in[35]; p.re_b = in[36];
  p.e_gate = in[37]; p.e_up = in[38]; p.e_down = in[39];
  p.out = (float*)d_out;
  p.ws = (unsigned char*)d_ws;
  unsigned char* ws = p.ws;
  (void)hipMemsetAsync(ws + WS_CTL, 0, CTL_ZERO_BYTES, stream);
  launch_mk(p, 0, 20, 0, grid, stream);
}
```

```cpp
#include <hip/hip_runtime.h>
#include <cstdio>
#include <cstdint>

#define T_TOK 16384
#define DM 1024
#define SEQ 4096
#define NBATCH 4
#define INC 2840
#define HC 2816
#define OFF_DQ 0
#define OFF_DK 512
#define OFF_DV 1024
#define OFF_NQ 1536
#define OFF_NKV 2048
#define OFF_NG 2816
#define NCMP 255
#define CAP 16384

#define GAS __attribute__((address_space(1)))
#define LAS __attribute__((address_space(3)))
typedef unsigned short bf16_t;
typedef unsigned v4u __attribute__((ext_vector_type(4)));
typedef unsigned v2u __attribute__((ext_vector_type(2)));
typedef float f32x4 __attribute__((ext_vector_type(4)));
typedef short bf16x8 __attribute__((ext_vector_type(8)));
typedef GAS unsigned gu32;
#define RLX_AGENT __ATOMIC_RELAXED, __HIP_MEMORY_SCOPE_AGENT
#define LDS_WAIT() asm volatile("s_waitcnt lgkmcnt(0)" ::: "memory")
#define VM_WAIT() asm volatile("s_waitcnt vmcnt(0)" ::: "memory")

__device__ __forceinline__ float bf2f(bf16_t v) { return __uint_as_float(((unsigned)v) << 16); }
__device__ __forceinline__ unsigned f2bf(float f) { unsigned u = __builtin_bit_cast(unsigned, f); return (u + 0x7fffu + ((u >> 16) & 1u)) >> 16; }
typedef float f32x2_t __attribute__((ext_vector_type(2))); typedef __bf16 bf16x2_t __attribute__((ext_vector_type(2)));
__device__ __forceinline__ unsigned pk2(float lo, float hi) { const f32x2_t v = {lo, hi}; return __builtin_bit_cast(unsigned, __builtin_convertvector(v, bf16x2_t)); }
__device__ __forceinline__ float wave_sum(float v) {
#pragma unroll
  for (int o = 32; o >= 1; o >>= 1) v += __shfl_xor(v, o, 64);
  return v;
}
__device__ __forceinline__ float wave_sum_dpp(float v) {
  v += __builtin_bit_cast(float, __builtin_amdgcn_update_dpp(0, __builtin_bit_cast(int, v), 0xB1, 0xf, 0xf, false));
  v += __builtin_bit_cast(float, __builtin_amdgcn_update_dpp(0, __builtin_bit_cast(int, v), 0x4E, 0xf, 0xf, false));
  v += __builtin_bit_cast(float, __builtin_amdgcn_update_dpp(0, __builtin_bit_cast(int, v), 0x141, 0xf, 0xf, false));
  v += __builtin_bit_cast(float, __builtin_amdgcn_update_dpp(0, __builtin_bit_cast(int, v), 0x140, 0xf, 0xf, false));
  const int iv = __builtin_bit_cast(int, v);
  return (__builtin_bit_cast(float, __builtin_amdgcn_readlane(iv, 0)) + __builtin_bit_cast(float, __builtin_amdgcn_readlane(iv, 16))) +
         (__builtin_bit_cast(float, __builtin_amdgcn_readlane(iv, 32)) + __builtin_bit_cast(float, __builtin_amdgcn_readlane(iv, 48)));
}
__device__ __forceinline__ int fresh_lane() { int l; asm volatile("v_mbcnt_lo_u32_b32 %0, -1, 0\n\tv_mbcnt_hi_u32_b32 %0, -1, %0" : "=v"(l)); return l; }
__device__ __forceinline__ float sigmoidf_(float x) { return 1.f / (1.f + __expf(-x)); }
__device__ __forceinline__ float softplusf_(float x) { return fmaxf(x, 0.f) + __logf(1.f + __expf(-fabsf(x))); }
__device__ __forceinline__ float gelu_tanh(float x) {
  float u = 0.7978845608028654f * (x + 0.044715f * x * x * x);
  return 0.5f * x * (1.f + tanhf(u));
}

constexpr size_t MiB = 1u << 20;
constexpr size_t WS_CTL = 0, CTL_ZERO_BYTES = 1 * MiB;
constexpr size_t WS_WIN = 1 * MiB;
constexpr size_t WS_WOUT = 7 * MiB;
constexpr size_t WS_WRKV = 9 * MiB;
constexpr size_t WS_WO = 15 * MiB;
constexpr size_t WS_WL1 = 17 * MiB;
constexpr size_t WS_WL2 = 19 * MiB;
constexpr size_t WS_EGU = 22 * MiB;
constexpr size_t WS_EDN = 54 * MiB;
constexpr size_t WS_ACT = 70 * MiB;
constexpr size_t WS_XN = WS_ACT;
constexpr size_t WS_H = WS_ACT + 32 * MiB;
constexpr size_t WS_GATES = WS_ACT + 120 * MiB;
constexpr size_t WS_CAT = WS_ACT + 122 * MiB;
constexpr size_t WS_KCMPB = WS_ACT + 154 * MiB;
constexpr size_t WS_VCMPB = WS_ACT + 155 * MiB;
constexpr size_t WS_CW1 = 21 * MiB + 256 * 1024;
constexpr size_t WS_XN2 = WS_ACT;
constexpr size_t WS_HID = WS_ACT + 32 * MiB;
constexpr size_t WS_Y1 = WS_EGU;
constexpr size_t WS_LIST = WS_ACT + 156 * MiB;
constexpr size_t WS_PGATE = WS_ACT + 158 * MiB;
constexpr size_t WS_XN2F = WS_ACT;
constexpr size_t WS_GUF = WS_ACT + 64 * MiB;
constexpr size_t WS_S0 = WS_ACT;
constexpr size_t WS_TMP = WS_ACT + 192 * MiB;
constexpr size_t WS_END = WS_ACT + 204 * MiB;
constexpr size_t SLOT = 32 * MiB;
constexpr int CW_BAR = 4096;
constexpr int CW_CNT = 32768;

namespace pg8 {
#define PG8_LAS __attribute__((address_space(3)))
typedef unsigned u32x4 __attribute__((ext_vector_type(4)));
constexpr int BM = 256, BK = 64, HALF = 128, HTB = HALF * BK * 2  , STAGE_BYTES = 8 * HTB, NXCD = 8, WGM = 8;

__host__ __device__ __forceinline__ int lds_byte(int r, int c) { const int st = (r >> 4) * 2 + (c >> 5), rr = r & 15, cc = c & 31, ob = rr * 64 + cc * 2; return st * 1024 + (ob ^ (((ob >> 9) & 1) << 5)); }
__host__ __device__ __forceinline__ void stage_rc(int b, int& R, int& C) { const int st = b / 1024, sb = b % 1024, swz = sb ^ (((sb >> 9) & 1) << 5); R = (st >> 1) * 16 + swz / 64; C = (st & 1) * 32 + (swz % 64) / 2; }
__host__ __device__ __forceinline__ int perm32(int rho) { const int n = rho >> 4, i = rho & 15; return 8 * (i >> 2) + 4 * n + (i & 3); }

struct Unit { int pm, pn, e, nrows, rt, par; };
struct Gemm { const bf16_t* A; const bf16_t* Bt; int K; };

__device__ __forceinline__ void static_map(int L, int nM, int nN, int& pm, int& pn) {
    const int nwg = nM * nN;
    int wgid = L; { const int q = nwg / NXCD, r = nwg % NXCD, xcd = wgid % NXCD, off = wgid / NXCD; wgid = (xcd < r ? xcd * (q + 1) : r * (q + 1) + (xcd - r) * q) + off; }
    const int nig = WGM * nN, gid = wgid / nig, fm = gid * WGM, gsz = (nM - fm) < WGM ? (nM - fm) : WGM;
    pm = fm + ((wgid % nig) % gsz); pn = (wgid % nig) / gsz;
}
struct StaticOrder {
    int nM, nN, G, c;
    __device__ void init(int M, int N, int G_, int c_) { nM = M / BM; nN = N / BM; G = G_; c = c_; }
    __device__ __forceinline__ bool next(int i, Unit& u) const {
        const int L = i * G + c; if (L >= nM * nN) return false;
        static_map(L, nM, nN, u.pm, u.pn); u.e = 0; u.nrows = 256; u.rt = 0; return true;
    }
    __device__ __forceinline__ unsigned rowoff(const Unit& u, int r, int C, int K) const { return (unsigned)((u.pm * BM + r) * K + C) * 2u; }
};
struct TallOrder {
    int nM, nN, G, c;
    __device__ void init(int ngemm, int nN_, int G_, int c_) { nM = 64 * ngemm; nN = nN_; G = G_; c = c_; }
    __device__ __forceinline__ bool next(int i, Unit& u) const {
        const int L = i * G + c; if (L >= nM * nN) return false;
        int pn; static_map(L, nM, nN, u.pm, pn); u.pn = (u.pm >> 6) * nN + pn; u.e = 0; u.nrows = 256; u.rt = 0; return true;
    }
    __device__ __forceinline__ unsigned rowoff(const Unit& u, int r, int C, int K) const { return (unsigned)((u.pm * BM + r) * K + C) * 2u; }
};


template <int NCOL, bool GATHER>
struct MoeOrder {
    const PG8_LAS int* tab;
    const int* list; int G, c;
    __device__ __forceinline__ bool next(int i, Unit& u) const {
        const int L = i * G + c; const int R = L / NCOL, j = L - R * NCOL;
        if (R >= tab[32]) return false;
        int e = 0;
#pragma unroll
        for (int s = 16; s >= 1; s >>= 1) { if (tab[e + s] <= R) e += s; }
        const int ce = tab[33 + e];
        u.pm = R; u.rt = R - tab[e]; u.e = e; u.pn = e * NCOL + j; u.nrows = ce - u.rt * 256; return true;
    }
    __device__ __forceinline__ unsigned rowoff(const Unit& u, int r, int C, int K) const {
        if (GATHER) { const int idx = (r < u.nrows) ? u.rt * 256 + r : 0; const int pr = list[(size_t)u.e * CAP + idx]; return (unsigned)((pr >> 1) * K + C) * 2u; }
        return (unsigned)((u.pm * BM + r) * K + C) * 2u;
    }
};
__device__ __forceinline__ void moe_order_setup(PG8_LAS int* tab, const unsigned* cnt) {
    if (threadIdx.x < 32) tab[33 + threadIdx.x] = (int)__hip_atomic_load(cnt + threadIdx.x * 64, __ATOMIC_RELAXED, __HIP_MEMORY_SCOPE_AGENT);
    __syncthreads();
    if (threadIdx.x == 0) { int pre = 0; for (int e = 0; e < 32; ++e) { tab[e] = pre; pre += (tab[33 + e] + 255) >> 8; } tab[32] = pre; }
    __syncthreads();
}

__device__ __forceinline__ unsigned cvt_pk_bf16(float lo, float hi) { unsigned r; asm volatile("v_cvt_pk_bf16_f32 %0, %1, %2" : "=v"(r) : "v"(lo), "v"(hi)); return r; }
__device__ __forceinline__ u32x4 pack8(const f32x4& a, const f32x4& b) { u32x4 w; w.x = cvt_pk_bf16(a[0], a[1]); w.y = cvt_pk_bf16(a[2], a[3]); w.z = cvt_pk_bf16(b[0], b[1]); w.w = cvt_pk_bf16(b[2], b[3]); return w; }

template <class Epi, class Sched, bool ALIGN_EPI>
__device__ __forceinline__ void gemm_phase(PG8_LAS unsigned char* lds, const Gemm g, const Sched& S, const Epi& E) {
    const int tid = threadIdx.x, wid = __builtin_amdgcn_readfirstlane(tid >> 6), lane = tid & 63, wr = wid >> 2, wc = wid & 3, fr = lane & 15, fq = lane >> 4;
    const int K = g.K, nt = K / BK;
    int RA[2], CA[2]; unsigned voffB[2];
#pragma unroll
    for (int i = 0; i < 2; ++i) { int R, C; stage_rc(tid * 16 + i * 8192, R, C); const int Rb = Epi::PERM ? ((R & ~31) + perm32(R & 31)) : R;
        RA[i] = R; CA[i] = C; voffB[i] = (unsigned)(Rb * K + C) * 2u; }
    const size_t kstep = (size_t)(BK * 2);
    const size_t hstep = (size_t)HALF * K * 2;
    const size_t tstep = 2 * hstep;
    const unsigned ldsw = (unsigned)wid * 1024u;
    const int aoff = lds_byte(wr * 64 + fr, fq * 8), boff = lds_byte(wc * 32 + fr, fq * 8);
    const char* const Abase = (const char*)g.A;
#define PG8_SA(b, h) (((b) * 2 + (h)) * HTB)
#define PG8_SB(b, h) ((4 + (b) * 2 + (h)) * HTB)
#define PG8_STAGE(bufoff, gbase, voff) do { _Pragma("unroll") for (int _i = 0; _i < 2; ++_i) \
        __builtin_amdgcn_global_load_lds((const unsigned*)((const char*)(gbase) + (voff)[_i]), (PG8_LAS unsigned*)(lds + (bufoff) + ldsw + _i * 8192), 16, 0, 0); } while (0)
#define PG8_STAGEA(bufoff, kbyte, o0, o1) do { \
        __builtin_amdgcn_global_load_lds((const unsigned*)(Abase + (size_t)(kbyte) + (o0)), (PG8_LAS unsigned*)(lds + (bufoff) + ldsw), 16, 0, 0); \
        __builtin_amdgcn_global_load_lds((const unsigned*)(Abase + (size_t)(kbyte) + (o1)), (PG8_LAS unsigned*)(lds + (bufoff) + ldsw + 8192), 16, 0, 0); } while (0)
#define PG8_LDA(dst, b, h) do { _Pragma("unroll") for (int m = 0; m < 4; ++m) _Pragma("unroll") for (int k = 0; k < 2; ++k) dst[m][k] = *(const PG8_LAS bf16x8*)(lds + PG8_SA(b, h) + aoff + m * 2048 + k * 1024); } while (0)
#define PG8_LDB(dst, b, h) do { _Pragma("unroll") for (int n = 0; n < 2; ++n) _Pragma("unroll") for (int k = 0; k < 2; ++k) dst[n][k] = *(const PG8_LAS bf16x8*)(lds + PG8_SB(b, h) + boff + n * 2048 + k * 1024); } while (0)
#define PG8_MMA(ai, bj, At, Bt) do { __builtin_amdgcn_s_setprio(1); _Pragma("unroll") for (int m = 0; m < 4; ++m) _Pragma("unroll") for (int n = 0; n < 2; ++n) _Pragma("unroll") for (int k = 0; k < 2; ++k) \
        acc[ai][bj][m][n] = __builtin_amdgcn_mfma_f32_16x16x32_bf16(Bt[n][k], At[m][k], acc[ai][bj][m][n], 0, 0, 0); __builtin_amdgcn_s_setprio(0); } while (0)
#define PG8_WAIT_V(n) asm volatile("s_waitcnt vmcnt(" #n ")" ::: "memory")
#define PG8_WAIT_L(n) asm volatile("s_waitcnt lgkmcnt(" #n ")" ::: "memory")
#define PG8_BAR __builtin_amdgcn_s_barrier()
#define PG8_SCHED __builtin_amdgcn_sched_barrier(0)
    Unit cur, nxt; int ui = 0;
    if (!S.next(0, cur)) return;
    cur.par = 0;
    if constexpr (Epi::HAS_PRE) E.pre(cur);
    f32x4 acc[2][2][4][2];
#pragma unroll
    for (int a = 0; a < 2; ++a)
#pragma unroll
        for (int b = 0; b < 2; ++b)
#pragma unroll
            for (int m = 0; m < 4; ++m)
#pragma unroll
                for (int n = 0; n < 2; ++n) acc[a][b][m][n] = (f32x4){0.f, 0.f, 0.f, 0.f};
    bf16x8 At[4][2], B0[2][2], B1[2][2];
    unsigned c00 = S.rowoff(cur, RA[0], CA[0], K), c01 = S.rowoff(cur, RA[1], CA[1], K), c10 = S.rowoff(cur, HALF + RA[0], CA[0], K), c11 = S.rowoff(cur, HALF + RA[1], CA[1], K);
    unsigned n00, n01, n10, n11;
    const char* cB = (const char*)g.Bt + (size_t)cur.pn * tstep;
    PG8_STAGE(PG8_SB(0, 0), cB, voffB); PG8_STAGE(PG8_SB(0, 1), cB + hstep, voffB); PG8_STAGEA(PG8_SA(0, 0), 0, c00, c01); PG8_STAGEA(PG8_SA(0, 1), 0, c10, c11);
    if (wr == 1) PG8_BAR;
    PG8_WAIT_V(2); PG8_BAR;
    PG8_STAGE(PG8_SB(1, 0), cB + kstep, voffB); PG8_STAGEA(PG8_SA(1, 0), kstep, c00, c01); PG8_STAGE(PG8_SB(1, 1), cB + hstep + kstep, voffB);
    PG8_WAIT_V(6); PG8_BAR;
    for (;;) {
        const bool has_next = S.next(ui + 1, nxt);
        const char* nB = has_next ? (const char*)g.Bt + (size_t)nxt.pn * tstep : cB;
        if (has_next) { n00 = S.rowoff(nxt, RA[0], CA[0], K); n01 = S.rowoff(nxt, RA[1], CA[1], K); n10 = S.rowoff(nxt, HALF + RA[0], CA[0], K); n11 = S.rowoff(nxt, HALF + RA[1], CA[1], K); }
        else { n00 = c00; n01 = c01; n10 = c10; n11 = c11; }
        for (int t = 0; t < nt; t += 2) {
            const bool last = (t == nt - 2);
            const size_t k1 = (size_t)(t + 1) * kstep;
            const size_t k2 = last ? 0 : (size_t)(t + 2) * kstep;
            const size_t k3 = k2 + kstep;
            const unsigned a00 = last ? n00 : c00, a01 = last ? n01 : c01, a10 = last ? n10 : c10, a11 = last ? n11 : c11;
            const char* b2 = last ? nB : cB + (size_t)(t + 2) * kstep;
            const char* b3 = b2 + kstep;
            PG8_LDB(B0, 0, 0); PG8_LDB(B1, 0, 1); PG8_SCHED; PG8_LDA(At, 0, 0); PG8_STAGEA(PG8_SA(1, 1), k1, c10, c11);
            PG8_WAIT_V(8); PG8_WAIT_L(0); PG8_BAR; PG8_MMA(0, 0, At, B0); PG8_MMA(0, 1, At, B1); PG8_BAR; PG8_SCHED;
            PG8_LDA(At, 0, 1); PG8_STAGE(PG8_SB(0, 0), b2, voffB); PG8_STAGE(PG8_SB(0, 1), b2 + hstep, voffB); PG8_STAGEA(PG8_SA(0, 0), k2, a00, a01);
            PG8_WAIT_V(8); PG8_WAIT_L(0); PG8_BAR; PG8_MMA(1, 0, At, B0); PG8_MMA(1, 1, At, B1); PG8_BAR; PG8_SCHED;
            PG8_LDB(B0, 1, 0); PG8_LDB(B1, 1, 1); PG8_SCHED; PG8_LDA(At, 1, 0); PG8_STAGEA(PG8_SA(0, 1), k2, a10, a11);
            PG8_WAIT_V(8); PG8_WAIT_L(0); PG8_BAR; PG8_MMA(0, 0, At, B0); PG8_MMA(0, 1, At, B1); PG8_BAR; PG8_SCHED;
            PG8_LDA(At, 1, 1); PG8_STAGE(PG8_SB(1, 0), b3, voffB); PG8_STAGE(PG8_SB(1, 1), b3 + hstep, voffB); PG8_STAGEA(PG8_SA(1, 0), k3, a00, a01);
            PG8_WAIT_V(8); PG8_WAIT_L(0); PG8_BAR; PG8_MMA(1, 0, At, B0); PG8_MMA(1, 1, At, B1); PG8_BAR; PG8_SCHED;
        }
        if constexpr (ALIGN_EPI) { if (wr == 0) PG8_BAR; }
        E(acc, cur, wr, wc, fr, fq);
        if (!has_next) break;
#pragma unroll
        for (int a = 0; a < 2; ++a)
#pragma unroll
            for (int b = 0; b < 2; ++b)
#pragma unroll
                for (int m = 0; m < 4; ++m)
#pragma unroll
                    for (int n = 0; n < 2; ++n) acc[a][b][m][n] = (f32x4){0.f, 0.f, 0.f, 0.f};
        cur = nxt; cB = nB; c00 = n00; c01 = n01; c10 = n10; c11 = n11; ++ui; cur.par = ui & 1;
        if constexpr (Epi::HAS_PRE) E.pre(cur);
        if constexpr (ALIGN_EPI) { if (wr == 1) PG8_BAR; }
    }
    PG8_WAIT_V(0);
    if constexpr (!ALIGN_EPI) { if (wr == 0) PG8_BAR; }
    PG8_BAR;
#undef PG8_SA
#undef PG8_SB
#undef PG8_STAGE
#undef PG8_STAGEA
#undef PG8_LDA
#undef PG8_LDB
#undef PG8_MMA
#undef PG8_WAIT_V
#undef PG8_WAIT_L
#undef PG8_BAR
#undef PG8_SCHED
}
}

#define XB_TMO      128
#define XB_XCNT(j)  (256  + 64 * (j))
#define XB_XSUB(j)  (1280 + 64 * (j))
#define XB_XGEN(j)  (2304 + 64 * (j))
#define XB_TOP      3328
#define XB_TOPGEN   3392
#define XCD_BAR_WORDS 3456
#define XB_SPIN_CAP (1u << 18)

__device__ __forceinline__ unsigned xb_ld(unsigned* p)              { return __hip_atomic_load(p, __ATOMIC_RELAXED, __HIP_MEMORY_SCOPE_AGENT); }
__device__ __forceinline__ unsigned xb_add(unsigned* p, unsigned v) { return __hip_atomic_fetch_add(p, v, __ATOMIC_RELAXED, __HIP_MEMORY_SCOPE_AGENT); }
__device__ __forceinline__ unsigned xb_xcc_id() { return (unsigned)__builtin_amdgcn_s_getreg((3 << 11) | 20) & 0xFu; }
#define XB_SPIN(cond, bar) do { unsigned _sp = 0; while (cond) { __builtin_amdgcn_s_sleep(1); \
    if ((++_sp & 255u) == 0u) { if (xb_ld(&(bar)[XB_TMO])) break; if (_sp > XB_SPIN_CAP) { atomicAdd(&(bar)[XB_TMO], 1u); break; } } } } while (0)

struct XcdBarrier {
    unsigned* bar; unsigned x;
    volatile LAS unsigned* st;
};

__device__ __forceinline__ XcdBarrier xcd_barrier_post(unsigned* bar, volatile LAS unsigned* st) {
    XcdBarrier b; b.bar = bar; b.x = xb_xcc_id(); b.st = st;
    if (threadIdx.x == 0) (void)xb_add(&bar[XB_XCNT(b.x)], 1u);
    return b;
}
__device__ __forceinline__ void xcd_barrier_complete(unsigned* bar, unsigned x, unsigned& nloc, unsigned& nx) {
    const unsigned G = gridDim.x * gridDim.y * gridDim.z;
    unsigned sum, cnt, mine, sp = 0u;
    for (;;) {
        sum = 0u; cnt = 0u; mine = 0u;
#pragma unroll
        for (unsigned j = 0; j < 16; ++j) { const unsigned c = xb_ld(&bar[XB_XCNT(j)]); sum += c; cnt += (c > 0u) ? 1u : 0u; mine = (j == x) ? c : mine; }
        if (sum == G) break;
        __builtin_amdgcn_s_sleep(1);
        if ((++sp & 255u) == 0u) { if (xb_ld(&bar[XB_TMO])) break; if (sp > XB_SPIN_CAP) { atomicAdd(&bar[XB_TMO], 1u); break; } }
    }
    nloc = mine > 0u ? mine : 1u; nx = cnt > 0u ? cnt : 1u;
}

__device__ __forceinline__ void xcd_barrier(const XcdBarrier& b) {
    asm volatile("s_waitcnt vmcnt(0)" ::: "memory");
    __syncthreads();
    if (threadIdx.x == 0) {
        unsigned* bar = b.bar;
        __builtin_amdgcn_s_waitcnt(0);
        unsigned nloc = b.st[0], nx = b.st[1];
        if (nloc == 0u) { xcd_barrier_complete(bar, b.x, nloc, nx); b.st[0] = nloc; b.st[1] = nx; }
        const unsigned old = xb_add(&bar[XB_XSUB(b.x)], 1u);
        const unsigned gen = old / nloc;
        if (old + 1u == (gen + 1u) * nloc) {
            __builtin_amdgcn_fence(__ATOMIC_RELEASE, "agent");
            asm volatile("s_waitcnt vmcnt(0)" ::: "memory");
            const unsigned og = xb_add(&bar[XB_TOP], 1u);
            const unsigned tg = og / nx;
            if (og + 1u == (tg + 1u) * nx) xb_add(&bar[XB_TOPGEN], 1u);
            else XB_SPIN(xb_ld(&bar[XB_TOPGEN]) == tg, bar);
            __builtin_amdgcn_fence(__ATOMIC_ACQUIRE, "agent");
            xb_add(&bar[XB_XGEN(b.x)], 1u);
            asm volatile("s_waitcnt vmcnt(0)" ::: "memory");
        } else {
            XB_SPIN(xb_ld(&bar[XB_XGEN(b.x)]) == gen, bar);
            __builtin_amdgcn_fence(__ATOMIC_ACQUIRE, "agent");
            asm volatile("s_waitcnt vmcnt(0)" ::: "memory");
        }
    }
    __syncthreads();
}
struct P {
  const float* x; const float* mix_norm; const float* w_in; const float* gate_bias;
  const float* dq_norm; const float* dk_norm; const float* dlam; const float* dsubln;
  const float* nq_norm; const float* nk_norm; const float* cmp_pe; const float* cmp_w1; const float* cmp_w2;
  const float* w_out;
  const float* rmix; const float* w_r; const float* w_k; const float* w_v;
  const float* w0; const float* w1; const float* w2; const float* a0; const float* a1; const float* a2;
  const float* g1; const float* g2; const float* k_k; const float* k_a; const float* r_k;
  const float* ln_w; const float* ln_b; const float* w_o;
  const float* ffn_norm; const float* rg_w; const float* rg_b; const float* re_w; const float* re_b;
  const float* e_gate; const float* e_up; const float* e_down;
  float* out;
  unsigned char* ws;
  int ph_lo, ph_hi, layer, pad;
};

#define PREF const __attribute__((address_space(4))) P&
__device__ __forceinline__ const __attribute__((address_space(4))) P* opaque_kernarg() { auto q = __builtin_amdgcn_kernarg_segment_ptr(); asm volatile("" : "+s"(q)); return (const __attribute__((address_space(4))) P*)q; }
#define KP (*opaque_kernarg())

constexpr int RING_OFF = 0, RING_BYTES = 131072;
constexpr int LDSCTL_OFF = RING_BYTES, MISC_OFF = LDSCTL_OFF + 320;
constexpr int LDS_BYTES = 147456;
constexpr int NWAVES = 8;

struct Frame {
  LAS unsigned char* lds;
  volatile LAS unsigned* MISC;
  gu32* ctl;
  int tid, lane, wave, vcu, G;
#ifdef PROBE_PH
  unsigned long long pr_t0, pr_t1;
#endif
};
#ifdef PROBE_PH
#define PROBE_MARK(k) do { if ((k) == PROBE_PH) F.pr_t0 = __builtin_amdgcn_s_memrealtime(); if ((k) == PROBE_PH + PROBE_N) F.pr_t1 = __builtin_amdgcn_s_memrealtime(); } while (0)
#else
#define PROBE_MARK(k) do {} while (0)
#endif

__device__ __forceinline__ void transpose_item(const float* W, int ldsrc, int k0, int c0, int ncols, bf16_t* dst, int ldk, int drow0, LAS float* scr, int lane) {
  const int kr = lane >> 3, c4 = (lane & 7) * 4;
  f32x4 v[8];
#pragma unroll
  for (int i = 0; i < 8; ++i) v[i] = (c4 < ncols) ? *(const GAS f32x4*)(W + (size_t)(k0 + kr + 8 * i) * ldsrc + c0 + c4) : (f32x4){0.f, 0.f, 0.f, 0.f};
#pragma unroll
  for (int i = 0; i < 8; ++i) { LAS float* s = scr + (kr + 8 * i) * 33 + c4; s[0] = v[i].x; s[1] = v[i].y; s[2] = v[i].z; s[3] = v[i].w; }
  LDS_WAIT(); asm volatile("" ::: "memory");
  const int c = lane & 7;
#pragma unroll
  for (int j = 0; j < 4; ++j) { const int n = (lane >> 3) + 8 * j; const LAS float* s = scr + (8 * c) * 33 + n;
    v4u o; o.x = pk2(s[0 * 33], s[1 * 33]); o.y = pk2(s[2 * 33], s[3 * 33]); o.z = pk2(s[4 * 33], s[5 * 33]); o.w = pk2(s[6 * 33], s[7 * 33]);
    *(GAS v4u*)(dst + (size_t)(drow0 + n) * ldk + k0 + 8 * c) = o; }
  LDS_WAIT(); asm volatile("" ::: "memory");
}
__device__ __forceinline__ void rms_row_to_bf16(const float* xrow, const float* gain, bf16_t* orow, int lane) {
  const GAS f32x4* xr = (const GAS f32x4*)xrow + lane;
  const GAS f32x4* gr = (const GAS f32x4*)gain + lane;
  f32x4 v[4]; float s = 0.f;
#pragma unroll
  for (int j = 0; j < 4; ++j) { v[j] = xr[64 * j]; s += (v[j].x * v[j].x + v[j].y * v[j].y) + (v[j].z * v[j].z + v[j].w * v[j].w); }
  const float r = rsqrtf(wave_sum(s) * (1.f / DM) + 1e-6f);
  GAS unsigned long long* o8 = (GAS unsigned long long*)orow + lane;
#pragma unroll
  for (int j = 0; j < 4; ++j) { const f32x4 g = gr[64 * j];
    o8[64 * j] = (unsigned long long)pk2(v[j].x * r * g.x, v[j].y * r * g.y) | ((unsigned long long)pk2(v[j].z * r * g.z, v[j].w * r * g.w) << 32); }
}

__device__ __forceinline__ void conv_win_item(PREF p, int it, LAS float* scr, int lane) {
  const int vg = it >> 4, kb = it & 15;
  const int pn = vg >> 3, bj = (vg >> 2) & 1, wc = vg & 3, s = pn * 4 + wc;
  int c0 = 0, nc = 0;
  if (s < 44) { c0 = 64 * s + 32 * bj; nc = 32; } else if (s == 44 && bj == 0) { c0 = OFF_NG; nc = 24; }
  transpose_item(p.w_in, INC, kb * 64, c0, nc, (bf16_t*)(p.ws + WS_WIN), DM, vg * 32, scr, lane);
}
__device__ __forceinline__ void conv_sq_item(const float* W, bf16_t* dst, int drow_base, int it, LAS float* scr, int lane) {
  const int cg = it >> 4, kb = it & 15;
  transpose_item(W, DM, kb * 64, cg * 32, 32, dst, DM, drow_base + cg * 32, scr, lane);
}
__device__ __forceinline__ void conv_expert_item(PREF p, int layer, int it, LAS float* scr, int lane) {
  const int e = it / 384, r = it % 384;
  if (r < 256) {
    const int up = r >> 7, q = r & 127, cgp = q >> 4, kb = q & 15;
    const int pn = cgp >> 2, qq = cgp & 3;
    const float* W = (up ? p.e_up : p.e_gate) + ((size_t)layer * 32 + e) * DM * 256;
    transpose_item(W, 256, kb * 64, cgp * 32, 32, (bf16_t*)(p.ws + WS_EGU), DM, e * 512 + pn * 256 + up * 128 + qq * 32, scr, lane);
  } else {
    const int q = r - 256, cg = q >> 2, kb = q & 3;
    const float* W = p.e_down + ((size_t)layer * 32 + e) * 256 * DM;
    transpose_item(W, DM, kb * 64, cg * 32, 32, (bf16_t*)(p.ws + WS_EDN), 256, e * 1024 + cg * 32, scr, lane);
  }
}

using pg8::Unit; using pg8::u32x4; using pg8::pack8;
struct EpiInProj {
  static constexpr bool PERM = true, HAS_PRE = false;
  bf16_t* H; float* GATES; const float* dq; const float* dk; const float* nq; const float* nk; const float* gbias;
  __device__ __forceinline__ void operator()(const f32x4 (&acc)[2][2][4][2], const Unit& u, int wr, int wc, int fr, int fq) const {
    const int s = u.pn * 4 + wc;
    if (s > 44) return;
    const int row0 = u.pm * 256 + wr * 64 + fr;
    if (s == 44) {
      if (fq < 3) {
        f32x4 b0 = *(const f32x4*)(gbias + 8 * fq), b1 = *(const f32x4*)(gbias + 8 * fq + 4);
#pragma unroll
        for (int ai = 0; ai < 2; ++ai)
#pragma unroll
          for (int m = 0; m < 4; ++m) { float* gp = GATES + (size_t)(row0 + ai * 128 + m * 16) * 24 + 8 * fq;
            f32x4 v0 = acc[ai][0][m][0] + b0, v1 = acc[ai][0][m][1] + b1;
#pragma unroll
            for (int i = 0; i < 4; ++i) { v0[i] = sigmoidf_(v0[i]); v1[i] = sigmoidf_(v1[i]); }
            *(f32x4*)gp = v0; *(f32x4*)(gp + 4) = v1; }
      }
      return;
    }
    int mode = 0; const float* gain = nullptr;
    if (s < 8) { mode = 1; gain = dq; } else if (s < 16) { mode = 1; gain = dk; }
    else if (s >= 24 && s < 32) { mode = 2; gain = nq; }
    else if (s >= 32) { const int q = s - 32, br = q >> 2, kv = (q >> 1) & 1; if (kv == 0 && br >= 1) { mode = 2; gain = nk + br * 64; } }
    const float qsc = (s < 8) ? 0.17677669529663687f * 1.4426950408889634f : ((s >= 24 && s < 32) ? 0.125f * 1.4426950408889634f : 1.f);
    f32x4 g[2][2];
#pragma unroll
    for (int bj = 0; bj < 2; ++bj)
#pragma unroll
      for (int n = 0; n < 2; ++n) {
        if (mode == 1) g[bj][n] = *(const f32x4*)(gain + 8 * fq + 4 * n);
        else if (mode == 2) g[bj][n] = *(const f32x4*)(gain + 32 * bj + 8 * fq + 4 * n);
        else g[bj][n] = (f32x4){1.f, 1.f, 1.f, 1.f};
      }
#pragma unroll
    for (int ai = 0; ai < 2; ++ai)
#pragma unroll
      for (int m = 0; m < 4; ++m) {
        float sc[2] = {1.f, 1.f};
        if (mode != 0) {
          float ss[2];
#pragma unroll
          for (int bj = 0; bj < 2; ++bj) { const f32x4 a = acc[ai][bj][m][0], b = acc[ai][bj][m][1];
            float t = (a[0] * a[0] + a[1] * a[1]) + (a[2] * a[2] + a[3] * a[3]) + (b[0] * b[0] + b[1] * b[1]) + (b[2] * b[2] + b[3] * b[3]);
            t += __shfl_xor(t, 16, 64); t += __shfl_xor(t, 32, 64); ss[bj] = t; }
          if (mode == 1) { sc[0] = rsqrtf(ss[0] * (1.f / 32.f) + 1e-6f) * qsc; sc[1] = rsqrtf(ss[1] * (1.f / 32.f) + 1e-6f) * qsc; }
          else { const float r = rsqrtf((ss[0] + ss[1]) * (1.f / 64.f) + 1e-6f) * qsc; sc[0] = r; sc[1] = r; }
        }
        bf16_t* rowp = H + (size_t)(row0 + ai * 128 + m * 16) * HC + 64 * s + 8 * fq;
#pragma unroll
        for (int bj = 0; bj < 2; ++bj) { const f32x4 v0 = acc[ai][bj][m][0] * sc[bj] * g[bj][0], v1 = acc[ai][bj][m][1] * sc[bj] * g[bj][1];
          *(u32x4*)(rowp + 32 * bj) = pack8(v0, v1); }
      }
  }
};
struct EpiResid {
  static constexpr bool PERM = false, HAS_PRE = false;
  const float* base; float* out; const bf16_t* y1;
  __device__ __forceinline__ void operator()(const f32x4 (&acc)[2][2][4][2], const Unit& u, int wr, int wc, int fr, int fq) const {
    const int row0 = u.pm * 256 + wr * 64 + fr, col0 = u.pn * 256 + wc * 32 + 4 * fq;
#pragma unroll
    for (int ai = 0; ai < 2; ++ai)
#pragma unroll
      for (int m = 0; m < 4; ++m) { const size_t off = (size_t)(row0 + ai * 128 + m * 16) * DM + col0;
#pragma unroll
        for (int bj = 0; bj < 2; ++bj)
#pragma unroll
          for (int n = 0; n < 2; ++n) { f32x4 b = *(const f32x4*)(base + off + bj * 128 + n * 16);
            if (y1) { const v2u y = *(const v2u*)(y1 + off + bj * 128 + n * 16);
              b.x += __uint_as_float(y.x << 16); b.y += __uint_as_float(y.x & 0xffff0000u); b.z += __uint_as_float(y.y << 16); b.w += __uint_as_float(y.y & 0xffff0000u); }
            *(f32x4*)(out + off + bj * 128 + n * 16) = b + acc[ai][bj][m][n]; asm volatile("" ::: "memory"); } }
  }
};
struct EpiRKV {
  static constexpr bool PERM = true, HAS_PRE = false;
  unsigned char* ws;
  __device__ __forceinline__ void operator()(const f32x4 (&acc)[2][2][4][2], const Unit& u, int wr, int wc, int fr, int fq) const {
    const int gi = u.pm >> 6;
    bf16_t* O = (bf16_t*)(ws + WS_S0 + (size_t)(3 + gi) * SLOT);
    const int row0 = (u.pm & 63) * 256 + wr * 64 + fr, col0 = (u.pn & 3) * 256 + wc * 32 + 8 * fq;
#pragma unroll
    for (int ai = 0; ai < 2; ++ai)
#pragma unroll
      for (int m = 0; m < 4; ++m) { bf16_t* rowp = O + (size_t)(row0 + ai * 128 + m * 16) * DM + col0;
#pragma unroll
        for (int bj = 0; bj < 2; ++bj) *(u32x4*)(rowp + bj * 128) = pack8(acc[ai][bj][m][0], acc[ai][bj][m][1]); }
  }
};
struct EpiLora1 {
  static constexpr bool PERM = true, HAS_PRE = false;
  bf16_t* TMP;
  template <int BJ>
  __device__ __forceinline__ void half(const f32x4 (&acc)[2][2][4][2], int gi, int row0, int wc, int fq) const {
    const int c = BJ * 128 + wc * 32 + 8 * fq;
    const bool skip = (gi < 2) && (c >= 64);
    const int dcol = (gi < 2) ? gi * 64 + c : 128 + c;
    const bool zero = (gi == 2) && (c >= 160);
    if (skip) return;
#pragma unroll
    for (int ai = 0; ai < 2; ++ai)
#pragma unroll
      for (int m = 0; m < 4; ++m) {
        f32x4 v0 = acc[ai][BJ][m][0], v1 = acc[ai][BJ][m][1];
#pragma unroll
        for (int i = 0; i < 4; ++i) {
          if (gi == 0) { v0[i] = tanhf(v0[i]); v1[i] = tanhf(v1[i]); }
          else if (gi == 2) { v0[i] = zero ? 0.f : sigmoidf_(v0[i]); v1[i] = zero ? 0.f : sigmoidf_(v1[i]); }
        }
        *(u32x4*)(TMP + (size_t)(row0 + ai * 128 + m * 16) * 384 + dcol) = pack8(v0, v1);
      }
  }
  __device__ __forceinline__ void operator()(const f32x4 (&acc)[2][2][4][2], const Unit& u, int wr, int wc, int fr, int fq) const {
    const int gi = u.pm >> 6;
    const int row0 = (u.pm & 63) * 256 + wr * 64 + fr;
    half<0>(acc, gi, row0, wc, fq);
    half<1>(acc, gi, row0, wc, fq);
  }
};
struct EpiLora2 {
  static constexpr bool PERM = true, HAS_PRE = false;
  unsigned char* ws; const float* w0; const float* a0;
  __device__ __forceinline__ void operator()(const f32x4 (&acc)[2][2][4][2], const Unit& u, int wr, int wc, int fr, int fq) const {
    const int gi = u.pn >> 2;
    bf16_t* O = (bf16_t*)(ws + WS_S0 + (size_t)gi * SLOT);
    const int row0 = u.pm * 256 + wr * 64 + fr, col0 = (u.pn & 3) * 256 + wc * 32 + 8 * fq;
    f32x4 b[2][2];
#pragma unroll
    for (int bj = 0; bj < 2; ++bj)
#pragma unroll
      for (int n = 0; n < 2; ++n) b[bj][n] = (gi == 0) ? *(const f32x4*)(w0 + col0 + bj * 128 + 4 * n) : (gi == 1 ? *(const f32x4*)(a0 + col0 + bj * 128 + 4 * n) : (f32x4){0.f, 0.f, 0.f, 0.f});
#pragma unroll
    for (int ai = 0; ai < 2; ++ai)
#pragma unroll
      for (int m = 0; m < 4; ++m) { bf16_t* rowp = O + (size_t)(row0 + ai * 128 + m * 16) * DM + col0;
#pragma unroll
        for (int bj = 0; bj < 2; ++bj) { f32x4 v0 = acc[ai][bj][m][0] + b[bj][0], v1 = acc[ai][bj][m][1] + b[bj][1];
          if (gi == 0) {
#pragma unroll
            for (int i = 0; i < 4; ++i) { v0[i] = -__expf(-softplusf_(-v0[i]) - 0.5f); v1[i] = -__expf(-softplusf_(-v1[i]) - 0.5f); }
          } else if (gi == 1) {
#pragma unroll
            for (int i = 0; i < 4; ++i) { v0[i] = sigmoidf_(v0[i]); v1[i] = sigmoidf_(v1[i]); }
          }
          *(u32x4*)(rowp + bj * 128) = pack8(v0, v1); } }
  }
};

struct EpiMoeGU {
  static constexpr bool PERM = true, HAS_PRE = false;
  bf16_t* HID;
  __device__ __forceinline__ void operator()(const f32x4 (&acc)[2][2][4][2], const Unit& u, int wr, int wc, int fr, int fq) const {
    const int row0 = u.pm * 256 + wr * 64 + fr, col0 = (u.pn & 1) * 128 + wc * 32 + 8 * fq;
#pragma unroll
    for (int ai = 0; ai < 2; ++ai)
#pragma unroll
      for (int m = 0; m < 4; ++m) {
        f32x4 h[2];
#pragma unroll
        for (int n = 0; n < 2; ++n) { const f32x4 g = acc[ai][0][m][n], up = acc[ai][1][m][n];
#pragma unroll
          for (int i = 0; i < 4; ++i) h[n][i] = g[i] * sigmoidf_(g[i]) * up[i]; }
        *(u32x4*)(HID + (size_t)(row0 + ai * 128 + m * 16) * 256 + col0) = pack8(h[0], h[1]);
      }
  }
};
struct EpiMoeDown {
  static constexpr bool PERM = false, HAS_PRE = true;
  float* out; bf16_t* Y1; const int* list; const float* pgate; LAS int* ept;
  __device__ __forceinline__ void pre(const Unit& u) const {
    const int r = threadIdx.x;
    if (r < 256) { int pr = -1; float gt = 0.f;
      if (r < u.nrows) { pr = list[(size_t)u.e * CAP + u.rt * 256 + r]; gt = pgate[pr]; }
      LAS int* e = ept + (u.par * 256 + r) * 2; e[0] = pr; e[1] = __float_as_int(gt); }
  }
  __device__ __forceinline__ void operator()(const f32x4 (&acc)[2][2][4][2], const Unit& u, int wr, int wc, int fr, int fq) const {
    const int col0 = (u.pn & 3) * 256 + wc * 32 + 4 * fq;
#pragma unroll
    for (int ai = 0; ai < 2; ++ai)
#pragma unroll
      for (int m = 0; m < 4; ++m) {
        const int r = ai * 128 + wr * 64 + m * 16 + fr;
        const LAS int* e = ept + (u.par * 256 + r) * 2;
        const int pr = e[0]; const float gt = __int_as_float(e[1]);
        if (pr >= 0) {
          const int tok = pr >> 1;
          if ((pr & 1) == 0) {
            float* op = out + (size_t)tok * DM + col0;
#pragma unroll
            for (int bj = 0; bj < 2; ++bj)
#pragma unroll
              for (int n = 0; n < 2; ++n) { f32x4 b = *(const f32x4*)(op + bj * 128 + n * 16); *(f32x4*)(op + bj * 128 + n * 16) = b + acc[ai][bj][m][n] * gt; }
          } else {
            bf16_t* yp = Y1 + (size_t)tok * DM + col0;
#pragma unroll
            for (int bj = 0; bj < 2; ++bj)
#pragma unroll
              for (int n = 0; n < 2; ++n) { const f32x4 v = acc[ai][bj][m][n] * gt; v2u w; w.x = pk2(v[0], v[1]); w.y = pk2(v[2], v[3]); *(v2u*)(yp + bj * 128 + n * 16) = w; }
          }
        }
      }
  }
};

__device__ __forceinline__ void phase_prologue(PREF p, Frame& F) {
  LAS float* scr = (LAS float*)(F.lds + RING_OFF + F.wave * 16384);
  const int gw = F.vcu * NWAVES + F.wave, NGW = F.G * NWAVES;
  constexpr int I_WIN = 96 * 16, I_SQ = 32 * 16;
  constexpr int NITEMS = I_WIN + 5 * I_SQ + 128;
  for (int it = gw; it < NITEMS; it += NGW) {
    int r = it;
    if (r < I_WIN) { conv_win_item(p, r, scr, fresh_lane()); continue; } r -= I_WIN;
    if (r < I_SQ) { conv_sq_item(p.w_out, (bf16_t*)(p.ws + WS_WOUT), 0, r, scr, fresh_lane()); continue; } r -= I_SQ;
    if (r < I_SQ) { conv_sq_item(p.w_r, (bf16_t*)(p.ws + WS_WRKV), 0, r, scr, fresh_lane()); continue; } r -= I_SQ;
    if (r < I_SQ) { conv_sq_item(p.w_k, (bf16_t*)(p.ws + WS_WRKV), 1024, r, scr, fresh_lane()); continue; } r -= I_SQ;
    if (r < I_SQ) { conv_sq_item(p.w_v, (bf16_t*)(p.ws + WS_WRKV), 2048, r, scr, fresh_lane()); continue; } r -= I_SQ;
    if (r < I_SQ) { conv_sq_item(p.w_o, (bf16_t*)(p.ws + WS_WO), 0, r, scr, fresh_lane()); continue; } r -= I_SQ;
    { const int kv = r >> 6, q = r & 63, kb = q >> 1, cg = q & 1;
      transpose_item(p.cmp_w1 + (size_t)kv * 2048 * 64, 64, kb * 64, cg * 32, 32, (bf16_t*)(p.ws + WS_CW1) + (size_t)kv * 64 * 2048, 2048, cg * 32, scr, fresh_lane()); }
  }
  {
    const int gt = (F.vcu * NWAVES + F.wave) * 64 + fresh_lane(), NGT = NGW * 64;
    bf16_t* WL1 = (bf16_t*)(p.ws + WS_WL1);
    for (int i = gt; i < 768 * 1024; i += NGT) {
      const int n = i >> 10, k = i & 1023, gi = n >> 8, c = n & 255;
      float v = 0.f;
      if (gi == 0) { if (c < 64) v = p.w1[k * 64 + c]; }
      else if (gi == 1) { if (c < 64) v = p.a1[k * 64 + c]; }
      else { if (c < 160) v = p.g1[k * 160 + c]; }
      WL1[i] = (bf16_t)f2bf(v);
    }
    bf16_t* WL2 = (bf16_t*)(p.ws + WS_WL2);
    for (int i = gt; i < 3072 * 384; i += NGT) {
      const int n = i / 384, k = i - n * 384, gi = n >> 10, c = n & 1023;
      float v = 0.f;
      if (gi == 0) { if (k < 64) v = p.w2[k * 1024 + c]; }
      else if (gi == 1) { if (k >= 64 && k < 128) v = p.a2[(k - 64) * 1024 + c]; }
      else { if (k >= 128 && k < 288) v = p.g2[(k - 128) * 1024 + c]; }
      WL2[i] = (bf16_t)f2bf(v);
    }
  }
  bf16_t* XN = (bf16_t*)(p.ws + WS_XN);
  for (int m = gw; m < T_TOK; m += NGW) rms_row_to_bf16(p.x + (size_t)m * DM, p.mix_norm, XN + (size_t)m * DM, fresh_lane());
}


__device__ __forceinline__ void phase_router(PREF p, Frame& F, int layer) {
  const int gw = F.vcu * NWAVES + F.wave, NGW = F.G * NWAVES;
  const int lane = fresh_lane();
  PROBE_MARK(100 + layer * 10);
  {
    LAS float* scr = (LAS float*)(F.lds + RING_OFF + F.wave * 16384);
    for (int it = gw; it < 32 * 384; it += NGW) conv_expert_item(p, layer, it, scr, lane);
  }
  __syncthreads();
  PROBE_MARK(101 + layer * 10);
  LAS float* WQ = (LAS float*)(F.lds);
  LAS float* XS = (LAS float*)(F.lds + 40960) + F.wave * 2080;
  LAS float* LG = (LAS float*)(F.lds + 107520) + F.wave * 8 * 36;
  const float* gain = p.ffn_norm + layer * DM;
  const float* wg = p.rg_w + (size_t)layer * DM * 4;
  const float* we = p.re_w + (size_t)layer * DM * 32;
  bf16_t* XN2 = (bf16_t*)(p.ws + WS_XN2);
  f32x4 v[8][4];
#pragma unroll
  for (int tt = 0; tt < 8; ++tt) { const GAS f32x4* xr = (const GAS f32x4*)(p.out + (size_t)(gw * 8 + tt) * DM) + lane;
#pragma unroll
    for (int j = 0; j < 4; ++j) v[tt][j] = xr[64 * j]; }
  {
    f32x4 g[4];
#pragma unroll
    for (int j = 0; j < 4; ++j) g[j] = ((const GAS f32x4*)gain)[lane + 64 * j];
#pragma unroll
    for (int tt = 0; tt < 8; ++tt) {
      float s = 0.f;
#pragma unroll
      for (int j = 0; j < 4; ++j) s += (v[tt][j].x * v[tt][j].x + v[tt][j].y * v[tt][j].y) + (v[tt][j].z * v[tt][j].z + v[tt][j].w * v[tt][j].w);
      const float r = rsqrtf(wave_sum_dpp(s) * (1.f / DM) + 1e-6f);
      GAS v2u* o = (GAS v2u*)(XN2 + (size_t)(gw * 8 + tt) * DM) + lane;
#pragma unroll
      for (int j = 0; j < 4; ++j) { v[tt][j] = v[tt][j] * r * g[j]; v2u w; w.x = pk2(v[tt][j].x, v[tt][j].y); w.y = pk2(v[tt][j].z, v[tt][j].w); o[64 * j] = w; }
    }
  }
  PROBE_MARK(102 + layer * 10);
  f32x4 acc[3];
#pragma unroll
  for (int nt = 0; nt < 3; ++nt) acc[nt] = (f32x4){0.f, 0.f, 0.f, 0.f};
  const int r16 = lane & 15, g4 = lane >> 4;
#pragma unroll
  for (int j = 0; j < 4; ++j) {
    __syncthreads();
    for (int idx = F.tid; idx < 256 * 9; idx += NWAVES * 64) {
      const int row = idx / 9, c4 = idx - row * 9, k = 256 * j + row;
      const f32x4 val = (c4 == 0) ? *(const GAS f32x4*)(wg + k * 4) : *(const GAS f32x4*)(we + k * 32 + (c4 - 1) * 4);
      *(LAS f32x4*)(WQ + row * 36 + c4 * 4) = val;
    }
#pragma unroll
    for (int tt = 0; tt < 8; ++tt) *(LAS f32x4*)(XS + tt * 260 + 4 * lane) = v[tt][j];
    __syncthreads();
    const LAS float* xa = XS + (r16 & 7) * 260 + g4;
    const LAS float* wb = WQ + g4 * 36 + r16;
#pragma unroll 4
    for (int ks = 0; ks < 64; ++ks) {
      const float a = xa[4 * ks];
#pragma unroll
      for (int nt = 0; nt < 3; ++nt) acc[nt] = __builtin_amdgcn_mfma_f32_16x16x4f32(a, wb[4 * ks * 36 + nt * 16], acc[nt], 0, 0, 0);
    }
  }
  PROBE_MARK(103 + layer * 10);
  if (g4 < 2) {
#pragma unroll
    for (int nt = 0; nt < 3; ++nt) { const int n = nt * 16 + r16;
      if (n < 36) {
#pragma unroll
        for (int i = 0; i < 4; ++i) LG[(4 * g4 + i) * 36 + n] = acc[nt][i]; } }
  }
  LAS unsigned* LC = (LAS unsigned*)(F.lds + 118784);
  if (F.tid < 64) LC[F.tid] = 0u;
  __syncthreads();
  int ea = 0, eb = 0; unsigned la = 0, lb = 0; float ga = 0.f, gb = 0.f;
  if (lane < 8) {
    const LAS float* lg = LG + lane * 36;
    const float* bg = p.rg_b + layer * 4;
    const float* be = p.re_b + layer * 32;
    float gl[4]; int gi = 0; float gm = -3.4e38f;
#pragma unroll
    for (int i = 0; i < 4; i++) { gl[i] = lg[i] + bg[i]; if (gl[i] > gm) { gm = gl[i]; gi = i; } }
    float gs = 0.f;
#pragma unroll
    for (int i = 0; i < 4; i++) gs += __expf(gl[i] - gm);
    const float grp_p = 1.f / gs;
    float v0 = -3.4e38f, v1 = -3.4e38f; int i0 = 0, i1 = 0;
    for (int i = 0; i < 8; i++) {
      const float v = lg[4 + gi * 8 + i] + be[gi * 8 + i];
      if (v > v0) { v1 = v0; i1 = i0; v0 = v; i0 = i; }
      else if (v > v1) { v1 = v; i1 = i; }
    }
    const float e1 = __expf(v1 - v0);
    ga = grp_p / (1.f + e1); gb = grp_p * e1 / (1.f + e1);
    ea = gi * 8 + i0; eb = gi * 8 + i1;
    la = __hip_atomic_fetch_add(LC + ea, 1u, __ATOMIC_RELAXED, __HIP_MEMORY_SCOPE_WORKGROUP);
    lb = __hip_atomic_fetch_add(LC + eb, 1u, __ATOMIC_RELAXED, __HIP_MEMORY_SCOPE_WORKGROUP);
  }
  __syncthreads();
  if (F.tid < 32) { const unsigned n = LC[F.tid];
    unsigned* cnt = (unsigned*)(p.ws + WS_CTL) + CW_CNT + (layer * 32 + F.tid) * 64;
    LC[32 + F.tid] = n ? __hip_atomic_fetch_add(cnt, n, __ATOMIC_RELAXED, __HIP_MEMORY_SCOPE_AGENT) : 0u; }
  __syncthreads();
  if (lane < 8) {
    const int t = gw * 8 + lane;
    int* list = (int*)(p.ws + WS_LIST); float* pgate = (float*)(p.ws + WS_PGATE);
    list[(size_t)ea * CAP + LC[32 + ea] + la] = 2 * t; pgate[2 * t] = ga;
    list[(size_t)eb * CAP + LC[32 + eb] + lb] = 2 * t + 1; pgate[2 * t + 1] = gb;
  }
  PROBE_MARK(104 + layer * 10);
}

__device__ __forceinline__ void phase_final(PREF p, Frame& F) {
  const int gw = F.vcu * NWAVES + F.wave, NGW = F.G * NWAVES;
  const bf16_t* Y1 = (const bf16_t*)(p.ws + WS_Y1);
  for (int t = gw; t < T_TOK; t += NGW) {
    GAS f32x4* xr = (GAS f32x4*)(p.out + (size_t)t * DM) + fresh_lane();
    const GAS v2u* yr = (const GAS v2u*)(Y1 + (size_t)t * DM) + fresh_lane();
#pragma unroll
    for (int j = 0; j < 4; ++j) { f32x4 v = xr[64 * j]; const v2u y = yr[64 * j];
      v.x += __uint_as_float(y.x << 16); v.y += __uint_as_float(y.x & 0xffff0000u); v.z += __uint_as_float(y.y << 16); v.w += __uint_as_float(y.y & 0xffff0000u);
      xr[64 * j] = v; }
  }
}

__device__ __forceinline__ void phase_rwkv_prep(PREF p, Frame& F) {
  const int gw = F.vcu * NWAVES + F.wave, NGW = F.G * NWAVES;
  const int lane = fresh_lane();
  const float* gain = p.mix_norm + DM;
  const bf16_t* Y1 = (const bf16_t*)(p.ws + WS_Y1);
  f32x4 g[4];
#pragma unroll
  for (int j = 0; j < 4; ++j) g[j] = ((const GAS f32x4*)gain)[lane + 64 * j];
  for (int run = gw; run < T_TOK / 8; run += NGW) {
    const int t0 = run * 8;
    f32x4 prev[4];
    if ((t0 & (SEQ - 1)) == 0) {
#pragma unroll
      for (int j = 0; j < 4; ++j) prev[j] = (f32x4){0.f, 0.f, 0.f, 0.f};
    } else {
      const GAS f32x4* xr = (const GAS f32x4*)(p.out + (size_t)(t0 - 1) * DM) + lane;
      const GAS v2u* yr = (const GAS v2u*)(Y1 + (size_t)(t0 - 1) * DM) + lane;
      float s = 0.f;
#pragma unroll
      for (int j = 0; j < 4; ++j) { prev[j] = xr[64 * j]; const v2u y = yr[64 * j];
        prev[j].x += __uint_as_float(y.x << 16); prev[j].y += __uint_as_float(y.x & 0xffff0000u); prev[j].z += __uint_as_float(y.y << 16); prev[j].w += __uint_as_float(y.y & 0xffff0000u);
        s += (prev[j].x * prev[j].x + prev[j].y * prev[j].y) + (prev[j].z * prev[j].z + prev[j].w * prev[j].w); }
      const float r = rsqrtf(wave_sum(s) * (1.f / DM) + 1e-6f);
#pragma unroll
      for (int j = 0; j < 4; ++j) prev[j] = prev[j] * r * g[j];
    }
    for (int tt = 0; tt < 8; ++tt) {
      const int t = t0 + tt;
      const GAS f32x4* xr = (const GAS f32x4*)(p.out + (size_t)t * DM) + lane;
      const GAS v2u* yr = (const GAS v2u*)(Y1 + (size_t)t * DM) + lane;
      f32x4 v[4]; float s = 0.f;
#pragma unroll
      for (int j = 0; j < 4; ++j) { v[j] = xr[64 * j]; const v2u y = yr[64 * j];
        v[j].x += __uint_as_float(y.x << 16); v[j].y += __uint_as_float(y.x & 0xffff0000u); v[j].z += __uint_as_float(y.y << 16); v[j].w += __uint_as_float(y.y & 0xffff0000u);
        s += (v[j].x * v[j].x + v[j].y * v[j].y) + (v[j].z * v[j].z + v[j].w * v[j].w); }
      const float r = rsqrtf(wave_sum(s) * (1.f / DM) + 1e-6f);
#pragma unroll
      for (int j = 0; j < 4; ++j) v[j] = v[j] * r * g[j];
#pragma unroll
      for (int sl = 0; sl < 6; ++sl) {
        const int mj = (sl == 0) ? 0 : (sl == 1) ? 2 : (sl == 2) ? 3 : (sl == 3) ? 1 : (sl == 4) ? 4 : 5;
        GAS v2u* o = (GAS v2u*)(p.ws + WS_S0 + (size_t)sl * SLOT + (size_t)t * DM * 2) + lane;
#pragma unroll
        for (int j = 0; j < 4; ++j) {
          const f32x4 mx = ((const GAS f32x4*)(p.rmix + mj * DM))[lane + 64 * j];
          const f32x4 q = v[j] + (prev[j] - v[j]) * mx;
          v2u w; w.x = pk2(q.x, q.y); w.y = pk2(q.z, q.w);
          o[64 * j] = w;
        }
      }
#pragma unroll
      for (int j = 0; j < 4; ++j) prev[j] = v[j];
    }
  }
}


constexpr int RP = 72;
constexpr int RB = 64 * RP * 2;
typedef LAS bf16_t* lbf;

__device__ __forceinline__ f32x4 mm16(f32x4 acc, const LAS bf16_t* A, int arow0, const LAS bf16_t* Bt, int brow0, int lane) {
  const int r = lane & 15, q = lane >> 4;
#pragma unroll
  for (int ks = 0; ks < 2; ++ks) {
    const bf16x8 a = *(const LAS bf16x8*)(A + (arow0 + r) * RP + ks * 32 + q * 8);
    const bf16x8 b = *(const LAS bf16x8*)(Bt + (brow0 + r) * RP + ks * 32 + q * 8);
    acc = __builtin_amdgcn_mfma_f32_16x16x32_bf16(a, b, acc, 0, 0, 0);
  }
  return acc;
}
__device__ __forceinline__ float sum8(float v) {
  v += __shfl_xor(v, 1, 64); v += __shfl_xor(v, 2, 64); v += __shfl_xor(v, 4, 64); return v;
}
__device__ __forceinline__ void ld8bf(const bf16_t* p, float (&o)[8]) {
  const v4u w = *(const GAS v4u*)p;
  o[0] = __uint_as_float(w.x << 16); o[1] = __uint_as_float(w.x & 0xffff0000u); o[2] = __uint_as_float(w.y << 16); o[3] = __uint_as_float(w.y & 0xffff0000u);
  o[4] = __uint_as_float(w.z << 16); o[5] = __uint_as_float(w.z & 0xffff0000u); o[6] = __uint_as_float(w.w << 16); o[7] = __uint_as_float(w.w & 0xffff0000u);
}
__device__ __forceinline__ v4u pk8(const float (&o)[8]) { v4u w; w.x = pk2(o[0], o[1]); w.y = pk2(o[2], o[3]); w.z = pk2(o[4], o[5]); w.w = pk2(o[6], o[7]); return w; }

#define R1_BAR() do { asm volatile("s_waitcnt lgkmcnt(0)" ::: "memory"); __builtin_amdgcn_s_barrier(); asm volatile("" ::: "memory"); } while (0)
__device__ __forceinline__ void stT(LAS bf16_t* Dst, int x0, int y0, const f32x4& acc, int lane) {
  v2u w; w.x = pk2(acc[0], acc[1]); w.y = pk2(acc[2], acc[3]);
  *(LAS v2u*)(Dst + (x0 + (lane & 15)) * RP + y0 + (lane >> 4) * 4) = w;
}
struct R1In { v4u r, ld, k, v, a; };
__device__ __forceinline__ R1In rwkv_r1_load(PREF p, int item, int tid) {
  const int ch = item >> 6, c = item & 63, b = ch >> 4, hd = ch & 15;
  const size_t off = ((size_t)(b * SEQ + c * 64 + (tid >> 3)) * DM + hd * 64 + (tid & 7) * 8);
  const bf16_t* s0 = (const bf16_t*)(p.ws + WS_S0);
  R1In in;
  in.r = *(const GAS v4u*)(s0 + 3 * (SLOT / 2) + off); in.ld = *(const GAS v4u*)(s0 + off); in.k = *(const GAS v4u*)(s0 + 4 * (SLOT / 2) + off);
  in.v = *(const GAS v4u*)(s0 + 5 * (SLOT / 2) + off); in.a = *(const GAS v4u*)(s0 + (SLOT / 2) + off);
  return in;
}
__device__ __forceinline__ void un8(const v4u w, float (&o)[8]) {
  o[0] = __uint_as_float(w.x << 16); o[1] = __uint_as_float(w.x & 0xffff0000u); o[2] = __uint_as_float(w.y << 16); o[3] = __uint_as_float(w.y & 0xffff0000u);
  o[4] = __uint_as_float(w.z << 16); o[5] = __uint_as_float(w.z & 0xffff0000u); o[6] = __uint_as_float(w.w << 16); o[7] = __uint_as_float(w.w & 0xffff0000u);
}
__device__ __forceinline__ void rwkv_r1_item(PREF p, Frame& F, int item, const R1In& in) {
  const int tid = F.tid, lane = fresh_lane(), w = F.wave;
  const int ch = item >> 6, c = item & 63, b = ch >> 4, hd = ch & 15;
  const size_t tile0 = ((size_t)(b * SEQ + c * 64) * DM + hd * 64);
  unsigned char* ws = p.ws;
  bf16_t* SL[6];
#pragma unroll
  for (int s = 0; s < 6; ++s) SL[s] = (bf16_t*)(ws + WS_S0 + (size_t)s * SLOT) + tile0;
  const lbf BtT = (lbf)(F.lds + 0 * RB), KtT = (lbf)(F.lds + 1 * RB), AbT = (lbf)(F.lds + 2 * RB), RbT = (lbf)(F.lds + 3 * RB);
  const lbf Ab = (lbf)(F.lds + 4 * RB), Vc = (lbf)(F.lds + 5 * RB), Bh = (lbf)(F.lds + 6 * RB), Kh = (lbf)(F.lds + 7 * RB);
  const lbf Tk = (lbf)(F.lds + 8 * RB), WbT = (lbf)(F.lds + 9 * RB), WkT = (lbf)(F.lds + 10 * RB);
  const lbf X = BtT, XT = KtT, Pb = AbT;
  const lbf At = X, TNT = XT, U0 = Tk;
  LAS float* Lf = (LAS float*)(F.lds + 11 * RB);
  LAS float* SEG = Lf + 64 * 65;
  LAS float* GC = (LAS float*)(F.lds + 14 * RB);
  const int t = tid >> 3, cg = tid & 7, k0 = cg * 8;
  float r_[8], ld_[8], kx[8], v_[8], a_[8];
  un8(in.r, r_); un8(in.ld, ld_); un8(in.k, kx); un8(in.v, v_); un8(in.a, a_);
  float kk[8], km[8], be[8];
  {
    float ss = 0.f, bo = 0.f;
#pragma unroll
    for (int i = 0; i < 8; ++i) { const int cc = hd * 64 + k0 + i; kk[i] = kx[i] * p.k_k[cc]; ss += kk[i] * kk[i]; km[i] = kx[i] * (1.f + (a_[i] - 1.f) * p.k_a[cc]); bo += r_[i] * km[i] * p.r_k[cc]; }
    ss = sum8(ss); bo = sum8(bo);
    const float inv = 1.f / fmaxf(sqrtf(ss), 1e-12f);
#pragma unroll
    for (int i = 0; i < 8; ++i) { kk[i] *= inv; be[i] = kk[i] * a_[i]; }
    if (cg == 0) ((float*)(ws + WS_TMP))[(size_t)item * 64 + t] = bo;
  }
#pragma unroll
  for (int i = 0; i < 8; ++i) Lf[t * 65 + k0 + i] = ld_[i];
  R1_BAR();
  {
    const int k = tid & 63, sg = tid >> 6;
    float run = 0.f;
#pragma unroll
    for (int i = 0; i < 8; ++i) { run += Lf[(sg * 8 + i) * 65 + k]; Lf[(sg * 8 + i) * 65 + k] = run; }
    SEG[sg * 64 + k] = run;
    R1_BAR();
    float off = 0.f;
    for (int j = 0; j < sg; ++j) off += SEG[j * 64 + k];
#pragma unroll
    for (int i = 0; i < 8; ++i) Lf[(sg * 8 + i) * 65 + k] += off;
  }
  R1_BAR();
  {
    float ab[8], bt[8], kt[8], rb[8], bh[8], kh[8];
#pragma unroll
    for (int i = 0; i < 8; ++i) {
      const float Lt = Lf[t * 65 + k0 + i], Lp = (t > 0) ? Lf[(t - 1) * 65 + k0 + i] : 0.f, LC = Lf[63 * 65 + k0 + i];
      const float ei = __expf(-Lt), eh = __expf(LC - Lt);
      if (t == 63) GC[k0 + i] = __expf(LC);
      ab[i] = -kk[i] * __expf(Lp); bt[i] = be[i] * ei; kt[i] = km[i] * ei; rb[i] = r_[i] * __expf(Lt); bh[i] = be[i] * eh; kh[i] = km[i] * eh;
    }
    *(LAS v4u*)(BtT + t * RP + k0) = pk8(bt); *(LAS v4u*)(KtT + t * RP + k0) = pk8(kt); *(LAS v4u*)(AbT + t * RP + k0) = pk8(ab); *(LAS v4u*)(RbT + t * RP + k0) = pk8(rb);
#pragma unroll
    for (int i = 0; i < 8; ++i) { Ab[(k0 + i) * RP + t] = (bf16_t)f2bf(ab[i]); Vc[(k0 + i) * RP + t] = (bf16_t)f2bf(v_[i]); Bh[(k0 + i) * RP + t] = (bf16_t)f2bf(bh[i]); Kh[(k0 + i) * RP + t] = (bf16_t)f2bf(kh[i]); }
  }
  R1_BAR();
  const int ya = (w >> 1) * 16, xb0 = (w & 1) * 32;
  const int cr = lane & 15, q4 = (lane >> 4) * 4;
  const f32x4 Z4 = {0.f, 0.f, 0.f, 0.f};
  f32x4 accP[2];
  {
    f32x4 tabn[2], tabs[2], taks[2], wbr[2], wkr[2];
#pragma unroll
    for (int j = 0; j < 2; ++j) { const int xb = xb0 + 16 * j;
      tabn[j] = mm16(Z4, BtT, ya, AbT, xb, lane);
      tabs[j] = mm16(Z4, AbT, ya, BtT, xb, lane);
      taks[j] = mm16(Z4, AbT, ya, KtT, xb, lane);
      wbr[j] = mm16(Z4, BtT, ya, RbT, xb, lane);
      wkr[j] = mm16(Z4, KtT, ya, RbT, xb, lane); }
    R1_BAR();
#pragma unroll
    for (int j = 0; j < 2; ++j) { const int xb = xb0 + 16 * j;
      f32x4 xt, xr, pr, tk, wb, wk;
#pragma unroll
      for (int i = 0; i < 4; ++i) {
        { const int s = ya + q4 + i, tt = xb + cr; xt[i] = (s < tt) ? tabn[j][i] : 0.f; wb[i] = (s <= tt) ? wbr[j][i] : 0.f; wk[i] = (s <= tt) ? wkr[j][i] : 0.f; }
        { const int tt = ya + q4 + i, s = xb + cr; xr[i] = (s < tt) ? tabs[j][i] : 0.f; pr[i] = xr[i] + ((s == tt) ? 1.f : 0.f); tk[i] = (s < tt) ? taks[j][i] : 0.f; }
      }
      accP[j] = pr;
      stT(XT, xb, ya, xt, lane); stT(WbT, xb, ya, wb, lane); stT(WkT, xb, ya, wk, lane);
      stT(X, xb, ya, xr, lane); stT(Pb, xb, ya, pr, lane); stT(Tk, xb, ya, tk, lane); }
  }
  R1_BAR();
#pragma unroll 1
  for (int st = 0; st < 5; ++st) {
    f32x4 xr[2], xt[2];
#pragma unroll
    for (int j = 0; j < 2; ++j) { const int xb = xb0 + 16 * j;
      xr[j] = mm16(Z4, XT, ya, X, xb, lane);
      xt[j] = mm16(Z4, X, ya, XT, xb, lane);
      if (st > 0) accP[j] = mm16(accP[j], XT, ya, Pb, xb, lane); }
    R1_BAR();
#pragma unroll
    for (int j = 0; j < 2; ++j) { const int xb = xb0 + 16 * j; stT(X, xb, ya, xr[j], lane); stT(XT, xb, ya, xt[j], lane); stT(Pb, xb, ya, accP[j], lane); }
    R1_BAR();
  }
  {
    f32x4 nt[2];
#pragma unroll
    for (int j = 0; j < 2; ++j) { const int xb = xb0 + 16 * j; nt[j] = mm16(Z4, Pb, ya, XT, xb, lane);
#pragma unroll
      for (int i = 0; i < 4; ++i) nt[j][i] += bf2f(Pb[(ya + q4 + i) * RP + xb + cr]); }
    R1_BAR();
#pragma unroll
    for (int j = 0; j < 2; ++j) stT(Pb, xb0 + 16 * j, ya, nt[j], lane);
    R1_BAR();
  }
  const lbf NT = Pb;
  {
    f32x4 at[2], tn[2];
#pragma unroll
    for (int j = 0; j < 2; ++j) { const int xb = xb0 + 16 * j; at[j] = mm16(Z4, NT, ya, Ab, xb, lane); tn[j] = mm16(Z4, Tk, ya, NT, xb, lane); }
#pragma unroll
    for (int j = 0; j < 2; ++j) { const int xb = xb0 + 16 * j; stT(At, xb, ya, at[j], lane); stT(TNT, xb, ya, tn[j], lane); }
  }
  R1_BAR();
  const lbf O_RT = (lbf)(F.lds + 11 * RB), O_PM = (lbf)(F.lds + 12 * RB), O_Y0 = (lbf)(F.lds + 13 * RB), O_Q = (lbf)(F.lds + 3 * RB)  ;
  {
    f32x4 u0[2], rt[2], pm[2];
#pragma unroll
    for (int j = 0; j < 2; ++j) { const int xb = xb0 + 16 * j;
      u0[j] = mm16(Z4, TNT, ya, Vc, xb, lane);
      rt[j] = mm16(Z4, At, ya, WbT, xb, lane);
      pm[j] = mm16(Z4, At, ya, Bh, xb, lane);
      const v2u rbw = *(const LAS v2u*)(RbT + (xb + cr) * RP + ya + q4);
      rt[j][0] += __uint_as_float(rbw.x << 16); rt[j][1] += __uint_as_float(rbw.x & 0xffff0000u); rt[j][2] += __uint_as_float(rbw.y << 16); rt[j][3] += __uint_as_float(rbw.y & 0xffff0000u);
#pragma unroll
      for (int i = 0; i < 4; ++i) if (ya + q4 + i == xb + cr) pm[j][i] += GC[xb + cr]; }
    R1_BAR();
#pragma unroll
    for (int j = 0; j < 2; ++j) { const int xb = xb0 + 16 * j; stT(U0, xb, ya, u0[j], lane); stT(O_RT, xb, ya, rt[j], lane); stT(O_PM, xb, ya, pm[j], lane); }
  }
  R1_BAR();
  {
    f32x4 y0[2], qq[2];
#pragma unroll
    for (int j = 0; j < 2; ++j) { const int xb = xb0 + 16 * j;
      y0[j] = mm16(mm16(Z4, U0, ya, WbT, xb, lane), Vc, ya, WkT, xb, lane);
      qq[j] = mm16(mm16(Z4, Bh, ya, U0, xb, lane), Kh, ya, Vc, xb, lane); }
#pragma unroll
    for (int j = 0; j < 2; ++j) { const int xb = xb0 + 16 * j; stT(O_Y0, xb, ya, y0[j], lane); stT(O_Q, xb, ya, qq[j], lane); }
  }
  R1_BAR();
  {
    const int row = tid >> 3, pc = (tid & 7) * 8;
    *(GAS v4u*)(SL[3] + (size_t)row * DM + pc) = *(const LAS v4u*)(O_RT + row * RP + pc);
    *(GAS v4u*)(SL[0] + (size_t)row * DM + pc) = *(const LAS v4u*)(O_PM + row * RP + pc);
    *(GAS v4u*)(SL[4] + (size_t)row * DM + pc) = *(const LAS v4u*)(O_Y0 + row * RP + pc);
    *(GAS v4u*)(SL[1] + (size_t)row * DM + pc) = *(const LAS v4u*)(O_Q + row * RP + pc);
  }
  R1_BAR();
}

__device__ __forceinline__ void phase_rwkv_r1(PREF p, Frame& F) {
  int item = F.vcu;
  if (item >= 4096) return;
  R1In nxt = rwkv_r1_load(p, item, F.tid);
  for (; item < 4096; item += F.G) {
    const R1In cur = nxt;
    if (item + F.G < 4096) nxt = rwkv_r1_load(p, item + F.G, F.tid);
    rwkv_r1_item(p, F, item, cur);
  }
}

#define R2_BAR() do { asm volatile("s_waitcnt lgkmcnt(0)" ::: "memory"); __builtin_amdgcn_s_barrier(); asm volatile("" ::: "memory"); } while (0)
__device__ __forceinline__ void phase_rwkv_r2(PREF p, Frame& F) {
  const int lane = fresh_lane(), w = F.wave, tid = F.tid;
  const lbf Sh = (lbf)(F.lds), Sl = (lbf)(F.lds + 16 * RP * 2);
  const int cr = lane & 15, q4 = (lane >> 4) * 4, q = lane >> 4;
  for (int task = F.vcu; task < 256; task += F.G) {
    const int ch = task >> 2, jb = task & 3, b = ch >> 4, hd = ch & 15;
    const bf16_t* PM = (const bf16_t*)(p.ws + WS_S0) + ((size_t)(b * SEQ) * DM + hd * 64);
    bf16_t* QS = (bf16_t*)(p.ws + WS_S0 + SLOT) + ((size_t)(b * SEQ) * DM + hd * 64);
    for (int i = tid; i < 16 * RP; i += NWAVES * 64) { Sh[i] = 0; Sl[i] = 0; }
    R2_BAR();
    const int wc = w & 3;
    const bf16_t* pmp = PM + (size_t)(16 * wc + cr) * DM + q * 8;
    const bf16_t* qsp = QS + (size_t)(16 * jb + q4) * DM + 16 * wc + cr;
    bf16x8 nb0[8], nb1[8]; unsigned short nq[8][4];
#pragma unroll
    for (int d = 0; d < 8; ++d) { nb0[d] = *(const GAS bf16x8*)(pmp + (size_t)d * 64 * DM); nb1[d] = *(const GAS bf16x8*)(pmp + (size_t)d * 64 * DM + 32);
#pragma unroll
      for (int i = 0; i < 4; ++i) nq[d][i] = *(const GAS unsigned short*)(qsp + (size_t)(d * 64 + i) * DM); }
#pragma unroll 1
    for (int c8 = 0; c8 < 64; c8 += 8) {
#pragma unroll
      for (int d = 0; d < 8; ++d) {
        const int c = c8 + d;
        f32x4 acc = {0.f, 0.f, 0.f, 0.f};
        const bf16x8 b0 = nb0[d], b1 = nb1[d];
        float qv[4];
#pragma unroll
        for (int i = 0; i < 4; ++i) qv[i] = bf2f(nq[d][i]);
        if (c + 8 < 64) { nb0[d] = *(const GAS bf16x8*)(pmp + (size_t)(c + 8) * 64 * DM); nb1[d] = *(const GAS bf16x8*)(pmp + (size_t)(c + 8) * 64 * DM + 32);
#pragma unroll
          for (int i = 0; i < 4; ++i) nq[d][i] = *(const GAS unsigned short*)(qsp + (size_t)((c + 8) * 64 + i) * DM); }
        const bf16x8 ah0 = *(const LAS bf16x8*)(Sh + cr * RP + q * 8), ah1 = *(const LAS bf16x8*)(Sh + cr * RP + 32 + q * 8);
        const bf16x8 al0 = *(const LAS bf16x8*)(Sl + cr * RP + q * 8), al1 = *(const LAS bf16x8*)(Sl + cr * RP + 32 + q * 8);
        acc = __builtin_amdgcn_mfma_f32_16x16x32_bf16(ah0, b0, acc, 0, 0, 0);
        acc = __builtin_amdgcn_mfma_f32_16x16x32_bf16(ah1, b1, acc, 0, 0, 0);
        acc = __builtin_amdgcn_mfma_f32_16x16x32_bf16(al0, b0, acc, 0, 0, 0);
        acc = __builtin_amdgcn_mfma_f32_16x16x32_bf16(al1, b1, acc, 0, 0, 0);
        R2_BAR();
        if (w < 4) {
#pragma unroll
          for (int i = 0; i < 4; ++i) { const float sv = acc[i] + qv[i]; const unsigned hi = f2bf(sv); const float lo = sv - __uint_as_float(hi << 16);
            Sh[(q4 + i) * RP + 16 * wc + cr] = (bf16_t)hi; Sl[(q4 + i) * RP + 16 * wc + cr] = (bf16_t)f2bf(lo); }
        }
        R2_BAR();
        if (tid >= 256 && tid < 384) {
          const int row = (tid - 256) >> 3, pc = (tid & 7) * 8;
          *(GAS v4u*)(QS + (size_t)(c * 64 + 16 * jb + row) * DM + pc) = *(const LAS v4u*)(Sh + row * RP + pc);
        }
      }
    }
    R2_BAR();
  }
}

__device__ __forceinline__ void phase_rwkv_r3(PREF p, Frame& F) {
  const int lane = fresh_lane(), w = F.wave;
  const int cr = lane & 15, q4 = (lane >> 4) * 4, q = lane >> 4;
  const int half = w >> 2, tb = w & 3;
  LAS bf16_t* stg = (LAS bf16_t*)(F.lds) + w * 16 * RP;
  for (int it2 = F.vcu; it2 < 2048; it2 += F.G) {
    const int item = it2 * 2 + half;
    const int ch = item >> 6, c = item & 63, b = ch >> 4, hd = ch & 15;
    const size_t tile0 = ((size_t)(b * SEQ + c * 64) * DM + hd * 64);
    bf16_t* RT = (bf16_t*)(p.ws + WS_S0 + 3 * SLOT) + tile0;
    const bf16_t* Y0 = (const bf16_t*)(p.ws + WS_S0 + 4 * SLOT) + tile0;
    const bf16_t* VV = (const bf16_t*)(p.ws + WS_S0 + 5 * SLOT) + tile0;
    const bf16_t* GG = (const bf16_t*)(p.ws + WS_S0 + 2 * SLOT) + tile0;
    const bf16_t* SC = (const bf16_t*)(p.ws + WS_S0 + SLOT) + tile0 - (size_t)64 * DM;
    const float* BO = (const float*)(p.ws + WS_TMP) + (size_t)item * 64;
    f32x4 y[4];
#pragma unroll
    for (int j = 0; j < 4; ++j) y[j] = (f32x4){0.f, 0.f, 0.f, 0.f};
    if (c > 0) {
      const bf16_t* ap = RT + (size_t)(16 * tb + cr) * DM + q * 8;
      const bf16x8 a0 = *(const GAS bf16x8*)ap, a1 = *(const GAS bf16x8*)(ap + 32);
#pragma unroll
      for (int j = 0; j < 4; ++j) {
        const bf16_t* bp = SC + (size_t)(16 * j + cr) * DM + q * 8;
        const bf16x8 b0 = *(const GAS bf16x8*)bp, b1 = *(const GAS bf16x8*)(bp + 32);
        y[j] = __builtin_amdgcn_mfma_f32_16x16x32_bf16(a0, b0, y[j], 0, 0, 0);
        y[j] = __builtin_amdgcn_mfma_f32_16x16x32_bf16(a1, b1, y[j], 0, 0, 0);
      }
    }
    float mu[4], rs[4];
#pragma unroll
    for (int i = 0; i < 4; ++i) {
      float s = 0.f;
#pragma unroll
      for (int j = 0; j < 4; ++j) { y[j][i] += bf2f(Y0[(size_t)(16 * tb + q4 + i) * DM + 16 * j + cr]); s += y[j][i]; }
      s += __shfl_xor(s, 1, 64); s += __shfl_xor(s, 2, 64); s += __shfl_xor(s, 4, 64); s += __shfl_xor(s, 8, 64);
      mu[i] = s * (1.f / 64.f);
      float qd = 0.f;
#pragma unroll
      for (int j = 0; j < 4; ++j) { const float d = y[j][i] - mu[i]; qd += d * d; }
      qd += __shfl_xor(qd, 1, 64); qd += __shfl_xor(qd, 2, 64); qd += __shfl_xor(qd, 4, 64); qd += __shfl_xor(qd, 8, 64);
      rs[i] = rsqrtf(qd * (1.f / 64.f) + 64e-5f);
    }
#pragma unroll
    for (int j = 0; j < 4; ++j) {
      const int cc = hd * 64 + 16 * j + cr;
      const float lw = p.ln_w[cc], lb = p.ln_b[cc];
#pragma unroll
      for (int i = 0; i < 4; ++i) {
        const int tt = 16 * tb + q4 + i;
        const float vv = bf2f(VV[(size_t)tt * DM + 16 * j + cr]), gg = bf2f(GG[(size_t)tt * DM + 16 * j + cr]);
        const float z = ((y[j][i] - mu[i]) * rs[i] * lw + lb + BO[tt] * vv) * gg;
        stg[(q4 + i) * RP + 16 * j + cr] = (bf16_t)f2bf(z);
      }
    }
    LDS_WAIT();
#pragma unroll
    for (int i = 0; i < 2; ++i) { const int row = (lane >> 3) + 8 * i, pc = (lane & 7) * 8;
      *(GAS v4u*)(RT + (size_t)(16 * tb + row) * DM + pc) = *(const LAS v4u*)(stg + row * RP + pc); }
    LDS_WAIT();
  }
}


typedef short v4i16_t __attribute__((ext_vector_type(4)));
__device__ __forceinline__ v4i16_t tr16(const LAS bf16_t* p) { return __builtin_amdgcn_ds_read_tr16_b64_v4i16((LAS v4i16_t*)p); }

template <int KS>
__device__ __forceinline__ void qk_tile(f32x4 (&st)[4][2], const LAS bf16_t* Kt, int kc0, const bf16x8 (&qf)[2][KS], int lane) {
  const int r = lane & 15, g = lane >> 4;
#pragma unroll
  for (int kt = 0; kt < 4; ++kt)
#pragma unroll
    for (int ks = 0; ks < KS; ++ks) {
      const bf16x8 a = *(const LAS bf16x8*)(Kt + (kt * 16 + r) * RP + kc0 + ks * 32 + g * 8);
#pragma unroll
      for (int qt = 0; qt < 2; ++qt) st[kt][qt] = __builtin_amdgcn_mfma_f32_16x16x32_bf16(a, qf[qt][ks], st[kt][qt], 0, 0, 0);
    }
}
__device__ __forceinline__ void pack_p(bf16x8 (&pb)[2][2], const f32x4 (&pr)[4][2]) {
#pragma unroll
  for (int kb = 0; kb < 2; ++kb)
#pragma unroll
    for (int qt = 0; qt < 2; ++qt) {
      const v4u w = {pk2(pr[2 * kb][qt][0], pr[2 * kb][qt][1]), pk2(pr[2 * kb][qt][2], pr[2 * kb][qt][3]), pk2(pr[2 * kb + 1][qt][0], pr[2 * kb + 1][qt][1]), pk2(pr[2 * kb + 1][qt][2], pr[2 * kb + 1][qt][3])};
      pb[kb][qt] = __builtin_bit_cast(bf16x8, w);
    }
}
__device__ __forceinline__ void pv_apply(f32x4 (&o)[4][2], f32x4 (&osum)[2], const bf16x8 (&pb)[2][2], const LAS bf16_t* Vt, int lane) {
  const int g = lane >> 4, qq = (lane & 15) >> 2, pp = lane & 3;
  const bf16x8 ones = {0x3F80, 0x3F80, 0x3F80, 0x3F80, 0x3F80, 0x3F80, 0x3F80, 0x3F80};
#pragma unroll
  for (int kb = 0; kb < 2; ++kb)
#pragma unroll
    for (int qt = 0; qt < 2; ++qt) osum[qt] = __builtin_amdgcn_mfma_f32_16x16x32_bf16(ones, pb[kb][qt], osum[qt], 0, 0, 0);
#pragma unroll
  for (int dt = 0; dt < 4; ++dt)
#pragma unroll
    for (int kb = 0; kb < 2; ++kb) {
      const v4i16_t lo = tr16(Vt + (32 * kb + 4 * g + qq) * RP + dt * 16 + 4 * pp);
      const v4i16_t hi = tr16(Vt + (32 * kb + 16 + 4 * g + qq) * RP + dt * 16 + 4 * pp);
      const bf16x8 a = {lo[0], lo[1], lo[2], lo[3], hi[0], hi[1], hi[2], hi[3]};
#pragma unroll
      for (int qt = 0; qt < 2; ++qt) o[dt][qt] = __builtin_amdgcn_mfma_f32_16x16x32_bf16(a, pb[kb][qt], o[dt][qt], 0, 0, 0);
    }
}
__device__ __forceinline__ void pv_apply2(f32x4 (&o1)[4][2], f32x4 (&o2)[4][2], f32x4 (&os1)[2], f32x4 (&os2)[2], const bf16x8 (&pb1)[2][2], const bf16x8 (&pb2)[2][2], const LAS bf16_t* Vt, int lane) {
  const int g = lane >> 4, qq = (lane & 15) >> 2, pp = lane & 3;
  const bf16x8 ones = {0x3F80, 0x3F80, 0x3F80, 0x3F80, 0x3F80, 0x3F80, 0x3F80, 0x3F80};
#pragma unroll
  for (int kb = 0; kb < 2; ++kb)
#pragma unroll
    for (int qt = 0; qt < 2; ++qt) { os1[qt] = __builtin_amdgcn_mfma_f32_16x16x32_bf16(ones, pb1[kb][qt], os1[qt], 0, 0, 0); os2[qt] = __builtin_amdgcn_mfma_f32_16x16x32_bf16(ones, pb2[kb][qt], os2[qt], 0, 0, 0); }
#pragma unroll
  for (int dt = 0; dt < 4; ++dt)
#pragma unroll
    for (int kb = 0; kb < 2; ++kb) {
      const v4i16_t lo = tr16(Vt + (32 * kb + 4 * g + qq) * RP + dt * 16 + 4 * pp);
      const v4i16_t hi = tr16(Vt + (32 * kb + 16 + 4 * g + qq) * RP + dt * 16 + 4 * pp);
      const bf16x8 a = {lo[0], lo[1], lo[2], lo[3], hi[0], hi[1], hi[2], hi[3]};
#pragma unroll
      for (int qt = 0; qt < 2; ++qt) { o1[dt][qt] = __builtin_amdgcn_mfma_f32_16x16x32_bf16(a, pb1[kb][qt], o1[dt][qt], 0, 0, 0); o2[dt][qt] = __builtin_amdgcn_mfma_f32_16x16x32_bf16(a, pb2[kb][qt], o2[dt][qt], 0, 0, 0); }
    }
}
__device__ __forceinline__ void fill42(f32x4 (&a)[4][2], const f32x4 v) {
#pragma unroll
  for (int i = 0; i < 4; ++i)
#pragma unroll
    for (int j = 0; j < 2; ++j) a[i][j] = v;
}
__device__ __forceinline__ void exp42(f32x4 (&a)[4][2]) {
#pragma unroll
  for (int i = 0; i < 4; ++i)
#pragma unroll
    for (int j = 0; j < 2; ++j)
#pragma unroll
      for (int e = 0; e < 4; ++e) a[i][j][e] = __builtin_amdgcn_exp2f(a[i][j][e]);
}
#if defined(PROBE_PH) && PROBE_PH == 300
#define AT_BAR() do { const unsigned long long _b0 = __builtin_amdgcn_s_memrealtime(); asm volatile("s_waitcnt lgkmcnt(0)" ::: "memory"); __builtin_amdgcn_s_barrier(); asm volatile("" ::: "memory"); F.pr_t1 += __builtin_amdgcn_s_memrealtime() - _b0; } while (0)
#else
#define AT_BAR() do { asm volatile("s_waitcnt lgkmcnt(0)" ::: "memory"); __builtin_amdgcn_s_barrier(); asm volatile("" ::: "memory"); } while (0)
#endif
__device__ __forceinline__ void zero42(f32x4 (&a)[4][2]) {
#pragma unroll
  for (int i = 0; i < 4; ++i)
#pragma unroll
    for (int j = 0; j < 2; ++j) a[i][j] = (f32x4){0.f, 0.f, 0.f, 0.f};
}

__device__ __forceinline__ void phase_compress(PREF p, Frame& F) {
  const int lane = fresh_lane(), w = F.wave, tid = F.tid;
  const int r = lane & 15, g4 = lane >> 4;
  const bf16_t* H = (const bf16_t*)(p.ws + WS_H);
  const bf16_t* W1T = (const bf16_t*)(p.ws + WS_CW1);
  LAS float* part = (LAS float*)F.lds;
  LAS float* hid = part + 8 * 16 * 64;
  LAS float* outv = hid + 16 * 64;
  for (int task = F.vcu; task < 256; task += F.G) {
    const int kv = task >> 7, rb = task & 127;
    int row = rb * 16 + r; if (row > 2039) row = 2039;
    const int gg = row & 1, cc = (row >> 1) % NCMP, bb = (row >> 1) / NCMP;
    const int colbase = OFF_NKV + ((0 * 2 + kv) * 2 + gg) * 64;
    f32x4 acc[4];
#pragma unroll
    for (int nt = 0; nt < 4; ++nt) acc[nt] = (f32x4){0.f, 0.f, 0.f, 0.f};
#pragma unroll 1
    for (int ks = 0; ks < 8; ++ks) {
      const int k = w * 256 + ks * 32 + g4 * 8, l = k >> 6, d0 = k & 63;
      float hv[8]; ld8bf(H + (size_t)(bb * SEQ + 16 * cc + l) * HC + colbase + d0, hv);
      const float* pe = p.cmp_pe + (kv * 32 + l) * 64 + d0;
#pragma unroll
      for (int i = 0; i < 8; ++i) hv[i] += pe[i];
      const bf16x8 a = __builtin_bit_cast(bf16x8, pk8(hv));
#pragma unroll
      for (int nt = 0; nt < 4; ++nt) {
        const bf16x8 bfr = *(const GAS bf16x8*)(W1T + ((size_t)kv * 64 + nt * 16 + r) * 2048 + k);
        acc[nt] = __builtin_amdgcn_mfma_f32_16x16x32_bf16(a, bfr, acc[nt], 0, 0, 0);
      }
    }
#pragma unroll
    for (int nt = 0; nt < 4; ++nt)
#pragma unroll
      for (int i = 0; i < 4; ++i) part[(w * 16 + g4 * 4 + i) * 64 + nt * 16 + r] = acc[nt][i];
    __syncthreads();
    for (int e = tid; e < 1024; e += NWAVES * 64) { float s = 0.f;
#pragma unroll
      for (int ww = 0; ww < 8; ++ww) s += part[ww * 1024 + e];
      hid[e] = gelu_tanh(s); }
    __syncthreads();
    const float* w2 = p.cmp_w2 + kv * 4096;
    for (int e = tid; e < 1024; e += NWAVES * 64) { const int rr = e >> 6, n = e & 63; float s = 0.f;
      for (int j = 0; j < 64; ++j) s += hid[rr * 64 + j] * w2[j * 64 + n];
      outv[e] = s; }
    __syncthreads();
    for (int e = tid; e < 1024; e += NWAVES * 64) { const int rr = e >> 6, n = e & 63;
      const int orow = rb * 16 + rr;
      if (orow < 2040) {
        float v = outv[e];
        if (kv == 0) { float ss = 0.f; for (int j = 0; j < 64; ++j) ss += outv[rr * 64 + j] * outv[rr * 64 + j]; v = v * rsqrtf(ss * (1.f / 64.f) + 1e-6f) * p.nk_norm[n]; }
        const int g2 = orow & 1, c2 = (orow >> 1) % NCMP, b2 = (orow >> 1) / NCMP;
        ((bf16_t*)(p.ws + (kv ? WS_VCMPB : WS_KCMPB)))[((size_t)(b2 * 2 + g2) * 256 + c2) * 64 + n] = (bf16_t)f2bf(v);
      }
    }
    if (task < 16 && tid < 64) { const int kk2 = task >> 3, bg = task & 7; ((bf16_t*)(p.ws + (kk2 ? WS_VCMPB : WS_KCMPB)))[((size_t)bg * 256 + 255) * 64 + tid] = 0; }
    __syncthreads();
  }
}

__device__ __forceinline__ v4u tile_ld(const bf16_t* base, size_t pitch, int tid) { return *(const GAS v4u*)(base + (size_t)(tid >> 3) * pitch + (tid & 7) * 8); }
__device__ __forceinline__ void tile_st(LAS bf16_t* dst, v4u v, int tid) { *(LAS v4u*)(dst + (tid >> 3) * RP + (tid & 7) * 8) = v; }

template <int KS, int MODE>
__device__ __forceinline__ void attn_tile(f32x4 (&o)[4][2], f32x4 (&os)[2], const bf16x8 (&qf)[2][KS], const LAS bf16_t* KBt, int kc0, const LAS bf16_t* VBt, const f32x4 nbv,
                                          const bool (&on)[2], int qq0, int koff, int lane) {
  const int r = lane & 15, g = lane >> 4;
  f32x4 st[4][2]; bf16x8 pb[2][2];
  fill42(st, nbv); qk_tile<KS>(st, KBt, kc0, qf, lane); exp42(st);
  if (MODE != 0) {
#pragma unroll
    for (int kt = 0; kt < 4; ++kt)
#pragma unroll
      for (int qt = 0; qt < 2; ++qt)
#pragma unroll
        for (int i = 0; i < 4; ++i) { const int kk = kt * 16 + g * 4 + i, qq = qq0 + qt * 16 + r;
          bool keep = true;
          if (MODE & 1) keep = keep && on[qt];
          if (MODE & 2) keep = keep && (kk + koff <= qq);
          if (MODE & 4) keep = keep && (kk > qq);
          if (!keep) st[kt][qt][i] = 0.f; }
  }
  pack_p(pb, st);
  pv_apply(o, os, pb, VBt, lane);
}
__device__ __forceinline__ void phase_diffattn(PREF p, Frame& F) {
  const int lane = fresh_lane(), w = F.wave, tid = F.tid;
  const int r = lane & 15, g = lane >> 4;
  const bf16_t* H = (const bf16_t*)(p.ws + WS_H);
  bf16_t* CAT = (bf16_t*)(p.ws + WS_CAT);
  float mq = 0.f, mk = 0.f, l0 = 0.f, l1 = 0.f;
  for (int i = 0; i < 32; i++) { mq = fmaxf(mq, fabsf(p.dq_norm[i])); mk = fmaxf(mk, fabsf(p.dk_norm[i])); l0 += p.dlam[i] * p.dlam[32 + i]; l1 += p.dlam[64 + i] * p.dlam[96 + i]; }
  const float c2 = 0.17677669529663687f * 1.4426950408889634f;
  const float nb = -(32.f * mq * mk) * c2;
  const f32x4 nbv = {nb, nb, nb, nb};
  const float lam = __expf(l0) - __expf(l1) + 0.2f;
  const bool on[2] = {true, true};
  for (int pr = F.vcu; pr < 256; pr += F.G) {
    const int bh = pr >> 3, sp = pr & 7, b = bh >> 3, hd = bh & 7;
#pragma unroll 1
    for (int ui = 0; ui < 2; ++ui) {
      const int qb = ui ? 15 - sp : sp;
      const int NT = 4 * (qb + 1);
      const bf16_t* Kg = H + (size_t)(b * SEQ) * HC + OFF_DK + hd * 64;
      const bf16_t* Vg = H + (size_t)(b * SEQ) * HC + OFF_DV + hd * 64;
      f32x4 o1[4][2];
#pragma unroll 1
      for (int mp = 0; mp < 2; ++mp) {
        bf16x8 qf[2][1];
#pragma unroll
        for (int qt = 0; qt < 2; ++qt) qf[qt][0] = *(const GAS bf16x8*)(H + (size_t)(b * SEQ + qb * 256 + w * 32 + qt * 16 + r) * HC + OFF_DQ + hd * 64 + mp * 32 + g * 8);
        f32x4 o[4][2]; zero42(o);
        f32x4 os[2] = {{0.f, 0.f, 0.f, 0.f}, {0.f, 0.f, 0.f, 0.f}};
        v4u krA = tile_ld(Kg, HC, tid), vrA = tile_ld(Vg, HC, tid);
        v4u krB = tile_ld(Kg + (size_t)64 * HC, HC, tid), vrB = tile_ld(Vg + (size_t)64 * HC, HC, tid);
#pragma unroll 1
        for (int t = 0; t < NT; t += 2) {
#pragma unroll
          for (int hf = 0; hf < 2; ++hf) {
            const int tt = t + hf;
            const lbf KBt = (lbf)(F.lds + hf * 2 * RB), VBt = KBt + 64 * RP;
            tile_st(KBt, hf ? krB : krA, tid); tile_st(VBt, hf ? vrB : vrA, tid);
            AT_BAR();
            if (tt + 2 < NT) { const v4u k2 = tile_ld(Kg + (size_t)(tt + 2) * 64 * HC, HC, tid), v2 = tile_ld(Vg + (size_t)(tt + 2) * 64 * HC, HC, tid);
              if (hf) { krB = k2; vrB = v2; } else { krA = k2; vrA = v2; } }
            const int koff = tt * 64 - (qb * 256 + w * 32);
            if (tt >= NT - 4) attn_tile<1, 2>(o, os, qf, KBt, mp * 32, VBt, nbv, on, 0, koff, lane);
            else attn_tile<1, 0>(o, os, qf, KBt, mp * 32, VBt, nbv, on, 0, koff, lane);
          }
        }
        if (mp == 0) {
#pragma unroll
          for (int qt = 0; qt < 2; ++qt) { const float i1 = 1.f / os[qt][0];
#pragma unroll
            for (int dt = 0; dt < 4; ++dt) o1[dt][qt] = o[dt][qt] * i1; }
        } else {
#pragma unroll
          for (int qt = 0; qt < 2; ++qt) {
            const float i2 = lam / os[qt][0];
            float ss = 0.f;
#pragma unroll
            for (int dt = 0; dt < 4; ++dt)
#pragma unroll
              for (int i = 0; i < 4; ++i) { const float v = o1[dt][qt][i] - o[dt][qt][i] * i2; o1[dt][qt][i] = v; ss += v * v; }
            ss += __shfl_xor(ss, 16, 64); ss += __shfl_xor(ss, 32, 64);
            const float rr = rsqrtf(ss * (1.f / 64.f) + 1e-6f) * 0.8f;
            bf16_t* op = CAT + (size_t)(b * SEQ + qb * 256 + w * 32 + qt * 16 + r) * DM + hd * 64;
#pragma unroll
            for (int dt = 0; dt < 4; ++dt) { const int d0 = dt * 16 + g * 4; const f32x4 sg = *(const f32x4*)(p.dsubln + d0);
              v2u wv; wv.x = pk2(o1[dt][qt][0] * rr * sg[0], o1[dt][qt][1] * rr * sg[1]); wv.y = pk2(o1[dt][qt][2] * rr * sg[2], o1[dt][qt][3] * rr * sg[3]);
              *(GAS v2u*)(op + d0) = wv; }
          }
        }
        AT_BAR();
      }
    }
  }
}

__device__ __forceinline__ void nsa_finish(f32x4 (&comb)[4][2], const f32x4 (&o)[4][2], const f32x4 (&os)[2], const float (&gate)[2], bool normalised) {
#pragma unroll
  for (int qt = 0; qt < 2; ++qt) {
    const float f = normalised ? gate[qt] : gate[qt] / os[qt][0];
#pragma unroll
    for (int dt = 0; dt < 4; ++dt) comb[dt][qt] += o[dt][qt] * f;
  }
}
__device__ __forceinline__ void phase_nsa(PREF p, Frame& F) {
  const int lane = fresh_lane(), w = F.wave, tid = F.tid;
  const int r = lane & 15, g = lane >> 4;
  const bf16_t* H = (const bf16_t*)(p.ws + WS_H);
  const float* GATES = (const float*)(p.ws + WS_GATES);
  bf16_t* CAT = (bf16_t*)(p.ws + WS_CAT);
  float mq = 0.f, mk0 = 0.f, mk1 = 0.f, mk2 = 0.f;
  for (int i = 0; i < 64; i++) { mq = fmaxf(mq, fabsf(p.nq_norm[i])); mk0 = fmaxf(mk0, fabsf(p.nk_norm[i])); mk1 = fmaxf(mk1, fabsf(p.nk_norm[64 + i])); mk2 = fmaxf(mk2, fabsf(p.nk_norm[128 + i])); }
  const float c2 = 0.125f * 1.4426950408889634f;
  const float nb0 = -(64.f * mq * mk0) * c2, nb1 = -(64.f * mq * mk1) * c2, nb2 = -(64.f * mq * mk2) * c2;
  LAS float* IMP = (LAS float*)(F.lds + 12 * RB);
  LAS unsigned char* SELB = (LAS unsigned char*)(F.lds + 12 * RB + 64 * 65 * 4);
  const int hj = w >> 1, th = w & 1;
  for (int pr = F.vcu; pr < 256; pr += F.G) {
    const int bg = pr >> 5, sp = pr & 31, b = bg >> 1, gq = bg & 1;
#pragma unroll 1
    for (int ui = 0; ui < 2; ++ui) {
      const int blk = ui ? 63 - sp : sp;
      const int hh = gq * 4 + hj;
      const int tokw = b * SEQ + blk * 64 + th * 32;
      bf16x8 qf[2][2];
      float gate0[2], gate1[2], gate2[2];
#pragma unroll
      for (int qt = 0; qt < 2; ++qt) { const bf16_t* qp = H + (size_t)(tokw + qt * 16 + r) * HC + OFF_NQ + hh * 64 + g * 8;
        qf[qt][0] = *(const GAS bf16x8*)qp; qf[qt][1] = *(const GAS bf16x8*)(qp + 32);
        const float* gp = GATES + (size_t)(tokw + qt * 16 + r) * 24 + hh * 3; gate0[qt] = gp[0]; gate1[qt] = gp[1]; gate2[qt] = gp[2]; }
      f32x4 comb[4][2]; zero42(comb);
      const int nct = (4 * blk + 3 + 63) >> 6;
      {
        const bf16_t* KC = (const bf16_t*)(p.ws + WS_KCMPB) + (size_t)(b * 2 + gq) * 256 * 64;
        const bf16_t* VC = (const bf16_t*)(p.ws + WS_VCMPB) + (size_t)(b * 2 + gq) * 256 * 64;
        for (int t4 = 0; t4 < nct; ++t4) { tile_st((lbf)(F.lds + t4 * RB), tile_ld(KC + t4 * 4096, 64, tid), tid); tile_st((lbf)(F.lds + (4 + t4) * RB), tile_ld(VC + t4 * 4096, 64, tid), tid); }
        for (int e = tid; e < 64 * 65; e += NWAVES * 64) IMP[e] = 0.f;
        AT_BAR();
        const f32x4 nbv0 = {nb0, nb0, nb0, nb0};
        int cmax[2];
#pragma unroll
        for (int qt = 0; qt < 2; ++qt) { const int pos = blk * 64 + th * 32 + qt * 16 + r; cmax[qt] = (pos >= 31) ? ((pos - 31) >> 4) : -1; }
        float lsum[2] = {0.f, 0.f};
        for (int t4 = 0; t4 < nct; ++t4) {
          f32x4 st[4][2]; fill42(st, nbv0);
          qk_tile<2>(st, (lbf)(F.lds + t4 * RB), 0, qf, lane); exp42(st);
#pragma unroll
          for (int kt = 0; kt < 4; ++kt)
#pragma unroll
            for (int qt = 0; qt < 2; ++qt)
#pragma unroll
              for (int i = 0; i < 4; ++i) { const int c = t4 * 64 + kt * 16 + g * 4 + i; if (c <= cmax[qt]) lsum[qt] += st[kt][qt][i]; }
        }
        float linv[2];
#pragma unroll
        for (int qt = 0; qt < 2; ++qt) { float s = lsum[qt]; s += __shfl_xor(s, 16, 64); s += __shfl_xor(s, 32, 64); linv[qt] = (cmax[qt] >= 0) ? 1.f / s : 0.f; }
        f32x4 o[4][2]; zero42(o);
        f32x4 osd[2] = {{0.f, 0.f, 0.f, 0.f}, {0.f, 0.f, 0.f, 0.f}};
        for (int t4 = 0; t4 < nct; ++t4) {
          f32x4 st[4][2]; fill42(st, nbv0);
          qk_tile<2>(st, (lbf)(F.lds + t4 * RB), 0, qf, lane); exp42(st);
#pragma unroll
          for (int kt = 0; kt < 4; ++kt)
#pragma unroll
            for (int qt = 0; qt < 2; ++qt) {
              float gs = 0.f;
#pragma unroll
              for (int i = 0; i < 4; ++i) { const int c = t4 * 64 + kt * 16 + g * 4 + i;
                const float e = (c <= cmax[qt]) ? st[kt][qt][i] * linv[qt] : 0.f;
                st[kt][qt][i] = e; gs += e; }
              const int ti = th * 32 + qt * 16 + r, j = t4 * 16 + kt * 4 + g;
              if (gs != 0.f) { __hip_atomic_fetch_add(IMP + ti * 65 + j, gs, __ATOMIC_RELAXED, __HIP_MEMORY_SCOPE_WORKGROUP); if (j < 63 && st[kt][qt][3] != 0.f) __hip_atomic_fetch_add(IMP + ti * 65 + j + 1, st[kt][qt][3], __ATOMIC_RELAXED, __HIP_MEMORY_SCOPE_WORKGROUP); }
            }
          bf16x8 pb[2][2]; pack_p(pb, st);
          pv_apply(o, osd, pb, (lbf)(F.lds + (4 + t4) * RB), lane);
        }
        nsa_finish(comb, o, osd, gate0, true);
      }
      AT_BAR();
      {
        const int ti = tid >> 3, jb = (tid & 7) * 8;
        float mine[8]; int rank[8];
#pragma unroll
        for (int u = 0; u < 8; ++u) { const int j = jb + u; float v = IMP[ti * 65 + j]; if (j == blk || j == 0) v = 1e4f; else if (j > blk) v = -1e30f; mine[u] = v; rank[u] = 0; }
        for (int i = 0; i < 64; ++i) { float v = IMP[ti * 65 + i]; if (i == blk || i == 0) v = 1e4f; else if (i > blk) v = -1e30f;
#pragma unroll
          for (int u = 0; u < 8; ++u) rank[u] += (v > mine[u] || (v == mine[u] && i < jb + u)) ? 1 : 0; }
        unsigned bits = 0;
#pragma unroll
        for (int u = 0; u < 8; ++u) bits |= (rank[u] < 16 ? 1u : 0u) << u;
        SELB[ti * 8 + (tid & 7)] = (unsigned char)bits;
      }
      AT_BAR();
      unsigned long long selm[2];
#pragma unroll
      for (int qt = 0; qt < 2; ++qt) { const int ti = th * 32 + qt * 16 + r; const LAS unsigned* sp2 = (const LAS unsigned*)(SELB + ti * 8); selm[qt] = (unsigned long long)sp2[0] | ((unsigned long long)sp2[1] << 32); }
#pragma unroll 1
      for (int br = 1; br < 3; ++br) {
        const int kcol = OFF_NKV + ((br * 2 + 0) * 2 + gq) * 64, vcol = OFF_NKV + ((br * 2 + 1) * 2 + gq) * 64;
        const float nbb = (br == 1) ? nb1 : nb2;
        const f32x4 nbv = {nbb, nbb, nbb, nbb};
        const int t_lo = (br == 1) ? 0 : (blk > 8 ? blk - 8 : 0);
        const bf16_t* Kg = H + (size_t)(b * SEQ) * HC + kcol;
        const bf16_t* Vg = H + (size_t)(b * SEQ) * HC + vcol;
        f32x4 o[4][2]; zero42(o);
        f32x4 os[2] = {{0.f, 0.f, 0.f, 0.f}, {0.f, 0.f, 0.f, 0.f}};
        v4u krA = tile_ld(Kg + (size_t)t_lo * 64 * HC, HC, tid), vrA = tile_ld(Vg + (size_t)t_lo * 64 * HC, HC, tid);
        v4u krB = krA, vrB = vrA;
        if (t_lo < blk) { krB = tile_ld(Kg + (size_t)(t_lo + 1) * 64 * HC, HC, tid); vrB = tile_ld(Vg + (size_t)(t_lo + 1) * 64 * HC, HC, tid); }
#pragma unroll 1
        for (int t0 = t_lo; t0 <= blk; t0 += 2) {
#pragma unroll
          for (int hf = 0; hf < 2; ++hf) {
            const int t = t0 + hf;
            if (t <= blk) {
              const lbf KBt = (lbf)(F.lds + (8 + hf * 2) * RB), VBt = KBt + 64 * RP;
              tile_st(KBt, hf ? krB : krA, tid); tile_st(VBt, hf ? vrB : vrA, tid);
              AT_BAR();
              if (t + 2 <= blk) { const v4u k2 = tile_ld(Kg + (size_t)(t + 2) * 64 * HC, HC, tid), v2 = tile_ld(Vg + (size_t)(t + 2) * 64 * HC, HC, tid);
                if (hf) { krB = k2; vrB = v2; } else { krA = k2; vrA = v2; } }
              const bool on[2] = {((selm[0] >> t) & 1ull) != 0ull, ((selm[1] >> t) & 1ull) != 0ull};
              const int qq0 = th * 32;
              if (br == 1) {
                if (__any((int)(on[0] || on[1]))) {
                  if (t == blk) attn_tile<2, 3>(o, os, qf, KBt, 0, VBt, nbv, on, qq0, 0, lane);
                  else if (__all((int)(on[0] && on[1]))) attn_tile<2, 0>(o, os, qf, KBt, 0, VBt, nbv, on, qq0, 0, lane);
                  else attn_tile<2, 1>(o, os, qf, KBt, 0, VBt, nbv, on, qq0, 0, lane);
                }
              } else {
                if (t == blk) attn_tile<2, 2>(o, os, qf, KBt, 0, VBt, nbv, on, qq0, 0, lane);
                else if (t == blk - 8) attn_tile<2, 4>(o, os, qf, KBt, 0, VBt, nbv, on, qq0, 0, lane);
                else attn_tile<2, 0>(o, os, qf, KBt, 0, VBt, nbv, on, qq0, 0, lane);
              }
            }
          }
        }
        nsa_finish(comb, o, os, (br == 1) ? gate1 : gate2, false);
        AT_BAR();
      }
#pragma unroll
      for (int qt = 0; qt < 2; ++qt) { bf16_t* op = CAT + (size_t)(tokw + qt * 16 + r) * DM + 512 + hh * 64;
#pragma unroll
        for (int dt = 0; dt < 4; ++dt) { const int d0 = dt * 16 + g * 4; v2u wv; wv.x = pk2(comb[dt][qt][0], comb[dt][qt][1]); wv.y = pk2(comb[dt][qt][2], comb[dt][qt][3]); *(GAS v2u*)(op + d0) = wv; } }
    }
  }
}

__global__ void __launch_bounds__(NWAVES * 64, 2) mk_fwd(P p_arg) {
  extern __shared__ __attribute__((aligned(16))) unsigned char lds[];
  Frame F;
  F.lds = (LAS unsigned char*)lds;
  F.MISC = (volatile LAS unsigned*)(F.lds + MISC_OFF);
  F.tid = threadIdx.x; F.lane = F.tid & 63; F.wave = __builtin_amdgcn_readfirstlane(F.tid >> 6);
  F.G = gridDim.x; { const int bx = blockIdx.x; F.vcu = (F.G % 8 == 0) ? (bx % 8) * (F.G / 8) + bx / 8 : bx; }
  unsigned char* const ws = p_arg.ws;
  F.ctl = (gu32*)(ws + WS_CTL);
  for (int u = F.tid; u < (LDS_BYTES - LDSCTL_OFF) / 4; u += NWAVES * 64) ((LAS unsigned*)(F.lds + LDSCTL_OFF))[u] = 0u;
  __syncthreads();
  XcdBarrier bar = xcd_barrier_post((unsigned*)(F.ctl + CW_BAR) + p_arg.pad * XCD_BAR_WORDS, F.MISC + 8);
  const int lo = p_arg.ph_lo, hi = p_arg.ph_hi;
#ifndef PHMASK
#define PHMASK 0xffffffffu
#endif
#define IN(k) (lo <= (k) && (k) < hi && ((PHMASK >> (k)) & 1u))
#define SEAM(k) do { if (IN(k) && IN((k) + 1)) xcd_barrier(bar); } while (0)
#ifdef PROBE_PH
  F.pr_t0 = 0; F.pr_t1 = 0;
#endif

  PROBE_MARK(0); if (IN(0)) { phase_prologue(KP, F); } SEAM(0);
  PROBE_MARK(1); if (IN(1)) {
    pg8::Gemm g{(const bf16_t*)(ws + WS_XN), (const bf16_t*)(ws + WS_WIN), DM};
    pg8::StaticOrder S; S.init(T_TOK, 3072, F.G, (int)blockIdx.x);
    PREF p = KP; EpiInProj E{(bf16_t*)(ws + WS_H), (float*)(ws + WS_GATES), p.dq_norm, p.dk_norm, p.nq_norm, p.nk_norm, p.gate_bias};
    pg8::gemm_phase<EpiInProj, pg8::StaticOrder, true>(F.lds + RING_OFF, g, S, E);
  } SEAM(1);
  PROBE_MARK(2); if (IN(2)) { phase_compress(KP, F); phase_diffattn(KP, F); } SEAM(2);
  PROBE_MARK(3); if (IN(3)) { phase_nsa(KP, F); } SEAM(3);
  PROBE_MARK(4); if (IN(4)) {
    pg8::Gemm g{(const bf16_t*)(ws + WS_CAT), (const bf16_t*)(ws + WS_WOUT), DM};
    pg8::StaticOrder S; S.init(T_TOK, DM, F.G, (int)blockIdx.x);
    PREF p = KP; EpiResid E{p.x, p.out, nullptr};
    pg8::gemm_phase<EpiResid, pg8::StaticOrder, false>(F.lds + RING_OFF, g, S, E);
  } SEAM(4);
#define MOE_PHASES(layer, pb) do { \
    PROBE_MARK(pb); if (IN(pb)) { phase_router(KP, F, layer); } SEAM(pb); \
    PROBE_MARK(pb + 1); if (IN(pb + 1)) { \
      pg8::Gemm g{(const bf16_t*)(ws + WS_XN2), (const bf16_t*)(ws + WS_EGU), DM}; \
      pg8::moe_order_setup((LAS int*)(F.lds + MISC_OFF + 256), (const unsigned*)(ws + WS_CTL) + CW_CNT + layer * 32 * 64); pg8::MoeOrder<2, true> S{(const LAS int*)(F.lds + MISC_OFF + 256), (const int*)(ws + WS_LIST), F.G, (int)blockIdx.x}; \
      EpiMoeGU E{(bf16_t*)(ws + WS_HID)}; \
      pg8::gemm_phase<EpiMoeGU, pg8::MoeOrder<2, true>, true>(F.lds + RING_OFF, g, S, E); \
    } SEAM(pb + 1); \
    PROBE_MARK(pb + 2); if (IN(pb + 2)) { \
      int k256 = 256; asm volatile("" : "+s"(k256)); \
      pg8::Gemm g{(const bf16_t*)(ws + WS_HID), (const bf16_t*)(ws + WS_EDN), k256}; \
      pg8::moe_order_setup((LAS int*)(F.lds + MISC_OFF + 256), (const unsigned*)(ws + WS_CTL) + CW_CNT + layer * 32 * 64); pg8::MoeOrder<4, false> S{(const LAS int*)(F.lds + MISC_OFF + 256), (const int*)(ws + WS_LIST), F.G, (int)blockIdx.x}; \
      PREF p = KP; EpiMoeDown E{p.out, (bf16_t*)(ws + WS_Y1), (const int*)(ws + WS_LIST), (const float*)(ws + WS_PGATE), (LAS int*)(F.lds + 132096)}; \
      pg8::gemm_phase<EpiMoeDown, pg8::MoeOrder<4, false>, true>(F.lds + RING_OFF, g, S, E); \
    } SEAM(pb + 2); \
  } while (0)
  MOE_PHASES(0, 5);
  PROBE_MARK(8); if (IN(8)) { phase_rwkv_prep(KP, F); } SEAM(8);
  PROBE_MARK(9); if (IN(9)) {
    pg8::Gemm g{(const bf16_t*)(ws + WS_S0 + 3 * SLOT), (const bf16_t*)(ws + WS_WL1), DM};
    pg8::TallOrder S; S.init(3, 1, F.G, (int)blockIdx.x);
    EpiLora1 E{(bf16_t*)(ws + WS_TMP)};
    pg8::gemm_phase<EpiLora1, pg8::TallOrder, false>(F.lds + RING_OFF, g, S, E);
  } SEAM(9);
  PROBE_MARK(10); if (IN(10)) {
    pg8::Gemm g{(const bf16_t*)(ws + WS_S0), (const bf16_t*)(ws + WS_WRKV), DM};
    pg8::TallOrder S; S.init(3, 4, F.G, (int)blockIdx.x);
    EpiRKV E{ws};
    pg8::gemm_phase<EpiRKV, pg8::TallOrder, true>(F.lds + RING_OFF, g, S, E);
  } SEAM(10);
  PROBE_MARK(11); if (IN(11)) {
    int k384 = 384; asm volatile("" : "+s"(k384));
    pg8::Gemm g{(const bf16_t*)(ws + WS_TMP), (const bf16_t*)(ws + WS_WL2), k384};
    pg8::StaticOrder S; S.init(T_TOK, 3072, F.G, (int)blockIdx.x);
    PREF p = KP; EpiLora2 E{ws, p.w0, p.a0};
    pg8::gemm_phase<EpiLora2, pg8::StaticOrder, true>(F.lds + RING_OFF, g, S, E);
  } SEAM(11);
  PROBE_MARK(12); if (IN(12)) { phase_rwkv_r1(KP, F); } SEAM(12);
  PROBE_MARK(13); if (IN(13)) { phase_rwkv_r2(KP, F); } SEAM(13);
  PROBE_MARK(14); if (IN(14)) { phase_rwkv_r3(KP, F); } SEAM(14);
  PROBE_MARK(15); if (IN(15)) {
    pg8::Gemm g{(const bf16_t*)(ws + WS_S0 + 3 * SLOT), (const bf16_t*)(ws + WS_WO), DM};
    pg8::StaticOrder S; S.init(T_TOK, DM, F.G, (int)blockIdx.x);
    PREF p = KP; EpiResid E{p.out, p.out, (const bf16_t*)(ws + WS_Y1)};
    pg8::gemm_phase<EpiResid, pg8::StaticOrder, false>(F.lds + RING_OFF, g, S, E);
  } SEAM(15);
  MOE_PHASES(1, 16);
#undef MOE_PHASES
  PROBE_MARK(19); if (IN(19)) { phase_final(KP, F); }
  PROBE_MARK(20);
#ifdef PROBE_PH
  { const unsigned long long dur = (F.pr_t1 - F.pr_t0) * PROBE_MUL, t0 = __builtin_amdgcn_s_memrealtime(); while (__builtin_amdgcn_s_memrealtime() - t0 < dur) __builtin_amdgcn_s_sleep(8); }
#endif
#undef IN
#undef SEAM
}

static void launch_mk(P p, int lo, int hi, int li, int grid, hipStream_t st) {
  p.ph_lo = lo; p.ph_hi = hi; p.pad = li;
  hipLaunchKernelGGL(mk_fwd, dim3(grid), dim3(NWAVES * 64), LDS_BYTES, st, p);
}

extern "C" void kernel_launch(void* const* d_in, const int* in_sizes, int n_in, void* d_out, int out_size, void* d_ws,
                              size_t ws_size, hipStream_t stream) {
  static int grid = 0;
  if (grid == 0) {
    if (n_in != 40 || ws_size < WS_END) { fprintf(stderr, "kernel_launch: bad n_in %d or ws_size %zu (< %zu)\n", n_in, ws_size, (size_t)WS_END); grid = -1; return; }
    int dev = 0, cus = 0;
    if (hipGetDevice(&dev) != hipSuccess || hipDeviceGetAttribute(&cus, hipDeviceAttributeMultiprocessorCount, dev) != hipSuccess) { grid = -1; return; }
    if (hipFuncSetAttribute((const void*)mk_fwd, hipFuncAttributeMaxDynamicSharedMemorySize, LDS_BYTES) != hipSuccess) { grid = -1; return; }
    grid = cus;
  }
  if (grid < 0) return;
  P p{};
  const float* const* in = (const float* const*)d_in;
  p.x = in[0]; p.mix_norm = in[1]; p.w_in = in[2]; p.gate_bias = in[3]; p.dq_norm = in[4]; p.dk_norm = in[5];
  p.dlam = in[6]; p.dsubln = in[7]; p.nq_norm = in[8]; p.nk_norm = in[9]; p.cmp_pe = in[10]; p.cmp_w1 = in[11];
  p.cmp_w2 = in[12]; p.w_out = in[13]; p.rmix = in[14]; p.w_r = in[15]; p.w_k = in[16]; p.w_v = in[17];
  p.w0 = in[18]; p.w1 = in[19]; p.w2 = in[20]; p.a0 = in[21]; p.a1 = in[22]; p.a2 = in[23]; p.g1 = in[24]; p.g2 = in[25];
  p.k_k = in[26]; p.k_a = in[27]; p.r_k = in[28]; p.ln_w = in[29]; p.ln_b = in[30]; p.w_o = in[31];
  p.ffn_norm = in[32]; p.rg_w = in[33]; p.rg_b = in[34]; p.re_w = in[35]; p.re_b = in[36];
  p.e_gate = in[37]; p.e_up = in[38]; p.e_down = in[39];
  p.out = (float*)d_out;
  p.ws = (unsigned char*)d_ws;
  unsigned char* ws = p.ws;
  (void)hipMemsetAsync(ws + WS_CTL, 0, CTL_ZERO_BYTES, stream);
  launch_mk(p, 0, 20, 0, grid, stream);
}
```

```cpp
#include <hip/hip_runtime.h>
#include <cstdio>
#include <cstdint>

#define T_TOK 16384
#define DM 1024
#define SEQ 4096
#define NBATCH 4
#define INC 2840
#define HC 2816
#define OFF_DQ 0
#define OFF_DK 512
#define OFF_DV 1024
#define OFF_NQ 1536
#define OFF_NKV 2048
#define OFF_NG 2816
#define NCMP 255
#define CAP 16384

#define GAS __attribute__((address_space(1)))
#define LAS __attribute__((address_space(3)))
typedef unsigned short bf16_t;
typedef unsigned v4u __attribute__((ext_vector_type(4)));
typedef unsigned v2u __attribute__((ext_vector_type(2)));
typedef float f32x4 __attribute__((ext_vector_type(4)));
typedef short bf16x8 __attribute__((ext_vector_type(8)));
typedef GAS unsigned gu32;
#define RLX_AGENT __ATOMIC_RELAXED, __HIP_MEMORY_SCOPE_AGENT
#define LDS_WAIT() asm volatile("s_waitcnt lgkmcnt(0)" ::: "memory")
#define VM_WAIT() asm volatile("s_waitcnt vmcnt(0)" ::: "memory")

__device__ __forceinline__ float bf2f(bf16_t v) { return __uint_as_float(((unsigned)v) << 16); }
__device__ __forceinline__ unsigned f2bf(float f) { unsigned u = __builtin_bit_cast(unsigned, f); return (u + 0x7fffu + ((u >> 16) & 1u)) >> 16; }
typedef float f32x2_t __attribute__((ext_vector_type(2))); typedef __bf16 bf16x2_t __attribute__((ext_vector_type(2)));
__device__ __forceinline__ unsigned pk2(float lo, float hi) { const f32x2_t v = {lo, hi}; return __builtin_bit_cast(unsigned, __builtin_convertvector(v, bf16x2_t)); }
__device__ __forceinline__ float wave_sum(float v) {
#pragma unroll
  for (int o = 32; o >= 1; o >>= 1) v += __shfl_xor(v, o, 64);
  return v;
}
__device__ __forceinline__ float wave_sum_dpp(float v) {
  v += __builtin_bit_cast(float, __builtin_amdgcn_update_dpp(0, __builtin_bit_cast(int, v), 0xB1, 0xf, 0xf, false));
  v += __builtin_bit_cast(float, __builtin_amdgcn_update_dpp(0, __builtin_bit_cast(int, v), 0x4E, 0xf, 0xf, false));
  v += __builtin_bit_cast(float, __builtin_amdgcn_update_dpp(0, __builtin_bit_cast(int, v), 0x141, 0xf, 0xf, false));
  v += __builtin_bit_cast(float, __builtin_amdgcn_update_dpp(0, __builtin_bit_cast(int, v), 0x140, 0xf, 0xf, false));
  const int iv = __builtin_bit_cast(int, v);
  return (__builtin_bit_cast(float, __builtin_amdgcn_readlane(iv, 0)) + __builtin_bit_cast(float, __builtin_amdgcn_readlane(iv, 16))) +
         (__builtin_bit_cast(float, __builtin_amdgcn_readlane(iv, 32)) + __builtin_bit_cast(float, __builtin_amdgcn_readlane(iv, 48)));
}
__device__ __forceinline__ int fresh_lane() { int l; asm volatile("v_mbcnt_lo_u32_b32 %0, -1, 0\n\tv_mbcnt_hi_u32_b32 %0, -1, %0" : "=v"(l)); return l; }
__device__ __forceinline__ float uniformf(float v) { return __builtin_bit_cast(float, __builtin_amdgcn_readfirstlane(__builtin_bit_cast(int, v))); }
__device__ __forceinline__ float sigmoidf_(float x) { return 1.f / (1.f + __expf(-x)); }
__device__ __forceinline__ float softplusf_(float x) { return fmaxf(x, 0.f) + __logf(1.f + __expf(-fabsf(x))); }
__device__ __forceinline__ float gelu_tanh(float x) {
  float u = 0.7978845608028654f * (x + 0.044715f * x * x * x);
  return 0.5f * x * (1.f + tanhf(u));
}

constexpr size_t MiB = 1u << 20;
constexpr size_t WS_CTL = 0, CTL_ZERO_BYTES = 1 * MiB;
constexpr size_t WS_WIN = 1 * MiB;
constexpr size_t WS_WOUT = 7 * MiB;
constexpr size_t WS_WRKV = 9 * MiB;
constexpr size_t WS_WO = 15 * MiB;
constexpr size_t WS_WL1 = 17 * MiB;
constexpr size_t WS_WL2 = 19 * MiB;
constexpr size_t WS_EGU = 22 * MiB;
constexpr size_t WS_EDN = 54 * MiB;
constexpr size_t WS_ACT = 70 * MiB;
constexpr size_t WS_XN = WS_ACT;
constexpr size_t WS_H = WS_ACT + 32 * MiB;
constexpr size_t WS_GATES = WS_ACT + 120 * MiB;
constexpr size_t WS_CAT = WS_ACT + 122 * MiB;
constexpr size_t WS_KCMPB = WS_ACT + 154 * MiB;
constexpr size_t WS_VCMPB = WS_ACT + 155 * MiB;
constexpr size_t WS_CW1 = 21 * MiB + 256 * 1024;
constexpr size_t WS_XN2 = WS_ACT;
constexpr size_t WS_HID = WS_ACT + 32 * MiB;
constexpr size_t WS_Y1 = WS_EGU;
constexpr size_t WS_LIST = WS_ACT + 156 * MiB;
constexpr size_t WS_PGATE = WS_ACT + 158 * MiB;
constexpr size_t WS_XN2F = WS_ACT;
constexpr size_t WS_GUF = WS_ACT + 64 * MiB;
constexpr size_t WS_S0 = WS_ACT;
constexpr size_t WS_TMP = WS_ACT + 192 * MiB;
constexpr size_t WS_END = WS_ACT + 204 * MiB;
constexpr size_t SLOT = 32 * MiB;
constexpr int CW_BAR = 4096;
constexpr int CW_CNT = 32768;

namespace pg8 {
#define PG8_LAS __attribute__((address_space(3)))
typedef unsigned u32x4 __attribute__((ext_vector_type(4)));
constexpr int BM = 256, BK = 64, HALF = 128, HTB = HALF * BK * 2  , STAGE_BYTES = 8 * HTB, NXCD = 8, WGM = 8;

__host__ __device__ __forceinline__ int lds_byte(int r, int c) { const int st = (r >> 4) * 2 + (c >> 5), rr = r & 15, cc = c & 31, ob = rr * 64 + cc * 2; return st * 1024 + (ob ^ (((ob >> 9) & 1) << 5)); }
__host__ __device__ __forceinline__ void stage_rc(int b, int& R, int& C) { const int st = b / 1024, sb = b % 1024, swz = sb ^ (((sb >> 9) & 1) << 5); R = (st >> 1) * 16 + swz / 64; C = (st & 1) * 32 + (swz % 64) / 2; }
__host__ __device__ __forceinline__ int perm32(int rho) { const int n = rho >> 4, i = rho & 15; return 8 * (i >> 2) + 4 * n + (i & 3); }

struct Unit { int pm, pn, e, nrows, rt, par; };
struct Gemm { const bf16_t* A; const bf16_t* Bt; int K; int lda; };

__device__ __forceinline__ void static_map(int L, int nM, int nN, int& pm, int& pn) {
    const int nwg = nM * nN;
    int wgid = L; { const int q = nwg / NXCD, r = nwg % NXCD, xcd = wgid % NXCD, off = wgid / NXCD; wgid = (xcd < r ? xcd * (q + 1) : r * (q + 1) + (xcd - r) * q) + off; }
    const int nig = WGM * nN, gid = wgid / nig, fm = gid * WGM, gsz = (nM - fm) < WGM ? (nM - fm) : WGM;
    pm = fm + ((wgid % nig) % gsz); pn = (wgid % nig) / gsz;
}
struct StaticOrder {
    int nM, nN, G, c;
    __device__ void init(int M, int N, int G_, int c_) { nM = M / BM; nN = N / BM; G = G_; c = c_; }
    __device__ __forceinline__ bool next(int i, Unit& u) const {
        const int L = i * G + c; if (L >= nM * nN) return false;
        static_map(L, nM, nN, u.pm, u.pn); u.e = 0; u.nrows = 256; u.rt = 0; return true;
    }
    __device__ __forceinline__ unsigned rowoff(const Unit& u, int r, int C, int K) const { return (unsigned)((u.pm * BM + r) * K + C) * 2u; }
};
struct TallOrder {
    int nM, nN, G, c;
    __device__ void init(int ngemm, int nN_, int G_, int c_) { nM = 64 * ngemm; nN = nN_; G = G_; c = c_; }
    __device__ __forceinline__ bool next(int i, Unit& u) const {
        const int L = i * G + c; if (L >= nM * nN) return false;
        int pn; static_map(L, nM, nN, u.pm, pn); u.pn = (u.pm >> 6) * nN + pn; u.e = 0; u.nrows = 256; u.rt = 0; return true;
    }
    __device__ __forceinline__ unsigned rowoff(const Unit& u, int r, int C, int K) const { return (unsigned)((u.pm * BM + r) * K + C) * 2u; }
};


template <int NCOL, bool GATHER>
struct MoeOrder {
    const PG8_LAS int* tab;
    const int* list; int G, c;
    __device__ __forceinline__ bool next(int i, Unit& u) const {
        const int L = i * G + c; const int R = L / NCOL, j = L - R * NCOL;
        if (R >= tab[32]) return false;
        int e = 0;
#pragma unroll
        for (int s = 16; s >= 1; s >>= 1) { if (tab[e + s] <= R) e += s; }
        const int ce = tab[33 + e];
        u.pm = R; u.rt = R - tab[e]; u.e = e; u.pn = e * NCOL + j; u.nrows = ce - u.rt * 256; return true;
    }
    __device__ __forceinline__ unsigned rowoff(const Unit& u, int r, int C, int K) const {
        if (GATHER) { const int idx = (r < u.nrows) ? u.rt * 256 + r : 0; const int pr = list[(size_t)u.e * CAP + idx]; return (unsigned)((pr >> 1) * K + C) * 2u; }
        return (unsigned)((u.pm * BM + r) * K + C) * 2u;
    }
};
__device__ __forceinline__ void moe_order_setup(PG8_LAS int* tab, const unsigned* cnt) {
    if (threadIdx.x < 32) tab[33 + threadIdx.x] = (int)__hip_atomic_load(cnt + threadIdx.x * 64, __ATOMIC_RELAXED, __HIP_MEMORY_SCOPE_AGENT);
    __syncthreads();
    if (threadIdx.x == 0) { int pre = 0; for (int e = 0; e < 32; ++e) { tab[e] = pre; pre += (tab[33 + e] + 255) >> 8; } tab[32] = pre; }
    __syncthreads();
}

__device__ __forceinline__ unsigned cvt_pk_bf16(float lo, float hi) { unsigned r; asm volatile("v_cvt_pk_bf16_f32 %0, %1, %2" : "=v"(r) : "v"(lo), "v"(hi)); return r; }
__device__ __forceinline__ u32x4 pack8(const f32x4& a, const f32x4& b) { u32x4 w; w.x = cvt_pk_bf16(a[0], a[1]); w.y = cvt_pk_bf16(a[2], a[3]); w.z = cvt_pk_bf16(b[0], b[1]); w.w = cvt_pk_bf16(b[2], b[3]); return w; }

template <class Epi, class Sched, bool ALIGN_EPI>
__device__ __forceinline__ void gemm_phase(PG8_LAS unsigned char* lds, const Gemm g, const Sched& S, const Epi& E) {
    const int tid = threadIdx.x, wid = __builtin_amdgcn_readfirstlane(tid >> 6), lane = tid & 63, wr = wid >> 2, wc = wid & 3, fr = lane & 15, fq = lane >> 4;
    const int K = g.K, nt = K / BK;
    int RA[2], CA[2]; unsigned voffB[2];
#pragma unroll
    for (int i = 0; i < 2; ++i) { int R, C; stage_rc(tid * 16 + i * 8192, R, C); const int Rb = Epi::PERM ? ((R & ~31) + perm32(R & 31)) : R;
        RA[i] = R; CA[i] = C; voffB[i] = (unsigned)(Rb * K + C) * 2u; }
    const size_t kstep = (size_t)(BK * 2);
    const size_t hstep = (size_t)HALF * K * 2;
    const size_t tstep = 2 * hstep;
    const unsigned ldsw = (unsigned)wid * 1024u;
    const int aoff = lds_byte(wr * 64 + fr, fq * 8), boff = lds_byte(wc * 32 + fr, fq * 8);
    const char* const Abase = (const char*)g.A;
#define PG8_SA(b, h) (((b) * 2 + (h)) * HTB)
#define PG8_SB(b, h) ((4 + (b) * 2 + (h)) * HTB)
#define PG8_STAGE(bufoff, gbase, voff) do { _Pragma("unroll") for (int _i = 0; _i < 2; ++_i) \
        __builtin_amdgcn_global_load_lds((const unsigned*)((const char*)(gbase) + (voff)[_i]), (PG8_LAS unsigned*)(lds + (bufoff) + ldsw + _i * 8192), 16, 0, 0); } while (0)
#define PG8_STAGEA(bufoff, kbyte, o0, o1) do { \
        __builtin_amdgcn_global_load_lds((const unsigned*)(Abase + (size_t)(kbyte) + (o0)), (PG8_LAS unsigned*)(lds + (bufoff) + ldsw), 16, 0, 0); \
        __builtin_amdgcn_global_load_lds((const unsigned*)(Abase + (size_t)(kbyte) + (o1)), (PG8_LAS unsigned*)(lds + (bufoff) + ldsw + 8192), 16, 0, 0); } while (0)
#define PG8_LDA(dst, b, h) do { _Pragma("unroll") for (int m = 0; m < 4; ++m) _Pragma("unroll") for (int k = 0; k < 2; ++k) dst[m][k] = *(const PG8_LAS bf16x8*)(lds + PG8_SA(b, h) + aoff + m * 2048 + k * 1024); } while (0)
#define PG8_LDB(dst, b, h) do { _Pragma("unroll") for (int n = 0; n < 2; ++n) _Pragma("unroll") for (int k = 0; k < 2; ++k) dst[n][k] = *(const PG8_LAS bf16x8*)(lds + PG8_SB(b, h) + boff + n * 2048 + k * 1024); } while (0)
#define PG8_MMA(ai, bj, At, Bt) do { __builtin_amdgcn_s_setprio(1); _Pragma("unroll") for (int m = 0; m < 4; ++m) _Pragma("unroll") for (int n = 0; n < 2; ++n) _Pragma("unroll") for (int k = 0; k < 2; ++k) \
        acc[ai][bj][m][n] = __builtin_amdgcn_mfma_f32_16x16x32_bf16(Bt[n][k], At[m][k], acc[ai][bj][m][n], 0, 0, 0); __builtin_amdgcn_s_setprio(0); } while (0)
#define PG8_WAIT_V(n) asm volatile("s_waitcnt vmcnt(" #n ")" ::: "memory")
#define PG8_WAIT_L(n) asm volatile("s_waitcnt lgkmcnt(" #n ")" ::: "memory")
#define PG8_BAR __builtin_amdgcn_s_barrier()
#define PG8_SCHED __builtin_amdgcn_sched_barrier(0)
    Unit cur, nxt; int ui = 0;
    if (!S.next(0, cur)) return;
    cur.par = 0;
    if constexpr (Epi::HAS_PRE) E.pre(cur);
    f32x4 acc[2][2][4][2];
#pragma unroll
    for (int a = 0; a < 2; ++a)
#pragma unroll
        for (int b = 0; b < 2; ++b)
#pragma unroll
            for (int m = 0; m < 4; ++m)
#pragma unroll
                for (int n = 0; n < 2; ++n) acc[a][b][m][n] = (f32x4){0.f, 0.f, 0.f, 0.f};
    bf16x8 At[4][2], B0[2][2], B1[2][2];
    unsigned c00 = S.rowoff(cur, RA[0], CA[0], g.lda), c01 = S.rowoff(cur, RA[1], CA[1], g.lda), c10 = S.rowoff(cur, HALF + RA[0], CA[0], g.lda), c11 = S.rowoff(cur, HALF + RA[1], CA[1], g.lda);
    unsigned n00, n01, n10, n11;
    const char* cB = (const char*)g.Bt + (size_t)cur.pn * tstep;
    PG8_STAGE(PG8_SB(0, 0), cB, voffB); PG8_STAGE(PG8_SB(0, 1), cB + hstep, voffB); PG8_STAGEA(PG8_SA(0, 0), 0, c00, c01); PG8_STAGEA(PG8_SA(0, 1), 0, c10, c11);
    if (wr == 1) PG8_BAR;
    PG8_WAIT_V(2); PG8_BAR;
    PG8_STAGE(PG8_SB(1, 0), cB + kstep, voffB); PG8_STAGEA(PG8_SA(1, 0), kstep, c00, c01); PG8_STAGE(PG8_SB(1, 1), cB + hstep + kstep, voffB);
    PG8_WAIT_V(6); PG8_BAR;
    for (;;) {
        const bool has_next = S.next(ui + 1, nxt);
        const char* nB = has_next ? (const char*)g.Bt + (size_t)nxt.pn * tstep : cB;
        if (has_next) { n00 = S.rowoff(nxt, RA[0], CA[0], g.lda); n01 = S.rowoff(nxt, RA[1], CA[1], g.lda); n10 = S.rowoff(nxt, HALF + RA[0], CA[0], g.lda); n11 = S.rowoff(nxt, HALF + RA[1], CA[1], g.lda); }
        else { n00 = c00; n01 = c01; n10 = c10; n11 = c11; }
        for (int t = 0; t < nt; t += 2) {
            const bool last = (t == nt - 2);
            const size_t k1 = (size_t)(t + 1) * kstep;
            const size_t k2 = last ? 0 : (size_t)(t + 2) * kstep;
            const size_t k3 = k2 + kstep;
            const unsigned a00 = last ? n00 : c00, a01 = last ? n01 : c01, a10 = last ? n10 : c10, a11 = last ? n11 : c11;
            const char* b2 = last ? nB : cB + (size_t)(t + 2) * kstep;
            const char* b3 = b2 + kstep;
            PG8_LDB(B0, 0, 0); PG8_LDB(B1, 0, 1); PG8_SCHED; PG8_LDA(At, 0, 0); PG8_STAGEA(PG8_SA(1, 1), k1, c10, c11);
            PG8_WAIT_V(8); PG8_WAIT_L(0); PG8_BAR; PG8_MMA(0, 0, At, B0); PG8_MMA(0, 1, At, B1); PG8_BAR; PG8_SCHED;
            PG8_LDA(At, 0, 1); PG8_STAGE(PG8_SB(0, 0), b2, voffB); PG8_STAGE(PG8_SB(0, 1), b2 + hstep, voffB); PG8_STAGEA(PG8_SA(0, 0), k2, a00, a01);
            PG8_WAIT_V(8); PG8_WAIT_L(0); PG8_BAR; PG8_MMA(1, 0, At, B0); PG8_MMA(1, 1, At, B1); PG8_BAR; PG8_SCHED;
            PG8_LDB(B0, 1, 0); PG8_LDB(B1, 1, 1); PG8_SCHED; PG8_LDA(At, 1, 0); PG8_STAGEA(PG8_SA(0, 1), k2, a10, a11);
            PG8_WAIT_V(8); PG8_WAIT_L(0); PG8_BAR; PG8_MMA(0, 0, At, B0); PG8_MMA(0, 1, At, B1); PG8_BAR; PG8_SCHED;
            PG8_LDA(At, 1, 1); PG8_STAGE(PG8_SB(1, 0), b3, voffB); PG8_STAGE(PG8_SB(1, 1), b3 + hstep, voffB); PG8_STAGEA(PG8_SA(1, 0), k3, a00, a01);
            PG8_WAIT_V(8); PG8_WAIT_L(0); PG8_BAR; PG8_MMA(1, 0, At, B0); PG8_MMA(1, 1, At, B1); PG8_BAR; PG8_SCHED;
        }
        if constexpr (ALIGN_EPI) { if (wr == 0) PG8_BAR; }
        E(acc, cur, wr, wc, fr, fq);
        if (!has_next) break;
#pragma unroll
        for (int a = 0; a < 2; ++a)
#pragma unroll
            for (int b = 0; b < 2; ++b)
#pragma unroll
                for (int m = 0; m < 4; ++m)
#pragma unroll
                    for (int n = 0; n < 2; ++n) acc[a][b][m][n] = (f32x4){0.f, 0.f, 0.f, 0.f};
        cur = nxt; cB = nB; c00 = n00; c01 = n01; c10 = n10; c11 = n11; ++ui; cur.par = ui & 1;
        if constexpr (Epi::HAS_PRE) E.pre(cur);
        if constexpr (ALIGN_EPI) { if (wr == 1) PG8_BAR; }
    }
    PG8_WAIT_V(0);
    if constexpr (!ALIGN_EPI) { if (wr == 0) PG8_BAR; }
    PG8_BAR;
#undef PG8_SA
#undef PG8_SB
#undef PG8_STAGE
#undef PG8_STAGEA
#undef PG8_LDA
#undef PG8_LDB
#undef PG8_MMA
#undef PG8_WAIT_V
#undef PG8_WAIT_L
#undef PG8_BAR
#undef PG8_SCHED
}
}

#define XB_TMO      128
#define XB_XCNT(j)  (256  + 64 * (j))
#define XB_XSUB(j)  (1280 + 64 * (j))
#define XB_XGEN(j)  (2304 + 64 * (j))
#define XB_TOP      3328
#define XB_TOPGEN   3392
#define XCD_BAR_WORDS 3456
#define XB_SPIN_CAP (1u << 18)

__device__ __forceinline__ unsigned xb_ld(unsigned* p)              { return __hip_atomic_load(p, __ATOMIC_RELAXED, __HIP_MEMORY_SCOPE_AGENT); }
__device__ __forceinline__ unsigned xb_add(unsigned* p, unsigned v) { return __hip_atomic_fetch_add(p, v, __ATOMIC_RELAXED, __HIP_MEMORY_SCOPE_AGENT); }
__device__ __forceinline__ unsigned xb_xcc_id() { return (unsigned)__builtin_amdgcn_s_getreg((3 << 11) | 20) & 0xFu; }
#define XB_SPIN(cond, bar) do { unsigned _sp = 0; while (cond) { __builtin_amdgcn_s_sleep(1); \
    if ((++_sp & 255u) == 0u) { if (xb_ld(&(bar)[XB_TMO])) break; if (_sp > XB_SPIN_CAP) { atomicAdd(&(bar)[XB_TMO], 1u); break; } } } } while (0)

struct XcdBarrier {
    unsigned* bar; unsigned x;
    volatile LAS unsigned* st;
};

__device__ __forceinline__ XcdBarrier xcd_barrier_post(unsigned* bar, volatile LAS unsigned* st) {
    XcdBarrier b; b.bar = bar; b.x = xb_xcc_id(); b.st = st;
    if (threadIdx.x == 0) (void)xb_add(&bar[XB_XCNT(b.x)], 1u);
    return b;
}
__device__ __forceinline__ void xcd_barrier_complete(unsigned* bar, unsigned x, unsigned& nloc, unsigned& nx) {
    const unsigned G = gridDim.x * gridDim.y * gridDim.z;
    unsigned sum, cnt, mine, sp = 0u;
    for (;;) {
        sum = 0u; cnt = 0u; mine = 0u;
#pragma unroll
        for (unsigned j = 0; j < 16; ++j) { const unsigned c = xb_ld(&bar[XB_XCNT(j)]); sum += c; cnt += (c > 0u) ? 1u : 0u; mine = (j == x) ? c : mine; }
        if (sum == G) break;
        __builtin_amdgcn_s_sleep(1);
        if ((++sp & 255u) == 0u) { if (xb_ld(&bar[XB_TMO])) break; if (sp > XB_SPIN_CAP) { atomicAdd(&bar[XB_TMO], 1u); break; } }
    }
    nloc = mine > 0u ? mine : 1u; nx = cnt > 0u ? cnt : 1u;
}

__device__ __forceinline__ void xcd_barrier(const XcdBarrier& b) {
    asm volatile("s_waitcnt vmcnt(0)" ::: "memory");
    __syncthreads();
    if (threadIdx.x == 0) {
        unsigned* bar = b.bar;
        __builtin_amdgcn_s_waitcnt(0);
        unsigned nloc = b.st[0], nx = b.st[1];
        if (nloc == 0u) { xcd_barrier_complete(bar, b.x, nloc, nx); b.st[0] = nloc; b.st[1] = nx; }
        const unsigned old = xb_add(&bar[XB_XSUB(b.x)], 1u);
        const unsigned gen = old / nloc;
        if (old + 1u == (gen + 1u) * nloc) {
            __builtin_amdgcn_fence(__ATOMIC_RELEASE, "agent");
            asm volatile("s_waitcnt vmcnt(0)" ::: "memory");
            const unsigned og = xb_add(&bar[XB_TOP], 1u);
            const unsigned tg = og / nx;
            if (og + 1u == (tg + 1u) * nx) xb_add(&bar[XB_TOPGEN], 1u);
            else XB_SPIN(xb_ld(&bar[XB_TOPGEN]) == tg, bar);
            __builtin_amdgcn_fence(__ATOMIC_ACQUIRE, "agent");
            xb_add(&bar[XB_XGEN(b.x)], 1u);
            asm volatile("s_waitcnt vmcnt(0)" ::: "memory");
        } else {
            XB_SPIN(xb_ld(&bar[XB_XGEN(b.x)]) == gen, bar);
            __builtin_amdgcn_fence(__ATOMIC_ACQUIRE, "agent");
            asm volatile("s_waitcnt vmcnt(0)" ::: "memory");
        }
    }
    __syncthreads();
}
struct P {
  const float* x; const float* mix_norm; const float* w_in; const float* gate_bias;
  const float* dq_norm; const float* dk_norm; const float* dlam; const float* dsubln;
  const float* nq_norm; const float* nk_norm; const float* cmp_pe; const float* cmp_w1; const float* cmp_w2;
  const float* w_out;
  const float* rmix; const float* w_r; const float* w_k; const float* w_v;
  const float* w0; const float* w1; const float* w2; const float* a0; const float* a1; const float* a2;
  const float* g1; const float* g2; const float* k_k; const float* k_a; const float* r_k;
  const float* ln_w; const float* ln_b; const float* w_o;
  const float* ffn_norm; const float* rg_w; const float* rg_b; const float* re_w; const float* re_b;
  const float* e_gate; const float* e_up; const float* e_down;
  float* out;
  unsigned char* ws;
  int ph_lo, ph_hi, layer, pad;
};

#define PREF const __attribute__((address_space(4))) P&
__device__ __forceinline__ const __attribute__((address_space(4))) P* opaque_kernarg() { auto q = __builtin_amdgcn_kernarg_segment_ptr(); asm volatile("" : "+s"(q)); return (const __attribute__((address_space(4))) P*)q; }
#define KP (*opaque_kernarg())

constexpr int RING_OFF = 0, RING_BYTES = 131072;
constexpr int LDSCTL_OFF = RING_BYTES, MISC_OFF = LDSCTL_OFF + 320;
constexpr int LDS_BYTES = 147456;
constexpr int NWAVES = 8;

struct Frame {
  LAS unsigned char* lds;
  volatile LAS unsigned* MISC;
  gu32* ctl;
  int tid, lane, wave, vcu, G;
#ifdef PROBE_PH
  unsigned long long pr_t0, pr_t1;
#endif
};
#ifdef PROBE_PH
#define PROBE_MARK(k) do { if ((k) == PROBE_PH) F.pr_t0 = __builtin_amdgcn_s_memrealtime(); if ((k) == PROBE_PH + PROBE_N) F.pr_t1 = __builtin_amdgcn_s_memrealtime(); } while (0)
#else
#define PROBE_MARK(k) do {} while (0)
#endif

__device__ __forceinline__ void transpose_item(const float* W, int ldsrc, int k0, int c0, int ncols, bf16_t* dst, int ldk, int drow0, LAS float* scr, int lane) {
  const int kr = lane >> 3, c4 = (lane & 7) * 4;
  f32x4 v[8];
#pragma unroll
  for (int i = 0; i < 8; ++i) v[i] = (c4 < ncols) ? *(const GAS f32x4*)(W + (size_t)(k0 + kr + 8 * i) * ldsrc + c0 + c4) : (f32x4){0.f, 0.f, 0.f, 0.f};
#pragma unroll
  for (int i = 0; i < 8; ++i) { LAS float* s = scr + (kr + 8 * i) * 33 + c4; s[0] = v[i].x; s[1] = v[i].y; s[2] = v[i].z; s[3] = v[i].w; }
  LDS_WAIT(); asm volatile("" ::: "memory");
  const int c = lane & 7;
#pragma unroll
  for (int j = 0; j < 4; ++j) { const int n = (lane >> 3) + 8 * j; const LAS float* s = scr + (8 * c) * 33 + n;
    v4u o; o.x = pk2(s[0 * 33], s[1 * 33]); o.y = pk2(s[2 * 33], s[3 * 33]); o.z = pk2(s[4 * 33], s[5 * 33]); o.w = pk2(s[6 * 33], s[7 * 33]);
    *(GAS v4u*)(dst + (size_t)(drow0 + n) * ldk + k0 + 8 * c) = o; }
  LDS_WAIT(); asm volatile("" ::: "memory");
}
template <int NR>
__device__ __forceinline__ void rms_rows_to_bf16(const float* x, const float* gain, bf16_t* o, int m0, int stride, int lane) {
  f32x4 v[NR][4];
#pragma unroll
  for (int r = 0; r < NR; ++r) { const GAS f32x4* xr = (const GAS f32x4*)(x + (size_t)(m0 + r * stride) * DM) + lane;
#pragma unroll
    for (int j = 0; j < 4; ++j) v[r][j] = xr[64 * j]; }
  const GAS f32x4* gr = (const GAS f32x4*)gain + lane;
  f32x4 g[4];
#pragma unroll
  for (int j = 0; j < 4; ++j) g[j] = gr[64 * j];
#pragma unroll
  for (int r = 0; r < NR; ++r) {
    float s = 0.f;
#pragma unroll
    for (int j = 0; j < 4; ++j) s += (v[r][j].x * v[r][j].x + v[r][j].y * v[r][j].y) + (v[r][j].z * v[r][j].z + v[r][j].w * v[r][j].w);
    const float rr = rsqrtf(wave_sum_dpp(s) * (1.f / DM) + 1e-6f);
    GAS v2u* o8 = (GAS v2u*)(o + (size_t)(m0 + r * stride) * DM) + lane;
#pragma unroll
    for (int j = 0; j < 4; ++j) { v2u w; w.x = pk2(v[r][j].x * rr * g[j].x, v[r][j].y * rr * g[j].y); w.y = pk2(v[r][j].z * rr * g[j].z, v[r][j].w * rr * g[j].w); o8[64 * j] = w; }
  }
}

__device__ __forceinline__ void conv_win_item(PREF p, int it, LAS float* scr, int lane) {
  const int vg = it >> 4, kb = it & 15;
  const int pn = vg >> 3, bj = (vg >> 2) & 1, wc = vg & 3, s = pn * 4 + wc;
  int c0 = 0, nc = 0;
  if (s < 44) { c0 = 64 * s + 32 * bj; nc = 32; } else if (s == 44 && bj == 0) { c0 = OFF_NG; nc = 24; }
  transpose_item(p.w_in, INC, kb * 64, c0, nc, (bf16_t*)(p.ws + WS_WIN), DM, vg * 32, scr, lane);
}
__device__ __forceinline__ void conv_sq_item(const float* W, bf16_t* dst, int drow_base, int it, LAS float* scr, int lane) {
  const int cg = it >> 4, kb = it & 15;
  transpose_item(W, DM, kb * 64, cg * 32, 32, dst, DM, drow_base + cg * 32, scr, lane);
}
__device__ __forceinline__ void conv_expert_item(PREF p, int layer, int it, LAS float* scr, int lane) {
  const int e = it / 384, r = it % 384;
  if (r < 256) {
    const int up = r >> 7, q = r & 127, cgp = q >> 4, kb = q & 15;
    const int pn = cgp >> 2, qq = cgp & 3;
    const float* W = (up ? p.e_up : p.e_gate) + ((size_t)layer * 32 + e) * DM * 256;
    transpose_item(W, 256, kb * 64, cgp * 32, 32, (bf16_t*)(p.ws + WS_EGU), DM, e * 512 + pn * 256 + up * 128 + qq * 32, scr, lane);
  } else {
    const int q = r - 256, cg = q >> 2, kb = q & 3;
    const float* W = p.e_down + ((size_t)layer * 32 + e) * 256 * DM;
    transpose_item(W, DM, kb * 64, cg * 32, 32, (bf16_t*)(p.ws + WS_EDN), 256, e * 1024 + cg * 32, scr, lane);
  }
}

using pg8::Unit; using pg8::u32x4; using pg8::pack8;
struct EpiInProj {
  static constexpr bool PERM = true, HAS_PRE = false;
  bf16_t* H; float* GATES; const float* dq; const float* dk; const float* nq; const float* nk; const float* gbias;
  __device__ __forceinline__ void operator()(const f32x4 (&acc)[2][2][4][2], const Unit& u, int wr, int wc, int fr, int fq) const {
    const int s = u.pn * 4 + wc;
    if (s > 44) return;
    const int row0 = u.pm * 256 + wr * 64 + fr;
    if (s == 44) {
      if (fq < 3) {
        f32x4 b0 = *(const f32x4*)(gbias + 8 * fq), b1 = *(const f32x4*)(gbias + 8 * fq + 4);
#pragma unroll
        for (int ai = 0; ai < 2; ++ai)
#pragma unroll
          for (int m = 0; m < 4; ++m) { float* gp = GATES + (size_t)(row0 + ai * 128 + m * 16) * 24 + 8 * fq;
            f32x4 v0 = acc[ai][0][m][0] + b0, v1 = acc[ai][0][m][1] + b1;
#pragma unroll
            for (int i = 0; i < 4; ++i) { v0[i] = sigmoidf_(v0[i]); v1[i] = sigmoidf_(v1[i]); }
            *(f32x4*)gp = v0; *(f32x4*)(gp + 4) = v1; }
      }
      return;
    }
    int mode = 0; const float* gain = nullptr;
    if (s < 8) { mode = 1; gain = dq; } else if (s < 16) { mode = 1; gain = dk; }
    else if (s >= 24 && s < 32) { mode = 2; gain = nq; }
    else if (s >= 32) { const int q = s - 32, br = q >> 2, kv = (q >> 1) & 1; if (kv == 0 && br >= 1) { mode = 2; gain = nk + br * 64; } }
    const float qsc = (s < 8) ? 0.17677669529663687f * 1.4426950408889634f : ((s >= 24 && s < 32) ? 0.125f * 1.4426950408889634f : 1.f);
    f32x4 g[2][2];
#pragma unroll
    for (int bj = 0; bj < 2; ++bj)
#pragma unroll
      for (int n = 0; n < 2; ++n) {
        if (mode == 1) g[bj][n] = *(const f32x4*)(gain + 8 * fq + 4 * n);
        else if (mode == 2) g[bj][n] = *(const f32x4*)(gain + 32 * bj + 8 * fq + 4 * n);
        else g[bj][n] = (f32x4){1.f, 1.f, 1.f, 1.f};
      }
#pragma unroll
    for (int ai = 0; ai < 2; ++ai)
#pragma unroll
      for (int m = 0; m < 4; ++m) {
        float sc[2] = {1.f, 1.f};
        if (mode != 0) {
          float ss[2];
#pragma unroll
          for (int bj = 0; bj < 2; ++bj) { const f32x4 a = acc[ai][bj][m][0], b = acc[ai][bj][m][1];
            float t = (a[0] * a[0] + a[1] * a[1]) + (a[2] * a[2] + a[3] * a[3]) + (b[0] * b[0] + b[1] * b[1]) + (b[2] * b[2] + b[3] * b[3]);
            t += __shfl_xor(t, 16, 64); t += __shfl_xor(t, 32, 64); ss[bj] = t; }
          if (mode == 1) { sc[0] = rsqrtf(ss[0] * (1.f / 32.f) + 1e-6f) * qsc; sc[1] = rsqrtf(ss[1] * (1.f / 32.f) + 1e-6f) * qsc; }
          else { const float r = rsqrtf((ss[0] + ss[1]) * (1.f / 64.f) + 1e-6f) * qsc; sc[0] = r; sc[1] = r; }
        }
        bf16_t* rowp = H + (size_t)(row0 + ai * 128 + m * 16) * HC + 64 * s + 8 * fq;
#pragma unroll
        for (int bj = 0; bj < 2; ++bj) { const f32x4 v0 = acc[ai][bj][m][0] * sc[bj] * g[bj][0], v1 = acc[ai][bj][m][1] * sc[bj] * g[bj][1];
          *(u32x4*)(rowp + 32 * bj) = pack8(v0, v1); }
      }
  }
};
struct EpiResid {
  static constexpr bool PERM = false, HAS_PRE = false;
  const float* base; float* out; const bf16_t* y1;
  __device__ __forceinline__ void operator()(const f32x4 (&acc)[2][2][4][2], const Unit& u, int wr, int wc, int fr, int fq) const {
    const int row0 = u.pm * 256 + wr * 64 + fr, col0 = u.pn * 256 + wc * 32 + 4 * fq;
#pragma unroll
    for (int ai = 0; ai < 2; ++ai)
#pragma unroll
      for (int m = 0; m < 4; ++m) { const size_t off = (size_t)(row0 + ai * 128 + m * 16) * DM + col0;
#pragma unroll
        for (int bj = 0; bj < 2; ++bj)
#pragma unroll
          for (int n = 0; n < 2; ++n) { f32x4 b = *(const f32x4*)(base + off + bj * 128 + n * 16);
            if (y1) { const v2u y = *(const v2u*)(y1 + off + bj * 128 + n * 16);
              b.x += __uint_as_float(y.x << 16); b.y += __uint_as_float(y.x & 0xffff0000u); b.z += __uint_as_float(y.y << 16); b.w += __uint_as_float(y.y & 0xffff0000u); }
            *(f32x4*)(out + off + bj * 128 + n * 16) = b + acc[ai][bj][m][n]; asm volatile("" ::: "memory"); } }
  }
};
struct EpiRKV {
  static constexpr bool PERM = true, HAS_PRE = false;
  unsigned char* ws;
  __device__ __forceinline__ void operator()(const f32x4 (&acc)[2][2][4][2], const Unit& u, int wr, int wc, int fr, int fq) const {
    const int gi = u.pm >> 6;
    bf16_t* O = (bf16_t*)(ws + WS_S0 + (size_t)(3 + gi) * SLOT);
    const int row0 = (u.pm & 63) * 256 + wr * 64 + fr, col0 = (u.pn & 3) * 256 + wc * 32 + 8 * fq;
#pragma unroll
    for (int ai = 0; ai < 2; ++ai)
#pragma unroll
      for (int m = 0; m < 4; ++m) { bf16_t* rowp = O + (size_t)(row0 + ai * 128 + m * 16) * DM + col0;
#pragma unroll
        for (int bj = 0; bj < 2; ++bj) *(u32x4*)(rowp + bj * 128) = pack8(acc[ai][bj][m][0], acc[ai][bj][m][1]); }
  }
};
struct EpiLora1 {
  static constexpr bool PERM = true, HAS_PRE = false;
  bf16_t* TMP;
  template <int BJ>
  __device__ __forceinline__ void half(const f32x4 (&acc)[2][2][4][2], int gi, int row0, int wc, int fq) const {
    const int c = BJ * 128 + wc * 32 + 8 * fq;
    const bool skip = (gi < 2) && (c >= 64);
    const int dcol = (gi < 2) ? gi * 64 + c : 128 + c;
    const bool zero = (gi == 2) && (c >= 160);
    if (skip) return;
#pragma unroll
    for (int ai = 0; ai < 2; ++ai)
#pragma unroll
      for (int m = 0; m < 4; ++m) {
        f32x4 v0 = acc[ai][BJ][m][0], v1 = acc[ai][BJ][m][1];
#pragma unroll
        for (int i = 0; i < 4; ++i) {
          if (gi == 0) { v0[i] = tanhf(v0[i]); v1[i] = tanhf(v1[i]); }
          else if (gi == 2) { v0[i] = zero ? 0.f : sigmoidf_(v0[i]); v1[i] = zero ? 0.f : sigmoidf_(v1[i]); }
        }
        *(u32x4*)(TMP + (size_t)(row0 + ai * 128 + m * 16) * 384 + dcol) = pack8(v0, v1);
      }
  }
  __device__ __forceinline__ void operator()(const f32x4 (&acc)[2][2][4][2], const Unit& u, int wr, int wc, int fr, int fq) const {
    const int gi = u.pm >> 6;
    const int row0 = (u.pm & 63) * 256 + wr * 64 + fr;
    half<0>(acc, gi, row0, wc, fq);
    half<1>(acc, gi, row0, wc, fq);
  }
};
struct EpiLora2 {
  static constexpr bool PERM = true, HAS_PRE = false;
  unsigned char* ws; const float* w0; const float* a0; int gbase;
  __device__ __forceinline__ void operator()(const f32x4 (&acc)[2][2][4][2], const Unit& u, int wr, int wc, int fr, int fq) const {
    const int gi = gbase + (u.pn >> 2);
    bf16_t* O = (bf16_t*)(ws + WS_S0 + (size_t)gi * SLOT);
    const int row0 = u.pm * 256 + wr * 64 + fr, col0 = (u.pn & 3) * 256 + wc * 32 + 8 * fq;
    f32x4 b[2][2];
#pragma unroll
    for (int bj = 0; bj < 2; ++bj)
#pragma unroll
      for (int n = 0; n < 2; ++n) b[bj][n] = (gi == 0) ? *(const f32x4*)(w0 + col0 + bj * 128 + 4 * n) : (gi == 1 ? *(const f32x4*)(a0 + col0 + bj * 128 + 4 * n) : (f32x4){0.f, 0.f, 0.f, 0.f});
#pragma unroll
    for (int ai = 0; ai < 2; ++ai)
#pragma unroll
      for (int m = 0; m < 4; ++m) { bf16_t* rowp = O + (size_t)(row0 + ai * 128 + m * 16) * DM + col0;
#pragma unroll
        for (int bj = 0; bj < 2; ++bj) { f32x4 v0 = acc[ai][bj][m][0] + b[bj][0], v1 = acc[ai][bj][m][1] + b[bj][1];
          if (gi == 0) {
#pragma unroll
            for (int i = 0; i < 4; ++i) { v0[i] = -__expf(-softplusf_(-v0[i]) - 0.5f); v1[i] = -__expf(-softplusf_(-v1[i]) - 0.5f); }
          } else if (gi == 1) {
#pragma unroll
            for (int i = 0; i < 4; ++i) { v0[i] = sigmoidf_(v0[i]); v1[i] = sigmoidf_(v1[i]); }
          }
          *(u32x4*)(rowp + bj * 128) = pack8(v0, v1); } }
  }
};
struct EpiMoeGU {
  static constexpr bool PERM = true, HAS_PRE = false;
  bf16_t* HID;
  __device__ __forceinline__ void operator()(const f32x4 (&acc)[2][2][4][2], const Unit& u, int wr, int wc, int fr, int fq) const {
    const int row0 = u.pm * 256 + wr * 64 + fr, col0 = (u.pn & 1) * 128 + wc * 32 + 8 * fq;
#pragma unroll
    for (int ai = 0; ai < 2; ++ai)
#pragma unroll
      for (int m = 0; m < 4; ++m) {
        f32x4 h[2];
#pragma unroll
        for (int n = 0; n < 2; ++n) { const f32x4 g = acc[ai][0][m][n], up = acc[ai][1][m][n];
#pragma unroll
          for (int i = 0; i < 4; ++i) h[n][i] = g[i] * sigmoidf_(g[i]) * up[i]; }
        *(u32x4*)(HID + (size_t)(row0 + ai * 128 + m * 16) * 256 + col0) = pack8(h[0], h[1]);
      }
  }
};
struct EpiMoeDown {
  static constexpr bool PERM = false, HAS_PRE = true;
  float* out; bf16_t* Y1; const int* list; const float* pgate; LAS int* ept;
  __device__ __forceinline__ void pre(const Unit& u) const {
    const int r = threadIdx.x;
    if (r < 256) { int pr = -1; float gt = 0.f;
      if (r < u.nrows) { pr = list[(size_t)u.e * CAP + u.rt * 256 + r]; gt = pgate[pr]; }
      LAS int* e = ept + (u.par * 256 + r) * 2; e[0] = pr; e[1] = __float_as_int(gt); }
  }
  __device__ __forceinline__ void operator()(const f32x4 (&acc)[2][2][4][2], const Unit& u, int wr, int wc, int fr, int fq) const {
    const int col0 = (u.pn & 3) * 256 + wc * 32 + 4 * fq;
#pragma unroll
    for (int ai = 0; ai < 2; ++ai)
#pragma unroll
      for (int m = 0; m < 4; ++m) {
        const int r = ai * 128 + wr * 64 + m * 16 + fr;
        const LAS int* e = ept + (u.par * 256 + r) * 2;
        const int pr = e[0]; const float gt = __int_as_float(e[1]);
        if (pr >= 0) {
          const int tok = pr >> 1;
          if ((pr & 1) == 0) {
            float* op = out + (size_t)tok * DM + col0;
#pragma unroll
            for (int bj = 0; bj < 2; ++bj)
#pragma unroll
              for (int n = 0; n < 2; ++n) { f32x4 b = *(const f32x4*)(op + bj * 128 + n * 16); *(f32x4*)(op + bj * 128 + n * 16) = b + acc[ai][bj][m][n] * gt; }
          } else {
            bf16_t* yp = Y1 + (size_t)tok * DM + col0;
#pragma unroll
            for (int bj = 0; bj < 2; ++bj)
#pragma unroll
              for (int n = 0; n < 2; ++n) { const f32x4 v = acc[ai][bj][m][n] * gt; v2u w; w.x = pk2(v[0], v[1]); w.y = pk2(v[2], v[3]); *(v2u*)(yp + bj * 128 + n * 16) = w; }
          }
        }
      }
  }
};

__device__ __forceinline__ void phase_prologue(PREF p, Frame& F) {
  const int lane = fresh_lane();
  LAS float* scr = (LAS float*)(F.lds + RING_OFF + F.wave * 16384);
  const int gw = F.vcu * NWAVES + F.wave, NGW = F.G * NWAVES;
  constexpr int I_WIN = 96 * 16, I_SQ = 32 * 16;
  constexpr int NITEMS = I_WIN + 5 * I_SQ + 128;
  for (int it = gw; it < NITEMS; it += NGW) {
    int r = it;
    if (r < I_WIN) { conv_win_item(p, r, scr, fresh_lane()); continue; } r -= I_WIN;
    if (r < I_SQ) { conv_sq_item(p.w_out, (bf16_t*)(p.ws + WS_WOUT), 0, r, scr, fresh_lane()); continue; } r -= I_SQ;
    if (r < I_SQ) { conv_sq_item(p.w_r, (bf16_t*)(p.ws + WS_WRKV), 0, r, scr, fresh_lane()); continue; } r -= I_SQ;
    if (r < I_SQ) { conv_sq_item(p.w_k, (bf16_t*)(p.ws + WS_WRKV), 1024, r, scr, fresh_lane()); continue; } r -= I_SQ;
    if (r < I_SQ) { conv_sq_item(p.w_v, (bf16_t*)(p.ws + WS_WRKV), 2048, r, scr, fresh_lane()); continue; } r -= I_SQ;
    if (r < I_SQ) { conv_sq_item(p.w_o, (bf16_t*)(p.ws + WS_WO), 0, r, scr, fresh_lane()); continue; } r -= I_SQ;
    { const int kv = r >> 6, q = r & 63, kb = q >> 1, cg = q & 1;
      transpose_item(p.cmp_w1 + (size_t)kv * 2048 * 64, 64, kb * 64, cg * 32, 32, (bf16_t*)(p.ws + WS_CW1) + (size_t)kv * 64 * 2048, 2048, cg * 32, scr, fresh_lane()); }
  }
  {
    const int gt = (F.vcu * NWAVES + F.wave) * 64 + fresh_lane(), NGT = NGW * 64;
    bf16_t* WL1 = (bf16_t*)(p.ws + WS_WL1);
    for (int i = gt; i < 768 * 1024; i += NGT) {
      const int n = i >> 10, k = i & 1023, gi = n >> 8, c = n & 255;
      float v = 0.f;
      if (gi == 0) { if (c < 64) v = p.w1[k * 64 + c]; }
      else if (gi == 1) { if (c < 64) v = p.a1[k * 64 + c]; }
      else { if (c < 160) v = p.g1[k * 160 + c]; }
      WL1[i] = (bf16_t)f2bf(v);
    }
    bf16_t* WL2 = (bf16_t*)(p.ws + WS_WL2);
    for (int i = gt; i < 2048 * 128; i += NGT) {
      const int n = i >> 7, k = i & 127, c = n & 1023;
      float v = 0.f;
      if (n < 1024) { if (k < 64) v = p.w2[k * 1024 + c]; }
      else { if (k >= 64) v = p.a2[(k - 64) * 1024 + c]; }
      WL2[i] = (bf16_t)f2bf(v);
    }
    bf16_t* WL2g = (bf16_t*)(p.ws + WS_WL2 + 512 * 1024);
    for (int i = gt; i < 1024 * 256; i += NGT) {
      const int n = i >> 8, k = i & 255;
      WL2g[i] = (bf16_t)f2bf(k < 160 ? p.g2[k * 1024 + n] : 0.f);
    }
  }
  bf16_t* XN = (bf16_t*)(p.ws + WS_XN);
  for (int m = gw; m < T_TOK; m += 4 * NGW) rms_rows_to_bf16<4>(p.x, p.mix_norm, XN, m, NGW, lane);
}


__device__ __forceinline__ void phase_router(PREF p, Frame& F, int layer) {
  const int gw = F.vcu * NWAVES + F.wave, NGW = F.G * NWAVES;
  const int lane = fresh_lane();
  PROBE_MARK(100 + layer * 10);
  {
    LAS float* scr = (LAS float*)(F.lds + RING_OFF + F.wave * 16384);
    for (int it = gw; it < 32 * 384; it += NGW) conv_expert_item(p, layer, it, scr, lane);
  }
  __syncthreads();
  PROBE_MARK(101 + layer * 10);
  LAS float* WQ = (LAS float*)(F.lds);
  LAS float* XS = (LAS float*)(F.lds + 40960) + F.wave * 2080;
  LAS float* LG = (LAS float*)(F.lds + 107520) + F.wave * 8 * 36;
  const float* gain = p.ffn_norm + layer * DM;
  const float* wg = p.rg_w + (size_t)layer * DM * 4;
  const float* we = p.re_w + (size_t)layer * DM * 32;
  bf16_t* XN2 = (bf16_t*)(p.ws + WS_XN2);
  f32x4 v[8][4];
#pragma unroll
  for (int tt = 0; tt < 8; ++tt) { const GAS f32x4* xr = (const GAS f32x4*)(p.out + (size_t)(gw * 8 + tt) * DM) + lane;
#pragma unroll
    for (int j = 0; j < 4; ++j) v[tt][j] = xr[64 * j]; }
  {
    f32x4 g[4];
#pragma unroll
    for (int j = 0; j < 4; ++j) g[j] = ((const GAS f32x4*)gain)[lane + 64 * j];
#pragma unroll
    for (int tt = 0; tt < 8; ++tt) {
      float s = 0.f;
#pragma unroll
      for (int j = 0; j < 4; ++j) s += (v[tt][j].x * v[tt][j].x + v[tt][j].y * v[tt][j].y) + (v[tt][j].z * v[tt][j].z + v[tt][j].w * v[tt][j].w);
      const float r = rsqrtf(wave_sum_dpp(s) * (1.f / DM) + 1e-6f);
      GAS v2u* o = (GAS v2u*)(XN2 + (size_t)(gw * 8 + tt) * DM) + lane;
#pragma unroll
      for (int j = 0; j < 4; ++j) { v[tt][j] = v[tt][j] * r * g[j]; v2u w; w.x = pk2(v[tt][j].x, v[tt][j].y); w.y = pk2(v[tt][j].z, v[tt][j].w); o[64 * j] = w; }
    }
  }
  PROBE_MARK(102 + layer * 10);
  f32x4 acc[3];
#pragma unroll
  for (int nt = 0; nt < 3; ++nt) acc[nt] = (f32x4){0.f, 0.f, 0.f, 0.f};
  const int r16 = lane & 15, g4 = lane >> 4;
#pragma unroll
  for (int j = 0; j < 4; ++j) {
    __syncthreads();
    for (int idx = F.tid; idx < 256 * 9; idx += NWAVES * 64) {
      const int row = idx / 9, c4 = idx - row * 9, k = 256 * j + row;
      const f32x4 val = (c4 == 0) ? *(const GAS f32x4*)(wg + k * 4) : *(const GAS f32x4*)(we + k * 32 + (c4 - 1) * 4);
      *(LAS f32x4*)(WQ + row * 36 + c4 * 4) = val;
    }
#pragma unroll
    for (int tt = 0; tt < 8; ++tt) *(LAS f32x4*)(XS + tt * 260 + 4 * lane) = v[tt][j];
    __syncthreads();
    const LAS float* xa = XS + (r16 & 7) * 260 + g4;
    const LAS float* wb = WQ + g4 * 36 + r16;
#pragma unroll 4
    for (int ks = 0; ks < 64; ++ks) {
      const float a = xa[4 * ks];
#pragma unroll
      for (int nt = 0; nt < 3; ++nt) acc[nt] = __builtin_amdgcn_mfma_f32_16x16x4f32(a, wb[4 * ks * 36 + nt * 16], acc[nt], 0, 0, 0);
    }
  }
  PROBE_MARK(103 + layer * 10);
  if (g4 < 2) {
#pragma unroll
    for (int nt = 0; nt < 3; ++nt) { const int n = nt * 16 + r16;
      if (n < 36) {
#pragma unroll
        for (int i = 0; i < 4; ++i) LG[(4 * g4 + i) * 36 + n] = acc[nt][i]; } }
  }
  LAS unsigned* LC = (LAS unsigned*)(F.lds + 118784);
  if (F.tid < 64) LC[F.tid] = 0u;
  __syncthreads();
  int ea = 0, eb = 0; unsigned la = 0, lb = 0; float ga = 0.f, gb = 0.f;
  if (lane < 8) {
    const LAS float* lg = LG + lane * 36;
    const float* bg = p.rg_b + layer * 4;
    const float* be = p.re_b + layer * 32;
    float gl[4]; int gi = 0; float gm = -3.4e38f;
#pragma unroll
    for (int i = 0; i < 4; i++) { gl[i] = lg[i] + bg[i]; if (gl[i] > gm) { gm = gl[i]; gi = i; } }
    float gs = 0.f;
#pragma unroll
    for (int i = 0; i < 4; i++) gs += __expf(gl[i] - gm);
    const float grp_p = 1.f / gs;
    float v0 = -3.4e38f, v1 = -3.4e38f; int i0 = 0, i1 = 0;
    for (int i = 0; i < 8; i++) {
      const float v = lg[4 + gi * 8 + i] + be[gi * 8 + i];
      if (v > v0) { v1 = v0; i1 = i0; v0 = v; i0 = i; }
      else if (v > v1) { v1 = v; i1 = i; }
    }
    const float e1 = __expf(v1 - v0);
    ga = grp_p / (1.f + e1); gb = grp_p * e1 / (1.f + e1);
    ea = gi * 8 + i0; eb = gi * 8 + i1;
    la = __hip_atomic_fetch_add(LC + ea, 1u, __ATOMIC_RELAXED, __HIP_MEMORY_SCOPE_WORKGROUP);
    lb = __hip_atomic_fetch_add(LC + eb, 1u, __ATOMIC_RELAXED, __HIP_MEMORY_SCOPE_WORKGROUP);
  }
  __syncthreads();
  if (F.tid < 32) { const unsigned n = LC[F.tid];
    unsigned* cnt = (unsigned*)(p.ws + WS_CTL) + CW_CNT + (layer * 32 + F.tid) * 64;
    LC[32 + F.tid] = n ? __hip_atomic_fetch_add(cnt, n, __ATOMIC_RELAXED, __HIP_MEMORY_SCOPE_AGENT) : 0u; }
  __syncthreads();
  if (lane < 8) {
    const int t = gw * 8 + lane;
    int* list = (int*)(p.ws + WS_LIST); float* pgate = (float*)(p.ws + WS_PGATE);
    list[(size_t)ea * CAP + LC[32 + ea] + la] = 2 * t; pgate[2 * t] = ga;
    list[(size_t)eb * CAP + LC[32 + eb] + lb] = 2 * t + 1; pgate[2 * t + 1] = gb;
  }
  PROBE_MARK(104 + layer * 10);
}

__device__ __forceinline__ void phase_final(PREF p, Frame& F) {
  const int gw = F.vcu * NWAVES + F.wave, NGW = F.G * NWAVES;
  const bf16_t* Y1 = (const bf16_t*)(p.ws + WS_Y1);
  for (int t = gw; t < T_TOK; t += NGW) {
    GAS f32x4* xr = (GAS f32x4*)(p.out + (size_t)t * DM) + fresh_lane();
    const GAS v2u* yr = (const GAS v2u*)(Y1 + (size_t)t * DM) + fresh_lane();
#pragma unroll
    for (int j = 0; j < 4; ++j) { f32x4 v = xr[64 * j]; const v2u y = yr[64 * j];
      v.x += __uint_as_float(y.x << 16); v.y += __uint_as_float(y.x & 0xffff0000u); v.z += __uint_as_float(y.y << 16); v.w += __uint_as_float(y.y & 0xffff0000u);
      xr[64 * j] = v; }
  }
}

__device__ __forceinline__ void phase_rwkv_prep(PREF p, Frame& F) {
  const int gw = F.vcu * NWAVES + F.wave, NGW = F.G * NWAVES;
  const int lane = fresh_lane();
  const float* gain = p.mix_norm + DM;
  const bf16_t* Y1 = (const bf16_t*)(p.ws + WS_Y1);
  f32x4 g[4];
#pragma unroll
  for (int j = 0; j < 4; ++j) g[j] = ((const GAS f32x4*)gain)[lane + 64 * j];
  for (int run = gw; run < T_TOK / 8; run += NGW) {
    const int t0 = run * 8;
    f32x4 prev[4];
    if ((t0 & (SEQ - 1)) == 0) {
#pragma unroll
      for (int j = 0; j < 4; ++j) prev[j] = (f32x4){0.f, 0.f, 0.f, 0.f};
    } else {
      const GAS f32x4* xr = (const GAS f32x4*)(p.out + (size_t)(t0 - 1) * DM) + lane;
      const GAS v2u* yr = (const GAS v2u*)(Y1 + (size_t)(t0 - 1) * DM) + lane;
      float s = 0.f;
#pragma unroll
      for (int j = 0; j < 4; ++j) { prev[j] = xr[64 * j]; const v2u y = yr[64 * j];
        prev[j].x += __uint_as_float(y.x << 16); prev[j].y += __uint_as_float(y.x & 0xffff0000u); prev[j].z += __uint_as_float(y.y << 16); prev[j].w += __uint_as_float(y.y & 0xffff0000u);
        s += (prev[j].x * prev[j].x + prev[j].y * prev[j].y) + (prev[j].z * prev[j].z + prev[j].w * prev[j].w); }
      const float r = rsqrtf(wave_sum(s) * (1.f / DM) + 1e-6f);
#pragma unroll
      for (int j = 0; j < 4; ++j) prev[j] = prev[j] * r * g[j];
    }
    f32x4 nx[4]; v2u ny[4];
    { const GAS f32x4* xr = (const GAS f32x4*)(p.out + (size_t)t0 * DM) + lane; const GAS v2u* yr = (const GAS v2u*)(Y1 + (size_t)t0 * DM) + lane;
#pragma unroll
      for (int j = 0; j < 4; ++j) { nx[j] = xr[64 * j]; ny[j] = yr[64 * j]; } }
#pragma unroll 1
    for (int tt = 0; tt < 8; ++tt) {
      const int t = t0 + tt;
      f32x4 v[4]; float s = 0.f;
#pragma unroll
      for (int j = 0; j < 4; ++j) { v[j] = nx[j]; const v2u y = ny[j];
        v[j].x += __uint_as_float(y.x << 16); v[j].y += __uint_as_float(y.x & 0xffff0000u); v[j].z += __uint_as_float(y.y << 16); v[j].w += __uint_as_float(y.y & 0xffff0000u);
        s += (v[j].x * v[j].x + v[j].y * v[j].y) + (v[j].z * v[j].z + v[j].w * v[j].w); }
      if (tt < 7) { const GAS f32x4* xr = (const GAS f32x4*)(p.out + (size_t)(t + 1) * DM) + lane; const GAS v2u* yr = (const GAS v2u*)(Y1 + (size_t)(t + 1) * DM) + lane;
#pragma unroll
        for (int j = 0; j < 4; ++j) { nx[j] = xr[64 * j]; ny[j] = yr[64 * j]; } }
      const float r = rsqrtf(wave_sum_dpp(s) * (1.f / DM) + 1e-6f);
#pragma unroll
      for (int j = 0; j < 4; ++j) v[j] = v[j] * r * g[j];
#pragma unroll
      for (int sl = 0; sl < 6; ++sl) {
        const int mj = (sl == 0) ? 0 : (sl == 1) ? 2 : (sl == 2) ? 3 : (sl == 3) ? 1 : (sl == 4) ? 4 : 5;
        GAS v2u* o = (GAS v2u*)(p.ws + WS_S0 + (size_t)sl * SLOT + (size_t)t * DM * 2) + lane;
#pragma unroll
        for (int j = 0; j < 4; ++j) {
          const f32x4 mx = ((const GAS f32x4*)(p.rmix + mj * DM))[lane + 64 * j];
          const f32x4 q = v[j] + (prev[j] - v[j]) * mx;
          v2u w; w.x = pk2(q.x, q.y); w.y = pk2(q.z, q.w);
          o[64 * j] = w;
        }
      }
#pragma unroll
      for (int j = 0; j < 4; ++j) prev[j] = v[j];
    }
  }
}


constexpr int RP = 72;
constexpr int RB = 64 * RP * 2;
typedef LAS bf16_t* lbf;

__device__ __forceinline__ f32x4 mm16(f32x4 acc, const LAS bf16_t* A, int arow0, const LAS bf16_t* Bt, int brow0, int lane) {
  const int r = lane & 15, q = lane >> 4;
#pragma unroll
  for (int ks = 0; ks < 2; ++ks) {
    const bf16x8 a = *(const LAS bf16x8*)(A + (arow0 + r) * RP + ks * 32 + q * 8);
    const bf16x8 b = *(const LAS bf16x8*)(Bt + (brow0 + r) * RP + ks * 32 + q * 8);
    acc = __builtin_amdgcn_mfma_f32_16x16x32_bf16(a, b, acc, 0, 0, 0);
  }
  return acc;
}
__device__ __forceinline__ float sum8(float v) {
  v += __shfl_xor(v, 1, 64); v += __shfl_xor(v, 2, 64); v += __shfl_xor(v, 4, 64); return v;
}
__device__ __forceinline__ void ld8bf(const bf16_t* p, float (&o)[8]) {
  const v4u w = *(const GAS v4u*)p;
  o[0] = __uint_as_float(w.x << 16); o[1] = __uint_as_float(w.x & 0xffff0000u); o[2] = __uint_as_float(w.y << 16); o[3] = __uint_as_float(w.y & 0xffff0000u);
  o[4] = __uint_as_float(w.z << 16); o[5] = __uint_as_float(w.z & 0xffff0000u); o[6] = __uint_as_float(w.w << 16); o[7] = __uint_as_float(w.w & 0xffff0000u);
}
__device__ __forceinline__ v4u pk8(const float (&o)[8]) { v4u w; w.x = pk2(o[0], o[1]); w.y = pk2(o[2], o[3]); w.z = pk2(o[4], o[5]); w.w = pk2(o[6], o[7]); return w; }

#define R1_BAR() do { asm volatile("s_waitcnt lgkmcnt(0)" ::: "memory"); __builtin_amdgcn_s_barrier(); asm volatile("" ::: "memory"); } while (0)
__device__ __forceinline__ void stT(LAS bf16_t* Dst, int x0, int y0, const f32x4& acc, int lane) {
  v2u w; w.x = pk2(acc[0], acc[1]); w.y = pk2(acc[2], acc[3]);
  *(LAS v2u*)(Dst + (x0 + (lane & 15)) * RP + y0 + (lane >> 4) * 4) = w;
}
struct R1In { v4u r, ld, k, v, a; };
__device__ __forceinline__ R1In rwkv_r1_load(PREF p, int item, int tid) {
  const int ch = item >> 6, c = item & 63, b = ch >> 4, hd = ch & 15;
  const size_t off = ((size_t)(b * SEQ + c * 64 + (tid >> 3)) * DM + hd * 64 + (tid & 7) * 8);
  const bf16_t* s0 = (const bf16_t*)(p.ws + WS_S0);
  R1In in;
  in.r = *(const GAS v4u*)(s0 + 3 * (SLOT / 2) + off); in.ld = *(const GAS v4u*)(s0 + off); in.k = *(const GAS v4u*)(s0 + 4 * (SLOT / 2) + off);
  in.v = *(const GAS v4u*)(s0 + 5 * (SLOT / 2) + off); in.a = *(const GAS v4u*)(s0 + (SLOT / 2) + off);
  return in;
}
__device__ __forceinline__ void un8(const v4u w, float (&o)[8]) {
  o[0] = __uint_as_float(w.x << 16); o[1] = __uint_as_float(w.x & 0xffff0000u); o[2] = __uint_as_float(w.y << 16); o[3] = __uint_as_float(w.y & 0xffff0000u);
  o[4] = __uint_as_float(w.z << 16); o[5] = __uint_as_float(w.z & 0xffff0000u); o[6] = __uint_as_float(w.w << 16); o[7] = __uint_as_float(w.w & 0xffff0000u);
}
__device__ __forceinline__ void rwkv_r1_item(PREF p, Frame& F, int item, const R1In& in) {
  const int tid = F.tid, lane = fresh_lane(), w = F.wave;
  const int ch = item >> 6, c = item & 63, b = ch >> 4, hd = ch & 15;
  const size_t tile0 = ((size_t)(b * SEQ + c * 64) * DM + hd * 64);
  unsigned char* ws = p.ws;
  bf16_t* SL[6];
#pragma unroll
  for (int s = 0; s < 6; ++s) SL[s] = (bf16_t*)(ws + WS_S0 + (size_t)s * SLOT) + tile0;
  const lbf BtT = (lbf)(F.lds + 0 * RB), KtT = (lbf)(F.lds + 1 * RB), AbT = (lbf)(F.lds + 2 * RB), RbT = (lbf)(F.lds + 3 * RB);
  const lbf Ab = (lbf)(F.lds + 4 * RB), Vc = (lbf)(F.lds + 5 * RB), Bh = (lbf)(F.lds + 6 * RB), Kh = (lbf)(F.lds + 7 * RB);
  const lbf Tk = (lbf)(F.lds + 8 * RB), WbT = (lbf)(F.lds + 9 * RB), WkT = (lbf)(F.lds + 10 * RB);
  const lbf X = BtT, XT = KtT, Pb = AbT;
  const lbf At = X, TNT = XT, U0 = Tk;
  LAS float* Lf = (LAS float*)(F.lds + 11 * RB);
  LAS float* SEG = Lf + 64 * 65;
  LAS float* GC = (LAS float*)(F.lds + 14 * RB);
  const int t = tid >> 3, cg = tid & 7, k0 = cg * 8;
  float r_[8], ld_[8], kx[8], v_[8], a_[8];
  un8(in.r, r_); un8(in.ld, ld_); un8(in.k, kx); un8(in.v, v_); un8(in.a, a_);
  float kk[8], km[8], be[8];
  {
    float ss = 0.f, bo = 0.f;
#pragma unroll
    for (int i = 0; i < 8; ++i) { const int cc = hd * 64 + k0 + i; kk[i] = kx[i] * p.k_k[cc]; ss += kk[i] * kk[i]; km[i] = kx[i] * (1.f + (a_[i] - 1.f) * p.k_a[cc]); bo += r_[i] * km[i] * p.r_k[cc]; }
    ss = sum8(ss); bo = sum8(bo);
    const float inv = 1.f / fmaxf(sqrtf(ss), 1e-12f);
#pragma unroll
    for (int i = 0; i < 8; ++i) { kk[i] *= inv; be[i] = kk[i] * a_[i]; }
    if (cg == 0) ((float*)(ws + WS_TMP))[(size_t)item * 64 + t] = bo;
  }
#pragma unroll
  for (int i = 0; i < 8; ++i) Lf[t * 65 + k0 + i] = ld_[i];
  R1_BAR();
  {
    const int k = tid & 63, sg = tid >> 6;
    float run = 0.f;
#pragma unroll
    for (int i = 0; i < 8; ++i) { run += Lf[(sg * 8 + i) * 65 + k]; Lf[(sg * 8 + i) * 65 + k] = run; }
    SEG[sg * 64 + k] = run;
    R1_BAR();
    float off = 0.f;
    for (int j = 0; j < sg; ++j) off += SEG[j * 64 + k];
#pragma unroll
    for (int i = 0; i < 8; ++i) Lf[(sg * 8 + i) * 65 + k] += off;
  }
  R1_BAR();
  {
    float ab[8], bt[8], kt[8], rb[8], bh[8], kh[8];
#pragma unroll
    for (int i = 0; i < 8; ++i) {
      const float Lt = Lf[t * 65 + k0 + i], Lp = (t > 0) ? Lf[(t - 1) * 65 + k0 + i] : 0.f, LC = Lf[63 * 65 + k0 + i];
      const float ei = __expf(-Lt), eh = __expf(LC - Lt);
      if (t == 63) GC[k0 + i] = __expf(LC);
      ab[i] = -kk[i] * __expf(Lp); bt[i] = be[i] * ei; kt[i] = km[i] * ei; rb[i] = r_[i] * __expf(Lt); bh[i] = be[i] * eh; kh[i] = km[i] * eh;
    }
    *(LAS v4u*)(BtT + t * RP + k0) = pk8(bt); *(LAS v4u*)(KtT + t * RP + k0) = pk8(kt); *(LAS v4u*)(AbT + t * RP + k0) = pk8(ab); *(LAS v4u*)(RbT + t * RP + k0) = pk8(rb);
#pragma unroll
    for (int i = 0; i < 8; ++i) { Ab[(k0 + i) * RP + t] = (bf16_t)f2bf(ab[i]); Vc[(k0 + i) * RP + t] = (bf16_t)f2bf(v_[i]); Bh[(k0 + i) * RP + t] = (bf16_t)f2bf(bh[i]); Kh[(k0 + i) * RP + t] = (bf16_t)f2bf(kh[i]); }
  }
  R1_BAR();
  const int ya = (w >> 1) * 16, xb0 = (w & 1) * 32;
  const int cr = lane & 15, q4 = (lane >> 4) * 4;
  const f32x4 Z4 = {0.f, 0.f, 0.f, 0.f};
  f32x4 accP[2];
  {
    f32x4 tabn[2], tabs[2], taks[2], wbr[2], wkr[2];
#pragma unroll
    for (int j = 0; j < 2; ++j) { const int xb = xb0 + 16 * j;
      tabn[j] = mm16(Z4, BtT, ya, AbT, xb, lane);
      tabs[j] = mm16(Z4, AbT, ya, BtT, xb, lane);
      taks[j] = mm16(Z4, AbT, ya, KtT, xb, lane);
      wbr[j] = mm16(Z4, BtT, ya, RbT, xb, lane);
      wkr[j] = mm16(Z4, KtT, ya, RbT, xb, lane); }
    R1_BAR();
#pragma unroll
    for (int j = 0; j < 2; ++j) { const int xb = xb0 + 16 * j;
      f32x4 xt, xr, pr, tk, wb, wk;
#pragma unroll
      for (int i = 0; i < 4; ++i) {
        { const int s = ya + q4 + i, tt = xb + cr; xt[i] = (s < tt) ? tabn[j][i] : 0.f; wb[i] = (s <= tt) ? wbr[j][i] : 0.f; wk[i] = (s <= tt) ? wkr[j][i] : 0.f; }
        { const int tt = ya + q4 + i, s = xb + cr; xr[i] = (s < tt) ? tabs[j][i] : 0.f; pr[i] = xr[i] + ((s == tt) ? 1.f : 0.f); tk[i] = (s < tt) ? taks[j][i] : 0.f; }
      }
      accP[j] = pr;
      stT(XT, xb, ya, xt, lane); stT(WbT, xb, ya, wb, lane); stT(WkT, xb, ya, wk, lane);
      stT(X, xb, ya, xr, lane); stT(Pb, xb, ya, pr, lane); stT(Tk, xb, ya, tk, lane); }
  }
  R1_BAR();
#pragma unroll 1
  for (int st = 0; st < 5; ++st) {
    f32x4 xr[2], xt[2];
#pragma unroll
    for (int j = 0; j < 2; ++j) { const int xb = xb0 + 16 * j;
      xr[j] = mm16(Z4, XT, ya, X, xb, lane);
      xt[j] = mm16(Z4, X, ya, XT, xb, lane);
      if (st > 0) accP[j] = mm16(accP[j], XT, ya, Pb, xb, lane); }
    R1_BAR();
#pragma unroll
    for (int j = 0; j < 2; ++j) { const int xb = xb0 + 16 * j; stT(X, xb, ya, xr[j], lane); stT(XT, xb, ya, xt[j], lane); stT(Pb, xb, ya, accP[j], lane); }
    R1_BAR();
  }
  {
    f32x4 nt[2];
#pragma unroll
    for (int j = 0; j < 2; ++j) { const int xb = xb0 + 16 * j; nt[j] = mm16(Z4, Pb, ya, XT, xb, lane);
#pragma unroll
      for (int i = 0; i < 4; ++i) nt[j][i] += bf2f(Pb[(ya + q4 + i) * RP + xb + cr]); }
    R1_BAR();
#pragma unroll
    for (int j = 0; j < 2; ++j) stT(Pb, xb0 + 16 * j, ya, nt[j], lane);
    R1_BAR();
  }
  const lbf NT = Pb;
  {
    f32x4 at[2], tn[2];
#pragma unroll
    for (int j = 0; j < 2; ++j) { const int xb = xb0 + 16 * j; at[j] = mm16(Z4, NT, ya, Ab, xb, lane); tn[j] = mm16(Z4, Tk, ya, NT, xb, lane); }
#pragma unroll
    for (int j = 0; j < 2; ++j) { const int xb = xb0 + 16 * j; stT(At, xb, ya, at[j], lane); stT(TNT, xb, ya, tn[j], lane); }
  }
  R1_BAR();
  const lbf O_RT = (lbf)(F.lds + 11 * RB), O_PM = (lbf)(F.lds + 12 * RB), O_Y0 = (lbf)(F.lds + 13 * RB), O_Q = (lbf)(F.lds + 3 * RB)  ;
  {
    f32x4 u0[2], rt[2], pm[2];
#pragma unroll
    for (int j = 0; j < 2; ++j) { const int xb = xb0 + 16 * j;
      u0[j] = mm16(Z4, TNT, ya, Vc, xb, lane);
      rt[j] = mm16(Z4, At, ya, WbT, xb, lane);
      pm[j] = mm16(Z4, At, ya, Bh, xb, lane);
      const v2u rbw = *(const LAS v2u*)(RbT + (xb + cr) * RP + ya + q4);
      rt[j][0] += __uint_as_float(rbw.x << 16); rt[j][1] += __uint_as_float(rbw.x & 0xffff0000u); rt[j][2] += __uint_as_float(rbw.y << 16); rt[j][3] += __uint_as_float(rbw.y & 0xffff0000u);
#pragma unroll
      for (int i = 0; i < 4; ++i) if (ya + q4 + i == xb + cr) pm[j][i] += GC[xb + cr]; }
    R1_BAR();
#pragma unroll
    for (int j = 0; j < 2; ++j) { const int xb = xb0 + 16 * j; stT(U0, xb, ya, u0[j], lane); stT(O_RT, xb, ya, rt[j], lane); stT(O_PM, xb, ya, pm[j], lane); }
  }
  R1_BAR();
  {
    f32x4 y0[2], qq[2];
#pragma unroll
    for (int j = 0; j < 2; ++j) { const int xb = xb0 + 16 * j;
      y0[j] = mm16(mm16(Z4, U0, ya, WbT, xb, lane), Vc, ya, WkT, xb, lane);
      qq[j] = mm16(mm16(Z4, Bh, ya, U0, xb, lane), Kh, ya, Vc, xb, lane); }
#pragma unroll
    for (int j = 0; j < 2; ++j) { const int xb = xb0 + 16 * j; stT(O_Y0, xb, ya, y0[j], lane); stT(O_Q, xb, ya, qq[j], lane); }
  }
  R1_BAR();
  {
    const int row = tid >> 3, pc = (tid & 7) * 8;
    *(GAS v4u*)(SL[3] + (size_t)row * DM + pc) = *(const LAS v4u*)(O_RT + row * RP + pc);
    *(GAS v4u*)(SL[0] + (size_t)row * DM + pc) = *(const LAS v4u*)(O_PM + row * RP + pc);
    *(GAS v4u*)(SL[4] + (size_t)row * DM + pc) = *(const LAS v4u*)(O_Y0 + row * RP + pc);
    *(GAS v4u*)(SL[1] + (size_t)row * DM + pc) = *(const LAS v4u*)(O_Q + row * RP + pc);
  }
  R1_BAR();
}

__device__ __forceinline__ void phase_rwkv_r1(PREF p, Frame& F) {
  int item = F.vcu;
  if (item >= 4096) return;
  R1In nxt = rwkv_r1_load(p, item, F.tid);
  for (; item < 4096; item += F.G) {
    const R1In cur = nxt;
    if (item + F.G < 4096) nxt = rwkv_r1_load(p, item + F.G, F.tid);
    rwkv_r1_item(p, F, item, cur);
  }
}

__device__ __forceinline__ void phase_rwkv_r2(PREF p, Frame& F) {
  if (F.wave != 0) return;
  const int lane = fresh_lane();
  const lbf Sh = (lbf)(F.lds), Sl = (lbf)(F.lds + 16 * RP * 2);
  const int cr = lane & 15, g = lane >> 4;
  for (int task = F.vcu; task < 256; task += F.G) {
    const int ch = task >> 2, jb = task & 3, b = ch >> 4, hd = ch & 15;
    const bf16_t* PM = (const bf16_t*)(p.ws + WS_S0) + ((size_t)(b * SEQ) * DM + hd * 64);
    bf16_t* QS = (bf16_t*)(p.ws + WS_S0 + SLOT) + ((size_t)(b * SEQ) * DM + hd * 64);
    for (int i = lane; i < 16 * RP; i += 64) { Sh[i] = 0; Sl[i] = 0; }
    const bf16_t* pmp = PM + (size_t)cr * DM + g * 8;
    bf16_t* qsp = QS + (size_t)(16 * jb + cr) * DM + g * 4;
    bf16x8 pa[4][4][2]; v2u qv[4][4];
#pragma unroll
    for (int d = 0; d < 4; ++d)
#pragma unroll
      for (int ct = 0; ct < 4; ++ct) { pa[d][ct][0] = *(const GAS bf16x8*)(pmp + (size_t)(d * 64 + 16 * ct) * DM); pa[d][ct][1] = *(const GAS bf16x8*)(pmp + (size_t)(d * 64 + 16 * ct) * DM + 32);
        qv[d][ct] = *(const GAS v2u*)(qsp + (size_t)d * 64 * DM + 16 * ct); }
    asm volatile("s_waitcnt lgkmcnt(0)" ::: "memory");
#pragma unroll 1
    for (int c4 = 0; c4 < 64; c4 += 4) {
#pragma unroll
      for (int d = 0; d < 4; ++d) {
        const int c = c4 + d;
        const bf16x8 bh0 = *(const LAS bf16x8*)(Sh + cr * RP + g * 8), bh1 = *(const LAS bf16x8*)(Sh + cr * RP + 32 + g * 8);
        const bf16x8 bl0 = *(const LAS bf16x8*)(Sl + cr * RP + g * 8), bl1 = *(const LAS bf16x8*)(Sl + cr * RP + 32 + g * 8);
        f32x4 acc[4];
#pragma unroll
        for (int ct = 0; ct < 4; ++ct) {
          acc[ct] = (f32x4){__uint_as_float(qv[d][ct].x << 16), __uint_as_float(qv[d][ct].x & 0xffff0000u), __uint_as_float(qv[d][ct].y << 16), __uint_as_float(qv[d][ct].y & 0xffff0000u)};
          acc[ct] = __builtin_amdgcn_mfma_f32_16x16x32_bf16(pa[d][ct][0], bh0, acc[ct], 0, 0, 0);
          acc[ct] = __builtin_amdgcn_mfma_f32_16x16x32_bf16(pa[d][ct][1], bh1, acc[ct], 0, 0, 0);
          acc[ct] = __builtin_amdgcn_mfma_f32_16x16x32_bf16(pa[d][ct][0], bl0, acc[ct], 0, 0, 0);
          acc[ct] = __builtin_amdgcn_mfma_f32_16x16x32_bf16(pa[d][ct][1], bl1, acc[ct], 0, 0, 0);
        }
        if (c + 4 < 64) {
#pragma unroll
          for (int ct = 0; ct < 4; ++ct) { pa[d][ct][0] = *(const GAS bf16x8*)(pmp + (size_t)((c + 4) * 64 + 16 * ct) * DM); pa[d][ct][1] = *(const GAS bf16x8*)(pmp + (size_t)((c + 4) * 64 + 16 * ct) * DM + 32);
            qv[d][ct] = *(const GAS v2u*)(qsp + (size_t)(c + 4) * 64 * DM + 16 * ct); }
        }
#pragma unroll
        for (int ct = 0; ct < 4; ++ct) {
          v2u hi; hi.x = pk2(acc[ct][0], acc[ct][1]); hi.y = pk2(acc[ct][2], acc[ct][3]);
          const float l0 = acc[ct][0] - __uint_as_float(hi.x << 16), l1 = acc[ct][1] - __uint_as_float(hi.x & 0xffff0000u), l2 = acc[ct][2] - __uint_as_float(hi.y << 16), l3 = acc[ct][3] - __uint_as_float(hi.y & 0xffff0000u);
          v2u lo; lo.x = pk2(l0, l1); lo.y = pk2(l2, l3);
          *(LAS v2u*)(Sh + cr * RP + 16 * ct + g * 4) = hi; *(LAS v2u*)(Sl + cr * RP + 16 * ct + g * 4) = lo;
          *(GAS v2u*)(qsp + (size_t)c * 64 * DM + 16 * ct) = hi;
        }
        asm volatile("s_waitcnt lgkmcnt(0)" ::: "memory");
      }
    }
  }
}

__device__ __forceinline__ void phase_rwkv_r3(PREF p, Frame& F) {
  const int lane = fresh_lane(), w = F.wave;
  const int cr = lane & 15, q4 = (lane >> 4) * 4, q = lane >> 4;
  const int half = w >> 2, tb = w & 3;
  LAS bf16_t* stg = (LAS bf16_t*)(F.lds) + w * 16 * RP;
  for (int it2 = F.vcu; it2 < 2048; it2 += F.G) {
    const int item = it2 * 2 + half;
    const int ch = item >> 6, c = item & 63, b = ch >> 4, hd = ch & 15;
    const size_t tile0 = ((size_t)(b * SEQ + c * 64) * DM + hd * 64);
    bf16_t* RT = (bf16_t*)(p.ws + WS_S0 + 3 * SLOT) + tile0;
    const bf16_t* Y0 = (const bf16_t*)(p.ws + WS_S0 + 4 * SLOT) + tile0;
    const bf16_t* VV = (const bf16_t*)(p.ws + WS_S0 + 5 * SLOT) + tile0;
    const bf16_t* GG = (const bf16_t*)(p.ws + WS_S0 + 2 * SLOT) + tile0;
    const bf16_t* SC = (const bf16_t*)(p.ws + WS_S0 + SLOT) + tile0 - (size_t)64 * DM;
    const float* BO = (const float*)(p.ws + WS_TMP) + (size_t)item * 64;
    f32x4 y[4];
#pragma unroll
    for (int j = 0; j < 4; ++j) y[j] = (f32x4){0.f, 0.f, 0.f, 0.f};
    if (c > 0) {
      const bf16_t* ap = RT + (size_t)(16 * tb + cr) * DM + q * 8;
      const bf16x8 a0 = *(const GAS bf16x8*)ap, a1 = *(const GAS bf16x8*)(ap + 32);
#pragma unroll
      for (int j = 0; j < 4; ++j) {
        const bf16_t* bp = SC + (size_t)(16 * j + cr) * DM + q * 8;
        const bf16x8 b0 = *(const GAS bf16x8*)bp, b1 = *(const GAS bf16x8*)(bp + 32);
        y[j] = __builtin_amdgcn_mfma_f32_16x16x32_bf16(a0, b0, y[j], 0, 0, 0);
        y[j] = __builtin_amdgcn_mfma_f32_16x16x32_bf16(a1, b1, y[j], 0, 0, 0);
      }
    }
    float mu[4], rs[4];
#pragma unroll
    for (int i = 0; i < 4; ++i) {
      float s = 0.f;
#pragma unroll
      for (int j = 0; j < 4; ++j) { y[j][i] += bf2f(Y0[(size_t)(16 * tb + q4 + i) * DM + 16 * j + cr]); s += y[j][i]; }
      s += __shfl_xor(s, 1, 64); s += __shfl_xor(s, 2, 64); s += __shfl_xor(s, 4, 64); s += __shfl_xor(s, 8, 64);
      mu[i] = s * (1.f / 64.f);
      float qd = 0.f;
#pragma unroll
      for (int j = 0; j < 4; ++j) { const float d = y[j][i] - mu[i]; qd += d * d; }
      qd += __shfl_xor(qd, 1, 64); qd += __shfl_xor(qd, 2, 64); qd += __shfl_xor(qd, 4, 64); qd += __shfl_xor(qd, 8, 64);
      rs[i] = rsqrtf(qd * (1.f / 64.f) + 64e-5f);
    }
#pragma unroll
    for (int j = 0; j < 4; ++j) {
      const int cc = hd * 64 + 16 * j + cr;
      const float lw = p.ln_w[cc], lb = p.ln_b[cc];
#pragma unroll
      for (int i = 0; i < 4; ++i) {
        const int tt = 16 * tb + q4 + i;
        const float vv = bf2f(VV[(size_t)tt * DM + 16 * j + cr]), gg = bf2f(GG[(size_t)tt * DM + 16 * j + cr]);
        const float z = ((y[j][i] - mu[i]) * rs[i] * lw + lb + BO[tt] * vv) * gg;
        stg[(q4 + i) * RP + 16 * j + cr] = (bf16_t)f2bf(z);
      }
    }
    LDS_WAIT();
#pragma unroll
    for (int i = 0; i < 2; ++i) { const int row = (lane >> 3) + 8 * i, pc = (lane & 7) * 8;
      *(GAS v4u*)(RT + (size_t)(16 * tb + row) * DM + pc) = *(const LAS v4u*)(stg + row * RP + pc); }
    LDS_WAIT();
  }
}


typedef short v4i16_t __attribute__((ext_vector_type(4)));
__device__ __forceinline__ v4i16_t tr16(const LAS bf16_t* p) { return __builtin_amdgcn_ds_read_tr16_b64_v4i16((LAS v4i16_t*)p); }

template <int KS>
__device__ __forceinline__ void qk_tile(f32x4 (&st)[4][2], const LAS bf16_t* Kt, int kc0, const bf16x8 (&qf)[2][KS], int lane) {
  const int r = lane & 15, g = lane >> 4;
#pragma unroll
  for (int kt = 0; kt < 4; ++kt)
#pragma unroll
    for (int ks = 0; ks < KS; ++ks) {
      const bf16x8 a = *(const LAS bf16x8*)(Kt + (kt * 16 + r) * RP + kc0 + ks * 32 + g * 8);
#pragma unroll
      for (int qt = 0; qt < 2; ++qt) st[kt][qt] = __builtin_amdgcn_mfma_f32_16x16x32_bf16(a, qf[qt][ks], st[kt][qt], 0, 0, 0);
    }
}
__device__ __forceinline__ void pack_p(bf16x8 (&pb)[2][2], const f32x4 (&pr)[4][2]) {
#pragma unroll
  for (int kb = 0; kb < 2; ++kb)
#pragma unroll
    for (int qt = 0; qt < 2; ++qt) {
      const v4u w = {pk2(pr[2 * kb][qt][0], pr[2 * kb][qt][1]), pk2(pr[2 * kb][qt][2], pr[2 * kb][qt][3]), pk2(pr[2 * kb + 1][qt][0], pr[2 * kb + 1][qt][1]), pk2(pr[2 * kb + 1][qt][2], pr[2 * kb + 1][qt][3])};
      pb[kb][qt] = __builtin_bit_cast(bf16x8, w);
    }
}
__device__ __forceinline__ void pv_apply(f32x4 (&o)[4][2], f32x4 (&osum)[2], const bf16x8 (&pb)[2][2], const LAS bf16_t* Vt, int lane) {
  const int g = lane >> 4, qq = (lane & 15) >> 2, pp = lane & 3;
  const bf16x8 ones = {0x3F80, 0x3F80, 0x3F80, 0x3F80, 0x3F80, 0x3F80, 0x3F80, 0x3F80};
#pragma unroll
  for (int kb = 0; kb < 2; ++kb)
#pragma unroll
    for (int qt = 0; qt < 2; ++qt) osum[qt] = __builtin_amdgcn_mfma_f32_16x16x32_bf16(ones, pb[kb][qt], osum[qt], 0, 0, 0);
#pragma unroll
  for (int dt = 0; dt < 4; ++dt)
#pragma unroll
    for (int kb = 0; kb < 2; ++kb) {
      const v4i16_t lo = tr16(Vt + (32 * kb + 4 * g + qq) * RP + dt * 16 + 4 * pp);
      const v4i16_t hi = tr16(Vt + (32 * kb + 16 + 4 * g + qq) * RP + dt * 16 + 4 * pp);
      const bf16x8 a = {lo[0], lo[1], lo[2], lo[3], hi[0], hi[1], hi[2], hi[3]};
#pragma unroll
      for (int qt = 0; qt < 2; ++qt) o[dt][qt] = __builtin_amdgcn_mfma_f32_16x16x32_bf16(a, pb[kb][qt], o[dt][qt], 0, 0, 0);
    }
}
__device__ __forceinline__ void pv_apply2(f32x4 (&o1)[4][2], f32x4 (&o2)[4][2], f32x4 (&os1)[2], f32x4 (&os2)[2], const bf16x8 (&pb1)[2][2], const bf16x8 (&pb2)[2][2], const LAS bf16_t* Vt, int lane) {
  const int g = lane >> 4, qq = (lane & 15) >> 2, pp = lane & 3;
  const bf16x8 ones = {0x3F80, 0x3F80, 0x3F80, 0x3F80, 0x3F80, 0x3F80, 0x3F80, 0x3F80};
#pragma unroll
  for (int kb = 0; kb < 2; ++kb)
#pragma unroll
    for (int qt = 0; qt < 2; ++qt) { os1[qt] = __builtin_amdgcn_mfma_f32_16x16x32_bf16(ones, pb1[kb][qt], os1[qt], 0, 0, 0); os2[qt] = __builtin_amdgcn_mfma_f32_16x16x32_bf16(ones, pb2[kb][qt], os2[qt], 0, 0, 0); }
#pragma unroll
  for (int dt = 0; dt < 4; ++dt)
#pragma unroll
    for (int kb = 0; kb < 2; ++kb) {
      const v4i16_t lo = tr16(Vt + (32 * kb + 4 * g + qq) * RP + dt * 16 + 4 * pp);
      const v4i16_t hi = tr16(Vt + (32 * kb + 16 + 4 * g + qq) * RP + dt * 16 + 4 * pp);
      const bf16x8 a = {lo[0], lo[1], lo[2], lo[3], hi[0], hi[1], hi[2], hi[3]};
#pragma unroll
      for (int qt = 0; qt < 2; ++qt) { o1[dt][qt] = __builtin_amdgcn_mfma_f32_16x16x32_bf16(a, pb1[kb][qt], o1[dt][qt], 0, 0, 0); o2[dt][qt] = __builtin_amdgcn_mfma_f32_16x16x32_bf16(a, pb2[kb][qt], o2[dt][qt], 0, 0, 0); }
    }
}
__device__ __forceinline__ void fill42(f32x4 (&a)[4][2], const f32x4 v) {
#pragma unroll
  for (int i = 0; i < 4; ++i)
#pragma unroll
    for (int j = 0; j < 2; ++j) a[i][j] = v;
}
__device__ __forceinline__ void exp42(f32x4 (&a)[4][2]) {
#pragma unroll
  for (int i = 0; i < 4; ++i)
#pragma unroll
    for (int j = 0; j < 2; ++j)
#pragma unroll
      for (int e = 0; e < 4; ++e) a[i][j][e] = __builtin_amdgcn_exp2f(a[i][j][e]);
}
#if defined(PROBE_PH) && PROBE_PH == 300
#define AT_BAR() do { const unsigned long long _b0 = __builtin_amdgcn_s_memrealtime(); asm volatile("s_waitcnt lgkmcnt(0)" ::: "memory"); __builtin_amdgcn_s_barrier(); asm volatile("" ::: "memory"); F.pr_t1 += __builtin_amdgcn_s_memrealtime() - _b0; } while (0)
#else
#define AT_BAR() do { asm volatile("s_waitcnt lgkmcnt(0)" ::: "memory"); __builtin_amdgcn_s_barrier(); asm volatile("" ::: "memory"); } while (0)
#endif
__device__ __forceinline__ void zero42(f32x4 (&a)[4][2]) {
#pragma unroll
  for (int i = 0; i < 4; ++i)
#pragma unroll
    for (int j = 0; j < 2; ++j) a[i][j] = (f32x4){0.f, 0.f, 0.f, 0.f};
}

__device__ __forceinline__ void phase_compress(PREF p, Frame& F) {
  const int lane = fresh_lane(), w = F.wave, tid = F.tid;
  const int r = lane & 15, g4 = lane >> 4;
  const bf16_t* H = (const bf16_t*)(p.ws + WS_H);
  const bf16_t* W1T = (const bf16_t*)(p.ws + WS_CW1);
  LAS float* part = (LAS float*)F.lds;
  LAS float* hid = part + 8 * 16 * 64;
  LAS float* outv = hid + 16 * 64;
  for (int task = F.vcu; task < 256; task += F.G) {
    const int kv = task >> 7, rb = task & 127;
    int row = rb * 16 + r; if (row > 2039) row = 2039;
    const int gg = row & 1, cc = (row >> 1) % NCMP, bb = (row >> 1) / NCMP;
    const int colbase = OFF_NKV + ((0 * 2 + kv) * 2 + gg) * 64;
    f32x4 acc[4];
#pragma unroll
    for (int nt = 0; nt < 4; ++nt) acc[nt] = (f32x4){0.f, 0.f, 0.f, 0.f};
#pragma unroll 1
    for (int ks = 0; ks < 8; ++ks) {
      const int k = w * 256 + ks * 32 + g4 * 8, l = k >> 6, d0 = k & 63;
      float hv[8]; ld8bf(H + (size_t)(bb * SEQ + 16 * cc + l) * HC + colbase + d0, hv);
      const float* pe = p.cmp_pe + (kv * 32 + l) * 64 + d0;
#pragma unroll
      for (int i = 0; i < 8; ++i) hv[i] += pe[i];
      const bf16x8 a = __builtin_bit_cast(bf16x8, pk8(hv));
#pragma unroll
      for (int nt = 0; nt < 4; ++nt) {
        const bf16x8 bfr = *(const GAS bf16x8*)(W1T + ((size_t)kv * 64 + nt * 16 + r) * 2048 + k);
        acc[nt] = __builtin_amdgcn_mfma_f32_16x16x32_bf16(a, bfr, acc[nt], 0, 0, 0);
      }
    }
#pragma unroll
    for (int nt = 0; nt < 4; ++nt)
#pragma unroll
      for (int i = 0; i < 4; ++i) part[(w * 16 + g4 * 4 + i) * 64 + nt * 16 + r] = acc[nt][i];
    __syncthreads();
    for (int e = tid; e < 1024; e += NWAVES * 64) { float s = 0.f;
#pragma unroll
      for (int ww = 0; ww < 8; ++ww) s += part[ww * 1024 + e];
      hid[e] = gelu_tanh(s); }
    __syncthreads();
    const float* w2 = p.cmp_w2 + kv * 4096;
    for (int e = tid; e < 1024; e += NWAVES * 64) { const int rr = e >> 6, n = e & 63; float s = 0.f;
      for (int j = 0; j < 64; ++j) s += hid[rr * 64 + j] * w2[j * 64 + n];
      outv[e] = s; }
    __syncthreads();
    for (int e = tid; e < 1024; e += NWAVES * 64) { const int rr = e >> 6, n = e & 63;
      const int orow = rb * 16 + rr;
      if (orow < 2040) {
        float v = outv[e];
        if (kv == 0) { float ss = 0.f; for (int j = 0; j < 64; ++j) ss += outv[rr * 64 + j] * outv[rr * 64 + j]; v = v * rsqrtf(ss * (1.f / 64.f) + 1e-6f) * p.nk_norm[n]; }
        const int g2 = orow & 1, c2 = (orow >> 1) % NCMP, b2 = (orow >> 1) / NCMP;
        ((bf16_t*)(p.ws + (kv ? WS_VCMPB : WS_KCMPB)))[((size_t)(b2 * 2 + g2) * 256 + c2) * 64 + n] = (bf16_t)f2bf(v);
      }
    }
    if (task < 16 && tid < 64) { const int kk2 = task >> 3, bg = task & 7; ((bf16_t*)(p.ws + (kk2 ? WS_VCMPB : WS_KCMPB)))[((size_t)bg * 256 + 255) * 64 + tid] = 0; }
    __syncthreads();
  }
}

__device__ __forceinline__ v4u tile_ld(const bf16_t* base, size_t pitch, int tid) { return *(const GAS v4u*)(base + (size_t)(tid >> 3) * pitch + (tid & 7) * 8); }
__device__ __forceinline__ void tile_st(LAS bf16_t* dst, v4u v, int tid) { *(LAS v4u*)(dst + (tid >> 3) * RP + (tid & 7) * 8) = v; }

template <int KS, int MODE>
__device__ __forceinline__ void attn_tile(f32x4 (&o)[4][2], f32x4 (&os)[2], const bf16x8 (&qf)[2][KS], const LAS bf16_t* KBt, int kc0, const LAS bf16_t* VBt, const f32x4 nbv,
                                          const bool (&on)[2], int qq0, int koff, int lane) {
  const int r = lane & 15, g = lane >> 4;
  f32x4 st[4][2]; bf16x8 pb[2][2];
  fill42(st, nbv); qk_tile<KS>(st, KBt, kc0, qf, lane); exp42(st);
  if (MODE != 0) {
#pragma unroll
    for (int kt = 0; kt < 4; ++kt)
#pragma unroll
      for (int qt = 0; qt < 2; ++qt)
#pragma unroll
        for (int i = 0; i < 4; ++i) { const int kk = kt * 16 + g * 4 + i, qq = qq0 + qt * 16 + r;
          bool keep = true;
          if (MODE & 1) keep = keep && on[qt];
          if (MODE & 2) keep = keep && (kk + koff <= qq);
          if (MODE & 4) keep = keep && (kk > qq);
          if (!keep) st[kt][qt][i] = 0.f; }
  }
  pack_p(pb, st);
  pv_apply(o, os, pb, VBt, lane);
}
__device__ __forceinline__ void phase_diffattn(PREF p, Frame& F) {
  const int lane = fresh_lane(), w = F.wave, tid = F.tid;
  const int r = lane & 15, g = lane >> 4;
  const bf16_t* H = (const bf16_t*)(p.ws + WS_H);
  bf16_t* CAT = (bf16_t*)(p.ws + WS_CAT);
  float mq = 0.f, mk = 0.f, l0 = 0.f, l1 = 0.f;
  for (int i = 0; i < 32; i++) { mq = fmaxf(mq, fabsf(p.dq_norm[i])); mk = fmaxf(mk, fabsf(p.dk_norm[i])); l0 += p.dlam[i] * p.dlam[32 + i]; l1 += p.dlam[64 + i] * p.dlam[96 + i]; }
  const float c2 = 0.17677669529663687f * 1.4426950408889634f;
  const float nb = -(32.f * mq * mk) * c2;
  const f32x4 nbv = {nb, nb, nb, nb};
  const float lam = __expf(l0) - __expf(l1) + 0.2f;
  const bool on[2] = {true, true};
  for (int pr = F.vcu; pr < 256; pr += F.G) {
    const int bh = pr >> 3, sp = pr & 7, b = bh >> 3, hd = bh & 7;
#pragma unroll 1
    for (int ui = 0; ui < 2; ++ui) {
      const int qb = ui ? 15 - sp : sp;
      const int NT = 4 * (qb + 1);
      const bf16_t* Kg = H + (size_t)(b * SEQ) * HC + OFF_DK + hd * 64;
      const bf16_t* Vg = H + (size_t)(b * SEQ) * HC + OFF_DV + hd * 64;
      f32x4 o1[4][2];
#pragma unroll 1
      for (int mp = 0; mp < 2; ++mp) {
        bf16x8 qf[2][1];
#pragma unroll
        for (int qt = 0; qt < 2; ++qt) qf[qt][0] = *(const GAS bf16x8*)(H + (size_t)(b * SEQ + qb * 256 + w * 32 + qt * 16 + r) * HC + OFF_DQ + hd * 64 + mp * 32 + g * 8);
        f32x4 o[4][2]; zero42(o);
        f32x4 os[2] = {{0.f, 0.f, 0.f, 0.f}, {0.f, 0.f, 0.f, 0.f}};
        v4u krA = tile_ld(Kg, HC, tid), vrA = tile_ld(Vg, HC, tid);
        v4u krB = tile_ld(Kg + (size_t)64 * HC, HC, tid), vrB = tile_ld(Vg + (size_t)64 * HC, HC, tid);
#pragma unroll 1
        for (int t = 0; t < NT; t += 2) {
#pragma unroll
          for (int hf = 0; hf < 2; ++hf) {
            const int tt = t + hf;
            const lbf KBt = (lbf)(F.lds + hf * 2 * RB), VBt = KBt + 64 * RP;
            tile_st(KBt, hf ? krB : krA, tid); tile_st(VBt, hf ? vrB : vrA, tid);
            AT_BAR();
            if (tt + 2 < NT) { const v4u k2 = tile_ld(Kg + (size_t)(tt + 2) * 64 * HC, HC, tid), v2 = tile_ld(Vg + (size_t)(tt + 2) * 64 * HC, HC, tid);
              if (hf) { krB = k2; vrB = v2; } else { krA = k2; vrA = v2; } }
            const int koff = tt * 64 - (qb * 256 + w * 32);
            if (tt >= NT - 4) attn_tile<1, 2>(o, os, qf, KBt, mp * 32, VBt, nbv, on, 0, koff, lane);
            else attn_tile<1, 0>(o, os, qf, KBt, mp * 32, VBt, nbv, on, 0, koff, lane);
          }
        }
        if (mp == 0) {
#pragma unroll
          for (int qt = 0; qt < 2; ++qt) { const float i1 = 1.f / os[qt][0];
#pragma unroll
            for (int dt = 0; dt < 4; ++dt) o1[dt][qt] = o[dt][qt] * i1; }
        } else {
#pragma unroll
          for (int qt = 0; qt < 2; ++qt) {
            const float i2 = lam / os[qt][0];
            float ss = 0.f;
#pragma unroll
            for (int dt = 0; dt < 4; ++dt)
#pragma unroll
              for (int i = 0; i < 4; ++i) { const float v = o1[dt][qt][i] - o[dt][qt][i] * i2; o1[dt][qt][i] = v; ss += v * v; }
            ss += __shfl_xor(ss, 16, 64); ss += __shfl_xor(ss, 32, 64);
            const float rr = rsqrtf(ss * (1.f / 64.f) + 1e-6f) * 0.8f;
            bf16_t* op = CAT + (size_t)(b * SEQ + qb * 256 + w * 32 + qt * 16 + r) * DM + hd * 64;
#pragma unroll
            for (int dt = 0; dt < 4; ++dt) { const int d0 = dt * 16 + g * 4; const f32x4 sg = *(const f32x4*)(p.dsubln + d0);
              v2u wv; wv.x = pk2(o1[dt][qt][0] * rr * sg[0], o1[dt][qt][1] * rr * sg[1]); wv.y = pk2(o1[dt][qt][2] * rr * sg[2], o1[dt][qt][3] * rr * sg[3]);
              *(GAS v2u*)(op + d0) = wv; }
          }
        }
        AT_BAR();
      }
    }
  }
}

__device__ __forceinline__ void nsa_finish(f32x4 (&comb)[4][2], const f32x4 (&o)[4][2], const f32x4 (&os)[2], const float (&gate)[2], bool normalised) {
#pragma unroll
  for (int qt = 0; qt < 2; ++qt) {
    const float f = normalised ? gate[qt] : gate[qt] / os[qt][0];
#pragma unroll
    for (int dt = 0; dt < 4; ++dt) comb[dt][qt] += o[dt][qt] * f;
  }
}
__device__ __forceinline__ void phase_nsa(PREF p, Frame& F) {
  const int lane = fresh_lane(), w = F.wave, tid = F.tid;
  const int r = lane & 15, g = lane >> 4;
  const bf16_t* H = (const bf16_t*)(p.ws + WS_H);
  const float* GATES = (const float*)(p.ws + WS_GATES);
  bf16_t* CAT = (bf16_t*)(p.ws + WS_CAT);
  float mq = 0.f, mk0 = 0.f, mk1 = 0.f, mk2 = 0.f;
  for (int i = 0; i < 64; i++) { mq = fmaxf(mq, fabsf(p.nq_norm[i])); mk0 = fmaxf(mk0, fabsf(p.nk_norm[i])); mk1 = fmaxf(mk1, fabsf(p.nk_norm[64 + i])); mk2 = fmaxf(mk2, fabsf(p.nk_norm[128 + i])); }
  const float c2 = 0.125f * 1.4426950408889634f;
  const float nb0 = -(64.f * mq * mk0) * c2, nb1 = -(64.f * mq * mk1) * c2, nb2 = -(64.f * mq * mk2) * c2;
  LAS float* IMP = (LAS float*)(F.lds + 12 * RB);
  LAS unsigned char* SELB = (LAS unsigned char*)(F.lds + 12 * RB + 64 * 65 * 4);
  const int hj = w >> 1, th = w & 1;
  for (int pr = F.vcu; pr < 256; pr += F.G) {
    const int bg = pr >> 5, sp = pr & 31, b = bg >> 1, gq = bg & 1;
#pragma unroll 1
    for (int ui = 0; ui < 2; ++ui) {
      const int blk = ui ? 63 - sp : sp;
      const int hh = gq * 4 + hj;
      const int tokw = b * SEQ + blk * 64 + th * 32;
      bf16x8 qf[2][2];
      float gate0[2], gate1[2], gate2[2];
#pragma unroll
      for (int qt = 0; qt < 2; ++qt) { const bf16_t* qp = H + (size_t)(tokw + qt * 16 + r) * HC + OFF_NQ + hh * 64 + g * 8;
        qf[qt][0] = *(const GAS bf16x8*)qp; qf[qt][1] = *(const GAS bf16x8*)(qp + 32);
        const float* gp = GATES + (size_t)(tokw + qt * 16 + r) * 24 + hh * 3; gate0[qt] = gp[0]; gate1[qt] = gp[1]; gate2[qt] = gp[2]; }
      f32x4 comb[4][2]; zero42(comb);
      const int nct = (4 * blk + 3 + 63) >> 6;
      {
        const bf16_t* KC = (const bf16_t*)(p.ws + WS_KCMPB) + (size_t)(b * 2 + gq) * 256 * 64;
        const bf16_t* VC = (const bf16_t*)(p.ws + WS_VCMPB) + (size_t)(b * 2 + gq) * 256 * 64;
        for (int t4 = 0; t4 < nct; ++t4) { tile_st((lbf)(F.lds + t4 * RB), tile_ld(KC + t4 * 4096, 64, tid), tid); tile_st((lbf)(F.lds + (4 + t4) * RB), tile_ld(VC + t4 * 4096, 64, tid), tid); }
        for (int e = tid; e < 64 * 65; e += NWAVES * 64) IMP[e] = 0.f;
        AT_BAR();
        const f32x4 nbv0 = {nb0, nb0, nb0, nb0};
        int cmax[2];
#pragma unroll
        for (int qt = 0; qt < 2; ++qt) { const int pos = blk * 64 + th * 32 + qt * 16 + r; cmax[qt] = (pos >= 31) ? ((pos - 31) >> 4) : -1; }
        float lsum[2] = {0.f, 0.f};
        for (int t4 = 0; t4 < nct; ++t4) {
          f32x4 st[4][2]; fill42(st, nbv0);
          qk_tile<2>(st, (lbf)(F.lds + t4 * RB), 0, qf, lane); exp42(st);
#pragma unroll
          for (int kt = 0; kt < 4; ++kt)
#pragma unroll
            for (int qt = 0; qt < 2; ++qt)
#pragma unroll
              for (int i = 0; i < 4; ++i) { const int c = t4 * 64 + kt * 16 + g * 4 + i; if (c <= cmax[qt]) lsum[qt] += st[kt][qt][i]; }
        }
        float linv[2];
#pragma unroll
        for (int qt = 0; qt < 2; ++qt) { float s = lsum[qt]; s += __shfl_xor(s, 16, 64); s += __shfl_xor(s, 32, 64); linv[qt] = (cmax[qt] >= 0) ? 1.f / s : 0.f; }
        f32x4 o[4][2]; zero42(o);
        f32x4 osd[2] = {{0.f, 0.f, 0.f, 0.f}, {0.f, 0.f, 0.f, 0.f}};
        for (int t4 = 0; t4 < nct; ++t4) {
          f32x4 st[4][2]; fill42(st, nbv0);
          qk_tile<2>(st, (lbf)(F.lds + t4 * RB), 0, qf, lane); exp42(st);
#pragma unroll
          for (int kt = 0; kt < 4; ++kt)
#pragma unroll
            for (int qt = 0; qt < 2; ++qt) {
              float gs = 0.f;
#pragma unroll
              for (int i = 0; i < 4; ++i) { const int c = t4 * 64 + kt * 16 + g * 4 + i;
                const float e = (c <= cmax[qt]) ? st[kt][qt][i] * linv[qt] : 0.f;
                st[kt][qt][i] = e; gs += e; }
              const int ti = th * 32 + qt * 16 + r, j = t4 * 16 + kt * 4 + g;
              if (gs != 0.f) { __hip_atomic_fetch_add(IMP + ti * 65 + j, gs, __ATOMIC_RELAXED, __HIP_MEMORY_SCOPE_WORKGROUP); if (j < 63 && st[kt][qt][3] != 0.f) __hip_atomic_fetch_add(IMP + ti * 65 + j + 1, st[kt][qt][3], __ATOMIC_RELAXED, __HIP_MEMORY_SCOPE_WORKGROUP); }
            }
          bf16x8 pb[2][2]; pack_p(pb, st);
          pv_apply(o, osd, pb, (lbf)(F.lds + (4 + t4) * RB), lane);
        }
        nsa_finish(comb, o, osd, gate0, true);
      }
      AT_BAR();
      {
        const int ti = tid >> 3, jb = (tid & 7) * 8;
        float mine[8]; int rank[8];
#pragma unroll
        for (int u = 0; u < 8; ++u) { const int j = jb + u; float v = IMP[ti * 65 + j]; if (j == blk || j == 0) v = 1e4f; else if (j > blk) v = -1e30f; mine[u] = v; rank[u] = 0; }
        for (int i = 0; i < 64; ++i) { float v = IMP[ti * 65 + i]; if (i == blk || i == 0) v = 1e4f; else if (i > blk) v = -1e30f;
#pragma unroll
          for (int u = 0; u < 8; ++u) rank[u] += (v > mine[u] || (v == mine[u] && i < jb + u)) ? 1 : 0; }
        unsigned bits = 0;
#pragma unroll
        for (int u = 0; u < 8; ++u) bits |= (rank[u] < 16 ? 1u : 0u) << u;
        SELB[ti * 8 + (tid & 7)] = (unsigned char)bits;
      }
      AT_BAR();
      unsigned long long selm[2];
#pragma unroll
      for (int qt = 0; qt < 2; ++qt) { const int ti = th * 32 + qt * 16 + r; const LAS unsigned* sp2 = (const LAS unsigned*)(SELB + ti * 8); selm[qt] = (unsigned long long)sp2[0] | ((unsigned long long)sp2[1] << 32); }
#pragma unroll 1
      for (int br = 1; br < 3; ++br) {
        const int kcol = OFF_NKV + ((br * 2 + 0) * 2 + gq) * 64, vcol = OFF_NKV + ((br * 2 + 1) * 2 + gq) * 64;
        const float nbb = (br == 1) ? nb1 : nb2;
        const f32x4 nbv = {nbb, nbb, nbb, nbb};
        const int t_lo = (br == 1) ? 0 : (blk > 8 ? blk - 8 : 0);
        const bf16_t* Kg = H + (size_t)(b * SEQ) * HC + kcol;
        const bf16_t* Vg = H + (size_t)(b * SEQ) * HC + vcol;
        f32x4 o[4][2]; zero42(o);
        f32x4 os[2] = {{0.f, 0.f, 0.f, 0.f}, {0.f, 0.f, 0.f, 0.f}};
        v4u krA = tile_ld(Kg + (size_t)t_lo * 64 * HC, HC, tid), vrA = tile_ld(Vg + (size_t)t_lo * 64 * HC, HC, tid);
        v4u krB = krA, vrB = vrA;
        if (t_lo < blk) { krB = tile_ld(Kg + (size_t)(t_lo + 1) * 64 * HC, HC, tid); vrB = tile_ld(Vg + (size_t)(t_lo + 1) * 64 * HC, HC, tid); }
#pragma unroll 1
        for (int t0 = t_lo; t0 <= blk; t0 += 2) {
#pragma unroll
          for (int hf = 0; hf < 2; ++hf) {
            const int t = t0 + hf;
            if (t <= blk) {
              const lbf KBt = (lbf)(F.lds + (8 + hf * 2) * RB), VBt = KBt + 64 * RP;
              tile_st(KBt, hf ? krB : krA, tid); tile_st(VBt, hf ? vrB : vrA, tid);
              AT_BAR();
              if (t + 2 <= blk) { const v4u k2 = tile_ld(Kg + (size_t)(t + 2) * 64 * HC, HC, tid), v2 = tile_ld(Vg + (size_t)(t + 2) * 64 * HC, HC, tid);
                if (hf) { krB = k2; vrB = v2; } else { krA = k2; vrA = v2; } }
              const bool on[2] = {((selm[0] >> t) & 1ull) != 0ull, ((selm[1] >> t) & 1ull) != 0ull};
              const int qq0 = th * 32;
              if (br == 1) {
                if (__any((int)(on[0] || on[1]))) {
                  if (t == blk) attn_tile<2, 3>(o, os, qf, KBt, 0, VBt, nbv, on, qq0, 0, lane);
                  else if (__all((int)(on[0] && on[1]))) attn_tile<2, 0>(o, os, qf, KBt, 0, VBt, nbv, on, qq0, 0, lane);
                  else attn_tile<2, 1>(o, os, qf, KBt, 0, VBt, nbv, on, qq0, 0, lane);
                }
              } else {
                if (t == blk) attn_tile<2, 2>(o, os, qf, KBt, 0, VBt, nbv, on, qq0, 0, lane);
                else if (t == blk - 8) attn_tile<2, 4>(o, os, qf, KBt, 0, VBt, nbv, on, qq0, 0, lane);
                else attn_tile<2, 0>(o, os, qf, KBt, 0, VBt, nbv, on, qq0, 0, lane);
              }
            }
          }
        }
        nsa_finish(comb, o, os, (br == 1) ? gate1 : gate2, false);
        AT_BAR();
      }
#pragma unroll
      for (int qt = 0; qt < 2; ++qt) { bf16_t* op = CAT + (size_t)(tokw + qt * 16 + r) * DM + 512 + hh * 64;
#pragma unroll
        for (int dt = 0; dt < 4; ++dt) { const int d0 = dt * 16 + g * 4; v2u wv; wv.x = pk2(comb[dt][qt][0], comb[dt][qt][1]); wv.y = pk2(comb[dt][qt][2], comb[dt][qt][3]); *(GAS v2u*)(op + d0) = wv; } }
    }
  }
}

__global__ void __launch_bounds__(NWAVES * 64, 2) mk_fwd(P p_arg) {
  extern __shared__ __attribute__((aligned(16))) unsigned char lds[];
  Frame F;
  F.lds = (LAS unsigned char*)lds;
  F.MISC = (volatile LAS unsigned*)(F.lds + MISC_OFF);
  F.tid = threadIdx.x; F.lane = F.tid & 63; F.wave = __builtin_amdgcn_readfirstlane(F.tid >> 6);
  F.G = gridDim.x; { const int bx = blockIdx.x; F.vcu = (F.G % 8 == 0) ? (bx % 8) * (F.G / 8) + bx / 8 : bx; }
  unsigned char* const ws = p_arg.ws;
  F.ctl = (gu32*)(ws + WS_CTL);
  for (int u = F.tid; u < (LDS_BYTES - LDSCTL_OFF) / 4; u += NWAVES * 64) ((LAS unsigned*)(F.lds + LDSCTL_OFF))[u] = 0u;
  __syncthreads();
  XcdBarrier bar = xcd_barrier_post((unsigned*)(F.ctl + CW_BAR) + p_arg.pad * XCD_BAR_WORDS, F.MISC + 8);
  const int lo = p_arg.ph_lo, hi = p_arg.ph_hi;
#ifndef PHMASK
#define PHMASK 0xffffffffu
#endif
#define IN(k) (lo <= (k) && (k) < hi && ((PHMASK >> (k)) & 1u))
#define SEAM(k) do { if (IN(k) && IN((k) + 1)) xcd_barrier(bar); } while (0)
#ifdef PROBE_PH
  F.pr_t0 = 0; F.pr_t1 = 0;
#endif

  PROBE_MARK(0); if (IN(0)) { phase_prologue(KP, F); } SEAM(0);
  PROBE_MARK(1); if (IN(1)) {
    pg8::Gemm g{(const bf16_t*)(ws + WS_XN), (const bf16_t*)(ws + WS_WIN), DM, DM};
    pg8::StaticOrder S; S.init(T_TOK, 3072, F.G, (int)blockIdx.x);
    PREF p = KP; EpiInProj E{(bf16_t*)(ws + WS_H), (float*)(ws + WS_GATES), p.dq_norm, p.dk_norm, p.nq_norm, p.nk_norm, p.gate_bias};
    pg8::gemm_phase<EpiInProj, pg8::StaticOrder, true>(F.lds + RING_OFF, g, S, E);
  } SEAM(1);
  PROBE_MARK(2); if (IN(2)) { phase_compress(KP, F); phase_diffattn(KP, F); } SEAM(2);
  PROBE_MARK(3); if (IN(3)) { phase_nsa(KP, F); } SEAM(3);
  PROBE_MARK(4); if (IN(4)) {
    pg8::Gemm g{(const bf16_t*)(ws + WS_CAT), (const bf16_t*)(ws + WS_WOUT), DM, DM};
    pg8::StaticOrder S; S.init(T_TOK, DM, F.G, (int)blockIdx.x);
    PREF p = KP; EpiResid E{p.x, p.out, nullptr};
    pg8::gemm_phase<EpiResid, pg8::StaticOrder, false>(F.lds + RING_OFF, g, S, E);
  } SEAM(4);
#define MOE_PHASES(layer, pb) do { \
    PROBE_MARK(pb); if (IN(pb)) { phase_router(KP, F, layer); } SEAM(pb); \
    PROBE_MARK(pb + 1); if (IN(pb + 1)) { \
      pg8::Gemm g{(const bf16_t*)(ws + WS_XN2), (const bf16_t*)(ws + WS_EGU), DM, DM}; \
      pg8::moe_order_setup((LAS int*)(F.lds + MISC_OFF + 256), (const unsigned*)(ws + WS_CTL) + CW_CNT + layer * 32 * 64); pg8::MoeOrder<2, true> S{(const LAS int*)(F.lds + MISC_OFF + 256), (const int*)(ws + WS_LIST), F.G, (int)blockIdx.x}; \
      EpiMoeGU E{(bf16_t*)(ws + WS_HID)}; \
      pg8::gemm_phase<EpiMoeGU, pg8::MoeOrder<2, true>, true>(F.lds + RING_OFF, g, S, E); \
    } SEAM(pb + 1); \
    PROBE_MARK(pb + 2); if (IN(pb + 2)) { \
      int k256 = 256; asm volatile("" : "+s"(k256)); \
      pg8::Gemm g{(const bf16_t*)(ws + WS_HID), (const bf16_t*)(ws + WS_EDN), k256, 256}; \
      pg8::moe_order_setup((LAS int*)(F.lds + MISC_OFF + 256), (const unsigned*)(ws + WS_CTL) + CW_CNT + layer * 32 * 64); pg8::MoeOrder<4, false> S{(const LAS int*)(F.lds + MISC_OFF + 256), (const int*)(ws + WS_LIST), F.G, (int)blockIdx.x}; \
      PREF p = KP; EpiMoeDown E{p.out, (bf16_t*)(ws + WS_Y1), (const int*)(ws + WS_LIST), (const float*)(ws + WS_PGATE), (LAS int*)(F.lds + 132096)}; \
      pg8::gemm_phase<EpiMoeDown, pg8::MoeOrder<4, false>, true>(F.lds + RING_OFF, g, S, E); \
    } SEAM(pb + 2); \
  } while (0)
  MOE_PHASES(0, 5);
  PROBE_MARK(8); if (IN(8)) { phase_rwkv_prep(KP, F); } SEAM(8);
  PROBE_MARK(9); if (IN(9)) {
    pg8::Gemm g{(const bf16_t*)(ws + WS_S0 + 3 * SLOT), (const bf16_t*)(ws + WS_WL1), DM, DM};
    pg8::TallOrder S; S.init(3, 1, F.G, (int)blockIdx.x);
    EpiLora1 E{(bf16_t*)(ws + WS_TMP)};
    pg8::gemm_phase<EpiLora1, pg8::TallOrder, false>(F.lds + RING_OFF, g, S, E);
  } SEAM(9);
  PROBE_MARK(10); if (IN(10)) {
    pg8::Gemm g{(const bf16_t*)(ws + WS_S0), (const bf16_t*)(ws + WS_WRKV), DM, DM};
    pg8::TallOrder S; S.init(3, 4, F.G, (int)blockIdx.x);
    EpiRKV E{ws};
    pg8::gemm_phase<EpiRKV, pg8::TallOrder, true>(F.lds + RING_OFF, g, S, E);
  } SEAM(10);
  PROBE_MARK(11); if (IN(11)) {
    {
      int k128 = 128; asm volatile("" : "+s"(k128));
      pg8::Gemm g{(const bf16_t*)(ws + WS_TMP), (const bf16_t*)(ws + WS_WL2), k128, 384};
      pg8::StaticOrder S; S.init(T_TOK, 2048, F.G, (int)blockIdx.x);
      PREF p = KP; EpiLora2 E{ws, p.w0, p.a0, 0};
      pg8::gemm_phase<EpiLora2, pg8::StaticOrder, true>(F.lds + RING_OFF, g, S, E);
    }
    {
      int k256 = 256; asm volatile("" : "+s"(k256));
      pg8::Gemm g{(const bf16_t*)(ws + WS_TMP) + 128, (const bf16_t*)(ws + WS_WL2 + 512 * 1024), k256, 384};
      pg8::StaticOrder S; S.init(T_TOK, 1024, F.G, (int)blockIdx.x);
      PREF p = KP; EpiLora2 E{ws, p.w0, p.a0, 2};
      pg8::gemm_phase<EpiLora2, pg8::StaticOrder, true>(F.lds + RING_OFF, g, S, E);
    }
  } SEAM(11);
  PROBE_MARK(12); if (IN(12)) { phase_rwkv_r1(KP, F); } SEAM(12);
  PROBE_MARK(13); if (IN(13)) { phase_rwkv_r2(KP, F); } SEAM(13);
  PROBE_MARK(14); if (IN(14)) { phase_rwkv_r3(KP, F); } SEAM(14);
  PROBE_MARK(15); if (IN(15)) {
    pg8::Gemm g{(const bf16_t*)(ws + WS_S0 + 3 * SLOT), (const bf16_t*)(ws + WS_WO), DM, DM};
    pg8::StaticOrder S; S.init(T_TOK, DM, F.G, (int)blockIdx.x);
    PREF p = KP; EpiResid E{p.out, p.out, (const bf16_t*)(ws + WS_Y1)};
    pg8::gemm_phase<EpiResid, pg8::StaticOrder, false>(F.lds + RING_OFF, g, S, E);
  } SEAM(15);
  MOE_PHASES(1, 16);
#undef MOE_PHASES
  PROBE_MARK(19); if (IN(19)) { phase_final(KP, F); }
  PROBE_MARK(20);
#ifdef PROBE_PH
  { const unsigned long long dur = (F.pr_t1 - F.pr_t0) * PROBE_MUL, t0 = __builtin_amdgcn_s_memrealtime(); while (__builtin_amdgcn_s_memrealtime() - t0 < dur) __builtin_amdgcn_s_sleep(8); }
#endif
#undef IN
#undef SEAM
}

static void launch_mk(P p, int lo, int hi, int li, int grid, hipStream_t st) {
  p.ph_lo = lo; p.ph_hi = hi; p.pad = li;
  hipLaunchKernelGGL(mk_fwd, dim3(grid), dim3(NWAVES * 64), LDS_BYTES, st, p);
}

extern "C" void kernel_launch(void* const* d_in, const int* in_sizes, int n_in, void* d_out, int out_size, void* d_ws,
                              size_t ws_size, hipStream_t stream) {
  static int grid = 0;
  if (grid == 0) {
    if (n_in != 40 || ws_size < WS_END) { fprintf(stderr, "kernel_launch: bad n_in %d or ws_size %zu (< %zu)\n", n_in, ws_size, (size_t)WS_END); grid = -1; return; }
    int dev = 0, cus = 0;
    if (hipGetDevice(&dev) != hipSuccess || hipDeviceGetAttribute(&cus, hipDeviceAttributeMultiprocessorCount, dev) != hipSuccess) { grid = -1; return; }
    if (hipFuncSetAttribute((const void*)mk_fwd, hipFuncAttributeMaxDynamicSharedMemorySize, LDS_BYTES) != hipSuccess) { grid = -1; return; }
    grid = cus;
  }
  if (grid < 0) return;
  P p{};
  const float* const* in = (const float* const*)d_in;
  p.x = in[0]; p.mix_norm = in[1]; p.w_in = in[2]; p.gate_bias = in[3]; p.dq_norm = in[4]; p.dk_norm = in[5];
  p.dlam = in[6]; p.dsubln = in[7]; p.nq_norm = in[8]; p.nk_norm = in[9]; p.cmp_pe = in[10]; p.cmp_w1 = in[11];
  p.cmp_w2 = in[12]; p.w_out = in[13]; p.rmix = in[14]; p.w_r = in[15]; p.w_k = in[16]; p.w_v = in[17];
  p.w0 = in[18]; p.w1 = in[19]; p.w2 = in[20]; p.a0 = in[21]; p.a1 = in[22]; p.a2 = in[23]; p.g1 = in[24]; p.g2 = in[25];
  p.k_k = in[26]; p.k_a = in[27]; p.r_k = in[28]; p.ln_w = in[29]; p.ln_b = in[30]; p.w_o = in[31];
  p.ffn_norm = in[32]; p.rg_w = in[33]; p.rg_b = in[34]; p.re_w = in[35]; p.re_b = in[36];
  p.e_gate = in[37]; p.e_up = in[38]; p.e_down = in[39];
  p.out = (float*)d_out;
  p.ws = (unsigned char*)d_ws;
  unsigned char* ws = p.ws;
  (void)hipMemsetAsync(ws + WS_CTL, 0, CTL_ZERO_BYTES, stream);
  launch_mk(p, 0, 20, 0, grid, stream);
}
```

```cpp
#include <hip/hip_runtime.h>
#include <cstdio>
#include <cstdint>

#define T_TOK 16384
#define DM 1024
#define SEQ 4096
#define NBATCH 4
#define INC 2840
#define HC 2816
#define OFF_DQ 0
#define OFF_DK 512
#define OFF_DV 1024
#define OFF_NQ 1536
#define OFF_NKV 2048
#define OFF_NG 2816
#define NCMP 255
#define CAP 16384

#define GAS __attribute__((address_space(1)))
#define LAS __attribute__((address_space(3)))
typedef unsigned short bf16_t;
typedef unsigned v4u __attribute__((ext_vector_type(4)));
typedef unsigned v2u __attribute__((ext_vector_type(2)));
typedef float f32x4 __attribute__((ext_vector_type(4)));
typedef short bf16x8 __attribute__((ext_vector_type(8)));
typedef GAS unsigned gu32;
#define RLX_AGENT __ATOMIC_RELAXED, __HIP_MEMORY_SCOPE_AGENT
#define LDS_WAIT() asm volatile("s_waitcnt lgkmcnt(0)" ::: "memory")
#define VM_WAIT() asm volatile("s_waitcnt vmcnt(0)" ::: "memory")

__device__ __forceinline__ float bf2f(bf16_t v) { return __uint_as_float(((unsigned)v) << 16); }
__device__ __forceinline__ unsigned f2bf(float f) { unsigned u = __builtin_bit_cast(unsigned, f); return (u + 0x7fffu + ((u >> 16) & 1u)) >> 16; }
typedef float f32x2_t __attribute__((ext_vector_type(2))); typedef __bf16 bf16x2_t __attribute__((ext_vector_type(2)));
__device__ __forceinline__ unsigned pk2(float lo, float hi) { const f32x2_t v = {lo, hi}; return __builtin_bit_cast(unsigned, __builtin_convertvector(v, bf16x2_t)); }
__device__ __forceinline__ float wave_sum(float v) {
#pragma unroll
  for (int o = 32; o >= 1; o >>= 1) v += __shfl_xor(v, o, 64);
  return v;
}
__device__ __forceinline__ float wave_sum_dpp(float v) {
  v += __builtin_bit_cast(float, __builtin_amdgcn_update_dpp(0, __builtin_bit_cast(int, v), 0xB1, 0xf, 0xf, false));
  v += __builtin_bit_cast(float, __builtin_amdgcn_update_dpp(0, __builtin_bit_cast(int, v), 0x4E, 0xf, 0xf, false));
  v += __builtin_bit_cast(float, __builtin_amdgcn_update_dpp(0, __builtin_bit_cast(int, v), 0x141, 0xf, 0xf, false));
  v += __builtin_bit_cast(float, __builtin_amdgcn_update_dpp(0, __builtin_bit_cast(int, v), 0x140, 0xf, 0xf, false));
  const int iv = __builtin_bit_cast(int, v);
  return (__builtin_bit_cast(float, __builtin_amdgcn_readlane(iv, 0)) + __builtin_bit_cast(float, __builtin_amdgcn_readlane(iv, 16))) +
         (__builtin_bit_cast(float, __builtin_amdgcn_readlane(iv, 32)) + __builtin_bit_cast(float, __builtin_amdgcn_readlane(iv, 48)));
}
__device__ __forceinline__ int fresh_lane() { int l; asm volatile("v_mbcnt_lo_u32_b32 %0, -1, 0\n\tv_mbcnt_hi_u32_b32 %0, -1, %0" : "=v"(l)); return l; }
__device__ __forceinline__ float uniformf(float v) { return __builtin_bit_cast(float, __builtin_amdgcn_readfirstlane(__builtin_bit_cast(int, v))); }
__device__ __forceinline__ float sigmoidf_(float x) { return 1.f / (1.f + __expf(-x)); }
__device__ __forceinline__ float softplusf_(float x) { return fmaxf(x, 0.f) + __logf(1.f + __expf(-fabsf(x))); }
__device__ __forceinline__ float gelu_tanh(float x) {
  float u = 0.7978845608028654f * (x + 0.044715f * x * x * x);
  return 0.5f * x * (1.f + tanhf(u));
}

constexpr size_t MiB = 1u << 20;
constexpr size_t WS_CTL = 0, CTL_ZERO_BYTES = 1 * MiB;
constexpr size_t WS_WIN = 1 * MiB;
constexpr size_t WS_WOUT = 7 * MiB;
constexpr size_t WS_WRKV = 9 * MiB;
constexpr size_t WS_WO = 15 * MiB;
constexpr size_t WS_WL1 = 17 * MiB;
constexpr size_t WS_WL2 = 19 * MiB;
constexpr size_t WS_EGU = 22 * MiB;
constexpr size_t WS_EDN = 54 * MiB;
constexpr size_t WS_ACT = 70 * MiB;
constexpr size_t WS_XN = WS_ACT;
constexpr size_t WS_H = WS_ACT + 32 * MiB;
constexpr size_t WS_GATES = WS_ACT + 120 * MiB;
constexpr size_t WS_CAT = WS_ACT + 122 * MiB;
constexpr size_t WS_KCMPB = WS_ACT + 154 * MiB;
constexpr size_t WS_VCMPB = WS_ACT + 155 * MiB;
constexpr size_t WS_CW1 = 21 * MiB + 256 * 1024;
constexpr size_t WS_XN2 = WS_ACT;
constexpr size_t WS_HID = WS_ACT + 32 * MiB;
constexpr size_t WS_Y1 = WS_EGU;
constexpr size_t WS_LIST = WS_ACT + 156 * MiB;
constexpr size_t WS_PGATE = WS_ACT + 158 * MiB;
constexpr size_t WS_XN2F = WS_ACT;
constexpr size_t WS_GUF = WS_ACT + 64 * MiB;
constexpr size_t WS_S0 = WS_ACT;
constexpr size_t WS_TMP = WS_ACT + 192 * MiB;
constexpr size_t WS_END = WS_ACT + 204 * MiB;
constexpr size_t SLOT = 32 * MiB;
constexpr int CW_BAR = 4096;
constexpr int CW_CNT = 32768;

namespace pg8 {
#define PG8_LAS __attribute__((address_space(3)))
typedef unsigned u32x4 __attribute__((ext_vector_type(4)));
constexpr int BM = 256, BK = 64, HALF = 128, HTB = HALF * BK * 2  , STAGE_BYTES = 8 * HTB, NXCD = 8, WGM = 8;

__host__ __device__ __forceinline__ int lds_byte(int r, int c) { const int st = (r >> 4) * 2 + (c >> 5), rr = r & 15, cc = c & 31, ob = rr * 64 + cc * 2; return st * 1024 + (ob ^ (((ob >> 9) & 1) << 5)); }
__host__ __device__ __forceinline__ void stage_rc(int b, int& R, int& C) { const int st = b / 1024, sb = b % 1024, swz = sb ^ (((sb >> 9) & 1) << 5); R = (st >> 1) * 16 + swz / 64; C = (st & 1) * 32 + (swz % 64) / 2; }
__host__ __device__ __forceinline__ int perm32(int rho) { const int n = rho >> 4, i = rho & 15; return 8 * (i >> 2) + 4 * n + (i & 3); }

struct Unit { int pm, pn, e, nrows, rt, par; };
struct Gemm { const bf16_t* A; const bf16_t* Bt; int K; int lda; };

__device__ __forceinline__ void static_map(int L, int nM, int nN, int& pm, int& pn) {
    const int nwg = nM * nN;
    int wgid = L; { const int q = nwg / NXCD, r = nwg % NXCD, xcd = wgid % NXCD, off = wgid / NXCD; wgid = (xcd < r ? xcd * (q + 1) : r * (q + 1) + (xcd - r) * q) + off; }
    const int nig = WGM * nN, gid = wgid / nig, fm = gid * WGM, gsz = (nM - fm) < WGM ? (nM - fm) : WGM;
    pm = fm + ((wgid % nig) % gsz); pn = (wgid % nig) / gsz;
}
struct StaticOrder {
    int nM, nN, G, c;
    __device__ void init(int M, int N, int G_, int c_) { nM = M / BM; nN = N / BM; G = G_; c = c_; }
    __device__ __forceinline__ bool next(int i, Unit& u) const {
        const int L = i * G + c; if (L >= nM * nN) return false;
        static_map(L, nM, nN, u.pm, u.pn); u.e = 0; u.nrows = 256; u.rt = 0; return true;
    }
    __device__ __forceinline__ unsigned rowoff(const Unit& u, int r, int C, int K) const { return (unsigned)((u.pm * BM + r) * K + C) * 2u; }
};
struct TallOrder {
    int nM, nN, G, c;
    __device__ void init(int ngemm, int nN_, int G_, int c_) { nM = 64 * ngemm; nN = nN_; G = G_; c = c_; }
    __device__ __forceinline__ bool next(int i, Unit& u) const {
        const int L = i * G + c; if (L >= nM * nN) return false;
        int pn; static_map(L, nM, nN, u.pm, pn); u.pn = (u.pm >> 6) * nN + pn; u.e = 0; u.nrows = 256; u.rt = 0; return true;
    }
    __device__ __forceinline__ unsigned rowoff(const Unit& u, int r, int C, int K) const { return (unsigned)((u.pm * BM + r) * K + C) * 2u; }
};


template <int NCOL, bool GATHER>
struct MoeOrder {
    const PG8_LAS int* tab;
    const int* list; int G, c;
    __device__ __forceinline__ bool next(int i, Unit& u) const {
        const int L = i * G + c; const int R = L / NCOL, j = L - R * NCOL;
        if (R >= tab[32]) return false;
        int e = 0;
#pragma unroll
        for (int s = 16; s >= 1; s >>= 1) { if (tab[e + s] <= R) e += s; }
        const int ce = tab[33 + e];
        u.pm = R; u.rt = R - tab[e]; u.e = e; u.pn = e * NCOL + j; u.nrows = ce - u.rt * 256; return true;
    }
    __device__ __forceinline__ unsigned rowoff(const Unit& u, int r, int C, int K) const {
        if (GATHER) { const int idx = (r < u.nrows) ? u.rt * 256 + r : 0; const int pr = list[(size_t)u.e * CAP + idx]; return (unsigned)((pr >> 1) * K + C) * 2u; }
        return (unsigned)((u.pm * BM + r) * K + C) * 2u;
    }
};
__device__ __forceinline__ void moe_order_setup(PG8_LAS int* tab, const unsigned* cnt) {
    if (threadIdx.x < 32) tab[33 + threadIdx.x] = (int)__hip_atomic_load(cnt + threadIdx.x * 64, __ATOMIC_RELAXED, __HIP_MEMORY_SCOPE_AGENT);
    __syncthreads();
    if (threadIdx.x == 0) { int pre = 0; for (int e = 0; e < 32; ++e) { tab[e] = pre; pre += (tab[33 + e] + 255) >> 8; } tab[32] = pre; }
    __syncthreads();
}

__device__ __forceinline__ unsigned cvt_pk_bf16(float lo, float hi) { unsigned r; asm volatile("v_cvt_pk_bf16_f32 %0, %1, %2" : "=v"(r) : "v"(lo), "v"(hi)); return r; }
__device__ __forceinline__ u32x4 pack8(const f32x4& a, const f32x4& b) { u32x4 w; w.x = cvt_pk_bf16(a[0], a[1]); w.y = cvt_pk_bf16(a[2], a[3]); w.z = cvt_pk_bf16(b[0], b[1]); w.w = cvt_pk_bf16(b[2], b[3]); return w; }

template <class Epi, class Sched, bool ALIGN_EPI>
__device__ __forceinline__ void gemm_phase(PG8_LAS unsigned char* lds, const Gemm g, const Sched& S, const Epi& E) {
    const int tid = threadIdx.x, wid = __builtin_amdgcn_readfirstlane(tid >> 6), lane = tid & 63, wr = wid >> 2, wc = wid & 3, fr = lane & 15, fq = lane >> 4;
    const int K = g.K, nt = K / BK;
    int RA[2], CA[2]; unsigned voffB[2];
#pragma unroll
    for (int i = 0; i < 2; ++i) { int R, C; stage_rc(tid * 16 + i * 8192, R, C); const int Rb = Epi::PERM ? ((R & ~31) + perm32(R & 31)) : R;
        RA[i] = R; CA[i] = C; voffB[i] = (unsigned)(Rb * K + C) * 2u; }
    const size_t kstep = (size_t)(BK * 2);
    const size_t hstep = (size_t)HALF * K * 2;
    const size_t tstep = 2 * hstep;
    const unsigned ldsw = (unsigned)wid * 1024u;
    const int aoff = lds_byte(wr * 64 + fr, fq * 8), boff = lds_byte(wc * 32 + fr, fq * 8);
    const char* const Abase = (const char*)g.A;
#define PG8_SA(b, h) (((b) * 2 + (h)) * HTB)
#define PG8_SB(b, h) ((4 + (b) * 2 + (h)) * HTB)
#define PG8_STAGE(bufoff, gbase, voff) do { _Pragma("unroll") for (int _i = 0; _i < 2; ++_i) \
        __builtin_amdgcn_global_load_lds((const unsigned*)((const char*)(gbase) + (voff)[_i]), (PG8_LAS unsigned*)(lds + (bufoff) + ldsw + _i * 8192), 16, 0, 0); } while (0)
#define PG8_STAGEA(bufoff, kbyte, o0, o1) do { \
        __builtin_amdgcn_global_load_lds((const unsigned*)(Abase + (size_t)(kbyte) + (o0)), (PG8_LAS unsigned*)(lds + (bufoff) + ldsw), 16, 0, 0); \
        __builtin_amdgcn_global_load_lds((const unsigned*)(Abase + (size_t)(kbyte) + (o1)), (PG8_LAS unsigned*)(lds + (bufoff) + ldsw + 8192), 16, 0, 0); } while (0)
#define PG8_LDA(dst, b, h) do { _Pragma("unroll") for (int m = 0; m < 4; ++m) _Pragma("unroll") for (int k = 0; k < 2; ++k) dst[m][k] = *(const PG8_LAS bf16x8*)(lds + PG8_SA(b, h) + aoff + m * 2048 + k * 1024); } while (0)
#define PG8_LDB(dst, b, h) do { _Pragma("unroll") for (int n = 0; n < 2; ++n) _Pragma("unroll") for (int k = 0; k < 2; ++k) dst[n][k] = *(const PG8_LAS bf16x8*)(lds + PG8_SB(b, h) + boff + n * 2048 + k * 1024); } while (0)
#define PG8_MMA(ai, bj, At, Bt) do { __builtin_amdgcn_s_setprio(1); _Pragma("unroll") for (int m = 0; m < 4; ++m) _Pragma("unroll") for (int n = 0; n < 2; ++n) _Pragma("unroll") for (int k = 0; k < 2; ++k) \
        acc[ai][bj][m][n] = __builtin_amdgcn_mfma_f32_16x16x32_bf16(Bt[n][k], At[m][k], acc[ai][bj][m][n], 0, 0, 0); __builtin_amdgcn_s_setprio(0); } while (0)
#define PG8_WAIT_V(n) asm volatile("s_waitcnt vmcnt(" #n ")" ::: "memory")
#define PG8_WAIT_L(n) asm volatile("s_waitcnt lgkmcnt(" #n ")" ::: "memory")
#define PG8_BAR __builtin_amdgcn_s_barrier()
#define PG8_SCHED __builtin_amdgcn_sched_barrier(0)
    Unit cur, nxt; int ui = 0;
    if (!S.next(0, cur)) return;
    cur.par = 0;
    if constexpr (Epi::HAS_PRE) E.pre(cur);
    f32x4 acc[2][2][4][2];
#pragma unroll
    for (int a = 0; a < 2; ++a)
#pragma unroll
        for (int b = 0; b < 2; ++b)
#pragma unroll
            for (int m = 0; m < 4; ++m)
#pragma unroll
                for (int n = 0; n < 2; ++n) acc[a][b][m][n] = (f32x4){0.f, 0.f, 0.f, 0.f};
    bf16x8 At[4][2], B0[2][2], B1[2][2];
    unsigned c00 = S.rowoff(cur, RA[0], CA[0], g.lda), c01 = S.rowoff(cur, RA[1], CA[1], g.lda), c10 = S.rowoff(cur, HALF + RA[0], CA[0], g.lda), c11 = S.rowoff(cur, HALF + RA[1], CA[1], g.lda);
    unsigned n00, n01, n10, n11;
    const char* cB = (const char*)g.Bt + (size_t)cur.pn * tstep;
    PG8_STAGE(PG8_SB(0, 0), cB, voffB); PG8_STAGE(PG8_SB(0, 1), cB + hstep, voffB); PG8_STAGEA(PG8_SA(0, 0), 0, c00, c01); PG8_STAGEA(PG8_SA(0, 1), 0, c10, c11);
    if (wr == 1) PG8_BAR;
    PG8_WAIT_V(2); PG8_BAR;
    PG8_STAGE(PG8_SB(1, 0), cB + kstep, voffB); PG8_STAGEA(PG8_SA(1, 0), kstep, c00, c01); PG8_STAGE(PG8_SB(1, 1), cB + hstep + kstep, voffB);
    PG8_WAIT_V(6); PG8_BAR;
    for (;;) {
        const bool has_next = S.next(ui + 1, nxt);
        const char* nB = has_next ? (const char*)g.Bt + (size_t)nxt.pn * tstep : cB;
        if (has_next) { n00 = S.rowoff(nxt, RA[0], CA[0], g.lda); n01 = S.rowoff(nxt, RA[1], CA[1], g.lda); n10 = S.rowoff(nxt, HALF + RA[0], CA[0], g.lda); n11 = S.rowoff(nxt, HALF + RA[1], CA[1], g.lda); }
        else { n00 = c00; n01 = c01; n10 = c10; n11 = c11; }
        for (int t = 0; t < nt; t += 2) {
            const bool last = (t == nt - 2);
            const size_t k1 = (size_t)(t + 1) * kstep;
            const size_t k2 = last ? 0 : (size_t)(t + 2) * kstep;
            const size_t k3 = k2 + kstep;
            const unsigned a00 = last ? n00 : c00, a01 = last ? n01 : c01, a10 = last ? n10 : c10, a11 = last ? n11 : c11;
            const char* b2 = last ? nB : cB + (size_t)(t + 2) * kstep;
            const char* b3 = b2 + kstep;
            PG8_LDB(B0, 0, 0); PG8_LDB(B1, 0, 1); PG8_SCHED; PG8_LDA(At, 0, 0); PG8_STAGEA(PG8_SA(1, 1), k1, c10, c11);
            PG8_WAIT_V(8); PG8_WAIT_L(0); PG8_BAR; PG8_MMA(0, 0, At, B0); PG8_MMA(0, 1, At, B1); PG8_BAR; PG8_SCHED;
            PG8_LDA(At, 0, 1); PG8_STAGE(PG8_SB(0, 0), b2, voffB); PG8_STAGE(PG8_SB(0, 1), b2 + hstep, voffB); PG8_STAGEA(PG8_SA(0, 0), k2, a00, a01);
            PG8_WAIT_V(8); PG8_WAIT_L(0); PG8_BAR; PG8_MMA(1, 0, At, B0); PG8_MMA(1, 1, At, B1); PG8_BAR; PG8_SCHED;
            PG8_LDB(B0, 1, 0); PG8_LDB(B1, 1, 1); PG8_SCHED; PG8_LDA(At, 1, 0); PG8_STAGEA(PG8_SA(0, 1), k2, a10, a11);
            PG8_WAIT_V(8); PG8_WAIT_L(0); PG8_BAR; PG8_MMA(0, 0, At, B0); PG8_MMA(0, 1, At, B1); PG8_BAR; PG8_SCHED;
            PG8_LDA(At, 1, 1); PG8_STAGE(PG8_SB(1, 0), b3, voffB); PG8_STAGE(PG8_SB(1, 1), b3 + hstep, voffB); PG8_STAGEA(PG8_SA(1, 0), k3, a00, a01);
            PG8_WAIT_V(8); PG8_WAIT_L(0); PG8_BAR; PG8_MMA(1, 0, At, B0); PG8_MMA(1, 1, At, B1); PG8_BAR; PG8_SCHED;
        }
        if constexpr (ALIGN_EPI) { if (wr == 0) PG8_BAR; }
        E(acc, cur, wr, wc, fr, fq);
        if (!has_next) break;
#pragma unroll
        for (int a = 0; a < 2; ++a)
#pragma unroll
            for (int b = 0; b < 2; ++b)
#pragma unroll
                for (int m = 0; m < 4; ++m)
#pragma unroll
                    for (int n = 0; n < 2; ++n) acc[a][b][m][n] = (f32x4){0.f, 0.f, 0.f, 0.f};
        cur = nxt; cB = nB; c00 = n00; c01 = n01; c10 = n10; c11 = n11; ++ui; cur.par = ui & 1;
        if constexpr (Epi::HAS_PRE) E.pre(cur);
        if constexpr (ALIGN_EPI) { if (wr == 1) PG8_BAR; }
    }
    PG8_WAIT_V(0);
    if constexpr (!ALIGN_EPI) { if (wr == 0) PG8_BAR; }
    PG8_BAR;
#undef PG8_SA
#undef PG8_SB
#undef PG8_STAGE
#undef PG8_STAGEA
#undef PG8_LDA
#undef PG8_LDB
#undef PG8_MMA
#undef PG8_WAIT_V
#undef PG8_WAIT_L
#undef PG8_BAR
#undef PG8_SCHED
}
}

#define XB_TMO      128
#define XB_XCNT(j)  (256  + 64 * (j))
#define XB_XSUB(j)  (1280 + 64 * (j))
#define XB_XGEN(j)  (2304 + 64 * (j))
#define XB_TOP      3328
#define XB_TOPGEN   3392
#define XCD_BAR_WORDS 3456
#define XB_SPIN_CAP (1u << 18)

__device__ __forceinline__ unsigned xb_ld(unsigned* p)              { return __hip_atomic_load(p, __ATOMIC_RELAXED, __HIP_MEMORY_SCOPE_AGENT); }
__device__ __forceinline__ unsigned xb_add(unsigned* p, unsigned v) { return __hip_atomic_fetch_add(p, v, __ATOMIC_RELAXED, __HIP_MEMORY_SCOPE_AGENT); }
__device__ __forceinline__ unsigned xb_xcc_id() { return (unsigned)__builtin_amdgcn_s_getreg((3 << 11) | 20) & 0xFu; }
#define XB_SPIN(cond, bar) do { unsigned _sp = 0; while (cond) { __builtin_amdgcn_s_sleep(1); \
    if ((++_sp & 255u) == 0u) { if (xb_ld(&(bar)[XB_TMO])) break; if (_sp > XB_SPIN_CAP) { atomicAdd(&(bar)[XB_TMO], 1u); break; } } } } while (0)

struct XcdBarrier {
    unsigned* bar; unsigned x;
    volatile LAS unsigned* st;
};

__device__ __forceinline__ XcdBarrier xcd_barrier_post(unsigned* bar, volatile LAS unsigned* st) {
    XcdBarrier b; b.bar = bar; b.x = xb_xcc_id(); b.st = st;
    if (threadIdx.x == 0) (void)xb_add(&bar[XB_XCNT(b.x)], 1u);
    return b;
}
__device__ __forceinline__ void xcd_barrier_complete(unsigned* bar, unsigned x, unsigned& nloc, unsigned& nx) {
    const unsigned G = gridDim.x * gridDim.y * gridDim.z;
    unsigned sum, cnt, mine, sp = 0u;
    for (;;) {
        sum = 0u; cnt = 0u; mine = 0u;
#pragma unroll
        for (unsigned j = 0; j < 16; ++j) { const unsigned c = xb_ld(&bar[XB_XCNT(j)]); sum += c; cnt += (c > 0u) ? 1u : 0u; mine = (j == x) ? c : mine; }
        if (sum == G) break;
        __builtin_amdgcn_s_sleep(1);
        if ((++sp & 255u) == 0u) { if (xb_ld(&bar[XB_TMO])) break; if (sp > XB_SPIN_CAP) { atomicAdd(&bar[XB_TMO], 1u); break; } }
    }
    nloc = mine > 0u ? mine : 1u; nx = cnt > 0u ? cnt : 1u;
}

__device__ __forceinline__ void xcd_barrier(const XcdBarrier& b) {
    asm volatile("s_waitcnt vmcnt(0)" ::: "memory");
    __syncthreads();
    if (threadIdx.x == 0) {
        unsigned* bar = b.bar;
        __builtin_amdgcn_s_waitcnt(0);
        unsigned nloc = b.st[0], nx = b.st[1];
        if (nloc == 0u) { xcd_barrier_complete(bar, b.x, nloc, nx); b.st[0] = nloc; b.st[1] = nx; }
        const unsigned old = xb_add(&bar[XB_XSUB(b.x)], 1u);
        const unsigned gen = old / nloc;
        if (old + 1u == (gen + 1u) * nloc) {
            __builtin_amdgcn_fence(__ATOMIC_RELEASE, "agent");
            asm volatile("s_waitcnt vmcnt(0)" ::: "memory");
            const unsigned og = xb_add(&bar[XB_TOP], 1u);
            const unsigned tg = og / nx;
            if (og + 1u == (tg + 1u) * nx) xb_add(&bar[XB_TOPGEN], 1u);
            else XB_SPIN(xb_ld(&bar[XB_TOPGEN]) == tg, bar);
            __builtin_amdgcn_fence(__ATOMIC_ACQUIRE, "agent");
            xb_add(&bar[XB_XGEN(b.x)], 1u);
            asm volatile("s_waitcnt vmcnt(0)" ::: "memory");
        } else {
            XB_SPIN(xb_ld(&bar[XB_XGEN(b.x)]) == gen, bar);
            __builtin_amdgcn_fence(__ATOMIC_ACQUIRE, "agent");
            asm volatile("s_waitcnt vmcnt(0)" ::: "memory");
        }
    }
    __syncthreads();
}
struct P {
  const float* x; const float* mix_norm; const float* w_in; const float* gate_bias;
  const float* dq_norm; const float* dk_norm; const float* dlam; const float* dsubln;
  const float* nq_norm; const float* nk_norm; const float* cmp_pe; const float* cmp_w1; const float* cmp_w2;
  const float* w_out;
  const float* rmix; const float* w_r; const float* w_k; const float* w_v;
  const float* w0; const float* w1; const float* w2; const float* a0; const float* a1; const float* a2;
  const float* g1; const float* g2; const float* k_k; const float* k_a; const float* r_k;
  const float* ln_w; const float* ln_b; const float* w_o;
  const float* ffn_norm; const float* rg_w; const float* rg_b; const float* re_w; const float* re_b;
  const float* e_gate; const float* e_up; const float* e_down;
  float* out;
  unsigned char* ws;
  int ph_lo, ph_hi, layer, pad;
};

#define PREF const __attribute__((address_space(4))) P&
__device__ __forceinline__ const __attribute__((address_space(4))) P* opaque_kernarg() { auto q = __builtin_amdgcn_kernarg_segment_ptr(); asm volatile("" : "+s"(q)); return (const __attribute__((address_space(4))) P*)q; }
#define KP (*opaque_kernarg())

constexpr int RING_OFF = 0, RING_BYTES = 131072;
constexpr int LDSCTL_OFF = RING_BYTES, MISC_OFF = LDSCTL_OFF + 320;
constexpr int LDS_BYTES = 147456;
constexpr int NWAVES = 8;

struct Frame {
  LAS unsigned char* lds;
  volatile LAS unsigned* MISC;
  gu32* ctl;
  int tid, lane, wave, vcu, G;
#ifdef PROBE_PH
  unsigned long long pr_t0, pr_t1;
#endif
};
#ifdef PROBE_PH
#define PROBE_MARK(k) do { if ((k) == PROBE_PH) F.pr_t0 = __builtin_amdgcn_s_memrealtime(); if ((k) == PROBE_PH + PROBE_N) F.pr_t1 = __builtin_amdgcn_s_memrealtime(); } while (0)
#else
#define PROBE_MARK(k) do {} while (0)
#endif

__device__ __forceinline__ void transpose_item(const float* W, int ldsrc, int k0, int c0, int ncols, bf16_t* dst, int ldk, int drow0, LAS float* scr, int lane) {
  const int kr = lane >> 3, c4 = (lane & 7) * 4;
  f32x4 v[8];
#pragma unroll
  for (int i = 0; i < 8; ++i) v[i] = (c4 < ncols) ? *(const GAS f32x4*)(W + (size_t)(k0 + kr + 8 * i) * ldsrc + c0 + c4) : (f32x4){0.f, 0.f, 0.f, 0.f};
#pragma unroll
  for (int i = 0; i < 8; ++i) { LAS float* s = scr + (kr + 8 * i) * 33 + c4; s[0] = v[i].x; s[1] = v[i].y; s[2] = v[i].z; s[3] = v[i].w; }
  LDS_WAIT(); asm volatile("" ::: "memory");
  const int c = lane & 7;
#pragma unroll
  for (int j = 0; j < 4; ++j) { const int n = (lane >> 3) + 8 * j; const LAS float* s = scr + (8 * c) * 33 + n;
    v4u o; o.x = pk2(s[0 * 33], s[1 * 33]); o.y = pk2(s[2 * 33], s[3 * 33]); o.z = pk2(s[4 * 33], s[5 * 33]); o.w = pk2(s[6 * 33], s[7 * 33]);
    *(GAS v4u*)(dst + (size_t)(drow0 + n) * ldk + k0 + 8 * c) = o; }
  LDS_WAIT(); asm volatile("" ::: "memory");
}
template <int NR>
__device__ __forceinline__ void rms_rows_to_bf16(const float* x, const float* gain, bf16_t* o, int m0, int stride, int lane) {
  f32x4 v[NR][4];
#pragma unroll
  for (int r = 0; r < NR; ++r) { const GAS f32x4* xr = (const GAS f32x4*)(x + (size_t)(m0 + r * stride) * DM) + lane;
#pragma unroll
    for (int j = 0; j < 4; ++j) v[r][j] = xr[64 * j]; }
  const GAS f32x4* gr = (const GAS f32x4*)gain + lane;
  f32x4 g[4];
#pragma unroll
  for (int j = 0; j < 4; ++j) g[j] = gr[64 * j];
#pragma unroll
  for (int r = 0; r < NR; ++r) {
    float s = 0.f;
#pragma unroll
    for (int j = 0; j < 4; ++j) s += (v[r][j].x * v[r][j].x + v[r][j].y * v[r][j].y) + (v[r][j].z * v[r][j].z + v[r][j].w * v[r][j].w);
    const float rr = rsqrtf(wave_sum_dpp(s) * (1.f / DM) + 1e-6f);
    GAS v2u* o8 = (GAS v2u*)(o + (size_t)(m0 + r * stride) * DM) + lane;
#pragma unroll
    for (int j = 0; j < 4; ++j) { v2u w; w.x = pk2(v[r][j].x * rr * g[j].x, v[r][j].y * rr * g[j].y); w.y = pk2(v[r][j].z * rr * g[j].z, v[r][j].w * rr * g[j].w); o8[64 * j] = w; }
  }
}

__device__ __forceinline__ void conv_win_item(PREF p, int it, LAS float* scr, int lane) {
  const int vg = it >> 4, kb = it & 15;
  const int pn = vg >> 3, bj = (vg >> 2) & 1, wc = vg & 3, s = pn * 4 + wc;
  int c0 = 0, nc = 0;
  if (s < 44) { c0 = 64 * s + 32 * bj; nc = 32; } else if (s == 44 && bj == 0) { c0 = OFF_NG; nc = 24; }
  transpose_item(p.w_in, INC, kb * 64, c0, nc, (bf16_t*)(p.ws + WS_WIN), DM, vg * 32, scr, lane);
}
__device__ __forceinline__ void conv_sq_item(const float* W, bf16_t* dst, int drow_base, int it, LAS float* scr, int lane) {
  const int cg = it >> 4, kb = it & 15;
  transpose_item(W, DM, kb * 64, cg * 32, 32, dst, DM, drow_base + cg * 32, scr, lane);
}
__device__ __forceinline__ void conv_expert_item(PREF p, int layer, int it, LAS float* scr, int lane) {
  const int e = it / 384, r = it % 384;
  if (r < 256) {
    const int up = r >> 7, q = r & 127, cgp = q >> 4, kb = q & 15;
    const int pn = cgp >> 2, qq = cgp & 3;
    const float* W = (up ? p.e_up : p.e_gate) + ((size_t)layer * 32 + e) * DM * 256;
    transpose_item(W, 256, kb * 64, cgp * 32, 32, (bf16_t*)(p.ws + WS_EGU), DM, e * 512 + pn * 256 + up * 128 + qq * 32, scr, lane);
  } else {
    const int q = r - 256, cg = q >> 2, kb = q & 3;
    const float* W = p.e_down + ((size_t)layer * 32 + e) * 256 * DM;
    transpose_item(W, DM, kb * 64, cg * 32, 32, (bf16_t*)(p.ws + WS_EDN), 256, e * 1024 + cg * 32, scr, lane);
  }
}

using pg8::Unit; using pg8::u32x4; using pg8::pack8;
struct EpiInProj {
  static constexpr bool PERM = true, HAS_PRE = false;
  bf16_t* H; float* GATES; const float* dq; const float* dk; const float* nq; const float* nk; const float* gbias;
  __device__ __forceinline__ void operator()(const f32x4 (&acc)[2][2][4][2], const Unit& u, int wr, int wc, int fr, int fq) const {
    const int s = u.pn * 4 + wc;
    if (s > 44) return;
    const int row0 = u.pm * 256 + wr * 64 + fr;
    if (s == 44) {
      if (fq < 3) {
        f32x4 b0 = *(const f32x4*)(gbias + 8 * fq), b1 = *(const f32x4*)(gbias + 8 * fq + 4);
#pragma unroll
        for (int ai = 0; ai < 2; ++ai)
#pragma unroll
          for (int m = 0; m < 4; ++m) { float* gp = GATES + (size_t)(row0 + ai * 128 + m * 16) * 24 + 8 * fq;
            f32x4 v0 = acc[ai][0][m][0] + b0, v1 = acc[ai][0][m][1] + b1;
#pragma unroll
            for (int i = 0; i < 4; ++i) { v0[i] = sigmoidf_(v0[i]); v1[i] = sigmoidf_(v1[i]); }
            *(f32x4*)gp = v0; *(f32x4*)(gp + 4) = v1; }
      }
      return;
    }
    int mode = 0; const float* gain = nullptr;
    if (s < 8) { mode = 1; gain = dq; } else if (s < 16) { mode = 1; gain = dk; }
    else if (s >= 24 && s < 32) { mode = 2; gain = nq; }
    else if (s >= 32) { const int q = s - 32, br = q >> 2, kv = (q >> 1) & 1; if (kv == 0 && br >= 1) { mode = 2; gain = nk + br * 64; } }
    const float qsc = (s < 8) ? 0.17677669529663687f * 1.4426950408889634f : ((s >= 24 && s < 32) ? 0.125f * 1.4426950408889634f : 1.f);
    f32x4 g[2][2];
#pragma unroll
    for (int bj = 0; bj < 2; ++bj)
#pragma unroll
      for (int n = 0; n < 2; ++n) {
        if (mode == 1) g[bj][n] = *(const f32x4*)(gain + 8 * fq + 4 * n);
        else if (mode == 2) g[bj][n] = *(const f32x4*)(gain + 32 * bj + 8 * fq + 4 * n);
        else g[bj][n] = (f32x4){1.f, 1.f, 1.f, 1.f};
      }
#pragma unroll
    for (int ai = 0; ai < 2; ++ai)
#pragma unroll
      for (int m = 0; m < 4; ++m) {
        float sc[2] = {1.f, 1.f};
        if (mode != 0) {
          float ss[2];
#pragma unroll
          for (int bj = 0; bj < 2; ++bj) { const f32x4 a = acc[ai][bj][m][0], b = acc[ai][bj][m][1];
            float t = (a[0] * a[0] + a[1] * a[1]) + (a[2] * a[2] + a[3] * a[3]) + (b[0] * b[0] + b[1] * b[1]) + (b[2] * b[2] + b[3] * b[3]);
            t += __shfl_xor(t, 16, 64); t += __shfl_xor(t, 32, 64); ss[bj] = t; }
          if (mode == 1) { sc[0] = rsqrtf(ss[0] * (1.f / 32.f) + 1e-6f) * qsc; sc[1] = rsqrtf(ss[1] * (1.f / 32.f) + 1e-6f) * qsc; }
          else { const float r = rsqrtf((ss[0] + ss[1]) * (1.f / 64.f) + 1e-6f) * qsc; sc[0] = r; sc[1] = r; }
        }
        bf16_t* rowp = H + (size_t)(row0 + ai * 128 + m * 16) * HC + 64 * s + 8 * fq;
#pragma unroll
        for (int bj = 0; bj < 2; ++bj) { const f32x4 v0 = acc[ai][bj][m][0] * sc[bj] * g[bj][0], v1 = acc[ai][bj][m][1] * sc[bj] * g[bj][1];
          *(u32x4*)(rowp + 32 * bj) = pack8(v0, v1); }
      }
  }
};
struct EpiResid {
  static constexpr bool PERM = false, HAS_PRE = false;
  const float* base; float* out; const bf16_t* y1;
  __device__ __forceinline__ void operator()(const f32x4 (&acc)[2][2][4][2], const Unit& u, int wr, int wc, int fr, int fq) const {
    const int row0 = u.pm * 256 + wr * 64 + fr, col0 = u.pn * 256 + wc * 32 + 4 * fq;
#pragma unroll
    for (int ai = 0; ai < 2; ++ai)
#pragma unroll
      for (int m = 0; m < 4; ++m) { const size_t off = (size_t)(row0 + ai * 128 + m * 16) * DM + col0;
#pragma unroll
        for (int bj = 0; bj < 2; ++bj)
#pragma unroll
          for (int n = 0; n < 2; ++n) { f32x4 b = *(const f32x4*)(base + off + bj * 128 + n * 16);
            if (y1) { const v2u y = *(const v2u*)(y1 + off + bj * 128 + n * 16);
              b.x += __uint_as_float(y.x << 16); b.y += __uint_as_float(y.x & 0xffff0000u); b.z += __uint_as_float(y.y << 16); b.w += __uint_as_float(y.y & 0xffff0000u); }
            *(f32x4*)(out + off + bj * 128 + n * 16) = b + acc[ai][bj][m][n]; asm volatile("" ::: "memory"); } }
  }
};
struct EpiRKV {
  static constexpr bool PERM = true, HAS_PRE = false;
  unsigned char* ws;
  __device__ __forceinline__ void operator()(const f32x4 (&acc)[2][2][4][2], const Unit& u, int wr, int wc, int fr, int fq) const {
    const int gi = u.pm >> 6;
    bf16_t* O = (bf16_t*)(ws + WS_S0 + (size_t)(3 + gi) * SLOT);
    const int row0 = (u.pm & 63) * 256 + wr * 64 + fr, col0 = (u.pn & 3) * 256 + wc * 32 + 8 * fq;
#pragma unroll
    for (int ai = 0; ai < 2; ++ai)
#pragma unroll
      for (int m = 0; m < 4; ++m) { bf16_t* rowp = O + (size_t)(row0 + ai * 128 + m * 16) * DM + col0;
#pragma unroll
        for (int bj = 0; bj < 2; ++bj) *(u32x4*)(rowp + bj * 128) = pack8(acc[ai][bj][m][0], acc[ai][bj][m][1]); }
  }
};
struct EpiLora1 {
  static constexpr bool PERM = true, HAS_PRE = false;
  bf16_t* TMP;
  template <int BJ>
  __device__ __forceinline__ void half(const f32x4 (&acc)[2][2][4][2], int gi, int row0, int wc, int fq) const {
    const int c = BJ * 128 + wc * 32 + 8 * fq;
    const bool skip = (gi < 2) && (c >= 64);
    const int dcol = (gi < 2) ? gi * 64 + c : 128 + c;
    const bool zero = (gi == 2) && (c >= 160);
    if (skip) return;
#pragma unroll
    for (int ai = 0; ai < 2; ++ai)
#pragma unroll
      for (int m = 0; m < 4; ++m) {
        f32x4 v0 = acc[ai][BJ][m][0], v1 = acc[ai][BJ][m][1];
#pragma unroll
        for (int i = 0; i < 4; ++i) {
          if (gi == 0) { v0[i] = tanhf(v0[i]); v1[i] = tanhf(v1[i]); }
          else if (gi == 2) { v0[i] = zero ? 0.f : sigmoidf_(v0[i]); v1[i] = zero ? 0.f : sigmoidf_(v1[i]); }
        }
        *(u32x4*)(TMP + (size_t)(row0 + ai * 128 + m * 16) * 384 + dcol) = pack8(v0, v1);
      }
  }
  __device__ __forceinline__ void operator()(const f32x4 (&acc)[2][2][4][2], const Unit& u, int wr, int wc, int fr, int fq) const {
    const int gi = u.pm >> 6;
    const int row0 = (u.pm & 63) * 256 + wr * 64 + fr;
    half<0>(acc, gi, row0, wc, fq);
    half<1>(acc, gi, row0, wc, fq);
  }
};
struct EpiLora2 {
  static constexpr bool PERM = true, HAS_PRE = false;
  unsigned char* ws; const float* w0; const float* a0; int gbase;
  __device__ __forceinline__ void operator()(const f32x4 (&acc)[2][2][4][2], const Unit& u, int wr, int wc, int fr, int fq) const {
    const int gi = gbase + (u.pn >> 2);
    bf16_t* O = (bf16_t*)(ws + WS_S0 + (size_t)gi * SLOT);
    const int row0 = u.pm * 256 + wr * 64 + fr, col0 = (u.pn & 3) * 256 + wc * 32 + 8 * fq;
    f32x4 b[2][2];
#pragma unroll
    for (int bj = 0; bj < 2; ++bj)
#pragma unroll
      for (int n = 0; n < 2; ++n) b[bj][n] = (gi == 0) ? *(const f32x4*)(w0 + col0 + bj * 128 + 4 * n) : (gi == 1 ? *(const f32x4*)(a0 + col0 + bj * 128 + 4 * n) : (f32x4){0.f, 0.f, 0.f, 0.f});
#pragma unroll
    for (int ai = 0; ai < 2; ++ai)
#pragma unroll
      for (int m = 0; m < 4; ++m) { bf16_t* rowp = O + (size_t)(row0 + ai * 128 + m * 16) * DM + col0;
#pragma unroll
        for (int bj = 0; bj < 2; ++bj) { f32x4 v0 = acc[ai][bj][m][0] + b[bj][0], v1 = acc[ai][bj][m][1] + b[bj][1];
          if (gi == 0) {
#pragma unroll
            for (int i = 0; i < 4; ++i) { v0[i] = -__expf(-softplusf_(-v0[i]) - 0.5f); v1[i] = -__expf(-softplusf_(-v1[i]) - 0.5f); }
          } else if (gi == 1) {
#pragma unroll
            for (int i = 0; i < 4; ++i) { v0[i] = sigmoidf_(v0[i]); v1[i] = sigmoidf_(v1[i]); }
          }
          *(u32x4*)(rowp + bj * 128) = pack8(v0, v1); } }
  }
};
struct EpiMoeGU {
  static constexpr bool PERM = true, HAS_PRE = false;
  bf16_t* HID;
  __device__ __forceinline__ void operator()(const f32x4 (&acc)[2][2][4][2], const Unit& u, int wr, int wc, int fr, int fq) const {
    const int row0 = u.pm * 256 + wr * 64 + fr, col0 = (u.pn & 1) * 128 + wc * 32 + 8 * fq;
#pragma unroll
    for (int ai = 0; ai < 2; ++ai)
#pragma unroll
      for (int m = 0; m < 4; ++m) {
        f32x4 h[2];
#pragma unroll
        for (int n = 0; n < 2; ++n) { const f32x4 g = acc[ai][0][m][n], up = acc[ai][1][m][n];
#pragma unroll
          for (int i = 0; i < 4; ++i) h[n][i] = g[i] * sigmoidf_(g[i]) * up[i]; }
        *(u32x4*)(HID + (size_t)(row0 + ai * 128 + m * 16) * 256 + col0) = pack8(h[0], h[1]);
      }
  }
};
struct EpiMoeDown {
  static constexpr bool PERM = false, HAS_PRE = true;
  float* out; bf16_t* Y1; const int* list; const float* pgate; LAS int* ept;
  __device__ __forceinline__ void pre(const Unit& u) const {
    const int r = threadIdx.x;
    if (r < 256) { int pr = -1; float gt = 0.f;
      if (r < u.nrows) { pr = list[(size_t)u.e * CAP + u.rt * 256 + r]; gt = pgate[pr]; }
      LAS int* e = ept + (u.par * 256 + r) * 2; e[0] = pr; e[1] = __float_as_int(gt); }
  }
  __device__ __forceinline__ void operator()(const f32x4 (&acc)[2][2][4][2], const Unit& u, int wr, int wc, int fr, int fq) const {
    const int col0 = (u.pn & 3) * 256 + wc * 32 + 4 * fq;
#pragma unroll
    for (int ai = 0; ai < 2; ++ai)
#pragma unroll
      for (int m = 0; m < 4; ++m) {
        const int r = ai * 128 + wr * 64 + m * 16 + fr;
        const LAS int* e = ept + (u.par * 256 + r) * 2;
        const int pr = e[0]; const float gt = __int_as_float(e[1]);
        if (pr >= 0) {
          const int tok = pr >> 1;
          if ((pr & 1) == 0) {
            float* op = out + (size_t)tok * DM + col0;
#pragma unroll
            for (int bj = 0; bj < 2; ++bj)
#pragma unroll
              for (int n = 0; n < 2; ++n) { f32x4 b = *(const f32x4*)(op + bj * 128 + n * 16); *(f32x4*)(op + bj * 128 + n * 16) = b + acc[ai][bj][m][n] * gt; }
          } else {
            bf16_t* yp = Y1 + (size_t)tok * DM + col0;
#pragma unroll
            for (int bj = 0; bj < 2; ++bj)
#pragma unroll
              for (int n = 0; n < 2; ++n) { const f32x4 v = acc[ai][bj][m][n] * gt; v2u w; w.x = pk2(v[0], v[1]); w.y = pk2(v[2], v[3]); *(v2u*)(yp + bj * 128 + n * 16) = w; }
          }
        }
      }
  }
};

__device__ __forceinline__ void phase_prologue(PREF p, Frame& F) {
  const int lane = fresh_lane();
  LAS float* scr = (LAS float*)(F.lds + RING_OFF + F.wave * 16384);
  const int gw = F.vcu * NWAVES + F.wave, NGW = F.G * NWAVES;
  constexpr int I_WIN = 96 * 16, I_SQ = 32 * 16;
  constexpr int NITEMS = I_WIN + 5 * I_SQ + 128;
  for (int it = gw; it < NITEMS; it += NGW) {
    int r = it;
    if (r < I_WIN) { conv_win_item(p, r, scr, fresh_lane()); continue; } r -= I_WIN;
    if (r < I_SQ) { conv_sq_item(p.w_out, (bf16_t*)(p.ws + WS_WOUT), 0, r, scr, fresh_lane()); continue; } r -= I_SQ;
    if (r < I_SQ) { conv_sq_item(p.w_r, (bf16_t*)(p.ws + WS_WRKV), 0, r, scr, fresh_lane()); continue; } r -= I_SQ;
    if (r < I_SQ) { conv_sq_item(p.w_k, (bf16_t*)(p.ws + WS_WRKV), 1024, r, scr, fresh_lane()); continue; } r -= I_SQ;
    if (r < I_SQ) { conv_sq_item(p.w_v, (bf16_t*)(p.ws + WS_WRKV), 2048, r, scr, fresh_lane()); continue; } r -= I_SQ;
    if (r < I_SQ) { conv_sq_item(p.w_o, (bf16_t*)(p.ws + WS_WO), 0, r, scr, fresh_lane()); continue; } r -= I_SQ;
    { const int kv = r >> 6, q = r & 63, kb = q >> 1, cg = q & 1;
      transpose_item(p.cmp_w1 + (size_t)kv * 2048 * 64, 64, kb * 64, cg * 32, 32, (bf16_t*)(p.ws + WS_CW1) + (size_t)kv * 64 * 2048, 2048, cg * 32, scr, fresh_lane()); }
  }
  {
    const int gt = (F.vcu * NWAVES + F.wave) * 64 + fresh_lane(), NGT = NGW * 64;
    bf16_t* WL1 = (bf16_t*)(p.ws + WS_WL1);
    for (int i = gt; i < 768 * 1024; i += NGT) {
      const int n = i >> 10, k = i & 1023, gi = n >> 8, c = n & 255;
      float v = 0.f;
      if (gi == 0) { if (c < 64) v = p.w1[k * 64 + c]; }
      else if (gi == 1) { if (c < 64) v = p.a1[k * 64 + c]; }
      else { if (c < 160) v = p.g1[k * 160 + c]; }
      WL1[i] = (bf16_t)f2bf(v);
    }
    bf16_t* WL2 = (bf16_t*)(p.ws + WS_WL2);
    for (int i = gt; i < 2048 * 128; i += NGT) {
      const int n = i >> 7, k = i & 127, c = n & 1023;
      float v = 0.f;
      if (n < 1024) { if (k < 64) v = p.w2[k * 1024 + c]; }
      else { if (k >= 64) v = p.a2[(k - 64) * 1024 + c]; }
      WL2[i] = (bf16_t)f2bf(v);
    }
    bf16_t* WL2g = (bf16_t*)(p.ws + WS_WL2 + 512 * 1024);
    for (int i = gt; i < 1024 * 256; i += NGT) {
      const int n = i >> 8, k = i & 255;
      WL2g[i] = (bf16_t)f2bf(k < 160 ? p.g2[k * 1024 + n] : 0.f);
    }
  }
  bf16_t* XN = (bf16_t*)(p.ws + WS_XN);
  for (int m = gw; m < T_TOK; m += 4 * NGW) rms_rows_to_bf16<4>(p.x, p.mix_norm, XN, m, NGW, lane);
}


__device__ __forceinline__ void phase_router(PREF p, Frame& F, int layer) {
  const int gw = F.vcu * NWAVES + F.wave, NGW = F.G * NWAVES;
  const int lane = fresh_lane();
  PROBE_MARK(100 + layer * 10);
  {
    LAS float* scr = (LAS float*)(F.lds + RING_OFF + F.wave * 16384);
    for (int it = gw; it < 32 * 384; it += NGW) conv_expert_item(p, layer, it, scr, lane);
  }
  __syncthreads();
  PROBE_MARK(101 + layer * 10);
  LAS float* WQ = (LAS float*)(F.lds);
  LAS float* XS = (LAS float*)(F.lds + 40960) + F.wave * 2080;
  LAS float* LG = (LAS float*)(F.lds + 107520) + F.wave * 8 * 36;
  const float* gain = p.ffn_norm + layer * DM;
  const float* wg = p.rg_w + (size_t)layer * DM * 4;
  const float* we = p.re_w + (size_t)layer * DM * 32;
  bf16_t* XN2 = (bf16_t*)(p.ws + WS_XN2);
  f32x4 v[8][4];
#pragma unroll
  for (int tt = 0; tt < 8; ++tt) { const GAS f32x4* xr = (const GAS f32x4*)(p.out + (size_t)(gw * 8 + tt) * DM) + lane;
#pragma unroll
    for (int j = 0; j < 4; ++j) v[tt][j] = xr[64 * j]; }
  {
    f32x4 g[4];
#pragma unroll
    for (int j = 0; j < 4; ++j) g[j] = ((const GAS f32x4*)gain)[lane + 64 * j];
#pragma unroll
    for (int tt = 0; tt < 8; ++tt) {
      float s = 0.f;
#pragma unroll
      for (int j = 0; j < 4; ++j) s += (v[tt][j].x * v[tt][j].x + v[tt][j].y * v[tt][j].y) + (v[tt][j].z * v[tt][j].z + v[tt][j].w * v[tt][j].w);
      const float r = rsqrtf(wave_sum_dpp(s) * (1.f / DM) + 1e-6f);
      GAS v2u* o = (GAS v2u*)(XN2 + (size_t)(gw * 8 + tt) * DM) + lane;
#pragma unroll
      for (int j = 0; j < 4; ++j) { v[tt][j] = v[tt][j] * r * g[j]; v2u w; w.x = pk2(v[tt][j].x, v[tt][j].y); w.y = pk2(v[tt][j].z, v[tt][j].w); o[64 * j] = w; }
    }
  }
  PROBE_MARK(102 + layer * 10);
  f32x4 acc[3];
#pragma unroll
  for (int nt = 0; nt < 3; ++nt) acc[nt] = (f32x4){0.f, 0.f, 0.f, 0.f};
  const int r16 = lane & 15, g4 = lane >> 4;
#pragma unroll
  for (int j = 0; j < 4; ++j) {
    __syncthreads();
    for (int idx = F.tid; idx < 256 * 9; idx += NWAVES * 64) {
      const int row = idx / 9, c4 = idx - row * 9, k = 256 * j + row;
      const f32x4 val = (c4 == 0) ? *(const GAS f32x4*)(wg + k * 4) : *(const GAS f32x4*)(we + k * 32 + (c4 - 1) * 4);
      *(LAS f32x4*)(WQ + row * 36 + c4 * 4) = val;
    }
#pragma unroll
    for (int tt = 0; tt < 8; ++tt) *(LAS f32x4*)(XS + tt * 260 + 4 * lane) = v[tt][j];
    __syncthreads();
    const LAS float* xa = XS + (r16 & 7) * 260 + g4;
    const LAS float* wb = WQ + g4 * 36 + r16;
#pragma unroll 4
    for (int ks = 0; ks < 64; ++ks) {
      const float a = xa[4 * ks];
#pragma unroll
      for (int nt = 0; nt < 3; ++nt) acc[nt] = __builtin_amdgcn_mfma_f32_16x16x4f32(a, wb[4 * ks * 36 + nt * 16], acc[nt], 0, 0, 0);
    }
  }
  PROBE_MARK(103 + layer * 10);
  if (g4 < 2) {
#pragma unroll
    for (int nt = 0; nt < 3; ++nt) { const int n = nt * 16 + r16;
      if (n < 36) {
#pragma unroll
        for (int i = 0; i < 4; ++i) LG[(4 * g4 + i) * 36 + n] = acc[nt][i]; } }
  }
  LAS unsigned* LC = (LAS unsigned*)(F.lds + 118784);
  if (F.tid < 64) LC[F.tid] = 0u;
  __syncthreads();
  int ea = 0, eb = 0; unsigned la = 0, lb = 0; float ga = 0.f, gb = 0.f;
  if (lane < 8) {
    const LAS float* lg = LG + lane * 36;
    const float* bg = p.rg_b + layer * 4;
    const float* be = p.re_b + layer * 32;
    float gl[4]; int gi = 0; float gm = -3.4e38f;
#pragma unroll
    for (int i = 0; i < 4; i++) { gl[i] = lg[i] + bg[i]; if (gl[i] > gm) { gm = gl[i]; gi = i; } }
    float gs = 0.f;
#pragma unroll
    for (int i = 0; i < 4; i++) gs += __expf(gl[i] - gm);
    const float grp_p = 1.f / gs;
    float v0 = -3.4e38f, v1 = -3.4e38f; int i0 = 0, i1 = 0;
    for (int i = 0; i < 8; i++) {
      const float v = lg[4 + gi * 8 + i] + be[gi * 8 + i];
      if (v > v0) { v1 = v0; i1 = i0; v0 = v; i0 = i; }
      else if (v > v1) { v1 = v; i1 = i; }
    }
    const float e1 = __expf(v1 - v0);
    ga = grp_p / (1.f + e1); gb = grp_p * e1 / (1.f + e1);
    ea = gi * 8 + i0; eb = gi * 8 + i1;
    la = __hip_atomic_fetch_add(LC + ea, 1u, __ATOMIC_RELAXED, __HIP_MEMORY_SCOPE_WORKGROUP);
    lb = __hip_atomic_fetch_add(LC + eb, 1u, __ATOMIC_RELAXED, __HIP_MEMORY_SCOPE_WORKGROUP);
  }
  __syncthreads();
  if (F.tid < 32) { const unsigned n = LC[F.tid];
    unsigned* cnt = (unsigned*)(p.ws + WS_CTL) + CW_CNT + (layer * 32 + F.tid) * 64;
    LC[32 + F.tid] = n ? __hip_atomic_fetch_add(cnt, n, __ATOMIC_RELAXED, __HIP_MEMORY_SCOPE_AGENT) : 0u; }
  __syncthreads();
  if (lane < 8) {
    const int t = gw * 8 + lane;
    int* list = (int*)(p.ws + WS_LIST); float* pgate = (float*)(p.ws + WS_PGATE);
    list[(size_t)ea * CAP + LC[32 + ea] + la] = 2 * t; pgate[2 * t] = ga;
    list[(size_t)eb * CAP + LC[32 + eb] + lb] = 2 * t + 1; pgate[2 * t + 1] = gb;
  }
  PROBE_MARK(104 + layer * 10);
}

__device__ __forceinline__ void phase_final(PREF p, Frame& F) {
  const int gw = F.vcu * NWAVES + F.wave, NGW = F.G * NWAVES;
  const bf16_t* Y1 = (const bf16_t*)(p.ws + WS_Y1);
  for (int t = gw; t < T_TOK; t += NGW) {
    GAS f32x4* xr = (GAS f32x4*)(p.out + (size_t)t * DM) + fresh_lane();
    const GAS v2u* yr = (const GAS v2u*)(Y1 + (size_t)t * DM) + fresh_lane();
#pragma unroll
    for (int j = 0; j < 4; ++j) { f32x4 v = xr[64 * j]; const v2u y = yr[64 * j];
      v.x += __uint_as_float(y.x << 16); v.y += __uint_as_float(y.x & 0xffff0000u); v.z += __uint_as_float(y.y << 16); v.w += __uint_as_float(y.y & 0xffff0000u);
      xr[64 * j] = v; }
  }
}

__device__ __forceinline__ void phase_rwkv_prep(PREF p, Frame& F) {
  const int gw = F.vcu * NWAVES + F.wave, NGW = F.G * NWAVES;
  const int lane = fresh_lane();
  const float* gain = p.mix_norm + DM;
  const bf16_t* Y1 = (const bf16_t*)(p.ws + WS_Y1);
  f32x4 g[4];
#pragma unroll
  for (int j = 0; j < 4; ++j) g[j] = ((const GAS f32x4*)gain)[lane + 64 * j];
  for (int run = gw; run < T_TOK / 8; run += NGW) {
    const int t0 = run * 8;
    f32x4 prev[4];
    if ((t0 & (SEQ - 1)) == 0) {
#pragma unroll
      for (int j = 0; j < 4; ++j) prev[j] = (f32x4){0.f, 0.f, 0.f, 0.f};
    } else {
      const GAS f32x4* xr = (const GAS f32x4*)(p.out + (size_t)(t0 - 1) * DM) + lane;
      const GAS v2u* yr = (const GAS v2u*)(Y1 + (size_t)(t0 - 1) * DM) + lane;
      float s = 0.f;
#pragma unroll
      for (int j = 0; j < 4; ++j) { prev[j] = xr[64 * j]; const v2u y = yr[64 * j];
        prev[j].x += __uint_as_float(y.x << 16); prev[j].y += __uint_as_float(y.x & 0xffff0000u); prev[j].z += __uint_as_float(y.y << 16); prev[j].w += __uint_as_float(y.y & 0xffff0000u);
        s += (prev[j].x * prev[j].x + prev[j].y * prev[j].y) + (prev[j].z * prev[j].z + prev[j].w * prev[j].w); }
      const float r = rsqrtf(wave_sum(s) * (1.f / DM) + 1e-6f);
#pragma unroll
      for (int j = 0; j < 4; ++j) prev[j] = prev[j] * r * g[j];
    }
    f32x4 nx[4]; v2u ny[4];
    { const GAS f32x4* xr = (const GAS f32x4*)(p.out + (size_t)t0 * DM) + lane; const GAS v2u* yr = (const GAS v2u*)(Y1 + (size_t)t0 * DM) + lane;
#pragma unroll
      for (int j = 0; j < 4; ++j) { nx[j] = xr[64 * j]; ny[j] = yr[64 * j]; } }
#pragma unroll 1
    for (int tt = 0; tt < 8; ++tt) {
      const int t = t0 + tt;
      f32x4 v[4]; float s = 0.f;
#pragma unroll
      for (int j = 0; j < 4; ++j) { v[j] = nx[j]; const v2u y = ny[j];
        v[j].x += __uint_as_float(y.x << 16); v[j].y += __uint_as_float(y.x & 0xffff0000u); v[j].z += __uint_as_float(y.y << 16); v[j].w += __uint_as_float(y.y & 0xffff0000u);
        s += (v[j].x * v[j].x + v[j].y * v[j].y) + (v[j].z * v[j].z + v[j].w * v[j].w); }
      if (tt < 7) { const GAS f32x4* xr = (const GAS f32x4*)(p.out + (size_t)(t + 1) * DM) + lane; const GAS v2u* yr = (const GAS v2u*)(Y1 + (size_t)(t + 1) * DM) + lane;
#pragma unroll
        for (int j = 0; j < 4; ++j) { nx[j] = xr[64 * j]; ny[j] = yr[64 * j]; } }
      const float r = rsqrtf(wave_sum_dpp(s) * (1.f / DM) + 1e-6f);
#pragma unroll
      for (int j = 0; j < 4; ++j) v[j] = v[j] * r * g[j];
#pragma unroll
      for (int sl = 0; sl < 6; ++sl) {
        const int mj = (sl == 0) ? 0 : (sl == 1) ? 2 : (sl == 2) ? 3 : (sl == 3) ? 1 : (sl == 4) ? 4 : 5;
        GAS v2u* o = (GAS v2u*)(p.ws + WS_S0 + (size_t)sl * SLOT + (size_t)t * DM * 2) + lane;
#pragma unroll
        for (int j = 0; j < 4; ++j) {
          const f32x4 mx = ((const GAS f32x4*)(p.rmix + mj * DM))[lane + 64 * j];
          const f32x4 q = v[j] + (prev[j] - v[j]) * mx;
          v2u w; w.x = pk2(q.x, q.y); w.y = pk2(q.z, q.w);
          o[64 * j] = w;
        }
      }
#pragma unroll
      for (int j = 0; j < 4; ++j) prev[j] = v[j];
    }
  }
}


constexpr int RP = 72;
constexpr int RB = 64 * RP * 2;
typedef LAS bf16_t* lbf;

__device__ __forceinline__ f32x4 mm16(f32x4 acc, const LAS bf16_t* A, int arow0, const LAS bf16_t* Bt, int brow0, int lane) {
  const int r = lane & 15, q = lane >> 4;
#pragma unroll
  for (int ks = 0; ks < 2; ++ks) {
    const bf16x8 a = *(const LAS bf16x8*)(A + (arow0 + r) * RP + ks * 32 + q * 8);
    const bf16x8 b = *(const LAS bf16x8*)(Bt + (brow0 + r) * RP + ks * 32 + q * 8);
    acc = __builtin_amdgcn_mfma_f32_16x16x32_bf16(a, b, acc, 0, 0, 0);
  }
  return acc;
}
__device__ __forceinline__ float sum8(float v) {
  v += __shfl_xor(v, 1, 64); v += __shfl_xor(v, 2, 64); v += __shfl_xor(v, 4, 64); return v;
}
__device__ __forceinline__ void ld8bf(const bf16_t* p, float (&o)[8]) {
  const v4u w = *(const GAS v4u*)p;
  o[0] = __uint_as_float(w.x << 16); o[1] = __uint_as_float(w.x & 0xffff0000u); o[2] = __uint_as_float(w.y << 16); o[3] = __uint_as_float(w.y & 0xffff0000u);
  o[4] = __uint_as_float(w.z << 16); o[5] = __uint_as_float(w.z & 0xffff0000u); o[6] = __uint_as_float(w.w << 16); o[7] = __uint_as_float(w.w & 0xffff0000u);
}
__device__ __forceinline__ v4u pk8(const float (&o)[8]) { v4u w; w.x = pk2(o[0], o[1]); w.y = pk2(o[2], o[3]); w.z = pk2(o[4], o[5]); w.w = pk2(o[6], o[7]); return w; }

#define R1_BAR() do { asm volatile("s_waitcnt lgkmcnt(0)" ::: "memory"); __builtin_amdgcn_s_barrier(); asm volatile("" ::: "memory"); } while (0)
__device__ __forceinline__ void stT(LAS bf16_t* Dst, int x0, int y0, const f32x4& acc, int lane) {
  v2u w; w.x = pk2(acc[0], acc[1]); w.y = pk2(acc[2], acc[3]);
  *(LAS v2u*)(Dst + (x0 + (lane & 15)) * RP + y0 + (lane >> 4) * 4) = w;
}
struct R1In { v4u r, ld, k, v, a; };
__device__ __forceinline__ R1In rwkv_r1_load(PREF p, int item, int tid) {
  const int ch = item >> 6, c = item & 63, b = ch >> 4, hd = ch & 15;
  const size_t off = ((size_t)(b * SEQ + c * 64 + (tid >> 3)) * DM + hd * 64 + (tid & 7) * 8);
  const bf16_t* s0 = (const bf16_t*)(p.ws + WS_S0);
  R1In in;
  in.r = *(const GAS v4u*)(s0 + 3 * (SLOT / 2) + off); in.ld = *(const GAS v4u*)(s0 + off); in.k = *(const GAS v4u*)(s0 + 4 * (SLOT / 2) + off);
  in.v = *(const GAS v4u*)(s0 + 5 * (SLOT / 2) + off); in.a = *(const GAS v4u*)(s0 + (SLOT / 2) + off);
  return in;
}
__device__ __forceinline__ void un8(const v4u w, float (&o)[8]) {
  o[0] = __uint_as_float(w.x << 16); o[1] = __uint_as_float(w.x & 0xffff0000u); o[2] = __uint_as_float(w.y << 16); o[3] = __uint_as_float(w.y & 0xffff0000u);
  o[4] = __uint_as_float(w.z << 16); o[5] = __uint_as_float(w.z & 0xffff0000u); o[6] = __uint_as_float(w.w << 16); o[7] = __uint_as_float(w.w & 0xffff0000u);
}
__device__ __forceinline__ void rwkv_r1_item(PREF p, Frame& F, int item, const R1In& in) {
  const int tid = F.tid, lane = fresh_lane(), w = F.wave;
  const int ch = item >> 6, c = item & 63, b = ch >> 4, hd = ch & 15;
  const size_t tile0 = ((size_t)(b * SEQ + c * 64) * DM + hd * 64);
  unsigned char* ws = p.ws;
  bf16_t* SL[6];
#pragma unroll
  for (int s = 0; s < 6; ++s) SL[s] = (bf16_t*)(ws + WS_S0 + (size_t)s * SLOT) + tile0;
  const lbf BtT = (lbf)(F.lds + 0 * RB), KtT = (lbf)(F.lds + 1 * RB), AbT = (lbf)(F.lds + 2 * RB), RbT = (lbf)(F.lds + 3 * RB);
  const lbf Ab = (lbf)(F.lds + 4 * RB), Vc = (lbf)(F.lds + 5 * RB), Bh = (lbf)(F.lds + 6 * RB), Kh = (lbf)(F.lds + 7 * RB);
  const lbf Tk = (lbf)(F.lds + 8 * RB), WbT = (lbf)(F.lds + 9 * RB), WkT = (lbf)(F.lds + 10 * RB);
  const lbf X = BtT, XT = KtT, Pb = AbT;
  const lbf At = X, TNT = XT, U0 = Tk;
  LAS float* Lf = (LAS float*)(F.lds + 11 * RB);
  LAS float* SEG = Lf + 64 * 65;
  LAS float* GC = (LAS float*)(F.lds + 14 * RB);
  const int t = tid >> 3, cg = tid & 7, k0 = cg * 8;
  float r_[8], ld_[8], kx[8], v_[8], a_[8];
  un8(in.r, r_); un8(in.ld, ld_); un8(in.k, kx); un8(in.v, v_); un8(in.a, a_);
  float kk[8], km[8], be[8];
  {
    float ss = 0.f, bo = 0.f;
#pragma unroll
    for (int i = 0; i < 8; ++i) { const int cc = hd * 64 + k0 + i; kk[i] = kx[i] * p.k_k[cc]; ss += kk[i] * kk[i]; km[i] = kx[i] * (1.f + (a_[i] - 1.f) * p.k_a[cc]); bo += r_[i] * km[i] * p.r_k[cc]; }
    ss = sum8(ss); bo = sum8(bo);
    const float inv = 1.f / fmaxf(sqrtf(ss), 1e-12f);
#pragma unroll
    for (int i = 0; i < 8; ++i) { kk[i] *= inv; be[i] = kk[i] * a_[i]; }
    if (cg == 0) ((float*)(ws + WS_TMP))[(size_t)item * 64 + t] = bo;
  }
#pragma unroll
  for (int i = 0; i < 8; ++i) Lf[t * 65 + k0 + i] = ld_[i];
  R1_BAR();
  {
    const int k = tid & 63, sg = tid >> 6;
    float run = 0.f;
#pragma unroll
    for (int i = 0; i < 8; ++i) { run += Lf[(sg * 8 + i) * 65 + k]; Lf[(sg * 8 + i) * 65 + k] = run; }
    SEG[sg * 64 + k] = run;
    R1_BAR();
    float off = 0.f;
    for (int j = 0; j < sg; ++j) off += SEG[j * 64 + k];
#pragma unroll
    for (int i = 0; i < 8; ++i) Lf[(sg * 8 + i) * 65 + k] += off;
  }
  R1_BAR();
  {
    float ab[8], bt[8], kt[8], rb[8], bh[8], kh[8];
#pragma unroll
    for (int i = 0; i < 8; ++i) {
      const float Lt = Lf[t * 65 + k0 + i], Lp = (t > 0) ? Lf[(t - 1) * 65 + k0 + i] : 0.f, LC = Lf[63 * 65 + k0 + i];
      const float ei = __expf(-Lt), eh = __expf(LC - Lt);
      if (t == 63) GC[k0 + i] = __expf(LC);
      ab[i] = -kk[i] * __expf(Lp); bt[i] = be[i] * ei; kt[i] = km[i] * ei; rb[i] = r_[i] * __expf(Lt); bh[i] = be[i] * eh; kh[i] = km[i] * eh;
    }
    *(LAS v4u*)(BtT + t * RP + k0) = pk8(bt); *(LAS v4u*)(KtT + t * RP + k0) = pk8(kt); *(LAS v4u*)(AbT + t * RP + k0) = pk8(ab); *(LAS v4u*)(RbT + t * RP + k0) = pk8(rb);
#pragma unroll
    for (int i = 0; i < 8; ++i) { Ab[(k0 + i) * RP + t] = (bf16_t)f2bf(ab[i]); Vc[(k0 + i) * RP + t] = (bf16_t)f2bf(v_[i]); Bh[(k0 + i) * RP + t] = (bf16_t)f2bf(bh[i]); Kh[(k0 + i) * RP + t] = (bf16_t)f2bf(kh[i]); }
  }
  R1_BAR();
  const int ya = (w >> 1) * 16, xb0 = (w & 1) * 32;
  const int cr = lane & 15, q4 = (lane >> 4) * 4;
  const f32x4 Z4 = {0.f, 0.f, 0.f, 0.f};
  f32x4 accP[2];
  {
    f32x4 tabn[2], tabs[2], taks[2], wbr[2], wkr[2];
#pragma unroll
    for (int j = 0; j < 2; ++j) { const int xb = xb0 + 16 * j;
      tabn[j] = mm16(Z4, BtT, ya, AbT, xb, lane);
      tabs[j] = mm16(Z4, AbT, ya, BtT, xb, lane);
      taks[j] = mm16(Z4, AbT, ya, KtT, xb, lane);
      wbr[j] = mm16(Z4, BtT, ya, RbT, xb, lane);
      wkr[j] = mm16(Z4, KtT, ya, RbT, xb, lane); }
    R1_BAR();
#pragma unroll
    for (int j = 0; j < 2; ++j) { const int xb = xb0 + 16 * j;
      f32x4 xt, xr, pr, tk, wb, wk;
#pragma unroll
      for (int i = 0; i < 4; ++i) {
        { const int s = ya + q4 + i, tt = xb + cr; xt[i] = (s < tt) ? tabn[j][i] : 0.f; wb[i] = (s <= tt) ? wbr[j][i] : 0.f; wk[i] = (s <= tt) ? wkr[j][i] : 0.f; }
        { const int tt = ya + q4 + i, s = xb + cr; xr[i] = (s < tt) ? tabs[j][i] : 0.f; pr[i] = xr[i] + ((s == tt) ? 1.f : 0.f); tk[i] = (s < tt) ? taks[j][i] : 0.f; }
      }
      accP[j] = pr;
      stT(XT, xb, ya, xt, lane); stT(WbT, xb, ya, wb, lane); stT(WkT, xb, ya, wk, lane);
      stT(X, xb, ya, xr, lane); stT(Pb, xb, ya, pr, lane); stT(Tk, xb, ya, tk, lane); }
  }
  R1_BAR();
#pragma unroll 1
  for (int st = 0; st < 5; ++st) {
    f32x4 xr[2], xt[2];
#pragma unroll
    for (int j = 0; j < 2; ++j) { const int xb = xb0 + 16 * j;
      xr[j] = mm16(Z4, XT, ya, X, xb, lane);
      xt[j] = mm16(Z4, X, ya, XT, xb, lane);
      if (st > 0) accP[j] = mm16(accP[j], XT, ya, Pb, xb, lane); }
    R1_BAR();
#pragma unroll
    for (int j = 0; j < 2; ++j) { const int xb = xb0 + 16 * j; stT(X, xb, ya, xr[j], lane); stT(XT, xb, ya, xt[j], lane); stT(Pb, xb, ya, accP[j], lane); }
    R1_BAR();
  }
  {
    f32x4 nt[2];
#pragma unroll
    for (int j = 0; j < 2; ++j) { const int xb = xb0 + 16 * j; nt[j] = mm16(Z4, Pb, ya, XT, xb, lane);
#pragma unroll
      for (int i = 0; i < 4; ++i) nt[j][i] += bf2f(Pb[(ya + q4 + i) * RP + xb + cr]); }
    R1_BAR();
#pragma unroll
    for (int j = 0; j < 2; ++j) stT(Pb, xb0 + 16 * j, ya, nt[j], lane);
    R1_BAR();
  }
  const lbf NT = Pb;
  {
    f32x4 at[2], tn[2];
#pragma unroll
    for (int j = 0; j < 2; ++j) { const int xb = xb0 + 16 * j; at[j] = mm16(Z4, NT, ya, Ab, xb, lane); tn[j] = mm16(Z4, Tk, ya, NT, xb, lane); }
#pragma unroll
    for (int j = 0; j < 2; ++j) { const int xb = xb0 + 16 * j; stT(At, xb, ya, at[j], lane); stT(TNT, xb, ya, tn[j], lane); }
  }
  R1_BAR();
  const lbf O_RT = (lbf)(F.lds + 11 * RB), O_PM = (lbf)(F.lds + 12 * RB), O_Y0 = (lbf)(F.lds + 13 * RB), O_Q = (lbf)(F.lds + 3 * RB)  ;
  {
    f32x4 u0[2], rt[2], pm[2];
#pragma unroll
    for (int j = 0; j < 2; ++j) { const int xb = xb0 + 16 * j;
      u0[j] = mm16(Z4, TNT, ya, Vc, xb, lane);
      rt[j] = mm16(Z4, At, ya, WbT, xb, lane);
      pm[j] = mm16(Z4, At, ya, Bh, xb, lane);
      const v2u rbw = *(const LAS v2u*)(RbT + (xb + cr) * RP + ya + q4);
      rt[j][0] += __uint_as_float(rbw.x << 16); rt[j][1] += __uint_as_float(rbw.x & 0xffff0000u); rt[j][2] += __uint_as_float(rbw.y << 16); rt[j][3] += __uint_as_float(rbw.y & 0xffff0000u);
#pragma unroll
      for (int i = 0; i < 4; ++i) if (ya + q4 + i == xb + cr) pm[j][i] += GC[xb + cr]; }
    R1_BAR();
#pragma unroll
    for (int j = 0; j < 2; ++j) { const int xb = xb0 + 16 * j; stT(U0, xb, ya, u0[j], lane); stT(O_RT, xb, ya, rt[j], lane); stT(O_PM, xb, ya, pm[j], lane); }
  }
  R1_BAR();
  {
    f32x4 y0[2], qq[2];
#pragma unroll
    for (int j = 0; j < 2; ++j) { const int xb = xb0 + 16 * j;
      y0[j] = mm16(mm16(Z4, U0, ya, WbT, xb, lane), Vc, ya, WkT, xb, lane);
      qq[j] = mm16(mm16(Z4, Bh, ya, U0, xb, lane), Kh, ya, Vc, xb, lane); }
#pragma unroll
    for (int j = 0; j < 2; ++j) { const int xb = xb0 + 16 * j; stT(O_Y0, xb, ya, y0[j], lane); stT(O_Q, xb, ya, qq[j], lane); }
  }
  R1_BAR();
  {
    const int row = tid >> 3, pc = (tid & 7) * 8;
    *(GAS v4u*)(SL[3] + (size_t)row * DM + pc) = *(const LAS v4u*)(O_RT + row * RP + pc);
    *(GAS v4u*)(SL[0] + (size_t)row * DM + pc) = *(const LAS v4u*)(O_PM + row * RP + pc);
    *(GAS v4u*)(SL[4] + (size_t)row * DM + pc) = *(const LAS v4u*)(O_Y0 + row * RP + pc);
    *(GAS v4u*)(SL[1] + (size_t)row * DM + pc) = *(const LAS v4u*)(O_Q + row * RP + pc);
  }
  R1_BAR();
}

__device__ __forceinline__ void phase_rwkv_r1(PREF p, Frame& F) {
  int item = F.vcu;
  if (item >= 4096) return;
  R1In nxt = rwkv_r1_load(p, item, F.tid);
  for (; item < 4096; item += F.G) {
    const R1In cur = nxt;
    if (item + F.G < 4096) nxt = rwkv_r1_load(p, item + F.G, F.tid);
    rwkv_r1_item(p, F, item, cur);
  }
}

__device__ __forceinline__ void phase_rwkv_r2(PREF p, Frame& F) {
  if (F.wave != 0) return;
  const int lane = fresh_lane();
  const lbf Sh = (lbf)(F.lds), Sl = (lbf)(F.lds + 16 * RP * 2);
  const int cr = lane & 15, g = lane >> 4;
  for (int task = F.vcu; task < 256; task += F.G) {
    const int ch = task >> 2, jb = task & 3, b = ch >> 4, hd = ch & 15;
    const bf16_t* PM = (const bf16_t*)(p.ws + WS_S0) + ((size_t)(b * SEQ) * DM + hd * 64);
    bf16_t* QS = (bf16_t*)(p.ws + WS_S0 + SLOT) + ((size_t)(b * SEQ) * DM + hd * 64);
    for (int i = lane; i < 16 * RP; i += 64) { Sh[i] = 0; Sl[i] = 0; }
    const bf16_t* pmp = PM + (size_t)cr * DM + g * 8;
    bf16_t* qsp = QS + (size_t)(16 * jb + cr) * DM + g * 4;
    bf16x8 pa[4][4][2]; v2u qv[4][4];
#pragma unroll
    for (int d = 0; d < 4; ++d)
#pragma unroll
      for (int ct = 0; ct < 4; ++ct) { pa[d][ct][0] = *(const GAS bf16x8*)(pmp + (size_t)(d * 64 + 16 * ct) * DM); pa[d][ct][1] = *(const GAS bf16x8*)(pmp + (size_t)(d * 64 + 16 * ct) * DM + 32);
        qv[d][ct] = *(const GAS v2u*)(qsp + (size_t)d * 64 * DM + 16 * ct); }
    asm volatile("s_waitcnt lgkmcnt(0)" ::: "memory");
#pragma unroll 1
    for (int c4 = 0; c4 < 64; c4 += 4) {
#pragma unroll
      for (int d = 0; d < 4; ++d) {
        const int c = c4 + d;
        const bf16x8 bh0 = *(const LAS bf16x8*)(Sh + cr * RP + g * 8), bh1 = *(const LAS bf16x8*)(Sh + cr * RP + 32 + g * 8);
        const bf16x8 bl0 = *(const LAS bf16x8*)(Sl + cr * RP + g * 8), bl1 = *(const LAS bf16x8*)(Sl + cr * RP + 32 + g * 8);
        f32x4 acc[4];
#pragma unroll
        for (int ct = 0; ct < 4; ++ct) {
          acc[ct] = (f32x4){__uint_as_float(qv[d][ct].x << 16), __uint_as_float(qv[d][ct].x & 0xffff0000u), __uint_as_float(qv[d][ct].y << 16), __uint_as_float(qv[d][ct].y & 0xffff0000u)};
          acc[ct] = __builtin_amdgcn_mfma_f32_16x16x32_bf16(pa[d][ct][0], bh0, acc[ct], 0, 0, 0);
          acc[ct] = __builtin_amdgcn_mfma_f32_16x16x32_bf16(pa[d][ct][1], bh1, acc[ct], 0, 0, 0);
          acc[ct] = __builtin_amdgcn_mfma_f32_16x16x32_bf16(pa[d][ct][0], bl0, acc[ct], 0, 0, 0);
          acc[ct] = __builtin_amdgcn_mfma_f32_16x16x32_bf16(pa[d][ct][1], bl1, acc[ct], 0, 0, 0);
        }
        if (c + 4 < 64) {
#pragma unroll
          for (int ct = 0; ct < 4; ++ct) { pa[d][ct][0] = *(const GAS bf16x8*)(pmp + (size_t)((c + 4) * 64 + 16 * ct) * DM); pa[d][ct][1] = *(const GAS bf16x8*)(pmp + (size_t)((c + 4) * 64 + 16 * ct) * DM + 32);
            qv[d][ct] = *(const GAS v2u*)(qsp + (size_t)(c + 4) * 64 * DM + 16 * ct); }
        }
#pragma unroll
        for (int ct = 0; ct < 4; ++ct) {
          v2u hi; hi.x = pk2(acc[ct][0], acc[ct][1]); hi.y = pk2(acc[ct][2], acc[ct][3]);
          const float l0 = acc[ct][0] - __uint_as_float(hi.x << 16), l1 = acc[ct][1] - __uint_as_float(hi.x & 0xffff0000u), l2 = acc[ct][2] - __uint_as_float(hi.y << 16), l3 = acc[ct][3] - __uint_as_float(hi.y & 0xffff0000u);
          v2u lo; lo.x = pk2(l0, l1); lo.y = pk2(l2, l3);
          *(LAS v2u*)(Sh + cr * RP + 16 * ct + g * 4) = hi; *(LAS v2u*)(Sl + cr * RP + 16 * ct + g * 4) = lo;
          *(GAS v2u*)(qsp + (size_t)c * 64 * DM + 16 * ct) = hi;
        }
        asm volatile("s_waitcnt lgkmcnt(0)" ::: "memory");
      }
    }
  }
}

__device__ __forceinline__ void phase_rwkv_r3(PREF p, Frame& F) {
  const int lane = fresh_lane(), w = F.wave;
  const int cr = lane & 15, g = lane >> 4;
  const int half = w >> 2, tb = w & 3;
  for (int it2 = F.vcu; it2 < 2048; it2 += F.G) {
    const int item = it2 * 2 + half;
    const int ch = item >> 6, c = item & 63, b = ch >> 4, hd = ch & 15;
    const size_t tile0 = ((size_t)(b * SEQ + c * 64) * DM + hd * 64);
    bf16_t* RT = (bf16_t*)(p.ws + WS_S0 + 3 * SLOT) + tile0;
    const bf16_t* Y0 = (const bf16_t*)(p.ws + WS_S0 + 4 * SLOT) + tile0;
    const bf16_t* VV = (const bf16_t*)(p.ws + WS_S0 + 5 * SLOT) + tile0;
    const bf16_t* GG = (const bf16_t*)(p.ws + WS_S0 + 2 * SLOT) + tile0;
    const bf16_t* SC = (const bf16_t*)(p.ws + WS_S0 + SLOT) + tile0 - (size_t)64 * DM;
    const int tt = 16 * tb + cr;
    const size_t trow = (size_t)tt * DM + g * 4;
    v2u y0w[4], vw[4], gw[4];
#pragma unroll
    for (int j = 0; j < 4; ++j) { y0w[j] = *(const GAS v2u*)(Y0 + trow + 16 * j); vw[j] = *(const GAS v2u*)(VV + trow + 16 * j); gw[j] = *(const GAS v2u*)(GG + trow + 16 * j); }
    const float bo = ((const float*)(p.ws + WS_TMP))[(size_t)item * 64 + tt];
    f32x4 y[4];
#pragma unroll
    for (int j = 0; j < 4; ++j) y[j] = (f32x4){__uint_as_float(y0w[j].x << 16), __uint_as_float(y0w[j].x & 0xffff0000u), __uint_as_float(y0w[j].y << 16), __uint_as_float(y0w[j].y & 0xffff0000u)};
    if (c > 0) {
      const bf16_t* bp = RT + (size_t)tt * DM + g * 8;
      const bf16x8 b0 = *(const GAS bf16x8*)bp, b1 = *(const GAS bf16x8*)(bp + 32);
#pragma unroll
      for (int j = 0; j < 4; ++j) {
        const bf16_t* ap = SC + (size_t)(16 * j + cr) * DM + g * 8;
        const bf16x8 a0 = *(const GAS bf16x8*)ap, a1 = *(const GAS bf16x8*)(ap + 32);
        y[j] = __builtin_amdgcn_mfma_f32_16x16x32_bf16(a0, b0, y[j], 0, 0, 0);
        y[j] = __builtin_amdgcn_mfma_f32_16x16x32_bf16(a1, b1, y[j], 0, 0, 0);
      }
    }
    float s = 0.f;
#pragma unroll
    for (int j = 0; j < 4; ++j) s += (y[j][0] + y[j][1]) + (y[j][2] + y[j][3]);
    s += __shfl_xor(s, 16, 64); s += __shfl_xor(s, 32, 64);
    const float mu = s * (1.f / 64.f);
    float qd = 0.f;
#pragma unroll
    for (int j = 0; j < 4; ++j)
#pragma unroll
      for (int i = 0; i < 4; ++i) { const float d = y[j][i] - mu; qd += d * d; }
    qd += __shfl_xor(qd, 16, 64); qd += __shfl_xor(qd, 32, 64);
    const float rs = rsqrtf(qd * (1.f / 64.f) + 64e-5f);
#pragma unroll
    for (int j = 0; j < 4; ++j) {
      const int cc = hd * 64 + 16 * j + 4 * g;
      const f32x4 lw = *(const f32x4*)(p.ln_w + cc), lb = *(const f32x4*)(p.ln_b + cc);
      const float vv[4] = {__uint_as_float(vw[j].x << 16), __uint_as_float(vw[j].x & 0xffff0000u), __uint_as_float(vw[j].y << 16), __uint_as_float(vw[j].y & 0xffff0000u)};
      const float gg[4] = {__uint_as_float(gw[j].x << 16), __uint_as_float(gw[j].x & 0xffff0000u), __uint_as_float(gw[j].y << 16), __uint_as_float(gw[j].y & 0xffff0000u)};
      float z[4];
#pragma unroll
      for (int i = 0; i < 4; ++i) z[i] = ((y[j][i] - mu) * rs * lw[i] + lb[i] + bo * vv[i]) * gg[i];
      v2u zw; zw.x = pk2(z[0], z[1]); zw.y = pk2(z[2], z[3]);
      *(GAS v2u*)(RT + trow + 16 * j) = zw;
    }
  }
}

typedef short v4i16_t __attribute__((ext_vector_type(4)));
__device__ __forceinline__ v4i16_t tr16(const LAS bf16_t* p) { return __builtin_amdgcn_ds_read_tr16_b64_v4i16((LAS v4i16_t*)p); }

template <int KS>
__device__ __forceinline__ void qk_tile(f32x4 (&st)[4][2], const LAS bf16_t* Kt, int kc0, const bf16x8 (&qf)[2][KS], int lane) {
  const int r = lane & 15, g = lane >> 4;
#pragma unroll
  for (int kt = 0; kt < 4; ++kt)
#pragma unroll
    for (int ks = 0; ks < KS; ++ks) {
      const bf16x8 a = *(const LAS bf16x8*)(Kt + (kt * 16 + r) * RP + kc0 + ks * 32 + g * 8);
#pragma unroll
      for (int qt = 0; qt < 2; ++qt) st[kt][qt] = __builtin_amdgcn_mfma_f32_16x16x32_bf16(a, qf[qt][ks], st[kt][qt], 0, 0, 0);
    }
}
__device__ __forceinline__ void pack_p(bf16x8 (&pb)[2][2], const f32x4 (&pr)[4][2]) {
#pragma unroll
  for (int kb = 0; kb < 2; ++kb)
#pragma unroll
    for (int qt = 0; qt < 2; ++qt) {
      const v4u w = {pk2(pr[2 * kb][qt][0], pr[2 * kb][qt][1]), pk2(pr[2 * kb][qt][2], pr[2 * kb][qt][3]), pk2(pr[2 * kb + 1][qt][0], pr[2 * kb + 1][qt][1]), pk2(pr[2 * kb + 1][qt][2], pr[2 * kb + 1][qt][3])};
      pb[kb][qt] = __builtin_bit_cast(bf16x8, w);
    }
}
__device__ __forceinline__ void pv_apply(f32x4 (&o)[4][2], f32x4 (&osum)[2], const bf16x8 (&pb)[2][2], const LAS bf16_t* Vt, int lane) {
  const int g = lane >> 4, qq = (lane & 15) >> 2, pp = lane & 3;
  const bf16x8 ones = {0x3F80, 0x3F80, 0x3F80, 0x3F80, 0x3F80, 0x3F80, 0x3F80, 0x3F80};
#pragma unroll
  for (int kb = 0; kb < 2; ++kb)
#pragma unroll
    for (int qt = 0; qt < 2; ++qt) osum[qt] = __builtin_amdgcn_mfma_f32_16x16x32_bf16(ones, pb[kb][qt], osum[qt], 0, 0, 0);
#pragma unroll
  for (int dt = 0; dt < 4; ++dt)
#pragma unroll
    for (int kb = 0; kb < 2; ++kb) {
      const v4i16_t lo = tr16(Vt + (32 * kb + 4 * g + qq) * RP + dt * 16 + 4 * pp);
      const v4i16_t hi = tr16(Vt + (32 * kb + 16 + 4 * g + qq) * RP + dt * 16 + 4 * pp);
      const bf16x8 a = {lo[0], lo[1], lo[2], lo[3], hi[0], hi[1], hi[2], hi[3]};
#pragma unroll
      for (int qt = 0; qt < 2; ++qt) o[dt][qt] = __builtin_amdgcn_mfma_f32_16x16x32_bf16(a, pb[kb][qt], o[dt][qt], 0, 0, 0);
    }
}
__device__ __forceinline__ void pv_apply2(f32x4 (&o1)[4][2], f32x4 (&o2)[4][2], f32x4 (&os1)[2], f32x4 (&os2)[2], const bf16x8 (&pb1)[2][2], const bf16x8 (&pb2)[2][2], const LAS bf16_t* Vt, int lane) {
  const int g = lane >> 4, qq = (lane & 15) >> 2, pp = lane & 3;
  const bf16x8 ones = {0x3F80, 0x3F80, 0x3F80, 0x3F80, 0x3F80, 0x3F80, 0x3F80, 0x3F80};
#pragma unroll
  for (int kb = 0; kb < 2; ++kb)
#pragma unroll
    for (int qt = 0; qt < 2; ++qt) { os1[qt] = __builtin_amdgcn_mfma_f32_16x16x32_bf16(ones, pb1[kb][qt], os1[qt], 0, 0, 0); os2[qt] = __builtin_amdgcn_mfma_f32_16x16x32_bf16(ones, pb2[kb][qt], os2[qt], 0, 0, 0); }
#pragma unroll
  for (int dt = 0; dt < 4; ++dt)
#pragma unroll
    for (int kb = 0; kb < 2; ++kb) {
      const v4i16_t lo = tr16(Vt + (32 * kb + 4 * g + qq) * RP + dt * 16 + 4 * pp);
      const v4i16_t hi = tr16(Vt + (32 * kb + 16 + 4 * g + qq) * RP + dt * 16 + 4 * pp);
      const bf16x8 a = {lo[0], lo[1], lo[2], lo[3], hi[0], hi[1], hi[2], hi[3]};
#pragma unroll
      for (int qt = 0; qt < 2; ++qt) { o1[dt][qt] = __builtin_amdgcn_mfma_f32_16x16x32_bf16(a, pb1[kb][qt], o1[dt][qt], 0, 0, 0); o2[dt][qt] = __builtin_amdgcn_mfma_f32_16x16x32_bf16(a, pb2[kb][qt], o2[dt][qt], 0, 0, 0); }
    }
}
__device__ __forceinline__ void fill42(f32x4 (&a)[4][2], const f32x4 v) {
#pragma unroll
  for (int i = 0; i < 4; ++i)
#pragma unroll
    for (int j = 0; j < 2; ++j) a[i][j] = v;
}
__device__ __forceinline__ void exp42(f32x4 (&a)[4][2]) {
#pragma unroll
  for (int i = 0; i < 4; ++i)
#pragma unroll
    for (int j = 0; j < 2; ++j)
#pragma unroll
      for (int e = 0; e < 4; ++e) a[i][j][e] = __builtin_amdgcn_exp2f(a[i][j][e]);
}
#if defined(PROBE_PH) && PROBE_PH == 300
#define AT_BAR() do { const unsigned long long _b0 = __builtin_amdgcn_s_memrealtime(); asm volatile("s_waitcnt lgkmcnt(0)" ::: "memory"); __builtin_amdgcn_s_barrier(); asm volatile("" ::: "memory"); F.pr_t1 += __builtin_amdgcn_s_memrealtime() - _b0; } while (0)
#else
#define AT_BAR() do { asm volatile("s_waitcnt lgkmcnt(0)" ::: "memory"); __builtin_amdgcn_s_barrier(); asm volatile("" ::: "memory"); } while (0)
#endif
__device__ __forceinline__ void zero42(f32x4 (&a)[4][2]) {
#pragma unroll
  for (int i = 0; i < 4; ++i)
#pragma unroll
    for (int j = 0; j < 2; ++j) a[i][j] = (f32x4){0.f, 0.f, 0.f, 0.f};
}

__device__ __forceinline__ void phase_compress(PREF p, Frame& F) {
  const int lane = fresh_lane(), w = F.wave, tid = F.tid;
  const int r = lane & 15, g4 = lane >> 4;
  const bf16_t* H = (const bf16_t*)(p.ws + WS_H);
  const bf16_t* W1T = (const bf16_t*)(p.ws + WS_CW1);
  LAS float* part = (LAS float*)F.lds;
  LAS float* hid = part + 8 * 16 * 64;
  LAS float* outv = hid + 16 * 64;
  for (int task = F.vcu; task < 256; task += F.G) {
    const int kv = task >> 7, rb = task & 127;
    int row = rb * 16 + r; if (row > 2039) row = 2039;
    const int gg = row & 1, cc = (row >> 1) % NCMP, bb = (row >> 1) / NCMP;
    const int colbase = OFF_NKV + ((0 * 2 + kv) * 2 + gg) * 64;
    f32x4 acc[4];
#pragma unroll
    for (int nt = 0; nt < 4; ++nt) acc[nt] = (f32x4){0.f, 0.f, 0.f, 0.f};
#pragma unroll 1
    for (int ks = 0; ks < 8; ++ks) {
      const int k = w * 256 + ks * 32 + g4 * 8, l = k >> 6, d0 = k & 63;
      float hv[8]; ld8bf(H + (size_t)(bb * SEQ + 16 * cc + l) * HC + colbase + d0, hv);
      const float* pe = p.cmp_pe + (kv * 32 + l) * 64 + d0;
#pragma unroll
      for (int i = 0; i < 8; ++i) hv[i] += pe[i];
      const bf16x8 a = __builtin_bit_cast(bf16x8, pk8(hv));
#pragma unroll
      for (int nt = 0; nt < 4; ++nt) {
        const bf16x8 bfr = *(const GAS bf16x8*)(W1T + ((size_t)kv * 64 + nt * 16 + r) * 2048 + k);
        acc[nt] = __builtin_amdgcn_mfma_f32_16x16x32_bf16(a, bfr, acc[nt], 0, 0, 0);
      }
    }
#pragma unroll
    for (int nt = 0; nt < 4; ++nt)
#pragma unroll
      for (int i = 0; i < 4; ++i) part[(w * 16 + g4 * 4 + i) * 64 + nt * 16 + r] = acc[nt][i];
    __syncthreads();
    for (int e = tid; e < 1024; e += NWAVES * 64) { float s = 0.f;
#pragma unroll
      for (int ww = 0; ww < 8; ++ww) s += part[ww * 1024 + e];
      hid[e] = gelu_tanh(s); }
    __syncthreads();
    const float* w2 = p.cmp_w2 + kv * 4096;
    for (int e = tid; e < 1024; e += NWAVES * 64) { const int rr = e >> 6, n = e & 63; float s = 0.f;
      for (int j = 0; j < 64; ++j) s += hid[rr * 64 + j] * w2[j * 64 + n];
      outv[e] = s; }
    __syncthreads();
    for (int e = tid; e < 1024; e += NWAVES * 64) { const int rr = e >> 6, n = e & 63;
      const int orow = rb * 16 + rr;
      if (orow < 2040) {
        float v = outv[e];
        if (kv == 0) { float ss = 0.f; for (int j = 0; j < 64; ++j) ss += outv[rr * 64 + j] * outv[rr * 64 + j]; v = v * rsqrtf(ss * (1.f / 64.f) + 1e-6f) * p.nk_norm[n]; }
        const int g2 = orow & 1, c2 = (orow >> 1) % NCMP, b2 = (orow >> 1) / NCMP;
        ((bf16_t*)(p.ws + (kv ? WS_VCMPB : WS_KCMPB)))[((size_t)(b2 * 2 + g2) * 256 + c2) * 64 + n] = (bf16_t)f2bf(v);
      }
    }
    if (task < 16 && tid < 64) { const int kk2 = task >> 3, bg = task & 7; ((bf16_t*)(p.ws + (kk2 ? WS_VCMPB : WS_KCMPB)))[((size_t)bg * 256 + 255) * 64 + tid] = 0; }
    __syncthreads();
  }
}

__device__ __forceinline__ v4u tile_ld(const bf16_t* base, size_t pitch, int tid) { return *(const GAS v4u*)(base + (size_t)(tid >> 3) * pitch + (tid & 7) * 8); }
__device__ __forceinline__ void tile_st(LAS bf16_t* dst, v4u v, int tid) { *(LAS v4u*)(dst + (tid >> 3) * RP + (tid & 7) * 8) = v; }

template <int KS, int MODE>
__device__ __forceinline__ void attn_tile(f32x4 (&o)[4][2], f32x4 (&os)[2], const bf16x8 (&qf)[2][KS], const LAS bf16_t* KBt, int kc0, const LAS bf16_t* VBt, const f32x4 nbv,
                                          const bool (&on)[2], int qq0, int koff, int lane) {
  const int r = lane & 15, g = lane >> 4;
  f32x4 st[4][2]; bf16x8 pb[2][2];
  fill42(st, nbv); qk_tile<KS>(st, KBt, kc0, qf, lane); exp42(st);
  if (MODE != 0) {
#pragma unroll
    for (int kt = 0; kt < 4; ++kt)
#pragma unroll
      for (int qt = 0; qt < 2; ++qt)
#pragma unroll
        for (int i = 0; i < 4; ++i) { const int kk = kt * 16 + g * 4 + i, qq = qq0 + qt * 16 + r;
          bool keep = true;
          if (MODE & 1) keep = keep && on[qt];
          if (MODE & 2) keep = keep && (kk + koff <= qq);
          if (MODE & 4) keep = keep && (kk > qq);
          if (!keep) st[kt][qt][i] = 0.f; }
  }
  pack_p(pb, st);
  pv_apply(o, os, pb, VBt, lane);
}
__device__ __forceinline__ void phase_diffattn(PREF p, Frame& F) {
  const int lane = fresh_lane(), w = F.wave, tid = F.tid;
  const int r = lane & 15, g = lane >> 4;
  const bf16_t* H = (const bf16_t*)(p.ws + WS_H);
  bf16_t* CAT = (bf16_t*)(p.ws + WS_CAT);
  float mq = 0.f, mk = 0.f, l0 = 0.f, l1 = 0.f;
  for (int i = 0; i < 32; i++) { mq = fmaxf(mq, fabsf(p.dq_norm[i])); mk = fmaxf(mk, fabsf(p.dk_norm[i])); l0 += p.dlam[i] * p.dlam[32 + i]; l1 += p.dlam[64 + i] * p.dlam[96 + i]; }
  const float c2 = 0.17677669529663687f * 1.4426950408889634f;
  const float nb = -(32.f * mq * mk) * c2;
  const f32x4 nbv = {nb, nb, nb, nb};
  const float lam = __expf(l0) - __expf(l1) + 0.2f;
  const bool on[2] = {true, true};
  for (int pr = F.vcu; pr < 256; pr += F.G) {
    const int bh = pr >> 3, sp = pr & 7, b = bh >> 3, hd = bh & 7;
#pragma unroll 1
    for (int ui = 0; ui < 2; ++ui) {
      const int qb = ui ? 15 - sp : sp;
      const int NT = 4 * (qb + 1);
      const bf16_t* Kg = H + (size_t)(b * SEQ) * HC + OFF_DK + hd * 64;
      const bf16_t* Vg = H + (size_t)(b * SEQ) * HC + OFF_DV + hd * 64;
      f32x4 o1[4][2];
#pragma unroll 1
      for (int mp = 0; mp < 2; ++mp) {
        bf16x8 qf[2][1];
#pragma unroll
        for (int qt = 0; qt < 2; ++qt) qf[qt][0] = *(const GAS bf16x8*)(H + (size_t)(b * SEQ + qb * 256 + w * 32 + qt * 16 + r) * HC + OFF_DQ + hd * 64 + mp * 32 + g * 8);
        f32x4 o[4][2]; zero42(o);
        f32x4 os[2] = {{0.f, 0.f, 0.f, 0.f}, {0.f, 0.f, 0.f, 0.f}};
        v4u krA = tile_ld(Kg, HC, tid), vrA = tile_ld(Vg, HC, tid);
        v4u krB = tile_ld(Kg + (size_t)64 * HC, HC, tid), vrB = tile_ld(Vg + (size_t)64 * HC, HC, tid);
#pragma unroll 1
        for (int t = 0; t < NT; t += 2) {
#pragma unroll
          for (int hf = 0; hf < 2; ++hf) {
            const int tt = t + hf;
            const lbf KBt = (lbf)(F.lds + hf * 2 * RB), VBt = KBt + 64 * RP;
            tile_st(KBt, hf ? krB : krA, tid); tile_st(VBt, hf ? vrB : vrA, tid);
            AT_BAR();
            if (tt + 2 < NT) { const v4u k2 = tile_ld(Kg + (size_t)(tt + 2) * 64 * HC, HC, tid), v2 = tile_ld(Vg + (size_t)(tt + 2) * 64 * HC, HC, tid);
              if (hf) { krB = k2; vrB = v2; } else { krA = k2; vrA = v2; } }
            const int koff = tt * 64 - (qb * 256 + w * 32);
            if (tt >= NT - 4) attn_tile<1, 2>(o, os, qf, KBt, mp * 32, VBt, nbv, on, 0, koff, lane);
            else attn_tile<1, 0>(o, os, qf, KBt, mp * 32, VBt, nbv, on, 0, koff, lane);
          }
        }
        if (mp == 0) {
#pragma unroll
          for (int qt = 0; qt < 2; ++qt) { const float i1 = 1.f / os[qt][0];
#pragma unroll
            for (int dt = 0; dt < 4; ++dt) o1[dt][qt] = o[dt][qt] * i1; }
        } else {
#pragma unroll
          for (int qt = 0; qt < 2; ++qt) {
            const float i2 = lam / os[qt][0];
            float ss = 0.f;
#pragma unroll
            for (int dt = 0; dt < 4; ++dt)
#pragma unroll
              for (int i = 0; i < 4; ++i) { const float v = o1[dt][qt][i] - o[dt][qt][i] * i2; o1[dt][qt][i] = v; ss += v * v; }
            ss += __shfl_xor(ss, 16, 64); ss += __shfl_xor(ss, 32, 64);
            const float rr = rsqrtf(ss * (1.f / 64.f) + 1e-6f) * 0.8f;
            bf16_t* op = CAT + (size_t)(b * SEQ + qb * 256 + w * 32 + qt * 16 + r) * DM + hd * 64;
#pragma unroll
            for (int dt = 0; dt < 4; ++dt) { const int d0 = dt * 16 + g * 4; const f32x4 sg = *(const f32x4*)(p.dsubln + d0);
              v2u wv; wv.x = pk2(o1[dt][qt][0] * rr * sg[0], o1[dt][qt][1] * rr * sg[1]); wv.y = pk2(o1[dt][qt][2] * rr * sg[2], o1[dt][qt][3] * rr * sg[3]);
              *(GAS v2u*)(op + d0) = wv; }
          }
        }
        AT_BAR();
      }
    }
  }
}

__device__ __forceinline__ void nsa_finish(f32x4 (&comb)[4][2], const f32x4 (&o)[4][2], const f32x4 (&os)[2], const float (&gate)[2], bool normalised) {
#pragma unroll
  for (int qt = 0; qt < 2; ++qt) {
    const float f = normalised ? gate[qt] : gate[qt] / os[qt][0];
#pragma unroll
    for (int dt = 0; dt < 4; ++dt) comb[dt][qt] += o[dt][qt] * f;
  }
}
__device__ __forceinline__ void phase_nsa(PREF p, Frame& F) {
  const int lane = fresh_lane(), w = F.wave, tid = F.tid;
  const int r = lane & 15, g = lane >> 4;
  const bf16_t* H = (const bf16_t*)(p.ws + WS_H);
  const float* GATES = (const float*)(p.ws + WS_GATES);
  bf16_t* CAT = (bf16_t*)(p.ws + WS_CAT);
  float mq = 0.f, mk0 = 0.f, mk1 = 0.f, mk2 = 0.f;
  for (int i = 0; i < 64; i++) { mq = fmaxf(mq, fabsf(p.nq_norm[i])); mk0 = fmaxf(mk0, fabsf(p.nk_norm[i])); mk1 = fmaxf(mk1, fabsf(p.nk_norm[64 + i])); mk2 = fmaxf(mk2, fabsf(p.nk_norm[128 + i])); }
  const float c2 = 0.125f * 1.4426950408889634f;
  const float nb0 = -(64.f * mq * mk0) * c2, nb1 = -(64.f * mq * mk1) * c2, nb2 = -(64.f * mq * mk2) * c2;
  LAS float* IMP = (LAS float*)(F.lds + 12 * RB);
  LAS unsigned char* SELB = (LAS unsigned char*)(F.lds + 12 * RB + 64 * 65 * 4);
  const int hj = w >> 1, th = w & 1;
  for (int pr = F.vcu; pr < 256; pr += F.G) {
    const int bg = pr >> 5, sp = pr & 31, b = bg >> 1, gq = bg & 1;
#pragma unroll 1
    for (int ui = 0; ui < 2; ++ui) {
      const int blk = ui ? 63 - sp : sp;
      const int hh = gq * 4 + hj;
      const int tokw = b * SEQ + blk * 64 + th * 32;
      bf16x8 qf[2][2];
      float gate0[2], gate1[2], gate2[2];
#pragma unroll
      for (int qt = 0; qt < 2; ++qt) { const bf16_t* qp = H + (size_t)(tokw + qt * 16 + r) * HC + OFF_NQ + hh * 64 + g * 8;
        qf[qt][0] = *(const GAS bf16x8*)qp; qf[qt][1] = *(const GAS bf16x8*)(qp + 32);
        const float* gp = GATES + (size_t)(tokw + qt * 16 + r) * 24 + hh * 3; gate0[qt] = gp[0]; gate1[qt] = gp[1]; gate2[qt] = gp[2]; }
      f32x4 comb[4][2]; zero42(comb);
      const int nct = (4 * blk + 3 + 63) >> 6;
      {
        const bf16_t* KC = (const bf16_t*)(p.ws + WS_KCMPB) + (size_t)(b * 2 + gq) * 256 * 64;
        const bf16_t* VC = (const bf16_t*)(p.ws + WS_VCMPB) + (size_t)(b * 2 + gq) * 256 * 64;
        for (int t4 = 0; t4 < nct; ++t4) { tile_st((lbf)(F.lds + t4 * RB), tile_ld(KC + t4 * 4096, 64, tid), tid); tile_st((lbf)(F.lds + (4 + t4) * RB), tile_ld(VC + t4 * 4096, 64, tid), tid); }
        for (int e = tid; e < 64 * 65; e += NWAVES * 64) IMP[e] = 0.f;
        AT_BAR();
        const f32x4 nbv0 = {nb0, nb0, nb0, nb0};
        int cmax[2];
#pragma unroll
        for (int qt = 0; qt < 2; ++qt) { const int pos = blk * 64 + th * 32 + qt * 16 + r; cmax[qt] = (pos >= 31) ? ((pos - 31) >> 4) : -1; }
        float lsum[2] = {0.f, 0.f};
        for (int t4 = 0; t4 < nct; ++t4) {
          f32x4 st[4][2]; fill42(st, nbv0);
          qk_tile<2>(st, (lbf)(F.lds + t4 * RB), 0, qf, lane); exp42(st);
#pragma unroll
          for (int kt = 0; kt < 4; ++kt)
#pragma unroll
            for (int qt = 0; qt < 2; ++qt)
#pragma unroll
              for (int i = 0; i < 4; ++i) { const int c = t4 * 64 + kt * 16 + g * 4 + i; if (c <= cmax[qt]) lsum[qt] += st[kt][qt][i]; }
        }
        float linv[2];
#pragma unroll
        for (int qt = 0; qt < 2; ++qt) { float s = lsum[qt]; s += __shfl_xor(s, 16, 64); s += __shfl_xor(s, 32, 64); linv[qt] = (cmax[qt] >= 0) ? 1.f / s : 0.f; }
        f32x4 o[4][2]; zero42(o);
        f32x4 osd[2] = {{0.f, 0.f, 0.f, 0.f}, {0.f, 0.f, 0.f, 0.f}};
        for (int t4 = 0; t4 < nct; ++t4) {
          f32x4 st[4][2]; fill42(st, nbv0);
          qk_tile<2>(st, (lbf)(F.lds + t4 * RB), 0, qf, lane); exp42(st);
#pragma unroll
          for (int kt = 0; kt < 4; ++kt)
#pragma unroll
            for (int qt = 0; qt < 2; ++qt) {
              float gs = 0.f;
#pragma unroll
              for (int i = 0; i < 4; ++i) { const int c = t4 * 64 + kt * 16 + g * 4 + i;
                const float e = (c <= cmax[qt]) ? st[kt][qt][i] * linv[qt] : 0.f;
                st[kt][qt][i] = e; gs += e; }
              const int ti = th * 32 + qt * 16 + r, j = t4 * 16 + kt * 4 + g;
              if (gs != 0.f) { __hip_atomic_fetch_add(IMP + ti * 65 + j, gs, __ATOMIC_RELAXED, __HIP_MEMORY_SCOPE_WORKGROUP); if (j < 63 && st[kt][qt][3] != 0.f) __hip_atomic_fetch_add(IMP + ti * 65 + j + 1, st[kt][qt][3], __ATOMIC_RELAXED, __HIP_MEMORY_SCOPE_WORKGROUP); }
            }
          bf16x8 pb[2][2]; pack_p(pb, st);
          pv_apply(o, osd, pb, (lbf)(F.lds + (4 + t4) * RB), lane);
        }
        nsa_finish(comb, o, osd, gate0, true);
      }
      AT_BAR();
      {
        const int ti = tid >> 3, jb = (tid & 7) * 8;
        float mine[8]; int rank[8];
#pragma unroll
        for (int u = 0; u < 8; ++u) { const int j = jb + u; float v = IMP[ti * 65 + j]; if (j == blk || j == 0) v = 1e4f; else if (j > blk) v = -1e30f; mine[u] = v; rank[u] = 0; }
        for (int i = 0; i < 64; ++i) { float v = IMP[ti * 65 + i]; if (i == blk || i == 0) v = 1e4f; else if (i > blk) v = -1e30f;
#pragma unroll
          for (int u = 0; u < 8; ++u) rank[u] += (v > mine[u] || (v == mine[u] && i < jb + u)) ? 1 : 0; }
        unsigned bits = 0;
#pragma unroll
        for (int u = 0; u < 8; ++u) bits |= (rank[u] < 16 ? 1u : 0u) << u;
        SELB[ti * 8 + (tid & 7)] = (unsigned char)bits;
      }
      AT_BAR();
      unsigned long long selm[2];
#pragma unroll
      for (int qt = 0; qt < 2; ++qt) { const int ti = th * 32 + qt * 16 + r; const LAS unsigned* sp2 = (const LAS unsigned*)(SELB + ti * 8); selm[qt] = (unsigned long long)sp2[0] | ((unsigned long long)sp2[1] << 32); }
#pragma unroll 1
      for (int br = 1; br < 3; ++br) {
        const int kcol = OFF_NKV + ((br * 2 + 0) * 2 + gq) * 64, vcol = OFF_NKV + ((br * 2 + 1) * 2 + gq) * 64;
        const float nbb = (br == 1) ? nb1 : nb2;
        const f32x4 nbv = {nbb, nbb, nbb, nbb};
        const int t_lo = (br == 1) ? 0 : (blk > 8 ? blk - 8 : 0);
        const bf16_t* Kg = H + (size_t)(b * SEQ) * HC + kcol;
        const bf16_t* Vg = H + (size_t)(b * SEQ) * HC + vcol;
        f32x4 o[4][2]; zero42(o);
        f32x4 os[2] = {{0.f, 0.f, 0.f, 0.f}, {0.f, 0.f, 0.f, 0.f}};
        v4u krA = tile_ld(Kg + (size_t)t_lo * 64 * HC, HC, tid), vrA = tile_ld(Vg + (size_t)t_lo * 64 * HC, HC, tid);
        v4u krB = krA, vrB = vrA;
        if (t_lo < blk) { krB = tile_ld(Kg + (size_t)(t_lo + 1) * 64 * HC, HC, tid); vrB = tile_ld(Vg + (size_t)(t_lo + 1) * 64 * HC, HC, tid); }
#pragma unroll 1
        for (int t0 = t_lo; t0 <= blk; t0 += 2) {
#pragma unroll
          for (int hf = 0; hf < 2; ++hf) {
            const int t = t0 + hf;
            if (t <= blk) {
              const lbf KBt = (lbf)(F.lds + (8 + hf * 2) * RB), VBt = KBt + 64 * RP;
              tile_st(KBt, hf ? krB : krA, tid); tile_st(VBt, hf ? vrB : vrA, tid);
              AT_BAR();
              if (t + 2 <= blk) { const v4u k2 = tile_ld(Kg + (size_t)(t + 2) * 64 * HC, HC, tid), v2 = tile_ld(Vg + (size_t)(t + 2) * 64 * HC, HC, tid);
                if (hf) { krB = k2; vrB = v2; } else { krA = k2; vrA = v2; } }
              const bool on[2] = {((selm[0] >> t) & 1ull) != 0ull, ((selm[1] >> t) & 1ull) != 0ull};
              const int qq0 = th * 32;
              if (br == 1) {
                if (__any((int)(on[0] || on[1]))) {
                  if (t == blk) attn_tile<2, 3>(o, os, qf, KBt, 0, VBt, nbv, on, qq0, 0, lane);
                  else if (__all((int)(on[0] && on[1]))) attn_tile<2, 0>(o, os, qf, KBt, 0, VBt, nbv, on, qq0, 0, lane);
                  else attn_tile<2, 1>(o, os, qf, KBt, 0, VBt, nbv, on, qq0, 0, lane);
                }
              } else {
                if (t == blk) attn_tile<2, 2>(o, os, qf, KBt, 0, VBt, nbv, on, qq0, 0, lane);
                else if (t == blk - 8) attn_tile<2, 4>(o, os, qf, KBt, 0, VBt, nbv, on, qq0, 0, lane);
                else attn_tile<2, 0>(o, os, qf, KBt, 0, VBt, nbv, on, qq0, 0, lane);
              }
            }
          }
        }
        nsa_finish(comb, o, os, (br == 1) ? gate1 : gate2, false);
        AT_BAR();
      }
#pragma unroll
      for (int qt = 0; qt < 2; ++qt) { bf16_t* op = CAT + (size_t)(tokw + qt * 16 + r) * DM + 512 + hh * 64;
#pragma unroll
        for (int dt = 0; dt < 4; ++dt) { const int d0 = dt * 16 + g * 4; v2u wv; wv.x = pk2(comb[dt][qt][0], comb[dt][qt][1]); wv.y = pk2(comb[dt][qt][2], comb[dt][qt][3]); *(GAS v2u*)(op + d0) = wv; } }
    }
  }
}

__global__ void __launch_bounds__(NWAVES * 64, 2) mk_fwd(P p_arg) {
  extern __shared__ __attribute__((aligned(16))) unsigned char lds[];
  Frame F;
  F.lds = (LAS unsigned char*)lds;
  F.MISC = (volatile LAS unsigned*)(F.lds + MISC_OFF);
  F.tid = threadIdx.x; F.lane = F.tid & 63; F.wave = __builtin_amdgcn_readfirstlane(F.tid >> 6);
  F.G = gridDim.x; { const int bx = blockIdx.x; F.vcu = (F.G % 8 == 0) ? (bx % 8) * (F.G / 8) + bx / 8 : bx; }
  unsigned char* const ws = p_arg.ws;
  F.ctl = (gu32*)(ws + WS_CTL);
  for (int u = F.tid; u < (LDS_BYTES - LDSCTL_OFF) / 4; u += NWAVES * 64) ((LAS unsigned*)(F.lds + LDSCTL_OFF))[u] = 0u;
  __syncthreads();
  XcdBarrier bar = xcd_barrier_post((unsigned*)(F.ctl + CW_BAR) + p_arg.pad * XCD_BAR_WORDS, F.MISC + 8);
  const int lo = p_arg.ph_lo, hi = p_arg.ph_hi;
#ifndef PHMASK
#define PHMASK 0xffffffffu
#endif
#define IN(k) (lo <= (k) && (k) < hi && ((PHMASK >> (k)) & 1u))
#define SEAM(k) do { if (IN(k) && IN((k) + 1)) xcd_barrier(bar); } while (0)
#ifdef PROBE_PH
  F.pr_t0 = 0; F.pr_t1 = 0;
#endif

  PROBE_MARK(0); if (IN(0)) { phase_prologue(KP, F); } SEAM(0);
  PROBE_MARK(1); if (IN(1)) {
    pg8::Gemm g{(const bf16_t*)(ws + WS_XN), (const bf16_t*)(ws + WS_WIN), DM, DM};
    pg8::StaticOrder S; S.init(T_TOK, 3072, F.G, (int)blockIdx.x);
    PREF p = KP; EpiInProj E{(bf16_t*)(ws + WS_H), (float*)(ws + WS_GATES), p.dq_norm, p.dk_norm, p.nq_norm, p.nk_norm, p.gate_bias};
    pg8::gemm_phase<EpiInProj, pg8::StaticOrder, true>(F.lds + RING_OFF, g, S, E);
  } SEAM(1);
  PROBE_MARK(2); if (IN(2)) { phase_compress(KP, F); phase_diffattn(KP, F); } SEAM(2);
  PROBE_MARK(3); if (IN(3)) { phase_nsa(KP, F); } SEAM(3);
  PROBE_MARK(4); if (IN(4)) {
    pg8::Gemm g{(const bf16_t*)(ws + WS_CAT), (const bf16_t*)(ws + WS_WOUT), DM, DM};
    pg8::StaticOrder S; S.init(T_TOK, DM, F.G, (int)blockIdx.x);
    PREF p = KP; EpiResid E{p.x, p.out, nullptr};
    pg8::gemm_phase<EpiResid, pg8::StaticOrder, false>(F.lds + RING_OFF, g, S, E);
  } SEAM(4);
#define MOE_PHASES(layer, pb) do { \
    PROBE_MARK(pb); if (IN(pb)) { phase_router(KP, F, layer); } SEAM(pb); \
    PROBE_MARK(pb + 1); if (IN(pb + 1)) { \
      pg8::Gemm g{(const bf16_t*)(ws + WS_XN2), (const bf16_t*)(ws + WS_EGU), DM, DM}; \
      pg8::moe_order_setup((LAS int*)(F.lds + MISC_OFF + 256), (const unsigned*)(ws + WS_CTL) + CW_CNT + layer * 32 * 64); pg8::MoeOrder<2, true> S{(const LAS int*)(F.lds + MISC_OFF + 256), (const int*)(ws + WS_LIST), F.G, (int)blockIdx.x}; \
      EpiMoeGU E{(bf16_t*)(ws + WS_HID)}; \
      pg8::gemm_phase<EpiMoeGU, pg8::MoeOrder<2, true>, true>(F.lds + RING_OFF, g, S, E); \
    } SEAM(pb + 1); \
    PROBE_MARK(pb + 2); if (IN(pb + 2)) { \
      int k256 = 256; asm volatile("" : "+s"(k256)); \
      pg8::Gemm g{(const bf16_t*)(ws + WS_HID), (const bf16_t*)(ws + WS_EDN), k256, 256}; \
      pg8::moe_order_setup((LAS int*)(F.lds + MISC_OFF + 256), (const unsigned*)(ws + WS_CTL) + CW_CNT + layer * 32 * 64); pg8::MoeOrder<4, false> S{(const LAS int*)(F.lds + MISC_OFF + 256), (const int*)(ws + WS_LIST), F.G, (int)blockIdx.x}; \
      PREF p = KP; EpiMoeDown E{p.out, (bf16_t*)(ws + WS_Y1), (const int*)(ws + WS_LIST), (const float*)(ws + WS_PGATE), (LAS int*)(F.lds + 132096)}; \
      pg8::gemm_phase<EpiMoeDown, pg8::MoeOrder<4, false>, true>(F.lds + RING_OFF, g, S, E); \
    } SEAM(pb + 2); \
  } while (0)
  MOE_PHASES(0, 5);
  PROBE_MARK(8); if (IN(8)) { phase_rwkv_prep(KP, F); } SEAM(8);
  PROBE_MARK(9); if (IN(9)) {
    pg8::Gemm g{(const bf16_t*)(ws + WS_S0 + 3 * SLOT), (const bf16_t*)(ws + WS_WL1), DM, DM};
    pg8::TallOrder S; S.init(3, 1, F.G, (int)blockIdx.x);
    EpiLora1 E{(bf16_t*)(ws + WS_TMP)};
    pg8::gemm_phase<EpiLora1, pg8::TallOrder, false>(F.lds + RING_OFF, g, S, E);
  } SEAM(9);
  PROBE_MARK(10); if (IN(10)) {
    pg8::Gemm g{(const bf16_t*)(ws + WS_S0), (const bf16_t*)(ws + WS_WRKV), DM, DM};
    pg8::TallOrder S; S.init(3, 4, F.G, (int)blockIdx.x);
    EpiRKV E{ws};
    pg8::gemm_phase<EpiRKV, pg8::TallOrder, true>(F.lds + RING_OFF, g, S, E);
  } SEAM(10);
  PROBE_MARK(11); if (IN(11)) {
    {
      int k128 = 128; asm volatile("" : "+s"(k128));
      pg8::Gemm g{(const bf16_t*)(ws + WS_TMP), (const bf16_t*)(ws + WS_WL2), k128, 384};
      pg8::StaticOrder S; S.init(T_TOK, 2048, F.G, (int)blockIdx.x);
      PREF p = KP; EpiLora2 E{ws, p.w0, p.a0, 0};
      pg8::gemm_phase<EpiLora2, pg8::StaticOrder, true>(F.lds + RING_OFF, g, S, E);
    }
    {
      int k256 = 256; asm volatile("" : "+s"(k256));
      pg8::Gemm g{(const bf16_t*)(ws + WS_TMP) + 128, (const bf16_t*)(ws + WS_WL2 + 512 * 1024), k256, 384};
      pg8::StaticOrder S; S.init(T_TOK, 1024, F.G, (int)blockIdx.x);
      PREF p = KP; EpiLora2 E{ws, p.w0, p.a0, 2};
      pg8::gemm_phase<EpiLora2, pg8::StaticOrder, true>(F.lds + RING_OFF, g, S, E);
    }
  } SEAM(11);
  PROBE_MARK(12); if (IN(12)) { phase_rwkv_r1(KP, F); } SEAM(12);
  PROBE_MARK(13); if (IN(13)) { phase_rwkv_r2(KP, F); } SEAM(13);
  PROBE_MARK(14); if (IN(14)) { phase_rwkv_r3(KP, F); } SEAM(14);
  PROBE_MARK(15); if (IN(15)) {
    pg8::Gemm g{(const bf16_t*)(ws + WS_S0 + 3 * SLOT), (const bf16_t*)(ws + WS_WO), DM, DM};
    pg8::StaticOrder S; S.init(T_TOK, DM, F.G, (int)blockIdx.x);
    PREF p = KP; EpiResid E{p.out, p.out, (const bf16_t*)(ws + WS_Y1)};
    pg8::gemm_phase<EpiResid, pg8::StaticOrder, false>(F.lds + RING_OFF, g, S, E);
  } SEAM(15);
  MOE_PHASES(1, 16);
#undef MOE_PHASES
  PROBE_MARK(19); if (IN(19)) { phase_final(KP, F); }
  PROBE_MARK(20);
#ifdef PROBE_PH
  { const unsigned long long dur = (F.pr_t1 - F.pr_t0) * PROBE_MUL, t0 = __builtin_amdgcn_s_memrealtime(); while (__builtin_amdgcn_s_memrealtime() - t0 < dur) __builtin_amdgcn_s_sleep(8); }
#endif
#undef IN
#undef SEAM
}

static void launch_mk(P p, int lo, int hi, int li, int grid, hipStream_t st) {
  p.ph_lo = lo; p.ph_hi = hi; p.pad = li;
  hipLaunchKernelGGL(mk_fwd, dim3(grid), dim3(NWAVES * 64), LDS_BYTES, st, p);
}

extern "C" void kernel_launch(void* const* d_in, const int* in_sizes, int n_in, void* d_out, int out_size, void* d_ws,
                              size_t ws_size, hipStream_t stream) {
  static int grid = 0;
  if (grid == 0) {
    if (n_in != 40 || ws_size < WS_END) { fprintf(stderr, "kernel_launch: bad n_in %d or ws_size %zu (< %zu)\n", n_in, ws_size, (size_t)WS_END); grid = -1; return; }
    int dev = 0, cus = 0;
    if (hipGetDevice(&dev) != hipSuccess || hipDeviceGetAttribute(&cus, hipDeviceAttributeMultiprocessorCount, dev) != hipSuccess) { grid = -1; return; }
    if (hipFuncSetAttribute((const void*)mk_fwd, hipFuncAttributeMaxDynamicSharedMemorySize, LDS_BYTES) != hipSuccess) { grid = -1; return; }
    grid = cus;
  }
  if (grid < 0) return;
  P p{};
  const float* const* in = (const float* const*)d_in;
  p.x = in[0]; p.mix_norm = in[1]; p.w_in = in[2]; p.gate_bias = in[3]; p.dq_norm = in[4]; p.dk_norm = in[5];
  p.dlam = in[6]; p.dsubln = in[7]; p.nq_norm = in[8]; p.nk_norm = in[9]; p.cmp_pe = in[10]; p.cmp_w1 = in[11];
  p.cmp_w2 = in[12]; p.w_out = in[13]; p.rmix = in[14]; p.w_r = in[15]; p.w_k = in[16]; p.w_v = in[17];
  p.w0 = in[18]; p.w1 = in[19]; p.w2 = in[20]; p.a0 = in[21]; p.a1 = in[22]; p.a2 = in[23]; p.g1 = in[24]; p.g2 = in[25];
  p.k_k = in[26]; p.k_a = in[27]; p.r_k = in[28]; p.ln_w = in[29]; p.ln_b = in[30]; p.w_o = in[31];
  p.ffn_norm = in[32]; p.rg_w = in[33]; p.rg_b = in[34]; p.re_w = in[35]; p.re_b = in[36];
  p.e_gate = in[37]; p.e_up = in[38]; p.e_down = in[39];
  p.out = (float*)d_out;
  p.ws = (unsigned char*)d_ws;
  unsigned char* ws = p.ws;
  (void)hipMemsetAsync(ws + WS_CTL, 0, CTL_ZERO_BYTES, stream);
  launch_mk(p, 0, 20, 0, grid, stream);
}
```

```cpp
#include <hip/hip_runtime.h>
#include <cstdio>
#include <cstdint>

#define T_TOK 16384
#define DM 1024
#define SEQ 4096
#define NBATCH 4
#define INC 2840
#define HC 2816
#define OFF_DQ 0
#define OFF_DK 512
#define OFF_DV 1024
#define OFF_NQ 1536
#define OFF_NKV 2048
#define OFF_NG 2816
#define NCMP 255
#define CAP 16384

#define GAS __attribute__((address_space(1)))
#define LAS __attribute__((address_space(3)))
typedef unsigned short bf16_t;
typedef unsigned v4u __attribute__((ext_vector_type(4)));
typedef unsigned v2u __attribute__((ext_vector_type(2)));
typedef float f32x4 __attribute__((ext_vector_type(4)));
typedef short bf16x8 __attribute__((ext_vector_type(8)));
typedef GAS unsigned gu32;
#define RLX_AGENT __ATOMIC_RELAXED, __HIP_MEMORY_SCOPE_AGENT
#define LDS_WAIT() asm volatile("s_waitcnt lgkmcnt(0)" ::: "memory")
#define VM_WAIT() asm volatile("s_waitcnt vmcnt(0)" ::: "memory")

__device__ __forceinline__ float bf2f(bf16_t v) { return __uint_as_float(((unsigned)v) << 16); }

typedef float f32x2_t __attribute__((ext_vector_type(2))); typedef __bf16 bf16x2_t __attribute__((ext_vector_type(2)));
__device__ __forceinline__ unsigned pk2(float lo, float hi) { const f32x2_t v = {lo, hi}; return __builtin_bit_cast(unsigned, __builtin_convertvector(v, bf16x2_t)); }
__device__ __forceinline__ unsigned f2bf(float f) { return pk2(f, f) & 0xffffu; }
__device__ __forceinline__ float wave_sum(float v) {
#pragma unroll
  for (int o = 32; o >= 1; o >>= 1) v += __shfl_xor(v, o, 64);
  return v;
}
__device__ __forceinline__ float wave_sum_dpp(float v) {
  v += __builtin_bit_cast(float, __builtin_amdgcn_update_dpp(0, __builtin_bit_cast(int, v), 0xB1, 0xf, 0xf, false));
  v += __builtin_bit_cast(float, __builtin_amdgcn_update_dpp(0, __builtin_bit_cast(int, v), 0x4E, 0xf, 0xf, false));
  v += __builtin_bit_cast(float, __builtin_amdgcn_update_dpp(0, __builtin_bit_cast(int, v), 0x141, 0xf, 0xf, false));
  v += __builtin_bit_cast(float, __builtin_amdgcn_update_dpp(0, __builtin_bit_cast(int, v), 0x140, 0xf, 0xf, false));
  const int iv = __builtin_bit_cast(int, v);
  return (__builtin_bit_cast(float, __builtin_amdgcn_readlane(iv, 0)) + __builtin_bit_cast(float, __builtin_amdgcn_readlane(iv, 16))) +
         (__builtin_bit_cast(float, __builtin_amdgcn_readlane(iv, 32)) + __builtin_bit_cast(float, __builtin_amdgcn_readlane(iv, 48)));
}
__device__ __forceinline__ int fresh_lane() { int l; asm volatile("v_mbcnt_lo_u32_b32 %0, -1, 0\n\tv_mbcnt_hi_u32_b32 %0, -1, %0" : "=v"(l)); return l; }
__device__ __forceinline__ float uniformf(float v) { return __builtin_bit_cast(float, __builtin_amdgcn_readfirstlane(__builtin_bit_cast(int, v))); }
__device__ __forceinline__ float sigmoidf_(float x) { return 1.f / (1.f + __expf(-x)); }
__device__ __forceinline__ float softplusf_(float x) { return fmaxf(x, 0.f) + __logf(1.f + __expf(-fabsf(x))); }
__device__ __forceinline__ float gelu_tanh(float x) {
  float u = 0.7978845608028654f * (x + 0.044715f * x * x * x);
  return 0.5f * x * (1.f + tanhf(u));
}

constexpr size_t MiB = 1u << 20;
constexpr size_t WS_CTL = 0, CTL_ZERO_BYTES = 160 * 1024;
constexpr size_t WS_WIN = 1 * MiB;
constexpr size_t WS_WOUT = 7 * MiB;
constexpr size_t WS_WRKV = 9 * MiB;
constexpr size_t WS_WO = 15 * MiB;
constexpr size_t WS_WL1 = 17 * MiB;
constexpr size_t WS_WL2 = 19 * MiB;
constexpr size_t WS_EGU = 22 * MiB;
constexpr size_t WS_EDN = 54 * MiB;
constexpr size_t WS_ACT = 70 * MiB;
constexpr size_t WS_XN = WS_ACT;
constexpr size_t WS_H = WS_ACT + 32 * MiB;
constexpr size_t WS_GATES = WS_ACT + 120 * MiB;
constexpr size_t WS_CAT = WS_ACT + 122 * MiB;
constexpr size_t WS_KCMPB = WS_ACT + 154 * MiB;
constexpr size_t WS_VCMPB = WS_ACT + 155 * MiB;
constexpr size_t WS_CW1 = 21 * MiB + 256 * 1024;
constexpr size_t WS_XN2 = WS_ACT;
constexpr size_t WS_HID = WS_ACT + 32 * MiB;
constexpr size_t WS_Y1 = WS_EGU;
constexpr size_t WS_LIST = WS_ACT + 156 * MiB;
constexpr size_t WS_PGATE = WS_ACT + 158 * MiB;
constexpr size_t WS_XN2F = WS_ACT;
constexpr size_t WS_GUF = WS_ACT + 64 * MiB;
constexpr size_t WS_S0 = WS_ACT;
constexpr size_t WS_TMP = WS_ACT + 192 * MiB;
constexpr size_t WS_END = WS_ACT + 204 * MiB;
constexpr size_t SLOT = 32 * MiB;
constexpr int CW_BAR = 4096;
constexpr int CW_CNT = 32768;

namespace pg8 {
#define PG8_LAS __attribute__((address_space(3)))
typedef unsigned u32x4 __attribute__((ext_vector_type(4)));
constexpr int BM = 256, BK = 64, HALF = 128, HTB = HALF * BK * 2  , STAGE_BYTES = 8 * HTB, NXCD = 8, WGM = 8;

__host__ __device__ __forceinline__ int lds_byte(int r, int c) { const int st = (r >> 4) * 2 + (c >> 5), rr = r & 15, cc = c & 31, ob = rr * 64 + cc * 2; return st * 1024 + (ob ^ (((ob >> 9) & 1) << 5)); }
__host__ __device__ __forceinline__ void stage_rc(int b, int& R, int& C) { const int st = b / 1024, sb = b % 1024, swz = sb ^ (((sb >> 9) & 1) << 5); R = (st >> 1) * 16 + swz / 64; C = (st & 1) * 32 + (swz % 64) / 2; }
__host__ __device__ __forceinline__ int perm32(int rho) { const int n = rho >> 4, i = rho & 15; return 8 * (i >> 2) + 4 * n + (i & 3); }

struct Unit { int pm, pn, e, nrows, rt, par; };
struct Gemm { const bf16_t* A; const bf16_t* Bt; int K; int lda; };

__device__ __forceinline__ void static_map(int L, int nM, int nN, int& pm, int& pn) {
    const int nwg = nM * nN;
    int wgid = L; { const int q = nwg / NXCD, r = nwg % NXCD, xcd = wgid % NXCD, off = wgid / NXCD; wgid = (xcd < r ? xcd * (q + 1) : r * (q + 1) + (xcd - r) * q) + off; }
    const int nig = WGM * nN, gid = wgid / nig, fm = gid * WGM, gsz = (nM - fm) < WGM ? (nM - fm) : WGM;
    pm = fm + ((wgid % nig) % gsz); pn = (wgid % nig) / gsz;
}
struct StaticOrder {
    int nM, nN, G, c;
    __device__ void init(int M, int N, int G_, int c_) { nM = M / BM; nN = N / BM; G = G_; c = c_; }
    __device__ __forceinline__ bool next(int i, Unit& u) const {
        const int L = i * G + c; if (L >= nM * nN) return false;
        static_map(L, nM, nN, u.pm, u.pn); u.e = 0; u.nrows = 256; u.rt = 0; return true;
    }
    __device__ __forceinline__ unsigned rowoff(const Unit& u, int r, int C, int K) const { return (unsigned)((u.pm * BM + r) * K + C) * 2u; }
};
struct TallOrder {
    int nM, nN, G, c;
    __device__ void init(int ngemm, int nN_, int G_, int c_) { nM = 64 * ngemm; nN = nN_; G = G_; c = c_; }
    __device__ __forceinline__ bool next(int i, Unit& u) const {
        const int L = i * G + c; if (L >= nM * nN) return false;
        int pn; static_map(L, nM, nN, u.pm, pn); u.pn = (u.pm >> 6) * nN + pn; u.e = 0; u.nrows = 256; u.rt = 0; return true;
    }
    __device__ __forceinline__ unsigned rowoff(const Unit& u, int r, int C, int K) const { return (unsigned)((u.pm * BM + r) * K + C) * 2u; }
};


template <int NCOL, bool GATHER>
struct MoeOrder {
    const PG8_LAS int* tab;
    const int* list; int G, c;
    __device__ __forceinline__ bool next(int i, Unit& u) const {
        const int L = i * G + c; const int R = L / NCOL, j = L - R * NCOL;
        if (R >= tab[32]) return false;
        int e = 0;
#pragma unroll
        for (int s = 16; s >= 1; s >>= 1) { if (tab[e + s] <= R) e += s; }
        const int ce = tab[33 + e];
        u.pm = R; u.rt = R - tab[e]; u.e = e; u.pn = e * NCOL + j; u.nrows = ce - u.rt * 256; return true;
    }
    __device__ __forceinline__ unsigned rowoff(const Unit& u, int r, int C, int K) const {
        if (GATHER) { const int idx = (r < u.nrows) ? u.rt * 256 + r : 0; const int pr = list[(size_t)u.e * CAP + idx]; return (unsigned)((pr >> 1) * K + C) * 2u; }
        return (unsigned)((u.pm * BM + r) * K + C) * 2u;
    }
};
__device__ __forceinline__ void moe_order_setup(PG8_LAS int* tab, const unsigned* cnt) {
    if (threadIdx.x < 32) tab[33 + threadIdx.x] = (int)__hip_atomic_load(cnt + threadIdx.x * 64, __ATOMIC_RELAXED, __HIP_MEMORY_SCOPE_AGENT);
    __syncthreads();
    if (threadIdx.x == 0) { int pre = 0; for (int e = 0; e < 32; ++e) { tab[e] = pre; pre += (tab[33 + e] + 255) >> 8; } tab[32] = pre; }
    __syncthreads();
}

__device__ __forceinline__ unsigned cvt_pk_bf16(float lo, float hi) { unsigned r; asm volatile("v_cvt_pk_bf16_f32 %0, %1, %2" : "=v"(r) : "v"(lo), "v"(hi)); return r; }
__device__ __forceinline__ u32x4 pack8(const f32x4& a, const f32x4& b) { u32x4 w; w.x = cvt_pk_bf16(a[0], a[1]); w.y = cvt_pk_bf16(a[2], a[3]); w.z = cvt_pk_bf16(b[0], b[1]); w.w = cvt_pk_bf16(b[2], b[3]); return w; }

template <class Epi, class Sched, bool ALIGN_EPI>
__device__ __forceinline__ void gemm_phase(PG8_LAS unsigned char* lds, const Gemm g, const Sched& S, const Epi& E) {
    const int tid = threadIdx.x, wid = __builtin_amdgcn_readfirstlane(tid >> 6), lane = tid & 63, wr = wid >> 2, wc = wid & 3, fr = lane & 15, fq = lane >> 4;
    const int K = g.K, nt = K / BK;
    int RA[2], CA[2]; unsigned voffB[2];
#pragma unroll
    for (int i = 0; i < 2; ++i) { int R, C; stage_rc(tid * 16 + i * 8192, R, C); const int Rb = Epi::PERM ? ((R & ~31) + perm32(R & 31)) : R;
        RA[i] = R; CA[i] = C; voffB[i] = (unsigned)(Rb * K + C) * 2u; }
    const size_t kstep = (size_t)(BK * 2);
    const size_t hstep = (size_t)HALF * K * 2;
    const size_t tstep = 2 * hstep;
    const unsigned ldsw = (unsigned)wid * 1024u;
    const int aoff = lds_byte(wr * 64 + fr, fq * 8), boff = lds_byte(wc * 32 + fr, fq * 8);
    const char* const Abase = (const char*)g.A;
#define PG8_SA(b, h) (((b) * 2 + (h)) * HTB)
#define PG8_SB(b, h) ((4 + (b) * 2 + (h)) * HTB)
#define PG8_STAGE(bufoff, gbase, voff) do { _Pragma("unroll") for (int _i = 0; _i < 2; ++_i) \
        __builtin_amdgcn_global_load_lds((const unsigned*)((const char*)(gbase) + (voff)[_i]), (PG8_LAS unsigned*)(lds + (bufoff) + ldsw + _i * 8192), 16, 0, 0); } while (0)
#define PG8_STAGEA(bufoff, kbyte, o0, o1) do { \
        __builtin_amdgcn_global_load_lds((const unsigned*)(Abase + (size_t)(kbyte) + (o0)), (PG8_LAS unsigned*)(lds + (bufoff) + ldsw), 16, 0, 0); \
        __builtin_amdgcn_global_load_lds((const unsigned*)(Abase + (size_t)(kbyte) + (o1)), (PG8_LAS unsigned*)(lds + (bufoff) + ldsw + 8192), 16, 0, 0); } while (0)
#define PG8_LDA(dst, b, h) do { _Pragma("unroll") for (int m = 0; m < 4; ++m) _Pragma("unroll") for (int k = 0; k < 2; ++k) dst[m][k] = *(const PG8_LAS bf16x8*)(lds + PG8_SA(b, h) + aoff + m * 2048 + k * 1024); } while (0)
#define PG8_LDB(dst, b, h) do { _Pragma("unroll") for (int n = 0; n < 2; ++n) _Pragma("unroll") for (int k = 0; k < 2; ++k) dst[n][k] = *(const PG8_LAS bf16x8*)(lds + PG8_SB(b, h) + boff + n * 2048 + k * 1024); } while (0)
#define PG8_MMA(ai, bj, At, Bt) do { __builtin_amdgcn_s_setprio(1); _Pragma("unroll") for (int m = 0; m < 4; ++m) _Pragma("unroll") for (int n = 0; n < 2; ++n) _Pragma("unroll") for (int k = 0; k < 2; ++k) \
        acc[ai][bj][m][n] = __builtin_amdgcn_mfma_f32_16x16x32_bf16(Bt[n][k], At[m][k], acc[ai][bj][m][n], 0, 0, 0); __builtin_amdgcn_s_setprio(0); } while (0)
#define PG8_WAIT_V(n) asm volatile("s_waitcnt vmcnt(" #n ")" ::: "memory")
#define PG8_WAIT_L(n) asm volatile("s_waitcnt lgkmcnt(" #n ")" ::: "memory")
#define PG8_BAR __builtin_amdgcn_s_barrier()
#define PG8_SCHED __builtin_amdgcn_sched_barrier(0)
    Unit cur, nxt; int ui = 0;
    if (!S.next(0, cur)) return;
    cur.par = 0;
    if constexpr (Epi::HAS_PRE) E.pre(cur);
    f32x4 acc[2][2][4][2];
#pragma unroll
    for (int a = 0; a < 2; ++a)
#pragma unroll
        for (int b = 0; b < 2; ++b)
#pragma unroll
            for (int m = 0; m < 4; ++m)
#pragma unroll
                for (int n = 0; n < 2; ++n) acc[a][b][m][n] = (f32x4){0.f, 0.f, 0.f, 0.f};
    bf16x8 At[4][2], B0[2][2], B1[2][2];
    unsigned c00 = S.rowoff(cur, RA[0], CA[0], g.lda), c01 = S.rowoff(cur, RA[1], CA[1], g.lda), c10 = S.rowoff(cur, HALF + RA[0], CA[0], g.lda), c11 = S.rowoff(cur, HALF + RA[1], CA[1], g.lda);
    unsigned n00, n01, n10, n11;
    const char* cB = (const char*)g.Bt + (size_t)cur.pn * tstep;
    PG8_STAGE(PG8_SB(0, 0), cB, voffB); PG8_STAGE(PG8_SB(0, 1), cB + hstep, voffB); PG8_STAGEA(PG8_SA(0, 0), 0, c00, c01); PG8_STAGEA(PG8_SA(0, 1), 0, c10, c11);
    if (wr == 1) PG8_BAR;
    PG8_WAIT_V(2); PG8_BAR;
    PG8_STAGE(PG8_SB(1, 0), cB + kstep, voffB); PG8_STAGEA(PG8_SA(1, 0), kstep, c00, c01); PG8_STAGE(PG8_SB(1, 1), cB + hstep + kstep, voffB);
    PG8_WAIT_V(6); PG8_BAR;
    for (;;) {
        const bool has_next = S.next(ui + 1, nxt);
        const char* nB = has_next ? (const char*)g.Bt + (size_t)nxt.pn * tstep : cB;
        if (has_next) { n00 = S.rowoff(nxt, RA[0], CA[0], g.lda); n01 = S.rowoff(nxt, RA[1], CA[1], g.lda); n10 = S.rowoff(nxt, HALF + RA[0], CA[0], g.lda); n11 = S.rowoff(nxt, HALF + RA[1], CA[1], g.lda); }
        else { n00 = c00; n01 = c01; n10 = c10; n11 = c11; }
        for (int t = 0; t < nt; t += 2) {
            const bool last = (t == nt - 2);
            const size_t k1 = (size_t)(t + 1) * kstep;
            const size_t k2 = last ? 0 : (size_t)(t + 2) * kstep;
            const size_t k3 = k2 + kstep;
            const unsigned a00 = last ? n00 : c00, a01 = last ? n01 : c01, a10 = last ? n10 : c10, a11 = last ? n11 : c11;
            const char* b2 = last ? nB : cB + (size_t)(t + 2) * kstep;
            const char* b3 = b2 + kstep;
            PG8_LDB(B0, 0, 0); PG8_LDB(B1, 0, 1); PG8_SCHED; PG8_LDA(At, 0, 0); PG8_STAGEA(PG8_SA(1, 1), k1, c10, c11);
            PG8_WAIT_V(8); PG8_WAIT_L(0); PG8_BAR; PG8_MMA(0, 0, At, B0); PG8_MMA(0, 1, At, B1); PG8_BAR; PG8_SCHED;
            PG8_LDA(At, 0, 1); PG8_STAGE(PG8_SB(0, 0), b2, voffB); PG8_STAGE(PG8_SB(0, 1), b2 + hstep, voffB); PG8_STAGEA(PG8_SA(0, 0), k2, a00, a01);
            PG8_WAIT_V(8); PG8_WAIT_L(0); PG8_BAR; PG8_MMA(1, 0, At, B0); PG8_MMA(1, 1, At, B1); PG8_BAR; PG8_SCHED;
            PG8_LDB(B0, 1, 0); PG8_LDB(B1, 1, 1); PG8_SCHED; PG8_LDA(At, 1, 0); PG8_STAGEA(PG8_SA(0, 1), k2, a10, a11);
            PG8_WAIT_V(8); PG8_WAIT_L(0); PG8_BAR; PG8_MMA(0, 0, At, B0); PG8_MMA(0, 1, At, B1); PG8_BAR; PG8_SCHED;
            PG8_LDA(At, 1, 1); PG8_STAGE(PG8_SB(1, 0), b3, voffB); PG8_STAGE(PG8_SB(1, 1), b3 + hstep, voffB); PG8_STAGEA(PG8_SA(1, 0), k3, a00, a01);
            PG8_WAIT_V(8); PG8_WAIT_L(0); PG8_BAR; PG8_MMA(1, 0, At, B0); PG8_MMA(1, 1, At, B1); PG8_BAR; PG8_SCHED;
        }
        if constexpr (ALIGN_EPI) { if (wr == 0) PG8_BAR; }
        E(acc, cur, wr, wc, fr, fq);
        if (!has_next) break;
#pragma unroll
        for (int a = 0; a < 2; ++a)
#pragma unroll
            for (int b = 0; b < 2; ++b)
#pragma unroll
                for (int m = 0; m < 4; ++m)
#pragma unroll
                    for (int n = 0; n < 2; ++n) acc[a][b][m][n] = (f32x4){0.f, 0.f, 0.f, 0.f};
        cur = nxt; cB = nB; c00 = n00; c01 = n01; c10 = n10; c11 = n11; ++ui; cur.par = ui & 1;
        if constexpr (Epi::HAS_PRE) E.pre(cur);
        if constexpr (ALIGN_EPI) { if (wr == 1) PG8_BAR; }
    }
    PG8_WAIT_V(0);
    if constexpr (!ALIGN_EPI) { if (wr == 0) PG8_BAR; }
    PG8_BAR;
#undef PG8_SA
#undef PG8_SB
#undef PG8_STAGE
#undef PG8_STAGEA
#undef PG8_LDA
#undef PG8_LDB
#undef PG8_MMA
#undef PG8_WAIT_V
#undef PG8_WAIT_L
#undef PG8_BAR
#undef PG8_SCHED
}
}

#define XB_TMO      128
#define XB_XCNT(j)  (256  + 64 * (j))
#define XB_XSUB(j)  (1280 + 64 * (j))
#define XB_XGEN(j)  (2304 + 64 * (j))
#define XB_TOP      3328
#define XB_TOPGEN   3392
#define XCD_BAR_WORDS 3456
#define XB_SPIN_CAP (1u << 18)

__device__ __forceinline__ unsigned xb_ld(unsigned* p)              { return __hip_atomic_load(p, __ATOMIC_RELAXED, __HIP_MEMORY_SCOPE_AGENT); }
__device__ __forceinline__ unsigned xb_add(unsigned* p, unsigned v) { return __hip_atomic_fetch_add(p, v, __ATOMIC_RELAXED, __HIP_MEMORY_SCOPE_AGENT); }
__device__ __forceinline__ unsigned xb_xcc_id() { return (unsigned)__builtin_amdgcn_s_getreg((3 << 11) | 20) & 0xFu; }
#define XB_SPIN(cond, bar) do { unsigned _sp = 0; while (cond) { __builtin_amdgcn_s_sleep(1); \
    if ((++_sp & 255u) == 0u) { if (xb_ld(&(bar)[XB_TMO])) break; if (_sp > XB_SPIN_CAP) { atomicAdd(&(bar)[XB_TMO], 1u); break; } } } } while (0)

struct XcdBarrier {
    unsigned* bar; unsigned x;
    volatile LAS unsigned* st;
};

__device__ __forceinline__ XcdBarrier xcd_barrier_post(unsigned* bar, volatile LAS unsigned* st) {
    XcdBarrier b; b.bar = bar; b.x = xb_xcc_id(); b.st = st;
    if (threadIdx.x == 0) (void)xb_add(&bar[XB_XCNT(b.x)], 1u);
    return b;
}
__device__ __forceinline__ void xcd_barrier_complete(unsigned* bar, unsigned x, unsigned& nloc, unsigned& nx) {
    const unsigned G = gridDim.x * gridDim.y * gridDim.z;
    unsigned sum, cnt, mine, sp = 0u;
    for (;;) {
        sum = 0u; cnt = 0u; mine = 0u;
#pragma unroll
        for (unsigned j = 0; j < 16; ++j) { const unsigned c = xb_ld(&bar[XB_XCNT(j)]); sum += c; cnt += (c > 0u) ? 1u : 0u; mine = (j == x) ? c : mine; }
        if (sum == G) break;
        __builtin_amdgcn_s_sleep(1);
        if ((++sp & 255u) == 0u) { if (xb_ld(&bar[XB_TMO])) break; if (sp > XB_SPIN_CAP) { atomicAdd(&bar[XB_TMO], 1u); break; } }
    }
    nloc = mine > 0u ? mine : 1u; nx = cnt > 0u ? cnt : 1u;
}

__device__ __forceinline__ void xcd_barrier(const XcdBarrier& b) {
    asm volatile("s_waitcnt vmcnt(0)" ::: "memory");
    __syncthreads();
    if (threadIdx.x == 0) {
        unsigned* bar = b.bar;
        __builtin_amdgcn_s_waitcnt(0);
        unsigned nloc = b.st[0], nx = b.st[1];
        if (nloc == 0u) { xcd_barrier_complete(bar, b.x, nloc, nx); b.st[0] = nloc; b.st[1] = nx; }
        const unsigned old = xb_add(&bar[XB_XSUB(b.x)], 1u);
        const unsigned gen = old / nloc;
        if (old + 1u == (gen + 1u) * nloc) {
            __builtin_amdgcn_fence(__ATOMIC_RELEASE, "agent");
            asm volatile("s_waitcnt vmcnt(0)" ::: "memory");
            const unsigned og = xb_add(&bar[XB_TOP], 1u);
            const unsigned tg = og / nx;
            if (og + 1u == (tg + 1u) * nx) xb_add(&bar[XB_TOPGEN], 1u);
            else XB_SPIN(xb_ld(&bar[XB_TOPGEN]) == tg, bar);
            __builtin_amdgcn_fence(__ATOMIC_ACQUIRE, "agent");
            xb_add(&bar[XB_XGEN(b.x)], 1u);
            asm volatile("s_waitcnt vmcnt(0)" ::: "memory");
        } else {
            XB_SPIN(xb_ld(&bar[XB_XGEN(b.x)]) == gen, bar);
            __builtin_amdgcn_fence(__ATOMIC_ACQUIRE, "agent");
            asm volatile("s_waitcnt vmcnt(0)" ::: "memory");
        }
    }
    __syncthreads();
}
struct P {
  const float* x; const float* mix_norm; const float* w_in; const float* gate_bias;
  const float* dq_norm; const float* dk_norm; const float* dlam; const float* dsubln;
  const float* nq_norm; const float* nk_norm; const float* cmp_pe; const float* cmp_w1; const float* cmp_w2;
  const float* w_out;
  const float* rmix; const float* w_r; const float* w_k; const float* w_v;
  const float* w0; const float* w1; const float* w2; const float* a0; const float* a1; const float* a2;
  const float* g1; const float* g2; const float* k_k; const float* k_a; const float* r_k;
  const float* ln_w; const float* ln_b; const float* w_o;
  const float* ffn_norm; const float* rg_w; const float* rg_b; const float* re_w; const float* re_b;
  const float* e_gate; const float* e_up; const float* e_down;
  float* out;
  unsigned char* ws;
  int ph_lo, ph_hi, layer, pad;
};

#define PREF const __attribute__((address_space(4))) P&
__device__ __forceinline__ const __attribute__((address_space(4))) P* opaque_kernarg() { auto q = __builtin_amdgcn_kernarg_segment_ptr(); asm volatile("" : "+s"(q)); return (const __attribute__((address_space(4))) P*)q; }
#define KP (*opaque_kernarg())

constexpr int RING_OFF = 0, RING_BYTES = 131072;
constexpr int LDSCTL_OFF = RING_BYTES, MISC_OFF = LDSCTL_OFF + 320;
constexpr int LDS_BYTES = 147456;
constexpr int NWAVES = 8;

struct Frame {
  LAS unsigned char* lds;
  volatile LAS unsigned* MISC;
  gu32* ctl;
  int tid, lane, wave, vcu, G;
#ifdef PROBE_PH
  unsigned long long pr_t0, pr_t1;
#endif
};
#ifdef PROBE_PH
#define PROBE_MARK(k) do { if ((k) == PROBE_PH) F.pr_t0 = __builtin_amdgcn_s_memrealtime(); if ((k) == PROBE_PH + PROBE_N) F.pr_t1 = __builtin_amdgcn_s_memrealtime(); } while (0)
#else
#define PROBE_MARK(k) do {} while (0)
#endif

__device__ __forceinline__ void transpose_item(const float* W, int ldsrc, int k0, int c0, int ncols, bf16_t* dst, int ldk, int drow0, LAS float* scr, int lane) {
  const int kr = lane >> 3, c4 = (lane & 7) * 4;
  f32x4 v[8];
#pragma unroll
  for (int i = 0; i < 8; ++i) v[i] = (c4 < ncols) ? *(const GAS f32x4*)(W + (size_t)(k0 + kr + 8 * i) * ldsrc + c0 + c4) : (f32x4){0.f, 0.f, 0.f, 0.f};
#pragma unroll
  for (int i = 0; i < 8; ++i) { LAS float* s = scr + (kr + 8 * i) * 33 + c4; s[0] = v[i].x; s[1] = v[i].y; s[2] = v[i].z; s[3] = v[i].w; }
  LDS_WAIT(); asm volatile("" ::: "memory");
  const int c = lane & 7;
#pragma unroll
  for (int j = 0; j < 4; ++j) { const int n = (lane >> 3) + 8 * j; const LAS float* s = scr + (8 * c) * 33 + n;
    v4u o; o.x = pk2(s[0 * 33], s[1 * 33]); o.y = pk2(s[2 * 33], s[3 * 33]); o.z = pk2(s[4 * 33], s[5 * 33]); o.w = pk2(s[6 * 33], s[7 * 33]);
    *(GAS v4u*)(dst + (size_t)(drow0 + n) * ldk + k0 + 8 * c) = o; }
  LDS_WAIT(); asm volatile("" ::: "memory");
}
template <int NR>
__device__ __forceinline__ void rms_rows_to_bf16(const float* x, const float* gain, bf16_t* o, int m0, int stride, int lane) {
  f32x4 v[NR][4];
#pragma unroll
  for (int r = 0; r < NR; ++r) { const GAS f32x4* xr = (const GAS f32x4*)(x + (size_t)(m0 + r * stride) * DM) + lane;
#pragma unroll
    for (int j = 0; j < 4; ++j) v[r][j] = xr[64 * j]; }
  const GAS f32x4* gr = (const GAS f32x4*)gain + lane;
  f32x4 g[4];
#pragma unroll
  for (int j = 0; j < 4; ++j) g[j] = gr[64 * j];
#pragma unroll
  for (int r = 0; r < NR; ++r) {
    float s = 0.f;
#pragma unroll
    for (int j = 0; j < 4; ++j) s += (v[r][j].x * v[r][j].x + v[r][j].y * v[r][j].y) + (v[r][j].z * v[r][j].z + v[r][j].w * v[r][j].w);
    const float rr = rsqrtf(wave_sum_dpp(s) * (1.f / DM) + 1e-6f);
    GAS v2u* o8 = (GAS v2u*)(o + (size_t)(m0 + r * stride) * DM) + lane;
#pragma unroll
    for (int j = 0; j < 4; ++j) { v2u w; w.x = pk2(v[r][j].x * rr * g[j].x, v[r][j].y * rr * g[j].y); w.y = pk2(v[r][j].z * rr * g[j].z, v[r][j].w * rr * g[j].w); o8[64 * j] = w; }
  }
}

__device__ __forceinline__ void conv_win_item(PREF p, int it, LAS float* scr, int lane) {
  const int vg = it >> 4, kb = it & 15;
  const int pn = vg >> 3, bj = (vg >> 2) & 1, wc = vg & 3, s = pn * 4 + wc;
  int c0 = 0, nc = 0;
  if (s < 44) { c0 = 64 * s + 32 * bj; nc = 32; } else if (s == 44 && bj == 0) { c0 = OFF_NG; nc = 24; }
  transpose_item(p.w_in, INC, kb * 64, c0, nc, (bf16_t*)(p.ws + WS_WIN), DM, vg * 32, scr, lane);
}
__device__ __forceinline__ void conv_sq_item(const float* W, bf16_t* dst, int drow_base, int it, LAS float* scr, int lane) {
  const int cg = it >> 4, kb = it & 15;
  transpose_item(W, DM, kb * 64, cg * 32, 32, dst, DM, drow_base + cg * 32, scr, lane);
}
__device__ __forceinline__ void conv_expert_item(PREF p, int layer, int it, LAS float* scr, int lane) {
  const int e = it / 384, r = it % 384;
  if (r < 256) {
    const int up = r >> 7, q = r & 127, cgp = q >> 4, kb = q & 15;
    const int pn = cgp >> 2, qq = cgp & 3;
    const float* W = (up ? p.e_up : p.e_gate) + ((size_t)layer * 32 + e) * DM * 256;
    transpose_item(W, 256, kb * 64, cgp * 32, 32, (bf16_t*)(p.ws + WS_EGU), DM, e * 512 + pn * 256 + up * 128 + qq * 32, scr, lane);
  } else {
    const int q = r - 256, cg = q >> 2, kb = q & 3;
    const float* W = p.e_down + ((size_t)layer * 32 + e) * 256 * DM;
    transpose_item(W, DM, kb * 64, cg * 32, 32, (bf16_t*)(p.ws + WS_EDN), 256, e * 1024 + cg * 32, scr, lane);
  }
}

using pg8::Unit; using pg8::u32x4; using pg8::pack8;
struct EpiInProj {
  static constexpr bool PERM = true, HAS_PRE = false;
  bf16_t* H; float* GATES; const float* dq; const float* dk; const float* nq; const float* nk; const float* gbias;
  __device__ __forceinline__ void operator()(const f32x4 (&acc)[2][2][4][2], const Unit& u, int wr, int wc, int fr, int fq) const {
    const int s = u.pn * 4 + wc;
    if (s > 44) return;
    const int row0 = u.pm * 256 + wr * 64 + fr;
    if (s == 44) {
      if (fq < 3) {
        f32x4 b0 = *(const f32x4*)(gbias + 8 * fq), b1 = *(const f32x4*)(gbias + 8 * fq + 4);
#pragma unroll
        for (int ai = 0; ai < 2; ++ai)
#pragma unroll
          for (int m = 0; m < 4; ++m) { float* gp = GATES + (size_t)(row0 + ai * 128 + m * 16) * 24 + 8 * fq;
            f32x4 v0 = acc[ai][0][m][0] + b0, v1 = acc[ai][0][m][1] + b1;
#pragma unroll
            for (int i = 0; i < 4; ++i) { v0[i] = sigmoidf_(v0[i]); v1[i] = sigmoidf_(v1[i]); }
            *(f32x4*)gp = v0; *(f32x4*)(gp + 4) = v1; }
      }
      return;
    }
    int mode = 0; const float* gain = nullptr;
    if (s < 8) { mode = 1; gain = dq; } else if (s < 16) { mode = 1; gain = dk; }
    else if (s >= 24 && s < 32) { mode = 2; gain = nq; }
    else if (s >= 32) { const int q = s - 32, br = q >> 2, kv = (q >> 1) & 1; if (kv == 0 && br >= 1) { mode = 2; gain = nk + br * 64; } }
    const float qsc = (s < 8) ? 0.17677669529663687f * 1.4426950408889634f : ((s >= 24 && s < 32) ? 0.125f * 1.4426950408889634f : 1.f);
    f32x4 g[2][2];
#pragma unroll
    for (int bj = 0; bj < 2; ++bj)
#pragma unroll
      for (int n = 0; n < 2; ++n) {
        if (mode == 1) g[bj][n] = *(const f32x4*)(gain + 8 * fq + 4 * n);
        else if (mode == 2) g[bj][n] = *(const f32x4*)(gain + 32 * bj + 8 * fq + 4 * n);
        else g[bj][n] = (f32x4){1.f, 1.f, 1.f, 1.f};
      }
#pragma unroll
    for (int ai = 0; ai < 2; ++ai)
#pragma unroll
      for (int m = 0; m < 4; ++m) {
        float sc[2] = {1.f, 1.f};
        if (mode != 0) {
          float ss[2];
#pragma unroll
          for (int bj = 0; bj < 2; ++bj) { const f32x4 a = acc[ai][bj][m][0], b = acc[ai][bj][m][1];
            float t = (a[0] * a[0] + a[1] * a[1]) + (a[2] * a[2] + a[3] * a[3]) + (b[0] * b[0] + b[1] * b[1]) + (b[2] * b[2] + b[3] * b[3]);
            t += __shfl_xor(t, 16, 64); t += __shfl_xor(t, 32, 64); ss[bj] = t; }
          if (mode == 1) { sc[0] = rsqrtf(ss[0] * (1.f / 32.f) + 1e-6f) * qsc; sc[1] = rsqrtf(ss[1] * (1.f / 32.f) + 1e-6f) * qsc; }
          else { const float r = rsqrtf((ss[0] + ss[1]) * (1.f / 64.f) + 1e-6f) * qsc; sc[0] = r; sc[1] = r; }
        }
        bf16_t* rowp = H + (size_t)(row0 + ai * 128 + m * 16) * HC + 64 * s + 8 * fq;
#pragma unroll
        for (int bj = 0; bj < 2; ++bj) { const f32x4 v0 = acc[ai][bj][m][0] * sc[bj] * g[bj][0], v1 = acc[ai][bj][m][1] * sc[bj] * g[bj][1];
          *(u32x4*)(rowp + 32 * bj) = pack8(v0, v1); }
      }
  }
};
struct EpiResid {
  static constexpr bool PERM = false, HAS_PRE = false;
  const float* base; float* out; const bf16_t* y1;
  __device__ __forceinline__ void operator()(const f32x4 (&acc)[2][2][4][2], const Unit& u, int wr, int wc, int fr, int fq) const {
    const int row0 = u.pm * 256 + wr * 64 + fr, col0 = u.pn * 256 + wc * 32 + 4 * fq;
#pragma unroll
    for (int ai = 0; ai < 2; ++ai)
#pragma unroll
      for (int m = 0; m < 4; ++m) { const size_t off = (size_t)(row0 + ai * 128 + m * 16) * DM + col0;
#pragma unroll
        for (int bj = 0; bj < 2; ++bj)
#pragma unroll
          for (int n = 0; n < 2; ++n) { f32x4 b = *(const f32x4*)(base + off + bj * 128 + n * 16);
            if (y1) { const v2u y = *(const v2u*)(y1 + off + bj * 128 + n * 16);
              b.x += __uint_as_float(y.x << 16); b.y += __uint_as_float(y.x & 0xffff0000u); b.z += __uint_as_float(y.y << 16); b.w += __uint_as_float(y.y & 0xffff0000u); }
            *(f32x4*)(out + off + bj * 128 + n * 16) = b + acc[ai][bj][m][n]; asm volatile("" ::: "memory"); } }
  }
};
struct EpiRKV {
  static constexpr bool PERM = true, HAS_PRE = false;
  unsigned char* ws;
  __device__ __forceinline__ void operator()(const f32x4 (&acc)[2][2][4][2], const Unit& u, int wr, int wc, int fr, int fq) const {
    const int gi = u.pm >> 6;
    bf16_t* O = (bf16_t*)(ws + WS_S0 + (size_t)(3 + gi) * SLOT);
    const int row0 = (u.pm & 63) * 256 + wr * 64 + fr, col0 = (u.pn & 3) * 256 + wc * 32 + 8 * fq;
#pragma unroll
    for (int ai = 0; ai < 2; ++ai)
#pragma unroll
      for (int m = 0; m < 4; ++m) { bf16_t* rowp = O + (size_t)(row0 + ai * 128 + m * 16) * DM + col0;
#pragma unroll
        for (int bj = 0; bj < 2; ++bj) *(u32x4*)(rowp + bj * 128) = pack8(acc[ai][bj][m][0], acc[ai][bj][m][1]); }
  }
};
struct EpiLora1 {
  static constexpr bool PERM = true, HAS_PRE = false;
  bf16_t* TMP;
  template <int BJ>
  __device__ __forceinline__ void half(const f32x4 (&acc)[2][2][4][2], int gi, int row0, int wc, int fq) const {
    const int c = BJ * 128 + wc * 32 + 8 * fq;
    const bool skip = (gi < 2) && (c >= 64);
    const int dcol = (gi < 2) ? gi * 64 + c : 128 + c;
    const bool zero = (gi == 2) && (c >= 160);
    if (skip) return;
#pragma unroll
    for (int ai = 0; ai < 2; ++ai)
#pragma unroll
      for (int m = 0; m < 4; ++m) {
        f32x4 v0 = acc[ai][BJ][m][0], v1 = acc[ai][BJ][m][1];
#pragma unroll
        for (int i = 0; i < 4; ++i) {
          if (gi == 0) { v0[i] = tanhf(v0[i]); v1[i] = tanhf(v1[i]); }
          else if (gi == 2) { v0[i] = zero ? 0.f : sigmoidf_(v0[i]); v1[i] = zero ? 0.f : sigmoidf_(v1[i]); }
        }
        *(u32x4*)(TMP + (size_t)(row0 + ai * 128 + m * 16) * 384 + dcol) = pack8(v0, v1);
      }
  }
  __device__ __forceinline__ void operator()(const f32x4 (&acc)[2][2][4][2], const Unit& u, int wr, int wc, int fr, int fq) const {
    const int gi = u.pm >> 6;
    const int row0 = (u.pm & 63) * 256 + wr * 64 + fr;
    half<0>(acc, gi, row0, wc, fq);
    half<1>(acc, gi, row0, wc, fq);
  }
};
struct EpiLora2 {
  static constexpr bool PERM = true, HAS_PRE = false;
  unsigned char* ws; const float* w0; const float* a0; int gbase;
  __device__ __forceinline__ void operator()(const f32x4 (&acc)[2][2][4][2], const Unit& u, int wr, int wc, int fr, int fq) const {
    const int gi = gbase + (u.pn >> 2);
    bf16_t* O = (bf16_t*)(ws + WS_S0 + (size_t)gi * SLOT);
    const int row0 = u.pm * 256 + wr * 64 + fr, col0 = (u.pn & 3) * 256 + wc * 32 + 8 * fq;
    f32x4 b[2][2];
#pragma unroll
    for (int bj = 0; bj < 2; ++bj)
#pragma unroll
      for (int n = 0; n < 2; ++n) b[bj][n] = (gi == 0) ? *(const f32x4*)(w0 + col0 + bj * 128 + 4 * n) : (gi == 1 ? *(const f32x4*)(a0 + col0 + bj * 128 + 4 * n) : (f32x4){0.f, 0.f, 0.f, 0.f});
#pragma unroll
    for (int ai = 0; ai < 2; ++ai)
#pragma unroll
      for (int m = 0; m < 4; ++m) { bf16_t* rowp = O + (size_t)(row0 + ai * 128 + m * 16) * DM + col0;
#pragma unroll
        for (int bj = 0; bj < 2; ++bj) { f32x4 v0 = acc[ai][bj][m][0] + b[bj][0], v1 = acc[ai][bj][m][1] + b[bj][1];
          if (gi == 0) {
#pragma unroll
            for (int i = 0; i < 4; ++i) { v0[i] = -__expf(-softplusf_(-v0[i]) - 0.5f); v1[i] = -__expf(-softplusf_(-v1[i]) - 0.5f); }
          } else if (gi == 1) {
#pragma unroll
            for (int i = 0; i < 4; ++i) { v0[i] = sigmoidf_(v0[i]); v1[i] = sigmoidf_(v1[i]); }
          }
          *(u32x4*)(rowp + bj * 128) = pack8(v0, v1); } }
  }
};
struct EpiMoeGU {
  static constexpr bool PERM = true, HAS_PRE = false;
  bf16_t* HID;
  __device__ __forceinline__ void operator()(const f32x4 (&acc)[2][2][4][2], const Unit& u, int wr, int wc, int fr, int fq) const {
    const int row0 = u.pm * 256 + wr * 64 + fr, col0 = (u.pn & 1) * 128 + wc * 32 + 8 * fq;
#pragma unroll
    for (int ai = 0; ai < 2; ++ai)
#pragma unroll
      for (int m = 0; m < 4; ++m) {
        f32x4 h[2];
#pragma unroll
        for (int n = 0; n < 2; ++n) { const f32x4 g = acc[ai][0][m][n], up = acc[ai][1][m][n];
#pragma unroll
          for (int i = 0; i < 4; ++i) h[n][i] = g[i] * sigmoidf_(g[i]) * up[i]; }
        *(u32x4*)(HID + (size_t)(row0 + ai * 128 + m * 16) * 256 + col0) = pack8(h[0], h[1]);
      }
  }
};
struct EpiMoeDown {
  static constexpr bool PERM = false, HAS_PRE = true;
  float* out; bf16_t* Y1; const int* list; const float* pgate; LAS int* ept;
  __device__ __forceinline__ void pre(const Unit& u) const {
    const int r = threadIdx.x;
    if (r < 256) { int pr = -1; float gt = 0.f;
      if (r < u.nrows) { pr = list[(size_t)u.e * CAP + u.rt * 256 + r]; gt = pgate[pr]; }
      LAS int* e = ept + (u.par * 256 + r) * 2; e[0] = pr; e[1] = __float_as_int(gt); }
  }
  __device__ __forceinline__ void operator()(const f32x4 (&acc)[2][2][4][2], const Unit& u, int wr, int wc, int fr, int fq) const {
    const int col0 = (u.pn & 3) * 256 + wc * 32 + 4 * fq;
#pragma unroll
    for (int ai = 0; ai < 2; ++ai)
#pragma unroll
      for (int m = 0; m < 4; ++m) {
        const int r = ai * 128 + wr * 64 + m * 16 + fr;
        const LAS int* e = ept + (u.par * 256 + r) * 2;
        const int pr = e[0]; const float gt = __int_as_float(e[1]);
        if (pr >= 0) {
          const int tok = pr >> 1;
          if ((pr & 1) == 0) {
            float* op = out + (size_t)tok * DM + col0;
#pragma unroll
            for (int bj = 0; bj < 2; ++bj)
#pragma unroll
              for (int n = 0; n < 2; ++n) { f32x4 b = *(const f32x4*)(op + bj * 128 + n * 16); *(f32x4*)(op + bj * 128 + n * 16) = b + acc[ai][bj][m][n] * gt; }
          } else {
            bf16_t* yp = Y1 + (size_t)tok * DM + col0;
#pragma unroll
            for (int bj = 0; bj < 2; ++bj)
#pragma unroll
              for (int n = 0; n < 2; ++n) { const f32x4 v = acc[ai][bj][m][n] * gt; v2u w; w.x = pk2(v[0], v[1]); w.y = pk2(v[2], v[3]); *(v2u*)(yp + bj * 128 + n * 16) = w; }
          }
        }
      }
  }
};

__device__ __forceinline__ void phase_prologue(PREF p, Frame& F) {
  const int lane = fresh_lane();
  LAS float* scr = (LAS float*)(F.lds + RING_OFF + F.wave * 16384);
  const int gw = F.vcu * NWAVES + F.wave, NGW = F.G * NWAVES;
  constexpr int I_WIN = 96 * 16, I_SQ = 32 * 16;
  constexpr int NITEMS = I_WIN + 5 * I_SQ + 128;
  for (int it = gw; it < NITEMS; it += NGW) {
    int r = it;
    if (r < I_WIN) { conv_win_item(p, r, scr, fresh_lane()); continue; } r -= I_WIN;
    if (r < I_SQ) { conv_sq_item(p.w_out, (bf16_t*)(p.ws + WS_WOUT), 0, r, scr, fresh_lane()); continue; } r -= I_SQ;
    if (r < I_SQ) { conv_sq_item(p.w_r, (bf16_t*)(p.ws + WS_WRKV), 0, r, scr, fresh_lane()); continue; } r -= I_SQ;
    if (r < I_SQ) { conv_sq_item(p.w_k, (bf16_t*)(p.ws + WS_WRKV), 1024, r, scr, fresh_lane()); continue; } r -= I_SQ;
    if (r < I_SQ) { conv_sq_item(p.w_v, (bf16_t*)(p.ws + WS_WRKV), 2048, r, scr, fresh_lane()); continue; } r -= I_SQ;
    if (r < I_SQ) { conv_sq_item(p.w_o, (bf16_t*)(p.ws + WS_WO), 0, r, scr, fresh_lane()); continue; } r -= I_SQ;
    { const int kv = r >> 6, q = r & 63, kb = q >> 1, cg = q & 1;
      transpose_item(p.cmp_w1 + (size_t)kv * 2048 * 64, 64, kb * 64, cg * 32, 32, (bf16_t*)(p.ws + WS_CW1) + (size_t)kv * 64 * 2048, 2048, cg * 32, scr, fresh_lane()); }
  }
  {
    const int gt = (F.vcu * NWAVES + F.wave) * 64 + fresh_lane(), NGT = NGW * 64;
    bf16_t* WL1 = (bf16_t*)(p.ws + WS_WL1);
    for (int i = gt; i < 768 * 1024; i += NGT) {
      const int n = i >> 10, k = i & 1023, gi = n >> 8, c = n & 255;
      float v = 0.f;
      if (gi == 0) { if (c < 64) v = p.w1[k * 64 + c]; }
      else if (gi == 1) { if (c < 64) v = p.a1[k * 64 + c]; }
      else { if (c < 160) v = p.g1[k * 160 + c]; }
      WL1[i] = (bf16_t)f2bf(v);
    }
    bf16_t* WL2 = (bf16_t*)(p.ws + WS_WL2);
    for (int i = gt; i < 2048 * 128; i += NGT) {
      const int n = i >> 7, k = i & 127, c = n & 1023;
      float v = 0.f;
      if (n < 1024) { if (k < 64) v = p.w2[k * 1024 + c]; }
      else { if (k >= 64) v = p.a2[(k - 64) * 1024 + c]; }
      WL2[i] = (bf16_t)f2bf(v);
    }
    bf16_t* WL2g = (bf16_t*)(p.ws + WS_WL2 + 512 * 1024);
    for (int i = gt; i < 1024 * 256; i += NGT) {
      const int n = i >> 8, k = i & 255;
      WL2g[i] = (bf16_t)f2bf(k < 160 ? p.g2[k * 1024 + n] : 0.f);
    }
  }
  bf16_t* XN = (bf16_t*)(p.ws + WS_XN);
  for (int m = gw; m < T_TOK; m += 4 * NGW) rms_rows_to_bf16<4>(p.x, p.mix_norm, XN, m, NGW, lane);
}


__device__ __forceinline__ void phase_router(PREF p, Frame& F, int layer) {
  const int gw = F.vcu * NWAVES + F.wave, NGW = F.G * NWAVES;
  const int lane = fresh_lane();
  PROBE_MARK(100 + layer * 10);
  {
    LAS float* scr = (LAS float*)(F.lds + RING_OFF + F.wave * 16384);
    for (int it = gw; it < 32 * 384; it += NGW) conv_expert_item(p, layer, it, scr, lane);
  }
  __syncthreads();
  PROBE_MARK(101 + layer * 10);
  LAS float* WQ = (LAS float*)(F.lds);
  LAS float* XS = (LAS float*)(F.lds + 40960) + F.wave * 2080;
  LAS float* LG = (LAS float*)(F.lds + 107520) + F.wave * 8 * 36;
  const float* gain = p.ffn_norm + layer * DM;
  const float* wg = p.rg_w + (size_t)layer * DM * 4;
  const float* we = p.re_w + (size_t)layer * DM * 32;
  bf16_t* XN2 = (bf16_t*)(p.ws + WS_XN2);
  f32x4 v[8][4];
#pragma unroll
  for (int tt = 0; tt < 8; ++tt) { const GAS f32x4* xr = (const GAS f32x4*)(p.out + (size_t)(gw * 8 + tt) * DM) + lane;
#pragma unroll
    for (int j = 0; j < 4; ++j) v[tt][j] = xr[64 * j]; }
  {
    f32x4 g[4];
#pragma unroll
    for (int j = 0; j < 4; ++j) g[j] = ((const GAS f32x4*)gain)[lane + 64 * j];
#pragma unroll
    for (int tt = 0; tt < 8; ++tt) {
      float s = 0.f;
#pragma unroll
      for (int j = 0; j < 4; ++j) s += (v[tt][j].x * v[tt][j].x + v[tt][j].y * v[tt][j].y) + (v[tt][j].z * v[tt][j].z + v[tt][j].w * v[tt][j].w);
      const float r = rsqrtf(wave_sum_dpp(s) * (1.f / DM) + 1e-6f);
      GAS v2u* o = (GAS v2u*)(XN2 + (size_t)(gw * 8 + tt) * DM) + lane;
#pragma unroll
      for (int j = 0; j < 4; ++j) { v[tt][j] = v[tt][j] * r * g[j]; v2u w; w.x = pk2(v[tt][j].x, v[tt][j].y); w.y = pk2(v[tt][j].z, v[tt][j].w); o[64 * j] = w; }
    }
  }
  PROBE_MARK(102 + layer * 10);
  f32x4 acc[3];
#pragma unroll
  for (int nt = 0; nt < 3; ++nt) acc[nt] = (f32x4){0.f, 0.f, 0.f, 0.f};
  const int r16 = lane & 15, g4 = lane >> 4;
#pragma unroll
  for (int j = 0; j < 4; ++j) {
    __syncthreads();
    for (int idx = F.tid; idx < 256 * 9; idx += NWAVES * 64) {
      const int row = idx / 9, c4 = idx - row * 9, k = 256 * j + row;
      const f32x4 val = (c4 == 0) ? *(const GAS f32x4*)(wg + k * 4) : *(const GAS f32x4*)(we + k * 32 + (c4 - 1) * 4);
      *(LAS f32x4*)(WQ + row * 36 + c4 * 4) = val;
    }
#pragma unroll
    for (int tt = 0; tt < 8; ++tt) *(LAS f32x4*)(XS + tt * 260 + 4 * lane) = v[tt][j];
    __syncthreads();
    const LAS float* xa = XS + (r16 & 7) * 260 + g4;
    const LAS float* wb = WQ + g4 * 36 + r16;
#pragma unroll 4
    for (int ks = 0; ks < 64; ++ks) {
      const float a = xa[4 * ks];
#pragma unroll
      for (int nt = 0; nt < 3; ++nt) acc[nt] = __builtin_amdgcn_mfma_f32_16x16x4f32(a, wb[4 * ks * 36 + nt * 16], acc[nt], 0, 0, 0);
    }
  }
  PROBE_MARK(103 + layer * 10);
  if (g4 < 2) {
#pragma unroll
    for (int nt = 0; nt < 3; ++nt) { const int n = nt * 16 + r16;
      if (n < 36) {
#pragma unroll
        for (int i = 0; i < 4; ++i) LG[(4 * g4 + i) * 36 + n] = acc[nt][i]; } }
  }
  LAS unsigned* LC = (LAS unsigned*)(F.lds + 118784);
  if (F.tid < 64) LC[F.tid] = 0u;
  __syncthreads();
  int ea = 0, eb = 0; unsigned la = 0, lb = 0; float ga = 0.f, gb = 0.f;
  if (lane < 8) {
    const LAS float* lg = LG + lane * 36;
    const float* bg = p.rg_b + layer * 4;
    const float* be = p.re_b + layer * 32;
    float gl[4]; int gi = 0; float gm = -3.4e38f;
#pragma unroll
    for (int i = 0; i < 4; i++) { gl[i] = lg[i] + bg[i]; if (gl[i] > gm) { gm = gl[i]; gi = i; } }
    float gs = 0.f;
#pragma unroll
    for (int i = 0; i < 4; i++) gs += __expf(gl[i] - gm);
    const float grp_p = 1.f / gs;
    float v0 = -3.4e38f, v1 = -3.4e38f; int i0 = 0, i1 = 0;
    for (int i = 0; i < 8; i++) {
      const float v = lg[4 + gi * 8 + i] + be[gi * 8 + i];
      if (v > v0) { v1 = v0; i1 = i0; v0 = v; i0 = i; }
      else if (v > v1) { v1 = v; i1 = i; }
    }
    const float e1 = __expf(v1 - v0);
    ga = grp_p / (1.f + e1); gb = grp_p * e1 / (1.f + e1);
    ea = gi * 8 + i0; eb = gi * 8 + i1;
    la = __hip_atomic_fetch_add(LC + ea, 1u, __ATOMIC_RELAXED, __HIP_MEMORY_SCOPE_WORKGROUP);
    lb = __hip_atomic_fetch_add(LC + eb, 1u, __ATOMIC_RELAXED, __HIP_MEMORY_SCOPE_WORKGROUP);
  }
  __syncthreads();
  if (F.tid < 32) { const unsigned n = LC[F.tid];
    unsigned* cnt = (unsigned*)(p.ws + WS_CTL) + CW_CNT + (layer * 32 + F.tid) * 64;
    LC[32 + F.tid] = n ? __hip_atomic_fetch_add(cnt, n, __ATOMIC_RELAXED, __HIP_MEMORY_SCOPE_AGENT) : 0u; }
  __syncthreads();
  if (lane < 8) {
    const int t = gw * 8 + lane;
    int* list = (int*)(p.ws + WS_LIST); float* pgate = (float*)(p.ws + WS_PGATE);
    list[(size_t)ea * CAP + LC[32 + ea] + la] = 2 * t; pgate[2 * t] = ga;
    list[(size_t)eb * CAP + LC[32 + eb] + lb] = 2 * t + 1; pgate[2 * t + 1] = gb;
  }
  PROBE_MARK(104 + layer * 10);
}

__device__ __forceinline__ void phase_final(PREF p, Frame& F) {
  const int gw = F.vcu * NWAVES + F.wave, NGW = F.G * NWAVES;
  const bf16_t* Y1 = (const bf16_t*)(p.ws + WS_Y1);
  for (int t = gw; t < T_TOK; t += NGW) {
    GAS f32x4* xr = (GAS f32x4*)(p.out + (size_t)t * DM) + fresh_lane();
    const GAS v2u* yr = (const GAS v2u*)(Y1 + (size_t)t * DM) + fresh_lane();
#pragma unroll
    for (int j = 0; j < 4; ++j) { f32x4 v = xr[64 * j]; const v2u y = yr[64 * j];
      v.x += __uint_as_float(y.x << 16); v.y += __uint_as_float(y.x & 0xffff0000u); v.z += __uint_as_float(y.y << 16); v.w += __uint_as_float(y.y & 0xffff0000u);
      xr[64 * j] = v; }
  }
}

__device__ __forceinline__ void phase_rwkv_prep(PREF p, Frame& F) {
  const int gw = F.vcu * NWAVES + F.wave, NGW = F.G * NWAVES;
  const int lane = fresh_lane();
  const float* gain = p.mix_norm + DM;
  const bf16_t* Y1 = (const bf16_t*)(p.ws + WS_Y1);
  f32x4 g[4];
#pragma unroll
  for (int j = 0; j < 4; ++j) g[j] = ((const GAS f32x4*)gain)[lane + 64 * j];
  for (int run = gw; run < T_TOK / 8; run += NGW) {
    const int t0 = run * 8;
    f32x4 prev[4];
    if ((t0 & (SEQ - 1)) == 0) {
#pragma unroll
      for (int j = 0; j < 4; ++j) prev[j] = (f32x4){0.f, 0.f, 0.f, 0.f};
    } else {
      const GAS f32x4* xr = (const GAS f32x4*)(p.out + (size_t)(t0 - 1) * DM) + lane;
      const GAS v2u* yr = (const GAS v2u*)(Y1 + (size_t)(t0 - 1) * DM) + lane;
      float s = 0.f;
#pragma unroll
      for (int j = 0; j < 4; ++j) { prev[j] = xr[64 * j]; const v2u y = yr[64 * j];
        prev[j].x += __uint_as_float(y.x << 16); prev[j].y += __uint_as_float(y.x & 0xffff0000u); prev[j].z += __uint_as_float(y.y << 16); prev[j].w += __uint_as_float(y.y & 0xffff0000u);
        s += (prev[j].x * prev[j].x + prev[j].y * prev[j].y) + (prev[j].z * prev[j].z + prev[j].w * prev[j].w); }
      const float r = rsqrtf(wave_sum(s) * (1.f / DM) + 1e-6f);
#pragma unroll
      for (int j = 0; j < 4; ++j) prev[j] = prev[j] * r * g[j];
    }
    f32x4 nx[4]; v2u ny[4];
    { const GAS f32x4* xr = (const GAS f32x4*)(p.out + (size_t)t0 * DM) + lane; const GAS v2u* yr = (const GAS v2u*)(Y1 + (size_t)t0 * DM) + lane;
#pragma unroll
      for (int j = 0; j < 4; ++j) { nx[j] = xr[64 * j]; ny[j] = yr[64 * j]; } }
#pragma unroll 1
    for (int tt = 0; tt < 8; ++tt) {
      const int t = t0 + tt;
      f32x4 v[4]; float s = 0.f;
#pragma unroll
      for (int j = 0; j < 4; ++j) { v[j] = nx[j]; const v2u y = ny[j];
        v[j].x += __uint_as_float(y.x << 16); v[j].y += __uint_as_float(y.x & 0xffff0000u); v[j].z += __uint_as_float(y.y << 16); v[j].w += __uint_as_float(y.y & 0xffff0000u);
        s += (v[j].x * v[j].x + v[j].y * v[j].y) + (v[j].z * v[j].z + v[j].w * v[j].w); }
      if (tt < 7) { const GAS f32x4* xr = (const GAS f32x4*)(p.out + (size_t)(t + 1) * DM) + lane; const GAS v2u* yr = (const GAS v2u*)(Y1 + (size_t)(t + 1) * DM) + lane;
#pragma unroll
        for (int j = 0; j < 4; ++j) { nx[j] = xr[64 * j]; ny[j] = yr[64 * j]; } }
      const float r = rsqrtf(wave_sum_dpp(s) * (1.f / DM) + 1e-6f);
#pragma unroll
      for (int j = 0; j < 4; ++j) v[j] = v[j] * r * g[j];
#pragma unroll
      for (int sl = 0; sl < 6; ++sl) {
        const int mj = (sl == 0) ? 0 : (sl == 1) ? 2 : (sl == 2) ? 3 : (sl == 3) ? 1 : (sl == 4) ? 4 : 5;
        GAS v2u* o = (GAS v2u*)(p.ws + WS_S0 + (size_t)sl * SLOT + (size_t)t * DM * 2) + lane;
#pragma unroll
        for (int j = 0; j < 4; ++j) {
          const f32x4 mx = ((const GAS f32x4*)(p.rmix + mj * DM))[lane + 64 * j];
          const f32x4 q = v[j] + (prev[j] - v[j]) * mx;
          v2u w; w.x = pk2(q.x, q.y); w.y = pk2(q.z, q.w);
          o[64 * j] = w;
        }
      }
#pragma unroll
      for (int j = 0; j < 4; ++j) prev[j] = v[j];
    }
  }
}


constexpr int RP = 72;
constexpr int RB = 64 * RP * 2;
typedef LAS bf16_t* lbf;

__device__ __forceinline__ f32x4 mm16(f32x4 acc, const LAS bf16_t* A, int arow0, const LAS bf16_t* Bt, int brow0, int lane) {
  const int r = lane & 15, q = lane >> 4;
#pragma unroll
  for (int ks = 0; ks < 2; ++ks) {
    const bf16x8 a = *(const LAS bf16x8*)(A + (arow0 + r) * RP + ks * 32 + q * 8);
    const bf16x8 b = *(const LAS bf16x8*)(Bt + (brow0 + r) * RP + ks * 32 + q * 8);
    acc = __builtin_amdgcn_mfma_f32_16x16x32_bf16(a, b, acc, 0, 0, 0);
  }
  return acc;
}
__device__ __forceinline__ float sum8(float v) {
  v += __shfl_xor(v, 1, 64); v += __shfl_xor(v, 2, 64); v += __shfl_xor(v, 4, 64); return v;
}
__device__ __forceinline__ void ld8bf(const bf16_t* p, float (&o)[8]) {
  const v4u w = *(const GAS v4u*)p;
  o[0] = __uint_as_float(w.x << 16); o[1] = __uint_as_float(w.x & 0xffff0000u); o[2] = __uint_as_float(w.y << 16); o[3] = __uint_as_float(w.y & 0xffff0000u);
  o[4] = __uint_as_float(w.z << 16); o[5] = __uint_as_float(w.z & 0xffff0000u); o[6] = __uint_as_float(w.w << 16); o[7] = __uint_as_float(w.w & 0xffff0000u);
}
__device__ __forceinline__ v4u pk8(const float (&o)[8]) { v4u w; w.x = pk2(o[0], o[1]); w.y = pk2(o[2], o[3]); w.z = pk2(o[4], o[5]); w.w = pk2(o[6], o[7]); return w; }

#define R1_BAR() do { asm volatile("s_waitcnt lgkmcnt(0)" ::: "memory"); __builtin_amdgcn_s_barrier(); asm volatile("" ::: "memory"); } while (0)
__device__ __forceinline__ void stT(LAS bf16_t* Dst, int x0, int y0, const f32x4& acc, int lane) {
  v2u w; w.x = pk2(acc[0], acc[1]); w.y = pk2(acc[2], acc[3]);
  *(LAS v2u*)(Dst + (x0 + (lane & 15)) * RP + y0 + (lane >> 4) * 4) = w;
}
struct R1In { v4u r, ld, k, v, a; f32x4 kk0, kk1, ka0, ka1, rk0, rk1; };
__device__ __forceinline__ R1In rwkv_r1_load(PREF p, int item, int tid) {
  const int ch = item >> 6, c = item & 63, b = ch >> 4, hd = ch & 15;
  const size_t off = ((size_t)(b * SEQ + c * 64 + (tid >> 3)) * DM + hd * 64 + (tid & 7) * 8);
  const bf16_t* s0 = (const bf16_t*)(p.ws + WS_S0);
  R1In in;
  in.r = *(const GAS v4u*)(s0 + 3 * (SLOT / 2) + off); in.ld = *(const GAS v4u*)(s0 + off); in.k = *(const GAS v4u*)(s0 + 4 * (SLOT / 2) + off);
  in.v = *(const GAS v4u*)(s0 + 5 * (SLOT / 2) + off); in.a = *(const GAS v4u*)(s0 + (SLOT / 2) + off);
  const int cc0 = hd * 64 + (tid & 7) * 8;
  in.kk0 = *(const GAS f32x4*)(p.k_k + cc0); in.kk1 = *(const GAS f32x4*)(p.k_k + cc0 + 4); in.ka0 = *(const GAS f32x4*)(p.k_a + cc0); in.ka1 = *(const GAS f32x4*)(p.k_a + cc0 + 4);
  in.rk0 = *(const GAS f32x4*)(p.r_k + cc0); in.rk1 = *(const GAS f32x4*)(p.r_k + cc0 + 4);
  return in;
}
__device__ __forceinline__ void un8(const v4u w, float (&o)[8]) {
  o[0] = __uint_as_float(w.x << 16); o[1] = __uint_as_float(w.x & 0xffff0000u); o[2] = __uint_as_float(w.y << 16); o[3] = __uint_as_float(w.y & 0xffff0000u);
  o[4] = __uint_as_float(w.z << 16); o[5] = __uint_as_float(w.z & 0xffff0000u); o[6] = __uint_as_float(w.w << 16); o[7] = __uint_as_float(w.w & 0xffff0000u);
}
__device__ __forceinline__ void rwkv_r1_item(PREF p, Frame& F, int item, const R1In& in) {
  const int tid = F.tid, lane = fresh_lane(), w = F.wave;
  const int ch = item >> 6, c = item & 63, b = ch >> 4, hd = ch & 15;
  const size_t tile0 = ((size_t)(b * SEQ + c * 64) * DM + hd * 64);
  unsigned char* ws = p.ws;
  bf16_t* SL[6];
#pragma unroll
  for (int s = 0; s < 6; ++s) SL[s] = (bf16_t*)(ws + WS_S0 + (size_t)s * SLOT) + tile0;
  const lbf BtT = (lbf)(F.lds + 0 * RB), KtT = (lbf)(F.lds + 1 * RB), AbT = (lbf)(F.lds + 2 * RB), RbT = (lbf)(F.lds + 3 * RB);
  const lbf Ab = (lbf)(F.lds + 4 * RB), Vc = (lbf)(F.lds + 5 * RB), Bh = (lbf)(F.lds + 6 * RB), Kh = (lbf)(F.lds + 7 * RB);
  const lbf Tk = (lbf)(F.lds + 8 * RB), WbT = (lbf)(F.lds + 9 * RB), WkT = (lbf)(F.lds + 10 * RB);
  const lbf X = BtT, XT = KtT, Pb = AbT;
  const lbf At = X, TNT = XT, U0 = Tk;
  LAS float* Lf = (LAS float*)(F.lds + 11 * RB);
  LAS float* SEG = Lf + 64 * 65;
  LAS float* GC = (LAS float*)(F.lds + 14 * RB);
#if defined(PROBE_PH) && PROBE_PH == 301
  const unsigned long long _sa0 = __builtin_amdgcn_s_memrealtime();
#endif
  const int t = tid >> 3, cg = tid & 7, k0 = cg * 8;
  float r_[8], ld_[8], kx[8], v_[8], a_[8];
  un8(in.r, r_); un8(in.ld, ld_); un8(in.k, kx); un8(in.v, v_); un8(in.a, a_);
  float kk[8], km[8], be[8];
  {
    float ss = 0.f, bo = 0.f;
#pragma unroll
    for (int i = 0; i < 8; ++i) { const float ckk = (i < 4) ? in.kk0[i & 3] : in.kk1[i & 3], cka = (i < 4) ? in.ka0[i & 3] : in.ka1[i & 3], crk = (i < 4) ? in.rk0[i & 3] : in.rk1[i & 3];
      kk[i] = kx[i] * ckk; ss += kk[i] * kk[i]; km[i] = kx[i] * (1.f + (a_[i] - 1.f) * cka); bo += r_[i] * km[i] * crk; }
    ss = sum8(ss); bo = sum8(bo);
    const float inv = 1.f / fmaxf(sqrtf(ss), 1e-12f);
#pragma unroll
    for (int i = 0; i < 8; ++i) { kk[i] *= inv; be[i] = kk[i] * a_[i]; }
    if (cg == 0) ((float*)(ws + WS_TMP))[(size_t)item * 64 + t] = bo;
  }
#pragma unroll
  for (int i = 0; i < 8; ++i) Lf[t * 65 + k0 + i] = ld_[i];
  R1_BAR();
  {
    const int k = tid & 63, sg = tid >> 6;
    float run = 0.f;
#pragma unroll
    for (int i = 0; i < 8; ++i) { run += Lf[(sg * 8 + i) * 65 + k]; Lf[(sg * 8 + i) * 65 + k] = run; }
    SEG[sg * 64 + k] = run;
    R1_BAR();
    float off = 0.f;
    for (int j = 0; j < sg; ++j) off += SEG[j * 64 + k];
#pragma unroll
    for (int i = 0; i < 8; ++i) Lf[(sg * 8 + i) * 65 + k] += off;
  }
  R1_BAR();
  {
    float ab[8], bt[8], kt[8], rb[8], bh[8], kh[8];
#pragma unroll
    for (int i = 0; i < 8; ++i) {
      const float Lt = Lf[t * 65 + k0 + i], Lp = (t > 0) ? Lf[(t - 1) * 65 + k0 + i] : 0.f, LC = Lf[63 * 65 + k0 + i];
      const float et = __expf(Lt), ei = __builtin_amdgcn_rcpf(et), eh = __expf(LC) * ei;
      if (t == 63) GC[k0 + i] = et;
      ab[i] = -kk[i] * __expf(Lp); bt[i] = be[i] * ei; kt[i] = km[i] * ei; rb[i] = r_[i] * et; bh[i] = be[i] * eh; kh[i] = km[i] * eh;
    }
    *(LAS v4u*)(BtT + t * RP + k0) = pk8(bt); *(LAS v4u*)(KtT + t * RP + k0) = pk8(kt); *(LAS v4u*)(AbT + t * RP + k0) = pk8(ab); *(LAS v4u*)(RbT + t * RP + k0) = pk8(rb);
    {
      float ra[8], rv[8], rb[8], rkh[8];
#pragma unroll
      for (int i = 0; i < 8; ++i) { ra[i] = ab[i]; rv[i] = v_[i]; rb[i] = bh[i]; rkh[i] = kh[i]; }
#pragma unroll
      for (int sh = 1; sh < 8; sh <<= 1) {
        const bool on = (cg & sh) != 0;
        float ta[8], tv[8], tb[8], tk[8];
#pragma unroll
        for (int i = 0; i < 8; ++i) { ta[i] = on ? ra[(i + sh) & 7] : ra[i]; tv[i] = on ? rv[(i + sh) & 7] : rv[i]; tb[i] = on ? rb[(i + sh) & 7] : rb[i]; tk[i] = on ? rkh[(i + sh) & 7] : rkh[i]; }
#pragma unroll
        for (int i = 0; i < 8; ++i) { ra[i] = ta[i]; rv[i] = tv[i]; rb[i] = tb[i]; rkh[i] = tk[i]; }
      }
#pragma unroll
      for (int i = 0; i < 8; ++i) { const int row = k0 + ((i + cg) & 7);
        Ab[row * RP + t] = (bf16_t)f2bf(ra[i]); Vc[row * RP + t] = (bf16_t)f2bf(rv[i]); Bh[row * RP + t] = (bf16_t)f2bf(rb[i]); Kh[row * RP + t] = (bf16_t)f2bf(rkh[i]); }
    }
  }
  R1_BAR();
#if defined(PROBE_PH) && PROBE_PH == 301
  F.pr_t1 += __builtin_amdgcn_s_memrealtime() - _sa0;
#endif
  const int ya = (w >> 1) * 16, xb0 = (w & 1) * 32;
  const int cr = lane & 15, q4 = (lane >> 4) * 4;
  const f32x4 Z4 = {0.f, 0.f, 0.f, 0.f};
  const lbf X1 = (lbf)(F.lds + 11 * RB), XT1 = (lbf)(F.lds + 12 * RB), Pb1 = (lbf)(F.lds + 13 * RB);
  f32x4 accP[2];
  {
    f32x4 tabn[2], tabs[2], taks[2], wbr[2], wkr[2];
#pragma unroll
    for (int j = 0; j < 2; ++j) { const int xb = xb0 + 16 * j;
      tabn[j] = mm16(Z4, BtT, ya, AbT, xb, lane);
      tabs[j] = mm16(Z4, AbT, ya, BtT, xb, lane);
      taks[j] = mm16(Z4, AbT, ya, KtT, xb, lane);
      wbr[j] = mm16(Z4, BtT, ya, RbT, xb, lane);
      wkr[j] = mm16(Z4, KtT, ya, RbT, xb, lane); }
#pragma unroll
    for (int j = 0; j < 2; ++j) { const int xb = xb0 + 16 * j;
      f32x4 xt, xr, pr, tk, wb, wk;
#pragma unroll
      for (int i = 0; i < 4; ++i) {
        { const int s = ya + q4 + i, tt = xb + cr; xt[i] = (s < tt) ? tabn[j][i] : 0.f; wb[i] = (s <= tt) ? wbr[j][i] : 0.f; wk[i] = (s <= tt) ? wkr[j][i] : 0.f; }
        { const int tt = ya + q4 + i, s = xb + cr; xr[i] = (s < tt) ? tabs[j][i] : 0.f; pr[i] = xr[i] + ((s == tt) ? 1.f : 0.f); tk[i] = (s < tt) ? taks[j][i] : 0.f; }
      }
      accP[j] = pr;
      stT(XT1, xb, ya, xt, lane); stT(WbT, xb, ya, wb, lane); stT(WkT, xb, ya, wk, lane);
      stT(X1, xb, ya, xr, lane); stT(Pb1, xb, ya, pr, lane); stT(Tk, xb, ya, tk, lane); }
  }
  R1_BAR();
#pragma unroll 1
  for (int st = 0; st < 5; ++st) {
    const lbf Xs = (st & 1) ? X : X1, XTs = (st & 1) ? XT : XT1, Pbs = (st & 1) ? Pb : Pb1;
    const lbf Xd = (st & 1) ? X1 : X, XTd = (st & 1) ? XT1 : XT, Pbd = (st & 1) ? Pb1 : Pb;
    f32x4 xr[2], xt[2];
#pragma unroll
    for (int j = 0; j < 2; ++j) { const int xb = xb0 + 16 * j;
      xr[j] = mm16(Z4, XTs, ya, Xs, xb, lane);
      xt[j] = mm16(Z4, Xs, ya, XTs, xb, lane);
      if (st > 0) accP[j] = mm16(accP[j], XTs, ya, Pbs, xb, lane); }
#pragma unroll
    for (int j = 0; j < 2; ++j) { const int xb = xb0 + 16 * j; stT(Xd, xb, ya, xr[j], lane); stT(XTd, xb, ya, xt[j], lane); stT(Pbd, xb, ya, accP[j], lane); }
    R1_BAR();
  }
  const lbf NT = Pb1;
  {
    f32x4 nt[2];
#pragma unroll
    for (int j = 0; j < 2; ++j) { const int xb = xb0 + 16 * j; nt[j] = mm16(Z4, Pb, ya, XT, xb, lane);
#pragma unroll
      for (int i = 0; i < 4; ++i) nt[j][i] += bf2f(Pb[(ya + q4 + i) * RP + xb + cr]); }
#pragma unroll
    for (int j = 0; j < 2; ++j) stT(NT, xb0 + 16 * j, ya, nt[j], lane);
    R1_BAR();
  }
  {
    f32x4 at[2], tn[2];
#pragma unroll
    for (int j = 0; j < 2; ++j) { const int xb = xb0 + 16 * j; at[j] = mm16(Z4, NT, ya, Ab, xb, lane); tn[j] = mm16(Z4, Tk, ya, NT, xb, lane); }
#pragma unroll
    for (int j = 0; j < 2; ++j) { const int xb = xb0 + 16 * j; stT(At, xb, ya, at[j], lane); stT(TNT, xb, ya, tn[j], lane); }
  }
  R1_BAR();
  const lbf O_RT = (lbf)(F.lds + 11 * RB), O_PM = (lbf)(F.lds + 12 * RB), O_Y0 = (lbf)(F.lds + 13 * RB), O_Q = (lbf)(F.lds + 3 * RB)  ;
  {
    f32x4 u0[2], rt[2], pm[2];
#pragma unroll
    for (int j = 0; j < 2; ++j) { const int xb = xb0 + 16 * j;
      u0[j] = mm16(Z4, TNT, ya, Vc, xb, lane);
      rt[j] = mm16(Z4, At, ya, WbT, xb, lane);
      pm[j] = mm16(Z4, At, ya, Bh, xb, lane);
      const v2u rbw = *(const LAS v2u*)(RbT + (xb + cr) * RP + ya + q4);
      rt[j][0] += __uint_as_float(rbw.x << 16); rt[j][1] += __uint_as_float(rbw.x & 0xffff0000u); rt[j][2] += __uint_as_float(rbw.y << 16); rt[j][3] += __uint_as_float(rbw.y & 0xffff0000u);
#pragma unroll
      for (int i = 0; i < 4; ++i) if (ya + q4 + i == xb + cr) pm[j][i] += GC[xb + cr]; }
#pragma unroll
    for (int j = 0; j < 2; ++j) { const int xb = xb0 + 16 * j; stT(U0, xb, ya, u0[j], lane); stT(O_RT, xb, ya, rt[j], lane); stT(O_PM, xb, ya, pm[j], lane); }
  }
  R1_BAR();
  {
    f32x4 y0[2], qq[2];
#pragma unroll
    for (int j = 0; j < 2; ++j) { const int xb = xb0 + 16 * j;
      y0[j] = mm16(mm16(Z4, U0, ya, WbT, xb, lane), Vc, ya, WkT, xb, lane);
      qq[j] = mm16(mm16(Z4, Bh, ya, U0, xb, lane), Kh, ya, Vc, xb, lane); }
#pragma unroll
    for (int j = 0; j < 2; ++j) { const int xb = xb0 + 16 * j; stT(O_Y0, xb, ya, y0[j], lane); stT(O_Q, xb, ya, qq[j], lane); }
  }
  R1_BAR();
  {
    const int row = tid >> 3, pc = (tid & 7) * 8;
    *(GAS v4u*)(SL[3] + (size_t)row * DM + pc) = *(const LAS v4u*)(O_RT + row * RP + pc);
    *(GAS v4u*)(SL[0] + (size_t)row * DM + pc) = *(const LAS v4u*)(O_PM + row * RP + pc);
    *(GAS v4u*)(SL[4] + (size_t)row * DM + pc) = *(const LAS v4u*)(O_Y0 + row * RP + pc);
    *(GAS v4u*)(SL[1] + (size_t)row * DM + pc) = *(const LAS v4u*)(O_Q + row * RP + pc);
  }
  R1_BAR();
}

__device__ __forceinline__ void phase_rwkv_r1(PREF p, Frame& F) {
  int item = F.vcu;
  if (item >= 4096) return;
  R1In nxt = rwkv_r1_load(p, item, F.tid);
  for (; item < 4096; item += F.G) {
    const R1In cur = nxt;
    if (item + F.G < 4096) nxt = rwkv_r1_load(p, item + F.G, F.tid);
    rwkv_r1_item(p, F, item, cur);
  }
}

__device__ __forceinline__ void phase_rwkv_r2(PREF p, Frame& F) {
  if (F.wave != 0) return;
  const int lane = fresh_lane();
  const lbf Sh = (lbf)(F.lds), Sl = (lbf)(F.lds + 16 * RP * 2);
  const int cr = lane & 15, g = lane >> 4;
  for (int task = F.vcu; task < 256; task += F.G) {
    const int ch = task >> 2, jb = task & 3, b = ch >> 4, hd = ch & 15;
    const bf16_t* PM = (const bf16_t*)(p.ws + WS_S0) + ((size_t)(b * SEQ) * DM + hd * 64);
    bf16_t* QS = (bf16_t*)(p.ws + WS_S0 + SLOT) + ((size_t)(b * SEQ) * DM + hd * 64);
    for (int i = lane; i < 16 * RP; i += 64) { Sh[i] = 0; Sl[i] = 0; }
    const bf16_t* pmp = PM + (size_t)cr * DM + g * 8;
    bf16_t* qsp = QS + (size_t)(16 * jb + cr) * DM + g * 4;
    bf16x8 pa[4][4][2]; v2u qv[4][4];
#pragma unroll
    for (int d = 0; d < 4; ++d)
#pragma unroll
      for (int ct = 0; ct < 4; ++ct) { pa[d][ct][0] = *(const GAS bf16x8*)(pmp + (size_t)(d * 64 + 16 * ct) * DM); pa[d][ct][1] = *(const GAS bf16x8*)(pmp + (size_t)(d * 64 + 16 * ct) * DM + 32);
        qv[d][ct] = *(const GAS v2u*)(qsp + (size_t)d * 64 * DM + 16 * ct); }
    asm volatile("s_waitcnt lgkmcnt(0)" ::: "memory");
#pragma unroll 1
    for (int c4 = 0; c4 < 64; c4 += 4) {
#pragma unroll
      for (int d = 0; d < 4; ++d) {
        const int c = c4 + d;
        const bf16x8 bh0 = *(const LAS bf16x8*)(Sh + cr * RP + g * 8), bh1 = *(const LAS bf16x8*)(Sh + cr * RP + 32 + g * 8);
        const bf16x8 bl0 = *(const LAS bf16x8*)(Sl + cr * RP + g * 8), bl1 = *(const LAS bf16x8*)(Sl + cr * RP + 32 + g * 8);
        f32x4 acc[4];
#pragma unroll
        for (int ct = 0; ct < 4; ++ct) {
          acc[ct] = (f32x4){__uint_as_float(qv[d][ct].x << 16), __uint_as_float(qv[d][ct].x & 0xffff0000u), __uint_as_float(qv[d][ct].y << 16), __uint_as_float(qv[d][ct].y & 0xffff0000u)};
          acc[ct] = __builtin_amdgcn_mfma_f32_16x16x32_bf16(pa[d][ct][0], bh0, acc[ct], 0, 0, 0);
          acc[ct] = __builtin_amdgcn_mfma_f32_16x16x32_bf16(pa[d][ct][1], bh1, acc[ct], 0, 0, 0);
          acc[ct] = __builtin_amdgcn_mfma_f32_16x16x32_bf16(pa[d][ct][0], bl0, acc[ct], 0, 0, 0);
          acc[ct] = __builtin_amdgcn_mfma_f32_16x16x32_bf16(pa[d][ct][1], bl1, acc[ct], 0, 0, 0);
        }
        if (c + 4 < 64) {
#pragma unroll
          for (int ct = 0; ct < 4; ++ct) { pa[d][ct][0] = *(const GAS bf16x8*)(pmp + (size_t)((c + 4) * 64 + 16 * ct) * DM); pa[d][ct][1] = *(const GAS bf16x8*)(pmp + (size_t)((c + 4) * 64 + 16 * ct) * DM + 32);
            qv[d][ct] = *(const GAS v2u*)(qsp + (size_t)(c + 4) * 64 * DM + 16 * ct); }
        }
#pragma unroll
        for (int ct = 0; ct < 4; ++ct) {
          v2u hi; hi.x = pk2(acc[ct][0], acc[ct][1]); hi.y = pk2(acc[ct][2], acc[ct][3]);
          const float l0 = acc[ct][0] - __uint_as_float(hi.x << 16), l1 = acc[ct][1] - __uint_as_float(hi.x & 0xffff0000u), l2 = acc[ct][2] - __uint_as_float(hi.y << 16), l3 = acc[ct][3] - __uint_as_float(hi.y & 0xffff0000u);
          v2u lo; lo.x = pk2(l0, l1); lo.y = pk2(l2, l3);
          *(LAS v2u*)(Sh + cr * RP + 16 * ct + g * 4) = hi; *(LAS v2u*)(Sl + cr * RP + 16 * ct + g * 4) = lo;
          *(GAS v2u*)(qsp + (size_t)c * 64 * DM + 16 * ct) = hi;
        }
        asm volatile("s_waitcnt lgkmcnt(0)" ::: "memory");
      }
    }
  }
}

__device__ __forceinline__ void phase_rwkv_r3(PREF p, Frame& F) {
  const int lane = fresh_lane(), w = F.wave;
  const int cr = lane & 15, q4 = (lane >> 4) * 4, q = lane >> 4;
  const int half = w >> 2, tb = w & 3;
  LAS bf16_t* stg = (LAS bf16_t*)(F.lds) + w * 16 * RP;
  for (int it2 = F.vcu; it2 < 2048; it2 += F.G) {
    const int item = it2 * 2 + half;
    const int ch = item >> 6, c = item & 63, b = ch >> 4, hd = ch & 15;
    const size_t tile0 = ((size_t)(b * SEQ + c * 64) * DM + hd * 64);
    bf16_t* RT = (bf16_t*)(p.ws + WS_S0 + 3 * SLOT) + tile0;
    const bf16_t* Y0 = (const bf16_t*)(p.ws + WS_S0 + 4 * SLOT) + tile0;
    const bf16_t* VV = (const bf16_t*)(p.ws + WS_S0 + 5 * SLOT) + tile0;
    const bf16_t* GG = (const bf16_t*)(p.ws + WS_S0 + 2 * SLOT) + tile0;
    const bf16_t* SC = (const bf16_t*)(p.ws + WS_S0 + SLOT) + tile0 - (size_t)64 * DM;
    const float* BO = (const float*)(p.ws + WS_TMP) + (size_t)item * 64;
    f32x4 y[4];
#pragma unroll
    for (int j = 0; j < 4; ++j) y[j] = (f32x4){0.f, 0.f, 0.f, 0.f};
    if (c > 0) {
      const bf16_t* ap = RT + (size_t)(16 * tb + cr) * DM + q * 8;
      const bf16x8 a0 = *(const GAS bf16x8*)ap, a1 = *(const GAS bf16x8*)(ap + 32);
#pragma unroll
      for (int j = 0; j < 4; ++j) {
        const bf16_t* bp = SC + (size_t)(16 * j + cr) * DM + q * 8;
        const bf16x8 b0 = *(const GAS bf16x8*)bp, b1 = *(const GAS bf16x8*)(bp + 32);
        y[j] = __builtin_amdgcn_mfma_f32_16x16x32_bf16(a0, b0, y[j], 0, 0, 0);
        y[j] = __builtin_amdgcn_mfma_f32_16x16x32_bf16(a1, b1, y[j], 0, 0, 0);
      }
    }
    float mu[4], rs[4];
#pragma unroll
    for (int i = 0; i < 4; ++i) {
      float s = 0.f;
#pragma unroll
      for (int j = 0; j < 4; ++j) { y[j][i] += bf2f(Y0[(size_t)(16 * tb + q4 + i) * DM + 16 * j + cr]); s += y[j][i]; }
      s += __shfl_xor(s, 1, 64); s += __shfl_xor(s, 2, 64); s += __shfl_xor(s, 4, 64); s += __shfl_xor(s, 8, 64);
      mu[i] = s * (1.f / 64.f);
      float qd = 0.f;
#pragma unroll
      for (int j = 0; j < 4; ++j) { const float d = y[j][i] - mu[i]; qd += d * d; }
      qd += __shfl_xor(qd, 1, 64); qd += __shfl_xor(qd, 2, 64); qd += __shfl_xor(qd, 4, 64); qd += __shfl_xor(qd, 8, 64);
      rs[i] = rsqrtf(qd * (1.f / 64.f) + 64e-5f);
    }
#pragma unroll
    for (int j = 0; j < 4; ++j) {
      const int cc = hd * 64 + 16 * j + cr;
      const float lw = p.ln_w[cc], lb = p.ln_b[cc];
#pragma unroll
      for (int i = 0; i < 4; ++i) {
        const int tt = 16 * tb + q4 + i;
        const float vv = bf2f(VV[(size_t)tt * DM + 16 * j + cr]), gg = bf2f(GG[(size_t)tt * DM + 16 * j + cr]);
        const float z = ((y[j][i] - mu[i]) * rs[i] * lw + lb + BO[tt] * vv) * gg;
        stg[(q4 + i) * RP + 16 * j + cr] = (bf16_t)f2bf(z);
      }
    }
    LDS_WAIT();
#pragma unroll
    for (int i = 0; i < 2; ++i) { const int row = (lane >> 3) + 8 * i, pc = (lane & 7) * 8;
      *(GAS v4u*)(RT + (size_t)(16 * tb + row) * DM + pc) = *(const LAS v4u*)(stg + row * RP + pc); }
    LDS_WAIT();
  }
}


typedef short v4i16_t __attribute__((ext_vector_type(4)));
__device__ __forceinline__ v4i16_t tr16(const LAS bf16_t* p) { return __builtin_amdgcn_ds_read_tr16_b64_v4i16((LAS v4i16_t*)p); }

template <int KS>
__device__ __forceinline__ void qk_tile(f32x4 (&st)[4][2], const LAS bf16_t* Kt, int kc0, const bf16x8 (&qf)[2][KS], int lane) {
  const int r = lane & 15, g = lane >> 4;
#pragma unroll
  for (int kt = 0; kt < 4; ++kt)
#pragma unroll
    for (int ks = 0; ks < KS; ++ks) {
      const bf16x8 a = *(const LAS bf16x8*)(Kt + (kt * 16 + r) * RP + kc0 + ks * 32 + g * 8);
#pragma unroll
      for (int qt = 0; qt < 2; ++qt) st[kt][qt] = __builtin_amdgcn_mfma_f32_16x16x32_bf16(a, qf[qt][ks], st[kt][qt], 0, 0, 0);
    }
}
__device__ __forceinline__ void pack_p(bf16x8 (&pb)[2][2], const f32x4 (&pr)[4][2]) {
#pragma unroll
  for (int kb = 0; kb < 2; ++kb)
#pragma unroll
    for (int qt = 0; qt < 2; ++qt) {
      const v4u w = {pk2(pr[2 * kb][qt][0], pr[2 * kb][qt][1]), pk2(pr[2 * kb][qt][2], pr[2 * kb][qt][3]), pk2(pr[2 * kb + 1][qt][0], pr[2 * kb + 1][qt][1]), pk2(pr[2 * kb + 1][qt][2], pr[2 * kb + 1][qt][3])};
      pb[kb][qt] = __builtin_bit_cast(bf16x8, w);
    }
}
__device__ __forceinline__ void pv_apply(f32x4 (&o)[4][2], f32x4 (&osum)[2], const bf16x8 (&pb)[2][2], const LAS bf16_t* Vt, int lane) {
  const int g = lane >> 4, qq = (lane & 15) >> 2, pp = lane & 3;
  const bf16x8 ones = {0x3F80, 0x3F80, 0x3F80, 0x3F80, 0x3F80, 0x3F80, 0x3F80, 0x3F80};
#pragma unroll
  for (int kb = 0; kb < 2; ++kb)
#pragma unroll
    for (int qt = 0; qt < 2; ++qt) osum[qt] = __builtin_amdgcn_mfma_f32_16x16x32_bf16(ones, pb[kb][qt], osum[qt], 0, 0, 0);
#pragma unroll
  for (int dt = 0; dt < 4; ++dt)
#pragma unroll
    for (int kb = 0; kb < 2; ++kb) {
      const v4i16_t lo = tr16(Vt + (32 * kb + 4 * g + qq) * RP + dt * 16 + 4 * pp);
      const v4i16_t hi = tr16(Vt + (32 * kb + 16 + 4 * g + qq) * RP + dt * 16 + 4 * pp);
      const bf16x8 a = {lo[0], lo[1], lo[2], lo[3], hi[0], hi[1], hi[2], hi[3]};
#pragma unroll
      for (int qt = 0; qt < 2; ++qt) o[dt][qt] = __builtin_amdgcn_mfma_f32_16x16x32_bf16(a, pb[kb][qt], o[dt][qt], 0, 0, 0);
    }
}
__device__ __forceinline__ void pv_apply2(f32x4 (&o1)[4][2], f32x4 (&o2)[4][2], f32x4 (&os1)[2], f32x4 (&os2)[2], const bf16x8 (&pb1)[2][2], const bf16x8 (&pb2)[2][2], const LAS bf16_t* Vt, int lane) {
  const int g = lane >> 4, qq = (lane & 15) >> 2, pp = lane & 3;
  const bf16x8 ones = {0x3F80, 0x3F80, 0x3F80, 0x3F80, 0x3F80, 0x3F80, 0x3F80, 0x3F80};
#pragma unroll
  for (int kb = 0; kb < 2; ++kb)
#pragma unroll
    for (int qt = 0; qt < 2; ++qt) { os1[qt] = __builtin_amdgcn_mfma_f32_16x16x32_bf16(ones, pb1[kb][qt], os1[qt], 0, 0, 0); os2[qt] = __builtin_amdgcn_mfma_f32_16x16x32_bf16(ones, pb2[kb][qt], os2[qt], 0, 0, 0); }
#pragma unroll
  for (int dt = 0; dt < 4; ++dt)
#pragma unroll
    for (int kb = 0; kb < 2; ++kb) {
      const v4i16_t lo = tr16(Vt + (32 * kb + 4 * g + qq) * RP + dt * 16 + 4 * pp);
      const v4i16_t hi = tr16(Vt + (32 * kb + 16 + 4 * g + qq) * RP + dt * 16 + 4 * pp);
      const bf16x8 a = {lo[0], lo[1], lo[2], lo[3], hi[0], hi[1], hi[2], hi[3]};
#pragma unroll
      for (int qt = 0; qt < 2; ++qt) { o1[dt][qt] = __builtin_amdgcn_mfma_f32_16x16x32_bf16(a, pb1[kb][qt], o1[dt][qt], 0, 0, 0); o2[dt][qt] = __builtin_amdgcn_mfma_f32_16x16x32_bf16(a, pb2[kb][qt], o2[dt][qt], 0, 0, 0); }
    }
}
__device__ __forceinline__ void fill42(f32x4 (&a)[4][2], const f32x4 v) {
#pragma unroll
  for (int i = 0; i < 4; ++i)
#pragma unroll
    for (int j = 0; j < 2; ++j) a[i][j] = v;
}
__device__ __forceinline__ void exp42(f32x4 (&a)[4][2]) {
#pragma unroll
  for (int i = 0; i < 4; ++i)
#pragma unroll
    for (int j = 0; j < 2; ++j)
#pragma unroll
      for (int e = 0; e < 4; ++e) a[i][j][e] = __builtin_amdgcn_exp2f(a[i][j][e]);
}
#if defined(PROBE_PH) && PROBE_PH == 300
#define AT_BAR() do { const unsigned long long _b0 = __builtin_amdgcn_s_memrealtime(); asm volatile("s_waitcnt lgkmcnt(0)" ::: "memory"); __builtin_amdgcn_s_barrier(); asm volatile("" ::: "memory"); F.pr_t1 += __builtin_amdgcn_s_memrealtime() - _b0; } while (0)
#else
#define AT_BAR() do { asm volatile("s_waitcnt lgkmcnt(0)" ::: "memory"); __builtin_amdgcn_s_barrier(); asm volatile("" ::: "memory"); } while (0)
#endif
__device__ __forceinline__ void zero42(f32x4 (&a)[4][2]) {
#pragma unroll
  for (int i = 0; i < 4; ++i)
#pragma unroll
    for (int j = 0; j < 2; ++j) a[i][j] = (f32x4){0.f, 0.f, 0.f, 0.f};
}

__device__ __forceinline__ void phase_compress(PREF p, Frame& F) {
  const int lane = fresh_lane(), w = F.wave, tid = F.tid;
  const int r = lane & 15, g4 = lane >> 4;
  const bf16_t* H = (const bf16_t*)(p.ws + WS_H);
  const bf16_t* W1T = (const bf16_t*)(p.ws + WS_CW1);
  LAS float* part = (LAS float*)F.lds;
  LAS float* hid = part + 8 * 16 * 64;
  LAS float* outv = hid + 16 * 64;
  for (int task = F.vcu; task < 256; task += F.G) {
    const int kv = task >> 7, rb = task & 127;
    int row = rb * 16 + r; if (row > 2039) row = 2039;
    const int gg = row & 1, cc = (row >> 1) % NCMP, bb = (row >> 1) / NCMP;
    const int colbase = OFF_NKV + ((0 * 2 + kv) * 2 + gg) * 64;
    f32x4 acc[4];
#pragma unroll
    for (int nt = 0; nt < 4; ++nt) acc[nt] = (f32x4){0.f, 0.f, 0.f, 0.f};
#pragma unroll 1
    for (int ks = 0; ks < 8; ++ks) {
      const int k = w * 256 + ks * 32 + g4 * 8, l = k >> 6, d0 = k & 63;
      float hv[8]; ld8bf(H + (size_t)(bb * SEQ + 16 * cc + l) * HC + colbase + d0, hv);
      const float* pe = p.cmp_pe + (kv * 32 + l) * 64 + d0;
#pragma unroll
      for (int i = 0; i < 8; ++i) hv[i] += pe[i];
      const bf16x8 a = __builtin_bit_cast(bf16x8, pk8(hv));
#pragma unroll
      for (int nt = 0; nt < 4; ++nt) {
        const bf16x8 bfr = *(const GAS bf16x8*)(W1T + ((size_t)kv * 64 + nt * 16 + r) * 2048 + k);
        acc[nt] = __builtin_amdgcn_mfma_f32_16x16x32_bf16(a, bfr, acc[nt], 0, 0, 0);
      }
    }
#pragma unroll
    for (int nt = 0; nt < 4; ++nt)
#pragma unroll
      for (int i = 0; i < 4; ++i) part[(w * 16 + g4 * 4 + i) * 64 + nt * 16 + r] = acc[nt][i];
    __syncthreads();
    for (int e = tid; e < 1024; e += NWAVES * 64) { float s = 0.f;
#pragma unroll
      for (int ww = 0; ww < 8; ++ww) s += part[ww * 1024 + e];
      hid[e] = gelu_tanh(s); }
    __syncthreads();
    const float* w2 = p.cmp_w2 + kv * 4096;
    for (int e = tid; e < 1024; e += NWAVES * 64) { const int rr = e >> 6, n = e & 63; float s = 0.f;
      for (int j = 0; j < 64; ++j) s += hid[rr * 64 + j] * w2[j * 64 + n];
      outv[e] = s; }
    __syncthreads();
    for (int e = tid; e < 1024; e += NWAVES * 64) { const int rr = e >> 6, n = e & 63;
      const int orow = rb * 16 + rr;
      if (orow < 2040) {
        float v = outv[e];
        if (kv == 0) { float ss = 0.f; for (int j = 0; j < 64; ++j) ss += outv[rr * 64 + j] * outv[rr * 64 + j]; v = v * rsqrtf(ss * (1.f / 64.f) + 1e-6f) * p.nk_norm[n]; }
        const int g2 = orow & 1, c2 = (orow >> 1) % NCMP, b2 = (orow >> 1) / NCMP;
        ((bf16_t*)(p.ws + (kv ? WS_VCMPB : WS_KCMPB)))[((size_t)(b2 * 2 + g2) * 256 + c2) * 64 + n] = (bf16_t)f2bf(v);
      }
    }
    if (task < 16 && tid < 64) { const int kk2 = task >> 3, bg = task & 7; ((bf16_t*)(p.ws + (kk2 ? WS_VCMPB : WS_KCMPB)))[((size_t)bg * 256 + 255) * 64 + tid] = 0; }
    __syncthreads();
  }
}

__device__ __forceinline__ v4u tile_ld(const bf16_t* base, size_t pitch, int tid) { return *(const GAS v4u*)(base + (size_t)(tid >> 3) * pitch + (tid & 7) * 8); }
__device__ __forceinline__ void tile_st(LAS bf16_t* dst, v4u v, int tid) { *(LAS v4u*)(dst + (tid >> 3) * RP + (tid & 7) * 8) = v; }

template <int KS, int MODE>
__device__ __forceinline__ void attn_tile(f32x4 (&o)[4][2], f32x4 (&os)[2], const bf16x8 (&qf)[2][KS], const LAS bf16_t* KBt, int kc0, const LAS bf16_t* VBt, const f32x4 nbv,
                                          const bool (&on)[2], int qq0, int koff, int lane) {
  const int r = lane & 15, g = lane >> 4;
  f32x4 st[4][2]; bf16x8 pb[2][2];
  fill42(st, nbv); qk_tile<KS>(st, KBt, kc0, qf, lane); exp42(st);
  if (MODE != 0) {
#pragma unroll
    for (int kt = 0; kt < 4; ++kt)
#pragma unroll
      for (int qt = 0; qt < 2; ++qt)
#pragma unroll
        for (int i = 0; i < 4; ++i) { const int kk = kt * 16 + g * 4 + i, qq = qq0 + qt * 16 + r;
          bool keep = true;
          if (MODE & 1) keep = keep && on[qt];
          if (MODE & 2) keep = keep && (kk + koff <= qq);
          if (MODE & 4) keep = keep && (kk > qq);
          if (!keep) st[kt][qt][i] = 0.f; }
  }
  pack_p(pb, st);
  pv_apply(o, os, pb, VBt, lane);
}
__device__ __forceinline__ void phase_diffattn(PREF p, Frame& F) {
  const int lane = fresh_lane(), w = F.wave, tid = F.tid;
  const int r = lane & 15, g = lane >> 4;
  const bf16_t* H = (const bf16_t*)(p.ws + WS_H);
  bf16_t* CAT = (bf16_t*)(p.ws + WS_CAT);
  float mq = 0.f, mk = 0.f, l0 = 0.f, l1 = 0.f;
  for (int i = 0; i < 32; i++) { mq = fmaxf(mq, fabsf(p.dq_norm[i])); mk = fmaxf(mk, fabsf(p.dk_norm[i])); l0 += p.dlam[i] * p.dlam[32 + i]; l1 += p.dlam[64 + i] * p.dlam[96 + i]; }
  const float c2 = 0.17677669529663687f * 1.4426950408889634f;
  const float nb = -(32.f * mq * mk) * c2;
  const f32x4 nbv = {nb, nb, nb, nb};
  const float lam = __expf(l0) - __expf(l1) + 0.2f;
  const bool on[2] = {true, true};
  for (int pr = F.vcu; pr < 256; pr += F.G) {
    const int bh = pr >> 3, sp = pr & 7, b = bh >> 3, hd = bh & 7;
#pragma unroll 1
    for (int ui = 0; ui < 2; ++ui) {
      const int qb = ui ? 15 - sp : sp;
      const int NT = 4 * (qb + 1);
      const bf16_t* Kg = H + (size_t)(b * SEQ) * HC + OFF_DK + hd * 64;
      const bf16_t* Vg = H + (size_t)(b * SEQ) * HC + OFF_DV + hd * 64;
      f32x4 o1[4][2];
#pragma unroll 1
      for (int mp = 0; mp < 2; ++mp) {
        bf16x8 qf[2][1];
#pragma unroll
        for (int qt = 0; qt < 2; ++qt) qf[qt][0] = *(const GAS bf16x8*)(H + (size_t)(b * SEQ + qb * 256 + w * 32 + qt * 16 + r) * HC + OFF_DQ + hd * 64 + mp * 32 + g * 8);
        f32x4 o[4][2]; zero42(o);
        f32x4 os[2] = {{0.f, 0.f, 0.f, 0.f}, {0.f, 0.f, 0.f, 0.f}};
        v4u krA = tile_ld(Kg, HC, tid), vrA = tile_ld(Vg, HC, tid);
        v4u krB = tile_ld(Kg + (size_t)64 * HC, HC, tid), vrB = tile_ld(Vg + (size_t)64 * HC, HC, tid);
#pragma unroll 1
        for (int t = 0; t < NT; t += 2) {
#pragma unroll
          for (int hf = 0; hf < 2; ++hf) {
            const int tt = t + hf;
            const lbf KBt = (lbf)(F.lds + hf * 2 * RB), VBt = KBt + 64 * RP;
            tile_st(KBt, hf ? krB : krA, tid); tile_st(VBt, hf ? vrB : vrA, tid);
            AT_BAR();
            if (tt + 2 < NT) { const v4u k2 = tile_ld(Kg + (size_t)(tt + 2) * 64 * HC, HC, tid), v2 = tile_ld(Vg + (size_t)(tt + 2) * 64 * HC, HC, tid);
              if (hf) { krB = k2; vrB = v2; } else { krA = k2; vrA = v2; } }
            const int koff = tt * 64 - (qb * 256 + w * 32);
            if (tt >= NT - 4) attn_tile<1, 2>(o, os, qf, KBt, mp * 32, VBt, nbv, on, 0, koff, lane);
            else attn_tile<1, 0>(o, os, qf, KBt, mp * 32, VBt, nbv, on, 0, koff, lane);
          }
        }
        if (mp == 0) {
#pragma unroll
          for (int qt = 0; qt < 2; ++qt) { const float i1 = 1.f / os[qt][0];
#pragma unroll
            for (int dt = 0; dt < 4; ++dt) o1[dt][qt] = o[dt][qt] * i1; }
        } else {
#pragma unroll
          for (int qt = 0; qt < 2; ++qt) {
            const float i2 = lam / os[qt][0];
            float ss = 0.f;
#pragma unroll
            for (int dt = 0; dt < 4; ++dt)
#pragma unroll
              for (int i = 0; i < 4; ++i) { const float v = o1[dt][qt][i] - o[dt][qt][i] * i2; o1[dt][qt][i] = v; ss += v * v; }
            ss += __shfl_xor(ss, 16, 64); ss += __shfl_xor(ss, 32, 64);
            const float rr = rsqrtf(ss * (1.f / 64.f) + 1e-6f) * 0.8f;
            bf16_t* op = CAT + (size_t)(b * SEQ + qb * 256 + w * 32 + qt * 16 + r) * DM + hd * 64;
#pragma unroll
            for (int dt = 0; dt < 4; ++dt) { const int d0 = dt * 16 + g * 4; const f32x4 sg = *(const f32x4*)(p.dsubln + d0);
              v2u wv; wv.x = pk2(o1[dt][qt][0] * rr * sg[0], o1[dt][qt][1] * rr * sg[1]); wv.y = pk2(o1[dt][qt][2] * rr * sg[2], o1[dt][qt][3] * rr * sg[3]);
              *(GAS v2u*)(op + d0) = wv; }
          }
        }
        AT_BAR();
      }
    }
  }
}

__device__ __forceinline__ void nsa_finish(f32x4 (&comb)[4][2], const f32x4 (&o)[4][2], const f32x4 (&os)[2], const float (&gate)[2], bool normalised) {
#pragma unroll
  for (int qt = 0; qt < 2; ++qt) {
    const float f = normalised ? gate[qt] : gate[qt] / os[qt][0];
#pragma unroll
    for (int dt = 0; dt < 4; ++dt) comb[dt][qt] += o[dt][qt] * f;
  }
}
__device__ __forceinline__ void phase_nsa(PREF p, Frame& F) {
  const int lane = fresh_lane(), w = F.wave, tid = F.tid;
  const int r = lane & 15, g = lane >> 4;
  const bf16_t* H = (const bf16_t*)(p.ws + WS_H);
  const float* GATES = (const float*)(p.ws + WS_GATES);
  bf16_t* CAT = (bf16_t*)(p.ws + WS_CAT);
  float mq = 0.f, mk0 = 0.f, mk1 = 0.f, mk2 = 0.f;
  for (int i = 0; i < 64; i++) { mq = fmaxf(mq, fabsf(p.nq_norm[i])); mk0 = fmaxf(mk0, fabsf(p.nk_norm[i])); mk1 = fmaxf(mk1, fabsf(p.nk_norm[64 + i])); mk2 = fmaxf(mk2, fabsf(p.nk_norm[128 + i])); }
  const float c2 = 0.125f * 1.4426950408889634f;
  const float nb0 = -(64.f * mq * mk0) * c2, nb1 = -(64.f * mq * mk1) * c2, nb2 = -(64.f * mq * mk2) * c2;
  LAS float* IMP = (LAS float*)(F.lds + 12 * RB);
  LAS unsigned char* SELB = (LAS unsigned char*)(F.lds + 12 * RB + 64 * 65 * 4);
  const int hj = w >> 1, th = w & 1;
  for (int pr = F.vcu; pr < 256; pr += F.G) {
    const int bg = pr >> 5, sp = pr & 31, b = bg >> 1, gq = bg & 1;
#pragma unroll 1
    for (int ui = 0; ui < 2; ++ui) {
      const int blk = ui ? 63 - sp : sp;
      const int hh = gq * 4 + hj;
      const int tokw = b * SEQ + blk * 64 + th * 32;
      bf16x8 qf[2][2];
      float gate0[2], gate1[2], gate2[2];
#pragma unroll
      for (int qt = 0; qt < 2; ++qt) { const bf16_t* qp = H + (size_t)(tokw + qt * 16 + r) * HC + OFF_NQ + hh * 64 + g * 8;
        qf[qt][0] = *(const GAS bf16x8*)qp; qf[qt][1] = *(const GAS bf16x8*)(qp + 32);
        const float* gp = GATES + (size_t)(tokw + qt * 16 + r) * 24 + hh * 3; gate0[qt] = gp[0]; gate1[qt] = gp[1]; gate2[qt] = gp[2]; }
      f32x4 comb[4][2]; zero42(comb);
      const int nct = (4 * blk + 3 + 63) >> 6;
      {
        const bf16_t* KC = (const bf16_t*)(p.ws + WS_KCMPB) + (size_t)(b * 2 + gq) * 256 * 64;
        const bf16_t* VC = (const bf16_t*)(p.ws + WS_VCMPB) + (size_t)(b * 2 + gq) * 256 * 64;
        for (int t4 = 0; t4 < nct; ++t4) { tile_st((lbf)(F.lds + t4 * RB), tile_ld(KC + t4 * 4096, 64, tid), tid); tile_st((lbf)(F.lds + (4 + t4) * RB), tile_ld(VC + t4 * 4096, 64, tid), tid); }
        for (int e = tid; e < 64 * 65; e += NWAVES * 64) IMP[e] = 0.f;
        AT_BAR();
        const f32x4 nbv0 = {nb0, nb0, nb0, nb0};
        int cmax[2];
#pragma unroll
        for (int qt = 0; qt < 2; ++qt) { const int pos = blk * 64 + th * 32 + qt * 16 + r; cmax[qt] = (pos >= 31) ? ((pos - 31) >> 4) : -1; }
        float lsum[2] = {0.f, 0.f};
        for (int t4 = 0; t4 < nct; ++t4) {
          f32x4 st[4][2]; fill42(st, nbv0);
          qk_tile<2>(st, (lbf)(F.lds + t4 * RB), 0, qf, lane); exp42(st);
#pragma unroll
          for (int kt = 0; kt < 4; ++kt)
#pragma unroll
            for (int qt = 0; qt < 2; ++qt)
#pragma unroll
              for (int i = 0; i < 4; ++i) { const int c = t4 * 64 + kt * 16 + g * 4 + i; if (c <= cmax[qt]) lsum[qt] += st[kt][qt][i]; }
        }
        float linv[2];
#pragma unroll
        for (int qt = 0; qt < 2; ++qt) { float s = lsum[qt]; s += __shfl_xor(s, 16, 64); s += __shfl_xor(s, 32, 64); linv[qt] = (cmax[qt] >= 0) ? 1.f / s : 0.f; }
        f32x4 o[4][2]; zero42(o);
        f32x4 osd[2] = {{0.f, 0.f, 0.f, 0.f}, {0.f, 0.f, 0.f, 0.f}};
        for (int t4 = 0; t4 < nct; ++t4) {
          f32x4 st[4][2]; fill42(st, nbv0);
          qk_tile<2>(st, (lbf)(F.lds + t4 * RB), 0, qf, lane); exp42(st);
#pragma unroll
          for (int kt = 0; kt < 4; ++kt)
#pragma unroll
            for (int qt = 0; qt < 2; ++qt) {
              float gs = 0.f;
#pragma unroll
              for (int i = 0; i < 4; ++i) { const int c = t4 * 64 + kt * 16 + g * 4 + i;
                const float e = (c <= cmax[qt]) ? st[kt][qt][i] * linv[qt] : 0.f;
                st[kt][qt][i] = e; gs += e; }
              const int ti = th * 32 + qt * 16 + r, j = t4 * 16 + kt * 4 + g;
              if (gs != 0.f) { __hip_atomic_fetch_add(IMP + ti * 65 + j, gs, __ATOMIC_RELAXED, __HIP_MEMORY_SCOPE_WORKGROUP); if (j < 63 && st[kt][qt][3] != 0.f) __hip_atomic_fetch_add(IMP + ti * 65 + j + 1, st[kt][qt][3], __ATOMIC_RELAXED, __HIP_MEMORY_SCOPE_WORKGROUP); }
            }
          bf16x8 pb[2][2]; pack_p(pb, st);
          pv_apply(o, osd, pb, (lbf)(F.lds + (4 + t4) * RB), lane);
        }
        nsa_finish(comb, o, osd, gate0, true);
      }
      AT_BAR();
      {
        const int ti = tid >> 3, jb = (tid & 7) * 8;
        float mine[8]; int rank[8];
#pragma unroll
        for (int u = 0; u < 8; ++u) { const int j = jb + u; float v = IMP[ti * 65 + j]; if (j == blk || j == 0) v = 1e4f; else if (j > blk) v = -1e30f; mine[u] = v; rank[u] = 0; }
        for (int i = 0; i < 64; ++i) { float v = IMP[ti * 65 + i]; if (i == blk || i == 0) v = 1e4f; else if (i > blk) v = -1e30f;
#pragma unroll
          for (int u = 0; u < 8; ++u) rank[u] += (v > mine[u] || (v == mine[u] && i < jb + u)) ? 1 : 0; }
        unsigned bits = 0;
#pragma unroll
        for (int u = 0; u < 8; ++u) bits |= (rank[u] < 16 ? 1u : 0u) << u;
        SELB[ti * 8 + (tid & 7)] = (unsigned char)bits;
      }
      AT_BAR();
      unsigned long long selm[2];
#pragma unroll
      for (int qt = 0; qt < 2; ++qt) { const int ti = th * 32 + qt * 16 + r; const LAS unsigned* sp2 = (const LAS unsigned*)(SELB + ti * 8); selm[qt] = (unsigned long long)sp2[0] | ((unsigned long long)sp2[1] << 32); }
#pragma unroll 1
      for (int br = 1; br < 3; ++br) {
        const int kcol = OFF_NKV + ((br * 2 + 0) * 2 + gq) * 64, vcol = OFF_NKV + ((br * 2 + 1) * 2 + gq) * 64;
        const float nbb = (br == 1) ? nb1 : nb2;
        const f32x4 nbv = {nbb, nbb, nbb, nbb};
        const int t_lo = (br == 1) ? 0 : (blk > 8 ? blk - 8 : 0);
        const bf16_t* Kg = H + (size_t)(b * SEQ) * HC + kcol;
        const bf16_t* Vg = H + (size_t)(b * SEQ) * HC + vcol;
        f32x4 o[4][2]; zero42(o);
        f32x4 os[2] = {{0.f, 0.f, 0.f, 0.f}, {0.f, 0.f, 0.f, 0.f}};
        v4u krA = tile_ld(Kg + (size_t)t_lo * 64 * HC, HC, tid), vrA = tile_ld(Vg + (size_t)t_lo * 64 * HC, HC, tid);
        v4u krB = krA, vrB = vrA;
        if (t_lo < blk) { krB = tile_ld(Kg + (size_t)(t_lo + 1) * 64 * HC, HC, tid); vrB = tile_ld(Vg + (size_t)(t_lo + 1) * 64 * HC, HC, tid); }
#pragma unroll 1
        for (int t0 = t_lo; t0 <= blk; t0 += 2) {
#pragma unroll
          for (int hf = 0; hf < 2; ++hf) {
            const int t = t0 + hf;
            if (t <= blk) {
              const lbf KBt = (lbf)(F.lds + (8 + hf * 2) * RB), VBt = KBt + 64 * RP;
              tile_st(KBt, hf ? krB : krA, tid); tile_st(VBt, hf ? vrB : vrA, tid);
              AT_BAR();
              if (t + 2 <= blk) { const v4u k2 = tile_ld(Kg + (size_t)(t + 2) * 64 * HC, HC, tid), v2 = tile_ld(Vg + (size_t)(t + 2) * 64 * HC, HC, tid);
                if (hf) { krB = k2; vrB = v2; } else { krA = k2; vrA = v2; } }
              const bool on[2] = {((selm[0] >> t) & 1ull) != 0ull, ((selm[1] >> t) & 1ull) != 0ull};
              const int qq0 = th * 32;
              if (br == 1) {
                if (__any((int)(on[0] || on[1]))) {
                  if (t == blk) attn_tile<2, 3>(o, os, qf, KBt, 0, VBt, nbv, on, qq0, 0, lane);
                  else if (__all((int)(on[0] && on[1]))) attn_tile<2, 0>(o, os, qf, KBt, 0, VBt, nbv, on, qq0, 0, lane);
                  else attn_tile<2, 1>(o, os, qf, KBt, 0, VBt, nbv, on, qq0, 0, lane);
                }
              } else {
                if (t == blk) attn_tile<2, 2>(o, os, qf, KBt, 0, VBt, nbv, on, qq0, 0, lane);
                else if (t == blk - 8) attn_tile<2, 4>(o, os, qf, KBt, 0, VBt, nbv, on, qq0, 0, lane);
                else attn_tile<2, 0>(o, os, qf, KBt, 0, VBt, nbv, on, qq0, 0, lane);
              }
            }
          }
        }
        nsa_finish(comb, o, os, (br == 1) ? gate1 : gate2, false);
        AT_BAR();
      }
#pragma unroll
      for (int qt = 0; qt < 2; ++qt) { bf16_t* op = CAT + (size_t)(tokw + qt * 16 + r) * DM + 512 + hh * 64;
#pragma unroll
        for (int dt = 0; dt < 4; ++dt) { const int d0 = dt * 16 + g * 4; v2u wv; wv.x = pk2(comb[dt][qt][0], comb[dt][qt][1]); wv.y = pk2(comb[dt][qt][2], comb[dt][qt][3]); *(GAS v2u*)(op + d0) = wv; } }
    }
  }
}

__global__ void __launch_bounds__(NWAVES * 64, 2) mk_fwd(P p_arg) {
  extern __shared__ __attribute__((aligned(16))) unsigned char lds[];
  Frame F;
  F.lds = (LAS unsigned char*)lds;
  F.MISC = (volatile LAS unsigned*)(F.lds + MISC_OFF);
  F.tid = threadIdx.x; F.lane = F.tid & 63; F.wave = __builtin_amdgcn_readfirstlane(F.tid >> 6);
  F.G = gridDim.x; { const int bx = blockIdx.x; F.vcu = (F.G % 8 == 0) ? (bx % 8) * (F.G / 8) + bx / 8 : bx; }
  unsigned char* const ws = p_arg.ws;
  F.ctl = (gu32*)(ws + WS_CTL);
  for (int u = F.tid; u < (LDS_BYTES - LDSCTL_OFF) / 4; u += NWAVES * 64) ((LAS unsigned*)(F.lds + LDSCTL_OFF))[u] = 0u;
  __syncthreads();
  XcdBarrier bar = xcd_barrier_post((unsigned*)(F.ctl + CW_BAR) + p_arg.pad * XCD_BAR_WORDS, F.MISC + 8);
  const int lo = p_arg.ph_lo, hi = p_arg.ph_hi;
#ifndef PHMASK
#define PHMASK 0xffffffffu
#endif
#define IN(k) (lo <= (k) && (k) < hi && ((PHMASK >> (k)) & 1u))
#define SEAM(k) do { if (IN(k) && IN((k) + 1)) xcd_barrier(bar); } while (0)
#ifdef PROBE_PH
  F.pr_t0 = 0; F.pr_t1 = 0;
#endif

  PROBE_MARK(0); if (IN(0)) { phase_prologue(KP, F); } SEAM(0);
  PROBE_MARK(1); if (IN(1)) {
    pg8::Gemm g{(const bf16_t*)(ws + WS_XN), (const bf16_t*)(ws + WS_WIN), DM, DM};
    pg8::StaticOrder S; S.init(T_TOK, 3072, F.G, (int)blockIdx.x);
    PREF p = KP; EpiInProj E{(bf16_t*)(ws + WS_H), (float*)(ws + WS_GATES), p.dq_norm, p.dk_norm, p.nq_norm, p.nk_norm, p.gate_bias};
    pg8::gemm_phase<EpiInProj, pg8::StaticOrder, true>(F.lds + RING_OFF, g, S, E);
  } SEAM(1);
  PROBE_MARK(2); if (IN(2)) { phase_compress(KP, F); phase_diffattn(KP, F); } SEAM(2);
  PROBE_MARK(3); if (IN(3)) { phase_nsa(KP, F); } SEAM(3);
  PROBE_MARK(4); if (IN(4)) {
    pg8::Gemm g{(const bf16_t*)(ws + WS_CAT), (const bf16_t*)(ws + WS_WOUT), DM, DM};
    pg8::StaticOrder S; S.init(T_TOK, DM, F.G, (int)blockIdx.x);
    PREF p = KP; EpiResid E{p.x, p.out, nullptr};
    pg8::gemm_phase<EpiResid, pg8::StaticOrder, false>(F.lds + RING_OFF, g, S, E);
  } SEAM(4);
#define MOE_PHASES(layer, pb) do { \
    PROBE_MARK(pb); if (IN(pb)) { phase_router(KP, F, layer); } SEAM(pb); \
    PROBE_MARK(pb + 1); if (IN(pb + 1)) { \
      pg8::Gemm g{(const bf16_t*)(ws + WS_XN2), (const bf16_t*)(ws + WS_EGU), DM, DM}; \
      pg8::moe_order_setup((LAS int*)(F.lds + MISC_OFF + 256), (const unsigned*)(ws + WS_CTL) + CW_CNT + layer * 32 * 64); pg8::MoeOrder<2, true> S{(const LAS int*)(F.lds + MISC_OFF + 256), (const int*)(ws + WS_LIST), F.G, (int)blockIdx.x}; \
      EpiMoeGU E{(bf16_t*)(ws + WS_HID)}; \
      pg8::gemm_phase<EpiMoeGU, pg8::MoeOrder<2, true>, true>(F.lds + RING_OFF, g, S, E); \
    } SEAM(pb + 1); \
    PROBE_MARK(pb + 2); if (IN(pb + 2)) { \
      int k256 = 256; asm volatile("" : "+s"(k256)); \
      pg8::Gemm g{(const bf16_t*)(ws + WS_HID), (const bf16_t*)(ws + WS_EDN), k256, 256}; \
      pg8::moe_order_setup((LAS int*)(F.lds + MISC_OFF + 256), (const unsigned*)(ws + WS_CTL) + CW_CNT + layer * 32 * 64); pg8::MoeOrder<4, false> S{(const LAS int*)(F.lds + MISC_OFF + 256), (const int*)(ws + WS_LIST), F.G, (int)blockIdx.x}; \
      PREF p = KP; EpiMoeDown E{p.out, (bf16_t*)(ws + WS_Y1), (const int*)(ws + WS_LIST), (const float*)(ws + WS_PGATE), (LAS int*)(F.lds + 132096)}; \
      pg8::gemm_phase<EpiMoeDown, pg8::MoeOrder<4, false>, true>(F.lds + RING_OFF, g, S, E); \
    } SEAM(pb + 2); \
  } while (0)
  MOE_PHASES(0, 5);
  PROBE_MARK(8); if (IN(8)) { phase_rwkv_prep(KP, F); } SEAM(8);
  PROBE_MARK(9); if (IN(9)) {
    pg8::Gemm g{(const bf16_t*)(ws + WS_S0 + 3 * SLOT), (const bf16_t*)(ws + WS_WL1), DM, DM};
    pg8::TallOrder S; S.init(3, 1, F.G, (int)blockIdx.x);
    EpiLora1 E{(bf16_t*)(ws + WS_TMP)};
    pg8::gemm_phase<EpiLora1, pg8::TallOrder, false>(F.lds + RING_OFF, g, S, E);
  } SEAM(9);
  PROBE_MARK(10); if (IN(10)) {
    pg8::Gemm g{(const bf16_t*)(ws + WS_S0), (const bf16_t*)(ws + WS_WRKV), DM, DM};
    pg8::TallOrder S; S.init(3, 4, F.G, (int)blockIdx.x);
    EpiRKV E{ws};
    pg8::gemm_phase<EpiRKV, pg8::TallOrder, true>(F.lds + RING_OFF, g, S, E);
  } SEAM(10);
  PROBE_MARK(11); if (IN(11)) {
    {
      int k128 = 128; asm volatile("" : "+s"(k128));
      pg8::Gemm g{(const bf16_t*)(ws + WS_TMP), (const bf16_t*)(ws + WS_WL2), k128, 384};
      pg8::StaticOrder S; S.init(T_TOK, 2048, F.G, (int)blockIdx.x);
      PREF p = KP; EpiLora2 E{ws, p.w0, p.a0, 0};
      pg8::gemm_phase<EpiLora2, pg8::StaticOrder, true>(F.lds + RING_OFF, g, S, E);
    }
    {
      int k256 = 256; asm volatile("" : "+s"(k256));
      pg8::Gemm g{(const bf16_t*)(ws + WS_TMP) + 128, (const bf16_t*)(ws + WS_WL2 + 512 * 1024), k256, 384};
      pg8::StaticOrder S; S.init(T_TOK, 1024, F.G, (int)blockIdx.x);
      PREF p = KP; EpiLora2 E{ws, p.w0, p.a0, 2};
      pg8::gemm_phase<EpiLora2, pg8::StaticOrder, true>(F.lds + RING_OFF, g, S, E);
    }
  } SEAM(11);
  PROBE_MARK(12); if (IN(12)) { phase_rwkv_r1(KP, F); } SEAM(12);
  PROBE_MARK(13); if (IN(13)) { phase_rwkv_r2(KP, F); } SEAM(13);
  PROBE_MARK(14); if (IN(14)) { phase_rwkv_r3(KP, F); } SEAM(14);
  PROBE_MARK(15); if (IN(15)) {
    pg8::Gemm g{(const bf16_t*)(ws + WS_S0 + 3 * SLOT), (const bf16_t*)(ws + WS_WO), DM, DM};
    pg8::StaticOrder S; S.init(T_TOK, DM, F.G, (int)blockIdx.x);
    PREF p = KP; EpiResid E{p.out, p.out, (const bf16_t*)(ws + WS_Y1)};
    pg8::gemm_phase<EpiResid, pg8::StaticOrder, false>(F.lds + RING_OFF, g, S, E);
  } SEAM(15);
  MOE_PHASES(1, 16);
#undef MOE_PHASES
  PROBE_MARK(19); if (IN(19)) { phase_final(KP, F); }
  PROBE_MARK(20);
#ifdef PROBE_PH
  { const unsigned long long dur = (F.pr_t1 - F.pr_t0) * PROBE_MUL, t0 = __builtin_amdgcn_s_memrealtime(); while (__builtin_amdgcn_s_memrealtime() - t0 < dur) __builtin_amdgcn_s_sleep(8); }
#endif
#undef IN
#undef SEAM
}

static void launch_mk(P p, int lo, int hi, int li, int grid, hipStream_t st) {
  p.ph_lo = lo; p.ph_hi = hi; p.pad = li;
  hipLaunchKernelGGL(mk_fwd, dim3(grid), dim3(NWAVES * 64), LDS_BYTES, st, p);
}

extern "C" void kernel_launch(void* const* d_in, const int* in_sizes, int n_in, void* d_out, int out_size, void* d_ws,
                              size_t ws_size, hipStream_t stream) {
  static int grid = 0;
  if (grid == 0) {
    if (n_in != 40 || ws_size < WS_END) { fprintf(stderr, "kernel_launch: bad n_in %d or ws_size %zu (< %zu)\n", n_in, ws_size, (size_t)WS_END); grid = -1; return; }
    int dev = 0, cus = 0;
    if (hipGetDevice(&dev) != hipSuccess || hipDeviceGetAttribute(&cus, hipDeviceAttributeMultiprocessorCount, dev) != hipSuccess) { grid = -1; return; }
    if (hipFuncSetAttribute((const void*)mk_fwd, hipFuncAttributeMaxDynamicSharedMemorySize, LDS_BYTES) != hipSuccess) { grid = -1; return; }
    if (cus < 256) { fprintf(stderr, "kernel_launch: needs 256 CUs (one workgroup per CU), found %d\n", cus); grid = -1; return; }
    grid = 256;
  }
  if (grid < 0) return;
  P p{};
  const float* const* in = (const float* const*)d_in;
  p.x = in[0]; p.mix_norm = in[1]; p.w_in = in[2]; p.gate_bias = in[3]; p.dq_norm = in[4]; p.dk_norm = in[5];
  p.dlam = in[6]; p.dsubln = in[7]; p.nq_norm = in[8]; p.nk_norm = in[9]; p.cmp_pe = in[10]; p.cmp_w1 = in[11];
  p.cmp_w2 = in[12]; p.w_out = in[13]; p.rmix = in[14]; p.w_r = in[15]; p.w_k = in[16]; p.w_v = in[17];
  p.w0 = in[18]; p.w1 = in[19]; p.w2 = in[20]; p.a0 = in[21]; p.a1 = in[22]; p.a2 = in[23]; p.g1 = in[24]; p.g2 = in[25];
  p.k_k = in[26]; p.k_a = in[27]; p.r_k = in[28]; p.ln_w = in[29]; p.ln_b = in[30]; p.w_o = in[31];
  p.ffn_norm = in[32]; p.rg_w = in[33]; p.rg_b = in[34]; p.re_w = in[35]; p.re_b = in[36];
  p.e_gate = in[37]; p.e_up = in[38]; p.e_down = in[39];
  p.out = (float*)d_out;
  p.ws = (unsigned char*)d_ws;
  unsigned char* ws = p.ws;
  (void)hipMemsetAsync(ws + WS_CTL, 0, CTL_ZERO_BYTES, stream);
  launch_mk(p, 0, 20, 0, grid, stream);
}
```

```cpp
#include <hip/hip_runtime.h>
#include <cstdio>
#include <cstdint>

#define T_TOK 16384
#define DM 1024
#define SEQ 4096
#define NBATCH 4
#define INC 2840
#define HC 2816
#define OFF_DQ 0
#define OFF_DK 512
#define OFF_DV 1024
#define OFF_NQ 1536
#define OFF_NKV 2048
#define OFF_NG 2816
#define NCMP 255
#define CAP 16384

#define GAS __attribute__((address_space(1)))
#define LAS __attribute__((address_space(3)))
typedef unsigned short bf16_t;
typedef unsigned v4u __attribute__((ext_vector_type(4)));
typedef unsigned v2u __attribute__((ext_vector_type(2)));
typedef float f32x4 __attribute__((ext_vector_type(4)));
typedef short bf16x8 __attribute__((ext_vector_type(8)));
typedef GAS unsigned gu32;
#define RLX_AGENT __ATOMIC_RELAXED, __HIP_MEMORY_SCOPE_AGENT
#define LDS_WAIT() asm volatile("s_waitcnt lgkmcnt(0)" ::: "memory")
#define VM_WAIT() asm volatile("s_waitcnt vmcnt(0)" ::: "memory")

__device__ __forceinline__ float bf2f(bf16_t v) { return __uint_as_float(((unsigned)v) << 16); }

typedef float f32x2_t __attribute__((ext_vector_type(2))); typedef __bf16 bf16x2_t __attribute__((ext_vector_type(2)));
__device__ __forceinline__ unsigned pk2(float lo, float hi) { const f32x2_t v = {lo, hi}; return __builtin_bit_cast(unsigned, __builtin_convertvector(v, bf16x2_t)); }
__device__ __forceinline__ unsigned f2bf(float f) { return pk2(f, f) & 0xffffu; }
__device__ __forceinline__ float wave_sum(float v) {
#pragma unroll
  for (int o = 32; o >= 1; o >>= 1) v += __shfl_xor(v, o, 64);
  return v;
}
__device__ __forceinline__ float wave_sum_dpp(float v) {
  v += __builtin_bit_cast(float, __builtin_amdgcn_update_dpp(0, __builtin_bit_cast(int, v), 0xB1, 0xf, 0xf, false));
  v += __builtin_bit_cast(float, __builtin_amdgcn_update_dpp(0, __builtin_bit_cast(int, v), 0x4E, 0xf, 0xf, false));
  v += __builtin_bit_cast(float, __builtin_amdgcn_update_dpp(0, __builtin_bit_cast(int, v), 0x141, 0xf, 0xf, false));
  v += __builtin_bit_cast(float, __builtin_amdgcn_update_dpp(0, __builtin_bit_cast(int, v), 0x140, 0xf, 0xf, false));
  const int iv = __builtin_bit_cast(int, v);
  return (__builtin_bit_cast(float, __builtin_amdgcn_readlane(iv, 0)) + __builtin_bit_cast(float, __builtin_amdgcn_readlane(iv, 16))) +
         (__builtin_bit_cast(float, __builtin_amdgcn_readlane(iv, 32)) + __builtin_bit_cast(float, __builtin_amdgcn_readlane(iv, 48)));
}
__device__ __forceinline__ int fresh_lane() { int l; asm volatile("v_mbcnt_lo_u32_b32 %0, -1, 0\n\tv_mbcnt_hi_u32_b32 %0, -1, %0" : "=v"(l)); return l; }
__device__ __forceinline__ float uniformf(float v) { return __builtin_bit_cast(float, __builtin_amdgcn_readfirstlane(__builtin_bit_cast(int, v))); }
__device__ __forceinline__ float sum_x32(float v) { const auto rr = __builtin_amdgcn_permlane32_swap(__float_as_uint(v), __float_as_uint(v), false, false); return __uint_as_float(rr[0]) + __uint_as_float(rr[1]); }
__device__ __forceinline__ float sum_x16(float v) { const auto rr = __builtin_amdgcn_permlane16_swap(__float_as_uint(v), __float_as_uint(v), false, false); return __uint_as_float(rr[0]) + __uint_as_float(rr[1]); }
__device__ __forceinline__ float sum_x16_32(float v) { return sum_x32(sum_x16(v)); }
__device__ __forceinline__ float sigmoidf_(float x) { return __builtin_amdgcn_rcpf(1.f + __builtin_amdgcn_exp2f(-1.44269504f * x)); }
__device__ __forceinline__ float tanhf_(float x) { return 1.f - 2.f * __builtin_amdgcn_rcpf(1.f + __builtin_amdgcn_exp2f(2.88539008f * x)); }
__device__ __forceinline__ float softplusf_(float x) { return fmaxf(x, 0.f) + __logf(1.f + __expf(-fabsf(x))); }
__device__ __forceinline__ float gelu_tanh(float x) {
  float u = 0.7978845608028654f * (x + 0.044715f * x * x * x);
  return 0.5f * x * (1.f + tanhf(u));
}

constexpr size_t MiB = 1u << 20;
constexpr size_t WS_CTL = 0, CTL_ZERO_BYTES = 160 * 1024;
constexpr size_t WS_WIN = 1 * MiB;
constexpr size_t WS_WOUT = 7 * MiB;
constexpr size_t WS_WRKV = 9 * MiB;
constexpr size_t WS_WO = 15 * MiB;
constexpr size_t WS_WL1 = 17 * MiB;
constexpr size_t WS_WL2 = 19 * MiB;
constexpr size_t WS_EGU = 22 * MiB;
constexpr size_t WS_EDN = 54 * MiB;
constexpr size_t WS_ACT = 70 * MiB;
constexpr size_t WS_XN = WS_ACT;
constexpr size_t WS_H = WS_ACT + 32 * MiB;
constexpr size_t WS_GATES = WS_ACT + 120 * MiB;
constexpr size_t WS_CAT = WS_ACT + 122 * MiB;
constexpr size_t WS_KCMPB = WS_ACT + 154 * MiB;
constexpr size_t WS_VCMPB = WS_ACT + 155 * MiB;
constexpr size_t WS_CW1 = 21 * MiB + 256 * 1024;
constexpr size_t WS_XN2 = WS_ACT;
constexpr size_t WS_HID = WS_ACT + 32 * MiB;
constexpr size_t WS_Y1 = WS_EGU;
constexpr size_t WS_LIST = WS_ACT + 156 * MiB;
constexpr size_t WS_PGATE = WS_ACT + 158 * MiB;
constexpr size_t WS_X3 = WS_ACT + 64 * MiB;
constexpr size_t WS_XN2F = WS_ACT;
constexpr size_t WS_GUF = WS_ACT + 64 * MiB;
constexpr size_t WS_S0 = WS_ACT;
constexpr size_t WS_TMP = WS_ACT + 192 * MiB;
constexpr size_t WS_END = WS_ACT + 204 * MiB;
constexpr size_t SLOT = 32 * MiB;
constexpr int CW_BAR = 4096;
constexpr int CW_CNT = 32768;

namespace pg8 {
#define PG8_LAS __attribute__((address_space(3)))
typedef unsigned u32x4 __attribute__((ext_vector_type(4)));
constexpr int BM = 256, BK = 64, HALF = 128, HTB = HALF * BK * 2  , STAGE_BYTES = 8 * HTB, NXCD = 8, WGM = 8;

__host__ __device__ __forceinline__ int lds_byte(int r, int c) { const int st = (r >> 4) * 2 + (c >> 5), rr = r & 15, cc = c & 31, ob = rr * 64 + cc * 2; return st * 1024 + (ob ^ (((ob >> 9) & 1) << 5)); }
__host__ __device__ __forceinline__ void stage_rc(int b, int& R, int& C) { const int st = b / 1024, sb = b % 1024, swz = sb ^ (((sb >> 9) & 1) << 5); R = (st >> 1) * 16 + swz / 64; C = (st & 1) * 32 + (swz % 64) / 2; }
__host__ __device__ __forceinline__ int perm32(int rho) { const int n = rho >> 4, i = rho & 15; return 8 * (i >> 2) + 4 * n + (i & 3); }

struct Unit { int pm, pn, e, nrows, rt, par; };
struct Gemm { const bf16_t* A; const bf16_t* Bt; int K; int lda; };

__device__ __forceinline__ void static_map(int L, int nM, int nN, int& pm, int& pn) {
    const int nwg = nM * nN;
    int wgid = L; { const int q = nwg / NXCD, r = nwg % NXCD, xcd = wgid % NXCD, off = wgid / NXCD; wgid = (xcd < r ? xcd * (q + 1) : r * (q + 1) + (xcd - r) * q) + off; }
    const int nig = WGM * nN, gid = wgid / nig, fm = gid * WGM, gsz = (nM - fm) < WGM ? (nM - fm) : WGM;
    pm = fm + ((wgid % nig) % gsz); pn = (wgid % nig) / gsz;
}
struct StaticOrder {
    int nM, nN, G, c;
    __device__ void init(int M, int N, int G_, int c_) { nM = M / BM; nN = N / BM; G = G_; c = c_; }
    __device__ __forceinline__ bool next(int i, Unit& u) const {
        const int L = i * G + c; if (L >= nM * nN) return false;
        static_map(L, nM, nN, u.pm, u.pn); u.e = 0; u.nrows = 256; u.rt = 0; return true;
    }
    __device__ __forceinline__ unsigned rowoff(const Unit& u, int r, int C, int K) const { return (unsigned)((u.pm * BM + r) * K + C) * 2u; }
};
struct TallOrder {
    int nM, nN, G, c;
    __device__ void init(int ngemm, int nN_, int G_, int c_) { nM = 64 * ngemm; nN = nN_; G = G_; c = c_; }
    __device__ __forceinline__ bool next(int i, Unit& u) const {
        const int L = i * G + c; if (L >= nM * nN) return false;
        int pn; static_map(L, nM, nN, u.pm, pn); u.pn = (u.pm >> 6) * nN + pn; u.e = 0; u.nrows = 256; u.rt = 0; return true;
    }
    __device__ __forceinline__ unsigned rowoff(const Unit& u, int r, int C, int K) const { return (unsigned)((u.pm * BM + r) * K + C) * 2u; }
};


template <int NCOL, bool GATHER>
struct MoeOrder {
    const PG8_LAS int* tab;
    const int* list; int G, c;
    __device__ __forceinline__ bool next(int i, Unit& u) const {
        const int L = i * G + c; const int R = L / NCOL, j = L - R * NCOL;
        if (R >= tab[32]) return false;
        int e = 0;
#pragma unroll
        for (int s = 16; s >= 1; s >>= 1) { if (tab[e + s] <= R) e += s; }
        const int ce = tab[33 + e];
        u.pm = R; u.rt = R - tab[e]; u.e = e; u.pn = e * NCOL + j; u.nrows = ce - u.rt * 256; return true;
    }
    __device__ __forceinline__ unsigned rowoff(const Unit& u, int r, int C, int K) const {
        if (GATHER) { const int idx = (r < u.nrows) ? u.rt * 256 + r : 0; const int pr = list[(size_t)u.e * CAP + idx]; return (unsigned)((pr >> 1) * K + C) * 2u; }
        return (unsigned)((u.pm * BM + r) * K + C) * 2u;
    }
};
__device__ __forceinline__ void moe_order_setup(PG8_LAS int* tab, const unsigned* cnt) {
    if (threadIdx.x < 32) tab[33 + threadIdx.x] = (int)__hip_atomic_load(cnt + threadIdx.x * 64, __ATOMIC_RELAXED, __HIP_MEMORY_SCOPE_AGENT);
    __syncthreads();
    if (threadIdx.x == 0) { int pre = 0; for (int e = 0; e < 32; ++e) { tab[e] = pre; pre += (tab[33 + e] + 255) >> 8; } tab[32] = pre; }
    __syncthreads();
}

__device__ __forceinline__ unsigned cvt_pk_bf16(float lo, float hi) { unsigned r; asm volatile("v_cvt_pk_bf16_f32 %0, %1, %2" : "=v"(r) : "v"(lo), "v"(hi)); return r; }
__device__ __forceinline__ u32x4 pack8(const f32x4& a, const f32x4& b) { u32x4 w; w.x = cvt_pk_bf16(a[0], a[1]); w.y = cvt_pk_bf16(a[2], a[3]); w.z = cvt_pk_bf16(b[0], b[1]); w.w = cvt_pk_bf16(b[2], b[3]); return w; }

template <class Epi, class Sched, bool ALIGN_EPI>
__device__ __forceinline__ void gemm_phase(PG8_LAS unsigned char* lds, const Gemm g, const Sched& S, const Epi& E) {
    const int tid = threadIdx.x, wid = __builtin_amdgcn_readfirstlane(tid >> 6), lane = tid & 63, wr = wid >> 2, wc = wid & 3, fr = lane & 15, fq = lane >> 4;
    const int K = g.K, nt = K / BK;
    int RA[2], CA[2]; unsigned voffB[2];
#pragma unroll
    for (int i = 0; i < 2; ++i) { int R, C; stage_rc(tid * 16 + i * 8192, R, C); const int Rb = Epi::PERM ? ((R & ~31) + perm32(R & 31)) : R;
        RA[i] = R; CA[i] = C; voffB[i] = (unsigned)(Rb * K + C) * 2u; }
    const size_t kstep = (size_t)(BK * 2);
    const size_t hstep = (size_t)HALF * K * 2;
    const size_t tstep = 2 * hstep;
    const unsigned ldsw = (unsigned)wid * 1024u;
    const int aoff = lds_byte(wr * 64 + fr, fq * 8), boff = lds_byte(wc * 32 + fr, fq * 8);
    const char* const Abase = (const char*)g.A;
#define PG8_SA(b, h) (((b) * 2 + (h)) * HTB)
#define PG8_SB(b, h) ((4 + (b) * 2 + (h)) * HTB)
#define PG8_STAGE(bufoff, gbase, voff) do { _Pragma("unroll") for (int _i = 0; _i < 2; ++_i) \
        __builtin_amdgcn_global_load_lds((const unsigned*)((const char*)(gbase) + (voff)[_i]), (PG8_LAS unsigned*)(lds + (bufoff) + ldsw + _i * 8192), 16, 0, 0); } while (0)
#define PG8_STAGEA(bufoff, kbyte, o0, o1) do { \
        __builtin_amdgcn_global_load_lds((const unsigned*)(Abase + (size_t)(kbyte) + (o0)), (PG8_LAS unsigned*)(lds + (bufoff) + ldsw), 16, 0, 0); \
        __builtin_amdgcn_global_load_lds((const unsigned*)(Abase + (size_t)(kbyte) + (o1)), (PG8_LAS unsigned*)(lds + (bufoff) + ldsw + 8192), 16, 0, 0); } while (0)
#define PG8_LDA(dst, b, h) do { _Pragma("unroll") for (int m = 0; m < 4; ++m) _Pragma("unroll") for (int k = 0; k < 2; ++k) dst[m][k] = *(const PG8_LAS bf16x8*)(lds + PG8_SA(b, h) + aoff + m * 2048 + k * 1024); } while (0)
#define PG8_LDB(dst, b, h) do { _Pragma("unroll") for (int n = 0; n < 2; ++n) _Pragma("unroll") for (int k = 0; k < 2; ++k) dst[n][k] = *(const PG8_LAS bf16x8*)(lds + PG8_SB(b, h) + boff + n * 2048 + k * 1024); } while (0)
#define PG8_MMA(ai, bj, At, Bt) do { __builtin_amdgcn_s_setprio(1); _Pragma("unroll") for (int m = 0; m < 4; ++m) _Pragma("unroll") for (int n = 0; n < 2; ++n) _Pragma("unroll") for (int k = 0; k < 2; ++k) \
        acc[ai][bj][m][n] = __builtin_amdgcn_mfma_f32_16x16x32_bf16(Bt[n][k], At[m][k], acc[ai][bj][m][n], 0, 0, 0); __builtin_amdgcn_s_setprio(0); } while (0)
#define PG8_WAIT_V(n) asm volatile("s_waitcnt vmcnt(" #n ")" ::: "memory")
#define PG8_WAIT_L(n) asm volatile("s_waitcnt lgkmcnt(" #n ")" ::: "memory")
#define PG8_BAR __builtin_amdgcn_s_barrier()
#define PG8_SCHED __builtin_amdgcn_sched_barrier(0)
    Unit cur, nxt; int ui = 0;
    if (!S.next(0, cur)) return;
    cur.par = 0;
    if constexpr (Epi::HAS_PRE) E.pre(cur);
    f32x4 acc[2][2][4][2];
#pragma unroll
    for (int a = 0; a < 2; ++a)
#pragma unroll
        for (int b = 0; b < 2; ++b)
#pragma unroll
            for (int m = 0; m < 4; ++m)
#pragma unroll
                for (int n = 0; n < 2; ++n) acc[a][b][m][n] = (f32x4){0.f, 0.f, 0.f, 0.f};
    bf16x8 At[4][2], B0[2][2], B1[2][2];
    unsigned c00 = S.rowoff(cur, RA[0], CA[0], g.lda), c01 = S.rowoff(cur, RA[1], CA[1], g.lda), c10 = S.rowoff(cur, HALF + RA[0], CA[0], g.lda), c11 = S.rowoff(cur, HALF + RA[1], CA[1], g.lda);
    unsigned n00, n01, n10, n11;
    const char* cB = (const char*)g.Bt + (size_t)cur.pn * tstep;
    PG8_STAGE(PG8_SB(0, 0), cB, voffB); PG8_STAGE(PG8_SB(0, 1), cB + hstep, voffB); PG8_STAGEA(PG8_SA(0, 0), 0, c00, c01); PG8_STAGEA(PG8_SA(0, 1), 0, c10, c11);
    if (wr == 1) PG8_BAR;
    PG8_WAIT_V(2); PG8_BAR;
    PG8_STAGE(PG8_SB(1, 0), cB + kstep, voffB); PG8_STAGEA(PG8_SA(1, 0), kstep, c00, c01); PG8_STAGE(PG8_SB(1, 1), cB + hstep + kstep, voffB);
    PG8_WAIT_V(6); PG8_BAR;
    for (;;) {
        const bool has_next = S.next(ui + 1, nxt);
        const char* nB = has_next ? (const char*)g.Bt + (size_t)nxt.pn * tstep : cB;
        if (has_next) { n00 = S.rowoff(nxt, RA[0], CA[0], g.lda); n01 = S.rowoff(nxt, RA[1], CA[1], g.lda); n10 = S.rowoff(nxt, HALF + RA[0], CA[0], g.lda); n11 = S.rowoff(nxt, HALF + RA[1], CA[1], g.lda); }
        else { n00 = c00; n01 = c01; n10 = c10; n11 = c11; }
        for (int t = 0; t < nt; t += 2) {
            const bool last = (t == nt - 2);
            const size_t k1 = (size_t)(t + 1) * kstep;
            const size_t k2 = last ? 0 : (size_t)(t + 2) * kstep;
            const size_t k3 = k2 + kstep;
            const unsigned a00 = last ? n00 : c00, a01 = last ? n01 : c01, a10 = last ? n10 : c10, a11 = last ? n11 : c11;
            const char* b2 = last ? nB : cB + (size_t)(t + 2) * kstep;
            const char* b3 = b2 + kstep;
            PG8_LDB(B0, 0, 0); PG8_LDB(B1, 0, 1); PG8_SCHED; PG8_LDA(At, 0, 0); PG8_STAGEA(PG8_SA(1, 1), k1, c10, c11);
            PG8_WAIT_V(8); PG8_WAIT_L(0); PG8_BAR; PG8_MMA(0, 0, At, B0); PG8_MMA(0, 1, At, B1); PG8_BAR; PG8_SCHED;
            PG8_LDA(At, 0, 1); PG8_STAGE(PG8_SB(0, 0), b2, voffB); PG8_STAGE(PG8_SB(0, 1), b2 + hstep, voffB); PG8_STAGEA(PG8_SA(0, 0), k2, a00, a01);
            PG8_WAIT_V(8); PG8_WAIT_L(0); PG8_BAR; PG8_MMA(1, 0, At, B0); PG8_MMA(1, 1, At, B1); PG8_BAR; PG8_SCHED;
            PG8_LDB(B0, 1, 0); PG8_LDB(B1, 1, 1); PG8_SCHED; PG8_LDA(At, 1, 0); PG8_STAGEA(PG8_SA(0, 1), k2, a10, a11);
            PG8_WAIT_V(8); PG8_WAIT_L(0); PG8_BAR; PG8_MMA(0, 0, At, B0); PG8_MMA(0, 1, At, B1); PG8_BAR; PG8_SCHED;
            PG8_LDA(At, 1, 1); PG8_STAGE(PG8_SB(1, 0), b3, voffB); PG8_STAGE(PG8_SB(1, 1), b3 + hstep, voffB); PG8_STAGEA(PG8_SA(1, 0), k3, a00, a01);
            PG8_WAIT_V(8); PG8_WAIT_L(0); PG8_BAR; PG8_MMA(1, 0, At, B0); PG8_MMA(1, 1, At, B1); PG8_BAR; PG8_SCHED;
        }
        if constexpr (ALIGN_EPI) { if (wr == 0) PG8_BAR; }
        E(acc, cur, wr, wc, fr, fq);
        if (!has_next) break;
#pragma unroll
        for (int a = 0; a < 2; ++a)
#pragma unroll
            for (int b = 0; b < 2; ++b)
#pragma unroll
                for (int m = 0; m < 4; ++m)
#pragma unroll
                    for (int n = 0; n < 2; ++n) acc[a][b][m][n] = (f32x4){0.f, 0.f, 0.f, 0.f};
        cur = nxt; cB = nB; c00 = n00; c01 = n01; c10 = n10; c11 = n11; ++ui; cur.par = ui & 1;
        if constexpr (Epi::HAS_PRE) E.pre(cur);
        if constexpr (ALIGN_EPI) { if (wr == 1) PG8_BAR; }
    }
    PG8_WAIT_V(0);
    if constexpr (!ALIGN_EPI) { if (wr == 0) PG8_BAR; }
    PG8_BAR;
#undef PG8_SA
#undef PG8_SB
#undef PG8_STAGE
#undef PG8_STAGEA
#undef PG8_LDA
#undef PG8_LDB
#undef PG8_MMA
#undef PG8_WAIT_V
#undef PG8_WAIT_L
#undef PG8_BAR
#undef PG8_SCHED
}
}

#define XB_TMO      128
#define XB_XCNT(j)  (256  + 64 * (j))
#define XB_XSUB(j)  (1280 + 64 * (j))
#define XB_XGEN(j)  (2304 + 64 * (j))
#define XB_TOP      3328
#define XB_TOPGEN   3392
#define XCD_BAR_WORDS 3456
#define XB_SPIN_CAP (1u << 18)

__device__ __forceinline__ unsigned xb_ld(unsigned* p)              { return __hip_atomic_load(p, __ATOMIC_RELAXED, __HIP_MEMORY_SCOPE_AGENT); }
__device__ __forceinline__ unsigned xb_add(unsigned* p, unsigned v) { return __hip_atomic_fetch_add(p, v, __ATOMIC_RELAXED, __HIP_MEMORY_SCOPE_AGENT); }
__device__ __forceinline__ unsigned xb_xcc_id() { return (unsigned)__builtin_amdgcn_s_getreg((3 << 11) | 20) & 0xFu; }
#define XB_SPIN(cond, bar) do { unsigned _sp = 0; while (cond) { __builtin_amdgcn_s_sleep(1); \
    if ((++_sp & 255u) == 0u) { if (xb_ld(&(bar)[XB_TMO])) break; if (_sp > XB_SPIN_CAP) { atomicAdd(&(bar)[XB_TMO], 1u); break; } } } } while (0)

struct XcdBarrier {
    unsigned* bar; unsigned x;
    volatile LAS unsigned* st;
};

__device__ __forceinline__ XcdBarrier xcd_barrier_post(unsigned* bar, volatile LAS unsigned* st) {
    XcdBarrier b; b.bar = bar; b.x = xb_xcc_id(); b.st = st;
    if (threadIdx.x == 0) (void)xb_add(&bar[XB_XCNT(b.x)], 1u);
    return b;
}
__device__ __forceinline__ void xcd_barrier_complete(unsigned* bar, unsigned x, unsigned& nloc, unsigned& nx) {
    const unsigned G = gridDim.x * gridDim.y * gridDim.z;
    unsigned sum, cnt, mine, sp = 0u;
    for (;;) {
        sum = 0u; cnt = 0u; mine = 0u;
#pragma unroll
        for (unsigned j = 0; j < 16; ++j) { const unsigned c = xb_ld(&bar[XB_XCNT(j)]); sum += c; cnt += (c > 0u) ? 1u : 0u; mine = (j == x) ? c : mine; }
        if (sum == G) break;
        __builtin_amdgcn_s_sleep(1);
        if ((++sp & 255u) == 0u) { if (xb_ld(&bar[XB_TMO])) break; if (sp > XB_SPIN_CAP) { atomicAdd(&bar[XB_TMO], 1u); break; } }
    }
    nloc = mine > 0u ? mine : 1u; nx = cnt > 0u ? cnt : 1u;
}

__device__ __forceinline__ void xcd_barrier(const XcdBarrier& b) {
    asm volatile("s_waitcnt vmcnt(0)" ::: "memory");
    __syncthreads();
    if (threadIdx.x == 0) {
        unsigned* bar = b.bar;
        __builtin_amdgcn_s_waitcnt(0);
        unsigned nloc = b.st[0], nx = b.st[1];
        if (nloc == 0u) { xcd_barrier_complete(bar, b.x, nloc, nx); b.st[0] = nloc; b.st[1] = nx; }
        const unsigned old = xb_add(&bar[XB_XSUB(b.x)], 1u);
        const unsigned gen = old / nloc;
        if (old + 1u == (gen + 1u) * nloc) {
            __builtin_amdgcn_fence(__ATOMIC_RELEASE, "agent");
            asm volatile("s_waitcnt vmcnt(0)" ::: "memory");
            const unsigned og = xb_add(&bar[XB_TOP], 1u);
            const unsigned tg = og / nx;
            if (og + 1u == (tg + 1u) * nx) xb_add(&bar[XB_TOPGEN], 1u);
            else XB_SPIN(xb_ld(&bar[XB_TOPGEN]) == tg, bar);
            __builtin_amdgcn_fence(__ATOMIC_ACQUIRE, "agent");
            xb_add(&bar[XB_XGEN(b.x)], 1u);
            asm volatile("s_waitcnt vmcnt(0)" ::: "memory");
        } else {
            XB_SPIN(xb_ld(&bar[XB_XGEN(b.x)]) == gen, bar);
            __builtin_amdgcn_fence(__ATOMIC_ACQUIRE, "agent");
            asm volatile("s_waitcnt vmcnt(0)" ::: "memory");
        }
    }
    __syncthreads();
}
struct P {
  const float* x; const float* mix_norm; const float* w_in; const float* gate_bias;
  const float* dq_norm; const float* dk_norm; const float* dlam; const float* dsubln;
  const float* nq_norm; const float* nk_norm; const float* cmp_pe; const float* cmp_w1; const float* cmp_w2;
  const float* w_out;
  const float* rmix; const float* w_r; const float* w_k; const float* w_v;
  const float* w0; const float* w1; const float* w2; const float* a0; const float* a1; const float* a2;
  const float* g1; const float* g2; const float* k_k; const float* k_a; const float* r_k;
  const float* ln_w; const float* ln_b; const float* w_o;
  const float* ffn_norm; const float* rg_w; const float* rg_b; const float* re_w; const float* re_b;
  const float* e_gate; const float* e_up; const float* e_down;
  float* out;
  unsigned char* ws;
  int ph_lo, ph_hi, layer, pad;
};

#define PREF const __attribute__((address_space(4))) P&
__device__ __forceinline__ const __attribute__((address_space(4))) P* opaque_kernarg() { auto q = __builtin_amdgcn_kernarg_segment_ptr(); asm volatile("" : "+s"(q)); return (const __attribute__((address_space(4))) P*)q; }
#define KP (*opaque_kernarg())

constexpr int RING_OFF = 0, RING_BYTES = 131072;
constexpr int LDSCTL_OFF = RING_BYTES, MISC_OFF = LDSCTL_OFF + 320;
constexpr int LDS_BYTES = 147456;
constexpr int NWAVES = 8;

struct Frame {
  LAS unsigned char* lds;
  volatile LAS unsigned* MISC;
  gu32* ctl;
  int tid, lane, wave, vcu, G;
#ifdef PROBE_PH
  unsigned long long pr_t0, pr_t1;
#endif
};
#ifdef PROBE_PH
#define PROBE_MARK(k) do { if ((k) == PROBE_PH) F.pr_t0 = __builtin_amdgcn_s_memrealtime(); if ((k) == PROBE_PH + PROBE_N) F.pr_t1 = __builtin_amdgcn_s_memrealtime(); } while (0)
#else
#define PROBE_MARK(k) do {} while (0)
#endif

__device__ __forceinline__ void transpose_item(const float* W, int ldsrc, int k0, int c0, int ncols, bf16_t* dst, int ldk, int drow0, LAS float* scr, int lane) {
  const int kr = lane >> 3, c4 = (lane & 7) * 4;
  f32x4 v[8];
#pragma unroll
  for (int i = 0; i < 8; ++i) v[i] = (c4 < ncols) ? *(const GAS f32x4*)(W + (size_t)(k0 + kr + 8 * i) * ldsrc + c0 + c4) : (f32x4){0.f, 0.f, 0.f, 0.f};
#pragma unroll
  for (int i = 0; i < 8; ++i) { LAS float* s = scr + (kr + 8 * i) * 33 + c4; s[0] = v[i].x; s[1] = v[i].y; s[2] = v[i].z; s[3] = v[i].w; }
  LDS_WAIT(); asm volatile("" ::: "memory");
  const int c = lane & 7;
#pragma unroll
  for (int j = 0; j < 4; ++j) { const int n = (lane >> 3) + 8 * j; const LAS float* s = scr + (8 * c) * 33 + n;
    v4u o; o.x = pk2(s[0 * 33], s[1 * 33]); o.y = pk2(s[2 * 33], s[3 * 33]); o.z = pk2(s[4 * 33], s[5 * 33]); o.w = pk2(s[6 * 33], s[7 * 33]);
    *(GAS v4u*)(dst + (size_t)(drow0 + n) * ldk + k0 + 8 * c) = o; }
  LDS_WAIT(); asm volatile("" ::: "memory");
}
template <int NR>
__device__ __forceinline__ void rms_rows_to_bf16(const float* x, const float* gain, bf16_t* o, int m0, int stride, int lane) {
  f32x4 v[NR][4];
#pragma unroll
  for (int r = 0; r < NR; ++r) { const GAS f32x4* xr = (const GAS f32x4*)(x + (size_t)(m0 + r * stride) * DM) + lane;
#pragma unroll
    for (int j = 0; j < 4; ++j) v[r][j] = xr[64 * j]; }
  const GAS f32x4* gr = (const GAS f32x4*)gain + lane;
  f32x4 g[4];
#pragma unroll
  for (int j = 0; j < 4; ++j) g[j] = gr[64 * j];
#pragma unroll
  for (int r = 0; r < NR; ++r) {
    float s = 0.f;
#pragma unroll
    for (int j = 0; j < 4; ++j) s += (v[r][j].x * v[r][j].x + v[r][j].y * v[r][j].y) + (v[r][j].z * v[r][j].z + v[r][j].w * v[r][j].w);
    const float rr = rsqrtf(wave_sum_dpp(s) * (1.f / DM) + 1e-6f);
    GAS v2u* o8 = (GAS v2u*)(o + (size_t)(m0 + r * stride) * DM) + lane;
#pragma unroll
    for (int j = 0; j < 4; ++j) { v2u w; w.x = pk2(v[r][j].x * rr * g[j].x, v[r][j].y * rr * g[j].y); w.y = pk2(v[r][j].z * rr * g[j].z, v[r][j].w * rr * g[j].w); o8[64 * j] = w; }
  }
}

__device__ __forceinline__ void conv_win_item(PREF p, int it, LAS float* scr, int lane) {
  const int vg = it >> 4, kb = it & 15;
  const int pn = vg >> 3, bj = (vg >> 2) & 1, wc = vg & 3, s = pn * 4 + wc;
  int c0 = 0, nc = 0;
  if (s < 44) { c0 = 64 * s + 32 * bj; nc = 32; } else if (s == 44 && bj == 0) { c0 = OFF_NG; nc = 24; }
  transpose_item(p.w_in, INC, kb * 64, c0, nc, (bf16_t*)(p.ws + WS_WIN), DM, vg * 32, scr, lane);
}
__device__ __forceinline__ void conv_sq_item(const float* W, bf16_t* dst, int drow_base, int it, LAS float* scr, int lane) {
  const int cg = it >> 4, kb = it & 15;
  transpose_item(W, DM, kb * 64, cg * 32, 32, dst, DM, drow_base + cg * 32, scr, lane);
}
__device__ __forceinline__ void conv_expert_item(PREF p, int layer, int it, LAS float* scr, int lane) {
  const int e = it / 384, r = it % 384;
  if (r < 256) {
    const int up = r >> 7, q = r & 127, cgp = q >> 4, kb = q & 15;
    const int pn = cgp >> 2, qq = cgp & 3;
    const float* W = (up ? p.e_up : p.e_gate) + ((size_t)layer * 32 + e) * DM * 256;
    transpose_item(W, 256, kb * 64, cgp * 32, 32, (bf16_t*)(p.ws + WS_EGU), DM, e * 512 + pn * 256 + up * 128 + qq * 32, scr, lane);
  } else {
    const int q = r - 256, cg = q >> 2, kb = q & 3;
    const float* W = p.e_down + ((size_t)layer * 32 + e) * 256 * DM;
    transpose_item(W, DM, kb * 64, cg * 32, 32, (bf16_t*)(p.ws + WS_EDN), 256, e * 1024 + cg * 32, scr, lane);
  }
}

using pg8::Unit; using pg8::u32x4; using pg8::pack8;
struct EpiInProj {
  static constexpr bool PERM = true, HAS_PRE = false;
  bf16_t* H; float* GATES; const float* dq; const float* dk; const float* nq; const float* nk; const float* gbias;
  __device__ __forceinline__ void operator()(const f32x4 (&acc)[2][2][4][2], const Unit& u, int wr, int wc, int fr, int fq) const {
    const int s = u.pn * 4 + wc;
    if (s > 44) return;
    const int row0 = u.pm * 256 + wr * 64 + fr;
    if (s == 44) {
      if (fq < 3) {
        f32x4 b0 = *(const f32x4*)(gbias + 8 * fq), b1 = *(const f32x4*)(gbias + 8 * fq + 4);
#pragma unroll
        for (int ai = 0; ai < 2; ++ai)
#pragma unroll
          for (int m = 0; m < 4; ++m) { float* gp = GATES + (size_t)(row0 + ai * 128 + m * 16) * 24 + 8 * fq;
            f32x4 v0 = acc[ai][0][m][0] + b0, v1 = acc[ai][0][m][1] + b1;
#pragma unroll
            for (int i = 0; i < 4; ++i) { v0[i] = sigmoidf_(v0[i]); v1[i] = sigmoidf_(v1[i]); }
            *(f32x4*)gp = v0; *(f32x4*)(gp + 4) = v1; }
      }
      return;
    }
    int mode = 0; const float* gain = nullptr;
    if (s < 8) { mode = 1; gain = dq; } else if (s < 16) { mode = 1; gain = dk; }
    else if (s >= 24 && s < 32) { mode = 2; gain = nq; }
    else if (s >= 32) { const int q = s - 32, br = q >> 2, kv = (q >> 1) & 1; if (kv == 0 && br >= 1) { mode = 2; gain = nk + br * 64; } }
    const float qsc = (s < 8) ? 0.17677669529663687f * 1.4426950408889634f : ((s >= 24 && s < 32) ? 0.125f * 1.4426950408889634f : 1.f);
    f32x4 g[2][2];
#pragma unroll
    for (int bj = 0; bj < 2; ++bj)
#pragma unroll
      for (int n = 0; n < 2; ++n) {
        if (mode == 1) g[bj][n] = *(const f32x4*)(gain + 8 * fq + 4 * n);
        else if (mode == 2) g[bj][n] = *(const f32x4*)(gain + 32 * bj + 8 * fq + 4 * n);
        else g[bj][n] = (f32x4){1.f, 1.f, 1.f, 1.f};
      }
#pragma unroll
    for (int ai = 0; ai < 2; ++ai)
#pragma unroll
      for (int m = 0; m < 4; ++m) {
        float sc[2] = {1.f, 1.f};
        if (mode != 0) {
          float ss[2];
#pragma unroll
          for (int bj = 0; bj < 2; ++bj) { const f32x4 a = acc[ai][bj][m][0], b = acc[ai][bj][m][1];
            float t = (a[0] * a[0] + a[1] * a[1]) + (a[2] * a[2] + a[3] * a[3]) + (b[0] * b[0] + b[1] * b[1]) + (b[2] * b[2] + b[3] * b[3]);
            ss[bj] = sum_x16_32(t); }
          if (mode == 1) { sc[0] = rsqrtf(ss[0] * (1.f / 32.f) + 1e-6f) * qsc; sc[1] = rsqrtf(ss[1] * (1.f / 32.f) + 1e-6f) * qsc; }
          else { const float r = rsqrtf((ss[0] + ss[1]) * (1.f / 64.f) + 1e-6f) * qsc; sc[0] = r; sc[1] = r; }
        }
        bf16_t* rowp = H + (size_t)(row0 + ai * 128 + m * 16) * HC + 64 * s + 8 * fq;
#pragma unroll
        for (int bj = 0; bj < 2; ++bj) { const f32x4 v0 = acc[ai][bj][m][0] * sc[bj] * g[bj][0], v1 = acc[ai][bj][m][1] * sc[bj] * g[bj][1];
          *(u32x4*)(rowp + 32 * bj) = pack8(v0, v1); }
      }
  }
};
struct EpiResid {
  static constexpr bool PERM = true, HAS_PRE = false;
  const float* xf; const bf16_t* xb; bf16_t* out; const bf16_t* y1;
  __device__ __forceinline__ void operator()(const f32x4 (&acc)[2][2][4][2], const Unit& u, int wr, int wc, int fr, int fq) const {
    const int row0 = u.pm * 256 + wr * 64 + fr, col0 = u.pn * 256 + wc * 32 + 8 * fq;
#pragma unroll
    for (int ai = 0; ai < 2; ++ai)
#pragma unroll
      for (int m = 0; m < 4; ++m) { const size_t off = (size_t)(row0 + ai * 128 + m * 16) * DM + col0;
#pragma unroll
        for (int bj = 0; bj < 2; ++bj) {
          f32x4 b0, b1;
          if (xf) { b0 = *(const f32x4*)(xf + off + bj * 128); b1 = *(const f32x4*)(xf + off + bj * 128 + 4); }
          else { const v4u w = *(const v4u*)(xb + off + bj * 128);
            b0 = (f32x4){__uint_as_float(w.x << 16), __uint_as_float(w.x & 0xffff0000u), __uint_as_float(w.y << 16), __uint_as_float(w.y & 0xffff0000u)};
            b1 = (f32x4){__uint_as_float(w.z << 16), __uint_as_float(w.z & 0xffff0000u), __uint_as_float(w.w << 16), __uint_as_float(w.w & 0xffff0000u)}; }
          if (y1) { const v4u w = *(const v4u*)(y1 + off + bj * 128);
            b0 += (f32x4){__uint_as_float(w.x << 16), __uint_as_float(w.x & 0xffff0000u), __uint_as_float(w.y << 16), __uint_as_float(w.y & 0xffff0000u)};
            b1 += (f32x4){__uint_as_float(w.z << 16), __uint_as_float(w.z & 0xffff0000u), __uint_as_float(w.w << 16), __uint_as_float(w.w & 0xffff0000u)}; }
          *(u32x4*)(out + off + bj * 128) = pack8(b0 + acc[ai][bj][m][0], b1 + acc[ai][bj][m][1]); asm volatile("" ::: "memory"); } }
  }
};
struct EpiRKV {
  static constexpr bool PERM = true, HAS_PRE = false;
  unsigned char* ws;
  __device__ __forceinline__ void operator()(const f32x4 (&acc)[2][2][4][2], const Unit& u, int wr, int wc, int fr, int fq) const {
    const int gi = u.pm >> 6;
    bf16_t* O = (bf16_t*)(ws + WS_S0 + (size_t)(3 + gi) * SLOT);
    const int row0 = (u.pm & 63) * 256 + wr * 64 + fr, col0 = (u.pn & 3) * 256 + wc * 32 + 8 * fq;
#pragma unroll
    for (int ai = 0; ai < 2; ++ai)
#pragma unroll
      for (int m = 0; m < 4; ++m) { bf16_t* rowp = O + (size_t)(row0 + ai * 128 + m * 16) * DM + col0;
#pragma unroll
        for (int bj = 0; bj < 2; ++bj) *(u32x4*)(rowp + bj * 128) = pack8(acc[ai][bj][m][0], acc[ai][bj][m][1]); }
  }
};
struct EpiLora1 {
  static constexpr bool PERM = true, HAS_PRE = false;
  bf16_t* TMP;
  template <int BJ>
  __device__ __forceinline__ void half(const f32x4 (&acc)[2][2][4][2], int gi, int row0, int wc, int fq) const {
    const int c = BJ * 128 + wc * 32 + 8 * fq;
    const bool skip = (gi < 2) && (c >= 64);
    const int dcol = (gi < 2) ? gi * 64 + c : 128 + c;
    const bool zero = (gi == 2) && (c >= 160);
    if (skip) return;
#pragma unroll
    for (int ai = 0; ai < 2; ++ai)
#pragma unroll
      for (int m = 0; m < 4; ++m) {
        f32x4 v0 = acc[ai][BJ][m][0], v1 = acc[ai][BJ][m][1];
#pragma unroll
        for (int i = 0; i < 4; ++i) {
          if (gi == 0) { v0[i] = tanhf_(v0[i]); v1[i] = tanhf_(v1[i]); }
          else if (gi == 2) { v0[i] = zero ? 0.f : sigmoidf_(v0[i]); v1[i] = zero ? 0.f : sigmoidf_(v1[i]); }
        }
        *(u32x4*)(TMP + (size_t)(row0 + ai * 128 + m * 16) * 384 + dcol) = pack8(v0, v1);
      }
  }
  __device__ __forceinline__ void operator()(const f32x4 (&acc)[2][2][4][2], const Unit& u, int wr, int wc, int fr, int fq) const {
    const int gi = u.pm >> 6;
    const int row0 = (u.pm & 63) * 256 + wr * 64 + fr;
    half<0>(acc, gi, row0, wc, fq);
    half<1>(acc, gi, row0, wc, fq);
  }
};
struct EpiLora2 {
  static constexpr bool PERM = true, HAS_PRE = false;
  unsigned char* ws; const float* w0; const float* a0; int gbase;
  __device__ __forceinline__ void operator()(const f32x4 (&acc)[2][2][4][2], const Unit& u, int wr, int wc, int fr, int fq) const {
    const int gi = gbase + (u.pn >> 2);
    bf16_t* O = (bf16_t*)(ws + WS_S0 + (size_t)gi * SLOT);
    const int row0 = u.pm * 256 + wr * 64 + fr, col0 = (u.pn & 3) * 256 + wc * 32 + 8 * fq;
    f32x4 b[2][2];
#pragma unroll
    for (int bj = 0; bj < 2; ++bj)
#pragma unroll
      for (int n = 0; n < 2; ++n) b[bj][n] = (gi == 0) ? *(const f32x4*)(w0 + col0 + bj * 128 + 4 * n) : (gi == 1 ? *(const f32x4*)(a0 + col0 + bj * 128 + 4 * n) : (f32x4){0.f, 0.f, 0.f, 0.f});
#pragma unroll
    for (int ai = 0; ai < 2; ++ai)
#pragma unroll
      for (int m = 0; m < 4; ++m) { bf16_t* rowp = O + (size_t)(row0 + ai * 128 + m * 16) * DM + col0;
#pragma unroll
        for (int bj = 0; bj < 2; ++bj) { f32x4 v0 = acc[ai][bj][m][0] + b[bj][0], v1 = acc[ai][bj][m][1] + b[bj][1];
          if (gi == 0) {
#pragma unroll
            for (int i = 0; i < 4; ++i) { v0[i] = -__expf(-softplusf_(-v0[i]) - 0.5f); v1[i] = -__expf(-softplusf_(-v1[i]) - 0.5f); }
          } else if (gi == 1) {
#pragma unroll
            for (int i = 0; i < 4; ++i) { v0[i] = sigmoidf_(v0[i]); v1[i] = sigmoidf_(v1[i]); }
          }
          *(u32x4*)(rowp + bj * 128) = pack8(v0, v1); } }
  }
};
struct EpiMoeGU {
  static constexpr bool PERM = true, HAS_PRE = false;
  bf16_t* HID;
  __device__ __forceinline__ void operator()(const f32x4 (&acc)[2][2][4][2], const Unit& u, int wr, int wc, int fr, int fq) const {
    const int row0 = u.pm * 256 + wr * 64 + fr, col0 = (u.pn & 1) * 128 + wc * 32 + 8 * fq;
#pragma unroll
    for (int ai = 0; ai < 2; ++ai)
#pragma unroll
      for (int m = 0; m < 4; ++m) {
        f32x4 h[2];
#pragma unroll
        for (int n = 0; n < 2; ++n) { const f32x4 g = acc[ai][0][m][n], up = acc[ai][1][m][n];
#pragma unroll
          for (int i = 0; i < 4; ++i) h[n][i] = g[i] * sigmoidf_(g[i]) * up[i]; }
        *(u32x4*)(HID + (size_t)(row0 + ai * 128 + m * 16) * 256 + col0) = pack8(h[0], h[1]);
      }
  }
};
struct EpiMoeDown {
  static constexpr bool PERM = false, HAS_PRE = true;
  bf16_t* out; bf16_t* Y1; const int* list; const float* pgate; LAS int* ept;
  __device__ __forceinline__ void pre(const Unit& u) const {
    const int r = threadIdx.x;
    if (r < 256) { int pr = -1; float gt = 0.f;
      if (r < u.nrows) { pr = list[(size_t)u.e * CAP + u.rt * 256 + r]; gt = pgate[pr]; }
      LAS int* e = ept + (u.par * 256 + r) * 2; e[0] = pr; e[1] = __float_as_int(gt); }
  }
  __device__ __forceinline__ void operator()(const f32x4 (&acc)[2][2][4][2], const Unit& u, int wr, int wc, int fr, int fq) const {
    const int col0 = (u.pn & 3) * 256 + wc * 32 + 4 * fq;
#pragma unroll
    for (int ai = 0; ai < 2; ++ai)
#pragma unroll
      for (int m = 0; m < 4; ++m) {
        const int r = ai * 128 + wr * 64 + m * 16 + fr;
        const LAS int* e = ept + (u.par * 256 + r) * 2;
        const int pr = e[0]; const float gt = __int_as_float(e[1]);
        if (pr >= 0) {
          const int tok = pr >> 1;
          if ((pr & 1) == 0) {
            bf16_t* op = out + (size_t)tok * DM + col0;
#pragma unroll
            for (int bj = 0; bj < 2; ++bj)
#pragma unroll
              for (int n = 0; n < 2; ++n) { const v2u w = *(const v2u*)(op + bj * 128 + n * 16);
                const f32x4 b = {__uint_as_float(w.x << 16), __uint_as_float(w.x & 0xffff0000u), __uint_as_float(w.y << 16), __uint_as_float(w.y & 0xffff0000u)};
                const f32x4 v = b + acc[ai][bj][m][n] * gt; v2u o; o.x = pk2(v[0], v[1]); o.y = pk2(v[2], v[3]); *(v2u*)(op + bj * 128 + n * 16) = o; }
          } else {
            bf16_t* yp = Y1 + (size_t)tok * DM + col0;
#pragma unroll
            for (int bj = 0; bj < 2; ++bj)
#pragma unroll
              for (int n = 0; n < 2; ++n) { const f32x4 v = acc[ai][bj][m][n] * gt; v2u w; w.x = pk2(v[0], v[1]); w.y = pk2(v[2], v[3]); *(v2u*)(yp + bj * 128 + n * 16) = w; }
          }
        }
      }
  }
};

__device__ __forceinline__ void phase_prologue(PREF p, Frame& F) {
  const int lane = fresh_lane();
  LAS float* scr = (LAS float*)(F.lds + RING_OFF + F.wave * 16384);
  const int gw = F.vcu * NWAVES + F.wave, NGW = F.G * NWAVES;
  constexpr int I_WIN = 96 * 16, I_SQ = 32 * 16;
  constexpr int NITEMS = I_WIN + 5 * I_SQ + 128;
  for (int it = gw; it < NITEMS; it += NGW) {
    int r = it;
    if (r < I_WIN) { conv_win_item(p, r, scr, fresh_lane()); continue; } r -= I_WIN;
    if (r < I_SQ) { conv_sq_item(p.w_out, (bf16_t*)(p.ws + WS_WOUT), 0, r, scr, fresh_lane()); continue; } r -= I_SQ;
    if (r < I_SQ) { conv_sq_item(p.w_r, (bf16_t*)(p.ws + WS_WRKV), 0, r, scr, fresh_lane()); continue; } r -= I_SQ;
    if (r < I_SQ) { conv_sq_item(p.w_k, (bf16_t*)(p.ws + WS_WRKV), 1024, r, scr, fresh_lane()); continue; } r -= I_SQ;
    if (r < I_SQ) { conv_sq_item(p.w_v, (bf16_t*)(p.ws + WS_WRKV), 2048, r, scr, fresh_lane()); continue; } r -= I_SQ;
    if (r < I_SQ) { conv_sq_item(p.w_o, (bf16_t*)(p.ws + WS_WO), 0, r, scr, fresh_lane()); continue; } r -= I_SQ;
    { const int kv = r >> 6, q = r & 63, kb = q >> 1, cg = q & 1;
      transpose_item(p.cmp_w1 + (size_t)kv * 2048 * 64, 64, kb * 64, cg * 32, 32, (bf16_t*)(p.ws + WS_CW1) + (size_t)kv * 64 * 2048, 2048, cg * 32, scr, fresh_lane()); }
  }
  {
    const int gt = (F.vcu * NWAVES + F.wave) * 64 + fresh_lane(), NGT = NGW * 64;
    bf16_t* WL1 = (bf16_t*)(p.ws + WS_WL1);
    for (int i = gt; i < 768 * 1024; i += NGT) {
      const int n = i >> 10, k = i & 1023, gi = n >> 8, c = n & 255;
      float v = 0.f;
      if (gi == 0) { if (c < 64) v = p.w1[k * 64 + c]; }
      else if (gi == 1) { if (c < 64) v = p.a1[k * 64 + c]; }
      else { if (c < 160) v = p.g1[k * 160 + c]; }
      WL1[i] = (bf16_t)f2bf(v);
    }
    bf16_t* WL2w = (bf16_t*)(p.ws + WS_WL2);
    bf16_t* WL2a = (bf16_t*)(p.ws + WS_WL2 + 128 * 1024);
    bf16_t* WL2g = (bf16_t*)(p.ws + WS_WL2 + 256 * 1024);
    for (int i = gt; i < 1024 * 64; i += NGT) { const int n = i >> 6, k = i & 63; WL2w[i] = (bf16_t)f2bf(p.w2[k * 1024 + n]); WL2a[i] = (bf16_t)f2bf(p.a2[k * 1024 + n]); }
    for (int i = gt; i < 1024 * 192; i += NGT) { const int n = i / 192, k = i - n * 192; WL2g[i] = (bf16_t)f2bf(k < 160 ? p.g2[k * 1024 + n] : 0.f); }
  }
  bf16_t* XN = (bf16_t*)(p.ws + WS_XN);
  for (int m = gw; m < T_TOK; m += 4 * NGW) rms_rows_to_bf16<4>(p.x, p.mix_norm, XN, m, NGW, lane);
}


__device__ __forceinline__ f32x4 bf4(const v2u w) { return (f32x4){__uint_as_float(w.x << 16), __uint_as_float(w.x & 0xffff0000u), __uint_as_float(w.y << 16), __uint_as_float(w.y & 0xffff0000u)}; }
__device__ __forceinline__ void phase_router(PREF p, Frame& F, int layer) {
  const int gw = F.vcu * NWAVES + F.wave, NGW = F.G * NWAVES;
  const int lane = fresh_lane();
  PROBE_MARK(100 + layer * 10);
  {
    LAS float* scr = (LAS float*)(F.lds + RING_OFF + F.wave * 16384);
    for (int it = gw; it < 32 * 384; it += NGW) conv_expert_item(p, layer, it, scr, lane);
  }
  __syncthreads();
  PROBE_MARK(101 + layer * 10);
  LAS float* WQ = (LAS float*)(F.lds);
  LAS float* XS = (LAS float*)(F.lds + 40960) + F.wave * 2080;
  LAS float* LG = (LAS float*)(F.lds + 107520) + F.wave * 8 * 36;
  const float* gain = p.ffn_norm + layer * DM;
  const float* wg = p.rg_w + (size_t)layer * DM * 4;
  const float* we = p.re_w + (size_t)layer * DM * 32;
  bf16_t* XN2 = (bf16_t*)(p.ws + WS_XN2);
  f32x4 v[8][4];
  const bf16_t* xres = layer ? (const bf16_t*)(p.ws + WS_X3) : (const bf16_t*)p.out;
#pragma unroll
  for (int tt = 0; tt < 8; ++tt) { const GAS v2u* xr = (const GAS v2u*)(xres + (size_t)(gw * 8 + tt) * DM) + lane;
#pragma unroll
    for (int j = 0; j < 4; ++j) v[tt][j] = bf4(xr[64 * j]); }
  {
    f32x4 g[4];
#pragma unroll
    for (int j = 0; j < 4; ++j) g[j] = ((const GAS f32x4*)gain)[lane + 64 * j];
#pragma unroll
    for (int tt = 0; tt < 8; ++tt) {
      float s = 0.f;
#pragma unroll
      for (int j = 0; j < 4; ++j) s += (v[tt][j].x * v[tt][j].x + v[tt][j].y * v[tt][j].y) + (v[tt][j].z * v[tt][j].z + v[tt][j].w * v[tt][j].w);
      const float r = rsqrtf(wave_sum_dpp(s) * (1.f / DM) + 1e-6f);
      GAS v2u* o = (GAS v2u*)(XN2 + (size_t)(gw * 8 + tt) * DM) + lane;
#pragma unroll
      for (int j = 0; j < 4; ++j) { v[tt][j] = v[tt][j] * r * g[j]; v2u w; w.x = pk2(v[tt][j].x, v[tt][j].y); w.y = pk2(v[tt][j].z, v[tt][j].w); o[64 * j] = w; }
    }
  }
  PROBE_MARK(102 + layer * 10);
  f32x4 acc[3];
#pragma unroll
  for (int nt = 0; nt < 3; ++nt) acc[nt] = (f32x4){0.f, 0.f, 0.f, 0.f};
  const int r16 = lane & 15, g4 = lane >> 4;
#pragma unroll
  for (int j = 0; j < 4; ++j) {
    __syncthreads();
    for (int idx = F.tid; idx < 256 * 9; idx += NWAVES * 64) {
      const int row = idx / 9, c4 = idx - row * 9, k = 256 * j + row;
      const f32x4 val = (c4 == 0) ? *(const GAS f32x4*)(wg + k * 4) : *(const GAS f32x4*)(we + k * 32 + (c4 - 1) * 4);
      *(LAS f32x4*)(WQ + row * 36 + c4 * 4) = val;
    }
#pragma unroll
    for (int tt = 0; tt < 8; ++tt) *(LAS f32x4*)(XS + tt * 260 + 4 * lane) = v[tt][j];
    __syncthreads();
    const LAS float* xa = XS + (r16 & 7) * 260 + g4;
    const LAS float* wb = WQ + g4 * 36 + r16;
#pragma unroll 4
    for (int ks = 0; ks < 64; ++ks) {
      const float a = xa[4 * ks];
#pragma unroll
      for (int nt = 0; nt < 3; ++nt) acc[nt] = __builtin_amdgcn_mfma_f32_16x16x4f32(a, wb[4 * ks * 36 + nt * 16], acc[nt], 0, 0, 0);
    }
  }
  PROBE_MARK(103 + layer * 10);
  if (g4 < 2) {
#pragma unroll
    for (int nt = 0; nt < 3; ++nt) { const int n = nt * 16 + r16;
      if (n < 36) {
#pragma unroll
        for (int i = 0; i < 4; ++i) LG[(4 * g4 + i) * 36 + n] = acc[nt][i]; } }
  }
  LAS unsigned* LC = (LAS unsigned*)(F.lds + 118784);
  if (F.tid < 64) LC[F.tid] = 0u;
  __syncthreads();
  int ea = 0, eb = 0; unsigned la = 0, lb = 0; float ga = 0.f, gb = 0.f;
  if (lane < 8) {
    const LAS float* lg = LG + lane * 36;
    const float* bg = p.rg_b + layer * 4;
    const float* be = p.re_b + layer * 32;
    float gl[4]; int gi = 0; float gm = -3.4e38f;
#pragma unroll
    for (int i = 0; i < 4; i++) { gl[i] = lg[i] + bg[i]; if (gl[i] > gm) { gm = gl[i]; gi = i; } }
    float gs = 0.f;
#pragma unroll
    for (int i = 0; i < 4; i++) gs += __expf(gl[i] - gm);
    const float grp_p = 1.f / gs;
    float v0 = -3.4e38f, v1 = -3.4e38f; int i0 = 0, i1 = 0;
    for (int i = 0; i < 8; i++) {
      const float v = lg[4 + gi * 8 + i] + be[gi * 8 + i];
      if (v > v0) { v1 = v0; i1 = i0; v0 = v; i0 = i; }
      else if (v > v1) { v1 = v; i1 = i; }
    }
    const float e1 = __expf(v1 - v0);
    ga = grp_p / (1.f + e1); gb = grp_p * e1 / (1.f + e1);
    ea = gi * 8 + i0; eb = gi * 8 + i1;
    la = __hip_atomic_fetch_add(LC + ea, 1u, __ATOMIC_RELAXED, __HIP_MEMORY_SCOPE_WORKGROUP);
    lb = __hip_atomic_fetch_add(LC + eb, 1u, __ATOMIC_RELAXED, __HIP_MEMORY_SCOPE_WORKGROUP);
  }
  __syncthreads();
  if (F.tid < 32) { const unsigned n = LC[F.tid];
    unsigned* cnt = (unsigned*)(p.ws + WS_CTL) + CW_CNT + (layer * 32 + F.tid) * 64;
    LC[32 + F.tid] = n ? __hip_atomic_fetch_add(cnt, n, __ATOMIC_RELAXED, __HIP_MEMORY_SCOPE_AGENT) : 0u; }
  __syncthreads();
  if (lane < 8) {
    const int t = gw * 8 + lane;
    int* list = (int*)(p.ws + WS_LIST); float* pgate = (float*)(p.ws + WS_PGATE);
    list[(size_t)ea * CAP + LC[32 + ea] + la] = 2 * t; pgate[2 * t] = ga;
    list[(size_t)eb * CAP + LC[32 + eb] + lb] = 2 * t + 1; pgate[2 * t + 1] = gb;
  }
  PROBE_MARK(104 + layer * 10);
}

__device__ __forceinline__ void phase_final(PREF p, Frame& F) {
  const int gw = F.vcu * NWAVES + F.wave, NGW = F.G * NWAVES;
  const int lane = fresh_lane();
  const bf16_t* Y1 = (const bf16_t*)(p.ws + WS_Y1);
  const bf16_t* X3 = (const bf16_t*)(p.ws + WS_X3);
  for (int t = gw; t < T_TOK; t += NGW) {
    GAS f32x4* xo = (GAS f32x4*)(p.out + (size_t)t * DM) + lane;
    const GAS v2u* xr = (const GAS v2u*)(X3 + (size_t)t * DM) + lane;
    const GAS v2u* yr = (const GAS v2u*)(Y1 + (size_t)t * DM) + lane;
#pragma unroll
    for (int j = 0; j < 4; ++j) xo[64 * j] = bf4(xr[64 * j]) + bf4(yr[64 * j]);
  }
}

__device__ __forceinline__ void up8(const v4u w, float (&o)[8]) {
  o[0] = __uint_as_float(w.x << 16); o[1] = __uint_as_float(w.x & 0xffff0000u); o[2] = __uint_as_float(w.y << 16); o[3] = __uint_as_float(w.y & 0xffff0000u);
  o[4] = __uint_as_float(w.z << 16); o[5] = __uint_as_float(w.z & 0xffff0000u); o[6] = __uint_as_float(w.w << 16); o[7] = __uint_as_float(w.w & 0xffff0000u);
}
__device__ __forceinline__ void phase_rwkv_prep(PREF p, Frame& F) {
  const int gw = F.vcu * NWAVES + F.wave, NGW = F.G * NWAVES;
  const int lane = fresh_lane();
  const float* gain = p.mix_norm + DM;
  const bf16_t* X1 = (const bf16_t*)p.out;
  const bf16_t* Y1 = (const bf16_t*)(p.ws + WS_Y1);
  float g[2][8];
#pragma unroll
  for (int c = 0; c < 2; ++c) { const f32x4 a = *(const GAS f32x4*)(gain + c * 512 + lane * 8), b = *(const GAS f32x4*)(gain + c * 512 + lane * 8 + 4);
    g[c][0] = a.x; g[c][1] = a.y; g[c][2] = a.z; g[c][3] = a.w; g[c][4] = b.x; g[c][5] = b.y; g[c][6] = b.z; g[c][7] = b.w; }
  for (int run = gw; run < T_TOK / 8; run += NGW) {
    const int t0 = run * 8;
    float prev[2][8];
    if ((t0 & (SEQ - 1)) == 0) {
#pragma unroll
      for (int c = 0; c < 2; ++c)
#pragma unroll
        for (int i = 0; i < 8; ++i) prev[c][i] = 0.f;
    } else {
      float s = 0.f;
#pragma unroll
      for (int c = 0; c < 2; ++c) { float xa[8], ya[8];
        up8(*(const GAS v4u*)(X1 + (size_t)(t0 - 1) * DM + c * 512 + lane * 8), xa); up8(*(const GAS v4u*)(Y1 + (size_t)(t0 - 1) * DM + c * 512 + lane * 8), ya);
#pragma unroll
        for (int i = 0; i < 8; ++i) { prev[c][i] = xa[i] + ya[i]; s += prev[c][i] * prev[c][i]; } }
      const float r = rsqrtf(wave_sum_dpp(s) * (1.f / DM) + 1e-6f);
#pragma unroll
      for (int c = 0; c < 2; ++c)
#pragma unroll
        for (int i = 0; i < 8; ++i) prev[c][i] *= r * g[c][i];
    }
    v4u nx[2], ny[2];
#pragma unroll
    for (int c = 0; c < 2; ++c) { nx[c] = *(const GAS v4u*)(X1 + (size_t)t0 * DM + c * 512 + lane * 8); ny[c] = *(const GAS v4u*)(Y1 + (size_t)t0 * DM + c * 512 + lane * 8); }
#pragma unroll 1
    for (int tt = 0; tt < 8; ++tt) {
      const int t = t0 + tt;
      float v[2][8]; float s = 0.f;
#pragma unroll
      for (int c = 0; c < 2; ++c) { float xa[8], ya[8]; up8(nx[c], xa); up8(ny[c], ya);
#pragma unroll
        for (int i = 0; i < 8; ++i) { v[c][i] = xa[i] + ya[i]; s += v[c][i] * v[c][i]; } }
      if (tt < 7) {
#pragma unroll
        for (int c = 0; c < 2; ++c) { nx[c] = *(const GAS v4u*)(X1 + (size_t)(t + 1) * DM + c * 512 + lane * 8); ny[c] = *(const GAS v4u*)(Y1 + (size_t)(t + 1) * DM + c * 512 + lane * 8); } }
      const float r = rsqrtf(wave_sum_dpp(s) * (1.f / DM) + 1e-6f);
#pragma unroll
      for (int c = 0; c < 2; ++c)
#pragma unroll
        for (int i = 0; i < 8; ++i) v[c][i] *= r * g[c][i];
#pragma unroll
      for (int sl = 0; sl < 6; ++sl) {
        const int mj = (sl == 0) ? 0 : (sl == 1) ? 2 : (sl == 2) ? 3 : (sl == 3) ? 1 : (sl == 4) ? 4 : 5;
        bf16_t* o = (bf16_t*)(p.ws + WS_S0 + (size_t)sl * SLOT) + (size_t)t * DM;
#pragma unroll
        for (int c = 0; c < 2; ++c) {
          const f32x4 ma = *(const GAS f32x4*)(p.rmix + mj * DM + c * 512 + lane * 8), mb = *(const GAS f32x4*)(p.rmix + mj * DM + c * 512 + lane * 8 + 4);
          const float mx[8] = {ma.x, ma.y, ma.z, ma.w, mb.x, mb.y, mb.z, mb.w};
          float q[8];
#pragma unroll
          for (int i = 0; i < 8; ++i) q[i] = v[c][i] + (prev[c][i] - v[c][i]) * mx[i];
          v4u w; w.x = pk2(q[0], q[1]); w.y = pk2(q[2], q[3]); w.z = pk2(q[4], q[5]); w.w = pk2(q[6], q[7]);
          *(GAS v4u*)(o + c * 512 + lane * 8) = w;
        }
      }
#pragma unroll
      for (int c = 0; c < 2; ++c)
#pragma unroll
        for (int i = 0; i < 8; ++i) prev[c][i] = v[c][i];
    }
  }
}

constexpr int RP = 72;
constexpr int RB = 64 * RP * 2;
typedef LAS bf16_t* lbf;

__device__ __forceinline__ f32x4 mm16(f32x4 acc, const LAS bf16_t* A, int arow0, const LAS bf16_t* Bt, int brow0, int lane) {
  const int r = lane & 15, q = lane >> 4;
#pragma unroll
  for (int ks = 0; ks < 2; ++ks) {
    const bf16x8 a = *(const LAS bf16x8*)(A + (arow0 + r) * RP + ks * 32 + q * 8);
    const bf16x8 b = *(const LAS bf16x8*)(Bt + (brow0 + r) * RP + ks * 32 + q * 8);
    acc = __builtin_amdgcn_mfma_f32_16x16x32_bf16(a, b, acc, 0, 0, 0);
  }
  return acc;
}
__device__ __forceinline__ float sum8(float v) {
  v += __shfl_xor(v, 1, 64); v += __shfl_xor(v, 2, 64); v += __shfl_xor(v, 4, 64); return v;
}
__device__ __forceinline__ void ld8bf(const bf16_t* p, float (&o)[8]) {
  const v4u w = *(const GAS v4u*)p;
  o[0] = __uint_as_float(w.x << 16); o[1] = __uint_as_float(w.x & 0xffff0000u); o[2] = __uint_as_float(w.y << 16); o[3] = __uint_as_float(w.y & 0xffff0000u);
  o[4] = __uint_as_float(w.z << 16); o[5] = __uint_as_float(w.z & 0xffff0000u); o[6] = __uint_as_float(w.w << 16); o[7] = __uint_as_float(w.w & 0xffff0000u);
}
__device__ __forceinline__ v4u pk8(const float (&o)[8]) { v4u w; w.x = pk2(o[0], o[1]); w.y = pk2(o[2], o[3]); w.z = pk2(o[4], o[5]); w.w = pk2(o[6], o[7]); return w; }

#define R1_BAR() do { asm volatile("s_waitcnt lgkmcnt(0)" ::: "memory"); __builtin_amdgcn_s_barrier(); asm volatile("" ::: "memory"); } while (0)
__device__ __forceinline__ void stT(LAS bf16_t* Dst, int x0, int y0, const f32x4& acc, int lane) {
  v2u w; w.x = pk2(acc[0], acc[1]); w.y = pk2(acc[2], acc[3]);
  *(LAS v2u*)(Dst + (x0 + (lane & 15)) * RP + y0 + (lane >> 4) * 4) = w;
}
struct R1In { v4u r, ld, k, v, a; f32x4 kk0, kk1, ka0, ka1, rk0, rk1; };
__device__ __forceinline__ R1In rwkv_r1_load(PREF p, int item, int tid) {
  const int ch = item >> 6, c = item & 63, b = ch >> 4, hd = ch & 15;
  const size_t off = ((size_t)(b * SEQ + c * 64 + (tid >> 3)) * DM + hd * 64 + (tid & 7) * 8);
  const bf16_t* s0 = (const bf16_t*)(p.ws + WS_S0);
  R1In in;
  in.r = *(const GAS v4u*)(s0 + 3 * (SLOT / 2) + off); in.ld = *(const GAS v4u*)(s0 + off); in.k = *(const GAS v4u*)(s0 + 4 * (SLOT / 2) + off);
  in.v = *(const GAS v4u*)(s0 + 5 * (SLOT / 2) + off); in.a = *(const GAS v4u*)(s0 + (SLOT / 2) + off);
  const int cc0 = hd * 64 + (tid & 7) * 8;
  in.kk0 = *(const GAS f32x4*)(p.k_k + cc0); in.kk1 = *(const GAS f32x4*)(p.k_k + cc0 + 4); in.ka0 = *(const GAS f32x4*)(p.k_a + cc0); in.ka1 = *(const GAS f32x4*)(p.k_a + cc0 + 4);
  in.rk0 = *(const GAS f32x4*)(p.r_k + cc0); in.rk1 = *(const GAS f32x4*)(p.r_k + cc0 + 4);
  return in;
}
__device__ __forceinline__ void un8(const v4u w, float (&o)[8]) {
  o[0] = __uint_as_float(w.x << 16); o[1] = __uint_as_float(w.x & 0xffff0000u); o[2] = __uint_as_float(w.y << 16); o[3] = __uint_as_float(w.y & 0xffff0000u);
  o[4] = __uint_as_float(w.z << 16); o[5] = __uint_as_float(w.z & 0xffff0000u); o[6] = __uint_as_float(w.w << 16); o[7] = __uint_as_float(w.w & 0xffff0000u);
}
__device__ __forceinline__ void rwkv_r1_item(PREF p, Frame& F, int item, const R1In& in) {
  const int tid = F.tid, lane = fresh_lane(), w = F.wave;
  const int ch = item >> 6, c = item & 63, b = ch >> 4, hd = ch & 15;
  const size_t tile0 = ((size_t)(b * SEQ + c * 64) * DM + hd * 64);
  unsigned char* ws = p.ws;
  bf16_t* SL[6];
#pragma unroll
  for (int s = 0; s < 6; ++s) SL[s] = (bf16_t*)(ws + WS_S0 + (size_t)s * SLOT) + tile0;
  const lbf BtT = (lbf)(F.lds + 0 * RB), KtT = (lbf)(F.lds + 1 * RB), AbT = (lbf)(F.lds + 2 * RB), RbT = (lbf)(F.lds + 3 * RB);
  const lbf Ab = (lbf)(F.lds + 4 * RB), Vc = (lbf)(F.lds + 5 * RB), Bh = (lbf)(F.lds + 6 * RB), Kh = (lbf)(F.lds + 7 * RB);
  const lbf Tk = (lbf)(F.lds + 8 * RB), WbT = (lbf)(F.lds + 9 * RB), WkT = (lbf)(F.lds + 10 * RB);
  const lbf X = BtT, XT = KtT, Pb = AbT;
  const lbf At = X, TNT = XT, U0 = Tk;
  LAS float* Lf = (LAS float*)(F.lds + 11 * RB);
  LAS float* SEG = Lf + 64 * 65;
  LAS float* GC = (LAS float*)(F.lds + 14 * RB);
#if defined(PROBE_PH) && PROBE_PH == 301
  const unsigned long long _sa0 = __builtin_amdgcn_s_memrealtime();
#endif
  const int t = tid >> 3, cg = tid & 7, k0 = cg * 8;
  float r_[8], ld_[8], kx[8], v_[8], a_[8];
  un8(in.r, r_); un8(in.ld, ld_); un8(in.k, kx); un8(in.v, v_); un8(in.a, a_);
  float kk[8], km[8], be[8];
  {
    float ss = 0.f, bo = 0.f;
#pragma unroll
    for (int i = 0; i < 8; ++i) { const float ckk = (i < 4) ? in.kk0[i & 3] : in.kk1[i & 3], cka = (i < 4) ? in.ka0[i & 3] : in.ka1[i & 3], crk = (i < 4) ? in.rk0[i & 3] : in.rk1[i & 3];
      kk[i] = kx[i] * ckk; ss += kk[i] * kk[i]; km[i] = kx[i] * (1.f + (a_[i] - 1.f) * cka); bo += r_[i] * km[i] * crk; }
    ss = sum8(ss); bo = sum8(bo);
    const float inv = 1.f / fmaxf(sqrtf(ss), 1e-12f);
#pragma unroll
    for (int i = 0; i < 8; ++i) { kk[i] *= inv; be[i] = kk[i] * a_[i]; }
    if (cg == 0) ((float*)(ws + WS_TMP))[(size_t)item * 64 + t] = bo;
  }
#pragma unroll
  for (int i = 0; i < 8; ++i) Lf[t * 65 + k0 + i] = ld_[i];
  R1_BAR();
  {
    const int k = tid & 63, sg = tid >> 6;
    float run = 0.f;
#pragma unroll
    for (int i = 0; i < 8; ++i) { run += Lf[(sg * 8 + i) * 65 + k]; Lf[(sg * 8 + i) * 65 + k] = run; }
    SEG[sg * 64 + k] = run;
    R1_BAR();
    float off = 0.f;
    for (int j = 0; j < sg; ++j) off += SEG[j * 64 + k];
#pragma unroll
    for (int i = 0; i < 8; ++i) Lf[(sg * 8 + i) * 65 + k] += off;
  }
  R1_BAR();
  {
    float ab[8], bt[8], kt[8], rb[8], bh[8], kh[8];
#pragma unroll
    for (int i = 0; i < 8; ++i) {
      const float Lt = Lf[t * 65 + k0 + i], Lp = (t > 0) ? Lf[(t - 1) * 65 + k0 + i] : 0.f, LC = Lf[63 * 65 + k0 + i];
      const float et = __expf(Lt), ei = __builtin_amdgcn_rcpf(et), eh = __expf(LC) * ei;
      if (t == 63) GC[k0 + i] = et;
      ab[i] = -kk[i] * __expf(Lp); bt[i] = be[i] * ei; kt[i] = km[i] * ei; rb[i] = r_[i] * et; bh[i] = be[i] * eh; kh[i] = km[i] * eh;
    }
    *(LAS v4u*)(BtT + t * RP + k0) = pk8(bt); *(LAS v4u*)(KtT + t * RP + k0) = pk8(kt); *(LAS v4u*)(AbT + t * RP + k0) = pk8(ab); *(LAS v4u*)(RbT + t * RP + k0) = pk8(rb);
    {
      float ra[8], rv[8], rb[8], rkh[8];
#pragma unroll
      for (int i = 0; i < 8; ++i) { ra[i] = ab[i]; rv[i] = v_[i]; rb[i] = bh[i]; rkh[i] = kh[i]; }
#pragma unroll
      for (int sh = 1; sh < 8; sh <<= 1) {
        const bool on = (cg & sh) != 0;
        float ta[8], tv[8], tb[8], tk[8];
#pragma unroll
        for (int i = 0; i < 8; ++i) { ta[i] = on ? ra[(i + sh) & 7] : ra[i]; tv[i] = on ? rv[(i + sh) & 7] : rv[i]; tb[i] = on ? rb[(i + sh) & 7] : rb[i]; tk[i] = on ? rkh[(i + sh) & 7] : rkh[i]; }
#pragma unroll
        for (int i = 0; i < 8; ++i) { ra[i] = ta[i]; rv[i] = tv[i]; rb[i] = tb[i]; rkh[i] = tk[i]; }
      }
#pragma unroll
      for (int i = 0; i < 8; ++i) { const int row = k0 + ((i + cg) & 7);
        Ab[row * RP + t] = (bf16_t)f2bf(ra[i]); Vc[row * RP + t] = (bf16_t)f2bf(rv[i]); Bh[row * RP + t] = (bf16_t)f2bf(rb[i]); Kh[row * RP + t] = (bf16_t)f2bf(rkh[i]); }
    }
  }
  R1_BAR();
#if defined(PROBE_PH) && PROBE_PH == 301
  F.pr_t1 += __builtin_amdgcn_s_memrealtime() - _sa0;
#endif
  const int ya = (w >> 1) * 16, xb0 = (w & 1) * 32;
  const int cr = lane & 15, q4 = (lane >> 4) * 4;
  const f32x4 Z4 = {0.f, 0.f, 0.f, 0.f};
  const lbf X1 = (lbf)(F.lds + 11 * RB), XT1 = (lbf)(F.lds + 12 * RB), Pb1 = (lbf)(F.lds + 13 * RB);
  f32x4 accP[2];
  {
    f32x4 tabn[2], tabs[2], taks[2], wbr[2], wkr[2];
#pragma unroll
    for (int j = 0; j < 2; ++j) { const int xb = xb0 + 16 * j;
      tabn[j] = mm16(Z4, BtT, ya, AbT, xb, lane);
      tabs[j] = mm16(Z4, AbT, ya, BtT, xb, lane);
      taks[j] = mm16(Z4, AbT, ya, KtT, xb, lane);
      wbr[j] = mm16(Z4, BtT, ya, RbT, xb, lane);
      wkr[j] = mm16(Z4, KtT, ya, RbT, xb, lane); }
#pragma unroll
    for (int j = 0; j < 2; ++j) { const int xb = xb0 + 16 * j;
      f32x4 xt, xr, pr, tk, wb, wk;
#pragma unroll
      for (int i = 0; i < 4; ++i) {
        { const int s = ya + q4 + i, tt = xb + cr; xt[i] = (s < tt) ? tabn[j][i] : 0.f; wb[i] = (s <= tt) ? wbr[j][i] : 0.f; wk[i] = (s <= tt) ? wkr[j][i] : 0.f; }
        { const int tt = ya + q4 + i, s = xb + cr; xr[i] = (s < tt) ? tabs[j][i] : 0.f; pr[i] = xr[i] + ((s == tt) ? 1.f : 0.f); tk[i] = (s < tt) ? taks[j][i] : 0.f; }
      }
      accP[j] = pr;
      stT(XT1, xb, ya, xt, lane); stT(WbT, xb, ya, wb, lane); stT(WkT, xb, ya, wk, lane);
      stT(X1, xb, ya, xr, lane); stT(Pb1, xb, ya, pr, lane); stT(Tk, xb, ya, tk, lane); }
  }
  R1_BAR();
#pragma unroll 1
  for (int st = 0; st < 5; ++st) {
    const lbf Xs = (st & 1) ? X : X1, XTs = (st & 1) ? XT : XT1, Pbs = (st & 1) ? Pb : Pb1;
    const lbf Xd = (st & 1) ? X1 : X, XTd = (st & 1) ? XT1 : XT, Pbd = (st & 1) ? Pb1 : Pb;
    f32x4 xr[2], xt[2];
#pragma unroll
    for (int j = 0; j < 2; ++j) { const int xb = xb0 + 16 * j;
      xr[j] = mm16(Z4, XTs, ya, Xs, xb, lane);
      xt[j] = mm16(Z4, Xs, ya, XTs, xb, lane);
      if (st > 0) accP[j] = mm16(accP[j], XTs, ya, Pbs, xb, lane); }
#pragma unroll
    for (int j = 0; j < 2; ++j) { const int xb = xb0 + 16 * j; stT(Xd, xb, ya, xr[j], lane); stT(XTd, xb, ya, xt[j], lane); stT(Pbd, xb, ya, accP[j], lane); }
    R1_BAR();
  }
  const lbf NT = Pb1;
  {
    f32x4 nt[2];
#pragma unroll
    for (int j = 0; j < 2; ++j) { const int xb = xb0 + 16 * j; nt[j] = mm16(Z4, Pb, ya, XT, xb, lane);
#pragma unroll
      for (int i = 0; i < 4; ++i) nt[j][i] += bf2f(Pb[(ya + q4 + i) * RP + xb + cr]); }
#pragma unroll
    for (int j = 0; j < 2; ++j) stT(NT, xb0 + 16 * j, ya, nt[j], lane);
    R1_BAR();
  }
  {
    f32x4 at[2], tn[2];
#pragma unroll
    for (int j = 0; j < 2; ++j) { const int xb = xb0 + 16 * j; at[j] = mm16(Z4, NT, ya, Ab, xb, lane); tn[j] = mm16(Z4, Tk, ya, NT, xb, lane); }
#pragma unroll
    for (int j = 0; j < 2; ++j) { const int xb = xb0 + 16 * j; stT(At, xb, ya, at[j], lane); stT(TNT, xb, ya, tn[j], lane); }
  }
  R1_BAR();
  const lbf O_RT = (lbf)(F.lds + 11 * RB), O_PM = (lbf)(F.lds + 12 * RB), O_Y0 = (lbf)(F.lds + 13 * RB), O_Q = (lbf)(F.lds + 3 * RB)  ;
  {
    f32x4 u0[2], rt[2], pm[2];
#pragma unroll
    for (int j = 0; j < 2; ++j) { const int xb = xb0 + 16 * j;
      u0[j] = mm16(Z4, TNT, ya, Vc, xb, lane);
      rt[j] = mm16(Z4, At, ya, WbT, xb, lane);
      pm[j] = mm16(Z4, At, ya, Bh, xb, lane);
      const v2u rbw = *(const LAS v2u*)(RbT + (xb + cr) * RP + ya + q4);
      rt[j][0] += __uint_as_float(rbw.x << 16); rt[j][1] += __uint_as_float(rbw.x & 0xffff0000u); rt[j][2] += __uint_as_float(rbw.y << 16); rt[j][3] += __uint_as_float(rbw.y & 0xffff0000u);
#pragma unroll
      for (int i = 0; i < 4; ++i) if (ya + q4 + i == xb + cr) pm[j][i] += GC[xb + cr]; }
#pragma unroll
    for (int j = 0; j < 2; ++j) { const int xb = xb0 + 16 * j; stT(U0, xb, ya, u0[j], lane); stT(O_RT, xb, ya, rt[j], lane); stT(O_PM, xb, ya, pm[j], lane); }
  }
  R1_BAR();
  {
    f32x4 y0[2], qq[2];
#pragma unroll
    for (int j = 0; j < 2; ++j) { const int xb = xb0 + 16 * j;
      y0[j] = mm16(mm16(Z4, U0, ya, WbT, xb, lane), Vc, ya, WkT, xb, lane);
      qq[j] = mm16(mm16(Z4, Bh, ya, U0, xb, lane), Kh, ya, Vc, xb, lane); }
#pragma unroll
    for (int j = 0; j < 2; ++j) { const int xb = xb0 + 16 * j; stT(O_Y0, xb, ya, y0[j], lane); stT(O_Q, xb, ya, qq[j], lane); }
  }
  R1_BAR();
  {
    const int row = tid >> 3, pc = (tid & 7) * 8;
    *(GAS v4u*)(SL[3] + (size_t)row * DM + pc) = *(const LAS v4u*)(O_RT + row * RP + pc);
    *(GAS v4u*)(SL[0] + (size_t)row * DM + pc) = *(const LAS v4u*)(O_PM + row * RP + pc);
    *(GAS v4u*)(SL[4] + (size_t)row * DM + pc) = *(const LAS v4u*)(O_Y0 + row * RP + pc);
    *(GAS v4u*)(SL[1] + (size_t)row * DM + pc) = *(const LAS v4u*)(O_Q + row * RP + pc);
  }
  R1_BAR();
}

__device__ __forceinline__ void phase_rwkv_r1(PREF p, Frame& F) {
  int item = F.vcu;
  if (item >= 4096) return;
  R1In nxt = rwkv_r1_load(p, item, F.tid);
  for (; item < 4096; item += F.G) {
    const R1In cur = nxt;
    if (item + F.G < 4096) nxt = rwkv_r1_load(p, item + F.G, F.tid);
    rwkv_r1_item(p, F, item, cur);
  }
}

__device__ __forceinline__ void phase_rwkv_r2(PREF p, Frame& F) {
  if (F.wave != 0) return;
  const int lane = fresh_lane();
  const lbf Sh = (lbf)(F.lds), Sl = (lbf)(F.lds + 16 * RP * 2);
  const int cr = lane & 15, g = lane >> 4;
  for (int task = F.vcu; task < 256; task += F.G) {
    const int ch = task >> 2, jb = task & 3, b = ch >> 4, hd = ch & 15;
    const bf16_t* PM = (const bf16_t*)(p.ws + WS_S0) + ((size_t)(b * SEQ) * DM + hd * 64);
    bf16_t* QS = (bf16_t*)(p.ws + WS_S0 + SLOT) + ((size_t)(b * SEQ) * DM + hd * 64);
    for (int i = lane; i < 16 * RP; i += 64) { Sh[i] = 0; Sl[i] = 0; }
    const bf16_t* pmp = PM + (size_t)cr * DM + g * 8;
    bf16_t* qsp = QS + (size_t)(16 * jb + cr) * DM + g * 4;
    bf16x8 pa[4][4][2]; v2u qv[4][4];
#pragma unroll
    for (int d = 0; d < 4; ++d)
#pragma unroll
      for (int ct = 0; ct < 4; ++ct) { pa[d][ct][0] = *(const GAS bf16x8*)(pmp + (size_t)(d * 64 + 16 * ct) * DM); pa[d][ct][1] = *(const GAS bf16x8*)(pmp + (size_t)(d * 64 + 16 * ct) * DM + 32);
        qv[d][ct] = *(const GAS v2u*)(qsp + (size_t)d * 64 * DM + 16 * ct); }
    asm volatile("s_waitcnt lgkmcnt(0)" ::: "memory");
#pragma unroll 1
    for (int c4 = 0; c4 < 64; c4 += 4) {
#pragma unroll
      for (int d = 0; d < 4; ++d) {
        const int c = c4 + d;
        const bf16x8 bh0 = *(const LAS bf16x8*)(Sh + cr * RP + g * 8), bh1 = *(const LAS bf16x8*)(Sh + cr * RP + 32 + g * 8);
        const bf16x8 bl0 = *(const LAS bf16x8*)(Sl + cr * RP + g * 8), bl1 = *(const LAS bf16x8*)(Sl + cr * RP + 32 + g * 8);
        f32x4 acc[4];
#pragma unroll
        for (int ct = 0; ct < 4; ++ct) {
          acc[ct] = (f32x4){__uint_as_float(qv[d][ct].x << 16), __uint_as_float(qv[d][ct].x & 0xffff0000u), __uint_as_float(qv[d][ct].y << 16), __uint_as_float(qv[d][ct].y & 0xffff0000u)};
          acc[ct] = __builtin_amdgcn_mfma_f32_16x16x32_bf16(pa[d][ct][0], bh0, acc[ct], 0, 0, 0);
          acc[ct] = __builtin_amdgcn_mfma_f32_16x16x32_bf16(pa[d][ct][1], bh1, acc[ct], 0, 0, 0);
          acc[ct] = __builtin_amdgcn_mfma_f32_16x16x32_bf16(pa[d][ct][0], bl0, acc[ct], 0, 0, 0);
          acc[ct] = __builtin_amdgcn_mfma_f32_16x16x32_bf16(pa[d][ct][1], bl1, acc[ct], 0, 0, 0);
        }
        if (c + 4 < 64) {
#pragma unroll
          for (int ct = 0; ct < 4; ++ct) { pa[d][ct][0] = *(const GAS bf16x8*)(pmp + (size_t)((c + 4) * 64 + 16 * ct) * DM); pa[d][ct][1] = *(const GAS bf16x8*)(pmp + (size_t)((c + 4) * 64 + 16 * ct) * DM + 32);
            qv[d][ct] = *(const GAS v2u*)(qsp + (size_t)(c + 4) * 64 * DM + 16 * ct); }
        }
#pragma unroll
        for (int ct = 0; ct < 4; ++ct) {
          v2u hi; hi.x = pk2(acc[ct][0], acc[ct][1]); hi.y = pk2(acc[ct][2], acc[ct][3]);
          const float l0 = acc[ct][0] - __uint_as_float(hi.x << 16), l1 = acc[ct][1] - __uint_as_float(hi.x & 0xffff0000u), l2 = acc[ct][2] - __uint_as_float(hi.y << 16), l3 = acc[ct][3] - __uint_as_float(hi.y & 0xffff0000u);
          v2u lo; lo.x = pk2(l0, l1); lo.y = pk2(l2, l3);
          *(LAS v2u*)(Sh + cr * RP + 16 * ct + g * 4) = hi; *(LAS v2u*)(Sl + cr * RP + 16 * ct + g * 4) = lo;
          *(GAS v2u*)(qsp + (size_t)c * 64 * DM + 16 * ct) = hi;
        }
        asm volatile("s_waitcnt lgkmcnt(0)" ::: "memory");
      }
    }
  }
}

__device__ __forceinline__ void phase_rwkv_r3(PREF p, Frame& F) {
  const int lane = fresh_lane(), w = F.wave;
  const int cr = lane & 15, q4 = (lane >> 4) * 4, q = lane >> 4;
  const int half = w >> 2, tb = w & 3;
  LAS bf16_t* stg = (LAS bf16_t*)(F.lds) + w * 16 * RP;
  for (int it2 = F.vcu; it2 < 2048; it2 += F.G) {
    const int item = it2 * 2 + half;
    const int ch = item >> 6, c = item & 63, b = ch >> 4, hd = ch & 15;
    const size_t tile0 = ((size_t)(b * SEQ + c * 64) * DM + hd * 64);
    bf16_t* RT = (bf16_t*)(p.ws + WS_S0 + 3 * SLOT) + tile0;
    const bf16_t* Y0 = (const bf16_t*)(p.ws + WS_S0 + 4 * SLOT) + tile0;
    const bf16_t* VV = (const bf16_t*)(p.ws + WS_S0 + 5 * SLOT) + tile0;
    const bf16_t* GG = (const bf16_t*)(p.ws + WS_S0 + 2 * SLOT) + tile0;
    const bf16_t* SC = (const bf16_t*)(p.ws + WS_S0 + SLOT) + tile0 - (size_t)64 * DM;
    const float* BO = (const float*)(p.ws + WS_TMP) + (size_t)item * 64;
    f32x4 y[4];
#pragma unroll
    for (int j = 0; j < 4; ++j) y[j] = (f32x4){0.f, 0.f, 0.f, 0.f};
    if (c > 0) {
      const bf16_t* ap = RT + (size_t)(16 * tb + cr) * DM + q * 8;
      const bf16x8 a0 = *(const GAS bf16x8*)ap, a1 = *(const GAS bf16x8*)(ap + 32);
#pragma unroll
      for (int j = 0; j < 4; ++j) {
        const bf16_t* bp = SC + (size_t)(16 * j + cr) * DM + q * 8;
        const bf16x8 b0 = *(const GAS bf16x8*)bp, b1 = *(const GAS bf16x8*)(bp + 32);
        y[j] = __builtin_amdgcn_mfma_f32_16x16x32_bf16(a0, b0, y[j], 0, 0, 0);
        y[j] = __builtin_amdgcn_mfma_f32_16x16x32_bf16(a1, b1, y[j], 0, 0, 0);
      }
    }
    float mu[4], rs[4];
#pragma unroll
    for (int i = 0; i < 4; ++i) {
      float s = 0.f;
#pragma unroll
      for (int j = 0; j < 4; ++j) { y[j][i] += bf2f(Y0[(size_t)(16 * tb + q4 + i) * DM + 16 * j + cr]); s += y[j][i]; }
      s += __shfl_xor(s, 1, 64); s += __shfl_xor(s, 2, 64); s += __shfl_xor(s, 4, 64); s += __shfl_xor(s, 8, 64);
      mu[i] = s * (1.f / 64.f);
      float qd = 0.f;
#pragma unroll
      for (int j = 0; j < 4; ++j) { const float d = y[j][i] - mu[i]; qd += d * d; }
      qd += __shfl_xor(qd, 1, 64); qd += __shfl_xor(qd, 2, 64); qd += __shfl_xor(qd, 4, 64); qd += __shfl_xor(qd, 8, 64);
      rs[i] = rsqrtf(qd * (1.f / 64.f) + 64e-5f);
    }
#pragma unroll
    for (int j = 0; j < 4; ++j) {
      const int cc = hd * 64 + 16 * j + cr;
      const float lw = p.ln_w[cc], lb = p.ln_b[cc];
#pragma unroll
      for (int i = 0; i < 4; ++i) {
        const int tt = 16 * tb + q4 + i;
        const float vv = bf2f(VV[(size_t)tt * DM + 16 * j + cr]), gg = bf2f(GG[(size_t)tt * DM + 16 * j + cr]);
        const float z = ((y[j][i] - mu[i]) * rs[i] * lw + lb + BO[tt] * vv) * gg;
        stg[(q4 + i) * RP + 16 * j + cr] = (bf16_t)f2bf(z);
      }
    }
    LDS_WAIT();
#pragma unroll
    for (int i = 0; i < 2; ++i) { const int row = (lane >> 3) + 8 * i, pc = (lane & 7) * 8;
      *(GAS v4u*)(RT + (size_t)(16 * tb + row) * DM + pc) = *(const LAS v4u*)(stg + row * RP + pc); }
    LDS_WAIT();
  }
}


typedef short v4i16_t __attribute__((ext_vector_type(4)));
__device__ __forceinline__ v4i16_t tr16(const LAS bf16_t* p) { return __builtin_amdgcn_ds_read_tr16_b64_v4i16((LAS v4i16_t*)p); }

template <int KS>
__device__ __forceinline__ void qk_tile(f32x4 (&st)[4][2], const LAS bf16_t* Kt, int kc0, const bf16x8 (&qf)[2][KS], int lane) {
  const int r = lane & 15, g = lane >> 4;
#pragma unroll
  for (int kt = 0; kt < 4; ++kt)
#pragma unroll
    for (int ks = 0; ks < KS; ++ks) {
      const bf16x8 a = *(const LAS bf16x8*)(Kt + (kt * 16 + r) * RP + kc0 + ks * 32 + g * 8);
#pragma unroll
      for (int qt = 0; qt < 2; ++qt) st[kt][qt] = __builtin_amdgcn_mfma_f32_16x16x32_bf16(a, qf[qt][ks], st[kt][qt], 0, 0, 0);
    }
}
__device__ __forceinline__ void pack_p(bf16x8 (&pb)[2][2], const f32x4 (&pr)[4][2]) {
#pragma unroll
  for (int kb = 0; kb < 2; ++kb)
#pragma unroll
    for (int qt = 0; qt < 2; ++qt) {
      const v4u w = {pk2(pr[2 * kb][qt][0], pr[2 * kb][qt][1]), pk2(pr[2 * kb][qt][2], pr[2 * kb][qt][3]), pk2(pr[2 * kb + 1][qt][0], pr[2 * kb + 1][qt][1]), pk2(pr[2 * kb + 1][qt][2], pr[2 * kb + 1][qt][3])};
      pb[kb][qt] = __builtin_bit_cast(bf16x8, w);
    }
}
__device__ __forceinline__ void pv_apply(f32x4 (&o)[4][2], f32x4 (&osum)[2], const bf16x8 (&pb)[2][2], const LAS bf16_t* Vt, int lane) {
  const int g = lane >> 4, qq = (lane & 15) >> 2, pp = lane & 3;
  const bf16x8 ones = {0x3F80, 0x3F80, 0x3F80, 0x3F80, 0x3F80, 0x3F80, 0x3F80, 0x3F80};
#pragma unroll
  for (int kb = 0; kb < 2; ++kb)
#pragma unroll
    for (int qt = 0; qt < 2; ++qt) osum[qt] = __builtin_amdgcn_mfma_f32_16x16x32_bf16(ones, pb[kb][qt], osum[qt], 0, 0, 0);
#pragma unroll
  for (int dt = 0; dt < 4; ++dt)
#pragma unroll
    for (int kb = 0; kb < 2; ++kb) {
      const v4i16_t lo = tr16(Vt + (32 * kb + 4 * g + qq) * RP + dt * 16 + 4 * pp);
      const v4i16_t hi = tr16(Vt + (32 * kb + 16 + 4 * g + qq) * RP + dt * 16 + 4 * pp);
      const bf16x8 a = {lo[0], lo[1], lo[2], lo[3], hi[0], hi[1], hi[2], hi[3]};
#pragma unroll
      for (int qt = 0; qt < 2; ++qt) o[dt][qt] = __builtin_amdgcn_mfma_f32_16x16x32_bf16(a, pb[kb][qt], o[dt][qt], 0, 0, 0);
    }
}
__device__ __forceinline__ void pv_apply2(f32x4 (&o1)[4][2], f32x4 (&o2)[4][2], f32x4 (&os1)[2], f32x4 (&os2)[2], const bf16x8 (&pb1)[2][2], const bf16x8 (&pb2)[2][2], const LAS bf16_t* Vt, int lane) {
  const int g = lane >> 4, qq = (lane & 15) >> 2, pp = lane & 3;
  const bf16x8 ones = {0x3F80, 0x3F80, 0x3F80, 0x3F80, 0x3F80, 0x3F80, 0x3F80, 0x3F80};
#pragma unroll
  for (int kb = 0; kb < 2; ++kb)
#pragma unroll
    for (int qt = 0; qt < 2; ++qt) { os1[qt] = __builtin_amdgcn_mfma_f32_16x16x32_bf16(ones, pb1[kb][qt], os1[qt], 0, 0, 0); os2[qt] = __builtin_amdgcn_mfma_f32_16x16x32_bf16(ones, pb2[kb][qt], os2[qt], 0, 0, 0); }
#pragma unroll
  for (int dt = 0; dt < 4; ++dt)
#pragma unroll
    for (int kb = 0; kb < 2; ++kb) {
      const v4i16_t lo = tr16(Vt + (32 * kb + 4 * g + qq) * RP + dt * 16 + 4 * pp);
      const v4i16_t hi = tr16(Vt + (32 * kb + 16 + 4 * g + qq) * RP + dt * 16 + 4 * pp);
      const bf16x8 a = {lo[0], lo[1], lo[2], lo[3], hi[0], hi[1], hi[2], hi[3]};
#pragma unroll
      for (int qt = 0; qt < 2; ++qt) { o1[dt][qt] = __builtin_amdgcn_mfma_f32_16x16x32_bf16(a, pb1[kb][qt], o1[dt][qt], 0, 0, 0); o2[dt][qt] = __builtin_amdgcn_mfma_f32_16x16x32_bf16(a, pb2[kb][qt], o2[dt][qt], 0, 0, 0); }
    }
}
__device__ __forceinline__ void fill42(f32x4 (&a)[4][2], const f32x4 v) {
#pragma unroll
  for (int i = 0; i < 4; ++i)
#pragma unroll
    for (int j = 0; j < 2; ++j) a[i][j] = v;
}
__device__ __forceinline__ void exp42(f32x4 (&a)[4][2]) {
#pragma unroll
  for (int i = 0; i < 4; ++i)
#pragma unroll
    for (int j = 0; j < 2; ++j)
#pragma unroll
      for (int e = 0; e < 4; ++e) a[i][j][e] = __builtin_amdgcn_exp2f(a[i][j][e]);
}
#if defined(PROBE_PH) && PROBE_PH == 300
#define AT_BAR() do { const unsigned long long _b0 = __builtin_amdgcn_s_memrealtime(); asm volatile("s_waitcnt lgkmcnt(0)" ::: "memory"); __builtin_amdgcn_s_barrier(); asm volatile("" ::: "memory"); F.pr_t1 += __builtin_amdgcn_s_memrealtime() - _b0; } while (0)
#else
#define AT_BAR() do { asm volatile("s_waitcnt lgkmcnt(0)" ::: "memory"); __builtin_amdgcn_s_barrier(); asm volatile("" ::: "memory"); } while (0)
#endif
__device__ __forceinline__ void zero42(f32x4 (&a)[4][2]) {
#pragma unroll
  for (int i = 0; i < 4; ++i)
#pragma unroll
    for (int j = 0; j < 2; ++j) a[i][j] = (f32x4){0.f, 0.f, 0.f, 0.f};
}

__device__ __forceinline__ void phase_compress(PREF p, Frame& F) {
  const int lane = fresh_lane(), w = F.wave, tid = F.tid;
  const int r = lane & 15, g4 = lane >> 4;
  const bf16_t* H = (const bf16_t*)(p.ws + WS_H);
  const bf16_t* W1T = (const bf16_t*)(p.ws + WS_CW1);
  LAS float* part = (LAS float*)F.lds;
  LAS float* hid = part + 8 * 16 * 64;
  LAS float* outv = hid + 16 * 64;
  for (int task = F.vcu; task < 256; task += F.G) {
    const int kv = task >> 7, rb = task & 127;
    int row = rb * 16 + r; if (row > 2039) row = 2039;
    const int gg = row & 1, cc = (row >> 1) % NCMP, bb = (row >> 1) / NCMP;
    const int colbase = OFF_NKV + ((0 * 2 + kv) * 2 + gg) * 64;
    f32x4 acc[4];
#pragma unroll
    for (int nt = 0; nt < 4; ++nt) acc[nt] = (f32x4){0.f, 0.f, 0.f, 0.f};
#pragma unroll 1
    for (int ks = 0; ks < 8; ++ks) {
      const int k = w * 256 + ks * 32 + g4 * 8, l = k >> 6, d0 = k & 63;
      float hv[8]; ld8bf(H + (size_t)(bb * SEQ + 16 * cc + l) * HC + colbase + d0, hv);
      const float* pe = p.cmp_pe + (kv * 32 + l) * 64 + d0;
#pragma unroll
      for (int i = 0; i < 8; ++i) hv[i] += pe[i];
      const bf16x8 a = __builtin_bit_cast(bf16x8, pk8(hv));
#pragma unroll
      for (int nt = 0; nt < 4; ++nt) {
        const bf16x8 bfr = *(const GAS bf16x8*)(W1T + ((size_t)kv * 64 + nt * 16 + r) * 2048 + k);
        acc[nt] = __builtin_amdgcn_mfma_f32_16x16x32_bf16(a, bfr, acc[nt], 0, 0, 0);
      }
    }
#pragma unroll
    for (int nt = 0; nt < 4; ++nt)
#pragma unroll
      for (int i = 0; i < 4; ++i) part[(w * 16 + g4 * 4 + i) * 64 + nt * 16 + r] = acc[nt][i];
    __syncthreads();
    for (int e = tid; e < 1024; e += NWAVES * 64) { float s = 0.f;
#pragma unroll
      for (int ww = 0; ww < 8; ++ww) s += part[ww * 1024 + e];
      hid[e] = gelu_tanh(s); }
    __syncthreads();
    const float* w2 = p.cmp_w2 + kv * 4096;
    for (int e = tid; e < 1024; e += NWAVES * 64) { const int rr = e >> 6, n = e & 63; float s = 0.f;
      for (int j = 0; j < 64; ++j) s += hid[rr * 64 + j] * w2[j * 64 + n];
      outv[e] = s; }
    __syncthreads();
    for (int e = tid; e < 1024; e += NWAVES * 64) { const int rr = e >> 6, n = e & 63;
      const int orow = rb * 16 + rr;
      if (orow < 2040) {
        float v = outv[e];
        if (kv == 0) { float ss = 0.f; for (int j = 0; j < 64; ++j) ss += outv[rr * 64 + j] * outv[rr * 64 + j]; v = v * rsqrtf(ss * (1.f / 64.f) + 1e-6f) * p.nk_norm[n]; }
        const int g2 = orow & 1, c2 = (orow >> 1) % NCMP, b2 = (orow >> 1) / NCMP;
        ((bf16_t*)(p.ws + (kv ? WS_VCMPB : WS_KCMPB)))[((size_t)(b2 * 2 + g2) * 256 + c2) * 64 + n] = (bf16_t)f2bf(v);
      }
    }
    if (task < 16 && tid < 64) { const int kk2 = task >> 3, bg = task & 7; ((bf16_t*)(p.ws + (kk2 ? WS_VCMPB : WS_KCMPB)))[((size_t)bg * 256 + 255) * 64 + tid] = 0; }
    __syncthreads();
  }
}

__device__ __forceinline__ v4u tile_ld(const bf16_t* base, size_t pitch, int tid) { return *(const GAS v4u*)(base + (size_t)(tid >> 3) * pitch + (tid & 7) * 8); }
__device__ __forceinline__ void tile_st(LAS bf16_t* dst, v4u v, int tid) { *(LAS v4u*)(dst + (tid >> 3) * RP + (tid & 7) * 8) = v; }

template <int KS, int MODE>
__device__ __forceinline__ void attn_tile(f32x4 (&o)[4][2], f32x4 (&os)[2], const bf16x8 (&qf)[2][KS], const LAS bf16_t* KBt, int kc0, const LAS bf16_t* VBt, const f32x4 nbv,
                                          const bool (&on)[2], int qq0, int koff, int lane) {
  const int r = lane & 15, g = lane >> 4;
  f32x4 st[4][2]; bf16x8 pb[2][2];
  fill42(st, nbv); qk_tile<KS>(st, KBt, kc0, qf, lane); exp42(st);
  if (MODE != 0) {
#pragma unroll
    for (int kt = 0; kt < 4; ++kt)
#pragma unroll
      for (int qt = 0; qt < 2; ++qt)
#pragma unroll
        for (int i = 0; i < 4; ++i) { const int kk = kt * 16 + g * 4 + i, qq = qq0 + qt * 16 + r;
          bool keep = true;
          if (MODE & 1) keep = keep && on[qt];
          if (MODE & 2) keep = keep && (kk + koff <= qq);
          if (MODE & 4) keep = keep && (kk > qq);
          if (!keep) st[kt][qt][i] = 0.f; }
  }
  pack_p(pb, st);
  pv_apply(o, os, pb, VBt, lane);
}
__device__ __forceinline__ void phase_diffattn(PREF p, Frame& F) {
  const int lane = fresh_lane(), w = F.wave, tid = F.tid;
  const int r = lane & 15, g = lane >> 4;
  const bf16_t* H = (const bf16_t*)(p.ws + WS_H);
  bf16_t* CAT = (bf16_t*)(p.ws + WS_CAT);
  float mq = 0.f, mk = 0.f, l0 = 0.f, l1 = 0.f;
  for (int i = 0; i < 32; i++) { mq = fmaxf(mq, fabsf(p.dq_norm[i])); mk = fmaxf(mk, fabsf(p.dk_norm[i])); l0 += p.dlam[i] * p.dlam[32 + i]; l1 += p.dlam[64 + i] * p.dlam[96 + i]; }
  const float c2 = 0.17677669529663687f * 1.4426950408889634f;
  const float nb = -(32.f * mq * mk) * c2;
  const f32x4 nbv = {nb, nb, nb, nb};
  const float lam = __expf(l0) - __expf(l1) + 0.2f;
  const bool on[2] = {true, true};
  for (int pr = F.vcu; pr < 256; pr += F.G) {
    const int bh = pr >> 3, sp = pr & 7, b = bh >> 3, hd = bh & 7;
#pragma unroll 1
    for (int ui = 0; ui < 2; ++ui) {
      const int qb = ui ? 15 - sp : sp;
      const int NT = 4 * (qb + 1);
      const bf16_t* Kg = H + (size_t)(b * SEQ) * HC + OFF_DK + hd * 64;
      const bf16_t* Vg = H + (size_t)(b * SEQ) * HC + OFF_DV + hd * 64;
      f32x4 o1[4][2];
#pragma unroll 1
      for (int mp = 0; mp < 2; ++mp) {
        bf16x8 qf[2][1];
#pragma unroll
        for (int qt = 0; qt < 2; ++qt) qf[qt][0] = *(const GAS bf16x8*)(H + (size_t)(b * SEQ + qb * 256 + w * 32 + qt * 16 + r) * HC + OFF_DQ + hd * 64 + mp * 32 + g * 8);
        f32x4 o[4][2]; zero42(o);
        f32x4 os[2] = {{0.f, 0.f, 0.f, 0.f}, {0.f, 0.f, 0.f, 0.f}};
        v4u krA = tile_ld(Kg, HC, tid), vrA = tile_ld(Vg, HC, tid);
        v4u krB = tile_ld(Kg + (size_t)64 * HC, HC, tid), vrB = tile_ld(Vg + (size_t)64 * HC, HC, tid);
#pragma unroll 1
        for (int t = 0; t < NT; t += 2) {
#pragma unroll
          for (int hf = 0; hf < 2; ++hf) {
            const int tt = t + hf;
            const lbf KBt = (lbf)(F.lds + hf * 2 * RB), VBt = KBt + 64 * RP;
            tile_st(KBt, hf ? krB : krA, tid); tile_st(VBt, hf ? vrB : vrA, tid);
            AT_BAR();
            if (tt + 2 < NT) { const v4u k2 = tile_ld(Kg + (size_t)(tt + 2) * 64 * HC, HC, tid), v2 = tile_ld(Vg + (size_t)(tt + 2) * 64 * HC, HC, tid);
              if (hf) { krB = k2; vrB = v2; } else { krA = k2; vrA = v2; } }
            const int koff = tt * 64 - (qb * 256 + w * 32);
            if (tt >= NT - 4) attn_tile<1, 2>(o, os, qf, KBt, mp * 32, VBt, nbv, on, 0, koff, lane);
            else attn_tile<1, 0>(o, os, qf, KBt, mp * 32, VBt, nbv, on, 0, koff, lane);
          }
        }
        if (mp == 0) {
#pragma unroll
          for (int qt = 0; qt < 2; ++qt) { const float i1 = 1.f / os[qt][0];
#pragma unroll
            for (int dt = 0; dt < 4; ++dt) o1[dt][qt] = o[dt][qt] * i1; }
        } else {
#pragma unroll
          for (int qt = 0; qt < 2; ++qt) {
            const float i2 = lam / os[qt][0];
            float ss = 0.f;
#pragma unroll
            for (int dt = 0; dt < 4; ++dt)
#pragma unroll
              for (int i = 0; i < 4; ++i) { const float v = o1[dt][qt][i] - o[dt][qt][i] * i2; o1[dt][qt][i] = v; ss += v * v; }
            ss += __shfl_xor(ss, 16, 64); ss += __shfl_xor(ss, 32, 64);
            const float rr = rsqrtf(ss * (1.f / 64.f) + 1e-6f) * 0.8f;
            bf16_t* op = CAT + (size_t)(b * SEQ + qb * 256 + w * 32 + qt * 16 + r) * DM + hd * 64;
#pragma unroll
            for (int dt = 0; dt < 4; ++dt) { const int d0 = dt * 16 + g * 4; const f32x4 sg = *(const f32x4*)(p.dsubln + d0);
              v2u wv; wv.x = pk2(o1[dt][qt][0] * rr * sg[0], o1[dt][qt][1] * rr * sg[1]); wv.y = pk2(o1[dt][qt][2] * rr * sg[2], o1[dt][qt][3] * rr * sg[3]);
              *(GAS v2u*)(op + d0) = wv; }
          }
        }
        AT_BAR();
      }
    }
  }
}

__device__ __forceinline__ void nsa_finish(f32x4 (&comb)[4][2], const f32x4 (&o)[4][2], const f32x4 (&os)[2], const float (&gate)[2], bool normalised) {
#pragma unroll
  for (int qt = 0; qt < 2; ++qt) {
    const float f = normalised ? gate[qt] : gate[qt] / os[qt][0];
#pragma unroll
    for (int dt = 0; dt < 4; ++dt) comb[dt][qt] += o[dt][qt] * f;
  }
}
__device__ __forceinline__ void phase_nsa(PREF p, Frame& F) {
  const int lane = fresh_lane(), w = F.wave, tid = F.tid;
  const int r = lane & 15, g = lane >> 4;
  const bf16_t* H = (const bf16_t*)(p.ws + WS_H);
  const float* GATES = (const float*)(p.ws + WS_GATES);
  bf16_t* CAT = (bf16_t*)(p.ws + WS_CAT);
  float mq = 0.f, mk0 = 0.f, mk1 = 0.f, mk2 = 0.f;
  for (int i = 0; i < 64; i++) { mq = fmaxf(mq, fabsf(p.nq_norm[i])); mk0 = fmaxf(mk0, fabsf(p.nk_norm[i])); mk1 = fmaxf(mk1, fabsf(p.nk_norm[64 + i])); mk2 = fmaxf(mk2, fabsf(p.nk_norm[128 + i])); }
  const float c2 = 0.125f * 1.4426950408889634f;
  const float nb0 = -(64.f * mq * mk0) * c2, nb1 = -(64.f * mq * mk1) * c2, nb2 = -(64.f * mq * mk2) * c2;
  LAS float* IMP = (LAS float*)(F.lds + 12 * RB);
  LAS unsigned char* SELB = (LAS unsigned char*)(F.lds + 12 * RB + 64 * 65 * 4);
  const int hj = w >> 1, th = w & 1;
  for (int pr = F.vcu; pr < 256; pr += F.G) {
    const int bg = pr >> 5, sp = pr & 31, b = bg >> 1, gq = bg & 1;
#pragma unroll 1
    for (int ui = 0; ui < 2; ++ui) {
      const int blk = ui ? 63 - sp : sp;
      const int hh = gq * 4 + hj;
      const int tokw = b * SEQ + blk * 64 + th * 32;
      bf16x8 qf[2][2];
      float gate0[2], gate1[2], gate2[2];
#pragma unroll
      for (int qt = 0; qt < 2; ++qt) { const bf16_t* qp = H + (size_t)(tokw + qt * 16 + r) * HC + OFF_NQ + hh * 64 + g * 8;
        qf[qt][0] = *(const GAS bf16x8*)qp; qf[qt][1] = *(const GAS bf16x8*)(qp + 32);
        const float* gp = GATES + (size_t)(tokw + qt * 16 + r) * 24 + hh * 3; gate0[qt] = gp[0]; gate1[qt] = gp[1]; gate2[qt] = gp[2]; }
      f32x4 comb[4][2]; zero42(comb);
      const int nct = (4 * blk + 3 + 63) >> 6;
      {
        const bf16_t* KC = (const bf16_t*)(p.ws + WS_KCMPB) + (size_t)(b * 2 + gq) * 256 * 64;
        const bf16_t* VC = (const bf16_t*)(p.ws + WS_VCMPB) + (size_t)(b * 2 + gq) * 256 * 64;
        for (int t4 = 0; t4 < nct; ++t4) { tile_st((lbf)(F.lds + t4 * RB), tile_ld(KC + t4 * 4096, 64, tid), tid); tile_st((lbf)(F.lds + (4 + t4) * RB), tile_ld(VC + t4 * 4096, 64, tid), tid); }
        for (int e = tid; e < 64 * 65; e += NWAVES * 64) IMP[e] = 0.f;
        AT_BAR();
        const f32x4 nbv0 = {nb0, nb0, nb0, nb0};
        int cmax[2];
#pragma unroll
        for (int qt = 0; qt < 2; ++qt) { const int pos = blk * 64 + th * 32 + qt * 16 + r; cmax[qt] = (pos >= 31) ? ((pos - 31) >> 4) : -1; }
        float lsum[2] = {0.f, 0.f};
        for (int t4 = 0; t4 < nct; ++t4) {
          f32x4 st[4][2]; fill42(st, nbv0);
          qk_tile<2>(st, (lbf)(F.lds + t4 * RB), 0, qf, lane); exp42(st);
#pragma unroll
          for (int kt = 0; kt < 4; ++kt)
#pragma unroll
            for (int qt = 0; qt < 2; ++qt)
#pragma unroll
              for (int i = 0; i < 4; ++i) { const int c = t4 * 64 + kt * 16 + g * 4 + i; if (c <= cmax[qt]) lsum[qt] += st[kt][qt][i]; }
        }
        float linv[2];
#pragma unroll
        for (int qt = 0; qt < 2; ++qt) { float s = lsum[qt]; s += __shfl_xor(s, 16, 64); s += __shfl_xor(s, 32, 64); linv[qt] = (cmax[qt] >= 0) ? 1.f / s : 0.f; }
        f32x4 o[4][2]; zero42(o);
        f32x4 osd[2] = {{0.f, 0.f, 0.f, 0.f}, {0.f, 0.f, 0.f, 0.f}};
        for (int t4 = 0; t4 < nct; ++t4) {
          f32x4 st[4][2]; fill42(st, nbv0);
          qk_tile<2>(st, (lbf)(F.lds + t4 * RB), 0, qf, lane); exp42(st);
#pragma unroll
          for (int kt = 0; kt < 4; ++kt)
#pragma unroll
            for (int qt = 0; qt < 2; ++qt) {
              float gs = 0.f;
#pragma unroll
              for (int i = 0; i < 4; ++i) { const int c = t4 * 64 + kt * 16 + g * 4 + i;
                const float e = (c <= cmax[qt]) ? st[kt][qt][i] * linv[qt] : 0.f;
                st[kt][qt][i] = e; gs += e; }
              const int ti = th * 32 + qt * 16 + r, j = t4 * 16 + kt * 4 + g;
              if (gs != 0.f) { __hip_atomic_fetch_add(IMP + ti * 65 + j, gs, __ATOMIC_RELAXED, __HIP_MEMORY_SCOPE_WORKGROUP); if (j < 63 && st[kt][qt][3] != 0.f) __hip_atomic_fetch_add(IMP + ti * 65 + j + 1, st[kt][qt][3], __ATOMIC_RELAXED, __HIP_MEMORY_SCOPE_WORKGROUP); }
            }
          bf16x8 pb[2][2]; pack_p(pb, st);
          pv_apply(o, osd, pb, (lbf)(F.lds + (4 + t4) * RB), lane);
        }
        nsa_finish(comb, o, osd, gate0, true);
      }
      AT_BAR();
      {
        const int ti = tid >> 3, jb = (tid & 7) * 8;
        float mine[8]; int rank[8];
#pragma unroll
        for (int u = 0; u < 8; ++u) { const int j = jb + u; float v = IMP[ti * 65 + j]; if (j == blk || j == 0) v = 1e4f; else if (j > blk) v = -1e30f; mine[u] = v; rank[u] = 0; }
        for (int i = 0; i < 64; ++i) { float v = IMP[ti * 65 + i]; if (i == blk || i == 0) v = 1e4f; else if (i > blk) v = -1e30f;
#pragma unroll
          for (int u = 0; u < 8; ++u) rank[u] += (v > mine[u] || (v == mine[u] && i < jb + u)) ? 1 : 0; }
        unsigned bits = 0;
#pragma unroll
        for (int u = 0; u < 8; ++u) bits |= (rank[u] < 16 ? 1u : 0u) << u;
        SELB[ti * 8 + (tid & 7)] = (unsigned char)bits;
      }
      AT_BAR();
      unsigned long long selm[2];
#pragma unroll
      for (int qt = 0; qt < 2; ++qt) { const int ti = th * 32 + qt * 16 + r; const LAS unsigned* sp2 = (const LAS unsigned*)(SELB + ti * 8); selm[qt] = (unsigned long long)sp2[0] | ((unsigned long long)sp2[1] << 32); }
#pragma unroll 1
      for (int br = 1; br < 3; ++br) {
        const int kcol = OFF_NKV + ((br * 2 + 0) * 2 + gq) * 64, vcol = OFF_NKV + ((br * 2 + 1) * 2 + gq) * 64;
        const float nbb = (br == 1) ? nb1 : nb2;
        const f32x4 nbv = {nbb, nbb, nbb, nbb};
        const int t_lo = (br == 1) ? 0 : (blk > 8 ? blk - 8 : 0);
        const bf16_t* Kg = H + (size_t)(b * SEQ) * HC + kcol;
        const bf16_t* Vg = H + (size_t)(b * SEQ) * HC + vcol;
        f32x4 o[4][2]; zero42(o);
        f32x4 os[2] = {{0.f, 0.f, 0.f, 0.f}, {0.f, 0.f, 0.f, 0.f}};
        v4u krA = tile_ld(Kg + (size_t)t_lo * 64 * HC, HC, tid), vrA = tile_ld(Vg + (size_t)t_lo * 64 * HC, HC, tid);
        v4u krB = krA, vrB = vrA;
        if (t_lo < blk) { krB = tile_ld(Kg + (size_t)(t_lo + 1) * 64 * HC, HC, tid); vrB = tile_ld(Vg + (size_t)(t_lo + 1) * 64 * HC, HC, tid); }
#pragma unroll 1
        for (int t0 = t_lo; t0 <= blk; t0 += 2) {
#pragma unroll
          for (int hf = 0; hf < 2; ++hf) {
            const int t = t0 + hf;
            if (t <= blk) {
              const lbf KBt = (lbf)(F.lds + (8 + hf * 2) * RB), VBt = KBt + 64 * RP;
              tile_st(KBt, hf ? krB : krA, tid); tile_st(VBt, hf ? vrB : vrA, tid);
              AT_BAR();
              if (t + 2 <= blk) { const v4u k2 = tile_ld(Kg + (size_t)(t + 2) * 64 * HC, HC, tid), v2 = tile_ld(Vg + (size_t)(t + 2) * 64 * HC, HC, tid);
                if (hf) { krB = k2; vrB = v2; } else { krA = k2; vrA = v2; } }
              const bool on[2] = {((selm[0] >> t) & 1ull) != 0ull, ((selm[1] >> t) & 1ull) != 0ull};
              const int qq0 = th * 32;
              if (br == 1) {
                if (__any((int)(on[0] || on[1]))) {
                  if (t == blk) attn_tile<2, 3>(o, os, qf, KBt, 0, VBt, nbv, on, qq0, 0, lane);
                  else if (__all((int)(on[0] && on[1]))) attn_tile<2, 0>(o, os, qf, KBt, 0, VBt, nbv, on, qq0, 0, lane);
                  else attn_tile<2, 1>(o, os, qf, KBt, 0, VBt, nbv, on, qq0, 0, lane);
                }
              } else {
                if (t == blk) attn_tile<2, 2>(o, os, qf, KBt, 0, VBt, nbv, on, qq0, 0, lane);
                else if (t == blk - 8) attn_tile<2, 4>(o, os, qf, KBt, 0, VBt, nbv, on, qq0, 0, lane);
                else attn_tile<2, 0>(o, os, qf, KBt, 0, VBt, nbv, on, qq0, 0, lane);
              }
            }
          }
        }
        nsa_finish(comb, o, os, (br == 1) ? gate1 : gate2, false);
        AT_BAR();
      }
#pragma unroll
      for (int qt = 0; qt < 2; ++qt) { bf16_t* op = CAT + (size_t)(tokw + qt * 16 + r) * DM + 512 + hh * 64;
#pragma unroll
        for (int dt = 0; dt < 4; ++dt) { const int d0 = dt * 16 + g * 4; v2u wv; wv.x = pk2(comb[dt][qt][0], comb[dt][qt][1]); wv.y = pk2(comb[dt][qt][2], comb[dt][qt][3]); *(GAS v2u*)(op + d0) = wv; } }
    }
  }
}


__device__ __forceinline__ void phase_lora2(PREF p, Frame& F) {
  const int lane = fresh_lane(), w = F.wave, tid = F.tid;
  const int cr = lane & 15, g = lane >> 4;
  constexpr int TP = 392;
  const lbf TM = (lbf)(F.lds);
  const lbf ST = (lbf)(F.lds + 64 * TP * 2) + w * 64 * RP;
  const bf16_t* TMPg = (const bf16_t*)(p.ws + WS_TMP);
  for (int unit = F.vcu; unit < 256; unit += F.G) {
    const int t0 = unit * 64;
#pragma unroll
    for (int i = 0; i < 6; ++i) { const int idx = tid + i * 512, row = idx / 48, pc = idx - row * 48;
      *(LAS v4u*)(TM + row * TP + pc * 8) = *(const GAS v4u*)(TMPg + (size_t)(t0 + row) * 384 + pc * 8); }
    __syncthreads();
#pragma unroll 1
    for (int j = 0; j < 6; ++j) {
      const int blk = (w * 6 + j + unit * 5) % 48;
      const int tensor = blk >> 4, cb = blk & 15;
      const int ldw = (tensor == 2) ? 192 : 64, kc0 = tensor * 64;
      const bf16_t* Wp = (const bf16_t*)(p.ws + WS_WL2 + (size_t)tensor * 128 * 1024) + (size_t)(cb * 64) * ldw;
      f32x4 acc[4][4];
#pragma unroll
      for (int ct = 0; ct < 4; ++ct)
#pragma unroll
        for (int tt = 0; tt < 4; ++tt) acc[ct][tt] = (f32x4){0.f, 0.f, 0.f, 0.f};
      auto run = [&](auto nks_c) {
        constexpr int NKS = decltype(nks_c)::value;
        bf16x8 a[NKS][4];
#pragma unroll
        for (int ks = 0; ks < NKS; ++ks)
#pragma unroll
          for (int ct = 0; ct < 4; ++ct) a[ks][ct] = *(const GAS bf16x8*)(Wp + (size_t)(16 * ct + cr) * ldw + ks * 32 + g * 8);
#pragma unroll
        for (int ks = 0; ks < NKS; ++ks) {
          bf16x8 b[4];
#pragma unroll
          for (int tt = 0; tt < 4; ++tt) b[tt] = *(const LAS bf16x8*)(TM + (16 * tt + cr) * TP + kc0 + ks * 32 + g * 8);
#pragma unroll
          for (int ct = 0; ct < 4; ++ct)
#pragma unroll
            for (int tt = 0; tt < 4; ++tt) acc[ct][tt] = __builtin_amdgcn_mfma_f32_16x16x32_bf16(a[ks][ct], b[tt], acc[ct][tt], 0, 0, 0);
        }
      };
      if (tensor == 2) run(std::integral_constant<int, 6>{}); else run(std::integral_constant<int, 2>{});
#pragma unroll
      for (int ct = 0; ct < 4; ++ct) {
        const int n0 = cb * 64 + 16 * ct + 4 * g;
        f32x4 bias = {0.f, 0.f, 0.f, 0.f};
        if (tensor == 0) bias = *(const f32x4*)(p.w0 + n0); else if (tensor == 1) bias = *(const f32x4*)(p.a0 + n0);
#pragma unroll
        for (int tt = 0; tt < 4; ++tt) {
          f32x4 v = acc[ct][tt] + bias;
          if (tensor == 0) {
#pragma unroll
            for (int i = 0; i < 4; ++i) v[i] = -0.60653066f * sigmoidf_(v[i]);
          } else if (tensor == 1) {
#pragma unroll
            for (int i = 0; i < 4; ++i) v[i] = sigmoidf_(v[i]);
          }
          v2u o; o.x = pk2(v[0], v[1]); o.y = pk2(v[2], v[3]);
          *(LAS v2u*)(ST + (16 * tt + cr) * RP + 16 * ct + 4 * g) = o;
        }
      }
      LDS_WAIT();
      bf16_t* O = (bf16_t*)(p.ws + WS_S0 + (size_t)tensor * SLOT) + (size_t)t0 * DM + cb * 64;
#pragma unroll
      for (int i = 0; i < 8; ++i) { const int row = (lane >> 3) + 8 * i, pc = (lane & 7) * 8;
        *(GAS v4u*)(O + (size_t)row * DM + pc) = *(const LAS v4u*)(ST + row * RP + pc); }
      LDS_WAIT();
    }
    __syncthreads();
  }
}

__global__ void __launch_bounds__(NWAVES * 64, 2) mk_fwd(P p_arg) {
  extern __shared__ __attribute__((aligned(16))) unsigned char lds[];
  Frame F;
  F.lds = (LAS unsigned char*)lds;
  F.MISC = (volatile LAS unsigned*)(F.lds + MISC_OFF);
  F.tid = threadIdx.x; F.lane = F.tid & 63; F.wave = __builtin_amdgcn_readfirstlane(F.tid >> 6);
  F.G = gridDim.x; { const int bx = blockIdx.x; F.vcu = (F.G % 8 == 0) ? (bx % 8) * (F.G / 8) + bx / 8 : bx; }
  unsigned char* const ws = p_arg.ws;
  F.ctl = (gu32*)(ws + WS_CTL);
  for (int u = F.tid; u < (LDS_BYTES - LDSCTL_OFF) / 4; u += NWAVES * 64) ((LAS unsigned*)(F.lds + LDSCTL_OFF))[u] = 0u;
  __syncthreads();
  XcdBarrier bar = xcd_barrier_post((unsigned*)(F.ctl + CW_BAR) + p_arg.pad * XCD_BAR_WORDS, F.MISC + 8);
  const int lo = p_arg.ph_lo, hi = p_arg.ph_hi;
#ifndef PHMASK
#define PHMASK 0xffffffffu
#endif
#define IN(k) (lo <= (k) && (k) < hi && ((PHMASK >> (k)) & 1u))
#define SEAM(k) do { if (IN(k) && IN((k) + 1)) xcd_barrier(bar); } while (0)
#ifdef PROBE_PH
  F.pr_t0 = 0; F.pr_t1 = 0;
#endif

  PROBE_MARK(0); if (IN(0)) { phase_prologue(KP, F); } SEAM(0);
  PROBE_MARK(1); if (IN(1)) {
    pg8::Gemm g{(const bf16_t*)(ws + WS_XN), (const bf16_t*)(ws + WS_WIN), DM, DM};
    pg8::StaticOrder S; S.init(T_TOK, 3072, F.G, (int)blockIdx.x);
    PREF p = KP; EpiInProj E{(bf16_t*)(ws + WS_H), (float*)(ws + WS_GATES), p.dq_norm, p.dk_norm, p.nq_norm, p.nk_norm, p.gate_bias};
    pg8::gemm_phase<EpiInProj, pg8::StaticOrder, true>(F.lds + RING_OFF, g, S, E);
  } SEAM(1);
  PROBE_MARK(2); if (IN(2)) { phase_compress(KP, F); phase_diffattn(KP, F); } SEAM(2);
  PROBE_MARK(3); if (IN(3)) { phase_nsa(KP, F); } SEAM(3);
  PROBE_MARK(4); if (IN(4)) {
    pg8::Gemm g{(const bf16_t*)(ws + WS_CAT), (const bf16_t*)(ws + WS_WOUT), DM, DM};
    pg8::StaticOrder S; S.init(T_TOK, DM, F.G, (int)blockIdx.x);
    PREF p = KP; EpiResid E{p.x, nullptr, (bf16_t*)p.out, nullptr};
    pg8::gemm_phase<EpiResid, pg8::StaticOrder, false>(F.lds + RING_OFF, g, S, E);
  } SEAM(4);
#define MOE_PHASES(layer, pb) do { \
    PROBE_MARK(pb); if (IN(pb)) { phase_router(KP, F, layer); } SEAM(pb); \
    PROBE_MARK(pb + 1); if (IN(pb + 1)) { \
      pg8::Gemm g{(const bf16_t*)(ws + WS_XN2), (const bf16_t*)(ws + WS_EGU), DM, DM}; \
      pg8::moe_order_setup((LAS int*)(F.lds + MISC_OFF + 256), (const unsigned*)(ws + WS_CTL) + CW_CNT + layer * 32 * 64); pg8::MoeOrder<2, true> S{(const LAS int*)(F.lds + MISC_OFF + 256), (const int*)(ws + WS_LIST), F.G, (int)blockIdx.x}; \
      EpiMoeGU E{(bf16_t*)(ws + WS_HID)}; \
      pg8::gemm_phase<EpiMoeGU, pg8::MoeOrder<2, true>, true>(F.lds + RING_OFF, g, S, E); \
    } SEAM(pb + 1); \
    PROBE_MARK(pb + 2); if (IN(pb + 2)) { \
      int k256 = 256; asm volatile("" : "+s"(k256)); \
      pg8::Gemm g{(const bf16_t*)(ws + WS_HID), (const bf16_t*)(ws + WS_EDN), k256, 256}; \
      pg8::moe_order_setup((LAS int*)(F.lds + MISC_OFF + 256), (const unsigned*)(ws + WS_CTL) + CW_CNT + layer * 32 * 64); pg8::MoeOrder<4, false> S{(const LAS int*)(F.lds + MISC_OFF + 256), (const int*)(ws + WS_LIST), F.G, (int)blockIdx.x}; \
      PREF p = KP; EpiMoeDown E{layer ? (bf16_t*)(ws + WS_X3) : (bf16_t*)p.out, (bf16_t*)(ws + WS_Y1), (const int*)(ws + WS_LIST), (const float*)(ws + WS_PGATE), (LAS int*)(F.lds + 132096)}; \
      pg8::gemm_phase<EpiMoeDown, pg8::MoeOrder<4, false>, true>(F.lds + RING_OFF, g, S, E); \
    } SEAM(pb + 2); \
  } while (0)
  MOE_PHASES(0, 5);
  PROBE_MARK(8); if (IN(8)) { phase_rwkv_prep(KP, F); } SEAM(8);
  PROBE_MARK(9); if (IN(9)) {
    pg8::Gemm g{(const bf16_t*)(ws + WS_S0 + 3 * SLOT), (const bf16_t*)(ws + WS_WL1), DM, DM};
    pg8::TallOrder S; S.init(3, 1, F.G, (int)blockIdx.x);
    EpiLora1 E{(bf16_t*)(ws + WS_TMP)};
    pg8::gemm_phase<EpiLora1, pg8::TallOrder, false>(F.lds + RING_OFF, g, S, E);
  } SEAM(9);
  PROBE_MARK(10); if (IN(10)) {
    pg8::Gemm g{(const bf16_t*)(ws + WS_S0), (const bf16_t*)(ws + WS_WRKV), DM, DM};
    pg8::TallOrder S; S.init(3, 4, F.G, (int)blockIdx.x);
    EpiRKV E{ws};
    pg8::gemm_phase<EpiRKV, pg8::TallOrder, true>(F.lds + RING_OFF, g, S, E);
  } SEAM(10);
  PROBE_MARK(11); if (IN(11)) {
    phase_lora2(KP, F);
  } SEAM(11);
  PROBE_MARK(12); if (IN(12)) { phase_rwkv_r1(KP, F); } SEAM(12);
  PROBE_MARK(13); if (IN(13)) { phase_rwkv_r2(KP, F); } SEAM(13);
  PROBE_MARK(14); if (IN(14)) { phase_rwkv_r3(KP, F); } SEAM(14);
  PROBE_MARK(15); if (IN(15)) {
    pg8::Gemm g{(const bf16_t*)(ws + WS_S0 + 3 * SLOT), (const bf16_t*)(ws + WS_WO), DM, DM};
    pg8::StaticOrder S; S.init(T_TOK, DM, F.G, (int)blockIdx.x);
    PREF p = KP; EpiResid E{nullptr, (const bf16_t*)p.out, (bf16_t*)(ws + WS_X3), (const bf16_t*)(ws + WS_Y1)};
    pg8::gemm_phase<EpiResid, pg8::StaticOrder, false>(F.lds + RING_OFF, g, S, E);
  } SEAM(15);
  MOE_PHASES(1, 16);
#undef MOE_PHASES
  PROBE_MARK(19); if (IN(19)) { phase_final(KP, F); }
  PROBE_MARK(20);
#ifdef PROBE_PH
  { const unsigned long long dur = (F.pr_t1 - F.pr_t0) * PROBE_MUL, t0 = __builtin_amdgcn_s_memrealtime(); while (__builtin_amdgcn_s_memrealtime() - t0 < dur) __builtin_amdgcn_s_sleep(8); }
#endif
#undef IN
#undef SEAM
}

static void launch_mk(P p, int lo, int hi, int li, int grid, hipStream_t st) {
  p.ph_lo = lo; p.ph_hi = hi; p.pad = li;
  hipLaunchKernelGGL(mk_fwd, dim3(grid), dim3(NWAVES * 64), LDS_BYTES, st, p);
}

extern "C" void kernel_launch(void* const* d_in, const int* in_sizes, int n_in, void* d_out, int out_size, void* d_ws,
                              size_t ws_size, hipStream_t stream) {
  static int grid = 0;
  if (grid == 0) {
    if (n_in != 40 || ws_size < WS_END) { fprintf(stderr, "kernel_launch: bad n_in %d or ws_size %zu (< %zu)\n", n_in, ws_size, (size_t)WS_END); grid = -1; return; }
    int dev = 0, cus = 0;
    if (hipGetDevice(&dev) != hipSuccess || hipDeviceGetAttribute(&cus, hipDeviceAttributeMultiprocessorCount, dev) != hipSuccess) { grid = -1; return; }
    if (hipFuncSetAttribute((const void*)mk_fwd, hipFuncAttributeMaxDynamicSharedMemorySize, LDS_BYTES) != hipSuccess) { grid = -1; return; }
    if (cus < 256) { fprintf(stderr, "kernel_launch: needs 256 CUs (one workgroup per CU), found %d\n", cus); grid = -1; return; }
    grid = 256;
  }
  if (grid < 0) return;
  P p{};
  const float* const* in = (const float* const*)d_in;
  p.x = in[0]; p.mix_norm = in[1]; p.w_in = in[2]; p.gate_bias = in[3]; p.dq_norm = in[4]; p.dk_norm = in[5];
  p.dlam = in[6]; p.dsubln = in[7]; p.nq_norm = in[8]; p.nk_norm = in[9]; p.cmp_pe = in[10]; p.cmp_w1 = in[11];
  p.cmp_w2 = in[12]; p.w_out = in[13]; p.rmix = in[14]; p.w_r = in[15]; p.w_k = in[16]; p.w_v = in[17];
  p.w0 = in[18]; p.w1 = in[19]; p.w2 = in[20]; p.a0 = in[21]; p.a1 = in[22]; p.a2 = in[23]; p.g1 = in[24]; p.g2 = in[25];
  p.k_k = in[26]; p.k_a = in[27]; p.r_k = in[28]; p.ln_w = in[29]; p.ln_b = in[30]; p.w_o = in[31];
  p.ffn_norm = in[32]; p.rg_w = in[33]; p.rg_b = in[34]; p.re_w = in[35]; p.re_b = in[36];
  p.e_gate = in[37]; p.e_up = in[38]; p.e_down = in[39];
  p.out = (float*)d_out;
  p.ws = (unsigned char*)d_ws;
  unsigned char* ws = p.ws;
  (void)hipMemsetAsync(ws + WS_CTL, 0, CTL_ZERO_BYTES, stream);
  launch_mk(p, 0, 20, 0, grid, stream);
}
```

```cpp
#include <hip/hip_runtime.h>
#include <cstdio>
#include <cstdint>

#define T_TOK 16384
#define DM 1024
#define SEQ 4096
#define NBATCH 4
#define INC 2840
#define HC 2816
#define OFF_DQ 0
#define OFF_DK 512
#define OFF_DV 1024
#define OFF_NQ 1536
#define OFF_NKV 2048
#define OFF_NG 2816
#define NCMP 255
#define CAP 16384

#define GAS __attribute__((address_space(1)))
#define LAS __attribute__((address_space(3)))
typedef unsigned short bf16_t;
typedef unsigned v4u __attribute__((ext_vector_type(4)));
typedef unsigned v2u __attribute__((ext_vector_type(2)));
typedef float f32x4 __attribute__((ext_vector_type(4)));
typedef short bf16x8 __attribute__((ext_vector_type(8)));
typedef GAS unsigned gu32;
#define RLX_AGENT __ATOMIC_RELAXED, __HIP_MEMORY_SCOPE_AGENT
#define LDS_WAIT() asm volatile("s_waitcnt lgkmcnt(0)" ::: "memory")
#define VM_WAIT() asm volatile("s_waitcnt vmcnt(0)" ::: "memory")

__device__ __forceinline__ float bf2f(bf16_t v) { return __uint_as_float(((unsigned)v) << 16); }

typedef float f32x2_t __attribute__((ext_vector_type(2))); typedef __bf16 bf16x2_t __attribute__((ext_vector_type(2)));
__device__ __forceinline__ unsigned pk2(float lo, float hi) { const f32x2_t v = {lo, hi}; return __builtin_bit_cast(unsigned, __builtin_convertvector(v, bf16x2_t)); }
__device__ __forceinline__ unsigned f2bf(float f) { return pk2(f, f) & 0xffffu; }
__device__ __forceinline__ float wave_sum(float v) {
#pragma unroll
  for (int o = 32; o >= 1; o >>= 1) v += __shfl_xor(v, o, 64);
  return v;
}
__device__ __forceinline__ float wave_sum_dpp(float v) {
  v += __builtin_bit_cast(float, __builtin_amdgcn_update_dpp(0, __builtin_bit_cast(int, v), 0xB1, 0xf, 0xf, false));
  v += __builtin_bit_cast(float, __builtin_amdgcn_update_dpp(0, __builtin_bit_cast(int, v), 0x4E, 0xf, 0xf, false));
  v += __builtin_bit_cast(float, __builtin_amdgcn_update_dpp(0, __builtin_bit_cast(int, v), 0x141, 0xf, 0xf, false));
  v += __builtin_bit_cast(float, __builtin_amdgcn_update_dpp(0, __builtin_bit_cast(int, v), 0x140, 0xf, 0xf, false));
  const int iv = __builtin_bit_cast(int, v);
  return (__builtin_bit_cast(float, __builtin_amdgcn_readlane(iv, 0)) + __builtin_bit_cast(float, __builtin_amdgcn_readlane(iv, 16))) +
         (__builtin_bit_cast(float, __builtin_amdgcn_readlane(iv, 32)) + __builtin_bit_cast(float, __builtin_amdgcn_readlane(iv, 48)));
}
__device__ __forceinline__ int fresh_lane() { int l; asm volatile("v_mbcnt_lo_u32_b32 %0, -1, 0\n\tv_mbcnt_hi_u32_b32 %0, -1, %0" : "=v"(l)); return l; }
__device__ __forceinline__ float uniformf(float v) { return __builtin_bit_cast(float, __builtin_amdgcn_readfirstlane(__builtin_bit_cast(int, v))); }
__device__ __forceinline__ float sum_x32(float v) { const auto rr = __builtin_amdgcn_permlane32_swap(__float_as_uint(v), __float_as_uint(v), false, false); return __uint_as_float(rr[0]) + __uint_as_float(rr[1]); }
__device__ __forceinline__ float sum_x16(float v) { const auto rr = __builtin_amdgcn_permlane16_swap(__float_as_uint(v), __float_as_uint(v), false, false); return __uint_as_float(rr[0]) + __uint_as_float(rr[1]); }
__device__ __forceinline__ float sum_x16_32(float v) { return sum_x32(sum_x16(v)); }
__device__ __forceinline__ float sigmoidf_(float x) { return __builtin_amdgcn_rcpf(1.f + __builtin_amdgcn_exp2f(-1.44269504f * x)); }
__device__ __forceinline__ float tanhf_(float x) { return 1.f - 2.f * __builtin_amdgcn_rcpf(1.f + __builtin_amdgcn_exp2f(2.88539008f * x)); }
__device__ __forceinline__ float softplusf_(float x) { return fmaxf(x, 0.f) + __logf(1.f + __expf(-fabsf(x))); }
__device__ __forceinline__ float gelu_tanh(float x) {
  float u = 0.7978845608028654f * (x + 0.044715f * x * x * x);
  return 0.5f * x * (1.f + tanhf(u));
}

constexpr size_t MiB = 1u << 20;
constexpr size_t WS_CTL = 0, CTL_ZERO_BYTES = 160 * 1024;
constexpr size_t WS_WIN = 1 * MiB;
constexpr size_t WS_WOUT = 7 * MiB;
constexpr size_t WS_WRKV = 9 * MiB;
constexpr size_t WS_WO = 15 * MiB;
constexpr size_t WS_WL1 = 17 * MiB;
constexpr size_t WS_WL2 = 19 * MiB;
constexpr size_t WS_WR = 20 * MiB;
constexpr size_t WS_EGU = 22 * MiB;
constexpr size_t WS_EDN = 54 * MiB;
constexpr size_t WS_ACT = 70 * MiB;
constexpr size_t WS_XN = WS_ACT;
constexpr size_t WS_H = WS_ACT + 32 * MiB;
constexpr size_t WS_GATES = WS_ACT + 120 * MiB;
constexpr size_t WS_CAT = WS_ACT + 122 * MiB;
constexpr size_t WS_KCMPB = WS_ACT + 154 * MiB;
constexpr size_t WS_VCMPB = WS_ACT + 155 * MiB;
constexpr size_t WS_CW1 = 21 * MiB + 256 * 1024;
constexpr size_t WS_XN2 = WS_ACT;
constexpr size_t WS_HID = WS_ACT + 32 * MiB;
constexpr size_t WS_Y1 = WS_EGU;
constexpr size_t WS_LIST = WS_ACT + 156 * MiB;
constexpr size_t WS_PGATE = WS_ACT + 158 * MiB;
constexpr size_t WS_X3 = WS_ACT + 64 * MiB;
constexpr size_t WS_XN2F = WS_ACT;
constexpr size_t WS_GUF = WS_ACT + 64 * MiB;
constexpr size_t WS_S0 = WS_ACT;
constexpr size_t WS_TMP = WS_ACT + 192 * MiB;
constexpr size_t WS_END = WS_ACT + 204 * MiB;
constexpr size_t SLOT = 32 * MiB;
constexpr int CW_BAR = 4096;
constexpr int CW_CNT = 32768;

namespace pg8 {
#define PG8_LAS __attribute__((address_space(3)))
typedef unsigned u32x4 __attribute__((ext_vector_type(4)));
constexpr int BM = 256, BK = 64, HALF = 128, HTB = HALF * BK * 2  , STAGE_BYTES = 8 * HTB, NXCD = 8, WGM = 8;

__host__ __device__ __forceinline__ int lds_byte(int r, int c) { const int st = (r >> 4) * 2 + (c >> 5), rr = r & 15, cc = c & 31, ob = rr * 64 + cc * 2; return st * 1024 + (ob ^ (((ob >> 9) & 1) << 5)); }
__host__ __device__ __forceinline__ void stage_rc(int b, int& R, int& C) { const int st = b / 1024, sb = b % 1024, swz = sb ^ (((sb >> 9) & 1) << 5); R = (st >> 1) * 16 + swz / 64; C = (st & 1) * 32 + (swz % 64) / 2; }
__host__ __device__ __forceinline__ int perm32(int rho) { const int n = rho >> 4, i = rho & 15; return 8 * (i >> 2) + 4 * n + (i & 3); }

struct Unit { int pm, pn, e, nrows, rt, par; };
struct Gemm { const bf16_t* A; const bf16_t* Bt; int K; int lda; };

__device__ __forceinline__ void static_map(int L, int nM, int nN, int& pm, int& pn) {
    const int nwg = nM * nN;
    int wgid = L; { const int q = nwg / NXCD, r = nwg % NXCD, xcd = wgid % NXCD, off = wgid / NXCD; wgid = (xcd < r ? xcd * (q + 1) : r * (q + 1) + (xcd - r) * q) + off; }
    const int nig = WGM * nN, gid = wgid / nig, fm = gid * WGM, gsz = (nM - fm) < WGM ? (nM - fm) : WGM;
    pm = fm + ((wgid % nig) % gsz); pn = (wgid % nig) / gsz;
}
struct StaticOrder {
    int nM, nN, G, c;
    __device__ void init(int M, int N, int G_, int c_) { nM = M / BM; nN = N / BM; G = G_; c = c_; }
    __device__ __forceinline__ bool next(int i, Unit& u) const {
        const int L = i * G + c; if (L >= nM * nN) return false;
        static_map(L, nM, nN, u.pm, u.pn); u.e = 0; u.nrows = 256; u.rt = 0; return true;
    }
    __device__ __forceinline__ unsigned rowoff(const Unit& u, int r, int C, int K) const { return (unsigned)((u.pm * BM + r) * K + C) * 2u; }
};
struct TallOrder {
    int nM, nN, G, c;
    __device__ void init(int ngemm, int nN_, int G_, int c_) { nM = 64 * ngemm; nN = nN_; G = G_; c = c_; }
    __device__ __forceinline__ bool next(int i, Unit& u) const {
        const int L = i * G + c; if (L >= nM * nN) return false;
        int pn; static_map(L, nM, nN, u.pm, pn); u.pn = (u.pm >> 6) * nN + pn; u.e = 0; u.nrows = 256; u.rt = 0; return true;
    }
    __device__ __forceinline__ unsigned rowoff(const Unit& u, int r, int C, int K) const { return (unsigned)((u.pm * BM + r) * K + C) * 2u; }
};


template <int NCOL, bool GATHER>
struct MoeOrder {
    const PG8_LAS int* tab;
    const int* list; int G, c;
    __device__ __forceinline__ bool next(int i, Unit& u) const {
        const int L = i * G + c; const int R = L / NCOL, j = L - R * NCOL;
        if (R >= tab[32]) return false;
        int e = 0;
#pragma unroll
        for (int s = 16; s >= 1; s >>= 1) { if (tab[e + s] <= R) e += s; }
        const int ce = tab[33 + e];
        u.pm = R; u.rt = R - tab[e]; u.e = e; u.pn = e * NCOL + j; u.nrows = ce - u.rt * 256; return true;
    }
    __device__ __forceinline__ unsigned rowoff(const Unit& u, int r, int C, int K) const {
        if (GATHER) { const int idx = (r < u.nrows) ? u.rt * 256 + r : 0; const int pr = list[(size_t)u.e * CAP + idx]; return (unsigned)((pr >> 1) * K + C) * 2u; }
        return (unsigned)((u.pm * BM + r) * K + C) * 2u;
    }
};
__device__ __forceinline__ void moe_order_setup(PG8_LAS int* tab, const unsigned* cnt) {
    if (threadIdx.x < 32) tab[33 + threadIdx.x] = (int)__hip_atomic_load(cnt + threadIdx.x * 64, __ATOMIC_RELAXED, __HIP_MEMORY_SCOPE_AGENT);
    __syncthreads();
    if (threadIdx.x == 0) { int pre = 0; for (int e = 0; e < 32; ++e) { tab[e] = pre; pre += (tab[33 + e] + 255) >> 8; } tab[32] = pre; }
    __syncthreads();
}

__device__ __forceinline__ unsigned cvt_pk_bf16(float lo, float hi) { unsigned r; asm volatile("v_cvt_pk_bf16_f32 %0, %1, %2" : "=v"(r) : "v"(lo), "v"(hi)); return r; }
__device__ __forceinline__ u32x4 pack8(const f32x4& a, const f32x4& b) { u32x4 w; w.x = cvt_pk_bf16(a[0], a[1]); w.y = cvt_pk_bf16(a[2], a[3]); w.z = cvt_pk_bf16(b[0], b[1]); w.w = cvt_pk_bf16(b[2], b[3]); return w; }

template <class Epi, class Sched, bool ALIGN_EPI>
__device__ __forceinline__ void gemm_phase(PG8_LAS unsigned char* lds, const Gemm g, const Sched& S, const Epi& E) {
    const int tid = threadIdx.x, wid = __builtin_amdgcn_readfirstlane(tid >> 6), lane = tid & 63, wr = wid >> 2, wc = wid & 3, fr = lane & 15, fq = lane >> 4;
    const int K = g.K, nt = K / BK;
    int RA[2], CA[2]; unsigned voffB[2];
#pragma unroll
    for (int i = 0; i < 2; ++i) { int R, C; stage_rc(tid * 16 + i * 8192, R, C); const int Rb = Epi::PERM ? ((R & ~31) + perm32(R & 31)) : R;
        RA[i] = R; CA[i] = C; voffB[i] = (unsigned)(Rb * K + C) * 2u; }
    const size_t kstep = (size_t)(BK * 2);
    const size_t hstep = (size_t)HALF * K * 2;
    const size_t tstep = 2 * hstep;
    const unsigned ldsw = (unsigned)wid * 1024u;
    const int aoff = lds_byte(wr * 64 + fr, fq * 8), boff = lds_byte(wc * 32 + fr, fq * 8);
    const char* const Abase = (const char*)g.A;
#define PG8_SA(b, h) (((b) * 2 + (h)) * HTB)
#define PG8_SB(b, h) ((4 + (b) * 2 + (h)) * HTB)
#define PG8_STAGE(bufoff, gbase, voff) do { _Pragma("unroll") for (int _i = 0; _i < 2; ++_i) \
        __builtin_amdgcn_global_load_lds((const unsigned*)((const char*)(gbase) + (voff)[_i]), (PG8_LAS unsigned*)(lds + (bufoff) + ldsw + _i * 8192), 16, 0, 0); } while (0)
#define PG8_STAGEA(bufoff, kbyte, o0, o1) do { \
        __builtin_amdgcn_global_load_lds((const unsigned*)(Abase + (size_t)(kbyte) + (o0)), (PG8_LAS unsigned*)(lds + (bufoff) + ldsw), 16, 0, 0); \
        __builtin_amdgcn_global_load_lds((const unsigned*)(Abase + (size_t)(kbyte) + (o1)), (PG8_LAS unsigned*)(lds + (bufoff) + ldsw + 8192), 16, 0, 0); } while (0)
#define PG8_LDA(dst, b, h) do { _Pragma("unroll") for (int m = 0; m < 4; ++m) _Pragma("unroll") for (int k = 0; k < 2; ++k) dst[m][k] = *(const PG8_LAS bf16x8*)(lds + PG8_SA(b, h) + aoff + m * 2048 + k * 1024); } while (0)
#define PG8_LDB(dst, b, h) do { _Pragma("unroll") for (int n = 0; n < 2; ++n) _Pragma("unroll") for (int k = 0; k < 2; ++k) dst[n][k] = *(const PG8_LAS bf16x8*)(lds + PG8_SB(b, h) + boff + n * 2048 + k * 1024); } while (0)
#define PG8_MMA(ai, bj, At, Bt) do { __builtin_amdgcn_s_setprio(1); _Pragma("unroll") for (int m = 0; m < 4; ++m) _Pragma("unroll") for (int n = 0; n < 2; ++n) _Pragma("unroll") for (int k = 0; k < 2; ++k) \
        acc[ai][bj][m][n] = __builtin_amdgcn_mfma_f32_16x16x32_bf16(Bt[n][k], At[m][k], acc[ai][bj][m][n], 0, 0, 0); __builtin_amdgcn_s_setprio(0); } while (0)
#define PG8_WAIT_V(n) asm volatile("s_waitcnt vmcnt(" #n ")" ::: "memory")
#define PG8_WAIT_L(n) asm volatile("s_waitcnt lgkmcnt(" #n ")" ::: "memory")
#define PG8_BAR __builtin_amdgcn_s_barrier()
#define PG8_SCHED __builtin_amdgcn_sched_barrier(0)
    Unit cur, nxt; int ui = 0;
    if (!S.next(0, cur)) return;
    cur.par = 0;
    if constexpr (Epi::HAS_PRE) E.pre(cur);
    f32x4 acc[2][2][4][2];
#pragma unroll
    for (int a = 0; a < 2; ++a)
#pragma unroll
        for (int b = 0; b < 2; ++b)
#pragma unroll
            for (int m = 0; m < 4; ++m)
#pragma unroll
                for (int n = 0; n < 2; ++n) acc[a][b][m][n] = (f32x4){0.f, 0.f, 0.f, 0.f};
    bf16x8 At[4][2], B0[2][2], B1[2][2];
    unsigned c00 = S.rowoff(cur, RA[0], CA[0], g.lda), c01 = S.rowoff(cur, RA[1], CA[1], g.lda), c10 = S.rowoff(cur, HALF + RA[0], CA[0], g.lda), c11 = S.rowoff(cur, HALF + RA[1], CA[1], g.lda);
    unsigned n00, n01, n10, n11;
    const char* cB = (const char*)g.Bt + (size_t)cur.pn * tstep;
    PG8_STAGE(PG8_SB(0, 0), cB, voffB); PG8_STAGE(PG8_SB(0, 1), cB + hstep, voffB); PG8_STAGEA(PG8_SA(0, 0), 0, c00, c01); PG8_STAGEA(PG8_SA(0, 1), 0, c10, c11);
    if (wr == 1) PG8_BAR;
    PG8_WAIT_V(2); PG8_BAR;
    PG8_STAGE(PG8_SB(1, 0), cB + kstep, voffB); PG8_STAGEA(PG8_SA(1, 0), kstep, c00, c01); PG8_STAGE(PG8_SB(1, 1), cB + hstep + kstep, voffB);
    PG8_WAIT_V(6); PG8_BAR;
    for (;;) {
        const bool has_next = S.next(ui + 1, nxt);
        const char* nB = has_next ? (const char*)g.Bt + (size_t)nxt.pn * tstep : cB;
        if (has_next) { n00 = S.rowoff(nxt, RA[0], CA[0], g.lda); n01 = S.rowoff(nxt, RA[1], CA[1], g.lda); n10 = S.rowoff(nxt, HALF + RA[0], CA[0], g.lda); n11 = S.rowoff(nxt, HALF + RA[1], CA[1], g.lda); }
        else { n00 = c00; n01 = c01; n10 = c10; n11 = c11; }
        for (int t = 0; t < nt; t += 2) {
            const bool last = (t == nt - 2);
            const size_t k1 = (size_t)(t + 1) * kstep;
            const size_t k2 = last ? 0 : (size_t)(t + 2) * kstep;
            const size_t k3 = k2 + kstep;
            const unsigned a00 = last ? n00 : c00, a01 = last ? n01 : c01, a10 = last ? n10 : c10, a11 = last ? n11 : c11;
            const char* b2 = last ? nB : cB + (size_t)(t + 2) * kstep;
            const char* b3 = b2 + kstep;
            PG8_LDB(B0, 0, 0); PG8_LDB(B1, 0, 1); PG8_SCHED; PG8_LDA(At, 0, 0); PG8_STAGEA(PG8_SA(1, 1), k1, c10, c11);
            PG8_WAIT_V(8); PG8_WAIT_L(0); PG8_BAR; PG8_MMA(0, 0, At, B0); PG8_MMA(0, 1, At, B1); PG8_BAR; PG8_SCHED;
            PG8_LDA(At, 0, 1); PG8_STAGE(PG8_SB(0, 0), b2, voffB); PG8_STAGE(PG8_SB(0, 1), b2 + hstep, voffB); PG8_STAGEA(PG8_SA(0, 0), k2, a00, a01);
            PG8_WAIT_V(8); PG8_WAIT_L(0); PG8_BAR; PG8_MMA(1, 0, At, B0); PG8_MMA(1, 1, At, B1); PG8_BAR; PG8_SCHED;
            PG8_LDB(B0, 1, 0); PG8_LDB(B1, 1, 1); PG8_SCHED; PG8_LDA(At, 1, 0); PG8_STAGEA(PG8_SA(0, 1), k2, a10, a11);
            PG8_WAIT_V(8); PG8_WAIT_L(0); PG8_BAR; PG8_MMA(0, 0, At, B0); PG8_MMA(0, 1, At, B1); PG8_BAR; PG8_SCHED;
            PG8_LDA(At, 1, 1); PG8_STAGE(PG8_SB(1, 0), b3, voffB); PG8_STAGE(PG8_SB(1, 1), b3 + hstep, voffB); PG8_STAGEA(PG8_SA(1, 0), k3, a00, a01);
            PG8_WAIT_V(8); PG8_WAIT_L(0); PG8_BAR; PG8_MMA(1, 0, At, B0); PG8_MMA(1, 1, At, B1); PG8_BAR; PG8_SCHED;
        }
        if constexpr (ALIGN_EPI) { if (wr == 0) PG8_BAR; }
        E(acc, cur, wr, wc, fr, fq);
        if (!has_next) break;
#pragma unroll
        for (int a = 0; a < 2; ++a)
#pragma unroll
            for (int b = 0; b < 2; ++b)
#pragma unroll
                for (int m = 0; m < 4; ++m)
#pragma unroll
                    for (int n = 0; n < 2; ++n) acc[a][b][m][n] = (f32x4){0.f, 0.f, 0.f, 0.f};
        cur = nxt; cB = nB; c00 = n00; c01 = n01; c10 = n10; c11 = n11; ++ui; cur.par = ui & 1;
        if constexpr (Epi::HAS_PRE) E.pre(cur);
        if constexpr (ALIGN_EPI) { if (wr == 1) PG8_BAR; }
    }
    PG8_WAIT_V(0);
    if constexpr (!ALIGN_EPI) { if (wr == 0) PG8_BAR; }
    PG8_BAR;
#undef PG8_SA
#undef PG8_SB
#undef PG8_STAGE
#undef PG8_STAGEA
#undef PG8_LDA
#undef PG8_LDB
#undef PG8_MMA
#undef PG8_WAIT_V
#undef PG8_WAIT_L
#undef PG8_BAR
#undef PG8_SCHED
}
}

#define XB_TMO      128
#define XB_XCNT(j)  (256  + 64 * (j))
#define XB_XSUB(j)  (1280 + 64 * (j))
#define XB_XGEN(j)  (2304 + 64 * (j))
#define XB_TOP      3328
#define XB_TOPGEN   3392
#define XCD_BAR_WORDS 3456
#define XB_SPIN_CAP (1u << 18)

__device__ __forceinline__ unsigned xb_ld(unsigned* p)              { return __hip_atomic_load(p, __ATOMIC_RELAXED, __HIP_MEMORY_SCOPE_AGENT); }
__device__ __forceinline__ unsigned xb_add(unsigned* p, unsigned v) { return __hip_atomic_fetch_add(p, v, __ATOMIC_RELAXED, __HIP_MEMORY_SCOPE_AGENT); }
__device__ __forceinline__ unsigned xb_xcc_id() { return (unsigned)__builtin_amdgcn_s_getreg((3 << 11) | 20) & 0xFu; }
#define XB_SPIN(cond, bar) do { unsigned _sp = 0; while (cond) { __builtin_amdgcn_s_sleep(1); \
    if ((++_sp & 255u) == 0u) { if (xb_ld(&(bar)[XB_TMO])) break; if (_sp > XB_SPIN_CAP) { atomicAdd(&(bar)[XB_TMO], 1u); break; } } } } while (0)

struct XcdBarrier {
    unsigned* bar; unsigned x;
    volatile LAS unsigned* st;
};

__device__ __forceinline__ XcdBarrier xcd_barrier_post(unsigned* bar, volatile LAS unsigned* st) {
    XcdBarrier b; b.bar = bar; b.x = xb_xcc_id(); b.st = st;
    if (threadIdx.x == 0) (void)xb_add(&bar[XB_XCNT(b.x)], 1u);
    return b;
}
__device__ __forceinline__ void xcd_barrier_complete(unsigned* bar, unsigned x, unsigned& nloc, unsigned& nx) {
    const unsigned G = gridDim.x * gridDim.y * gridDim.z;
    unsigned sum, cnt, mine, sp = 0u;
    for (;;) {
        sum = 0u; cnt = 0u; mine = 0u;
#pragma unroll
        for (unsigned j = 0; j < 16; ++j) { const unsigned c = xb_ld(&bar[XB_XCNT(j)]); sum += c; cnt += (c > 0u) ? 1u : 0u; mine = (j == x) ? c : mine; }
        if (sum == G) break;
        __builtin_amdgcn_s_sleep(1);
        if ((++sp & 255u) == 0u) { if (xb_ld(&bar[XB_TMO])) break; if (sp > XB_SPIN_CAP) { atomicAdd(&bar[XB_TMO], 1u); break; } }
    }
    nloc = mine > 0u ? mine : 1u; nx = cnt > 0u ? cnt : 1u;
}

__device__ __forceinline__ void xcd_barrier(const XcdBarrier& b) {
    asm volatile("s_waitcnt vmcnt(0)" ::: "memory");
    __syncthreads();
    if (threadIdx.x == 0) {
        unsigned* bar = b.bar;
        __builtin_amdgcn_s_waitcnt(0);
        unsigned nloc = b.st[0], nx = b.st[1];
        if (nloc == 0u) { xcd_barrier_complete(bar, b.x, nloc, nx); b.st[0] = nloc; b.st[1] = nx; }
        const unsigned old = xb_add(&bar[XB_XSUB(b.x)], 1u);
        const unsigned gen = old / nloc;
        if (old + 1u == (gen + 1u) * nloc) {
            __builtin_amdgcn_fence(__ATOMIC_RELEASE, "agent");
            asm volatile("s_waitcnt vmcnt(0)" ::: "memory");
            const unsigned og = xb_add(&bar[XB_TOP], 1u);
            const unsigned tg = og / nx;
            if (og + 1u == (tg + 1u) * nx) xb_add(&bar[XB_TOPGEN], 1u);
            else XB_SPIN(xb_ld(&bar[XB_TOPGEN]) == tg, bar);
            __builtin_amdgcn_fence(__ATOMIC_ACQUIRE, "agent");
            xb_add(&bar[XB_XGEN(b.x)], 1u);
            asm volatile("s_waitcnt vmcnt(0)" ::: "memory");
        } else {
            XB_SPIN(xb_ld(&bar[XB_XGEN(b.x)]) == gen, bar);
            __builtin_amdgcn_fence(__ATOMIC_ACQUIRE, "agent");
            asm volatile("s_waitcnt vmcnt(0)" ::: "memory");
        }
    }
    __syncthreads();
}
struct P {
  const float* x; const float* mix_norm; const float* w_in; const float* gate_bias;
  const float* dq_norm; const float* dk_norm; const float* dlam; const float* dsubln;
  const float* nq_norm; const float* nk_norm; const float* cmp_pe; const float* cmp_w1; const float* cmp_w2;
  const float* w_out;
  const float* rmix; const float* w_r; const float* w_k; const float* w_v;
  const float* w0; const float* w1; const float* w2; const float* a0; const float* a1; const float* a2;
  const float* g1; const float* g2; const float* k_k; const float* k_a; const float* r_k;
  const float* ln_w; const float* ln_b; const float* w_o;
  const float* ffn_norm; const float* rg_w; const float* rg_b; const float* re_w; const float* re_b;
  const float* e_gate; const float* e_up; const float* e_down;
  float* out;
  unsigned char* ws;
  int ph_lo, ph_hi, layer, pad;
};

#define PREF const __attribute__((address_space(4))) P&
__device__ __forceinline__ const __attribute__((address_space(4))) P* opaque_kernarg() { auto q = __builtin_amdgcn_kernarg_segment_ptr(); asm volatile("" : "+s"(q)); return (const __attribute__((address_space(4))) P*)q; }
#define KP (*opaque_kernarg())

constexpr int RING_OFF = 0, RING_BYTES = 131072;
constexpr int LDSCTL_OFF = RING_BYTES, MISC_OFF = LDSCTL_OFF + 320;
constexpr int LDS_BYTES = 147456;
constexpr int NWAVES = 8;

struct Frame {
  LAS unsigned char* lds;
  volatile LAS unsigned* MISC;
  gu32* ctl;
  int tid, lane, wave, vcu, G;
#ifdef PROBE_PH
  unsigned long long pr_t0, pr_t1;
#endif
};
#ifdef PROBE_PH
#define PROBE_MARK(k) do { if ((k) == PROBE_PH) F.pr_t0 = __builtin_amdgcn_s_memrealtime(); if ((k) == PROBE_PH + PROBE_N) F.pr_t1 = __builtin_amdgcn_s_memrealtime(); } while (0)
#else
#define PROBE_MARK(k) do {} while (0)
#endif

__device__ __forceinline__ void transpose_item(const float* W, int ldsrc, int k0, int c0, int ncols, bf16_t* dst, int ldk, int drow0, LAS float* scr, int lane) {
  const int kr = lane >> 3, c4 = (lane & 7) * 4;
  f32x4 v[8];
#pragma unroll
  for (int i = 0; i < 8; ++i) v[i] = (c4 < ncols) ? *(const GAS f32x4*)(W + (size_t)(k0 + kr + 8 * i) * ldsrc + c0 + c4) : (f32x4){0.f, 0.f, 0.f, 0.f};
#pragma unroll
  for (int i = 0; i < 8; ++i) { LAS float* s = scr + (kr + 8 * i) * 33 + c4; s[0] = v[i].x; s[1] = v[i].y; s[2] = v[i].z; s[3] = v[i].w; }
  LDS_WAIT(); asm volatile("" ::: "memory");
  const int c = lane & 7;
#pragma unroll
  for (int j = 0; j < 4; ++j) { const int n = (lane >> 3) + 8 * j; const LAS float* s = scr + (8 * c) * 33 + n;
    v4u o; o.x = pk2(s[0 * 33], s[1 * 33]); o.y = pk2(s[2 * 33], s[3 * 33]); o.z = pk2(s[4 * 33], s[5 * 33]); o.w = pk2(s[6 * 33], s[7 * 33]);
    *(GAS v4u*)(dst + (size_t)(drow0 + n) * ldk + k0 + 8 * c) = o; }
  LDS_WAIT(); asm volatile("" ::: "memory");
}
template <int NR>
__device__ __forceinline__ void rms_rows_to_bf16(const float* x, const float* gain, bf16_t* o, int m0, int stride, int lane) {
  f32x4 v[NR][4];
#pragma unroll
  for (int r = 0; r < NR; ++r) { const GAS f32x4* xr = (const GAS f32x4*)(x + (size_t)(m0 + r * stride) * DM) + lane;
#pragma unroll
    for (int j = 0; j < 4; ++j) v[r][j] = xr[64 * j]; }
  const GAS f32x4* gr = (const GAS f32x4*)gain + lane;
  f32x4 g[4];
#pragma unroll
  for (int j = 0; j < 4; ++j) g[j] = gr[64 * j];
#pragma unroll
  for (int r = 0; r < NR; ++r) {
    float s = 0.f;
#pragma unroll
    for (int j = 0; j < 4; ++j) s += (v[r][j].x * v[r][j].x + v[r][j].y * v[r][j].y) + (v[r][j].z * v[r][j].z + v[r][j].w * v[r][j].w);
    const float rr = rsqrtf(wave_sum_dpp(s) * (1.f / DM) + 1e-6f);
    GAS v2u* o8 = (GAS v2u*)(o + (size_t)(m0 + r * stride) * DM) + lane;
#pragma unroll
    for (int j = 0; j < 4; ++j) { v2u w; w.x = pk2(v[r][j].x * rr * g[j].x, v[r][j].y * rr * g[j].y); w.y = pk2(v[r][j].z * rr * g[j].z, v[r][j].w * rr * g[j].w); o8[64 * j] = w; }
  }
}

__device__ __forceinline__ void conv_win_item(PREF p, int it, LAS float* scr, int lane) {
  const int vg = it >> 4, kb = it & 15;
  const int pn = vg >> 3, bj = (vg >> 2) & 1, wc = vg & 3, s = pn * 4 + wc;
  int c0 = 0, nc = 0;
  if (s < 44) { c0 = 64 * s + 32 * bj; nc = 32; } else if (s == 44 && bj == 0) { c0 = OFF_NG; nc = 24; }
  transpose_item(p.w_in, INC, kb * 64, c0, nc, (bf16_t*)(p.ws + WS_WIN), DM, vg * 32, scr, lane);
}
__device__ __forceinline__ void conv_sq_item(const float* W, bf16_t* dst, int drow_base, int it, LAS float* scr, int lane) {
  const int cg = it >> 4, kb = it & 15;
  transpose_item(W, DM, kb * 64, cg * 32, 32, dst, DM, drow_base + cg * 32, scr, lane);
}
__device__ __forceinline__ void conv_expert_item(PREF p, int layer, int it, LAS float* scr, int lane, bf16_t* egu) {
  const int e = it / 384, r = it % 384;
  if (r < 256) {
    const int up = r >> 7, q = r & 127, cgp = q >> 4, kb = q & 15;
    const int pn = cgp >> 2, qq = cgp & 3;
    const float* W = (up ? p.e_up : p.e_gate) + ((size_t)layer * 32 + e) * DM * 256;
    transpose_item(W, 256, kb * 64, cgp * 32, 32, egu, DM, e * 512 + pn * 256 + up * 128 + qq * 32, scr, lane);
  } else {
    const int q = r - 256, cg = q >> 2, kb = q & 3;
    const float* W = p.e_down + ((size_t)layer * 32 + e) * 256 * DM;
    transpose_item(W, DM, kb * 64, cg * 32, 32, (bf16_t*)(p.ws + WS_EDN), 256, e * 1024 + cg * 32, scr, lane);
  }
}

using pg8::Unit; using pg8::u32x4; using pg8::pack8;
struct EpiInProj {
  static constexpr bool PERM = true, HAS_PRE = false;
  bf16_t* H; float* GATES; const float* dq; const float* dk; const float* nq; const float* nk; const float* gbias;
  __device__ __forceinline__ void operator()(const f32x4 (&acc)[2][2][4][2], const Unit& u, int wr, int wc, int fr, int fq) const {
    const int s = u.pn * 4 + wc;
    if (s > 44) return;
    const int row0 = u.pm * 256 + wr * 64 + fr;
    if (s == 44) {
      if (fq < 3) {
        f32x4 b0 = *(const f32x4*)(gbias + 8 * fq), b1 = *(const f32x4*)(gbias + 8 * fq + 4);
#pragma unroll
        for (int ai = 0; ai < 2; ++ai)
#pragma unroll
          for (int m = 0; m < 4; ++m) { float* gp = GATES + (size_t)(row0 + ai * 128 + m * 16) * 24 + 8 * fq;
            f32x4 v0 = acc[ai][0][m][0] + b0, v1 = acc[ai][0][m][1] + b1;
#pragma unroll
            for (int i = 0; i < 4; ++i) { v0[i] = sigmoidf_(v0[i]); v1[i] = sigmoidf_(v1[i]); }
            *(f32x4*)gp = v0; *(f32x4*)(gp + 4) = v1; }
      }
      return;
    }
    int mode = 0; const float* gain = nullptr;
    if (s < 8) { mode = 1; gain = dq; } else if (s < 16) { mode = 1; gain = dk; }
    else if (s >= 24 && s < 32) { mode = 2; gain = nq; }
    else if (s >= 32) { const int q = s - 32, br = q >> 2, kv = (q >> 1) & 1; if (kv == 0 && br >= 1) { mode = 2; gain = nk + br * 64; } }
    const float qsc = (s < 8) ? 0.17677669529663687f * 1.4426950408889634f : ((s >= 24 && s < 32) ? 0.125f * 1.4426950408889634f : 1.f);
    f32x4 g[2][2];
#pragma unroll
    for (int bj = 0; bj < 2; ++bj)
#pragma unroll
      for (int n = 0; n < 2; ++n) {
        if (mode == 1) g[bj][n] = *(const f32x4*)(gain + 8 * fq + 4 * n);
        else if (mode == 2) g[bj][n] = *(const f32x4*)(gain + 32 * bj + 8 * fq + 4 * n);
        else g[bj][n] = (f32x4){1.f, 1.f, 1.f, 1.f};
      }
#pragma unroll
    for (int ai = 0; ai < 2; ++ai)
#pragma unroll
      for (int m = 0; m < 4; ++m) {
        float sc[2] = {1.f, 1.f};
        if (mode != 0) {
          float ss[2];
#pragma unroll
          for (int bj = 0; bj < 2; ++bj) { const f32x4 a = acc[ai][bj][m][0], b = acc[ai][bj][m][1];
            float t = (a[0] * a[0] + a[1] * a[1]) + (a[2] * a[2] + a[3] * a[3]) + (b[0] * b[0] + b[1] * b[1]) + (b[2] * b[2] + b[3] * b[3]);
            ss[bj] = sum_x16_32(t); }
          if (mode == 1) { sc[0] = rsqrtf(ss[0] * (1.f / 32.f) + 1e-6f) * qsc; sc[1] = rsqrtf(ss[1] * (1.f / 32.f) + 1e-6f) * qsc; }
          else { const float r = rsqrtf((ss[0] + ss[1]) * (1.f / 64.f) + 1e-6f) * qsc; sc[0] = r; sc[1] = r; }
        }
        bf16_t* rowp = H + (size_t)(row0 + ai * 128 + m * 16) * HC + 64 * s + 8 * fq;
#pragma unroll
        for (int bj = 0; bj < 2; ++bj) { const f32x4 v0 = acc[ai][bj][m][0] * sc[bj] * g[bj][0], v1 = acc[ai][bj][m][1] * sc[bj] * g[bj][1];
          *(u32x4*)(rowp + 32 * bj) = pack8(v0, v1); }
      }
  }
};
struct EpiResid {
  static constexpr bool PERM = true, HAS_PRE = false;
  const float* xf; const bf16_t* xb; bf16_t* out; const bf16_t* y1;
  __device__ __forceinline__ void operator()(const f32x4 (&acc)[2][2][4][2], const Unit& u, int wr, int wc, int fr, int fq) const {
    const int row0 = u.pm * 256 + wr * 64 + fr, col0 = u.pn * 256 + wc * 32 + 8 * fq;
#pragma unroll
    for (int ai = 0; ai < 2; ++ai)
#pragma unroll
      for (int m = 0; m < 4; ++m) { const size_t off = (size_t)(row0 + ai * 128 + m * 16) * DM + col0;
#pragma unroll
        for (int bj = 0; bj < 2; ++bj) {
          f32x4 b0, b1;
          if (xf) { b0 = *(const f32x4*)(xf + off + bj * 128); b1 = *(const f32x4*)(xf + off + bj * 128 + 4); }
          else { const v4u w = *(const v4u*)(xb + off + bj * 128);
            b0 = (f32x4){__uint_as_float(w.x << 16), __uint_as_float(w.x & 0xffff0000u), __uint_as_float(w.y << 16), __uint_as_float(w.y & 0xffff0000u)};
            b1 = (f32x4){__uint_as_float(w.z << 16), __uint_as_float(w.z & 0xffff0000u), __uint_as_float(w.w << 16), __uint_as_float(w.w & 0xffff0000u)}; }
          if (y1) { const v4u w = *(const v4u*)(y1 + off + bj * 128);
            b0 += (f32x4){__uint_as_float(w.x << 16), __uint_as_float(w.x & 0xffff0000u), __uint_as_float(w.y << 16), __uint_as_float(w.y & 0xffff0000u)};
            b1 += (f32x4){__uint_as_float(w.z << 16), __uint_as_float(w.z & 0xffff0000u), __uint_as_float(w.w << 16), __uint_as_float(w.w & 0xffff0000u)}; }
          *(u32x4*)(out + off + bj * 128) = pack8(b0 + acc[ai][bj][m][0], b1 + acc[ai][bj][m][1]); asm volatile("" ::: "memory"); } }
  }
};
struct EpiRKV {
  static constexpr bool PERM = true, HAS_PRE = false;
  unsigned char* ws;
  __device__ __forceinline__ void operator()(const f32x4 (&acc)[2][2][4][2], const Unit& u, int wr, int wc, int fr, int fq) const {
    const int gi = u.pm >> 6;
    bf16_t* O = (bf16_t*)(ws + WS_S0 + (size_t)(3 + gi) * SLOT);
    const int row0 = (u.pm & 63) * 256 + wr * 64 + fr, col0 = (u.pn & 3) * 256 + wc * 32 + 8 * fq;
#pragma unroll
    for (int ai = 0; ai < 2; ++ai)
#pragma unroll
      for (int m = 0; m < 4; ++m) { bf16_t* rowp = O + (size_t)(row0 + ai * 128 + m * 16) * DM + col0;
#pragma unroll
        for (int bj = 0; bj < 2; ++bj) *(u32x4*)(rowp + bj * 128) = pack8(acc[ai][bj][m][0], acc[ai][bj][m][1]); }
  }
};
struct EpiLora1 {
  static constexpr bool PERM = true, HAS_PRE = false;
  bf16_t* TMP;
  template <int BJ>
  __device__ __forceinline__ void half(const f32x4 (&acc)[2][2][4][2], int gi, int row0, int wc, int fq) const {
    const int c = BJ * 128 + wc * 32 + 8 * fq;
    const bool skip = (gi < 2) && (c >= 64);
    const int dcol = (gi < 2) ? gi * 64 + c : 128 + c;
    const bool zero = (gi == 2) && (c >= 160);
    if (skip) return;
#pragma unroll
    for (int ai = 0; ai < 2; ++ai)
#pragma unroll
      for (int m = 0; m < 4; ++m) {
        f32x4 v0 = acc[ai][BJ][m][0], v1 = acc[ai][BJ][m][1];
#pragma unroll
        for (int i = 0; i < 4; ++i) {
          if (gi == 0) { v0[i] = tanhf_(v0[i]); v1[i] = tanhf_(v1[i]); }
          else if (gi == 2) { v0[i] = zero ? 0.f : sigmoidf_(v0[i]); v1[i] = zero ? 0.f : sigmoidf_(v1[i]); }
        }
        *(u32x4*)(TMP + (size_t)(row0 + ai * 128 + m * 16) * 384 + dcol) = pack8(v0, v1);
      }
  }
  __device__ __forceinline__ void operator()(const f32x4 (&acc)[2][2][4][2], const Unit& u, int wr, int wc, int fr, int fq) const {
    const int gi = u.pm >> 6;
    const int row0 = (u.pm & 63) * 256 + wr * 64 + fr;
    half<0>(acc, gi, row0, wc, fq);
    half<1>(acc, gi, row0, wc, fq);
  }
};
struct EpiLora2 {
  static constexpr bool PERM = true, HAS_PRE = false;
  unsigned char* ws; const float* w0; const float* a0; int gbase;
  __device__ __forceinline__ void operator()(const f32x4 (&acc)[2][2][4][2], const Unit& u, int wr, int wc, int fr, int fq) const {
    const int gi = gbase + (u.pn >> 2);
    bf16_t* O = (bf16_t*)(ws + WS_S0 + (size_t)gi * SLOT);
    const int row0 = u.pm * 256 + wr * 64 + fr, col0 = (u.pn & 3) * 256 + wc * 32 + 8 * fq;
    f32x4 b[2][2];
#pragma unroll
    for (int bj = 0; bj < 2; ++bj)
#pragma unroll
      for (int n = 0; n < 2; ++n) b[bj][n] = (gi == 0) ? *(const f32x4*)(w0 + col0 + bj * 128 + 4 * n) : (gi == 1 ? *(const f32x4*)(a0 + col0 + bj * 128 + 4 * n) : (f32x4){0.f, 0.f, 0.f, 0.f});
#pragma unroll
    for (int ai = 0; ai < 2; ++ai)
#pragma unroll
      for (int m = 0; m < 4; ++m) { bf16_t* rowp = O + (size_t)(row0 + ai * 128 + m * 16) * DM + col0;
#pragma unroll
        for (int bj = 0; bj < 2; ++bj) { f32x4 v0 = acc[ai][bj][m][0] + b[bj][0], v1 = acc[ai][bj][m][1] + b[bj][1];
          if (gi == 0) {
#pragma unroll
            for (int i = 0; i < 4; ++i) { v0[i] = -__expf(-softplusf_(-v0[i]) - 0.5f); v1[i] = -__expf(-softplusf_(-v1[i]) - 0.5f); }
          } else if (gi == 1) {
#pragma unroll
            for (int i = 0; i < 4; ++i) { v0[i] = sigmoidf_(v0[i]); v1[i] = sigmoidf_(v1[i]); }
          }
          *(u32x4*)(rowp + bj * 128) = pack8(v0, v1); } }
  }
};
struct EpiMoeGU {
  static constexpr bool PERM = true, HAS_PRE = false;
  bf16_t* HID;
  __device__ __forceinline__ void operator()(const f32x4 (&acc)[2][2][4][2], const Unit& u, int wr, int wc, int fr, int fq) const {
    const int row0 = u.pm * 256 + wr * 64 + fr, col0 = (u.pn & 1) * 128 + wc * 32 + 8 * fq;
#pragma unroll
    for (int ai = 0; ai < 2; ++ai)
#pragma unroll
      for (int m = 0; m < 4; ++m) {
        f32x4 h[2];
#pragma unroll
        for (int n = 0; n < 2; ++n) { const f32x4 g = acc[ai][0][m][n], up = acc[ai][1][m][n];
#pragma unroll
          for (int i = 0; i < 4; ++i) h[n][i] = g[i] * sigmoidf_(g[i]) * up[i]; }
        *(u32x4*)(HID + (size_t)(row0 + ai * 128 + m * 16) * 256 + col0) = pack8(h[0], h[1]);
      }
  }
};
struct EpiMoeDown {
  static constexpr bool PERM = false, HAS_PRE = true;
  bf16_t* out; bf16_t* Y1; const int* list; const float* pgate; LAS int* ept;
  __device__ __forceinline__ void pre(const Unit& u) const {
    const int r = threadIdx.x;
    if (r < 256) { int pr = -1; float gt = 0.f;
      if (r < u.nrows) { pr = list[(size_t)u.e * CAP + u.rt * 256 + r]; gt = pgate[pr]; }
      LAS int* e = ept + (u.par * 256 + r) * 2; e[0] = pr; e[1] = __float_as_int(gt); }
  }
  __device__ __forceinline__ void operator()(const f32x4 (&acc)[2][2][4][2], const Unit& u, int wr, int wc, int fr, int fq) const {
    const int col0 = (u.pn & 3) * 256 + wc * 32 + 4 * fq;
#pragma unroll
    for (int ai = 0; ai < 2; ++ai)
#pragma unroll
      for (int m = 0; m < 4; ++m) {
        const int r = ai * 128 + wr * 64 + m * 16 + fr;
        const LAS int* e = ept + (u.par * 256 + r) * 2;
        const int pr = e[0]; const float gt = __int_as_float(e[1]);
        if (pr >= 0) {
          const int tok = pr >> 1;
          if ((pr & 1) == 0) {
            bf16_t* op = out + (size_t)tok * DM + col0;
#pragma unroll
            for (int bj = 0; bj < 2; ++bj)
#pragma unroll
              for (int n = 0; n < 2; ++n) { const v2u w = *(const v2u*)(op + bj * 128 + n * 16);
                const f32x4 b = {__uint_as_float(w.x << 16), __uint_as_float(w.x & 0xffff0000u), __uint_as_float(w.y << 16), __uint_as_float(w.y & 0xffff0000u)};
                const f32x4 v = b + acc[ai][bj][m][n] * gt; v2u o; o.x = pk2(v[0], v[1]); o.y = pk2(v[2], v[3]); *(v2u*)(op + bj * 128 + n * 16) = o; }
          } else {
            bf16_t* yp = Y1 + (size_t)tok * DM + col0;
#pragma unroll
            for (int bj = 0; bj < 2; ++bj)
#pragma unroll
              for (int n = 0; n < 2; ++n) { const f32x4 v = acc[ai][bj][m][n] * gt; v2u w; w.x = pk2(v[0], v[1]); w.y = pk2(v[2], v[3]); *(v2u*)(yp + bj * 128 + n * 16) = w; }
          }
        }
      }
  }
};

typedef LAS bf16_t* lbf;
__device__ __forceinline__ void phase_prologue(PREF p, Frame& F) {
  const int lane = fresh_lane();
  LAS float* scr = (LAS float*)(F.lds + RING_OFF + F.wave * 16384);
  const int gw = F.vcu * NWAVES + F.wave, NGW = F.G * NWAVES;
  constexpr int I_WIN = 96 * 16, I_SQ = 32 * 16;
  constexpr int NITEMS = I_WIN + 5 * I_SQ + 128;
  for (int it = gw; it < NITEMS; it += NGW) {
    int r = it;
    if (r < I_WIN) { conv_win_item(p, r, scr, fresh_lane()); continue; } r -= I_WIN;
    if (r < I_SQ) { conv_sq_item(p.w_out, (bf16_t*)(p.ws + WS_WOUT), 0, r, scr, fresh_lane()); continue; } r -= I_SQ;
    if (r < I_SQ) { conv_sq_item(p.w_r, (bf16_t*)(p.ws + WS_WRKV), 0, r, scr, fresh_lane()); continue; } r -= I_SQ;
    if (r < I_SQ) { conv_sq_item(p.w_k, (bf16_t*)(p.ws + WS_WRKV), 1024, r, scr, fresh_lane()); continue; } r -= I_SQ;
    if (r < I_SQ) { conv_sq_item(p.w_v, (bf16_t*)(p.ws + WS_WRKV), 2048, r, scr, fresh_lane()); continue; } r -= I_SQ;
    if (r < I_SQ) { conv_sq_item(p.w_o, (bf16_t*)(p.ws + WS_WO), 0, r, scr, fresh_lane()); continue; } r -= I_SQ;
    { const int kv = r >> 6, q = r & 63, kb = q >> 1, cg = q & 1;
      transpose_item(p.cmp_w1 + (size_t)kv * 2048 * 64, 64, kb * 64, cg * 32, 32, (bf16_t*)(p.ws + WS_CW1) + (size_t)kv * 64 * 2048, 2048, cg * 32, scr, fresh_lane()); }
  }
  {
    const int gt = (F.vcu * NWAVES + F.wave) * 64 + fresh_lane(), NGT = NGW * 64;
    bf16_t* WL1 = (bf16_t*)(p.ws + WS_WL1);
    for (int i = gt; i < 768 * 1024; i += NGT) {
      const int n = i >> 10, k = i & 1023, gi = n >> 8, c = n & 255;
      float v = 0.f;
      if (gi == 0) { if (c < 64) v = p.w1[k * 64 + c]; }
      else if (gi == 1) { if (c < 64) v = p.a1[k * 64 + c]; }
      else { if (c < 160) v = p.g1[k * 160 + c]; }
      WL1[i] = (bf16_t)f2bf(v);
    }
    bf16_t* WL2w = (bf16_t*)(p.ws + WS_WL2);
    bf16_t* WL2a = (bf16_t*)(p.ws + WS_WL2 + 128 * 1024);
    bf16_t* WL2g = (bf16_t*)(p.ws + WS_WL2 + 256 * 1024);
    for (int i = gt; i < 1024 * 64; i += NGT) { const int n = i >> 6, k = i & 63; WL2w[i] = (bf16_t)f2bf(p.w2[k * 1024 + n]); WL2a[i] = (bf16_t)f2bf(p.a2[k * 1024 + n]); }
    for (int i = gt; i < 1024 * 192; i += NGT) { const int n = i / 192, k = i - n * 192; WL2g[i] = (bf16_t)f2bf(k < 160 ? p.g2[k * 1024 + n] : 0.f); }
    bf16_t* WR = (bf16_t*)(p.ws + WS_WR);
    for (int i = gt; i < 2 * 48 * 1024; i += NGT) {
      const int layer = i / (48 * 1024), rem = i - layer * 48 * 1024, n = rem >> 10, k = rem & 1023;
      float wv = 0.f;
      if (n < 4) wv = p.rg_w[(size_t)layer * DM * 4 + k * 4 + n]; else if (n < 36) wv = p.re_w[(size_t)layer * DM * 32 + k * 32 + (n - 4)];
      wv *= p.ffn_norm[layer * DM + k];
      const unsigned h = f2bf(wv); const float r1 = wv - __uint_as_float(h << 16);
      const unsigned m = f2bf(r1); const float r2 = r1 - __uint_as_float(m << 16);
      const unsigned l = f2bf(r2);
      bf16_t* o = WR + (size_t)layer * 144 * 1024 + (size_t)n * 1024 + k;
      o[0] = (bf16_t)h; o[48 * 1024] = (bf16_t)m; o[96 * 1024] = (bf16_t)l;
    }
  }
  bf16_t* XN = (bf16_t*)(p.ws + WS_XN);
  for (int m = gw; m < T_TOK; m += 4 * NGW) rms_rows_to_bf16<4>(p.x, p.mix_norm, XN, m, NGW, lane);
}


__device__ __forceinline__ void up8(const v4u w, float (&o)[8]) {
  o[0] = __uint_as_float(w.x << 16); o[1] = __uint_as_float(w.x & 0xffff0000u); o[2] = __uint_as_float(w.y << 16); o[3] = __uint_as_float(w.y & 0xffff0000u);
  o[4] = __uint_as_float(w.z << 16); o[5] = __uint_as_float(w.z & 0xffff0000u); o[6] = __uint_as_float(w.w << 16); o[7] = __uint_as_float(w.w & 0xffff0000u);
}
__device__ __forceinline__ f32x4 bf4(const v2u w) { return (f32x4){__uint_as_float(w.x << 16), __uint_as_float(w.x & 0xffff0000u), __uint_as_float(w.y << 16), __uint_as_float(w.y & 0xffff0000u)}; }
__device__ __forceinline__ void phase_router(PREF p, Frame& F, int layer) {
  const int gw = F.vcu * NWAVES + F.wave, NGW = F.G * NWAVES;
  const int lane = fresh_lane();
  PROBE_MARK(100 + layer * 10);
  {
    LAS float* scr = (LAS float*)(F.lds + RING_OFF + F.wave * 16384);
    for (int it = gw; it < 32 * 384; it += NGW) conv_expert_item(p, layer, it, scr, lane, (bf16_t*)(p.ws + WS_EGU));
  }
  __syncthreads();
  PROBE_MARK(101 + layer * 10);
  constexpr int WQP = 264;
  const lbf WQ = (lbf)(F.lds);
  LAS float* SSP = (LAS float*)(F.lds + 80 * 1024);
  LAS float* LGP = (LAS float*)(F.lds + 81 * 1024);
  const int w = F.wave, par = w & 1, tk = lane & 15, kg = lane >> 4;
  const float* gain = p.ffn_norm + layer * DM;
  bf16_t* XN2 = (bf16_t*)(p.ws + WS_XN2);
  const bf16_t* xres = layer ? (const bf16_t*)(p.ws + WS_X3) : (const bf16_t*)p.out;
  const int tok = F.vcu * 64 + (w >> 1) * 16 + tk;
  bf16x8 xf[4][4];
  { const bf16_t* xr = xres + (size_t)tok * DM + 128 * par + 8 * kg;
#pragma unroll
    for (int j = 0; j < 4; ++j)
#pragma unroll
      for (int s = 0; s < 4; ++s) xf[j][s] = *(const GAS bf16x8*)(xr + 256 * j + 32 * s); }
  {
    float ss = 0.f;
#pragma unroll
    for (int j = 0; j < 4; ++j)
#pragma unroll
      for (int s = 0; s < 4; ++s) { float f[8]; up8(__builtin_bit_cast(v4u, xf[j][s]), f);
#pragma unroll
        for (int i = 0; i < 8; ++i) ss += f[i] * f[i]; }
    ss += __shfl_xor(ss, 16, 64); ss += __shfl_xor(ss, 32, 64);
    if (kg == 0) SSP[w * 16 + tk] = ss;
  }
  PROBE_MARK(102 + layer * 10);
  f32x4 acc[9];
#pragma unroll
  for (int nt = 0; nt < 9; ++nt) acc[nt] = (f32x4){0.f, 0.f, 0.f, 0.f};
  const bf16_t* WRl = (const bf16_t*)(p.ws + WS_WR) + (size_t)layer * 144 * 1024;
  float rs = 0.f;
#pragma unroll
  for (int j = 0; j < 4; ++j) {
    __syncthreads();
#pragma unroll
    for (int i = 0; i < 9; ++i) { const int idx = F.tid + i * 512, row = idx >> 5, pc = idx & 31;
      *(LAS v4u*)(WQ + row * WQP + pc * 8) = *(const GAS v4u*)(WRl + (size_t)row * 1024 + 256 * j + pc * 8); }
    __syncthreads();
    if (j == 0) {
      rs = rsqrtf((SSP[(w & ~1) * 16 + tk] + SSP[(w | 1) * 16 + tk]) * (1.f / DM) + 1e-6f);
      bf16_t* xo = XN2 + (size_t)tok * DM + 128 * par + 8 * kg;
#pragma unroll
      for (int jj = 0; jj < 4; ++jj)
#pragma unroll
        for (int s = 0; s < 4; ++s) { float f[8]; v4u xl = __builtin_bit_cast(v4u, xf[jj][s]); asm volatile("" : "+v"(xl)); up8(xl, f);
          const float* gp = gain + 256 * jj + 128 * par + 32 * s + 8 * kg; const f32x4 g0 = *(const GAS f32x4*)gp, g1 = *(const GAS f32x4*)(gp + 4);
          v4u o; o.x = pk2(f[0] * rs * g0[0], f[1] * rs * g0[1]); o.y = pk2(f[2] * rs * g0[2], f[3] * rs * g0[3]); o.z = pk2(f[4] * rs * g1[0], f[5] * rs * g1[1]); o.w = pk2(f[6] * rs * g1[2], f[7] * rs * g1[3]);
          *(GAS v4u*)(xo + 256 * jj + 32 * s) = o; asm volatile("" ::: "memory"); }
    }
#pragma unroll
    for (int s = 0; s < 4; ++s)
#pragma unroll
      for (int nt = 0; nt < 9; ++nt) {
        const bf16x8 a = *(const LAS bf16x8*)(WQ + (nt * 16 + tk) * WQP + 128 * par + 32 * s + 8 * kg);
        acc[nt] = __builtin_amdgcn_mfma_f32_16x16x32_bf16(a, xf[j][s], acc[nt], 0, 0, 0);
      }
  }
  PROBE_MARK(103 + layer * 10);
#pragma unroll
  for (int nt = 0; nt < 3; ++nt)
#pragma unroll
    for (int i = 0; i < 4; ++i) { const int n = nt * 16 + 4 * kg + i;
      if (n < 36) LGP[(w * 16 + tk) * 36 + n] = ((acc[6 + nt][i] + acc[3 + nt][i]) + acc[nt][i]) * rs; }
  LAS unsigned* LC = (LAS unsigned*)(F.lds + 118784);
  if (F.tid < 64) LC[F.tid] = 0u;
  __syncthreads();
  int ea = 0, eb = 0; unsigned la = 0, lb = 0; float ga = 0.f, gb = 0.f;
  if (lane < 8) {
    const LAS float* lg0 = LGP + ((w & ~1) * 16 + par * 8 + lane) * 36; const LAS float* lg1 = LGP + ((w | 1) * 16 + par * 8 + lane) * 36;
    const float* bg = p.rg_b + layer * 4;
    const float* be = p.re_b + layer * 32;
    float gl[4]; int gi = 0; float gm = -3.4e38f;
#pragma unroll
    for (int i = 0; i < 4; i++) { gl[i] = (lg0[i] + lg1[i]) + bg[i]; if (gl[i] > gm) { gm = gl[i]; gi = i; } }
    float gs = 0.f;
#pragma unroll
    for (int i = 0; i < 4; i++) gs += __expf(gl[i] - gm);
    const float grp_p = 1.f / gs;
    float v0 = -3.4e38f, v1 = -3.4e38f; int i0 = 0, i1 = 0;
    for (int i = 0; i < 8; i++) {
      const float v = (lg0[4 + gi * 8 + i] + lg1[4 + gi * 8 + i]) + be[gi * 8 + i];
      if (v > v0) { v1 = v0; i1 = i0; v0 = v; i0 = i; }
      else if (v > v1) { v1 = v; i1 = i; }
    }
    const float e1 = __expf(v1 - v0);
    ga = grp_p / (1.f + e1); gb = grp_p * e1 / (1.f + e1);
    ea = gi * 8 + i0; eb = gi * 8 + i1;
    la = __hip_atomic_fetch_add(LC + ea, 1u, __ATOMIC_RELAXED, __HIP_MEMORY_SCOPE_WORKGROUP);
    lb = __hip_atomic_fetch_add(LC + eb, 1u, __ATOMIC_RELAXED, __HIP_MEMORY_SCOPE_WORKGROUP);
  }
  __syncthreads();
  if (F.tid < 32) { const unsigned n = LC[F.tid];
    unsigned* cnt = (unsigned*)(p.ws + WS_CTL) + CW_CNT + (layer * 32 + F.tid) * 64;
    LC[32 + F.tid] = n ? __hip_atomic_fetch_add(cnt, n, __ATOMIC_RELAXED, __HIP_MEMORY_SCOPE_AGENT) : 0u; }
  __syncthreads();
  if (lane < 8) {
    const int t = gw * 8 + lane;
    int* list = (int*)(p.ws + WS_LIST); float* pgate = (float*)(p.ws + WS_PGATE);
    list[(size_t)ea * CAP + LC[32 + ea] + la] = 2 * t; pgate[2 * t] = ga;
    list[(size_t)eb * CAP + LC[32 + eb] + lb] = 2 * t + 1; pgate[2 * t + 1] = gb;
  }
  PROBE_MARK(104 + layer * 10);
}

__device__ __forceinline__ void phase_final(PREF p, Frame& F) {
  const int gw = F.vcu * NWAVES + F.wave, NGW = F.G * NWAVES;
  const int lane = fresh_lane();
  const bf16_t* Y1 = (const bf16_t*)(p.ws + WS_Y1);
  const bf16_t* X3 = (const bf16_t*)(p.ws + WS_X3);
  for (int t = gw; t < T_TOK; t += NGW) {
    GAS f32x4* xo = (GAS f32x4*)(p.out + (size_t)t * DM) + lane;
    const GAS v2u* xr = (const GAS v2u*)(X3 + (size_t)t * DM) + lane;
    const GAS v2u* yr = (const GAS v2u*)(Y1 + (size_t)t * DM) + lane;
#pragma unroll
    for (int j = 0; j < 4; ++j) xo[64 * j] = bf4(xr[64 * j]) + bf4(yr[64 * j]);
  }
}

__device__ __forceinline__ void phase_rwkv_prep(PREF p, Frame& F) {
  const int gw = F.vcu * NWAVES + F.wave, NGW = F.G * NWAVES;
  const int lane = fresh_lane();
  const float* gain = p.mix_norm + DM;
  const bf16_t* X1 = (const bf16_t*)p.out;
  const bf16_t* Y1 = (const bf16_t*)(p.ws + WS_Y1);
  float g[2][8];
#pragma unroll
  for (int c = 0; c < 2; ++c) { const f32x4 a = *(const GAS f32x4*)(gain + c * 512 + lane * 8), b = *(const GAS f32x4*)(gain + c * 512 + lane * 8 + 4);
    g[c][0] = a.x; g[c][1] = a.y; g[c][2] = a.z; g[c][3] = a.w; g[c][4] = b.x; g[c][5] = b.y; g[c][6] = b.z; g[c][7] = b.w; }
  for (int run = gw; run < T_TOK / 8; run += NGW) {
    const int t0 = run * 8;
    float prev[2][8];
    if ((t0 & (SEQ - 1)) == 0) {
#pragma unroll
      for (int c = 0; c < 2; ++c)
#pragma unroll
        for (int i = 0; i < 8; ++i) prev[c][i] = 0.f;
    } else {
      float s = 0.f;
#pragma unroll
      for (int c = 0; c < 2; ++c) { float xa[8], ya[8];
        up8(*(const GAS v4u*)(X1 + (size_t)(t0 - 1) * DM + c * 512 + lane * 8), xa); up8(*(const GAS v4u*)(Y1 + (size_t)(t0 - 1) * DM + c * 512 + lane * 8), ya);
#pragma unroll
        for (int i = 0; i < 8; ++i) { prev[c][i] = xa[i] + ya[i]; s += prev[c][i] * prev[c][i]; } }
      const float r = rsqrtf(wave_sum_dpp(s) * (1.f / DM) + 1e-6f);
#pragma unroll
      for (int c = 0; c < 2; ++c)
#pragma unroll
        for (int i = 0; i < 8; ++i) prev[c][i] *= r * g[c][i];
    }
    v4u nx[2], ny[2];
#pragma unroll
    for (int c = 0; c < 2; ++c) { nx[c] = *(const GAS v4u*)(X1 + (size_t)t0 * DM + c * 512 + lane * 8); ny[c] = *(const GAS v4u*)(Y1 + (size_t)t0 * DM + c * 512 + lane * 8); }
#pragma unroll 1
    for (int tt = 0; tt < 8; ++tt) {
      const int t = t0 + tt;
      float v[2][8]; float s = 0.f;
#pragma unroll
      for (int c = 0; c < 2; ++c) { float xa[8], ya[8]; up8(nx[c], xa); up8(ny[c], ya);
#pragma unroll
        for (int i = 0; i < 8; ++i) { v[c][i] = xa[i] + ya[i]; s += v[c][i] * v[c][i]; } }
      if (tt < 7) {
#pragma unroll
        for (int c = 0; c < 2; ++c) { nx[c] = *(const GAS v4u*)(X1 + (size_t)(t + 1) * DM + c * 512 + lane * 8); ny[c] = *(const GAS v4u*)(Y1 + (size_t)(t + 1) * DM + c * 512 + lane * 8); } }
      const float r = rsqrtf(wave_sum_dpp(s) * (1.f / DM) + 1e-6f);
#pragma unroll
      for (int c = 0; c < 2; ++c)
#pragma unroll
        for (int i = 0; i < 8; ++i) v[c][i] *= r * g[c][i];
#pragma unroll
      for (int sl = 0; sl < 6; ++sl) {
        const int mj = (sl == 0) ? 0 : (sl == 1) ? 2 : (sl == 2) ? 3 : (sl == 3) ? 1 : (sl == 4) ? 4 : 5;
        bf16_t* o = (bf16_t*)(p.ws + WS_S0 + (size_t)sl * SLOT) + (size_t)t * DM;
#pragma unroll
        for (int c = 0; c < 2; ++c) {
          const f32x4 ma = *(const GAS f32x4*)(p.rmix + mj * DM + c * 512 + lane * 8), mb = *(const GAS f32x4*)(p.rmix + mj * DM + c * 512 + lane * 8 + 4);
          const float mx[8] = {ma.x, ma.y, ma.z, ma.w, mb.x, mb.y, mb.z, mb.w};
          float q[8];
#pragma unroll
          for (int i = 0; i < 8; ++i) q[i] = v[c][i] + (prev[c][i] - v[c][i]) * mx[i];
          v4u w; w.x = pk2(q[0], q[1]); w.y = pk2(q[2], q[3]); w.z = pk2(q[4], q[5]); w.w = pk2(q[6], q[7]);
          *(GAS v4u*)(o + c * 512 + lane * 8) = w;
        }
      }
#pragma unroll
      for (int c = 0; c < 2; ++c)
#pragma unroll
        for (int i = 0; i < 8; ++i) prev[c][i] = v[c][i];
    }
  }
}

constexpr int RP = 72;
constexpr int RB = 64 * RP * 2;

__device__ __forceinline__ f32x4 mm16(f32x4 acc, const LAS bf16_t* A, int arow0, const LAS bf16_t* Bt, int brow0, int lane) {
  const int r = lane & 15, q = lane >> 4;
#pragma unroll
  for (int ks = 0; ks < 2; ++ks) {
    const bf16x8 a = *(const LAS bf16x8*)(A + (arow0 + r) * RP + ks * 32 + q * 8);
    const bf16x8 b = *(const LAS bf16x8*)(Bt + (brow0 + r) * RP + ks * 32 + q * 8);
    acc = __builtin_amdgcn_mfma_f32_16x16x32_bf16(a, b, acc, 0, 0, 0);
  }
  return acc;
}
__device__ __forceinline__ float sum8(float v) {
  v += __shfl_xor(v, 1, 64); v += __shfl_xor(v, 2, 64); v += __shfl_xor(v, 4, 64); return v;
}
__device__ __forceinline__ void ld8bf(const bf16_t* p, float (&o)[8]) {
  const v4u w = *(const GAS v4u*)p;
  o[0] = __uint_as_float(w.x << 16); o[1] = __uint_as_float(w.x & 0xffff0000u); o[2] = __uint_as_float(w.y << 16); o[3] = __uint_as_float(w.y & 0xffff0000u);
  o[4] = __uint_as_float(w.z << 16); o[5] = __uint_as_float(w.z & 0xffff0000u); o[6] = __uint_as_float(w.w << 16); o[7] = __uint_as_float(w.w & 0xffff0000u);
}
__device__ __forceinline__ v4u pk8(const float (&o)[8]) { v4u w; w.x = pk2(o[0], o[1]); w.y = pk2(o[2], o[3]); w.z = pk2(o[4], o[5]); w.w = pk2(o[6], o[7]); return w; }

#define R1_BAR() do { asm volatile("s_waitcnt lgkmcnt(0)" ::: "memory"); __builtin_amdgcn_s_barrier(); asm volatile("" ::: "memory"); } while (0)
__device__ __forceinline__ void stT(LAS bf16_t* Dst, int x0, int y0, const f32x4& acc, int lane) {
  v2u w; w.x = pk2(acc[0], acc[1]); w.y = pk2(acc[2], acc[3]);
  *(LAS v2u*)(Dst + (x0 + (lane & 15)) * RP + y0 + (lane >> 4) * 4) = w;
}
struct R1In { v4u r, ld, k, v, a; f32x4 kk0, kk1, ka0, ka1, rk0, rk1; };
__device__ __forceinline__ R1In rwkv_r1_load(PREF p, int item, int tid) {
  const int ch = item >> 6, c = item & 63, b = ch >> 4, hd = ch & 15;
  const size_t off = ((size_t)(b * SEQ + c * 64 + (tid >> 3)) * DM + hd * 64 + (tid & 7) * 8);
  const bf16_t* s0 = (const bf16_t*)(p.ws + WS_S0);
  R1In in;
  in.r = *(const GAS v4u*)(s0 + 3 * (SLOT / 2) + off); in.ld = *(const GAS v4u*)(s0 + off); in.k = *(const GAS v4u*)(s0 + 4 * (SLOT / 2) + off);
  in.v = *(const GAS v4u*)(s0 + 5 * (SLOT / 2) + off); in.a = *(const GAS v4u*)(s0 + (SLOT / 2) + off);
  const int cc0 = hd * 64 + (tid & 7) * 8;
  in.kk0 = *(const GAS f32x4*)(p.k_k + cc0); in.kk1 = *(const GAS f32x4*)(p.k_k + cc0 + 4); in.ka0 = *(const GAS f32x4*)(p.k_a + cc0); in.ka1 = *(const GAS f32x4*)(p.k_a + cc0 + 4);
  in.rk0 = *(const GAS f32x4*)(p.r_k + cc0); in.rk1 = *(const GAS f32x4*)(p.r_k + cc0 + 4);
  return in;
}
__device__ __forceinline__ void un8(const v4u w, float (&o)[8]) {
  o[0] = __uint_as_float(w.x << 16); o[1] = __uint_as_float(w.x & 0xffff0000u); o[2] = __uint_as_float(w.y << 16); o[3] = __uint_as_float(w.y & 0xffff0000u);
  o[4] = __uint_as_float(w.z << 16); o[5] = __uint_as_float(w.z & 0xffff0000u); o[6] = __uint_as_float(w.w << 16); o[7] = __uint_as_float(w.w & 0xffff0000u);
}
__device__ __forceinline__ void rwkv_r1_item(PREF p, Frame& F, int item, const R1In& in) {
  const int tid = F.tid, lane = fresh_lane(), w = F.wave;
  const int ch = item >> 6, c = item & 63, b = ch >> 4, hd = ch & 15;
  const size_t tile0 = ((size_t)(b * SEQ + c * 64) * DM + hd * 64);
  unsigned char* ws = p.ws;
  bf16_t* SL[6];
#pragma unroll
  for (int s = 0; s < 6; ++s) SL[s] = (bf16_t*)(ws + WS_S0 + (size_t)s * SLOT) + tile0;
  const lbf BtT = (lbf)(F.lds + 0 * RB), KtT = (lbf)(F.lds + 1 * RB), AbT = (lbf)(F.lds + 2 * RB), RbT = (lbf)(F.lds + 3 * RB);
  const lbf Ab = (lbf)(F.lds + 4 * RB), Vc = (lbf)(F.lds + 5 * RB), Bh = (lbf)(F.lds + 6 * RB), Kh = (lbf)(F.lds + 7 * RB);
  const lbf Tk = (lbf)(F.lds + 8 * RB), WbT = (lbf)(F.lds + 9 * RB), WkT = (lbf)(F.lds + 10 * RB);
  const lbf X = BtT, XT = KtT, Pb = AbT;
  const lbf At = X, TNT = XT, U0 = Tk;
  LAS float* Lf = (LAS float*)(F.lds + 11 * RB);
  LAS float* SEG = Lf + 64 * 65;
  LAS float* GC = (LAS float*)(F.lds + 14 * RB);
#if defined(PROBE_PH) && PROBE_PH == 301
  const unsigned long long _sa0 = __builtin_amdgcn_s_memrealtime();
#endif
  const int t = tid >> 3, cg = tid & 7, k0 = cg * 8;
  float r_[8], ld_[8], kx[8], v_[8], a_[8];
  un8(in.r, r_); un8(in.ld, ld_); un8(in.k, kx); un8(in.v, v_); un8(in.a, a_);
  float kk[8], km[8], be[8];
  {
    float ss = 0.f, bo = 0.f;
#pragma unroll
    for (int i = 0; i < 8; ++i) { const float ckk = (i < 4) ? in.kk0[i & 3] : in.kk1[i & 3], cka = (i < 4) ? in.ka0[i & 3] : in.ka1[i & 3], crk = (i < 4) ? in.rk0[i & 3] : in.rk1[i & 3];
      kk[i] = kx[i] * ckk; ss += kk[i] * kk[i]; km[i] = kx[i] * (1.f + (a_[i] - 1.f) * cka); bo += r_[i] * km[i] * crk; }
    ss = sum8(ss); bo = sum8(bo);
    const float inv = 1.f / fmaxf(sqrtf(ss), 1e-12f);
#pragma unroll
    for (int i = 0; i < 8; ++i) { kk[i] *= inv; be[i] = kk[i] * a_[i]; }
    if (cg == 0) ((float*)(ws + WS_TMP))[(size_t)item * 64 + t] = bo;
  }
#pragma unroll
  for (int i = 0; i < 8; ++i) Lf[t * 65 + k0 + i] = ld_[i];
  R1_BAR();
  {
    const int k = tid & 63, sg = tid >> 6;
    float run = 0.f;
#pragma unroll
    for (int i = 0; i < 8; ++i) { run += Lf[(sg * 8 + i) * 65 + k]; Lf[(sg * 8 + i) * 65 + k] = run; }
    SEG[sg * 64 + k] = run;
    R1_BAR();
    float off = 0.f;
    for (int j = 0; j < sg; ++j) off += SEG[j * 64 + k];
#pragma unroll
    for (int i = 0; i < 8; ++i) Lf[(sg * 8 + i) * 65 + k] += off;
  }
  R1_BAR();
  {
    float ab[8], bt[8], kt[8], rb[8], bh[8], kh[8];
#pragma unroll
    for (int i = 0; i < 8; ++i) {
      const float Lt = Lf[t * 65 + k0 + i], Lp = (t > 0) ? Lf[(t - 1) * 65 + k0 + i] : 0.f, LC = Lf[63 * 65 + k0 + i];
      const float et = __expf(Lt), ei = __builtin_amdgcn_rcpf(et), eh = __expf(LC) * ei;
      if (t == 63) GC[k0 + i] = et;
      ab[i] = -kk[i] * __expf(Lp); bt[i] = be[i] * ei; kt[i] = km[i] * ei; rb[i] = r_[i] * et; bh[i] = be[i] * eh; kh[i] = km[i] * eh;
    }
    *(LAS v4u*)(BtT + t * RP + k0) = pk8(bt); *(LAS v4u*)(KtT + t * RP + k0) = pk8(kt); *(LAS v4u*)(AbT + t * RP + k0) = pk8(ab); *(LAS v4u*)(RbT + t * RP + k0) = pk8(rb);
    {
      float ra[8], rv[8], rb[8], rkh[8];
#pragma unroll
      for (int i = 0; i < 8; ++i) { ra[i] = ab[i]; rv[i] = v_[i]; rb[i] = bh[i]; rkh[i] = kh[i]; }
#pragma unroll
      for (int sh = 1; sh < 8; sh <<= 1) {
        const bool on = (cg & sh) != 0;
        float ta[8], tv[8], tb[8], tk[8];
#pragma unroll
        for (int i = 0; i < 8; ++i) { ta[i] = on ? ra[(i + sh) & 7] : ra[i]; tv[i] = on ? rv[(i + sh) & 7] : rv[i]; tb[i] = on ? rb[(i + sh) & 7] : rb[i]; tk[i] = on ? rkh[(i + sh) & 7] : rkh[i]; }
#pragma unroll
        for (int i = 0; i < 8; ++i) { ra[i] = ta[i]; rv[i] = tv[i]; rb[i] = tb[i]; rkh[i] = tk[i]; }
      }
#pragma unroll
      for (int i = 0; i < 8; ++i) { const int row = k0 + ((i + cg) & 7);
        Ab[row * RP + t] = (bf16_t)f2bf(ra[i]); Vc[row * RP + t] = (bf16_t)f2bf(rv[i]); Bh[row * RP + t] = (bf16_t)f2bf(rb[i]); Kh[row * RP + t] = (bf16_t)f2bf(rkh[i]); }
    }
  }
  R1_BAR();
#if defined(PROBE_PH) && PROBE_PH == 301
  F.pr_t1 += __builtin_amdgcn_s_memrealtime() - _sa0;
#endif
  const int ya = (w >> 1) * 16, xb0 = (w & 1) * 32;
  const int cr = lane & 15, q4 = (lane >> 4) * 4;
  const f32x4 Z4 = {0.f, 0.f, 0.f, 0.f};
  const lbf X1 = (lbf)(F.lds + 11 * RB), XT1 = (lbf)(F.lds + 12 * RB), Pb1 = (lbf)(F.lds + 13 * RB);
  f32x4 accP[2];
  {
    f32x4 tabn[2], tabs[2], taks[2], wbr[2], wkr[2];
#pragma unroll
    for (int j = 0; j < 2; ++j) { const int xb = xb0 + 16 * j;
      tabn[j] = mm16(Z4, BtT, ya, AbT, xb, lane);
      tabs[j] = mm16(Z4, AbT, ya, BtT, xb, lane);
      taks[j] = mm16(Z4, AbT, ya, KtT, xb, lane);
      wbr[j] = mm16(Z4, BtT, ya, RbT, xb, lane);
      wkr[j] = mm16(Z4, KtT, ya, RbT, xb, lane); }
#pragma unroll
    for (int j = 0; j < 2; ++j) { const int xb = xb0 + 16 * j;
      f32x4 xt, xr, pr, tk, wb, wk;
#pragma unroll
      for (int i = 0; i < 4; ++i) {
        { const int s = ya + q4 + i, tt = xb + cr; xt[i] = (s < tt) ? tabn[j][i] : 0.f; wb[i] = (s <= tt) ? wbr[j][i] : 0.f; wk[i] = (s <= tt) ? wkr[j][i] : 0.f; }
        { const int tt = ya + q4 + i, s = xb + cr; xr[i] = (s < tt) ? tabs[j][i] : 0.f; pr[i] = xr[i] + ((s == tt) ? 1.f : 0.f); tk[i] = (s < tt) ? taks[j][i] : 0.f; }
      }
      accP[j] = pr;
      stT(XT1, xb, ya, xt, lane); stT(WbT, xb, ya, wb, lane); stT(WkT, xb, ya, wk, lane);
      stT(X1, xb, ya, xr, lane); stT(Pb1, xb, ya, pr, lane); stT(Tk, xb, ya, tk, lane); }
  }
  R1_BAR();
#pragma unroll 1
  for (int st = 0; st < 5; ++st) {
    const lbf Xs = (st & 1) ? X : X1, XTs = (st & 1) ? XT : XT1, Pbs = (st & 1) ? Pb : Pb1;
    const lbf Xd = (st & 1) ? X1 : X, XTd = (st & 1) ? XT1 : XT, Pbd = (st & 1) ? Pb1 : Pb;
    f32x4 xr[2], xt[2];
#pragma unroll
    for (int j = 0; j < 2; ++j) { const int xb = xb0 + 16 * j;
      xr[j] = mm16(Z4, XTs, ya, Xs, xb, lane);
      xt[j] = mm16(Z4, Xs, ya, XTs, xb, lane);
      if (st > 0) accP[j] = mm16(accP[j], XTs, ya, Pbs, xb, lane); }
#pragma unroll
    for (int j = 0; j < 2; ++j) { const int xb = xb0 + 16 * j; stT(Xd, xb, ya, xr[j], lane); stT(XTd, xb, ya, xt[j], lane); stT(Pbd, xb, ya, accP[j], lane); }
    R1_BAR();
  }
  const lbf NT = Pb1;
  {
    f32x4 nt[2];
#pragma unroll
    for (int j = 0; j < 2; ++j) { const int xb = xb0 + 16 * j; nt[j] = mm16(Z4, Pb, ya, XT, xb, lane);
#pragma unroll
      for (int i = 0; i < 4; ++i) nt[j][i] += bf2f(Pb[(ya + q4 + i) * RP + xb + cr]); }
#pragma unroll
    for (int j = 0; j < 2; ++j) stT(NT, xb0 + 16 * j, ya, nt[j], lane);
    R1_BAR();
  }
  {
    f32x4 at[2], tn[2];
#pragma unroll
    for (int j = 0; j < 2; ++j) { const int xb = xb0 + 16 * j; at[j] = mm16(Z4, NT, ya, Ab, xb, lane); tn[j] = mm16(Z4, Tk, ya, NT, xb, lane); }
#pragma unroll
    for (int j = 0; j < 2; ++j) { const int xb = xb0 + 16 * j; stT(At, xb, ya, at[j], lane); stT(TNT, xb, ya, tn[j], lane); }
  }
  R1_BAR();
  const lbf O_RT = (lbf)(F.lds + 11 * RB), O_PM = (lbf)(F.lds + 12 * RB), O_Y0 = (lbf)(F.lds + 13 * RB), O_Q = (lbf)(F.lds + 3 * RB)  ;
  {
    f32x4 u0[2], rt[2], pm[2];
#pragma unroll
    for (int j = 0; j < 2; ++j) { const int xb = xb0 + 16 * j;
      u0[j] = mm16(Z4, TNT, ya, Vc, xb, lane);
      rt[j] = mm16(Z4, At, ya, WbT, xb, lane);
      pm[j] = mm16(Z4, At, ya, Bh, xb, lane);
      const v2u rbw = *(const LAS v2u*)(RbT + (xb + cr) * RP + ya + q4);
      rt[j][0] += __uint_as_float(rbw.x << 16); rt[j][1] += __uint_as_float(rbw.x & 0xffff0000u); rt[j][2] += __uint_as_float(rbw.y << 16); rt[j][3] += __uint_as_float(rbw.y & 0xffff0000u);
#pragma unroll
      for (int i = 0; i < 4; ++i) if (ya + q4 + i == xb + cr) pm[j][i] += GC[xb + cr]; }
#pragma unroll
    for (int j = 0; j < 2; ++j) { const int xb = xb0 + 16 * j; stT(U0, xb, ya, u0[j], lane); stT(O_RT, xb, ya, rt[j], lane); stT(O_PM, xb, ya, pm[j], lane); }
  }
  R1_BAR();
  {
    f32x4 y0[2], qq[2];
#pragma unroll
    for (int j = 0; j < 2; ++j) { const int xb = xb0 + 16 * j;
      y0[j] = mm16(mm16(Z4, U0, ya, WbT, xb, lane), Vc, ya, WkT, xb, lane);
      qq[j] = mm16(mm16(Z4, Bh, ya, U0, xb, lane), Kh, ya, Vc, xb, lane); }
#pragma unroll
    for (int j = 0; j < 2; ++j) { const int xb = xb0 + 16 * j; stT(O_Y0, xb, ya, y0[j], lane); stT(O_Q, xb, ya, qq[j], lane); }
  }
  R1_BAR();
  {
    const int row = tid >> 3, pc = (tid & 7) * 8;
    *(GAS v4u*)(SL[3] + (size_t)row * DM + pc) = *(const LAS v4u*)(O_RT + row * RP + pc);
    *(GAS v4u*)(SL[0] + (size_t)row * DM + pc) = *(const LAS v4u*)(O_PM + row * RP + pc);
    *(GAS v4u*)(SL[4] + (size_t)row * DM + pc) = *(const LAS v4u*)(O_Y0 + row * RP + pc);
    *(GAS v4u*)(SL[1] + (size_t)row * DM + pc) = *(const LAS v4u*)(O_Q + row * RP + pc);
  }
  R1_BAR();
}

__device__ __forceinline__ void phase_rwkv_r1(PREF p, Frame& F) {
  int item = F.vcu;
  if (item >= 4096) return;
  R1In nxt = rwkv_r1_load(p, item, F.tid);
  for (; item < 4096; item += F.G) {
    const R1In cur = nxt;
    if (item + F.G < 4096) nxt = rwkv_r1_load(p, item + F.G, F.tid);
    rwkv_r1_item(p, F, item, cur);
  }
}

__device__ __forceinline__ void phase_rwkv_r2(PREF p, Frame& F) {
  if (F.wave != 0) return;
  const int lane = fresh_lane();
  const lbf Sh = (lbf)(F.lds), Sl = (lbf)(F.lds + 16 * RP * 2);
  const int cr = lane & 15, g = lane >> 4;
  for (int task = F.vcu; task < 256; task += F.G) {
    const int ch = task >> 2, jb = task & 3, b = ch >> 4, hd = ch & 15;
    const bf16_t* PM = (const bf16_t*)(p.ws + WS_S0) + ((size_t)(b * SEQ) * DM + hd * 64);
    bf16_t* QS = (bf16_t*)(p.ws + WS_S0 + SLOT) + ((size_t)(b * SEQ) * DM + hd * 64);
    for (int i = lane; i < 16 * RP; i += 64) { Sh[i] = 0; Sl[i] = 0; }
    const bf16_t* pmp = PM + (size_t)cr * DM + g * 8;
    bf16_t* qsp = QS + (size_t)(16 * jb + cr) * DM + g * 4;
    bf16x8 pa[4][4][2]; v2u qv[4][4];
#pragma unroll
    for (int d = 0; d < 4; ++d)
#pragma unroll
      for (int ct = 0; ct < 4; ++ct) { pa[d][ct][0] = *(const GAS bf16x8*)(pmp + (size_t)(d * 64 + 16 * ct) * DM); pa[d][ct][1] = *(const GAS bf16x8*)(pmp + (size_t)(d * 64 + 16 * ct) * DM + 32);
        qv[d][ct] = *(const GAS v2u*)(qsp + (size_t)d * 64 * DM + 16 * ct); }
    asm volatile("s_waitcnt lgkmcnt(0)" ::: "memory");
#pragma unroll 1
    for (int c4 = 0; c4 < 64; c4 += 4) {
#pragma unroll
      for (int d = 0; d < 4; ++d) {
        const int c = c4 + d;
        const bf16x8 bh0 = *(const LAS bf16x8*)(Sh + cr * RP + g * 8), bh1 = *(const LAS bf16x8*)(Sh + cr * RP + 32 + g * 8);
        const bf16x8 bl0 = *(const LAS bf16x8*)(Sl + cr * RP + g * 8), bl1 = *(const LAS bf16x8*)(Sl + cr * RP + 32 + g * 8);
        f32x4 acc[4];
#pragma unroll
        for (int ct = 0; ct < 4; ++ct) {
          acc[ct] = (f32x4){__uint_as_float(qv[d][ct].x << 16), __uint_as_float(qv[d][ct].x & 0xffff0000u), __uint_as_float(qv[d][ct].y << 16), __uint_as_float(qv[d][ct].y & 0xffff0000u)};
          acc[ct] = __builtin_amdgcn_mfma_f32_16x16x32_bf16(pa[d][ct][0], bh0, acc[ct], 0, 0, 0);
          acc[ct] = __builtin_amdgcn_mfma_f32_16x16x32_bf16(pa[d][ct][1], bh1, acc[ct], 0, 0, 0);
          acc[ct] = __builtin_amdgcn_mfma_f32_16x16x32_bf16(pa[d][ct][0], bl0, acc[ct], 0, 0, 0);
          acc[ct] = __builtin_amdgcn_mfma_f32_16x16x32_bf16(pa[d][ct][1], bl1, acc[ct], 0, 0, 0);
        }
        if (c + 4 < 64) {
#pragma unroll
          for (int ct = 0; ct < 4; ++ct) { pa[d][ct][0] = *(const GAS bf16x8*)(pmp + (size_t)((c + 4) * 64 + 16 * ct) * DM); pa[d][ct][1] = *(const GAS bf16x8*)(pmp + (size_t)((c + 4) * 64 + 16 * ct) * DM + 32);
            qv[d][ct] = *(const GAS v2u*)(qsp + (size_t)(c + 4) * 64 * DM + 16 * ct); }
        }
#pragma unroll
        for (int ct = 0; ct < 4; ++ct) {
          v2u hi; hi.x = pk2(acc[ct][0], acc[ct][1]); hi.y = pk2(acc[ct][2], acc[ct][3]);
          const float l0 = acc[ct][0] - __uint_as_float(hi.x << 16), l1 = acc[ct][1] - __uint_as_float(hi.x & 0xffff0000u), l2 = acc[ct][2] - __uint_as_float(hi.y << 16), l3 = acc[ct][3] - __uint_as_float(hi.y & 0xffff0000u);
          v2u lo; lo.x = pk2(l0, l1); lo.y = pk2(l2, l3);
          *(LAS v2u*)(Sh + cr * RP + 16 * ct + g * 4) = hi; *(LAS v2u*)(Sl + cr * RP + 16 * ct + g * 4) = lo;
          *(GAS v2u*)(qsp + (size_t)c * 64 * DM + 16 * ct) = hi;
        }
        asm volatile("s_waitcnt lgkmcnt(0)" ::: "memory");
      }
    }
  }
}

__device__ __forceinline__ void phase_rwkv_r3(PREF p, Frame& F) {
  const int lane = fresh_lane(), w = F.wave;
  const int cr = lane & 15, q4 = (lane >> 4) * 4, q = lane >> 4;
  const int half = w >> 2, tb = w & 3;
  LAS bf16_t* stg = (LAS bf16_t*)(F.lds) + w * 16 * RP;
  for (int it2 = F.vcu; it2 < 2048; it2 += F.G) {
    const int item = it2 * 2 + half;
    const int ch = item >> 6, c = item & 63, b = ch >> 4, hd = ch & 15;
    const size_t tile0 = ((size_t)(b * SEQ + c * 64) * DM + hd * 64);
    bf16_t* RT = (bf16_t*)(p.ws + WS_S0 + 3 * SLOT) + tile0;
    const bf16_t* Y0 = (const bf16_t*)(p.ws + WS_S0 + 4 * SLOT) + tile0;
    const bf16_t* VV = (const bf16_t*)(p.ws + WS_S0 + 5 * SLOT) + tile0;
    const bf16_t* GG = (const bf16_t*)(p.ws + WS_S0 + 2 * SLOT) + tile0;
    const bf16_t* SC = (const bf16_t*)(p.ws + WS_S0 + SLOT) + tile0 - (size_t)64 * DM;
    const float* BO = (const float*)(p.ws + WS_TMP) + (size_t)item * 64;
    f32x4 y[4];
#pragma unroll
    for (int j = 0; j < 4; ++j) y[j] = (f32x4){0.f, 0.f, 0.f, 0.f};
    if (c > 0) {
      const bf16_t* ap = RT + (size_t)(16 * tb + cr) * DM + q * 8;
      const bf16x8 a0 = *(const GAS bf16x8*)ap, a1 = *(const GAS bf16x8*)(ap + 32);
#pragma unroll
      for (int j = 0; j < 4; ++j) {
        const bf16_t* bp = SC + (size_t)(16 * j + cr) * DM + q * 8;
        const bf16x8 b0 = *(const GAS bf16x8*)bp, b1 = *(const GAS bf16x8*)(bp + 32);
        y[j] = __builtin_amdgcn_mfma_f32_16x16x32_bf16(a0, b0, y[j], 0, 0, 0);
        y[j] = __builtin_amdgcn_mfma_f32_16x16x32_bf16(a1, b1, y[j], 0, 0, 0);
      }
    }
    float mu[4], rs[4];
#pragma unroll
    for (int i = 0; i < 4; ++i) {
      float s = 0.f;
#pragma unroll
      for (int j = 0; j < 4; ++j) { y[j][i] += bf2f(Y0[(size_t)(16 * tb + q4 + i) * DM + 16 * j + cr]); s += y[j][i]; }
      s += __shfl_xor(s, 1, 64); s += __shfl_xor(s, 2, 64); s += __shfl_xor(s, 4, 64); s += __shfl_xor(s, 8, 64);
      mu[i] = s * (1.f / 64.f);
      float qd = 0.f;
#pragma unroll
      for (int j = 0; j < 4; ++j) { const float d = y[j][i] - mu[i]; qd += d * d; }
      qd += __shfl_xor(qd, 1, 64); qd += __shfl_xor(qd, 2, 64); qd += __shfl_xor(qd, 4, 64); qd += __shfl_xor(qd, 8, 64);
      rs[i] = rsqrtf(qd * (1.f / 64.f) + 64e-5f);
    }
#pragma unroll
    for (int j = 0; j < 4; ++j) {
      const int cc = hd * 64 + 16 * j + cr;
      const float lw = p.ln_w[cc], lb = p.ln_b[cc];
#pragma unroll
      for (int i = 0; i < 4; ++i) {
        const int tt = 16 * tb + q4 + i;
        const float vv = bf2f(VV[(size_t)tt * DM + 16 * j + cr]), gg = bf2f(GG[(size_t)tt * DM + 16 * j + cr]);
        const float z = ((y[j][i] - mu[i]) * rs[i] * lw + lb + BO[tt] * vv) * gg;
        stg[(q4 + i) * RP + 16 * j + cr] = (bf16_t)f2bf(z);
      }
    }
    LDS_WAIT();
#pragma unroll
    for (int i = 0; i < 2; ++i) { const int row = (lane >> 3) + 8 * i, pc = (lane & 7) * 8;
      *(GAS v4u*)(RT + (size_t)(16 * tb + row) * DM + pc) = *(const LAS v4u*)(stg + row * RP + pc); }
    LDS_WAIT();
  }
}


typedef short v4i16_t __attribute__((ext_vector_type(4)));
__device__ __forceinline__ v4i16_t tr16(const LAS bf16_t* p) { return __builtin_amdgcn_ds_read_tr16_b64_v4i16((LAS v4i16_t*)p); }

template <int KS>
__device__ __forceinline__ void qk_tile(f32x4 (&st)[4][2], const LAS bf16_t* Kt, int kc0, const bf16x8 (&qf)[2][KS], int lane) {
  const int r = lane & 15, g = lane >> 4;
#pragma unroll
  for (int kt = 0; kt < 4; ++kt)
#pragma unroll
    for (int ks = 0; ks < KS; ++ks) {
      const bf16x8 a = *(const LAS bf16x8*)(Kt + (kt * 16 + r) * RP + kc0 + ks * 32 + g * 8);
#pragma unroll
      for (int qt = 0; qt < 2; ++qt) st[kt][qt] = __builtin_amdgcn_mfma_f32_16x16x32_bf16(a, qf[qt][ks], st[kt][qt], 0, 0, 0);
    }
}
__device__ __forceinline__ void pack_p(bf16x8 (&pb)[2][2], const f32x4 (&pr)[4][2]) {
#pragma unroll
  for (int kb = 0; kb < 2; ++kb)
#pragma unroll
    for (int qt = 0; qt < 2; ++qt) {
      const v4u w = {pk2(pr[2 * kb][qt][0], pr[2 * kb][qt][1]), pk2(pr[2 * kb][qt][2], pr[2 * kb][qt][3]), pk2(pr[2 * kb + 1][qt][0], pr[2 * kb + 1][qt][1]), pk2(pr[2 * kb + 1][qt][2], pr[2 * kb + 1][qt][3])};
      pb[kb][qt] = __builtin_bit_cast(bf16x8, w);
    }
}
__device__ __forceinline__ void pv_apply(f32x4 (&o)[4][2], f32x4 (&osum)[2], const bf16x8 (&pb)[2][2], const LAS bf16_t* Vt, int lane) {
  const int g = lane >> 4, qq = (lane & 15) >> 2, pp = lane & 3;
  const bf16x8 ones = {0x3F80, 0x3F80, 0x3F80, 0x3F80, 0x3F80, 0x3F80, 0x3F80, 0x3F80};
#pragma unroll
  for (int kb = 0; kb < 2; ++kb)
#pragma unroll
    for (int qt = 0; qt < 2; ++qt) osum[qt] = __builtin_amdgcn_mfma_f32_16x16x32_bf16(ones, pb[kb][qt], osum[qt], 0, 0, 0);
#pragma unroll
  for (int dt = 0; dt < 4; ++dt)
#pragma unroll
    for (int kb = 0; kb < 2; ++kb) {
      const v4i16_t lo = tr16(Vt + (32 * kb + 4 * g + qq) * RP + dt * 16 + 4 * pp);
      const v4i16_t hi = tr16(Vt + (32 * kb + 16 + 4 * g + qq) * RP + dt * 16 + 4 * pp);
      const bf16x8 a = {lo[0], lo[1], lo[2], lo[3], hi[0], hi[1], hi[2], hi[3]};
#pragma unroll
      for (int qt = 0; qt < 2; ++qt) o[dt][qt] = __builtin_amdgcn_mfma_f32_16x16x32_bf16(a, pb[kb][qt], o[dt][qt], 0, 0, 0);
    }
}
__device__ __forceinline__ void pv_apply2(f32x4 (&o1)[4][2], f32x4 (&o2)[4][2], f32x4 (&os1)[2], f32x4 (&os2)[2], const bf16x8 (&pb1)[2][2], const bf16x8 (&pb2)[2][2], const LAS bf16_t* Vt, int lane) {
  const int g = lane >> 4, qq = (lane & 15) >> 2, pp = lane & 3;
  const bf16x8 ones = {0x3F80, 0x3F80, 0x3F80, 0x3F80, 0x3F80, 0x3F80, 0x3F80, 0x3F80};
#pragma unroll
  for (int kb = 0; kb < 2; ++kb)
#pragma unroll
    for (int qt = 0; qt < 2; ++qt) { os1[qt] = __builtin_amdgcn_mfma_f32_16x16x32_bf16(ones, pb1[kb][qt], os1[qt], 0, 0, 0); os2[qt] = __builtin_amdgcn_mfma_f32_16x16x32_bf16(ones, pb2[kb][qt], os2[qt], 0, 0, 0); }
#pragma unroll
  for (int dt = 0; dt < 4; ++dt)
#pragma unroll
    for (int kb = 0; kb < 2; ++kb) {
      const v4i16_t lo = tr16(Vt + (32 * kb + 4 * g + qq) * RP + dt * 16 + 4 * pp);
      const v4i16_t hi = tr16(Vt + (32 * kb + 16 + 4 * g + qq) * RP + dt * 16 + 4 * pp);
      const bf16x8 a = {lo[0], lo[1], lo[2], lo[3], hi[0], hi[1], hi[2], hi[3]};
#pragma unroll
      for (int qt = 0; qt < 2; ++qt) { o1[dt][qt] = __builtin_amdgcn_mfma_f32_16x16x32_bf16(a, pb1[kb][qt], o1[dt][qt], 0, 0, 0); o2[dt][qt] = __builtin_amdgcn_mfma_f32_16x16x32_bf16(a, pb2[kb][qt], o2[dt][qt], 0, 0, 0); }
    }
}
__device__ __forceinline__ void fill42(f32x4 (&a)[4][2], const f32x4 v) {
#pragma unroll
  for (int i = 0; i < 4; ++i)
#pragma unroll
    for (int j = 0; j < 2; ++j) a[i][j] = v;
}
__device__ __forceinline__ void exp42(f32x4 (&a)[4][2]) {
#pragma unroll
  for (int i = 0; i < 4; ++i)
#pragma unroll
    for (int j = 0; j < 2; ++j)
#pragma unroll
      for (int e = 0; e < 4; ++e) a[i][j][e] = __builtin_amdgcn_exp2f(a[i][j][e]);
}
#if defined(PROBE_PH) && PROBE_PH == 300
#define AT_BAR() do { const unsigned long long _b0 = __builtin_amdgcn_s_memrealtime(); asm volatile("s_waitcnt lgkmcnt(0)" ::: "memory"); __builtin_amdgcn_s_barrier(); asm volatile("" ::: "memory"); F.pr_t1 += __builtin_amdgcn_s_memrealtime() - _b0; } while (0)
#else
#define AT_BAR() do { asm volatile("s_waitcnt lgkmcnt(0)" ::: "memory"); __builtin_amdgcn_s_barrier(); asm volatile("" ::: "memory"); } while (0)
#endif
__device__ __forceinline__ void zero42(f32x4 (&a)[4][2]) {
#pragma unroll
  for (int i = 0; i < 4; ++i)
#pragma unroll
    for (int j = 0; j < 2; ++j) a[i][j] = (f32x4){0.f, 0.f, 0.f, 0.f};
}

__device__ __forceinline__ void phase_compress(PREF p, Frame& F) {
  const int lane = fresh_lane(), w = F.wave, tid = F.tid;
  const int r = lane & 15, g4 = lane >> 4;
  const bf16_t* H = (const bf16_t*)(p.ws + WS_H);
  const bf16_t* W1T = (const bf16_t*)(p.ws + WS_CW1);
  LAS float* part = (LAS float*)F.lds;
  LAS float* hid = part + 8 * 16 * 64;
  LAS float* outv = hid + 16 * 64;
  for (int task = F.vcu; task < 256; task += F.G) {
    const int kv = task >> 7, rb = task & 127;
    int row = rb * 16 + r; if (row > 2039) row = 2039;
    const int gg = row & 1, cc = (row >> 1) % NCMP, bb = (row >> 1) / NCMP;
    const int colbase = OFF_NKV + ((0 * 2 + kv) * 2 + gg) * 64;
    f32x4 acc[4];
#pragma unroll
    for (int nt = 0; nt < 4; ++nt) acc[nt] = (f32x4){0.f, 0.f, 0.f, 0.f};
#pragma unroll 1
    for (int ks = 0; ks < 8; ++ks) {
      const int k = w * 256 + ks * 32 + g4 * 8, l = k >> 6, d0 = k & 63;
      float hv[8]; ld8bf(H + (size_t)(bb * SEQ + 16 * cc + l) * HC + colbase + d0, hv);
      const float* pe = p.cmp_pe + (kv * 32 + l) * 64 + d0;
#pragma unroll
      for (int i = 0; i < 8; ++i) hv[i] += pe[i];
      const bf16x8 a = __builtin_bit_cast(bf16x8, pk8(hv));
#pragma unroll
      for (int nt = 0; nt < 4; ++nt) {
        const bf16x8 bfr = *(const GAS bf16x8*)(W1T + ((size_t)kv * 64 + nt * 16 + r) * 2048 + k);
        acc[nt] = __builtin_amdgcn_mfma_f32_16x16x32_bf16(a, bfr, acc[nt], 0, 0, 0);
      }
    }
#pragma unroll
    for (int nt = 0; nt < 4; ++nt)
#pragma unroll
      for (int i = 0; i < 4; ++i) part[(w * 16 + g4 * 4 + i) * 64 + nt * 16 + r] = acc[nt][i];
    __syncthreads();
    for (int e = tid; e < 1024; e += NWAVES * 64) { float s = 0.f;
#pragma unroll
      for (int ww = 0; ww < 8; ++ww) s += part[ww * 1024 + e];
      hid[e] = gelu_tanh(s); }
    __syncthreads();
    const float* w2 = p.cmp_w2 + kv * 4096;
    for (int e = tid; e < 1024; e += NWAVES * 64) { const int rr = e >> 6, n = e & 63; float s = 0.f;
      for (int j = 0; j < 64; ++j) s += hid[rr * 64 + j] * w2[j * 64 + n];
      outv[e] = s; }
    __syncthreads();
    for (int e = tid; e < 1024; e += NWAVES * 64) { const int rr = e >> 6, n = e & 63;
      const int orow = rb * 16 + rr;
      if (orow < 2040) {
        float v = outv[e];
        if (kv == 0) { float ss = 0.f; for (int j = 0; j < 64; ++j) ss += outv[rr * 64 + j] * outv[rr * 64 + j]; v = v * rsqrtf(ss * (1.f / 64.f) + 1e-6f) * p.nk_norm[n]; }
        const int g2 = orow & 1, c2 = (orow >> 1) % NCMP, b2 = (orow >> 1) / NCMP;
        ((bf16_t*)(p.ws + (kv ? WS_VCMPB : WS_KCMPB)))[((size_t)(b2 * 2 + g2) * 256 + c2) * 64 + n] = (bf16_t)f2bf(v);
      }
    }
    if (task < 16 && tid < 64) { const int kk2 = task >> 3, bg = task & 7; ((bf16_t*)(p.ws + (kk2 ? WS_VCMPB : WS_KCMPB)))[((size_t)bg * 256 + 255) * 64 + tid] = 0; }
    __syncthreads();
  }
}

__device__ __forceinline__ v4u tile_ld(const bf16_t* base, size_t pitch, int tid) { return *(const GAS v4u*)(base + (size_t)(tid >> 3) * pitch + (tid & 7) * 8); }
__device__ __forceinline__ void tile_st(LAS bf16_t* dst, v4u v, int tid) { *(LAS v4u*)(dst + (tid >> 3) * RP + (tid & 7) * 8) = v; }

template <int KS, int MODE>
__device__ __forceinline__ void attn_tile(f32x4 (&o)[4][2], f32x4 (&os)[2], const bf16x8 (&qf)[2][KS], const LAS bf16_t* KBt, int kc0, const LAS bf16_t* VBt, const f32x4 nbv,
                                          const bool (&on)[2], int qq0, int koff, int lane) {
  const int r = lane & 15, g = lane >> 4;
  f32x4 st[4][2]; bf16x8 pb[2][2];
  fill42(st, nbv); qk_tile<KS>(st, KBt, kc0, qf, lane); exp42(st);
  if (MODE != 0) {
#pragma unroll
    for (int kt = 0; kt < 4; ++kt)
#pragma unroll
      for (int qt = 0; qt < 2; ++qt)
#pragma unroll
        for (int i = 0; i < 4; ++i) { const int kk = kt * 16 + g * 4 + i, qq = qq0 + qt * 16 + r;
          bool keep = true;
          if (MODE & 1) keep = keep && on[qt];
          if (MODE & 2) keep = keep && (kk + koff <= qq);
          if (MODE & 4) keep = keep && (kk > qq);
          if (!keep) st[kt][qt][i] = 0.f; }
  }
  pack_p(pb, st);
  pv_apply(o, os, pb, VBt, lane);
}
__device__ __forceinline__ void phase_diffattn(PREF p, Frame& F) {
  const int lane = fresh_lane(), w = F.wave, tid = F.tid;
  const int r = lane & 15, g = lane >> 4;
  const bf16_t* H = (const bf16_t*)(p.ws + WS_H);
  bf16_t* CAT = (bf16_t*)(p.ws + WS_CAT);
  float mq = 0.f, mk = 0.f, l0 = 0.f, l1 = 0.f;
  for (int i = 0; i < 32; i++) { mq = fmaxf(mq, fabsf(p.dq_norm[i])); mk = fmaxf(mk, fabsf(p.dk_norm[i])); l0 += p.dlam[i] * p.dlam[32 + i]; l1 += p.dlam[64 + i] * p.dlam[96 + i]; }
  const float c2 = 0.17677669529663687f * 1.4426950408889634f;
  const float nb = -(32.f * mq * mk) * c2;
  const f32x4 nbv = {nb, nb, nb, nb};
  const float lam = __expf(l0) - __expf(l1) + 0.2f;
  const bool on[2] = {true, true};
  for (int pr = F.vcu; pr < 256; pr += F.G) {
    const int bh = pr >> 3, sp = pr & 7, b = bh >> 3, hd = bh & 7;
#pragma unroll 1
    for (int ui = 0; ui < 2; ++ui) {
      const int qb = ui ? 15 - sp : sp;
      const int NT = 4 * (qb + 1);
      const bf16_t* Kg = H + (size_t)(b * SEQ) * HC + OFF_DK + hd * 64;
      const bf16_t* Vg = H + (size_t)(b * SEQ) * HC + OFF_DV + hd * 64;
      f32x4 o1[4][2];
#pragma unroll 1
      for (int mp = 0; mp < 2; ++mp) {
        bf16x8 qf[2][1];
#pragma unroll
        for (int qt = 0; qt < 2; ++qt) qf[qt][0] = *(const GAS bf16x8*)(H + (size_t)(b * SEQ + qb * 256 + w * 32 + qt * 16 + r) * HC + OFF_DQ + hd * 64 + mp * 32 + g * 8);
        f32x4 o[4][2]; zero42(o);
        f32x4 os[2] = {{0.f, 0.f, 0.f, 0.f}, {0.f, 0.f, 0.f, 0.f}};
        v4u krA = tile_ld(Kg, HC, tid), vrA = tile_ld(Vg, HC, tid);
        v4u krB = tile_ld(Kg + (size_t)64 * HC, HC, tid), vrB = tile_ld(Vg + (size_t)64 * HC, HC, tid);
#pragma unroll 1
        for (int t = 0; t < NT; t += 2) {
#pragma unroll
          for (int hf = 0; hf < 2; ++hf) {
            const int tt = t + hf;
            const lbf KBt = (lbf)(F.lds + hf * 2 * RB), VBt = KBt + 64 * RP;
            tile_st(KBt, hf ? krB : krA, tid); tile_st(VBt, hf ? vrB : vrA, tid);
            AT_BAR();
            if (tt + 2 < NT) { const v4u k2 = tile_ld(Kg + (size_t)(tt + 2) * 64 * HC, HC, tid), v2 = tile_ld(Vg + (size_t)(tt + 2) * 64 * HC, HC, tid);
              if (hf) { krB = k2; vrB = v2; } else { krA = k2; vrA = v2; } }
            const int koff = tt * 64 - (qb * 256 + w * 32);
            if (tt >= NT - 4) attn_tile<1, 2>(o, os, qf, KBt, mp * 32, VBt, nbv, on, 0, koff, lane);
            else attn_tile<1, 0>(o, os, qf, KBt, mp * 32, VBt, nbv, on, 0, koff, lane);
          }
        }
        if (mp == 0) {
#pragma unroll
          for (int qt = 0; qt < 2; ++qt) { const float i1 = 1.f / os[qt][0];
#pragma unroll
            for (int dt = 0; dt < 4; ++dt) o1[dt][qt] = o[dt][qt] * i1; }
        } else {
#pragma unroll
          for (int qt = 0; qt < 2; ++qt) {
            const float i2 = lam / os[qt][0];
            float ss = 0.f;
#pragma unroll
            for (int dt = 0; dt < 4; ++dt)
#pragma unroll
              for (int i = 0; i < 4; ++i) { const float v = o1[dt][qt][i] - o[dt][qt][i] * i2; o1[dt][qt][i] = v; ss += v * v; }
            ss += __shfl_xor(ss, 16, 64); ss += __shfl_xor(ss, 32, 64);
            const float rr = rsqrtf(ss * (1.f / 64.f) + 1e-6f) * 0.8f;
            bf16_t* op = CAT + (size_t)(b * SEQ + qb * 256 + w * 32 + qt * 16 + r) * DM + hd * 64;
#pragma unroll
            for (int dt = 0; dt < 4; ++dt) { const int d0 = dt * 16 + g * 4; const f32x4 sg = *(const f32x4*)(p.dsubln + d0);
              v2u wv; wv.x = pk2(o1[dt][qt][0] * rr * sg[0], o1[dt][qt][1] * rr * sg[1]); wv.y = pk2(o1[dt][qt][2] * rr * sg[2], o1[dt][qt][3] * rr * sg[3]);
              *(GAS v2u*)(op + d0) = wv; }
          }
        }
        AT_BAR();
      }
    }
  }
}

__device__ __forceinline__ void nsa_finish(f32x4 (&comb)[4][2], const f32x4 (&o)[4][2], const f32x4 (&os)[2], const float (&gate)[2], bool normalised) {
#pragma unroll
  for (int qt = 0; qt < 2; ++qt) {
    const float f = normalised ? gate[qt] : gate[qt] / os[qt][0];
#pragma unroll
    for (int dt = 0; dt < 4; ++dt) comb[dt][qt] += o[dt][qt] * f;
  }
}
__device__ __forceinline__ void phase_nsa(PREF p, Frame& F) {
  const int lane = fresh_lane(), w = F.wave, tid = F.tid;
  const int r = lane & 15, g = lane >> 4;
  const bf16_t* H = (const bf16_t*)(p.ws + WS_H);
  const float* GATES = (const float*)(p.ws + WS_GATES);
  bf16_t* CAT = (bf16_t*)(p.ws + WS_CAT);
  float mq = 0.f, mk0 = 0.f, mk1 = 0.f, mk2 = 0.f;
  for (int i = 0; i < 64; i++) { mq = fmaxf(mq, fabsf(p.nq_norm[i])); mk0 = fmaxf(mk0, fabsf(p.nk_norm[i])); mk1 = fmaxf(mk1, fabsf(p.nk_norm[64 + i])); mk2 = fmaxf(mk2, fabsf(p.nk_norm[128 + i])); }
  const float c2 = 0.125f * 1.4426950408889634f;
  const float nb0 = -(64.f * mq * mk0) * c2, nb1 = -(64.f * mq * mk1) * c2, nb2 = -(64.f * mq * mk2) * c2;
  LAS float* IMP = (LAS float*)(F.lds + 12 * RB);
  LAS unsigned char* SELB = (LAS unsigned char*)(F.lds + 12 * RB + 64 * 65 * 4);
  const int hj = w >> 1, th = w & 1;
  for (int pr = F.vcu; pr < 256; pr += F.G) {
    const int bg = pr >> 5, sp = pr & 31, b = bg >> 1, gq = bg & 1;
#pragma unroll 1
    for (int ui = 0; ui < 2; ++ui) {
      const int blk = ui ? 63 - sp : sp;
      const int hh = gq * 4 + hj;
      const int tokw = b * SEQ + blk * 64 + th * 32;
      bf16x8 qf[2][2];
      float gate0[2], gate1[2], gate2[2];
#pragma unroll
      for (int qt = 0; qt < 2; ++qt) { const bf16_t* qp = H + (size_t)(tokw + qt * 16 + r) * HC + OFF_NQ + hh * 64 + g * 8;
        qf[qt][0] = *(const GAS bf16x8*)qp; qf[qt][1] = *(const GAS bf16x8*)(qp + 32);
        const float* gp = GATES + (size_t)(tokw + qt * 16 + r) * 24 + hh * 3; gate0[qt] = gp[0]; gate1[qt] = gp[1]; gate2[qt] = gp[2]; }
      f32x4 comb[4][2]; zero42(comb);
      const int nct = (4 * blk + 3 + 63) >> 6;
      {
        const bf16_t* KC = (const bf16_t*)(p.ws + WS_KCMPB) + (size_t)(b * 2 + gq) * 256 * 64;
        const bf16_t* VC = (const bf16_t*)(p.ws + WS_VCMPB) + (size_t)(b * 2 + gq) * 256 * 64;
        for (int t4 = 0; t4 < nct; ++t4) { tile_st((lbf)(F.lds + t4 * RB), tile_ld(KC + t4 * 4096, 64, tid), tid); tile_st((lbf)(F.lds + (4 + t4) * RB), tile_ld(VC + t4 * 4096, 64, tid), tid); }
        for (int e = tid; e < 64 * 65; e += NWAVES * 64) IMP[e] = 0.f;
        AT_BAR();
        const f32x4 nbv0 = {nb0, nb0, nb0, nb0};
        int cmax[2];
#pragma unroll
        for (int qt = 0; qt < 2; ++qt) { const int pos = blk * 64 + th * 32 + qt * 16 + r; cmax[qt] = (pos >= 31) ? ((pos - 31) >> 4) : -1; }
        float lsum[2] = {0.f, 0.f};
        for (int t4 = 0; t4 < nct; ++t4) {
          f32x4 st[4][2]; fill42(st, nbv0);
          qk_tile<2>(st, (lbf)(F.lds + t4 * RB), 0, qf, lane); exp42(st);
#pragma unroll
          for (int kt = 0; kt < 4; ++kt)
#pragma unroll
            for (int qt = 0; qt < 2; ++qt)
#pragma unroll
              for (int i = 0; i < 4; ++i) { const int c = t4 * 64 + kt * 16 + g * 4 + i; if (c <= cmax[qt]) lsum[qt] += st[kt][qt][i]; }
        }
        float linv[2];
#pragma unroll
        for (int qt = 0; qt < 2; ++qt) { float s = lsum[qt]; s += __shfl_xor(s, 16, 64); s += __shfl_xor(s, 32, 64); linv[qt] = (cmax[qt] >= 0) ? 1.f / s : 0.f; }
        f32x4 o[4][2]; zero42(o);
        f32x4 osd[2] = {{0.f, 0.f, 0.f, 0.f}, {0.f, 0.f, 0.f, 0.f}};
        for (int t4 = 0; t4 < nct; ++t4) {
          f32x4 st[4][2]; fill42(st, nbv0);
          qk_tile<2>(st, (lbf)(F.lds + t4 * RB), 0, qf, lane); exp42(st);
#pragma unroll
          for (int kt = 0; kt < 4; ++kt)
#pragma unroll
            for (int qt = 0; qt < 2; ++qt) {
              float gs = 0.f;
#pragma unroll
              for (int i = 0; i < 4; ++i) { const int c = t4 * 64 + kt * 16 + g * 4 + i;
                const float e = (c <= cmax[qt]) ? st[kt][qt][i] * linv[qt] : 0.f;
                st[kt][qt][i] = e; gs += e; }
              const int ti = th * 32 + qt * 16 + r, j = t4 * 16 + kt * 4 + g;
              if (gs != 0.f) { __hip_atomic_fetch_add(IMP + ti * 65 + j, gs, __ATOMIC_RELAXED, __HIP_MEMORY_SCOPE_WORKGROUP); if (j < 63 && st[kt][qt][3] != 0.f) __hip_atomic_fetch_add(IMP + ti * 65 + j + 1, st[kt][qt][3], __ATOMIC_RELAXED, __HIP_MEMORY_SCOPE_WORKGROUP); }
            }
          bf16x8 pb[2][2]; pack_p(pb, st);
          pv_apply(o, osd, pb, (lbf)(F.lds + (4 + t4) * RB), lane);
        }
        nsa_finish(comb, o, osd, gate0, true);
      }
      AT_BAR();
      {
        const int ti = tid >> 3, jb = (tid & 7) * 8;
        float mine[8]; int rank[8];
#pragma unroll
        for (int u = 0; u < 8; ++u) { const int j = jb + u; float v = IMP[ti * 65 + j]; if (j == blk || j == 0) v = 1e4f; else if (j > blk) v = -1e30f; mine[u] = v; rank[u] = 0; }
        for (int i = 0; i < 64; ++i) { float v = IMP[ti * 65 + i]; if (i == blk || i == 0) v = 1e4f; else if (i > blk) v = -1e30f;
#pragma unroll
          for (int u = 0; u < 8; ++u) rank[u] += (v > mine[u] || (v == mine[u] && i < jb + u)) ? 1 : 0; }
        unsigned bits = 0;
#pragma unroll
        for (int u = 0; u < 8; ++u) bits |= (rank[u] < 16 ? 1u : 0u) << u;
        SELB[ti * 8 + (tid & 7)] = (unsigned char)bits;
      }
      AT_BAR();
      unsigned long long selm[2];
#pragma unroll
      for (int qt = 0; qt < 2; ++qt) { const int ti = th * 32 + qt * 16 + r; const LAS unsigned* sp2 = (const LAS unsigned*)(SELB + ti * 8); selm[qt] = (unsigned long long)sp2[0] | ((unsigned long long)sp2[1] << 32); }
#pragma unroll 1
      for (int br = 1; br < 3; ++br) {
        const int kcol = OFF_NKV + ((br * 2 + 0) * 2 + gq) * 64, vcol = OFF_NKV + ((br * 2 + 1) * 2 + gq) * 64;
        const float nbb = (br == 1) ? nb1 : nb2;
        const f32x4 nbv = {nbb, nbb, nbb, nbb};
        const int t_lo = (br == 1) ? 0 : (blk > 8 ? blk - 8 : 0);
        const bf16_t* Kg = H + (size_t)(b * SEQ) * HC + kcol;
        const bf16_t* Vg = H + (size_t)(b * SEQ) * HC + vcol;
        f32x4 o[4][2]; zero42(o);
        f32x4 os[2] = {{0.f, 0.f, 0.f, 0.f}, {0.f, 0.f, 0.f, 0.f}};
        v4u krA = tile_ld(Kg + (size_t)t_lo * 64 * HC, HC, tid), vrA = tile_ld(Vg + (size_t)t_lo * 64 * HC, HC, tid);
        v4u krB = krA, vrB = vrA;
        if (t_lo < blk) { krB = tile_ld(Kg + (size_t)(t_lo + 1) * 64 * HC, HC, tid); vrB = tile_ld(Vg + (size_t)(t_lo + 1) * 64 * HC, HC, tid); }
#pragma unroll 1
        for (int t0 = t_lo; t0 <= blk; t0 += 2) {
#pragma unroll
          for (int hf = 0; hf < 2; ++hf) {
            const int t = t0 + hf;
            if (t <= blk) {
              const lbf KBt = (lbf)(F.lds + (8 + hf * 2) * RB), VBt = KBt + 64 * RP;
              tile_st(KBt, hf ? krB : krA, tid); tile_st(VBt, hf ? vrB : vrA, tid);
              AT_BAR();
              if (t + 2 <= blk) { const v4u k2 = tile_ld(Kg + (size_t)(t + 2) * 64 * HC, HC, tid), v2 = tile_ld(Vg + (size_t)(t + 2) * 64 * HC, HC, tid);
                if (hf) { krB = k2; vrB = v2; } else { krA = k2; vrA = v2; } }
              const bool on[2] = {((selm[0] >> t) & 1ull) != 0ull, ((selm[1] >> t) & 1ull) != 0ull};
              const int qq0 = th * 32;
              if (br == 1) {
                if (__any((int)(on[0] || on[1]))) {
                  if (t == blk) attn_tile<2, 3>(o, os, qf, KBt, 0, VBt, nbv, on, qq0, 0, lane);
                  else if (__all((int)(on[0] && on[1]))) attn_tile<2, 0>(o, os, qf, KBt, 0, VBt, nbv, on, qq0, 0, lane);
                  else attn_tile<2, 1>(o, os, qf, KBt, 0, VBt, nbv, on, qq0, 0, lane);
                }
              } else {
                if (t == blk) attn_tile<2, 2>(o, os, qf, KBt, 0, VBt, nbv, on, qq0, 0, lane);
                else if (t == blk - 8) attn_tile<2, 4>(o, os, qf, KBt, 0, VBt, nbv, on, qq0, 0, lane);
                else attn_tile<2, 0>(o, os, qf, KBt, 0, VBt, nbv, on, qq0, 0, lane);
              }
            }
          }
        }
        nsa_finish(comb, o, os, (br == 1) ? gate1 : gate2, false);
        AT_BAR();
      }
#pragma unroll
      for (int qt = 0; qt < 2; ++qt) { bf16_t* op = CAT + (size_t)(tokw + qt * 16 + r) * DM + 512 + hh * 64;
#pragma unroll
        for (int dt = 0; dt < 4; ++dt) { const int d0 = dt * 16 + g * 4; v2u wv; wv.x = pk2(comb[dt][qt][0], comb[dt][qt][1]); wv.y = pk2(comb[dt][qt][2], comb[dt][qt][3]); *(GAS v2u*)(op + d0) = wv; } }
    }
  }
}


__device__ __forceinline__ void phase_lora2(PREF p, Frame& F, const bool skip_store = false, const bool skip_math = false) {
  const int lane = fresh_lane(), w = F.wave, tid = F.tid;
  const int cr = lane & 15, g = lane >> 4;
  constexpr int TP = 392;
  const lbf TM = (lbf)(F.lds);
  const lbf ST = (lbf)(F.lds + 64 * TP * 2) + w * 64 * RP;
  const bf16_t* TMPg = (const bf16_t*)(p.ws + WS_TMP);
  for (int unit = F.vcu; unit < 256; unit += F.G) {
    const int t0 = unit * 64;
    bf16x8 a0[2][4];
    auto wptr = [&](int blk) { const int tensor = blk >> 4, cb = blk & 15, ldw = (tensor == 2) ? 192 : 64;
      return (const bf16_t*)(p.ws + WS_WL2 + (size_t)tensor * 128 * 1024) + (size_t)(cb * 64 + cr) * ldw + g * 8; };
    auto wload = [&](int blk) {
      const int ldw = ((blk >> 4) == 2) ? 192 : 64; const bf16_t* Wp = wptr(blk);
#pragma unroll
      for (int k2 = 0; k2 < 2; ++k2)
#pragma unroll
        for (int ct = 0; ct < 4; ++ct) a0[k2][ct] = *(const GAS bf16x8*)(Wp + (size_t)(16 * ct) * ldw + k2 * 32);
    };
    auto blkof = [&](int j) { return ((j >> 1) << 4) | ((w * 2 + (j & 1) + unit * 3) & 15); };
    wload(blkof(0));
#pragma unroll
    for (int i = 0; i < 6; ++i) { const int idx = tid + i * 512, row = idx / 48, pc = idx - row * 48;
      *(LAS v4u*)(TM + row * TP + pc * 8) = *(const GAS v4u*)(TMPg + (size_t)(t0 + row) * 384 + pc * 8); }
    __syncthreads();
#pragma unroll 1
    for (int j = 0; j < 6; ++j) {
      const int blk = blkof(j);
      const int tensor = blk >> 4, cb = blk & 15, kc0 = tensor * 64;
      f32x4 acc[4][4];
#pragma unroll
      for (int ct = 0; ct < 4; ++ct)
#pragma unroll
        for (int tt = 0; tt < 4; ++tt) acc[ct][tt] = (f32x4){0.f, 0.f, 0.f, 0.f};
      auto kpair = [&](int kp, bf16x8 (&a)[2][4]) {
#pragma unroll
        for (int k2 = 0; k2 < 2; ++k2) {
          bf16x8 b[4];
#pragma unroll
          for (int tt = 0; tt < 4; ++tt) b[tt] = *(const LAS bf16x8*)(TM + (16 * tt + cr) * TP + kc0 + kp * 64 + k2 * 32 + g * 8);
#pragma unroll
          for (int ct = 0; ct < 4; ++ct)
#pragma unroll
            for (int tt = 0; tt < 4; ++tt) acc[ct][tt] = __builtin_amdgcn_mfma_f32_16x16x32_bf16(a[k2][ct], b[tt], acc[ct][tt], 0, 0, 0);
        }
      };
      if (tensor == 2) {
        bf16x8 a1[2][4], a2[2][4]; const bf16_t* Wp = wptr(blk);
#pragma unroll
        for (int k2 = 0; k2 < 2; ++k2)
#pragma unroll
          for (int ct = 0; ct < 4; ++ct) { a1[k2][ct] = *(const GAS bf16x8*)(Wp + (size_t)(16 * ct) * 192 + 64 + k2 * 32); a2[k2][ct] = *(const GAS bf16x8*)(Wp + (size_t)(16 * ct) * 192 + 128 + k2 * 32); }
        kpair(0, a0); kpair(1, a1); kpair(2, a2);
      } else kpair(0, a0);
      if (j < 5) wload(blkof(j + 1));
#pragma unroll
      for (int ct = 0; ct < 4; ++ct) {
        const int n0 = cb * 64 + 16 * ct + 4 * g;
        f32x4 bias = {0.f, 0.f, 0.f, 0.f};
        if (tensor == 0) bias = *(const f32x4*)(p.w0 + n0); else if (tensor == 1) bias = *(const f32x4*)(p.a0 + n0);
#pragma unroll
        for (int tt = 0; tt < 4; ++tt) {
          f32x4 v = acc[ct][tt] + bias;
          if (skip_math) {} else if (tensor == 0) {
#pragma unroll
            for (int i = 0; i < 4; ++i) v[i] = -0.60653066f * sigmoidf_(v[i]);
          } else if (tensor == 1) {
#pragma unroll
            for (int i = 0; i < 4; ++i) v[i] = sigmoidf_(v[i]);
          }
          v2u o; o.x = pk2(v[0], v[1]); o.y = pk2(v[2], v[3]);
          *(LAS v2u*)(ST + (16 * tt + cr) * RP + 16 * ct + 4 * g) = o;
        }
      }
      LDS_WAIT();
      bf16_t* O = (bf16_t*)(p.ws + WS_S0 + (size_t)tensor * SLOT) + (size_t)t0 * DM + cb * 64;
#pragma unroll
      for (int i = 0; i < 8; ++i) { const int row = (lane >> 3) + 8 * i, pc = (lane & 7) * 8;
        const v4u sv = *(const LAS v4u*)(ST + row * RP + pc); if (!skip_store) *(GAS v4u*)(O + (size_t)row * DM + pc) = sv; }
      LDS_WAIT();
    }
    __syncthreads();
  }
}

__global__ void __launch_bounds__(NWAVES * 64, 2) mk_fwd(P p_arg) {
  extern __shared__ __attribute__((aligned(16))) unsigned char lds[];
  Frame F;
  F.lds = (LAS unsigned char*)lds;
  F.MISC = (volatile LAS unsigned*)(F.lds + MISC_OFF);
  F.tid = threadIdx.x; F.lane = F.tid & 63; F.wave = __builtin_amdgcn_readfirstlane(F.tid >> 6);
  F.G = gridDim.x; { const int bx = blockIdx.x; F.vcu = (F.G % 8 == 0) ? (bx % 8) * (F.G / 8) + bx / 8 : bx; }
  unsigned char* const ws = p_arg.ws;
  F.ctl = (gu32*)(ws + WS_CTL);
  for (int u = F.tid; u < (LDS_BYTES - LDSCTL_OFF) / 4; u += NWAVES * 64) ((LAS unsigned*)(F.lds + LDSCTL_OFF))[u] = 0u;
  __syncthreads();
  XcdBarrier bar = xcd_barrier_post((unsigned*)(F.ctl + CW_BAR) + p_arg.pad * XCD_BAR_WORDS, F.MISC + 8);
  const int lo = p_arg.ph_lo, hi = p_arg.ph_hi;
#ifndef PHMASK
#define PHMASK 0xffffffffu
#endif
#define IN(k) (lo <= (k) && (k) < hi && ((PHMASK >> (k)) & 1u))
#define SEAM(k) do { if (IN(k) && IN((k) + 1)) xcd_barrier(bar); } while (0)
#ifdef PROBE_PH
  F.pr_t0 = 0; F.pr_t1 = 0;
#endif

  PROBE_MARK(0); if (IN(0)) { phase_prologue(KP, F); } SEAM(0);
  PROBE_MARK(1); if (IN(1)) {
    pg8::Gemm g{(const bf16_t*)(ws + WS_XN), (const bf16_t*)(ws + WS_WIN), DM, DM};
    pg8::StaticOrder S; S.init(T_TOK, 3072, F.G, (int)blockIdx.x);
    PREF p = KP; EpiInProj E{(bf16_t*)(ws + WS_H), (float*)(ws + WS_GATES), p.dq_norm, p.dk_norm, p.nq_norm, p.nk_norm, p.gate_bias};
    pg8::gemm_phase<EpiInProj, pg8::StaticOrder, true>(F.lds + RING_OFF, g, S, E);
  } SEAM(1);
  PROBE_MARK(2); if (IN(2)) { phase_compress(KP, F); phase_diffattn(KP, F); } SEAM(2);
  PROBE_MARK(3); if (IN(3)) { phase_nsa(KP, F); } SEAM(3);
  PROBE_MARK(4); if (IN(4)) {
    pg8::Gemm g{(const bf16_t*)(ws + WS_CAT), (const bf16_t*)(ws + WS_WOUT), DM, DM};
    pg8::StaticOrder S; S.init(T_TOK, DM, F.G, (int)blockIdx.x);
    PREF p = KP; EpiResid E{p.x, nullptr, (bf16_t*)p.out, nullptr};
    pg8::gemm_phase<EpiResid, pg8::StaticOrder, false>(F.lds + RING_OFF, g, S, E);
  } SEAM(4);
#define MOE_PHASES(layer, pb) do { \
    PROBE_MARK(pb); if (IN(pb)) { phase_router(KP, F, layer); } SEAM(pb); \
    PROBE_MARK(pb + 1); if (IN(pb + 1)) { \
      pg8::Gemm g{(const bf16_t*)(ws + WS_XN2), (const bf16_t*)(ws + WS_EGU), DM, DM}; \
      pg8::moe_order_setup((LAS int*)(F.lds + MISC_OFF + 256), (const unsigned*)(ws + WS_CTL) + CW_CNT + layer * 32 * 64); pg8::MoeOrder<2, true> S{(const LAS int*)(F.lds + MISC_OFF + 256), (const int*)(ws + WS_LIST), F.G, (int)blockIdx.x}; \
      EpiMoeGU E{(bf16_t*)(ws + WS_HID)}; \
      pg8::gemm_phase<EpiMoeGU, pg8::MoeOrder<2, true>, true>(F.lds + RING_OFF, g, S, E); \
    } SEAM(pb + 1); \
    PROBE_MARK(pb + 2); if (IN(pb + 2)) { \
      int k256 = 256; asm volatile("" : "+s"(k256)); \
      pg8::Gemm g{(const bf16_t*)(ws + WS_HID), (const bf16_t*)(ws + WS_EDN), k256, 256}; \
      pg8::moe_order_setup((LAS int*)(F.lds + MISC_OFF + 256), (const unsigned*)(ws + WS_CTL) + CW_CNT + layer * 32 * 64); pg8::MoeOrder<4, false> S{(const LAS int*)(F.lds + MISC_OFF + 256), (const int*)(ws + WS_LIST), F.G, (int)blockIdx.x}; \
      PREF p = KP; EpiMoeDown E{layer ? (bf16_t*)(ws + WS_X3) : (bf16_t*)p.out, (bf16_t*)(ws + WS_Y1), (const int*)(ws + WS_LIST), (const float*)(ws + WS_PGATE), (LAS int*)(F.lds + 132096)}; \
      pg8::gemm_phase<EpiMoeDown, pg8::MoeOrder<4, false>, true>(F.lds + RING_OFF, g, S, E); \
    } SEAM(pb + 2); \
  } while (0)
  MOE_PHASES(0, 5);
  PROBE_MARK(8); if (IN(8)) { phase_rwkv_prep(KP, F); } SEAM(8);
  PROBE_MARK(9); if (IN(9)) {
    pg8::Gemm g{(const bf16_t*)(ws + WS_S0 + 3 * SLOT), (const bf16_t*)(ws + WS_WL1), DM, DM};
    pg8::TallOrder S; S.init(3, 1, F.G, (int)blockIdx.x);
    EpiLora1 E{(bf16_t*)(ws + WS_TMP)};
    pg8::gemm_phase<EpiLora1, pg8::TallOrder, false>(F.lds + RING_OFF, g, S, E);
  } SEAM(9);
  PROBE_MARK(10); if (IN(10)) {
    pg8::Gemm g{(const bf16_t*)(ws + WS_S0), (const bf16_t*)(ws + WS_WRKV), DM, DM};
    pg8::TallOrder S; S.init(3, 4, F.G, (int)blockIdx.x);
    EpiRKV E{ws};
    pg8::gemm_phase<EpiRKV, pg8::TallOrder, true>(F.lds + RING_OFF, g, S, E);
  } SEAM(10);
  PROBE_MARK(11); if (IN(11)) {
#ifdef EXP_A
    phase_lora2(KP, F, KP.ph_lo == 0, false); __syncthreads();
#endif
#ifdef EXP_B
    phase_lora2(KP, F, KP.ph_lo == 0, KP.ph_lo == 0); __syncthreads();
#endif
    phase_lora2(KP, F);
  } SEAM(11);
  PROBE_MARK(12); if (IN(12)) { phase_rwkv_r1(KP, F); } SEAM(12);
  PROBE_MARK(13); if (IN(13)) { phase_rwkv_r2(KP, F); } SEAM(13);
  PROBE_MARK(14); if (IN(14)) { phase_rwkv_r3(KP, F); } SEAM(14);
  PROBE_MARK(15); if (IN(15)) {
    pg8::Gemm g{(const bf16_t*)(ws + WS_S0 + 3 * SLOT), (const bf16_t*)(ws + WS_WO), DM, DM};
    pg8::StaticOrder S; S.init(T_TOK, DM, F.G, (int)blockIdx.x);
    PREF p = KP; EpiResid E{nullptr, (const bf16_t*)p.out, (bf16_t*)(ws + WS_X3), (const bf16_t*)(ws + WS_Y1)};
    pg8::gemm_phase<EpiResid, pg8::StaticOrder, false>(F.lds + RING_OFF, g, S, E);
  } SEAM(15);
  MOE_PHASES(1, 16);
#undef MOE_PHASES
  PROBE_MARK(19); if (IN(19)) { phase_final(KP, F); }
  PROBE_MARK(20);
#ifdef PROBE_PH
  { const unsigned long long dur = (F.pr_t1 - F.pr_t0) * PROBE_MUL, t0 = __builtin_amdgcn_s_memrealtime(); while (__builtin_amdgcn_s_memrealtime() - t0 < dur) __builtin_amdgcn_s_sleep(8); }
#endif
#undef IN
#undef SEAM
}

static void launch_mk(P p, int lo, int hi, int li, int grid, hipStream_t st) {
  p.ph_lo = lo; p.ph_hi = hi; p.pad = li;
  hipLaunchKernelGGL(mk_fwd, dim3(grid), dim3(NWAVES * 64), LDS_BYTES, st, p);
}

extern "C" void kernel_launch(void* const* d_in, const int* in_sizes, int n_in, void* d_out, int out_size, void* d_ws,
                              size_t ws_size, hipStream_t stream) {
  static int grid = 0;
  if (grid == 0) {
    if (n_in != 40 || ws_size < WS_END) { fprintf(stderr, "kernel_launch: bad n_in %d or ws_size %zu (< %zu)\n", n_in, ws_size, (size_t)WS_END); grid = -1; return; }
    int dev = 0, cus = 0;
    if (hipGetDevice(&dev) != hipSuccess || hipDeviceGetAttribute(&cus, hipDeviceAttributeMultiprocessorCount, dev) != hipSuccess) { grid = -1; return; }
    if (hipFuncSetAttribute((const void*)mk_fwd, hipFuncAttributeMaxDynamicSharedMemorySize, LDS_BYTES) != hipSuccess) { grid = -1; return; }
    if (cus < 256) { fprintf(stderr, "kernel_launch: needs 256 CUs (one workgroup per CU), found %d\n", cus); grid = -1; return; }
    grid = 256;
  }
  if (grid < 0) return;
  P p{};
  const float* const* in = (const float* const*)d_in;
  p.x = in[0]; p.mix_norm = in[1]; p.w_in = in[2]; p.gate_bias = in[3]; p.dq_norm = in[4]; p.dk_norm = in[5];
  p.dlam = in[6]; p.dsubln = in[7]; p.nq_norm = in[8]; p.nk_norm = in[9]; p.cmp_pe = in[10]; p.cmp_w1 = in[11];
  p.cmp_w2 = in[12]; p.w_out = in[13]; p.rmix = in[14]; p.w_r = in[15]; p.w_k = in[16]; p.w_v = in[17];
  p.w0 = in[18]; p.w1 = in[19]; p.w2 = in[20]; p.a0 = in[21]; p.a1 = in[22]; p.a2 = in[23]; p.g1 = in[24]; p.g2 = in[25];
  p.k_k = in[26]; p.k_a = in[27]; p.r_k = in[28]; p.ln_w = in[29]; p.ln_b = in[30]; p.w_o = in[31];
  p.ffn_norm = in[32]; p.rg_w = in[33]; p.rg_b = in[34]; p.re_w = in[35]; p.re_b = in[36];
  p.e_gate = in[37]; p.e_up = in[38]; p.e_down = in[39];
  p.out = (float*)d_out;
  p.ws = (unsigned char*)d_ws;
  unsigned char* ws = p.ws;
  (void)hipMemsetAsync(ws + WS_CTL, 0, CTL_ZERO_BYTES, stream);
  launch_mk(p, 0, 20, 0, grid, stream);
}
```

```cpp
#include <hip/hip_runtime.h>
#include <cstdio>
#include <cstdint>

#define T_TOK 16384
#define DM 1024
#define SEQ 4096
#define NBATCH 4
#define INC 2840
#define HC 2816
#define OFF_DQ 0
#define OFF_DK 512
#define OFF_DV 1024
#define OFF_NQ 1536
#define OFF_NKV 2048
#define OFF_NG 2816
#define NCMP 255
#define CAP 16384

#define GAS __attribute__((address_space(1)))
#define LAS __attribute__((address_space(3)))
typedef unsigned short bf16_t;
typedef unsigned v4u __attribute__((ext_vector_type(4)));
typedef unsigned v2u __attribute__((ext_vector_type(2)));
typedef float f32x4 __attribute__((ext_vector_type(4)));
typedef short bf16x8 __attribute__((ext_vector_type(8)));
typedef GAS unsigned gu32;
#define RLX_AGENT __ATOMIC_RELAXED, __HIP_MEMORY_SCOPE_AGENT
#define LDS_WAIT() asm volatile("s_waitcnt lgkmcnt(0)" ::: "memory")
#define VM_WAIT() asm volatile("s_waitcnt vmcnt(0)" ::: "memory")

__device__ __forceinline__ float bf2f(bf16_t v) { return __uint_as_float(((unsigned)v) << 16); }

typedef float f32x2_t __attribute__((ext_vector_type(2))); typedef __bf16 bf16x2_t __attribute__((ext_vector_type(2)));
__device__ __forceinline__ unsigned pk2(float lo, float hi) { const f32x2_t v = {lo, hi}; return __builtin_bit_cast(unsigned, __builtin_convertvector(v, bf16x2_t)); }
__device__ __forceinline__ unsigned f2bf(float f) { return pk2(f, f) & 0xffffu; }
__device__ __forceinline__ float wave_sum(float v) {
#pragma unroll
  for (int o = 32; o >= 1; o >>= 1) v += __shfl_xor(v, o, 64);
  return v;
}
__device__ __forceinline__ float wave_sum_dpp(float v) {
  v += __builtin_bit_cast(float, __builtin_amdgcn_update_dpp(0, __builtin_bit_cast(int, v), 0xB1, 0xf, 0xf, false));
  v += __builtin_bit_cast(float, __builtin_amdgcn_update_dpp(0, __builtin_bit_cast(int, v), 0x4E, 0xf, 0xf, false));
  v += __builtin_bit_cast(float, __builtin_amdgcn_update_dpp(0, __builtin_bit_cast(int, v), 0x141, 0xf, 0xf, false));
  v += __builtin_bit_cast(float, __builtin_amdgcn_update_dpp(0, __builtin_bit_cast(int, v), 0x140, 0xf, 0xf, false));
  const int iv = __builtin_bit_cast(int, v);
  return (__builtin_bit_cast(float, __builtin_amdgcn_readlane(iv, 0)) + __builtin_bit_cast(float, __builtin_amdgcn_readlane(iv, 16))) +
         (__builtin_bit_cast(float, __builtin_amdgcn_readlane(iv, 32)) + __builtin_bit_cast(float, __builtin_amdgcn_readlane(iv, 48)));
}
__device__ __forceinline__ int fresh_lane() { int l; asm volatile("v_mbcnt_lo_u32_b32 %0, -1, 0\n\tv_mbcnt_hi_u32_b32 %0, -1, %0" : "=v"(l)); return l; }
__device__ __forceinline__ float uniformf(float v) { return __builtin_bit_cast(float, __builtin_amdgcn_readfirstlane(__builtin_bit_cast(int, v))); }
__device__ __forceinline__ float sum_x32(float v) { const auto rr = __builtin_amdgcn_permlane32_swap(__float_as_uint(v), __float_as_uint(v), false, false); return __uint_as_float(rr[0]) + __uint_as_float(rr[1]); }
__device__ __forceinline__ float sum_x16(float v) { const auto rr = __builtin_amdgcn_permlane16_swap(__float_as_uint(v), __float_as_uint(v), false, false); return __uint_as_float(rr[0]) + __uint_as_float(rr[1]); }
__device__ __forceinline__ float sum_x16_32(float v) { return sum_x32(sum_x16(v)); }
__device__ __forceinline__ float sigmoidf_(float x) { return __builtin_amdgcn_rcpf(1.f + __builtin_amdgcn_exp2f(-1.44269504f * x)); }
__device__ __forceinline__ float tanhf_(float x) { return 1.f - 2.f * __builtin_amdgcn_rcpf(1.f + __builtin_amdgcn_exp2f(2.88539008f * x)); }
__device__ __forceinline__ float softplusf_(float x) { return fmaxf(x, 0.f) + __logf(1.f + __expf(-fabsf(x))); }
__device__ __forceinline__ float gelu_tanh(float x) {
  float u = 0.7978845608028654f * (x + 0.044715f * x * x * x);
  return 0.5f * x * (1.f + tanhf(u));
}

constexpr size_t MiB = 1u << 20;
constexpr size_t WS_CTL = 0, CTL_ZERO_BYTES = 160 * 1024;
constexpr size_t WS_WIN = 1 * MiB;
constexpr size_t WS_WOUT = 7 * MiB;
constexpr size_t WS_WRKV = 9 * MiB;
constexpr size_t WS_WO = 15 * MiB;
constexpr size_t WS_WL1 = 17 * MiB;
constexpr size_t WS_WL2 = 19 * MiB;
constexpr size_t WS_WR = 20 * MiB;
constexpr size_t WS_RS = 20 * MiB + 640 * 1024;
constexpr size_t WS_EGU = 22 * MiB;
constexpr size_t WS_EDN = 54 * MiB;
constexpr size_t WS_ACT = 70 * MiB;
constexpr size_t WS_XN = WS_ACT;
constexpr size_t WS_H = WS_ACT + 32 * MiB;
constexpr size_t WS_GATES = WS_ACT + 120 * MiB;
constexpr size_t WS_CAT = WS_ACT + 122 * MiB;
constexpr size_t WS_KCMPB = WS_ACT + 154 * MiB;
constexpr size_t WS_VCMPB = WS_ACT + 155 * MiB;
constexpr size_t WS_CW1 = 21 * MiB + 256 * 1024;
constexpr size_t WS_XN2 = WS_ACT;
constexpr size_t WS_HID = WS_ACT + 32 * MiB;
constexpr size_t WS_Y1 = WS_EGU;
constexpr size_t WS_LIST = WS_ACT + 156 * MiB;
constexpr size_t WS_PGATE = WS_ACT + 158 * MiB;
constexpr size_t WS_X3 = WS_ACT + 64 * MiB;
constexpr size_t WS_XN2F = WS_ACT;
constexpr size_t WS_GUF = WS_ACT + 64 * MiB;
constexpr size_t WS_S0 = WS_ACT;
constexpr size_t WS_TMP = WS_ACT + 192 * MiB;
constexpr size_t WS_END = WS_ACT + 204 * MiB;
constexpr size_t SLOT = 32 * MiB;
constexpr int CW_BAR = 4096;
constexpr int CW_CNT = 32768;

namespace pg8 {
#define PG8_LAS __attribute__((address_space(3)))
typedef unsigned u32x4 __attribute__((ext_vector_type(4)));
constexpr int BM = 256, BK = 64, HALF = 128, HTB = HALF * BK * 2  , STAGE_BYTES = 8 * HTB, NXCD = 8, WGM = 8;

__host__ __device__ __forceinline__ int lds_byte(int r, int c) { const int st = (r >> 4) * 2 + (c >> 5), rr = r & 15, cc = c & 31, ob = rr * 64 + cc * 2; return st * 1024 + (ob ^ (((ob >> 9) & 1) << 5)); }
__host__ __device__ __forceinline__ void stage_rc(int b, int& R, int& C) { const int st = b / 1024, sb = b % 1024, swz = sb ^ (((sb >> 9) & 1) << 5); R = (st >> 1) * 16 + swz / 64; C = (st & 1) * 32 + (swz % 64) / 2; }
__host__ __device__ __forceinline__ int perm32(int rho) { const int n = rho >> 4, i = rho & 15; return 8 * (i >> 2) + 4 * n + (i & 3); }

struct Unit { int pm, pn, e, nrows, rt, par; };
struct Gemm { const bf16_t* A; const bf16_t* Bt; int K; int lda; };

__device__ __forceinline__ void static_map(int L, int nM, int nN, int& pm, int& pn) {
    const int nwg = nM * nN;
    int wgid = L; { const int q = nwg / NXCD, r = nwg % NXCD, xcd = wgid % NXCD, off = wgid / NXCD; wgid = (xcd < r ? xcd * (q + 1) : r * (q + 1) + (xcd - r) * q) + off; }
    const int nig = WGM * nN, gid = wgid / nig, fm = gid * WGM, gsz = (nM - fm) < WGM ? (nM - fm) : WGM;
    pm = fm + ((wgid % nig) % gsz); pn = (wgid % nig) / gsz;
}
struct StaticOrder {
    int nM, nN, G, c;
    __device__ void init(int M, int N, int G_, int c_) { nM = M / BM; nN = N / BM; G = G_; c = c_; }
    __device__ __forceinline__ bool next(int i, Unit& u) const {
        const int L = i * G + c; if (L >= nM * nN) return false;
        static_map(L, nM, nN, u.pm, u.pn); u.e = 0; u.nrows = 256; u.rt = 0; return true;
    }
    __device__ __forceinline__ unsigned rowoff(const Unit& u, int r, int C, int K) const { return (unsigned)((u.pm * BM + r) * K + C) * 2u; }
};
struct TallOrder {
    int nM, nN, G, c;
    __device__ void init(int ngemm, int nN_, int G_, int c_) { nM = 64 * ngemm; nN = nN_; G = G_; c = c_; }
    __device__ __forceinline__ bool next(int i, Unit& u) const {
        const int L = i * G + c; if (L >= nM * nN) return false;
        int pn; static_map(L, nM, nN, u.pm, pn); u.pn = (u.pm >> 6) * nN + pn; u.e = 0; u.nrows = 256; u.rt = 0; return true;
    }
    __device__ __forceinline__ unsigned rowoff(const Unit& u, int r, int C, int K) const { return (unsigned)((u.pm * BM + r) * K + C) * 2u; }
};


template <int NCOL, bool GATHER>
struct MoeOrder {
    const PG8_LAS int* tab;
    const int* list; int G, c;
    __device__ __forceinline__ bool next(int i, Unit& u) const {
        const int L = i * G + c; const int R = L / NCOL, j = L - R * NCOL;
        if (R >= tab[32]) return false;
        int e = 0;
#pragma unroll
        for (int s = 16; s >= 1; s >>= 1) { if (tab[e + s] <= R) e += s; }
        const int ce = tab[33 + e];
        u.pm = R; u.rt = R - tab[e]; u.e = e; u.pn = e * NCOL + j; u.nrows = ce - u.rt * 256; return true;
    }
    __device__ __forceinline__ unsigned rowoff(const Unit& u, int r, int C, int K) const {
        if (GATHER) { const int idx = (r < u.nrows) ? u.rt * 256 + r : 0; const int pr = list[(size_t)u.e * CAP + idx]; return (unsigned)((pr >> 1) * K + C) * 2u; }
        return (unsigned)((u.pm * BM + r) * K + C) * 2u;
    }
};
__device__ __forceinline__ void moe_order_setup(PG8_LAS int* tab, const unsigned* cnt) {
    if (threadIdx.x < 32) tab[33 + threadIdx.x] = (int)__hip_atomic_load(cnt + threadIdx.x * 64, __ATOMIC_RELAXED, __HIP_MEMORY_SCOPE_AGENT);
    __syncthreads();
    if (threadIdx.x == 0) { int pre = 0; for (int e = 0; e < 32; ++e) { tab[e] = pre; pre += (tab[33 + e] + 255) >> 8; } tab[32] = pre; }
    __syncthreads();
}

__device__ __forceinline__ unsigned cvt_pk_bf16(float lo, float hi) { unsigned r; asm volatile("v_cvt_pk_bf16_f32 %0, %1, %2" : "=v"(r) : "v"(lo), "v"(hi)); return r; }
__device__ __forceinline__ u32x4 pack8(const f32x4& a, const f32x4& b) { u32x4 w; w.x = cvt_pk_bf16(a[0], a[1]); w.y = cvt_pk_bf16(a[2], a[3]); w.z = cvt_pk_bf16(b[0], b[1]); w.w = cvt_pk_bf16(b[2], b[3]); return w; }

template <class Epi, class Sched, bool ALIGN_EPI>
__device__ __forceinline__ void gemm_phase(PG8_LAS unsigned char* lds, const Gemm g, const Sched& S, const Epi& E) {
    const int tid = threadIdx.x, wid = __builtin_amdgcn_readfirstlane(tid >> 6), lane = tid & 63, wr = wid >> 2, wc = wid & 3, fr = lane & 15, fq = lane >> 4;
    const int K = g.K, nt = K / BK;
    int RA[2], CA[2]; unsigned voffB[2];
#pragma unroll
    for (int i = 0; i < 2; ++i) { int R, C; stage_rc(tid * 16 + i * 8192, R, C); const int Rb = Epi::PERM ? ((R & ~31) + perm32(R & 31)) : R;
        RA[i] = R; CA[i] = C; voffB[i] = (unsigned)(Rb * K + C) * 2u; }
    const size_t kstep = (size_t)(BK * 2);
    const size_t hstep = (size_t)HALF * K * 2;
    const size_t tstep = 2 * hstep;
    const unsigned ldsw = (unsigned)wid * 1024u;
    const int aoff = lds_byte(wr * 64 + fr, fq * 8), boff = lds_byte(wc * 32 + fr, fq * 8);
    const char* const Abase = (const char*)g.A;
#define PG8_SA(b, h) (((b) * 2 + (h)) * HTB)
#define PG8_SB(b, h) ((4 + (b) * 2 + (h)) * HTB)
#define PG8_STAGE(bufoff, gbase, voff) do { _Pragma("unroll") for (int _i = 0; _i < 2; ++_i) \
        __builtin_amdgcn_global_load_lds((const unsigned*)((const char*)(gbase) + (voff)[_i]), (PG8_LAS unsigned*)(lds + (bufoff) + ldsw + _i * 8192), 16, 0, 0); } while (0)
#define PG8_STAGEA(bufoff, kbyte, o0, o1) do { \
        __builtin_amdgcn_global_load_lds((const unsigned*)(Abase + (size_t)(kbyte) + (o0)), (PG8_LAS unsigned*)(lds + (bufoff) + ldsw), 16, 0, 0); \
        __builtin_amdgcn_global_load_lds((const unsigned*)(Abase + (size_t)(kbyte) + (o1)), (PG8_LAS unsigned*)(lds + (bufoff) + ldsw + 8192), 16, 0, 0); } while (0)
#define PG8_LDA(dst, b, h) do { _Pragma("unroll") for (int m = 0; m < 4; ++m) _Pragma("unroll") for (int k = 0; k < 2; ++k) dst[m][k] = *(const PG8_LAS bf16x8*)(lds + PG8_SA(b, h) + aoff + m * 2048 + k * 1024); } while (0)
#define PG8_LDB(dst, b, h) do { _Pragma("unroll") for (int n = 0; n < 2; ++n) _Pragma("unroll") for (int k = 0; k < 2; ++k) dst[n][k] = *(const PG8_LAS bf16x8*)(lds + PG8_SB(b, h) + boff + n * 2048 + k * 1024); } while (0)
#define PG8_MMA(ai, bj, At, Bt) do { __builtin_amdgcn_s_setprio(1); _Pragma("unroll") for (int m = 0; m < 4; ++m) _Pragma("unroll") for (int n = 0; n < 2; ++n) _Pragma("unroll") for (int k = 0; k < 2; ++k) \
        acc[ai][bj][m][n] = __builtin_amdgcn_mfma_f32_16x16x32_bf16(Bt[n][k], At[m][k], acc[ai][bj][m][n], 0, 0, 0); __builtin_amdgcn_s_setprio(0); } while (0)
#define PG8_WAIT_V(n) asm volatile("s_waitcnt vmcnt(" #n ")" ::: "memory")
#define PG8_WAIT_L(n) asm volatile("s_waitcnt lgkmcnt(" #n ")" ::: "memory")
#define PG8_BAR __builtin_amdgcn_s_barrier()
#define PG8_SCHED __builtin_amdgcn_sched_barrier(0)
    Unit cur, nxt; int ui = 0;
    if (!S.next(0, cur)) return;
    cur.par = 0;
    if constexpr (Epi::HAS_PRE) E.pre(cur);
    f32x4 acc[2][2][4][2];
#pragma unroll
    for (int a = 0; a < 2; ++a)
#pragma unroll
        for (int b = 0; b < 2; ++b)
#pragma unroll
            for (int m = 0; m < 4; ++m)
#pragma unroll
                for (int n = 0; n < 2; ++n) acc[a][b][m][n] = (f32x4){0.f, 0.f, 0.f, 0.f};
    bf16x8 At[4][2], B0[2][2], B1[2][2];
    unsigned c00 = S.rowoff(cur, RA[0], CA[0], g.lda), c01 = S.rowoff(cur, RA[1], CA[1], g.lda), c10 = S.rowoff(cur, HALF + RA[0], CA[0], g.lda), c11 = S.rowoff(cur, HALF + RA[1], CA[1], g.lda);
    unsigned n00, n01, n10, n11;
    const char* cB = (const char*)g.Bt + (size_t)cur.pn * tstep;
    PG8_STAGE(PG8_SB(0, 0), cB, voffB); PG8_STAGE(PG8_SB(0, 1), cB + hstep, voffB); PG8_STAGEA(PG8_SA(0, 0), 0, c00, c01); PG8_STAGEA(PG8_SA(0, 1), 0, c10, c11);
    if (wr == 1) PG8_BAR;
    PG8_WAIT_V(2); PG8_BAR;
    PG8_STAGE(PG8_SB(1, 0), cB + kstep, voffB); PG8_STAGEA(PG8_SA(1, 0), kstep, c00, c01); PG8_STAGE(PG8_SB(1, 1), cB + hstep + kstep, voffB);
    PG8_WAIT_V(6); PG8_BAR;
    for (;;) {
        const bool has_next = S.next(ui + 1, nxt);
        const char* nB = has_next ? (const char*)g.Bt + (size_t)nxt.pn * tstep : cB;
        if (has_next) { n00 = S.rowoff(nxt, RA[0], CA[0], g.lda); n01 = S.rowoff(nxt, RA[1], CA[1], g.lda); n10 = S.rowoff(nxt, HALF + RA[0], CA[0], g.lda); n11 = S.rowoff(nxt, HALF + RA[1], CA[1], g.lda); }
        else { n00 = c00; n01 = c01; n10 = c10; n11 = c11; }
        for (int t = 0; t < nt; t += 2) {
            const bool last = (t == nt - 2);
            const size_t k1 = (size_t)(t + 1) * kstep;
            const size_t k2 = last ? 0 : (size_t)(t + 2) * kstep;
            const size_t k3 = k2 + kstep;
            const unsigned a00 = last ? n00 : c00, a01 = last ? n01 : c01, a10 = last ? n10 : c10, a11 = last ? n11 : c11;
            const char* b2 = last ? nB : cB + (size_t)(t + 2) * kstep;
            const char* b3 = b2 + kstep;
            PG8_LDB(B0, 0, 0); PG8_LDB(B1, 0, 1); PG8_SCHED; PG8_LDA(At, 0, 0); PG8_STAGEA(PG8_SA(1, 1), k1, c10, c11);
            PG8_WAIT_V(8); PG8_WAIT_L(0); PG8_BAR; PG8_MMA(0, 0, At, B0); PG8_MMA(0, 1, At, B1); PG8_BAR; PG8_SCHED;
            PG8_LDA(At, 0, 1); PG8_STAGE(PG8_SB(0, 0), b2, voffB); PG8_STAGE(PG8_SB(0, 1), b2 + hstep, voffB); PG8_STAGEA(PG8_SA(0, 0), k2, a00, a01);
            PG8_WAIT_V(8); PG8_WAIT_L(0); PG8_BAR; PG8_MMA(1, 0, At, B0); PG8_MMA(1, 1, At, B1); PG8_BAR; PG8_SCHED;
            PG8_LDB(B0, 1, 0); PG8_LDB(B1, 1, 1); PG8_SCHED; PG8_LDA(At, 1, 0); PG8_STAGEA(PG8_SA(0, 1), k2, a10, a11);
            PG8_WAIT_V(8); PG8_WAIT_L(0); PG8_BAR; PG8_MMA(0, 0, At, B0); PG8_MMA(0, 1, At, B1); PG8_BAR; PG8_SCHED;
            PG8_LDA(At, 1, 1); PG8_STAGE(PG8_SB(1, 0), b3, voffB); PG8_STAGE(PG8_SB(1, 1), b3 + hstep, voffB); PG8_STAGEA(PG8_SA(1, 0), k3, a00, a01);
            PG8_WAIT_V(8); PG8_WAIT_L(0); PG8_BAR; PG8_MMA(1, 0, At, B0); PG8_MMA(1, 1, At, B1); PG8_BAR; PG8_SCHED;
        }
        if constexpr (ALIGN_EPI) { if (wr == 0) PG8_BAR; }
        E(acc, cur, wr, wc, fr, fq);
        if (!has_next) break;
#pragma unroll
        for (int a = 0; a < 2; ++a)
#pragma unroll
            for (int b = 0; b < 2; ++b)
#pragma unroll
                for (int m = 0; m < 4; ++m)
#pragma unroll
                    for (int n = 0; n < 2; ++n) acc[a][b][m][n] = (f32x4){0.f, 0.f, 0.f, 0.f};
        cur = nxt; cB = nB; c00 = n00; c01 = n01; c10 = n10; c11 = n11; ++ui; cur.par = ui & 1;
        if constexpr (Epi::HAS_PRE) E.pre(cur);
        if constexpr (ALIGN_EPI) { if (wr == 1) PG8_BAR; }
    }
    PG8_WAIT_V(0);
    if constexpr (!ALIGN_EPI) { if (wr == 0) PG8_BAR; }
    PG8_BAR;
#undef PG8_SA
#undef PG8_SB
#undef PG8_STAGE
#undef PG8_STAGEA
#undef PG8_LDA
#undef PG8_LDB
#undef PG8_MMA
#undef PG8_WAIT_V
#undef PG8_WAIT_L
#undef PG8_BAR
#undef PG8_SCHED
}
}

#define XB_TMO      128
#define XB_XCNT(j)  (256  + 64 * (j))
#define XB_XSUB(j)  (1280 + 64 * (j))
#define XB_XGEN(j)  (2304 + 64 * (j))
#define XB_TOP      3328
#define XB_TOPGEN   3392
#define XCD_BAR_WORDS 3456
#define XB_SPIN_CAP (1u << 18)

__device__ __forceinline__ unsigned xb_ld(unsigned* p)              { return __hip_atomic_load(p, __ATOMIC_RELAXED, __HIP_MEMORY_SCOPE_AGENT); }
__device__ __forceinline__ unsigned xb_add(unsigned* p, unsigned v) { return __hip_atomic_fetch_add(p, v, __ATOMIC_RELAXED, __HIP_MEMORY_SCOPE_AGENT); }
__device__ __forceinline__ unsigned xb_xcc_id() { return (unsigned)__builtin_amdgcn_s_getreg((3 << 11) | 20) & 0xFu; }
#define XB_SPIN(cond, bar) do { unsigned _sp = 0; while (cond) { __builtin_amdgcn_s_sleep(1); \
    if ((++_sp & 255u) == 0u) { if (xb_ld(&(bar)[XB_TMO])) break; if (_sp > XB_SPIN_CAP) { atomicAdd(&(bar)[XB_TMO], 1u); break; } } } } while (0)

struct XcdBarrier {
    unsigned* bar; unsigned x;
    volatile LAS unsigned* st;
};

__device__ __forceinline__ XcdBarrier xcd_barrier_post(unsigned* bar, volatile LAS unsigned* st) {
    XcdBarrier b; b.bar = bar; b.x = xb_xcc_id(); b.st = st;
    if (threadIdx.x == 0) (void)xb_add(&bar[XB_XCNT(b.x)], 1u);
    return b;
}
__device__ __forceinline__ void xcd_barrier_complete(unsigned* bar, unsigned x, unsigned& nloc, unsigned& nx) {
    const unsigned G = gridDim.x * gridDim.y * gridDim.z;
    unsigned sum, cnt, mine, sp = 0u;
    for (;;) {
        sum = 0u; cnt = 0u; mine = 0u;
#pragma unroll
        for (unsigned j = 0; j < 16; ++j) { const unsigned c = xb_ld(&bar[XB_XCNT(j)]); sum += c; cnt += (c > 0u) ? 1u : 0u; mine = (j == x) ? c : mine; }
        if (sum == G) break;
        __builtin_amdgcn_s_sleep(1);
        if ((++sp & 255u) == 0u) { if (xb_ld(&bar[XB_TMO])) break; if (sp > XB_SPIN_CAP) { atomicAdd(&bar[XB_TMO], 1u); break; } }
    }
    nloc = mine > 0u ? mine : 1u; nx = cnt > 0u ? cnt : 1u;
}

__device__ __forceinline__ void xcd_barrier(const XcdBarrier& b) {
    asm volatile("s_waitcnt vmcnt(0)" ::: "memory");
    __syncthreads();
    if (threadIdx.x == 0) {
        unsigned* bar = b.bar;
        __builtin_amdgcn_s_waitcnt(0);
        unsigned nloc = b.st[0], nx = b.st[1];
        if (nloc == 0u) { xcd_barrier_complete(bar, b.x, nloc, nx); b.st[0] = nloc; b.st[1] = nx; }
        const unsigned old = xb_add(&bar[XB_XSUB(b.x)], 1u);
        const unsigned gen = old / nloc;
        if (old + 1u == (gen + 1u) * nloc) {
            __builtin_amdgcn_fence(__ATOMIC_RELEASE, "agent");
            asm volatile("s_waitcnt vmcnt(0)" ::: "memory");
            const unsigned og = xb_add(&bar[XB_TOP], 1u);
            const unsigned tg = og / nx;
            if (og + 1u == (tg + 1u) * nx) xb_add(&bar[XB_TOPGEN], 1u);
            else XB_SPIN(xb_ld(&bar[XB_TOPGEN]) == tg, bar);
            __builtin_amdgcn_fence(__ATOMIC_ACQUIRE, "agent");
            xb_add(&bar[XB_XGEN(b.x)], 1u);
            asm volatile("s_waitcnt vmcnt(0)" ::: "memory");
        } else {
            XB_SPIN(xb_ld(&bar[XB_XGEN(b.x)]) == gen, bar);
            __builtin_amdgcn_fence(__ATOMIC_ACQUIRE, "agent");
            asm volatile("s_waitcnt vmcnt(0)" ::: "memory");
        }
    }
    __syncthreads();
}
struct P {
  const float* x; const float* mix_norm; const float* w_in; const float* gate_bias;
  const float* dq_norm; const float* dk_norm; const float* dlam; const float* dsubln;
  const float* nq_norm; const float* nk_norm; const float* cmp_pe; const float* cmp_w1; const float* cmp_w2;
  const float* w_out;
  const float* rmix; const float* w_r; const float* w_k; const float* w_v;
  const float* w0; const float* w1; const float* w2; const float* a0; const float* a1; const float* a2;
  const float* g1; const float* g2; const float* k_k; const float* k_a; const float* r_k;
  const float* ln_w; const float* ln_b; const float* w_o;
  const float* ffn_norm; const float* rg_w; const float* rg_b; const float* re_w; const float* re_b;
  const float* e_gate; const float* e_up; const float* e_down;
  float* out;
  unsigned char* ws;
  int ph_lo, ph_hi, layer, pad;
};

#define PREF const __attribute__((address_space(4))) P&
__device__ __forceinline__ const __attribute__((address_space(4))) P* opaque_kernarg() { auto q = __builtin_amdgcn_kernarg_segment_ptr(); asm volatile("" : "+s"(q)); return (const __attribute__((address_space(4))) P*)q; }
#define KP (*opaque_kernarg())

constexpr int RING_OFF = 0, RING_BYTES = 131072;
constexpr int LDSCTL_OFF = RING_BYTES, MISC_OFF = LDSCTL_OFF + 320;
constexpr int LDS_BYTES = 147456;
constexpr int NWAVES = 8;

struct Frame {
  LAS unsigned char* lds;
  volatile LAS unsigned* MISC;
  gu32* ctl;
  int tid, lane, wave, vcu, G;
#ifdef PROBE_PH
  unsigned long long pr_t0, pr_t1;
#endif
};
#ifdef PROBE_PH
#define PROBE_MARK(k) do { if ((k) == PROBE_PH) F.pr_t0 = __builtin_amdgcn_s_memrealtime(); if ((k) == PROBE_PH + PROBE_N) F.pr_t1 = __builtin_amdgcn_s_memrealtime(); } while (0)
#else
#define PROBE_MARK(k) do {} while (0)
#endif

__device__ __forceinline__ void transpose_item(const float* W, int ldsrc, int k0, int c0, int ncols, bf16_t* dst, int ldk, int drow0, LAS float* scr, int lane, const float* kscale = nullptr) {
  const int kr = lane >> 3, c4 = (lane & 7) * 4;
  f32x4 v[8];
#pragma unroll
  for (int i = 0; i < 8; ++i) v[i] = (c4 < ncols) ? *(const GAS f32x4*)(W + (size_t)(k0 + kr + 8 * i) * ldsrc + c0 + c4) : (f32x4){0.f, 0.f, 0.f, 0.f};
  if (kscale) {
#pragma unroll
    for (int i = 0; i < 8; ++i) v[i] = v[i] * kscale[k0 + kr + 8 * i]; }
#pragma unroll
  for (int i = 0; i < 8; ++i) { LAS float* s = scr + (kr + 8 * i) * 33 + c4; s[0] = v[i].x; s[1] = v[i].y; s[2] = v[i].z; s[3] = v[i].w; }
  LDS_WAIT(); asm volatile("" ::: "memory");
  const int c = lane & 7;
#pragma unroll
  for (int j = 0; j < 4; ++j) { const int n = (lane >> 3) + 8 * j; const LAS float* s = scr + (8 * c) * 33 + n;
    v4u o; o.x = pk2(s[0 * 33], s[1 * 33]); o.y = pk2(s[2 * 33], s[3 * 33]); o.z = pk2(s[4 * 33], s[5 * 33]); o.w = pk2(s[6 * 33], s[7 * 33]);
    *(GAS v4u*)(dst + (size_t)(drow0 + n) * ldk + k0 + 8 * c) = o; }
  LDS_WAIT(); asm volatile("" ::: "memory");
}
template <int NR>
__device__ __forceinline__ void rms_rows_to_bf16(const float* x, const float* gain, bf16_t* o, int m0, int stride, int lane) {
  f32x4 v[NR][4];
#pragma unroll
  for (int r = 0; r < NR; ++r) { const GAS f32x4* xr = (const GAS f32x4*)(x + (size_t)(m0 + r * stride) * DM) + lane;
#pragma unroll
    for (int j = 0; j < 4; ++j) v[r][j] = xr[64 * j]; }
  const GAS f32x4* gr = (const GAS f32x4*)gain + lane;
  f32x4 g[4];
#pragma unroll
  for (int j = 0; j < 4; ++j) g[j] = gr[64 * j];
#pragma unroll
  for (int r = 0; r < NR; ++r) {
    float s = 0.f;
#pragma unroll
    for (int j = 0; j < 4; ++j) s += (v[r][j].x * v[r][j].x + v[r][j].y * v[r][j].y) + (v[r][j].z * v[r][j].z + v[r][j].w * v[r][j].w);
    const float rr = rsqrtf(wave_sum_dpp(s) * (1.f / DM) + 1e-6f);
    GAS v2u* o8 = (GAS v2u*)(o + (size_t)(m0 + r * stride) * DM) + lane;
#pragma unroll
    for (int j = 0; j < 4; ++j) { v2u w; w.x = pk2(v[r][j].x * rr * g[j].x, v[r][j].y * rr * g[j].y); w.y = pk2(v[r][j].z * rr * g[j].z, v[r][j].w * rr * g[j].w); o8[64 * j] = w; }
  }
}

__device__ __forceinline__ void conv_win_item(PREF p, int it, LAS float* scr, int lane) {
  const int vg = it >> 4, kb = it & 15;
  const int pn = vg >> 3, bj = (vg >> 2) & 1, wc = vg & 3, s = pn * 4 + wc;
  int c0 = 0, nc = 0;
  if (s < 44) { c0 = 64 * s + 32 * bj; nc = 32; } else if (s == 44 && bj == 0) { c0 = OFF_NG; nc = 24; }
  transpose_item(p.w_in, INC, kb * 64, c0, nc, (bf16_t*)(p.ws + WS_WIN), DM, vg * 32, scr, lane);
}
__device__ __forceinline__ void conv_sq_item(const float* W, bf16_t* dst, int drow_base, int it, LAS float* scr, int lane) {
  const int cg = it >> 4, kb = it & 15;
  transpose_item(W, DM, kb * 64, cg * 32, 32, dst, DM, drow_base + cg * 32, scr, lane);
}
__device__ __forceinline__ void conv_expert_item(PREF p, int layer, int it, LAS float* scr, int lane, bf16_t* egu) {
  const int e = it / 384, r = it % 384;
  if (r < 256) {
    const int up = r >> 7, q = r & 127, cgp = q >> 4, kb = q & 15;
    const int pn = cgp >> 2, qq = cgp & 3;
    const float* W = (up ? p.e_up : p.e_gate) + ((size_t)layer * 32 + e) * DM * 256;
    transpose_item(W, 256, kb * 64, cgp * 32, 32, egu, DM, e * 512 + pn * 256 + up * 128 + qq * 32, scr, lane, p.ffn_norm + layer * DM);
  } else {
    const int q = r - 256, cg = q >> 2, kb = q & 3;
    const float* W = p.e_down + ((size_t)layer * 32 + e) * 256 * DM;
    transpose_item(W, DM, kb * 64, cg * 32, 32, (bf16_t*)(p.ws + WS_EDN), 256, e * 1024 + cg * 32, scr, lane);
  }
}

using pg8::Unit; using pg8::u32x4; using pg8::pack8;
struct EpiInProj {
  static constexpr bool PERM = true, HAS_PRE = false;
  bf16_t* H; float* GATES; const float* dq; const float* dk; const float* nq; const float* nk; const float* gbias;
  __device__ __forceinline__ void operator()(const f32x4 (&acc)[2][2][4][2], const Unit& u, int wr, int wc, int fr, int fq) const {
    const int s = u.pn * 4 + wc;
    if (s > 44) return;
    const int row0 = u.pm * 256 + wr * 64 + fr;
    if (s == 44) {
      if (fq < 3) {
        f32x4 b0 = *(const f32x4*)(gbias + 8 * fq), b1 = *(const f32x4*)(gbias + 8 * fq + 4);
#pragma unroll
        for (int ai = 0; ai < 2; ++ai)
#pragma unroll
          for (int m = 0; m < 4; ++m) { float* gp = GATES + (size_t)(row0 + ai * 128 + m * 16) * 24 + 8 * fq;
            f32x4 v0 = acc[ai][0][m][0] + b0, v1 = acc[ai][0][m][1] + b1;
#pragma unroll
            for (int i = 0; i < 4; ++i) { v0[i] = sigmoidf_(v0[i]); v1[i] = sigmoidf_(v1[i]); }
            *(f32x4*)gp = v0; *(f32x4*)(gp + 4) = v1; }
      }
      return;
    }
    int mode = 0; const float* gain = nullptr;
    if (s < 8) { mode = 1; gain = dq; } else if (s < 16) { mode = 1; gain = dk; }
    else if (s >= 24 && s < 32) { mode = 2; gain = nq; }
    else if (s >= 32) { const int q = s - 32, br = q >> 2, kv = (q >> 1) & 1; if (kv == 0 && br >= 1) { mode = 2; gain = nk + br * 64; } }
    const float qsc = (s < 8) ? 0.17677669529663687f * 1.4426950408889634f : ((s >= 24 && s < 32) ? 0.125f * 1.4426950408889634f : 1.f);
    f32x4 g[2][2];
#pragma unroll
    for (int bj = 0; bj < 2; ++bj)
#pragma unroll
      for (int n = 0; n < 2; ++n) {
        if (mode == 1) g[bj][n] = *(const f32x4*)(gain + 8 * fq + 4 * n);
        else if (mode == 2) g[bj][n] = *(const f32x4*)(gain + 32 * bj + 8 * fq + 4 * n);
        else g[bj][n] = (f32x4){1.f, 1.f, 1.f, 1.f};
      }
#pragma unroll
    for (int ai = 0; ai < 2; ++ai)
#pragma unroll
      for (int m = 0; m < 4; ++m) {
        float sc[2] = {1.f, 1.f};
        if (mode != 0) {
          float ss[2];
#pragma unroll
          for (int bj = 0; bj < 2; ++bj) { const f32x4 a = acc[ai][bj][m][0], b = acc[ai][bj][m][1];
            float t = (a[0] * a[0] + a[1] * a[1]) + (a[2] * a[2] + a[3] * a[3]) + (b[0] * b[0] + b[1] * b[1]) + (b[2] * b[2] + b[3] * b[3]);
            ss[bj] = sum_x16_32(t); }
          if (mode == 1) { sc[0] = rsqrtf(ss[0] * (1.f / 32.f) + 1e-6f) * qsc; sc[1] = rsqrtf(ss[1] * (1.f / 32.f) + 1e-6f) * qsc; }
          else { const float r = rsqrtf((ss[0] + ss[1]) * (1.f / 64.f) + 1e-6f) * qsc; sc[0] = r; sc[1] = r; }
        }
        bf16_t* rowp = H + (size_t)(row0 + ai * 128 + m * 16) * HC + 64 * s + 8 * fq;
#pragma unroll
        for (int bj = 0; bj < 2; ++bj) { const f32x4 v0 = acc[ai][bj][m][0] * sc[bj] * g[bj][0], v1 = acc[ai][bj][m][1] * sc[bj] * g[bj][1];
          *(u32x4*)(rowp + 32 * bj) = pack8(v0, v1); }
      }
  }
};
struct EpiResid {
  static constexpr bool PERM = true, HAS_PRE = false;
  const float* xf; const bf16_t* xb; bf16_t* out; const bf16_t* y1;
  __device__ __forceinline__ void operator()(const f32x4 (&acc)[2][2][4][2], const Unit& u, int wr, int wc, int fr, int fq) const {
    const int row0 = u.pm * 256 + wr * 64 + fr, col0 = u.pn * 256 + wc * 32 + 8 * fq;
#pragma unroll
    for (int ai = 0; ai < 2; ++ai)
#pragma unroll
      for (int m = 0; m < 4; ++m) { const size_t off = (size_t)(row0 + ai * 128 + m * 16) * DM + col0;
#pragma unroll
        for (int bj = 0; bj < 2; ++bj) {
          f32x4 b0, b1;
          if (xf) { b0 = *(const f32x4*)(xf + off + bj * 128); b1 = *(const f32x4*)(xf + off + bj * 128 + 4); }
          else { const v4u w = *(const v4u*)(xb + off + bj * 128);
            b0 = (f32x4){__uint_as_float(w.x << 16), __uint_as_float(w.x & 0xffff0000u), __uint_as_float(w.y << 16), __uint_as_float(w.y & 0xffff0000u)};
            b1 = (f32x4){__uint_as_float(w.z << 16), __uint_as_float(w.z & 0xffff0000u), __uint_as_float(w.w << 16), __uint_as_float(w.w & 0xffff0000u)}; }
          if (y1) { const v4u w = *(const v4u*)(y1 + off + bj * 128);
            b0 += (f32x4){__uint_as_float(w.x << 16), __uint_as_float(w.x & 0xffff0000u), __uint_as_float(w.y << 16), __uint_as_float(w.y & 0xffff0000u)};
            b1 += (f32x4){__uint_as_float(w.z << 16), __uint_as_float(w.z & 0xffff0000u), __uint_as_float(w.w << 16), __uint_as_float(w.w & 0xffff0000u)}; }
          *(u32x4*)(out + off + bj * 128) = pack8(b0 + acc[ai][bj][m][0], b1 + acc[ai][bj][m][1]); asm volatile("" ::: "memory"); } }
  }
};
struct EpiRKV {
  static constexpr bool PERM = true, HAS_PRE = false;
  unsigned char* ws;
  __device__ __forceinline__ void operator()(const f32x4 (&acc)[2][2][4][2], const Unit& u, int wr, int wc, int fr, int fq) const {
    const int gi = u.pm >> 6;
    bf16_t* O = (bf16_t*)(ws + WS_S0 + (size_t)(3 + gi) * SLOT);
    const int row0 = (u.pm & 63) * 256 + wr * 64 + fr, col0 = (u.pn & 3) * 256 + wc * 32 + 8 * fq;
#pragma unroll
    for (int ai = 0; ai < 2; ++ai)
#pragma unroll
      for (int m = 0; m < 4; ++m) { bf16_t* rowp = O + (size_t)(row0 + ai * 128 + m * 16) * DM + col0;
#pragma unroll
        for (int bj = 0; bj < 2; ++bj) *(u32x4*)(rowp + bj * 128) = pack8(acc[ai][bj][m][0], acc[ai][bj][m][1]); }
  }
};
struct EpiLora1 {
  static constexpr bool PERM = true, HAS_PRE = false;
  bf16_t* TMP;
  template <int BJ>
  __device__ __forceinline__ void half(const f32x4 (&acc)[2][2][4][2], int gi, int row0, int wc, int fq) const {
    const int c = BJ * 128 + wc * 32 + 8 * fq;
    const bool skip = (gi < 2) && (c >= 64);
    const int dcol = (gi < 2) ? gi * 64 + c : 128 + c;
    const bool zero = (gi == 2) && (c >= 160);
    if (skip) return;
#pragma unroll
    for (int ai = 0; ai < 2; ++ai)
#pragma unroll
      for (int m = 0; m < 4; ++m) {
        f32x4 v0 = acc[ai][BJ][m][0], v1 = acc[ai][BJ][m][1];
#pragma unroll
        for (int i = 0; i < 4; ++i) {
          if (gi == 0) { v0[i] = tanhf_(v0[i]); v1[i] = tanhf_(v1[i]); }
          else if (gi == 2) { v0[i] = zero ? 0.f : sigmoidf_(v0[i]); v1[i] = zero ? 0.f : sigmoidf_(v1[i]); }
        }
        *(u32x4*)(TMP + (size_t)(row0 + ai * 128 + m * 16) * 384 + dcol) = pack8(v0, v1);
      }
  }
  __device__ __forceinline__ void operator()(const f32x4 (&acc)[2][2][4][2], const Unit& u, int wr, int wc, int fr, int fq) const {
    const int gi = u.pm >> 6;
    const int row0 = (u.pm & 63) * 256 + wr * 64 + fr;
    half<0>(acc, gi, row0, wc, fq);
    half<1>(acc, gi, row0, wc, fq);
  }
};
struct EpiLora2 {
  static constexpr bool PERM = true, HAS_PRE = false;
  unsigned char* ws; const float* w0; const float* a0; int gbase;
  __device__ __forceinline__ void operator()(const f32x4 (&acc)[2][2][4][2], const Unit& u, int wr, int wc, int fr, int fq) const {
    const int gi = gbase + (u.pn >> 2);
    bf16_t* O = (bf16_t*)(ws + WS_S0 + (size_t)gi * SLOT);
    const int row0 = u.pm * 256 + wr * 64 + fr, col0 = (u.pn & 3) * 256 + wc * 32 + 8 * fq;
    f32x4 b[2][2];
#pragma unroll
    for (int bj = 0; bj < 2; ++bj)
#pragma unroll
      for (int n = 0; n < 2; ++n) b[bj][n] = (gi == 0) ? *(const f32x4*)(w0 + col0 + bj * 128 + 4 * n) : (gi == 1 ? *(const f32x4*)(a0 + col0 + bj * 128 + 4 * n) : (f32x4){0.f, 0.f, 0.f, 0.f});
#pragma unroll
    for (int ai = 0; ai < 2; ++ai)
#pragma unroll
      for (int m = 0; m < 4; ++m) { bf16_t* rowp = O + (size_t)(row0 + ai * 128 + m * 16) * DM + col0;
#pragma unroll
        for (int bj = 0; bj < 2; ++bj) { f32x4 v0 = acc[ai][bj][m][0] + b[bj][0], v1 = acc[ai][bj][m][1] + b[bj][1];
          if (gi == 0) {
#pragma unroll
            for (int i = 0; i < 4; ++i) { v0[i] = -__expf(-softplusf_(-v0[i]) - 0.5f); v1[i] = -__expf(-softplusf_(-v1[i]) - 0.5f); }
          } else if (gi == 1) {
#pragma unroll
            for (int i = 0; i < 4; ++i) { v0[i] = sigmoidf_(v0[i]); v1[i] = sigmoidf_(v1[i]); }
          }
          *(u32x4*)(rowp + bj * 128) = pack8(v0, v1); } }
  }
};
struct EpiMoeGU {
  static constexpr bool PERM = true, HAS_PRE = false;
  bf16_t* HID; const int* list; const float* RS;
  __device__ __forceinline__ void operator()(const f32x4 (&acc)[2][2][4][2], const Unit& u, int wr, int wc, int fr, int fq) const {
    const int row0 = u.pm * 256 + wr * 64 + fr, col0 = (u.pn & 1) * 128 + wc * 32 + 8 * fq;
    const int* lp = list + (size_t)u.e * CAP + u.rt * 256;
#pragma unroll
    for (int ai = 0; ai < 2; ++ai)
#pragma unroll
      for (int m = 0; m < 4; ++m) {
        const int r = wr * 64 + fr + ai * 128 + m * 16;
        const float rs = RS[lp[(r < u.nrows) ? r : 0] >> 1];
        f32x4 h[2];
#pragma unroll
        for (int n = 0; n < 2; ++n) { const f32x4 g = acc[ai][0][m][n] * rs, up = acc[ai][1][m][n] * rs;
#pragma unroll
          for (int i = 0; i < 4; ++i) h[n][i] = g[i] * sigmoidf_(g[i]) * up[i]; }
        *(u32x4*)(HID + (size_t)(row0 + ai * 128 + m * 16) * 256 + col0) = pack8(h[0], h[1]);
      }
  }
};
struct EpiMoeDown {
  static constexpr bool PERM = false, HAS_PRE = true;
  bf16_t* out; bf16_t* Y1; const int* list; const float* pgate; LAS int* ept;
  __device__ __forceinline__ void pre(const Unit& u) const {
    const int r = threadIdx.x;
    if (r < 256) { int pr = -1; float gt = 0.f;
      if (r < u.nrows) { pr = list[(size_t)u.e * CAP + u.rt * 256 + r]; gt = pgate[pr]; }
      LAS int* e = ept + (u.par * 256 + r) * 2; e[0] = pr; e[1] = __float_as_int(gt); }
  }
  __device__ __forceinline__ void operator()(const f32x4 (&acc)[2][2][4][2], const Unit& u, int wr, int wc, int fr, int fq) const {
    const int col0 = (u.pn & 3) * 256 + wc * 32 + 4 * fq;
#pragma unroll
    for (int ai = 0; ai < 2; ++ai)
#pragma unroll
      for (int m = 0; m < 4; ++m) {
        const int r = ai * 128 + wr * 64 + m * 16 + fr;
        const LAS int* e = ept + (u.par * 256 + r) * 2;
        const int pr = e[0]; const float gt = __int_as_float(e[1]);
        if (pr >= 0) {
          const int tok = pr >> 1;
          if ((pr & 1) == 0) {
            bf16_t* op = out + (size_t)tok * DM + col0;
#pragma unroll
            for (int bj = 0; bj < 2; ++bj)
#pragma unroll
              for (int n = 0; n < 2; ++n) { const v2u w = *(const v2u*)(op + bj * 128 + n * 16);
                const f32x4 b = {__uint_as_float(w.x << 16), __uint_as_float(w.x & 0xffff0000u), __uint_as_float(w.y << 16), __uint_as_float(w.y & 0xffff0000u)};
                const f32x4 v = b + acc[ai][bj][m][n] * gt; v2u o; o.x = pk2(v[0], v[1]); o.y = pk2(v[2], v[3]); *(v2u*)(op + bj * 128 + n * 16) = o; }
          } else {
            bf16_t* yp = Y1 + (size_t)tok * DM + col0;
#pragma unroll
            for (int bj = 0; bj < 2; ++bj)
#pragma unroll
              for (int n = 0; n < 2; ++n) { const f32x4 v = acc[ai][bj][m][n] * gt; v2u w; w.x = pk2(v[0], v[1]); w.y = pk2(v[2], v[3]); *(v2u*)(yp + bj * 128 + n * 16) = w; }
          }
        }
      }
  }
};

typedef LAS bf16_t* lbf;
__device__ __forceinline__ void phase_prologue(PREF p, Frame& F) {
  const int lane = fresh_lane();
  LAS float* scr = (LAS float*)(F.lds + RING_OFF + F.wave * 16384);
  const int gw = F.vcu * NWAVES + F.wave, NGW = F.G * NWAVES;
  constexpr int I_WIN = 96 * 16, I_SQ = 32 * 16;
  constexpr int NITEMS = I_WIN + 5 * I_SQ + 128;
  for (int it = gw; it < NITEMS; it += NGW) {
    int r = it;
    if (r < I_WIN) { conv_win_item(p, r, scr, fresh_lane()); continue; } r -= I_WIN;
    if (r < I_SQ) { conv_sq_item(p.w_out, (bf16_t*)(p.ws + WS_WOUT), 0, r, scr, fresh_lane()); continue; } r -= I_SQ;
    if (r < I_SQ) { conv_sq_item(p.w_r, (bf16_t*)(p.ws + WS_WRKV), 0, r, scr, fresh_lane()); continue; } r -= I_SQ;
    if (r < I_SQ) { conv_sq_item(p.w_k, (bf16_t*)(p.ws + WS_WRKV), 1024, r, scr, fresh_lane()); continue; } r -= I_SQ;
    if (r < I_SQ) { conv_sq_item(p.w_v, (bf16_t*)(p.ws + WS_WRKV), 2048, r, scr, fresh_lane()); continue; } r -= I_SQ;
    if (r < I_SQ) { conv_sq_item(p.w_o, (bf16_t*)(p.ws + WS_WO), 0, r, scr, fresh_lane()); continue; } r -= I_SQ;
    { const int kv = r >> 6, q = r & 63, kb = q >> 1, cg = q & 1;
      transpose_item(p.cmp_w1 + (size_t)kv * 2048 * 64, 64, kb * 64, cg * 32, 32, (bf16_t*)(p.ws + WS_CW1) + (size_t)kv * 64 * 2048, 2048, cg * 32, scr, fresh_lane()); }
  }
  {
    const int gt = (F.vcu * NWAVES + F.wave) * 64 + fresh_lane(), NGT = NGW * 64;
    bf16_t* WL1 = (bf16_t*)(p.ws + WS_WL1);
    for (int i = gt; i < 768 * 1024; i += NGT) {
      const int n = i >> 10, k = i & 1023, gi = n >> 8, c = n & 255;
      float v = 0.f;
      if (gi == 0) { if (c < 64) v = p.w1[k * 64 + c]; }
      else if (gi == 1) { if (c < 64) v = p.a1[k * 64 + c]; }
      else { if (c < 160) v = p.g1[k * 160 + c]; }
      WL1[i] = (bf16_t)f2bf(v);
    }
    bf16_t* WL2w = (bf16_t*)(p.ws + WS_WL2);
    bf16_t* WL2a = (bf16_t*)(p.ws + WS_WL2 + 128 * 1024);
    bf16_t* WL2g = (bf16_t*)(p.ws + WS_WL2 + 256 * 1024);
    for (int i = gt; i < 1024 * 64; i += NGT) { const int n = i >> 6, k = i & 63; WL2w[i] = (bf16_t)f2bf(p.w2[k * 1024 + n]); WL2a[i] = (bf16_t)f2bf(p.a2[k * 1024 + n]); }
    for (int i = gt; i < 1024 * 192; i += NGT) { const int n = i / 192, k = i - n * 192; WL2g[i] = (bf16_t)f2bf(k < 160 ? p.g2[k * 1024 + n] : 0.f); }
    bf16_t* WR = (bf16_t*)(p.ws + WS_WR);
    for (int i = gt; i < 2 * 48 * 1024; i += NGT) {
      const int layer = i / (48 * 1024), rem = i - layer * 48 * 1024, n = rem >> 10, k = rem & 1023;
      float wv = 0.f;
      if (n < 4) wv = p.rg_w[(size_t)layer * DM * 4 + k * 4 + n]; else if (n < 36) wv = p.re_w[(size_t)layer * DM * 32 + k * 32 + (n - 4)];
      wv *= p.ffn_norm[layer * DM + k];
      const unsigned h = f2bf(wv); const float r1 = wv - __uint_as_float(h << 16);
      const unsigned m = f2bf(r1); const float r2 = r1 - __uint_as_float(m << 16);
      const unsigned l = f2bf(r2);
      bf16_t* o = WR + (size_t)layer * 144 * 1024 + (size_t)n * 1024 + k;
      o[0] = (bf16_t)h; o[48 * 1024] = (bf16_t)m; o[96 * 1024] = (bf16_t)l;
    }
  }
  bf16_t* XN = (bf16_t*)(p.ws + WS_XN);
  for (int m = gw; m < T_TOK; m += 4 * NGW) rms_rows_to_bf16<4>(p.x, p.mix_norm, XN, m, NGW, lane);
}


__device__ __forceinline__ void up8(const v4u w, float (&o)[8]) {
  o[0] = __uint_as_float(w.x << 16); o[1] = __uint_as_float(w.x & 0xffff0000u); o[2] = __uint_as_float(w.y << 16); o[3] = __uint_as_float(w.y & 0xffff0000u);
  o[4] = __uint_as_float(w.z << 16); o[5] = __uint_as_float(w.z & 0xffff0000u); o[6] = __uint_as_float(w.w << 16); o[7] = __uint_as_float(w.w & 0xffff0000u);
}
__device__ __forceinline__ f32x4 bf4(const v2u w) { return (f32x4){__uint_as_float(w.x << 16), __uint_as_float(w.x & 0xffff0000u), __uint_as_float(w.y << 16), __uint_as_float(w.y & 0xffff0000u)}; }
__device__ __forceinline__ void phase_router(PREF p, Frame& F, int layer) {
  const int gw = F.vcu * NWAVES + F.wave, NGW = F.G * NWAVES;
  const int lane = fresh_lane();
  PROBE_MARK(100 + layer * 10);
  {
    LAS float* scr = (LAS float*)(F.lds + RING_OFF + F.wave * 16384);
    for (int it = gw; it < 32 * 384; it += NGW) conv_expert_item(p, layer, it, scr, lane, (bf16_t*)(p.ws + WS_EGU));
  }
  __syncthreads();
  PROBE_MARK(101 + layer * 10);
  constexpr int WQP = 264;
  const lbf WQ = (lbf)(F.lds);
  LAS float* SSP = (LAS float*)(F.lds + 80 * 1024);
  LAS float* LGP = (LAS float*)(F.lds + 81 * 1024);
  const int w = F.wave, par = w & 1, tk = lane & 15, kg = lane >> 4;
  const bf16_t* xres = layer ? (const bf16_t*)(p.ws + WS_X3) : (const bf16_t*)p.out;
  const int tok = F.vcu * 64 + (w >> 1) * 16 + tk;
  bf16x8 xf[4][4];
  { const bf16_t* xr = xres + (size_t)tok * DM + 128 * par + 8 * kg;
#pragma unroll
    for (int j = 0; j < 4; ++j)
#pragma unroll
      for (int s = 0; s < 4; ++s) xf[j][s] = *(const GAS bf16x8*)(xr + 256 * j + 32 * s); }
  {
    float ss = 0.f;
#pragma unroll
    for (int j = 0; j < 4; ++j)
#pragma unroll
      for (int s = 0; s < 4; ++s) { float f[8]; up8(__builtin_bit_cast(v4u, xf[j][s]), f);
#pragma unroll
        for (int i = 0; i < 8; ++i) ss += f[i] * f[i]; }
    ss += __shfl_xor(ss, 16, 64); ss += __shfl_xor(ss, 32, 64);
    if (kg == 0) SSP[w * 16 + tk] = ss;
  }
  PROBE_MARK(102 + layer * 10);
  f32x4 acc[9];
#pragma unroll
  for (int nt = 0; nt < 9; ++nt) acc[nt] = (f32x4){0.f, 0.f, 0.f, 0.f};
  const bf16_t* WRl = (const bf16_t*)(p.ws + WS_WR) + (size_t)layer * 144 * 1024;
  float rs = 0.f;
#pragma unroll
  for (int j = 0; j < 4; ++j) {
    __syncthreads();
#pragma unroll
    for (int i = 0; i < 9; ++i) { const int idx = F.tid + i * 512, row = idx >> 5, pc = idx & 31;
      *(LAS v4u*)(WQ + row * WQP + pc * 8) = *(const GAS v4u*)(WRl + (size_t)row * 1024 + 256 * j + pc * 8); }
    __syncthreads();
    if (j == 0) {
      rs = rsqrtf((SSP[(w & ~1) * 16 + tk] + SSP[(w | 1) * 16 + tk]) * (1.f / DM) + 1e-6f);
      if (par == 0 && kg == 0) ((float*)(p.ws + WS_RS))[tok] = rs;
    }
#pragma unroll
    for (int s = 0; s < 4; ++s)
#pragma unroll
      for (int nt = 0; nt < 9; ++nt) {
        const bf16x8 a = *(const LAS bf16x8*)(WQ + (nt * 16 + tk) * WQP + 128 * par + 32 * s + 8 * kg);
        acc[nt] = __builtin_amdgcn_mfma_f32_16x16x32_bf16(a, xf[j][s], acc[nt], 0, 0, 0);
      }
  }
  PROBE_MARK(103 + layer * 10);
#pragma unroll
  for (int nt = 0; nt < 3; ++nt)
#pragma unroll
    for (int i = 0; i < 4; ++i) { const int n = nt * 16 + 4 * kg + i;
      if (n < 36) LGP[(w * 16 + tk) * 36 + n] = ((acc[6 + nt][i] + acc[3 + nt][i]) + acc[nt][i]) * rs; }
  LAS unsigned* LC = (LAS unsigned*)(F.lds + 118784);
  if (F.tid < 64) LC[F.tid] = 0u;
  __syncthreads();
  int ea = 0, eb = 0; unsigned la = 0, lb = 0; float ga = 0.f, gb = 0.f;
  if (lane < 8) {
    const LAS float* lg0 = LGP + ((w & ~1) * 16 + par * 8 + lane) * 36; const LAS float* lg1 = LGP + ((w | 1) * 16 + par * 8 + lane) * 36;
    const float* bg = p.rg_b + layer * 4;
    const float* be = p.re_b + layer * 32;
    float gl[4]; int gi = 0; float gm = -3.4e38f;
#pragma unroll
    for (int i = 0; i < 4; i++) { gl[i] = (lg0[i] + lg1[i]) + bg[i]; if (gl[i] > gm) { gm = gl[i]; gi = i; } }
    float gs = 0.f;
#pragma unroll
    for (int i = 0; i < 4; i++) gs += __expf(gl[i] - gm);
    const float grp_p = 1.f / gs;
    float v0 = -3.4e38f, v1 = -3.4e38f; int i0 = 0, i1 = 0;
    for (int i = 0; i < 8; i++) {
      const float v = (lg0[4 + gi * 8 + i] + lg1[4 + gi * 8 + i]) + be[gi * 8 + i];
      if (v > v0) { v1 = v0; i1 = i0; v0 = v; i0 = i; }
      else if (v > v1) { v1 = v; i1 = i; }
    }
    const float e1 = __expf(v1 - v0);
    ga = grp_p / (1.f + e1); gb = grp_p * e1 / (1.f + e1);
    ea = gi * 8 + i0; eb = gi * 8 + i1;
    la = __hip_atomic_fetch_add(LC + ea, 1u, __ATOMIC_RELAXED, __HIP_MEMORY_SCOPE_WORKGROUP);
    lb = __hip_atomic_fetch_add(LC + eb, 1u, __ATOMIC_RELAXED, __HIP_MEMORY_SCOPE_WORKGROUP);
  }
  __syncthreads();
  if (F.tid < 32) { const unsigned n = LC[F.tid];
    unsigned* cnt = (unsigned*)(p.ws + WS_CTL) + CW_CNT + (layer * 32 + F.tid) * 64;
    LC[32 + F.tid] = n ? __hip_atomic_fetch_add(cnt, n, __ATOMIC_RELAXED, __HIP_MEMORY_SCOPE_AGENT) : 0u; }
  __syncthreads();
  if (lane < 8) {
    const int t = gw * 8 + lane;
    int* list = (int*)(p.ws + WS_LIST); float* pgate = (float*)(p.ws + WS_PGATE);
    list[(size_t)ea * CAP + LC[32 + ea] + la] = 2 * t; pgate[2 * t] = ga;
    list[(size_t)eb * CAP + LC[32 + eb] + lb] = 2 * t + 1; pgate[2 * t + 1] = gb;
  }
  PROBE_MARK(104 + layer * 10);
}

__device__ __forceinline__ void phase_final(PREF p, Frame& F) {
  const int gw = F.vcu * NWAVES + F.wave, NGW = F.G * NWAVES;
  const int lane = fresh_lane();
  const bf16_t* Y1 = (const bf16_t*)(p.ws + WS_Y1);
  const bf16_t* X3 = (const bf16_t*)(p.ws + WS_X3);
  for (int t = gw; t < T_TOK; t += NGW) {
    GAS f32x4* xo = (GAS f32x4*)(p.out + (size_t)t * DM) + lane;
    const GAS v2u* xr = (const GAS v2u*)(X3 + (size_t)t * DM) + lane;
    const GAS v2u* yr = (const GAS v2u*)(Y1 + (size_t)t * DM) + lane;
#pragma unroll
    for (int j = 0; j < 4; ++j) xo[64 * j] = bf4(xr[64 * j]) + bf4(yr[64 * j]);
  }
}

__device__ __forceinline__ void phase_rwkv_prep(PREF p, Frame& F) {
  const int gw = F.vcu * NWAVES + F.wave, NGW = F.G * NWAVES;
  const int lane = fresh_lane();
  const float* gain = p.mix_norm + DM;
  const bf16_t* X1 = (const bf16_t*)p.out;
  const bf16_t* Y1 = (const bf16_t*)(p.ws + WS_Y1);
  float g[2][8];
#pragma unroll
  for (int c = 0; c < 2; ++c) { const f32x4 a = *(const GAS f32x4*)(gain + c * 512 + lane * 8), b = *(const GAS f32x4*)(gain + c * 512 + lane * 8 + 4);
    g[c][0] = a.x; g[c][1] = a.y; g[c][2] = a.z; g[c][3] = a.w; g[c][4] = b.x; g[c][5] = b.y; g[c][6] = b.z; g[c][7] = b.w; }
  for (int run = gw; run < T_TOK / 8; run += NGW) {
    const int t0 = run * 8;
    float prev[2][8];
    if ((t0 & (SEQ - 1)) == 0) {
#pragma unroll
      for (int c = 0; c < 2; ++c)
#pragma unroll
        for (int i = 0; i < 8; ++i) prev[c][i] = 0.f;
    } else {
      float s = 0.f;
#pragma unroll
      for (int c = 0; c < 2; ++c) { float xa[8], ya[8];
        up8(*(const GAS v4u*)(X1 + (size_t)(t0 - 1) * DM + c * 512 + lane * 8), xa); up8(*(const GAS v4u*)(Y1 + (size_t)(t0 - 1) * DM + c * 512 + lane * 8), ya);
#pragma unroll
        for (int i = 0; i < 8; ++i) { prev[c][i] = xa[i] + ya[i]; s += prev[c][i] * prev[c][i]; } }
      const float r = rsqrtf(wave_sum_dpp(s) * (1.f / DM) + 1e-6f);
#pragma unroll
      for (int c = 0; c < 2; ++c)
#pragma unroll
        for (int i = 0; i < 8; ++i) prev[c][i] *= r * g[c][i];
    }
    v4u nx[2], ny[2];
#pragma unroll
    for (int c = 0; c < 2; ++c) { nx[c] = *(const GAS v4u*)(X1 + (size_t)t0 * DM + c * 512 + lane * 8); ny[c] = *(const GAS v4u*)(Y1 + (size_t)t0 * DM + c * 512 + lane * 8); }
#pragma unroll 1
    for (int tt = 0; tt < 8; ++tt) {
      const int t = t0 + tt;
      float v[2][8]; float s = 0.f;
#pragma unroll
      for (int c = 0; c < 2; ++c) { float xa[8], ya[8]; up8(nx[c], xa); up8(ny[c], ya);
#pragma unroll
        for (int i = 0; i < 8; ++i) { v[c][i] = xa[i] + ya[i]; s += v[c][i] * v[c][i]; } }
      if (tt < 7) {
#pragma unroll
        for (int c = 0; c < 2; ++c) { nx[c] = *(const GAS v4u*)(X1 + (size_t)(t + 1) * DM + c * 512 + lane * 8); ny[c] = *(const GAS v4u*)(Y1 + (size_t)(t + 1) * DM + c * 512 + lane * 8); } }
      const float r = rsqrtf(wave_sum_dpp(s) * (1.f / DM) + 1e-6f);
#pragma unroll
      for (int c = 0; c < 2; ++c)
#pragma unroll
        for (int i = 0; i < 8; ++i) v[c][i] *= r * g[c][i];
#pragma unroll
      for (int sl = 0; sl < 6; ++sl) {
        const int mj = (sl == 0) ? 0 : (sl == 1) ? 2 : (sl == 2) ? 3 : (sl == 3) ? 1 : (sl == 4) ? 4 : 5;
        bf16_t* o = (bf16_t*)(p.ws + WS_S0 + (size_t)sl * SLOT) + (size_t)t * DM;
#pragma unroll
        for (int c = 0; c < 2; ++c) {
          const f32x4 ma = *(const GAS f32x4*)(p.rmix + mj * DM + c * 512 + lane * 8), mb = *(const GAS f32x4*)(p.rmix + mj * DM + c * 512 + lane * 8 + 4);
          const float mx[8] = {ma.x, ma.y, ma.z, ma.w, mb.x, mb.y, mb.z, mb.w};
          float q[8];
#pragma unroll
          for (int i = 0; i < 8; ++i) q[i] = v[c][i] + (prev[c][i] - v[c][i]) * mx[i];
          v4u w; w.x = pk2(q[0], q[1]); w.y = pk2(q[2], q[3]); w.z = pk2(q[4], q[5]); w.w = pk2(q[6], q[7]);
          *(GAS v4u*)(o + c * 512 + lane * 8) = w;
        }
      }
#pragma unroll
      for (int c = 0; c < 2; ++c)
#pragma unroll
        for (int i = 0; i < 8; ++i) prev[c][i] = v[c][i];
    }
  }
}

constexpr int RP = 72;
constexpr int RB = 64 * RP * 2;

__device__ __forceinline__ f32x4 mm16(f32x4 acc, const LAS bf16_t* A, int arow0, const LAS bf16_t* Bt, int brow0, int lane) {
  const int r = lane & 15, q = lane >> 4;
#pragma unroll
  for (int ks = 0; ks < 2; ++ks) {
    const bf16x8 a = *(const LAS bf16x8*)(A + (arow0 + r) * RP + ks * 32 + q * 8);
    const bf16x8 b = *(const LAS bf16x8*)(Bt + (brow0 + r) * RP + ks * 32 + q * 8);
    acc = __builtin_amdgcn_mfma_f32_16x16x32_bf16(a, b, acc, 0, 0, 0);
  }
  return acc;
}
__device__ __forceinline__ float sum8(float v) {
  v += __shfl_xor(v, 1, 64); v += __shfl_xor(v, 2, 64); v += __shfl_xor(v, 4, 64); return v;
}
__device__ __forceinline__ void ld8bf(const bf16_t* p, float (&o)[8]) {
  const v4u w = *(const GAS v4u*)p;
  o[0] = __uint_as_float(w.x << 16); o[1] = __uint_as_float(w.x & 0xffff0000u); o[2] = __uint_as_float(w.y << 16); o[3] = __uint_as_float(w.y & 0xffff0000u);
  o[4] = __uint_as_float(w.z << 16); o[5] = __uint_as_float(w.z & 0xffff0000u); o[6] = __uint_as_float(w.w << 16); o[7] = __uint_as_float(w.w & 0xffff0000u);
}
__device__ __forceinline__ v4u pk8(const float (&o)[8]) { v4u w; w.x = pk2(o[0], o[1]); w.y = pk2(o[2], o[3]); w.z = pk2(o[4], o[5]); w.w = pk2(o[6], o[7]); return w; }

#define R1_BAR() do { asm volatile("s_waitcnt lgkmcnt(0)" ::: "memory"); __builtin_amdgcn_s_barrier(); asm volatile("" ::: "memory"); } while (0)
__device__ __forceinline__ void stT(LAS bf16_t* Dst, int x0, int y0, const f32x4& acc, int lane) {
  v2u w; w.x = pk2(acc[0], acc[1]); w.y = pk2(acc[2], acc[3]);
  *(LAS v2u*)(Dst + (x0 + (lane & 15)) * RP + y0 + (lane >> 4) * 4) = w;
}
struct R1In { v4u r, ld, k, v, a; f32x4 kk0, kk1, ka0, ka1, rk0, rk1; };
__device__ __forceinline__ R1In rwkv_r1_load(PREF p, int item, int tid) {
  const int ch = item >> 6, c = item & 63, b = ch >> 4, hd = ch & 15;
  const size_t off = ((size_t)(b * SEQ + c * 64 + (tid >> 3)) * DM + hd * 64 + (tid & 7) * 8);
  const bf16_t* s0 = (const bf16_t*)(p.ws + WS_S0);
  R1In in;
  in.r = *(const GAS v4u*)(s0 + 3 * (SLOT / 2) + off); in.ld = *(const GAS v4u*)(s0 + off); in.k = *(const GAS v4u*)(s0 + 4 * (SLOT / 2) + off);
  in.v = *(const GAS v4u*)(s0 + 5 * (SLOT / 2) + off); in.a = *(const GAS v4u*)(s0 + (SLOT / 2) + off);
  const int cc0 = hd * 64 + (tid & 7) * 8;
  in.kk0 = *(const GAS f32x4*)(p.k_k + cc0); in.kk1 = *(const GAS f32x4*)(p.k_k + cc0 + 4); in.ka0 = *(const GAS f32x4*)(p.k_a + cc0); in.ka1 = *(const GAS f32x4*)(p.k_a + cc0 + 4);
  in.rk0 = *(const GAS f32x4*)(p.r_k + cc0); in.rk1 = *(const GAS f32x4*)(p.r_k + cc0 + 4);
  return in;
}
__device__ __forceinline__ void un8(const v4u w, float (&o)[8]) {
  o[0] = __uint_as_float(w.x << 16); o[1] = __uint_as_float(w.x & 0xffff0000u); o[2] = __uint_as_float(w.y << 16); o[3] = __uint_as_float(w.y & 0xffff0000u);
  o[4] = __uint_as_float(w.z << 16); o[5] = __uint_as_float(w.z & 0xffff0000u); o[6] = __uint_as_float(w.w << 16); o[7] = __uint_as_float(w.w & 0xffff0000u);
}
__device__ __forceinline__ void rwkv_r1_item(PREF p, Frame& F, int item, const R1In& in) {
  const int tid = F.tid, lane = fresh_lane(), w = F.wave;
  const int ch = item >> 6, c = item & 63, b = ch >> 4, hd = ch & 15;
  const size_t tile0 = ((size_t)(b * SEQ + c * 64) * DM + hd * 64);
  unsigned char* ws = p.ws;
  bf16_t* SL[6];
#pragma unroll
  for (int s = 0; s < 6; ++s) SL[s] = (bf16_t*)(ws + WS_S0 + (size_t)s * SLOT) + tile0;
  const lbf BtT = (lbf)(F.lds + 0 * RB), KtT = (lbf)(F.lds + 1 * RB), AbT = (lbf)(F.lds + 2 * RB), RbT = (lbf)(F.lds + 3 * RB);
  const lbf Ab = (lbf)(F.lds + 4 * RB), Vc = (lbf)(F.lds + 5 * RB), Bh = (lbf)(F.lds + 6 * RB), Kh = (lbf)(F.lds + 7 * RB);
  const lbf Tk = (lbf)(F.lds + 8 * RB), WbT = (lbf)(F.lds + 9 * RB), WkT = (lbf)(F.lds + 10 * RB);
  const lbf X = BtT, XT = KtT, Pb = AbT;
  const lbf At = X, TNT = XT, U0 = Tk;
  LAS float* Lf = (LAS float*)(F.lds + 11 * RB);
  LAS float* SEG = Lf + 64 * 65;
  LAS float* GC = (LAS float*)(F.lds + 14 * RB);
#if defined(PROBE_PH) && PROBE_PH == 301
  const unsigned long long _sa0 = __builtin_amdgcn_s_memrealtime();
#endif
  const int t = tid >> 3, cg = tid & 7, k0 = cg * 8;
  float r_[8], ld_[8], kx[8], v_[8], a_[8];
  un8(in.r, r_); un8(in.ld, ld_); un8(in.k, kx); un8(in.v, v_); un8(in.a, a_);
  float kk[8], km[8], be[8];
  {
    float ss = 0.f, bo = 0.f;
#pragma unroll
    for (int i = 0; i < 8; ++i) { const float ckk = (i < 4) ? in.kk0[i & 3] : in.kk1[i & 3], cka = (i < 4) ? in.ka0[i & 3] : in.ka1[i & 3], crk = (i < 4) ? in.rk0[i & 3] : in.rk1[i & 3];
      kk[i] = kx[i] * ckk; ss += kk[i] * kk[i]; km[i] = kx[i] * (1.f + (a_[i] - 1.f) * cka); bo += r_[i] * km[i] * crk; }
    ss = sum8(ss); bo = sum8(bo);
    const float inv = 1.f / fmaxf(sqrtf(ss), 1e-12f);
#pragma unroll
    for (int i = 0; i < 8; ++i) { kk[i] *= inv; be[i] = kk[i] * a_[i]; }
    if (cg == 0) ((float*)(ws + WS_TMP))[(size_t)item * 64 + t] = bo;
  }
#pragma unroll
  for (int i = 0; i < 8; ++i) Lf[t * 65 + k0 + i] = ld_[i];
  R1_BAR();
  {
    const int k = tid & 63, sg = tid >> 6;
    float run = 0.f;
#pragma unroll
    for (int i = 0; i < 8; ++i) { run += Lf[(sg * 8 + i) * 65 + k]; Lf[(sg * 8 + i) * 65 + k] = run; }
    SEG[sg * 64 + k] = run;
    R1_BAR();
    float off = 0.f;
    for (int j = 0; j < sg; ++j) off += SEG[j * 64 + k];
#pragma unroll
    for (int i = 0; i < 8; ++i) Lf[(sg * 8 + i) * 65 + k] += off;
  }
  R1_BAR();
  {
    float ab[8], bt[8], kt[8], rb[8], bh[8], kh[8];
#pragma unroll
    for (int i = 0; i < 8; ++i) {
      const float Lt = Lf[t * 65 + k0 + i], Lp = (t > 0) ? Lf[(t - 1) * 65 + k0 + i] : 0.f, LC = Lf[63 * 65 + k0 + i];
      const float et = __expf(Lt), ei = __builtin_amdgcn_rcpf(et), eh = __expf(LC) * ei;
      if (t == 63) GC[k0 + i] = et;
      ab[i] = -kk[i] * __expf(Lp); bt[i] = be[i] * ei; kt[i] = km[i] * ei; rb[i] = r_[i] * et; bh[i] = be[i] * eh; kh[i] = km[i] * eh;
    }
    *(LAS v4u*)(BtT + t * RP + k0) = pk8(bt); *(LAS v4u*)(KtT + t * RP + k0) = pk8(kt); *(LAS v4u*)(AbT + t * RP + k0) = pk8(ab); *(LAS v4u*)(RbT + t * RP + k0) = pk8(rb);
    {
      float ra[8], rv[8], rb[8], rkh[8];
#pragma unroll
      for (int i = 0; i < 8; ++i) { ra[i] = ab[i]; rv[i] = v_[i]; rb[i] = bh[i]; rkh[i] = kh[i]; }
#pragma unroll
      for (int sh = 1; sh < 8; sh <<= 1) {
        const bool on = (cg & sh) != 0;
        float ta[8], tv[8], tb[8], tk[8];
#pragma unroll
        for (int i = 0; i < 8; ++i) { ta[i] = on ? ra[(i + sh) & 7] : ra[i]; tv[i] = on ? rv[(i + sh) & 7] : rv[i]; tb[i] = on ? rb[(i + sh) & 7] : rb[i]; tk[i] = on ? rkh[(i + sh) & 7] : rkh[i]; }
#pragma unroll
        for (int i = 0; i < 8; ++i) { ra[i] = ta[i]; rv[i] = tv[i]; rb[i] = tb[i]; rkh[i] = tk[i]; }
      }
#pragma unroll
      for (int i = 0; i < 8; ++i) { const int row = k0 + ((i + cg) & 7);
        Ab[row * RP + t] = (bf16_t)f2bf(ra[i]); Vc[row * RP + t] = (bf16_t)f2bf(rv[i]); Bh[row * RP + t] = (bf16_t)f2bf(rb[i]); Kh[row * RP + t] = (bf16_t)f2bf(rkh[i]); }
    }
  }
  R1_BAR();
#if defined(PROBE_PH) && PROBE_PH == 301
  F.pr_t1 += __builtin_amdgcn_s_memrealtime() - _sa0;
#endif
  const int ya = (w >> 1) * 16, xb0 = (w & 1) * 32;
  const int cr = lane & 15, q4 = (lane >> 4) * 4;
  const f32x4 Z4 = {0.f, 0.f, 0.f, 0.f};
  const lbf X1 = (lbf)(F.lds + 11 * RB), XT1 = (lbf)(F.lds + 12 * RB), Pb1 = (lbf)(F.lds + 13 * RB);
  f32x4 accP[2];
  {
    f32x4 tabn[2], tabs[2], taks[2], wbr[2], wkr[2];
#pragma unroll
    for (int j = 0; j < 2; ++j) { const int xb = xb0 + 16 * j;
      tabn[j] = mm16(Z4, BtT, ya, AbT, xb, lane);
      tabs[j] = mm16(Z4, AbT, ya, BtT, xb, lane);
      taks[j] = mm16(Z4, AbT, ya, KtT, xb, lane);
      wbr[j] = mm16(Z4, BtT, ya, RbT, xb, lane);
      wkr[j] = mm16(Z4, KtT, ya, RbT, xb, lane); }
#pragma unroll
    for (int j = 0; j < 2; ++j) { const int xb = xb0 + 16 * j;
      f32x4 xt, xr, pr, tk, wb, wk;
#pragma unroll
      for (int i = 0; i < 4; ++i) {
        { const int s = ya + q4 + i, tt = xb + cr; xt[i] = (s < tt) ? tabn[j][i] : 0.f; wb[i] = (s <= tt) ? wbr[j][i] : 0.f; wk[i] = (s <= tt) ? wkr[j][i] : 0.f; }
        { const int tt = ya + q4 + i, s = xb + cr; xr[i] = (s < tt) ? tabs[j][i] : 0.f; pr[i] = xr[i] + ((s == tt) ? 1.f : 0.f); tk[i] = (s < tt) ? taks[j][i] : 0.f; }
      }
      accP[j] = pr;
      stT(XT1, xb, ya, xt, lane); stT(WbT, xb, ya, wb, lane); stT(WkT, xb, ya, wk, lane);
      stT(X1, xb, ya, xr, lane); stT(Pb1, xb, ya, pr, lane); stT(Tk, xb, ya, tk, lane); }
  }
  R1_BAR();
#pragma unroll 1
  for (int st = 0; st < 5; ++st) {
    const lbf Xs = (st & 1) ? X : X1, XTs = (st & 1) ? XT : XT1, Pbs = (st & 1) ? Pb : Pb1;
    const lbf Xd = (st & 1) ? X1 : X, XTd = (st & 1) ? XT1 : XT, Pbd = (st & 1) ? Pb1 : Pb;
    f32x4 xr[2], xt[2];
#pragma unroll
    for (int j = 0; j < 2; ++j) { const int xb = xb0 + 16 * j;
      xr[j] = mm16(Z4, XTs, ya, Xs, xb, lane);
      xt[j] = mm16(Z4, Xs, ya, XTs, xb, lane);
      if (st > 0) accP[j] = mm16(accP[j], XTs, ya, Pbs, xb, lane); }
#pragma unroll
    for (int j = 0; j < 2; ++j) { const int xb = xb0 + 16 * j; stT(Xd, xb, ya, xr[j], lane); stT(XTd, xb, ya, xt[j], lane); stT(Pbd, xb, ya, accP[j], lane); }
    R1_BAR();
  }
  const lbf NT = Pb1;
  {
    f32x4 nt[2];
#pragma unroll
    for (int j = 0; j < 2; ++j) { const int xb = xb0 + 16 * j; nt[j] = mm16(Z4, Pb, ya, XT, xb, lane);
#pragma unroll
      for (int i = 0; i < 4; ++i) nt[j][i] += bf2f(Pb[(ya + q4 + i) * RP + xb + cr]); }
#pragma unroll
    for (int j = 0; j < 2; ++j) stT(NT, xb0 + 16 * j, ya, nt[j], lane);
    R1_BAR();
  }
  {
    f32x4 at[2], tn[2];
#pragma unroll
    for (int j = 0; j < 2; ++j) { const int xb = xb0 + 16 * j; at[j] = mm16(Z4, NT, ya, Ab, xb, lane); tn[j] = mm16(Z4, Tk, ya, NT, xb, lane); }
#pragma unroll
    for (int j = 0; j < 2; ++j) { const int xb = xb0 + 16 * j; stT(At, xb, ya, at[j], lane); stT(TNT, xb, ya, tn[j], lane); }
  }
  R1_BAR();
  const lbf O_RT = (lbf)(F.lds + 11 * RB), O_PM = (lbf)(F.lds + 12 * RB), O_Y0 = (lbf)(F.lds + 13 * RB), O_Q = (lbf)(F.lds + 3 * RB)  ;
  {
    f32x4 u0[2], rt[2], pm[2];
#pragma unroll
    for (int j = 0; j < 2; ++j) { const int xb = xb0 + 16 * j;
      u0[j] = mm16(Z4, TNT, ya, Vc, xb, lane);
      rt[j] = mm16(Z4, At, ya, WbT, xb, lane);
      pm[j] = mm16(Z4, At, ya, Bh, xb, lane);
      const v2u rbw = *(const LAS v2u*)(RbT + (xb + cr) * RP + ya + q4);
      rt[j][0] += __uint_as_float(rbw.x << 16); rt[j][1] += __uint_as_float(rbw.x & 0xffff0000u); rt[j][2] += __uint_as_float(rbw.y << 16); rt[j][3] += __uint_as_float(rbw.y & 0xffff0000u);
#pragma unroll
      for (int i = 0; i < 4; ++i) if (ya + q4 + i == xb + cr) pm[j][i] += GC[xb + cr]; }
#pragma unroll
    for (int j = 0; j < 2; ++j) { const int xb = xb0 + 16 * j; stT(U0, xb, ya, u0[j], lane); stT(O_RT, xb, ya, rt[j], lane); stT(O_PM, xb, ya, pm[j], lane); }
  }
  R1_BAR();
  {
    f32x4 y0[2], qq[2];
#pragma unroll
    for (int j = 0; j < 2; ++j) { const int xb = xb0 + 16 * j;
      y0[j] = mm16(mm16(Z4, U0, ya, WbT, xb, lane), Vc, ya, WkT, xb, lane);
      qq[j] = mm16(mm16(Z4, Bh, ya, U0, xb, lane), Kh, ya, Vc, xb, lane); }
#pragma unroll
    for (int j = 0; j < 2; ++j) { const int xb = xb0 + 16 * j; stT(O_Y0, xb, ya, y0[j], lane); stT(O_Q, xb, ya, qq[j], lane); }
  }
  R1_BAR();
  {
    const int row = tid >> 3, pc = (tid & 7) * 8;
    *(GAS v4u*)(SL[3] + (size_t)row * DM + pc) = *(const LAS v4u*)(O_RT + row * RP + pc);
    *(GAS v4u*)(SL[0] + (size_t)row * DM + pc) = *(const LAS v4u*)(O_PM + row * RP + pc);
    *(GAS v4u*)(SL[4] + (size_t)row * DM + pc) = *(const LAS v4u*)(O_Y0 + row * RP + pc);
    *(GAS v4u*)(SL[1] + (size_t)row * DM + pc) = *(const LAS v4u*)(O_Q + row * RP + pc);
  }
  R1_BAR();
}

__device__ __forceinline__ void phase_rwkv_r1(PREF p, Frame& F) {
  int item = F.vcu;
  if (item >= 4096) return;
  R1In nxt = rwkv_r1_load(p, item, F.tid);
  for (; item < 4096; item += F.G) {
    const R1In cur = nxt;
    if (item + F.G < 4096) nxt = rwkv_r1_load(p, item + F.G, F.tid);
    rwkv_r1_item(p, F, item, cur);
  }
}

__device__ __forceinline__ void phase_rwkv_r2(PREF p, Frame& F) {
  if (F.wave != 0) return;
  const int lane = fresh_lane();
  const lbf Sh = (lbf)(F.lds), Sl = (lbf)(F.lds + 16 * RP * 2);
  const int cr = lane & 15, g = lane >> 4;
  for (int task = F.vcu; task < 256; task += F.G) {
    const int ch = task >> 2, jb = task & 3, b = ch >> 4, hd = ch & 15;
    const bf16_t* PM = (const bf16_t*)(p.ws + WS_S0) + ((size_t)(b * SEQ) * DM + hd * 64);
    bf16_t* QS = (bf16_t*)(p.ws + WS_S0 + SLOT) + ((size_t)(b * SEQ) * DM + hd * 64);
    for (int i = lane; i < 16 * RP; i += 64) { Sh[i] = 0; Sl[i] = 0; }
    const bf16_t* pmp = PM + (size_t)cr * DM + g * 8;
    bf16_t* qsp = QS + (size_t)(16 * jb + cr) * DM + g * 4;
    bf16x8 pa[4][4][2]; v2u qv[4][4];
#pragma unroll
    for (int d = 0; d < 4; ++d)
#pragma unroll
      for (int ct = 0; ct < 4; ++ct) { pa[d][ct][0] = *(const GAS bf16x8*)(pmp + (size_t)(d * 64 + 16 * ct) * DM); pa[d][ct][1] = *(const GAS bf16x8*)(pmp + (size_t)(d * 64 + 16 * ct) * DM + 32);
        qv[d][ct] = *(const GAS v2u*)(qsp + (size_t)d * 64 * DM + 16 * ct); }
    asm volatile("s_waitcnt lgkmcnt(0)" ::: "memory");
#pragma unroll 1
    for (int c4 = 0; c4 < 64; c4 += 4) {
#pragma unroll
      for (int d = 0; d < 4; ++d) {
        const int c = c4 + d;
        const bf16x8 bh0 = *(const LAS bf16x8*)(Sh + cr * RP + g * 8), bh1 = *(const LAS bf16x8*)(Sh + cr * RP + 32 + g * 8);
        const bf16x8 bl0 = *(const LAS bf16x8*)(Sl + cr * RP + g * 8), bl1 = *(const LAS bf16x8*)(Sl + cr * RP + 32 + g * 8);
        f32x4 acc[4];
#pragma unroll
        for (int ct = 0; ct < 4; ++ct) {
          acc[ct] = (f32x4){__uint_as_float(qv[d][ct].x << 16), __uint_as_float(qv[d][ct].x & 0xffff0000u), __uint_as_float(qv[d][ct].y << 16), __uint_as_float(qv[d][ct].y & 0xffff0000u)};
          acc[ct] = __builtin_amdgcn_mfma_f32_16x16x32_bf16(pa[d][ct][0], bh0, acc[ct], 0, 0, 0);
          acc[ct] = __builtin_amdgcn_mfma_f32_16x16x32_bf16(pa[d][ct][1], bh1, acc[ct], 0, 0, 0);
          acc[ct] = __builtin_amdgcn_mfma_f32_16x16x32_bf16(pa[d][ct][0], bl0, acc[ct], 0, 0, 0);
          acc[ct] = __builtin_amdgcn_mfma_f32_16x16x32_bf16(pa[d][ct][1], bl1, acc[ct], 0, 0, 0);
        }
        if (c + 4 < 64) {
#pragma unroll
          for (int ct = 0; ct < 4; ++ct) { pa[d][ct][0] = *(const GAS bf16x8*)(pmp + (size_t)((c + 4) * 64 + 16 * ct) * DM); pa[d][ct][1] = *(const GAS bf16x8*)(pmp + (size_t)((c + 4) * 64 + 16 * ct) * DM + 32);
            qv[d][ct] = *(const GAS v2u*)(qsp + (size_t)(c + 4) * 64 * DM + 16 * ct); }
        }
#pragma unroll
        for (int ct = 0; ct < 4; ++ct) {
          v2u hi; hi.x = pk2(acc[ct][0], acc[ct][1]); hi.y = pk2(acc[ct][2], acc[ct][3]);
          const float l0 = acc[ct][0] - __uint_as_float(hi.x << 16), l1 = acc[ct][1] - __uint_as_float(hi.x & 0xffff0000u), l2 = acc[ct][2] - __uint_as_float(hi.y << 16), l3 = acc[ct][3] - __uint_as_float(hi.y & 0xffff0000u);
          v2u lo; lo.x = pk2(l0, l1); lo.y = pk2(l2, l3);
          *(LAS v2u*)(Sh + cr * RP + 16 * ct + g * 4) = hi; *(LAS v2u*)(Sl + cr * RP + 16 * ct + g * 4) = lo;
          *(GAS v2u*)(qsp + (size_t)c * 64 * DM + 16 * ct) = hi;
        }
        asm volatile("s_waitcnt lgkmcnt(0)" ::: "memory");
      }
    }
  }
}

__device__ __forceinline__ void phase_rwkv_r3(PREF p, Frame& F) {
  const int lane = fresh_lane(), w = F.wave;
  const int cr = lane & 15, q4 = (lane >> 4) * 4, q = lane >> 4;
  const int half = w >> 2, tb = w & 3;
  LAS bf16_t* stg = (LAS bf16_t*)(F.lds) + w * 16 * RP;
  for (int it2 = F.vcu; it2 < 2048; it2 += F.G) {
    const int item = it2 * 2 + half;
    const int ch = item >> 6, c = item & 63, b = ch >> 4, hd = ch & 15;
    const size_t tile0 = ((size_t)(b * SEQ + c * 64) * DM + hd * 64);
    bf16_t* RT = (bf16_t*)(p.ws + WS_S0 + 3 * SLOT) + tile0;
    const bf16_t* Y0 = (const bf16_t*)(p.ws + WS_S0 + 4 * SLOT) + tile0;
    const bf16_t* VV = (const bf16_t*)(p.ws + WS_S0 + 5 * SLOT) + tile0;
    const bf16_t* GG = (const bf16_t*)(p.ws + WS_S0 + 2 * SLOT) + tile0;
    const bf16_t* SC = (const bf16_t*)(p.ws + WS_S0 + SLOT) + tile0 - (size_t)64 * DM;
    const float* BO = (const float*)(p.ws + WS_TMP) + (size_t)item * 64;
    f32x4 y[4];
#pragma unroll
    for (int j = 0; j < 4; ++j) y[j] = (f32x4){0.f, 0.f, 0.f, 0.f};
    if (c > 0) {
      const bf16_t* ap = RT + (size_t)(16 * tb + cr) * DM + q * 8;
      const bf16x8 a0 = *(const GAS bf16x8*)ap, a1 = *(const GAS bf16x8*)(ap + 32);
#pragma unroll
      for (int j = 0; j < 4; ++j) {
        const bf16_t* bp = SC + (size_t)(16 * j + cr) * DM + q * 8;
        const bf16x8 b0 = *(const GAS bf16x8*)bp, b1 = *(const GAS bf16x8*)(bp + 32);
        y[j] = __builtin_amdgcn_mfma_f32_16x16x32_bf16(a0, b0, y[j], 0, 0, 0);
        y[j] = __builtin_amdgcn_mfma_f32_16x16x32_bf16(a1, b1, y[j], 0, 0, 0);
      }
    }
    float mu[4], rs[4];
#pragma unroll
    for (int i = 0; i < 4; ++i) {
      float s = 0.f;
#pragma unroll
      for (int j = 0; j < 4; ++j) { y[j][i] += bf2f(Y0[(size_t)(16 * tb + q4 + i) * DM + 16 * j + cr]); s += y[j][i]; }
      s += __shfl_xor(s, 1, 64); s += __shfl_xor(s, 2, 64); s += __shfl_xor(s, 4, 64); s += __shfl_xor(s, 8, 64);
      mu[i] = s * (1.f / 64.f);
      float qd = 0.f;
#pragma unroll
      for (int j = 0; j < 4; ++j) { const float d = y[j][i] - mu[i]; qd += d * d; }
      qd += __shfl_xor(qd, 1, 64); qd += __shfl_xor(qd, 2, 64); qd += __shfl_xor(qd, 4, 64); qd += __shfl_xor(qd, 8, 64);
      rs[i] = rsqrtf(qd * (1.f / 64.f) + 64e-5f);
    }
#pragma unroll
    for (int j = 0; j < 4; ++j) {
      const int cc = hd * 64 + 16 * j + cr;
      const float lw = p.ln_w[cc], lb = p.ln_b[cc];
#pragma unroll
      for (int i = 0; i < 4; ++i) {
        const int tt = 16 * tb + q4 + i;
        const float vv = bf2f(VV[(size_t)tt * DM + 16 * j + cr]), gg = bf2f(GG[(size_t)tt * DM + 16 * j + cr]);
        const float z = ((y[j][i] - mu[i]) * rs[i] * lw + lb + BO[tt] * vv) * gg;
        stg[(q4 + i) * RP + 16 * j + cr] = (bf16_t)f2bf(z);
      }
    }
    LDS_WAIT();
#pragma unroll
    for (int i = 0; i < 2; ++i) { const int row = (lane >> 3) + 8 * i, pc = (lane & 7) * 8;
      *(GAS v4u*)(RT + (size_t)(16 * tb + row) * DM + pc) = *(const LAS v4u*)(stg + row * RP + pc); }
    LDS_WAIT();
  }
}


typedef short v4i16_t __attribute__((ext_vector_type(4)));
__device__ __forceinline__ v4i16_t tr16(const LAS bf16_t* p) { return __builtin_amdgcn_ds_read_tr16_b64_v4i16((LAS v4i16_t*)p); }

template <int KS>
__device__ __forceinline__ void qk_tile(f32x4 (&st)[4][2], const LAS bf16_t* Kt, int kc0, const bf16x8 (&qf)[2][KS], int lane) {
  const int r = lane & 15, g = lane >> 4;
#pragma unroll
  for (int kt = 0; kt < 4; ++kt)
#pragma unroll
    for (int ks = 0; ks < KS; ++ks) {
      const bf16x8 a = *(const LAS bf16x8*)(Kt + (kt * 16 + r) * RP + kc0 + ks * 32 + g * 8);
#pragma unroll
      for (int qt = 0; qt < 2; ++qt) st[kt][qt] = __builtin_amdgcn_mfma_f32_16x16x32_bf16(a, qf[qt][ks], st[kt][qt], 0, 0, 0);
    }
}
__device__ __forceinline__ void pack_p(bf16x8 (&pb)[2][2], const f32x4 (&pr)[4][2]) {
#pragma unroll
  for (int kb = 0; kb < 2; ++kb)
#pragma unroll
    for (int qt = 0; qt < 2; ++qt) {
      const v4u w = {pk2(pr[2 * kb][qt][0], pr[2 * kb][qt][1]), pk2(pr[2 * kb][qt][2], pr[2 * kb][qt][3]), pk2(pr[2 * kb + 1][qt][0], pr[2 * kb + 1][qt][1]), pk2(pr[2 * kb + 1][qt][2], pr[2 * kb + 1][qt][3])};
      pb[kb][qt] = __builtin_bit_cast(bf16x8, w);
    }
}
__device__ __forceinline__ void pv_apply(f32x4 (&o)[4][2], f32x4 (&osum)[2], const bf16x8 (&pb)[2][2], const LAS bf16_t* Vt, int lane) {
  const int g = lane >> 4, qq = (lane & 15) >> 2, pp = lane & 3;
  const bf16x8 ones = {0x3F80, 0x3F80, 0x3F80, 0x3F80, 0x3F80, 0x3F80, 0x3F80, 0x3F80};
#pragma unroll
  for (int kb = 0; kb < 2; ++kb)
#pragma unroll
    for (int qt = 0; qt < 2; ++qt) osum[qt] = __builtin_amdgcn_mfma_f32_16x16x32_bf16(ones, pb[kb][qt], osum[qt], 0, 0, 0);
#pragma unroll
  for (int dt = 0; dt < 4; ++dt)
#pragma unroll
    for (int kb = 0; kb < 2; ++kb) {
      const v4i16_t lo = tr16(Vt + (32 * kb + 4 * g + qq) * RP + dt * 16 + 4 * pp);
      const v4i16_t hi = tr16(Vt + (32 * kb + 16 + 4 * g + qq) * RP + dt * 16 + 4 * pp);
      const bf16x8 a = {lo[0], lo[1], lo[2], lo[3], hi[0], hi[1], hi[2], hi[3]};
#pragma unroll
      for (int qt = 0; qt < 2; ++qt) o[dt][qt] = __builtin_amdgcn_mfma_f32_16x16x32_bf16(a, pb[kb][qt], o[dt][qt], 0, 0, 0);
    }
}
__device__ __forceinline__ void pv_apply2(f32x4 (&o1)[4][2], f32x4 (&o2)[4][2], f32x4 (&os1)[2], f32x4 (&os2)[2], const bf16x8 (&pb1)[2][2], const bf16x8 (&pb2)[2][2], const LAS bf16_t* Vt, int lane) {
  const int g = lane >> 4, qq = (lane & 15) >> 2, pp = lane & 3;
  const bf16x8 ones = {0x3F80, 0x3F80, 0x3F80, 0x3F80, 0x3F80, 0x3F80, 0x3F80, 0x3F80};
#pragma unroll
  for (int kb = 0; kb < 2; ++kb)
#pragma unroll
    for (int qt = 0; qt < 2; ++qt) { os1[qt] = __builtin_amdgcn_mfma_f32_16x16x32_bf16(ones, pb1[kb][qt], os1[qt], 0, 0, 0); os2[qt] = __builtin_amdgcn_mfma_f32_16x16x32_bf16(ones, pb2[kb][qt], os2[qt], 0, 0, 0); }
#pragma unroll
  for (int dt = 0; dt < 4; ++dt)
#pragma unroll
    for (int kb = 0; kb < 2; ++kb) {
      const v4i16_t lo = tr16(Vt + (32 * kb + 4 * g + qq) * RP + dt * 16 + 4 * pp);
      const v4i16_t hi = tr16(Vt + (32 * kb + 16 + 4 * g + qq) * RP + dt * 16 + 4 * pp);
      const bf16x8 a = {lo[0], lo[1], lo[2], lo[3], hi[0], hi[1], hi[2], hi[3]};
#pragma unroll
      for (int qt = 0; qt < 2; ++qt) { o1[dt][qt] = __builtin_amdgcn_mfma_f32_16x16x32_bf16(a, pb1[kb][qt], o1[dt][qt], 0, 0, 0); o2[dt][qt] = __builtin_amdgcn_mfma_f32_16x16x32_bf16(a, pb2[kb][qt], o2[dt][qt], 0, 0, 0); }
    }
}
__device__ __forceinline__ void fill42(f32x4 (&a)[4][2], const f32x4 v) {
#pragma unroll
  for (int i = 0; i < 4; ++i)
#pragma unroll
    for (int j = 0; j < 2; ++j) a[i][j] = v;
}
__device__ __forceinline__ void exp42(f32x4 (&a)[4][2]) {
#pragma unroll
  for (int i = 0; i < 4; ++i)
#pragma unroll
    for (int j = 0; j < 2; ++j)
#pragma unroll
      for (int e = 0; e < 4; ++e) a[i][j][e] = __builtin_amdgcn_exp2f(a[i][j][e]);
}
#if defined(PROBE_PH) && PROBE_PH == 300
#define AT_BAR() do { const unsigned long long _b0 = __builtin_amdgcn_s_memrealtime(); asm volatile("s_waitcnt lgkmcnt(0)" ::: "memory"); __builtin_amdgcn_s_barrier(); asm volatile("" ::: "memory"); F.pr_t1 += __builtin_amdgcn_s_memrealtime() - _b0; } while (0)
#else
#define AT_BAR() do { asm volatile("s_waitcnt lgkmcnt(0)" ::: "memory"); __builtin_amdgcn_s_barrier(); asm volatile("" ::: "memory"); } while (0)
#endif
__device__ __forceinline__ void zero42(f32x4 (&a)[4][2]) {
#pragma unroll
  for (int i = 0; i < 4; ++i)
#pragma unroll
    for (int j = 0; j < 2; ++j) a[i][j] = (f32x4){0.f, 0.f, 0.f, 0.f};
}

__device__ __forceinline__ void phase_compress(PREF p, Frame& F) {
  const int lane = fresh_lane(), w = F.wave, tid = F.tid;
  const int r = lane & 15, g4 = lane >> 4;
  const bf16_t* H = (const bf16_t*)(p.ws + WS_H);
  const bf16_t* W1T = (const bf16_t*)(p.ws + WS_CW1);
  LAS float* part = (LAS float*)F.lds;
  LAS float* hid = part + 8 * 16 * 64;
  LAS float* outv = hid + 16 * 64;
  for (int task = F.vcu; task < 256; task += F.G) {
    const int kv = task >> 7, rb = task & 127;
    int row = rb * 16 + r; if (row > 2039) row = 2039;
    const int gg = row & 1, cc = (row >> 1) % NCMP, bb = (row >> 1) / NCMP;
    const int colbase = OFF_NKV + ((0 * 2 + kv) * 2 + gg) * 64;
    f32x4 acc[4];
#pragma unroll
    for (int nt = 0; nt < 4; ++nt) acc[nt] = (f32x4){0.f, 0.f, 0.f, 0.f};
#pragma unroll 1
    for (int ks = 0; ks < 8; ++ks) {
      const int k = w * 256 + ks * 32 + g4 * 8, l = k >> 6, d0 = k & 63;
      float hv[8]; ld8bf(H + (size_t)(bb * SEQ + 16 * cc + l) * HC + colbase + d0, hv);
      const float* pe = p.cmp_pe + (kv * 32 + l) * 64 + d0;
#pragma unroll
      for (int i = 0; i < 8; ++i) hv[i] += pe[i];
      const bf16x8 a = __builtin_bit_cast(bf16x8, pk8(hv));
#pragma unroll
      for (int nt = 0; nt < 4; ++nt) {
        const bf16x8 bfr = *(const GAS bf16x8*)(W1T + ((size_t)kv * 64 + nt * 16 + r) * 2048 + k);
        acc[nt] = __builtin_amdgcn_mfma_f32_16x16x32_bf16(a, bfr, acc[nt], 0, 0, 0);
      }
    }
#pragma unroll
    for (int nt = 0; nt < 4; ++nt)
#pragma unroll
      for (int i = 0; i < 4; ++i) part[(w * 16 + g4 * 4 + i) * 64 + nt * 16 + r] = acc[nt][i];
    __syncthreads();
    for (int e = tid; e < 1024; e += NWAVES * 64) { float s = 0.f;
#pragma unroll
      for (int ww = 0; ww < 8; ++ww) s += part[ww * 1024 + e];
      hid[e] = gelu_tanh(s); }
    __syncthreads();
    const float* w2 = p.cmp_w2 + kv * 4096;
    for (int e = tid; e < 1024; e += NWAVES * 64) { const int rr = e >> 6, n = e & 63; float s = 0.f;
      for (int j = 0; j < 64; ++j) s += hid[rr * 64 + j] * w2[j * 64 + n];
      outv[e] = s; }
    __syncthreads();
    for (int e = tid; e < 1024; e += NWAVES * 64) { const int rr = e >> 6, n = e & 63;
      const int orow = rb * 16 + rr;
      if (orow < 2040) {
        float v = outv[e];
        if (kv == 0) { float ss = 0.f; for (int j = 0; j < 64; ++j) ss += outv[rr * 64 + j] * outv[rr * 64 + j]; v = v * rsqrtf(ss * (1.f / 64.f) + 1e-6f) * p.nk_norm[n]; }
        const int g2 = orow & 1, c2 = (orow >> 1) % NCMP, b2 = (orow >> 1) / NCMP;
        ((bf16_t*)(p.ws + (kv ? WS_VCMPB : WS_KCMPB)))[((size_t)(b2 * 2 + g2) * 256 + c2) * 64 + n] = (bf16_t)f2bf(v);
      }
    }
    if (task < 16 && tid < 64) { const int kk2 = task >> 3, bg = task & 7; ((bf16_t*)(p.ws + (kk2 ? WS_VCMPB : WS_KCMPB)))[((size_t)bg * 256 + 255) * 64 + tid] = 0; }
    __syncthreads();
  }
}

__device__ __forceinline__ v4u tile_ld(const bf16_t* base, size_t pitch, int tid) { return *(const GAS v4u*)(base + (size_t)(tid >> 3) * pitch + (tid & 7) * 8); }
__device__ __forceinline__ void tile_st(LAS bf16_t* dst, v4u v, int tid) { *(LAS v4u*)(dst + (tid >> 3) * RP + (tid & 7) * 8) = v; }

template <int KS, int MODE>
__device__ __forceinline__ void attn_tile(f32x4 (&o)[4][2], f32x4 (&os)[2], const bf16x8 (&qf)[2][KS], const LAS bf16_t* KBt, int kc0, const LAS bf16_t* VBt, const f32x4 nbv,
                                          const bool (&on)[2], int qq0, int koff, int lane) {
  const int r = lane & 15, g = lane >> 4;
  f32x4 st[4][2]; bf16x8 pb[2][2];
  fill42(st, nbv); qk_tile<KS>(st, KBt, kc0, qf, lane); exp42(st);
  if (MODE != 0) {
#pragma unroll
    for (int kt = 0; kt < 4; ++kt)
#pragma unroll
      for (int qt = 0; qt < 2; ++qt)
#pragma unroll
        for (int i = 0; i < 4; ++i) { const int kk = kt * 16 + g * 4 + i, qq = qq0 + qt * 16 + r;
          bool keep = true;
          if (MODE & 1) keep = keep && on[qt];
          if (MODE & 2) keep = keep && (kk + koff <= qq);
          if (MODE & 4) keep = keep && (kk > qq);
          if (!keep) st[kt][qt][i] = 0.f; }
  }
  pack_p(pb, st);
  pv_apply(o, os, pb, VBt, lane);
}
__device__ __forceinline__ void phase_diffattn(PREF p, Frame& F) {
  const int lane = fresh_lane(), w = F.wave, tid = F.tid;
  const int r = lane & 15, g = lane >> 4;
  const bf16_t* H = (const bf16_t*)(p.ws + WS_H);
  bf16_t* CAT = (bf16_t*)(p.ws + WS_CAT);
  float mq = 0.f, mk = 0.f, l0 = 0.f, l1 = 0.f;
  for (int i = 0; i < 32; i++) { mq = fmaxf(mq, fabsf(p.dq_norm[i])); mk = fmaxf(mk, fabsf(p.dk_norm[i])); l0 += p.dlam[i] * p.dlam[32 + i]; l1 += p.dlam[64 + i] * p.dlam[96 + i]; }
  const float c2 = 0.17677669529663687f * 1.4426950408889634f;
  const float nb = -(32.f * mq * mk) * c2;
  const f32x4 nbv = {nb, nb, nb, nb};
  const float lam = __expf(l0) - __expf(l1) + 0.2f;
  const bool on[2] = {true, true};
  for (int pr = F.vcu; pr < 256; pr += F.G) {
    const int bh = pr >> 3, sp = pr & 7, b = bh >> 3, hd = bh & 7;
#pragma unroll 1
    for (int ui = 0; ui < 2; ++ui) {
      const int qb = ui ? 15 - sp : sp;
      const int NT = 4 * (qb + 1);
      const bf16_t* Kg = H + (size_t)(b * SEQ) * HC + OFF_DK + hd * 64;
      const bf16_t* Vg = H + (size_t)(b * SEQ) * HC + OFF_DV + hd * 64;
      f32x4 o1[4][2];
#pragma unroll 1
      for (int mp = 0; mp < 2; ++mp) {
        bf16x8 qf[2][1];
#pragma unroll
        for (int qt = 0; qt < 2; ++qt) qf[qt][0] = *(const GAS bf16x8*)(H + (size_t)(b * SEQ + qb * 256 + w * 32 + qt * 16 + r) * HC + OFF_DQ + hd * 64 + mp * 32 + g * 8);
        f32x4 o[4][2]; zero42(o);
        f32x4 os[2] = {{0.f, 0.f, 0.f, 0.f}, {0.f, 0.f, 0.f, 0.f}};
        v4u krA = tile_ld(Kg, HC, tid), vrA = tile_ld(Vg, HC, tid);
        v4u krB = tile_ld(Kg + (size_t)64 * HC, HC, tid), vrB = tile_ld(Vg + (size_t)64 * HC, HC, tid);
#pragma unroll 1
        for (int t = 0; t < NT; t += 2) {
#pragma unroll
          for (int hf = 0; hf < 2; ++hf) {
            const int tt = t + hf;
            const lbf KBt = (lbf)(F.lds + hf * 2 * RB), VBt = KBt + 64 * RP;
            tile_st(KBt, hf ? krB : krA, tid); tile_st(VBt, hf ? vrB : vrA, tid);
            AT_BAR();
            if (tt + 2 < NT) { const v4u k2 = tile_ld(Kg + (size_t)(tt + 2) * 64 * HC, HC, tid), v2 = tile_ld(Vg + (size_t)(tt + 2) * 64 * HC, HC, tid);
              if (hf) { krB = k2; vrB = v2; } else { krA = k2; vrA = v2; } }
            const int koff = tt * 64 - (qb * 256 + w * 32);
            if (tt >= NT - 4) attn_tile<1, 2>(o, os, qf, KBt, mp * 32, VBt, nbv, on, 0, koff, lane);
            else attn_tile<1, 0>(o, os, qf, KBt, mp * 32, VBt, nbv, on, 0, koff, lane);
          }
        }
        if (mp == 0) {
#pragma unroll
          for (int qt = 0; qt < 2; ++qt) { const float i1 = 1.f / os[qt][0];
#pragma unroll
            for (int dt = 0; dt < 4; ++dt) o1[dt][qt] = o[dt][qt] * i1; }
        } else {
#pragma unroll
          for (int qt = 0; qt < 2; ++qt) {
            const float i2 = lam / os[qt][0];
            float ss = 0.f;
#pragma unroll
            for (int dt = 0; dt < 4; ++dt)
#pragma unroll
              for (int i = 0; i < 4; ++i) { const float v = o1[dt][qt][i] - o[dt][qt][i] * i2; o1[dt][qt][i] = v; ss += v * v; }
            ss += __shfl_xor(ss, 16, 64); ss += __shfl_xor(ss, 32, 64);
            const float rr = rsqrtf(ss * (1.f / 64.f) + 1e-6f) * 0.8f;
            bf16_t* op = CAT + (size_t)(b * SEQ + qb * 256 + w * 32 + qt * 16 + r) * DM + hd * 64;
#pragma unroll
            for (int dt = 0; dt < 4; ++dt) { const int d0 = dt * 16 + g * 4; const f32x4 sg = *(const f32x4*)(p.dsubln + d0);
              v2u wv; wv.x = pk2(o1[dt][qt][0] * rr * sg[0], o1[dt][qt][1] * rr * sg[1]); wv.y = pk2(o1[dt][qt][2] * rr * sg[2], o1[dt][qt][3] * rr * sg[3]);
              *(GAS v2u*)(op + d0) = wv; }
          }
        }
        AT_BAR();
      }
    }
  }
}

__device__ __forceinline__ void nsa_finish(f32x4 (&comb)[4][2], const f32x4 (&o)[4][2], const f32x4 (&os)[2], const float (&gate)[2], bool normalised) {
#pragma unroll
  for (int qt = 0; qt < 2; ++qt) {
    const float f = normalised ? gate[qt] : gate[qt] / os[qt][0];
#pragma unroll
    for (int dt = 0; dt < 4; ++dt) comb[dt][qt] += o[dt][qt] * f;
  }
}
__device__ __forceinline__ void phase_nsa(PREF p, Frame& F) {
  const int lane = fresh_lane(), w = F.wave, tid = F.tid;
  const int r = lane & 15, g = lane >> 4;
  const bf16_t* H = (const bf16_t*)(p.ws + WS_H);
  const float* GATES = (const float*)(p.ws + WS_GATES);
  bf16_t* CAT = (bf16_t*)(p.ws + WS_CAT);
  float mq = 0.f, mk0 = 0.f, mk1 = 0.f, mk2 = 0.f;
  for (int i = 0; i < 64; i++) { mq = fmaxf(mq, fabsf(p.nq_norm[i])); mk0 = fmaxf(mk0, fabsf(p.nk_norm[i])); mk1 = fmaxf(mk1, fabsf(p.nk_norm[64 + i])); mk2 = fmaxf(mk2, fabsf(p.nk_norm[128 + i])); }
  const float c2 = 0.125f * 1.4426950408889634f;
  const float nb0 = -(64.f * mq * mk0) * c2, nb1 = -(64.f * mq * mk1) * c2, nb2 = -(64.f * mq * mk2) * c2;
  LAS float* IMP = (LAS float*)(F.lds + 12 * RB);
  LAS unsigned char* SELB = (LAS unsigned char*)(F.lds + 12 * RB + 64 * 65 * 4);
  const int hj = w >> 1, th = w & 1;
  for (int pr = F.vcu; pr < 256; pr += F.G) {
    const int bg = pr >> 5, sp = pr & 31, b = bg >> 1, gq = bg & 1;
#pragma unroll 1
    for (int ui = 0; ui < 2; ++ui) {
      const int blk = ui ? 63 - sp : sp;
      const int hh = gq * 4 + hj;
      const int tokw = b * SEQ + blk * 64 + th * 32;
      bf16x8 qf[2][2];
      float gate0[2], gate1[2], gate2[2];
#pragma unroll
      for (int qt = 0; qt < 2; ++qt) { const bf16_t* qp = H + (size_t)(tokw + qt * 16 + r) * HC + OFF_NQ + hh * 64 + g * 8;
        qf[qt][0] = *(const GAS bf16x8*)qp; qf[qt][1] = *(const GAS bf16x8*)(qp + 32);
        const float* gp = GATES + (size_t)(tokw + qt * 16 + r) * 24 + hh * 3; gate0[qt] = gp[0]; gate1[qt] = gp[1]; gate2[qt] = gp[2]; }
      f32x4 comb[4][2]; zero42(comb);
      const int nct = (4 * blk + 3 + 63) >> 6;
      {
        const bf16_t* KC = (const bf16_t*)(p.ws + WS_KCMPB) + (size_t)(b * 2 + gq) * 256 * 64;
        const bf16_t* VC = (const bf16_t*)(p.ws + WS_VCMPB) + (size_t)(b * 2 + gq) * 256 * 64;
        for (int t4 = 0; t4 < nct; ++t4) { tile_st((lbf)(F.lds + t4 * RB), tile_ld(KC + t4 * 4096, 64, tid), tid); tile_st((lbf)(F.lds + (4 + t4) * RB), tile_ld(VC + t4 * 4096, 64, tid), tid); }
        for (int e = tid; e < 64 * 65; e += NWAVES * 64) IMP[e] = 0.f;
        AT_BAR();
        const f32x4 nbv0 = {nb0, nb0, nb0, nb0};
        int cmax[2];
#pragma unroll
        for (int qt = 0; qt < 2; ++qt) { const int pos = blk * 64 + th * 32 + qt * 16 + r; cmax[qt] = (pos >= 31) ? ((pos - 31) >> 4) : -1; }
        float lsum[2] = {0.f, 0.f};
        for (int t4 = 0; t4 < nct; ++t4) {
          f32x4 st[4][2]; fill42(st, nbv0);
          qk_tile<2>(st, (lbf)(F.lds + t4 * RB), 0, qf, lane); exp42(st);
#pragma unroll
          for (int kt = 0; kt < 4; ++kt)
#pragma unroll
            for (int qt = 0; qt < 2; ++qt)
#pragma unroll
              for (int i = 0; i < 4; ++i) { const int c = t4 * 64 + kt * 16 + g * 4 + i; if (c <= cmax[qt]) lsum[qt] += st[kt][qt][i]; }
        }
        float linv[2];
#pragma unroll
        for (int qt = 0; qt < 2; ++qt) { float s = lsum[qt]; s += __shfl_xor(s, 16, 64); s += __shfl_xor(s, 32, 64); linv[qt] = (cmax[qt] >= 0) ? 1.f / s : 0.f; }
        f32x4 o[4][2]; zero42(o);
        f32x4 osd[2] = {{0.f, 0.f, 0.f, 0.f}, {0.f, 0.f, 0.f, 0.f}};
        for (int t4 = 0; t4 < nct; ++t4) {
          f32x4 st[4][2]; fill42(st, nbv0);
          qk_tile<2>(st, (lbf)(F.lds + t4 * RB), 0, qf, lane); exp42(st);
#pragma unroll
          for (int kt = 0; kt < 4; ++kt)
#pragma unroll
            for (int qt = 0; qt < 2; ++qt) {
              float gs = 0.f;
#pragma unroll
              for (int i = 0; i < 4; ++i) { const int c = t4 * 64 + kt * 16 + g * 4 + i;
                const float e = (c <= cmax[qt]) ? st[kt][qt][i] * linv[qt] : 0.f;
                st[kt][qt][i] = e; gs += e; }
              const int ti = th * 32 + qt * 16 + r, j = t4 * 16 + kt * 4 + g;
              if (gs != 0.f) { __hip_atomic_fetch_add(IMP + ti * 65 + j, gs, __ATOMIC_RELAXED, __HIP_MEMORY_SCOPE_WORKGROUP); if (j < 63 && st[kt][qt][3] != 0.f) __hip_atomic_fetch_add(IMP + ti * 65 + j + 1, st[kt][qt][3], __ATOMIC_RELAXED, __HIP_MEMORY_SCOPE_WORKGROUP); }
            }
          bf16x8 pb[2][2]; pack_p(pb, st);
          pv_apply(o, osd, pb, (lbf)(F.lds + (4 + t4) * RB), lane);
        }
        nsa_finish(comb, o, osd, gate0, true);
      }
      AT_BAR();
      {
        const int ti = tid >> 3, jb = (tid & 7) * 8;
        float mine[8]; int rank[8];
#pragma unroll
        for (int u = 0; u < 8; ++u) { const int j = jb + u; float v = IMP[ti * 65 + j]; if (j == blk || j == 0) v = 1e4f; else if (j > blk) v = -1e30f; mine[u] = v; rank[u] = 0; }
        for (int i = 0; i < 64; ++i) { float v = IMP[ti * 65 + i]; if (i == blk || i == 0) v = 1e4f; else if (i > blk) v = -1e30f;
#pragma unroll
          for (int u = 0; u < 8; ++u) rank[u] += (v > mine[u] || (v == mine[u] && i < jb + u)) ? 1 : 0; }
        unsigned bits = 0;
#pragma unroll
        for (int u = 0; u < 8; ++u) bits |= (rank[u] < 16 ? 1u : 0u) << u;
        SELB[ti * 8 + (tid & 7)] = (unsigned char)bits;
      }
      AT_BAR();
      unsigned long long selm[2];
#pragma unroll
      for (int qt = 0; qt < 2; ++qt) { const int ti = th * 32 + qt * 16 + r; const LAS unsigned* sp2 = (const LAS unsigned*)(SELB + ti * 8); selm[qt] = (unsigned long long)sp2[0] | ((unsigned long long)sp2[1] << 32); }
#pragma unroll 1
      for (int br = 1; br < 3; ++br) {
        const int kcol = OFF_NKV + ((br * 2 + 0) * 2 + gq) * 64, vcol = OFF_NKV + ((br * 2 + 1) * 2 + gq) * 64;
        const float nbb = (br == 1) ? nb1 : nb2;
        const f32x4 nbv = {nbb, nbb, nbb, nbb};
        const int t_lo = (br == 1) ? 0 : (blk > 8 ? blk - 8 : 0);
        const bf16_t* Kg = H + (size_t)(b * SEQ) * HC + kcol;
        const bf16_t* Vg = H + (size_t)(b * SEQ) * HC + vcol;
        f32x4 o[4][2]; zero42(o);
        f32x4 os[2] = {{0.f, 0.f, 0.f, 0.f}, {0.f, 0.f, 0.f, 0.f}};
        v4u krA = tile_ld(Kg + (size_t)t_lo * 64 * HC, HC, tid), vrA = tile_ld(Vg + (size_t)t_lo * 64 * HC, HC, tid);
        v4u krB = krA, vrB = vrA;
        if (t_lo < blk) { krB = tile_ld(Kg + (size_t)(t_lo + 1) * 64 * HC, HC, tid); vrB = tile_ld(Vg + (size_t)(t_lo + 1) * 64 * HC, HC, tid); }
#pragma unroll 1
        for (int t0 = t_lo; t0 <= blk; t0 += 2) {
#pragma unroll
          for (int hf = 0; hf < 2; ++hf) {
            const int t = t0 + hf;
            if (t <= blk) {
              const lbf KBt = (lbf)(F.lds + (8 + hf * 2) * RB), VBt = KBt + 64 * RP;
              tile_st(KBt, hf ? krB : krA, tid); tile_st(VBt, hf ? vrB : vrA, tid);
              AT_BAR();
              if (t + 2 <= blk) { const v4u k2 = tile_ld(Kg + (size_t)(t + 2) * 64 * HC, HC, tid), v2 = tile_ld(Vg + (size_t)(t + 2) * 64 * HC, HC, tid);
                if (hf) { krB = k2; vrB = v2; } else { krA = k2; vrA = v2; } }
              const bool on[2] = {((selm[0] >> t) & 1ull) != 0ull, ((selm[1] >> t) & 1ull) != 0ull};
              const int qq0 = th * 32;
              if (br == 1) {
                if (__any((int)(on[0] || on[1]))) {
                  if (t == blk) attn_tile<2, 3>(o, os, qf, KBt, 0, VBt, nbv, on, qq0, 0, lane);
                  else if (__all((int)(on[0] && on[1]))) attn_tile<2, 0>(o, os, qf, KBt, 0, VBt, nbv, on, qq0, 0, lane);
                  else attn_tile<2, 1>(o, os, qf, KBt, 0, VBt, nbv, on, qq0, 0, lane);
                }
              } else {
                if (t == blk) attn_tile<2, 2>(o, os, qf, KBt, 0, VBt, nbv, on, qq0, 0, lane);
                else if (t == blk - 8) attn_tile<2, 4>(o, os, qf, KBt, 0, VBt, nbv, on, qq0, 0, lane);
                else attn_tile<2, 0>(o, os, qf, KBt, 0, VBt, nbv, on, qq0, 0, lane);
              }
            }
          }
        }
        nsa_finish(comb, o, os, (br == 1) ? gate1 : gate2, false);
        AT_BAR();
      }
#pragma unroll
      for (int qt = 0; qt < 2; ++qt) { bf16_t* op = CAT + (size_t)(tokw + qt * 16 + r) * DM + 512 + hh * 64;
#pragma unroll
        for (int dt = 0; dt < 4; ++dt) { const int d0 = dt * 16 + g * 4; v2u wv; wv.x = pk2(comb[dt][qt][0], comb[dt][qt][1]); wv.y = pk2(comb[dt][qt][2], comb[dt][qt][3]); *(GAS v2u*)(op + d0) = wv; } }
    }
  }
}


__device__ __forceinline__ void phase_lora2(PREF p, Frame& F, const bool skip_store = false, const bool skip_math = false) {
  const int lane = fresh_lane(), w = F.wave, tid = F.tid;
  const int cr = lane & 15, g = lane >> 4;
  constexpr int TP = 392;
  const lbf TM = (lbf)(F.lds);
  const lbf ST = (lbf)(F.lds + 64 * TP * 2) + w * 64 * RP;
  const bf16_t* TMPg = (const bf16_t*)(p.ws + WS_TMP);
  for (int unit = F.vcu; unit < 256; unit += F.G) {
    const int t0 = unit * 64;
    bf16x8 a0[2][4];
    auto wptr = [&](int blk) { const int tensor = blk >> 4, cb = blk & 15, ldw = (tensor == 2) ? 192 : 64;
      return (const bf16_t*)(p.ws + WS_WL2 + (size_t)tensor * 128 * 1024) + (size_t)(cb * 64 + cr) * ldw + g * 8; };
    auto wload = [&](int blk) {
      const int ldw = ((blk >> 4) == 2) ? 192 : 64; const bf16_t* Wp = wptr(blk);
#pragma unroll
      for (int k2 = 0; k2 < 2; ++k2)
#pragma unroll
        for (int ct = 0; ct < 4; ++ct) a0[k2][ct] = *(const GAS bf16x8*)(Wp + (size_t)(16 * ct) * ldw + k2 * 32);
    };
    auto blkof = [&](int j) { return ((j >> 1) << 4) | ((w * 2 + (j & 1) + unit * 3) & 15); };
    wload(blkof(0));
#pragma unroll
    for (int i = 0; i < 6; ++i) { const int idx = tid + i * 512, row = idx / 48, pc = idx - row * 48;
      *(LAS v4u*)(TM + row * TP + pc * 8) = *(const GAS v4u*)(TMPg + (size_t)(t0 + row) * 384 + pc * 8); }
    __syncthreads();
#pragma unroll 1
    for (int j = 0; j < 6; ++j) {
      const int blk = blkof(j);
      const int tensor = blk >> 4, cb = blk & 15, kc0 = tensor * 64;
      f32x4 acc[4][4];
#pragma unroll
      for (int ct = 0; ct < 4; ++ct)
#pragma unroll
        for (int tt = 0; tt < 4; ++tt) acc[ct][tt] = (f32x4){0.f, 0.f, 0.f, 0.f};
      auto kpair = [&](int kp, bf16x8 (&a)[2][4]) {
#pragma unroll
        for (int k2 = 0; k2 < 2; ++k2) {
          bf16x8 b[4];
#pragma unroll
          for (int tt = 0; tt < 4; ++tt) b[tt] = *(const LAS bf16x8*)(TM + (16 * tt + cr) * TP + kc0 + kp * 64 + k2 * 32 + g * 8);
#pragma unroll
          for (int ct = 0; ct < 4; ++ct)
#pragma unroll
            for (int tt = 0; tt < 4; ++tt) acc[ct][tt] = __builtin_amdgcn_mfma_f32_16x16x32_bf16(a[k2][ct], b[tt], acc[ct][tt], 0, 0, 0);
        }
      };
      if (tensor == 2) {
        bf16x8 a1[2][4], a2[2][4]; const bf16_t* Wp = wptr(blk);
#pragma unroll
        for (int k2 = 0; k2 < 2; ++k2)
#pragma unroll
          for (int ct = 0; ct < 4; ++ct) { a1[k2][ct] = *(const GAS bf16x8*)(Wp + (size_t)(16 * ct) * 192 + 64 + k2 * 32); a2[k2][ct] = *(const GAS bf16x8*)(Wp + (size_t)(16 * ct) * 192 + 128 + k2 * 32); }
        kpair(0, a0); kpair(1, a1); kpair(2, a2);
      } else kpair(0, a0);
      if (j < 5) wload(blkof(j + 1));
#pragma unroll
      for (int ct = 0; ct < 4; ++ct) {
        const int n0 = cb * 64 + 16 * ct + 4 * g;
        f32x4 bias = {0.f, 0.f, 0.f, 0.f};
        if (tensor == 0) bias = *(const f32x4*)(p.w0 + n0); else if (tensor == 1) bias = *(const f32x4*)(p.a0 + n0);
#pragma unroll
        for (int tt = 0; tt < 4; ++tt) {
          f32x4 v = acc[ct][tt] + bias;
          if (skip_math) {} else if (tensor == 0) {
#pragma unroll
            for (int i = 0; i < 4; ++i) v[i] = -0.60653066f * sigmoidf_(v[i]);
          } else if (tensor == 1) {
#pragma unroll
            for (int i = 0; i < 4; ++i) v[i] = sigmoidf_(v[i]);
          }
          v2u o; o.x = pk2(v[0], v[1]); o.y = pk2(v[2], v[3]);
          *(LAS v2u*)(ST + (16 * tt + cr) * RP + 16 * ct + 4 * g) = o;
        }
      }
      LDS_WAIT();
      bf16_t* O = (bf16_t*)(p.ws + WS_S0 + (size_t)tensor * SLOT) + (size_t)t0 * DM + cb * 64;
#pragma unroll
      for (int i = 0; i < 8; ++i) { const int row = (lane >> 3) + 8 * i, pc = (lane & 7) * 8;
        const v4u sv = *(const LAS v4u*)(ST + row * RP + pc); if (!skip_store) *(GAS v4u*)(O + (size_t)row * DM + pc) = sv; }
      LDS_WAIT();
    }
    __syncthreads();
  }
}

__global__ void __launch_bounds__(NWAVES * 64, 2) mk_fwd(P p_arg) {
  extern __shared__ __attribute__((aligned(16))) unsigned char lds[];
  Frame F;
  F.lds = (LAS unsigned char*)lds;
  F.MISC = (volatile LAS unsigned*)(F.lds + MISC_OFF);
  F.tid = threadIdx.x; F.lane = F.tid & 63; F.wave = __builtin_amdgcn_readfirstlane(F.tid >> 6);
  F.G = gridDim.x; { const int bx = blockIdx.x; F.vcu = (F.G % 8 == 0) ? (bx % 8) * (F.G / 8) + bx / 8 : bx; }
  unsigned char* const ws = p_arg.ws;
  F.ctl = (gu32*)(ws + WS_CTL);
  for (int u = F.tid; u < (LDS_BYTES - LDSCTL_OFF) / 4; u += NWAVES * 64) ((LAS unsigned*)(F.lds + LDSCTL_OFF))[u] = 0u;
  __syncthreads();
  XcdBarrier bar = xcd_barrier_post((unsigned*)(F.ctl + CW_BAR) + p_arg.pad * XCD_BAR_WORDS, F.MISC + 8);
  const int lo = p_arg.ph_lo, hi = p_arg.ph_hi;
#ifndef PHMASK
#define PHMASK 0xffffffffu
#endif
#define IN(k) (lo <= (k) && (k) < hi && ((PHMASK >> (k)) & 1u))
#define SEAM(k) do { if (IN(k) && IN((k) + 1)) xcd_barrier(bar); } while (0)
#ifdef PROBE_PH
  F.pr_t0 = 0; F.pr_t1 = 0;
#endif

  PROBE_MARK(0); if (IN(0)) { phase_prologue(KP, F); } SEAM(0);
  PROBE_MARK(1); if (IN(1)) {
    pg8::Gemm g{(const bf16_t*)(ws + WS_XN), (const bf16_t*)(ws + WS_WIN), DM, DM};
    pg8::StaticOrder S; S.init(T_TOK, 3072, F.G, (int)blockIdx.x);
    PREF p = KP; EpiInProj E{(bf16_t*)(ws + WS_H), (float*)(ws + WS_GATES), p.dq_norm, p.dk_norm, p.nq_norm, p.nk_norm, p.gate_bias};
    pg8::gemm_phase<EpiInProj, pg8::StaticOrder, true>(F.lds + RING_OFF, g, S, E);
  } SEAM(1);
  PROBE_MARK(2); if (IN(2)) { phase_compress(KP, F); phase_diffattn(KP, F); } SEAM(2);
  PROBE_MARK(3); if (IN(3)) { phase_nsa(KP, F); } SEAM(3);
  PROBE_MARK(4); if (IN(4)) {
    pg8::Gemm g{(const bf16_t*)(ws + WS_CAT), (const bf16_t*)(ws + WS_WOUT), DM, DM};
    pg8::StaticOrder S; S.init(T_TOK, DM, F.G, (int)blockIdx.x);
    PREF p = KP; EpiResid E{p.x, nullptr, (bf16_t*)p.out, nullptr};
    pg8::gemm_phase<EpiResid, pg8::StaticOrder, false>(F.lds + RING_OFF, g, S, E);
  } SEAM(4);
#define MOE_PHASES(layer, pb) do { \
    PROBE_MARK(pb); if (IN(pb)) { phase_router(KP, F, layer); } SEAM(pb); \
    PROBE_MARK(pb + 1); if (IN(pb + 1)) { \
      pg8::Gemm g{layer ? (const bf16_t*)(ws + WS_X3) : (const bf16_t*)KP.out, (const bf16_t*)(ws + WS_EGU), DM, DM}; \
      pg8::moe_order_setup((LAS int*)(F.lds + MISC_OFF + 256), (const unsigned*)(ws + WS_CTL) + CW_CNT + layer * 32 * 64); pg8::MoeOrder<2, true> S{(const LAS int*)(F.lds + MISC_OFF + 256), (const int*)(ws + WS_LIST), F.G, (int)blockIdx.x}; \
      EpiMoeGU E{(bf16_t*)(ws + WS_HID), (const int*)(ws + WS_LIST), (const float*)(ws + WS_RS)}; \
      pg8::gemm_phase<EpiMoeGU, pg8::MoeOrder<2, true>, true>(F.lds + RING_OFF, g, S, E); \
    } SEAM(pb + 1); \
    PROBE_MARK(pb + 2); if (IN(pb + 2)) { \
      int k256 = 256; asm volatile("" : "+s"(k256)); \
      pg8::Gemm g{(const bf16_t*)(ws + WS_HID), (const bf16_t*)(ws + WS_EDN), k256, 256}; \
      pg8::moe_order_setup((LAS int*)(F.lds + MISC_OFF + 256), (const unsigned*)(ws + WS_CTL) + CW_CNT + layer * 32 * 64); pg8::MoeOrder<4, false> S{(const LAS int*)(F.lds + MISC_OFF + 256), (const int*)(ws + WS_LIST), F.G, (int)blockIdx.x}; \
      PREF p = KP; EpiMoeDown E{layer ? (bf16_t*)(ws + WS_X3) : (bf16_t*)p.out, (bf16_t*)(ws + WS_Y1), (const int*)(ws + WS_LIST), (const float*)(ws + WS_PGATE), (LAS int*)(F.lds + 132096)}; \
      pg8::gemm_phase<EpiMoeDown, pg8::MoeOrder<4, false>, true>(F.lds + RING_OFF, g, S, E); \
    } SEAM(pb + 2); \
  } while (0)
  MOE_PHASES(0, 5);
  PROBE_MARK(8); if (IN(8)) { phase_rwkv_prep(KP, F); } SEAM(8);
  PROBE_MARK(9); if (IN(9)) {
    pg8::Gemm g{(const bf16_t*)(ws + WS_S0 + 3 * SLOT), (const bf16_t*)(ws + WS_WL1), DM, DM};
    pg8::TallOrder S; S.init(3, 1, F.G, (int)blockIdx.x);
    EpiLora1 E{(bf16_t*)(ws + WS_TMP)};
    pg8::gemm_phase<EpiLora1, pg8::TallOrder, false>(F.lds + RING_OFF, g, S, E);
  } SEAM(9);
  PROBE_MARK(10); if (IN(10)) {
    pg8::Gemm g{(const bf16_t*)(ws + WS_S0), (const bf16_t*)(ws + WS_WRKV), DM, DM};
    pg8::TallOrder S; S.init(3, 4, F.G, (int)blockIdx.x);
    EpiRKV E{ws};
    pg8::gemm_phase<EpiRKV, pg8::TallOrder, true>(F.lds + RING_OFF, g, S, E);
  } SEAM(10);
  PROBE_MARK(11); if (IN(11)) {
#ifdef EXP_A
    phase_lora2(KP, F, KP.ph_lo == 0, false); __syncthreads();
#endif
#ifdef EXP_B
    phase_lora2(KP, F, KP.ph_lo == 0, KP.ph_lo == 0); __syncthreads();
#endif
    phase_lora2(KP, F);
  } SEAM(11);
  PROBE_MARK(12); if (IN(12)) { phase_rwkv_r1(KP, F); } SEAM(12);
  PROBE_MARK(13); if (IN(13)) { phase_rwkv_r2(KP, F); } SEAM(13);
  PROBE_MARK(14); if (IN(14)) { phase_rwkv_r3(KP, F); } SEAM(14);
  PROBE_MARK(15); if (IN(15)) {
    pg8::Gemm g{(const bf16_t*)(ws + WS_S0 + 3 * SLOT), (const bf16_t*)(ws + WS_WO), DM, DM};
    pg8::StaticOrder S; S.init(T_TOK, DM, F.G, (int)blockIdx.x);
    PREF p = KP; EpiResid E{nullptr, (const bf16_t*)p.out, (bf16_t*)(ws + WS_X3), (const bf16_t*)(ws + WS_Y1)};
    pg8::gemm_phase<EpiResid, pg8::StaticOrder, false>(F.lds + RING_OFF, g, S, E);
  } SEAM(15);
  MOE_PHASES(1, 16);
#undef MOE_PHASES
  PROBE_MARK(19); if (IN(19)) { phase_final(KP, F); }
  PROBE_MARK(20);
#ifdef PROBE_PH
  { const unsigned long long dur = (F.pr_t1 - F.pr_t0) * PROBE_MUL, t0 = __builtin_amdgcn_s_memrealtime(); while (__builtin_amdgcn_s_memrealtime() - t0 < dur) __builtin_amdgcn_s_sleep(8); }
#endif
#undef IN
#undef SEAM
}

static void launch_mk(P p, int lo, int hi, int li, int grid, hipStream_t st) {
  p.ph_lo = lo; p.ph_hi = hi; p.pad = li;
  hipLaunchKernelGGL(mk_fwd, dim3(grid), dim3(NWAVES * 64), LDS_BYTES, st, p);
}

extern "C" void kernel_launch(void* const* d_in, const int* in_sizes, int n_in, void* d_out, int out_size, void* d_ws,
                              size_t ws_size, hipStream_t stream) {
  static int grid = 0;
  if (grid == 0) {
    if (n_in != 40 || ws_size < WS_END) { fprintf(stderr, "kernel_launch: bad n_in %d or ws_size %zu (< %zu)\n", n_in, ws_size, (size_t)WS_END); grid = -1; return; }
    int dev = 0, cus = 0;
    if (hipGetDevice(&dev) != hipSuccess || hipDeviceGetAttribute(&cus, hipDeviceAttributeMultiprocessorCount, dev) != hipSuccess) { grid = -1; return; }
    if (hipFuncSetAttribute((const void*)mk_fwd, hipFuncAttributeMaxDynamicSharedMemorySize, LDS_BYTES) != hipSuccess) { grid = -1; return; }
    if (cus < 256) { fprintf(stderr, "kernel_launch: needs 256 CUs (one workgroup per CU), found %d\n", cus); grid = -1; return; }
    grid = 256;
  }
  if (grid < 0) return;
  P p{};
  const float* const* in = (const float* const*)d_in;
  p.x = in[0]; p.mix_norm = in[1]; p.w_in = in[2]; p.gate_bias = in[3]; p.dq_norm = in[4]; p.dk_norm = in[5];
  p.dlam = in[6]; p.dsubln = in[7]; p.nq_norm = in[8]; p.nk_norm = in[9]; p.cmp_pe = in[10]; p.cmp_w1 = in[11];
  p.cmp_w2 = in[12]; p.w_out = in[13]; p.rmix = in[14]; p.w_r = in[15]; p.w_k = in[16]; p.w_v = in[17];
  p.w0 = in[18]; p.w1 = in[19]; p.w2 = in[20]; p.a0 = in[21]; p.a1 = in[22]; p.a2 = in[23]; p.g1 = in[24]; p.g2 = in[25];
  p.k_k = in[26]; p.k_a = in[27]; p.r_k = in[28]; p.ln_w = in[29]; p.ln_b = in[30]; p.w_o = in[31];
  p.ffn_norm = in[32]; p.rg_w = in[33]; p.rg_b = in[34]; p.re_w = in[35]; p.re_b = in[36];
  p.e_gate = in[37]; p.e_up = in[38]; p.e_down = in[39];
  p.out = (float*)d_out;
  p.ws = (unsigned char*)d_ws;
  unsigned char* ws = p.ws;
  (void)hipMemsetAsync(ws + WS_CTL, 0, CTL_ZERO_BYTES, stream);
  launch_mk(p, 0, 20, 0, grid, stream);
}
```

```cpp
#include <hip/hip_runtime.h>
#include <cstdio>
#include <cstdint>

#define T_TOK 16384
#define DM 1024
#define SEQ 4096
#define NBATCH 4
#define INC 2840
#define HC 2816
#define OFF_DQ 0
#define OFF_DK 512
#define OFF_DV 1024
#define OFF_NQ 1536
#define OFF_NKV 2048
#define OFF_NG 2816
#define NCMP 255
#define CAP 16384

#define GAS __attribute__((address_space(1)))
#define LAS __attribute__((address_space(3)))
typedef unsigned short bf16_t;
typedef unsigned v4u __attribute__((ext_vector_type(4)));
typedef unsigned v2u __attribute__((ext_vector_type(2)));
typedef float f32x4 __attribute__((ext_vector_type(4)));
typedef short bf16x8 __attribute__((ext_vector_type(8)));
typedef GAS unsigned gu32;
#define RLX_AGENT __ATOMIC_RELAXED, __HIP_MEMORY_SCOPE_AGENT
#define LDS_WAIT() asm volatile("s_waitcnt lgkmcnt(0)" ::: "memory")
#define VM_WAIT() asm volatile("s_waitcnt vmcnt(0)" ::: "memory")

__device__ __forceinline__ float bf2f(bf16_t v) { return __uint_as_float(((unsigned)v) << 16); }

typedef float f32x2_t __attribute__((ext_vector_type(2))); typedef __bf16 bf16x2_t __attribute__((ext_vector_type(2)));
__device__ __forceinline__ unsigned pk2(float lo, float hi) { const f32x2_t v = {lo, hi}; return __builtin_bit_cast(unsigned, __builtin_convertvector(v, bf16x2_t)); }
__device__ __forceinline__ unsigned f2bf(float f) { return pk2(f, f) & 0xffffu; }
__device__ __forceinline__ float wave_sum(float v) {
#pragma unroll
  for (int o = 32; o >= 1; o >>= 1) v += __shfl_xor(v, o, 64);
  return v;
}
__device__ __forceinline__ float wave_sum_dpp(float v) {
  v += __builtin_bit_cast(float, __builtin_amdgcn_update_dpp(0, __builtin_bit_cast(int, v), 0xB1, 0xf, 0xf, false));
  v += __builtin_bit_cast(float, __builtin_amdgcn_update_dpp(0, __builtin_bit_cast(int, v), 0x4E, 0xf, 0xf, false));
  v += __builtin_bit_cast(float, __builtin_amdgcn_update_dpp(0, __builtin_bit_cast(int, v), 0x141, 0xf, 0xf, false));
  v += __builtin_bit_cast(float, __builtin_amdgcn_update_dpp(0, __builtin_bit_cast(int, v), 0x140, 0xf, 0xf, false));
  const int iv = __builtin_bit_cast(int, v);
  return (__builtin_bit_cast(float, __builtin_amdgcn_readlane(iv, 0)) + __builtin_bit_cast(float, __builtin_amdgcn_readlane(iv, 16))) +
         (__builtin_bit_cast(float, __builtin_amdgcn_readlane(iv, 32)) + __builtin_bit_cast(float, __builtin_amdgcn_readlane(iv, 48)));
}
__device__ __forceinline__ int fresh_lane() { int l; asm volatile("v_mbcnt_lo_u32_b32 %0, -1, 0\n\tv_mbcnt_hi_u32_b32 %0, -1, %0" : "=v"(l)); return l; }
__device__ __forceinline__ float uniformf(float v) { return __builtin_bit_cast(float, __builtin_amdgcn_readfirstlane(__builtin_bit_cast(int, v))); }
__device__ __forceinline__ float sum_x32(float v) { const auto rr = __builtin_amdgcn_permlane32_swap(__float_as_uint(v), __float_as_uint(v), false, false); return __uint_as_float(rr[0]) + __uint_as_float(rr[1]); }
__device__ __forceinline__ float sum_x16(float v) { const auto rr = __builtin_amdgcn_permlane16_swap(__float_as_uint(v), __float_as_uint(v), false, false); return __uint_as_float(rr[0]) + __uint_as_float(rr[1]); }
__device__ __forceinline__ float sum_x16_32(float v) { return sum_x32(sum_x16(v)); }
__device__ __forceinline__ float sigmoidf_(float x) { return __builtin_amdgcn_rcpf(1.f + __builtin_amdgcn_exp2f(-1.44269504f * x)); }
__device__ __forceinline__ float tanhf_(float x) { return 1.f - 2.f * __builtin_amdgcn_rcpf(1.f + __builtin_amdgcn_exp2f(2.88539008f * x)); }
__device__ __forceinline__ float softplusf_(float x) { return fmaxf(x, 0.f) + __logf(1.f + __expf(-fabsf(x))); }
__device__ __forceinline__ float gelu_tanh(float x) {
  float u = 0.7978845608028654f * (x + 0.044715f * x * x * x);
  return 0.5f * x * (1.f + tanhf(u));
}

constexpr size_t MiB = 1u << 20;
constexpr size_t WS_CTL = 0, CTL_ZERO_BYTES = 160 * 1024;
constexpr size_t WS_WIN = 1 * MiB;
constexpr size_t WS_WOUT = 7 * MiB;
constexpr size_t WS_WRKV = 9 * MiB;
constexpr size_t WS_WO = 15 * MiB;
constexpr size_t WS_WL1 = 17 * MiB;
constexpr size_t WS_WL2 = 19 * MiB;
constexpr size_t WS_WR = 20 * MiB;
constexpr size_t WS_RS = 20 * MiB + 640 * 1024;
constexpr size_t WS_EGU = 22 * MiB;
constexpr size_t WS_EDN = 54 * MiB;
constexpr size_t WS_ACT = 70 * MiB;
constexpr size_t WS_XN = WS_ACT;
constexpr size_t WS_H = WS_ACT + 32 * MiB;
constexpr size_t WS_GATES = WS_ACT + 120 * MiB;
constexpr size_t WS_CAT = WS_ACT + 122 * MiB;
constexpr size_t WS_KCMPB = WS_ACT + 154 * MiB;
constexpr size_t WS_VCMPB = WS_ACT + 155 * MiB;
constexpr size_t WS_CW1 = 21 * MiB + 256 * 1024;
constexpr size_t WS_XN2 = WS_ACT;
constexpr size_t WS_HID = WS_ACT + 32 * MiB;
constexpr size_t WS_Y1 = WS_EGU;
constexpr size_t WS_LIST = WS_ACT + 156 * MiB;
constexpr size_t WS_PGATE = WS_ACT + 158 * MiB;
constexpr size_t WS_X3 = WS_ACT + 64 * MiB;
constexpr size_t WS_XN2F = WS_ACT;
constexpr size_t WS_GUF = WS_ACT + 64 * MiB;
constexpr size_t WS_S0 = WS_ACT;
constexpr size_t WS_TMP = WS_ACT + 192 * MiB;
constexpr size_t WS_END = WS_ACT + 204 * MiB;
constexpr size_t SLOT = 32 * MiB;
constexpr int CW_BAR = 4096;
constexpr int CW_CNT = 32768;

namespace pg8 {
#define PG8_LAS __attribute__((address_space(3)))
typedef unsigned u32x4 __attribute__((ext_vector_type(4)));
constexpr int BM = 256, BK = 64, HALF = 128, HTB = HALF * BK * 2  , STAGE_BYTES = 8 * HTB, NXCD = 8, WGM = 8;

__host__ __device__ __forceinline__ int lds_byte(int r, int c) { const int st = (r >> 4) * 2 + (c >> 5), rr = r & 15, cc = c & 31, ob = rr * 64 + cc * 2; return st * 1024 + (ob ^ (((ob >> 9) & 1) << 5)); }
__host__ __device__ __forceinline__ void stage_rc(int b, int& R, int& C) { const int st = b / 1024, sb = b % 1024, swz = sb ^ (((sb >> 9) & 1) << 5); R = (st >> 1) * 16 + swz / 64; C = (st & 1) * 32 + (swz % 64) / 2; }
__host__ __device__ __forceinline__ int perm32(int rho) { const int n = rho >> 4, i = rho & 15; return 8 * (i >> 2) + 4 * n + (i & 3); }

struct Unit { int pm, pn, e, nrows, rt, par; };
struct Gemm { const bf16_t* A; const bf16_t* Bt; int K; int lda; };

__device__ __forceinline__ void static_map(int L, int nM, int nN, int& pm, int& pn) {
    const int nwg = nM * nN;
    int wgid = L; { const int q = nwg / NXCD, r = nwg % NXCD, xcd = wgid % NXCD, off = wgid / NXCD; wgid = (xcd < r ? xcd * (q + 1) : r * (q + 1) + (xcd - r) * q) + off; }
    const int nig = WGM * nN, gid = wgid / nig, fm = gid * WGM, gsz = (nM - fm) < WGM ? (nM - fm) : WGM;
    pm = fm + ((wgid % nig) % gsz); pn = (wgid % nig) / gsz;
}
struct StaticOrder {
    int nM, nN, G, c;
    __device__ void init(int M, int N, int G_, int c_) { nM = M / BM; nN = N / BM; G = G_; c = c_; }
    __device__ __forceinline__ bool next(int i, Unit& u) const {
        const int L = i * G + c; if (L >= nM * nN) return false;
        static_map(L, nM, nN, u.pm, u.pn); u.e = 0; u.nrows = 256; u.rt = 0; return true;
    }
    __device__ __forceinline__ unsigned rowoff(const Unit& u, int r, int C, int K) const { return (unsigned)((u.pm * BM + r) * K + C) * 2u; }
};
struct TallOrder {
    int nM, nN, G, c;
    __device__ void init(int ngemm, int nN_, int G_, int c_) { nM = 64 * ngemm; nN = nN_; G = G_; c = c_; }
    __device__ __forceinline__ bool next(int i, Unit& u) const {
        const int L = i * G + c; if (L >= nM * nN) return false;
        int pn; static_map(L, nM, nN, u.pm, pn); u.pn = (u.pm >> 6) * nN + pn; u.e = 0; u.nrows = 256; u.rt = 0; return true;
    }
    __device__ __forceinline__ unsigned rowoff(const Unit& u, int r, int C, int K) const { return (unsigned)((u.pm * BM + r) * K + C) * 2u; }
};


template <int NCOL, bool GATHER>
struct MoeOrder {
    const PG8_LAS int* tab;
    const int* list; int G, c;
    __device__ __forceinline__ bool next(int i, Unit& u) const {
        const int L = i * G + c; const int R = L / NCOL, j = L - R * NCOL;
        if (R >= tab[32]) return false;
        int e = 0;
#pragma unroll
        for (int s = 16; s >= 1; s >>= 1) { if (tab[e + s] <= R) e += s; }
        const int ce = tab[33 + e];
        u.pm = R; u.rt = R - tab[e]; u.e = e; u.pn = e * NCOL + j; u.nrows = ce - u.rt * 256; return true;
    }
    __device__ __forceinline__ unsigned rowoff(const Unit& u, int r, int C, int K) const {
        if (GATHER) { const int idx = (r < u.nrows) ? u.rt * 256 + r : 0; const int pr = list[(size_t)u.e * CAP + idx]; return (unsigned)((pr >> 1) * K + C) * 2u; }
        return (unsigned)((u.pm * BM + r) * K + C) * 2u;
    }
};
__device__ __forceinline__ void moe_order_setup(PG8_LAS int* tab, const unsigned* cnt) {
    if (threadIdx.x < 32) tab[33 + threadIdx.x] = (int)__hip_atomic_load(cnt + threadIdx.x * 64, __ATOMIC_RELAXED, __HIP_MEMORY_SCOPE_AGENT);
    __syncthreads();
    if (threadIdx.x == 0) { int pre = 0; for (int e = 0; e < 32; ++e) { tab[e] = pre; pre += (tab[33 + e] + 255) >> 8; } tab[32] = pre; }
    __syncthreads();
}

__device__ __forceinline__ unsigned cvt_pk_bf16(float lo, float hi) { unsigned r; asm volatile("v_cvt_pk_bf16_f32 %0, %1, %2" : "=v"(r) : "v"(lo), "v"(hi)); return r; }
__device__ __forceinline__ u32x4 pack8(const f32x4& a, const f32x4& b) { u32x4 w; w.x = cvt_pk_bf16(a[0], a[1]); w.y = cvt_pk_bf16(a[2], a[3]); w.z = cvt_pk_bf16(b[0], b[1]); w.w = cvt_pk_bf16(b[2], b[3]); return w; }

template <class Epi, class Sched, bool ALIGN_EPI>
__device__ __forceinline__ void gemm_phase(PG8_LAS unsigned char* lds, const Gemm g, const Sched& S, const Epi& E) {
    const int tid = threadIdx.x, wid = __builtin_amdgcn_readfirstlane(tid >> 6), lane = tid & 63, wr = wid >> 2, wc = wid & 3, fr = lane & 15, fq = lane >> 4;
    const int K = g.K, nt = K / BK;
    int RA[2], CA[2]; unsigned voffB[2];
#pragma unroll
    for (int i = 0; i < 2; ++i) { int R, C; stage_rc(tid * 16 + i * 8192, R, C); const int Rb = Epi::PERM ? ((R & ~31) + perm32(R & 31)) : R;
        RA[i] = R; CA[i] = C; voffB[i] = (unsigned)(Rb * K + C) * 2u; }
    const size_t kstep = (size_t)(BK * 2);
    const size_t hstep = (size_t)HALF * K * 2;
    const size_t tstep = 2 * hstep;
    const unsigned ldsw = (unsigned)wid * 1024u;
    const int aoff = lds_byte(wr * 64 + fr, fq * 8), boff = lds_byte(wc * 32 + fr, fq * 8);
    const char* const Abase = (const char*)g.A;
#define PG8_SA(b, h) (((b) * 2 + (h)) * HTB)
#define PG8_SB(b, h) ((4 + (b) * 2 + (h)) * HTB)
#define PG8_STAGE(bufoff, gbase, voff) do { _Pragma("unroll") for (int _i = 0; _i < 2; ++_i) \
        __builtin_amdgcn_global_load_lds((const unsigned*)((const char*)(gbase) + (voff)[_i]), (PG8_LAS unsigned*)(lds + (bufoff) + ldsw + _i * 8192), 16, 0, 0); } while (0)
#define PG8_STAGEA(bufoff, kbyte, o0, o1) do { \
        __builtin_amdgcn_global_load_lds((const unsigned*)(Abase + (size_t)(kbyte) + (o0)), (PG8_LAS unsigned*)(lds + (bufoff) + ldsw), 16, 0, 0); \
        __builtin_amdgcn_global_load_lds((const unsigned*)(Abase + (size_t)(kbyte) + (o1)), (PG8_LAS unsigned*)(lds + (bufoff) + ldsw + 8192), 16, 0, 0); } while (0)
#define PG8_LDA(dst, b, h) do { _Pragma("unroll") for (int m = 0; m < 4; ++m) _Pragma("unroll") for (int k = 0; k < 2; ++k) dst[m][k] = *(const PG8_LAS bf16x8*)(lds + PG8_SA(b, h) + aoff + m * 2048 + k * 1024); } while (0)
#define PG8_LDB(dst, b, h) do { _Pragma("unroll") for (int n = 0; n < 2; ++n) _Pragma("unroll") for (int k = 0; k < 2; ++k) dst[n][k] = *(const PG8_LAS bf16x8*)(lds + PG8_SB(b, h) + boff + n * 2048 + k * 1024); } while (0)
#define PG8_MMA(ai, bj, At, Bt) do { __builtin_amdgcn_s_setprio(1); _Pragma("unroll") for (int m = 0; m < 4; ++m) _Pragma("unroll") for (int n = 0; n < 2; ++n) _Pragma("unroll") for (int k = 0; k < 2; ++k) \
        acc[ai][bj][m][n] = __builtin_amdgcn_mfma_f32_16x16x32_bf16(Bt[n][k], At[m][k], acc[ai][bj][m][n], 0, 0, 0); __builtin_amdgcn_s_setprio(0); } while (0)
#define PG8_WAIT_V(n) asm volatile("s_waitcnt vmcnt(" #n ")" ::: "memory")
#define PG8_WAIT_L(n) asm volatile("s_waitcnt lgkmcnt(" #n ")" ::: "memory")
#define PG8_BAR __builtin_amdgcn_s_barrier()
#define PG8_SCHED __builtin_amdgcn_sched_barrier(0)
    Unit cur, nxt; int ui = 0;
    if (!S.next(0, cur)) return;
    cur.par = 0;
    if constexpr (Epi::HAS_PRE) E.pre(cur);
    f32x4 acc[2][2][4][2];
#pragma unroll
    for (int a = 0; a < 2; ++a)
#pragma unroll
        for (int b = 0; b < 2; ++b)
#pragma unroll
            for (int m = 0; m < 4; ++m)
#pragma unroll
                for (int n = 0; n < 2; ++n) acc[a][b][m][n] = (f32x4){0.f, 0.f, 0.f, 0.f};
    bf16x8 At[4][2], B0[2][2], B1[2][2];
    unsigned c00 = S.rowoff(cur, RA[0], CA[0], g.lda), c01 = S.rowoff(cur, RA[1], CA[1], g.lda), c10 = S.rowoff(cur, HALF + RA[0], CA[0], g.lda), c11 = S.rowoff(cur, HALF + RA[1], CA[1], g.lda);
    unsigned n00, n01, n10, n11;
    const char* cB = (const char*)g.Bt + (size_t)cur.pn * tstep;
    PG8_STAGE(PG8_SB(0, 0), cB, voffB); PG8_STAGE(PG8_SB(0, 1), cB + hstep, voffB); PG8_STAGEA(PG8_SA(0, 0), 0, c00, c01); PG8_STAGEA(PG8_SA(0, 1), 0, c10, c11);
    if (wr == 1) PG8_BAR;
    PG8_WAIT_V(2); PG8_BAR;
    PG8_STAGE(PG8_SB(1, 0), cB + kstep, voffB); PG8_STAGEA(PG8_SA(1, 0), kstep, c00, c01); PG8_STAGE(PG8_SB(1, 1), cB + hstep + kstep, voffB);
    PG8_WAIT_V(6); PG8_BAR;
    for (;;) {
        const bool has_next = S.next(ui + 1, nxt);
        const char* nB = has_next ? (const char*)g.Bt + (size_t)nxt.pn * tstep : cB;
        if (has_next) { n00 = S.rowoff(nxt, RA[0], CA[0], g.lda); n01 = S.rowoff(nxt, RA[1], CA[1], g.lda); n10 = S.rowoff(nxt, HALF + RA[0], CA[0], g.lda); n11 = S.rowoff(nxt, HALF + RA[1], CA[1], g.lda); }
        else { n00 = c00; n01 = c01; n10 = c10; n11 = c11; }
        for (int t = 0; t < nt; t += 2) {
            const bool last = (t == nt - 2);
            const size_t k1 = (size_t)(t + 1) * kstep;
            const size_t k2 = last ? 0 : (size_t)(t + 2) * kstep;
            const size_t k3 = k2 + kstep;
            const unsigned a00 = last ? n00 : c00, a01 = last ? n01 : c01, a10 = last ? n10 : c10, a11 = last ? n11 : c11;
            const char* b2 = last ? nB : cB + (size_t)(t + 2) * kstep;
            const char* b3 = b2 + kstep;
            PG8_LDB(B0, 0, 0); PG8_LDB(B1, 0, 1); PG8_SCHED; PG8_LDA(At, 0, 0); PG8_STAGEA(PG8_SA(1, 1), k1, c10, c11);
            PG8_WAIT_V(8); PG8_WAIT_L(0); PG8_BAR; PG8_MMA(0, 0, At, B0); PG8_MMA(0, 1, At, B1); PG8_BAR; PG8_SCHED;
            PG8_LDA(At, 0, 1); PG8_STAGE(PG8_SB(0, 0), b2, voffB); PG8_STAGE(PG8_SB(0, 1), b2 + hstep, voffB); PG8_STAGEA(PG8_SA(0, 0), k2, a00, a01);
            PG8_WAIT_V(8); PG8_WAIT_L(0); PG8_BAR; PG8_MMA(1, 0, At, B0); PG8_MMA(1, 1, At, B1); PG8_BAR; PG8_SCHED;
            PG8_LDB(B0, 1, 0); PG8_LDB(B1, 1, 1); PG8_SCHED; PG8_LDA(At, 1, 0); PG8_STAGEA(PG8_SA(0, 1), k2, a10, a11);
            PG8_WAIT_V(8); PG8_WAIT_L(0); PG8_BAR; PG8_MMA(0, 0, At, B0); PG8_MMA(0, 1, At, B1); PG8_BAR; PG8_SCHED;
            PG8_LDA(At, 1, 1); PG8_STAGE(PG8_SB(1, 0), b3, voffB); PG8_STAGE(PG8_SB(1, 1), b3 + hstep, voffB); PG8_STAGEA(PG8_SA(1, 0), k3, a00, a01);
            PG8_WAIT_V(8); PG8_WAIT_L(0); PG8_BAR; PG8_MMA(1, 0, At, B0); PG8_MMA(1, 1, At, B1); PG8_BAR; PG8_SCHED;
        }
        if constexpr (ALIGN_EPI) { if (wr == 0) PG8_BAR; }
        E(acc, cur, wr, wc, fr, fq);
        if (!has_next) break;
#pragma unroll
        for (int a = 0; a < 2; ++a)
#pragma unroll
            for (int b = 0; b < 2; ++b)
#pragma unroll
                for (int m = 0; m < 4; ++m)
#pragma unroll
                    for (int n = 0; n < 2; ++n) acc[a][b][m][n] = (f32x4){0.f, 0.f, 0.f, 0.f};
        cur = nxt; cB = nB; c00 = n00; c01 = n01; c10 = n10; c11 = n11; ++ui; cur.par = ui & 1;
        if constexpr (Epi::HAS_PRE) E.pre(cur);
        if constexpr (ALIGN_EPI) { if (wr == 1) PG8_BAR; }
    }
    PG8_WAIT_V(0);
    if constexpr (!ALIGN_EPI) { if (wr == 0) PG8_BAR; }
    PG8_BAR;
#undef PG8_SA
#undef PG8_SB
#undef PG8_STAGE
#undef PG8_STAGEA
#undef PG8_LDA
#undef PG8_LDB
#undef PG8_MMA
#undef PG8_WAIT_V
#undef PG8_WAIT_L
#undef PG8_BAR
#undef PG8_SCHED
}
}

#define XB_TMO      128
#define XB_XCNT(j)  (256  + 64 * (j))
#define XB_XSUB(j)  (1280 + 64 * (j))
#define XB_XGEN(j)  (2304 + 64 * (j))
#define XB_TOP      3328
#define XB_TOPGEN   3392
#define XCD_BAR_WORDS 3456
#define XB_SPIN_CAP (1u << 18)

__device__ __forceinline__ unsigned xb_ld(unsigned* p)              { return __hip_atomic_load(p, __ATOMIC_RELAXED, __HIP_MEMORY_SCOPE_AGENT); }
__device__ __forceinline__ unsigned xb_add(unsigned* p, unsigned v) { return __hip_atomic_fetch_add(p, v, __ATOMIC_RELAXED, __HIP_MEMORY_SCOPE_AGENT); }
__device__ __forceinline__ unsigned xb_xcc_id() { return (unsigned)__builtin_amdgcn_s_getreg((3 << 11) | 20) & 0xFu; }
#define XB_SPIN(cond, bar) do { unsigned _sp = 0; while (cond) { __builtin_amdgcn_s_sleep(1); \
    if ((++_sp & 255u) == 0u) { if (xb_ld(&(bar)[XB_TMO])) break; if (_sp > XB_SPIN_CAP) { atomicAdd(&(bar)[XB_TMO], 1u); break; } } } } while (0)

struct XcdBarrier {
    unsigned* bar; unsigned x;
    volatile LAS unsigned* st;
};

__device__ __forceinline__ XcdBarrier xcd_barrier_post(unsigned* bar, volatile LAS unsigned* st) {
    XcdBarrier b; b.bar = bar; b.x = xb_xcc_id(); b.st = st;
    if (threadIdx.x == 0) (void)xb_add(&bar[XB_XCNT(b.x)], 1u);
    return b;
}
__device__ __forceinline__ void xcd_barrier_complete(unsigned* bar, unsigned x, unsigned& nloc, unsigned& nx) {
    const unsigned G = gridDim.x * gridDim.y * gridDim.z;
    unsigned sum, cnt, mine, sp = 0u;
    for (;;) {
        sum = 0u; cnt = 0u; mine = 0u;
#pragma unroll
        for (unsigned j = 0; j < 16; ++j) { const unsigned c = xb_ld(&bar[XB_XCNT(j)]); sum += c; cnt += (c > 0u) ? 1u : 0u; mine = (j == x) ? c : mine; }
        if (sum == G) break;
        __builtin_amdgcn_s_sleep(1);
        if ((++sp & 255u) == 0u) { if (xb_ld(&bar[XB_TMO])) break; if (sp > XB_SPIN_CAP) { atomicAdd(&bar[XB_TMO], 1u); break; } }
    }
    nloc = mine > 0u ? mine : 1u; nx = cnt > 0u ? cnt : 1u;
}

__device__ __forceinline__ void xcd_barrier(const XcdBarrier& b) {
    asm volatile("s_waitcnt vmcnt(0)" ::: "memory");
    __syncthreads();
    if (threadIdx.x == 0) {
        unsigned* bar = b.bar;
        __builtin_amdgcn_s_waitcnt(0);
        unsigned nloc = b.st[0], nx = b.st[1];
        if (nloc == 0u) { xcd_barrier_complete(bar, b.x, nloc, nx); b.st[0] = nloc; b.st[1] = nx; }
        const unsigned old = xb_add(&bar[XB_XSUB(b.x)], 1u);
        const unsigned gen = old / nloc;
        if (old + 1u == (gen + 1u) * nloc) {
            __builtin_amdgcn_fence(__ATOMIC_RELEASE, "agent");
            asm volatile("s_waitcnt vmcnt(0)" ::: "memory");
            const unsigned og = xb_add(&bar[XB_TOP], 1u);
            const unsigned tg = og / nx;
            if (og + 1u == (tg + 1u) * nx) xb_add(&bar[XB_TOPGEN], 1u);
            else XB_SPIN(xb_ld(&bar[XB_TOPGEN]) == tg, bar);
            __builtin_amdgcn_fence(__ATOMIC_ACQUIRE, "agent");
            xb_add(&bar[XB_XGEN(b.x)], 1u);
            asm volatile("s_waitcnt vmcnt(0)" ::: "memory");
        } else {
            XB_SPIN(xb_ld(&bar[XB_XGEN(b.x)]) == gen, bar);
            __builtin_amdgcn_fence(__ATOMIC_ACQUIRE, "agent");
            asm volatile("s_waitcnt vmcnt(0)" ::: "memory");
        }
    }
    __syncthreads();
}
struct P {
  const float* x; const float* mix_norm; const float* w_in; const float* gate_bias;
  const float* dq_norm; const float* dk_norm; const float* dlam; const float* dsubln;
  const float* nq_norm; const float* nk_norm; const float* cmp_pe; const float* cmp_w1; const float* cmp_w2;
  const float* w_out;
  const float* rmix; const float* w_r; const float* w_k; const float* w_v;
  const float* w0; const float* w1; const float* w2; const float* a0; const float* a1; const float* a2;
  const float* g1; const float* g2; const float* k_k; const float* k_a; const float* r_k;
  const float* ln_w; const float* ln_b; const float* w_o;
  const float* ffn_norm; const float* rg_w; const float* rg_b; const float* re_w; const float* re_b;
  const float* e_gate; const float* e_up; const float* e_down;
  float* out;
  unsigned char* ws;
  int ph_lo, ph_hi, layer, pad;
};

#define PREF const __attribute__((address_space(4))) P&
__device__ __forceinline__ const __attribute__((address_space(4))) P* opaque_kernarg() { auto q = __builtin_amdgcn_kernarg_segment_ptr(); asm volatile("" : "+s"(q)); return (const __attribute__((address_space(4))) P*)q; }
#define KP (*opaque_kernarg())

constexpr int RING_OFF = 0, RING_BYTES = 131072;
constexpr int LDSCTL_OFF = RING_BYTES, MISC_OFF = LDSCTL_OFF + 320;
constexpr int LDS_BYTES = 147456;
constexpr int NWAVES = 8;

struct Frame {
  LAS unsigned char* lds;
  volatile LAS unsigned* MISC;
  gu32* ctl;
  int tid, lane, wave, vcu, G;
#ifdef PROBE_PH
  unsigned long long pr_t0, pr_t1;
#endif
};
#ifdef PROBE_PH
#define PROBE_MARK(k) do { if ((k) == PROBE_PH) F.pr_t0 = __builtin_amdgcn_s_memrealtime(); if ((k) == PROBE_PH + PROBE_N) F.pr_t1 = __builtin_amdgcn_s_memrealtime(); } while (0)
#else
#define PROBE_MARK(k) do {} while (0)
#endif

__device__ __forceinline__ void transpose_item(const float* W, int ldsrc, int k0, int c0, int ncols, bf16_t* dst, int ldk, int drow0, LAS float* scr, int lane, const float* kscale = nullptr) {
  const int kr = lane >> 3, c4 = (lane & 7) * 4;
  f32x4 v[8];
#pragma unroll
  for (int i = 0; i < 8; ++i) v[i] = (c4 < ncols) ? *(const GAS f32x4*)(W + (size_t)(k0 + kr + 8 * i) * ldsrc + c0 + c4) : (f32x4){0.f, 0.f, 0.f, 0.f};
  if (kscale) {
#pragma unroll
    for (int i = 0; i < 8; ++i) v[i] = v[i] * kscale[k0 + kr + 8 * i]; }
#pragma unroll
  for (int i = 0; i < 8; ++i) { LAS float* s = scr + (kr + 8 * i) * 33 + c4; s[0] = v[i].x; s[1] = v[i].y; s[2] = v[i].z; s[3] = v[i].w; }
  LDS_WAIT(); asm volatile("" ::: "memory");
  const int c = lane & 7;
#pragma unroll
  for (int j = 0; j < 4; ++j) { const int n = (lane >> 3) + 8 * j; const LAS float* s = scr + (8 * c) * 33 + n;
    v4u o; o.x = pk2(s[0 * 33], s[1 * 33]); o.y = pk2(s[2 * 33], s[3 * 33]); o.z = pk2(s[4 * 33], s[5 * 33]); o.w = pk2(s[6 * 33], s[7 * 33]);
    *(GAS v4u*)(dst + (size_t)(drow0 + n) * ldk + k0 + 8 * c) = o; }
  LDS_WAIT(); asm volatile("" ::: "memory");
}
template <int NR>
__device__ __forceinline__ void rms_rows_to_bf16(const float* x, const float* gain, bf16_t* o, int m0, int stride, int lane) {
  f32x4 v[NR][4];
#pragma unroll
  for (int r = 0; r < NR; ++r) { const GAS f32x4* xr = (const GAS f32x4*)(x + (size_t)(m0 + r * stride) * DM) + lane;
#pragma unroll
    for (int j = 0; j < 4; ++j) v[r][j] = xr[64 * j]; }
  const GAS f32x4* gr = (const GAS f32x4*)gain + lane;
  f32x4 g[4];
#pragma unroll
  for (int j = 0; j < 4; ++j) g[j] = gr[64 * j];
#pragma unroll
  for (int r = 0; r < NR; ++r) {
    float s = 0.f;
#pragma unroll
    for (int j = 0; j < 4; ++j) s += (v[r][j].x * v[r][j].x + v[r][j].y * v[r][j].y) + (v[r][j].z * v[r][j].z + v[r][j].w * v[r][j].w);
    const float rr = rsqrtf(wave_sum_dpp(s) * (1.f / DM) + 1e-6f);
    GAS v2u* o8 = (GAS v2u*)(o + (size_t)(m0 + r * stride) * DM) + lane;
#pragma unroll
    for (int j = 0; j < 4; ++j) { v2u w; w.x = pk2(v[r][j].x * rr * g[j].x, v[r][j].y * rr * g[j].y); w.y = pk2(v[r][j].z * rr * g[j].z, v[r][j].w * rr * g[j].w); o8[64 * j] = w; }
  }
}

__device__ __forceinline__ void conv_win_item(PREF p, int it, LAS float* scr, int lane) {
  const int vg = it >> 4, kb = it & 15;
  const int pn = vg >> 3, bj = (vg >> 2) & 1, wc = vg & 3, s = pn * 4 + wc;
  int c0 = 0, nc = 0;
  if (s < 44) { c0 = 64 * s + 32 * bj; nc = 32; } else if (s == 44 && bj == 0) { c0 = OFF_NG; nc = 24; }
  transpose_item(p.w_in, INC, kb * 64, c0, nc, (bf16_t*)(p.ws + WS_WIN), DM, vg * 32, scr, lane);
}
__device__ __forceinline__ void conv_sq_item(const float* W, bf16_t* dst, int drow_base, int it, LAS float* scr, int lane) {
  const int cg = it >> 4, kb = it & 15;
  transpose_item(W, DM, kb * 64, cg * 32, 32, dst, DM, drow_base + cg * 32, scr, lane);
}
__device__ __forceinline__ void conv_expert_item(PREF p, int layer, int it, LAS float* scr, int lane, bf16_t* egu) {
  const int e = it / 384, r = it % 384;
  if (r < 256) {
    const int up = r >> 7, q = r & 127, cgp = q >> 4, kb = q & 15;
    const int pn = cgp >> 2, qq = cgp & 3;
    const float* W = (up ? p.e_up : p.e_gate) + ((size_t)layer * 32 + e) * DM * 256;
    transpose_item(W, 256, kb * 64, cgp * 32, 32, egu, DM, e * 512 + pn * 256 + up * 128 + qq * 32, scr, lane, p.ffn_norm + layer * DM);
  } else {
    const int q = r - 256, cg = q >> 2, kb = q & 3;
    const float* W = p.e_down + ((size_t)layer * 32 + e) * 256 * DM;
    transpose_item(W, DM, kb * 64, cg * 32, 32, (bf16_t*)(p.ws + WS_EDN), 256, e * 1024 + cg * 32, scr, lane);
  }
}

using pg8::Unit; using pg8::u32x4; using pg8::pack8;
struct EpiInProj {
  static constexpr bool PERM = true, HAS_PRE = false;
  bf16_t* H; float* GATES; const float* dq; const float* dk; const float* nq; const float* nk; const float* gbias;
  __device__ __forceinline__ void operator()(const f32x4 (&acc)[2][2][4][2], const Unit& u, int wr, int wc, int fr, int fq) const {
    const int s = u.pn * 4 + wc;
    if (s > 44) return;
    const int row0 = u.pm * 256 + wr * 64 + fr;
    if (s == 44) {
      if (fq < 3) {
        f32x4 b0 = *(const f32x4*)(gbias + 8 * fq), b1 = *(const f32x4*)(gbias + 8 * fq + 4);
#pragma unroll
        for (int ai = 0; ai < 2; ++ai)
#pragma unroll
          for (int m = 0; m < 4; ++m) { float* gp = GATES + (size_t)(row0 + ai * 128 + m * 16) * 24 + 8 * fq;
            f32x4 v0 = acc[ai][0][m][0] + b0, v1 = acc[ai][0][m][1] + b1;
#pragma unroll
            for (int i = 0; i < 4; ++i) { v0[i] = sigmoidf_(v0[i]); v1[i] = sigmoidf_(v1[i]); }
            *(f32x4*)gp = v0; *(f32x4*)(gp + 4) = v1; }
      }
      return;
    }
    int mode = 0; const float* gain = nullptr;
    if (s < 8) { mode = 1; gain = dq; } else if (s < 16) { mode = 1; gain = dk; }
    else if (s >= 24 && s < 32) { mode = 2; gain = nq; }
    else if (s >= 32) { const int q = s - 32, br = q >> 2, kv = (q >> 1) & 1; if (kv == 0 && br >= 1) { mode = 2; gain = nk + br * 64; } }
    const float qsc = (s < 8) ? 0.17677669529663687f * 1.4426950408889634f : ((s >= 24 && s < 32) ? 0.125f * 1.4426950408889634f : 1.f);
    f32x4 g[2][2];
#pragma unroll
    for (int bj = 0; bj < 2; ++bj)
#pragma unroll
      for (int n = 0; n < 2; ++n) {
        if (mode == 1) g[bj][n] = *(const f32x4*)(gain + 8 * fq + 4 * n);
        else if (mode == 2) g[bj][n] = *(const f32x4*)(gain + 32 * bj + 8 * fq + 4 * n);
        else g[bj][n] = (f32x4){1.f, 1.f, 1.f, 1.f};
      }
#pragma unroll
    for (int ai = 0; ai < 2; ++ai)
#pragma unroll
      for (int m = 0; m < 4; ++m) {
        float sc[2] = {1.f, 1.f};
        if (mode != 0) {
          float ss[2];
#pragma unroll
          for (int bj = 0; bj < 2; ++bj) { const f32x4 a = acc[ai][bj][m][0], b = acc[ai][bj][m][1];
            float t = (a[0] * a[0] + a[1] * a[1]) + (a[2] * a[2] + a[3] * a[3]) + (b[0] * b[0] + b[1] * b[1]) + (b[2] * b[2] + b[3] * b[3]);
            ss[bj] = sum_x16_32(t); }
          if (mode == 1) { sc[0] = rsqrtf(ss[0] * (1.f / 32.f) + 1e-6f) * qsc; sc[1] = rsqrtf(ss[1] * (1.f / 32.f) + 1e-6f) * qsc; }
          else { const float r = rsqrtf((ss[0] + ss[1]) * (1.f / 64.f) + 1e-6f) * qsc; sc[0] = r; sc[1] = r; }
        }
        bf16_t* rowp = H + (size_t)(row0 + ai * 128 + m * 16) * HC + 64 * s + 8 * fq;
#pragma unroll
        for (int bj = 0; bj < 2; ++bj) { const f32x4 v0 = acc[ai][bj][m][0] * sc[bj] * g[bj][0], v1 = acc[ai][bj][m][1] * sc[bj] * g[bj][1];
          *(u32x4*)(rowp + 32 * bj) = pack8(v0, v1); }
      }
  }
};
struct EpiResid {
  static constexpr bool PERM = true, HAS_PRE = false;
  const float* xf; const bf16_t* xb; bf16_t* out; const bf16_t* y1;
  __device__ __forceinline__ void operator()(const f32x4 (&acc)[2][2][4][2], const Unit& u, int wr, int wc, int fr, int fq) const {
    const int row0 = u.pm * 256 + wr * 64 + fr, col0 = u.pn * 256 + wc * 32 + 8 * fq;
#pragma unroll
    for (int ai = 0; ai < 2; ++ai)
#pragma unroll
      for (int m = 0; m < 4; ++m) { const size_t off = (size_t)(row0 + ai * 128 + m * 16) * DM + col0;
#pragma unroll
        for (int bj = 0; bj < 2; ++bj) {
          f32x4 b0, b1;
          if (xf) { b0 = *(const f32x4*)(xf + off + bj * 128); b1 = *(const f32x4*)(xf + off + bj * 128 + 4); }
          else { const v4u w = *(const v4u*)(xb + off + bj * 128);
            b0 = (f32x4){__uint_as_float(w.x << 16), __uint_as_float(w.x & 0xffff0000u), __uint_as_float(w.y << 16), __uint_as_float(w.y & 0xffff0000u)};
            b1 = (f32x4){__uint_as_float(w.z << 16), __uint_as_float(w.z & 0xffff0000u), __uint_as_float(w.w << 16), __uint_as_float(w.w & 0xffff0000u)}; }
          if (y1) { const v4u w = *(const v4u*)(y1 + off + bj * 128);
            b0 += (f32x4){__uint_as_float(w.x << 16), __uint_as_float(w.x & 0xffff0000u), __uint_as_float(w.y << 16), __uint_as_float(w.y & 0xffff0000u)};
            b1 += (f32x4){__uint_as_float(w.z << 16), __uint_as_float(w.z & 0xffff0000u), __uint_as_float(w.w << 16), __uint_as_float(w.w & 0xffff0000u)}; }
          *(u32x4*)(out + off + bj * 128) = pack8(b0 + acc[ai][bj][m][0], b1 + acc[ai][bj][m][1]); asm volatile("" ::: "memory"); } }
  }
};
struct EpiRKV {
  static constexpr bool PERM = true, HAS_PRE = false;
  unsigned char* ws;
  __device__ __forceinline__ void operator()(const f32x4 (&acc)[2][2][4][2], const Unit& u, int wr, int wc, int fr, int fq) const {
    const int gi = u.pm >> 6;
    bf16_t* O = (bf16_t*)(ws + WS_S0 + (size_t)(3 + gi) * SLOT);
    const int row0 = (u.pm & 63) * 256 + wr * 64 + fr, col0 = (u.pn & 3) * 256 + wc * 32 + 8 * fq;
#pragma unroll
    for (int ai = 0; ai < 2; ++ai)
#pragma unroll
      for (int m = 0; m < 4; ++m) { bf16_t* rowp = O + (size_t)(row0 + ai * 128 + m * 16) * DM + col0;
#pragma unroll
        for (int bj = 0; bj < 2; ++bj) *(u32x4*)(rowp + bj * 128) = pack8(acc[ai][bj][m][0], acc[ai][bj][m][1]); }
  }
};
struct EpiLora1 {
  static constexpr bool PERM = true, HAS_PRE = false;
  bf16_t* TMP;
  template <int BJ>
  __device__ __forceinline__ void half(const f32x4 (&acc)[2][2][4][2], int gi, int row0, int wc, int fq) const {
    const int c = BJ * 128 + wc * 32 + 8 * fq;
    const bool skip = (gi < 2) && (c >= 64);
    const int dcol = (gi < 2) ? gi * 64 + c : 128 + c;
    const bool zero = (gi == 2) && (c >= 160);
    if (skip) return;
#pragma unroll
    for (int ai = 0; ai < 2; ++ai)
#pragma unroll
      for (int m = 0; m < 4; ++m) {
        f32x4 v0 = acc[ai][BJ][m][0], v1 = acc[ai][BJ][m][1];
#pragma unroll
        for (int i = 0; i < 4; ++i) {
          if (gi == 0) { v0[i] = tanhf_(v0[i]); v1[i] = tanhf_(v1[i]); }
          else if (gi == 2) { v0[i] = zero ? 0.f : sigmoidf_(v0[i]); v1[i] = zero ? 0.f : sigmoidf_(v1[i]); }
        }
        *(u32x4*)(TMP + (size_t)(row0 + ai * 128 + m * 16) * 384 + dcol) = pack8(v0, v1);
      }
  }
  __device__ __forceinline__ void operator()(const f32x4 (&acc)[2][2][4][2], const Unit& u, int wr, int wc, int fr, int fq) const {
    const int gi = u.pm >> 6;
    const int row0 = (u.pm & 63) * 256 + wr * 64 + fr;
    half<0>(acc, gi, row0, wc, fq);
    half<1>(acc, gi, row0, wc, fq);
  }
};
struct EpiLora2 {
  static constexpr bool PERM = true, HAS_PRE = false;
  unsigned char* ws; const float* w0; const float* a0; int gbase;
  __device__ __forceinline__ void operator()(const f32x4 (&acc)[2][2][4][2], const Unit& u, int wr, int wc, int fr, int fq) const {
    const int gi = gbase + (u.pn >> 2);
    bf16_t* O = (bf16_t*)(ws + WS_S0 + (size_t)gi * SLOT);
    const int row0 = u.pm * 256 + wr * 64 + fr, col0 = (u.pn & 3) * 256 + wc * 32 + 8 * fq;
    f32x4 b[2][2];
#pragma unroll
    for (int bj = 0; bj < 2; ++bj)
#pragma unroll
      for (int n = 0; n < 2; ++n) b[bj][n] = (gi == 0) ? *(const f32x4*)(w0 + col0 + bj * 128 + 4 * n) : (gi == 1 ? *(const f32x4*)(a0 + col0 + bj * 128 + 4 * n) : (f32x4){0.f, 0.f, 0.f, 0.f});
#pragma unroll
    for (int ai = 0; ai < 2; ++ai)
#pragma unroll
      for (int m = 0; m < 4; ++m) { bf16_t* rowp = O + (size_t)(row0 + ai * 128 + m * 16) * DM + col0;
#pragma unroll
        for (int bj = 0; bj < 2; ++bj) { f32x4 v0 = acc[ai][bj][m][0] + b[bj][0], v1 = acc[ai][bj][m][1] + b[bj][1];
          if (gi == 0) {
#pragma unroll
            for (int i = 0; i < 4; ++i) { v0[i] = -__expf(-softplusf_(-v0[i]) - 0.5f); v1[i] = -__expf(-softplusf_(-v1[i]) - 0.5f); }
          } else if (gi == 1) {
#pragma unroll
            for (int i = 0; i < 4; ++i) { v0[i] = sigmoidf_(v0[i]); v1[i] = sigmoidf_(v1[i]); }
          }
          *(u32x4*)(rowp + bj * 128) = pack8(v0, v1); } }
  }
};
struct EpiMoeGU {
  static constexpr bool PERM = true, HAS_PRE = false;
  bf16_t* HID; const int* list; const float* RS;
  __device__ __forceinline__ void operator()(const f32x4 (&acc)[2][2][4][2], const Unit& u, int wr, int wc, int fr, int fq) const {
    const int row0 = u.pm * 256 + wr * 64 + fr, col0 = (u.pn & 1) * 128 + wc * 32 + 8 * fq;
    const int* lp = list + (size_t)u.e * CAP + u.rt * 256;
#pragma unroll
    for (int ai = 0; ai < 2; ++ai)
#pragma unroll
      for (int m = 0; m < 4; ++m) {
        const int r = wr * 64 + fr + ai * 128 + m * 16;
        const float rs = RS[lp[(r < u.nrows) ? r : 0] >> 1];
        f32x4 h[2];
#pragma unroll
        for (int n = 0; n < 2; ++n) { const f32x4 g = acc[ai][0][m][n] * rs, up = acc[ai][1][m][n] * rs;
#pragma unroll
          for (int i = 0; i < 4; ++i) h[n][i] = g[i] * sigmoidf_(g[i]) * up[i]; }
        *(u32x4*)(HID + (size_t)(row0 + ai * 128 + m * 16) * 256 + col0) = pack8(h[0], h[1]);
      }
  }
};
struct EpiMoeDown {
  static constexpr bool PERM = false, HAS_PRE = true;
  bf16_t* out; bf16_t* Y1; const int* list; const float* pgate; LAS int* ept;
  __device__ __forceinline__ void pre(const Unit& u) const {
    const int r = threadIdx.x;
    if (r < 256) { int pr = -1; float gt = 0.f;
      if (r < u.nrows) { pr = list[(size_t)u.e * CAP + u.rt * 256 + r]; gt = pgate[pr]; }
      LAS int* e = ept + (u.par * 256 + r) * 2; e[0] = pr; e[1] = __float_as_int(gt); }
  }
  __device__ __forceinline__ void operator()(const f32x4 (&acc)[2][2][4][2], const Unit& u, int wr, int wc, int fr, int fq) const {
    const int col0 = (u.pn & 3) * 256 + wc * 32 + 4 * fq;
#pragma unroll
    for (int ai = 0; ai < 2; ++ai)
#pragma unroll
      for (int m = 0; m < 4; ++m) {
        const int r = ai * 128 + wr * 64 + m * 16 + fr;
        const LAS int* e = ept + (u.par * 256 + r) * 2;
        const int pr = e[0]; const float gt = __int_as_float(e[1]);
        if (pr >= 0) {
          const int tok = pr >> 1;
          if ((pr & 1) == 0) {
            bf16_t* op = out + (size_t)tok * DM + col0;
#pragma unroll
            for (int bj = 0; bj < 2; ++bj)
#pragma unroll
              for (int n = 0; n < 2; ++n) { const v2u w = *(const v2u*)(op + bj * 128 + n * 16);
                const f32x4 b = {__uint_as_float(w.x << 16), __uint_as_float(w.x & 0xffff0000u), __uint_as_float(w.y << 16), __uint_as_float(w.y & 0xffff0000u)};
                const f32x4 v = b + acc[ai][bj][m][n] * gt; v2u o; o.x = pk2(v[0], v[1]); o.y = pk2(v[2], v[3]); *(v2u*)(op + bj * 128 + n * 16) = o; }
          } else {
            bf16_t* yp = Y1 + (size_t)tok * DM + col0;
#pragma unroll
            for (int bj = 0; bj < 2; ++bj)
#pragma unroll
              for (int n = 0; n < 2; ++n) { const f32x4 v = acc[ai][bj][m][n] * gt; v2u w; w.x = pk2(v[0], v[1]); w.y = pk2(v[2], v[3]); *(v2u*)(yp + bj * 128 + n * 16) = w; }
          }
        }
      }
  }
};

typedef LAS bf16_t* lbf;
__device__ __forceinline__ void phase_prologue(PREF p, Frame& F) {
  const int lane = fresh_lane();
  LAS float* scr = (LAS float*)(F.lds + RING_OFF + F.wave * 16384);
  const int gw = F.vcu * NWAVES + F.wave, NGW = F.G * NWAVES;
  constexpr int I_WIN = 96 * 16, I_SQ = 32 * 16;
  constexpr int NITEMS = I_WIN + 5 * I_SQ + 128;
  for (int it = gw; it < NITEMS; it += NGW) {
    int r = it;
    if (r < I_WIN) { conv_win_item(p, r, scr, fresh_lane()); continue; } r -= I_WIN;
    if (r < I_SQ) { conv_sq_item(p.w_out, (bf16_t*)(p.ws + WS_WOUT), 0, r, scr, fresh_lane()); continue; } r -= I_SQ;
    if (r < I_SQ) { conv_sq_item(p.w_r, (bf16_t*)(p.ws + WS_WRKV), 0, r, scr, fresh_lane()); continue; } r -= I_SQ;
    if (r < I_SQ) { conv_sq_item(p.w_k, (bf16_t*)(p.ws + WS_WRKV), 1024, r, scr, fresh_lane()); continue; } r -= I_SQ;
    if (r < I_SQ) { conv_sq_item(p.w_v, (bf16_t*)(p.ws + WS_WRKV), 2048, r, scr, fresh_lane()); continue; } r -= I_SQ;
    if (r < I_SQ) { conv_sq_item(p.w_o, (bf16_t*)(p.ws + WS_WO), 0, r, scr, fresh_lane()); continue; } r -= I_SQ;
    { const int kv = r >> 6, q = r & 63, kb = q >> 1, cg = q & 1;
      transpose_item(p.cmp_w1 + (size_t)kv * 2048 * 64, 64, kb * 64, cg * 32, 32, (bf16_t*)(p.ws + WS_CW1) + (size_t)kv * 64 * 2048, 2048, cg * 32, scr, fresh_lane()); }
  }
  {
    const int gt = (F.vcu * NWAVES + F.wave) * 64 + fresh_lane(), NGT = NGW * 64;
    bf16_t* WL1 = (bf16_t*)(p.ws + WS_WL1);
    for (int i = gt; i < 768 * 1024; i += NGT) {
      const int n = i >> 10, k = i & 1023, gi = n >> 8, c = n & 255;
      float v = 0.f;
      if (gi == 0) { if (c < 64) v = p.w1[k * 64 + c]; }
      else if (gi == 1) { if (c < 64) v = p.a1[k * 64 + c]; }
      else { if (c < 160) v = p.g1[k * 160 + c]; }
      WL1[i] = (bf16_t)f2bf(v);
    }
    bf16_t* WL2w = (bf16_t*)(p.ws + WS_WL2);
    bf16_t* WL2a = (bf16_t*)(p.ws + WS_WL2 + 128 * 1024);
    bf16_t* WL2g = (bf16_t*)(p.ws + WS_WL2 + 256 * 1024);
    for (int i = gt; i < 1024 * 64; i += NGT) { const int n = i >> 6, k = i & 63; WL2w[i] = (bf16_t)f2bf(p.w2[k * 1024 + n]); WL2a[i] = (bf16_t)f2bf(p.a2[k * 1024 + n]); }
    for (int i = gt; i < 1024 * 192; i += NGT) { const int n = i / 192, k = i - n * 192; WL2g[i] = (bf16_t)f2bf(k < 160 ? p.g2[k * 1024 + n] : 0.f); }
    bf16_t* WR = (bf16_t*)(p.ws + WS_WR);
    for (int i = gt; i < 2 * 48 * 1024; i += NGT) {
      const int layer = i / (48 * 1024), rem = i - layer * 48 * 1024, n = rem >> 10, k = rem & 1023;
      float wv = 0.f;
      if (n < 4) wv = p.rg_w[(size_t)layer * DM * 4 + k * 4 + n]; else if (n < 36) wv = p.re_w[(size_t)layer * DM * 32 + k * 32 + (n - 4)];
      wv *= p.ffn_norm[layer * DM + k];
      const unsigned h = f2bf(wv); const float r1 = wv - __uint_as_float(h << 16);
      const unsigned m = f2bf(r1); const float r2 = r1 - __uint_as_float(m << 16);
      const unsigned l = f2bf(r2);
      bf16_t* o = WR + (size_t)layer * 144 * 1024 + (size_t)n * 1024 + k;
      o[0] = (bf16_t)h; o[48 * 1024] = (bf16_t)m; o[96 * 1024] = (bf16_t)l;
    }
  }
  bf16_t* XN = (bf16_t*)(p.ws + WS_XN);
  for (int m = gw; m < T_TOK; m += 4 * NGW) rms_rows_to_bf16<4>(p.x, p.mix_norm, XN, m, NGW, lane);
}


__device__ __forceinline__ void up8(const v4u w, float (&o)[8]) {
  o[0] = __uint_as_float(w.x << 16); o[1] = __uint_as_float(w.x & 0xffff0000u); o[2] = __uint_as_float(w.y << 16); o[3] = __uint_as_float(w.y & 0xffff0000u);
  o[4] = __uint_as_float(w.z << 16); o[5] = __uint_as_float(w.z & 0xffff0000u); o[6] = __uint_as_float(w.w << 16); o[7] = __uint_as_float(w.w & 0xffff0000u);
}
__device__ __forceinline__ f32x4 bf4(const v2u w) { return (f32x4){__uint_as_float(w.x << 16), __uint_as_float(w.x & 0xffff0000u), __uint_as_float(w.y << 16), __uint_as_float(w.y & 0xffff0000u)}; }
__device__ __forceinline__ void phase_router(PREF p, Frame& F, int layer) {
  const int gw = F.vcu * NWAVES + F.wave, NGW = F.G * NWAVES;
  const int lane = fresh_lane();
  PROBE_MARK(100 + layer * 10);
  {
    LAS float* scr = (LAS float*)(F.lds + RING_OFF + F.wave * 16384);
    for (int it = gw; it < 32 * 384; it += NGW) conv_expert_item(p, layer, it, scr, lane, (bf16_t*)(p.ws + WS_EGU));
  }
  __syncthreads();
  PROBE_MARK(101 + layer * 10);
  constexpr int WQP = 264;
  const lbf WQ = (lbf)(F.lds);
  LAS float* SSP = (LAS float*)(F.lds + 80 * 1024);
  LAS float* LGP = (LAS float*)(F.lds + 81 * 1024);
  const int w = F.wave, par = w & 1, tk = lane & 15, kg = lane >> 4;
  const bf16_t* xres = layer ? (const bf16_t*)(p.ws + WS_X3) : (const bf16_t*)p.out;
  const int tok = F.vcu * 64 + (w >> 1) * 16 + tk;
  bf16x8 xf[4][4];
  { const bf16_t* xr = xres + (size_t)tok * DM + 128 * par + 8 * kg;
#pragma unroll
    for (int j = 0; j < 4; ++j)
#pragma unroll
      for (int s = 0; s < 4; ++s) xf[j][s] = *(const GAS bf16x8*)(xr + 256 * j + 32 * s); }
  {
    float ss = 0.f;
#pragma unroll
    for (int j = 0; j < 4; ++j)
#pragma unroll
      for (int s = 0; s < 4; ++s) { float f[8]; up8(__builtin_bit_cast(v4u, xf[j][s]), f);
#pragma unroll
        for (int i = 0; i < 8; ++i) ss += f[i] * f[i]; }
    ss += __shfl_xor(ss, 16, 64); ss += __shfl_xor(ss, 32, 64);
    if (kg == 0) SSP[w * 16 + tk] = ss;
  }
  PROBE_MARK(102 + layer * 10);
  f32x4 acc[9];
#pragma unroll
  for (int nt = 0; nt < 9; ++nt) acc[nt] = (f32x4){0.f, 0.f, 0.f, 0.f};
  const bf16_t* WRl = (const bf16_t*)(p.ws + WS_WR) + (size_t)layer * 144 * 1024;
  float rs = 0.f;
#pragma unroll
  for (int j = 0; j < 4; ++j) {
    __syncthreads();
#pragma unroll
    for (int i = 0; i < 9; ++i) { const int idx = F.tid + i * 512, row = idx >> 5, pc = idx & 31;
      *(LAS v4u*)(WQ + row * WQP + pc * 8) = *(const GAS v4u*)(WRl + (size_t)row * 1024 + 256 * j + pc * 8); }
    __syncthreads();
    if (j == 0) {
      rs = rsqrtf((SSP[(w & ~1) * 16 + tk] + SSP[(w | 1) * 16 + tk]) * (1.f / DM) + 1e-6f);
      if (par == 0 && kg == 0) ((float*)(p.ws + WS_RS))[tok] = rs;
    }
#pragma unroll
    for (int s = 0; s < 4; ++s)
#pragma unroll
      for (int nt = 0; nt < 9; ++nt) {
        const bf16x8 a = *(const LAS bf16x8*)(WQ + (nt * 16 + tk) * WQP + 128 * par + 32 * s + 8 * kg);
        acc[nt] = __builtin_amdgcn_mfma_f32_16x16x32_bf16(a, xf[j][s], acc[nt], 0, 0, 0);
      }
  }
  PROBE_MARK(103 + layer * 10);
#pragma unroll
  for (int nt = 0; nt < 3; ++nt)
#pragma unroll
    for (int i = 0; i < 4; ++i) { const int n = nt * 16 + 4 * kg + i;
      if (n < 36) LGP[(w * 16 + tk) * 36 + n] = ((acc[6 + nt][i] + acc[3 + nt][i]) + acc[nt][i]) * rs; }
  LAS unsigned* LC = (LAS unsigned*)(F.lds + 118784);
  if (F.tid < 64) LC[F.tid] = 0u;
  __syncthreads();
  int ea = 0, eb = 0; unsigned la = 0, lb = 0; float ga = 0.f, gb = 0.f;
  if (lane < 8) {
    const LAS float* lg0 = LGP + ((w & ~1) * 16 + par * 8 + lane) * 36; const LAS float* lg1 = LGP + ((w | 1) * 16 + par * 8 + lane) * 36;
    const float* bg = p.rg_b + layer * 4;
    const float* be = p.re_b + layer * 32;
    float gl[4]; int gi = 0; float gm = -3.4e38f;
#pragma unroll
    for (int i = 0; i < 4; i++) { gl[i] = (lg0[i] + lg1[i]) + bg[i]; if (gl[i] > gm) { gm = gl[i]; gi = i; } }
    float gs = 0.f;
#pragma unroll
    for (int i = 0; i < 4; i++) gs += __expf(gl[i] - gm);
    const float grp_p = 1.f / gs;
    float v0 = -3.4e38f, v1 = -3.4e38f; int i0 = 0, i1 = 0;
    for (int i = 0; i < 8; i++) {
      const float v = (lg0[4 + gi * 8 + i] + lg1[4 + gi * 8 + i]) + be[gi * 8 + i];
      if (v > v0) { v1 = v0; i1 = i0; v0 = v; i0 = i; }
      else if (v > v1) { v1 = v; i1 = i; }
    }
    const float e1 = __expf(v1 - v0);
    ga = grp_p / (1.f + e1); gb = grp_p * e1 / (1.f + e1);
    ea = gi * 8 + i0; eb = gi * 8 + i1;
    la = __hip_atomic_fetch_add(LC + ea, 1u, __ATOMIC_RELAXED, __HIP_MEMORY_SCOPE_WORKGROUP);
    lb = __hip_atomic_fetch_add(LC + eb, 1u, __ATOMIC_RELAXED, __HIP_MEMORY_SCOPE_WORKGROUP);
  }
  __syncthreads();
  if (F.tid < 32) { const unsigned n = LC[F.tid];
    unsigned* cnt = (unsigned*)(p.ws + WS_CTL) + CW_CNT + (layer * 32 + F.tid) * 64;
    LC[32 + F.tid] = n ? __hip_atomic_fetch_add(cnt, n, __ATOMIC_RELAXED, __HIP_MEMORY_SCOPE_AGENT) : 0u; }
  __syncthreads();
  if (lane < 8) {
    const int t = gw * 8 + lane;
    int* list = (int*)(p.ws + WS_LIST); float* pgate = (float*)(p.ws + WS_PGATE);
    list[(size_t)ea * CAP + LC[32 + ea] + la] = 2 * t; pgate[2 * t] = ga;
    list[(size_t)eb * CAP + LC[32 + eb] + lb] = 2 * t + 1; pgate[2 * t + 1] = gb;
  }
  PROBE_MARK(104 + layer * 10);
}

__device__ __forceinline__ void phase_final(PREF p, Frame& F) {
  const int gw = F.vcu * NWAVES + F.wave, NGW = F.G * NWAVES;
  const int lane = fresh_lane();
  const bf16_t* Y1 = (const bf16_t*)(p.ws + WS_Y1);
  const bf16_t* X3 = (const bf16_t*)(p.ws + WS_X3);
  for (int t = gw; t < T_TOK; t += NGW) {
    GAS f32x4* xo = (GAS f32x4*)(p.out + (size_t)t * DM) + lane;
    const GAS v2u* xr = (const GAS v2u*)(X3 + (size_t)t * DM) + lane;
    const GAS v2u* yr = (const GAS v2u*)(Y1 + (size_t)t * DM) + lane;
#pragma unroll
    for (int j = 0; j < 4; ++j) xo[64 * j] = bf4(xr[64 * j]) + bf4(yr[64 * j]);
  }
}

__device__ __forceinline__ void phase_rwkv_prep(PREF p, Frame& F) {
  const int gw = F.vcu * NWAVES + F.wave, NGW = F.G * NWAVES;
  const int lane = fresh_lane();
  const float* gain = p.mix_norm + DM;
  const bf16_t* X1 = (const bf16_t*)p.out;
  const bf16_t* Y1 = (const bf16_t*)(p.ws + WS_Y1);
  float g[2][8];
#pragma unroll
  for (int c = 0; c < 2; ++c) { const f32x4 a = *(const GAS f32x4*)(gain + c * 512 + lane * 8), b = *(const GAS f32x4*)(gain + c * 512 + lane * 8 + 4);
    g[c][0] = a.x; g[c][1] = a.y; g[c][2] = a.z; g[c][3] = a.w; g[c][4] = b.x; g[c][5] = b.y; g[c][6] = b.z; g[c][7] = b.w; }
  for (int run = gw; run < T_TOK / 8; run += NGW) {
    const int t0 = run * 8;
    float prev[2][8];
    if ((t0 & (SEQ - 1)) == 0) {
#pragma unroll
      for (int c = 0; c < 2; ++c)
#pragma unroll
        for (int i = 0; i < 8; ++i) prev[c][i] = 0.f;
    } else {
      float s = 0.f;
#pragma unroll
      for (int c = 0; c < 2; ++c) { float xa[8], ya[8];
        up8(*(const GAS v4u*)(X1 + (size_t)(t0 - 1) * DM + c * 512 + lane * 8), xa); up8(*(const GAS v4u*)(Y1 + (size_t)(t0 - 1) * DM + c * 512 + lane * 8), ya);
#pragma unroll
        for (int i = 0; i < 8; ++i) { prev[c][i] = xa[i] + ya[i]; s += prev[c][i] * prev[c][i]; } }
      const float r = rsqrtf(wave_sum_dpp(s) * (1.f / DM) + 1e-6f);
#pragma unroll
      for (int c = 0; c < 2; ++c)
#pragma unroll
        for (int i = 0; i < 8; ++i) prev[c][i] *= r * g[c][i];
    }
    v4u nx[2], ny[2];
#pragma unroll
    for (int c = 0; c < 2; ++c) { nx[c] = *(const GAS v4u*)(X1 + (size_t)t0 * DM + c * 512 + lane * 8); ny[c] = *(const GAS v4u*)(Y1 + (size_t)t0 * DM + c * 512 + lane * 8); }
#pragma unroll 1
    for (int tt = 0; tt < 8; ++tt) {
      const int t = t0 + tt;
      float v[2][8]; float s = 0.f;
#pragma unroll
      for (int c = 0; c < 2; ++c) { float xa[8], ya[8]; up8(nx[c], xa); up8(ny[c], ya);
#pragma unroll
        for (int i = 0; i < 8; ++i) { v[c][i] = xa[i] + ya[i]; s += v[c][i] * v[c][i]; } }
      if (tt < 7) {
#pragma unroll
        for (int c = 0; c < 2; ++c) { nx[c] = *(const GAS v4u*)(X1 + (size_t)(t + 1) * DM + c * 512 + lane * 8); ny[c] = *(const GAS v4u*)(Y1 + (size_t)(t + 1) * DM + c * 512 + lane * 8); } }
      const float r = rsqrtf(wave_sum_dpp(s) * (1.f / DM) + 1e-6f);
#pragma unroll
      for (int c = 0; c < 2; ++c)
#pragma unroll
        for (int i = 0; i < 8; ++i) v[c][i] *= r * g[c][i];
#pragma unroll
      for (int sl = 0; sl < 6; ++sl) {
        const int mj = (sl == 0) ? 0 : (sl == 1) ? 2 : (sl == 2) ? 3 : (sl == 3) ? 1 : (sl == 4) ? 4 : 5;
        bf16_t* o = (bf16_t*)(p.ws + WS_S0 + (size_t)sl * SLOT) + (size_t)t * DM;
#pragma unroll
        for (int c = 0; c < 2; ++c) {
          const f32x4 ma = *(const GAS f32x4*)(p.rmix + mj * DM + c * 512 + lane * 8), mb = *(const GAS f32x4*)(p.rmix + mj * DM + c * 512 + lane * 8 + 4);
          const float mx[8] = {ma.x, ma.y, ma.z, ma.w, mb.x, mb.y, mb.z, mb.w};
          float q[8];
#pragma unroll
          for (int i = 0; i < 8; ++i) q[i] = v[c][i] + (prev[c][i] - v[c][i]) * mx[i];
          v4u w; w.x = pk2(q[0], q[1]); w.y = pk2(q[2], q[3]); w.z = pk2(q[4], q[5]); w.w = pk2(q[6], q[7]);
          *(GAS v4u*)(o + c * 512 + lane * 8) = w;
        }
      }
#pragma unroll
      for (int c = 0; c < 2; ++c)
#pragma unroll
        for (int i = 0; i < 8; ++i) prev[c][i] = v[c][i];
    }
  }
}

constexpr int RP = 72;
constexpr int RB = 64 * RP * 2;

__device__ __forceinline__ f32x4 mm16(f32x4 acc, const LAS bf16_t* A, int arow0, const LAS bf16_t* Bt, int brow0, int lane) {
  const int r = lane & 15, q = lane >> 4;
#pragma unroll
  for (int ks = 0; ks < 2; ++ks) {
    const bf16x8 a = *(const LAS bf16x8*)(A + (arow0 + r) * RP + ks * 32 + q * 8);
    const bf16x8 b = *(const LAS bf16x8*)(Bt + (brow0 + r) * RP + ks * 32 + q * 8);
    acc = __builtin_amdgcn_mfma_f32_16x16x32_bf16(a, b, acc, 0, 0, 0);
  }
  return acc;
}
__device__ __forceinline__ float sum8(float v) {
  v += __shfl_xor(v, 1, 64); v += __shfl_xor(v, 2, 64); v += __shfl_xor(v, 4, 64); return v;
}
__device__ __forceinline__ void ld8bf(const bf16_t* p, float (&o)[8]) {
  const v4u w = *(const GAS v4u*)p;
  o[0] = __uint_as_float(w.x << 16); o[1] = __uint_as_float(w.x & 0xffff0000u); o[2] = __uint_as_float(w.y << 16); o[3] = __uint_as_float(w.y & 0xffff0000u);
  o[4] = __uint_as_float(w.z << 16); o[5] = __uint_as_float(w.z & 0xffff0000u); o[6] = __uint_as_float(w.w << 16); o[7] = __uint_as_float(w.w & 0xffff0000u);
}
__device__ __forceinline__ v4u pk8(const float (&o)[8]) { v4u w; w.x = pk2(o[0], o[1]); w.y = pk2(o[2], o[3]); w.z = pk2(o[4], o[5]); w.w = pk2(o[6], o[7]); return w; }

#define R1_BAR() do { asm volatile("s_waitcnt lgkmcnt(0)" ::: "memory"); __builtin_amdgcn_s_barrier(); asm volatile("" ::: "memory"); } while (0)
__device__ __forceinline__ void stT(LAS bf16_t* Dst, int x0, int y0, const f32x4& acc, int lane) {
  v2u w; w.x = pk2(acc[0], acc[1]); w.y = pk2(acc[2], acc[3]);
  *(LAS v2u*)(Dst + (x0 + (lane & 15)) * RP + y0 + (lane >> 4) * 4) = w;
}
struct R1In { v4u r, ld, k, v, a; f32x4 kk0, kk1, ka0, ka1, rk0, rk1; };
__device__ __forceinline__ R1In rwkv_r1_load(PREF p, int item, int tid) {
  const int ch = item >> 6, c = item & 63, b = ch >> 4, hd = ch & 15;
  const size_t off = ((size_t)(b * SEQ + c * 64 + (tid >> 3)) * DM + hd * 64 + (tid & 7) * 8);
  const bf16_t* s0 = (const bf16_t*)(p.ws + WS_S0);
  R1In in;
  in.r = *(const GAS v4u*)(s0 + 3 * (SLOT / 2) + off); in.ld = *(const GAS v4u*)(s0 + off); in.k = *(const GAS v4u*)(s0 + 4 * (SLOT / 2) + off);
  in.v = *(const GAS v4u*)(s0 + 5 * (SLOT / 2) + off); in.a = *(const GAS v4u*)(s0 + (SLOT / 2) + off);
  const int cc0 = hd * 64 + (tid & 7) * 8;
  in.kk0 = *(const GAS f32x4*)(p.k_k + cc0); in.kk1 = *(const GAS f32x4*)(p.k_k + cc0 + 4); in.ka0 = *(const GAS f32x4*)(p.k_a + cc0); in.ka1 = *(const GAS f32x4*)(p.k_a + cc0 + 4);
  in.rk0 = *(const GAS f32x4*)(p.r_k + cc0); in.rk1 = *(const GAS f32x4*)(p.r_k + cc0 + 4);
  return in;
}
__device__ __forceinline__ void un8(const v4u w, float (&o)[8]) {
  o[0] = __uint_as_float(w.x << 16); o[1] = __uint_as_float(w.x & 0xffff0000u); o[2] = __uint_as_float(w.y << 16); o[3] = __uint_as_float(w.y & 0xffff0000u);
  o[4] = __uint_as_float(w.z << 16); o[5] = __uint_as_float(w.z & 0xffff0000u); o[6] = __uint_as_float(w.w << 16); o[7] = __uint_as_float(w.w & 0xffff0000u);
}
__device__ __forceinline__ void rwkv_r1_item(PREF p, Frame& F, int item, const R1In& in) {
  const int tid = F.tid, lane = fresh_lane(), w = F.wave;
  const int ch = item >> 6, c = item & 63, b = ch >> 4, hd = ch & 15;
  const size_t tile0 = ((size_t)(b * SEQ + c * 64) * DM + hd * 64);
  unsigned char* ws = p.ws;
  bf16_t* SL[6];
#pragma unroll
  for (int s = 0; s < 6; ++s) SL[s] = (bf16_t*)(ws + WS_S0 + (size_t)s * SLOT) + tile0;
  const lbf BtT = (lbf)(F.lds + 0 * RB), KtT = (lbf)(F.lds + 1 * RB), AbT = (lbf)(F.lds + 2 * RB), RbT = (lbf)(F.lds + 3 * RB);
  const lbf Ab = (lbf)(F.lds + 4 * RB), Vc = (lbf)(F.lds + 5 * RB), Bh = (lbf)(F.lds + 6 * RB), Kh = (lbf)(F.lds + 7 * RB);
  const lbf Tk = (lbf)(F.lds + 8 * RB), WbT = (lbf)(F.lds + 9 * RB), WkT = (lbf)(F.lds + 10 * RB);
  const lbf X = BtT, XT = KtT, Pb = AbT;
  const lbf At = X, TNT = XT, U0 = Tk;
  LAS float* Lf = (LAS float*)(F.lds + 11 * RB);
  LAS float* SEG = Lf + 64 * 65;
  LAS float* GC = (LAS float*)(F.lds + 14 * RB);
#if defined(PROBE_PH) && PROBE_PH == 301
  const unsigned long long _sa0 = __builtin_amdgcn_s_memrealtime();
#endif
  const int t = tid >> 3, cg = tid & 7, k0 = cg * 8;
  float r_[8], ld_[8], kx[8], v_[8], a_[8];
  un8(in.r, r_); un8(in.ld, ld_); un8(in.k, kx); un8(in.v, v_); un8(in.a, a_);
  float kk[8], km[8], be[8];
  {
    float ss = 0.f, bo = 0.f;
#pragma unroll
    for (int i = 0; i < 8; ++i) { const float ckk = (i < 4) ? in.kk0[i & 3] : in.kk1[i & 3], cka = (i < 4) ? in.ka0[i & 3] : in.ka1[i & 3], crk = (i < 4) ? in.rk0[i & 3] : in.rk1[i & 3];
      kk[i] = kx[i] * ckk; ss += kk[i] * kk[i]; km[i] = kx[i] * (1.f + (a_[i] - 1.f) * cka); bo += r_[i] * km[i] * crk; }
    ss = sum8(ss); bo = sum8(bo);
    const float inv = 1.f / fmaxf(sqrtf(ss), 1e-12f);
#pragma unroll
    for (int i = 0; i < 8; ++i) { kk[i] *= inv; be[i] = kk[i] * a_[i]; }
    if (cg == 0) ((float*)(ws + WS_TMP))[(size_t)item * 64 + t] = bo;
  }
#pragma unroll
  for (int i = 0; i < 8; ++i) Lf[t * 65 + k0 + i] = ld_[i];
  R1_BAR();
  {
    const int k = tid & 63, sg = tid >> 6;
    float run = 0.f;
#pragma unroll
    for (int i = 0; i < 8; ++i) { run += Lf[(sg * 8 + i) * 65 + k]; Lf[(sg * 8 + i) * 65 + k] = run; }
    SEG[sg * 64 + k] = run;
    R1_BAR();
    float off = 0.f;
    for (int j = 0; j < sg; ++j) off += SEG[j * 64 + k];
#pragma unroll
    for (int i = 0; i < 8; ++i) Lf[(sg * 8 + i) * 65 + k] += off;
  }
  R1_BAR();
  {
    float ab[8], bt[8], kt[8], rb[8], bh[8], kh[8];
#pragma unroll
    for (int i = 0; i < 8; ++i) {
      const float Lt = Lf[t * 65 + k0 + i], Lp = (t > 0) ? Lf[(t - 1) * 65 + k0 + i] : 0.f, LC = Lf[63 * 65 + k0 + i];
      const float et = __expf(Lt), ei = __builtin_amdgcn_rcpf(et), eh = __expf(LC) * ei;
      if (t == 63) GC[k0 + i] = et;
      ab[i] = -kk[i] * __expf(Lp); bt[i] = be[i] * ei; kt[i] = km[i] * ei; rb[i] = r_[i] * et; bh[i] = be[i] * eh; kh[i] = km[i] * eh;
    }
    *(LAS v4u*)(BtT + t * RP + k0) = pk8(bt); *(LAS v4u*)(KtT + t * RP + k0) = pk8(kt); *(LAS v4u*)(AbT + t * RP + k0) = pk8(ab); *(LAS v4u*)(RbT + t * RP + k0) = pk8(rb);
    {
      float ra[8], rv[8], rb[8], rkh[8];
#pragma unroll
      for (int i = 0; i < 8; ++i) { ra[i] = ab[i]; rv[i] = v_[i]; rb[i] = bh[i]; rkh[i] = kh[i]; }
#pragma unroll
      for (int sh = 1; sh < 8; sh <<= 1) {
        const bool on = (cg & sh) != 0;
        float ta[8], tv[8], tb[8], tk[8];
#pragma unroll
        for (int i = 0; i < 8; ++i) { ta[i] = on ? ra[(i + sh) & 7] : ra[i]; tv[i] = on ? rv[(i + sh) & 7] : rv[i]; tb[i] = on ? rb[(i + sh) & 7] : rb[i]; tk[i] = on ? rkh[(i + sh) & 7] : rkh[i]; }
#pragma unroll
        for (int i = 0; i < 8; ++i) { ra[i] = ta[i]; rv[i] = tv[i]; rb[i] = tb[i]; rkh[i] = tk[i]; }
      }
#pragma unroll
      for (int i = 0; i < 8; ++i) { const int row = k0 + ((i + cg) & 7);
        Ab[row * RP + t] = (bf16_t)f2bf(ra[i]); Vc[row * RP + t] = (bf16_t)f2bf(rv[i]); Bh[row * RP + t] = (bf16_t)f2bf(rb[i]); Kh[row * RP + t] = (bf16_t)f2bf(rkh[i]); }
    }
  }
  R1_BAR();
#if defined(PROBE_PH) && PROBE_PH == 301
  F.pr_t1 += __builtin_amdgcn_s_memrealtime() - _sa0;
#endif
  const int ya = (w >> 1) * 16, xb0 = (w & 1) * 32;
  const int cr = lane & 15, q4 = (lane >> 4) * 4;
  const f32x4 Z4 = {0.f, 0.f, 0.f, 0.f};
  const lbf X1 = (lbf)(F.lds + 11 * RB), XT1 = (lbf)(F.lds + 12 * RB), Pb1 = (lbf)(F.lds + 13 * RB);
  f32x4 accP[2];
  {
    f32x4 tabn[2], tabs[2], taks[2], wbr[2], wkr[2];
#pragma unroll
    for (int j = 0; j < 2; ++j) { const int xb = xb0 + 16 * j;
      tabn[j] = mm16(Z4, BtT, ya, AbT, xb, lane);
      tabs[j] = mm16(Z4, AbT, ya, BtT, xb, lane);
      taks[j] = mm16(Z4, AbT, ya, KtT, xb, lane);
      wbr[j] = mm16(Z4, BtT, ya, RbT, xb, lane);
      wkr[j] = mm16(Z4, KtT, ya, RbT, xb, lane); }
#pragma unroll
    for (int j = 0; j < 2; ++j) { const int xb = xb0 + 16 * j;
      f32x4 xt, xr, pr, tk, wb, wk;
#pragma unroll
      for (int i = 0; i < 4; ++i) {
        { const int s = ya + q4 + i, tt = xb + cr; xt[i] = (s < tt) ? tabn[j][i] : 0.f; wb[i] = (s <= tt) ? wbr[j][i] : 0.f; wk[i] = (s <= tt) ? wkr[j][i] : 0.f; }
        { const int tt = ya + q4 + i, s = xb + cr; xr[i] = (s < tt) ? tabs[j][i] : 0.f; pr[i] = xr[i] + ((s == tt) ? 1.f : 0.f); tk[i] = (s < tt) ? taks[j][i] : 0.f; }
      }
      accP[j] = pr;
      stT(XT1, xb, ya, xt, lane); stT(WbT, xb, ya, wb, lane); stT(WkT, xb, ya, wk, lane);
      stT(X1, xb, ya, xr, lane); stT(Pb1, xb, ya, pr, lane); stT(Tk, xb, ya, tk, lane); }
  }
  R1_BAR();
#pragma unroll 1
  for (int st = 0; st < 5; ++st) {
    const lbf Xs = (st & 1) ? X : X1, XTs = (st & 1) ? XT : XT1, Pbs = (st & 1) ? Pb : Pb1;
    const lbf Xd = (st & 1) ? X1 : X, XTd = (st & 1) ? XT1 : XT, Pbd = (st & 1) ? Pb1 : Pb;
    f32x4 xr[2], xt[2];
#pragma unroll
    for (int j = 0; j < 2; ++j) { const int xb = xb0 + 16 * j;
      xr[j] = mm16(Z4, XTs, ya, Xs, xb, lane);
      xt[j] = mm16(Z4, Xs, ya, XTs, xb, lane);
      if (st > 0) accP[j] = mm16(accP[j], XTs, ya, Pbs, xb, lane); }
#pragma unroll
    for (int j = 0; j < 2; ++j) { const int xb = xb0 + 16 * j; stT(Xd, xb, ya, xr[j], lane); stT(XTd, xb, ya, xt[j], lane); stT(Pbd, xb, ya, accP[j], lane); }
    R1_BAR();
  }
  const lbf NT = Pb1;
  {
    f32x4 nt[2];
#pragma unroll
    for (int j = 0; j < 2; ++j) { const int xb = xb0 + 16 * j; nt[j] = mm16(Z4, Pb, ya, XT, xb, lane);
#pragma unroll
      for (int i = 0; i < 4; ++i) nt[j][i] += bf2f(Pb[(ya + q4 + i) * RP + xb + cr]); }
#pragma unroll
    for (int j = 0; j < 2; ++j) stT(NT, xb0 + 16 * j, ya, nt[j], lane);
    R1_BAR();
  }
  {
    f32x4 at[2], tn[2];
#pragma unroll
    for (int j = 0; j < 2; ++j) { const int xb = xb0 + 16 * j; at[j] = mm16(Z4, NT, ya, Ab, xb, lane); tn[j] = mm16(Z4, Tk, ya, NT, xb, lane); }
#pragma unroll
    for (int j = 0; j < 2; ++j) { const int xb = xb0 + 16 * j; stT(At, xb, ya, at[j], lane); stT(TNT, xb, ya, tn[j], lane); }
  }
  R1_BAR();
  const lbf O_RT = (lbf)(F.lds + 11 * RB), O_PM = (lbf)(F.lds + 12 * RB), O_Y0 = (lbf)(F.lds + 13 * RB), O_Q = (lbf)(F.lds + 3 * RB)  ;
  {
    f32x4 u0[2], rt[2], pm[2];
#pragma unroll
    for (int j = 0; j < 2; ++j) { const int xb = xb0 + 16 * j;
      u0[j] = mm16(Z4, TNT, ya, Vc, xb, lane);
      rt[j] = mm16(Z4, At, ya, WbT, xb, lane);
      pm[j] = mm16(Z4, At, ya, Bh, xb, lane);
      const v2u rbw = *(const LAS v2u*)(RbT + (xb + cr) * RP + ya + q4);
      rt[j][0] += __uint_as_float(rbw.x << 16); rt[j][1] += __uint_as_float(rbw.x & 0xffff0000u); rt[j][2] += __uint_as_float(rbw.y << 16); rt[j][3] += __uint_as_float(rbw.y & 0xffff0000u);
#pragma unroll
      for (int i = 0; i < 4; ++i) if (ya + q4 + i == xb + cr) pm[j][i] += GC[xb + cr]; }
#pragma unroll
    for (int j = 0; j < 2; ++j) { const int xb = xb0 + 16 * j; stT(U0, xb, ya, u0[j], lane); stT(O_RT, xb, ya, rt[j], lane); stT(O_PM, xb, ya, pm[j], lane); }
  }
  R1_BAR();
  {
    f32x4 y0[2], qq[2];
#pragma unroll
    for (int j = 0; j < 2; ++j) { const int xb = xb0 + 16 * j;
      y0[j] = mm16(mm16(Z4, U0, ya, WbT, xb, lane), Vc, ya, WkT, xb, lane);
      qq[j] = mm16(mm16(Z4, Bh, ya, U0, xb, lane), Kh, ya, Vc, xb, lane); }
#pragma unroll
    for (int j = 0; j < 2; ++j) { const int xb = xb0 + 16 * j; stT(O_Y0, xb, ya, y0[j], lane); stT(O_Q, xb, ya, qq[j], lane); }
  }
  R1_BAR();
  {
    const int row = tid >> 3, pc = (tid & 7) * 8;
    *(GAS v4u*)(SL[3] + (size_t)row * DM + pc) = *(const LAS v4u*)(O_RT + row * RP + pc);
    *(GAS v4u*)(SL[0] + (size_t)row * DM + pc) = *(const LAS v4u*)(O_PM + row * RP + pc);
    *(GAS v4u*)(SL[4] + (size_t)row * DM + pc) = *(const LAS v4u*)(O_Y0 + row * RP + pc);
    *(GAS v4u*)(SL[1] + (size_t)row * DM + pc) = *(const LAS v4u*)(O_Q + row * RP + pc);
  }
  R1_BAR();
}

__device__ __forceinline__ void phase_rwkv_r1(PREF p, Frame& F) {
  int item = F.vcu;
  if (item >= 4096) return;
  R1In nxt = rwkv_r1_load(p, item, F.tid);
  for (; item < 4096; item += F.G) {
    const R1In cur = nxt;
    if (item + F.G < 4096) nxt = rwkv_r1_load(p, item + F.G, F.tid);
    rwkv_r1_item(p, F, item, cur);
  }
}

__device__ __forceinline__ void phase_rwkv_r2(PREF p, Frame& F) {
  if (F.wave != 0) return;
  const int lane = fresh_lane();
  const lbf Sh = (lbf)(F.lds), Sl = (lbf)(F.lds + 16 * RP * 2);
  const int cr = lane & 15, g = lane >> 4;
  for (int task = F.vcu; task < 256; task += F.G) {
    const int ch = task >> 2, jb = task & 3, b = ch >> 4, hd = ch & 15;
    const bf16_t* PM = (const bf16_t*)(p.ws + WS_S0) + ((size_t)(b * SEQ) * DM + hd * 64);
    bf16_t* QS = (bf16_t*)(p.ws + WS_S0 + SLOT) + ((size_t)(b * SEQ) * DM + hd * 64);
    for (int i = lane; i < 16 * RP; i += 64) { Sh[i] = 0; Sl[i] = 0; }
    const bf16_t* pmp = PM + (size_t)cr * DM + g * 8;
    bf16_t* qsp = QS + (size_t)(16 * jb + cr) * DM + g * 4;
    bf16x8 pa[4][4][2]; v2u qv[4][4];
#pragma unroll
    for (int d = 0; d < 4; ++d)
#pragma unroll
      for (int ct = 0; ct < 4; ++ct) { pa[d][ct][0] = *(const GAS bf16x8*)(pmp + (size_t)(d * 64 + 16 * ct) * DM); pa[d][ct][1] = *(const GAS bf16x8*)(pmp + (size_t)(d * 64 + 16 * ct) * DM + 32);
        qv[d][ct] = *(const GAS v2u*)(qsp + (size_t)d * 64 * DM + 16 * ct); }
    asm volatile("s_waitcnt lgkmcnt(0)" ::: "memory");
#pragma unroll 1
    for (int c4 = 0; c4 < 64; c4 += 4) {
#pragma unroll
      for (int d = 0; d < 4; ++d) {
        const int c = c4 + d;
        const bf16x8 bh0 = *(const LAS bf16x8*)(Sh + cr * RP + g * 8), bh1 = *(const LAS bf16x8*)(Sh + cr * RP + 32 + g * 8);
        const bf16x8 bl0 = *(const LAS bf16x8*)(Sl + cr * RP + g * 8), bl1 = *(const LAS bf16x8*)(Sl + cr * RP + 32 + g * 8);
        f32x4 acc[4];
#pragma unroll
        for (int ct = 0; ct < 4; ++ct) {
          acc[ct] = (f32x4){__uint_as_float(qv[d][ct].x << 16), __uint_as_float(qv[d][ct].x & 0xffff0000u), __uint_as_float(qv[d][ct].y << 16), __uint_as_float(qv[d][ct].y & 0xffff0000u)};
          acc[ct] = __builtin_amdgcn_mfma_f32_16x16x32_bf16(pa[d][ct][0], bh0, acc[ct], 0, 0, 0);
          acc[ct] = __builtin_amdgcn_mfma_f32_16x16x32_bf16(pa[d][ct][1], bh1, acc[ct], 0, 0, 0);
          acc[ct] = __builtin_amdgcn_mfma_f32_16x16x32_bf16(pa[d][ct][0], bl0, acc[ct], 0, 0, 0);
          acc[ct] = __builtin_amdgcn_mfma_f32_16x16x32_bf16(pa[d][ct][1], bl1, acc[ct], 0, 0, 0);
        }
        if (c + 4 < 64) {
#pragma unroll
          for (int ct = 0; ct < 4; ++ct) { pa[d][ct][0] = *(const GAS bf16x8*)(pmp + (size_t)((c + 4) * 64 + 16 * ct) * DM); pa[d][ct][1] = *(const GAS bf16x8*)(pmp + (size_t)((c + 4) * 64 + 16 * ct) * DM + 32);
            qv[d][ct] = *(const GAS v2u*)(qsp + (size_t)(c + 4) * 64 * DM + 16 * ct); }
        }
#pragma unroll
        for (int ct = 0; ct < 4; ++ct) {
          v2u hi; hi.x = pk2(acc[ct][0], acc[ct][1]); hi.y = pk2(acc[ct][2], acc[ct][3]);
          const float l0 = acc[ct][0] - __uint_as_float(hi.x << 16), l1 = acc[ct][1] - __uint_as_float(hi.x & 0xffff0000u), l2 = acc[ct][2] - __uint_as_float(hi.y << 16), l3 = acc[ct][3] - __uint_as_float(hi.y & 0xffff0000u);
          v2u lo; lo.x = pk2(l0, l1); lo.y = pk2(l2, l3);
          *(LAS v2u*)(Sh + cr * RP + 16 * ct + g * 4) = hi; *(LAS v2u*)(Sl + cr * RP + 16 * ct + g * 4) = lo;
          *(GAS v2u*)(qsp + (size_t)c * 64 * DM + 16 * ct) = hi;
        }
        asm volatile("s_waitcnt lgkmcnt(0)" ::: "memory");
      }
    }
  }
}

__device__ __forceinline__ void phase_rwkv_r3(PREF p, Frame& F) {
  const int lane = fresh_lane(), w = F.wave;
  const int cr = lane & 15, q4 = (lane >> 4) * 4, q = lane >> 4;
  const int half = w >> 2, tb = w & 3;
  LAS bf16_t* stg = (LAS bf16_t*)(F.lds) + w * 16 * RP;
  for (int it2 = F.vcu; it2 < 2048; it2 += F.G) {
    const int item = it2 * 2 + half;
    const int ch = item >> 6, c = item & 63, b = ch >> 4, hd = ch & 15;
    const size_t tile0 = ((size_t)(b * SEQ + c * 64) * DM + hd * 64);
    bf16_t* RT = (bf16_t*)(p.ws + WS_S0 + 3 * SLOT) + tile0;
    const bf16_t* Y0 = (const bf16_t*)(p.ws + WS_S0 + 4 * SLOT) + tile0;
    const bf16_t* VV = (const bf16_t*)(p.ws + WS_S0 + 5 * SLOT) + tile0;
    const bf16_t* GG = (const bf16_t*)(p.ws + WS_S0 + 2 * SLOT) + tile0;
    const bf16_t* SC = (const bf16_t*)(p.ws + WS_S0 + SLOT) + tile0 - (size_t)64 * DM;
    const float* BO = (const float*)(p.ws + WS_TMP) + (size_t)item * 64;
    f32x4 y[4];
#pragma unroll
    for (int j = 0; j < 4; ++j) y[j] = (f32x4){0.f, 0.f, 0.f, 0.f};
    if (c > 0) {
      const bf16_t* ap = RT + (size_t)(16 * tb + cr) * DM + q * 8;
      const bf16x8 a0 = *(const GAS bf16x8*)ap, a1 = *(const GAS bf16x8*)(ap + 32);
#pragma unroll
      for (int j = 0; j < 4; ++j) {
        const bf16_t* bp = SC + (size_t)(16 * j + cr) * DM + q * 8;
        const bf16x8 b0 = *(const GAS bf16x8*)bp, b1 = *(const GAS bf16x8*)(bp + 32);
        y[j] = __builtin_amdgcn_mfma_f32_16x16x32_bf16(a0, b0, y[j], 0, 0, 0);
        y[j] = __builtin_amdgcn_mfma_f32_16x16x32_bf16(a1, b1, y[j], 0, 0, 0);
      }
    }
    float mu[4], rs[4];
#pragma unroll
    for (int i = 0; i < 4; ++i) {
      float s = 0.f;
#pragma unroll
      for (int j = 0; j < 4; ++j) { y[j][i] += bf2f(Y0[(size_t)(16 * tb + q4 + i) * DM + 16 * j + cr]); s += y[j][i]; }
      s += __shfl_xor(s, 1, 64); s += __shfl_xor(s, 2, 64); s += __shfl_xor(s, 4, 64); s += __shfl_xor(s, 8, 64);
      mu[i] = s * (1.f / 64.f);
      float qd = 0.f;
#pragma unroll
      for (int j = 0; j < 4; ++j) { const float d = y[j][i] - mu[i]; qd += d * d; }
      qd += __shfl_xor(qd, 1, 64); qd += __shfl_xor(qd, 2, 64); qd += __shfl_xor(qd, 4, 64); qd += __shfl_xor(qd, 8, 64);
      rs[i] = rsqrtf(qd * (1.f / 64.f) + 64e-5f);
    }
#pragma unroll
    for (int j = 0; j < 4; ++j) {
      const int cc = hd * 64 + 16 * j + cr;
      const float lw = p.ln_w[cc], lb = p.ln_b[cc];
#pragma unroll
      for (int i = 0; i < 4; ++i) {
        const int tt = 16 * tb + q4 + i;
        const float vv = bf2f(VV[(size_t)tt * DM + 16 * j + cr]), gg = bf2f(GG[(size_t)tt * DM + 16 * j + cr]);
        const float z = ((y[j][i] - mu[i]) * rs[i] * lw + lb + BO[tt] * vv) * gg;
        stg[(q4 + i) * RP + 16 * j + cr] = (bf16_t)f2bf(z);
      }
    }
    LDS_WAIT();
#pragma unroll
    for (int i = 0; i < 2; ++i) { const int row = (lane >> 3) + 8 * i, pc = (lane & 7) * 8;
      *(GAS v4u*)(RT + (size_t)(16 * tb + row) * DM + pc) = *(const LAS v4u*)(stg + row * RP + pc); }
    LDS_WAIT();
  }
}


typedef short v4i16_t __attribute__((ext_vector_type(4)));
__device__ __forceinline__ v4i16_t tr16(const LAS bf16_t* p) { return __builtin_amdgcn_ds_read_tr16_b64_v4i16((LAS v4i16_t*)p); }

template <int KS>
__device__ __forceinline__ void qk_tile(f32x4 (&st)[4][2], const LAS bf16_t* Kt, int kc0, const bf16x8 (&qf)[2][KS], int lane) {
  const int r = lane & 15, g = lane >> 4;
#pragma unroll
  for (int kt = 0; kt < 4; ++kt)
#pragma unroll
    for (int ks = 0; ks < KS; ++ks) {
      const bf16x8 a = *(const LAS bf16x8*)(Kt + (kt * 16 + r) * RP + kc0 + ks * 32 + g * 8);
#pragma unroll
      for (int qt = 0; qt < 2; ++qt) st[kt][qt] = __builtin_amdgcn_mfma_f32_16x16x32_bf16(a, qf[qt][ks], st[kt][qt], 0, 0, 0);
    }
}
__device__ __forceinline__ void pack_p(bf16x8 (&pb)[2][2], const f32x4 (&pr)[4][2]) {
#pragma unroll
  for (int kb = 0; kb < 2; ++kb)
#pragma unroll
    for (int qt = 0; qt < 2; ++qt) {
      const v4u w = {pk2(pr[2 * kb][qt][0], pr[2 * kb][qt][1]), pk2(pr[2 * kb][qt][2], pr[2 * kb][qt][3]), pk2(pr[2 * kb + 1][qt][0], pr[2 * kb + 1][qt][1]), pk2(pr[2 * kb + 1][qt][2], pr[2 * kb + 1][qt][3])};
      pb[kb][qt] = __builtin_bit_cast(bf16x8, w);
    }
}
__device__ __forceinline__ void pv_apply(f32x4 (&o)[4][2], f32x4 (&osum)[2], const bf16x8 (&pb)[2][2], const LAS bf16_t* Vt, int lane) {
  const int g = lane >> 4, qq = (lane & 15) >> 2, pp = lane & 3;
  const bf16x8 ones = {0x3F80, 0x3F80, 0x3F80, 0x3F80, 0x3F80, 0x3F80, 0x3F80, 0x3F80};
#pragma unroll
  for (int kb = 0; kb < 2; ++kb)
#pragma unroll
    for (int qt = 0; qt < 2; ++qt) osum[qt] = __builtin_amdgcn_mfma_f32_16x16x32_bf16(ones, pb[kb][qt], osum[qt], 0, 0, 0);
#pragma unroll
  for (int dt = 0; dt < 4; ++dt)
#pragma unroll
    for (int kb = 0; kb < 2; ++kb) {
      const v4i16_t lo = tr16(Vt + (32 * kb + 4 * g + qq) * RP + dt * 16 + 4 * pp);
      const v4i16_t hi = tr16(Vt + (32 * kb + 16 + 4 * g + qq) * RP + dt * 16 + 4 * pp);
      const bf16x8 a = {lo[0], lo[1], lo[2], lo[3], hi[0], hi[1], hi[2], hi[3]};
#pragma unroll
      for (int qt = 0; qt < 2; ++qt) o[dt][qt] = __builtin_amdgcn_mfma_f32_16x16x32_bf16(a, pb[kb][qt], o[dt][qt], 0, 0, 0);
    }
}
__device__ __forceinline__ void pv_apply2(f32x4 (&o1)[4][2], f32x4 (&o2)[4][2], f32x4 (&os1)[2], f32x4 (&os2)[2], const bf16x8 (&pb1)[2][2], const bf16x8 (&pb2)[2][2], const LAS bf16_t* Vt, int lane) {
  const int g = lane >> 4, qq = (lane & 15) >> 2, pp = lane & 3;
  const bf16x8 ones = {0x3F80, 0x3F80, 0x3F80, 0x3F80, 0x3F80, 0x3F80, 0x3F80, 0x3F80};
#pragma unroll
  for (int kb = 0; kb < 2; ++kb)
#pragma unroll
    for (int qt = 0; qt < 2; ++qt) { os1[qt] = __builtin_amdgcn_mfma_f32_16x16x32_bf16(ones, pb1[kb][qt], os1[qt], 0, 0, 0); os2[qt] = __builtin_amdgcn_mfma_f32_16x16x32_bf16(ones, pb2[kb][qt], os2[qt], 0, 0, 0); }
#pragma unroll
  for (int dt = 0; dt < 4; ++dt)
#pragma unroll
    for (int kb = 0; kb < 2; ++kb) {
      const v4i16_t lo = tr16(Vt + (32 * kb + 4 * g + qq) * RP + dt * 16 + 4 * pp);
      const v4i16_t hi = tr16(Vt + (32 * kb + 16 + 4 * g + qq) * RP + dt * 16 + 4 * pp);
      const bf16x8 a = {lo[0], lo[1], lo[2], lo[3], hi[0], hi[1], hi[2], hi[3]};
#pragma unroll
      for (int qt = 0; qt < 2; ++qt) { o1[dt][qt] = __builtin_amdgcn_mfma_f32_16x16x32_bf16(a, pb1[kb][qt], o1[dt][qt], 0, 0, 0); o2[dt][qt] = __builtin_amdgcn_mfma_f32_16x16x32_bf16(a, pb2[kb][qt], o2[dt][qt], 0, 0, 0); }
    }
}
__device__ __forceinline__ void fill42(f32x4 (&a)[4][2], const f32x4 v) {
#pragma unroll
  for (int i = 0; i < 4; ++i)
#pragma unroll
    for (int j = 0; j < 2; ++j) a[i][j] = v;
}
__device__ __forceinline__ void exp42(f32x4 (&a)[4][2]) {
#pragma unroll
  for (int i = 0; i < 4; ++i)
#pragma unroll
    for (int j = 0; j < 2; ++j)
#pragma unroll
      for (int e = 0; e < 4; ++e) a[i][j][e] = __builtin_amdgcn_exp2f(a[i][j][e]);
}
#if defined(PROBE_PH) && PROBE_PH == 300
#define AT_BAR() do { const unsigned long long _b0 = __builtin_amdgcn_s_memrealtime(); asm volatile("s_waitcnt lgkmcnt(0)" ::: "memory"); __builtin_amdgcn_s_barrier(); asm volatile("" ::: "memory"); F.pr_t1 += __builtin_amdgcn_s_memrealtime() - _b0; } while (0)
#else
#define AT_BAR() do { asm volatile("s_waitcnt lgkmcnt(0)" ::: "memory"); __builtin_amdgcn_s_barrier(); asm volatile("" ::: "memory"); } while (0)
#endif
__device__ __forceinline__ void zero42(f32x4 (&a)[4][2]) {
#pragma unroll
  for (int i = 0; i < 4; ++i)
#pragma unroll
    for (int j = 0; j < 2; ++j) a[i][j] = (f32x4){0.f, 0.f, 0.f, 0.f};
}

__device__ __forceinline__ void phase_compress(PREF p, Frame& F) {
  const int lane = fresh_lane(), w = F.wave, tid = F.tid;
  const int r = lane & 15, g4 = lane >> 4;
  const bf16_t* H = (const bf16_t*)(p.ws + WS_H);
  const bf16_t* W1T = (const bf16_t*)(p.ws + WS_CW1);
  LAS float* part = (LAS float*)F.lds;
  LAS float* hid = part + 8 * 16 * 64;
  LAS float* outv = hid + 16 * 64;
  for (int task = F.vcu; task < 256; task += F.G) {
    const int kv = task >> 7, rb = task & 127;
    int row = rb * 16 + r; if (row > 2039) row = 2039;
    const int gg = row & 1, cc = (row >> 1) % NCMP, bb = (row >> 1) / NCMP;
    const int colbase = OFF_NKV + ((0 * 2 + kv) * 2 + gg) * 64;
    f32x4 acc[4];
#pragma unroll
    for (int nt = 0; nt < 4; ++nt) acc[nt] = (f32x4){0.f, 0.f, 0.f, 0.f};
#pragma unroll 1
    for (int ks = 0; ks < 8; ++ks) {
      const int k = w * 256 + ks * 32 + g4 * 8, l = k >> 6, d0 = k & 63;
      float hv[8]; ld8bf(H + (size_t)(bb * SEQ + 16 * cc + l) * HC + colbase + d0, hv);
      const float* pe = p.cmp_pe + (kv * 32 + l) * 64 + d0;
#pragma unroll
      for (int i = 0; i < 8; ++i) hv[i] += pe[i];
      const bf16x8 a = __builtin_bit_cast(bf16x8, pk8(hv));
#pragma unroll
      for (int nt = 0; nt < 4; ++nt) {
        const bf16x8 bfr = *(const GAS bf16x8*)(W1T + ((size_t)kv * 64 + nt * 16 + r) * 2048 + k);
        acc[nt] = __builtin_amdgcn_mfma_f32_16x16x32_bf16(a, bfr, acc[nt], 0, 0, 0);
      }
    }
#pragma unroll
    for (int nt = 0; nt < 4; ++nt)
#pragma unroll
      for (int i = 0; i < 4; ++i) part[(w * 16 + g4 * 4 + i) * 64 + nt * 16 + r] = acc[nt][i];
    __syncthreads();
    for (int e = tid; e < 1024; e += NWAVES * 64) { float s = 0.f;
#pragma unroll
      for (int ww = 0; ww < 8; ++ww) s += part[ww * 1024 + e];
      hid[e] = gelu_tanh(s); }
    __syncthreads();
    const float* w2 = p.cmp_w2 + kv * 4096;
    for (int e = tid; e < 1024; e += NWAVES * 64) { const int rr = e >> 6, n = e & 63; float s = 0.f;
      for (int j = 0; j < 64; ++j) s += hid[rr * 64 + j] * w2[j * 64 + n];
      outv[e] = s; }
    __syncthreads();
    for (int e = tid; e < 1024; e += NWAVES * 64) { const int rr = e >> 6, n = e & 63;
      const int orow = rb * 16 + rr;
      if (orow < 2040) {
        float v = outv[e];
        if (kv == 0) { float ss = 0.f; for (int j = 0; j < 64; ++j) ss += outv[rr * 64 + j] * outv[rr * 64 + j]; v = v * rsqrtf(ss * (1.f / 64.f) + 1e-6f) * p.nk_norm[n]; }
        const int g2 = orow & 1, c2 = (orow >> 1) % NCMP, b2 = (orow >> 1) / NCMP;
        ((bf16_t*)(p.ws + (kv ? WS_VCMPB : WS_KCMPB)))[((size_t)(b2 * 2 + g2) * 256 + c2) * 64 + n] = (bf16_t)f2bf(v);
      }
    }
    if (task < 16 && tid < 64) { const int kk2 = task >> 3, bg = task & 7; ((bf16_t*)(p.ws + (kk2 ? WS_VCMPB : WS_KCMPB)))[((size_t)bg * 256 + 255) * 64 + tid] = 0; }
    __syncthreads();
  }
}

__device__ __forceinline__ v4u tile_ld(const bf16_t* base, size_t pitch, int tid) { return *(const GAS v4u*)(base + (size_t)(tid >> 3) * pitch + (tid & 7) * 8); }
__device__ __forceinline__ void tile_st(LAS bf16_t* dst, v4u v, int tid) { *(LAS v4u*)(dst + (tid >> 3) * RP + (tid & 7) * 8) = v; }

template <int KS, int MODE>
__device__ __forceinline__ void attn_tile(f32x4 (&o)[4][2], f32x4 (&os)[2], const bf16x8 (&qf)[2][KS], const LAS bf16_t* KBt, int kc0, const LAS bf16_t* VBt, const f32x4 nbv,
                                          const bool (&on)[2], int qq0, int koff, int lane) {
  const int r = lane & 15, g = lane >> 4;
  f32x4 st[4][2]; bf16x8 pb[2][2];
  fill42(st, nbv); qk_tile<KS>(st, KBt, kc0, qf, lane); exp42(st);
  if (MODE != 0) {
#pragma unroll
    for (int kt = 0; kt < 4; ++kt)
#pragma unroll
      for (int qt = 0; qt < 2; ++qt)
#pragma unroll
        for (int i = 0; i < 4; ++i) { const int kk = kt * 16 + g * 4 + i, qq = qq0 + qt * 16 + r;
          bool keep = true;
          if (MODE & 1) keep = keep && on[qt];
          if (MODE & 2) keep = keep && (kk + koff <= qq);
          if (MODE & 4) keep = keep && (kk > qq);
          if (!keep) st[kt][qt][i] = 0.f; }
  }
  pack_p(pb, st);
  pv_apply(o, os, pb, VBt, lane);
}
__device__ __forceinline__ void phase_diffattn(PREF p, Frame& F) {
  const int lane = fresh_lane(), w = F.wave, tid = F.tid;
  const int r = lane & 15, g = lane >> 4;
  const bf16_t* H = (const bf16_t*)(p.ws + WS_H);
  bf16_t* CAT = (bf16_t*)(p.ws + WS_CAT);
  float mq = 0.f, mk = 0.f, l0 = 0.f, l1 = 0.f;
  for (int i = 0; i < 32; i++) { mq = fmaxf(mq, fabsf(p.dq_norm[i])); mk = fmaxf(mk, fabsf(p.dk_norm[i])); l0 += p.dlam[i] * p.dlam[32 + i]; l1 += p.dlam[64 + i] * p.dlam[96 + i]; }
  const float c2 = 0.17677669529663687f * 1.4426950408889634f;
  const float nb = -(32.f * mq * mk) * c2;
  const f32x4 nbv = {nb, nb, nb, nb};
  const float lam = __expf(l0) - __expf(l1) + 0.2f;
  const bool on[2] = {true, true};
  for (int pr = F.vcu; pr < 256; pr += F.G) {
    const int bh = pr >> 3, sp = pr & 7, b = bh >> 3, hd = bh & 7;
#pragma unroll 1
    for (int ui = 0; ui < 2; ++ui) {
      const int qb = ui ? 15 - sp : sp;
      const int NT = 4 * (qb + 1);
      const bf16_t* Kg = H + (size_t)(b * SEQ) * HC + OFF_DK + hd * 64;
      const bf16_t* Vg = H + (size_t)(b * SEQ) * HC + OFF_DV + hd * 64;
      f32x4 o1[4][2];
#pragma unroll 1
      for (int mp = 0; mp < 2; ++mp) {
        bf16x8 qf[2][1];
#pragma unroll
        for (int qt = 0; qt < 2; ++qt) qf[qt][0] = *(const GAS bf16x8*)(H + (size_t)(b * SEQ + qb * 256 + w * 32 + qt * 16 + r) * HC + OFF_DQ + hd * 64 + mp * 32 + g * 8);
        f32x4 o[4][2]; zero42(o);
        f32x4 os[2] = {{0.f, 0.f, 0.f, 0.f}, {0.f, 0.f, 0.f, 0.f}};
        v4u krA = tile_ld(Kg, HC, tid), vrA = tile_ld(Vg, HC, tid);
        v4u krB = tile_ld(Kg + (size_t)64 * HC, HC, tid), vrB = tile_ld(Vg + (size_t)64 * HC, HC, tid);
#pragma unroll 1
        for (int t = 0; t < NT; t += 2) {
#pragma unroll
          for (int hf = 0; hf < 2; ++hf) {
            const int tt = t + hf;
            const lbf KBt = (lbf)(F.lds + hf * 2 * RB), VBt = KBt + 64 * RP;
            tile_st(KBt, hf ? krB : krA, tid); tile_st(VBt, hf ? vrB : vrA, tid);
            AT_BAR();
            if (tt + 2 < NT) { const v4u k2 = tile_ld(Kg + (size_t)(tt + 2) * 64 * HC, HC, tid), v2 = tile_ld(Vg + (size_t)(tt + 2) * 64 * HC, HC, tid);
              if (hf) { krB = k2; vrB = v2; } else { krA = k2; vrA = v2; } }
            const int koff = tt * 64 - (qb * 256 + w * 32);
            if (tt >= NT - 4) attn_tile<1, 2>(o, os, qf, KBt, mp * 32, VBt, nbv, on, 0, koff, lane);
            else attn_tile<1, 0>(o, os, qf, KBt, mp * 32, VBt, nbv, on, 0, koff, lane);
          }
        }
        if (mp == 0) {
#pragma unroll
          for (int qt = 0; qt < 2; ++qt) { const float i1 = 1.f / os[qt][0];
#pragma unroll
            for (int dt = 0; dt < 4; ++dt) o1[dt][qt] = o[dt][qt] * i1; }
        } else {
#pragma unroll
          for (int qt = 0; qt < 2; ++qt) {
            const float i2 = lam / os[qt][0];
            float ss = 0.f;
#pragma unroll
            for (int dt = 0; dt < 4; ++dt)
#pragma unroll
              for (int i = 0; i < 4; ++i) { const float v = o1[dt][qt][i] - o[dt][qt][i] * i2; o1[dt][qt][i] = v; ss += v * v; }
            ss += __shfl_xor(ss, 16, 64); ss += __shfl_xor(ss, 32, 64);
            const float rr = rsqrtf(ss * (1.f / 64.f) + 1e-6f) * 0.8f;
            bf16_t* op = CAT + (size_t)(b * SEQ + qb * 256 + w * 32 + qt * 16 + r) * DM + hd * 64;
#pragma unroll
            for (int dt = 0; dt < 4; ++dt) { const int d0 = dt * 16 + g * 4; const f32x4 sg = *(const f32x4*)(p.dsubln + d0);
              v2u wv; wv.x = pk2(o1[dt][qt][0] * rr * sg[0], o1[dt][qt][1] * rr * sg[1]); wv.y = pk2(o1[dt][qt][2] * rr * sg[2], o1[dt][qt][3] * rr * sg[3]);
              *(GAS v2u*)(op + d0) = wv; }
          }
        }
        AT_BAR();
      }
    }
  }
}

__device__ __forceinline__ void nsa_finish(f32x4 (&comb)[4][2], const f32x4 (&o)[4][2], const f32x4 (&os)[2], const float (&gate)[2], bool normalised) {
#pragma unroll
  for (int qt = 0; qt < 2; ++qt) {
    const float f = normalised ? gate[qt] : gate[qt] / os[qt][0];
#pragma unroll
    for (int dt = 0; dt < 4; ++dt) comb[dt][qt] += o[dt][qt] * f;
  }
}
__device__ __forceinline__ void phase_nsa(PREF p, Frame& F) {
  const int lane = fresh_lane(), w = F.wave, tid = F.tid;
  const int r = lane & 15, g = lane >> 4;
  const bf16_t* H = (const bf16_t*)(p.ws + WS_H);
  const float* GATES = (const float*)(p.ws + WS_GATES);
  bf16_t* CAT = (bf16_t*)(p.ws + WS_CAT);
  float mq = 0.f, mk0 = 0.f, mk1 = 0.f, mk2 = 0.f;
  for (int i = 0; i < 64; i++) { mq = fmaxf(mq, fabsf(p.nq_norm[i])); mk0 = fmaxf(mk0, fabsf(p.nk_norm[i])); mk1 = fmaxf(mk1, fabsf(p.nk_norm[64 + i])); mk2 = fmaxf(mk2, fabsf(p.nk_norm[128 + i])); }
  const float c2 = 0.125f * 1.4426950408889634f;
  const float nb0 = -(64.f * mq * mk0) * c2, nb1 = -(64.f * mq * mk1) * c2, nb2 = -(64.f * mq * mk2) * c2;
  LAS float* IMP = (LAS float*)(F.lds + 12 * RB);
  LAS unsigned char* SELB = (LAS unsigned char*)(F.lds + 12 * RB + 64 * 65 * 4);
  const int hj = w >> 1, th = w & 1;
  for (int pr = F.vcu; pr < 256; pr += F.G) {
    const int bg = pr >> 5, sp = pr & 31, b = bg >> 1, gq = bg & 1;
#pragma unroll 1
    for (int ui = 0; ui < 2; ++ui) {
      const int blk = ui ? 63 - sp : sp;
      const int hh = gq * 4 + hj;
      const int tokw = b * SEQ + blk * 64 + th * 32;
      bf16x8 qf[2][2];
      float gate0[2], gate1[2], gate2[2];
#pragma unroll
      for (int qt = 0; qt < 2; ++qt) { const bf16_t* qp = H + (size_t)(tokw + qt * 16 + r) * HC + OFF_NQ + hh * 64 + g * 8;
        qf[qt][0] = *(const GAS bf16x8*)qp; qf[qt][1] = *(const GAS bf16x8*)(qp + 32);
        const float* gp = GATES + (size_t)(tokw + qt * 16 + r) * 24 + hh * 3; gate0[qt] = gp[0]; gate1[qt] = gp[1]; gate2[qt] = gp[2]; }
      f32x4 comb[4][2]; zero42(comb);
      const int nct = (4 * blk + 3 + 63) >> 6;
      {
        const bf16_t* KC = (const bf16_t*)(p.ws + WS_KCMPB) + (size_t)(b * 2 + gq) * 256 * 64;
        const bf16_t* VC = (const bf16_t*)(p.ws + WS_VCMPB) + (size_t)(b * 2 + gq) * 256 * 64;
        for (int t4 = 0; t4 < nct; ++t4) { tile_st((lbf)(F.lds + t4 * RB), tile_ld(KC + t4 * 4096, 64, tid), tid); tile_st((lbf)(F.lds + (4 + t4) * RB), tile_ld(VC + t4 * 4096, 64, tid), tid); }
        for (int e = tid; e < 64 * 65; e += NWAVES * 64) IMP[e] = 0.f;
        AT_BAR();
        const f32x4 nbv0 = {nb0, nb0, nb0, nb0};
        int cmax[2];
#pragma unroll
        for (int qt = 0; qt < 2; ++qt) { const int pos = blk * 64 + th * 32 + qt * 16 + r; cmax[qt] = (pos >= 31) ? ((pos - 31) >> 4) : -1; }
        float lsum[2] = {0.f, 0.f};
        for (int t4 = 0; t4 < nct; ++t4) {
          f32x4 st[4][2]; fill42(st, nbv0);
          qk_tile<2>(st, (lbf)(F.lds + t4 * RB), 0, qf, lane); exp42(st);
#pragma unroll
          for (int kt = 0; kt < 4; ++kt)
#pragma unroll
            for (int qt = 0; qt < 2; ++qt)
#pragma unroll
              for (int i = 0; i < 4; ++i) { const int c = t4 * 64 + kt * 16 + g * 4 + i; if (c <= cmax[qt]) lsum[qt] += st[kt][qt][i]; }
        }
        float linv[2];
#pragma unroll
        for (int qt = 0; qt < 2; ++qt) { float s = lsum[qt]; s += __shfl_xor(s, 16, 64); s += __shfl_xor(s, 32, 64); linv[qt] = (cmax[qt] >= 0) ? 1.f / s : 0.f; }
        f32x4 o[4][2]; zero42(o);
        f32x4 osd[2] = {{0.f, 0.f, 0.f, 0.f}, {0.f, 0.f, 0.f, 0.f}};
        for (int t4 = 0; t4 < nct; ++t4) {
          f32x4 st[4][2]; fill42(st, nbv0);
          qk_tile<2>(st, (lbf)(F.lds + t4 * RB), 0, qf, lane); exp42(st);
#pragma unroll
          for (int kt = 0; kt < 4; ++kt)
#pragma unroll
            for (int qt = 0; qt < 2; ++qt) {
              float gs = 0.f;
#pragma unroll
              for (int i = 0; i < 4; ++i) { const int c = t4 * 64 + kt * 16 + g * 4 + i;
                const float e = (c <= cmax[qt]) ? st[kt][qt][i] * linv[qt] : 0.f;
                st[kt][qt][i] = e; gs += e; }
              const int ti = th * 32 + qt * 16 + r, j = t4 * 16 + kt * 4 + g;
              if (gs != 0.f) { __hip_atomic_fetch_add(IMP + ti * 65 + j, gs, __ATOMIC_RELAXED, __HIP_MEMORY_SCOPE_WORKGROUP); if (j < 63 && st[kt][qt][3] != 0.f) __hip_atomic_fetch_add(IMP + ti * 65 + j + 1, st[kt][qt][3], __ATOMIC_RELAXED, __HIP_MEMORY_SCOPE_WORKGROUP); }
            }
          bf16x8 pb[2][2]; pack_p(pb, st);
          pv_apply(o, osd, pb, (lbf)(F.lds + (4 + t4) * RB), lane);
        }
        nsa_finish(comb, o, osd, gate0, true);
      }
      AT_BAR();
      {
        const int ti = tid >> 3, jb = (tid & 7) * 8;
        float mine[8]; int rank[8];
#pragma unroll
        for (int u = 0; u < 8; ++u) { const int j = jb + u; float v = IMP[ti * 65 + j]; if (j == blk || j == 0) v = 1e4f; else if (j > blk) v = -1e30f; mine[u] = v; rank[u] = 0; }
        for (int i = 0; i < 64; ++i) { float v = IMP[ti * 65 + i]; if (i == blk || i == 0) v = 1e4f; else if (i > blk) v = -1e30f;
#pragma unroll
          for (int u = 0; u < 8; ++u) rank[u] += (v > mine[u] || (v == mine[u] && i < jb + u)) ? 1 : 0; }
        unsigned bits = 0;
#pragma unroll
        for (int u = 0; u < 8; ++u) bits |= (rank[u] < 16 ? 1u : 0u) << u;
        SELB[ti * 8 + (tid & 7)] = (unsigned char)bits;
      }
      AT_BAR();
      unsigned long long selm[2];
#pragma unroll
      for (int qt = 0; qt < 2; ++qt) { const int ti = th * 32 + qt * 16 + r; const LAS unsigned* sp2 = (const LAS unsigned*)(SELB + ti * 8); selm[qt] = (unsigned long long)sp2[0] | ((unsigned long long)sp2[1] << 32); }
#pragma unroll 1
      for (int br = 1; br < 3; ++br) {
        const int kcol = OFF_NKV + ((br * 2 + 0) * 2 + gq) * 64, vcol = OFF_NKV + ((br * 2 + 1) * 2 + gq) * 64;
        const float nbb = (br == 1) ? nb1 : nb2;
        const f32x4 nbv = {nbb, nbb, nbb, nbb};
        const int t_lo = (br == 1) ? 0 : (blk > 8 ? blk - 8 : 0);
        const bf16_t* Kg = H + (size_t)(b * SEQ) * HC + kcol;
        const bf16_t* Vg = H + (size_t)(b * SEQ) * HC + vcol;
        f32x4 o[4][2]; zero42(o);
        f32x4 os[2] = {{0.f, 0.f, 0.f, 0.f}, {0.f, 0.f, 0.f, 0.f}};
        v4u krA = tile_ld(Kg + (size_t)t_lo * 64 * HC, HC, tid), vrA = tile_ld(Vg + (size_t)t_lo * 64 * HC, HC, tid);
        v4u krB = krA, vrB = vrA;
        if (t_lo < blk) { krB = tile_ld(Kg + (size_t)(t_lo + 1) * 64 * HC, HC, tid); vrB = tile_ld(Vg + (size_t)(t_lo + 1) * 64 * HC, HC, tid); }
#pragma unroll 1
        for (int t0 = t_lo; t0 <= blk; t0 += 2) {
#pragma unroll
          for (int hf = 0; hf < 2; ++hf) {
            const int t = t0 + hf;
            if (t <= blk) {
              const lbf KBt = (lbf)(F.lds + (8 + hf * 2) * RB), VBt = KBt + 64 * RP;
              tile_st(KBt, hf ? krB : krA, tid); tile_st(VBt, hf ? vrB : vrA, tid);
              AT_BAR();
              if (t + 2 <= blk) { const v4u k2 = tile_ld(Kg + (size_t)(t + 2) * 64 * HC, HC, tid), v2 = tile_ld(Vg + (size_t)(t + 2) * 64 * HC, HC, tid);
                if (hf) { krB = k2; vrB = v2; } else { krA = k2; vrA = v2; } }
              const bool on[2] = {((selm[0] >> t) & 1ull) != 0ull, ((selm[1] >> t) & 1ull) != 0ull};
              const int qq0 = th * 32;
              if (br == 1) {
                if (__any((int)(on[0] || on[1]))) {
                  if (t == blk) attn_tile<2, 3>(o, os, qf, KBt, 0, VBt, nbv, on, qq0, 0, lane);
                  else if (__all((int)(on[0] && on[1]))) attn_tile<2, 0>(o, os, qf, KBt, 0, VBt, nbv, on, qq0, 0, lane);
                  else attn_tile<2, 1>(o, os, qf, KBt, 0, VBt, nbv, on, qq0, 0, lane);
                }
              } else {
                if (t == blk) attn_tile<2, 2>(o, os, qf, KBt, 0, VBt, nbv, on, qq0, 0, lane);
                else if (t == blk - 8) attn_tile<2, 4>(o, os, qf, KBt, 0, VBt, nbv, on, qq0, 0, lane);
                else attn_tile<2, 0>(o, os, qf, KBt, 0, VBt, nbv, on, qq0, 0, lane);
              }
            }
          }
        }
        nsa_finish(comb, o, os, (br == 1) ? gate1 : gate2, false);
        AT_BAR();
      }
#pragma unroll
      for (int qt = 0; qt < 2; ++qt) { bf16_t* op = CAT + (size_t)(tokw + qt * 16 + r) * DM + 512 + hh * 64;
#pragma unroll
        for (int dt = 0; dt < 4; ++dt) { const int d0 = dt * 16 + g * 4; v2u wv; wv.x = pk2(comb[dt][qt][0], comb[dt][qt][1]); wv.y = pk2(comb[dt][qt][2], comb[dt][qt][3]); *(GAS v2u*)(op + d0) = wv; } }
    }
  }
}


__device__ __forceinline__ void phase_lora2(PREF p, Frame& F, const bool skip_store = false, const bool skip_math = false) {
  const int lane = fresh_lane(), w = F.wave, tid = F.tid;
  const int cr = lane & 15, g = lane >> 4;
  constexpr int TP = 392;
  const lbf TM = (lbf)(F.lds);
  const lbf ST = (lbf)(F.lds + 64 * TP * 2) + w * 64 * RP;
  const bf16_t* TMPg = (const bf16_t*)(p.ws + WS_TMP);
  for (int unit = F.vcu; unit < 256; unit += F.G) {
    const int t0 = unit * 64;
    bf16x8 a0[2][4];
    auto wptr = [&](int blk) { const int tensor = blk >> 4, cb = blk & 15, ldw = (tensor == 2) ? 192 : 64;
      return (const bf16_t*)(p.ws + WS_WL2 + (size_t)tensor * 128 * 1024) + (size_t)(cb * 64 + cr) * ldw + g * 8; };
    auto wload = [&](int blk) {
      const int ldw = ((blk >> 4) == 2) ? 192 : 64; const bf16_t* Wp = wptr(blk);
#pragma unroll
      for (int k2 = 0; k2 < 2; ++k2)
#pragma unroll
        for (int ct = 0; ct < 4; ++ct) a0[k2][ct] = *(const GAS bf16x8*)(Wp + (size_t)(16 * ct) * ldw + k2 * 32);
    };
    auto blkof = [&](int j) { return ((j >> 1) << 4) | ((w * 2 + (j & 1) + unit * 3) & 15); };
    wload(blkof(0));
#pragma unroll
    for (int i = 0; i < 6; ++i) { const int idx = tid + i * 512, row = idx / 48, pc = idx - row * 48;
      *(LAS v4u*)(TM + row * TP + pc * 8) = *(const GAS v4u*)(TMPg + (size_t)(t0 + row) * 384 + pc * 8); }
    __syncthreads();
#pragma unroll 1
    for (int j = 0; j < 6; ++j) {
      const int blk = blkof(j);
      const int tensor = blk >> 4, cb = blk & 15, kc0 = tensor * 64;
      f32x4 acc[4][4];
#pragma unroll
      for (int ct = 0; ct < 4; ++ct)
#pragma unroll
        for (int tt = 0; tt < 4; ++tt) acc[ct][tt] = (f32x4){0.f, 0.f, 0.f, 0.f};
      auto kpair = [&](int kp, bf16x8 (&a)[2][4]) {
#pragma unroll
        for (int k2 = 0; k2 < 2; ++k2) {
          bf16x8 b[4];
#pragma unroll
          for (int tt = 0; tt < 4; ++tt) b[tt] = *(const LAS bf16x8*)(TM + (16 * tt + cr) * TP + kc0 + kp * 64 + k2 * 32 + g * 8);
#pragma unroll
          for (int ct = 0; ct < 4; ++ct)
#pragma unroll
            for (int tt = 0; tt < 4; ++tt) acc[ct][tt] = __builtin_amdgcn_mfma_f32_16x16x32_bf16(a[k2][ct], b[tt], acc[ct][tt], 0, 0, 0);
        }
      };
      if (tensor == 2) {
        bf16x8 a1[2][4], a2[2][4]; const bf16_t* Wp = wptr(blk);
#pragma unroll
        for (int k2 = 0; k2 < 2; ++k2)
#pragma unroll
          for (int ct = 0; ct < 4; ++ct) { a1[k2][ct] = *(const GAS bf16x8*)(Wp + (size_t)(16 * ct) * 192 + 64 + k2 * 32); a2[k2][ct] = *(const GAS bf16x8*)(Wp + (size_t)(16 * ct) * 192 + 128 + k2 * 32); }
        kpair(0, a0); kpair(1, a1); kpair(2, a2);
      } else kpair(0, a0);
      if (j < 5) wload(blkof(j + 1));
#pragma unroll
      for (int ct = 0; ct < 4; ++ct) {
        const int n0 = cb * 64 + 16 * ct + 4 * g;
        f32x4 bias = {0.f, 0.f, 0.f, 0.f};
        if (tensor == 0) bias = *(const f32x4*)(p.w0 + n0); else if (tensor == 1) bias = *(const f32x4*)(p.a0 + n0);
#pragma unroll
        for (int tt = 0; tt < 4; ++tt) {
          f32x4 v = acc[ct][tt] + bias;
          if (skip_math) {} else if (tensor == 0) {
#pragma unroll
            for (int i = 0; i < 4; ++i) v[i] = -0.60653066f * sigmoidf_(v[i]);
          } else if (tensor == 1) {
#pragma unroll
            for (int i = 0; i < 4; ++i) v[i] = sigmoidf_(v[i]);
          }
          v2u o; o.x = pk2(v[0], v[1]); o.y = pk2(v[2], v[3]);
          *(LAS v2u*)(ST + (16 * tt + cr) * RP + 16 * ct + 4 * g) = o;
        }
      }
      LDS_WAIT();
      bf16_t* O = (bf16_t*)(p.ws + WS_S0 + (size_t)tensor * SLOT) + (size_t)t0 * DM + cb * 64;
#pragma unroll
      for (int i = 0; i < 8; ++i) { const int row = (lane >> 3) + 8 * i, pc = (lane & 7) * 8;
        const v4u sv = *(const LAS v4u*)(ST + row * RP + pc); if (!skip_store) *(GAS v4u*)(O + (size_t)row * DM + pc) = sv; }
      LDS_WAIT();
    }
    __syncthreads();
  }
}

__global__ void __launch_bounds__(NWAVES * 64, 2) mk_fwd(P p_arg) {
  extern __shared__ __attribute__((aligned(16))) unsigned char lds[];
  Frame F;
  F.lds = (LAS unsigned char*)lds;
  F.MISC = (volatile LAS unsigned*)(F.lds + MISC_OFF);
  F.tid = threadIdx.x; F.lane = F.tid & 63; F.wave = __builtin_amdgcn_readfirstlane(F.tid >> 6);
  F.G = gridDim.x; { const int bx = blockIdx.x; F.vcu = (F.G % 8 == 0) ? (bx % 8) * (F.G / 8) + bx / 8 : bx; }
  unsigned char* const ws = p_arg.ws;
  F.ctl = (gu32*)(ws + WS_CTL);
  for (int u = F.tid; u < (LDS_BYTES - LDSCTL_OFF) / 4; u += NWAVES * 64) ((LAS unsigned*)(F.lds + LDSCTL_OFF))[u] = 0u;
  __syncthreads();
  XcdBarrier bar = xcd_barrier_post((unsigned*)(F.ctl + CW_BAR) + p_arg.pad * XCD_BAR_WORDS, F.MISC + 8);
  const int lo = p_arg.ph_lo, hi = p_arg.ph_hi;
#ifndef PHMASK
#define PHMASK 0xffffffffu
#endif
#define IN(k) (lo <= (k) && (k) < hi && ((PHMASK >> (k)) & 1u))
#define SEAM(k) do { if (IN(k) && IN((k) + 1)) xcd_barrier(bar); } while (0)
#ifdef PROBE_PH
  F.pr_t0 = 0; F.pr_t1 = 0;
#endif

  PROBE_MARK(0); if (IN(0)) { phase_prologue(KP, F); } SEAM(0);
  PROBE_MARK(1); if (IN(1)) {
    pg8::Gemm g{(const bf16_t*)(ws + WS_XN), (const bf16_t*)(ws + WS_WIN), DM, DM};
    pg8::StaticOrder S; S.init(T_TOK, 3072, F.G, (int)blockIdx.x);
    PREF p = KP; EpiInProj E{(bf16_t*)(ws + WS_H), (float*)(ws + WS_GATES), p.dq_norm, p.dk_norm, p.nq_norm, p.nk_norm, p.gate_bias};
    pg8::gemm_phase<EpiInProj, pg8::StaticOrder, true>(F.lds + RING_OFF, g, S, E);
  } SEAM(1);
  PROBE_MARK(2); if (IN(2)) { phase_compress(KP, F); phase_diffattn(KP, F); } SEAM(2);
  PROBE_MARK(3); if (IN(3)) { phase_nsa(KP, F); } SEAM(3);
  PROBE_MARK(4); if (IN(4)) {
    pg8::Gemm g{(const bf16_t*)(ws + WS_CAT), (const bf16_t*)(ws + WS_WOUT), DM, DM};
    pg8::StaticOrder S; S.init(T_TOK, DM, F.G, (int)blockIdx.x);
    PREF p = KP; EpiResid E{p.x, nullptr, (bf16_t*)p.out, nullptr};
    pg8::gemm_phase<EpiResid, pg8::StaticOrder, false>(F.lds + RING_OFF, g, S, E);
  } SEAM(4);
#define MOE_PHASES(layer, pb) do { \
    PROBE_MARK(pb); if (IN(pb)) { phase_router(KP, F, layer); } SEAM(pb); \
    PROBE_MARK(pb + 1); if (IN(pb + 1)) { \
      pg8::Gemm g{layer ? (const bf16_t*)(ws + WS_X3) : (const bf16_t*)KP.out, (const bf16_t*)(ws + WS_EGU), DM, DM}; \
      pg8::moe_order_setup((LAS int*)(F.lds + MISC_OFF + 256), (const unsigned*)(ws + WS_CTL) + CW_CNT + layer * 32 * 64); pg8::MoeOrder<2, true> S{(const LAS int*)(F.lds + MISC_OFF + 256), (const int*)(ws + WS_LIST), F.G, F.vcu}; \
      EpiMoeGU E{(bf16_t*)(ws + WS_HID), (const int*)(ws + WS_LIST), (const float*)(ws + WS_RS)}; \
      pg8::gemm_phase<EpiMoeGU, pg8::MoeOrder<2, true>, true>(F.lds + RING_OFF, g, S, E); \
    } SEAM(pb + 1); \
    PROBE_MARK(pb + 2); if (IN(pb + 2)) { \
      int k256 = 256; asm volatile("" : "+s"(k256)); \
      pg8::Gemm g{(const bf16_t*)(ws + WS_HID), (const bf16_t*)(ws + WS_EDN), k256, 256}; \
      pg8::moe_order_setup((LAS int*)(F.lds + MISC_OFF + 256), (const unsigned*)(ws + WS_CTL) + CW_CNT + layer * 32 * 64); pg8::MoeOrder<4, false> S{(const LAS int*)(F.lds + MISC_OFF + 256), (const int*)(ws + WS_LIST), F.G, F.vcu}; \
      PREF p = KP; EpiMoeDown E{layer ? (bf16_t*)(ws + WS_X3) : (bf16_t*)p.out, (bf16_t*)(ws + WS_Y1), (const int*)(ws + WS_LIST), (const float*)(ws + WS_PGATE), (LAS int*)(F.lds + 132096)}; \
      pg8::gemm_phase<EpiMoeDown, pg8::MoeOrder<4, false>, true>(F.lds + RING_OFF, g, S, E); \
    } SEAM(pb + 2); \
  } while (0)
  MOE_PHASES(0, 5);
  PROBE_MARK(8); if (IN(8)) { phase_rwkv_prep(KP, F); } SEAM(8);
  PROBE_MARK(9); if (IN(9)) {
    pg8::Gemm g{(const bf16_t*)(ws + WS_S0 + 3 * SLOT), (const bf16_t*)(ws + WS_WL1), DM, DM};
    pg8::TallOrder S; S.init(3, 1, F.G, (int)blockIdx.x);
    EpiLora1 E{(bf16_t*)(ws + WS_TMP)};
    pg8::gemm_phase<EpiLora1, pg8::TallOrder, false>(F.lds + RING_OFF, g, S, E);
  } SEAM(9);
  PROBE_MARK(10); if (IN(10)) {
    pg8::Gemm g{(const bf16_t*)(ws + WS_S0), (const bf16_t*)(ws + WS_WRKV), DM, DM};
    pg8::TallOrder S; S.init(3, 4, F.G, (int)blockIdx.x);
    EpiRKV E{ws};
    pg8::gemm_phase<EpiRKV, pg8::TallOrder, true>(F.lds + RING_OFF, g, S, E);
  } SEAM(10);
  PROBE_MARK(11); if (IN(11)) {
#ifdef EXP_A
    phase_lora2(KP, F, KP.ph_lo == 0, false); __syncthreads();
#endif
#ifdef EXP_B
    phase_lora2(KP, F, KP.ph_lo == 0, KP.ph_lo == 0); __syncthreads();
#endif
    phase_lora2(KP, F);
  } SEAM(11);
  PROBE_MARK(12); if (IN(12)) { phase_rwkv_r1(KP, F); } SEAM(12);
  PROBE_MARK(13); if (IN(13)) { phase_rwkv_r2(KP, F); } SEAM(13);
  PROBE_MARK(14); if (IN(14)) { phase_rwkv_r3(KP, F); } SEAM(14);
  PROBE_MARK(15); if (IN(15)) {
    pg8::Gemm g{(const bf16_t*)(ws + WS_S0 + 3 * SLOT), (const bf16_t*)(ws + WS_WO), DM, DM};
    pg8::StaticOrder S; S.init(T_TOK, DM, F.G, (int)blockIdx.x);
    PREF p = KP; EpiResid E{nullptr, (const bf16_t*)p.out, (bf16_t*)(ws + WS_X3), (const bf16_t*)(ws + WS_Y1)};
    pg8::gemm_phase<EpiResid, pg8::StaticOrder, false>(F.lds + RING_OFF, g, S, E);
  } SEAM(15);
  MOE_PHASES(1, 16);
#undef MOE_PHASES
  PROBE_MARK(19); if (IN(19)) { phase_final(KP, F); }
  PROBE_MARK(20);
#ifdef PROBE_PH
  { const unsigned long long dur = (F.pr_t1 - F.pr_t0) * PROBE_MUL, t0 = __builtin_amdgcn_s_memrealtime(); while (__builtin_amdgcn_s_memrealtime() - t0 < dur) __builtin_amdgcn_s_sleep(8); }
#endif
#undef IN
#undef SEAM
}

static void launch_mk(P p, int lo, int hi, int li, int grid, hipStream_t st) {
  p.ph_lo = lo; p.ph_hi = hi; p.pad = li;
  hipLaunchKernelGGL(mk_fwd, dim3(grid), dim3(NWAVES * 64), LDS_BYTES, st, p);
}

extern "C" void kernel_launch(void* const* d_in, const int* in_sizes, int n_in, void* d_out, int out_size, void* d_ws,
                              size_t ws_size, hipStream_t stream) {
  static int grid = 0;
  if (grid == 0) {
    if (n_in != 40 || ws_size < WS_END) { fprintf(stderr, "kernel_launch: bad n_in %d or ws_size %zu (< %zu)\n", n_in, ws_size, (size_t)WS_END); grid = -1; return; }
    int dev = 0, cus = 0;
    if (hipGetDevice(&dev) != hipSuccess || hipDeviceGetAttribute(&cus, hipDeviceAttributeMultiprocessorCount, dev) != hipSuccess) { grid = -1; return; }
    if (hipFuncSetAttribute((const void*)mk_fwd, hipFuncAttributeMaxDynamicSharedMemorySize, LDS_BYTES) != hipSuccess) { grid = -1; return; }
    if (cus < 256) { fprintf(stderr, "kernel_launch: needs 256 CUs (one workgroup per CU), found %d\n", cus); grid = -1; return; }
    grid = 256;
  }
  if (grid < 0) return;
  P p{};
  const float* const* in = (const float* const*)d_in;
  p.x = in[0]; p.mix_norm = in[1]; p.w_in = in[2]; p.gate_bias = in[3]; p.dq_norm = in[4]; p.dk_norm = in[5];
  p.dlam = in[6]; p.dsubln = in[7]; p.nq_norm = in[8]; p.nk_norm = in[9]; p.cmp_pe = in[10]; p.cmp_w1 = in[11];
  p.cmp_w2 = in[12]; p.w_out = in[13]; p.rmix = in[14]; p.w_r = in[15]; p.w_k = in[16]; p.w_v = in[17];
  p.w0 = in[18]; p.w1 = in[19]; p.w2 = in[20]; p.a0 = in[21]; p.a1 = in[22]; p.a2 = in[23]; p.g1 = in[24]; p.g2 = in[25];
  p.k_k = in[26]; p.k_a = in[27]; p.r_k = in[28]; p.ln_w = in[29]; p.ln_b = in[30]; p.w_o = in[31];
  p.ffn_norm = in[32]; p.rg_w = in[33]; p.rg_b = in[34]; p.re_w = in[35]; p.re_b = in[36];
  p.e_gate = in[37]; p.e_up = in[38]; p.e_down = in[39];
  p.out = (float*)d_out;
  p.ws = (unsigned char*)d_ws;
  unsigned char* ws = p.ws;
  (void)hipMemsetAsync(ws + WS_CTL, 0, CTL_ZERO_BYTES, stream);
  launch_mk(p, 0, 20, 0, grid, stream);
}
```

```cpp
#include <hip/hip_runtime.h>
#include <cstdio>
#include <cstdint>

#define T_TOK 16384
#define DM 1024
#define SEQ 4096
#define NBATCH 4
#define INC 2840
#define HC 2816
#define OFF_DQ 0
#define OFF_DK 512
#define OFF_DV 1024
#define OFF_NQ 1536
#define OFF_NKV 2048
#define OFF_NG 2816
#define NCMP 255
#define CAP 16384

#define GAS __attribute__((address_space(1)))
#define LAS __attribute__((address_space(3)))
typedef unsigned short bf16_t;
typedef unsigned v4u __attribute__((ext_vector_type(4)));
typedef unsigned v2u __attribute__((ext_vector_type(2)));
typedef float f32x4 __attribute__((ext_vector_type(4)));
typedef short bf16x8 __attribute__((ext_vector_type(8)));
typedef GAS unsigned gu32;
#define RLX_AGENT __ATOMIC_RELAXED, __HIP_MEMORY_SCOPE_AGENT
#define LDS_WAIT() asm volatile("s_waitcnt lgkmcnt(0)" ::: "memory")
#define VM_WAIT() asm volatile("s_waitcnt vmcnt(0)" ::: "memory")

__device__ __forceinline__ float bf2f(bf16_t v) { return __uint_as_float(((unsigned)v) << 16); }

typedef float f32x2_t __attribute__((ext_vector_type(2))); typedef __bf16 bf16x2_t __attribute__((ext_vector_type(2)));
__device__ __forceinline__ unsigned pk2(float lo, float hi) { const f32x2_t v = {lo, hi}; return __builtin_bit_cast(unsigned, __builtin_convertvector(v, bf16x2_t)); }
__device__ __forceinline__ unsigned f2bf(float f) { return pk2(f, f) & 0xffffu; }
__device__ __forceinline__ float wave_sum(float v) {
#pragma unroll
  for (int o = 32; o >= 1; o >>= 1) v += __shfl_xor(v, o, 64);
  return v;
}
__device__ __forceinline__ float wave_sum_dpp(float v) {
  v += __builtin_bit_cast(float, __builtin_amdgcn_update_dpp(0, __builtin_bit_cast(int, v), 0xB1, 0xf, 0xf, false));
  v += __builtin_bit_cast(float, __builtin_amdgcn_update_dpp(0, __builtin_bit_cast(int, v), 0x4E, 0xf, 0xf, false));
  v += __builtin_bit_cast(float, __builtin_amdgcn_update_dpp(0, __builtin_bit_cast(int, v), 0x141, 0xf, 0xf, false));
  v += __builtin_bit_cast(float, __builtin_amdgcn_update_dpp(0, __builtin_bit_cast(int, v), 0x140, 0xf, 0xf, false));
  const int iv = __builtin_bit_cast(int, v);
  return (__builtin_bit_cast(float, __builtin_amdgcn_readlane(iv, 0)) + __builtin_bit_cast(float, __builtin_amdgcn_readlane(iv, 16))) +
         (__builtin_bit_cast(float, __builtin_amdgcn_readlane(iv, 32)) + __builtin_bit_cast(float, __builtin_amdgcn_readlane(iv, 48)));
}
__device__ __forceinline__ int fresh_lane() { int l; asm volatile("v_mbcnt_lo_u32_b32 %0, -1, 0\n\tv_mbcnt_hi_u32_b32 %0, -1, %0" : "=v"(l)); return l; }
__device__ __forceinline__ float uniformf(float v) { return __builtin_bit_cast(float, __builtin_amdgcn_readfirstlane(__builtin_bit_cast(int, v))); }
__device__ __forceinline__ float sum_x32(float v) { const auto rr = __builtin_amdgcn_permlane32_swap(__float_as_uint(v), __float_as_uint(v), false, false); return __uint_as_float(rr[0]) + __uint_as_float(rr[1]); }
__device__ __forceinline__ float sum_x16(float v) { const auto rr = __builtin_amdgcn_permlane16_swap(__float_as_uint(v), __float_as_uint(v), false, false); return __uint_as_float(rr[0]) + __uint_as_float(rr[1]); }
__device__ __forceinline__ float sum_x16_32(float v) { return sum_x32(sum_x16(v)); }
__device__ __forceinline__ float sigmoidf_(float x) { return __builtin_amdgcn_rcpf(1.f + __builtin_amdgcn_exp2f(-1.44269504f * x)); }
__device__ __forceinline__ float tanhf_(float x) { return 1.f - 2.f * __builtin_amdgcn_rcpf(1.f + __builtin_amdgcn_exp2f(2.88539008f * x)); }
__device__ __forceinline__ float softplusf_(float x) { return fmaxf(x, 0.f) + __logf(1.f + __expf(-fabsf(x))); }
__device__ __forceinline__ float gelu_tanh(float x) {
  float u = 0.7978845608028654f * (x + 0.044715f * x * x * x);
  return 0.5f * x * (1.f + tanhf(u));
}

constexpr size_t MiB = 1u << 20;
constexpr size_t WS_CTL = 0, CTL_ZERO_BYTES = 160 * 1024;
constexpr size_t WS_WIN = 1 * MiB;
constexpr size_t WS_WOUT = 7 * MiB;
constexpr size_t WS_WRKV = 9 * MiB;
constexpr size_t WS_WO = 15 * MiB;
constexpr size_t WS_WL1 = 17 * MiB;
constexpr size_t WS_WL2 = 19 * MiB;
constexpr size_t WS_WR = 20 * MiB;
constexpr size_t WS_RS = 20 * MiB + 640 * 1024;
constexpr size_t WS_EGU = 22 * MiB;
constexpr size_t WS_EDN = 54 * MiB;
constexpr size_t WS_ACT = 70 * MiB;
constexpr size_t WS_XN = WS_ACT;
constexpr size_t WS_H = WS_ACT + 32 * MiB;
constexpr size_t WS_GATES = WS_ACT + 120 * MiB;
constexpr size_t WS_CAT = WS_ACT + 122 * MiB;
constexpr size_t WS_KCMPB = WS_ACT + 154 * MiB;
constexpr size_t WS_VCMPB = WS_ACT + 155 * MiB;
constexpr size_t WS_CW1 = 21 * MiB + 256 * 1024;
constexpr size_t WS_XN2 = WS_ACT;
constexpr size_t WS_HID = WS_ACT + 32 * MiB;
constexpr size_t WS_Y1 = WS_EGU;
constexpr size_t WS_LIST = WS_ACT + 156 * MiB;
constexpr size_t WS_PGATE = WS_ACT + 158 * MiB;
constexpr size_t WS_X3 = WS_ACT + 64 * MiB;
constexpr size_t WS_XN2F = WS_ACT;
constexpr size_t WS_GUF = WS_ACT + 64 * MiB;
constexpr size_t WS_S0 = WS_ACT;
constexpr size_t WS_TMP = WS_ACT + 192 * MiB;
constexpr size_t WS_END = WS_ACT + 204 * MiB;
constexpr size_t SLOT = 32 * MiB;
constexpr int CW_BAR = 4096;
constexpr int CW_CNT = 32768;

namespace pg8 {
#define PG8_LAS __attribute__((address_space(3)))
typedef unsigned u32x4 __attribute__((ext_vector_type(4)));
constexpr int BM = 256, BK = 64, HALF = 128, HTB = HALF * BK * 2  , STAGE_BYTES = 8 * HTB, NXCD = 8, WGM = 8;

__host__ __device__ __forceinline__ int lds_byte(int r, int c) { const int st = (r >> 4) * 2 + (c >> 5), rr = r & 15, cc = c & 31, ob = rr * 64 + cc * 2; return st * 1024 + (ob ^ (((ob >> 9) & 1) << 5)); }
__host__ __device__ __forceinline__ void stage_rc(int b, int& R, int& C) { const int st = b / 1024, sb = b % 1024, swz = sb ^ (((sb >> 9) & 1) << 5); R = (st >> 1) * 16 + swz / 64; C = (st & 1) * 32 + (swz % 64) / 2; }
__host__ __device__ __forceinline__ int perm32(int rho) { const int n = rho >> 4, i = rho & 15; return 8 * (i >> 2) + 4 * n + (i & 3); }

struct Unit { int pm, pn, e, nrows, rt, par; };
struct Gemm { const bf16_t* A; const bf16_t* Bt; int K; int lda; };

__device__ __forceinline__ void static_map(int L, int nM, int nN, int& pm, int& pn) {
    const int nwg = nM * nN;
    int wgid = L; { const int q = nwg / NXCD, r = nwg % NXCD, xcd = wgid % NXCD, off = wgid / NXCD; wgid = (xcd < r ? xcd * (q + 1) : r * (q + 1) + (xcd - r) * q) + off; }
    const int nig = WGM * nN, gid = wgid / nig, fm = gid * WGM, gsz = (nM - fm) < WGM ? (nM - fm) : WGM;
    pm = fm + ((wgid % nig) % gsz); pn = (wgid % nig) / gsz;
}
struct StaticOrder {
    int nM, nN, G, c;
    __device__ void init(int M, int N, int G_, int c_) { nM = M / BM; nN = N / BM; G = G_; c = c_; }
    __device__ __forceinline__ bool next(int i, Unit& u) const {
        const int L = i * G + c; if (L >= nM * nN) return false;
        static_map(L, nM, nN, u.pm, u.pn); u.e = 0; u.nrows = 256; u.rt = 0; return true;
    }
    __device__ __forceinline__ unsigned rowoff(const Unit& u, int r, int C, int K) const { return (unsigned)((u.pm * BM + r) * K + C) * 2u; }
};
struct TallOrder {
    int nM, nN, G, c;
    __device__ void init(int ngemm, int nN_, int G_, int c_) { nM = 64 * ngemm; nN = nN_; G = G_; c = c_; }
    __device__ __forceinline__ bool next(int i, Unit& u) const {
        const int L = i * G + c; if (L >= nM * nN) return false;
        int pn; static_map(L, nM, nN, u.pm, pn); u.pn = (u.pm >> 6) * nN + pn; u.e = 0; u.nrows = 256; u.rt = 0; return true;
    }
    __device__ __forceinline__ unsigned rowoff(const Unit& u, int r, int C, int K) const { return (unsigned)((u.pm * BM + r) * K + C) * 2u; }
};


template <int NCOL, bool GATHER>
struct MoeOrder {
    const PG8_LAS int* tab;
    const int* list; int G, c;
    __device__ __forceinline__ bool next(int i, Unit& u) const {
        const int L = i * G + c; const int R = L / NCOL, j = L - R * NCOL;
        if (R >= tab[32]) return false;
        int e = 0;
#pragma unroll
        for (int s = 16; s >= 1; s >>= 1) { if (tab[e + s] <= R) e += s; }
        const int ce = tab[33 + e];
        u.pm = R; u.rt = R - tab[e]; u.e = e; u.pn = e * NCOL + j; u.nrows = ce - u.rt * 256; return true;
    }
    __device__ __forceinline__ unsigned rowoff(const Unit& u, int r, int C, int K) const {
        if (GATHER) { const int idx = (r < u.nrows) ? u.rt * 256 + r : 0; const int pr = list[(size_t)u.e * CAP + idx]; return (unsigned)((pr >> 1) * K + C) * 2u; }
        return (unsigned)((u.pm * BM + r) * K + C) * 2u;
    }
};
__device__ __forceinline__ void moe_order_setup(PG8_LAS int* tab, const unsigned* cnt) {
    if (threadIdx.x < 32) tab[33 + threadIdx.x] = (int)__hip_atomic_load(cnt + threadIdx.x * 64, __ATOMIC_RELAXED, __HIP_MEMORY_SCOPE_AGENT);
    __syncthreads();
    if (threadIdx.x == 0) { int pre = 0; for (int e = 0; e < 32; ++e) { tab[e] = pre; pre += (tab[33 + e] + 255) >> 8; } tab[32] = pre; }
    __syncthreads();
}

__device__ __forceinline__ unsigned cvt_pk_bf16(float lo, float hi) { unsigned r; asm volatile("v_cvt_pk_bf16_f32 %0, %1, %2" : "=v"(r) : "v"(lo), "v"(hi)); return r; }
__device__ __forceinline__ u32x4 pack8(const f32x4& a, const f32x4& b) { u32x4 w; w.x = cvt_pk_bf16(a[0], a[1]); w.y = cvt_pk_bf16(a[2], a[3]); w.z = cvt_pk_bf16(b[0], b[1]); w.w = cvt_pk_bf16(b[2], b[3]); return w; }

template <class Epi, class Sched, bool ALIGN_EPI>
__device__ __forceinline__ void gemm_phase(PG8_LAS unsigned char* lds, const Gemm g, const Sched& S, const Epi& E) {
    const int tid = threadIdx.x, wid = __builtin_amdgcn_readfirstlane(tid >> 6), lane = tid & 63, wr = wid >> 2, wc = wid & 3, fr = lane & 15, fq = lane >> 4;
    const int K = g.K, nt = K / BK;
    int RA[2], CA[2]; unsigned voffB[2];
#pragma unroll
    for (int i = 0; i < 2; ++i) { int R, C; stage_rc(tid * 16 + i * 8192, R, C); const int Rb = Epi::PERM ? ((R & ~31) + perm32(R & 31)) : R;
        RA[i] = R; CA[i] = C; voffB[i] = (unsigned)(Rb * K + C) * 2u; }
    const size_t kstep = (size_t)(BK * 2);
    const size_t hstep = (size_t)HALF * K * 2;
    const size_t tstep = 2 * hstep;
    const unsigned ldsw = (unsigned)wid * 1024u;
    const int aoff = lds_byte(wr * 64 + fr, fq * 8), boff = lds_byte(wc * 32 + fr, fq * 8);
    const char* const Abase = (const char*)g.A;
#define PG8_SA(b, h) (((b) * 2 + (h)) * HTB)
#define PG8_SB(b, h) ((4 + (b) * 2 + (h)) * HTB)
#define PG8_STAGE(bufoff, gbase, voff) do { _Pragma("unroll") for (int _i = 0; _i < 2; ++_i) \
        __builtin_amdgcn_global_load_lds((const unsigned*)((const char*)(gbase) + (voff)[_i]), (PG8_LAS unsigned*)(lds + (bufoff) + ldsw + _i * 8192), 16, 0, 0); } while (0)
#define PG8_STAGEA(bufoff, kbyte, o0, o1) do { \
        __builtin_amdgcn_global_load_lds((const unsigned*)(Abase + (size_t)(kbyte) + (o0)), (PG8_LAS unsigned*)(lds + (bufoff) + ldsw), 16, 0, 0); \
        __builtin_amdgcn_global_load_lds((const unsigned*)(Abase + (size_t)(kbyte) + (o1)), (PG8_LAS unsigned*)(lds + (bufoff) + ldsw + 8192), 16, 0, 0); } while (0)
#define PG8_LDA(dst, b, h) do { _Pragma("unroll") for (int m = 0; m < 4; ++m) _Pragma("unroll") for (int k = 0; k < 2; ++k) dst[m][k] = *(const PG8_LAS bf16x8*)(lds + PG8_SA(b, h) + aoff + m * 2048 + k * 1024); } while (0)
#define PG8_LDB(dst, b, h) do { _Pragma("unroll") for (int n = 0; n < 2; ++n) _Pragma("unroll") for (int k = 0; k < 2; ++k) dst[n][k] = *(const PG8_LAS bf16x8*)(lds + PG8_SB(b, h) + boff + n * 2048 + k * 1024); } while (0)
#define PG8_MMA(ai, bj, At, Bt) do { __builtin_amdgcn_s_setprio(1); _Pragma("unroll") for (int m = 0; m < 4; ++m) _Pragma("unroll") for (int n = 0; n < 2; ++n) _Pragma("unroll") for (int k = 0; k < 2; ++k) \
        acc[ai][bj][m][n] = __builtin_amdgcn_mfma_f32_16x16x32_bf16(Bt[n][k], At[m][k], acc[ai][bj][m][n], 0, 0, 0); __builtin_amdgcn_s_setprio(0); } while (0)
#define PG8_WAIT_V(n) asm volatile("s_waitcnt vmcnt(" #n ")" ::: "memory")
#define PG8_WAIT_L(n) asm volatile("s_waitcnt lgkmcnt(" #n ")" ::: "memory")
#define PG8_BAR __builtin_amdgcn_s_barrier()
#define PG8_SCHED __builtin_amdgcn_sched_barrier(0)
    Unit cur, nxt; int ui = 0;
    if (!S.next(0, cur)) return;
    cur.par = 0;
    if constexpr (Epi::HAS_PRE) E.pre(cur);
    f32x4 acc[2][2][4][2];
#pragma unroll
    for (int a = 0; a < 2; ++a)
#pragma unroll
        for (int b = 0; b < 2; ++b)
#pragma unroll
            for (int m = 0; m < 4; ++m)
#pragma unroll
                for (int n = 0; n < 2; ++n) acc[a][b][m][n] = (f32x4){0.f, 0.f, 0.f, 0.f};
    bf16x8 At[4][2], B0[2][2], B1[2][2];
    unsigned c00 = S.rowoff(cur, RA[0], CA[0], g.lda), c01 = S.rowoff(cur, RA[1], CA[1], g.lda), c10 = S.rowoff(cur, HALF + RA[0], CA[0], g.lda), c11 = S.rowoff(cur, HALF + RA[1], CA[1], g.lda);
    unsigned n00, n01, n10, n11;
    const char* cB = (const char*)g.Bt + (size_t)cur.pn * tstep;
    PG8_STAGE(PG8_SB(0, 0), cB, voffB); PG8_STAGE(PG8_SB(0, 1), cB + hstep, voffB); PG8_STAGEA(PG8_SA(0, 0), 0, c00, c01); PG8_STAGEA(PG8_SA(0, 1), 0, c10, c11);
    if (wr == 1) PG8_BAR;
    PG8_WAIT_V(2); PG8_BAR;
    PG8_STAGE(PG8_SB(1, 0), cB + kstep, voffB); PG8_STAGEA(PG8_SA(1, 0), kstep, c00, c01); PG8_STAGE(PG8_SB(1, 1), cB + hstep + kstep, voffB);
    PG8_WAIT_V(6); PG8_BAR;
    for (;;) {
        const bool has_next = S.next(ui + 1, nxt);
        const char* nB = has_next ? (const char*)g.Bt + (size_t)nxt.pn * tstep : cB;
        if (has_next) { n00 = S.rowoff(nxt, RA[0], CA[0], g.lda); n01 = S.rowoff(nxt, RA[1], CA[1], g.lda); n10 = S.rowoff(nxt, HALF + RA[0], CA[0], g.lda); n11 = S.rowoff(nxt, HALF + RA[1], CA[1], g.lda); }
        else { n00 = c00; n01 = c01; n10 = c10; n11 = c11; }
        for (int t = 0; t < nt; t += 2) {
            const bool last = (t == nt - 2);
            const size_t k1 = (size_t)(t + 1) * kstep;
            const size_t k2 = last ? 0 : (size_t)(t + 2) * kstep;
            const size_t k3 = k2 + kstep;
            const unsigned a00 = last ? n00 : c00, a01 = last ? n01 : c01, a10 = last ? n10 : c10, a11 = last ? n11 : c11;
            const char* b2 = last ? nB : cB + (size_t)(t + 2) * kstep;
            const char* b3 = b2 + kstep;
            PG8_LDB(B0, 0, 0); PG8_LDB(B1, 0, 1); PG8_SCHED; PG8_LDA(At, 0, 0); PG8_STAGEA(PG8_SA(1, 1), k1, c10, c11);
            PG8_WAIT_V(8); PG8_WAIT_L(0); PG8_BAR; PG8_MMA(0, 0, At, B0); PG8_MMA(0, 1, At, B1); PG8_BAR; PG8_SCHED;
            PG8_LDA(At, 0, 1); PG8_STAGE(PG8_SB(0, 0), b2, voffB); PG8_STAGE(PG8_SB(0, 1), b2 + hstep, voffB); PG8_STAGEA(PG8_SA(0, 0), k2, a00, a01);
            PG8_WAIT_V(8); PG8_WAIT_L(0); PG8_BAR; PG8_MMA(1, 0, At, B0); PG8_MMA(1, 1, At, B1); PG8_BAR; PG8_SCHED;
            PG8_LDB(B0, 1, 0); PG8_LDB(B1, 1, 1); PG8_SCHED; PG8_LDA(At, 1, 0); PG8_STAGEA(PG8_SA(0, 1), k2, a10, a11);
            PG8_WAIT_V(8); PG8_WAIT_L(0); PG8_BAR; PG8_MMA(0, 0, At, B0); PG8_MMA(0, 1, At, B1); PG8_BAR; PG8_SCHED;
            PG8_LDA(At, 1, 1); PG8_STAGE(PG8_SB(1, 0), b3, voffB); PG8_STAGE(PG8_SB(1, 1), b3 + hstep, voffB); PG8_STAGEA(PG8_SA(1, 0), k3, a00, a01);
            PG8_WAIT_V(8); PG8_WAIT_L(0); PG8_BAR; PG8_MMA(1, 0, At, B0); PG8_MMA(1, 1, At, B1); PG8_BAR; PG8_SCHED;
        }
        if constexpr (ALIGN_EPI) { if (wr == 0) PG8_BAR; }
        E(acc, cur, wr, wc, fr, fq);
        if (!has_next) break;
#pragma unroll
        for (int a = 0; a < 2; ++a)
#pragma unroll
            for (int b = 0; b < 2; ++b)
#pragma unroll
                for (int m = 0; m < 4; ++m)
#pragma unroll
                    for (int n = 0; n < 2; ++n) acc[a][b][m][n] = (f32x4){0.f, 0.f, 0.f, 0.f};
        cur = nxt; cB = nB; c00 = n00; c01 = n01; c10 = n10; c11 = n11; ++ui; cur.par = ui & 1;
        if constexpr (Epi::HAS_PRE) E.pre(cur);
        if constexpr (ALIGN_EPI) { if (wr == 1) PG8_BAR; }
    }
    PG8_WAIT_V(0);
    if constexpr (!ALIGN_EPI) { if (wr == 0) PG8_BAR; }
    PG8_BAR;
#undef PG8_SA
#undef PG8_SB
#undef PG8_STAGE
#undef PG8_STAGEA
#undef PG8_LDA
#undef PG8_LDB
#undef PG8_MMA
#undef PG8_WAIT_V
#undef PG8_WAIT_L
#undef PG8_BAR
#undef PG8_SCHED
}
}

#define XB_TMO      128
#define XB_XCNT(j)  (256  + 64 * (j))
#define XB_XSUB(j)  (1280 + 64 * (j))
#define XB_XGEN(j)  (2304 + 64 * (j))
#define XB_TOP      3328
#define XB_TOPGEN   3392
#define XCD_BAR_WORDS 3456
#define XB_SPIN_CAP (1u << 18)

__device__ __forceinline__ unsigned xb_ld(unsigned* p)              { return __hip_atomic_load(p, __ATOMIC_RELAXED, __HIP_MEMORY_SCOPE_AGENT); }
__device__ __forceinline__ unsigned xb_add(unsigned* p, unsigned v) { return __hip_atomic_fetch_add(p, v, __ATOMIC_RELAXED, __HIP_MEMORY_SCOPE_AGENT); }
__device__ __forceinline__ unsigned xb_xcc_id() { return (unsigned)__builtin_amdgcn_s_getreg((3 << 11) | 20) & 0xFu; }
#define XB_SPIN(cond, bar) do { unsigned _sp = 0; while (cond) { __builtin_amdgcn_s_sleep(1); \
    if ((++_sp & 255u) == 0u) { if (xb_ld(&(bar)[XB_TMO])) break; if (_sp > XB_SPIN_CAP) { atomicAdd(&(bar)[XB_TMO], 1u); break; } } } } while (0)

struct XcdBarrier {
    unsigned* bar; unsigned x;
    volatile LAS unsigned* st;
};

__device__ __forceinline__ XcdBarrier xcd_barrier_post(unsigned* bar, volatile LAS unsigned* st) {
    XcdBarrier b; b.bar = bar; b.x = xb_xcc_id(); b.st = st;
    if (threadIdx.x == 0) (void)xb_add(&bar[XB_XCNT(b.x)], 1u);
    return b;
}
__device__ __forceinline__ void xcd_barrier_complete(unsigned* bar, unsigned x, unsigned& nloc, unsigned& nx) {
    const unsigned G = gridDim.x * gridDim.y * gridDim.z;
    unsigned sum, cnt, mine, sp = 0u;
    for (;;) {
        sum = 0u; cnt = 0u; mine = 0u;
#pragma unroll
        for (unsigned j = 0; j < 16; ++j) { const unsigned c = xb_ld(&bar[XB_XCNT(j)]); sum += c; cnt += (c > 0u) ? 1u : 0u; mine = (j == x) ? c : mine; }
        if (sum == G) break;
        __builtin_amdgcn_s_sleep(1);
        if ((++sp & 255u) == 0u) { if (xb_ld(&bar[XB_TMO])) break; if (sp > XB_SPIN_CAP) { atomicAdd(&bar[XB_TMO], 1u); break; } }
    }
    nloc = mine > 0u ? mine : 1u; nx = cnt > 0u ? cnt : 1u;
}

__device__ __forceinline__ void xcd_barrier(const XcdBarrier& b) {
    asm volatile("s_waitcnt vmcnt(0)" ::: "memory");
    __syncthreads();
    if (threadIdx.x == 0) {
        unsigned* bar = b.bar;
        __builtin_amdgcn_s_waitcnt(0);
        unsigned nloc = b.st[0], nx = b.st[1];
        if (nloc == 0u) { xcd_barrier_complete(bar, b.x, nloc, nx); b.st[0] = nloc; b.st[1] = nx; }
        const unsigned old = xb_add(&bar[XB_XSUB(b.x)], 1u);
        const unsigned gen = old / nloc;
        if (old + 1u == (gen + 1u) * nloc) {
            __builtin_amdgcn_fence(__ATOMIC_RELEASE, "agent");
            asm volatile("s_waitcnt vmcnt(0)" ::: "memory");
            const unsigned og = xb_add(&bar[XB_TOP], 1u);
            const unsigned tg = og / nx;
            if (og + 1u == (tg + 1u) * nx) xb_add(&bar[XB_TOPGEN], 1u);
            else XB_SPIN(xb_ld(&bar[XB_TOPGEN]) == tg, bar);
            __builtin_amdgcn_fence(__ATOMIC_ACQUIRE, "agent");
            xb_add(&bar[XB_XGEN(b.x)], 1u);
            asm volatile("s_waitcnt vmcnt(0)" ::: "memory");
        } else {
            XB_SPIN(xb_ld(&bar[XB_XGEN(b.x)]) == gen, bar);
            __builtin_amdgcn_fence(__ATOMIC_ACQUIRE, "agent");
            asm volatile("s_waitcnt vmcnt(0)" ::: "memory");
        }
    }
    __syncthreads();
}
struct P {
  const float* x; const float* mix_norm; const float* w_in; const float* gate_bias;
  const float* dq_norm; const float* dk_norm; const float* dlam; const float* dsubln;
  const float* nq_norm; const float* nk_norm; const float* cmp_pe; const float* cmp_w1; const float* cmp_w2;
  const float* w_out;
  const float* rmix; const float* w_r; const float* w_k; const float* w_v;
  const float* w0; const float* w1; const float* w2; const float* a0; const float* a1; const float* a2;
  const float* g1; const float* g2; const float* k_k; const float* k_a; const float* r_k;
  const float* ln_w; const float* ln_b; const float* w_o;
  const float* ffn_norm; const float* rg_w; const float* rg_b; const float* re_w; const float* re_b;
  const float* e_gate; const float* e_up; const float* e_down;
  float* out;
  unsigned char* ws;
  int ph_lo, ph_hi, layer, pad;
};

#define PREF const __attribute__((address_space(4))) P&
__device__ __forceinline__ const __attribute__((address_space(4))) P* opaque_kernarg() { auto q = __builtin_amdgcn_kernarg_segment_ptr(); asm volatile("" : "+s"(q)); return (const __attribute__((address_space(4))) P*)q; }
#define KP (*opaque_kernarg())

constexpr int RING_OFF = 0, RING_BYTES = 131072;
constexpr int LDSCTL_OFF = RING_BYTES, MISC_OFF = LDSCTL_OFF + 320;
constexpr int LDS_BYTES = 147456;
constexpr int NWAVES = 8;

struct Frame {
  LAS unsigned char* lds;
  volatile LAS unsigned* MISC;
  gu32* ctl;
  int tid, lane, wave, vcu, G;
#ifdef PROBE_PH
  unsigned long long pr_t0, pr_t1;
#endif
};
#ifdef PROBE_PH
#define PROBE_MARK(k) do { if ((k) == PROBE_PH) F.pr_t0 = __builtin_amdgcn_s_memrealtime(); if ((k) == PROBE_PH + PROBE_N) F.pr_t1 = __builtin_amdgcn_s_memrealtime(); } while (0)
#else
#define PROBE_MARK(k) do {} while (0)
#endif

__device__ __forceinline__ void transpose_item(const float* W, int ldsrc, int k0, int c0, int ncols, bf16_t* dst, int ldk, int drow0, LAS float* scr, int lane, const float* kscale = nullptr) {
  const int kr = lane >> 3, c4 = (lane & 7) * 4;
  f32x4 v[8];
#pragma unroll
  for (int i = 0; i < 8; ++i) v[i] = (c4 < ncols) ? *(const GAS f32x4*)(W + (size_t)(k0 + kr + 8 * i) * ldsrc + c0 + c4) : (f32x4){0.f, 0.f, 0.f, 0.f};
  if (kscale) {
#pragma unroll
    for (int i = 0; i < 8; ++i) v[i] = v[i] * kscale[k0 + kr + 8 * i]; }
#pragma unroll
  for (int i = 0; i < 8; ++i) { LAS float* s = scr + (kr + 8 * i) * 33 + c4; s[0] = v[i].x; s[1] = v[i].y; s[2] = v[i].z; s[3] = v[i].w; }
  LDS_WAIT(); asm volatile("" ::: "memory");
  const int c = lane & 7;
#pragma unroll
  for (int j = 0; j < 4; ++j) { const int n = (lane >> 3) + 8 * j; const LAS float* s = scr + (8 * c) * 33 + n;
    v4u o; o.x = pk2(s[0 * 33], s[1 * 33]); o.y = pk2(s[2 * 33], s[3 * 33]); o.z = pk2(s[4 * 33], s[5 * 33]); o.w = pk2(s[6 * 33], s[7 * 33]);
    *(GAS v4u*)(dst + (size_t)(drow0 + n) * ldk + k0 + 8 * c) = o; }
  LDS_WAIT(); asm volatile("" ::: "memory");
}
template <int NR>
__device__ __forceinline__ void rms_rows_to_bf16(const float* x, const float* gain, bf16_t* o, int m0, int stride, int lane) {
  f32x4 v[NR][4];
#pragma unroll
  for (int r = 0; r < NR; ++r) { const GAS f32x4* xr = (const GAS f32x4*)(x + (size_t)(m0 + r * stride) * DM) + lane;
#pragma unroll
    for (int j = 0; j < 4; ++j) v[r][j] = xr[64 * j]; }
  const GAS f32x4* gr = (const GAS f32x4*)gain + lane;
  f32x4 g[4];
#pragma unroll
  for (int j = 0; j < 4; ++j) g[j] = gr[64 * j];
#pragma unroll
  for (int r = 0; r < NR; ++r) {
    float s = 0.f;
#pragma unroll
    for (int j = 0; j < 4; ++j) s += (v[r][j].x * v[r][j].x + v[r][j].y * v[r][j].y) + (v[r][j].z * v[r][j].z + v[r][j].w * v[r][j].w);
    const float rr = rsqrtf(wave_sum_dpp(s) * (1.f / DM) + 1e-6f);
    GAS v2u* o8 = (GAS v2u*)(o + (size_t)(m0 + r * stride) * DM) + lane;
#pragma unroll
    for (int j = 0; j < 4; ++j) { v2u w; w.x = pk2(v[r][j].x * rr * g[j].x, v[r][j].y * rr * g[j].y); w.y = pk2(v[r][j].z * rr * g[j].z, v[r][j].w * rr * g[j].w); o8[64 * j] = w; }
  }
}

__device__ __forceinline__ void conv_win_item(PREF p, int it, LAS float* scr, int lane) {
  const int vg = it >> 4, kb = it & 15;
  const int pn = vg >> 3, bj = (vg >> 2) & 1, wc = vg & 3, s = pn * 4 + wc;
  int c0 = 0, nc = 0;
  if (s < 44) { c0 = 64 * s + 32 * bj; nc = 32; } else if (s == 44 && bj == 0) { c0 = OFF_NG; nc = 24; }
  transpose_item(p.w_in, INC, kb * 64, c0, nc, (bf16_t*)(p.ws + WS_WIN), DM, vg * 32, scr, lane);
}
__device__ __forceinline__ void conv_sq_item(const float* W, bf16_t* dst, int drow_base, int it, LAS float* scr, int lane) {
  const int cg = it >> 4, kb = it & 15;
  transpose_item(W, DM, kb * 64, cg * 32, 32, dst, DM, drow_base + cg * 32, scr, lane);
}
__device__ __forceinline__ void conv_expert_item(PREF p, int layer, int it, LAS float* scr, int lane, bf16_t* egu) {
  const int e = it / 384, r = it % 384;
  if (r < 256) {
    const int up = r >> 7, q = r & 127, cgp = q >> 4, kb = q & 15;
    const int pn = cgp >> 2, qq = cgp & 3;
    const float* W = (up ? p.e_up : p.e_gate) + ((size_t)layer * 32 + e) * DM * 256;
    transpose_item(W, 256, kb * 64, cgp * 32, 32, egu, DM, e * 512 + pn * 256 + up * 128 + qq * 32, scr, lane, p.ffn_norm + layer * DM);
  } else {
    const int q = r - 256, cg = q >> 2, kb = q & 3;
    const float* W = p.e_down + ((size_t)layer * 32 + e) * 256 * DM;
    transpose_item(W, DM, kb * 64, cg * 32, 32, (bf16_t*)(p.ws + WS_EDN), 256, e * 1024 + cg * 32, scr, lane);
  }
}

using pg8::Unit; using pg8::u32x4; using pg8::pack8;
struct EpiInProj {
  static constexpr bool PERM = true, HAS_PRE = false;
  bf16_t* H; float* GATES; const float* dq; const float* dk; const float* nq; const float* nk; const float* gbias;
  __device__ __forceinline__ void operator()(const f32x4 (&acc)[2][2][4][2], const Unit& u, int wr, int wc, int fr, int fq) const {
    const int s = u.pn * 4 + wc;
    if (s > 44) return;
    const int row0 = u.pm * 256 + wr * 64 + fr;
    if (s == 44) {
      if (fq < 3) {
        f32x4 b0 = *(const f32x4*)(gbias + 8 * fq), b1 = *(const f32x4*)(gbias + 8 * fq + 4);
#pragma unroll
        for (int ai = 0; ai < 2; ++ai)
#pragma unroll
          for (int m = 0; m < 4; ++m) { float* gp = GATES + (size_t)(row0 + ai * 128 + m * 16) * 24 + 8 * fq;
            f32x4 v0 = acc[ai][0][m][0] + b0, v1 = acc[ai][0][m][1] + b1;
#pragma unroll
            for (int i = 0; i < 4; ++i) { v0[i] = sigmoidf_(v0[i]); v1[i] = sigmoidf_(v1[i]); }
            *(f32x4*)gp = v0; *(f32x4*)(gp + 4) = v1; }
      }
      return;
    }
    int mode = 0; const float* gain = nullptr;
    if (s < 8) { mode = 1; gain = dq; } else if (s < 16) { mode = 1; gain = dk; }
    else if (s >= 24 && s < 32) { mode = 2; gain = nq; }
    else if (s >= 32) { const int q = s - 32, br = q >> 2, kv = (q >> 1) & 1; if (kv == 0 && br >= 1) { mode = 2; gain = nk + br * 64; } }
    const float qsc = (s < 8) ? 0.17677669529663687f * 1.4426950408889634f : ((s >= 24 && s < 32) ? 0.125f * 1.4426950408889634f : 1.f);
    f32x4 g[2][2];
#pragma unroll
    for (int bj = 0; bj < 2; ++bj)
#pragma unroll
      for (int n = 0; n < 2; ++n) {
        if (mode == 1) g[bj][n] = *(const f32x4*)(gain + 8 * fq + 4 * n);
        else if (mode == 2) g[bj][n] = *(const f32x4*)(gain + 32 * bj + 8 * fq + 4 * n);
        else g[bj][n] = (f32x4){1.f, 1.f, 1.f, 1.f};
      }
#pragma unroll
    for (int ai = 0; ai < 2; ++ai)
#pragma unroll
      for (int m = 0; m < 4; ++m) {
        float sc[2] = {1.f, 1.f};
        if (mode != 0) {
          float ss[2];
#pragma unroll
          for (int bj = 0; bj < 2; ++bj) { const f32x4 a = acc[ai][bj][m][0], b = acc[ai][bj][m][1];
            float t = (a[0] * a[0] + a[1] * a[1]) + (a[2] * a[2] + a[3] * a[3]) + (b[0] * b[0] + b[1] * b[1]) + (b[2] * b[2] + b[3] * b[3]);
            ss[bj] = sum_x16_32(t); }
          if (mode == 1) { sc[0] = rsqrtf(ss[0] * (1.f / 32.f) + 1e-6f) * qsc; sc[1] = rsqrtf(ss[1] * (1.f / 32.f) + 1e-6f) * qsc; }
          else { const float r = rsqrtf((ss[0] + ss[1]) * (1.f / 64.f) + 1e-6f) * qsc; sc[0] = r; sc[1] = r; }
        }
        bf16_t* rowp = H + (size_t)(row0 + ai * 128 + m * 16) * HC + 64 * s + 8 * fq;
#pragma unroll
        for (int bj = 0; bj < 2; ++bj) { const f32x4 v0 = acc[ai][bj][m][0] * sc[bj] * g[bj][0], v1 = acc[ai][bj][m][1] * sc[bj] * g[bj][1];
          *(u32x4*)(rowp + 32 * bj) = pack8(v0, v1); }
      }
  }
};
struct EpiResid {
  static constexpr bool PERM = true, HAS_PRE = false;
  const float* xf; const bf16_t* xb; bf16_t* out; const bf16_t* y1;
  __device__ __forceinline__ void operator()(const f32x4 (&acc)[2][2][4][2], const Unit& u, int wr, int wc, int fr, int fq) const {
    const int row0 = u.pm * 256 + wr * 64 + fr, col0 = u.pn * 256 + wc * 32 + 8 * fq;
#pragma unroll
    for (int ai = 0; ai < 2; ++ai)
#pragma unroll
      for (int m = 0; m < 4; ++m) { const size_t off = (size_t)(row0 + ai * 128 + m * 16) * DM + col0;
#pragma unroll
        for (int bj = 0; bj < 2; ++bj) {
          f32x4 b0, b1;
          if (xf) { b0 = *(const f32x4*)(xf + off + bj * 128); b1 = *(const f32x4*)(xf + off + bj * 128 + 4); }
          else { const v4u w = *(const v4u*)(xb + off + bj * 128);
            b0 = (f32x4){__uint_as_float(w.x << 16), __uint_as_float(w.x & 0xffff0000u), __uint_as_float(w.y << 16), __uint_as_float(w.y & 0xffff0000u)};
            b1 = (f32x4){__uint_as_float(w.z << 16), __uint_as_float(w.z & 0xffff0000u), __uint_as_float(w.w << 16), __uint_as_float(w.w & 0xffff0000u)}; }
          if (y1) { const v4u w = *(const v4u*)(y1 + off + bj * 128);
            b0 += (f32x4){__uint_as_float(w.x << 16), __uint_as_float(w.x & 0xffff0000u), __uint_as_float(w.y << 16), __uint_as_float(w.y & 0xffff0000u)};
            b1 += (f32x4){__uint_as_float(w.z << 16), __uint_as_float(w.z & 0xffff0000u), __uint_as_float(w.w << 16), __uint_as_float(w.w & 0xffff0000u)}; }
          *(u32x4*)(out + off + bj * 128) = pack8(b0 + acc[ai][bj][m][0], b1 + acc[ai][bj][m][1]); asm volatile("" ::: "memory"); } }
  }
};
struct EpiRKV {
  static constexpr bool PERM = true, HAS_PRE = false;
  unsigned char* ws;
  __device__ __forceinline__ void operator()(const f32x4 (&acc)[2][2][4][2], const Unit& u, int wr, int wc, int fr, int fq) const {
    const int gi = u.pm >> 6;
    bf16_t* O = (bf16_t*)(ws + WS_S0 + (size_t)(3 + gi) * SLOT);
    const int row0 = (u.pm & 63) * 256 + wr * 64 + fr, col0 = (u.pn & 3) * 256 + wc * 32 + 8 * fq;
#pragma unroll
    for (int ai = 0; ai < 2; ++ai)
#pragma unroll
      for (int m = 0; m < 4; ++m) { bf16_t* rowp = O + (size_t)(row0 + ai * 128 + m * 16) * DM + col0;
#pragma unroll
        for (int bj = 0; bj < 2; ++bj) *(u32x4*)(rowp + bj * 128) = pack8(acc[ai][bj][m][0], acc[ai][bj][m][1]); }
  }
};
struct EpiLora1 {
  static constexpr bool PERM = true, HAS_PRE = false;
  bf16_t* TMP;
  template <int BJ>
  __device__ __forceinline__ void half(const f32x4 (&acc)[2][2][4][2], int gi, int row0, int wc, int fq) const {
    const int c = BJ * 128 + wc * 32 + 8 * fq;
    const bool skip = (gi < 2) && (c >= 64);
    const int dcol = (gi < 2) ? gi * 64 + c : 128 + c;
    const bool zero = (gi == 2) && (c >= 160);
    if (skip) return;
#pragma unroll
    for (int ai = 0; ai < 2; ++ai)
#pragma unroll
      for (int m = 0; m < 4; ++m) {
        f32x4 v0 = acc[ai][BJ][m][0], v1 = acc[ai][BJ][m][1];
#pragma unroll
        for (int i = 0; i < 4; ++i) {
          if (gi == 0) { v0[i] = tanhf_(v0[i]); v1[i] = tanhf_(v1[i]); }
          else if (gi == 2) { v0[i] = zero ? 0.f : sigmoidf_(v0[i]); v1[i] = zero ? 0.f : sigmoidf_(v1[i]); }
        }
        *(u32x4*)(TMP + (size_t)(row0 + ai * 128 + m * 16) * 384 + dcol) = pack8(v0, v1);
      }
  }
  __device__ __forceinline__ void operator()(const f32x4 (&acc)[2][2][4][2], const Unit& u, int wr, int wc, int fr, int fq) const {
    const int gi = u.pm >> 6;
    const int row0 = (u.pm & 63) * 256 + wr * 64 + fr;
    half<0>(acc, gi, row0, wc, fq);
    half<1>(acc, gi, row0, wc, fq);
  }
};
struct EpiLora2 {
  static constexpr bool PERM = true, HAS_PRE = false;
  unsigned char* ws; const float* w0; const float* a0; int gbase;
  __device__ __forceinline__ void operator()(const f32x4 (&acc)[2][2][4][2], const Unit& u, int wr, int wc, int fr, int fq) const {
    const int gi = gbase + (u.pn >> 2);
    bf16_t* O = (bf16_t*)(ws + WS_S0 + (size_t)gi * SLOT);
    const int row0 = u.pm * 256 + wr * 64 + fr, col0 = (u.pn & 3) * 256 + wc * 32 + 8 * fq;
    f32x4 b[2][2];
#pragma unroll
    for (int bj = 0; bj < 2; ++bj)
#pragma unroll
      for (int n = 0; n < 2; ++n) b[bj][n] = (gi == 0) ? *(const f32x4*)(w0 + col0 + bj * 128 + 4 * n) : (gi == 1 ? *(const f32x4*)(a0 + col0 + bj * 128 + 4 * n) : (f32x4){0.f, 0.f, 0.f, 0.f});
#pragma unroll
    for (int ai = 0; ai < 2; ++ai)
#pragma unroll
      for (int m = 0; m < 4; ++m) { bf16_t* rowp = O + (size_t)(row0 + ai * 128 + m * 16) * DM + col0;
#pragma unroll
        for (int bj = 0; bj < 2; ++bj) { f32x4 v0 = acc[ai][bj][m][0] + b[bj][0], v1 = acc[ai][bj][m][1] + b[bj][1];
          if (gi == 0) {
#pragma unroll
            for (int i = 0; i < 4; ++i) { v0[i] = -__expf(-softplusf_(-v0[i]) - 0.5f); v1[i] = -__expf(-softplusf_(-v1[i]) - 0.5f); }
          } else if (gi == 1) {
#pragma unroll
            for (int i = 0; i < 4; ++i) { v0[i] = sigmoidf_(v0[i]); v1[i] = sigmoidf_(v1[i]); }
          }
          *(u32x4*)(rowp + bj * 128) = pack8(v0, v1); } }
  }
};
struct EpiMoeGU {
  static constexpr bool PERM = true, HAS_PRE = false;
  bf16_t* HID; const int* list; const float* RS;
  __device__ __forceinline__ void operator()(const f32x4 (&acc)[2][2][4][2], const Unit& u, int wr, int wc, int fr, int fq) const {
    const int row0 = u.pm * 256 + wr * 64 + fr, col0 = (u.pn & 1) * 128 + wc * 32 + 8 * fq;
    const int* lp = list + (size_t)u.e * CAP + u.rt * 256;
#pragma unroll
    for (int ai = 0; ai < 2; ++ai)
#pragma unroll
      for (int m = 0; m < 4; ++m) {
        const int r = wr * 64 + fr + ai * 128 + m * 16;
        const float rs = RS[lp[(r < u.nrows) ? r : 0] >> 1];
        f32x4 h[2];
#pragma unroll
        for (int n = 0; n < 2; ++n) { const f32x4 g = acc[ai][0][m][n] * rs, up = acc[ai][1][m][n] * rs;
#pragma unroll
          for (int i = 0; i < 4; ++i) h[n][i] = g[i] * sigmoidf_(g[i]) * up[i]; }
        *(u32x4*)(HID + (size_t)(row0 + ai * 128 + m * 16) * 256 + col0) = pack8(h[0], h[1]);
      }
  }
};
struct EpiMoeDown {
  static constexpr bool PERM = false, HAS_PRE = true;
  bf16_t* out; bf16_t* Y1; const int* list; const float* pgate; LAS int* ept;
  __device__ __forceinline__ void pre(const Unit& u) const {
    const int r = threadIdx.x;
    if (r < 256) { int pr = -1; float gt = 0.f;
      if (r < u.nrows) { pr = list[(size_t)u.e * CAP + u.rt * 256 + r]; gt = pgate[pr]; }
      LAS int* e = ept + (u.par * 256 + r) * 2; e[0] = pr; e[1] = __float_as_int(gt); }
  }
  __device__ __forceinline__ void operator()(const f32x4 (&acc)[2][2][4][2], const Unit& u, int wr, int wc, int fr, int fq) const {
    const int col0 = (u.pn & 3) * 256 + wc * 32 + 4 * fq;
#pragma unroll
    for (int ai = 0; ai < 2; ++ai)
#pragma unroll
      for (int m = 0; m < 4; ++m) {
        const int r = ai * 128 + wr * 64 + m * 16 + fr;
        const LAS int* e = ept + (u.par * 256 + r) * 2;
        const int pr = e[0]; const float gt = __int_as_float(e[1]);
        if (pr >= 0) {
          const int tok = pr >> 1;
          if ((pr & 1) == 0) {
            bf16_t* op = out + (size_t)tok * DM + col0;
#pragma unroll
            for (int bj = 0; bj < 2; ++bj)
#pragma unroll
              for (int n = 0; n < 2; ++n) { const v2u w = *(const v2u*)(op + bj * 128 + n * 16);
                const f32x4 b = {__uint_as_float(w.x << 16), __uint_as_float(w.x & 0xffff0000u), __uint_as_float(w.y << 16), __uint_as_float(w.y & 0xffff0000u)};
                const f32x4 v = b + acc[ai][bj][m][n] * gt; v2u o; o.x = pk2(v[0], v[1]); o.y = pk2(v[2], v[3]); *(v2u*)(op + bj * 128 + n * 16) = o; }
          } else {
            bf16_t* yp = Y1 + (size_t)tok * DM + col0;
#pragma unroll
            for (int bj = 0; bj < 2; ++bj)
#pragma unroll
              for (int n = 0; n < 2; ++n) { const f32x4 v = acc[ai][bj][m][n] * gt; v2u w; w.x = pk2(v[0], v[1]); w.y = pk2(v[2], v[3]); *(v2u*)(yp + bj * 128 + n * 16) = w; }
          }
        }
      }
  }
};

typedef LAS bf16_t* lbf;
__device__ __forceinline__ void phase_prologue(PREF p, Frame& F) {
  const int lane = fresh_lane();
  LAS float* scr = (LAS float*)(F.lds + RING_OFF + F.wave * 16384);
  const int gw = F.vcu * NWAVES + F.wave, NGW = F.G * NWAVES;
  constexpr int I_WIN = 96 * 16, I_SQ = 32 * 16;
  constexpr int NITEMS = I_WIN + 5 * I_SQ + 128;
  for (int it = gw; it < NITEMS; it += NGW) {
    int r = it;
    if (r < I_WIN) { conv_win_item(p, r, scr, fresh_lane()); continue; } r -= I_WIN;
    if (r < I_SQ) { conv_sq_item(p.w_out, (bf16_t*)(p.ws + WS_WOUT), 0, r, scr, fresh_lane()); continue; } r -= I_SQ;
    if (r < I_SQ) { conv_sq_item(p.w_r, (bf16_t*)(p.ws + WS_WRKV), 0, r, scr, fresh_lane()); continue; } r -= I_SQ;
    if (r < I_SQ) { conv_sq_item(p.w_k, (bf16_t*)(p.ws + WS_WRKV), 1024, r, scr, fresh_lane()); continue; } r -= I_SQ;
    if (r < I_SQ) { conv_sq_item(p.w_v, (bf16_t*)(p.ws + WS_WRKV), 2048, r, scr, fresh_lane()); continue; } r -= I_SQ;
    if (r < I_SQ) { conv_sq_item(p.w_o, (bf16_t*)(p.ws + WS_WO), 0, r, scr, fresh_lane()); continue; } r -= I_SQ;
    { const int kv = r >> 6, q = r & 63, kb = q >> 1, cg = q & 1;
      transpose_item(p.cmp_w1 + (size_t)kv * 2048 * 64, 64, kb * 64, cg * 32, 32, (bf16_t*)(p.ws + WS_CW1) + (size_t)kv * 64 * 2048, 2048, cg * 32, scr, fresh_lane()); }
  }
  {
    const int gt = (F.vcu * NWAVES + F.wave) * 64 + fresh_lane(), NGT = NGW * 64;
    bf16_t* WL1 = (bf16_t*)(p.ws + WS_WL1);
    for (int i = gt; i < 768 * 1024; i += NGT) {
      const int n = i >> 10, k = i & 1023, gi = n >> 8, c = n & 255;
      float v = 0.f;
      if (gi == 0) { if (c < 64) v = p.w1[k * 64 + c]; }
      else if (gi == 1) { if (c < 64) v = p.a1[k * 64 + c]; }
      else { if (c < 160) v = p.g1[k * 160 + c]; }
      WL1[i] = (bf16_t)f2bf(v);
    }
    bf16_t* WL2w = (bf16_t*)(p.ws + WS_WL2);
    bf16_t* WL2a = (bf16_t*)(p.ws + WS_WL2 + 128 * 1024);
    bf16_t* WL2g = (bf16_t*)(p.ws + WS_WL2 + 256 * 1024);
    for (int i = gt; i < 1024 * 64; i += NGT) { const int n = i >> 6, k = i & 63; WL2w[i] = (bf16_t)f2bf(p.w2[k * 1024 + n]); WL2a[i] = (bf16_t)f2bf(p.a2[k * 1024 + n]); }
    for (int i = gt; i < 1024 * 192; i += NGT) { const int n = i / 192, k = i - n * 192; WL2g[i] = (bf16_t)f2bf(k < 160 ? p.g2[k * 1024 + n] : 0.f); }
    bf16_t* WR = (bf16_t*)(p.ws + WS_WR);
    for (int i = gt; i < 2 * 48 * 1024; i += NGT) {
      const int layer = i / (48 * 1024), rem = i - layer * 48 * 1024, n = rem >> 10, k = rem & 1023;
      float wv = 0.f;
      if (n < 4) wv = p.rg_w[(size_t)layer * DM * 4 + k * 4 + n]; else if (n < 36) wv = p.re_w[(size_t)layer * DM * 32 + k * 32 + (n - 4)];
      wv *= p.ffn_norm[layer * DM + k];
      const unsigned h = f2bf(wv); const float r1 = wv - __uint_as_float(h << 16);
      const unsigned m = f2bf(r1); const float r2 = r1 - __uint_as_float(m << 16);
      const unsigned l = f2bf(r2);
      bf16_t* o = WR + (size_t)layer * 144 * 1024 + (size_t)n * 1024 + k;
      o[0] = (bf16_t)h; o[48 * 1024] = (bf16_t)m; o[96 * 1024] = (bf16_t)l;
    }
  }
  bf16_t* XN = (bf16_t*)(p.ws + WS_XN);
  for (int m = gw; m < T_TOK; m += 4 * NGW) rms_rows_to_bf16<4>(p.x, p.mix_norm, XN, m, NGW, lane);
}


__device__ __forceinline__ void up8(const v4u w, float (&o)[8]) {
  o[0] = __uint_as_float(w.x << 16); o[1] = __uint_as_float(w.x & 0xffff0000u); o[2] = __uint_as_float(w.y << 16); o[3] = __uint_as_float(w.y & 0xffff0000u);
  o[4] = __uint_as_float(w.z << 16); o[5] = __uint_as_float(w.z & 0xffff0000u); o[6] = __uint_as_float(w.w << 16); o[7] = __uint_as_float(w.w & 0xffff0000u);
}
__device__ __forceinline__ f32x4 bf4(const v2u w) { return (f32x4){__uint_as_float(w.x << 16), __uint_as_float(w.x & 0xffff0000u), __uint_as_float(w.y << 16), __uint_as_float(w.y & 0xffff0000u)}; }
__device__ __forceinline__ void phase_router(PREF p, Frame& F, int layer) {
  const int gw = F.vcu * NWAVES + F.wave, NGW = F.G * NWAVES;
  const int lane = fresh_lane();
  PROBE_MARK(100 + layer * 10);
  {
    LAS float* scr = (LAS float*)(F.lds + RING_OFF + F.wave * 16384);
    for (int it = gw; it < 32 * 384; it += NGW) conv_expert_item(p, layer, it, scr, lane, (bf16_t*)(p.ws + WS_EGU));
  }
  __syncthreads();
  PROBE_MARK(101 + layer * 10);
  constexpr int WQP = 264;
  const lbf WQ = (lbf)(F.lds);
  LAS float* SSP = (LAS float*)(F.lds + 80 * 1024);
  LAS float* LGP = (LAS float*)(F.lds + 81 * 1024);
  const int w = F.wave, par = w & 1, tk = lane & 15, kg = lane >> 4;
  const bf16_t* xres = layer ? (const bf16_t*)(p.ws + WS_X3) : (const bf16_t*)p.out;
  const int tok = F.vcu * 64 + (w >> 1) * 16 + tk;
  bf16x8 xf[4][4];
  { const bf16_t* xr = xres + (size_t)tok * DM + 128 * par + 8 * kg;
#pragma unroll
    for (int j = 0; j < 4; ++j)
#pragma unroll
      for (int s = 0; s < 4; ++s) xf[j][s] = *(const GAS bf16x8*)(xr + 256 * j + 32 * s); }
  {
    float ss = 0.f;
#pragma unroll
    for (int j = 0; j < 4; ++j)
#pragma unroll
      for (int s = 0; s < 4; ++s) { float f[8]; up8(__builtin_bit_cast(v4u, xf[j][s]), f);
#pragma unroll
        for (int i = 0; i < 8; ++i) ss += f[i] * f[i]; }
    ss += __shfl_xor(ss, 16, 64); ss += __shfl_xor(ss, 32, 64);
    if (kg == 0) SSP[w * 16 + tk] = ss;
  }
  PROBE_MARK(102 + layer * 10);
  f32x4 acc[9];
#pragma unroll
  for (int nt = 0; nt < 9; ++nt) acc[nt] = (f32x4){0.f, 0.f, 0.f, 0.f};
  const bf16_t* WRl = (const bf16_t*)(p.ws + WS_WR) + (size_t)layer * 144 * 1024;
  float rs = 0.f;
#pragma unroll
  for (int j = 0; j < 4; ++j) {
    __syncthreads();
#pragma unroll
    for (int i = 0; i < 9; ++i) { const int idx = F.tid + i * 512, row = idx >> 5, pc = idx & 31;
      *(LAS v4u*)(WQ + row * WQP + pc * 8) = *(const GAS v4u*)(WRl + (size_t)row * 1024 + 256 * j + pc * 8); }
    __syncthreads();
    if (j == 0) {
      rs = rsqrtf((SSP[(w & ~1) * 16 + tk] + SSP[(w | 1) * 16 + tk]) * (1.f / DM) + 1e-6f);
      if (par == 0 && kg == 0) ((float*)(p.ws + WS_RS))[tok] = rs;
    }
#pragma unroll
    for (int s = 0; s < 4; ++s)
#pragma unroll
      for (int nt = 0; nt < 9; ++nt) {
        const bf16x8 a = *(const LAS bf16x8*)(WQ + (nt * 16 + tk) * WQP + 128 * par + 32 * s + 8 * kg);
        acc[nt] = __builtin_amdgcn_mfma_f32_16x16x32_bf16(a, xf[j][s], acc[nt], 0, 0, 0);
      }
  }
  PROBE_MARK(103 + layer * 10);
#pragma unroll
  for (int nt = 0; nt < 3; ++nt)
#pragma unroll
    for (int i = 0; i < 4; ++i) { const int n = nt * 16 + 4 * kg + i;
      if (n < 36) LGP[(w * 16 + tk) * 36 + n] = ((acc[6 + nt][i] + acc[3 + nt][i]) + acc[nt][i]) * rs; }
  LAS unsigned* LC = (LAS unsigned*)(F.lds + 118784);
  if (F.tid < 64) LC[F.tid] = 0u;
  __syncthreads();
  int ea = 0, eb = 0; unsigned la = 0, lb = 0; float ga = 0.f, gb = 0.f;
  if (lane < 8) {
    const LAS float* lg0 = LGP + ((w & ~1) * 16 + par * 8 + lane) * 36; const LAS float* lg1 = LGP + ((w | 1) * 16 + par * 8 + lane) * 36;
    const float* bg = p.rg_b + layer * 4;
    const float* be = p.re_b + layer * 32;
    float gl[4]; int gi = 0; float gm = -3.4e38f;
#pragma unroll
    for (int i = 0; i < 4; i++) { gl[i] = (lg0[i] + lg1[i]) + bg[i]; if (gl[i] > gm) { gm = gl[i]; gi = i; } }
    float gs = 0.f;
#pragma unroll
    for (int i = 0; i < 4; i++) gs += __expf(gl[i] - gm);
    const float grp_p = 1.f / gs;
    float v0 = -3.4e38f, v1 = -3.4e38f; int i0 = 0, i1 = 0;
    for (int i = 0; i < 8; i++) {
      const float v = (lg0[4 + gi * 8 + i] + lg1[4 + gi * 8 + i]) + be[gi * 8 + i];
      if (v > v0) { v1 = v0; i1 = i0; v0 = v; i0 = i; }
      else if (v > v1) { v1 = v; i1 = i; }
    }
    const float e1 = __expf(v1 - v0);
    ga = grp_p / (1.f + e1); gb = grp_p * e1 / (1.f + e1);
    ea = gi * 8 + i0; eb = gi * 8 + i1;
    la = __hip_atomic_fetch_add(LC + ea, 1u, __ATOMIC_RELAXED, __HIP_MEMORY_SCOPE_WORKGROUP);
    lb = __hip_atomic_fetch_add(LC + eb, 1u, __ATOMIC_RELAXED, __HIP_MEMORY_SCOPE_WORKGROUP);
  }
  __syncthreads();
  if (F.tid < 32) { const unsigned n = LC[F.tid];
    unsigned* cnt = (unsigned*)(p.ws + WS_CTL) + CW_CNT + (layer * 32 + F.tid) * 64;
    LC[32 + F.tid] = n ? __hip_atomic_fetch_add(cnt, n, __ATOMIC_RELAXED, __HIP_MEMORY_SCOPE_AGENT) : 0u; }
  __syncthreads();
  if (lane < 8) {
    const int t = gw * 8 + lane;
    int* list = (int*)(p.ws + WS_LIST); float* pgate = (float*)(p.ws + WS_PGATE);
    list[(size_t)ea * CAP + LC[32 + ea] + la] = 2 * t; pgate[2 * t] = ga;
    list[(size_t)eb * CAP + LC[32 + eb] + lb] = 2 * t + 1; pgate[2 * t + 1] = gb;
  }
  PROBE_MARK(104 + layer * 10);
}

__device__ __forceinline__ void phase_final(PREF p, Frame& F) {
  const int gw = F.vcu * NWAVES + F.wave, NGW = F.G * NWAVES;
  const int lane = fresh_lane();
  const bf16_t* Y1 = (const bf16_t*)(p.ws + WS_Y1);
  const bf16_t* X3 = (const bf16_t*)(p.ws + WS_X3);
  for (int t = gw; t < T_TOK; t += NGW) {
    GAS f32x4* xo = (GAS f32x4*)(p.out + (size_t)t * DM) + lane;
    const GAS v2u* xr = (const GAS v2u*)(X3 + (size_t)t * DM) + lane;
    const GAS v2u* yr = (const GAS v2u*)(Y1 + (size_t)t * DM) + lane;
#pragma unroll
    for (int j = 0; j < 4; ++j) xo[64 * j] = bf4(xr[64 * j]) + bf4(yr[64 * j]);
  }
}

__device__ __forceinline__ void phase_rwkv_prep(PREF p, Frame& F) {
  const int gw = F.vcu * NWAVES + F.wave, NGW = F.G * NWAVES;
  const int lane = fresh_lane();
  const float* gain = p.mix_norm + DM;
  const bf16_t* X1 = (const bf16_t*)p.out;
  const bf16_t* Y1 = (const bf16_t*)(p.ws + WS_Y1);
  float g[2][8];
#pragma unroll
  for (int c = 0; c < 2; ++c) { const f32x4 a = *(const GAS f32x4*)(gain + c * 512 + lane * 8), b = *(const GAS f32x4*)(gain + c * 512 + lane * 8 + 4);
    g[c][0] = a.x; g[c][1] = a.y; g[c][2] = a.z; g[c][3] = a.w; g[c][4] = b.x; g[c][5] = b.y; g[c][6] = b.z; g[c][7] = b.w; }
  for (int run = gw; run < T_TOK / 8; run += NGW) {
    const int t0 = run * 8;
    float prev[2][8];
    if ((t0 & (SEQ - 1)) == 0) {
#pragma unroll
      for (int c = 0; c < 2; ++c)
#pragma unroll
        for (int i = 0; i < 8; ++i) prev[c][i] = 0.f;
    } else {
      float s = 0.f;
#pragma unroll
      for (int c = 0; c < 2; ++c) { float xa[8], ya[8];
        up8(*(const GAS v4u*)(X1 + (size_t)(t0 - 1) * DM + c * 512 + lane * 8), xa); up8(*(const GAS v4u*)(Y1 + (size_t)(t0 - 1) * DM + c * 512 + lane * 8), ya);
#pragma unroll
        for (int i = 0; i < 8; ++i) { prev[c][i] = xa[i] + ya[i]; s += prev[c][i] * prev[c][i]; } }
      const float r = rsqrtf(wave_sum_dpp(s) * (1.f / DM) + 1e-6f);
#pragma unroll
      for (int c = 0; c < 2; ++c)
#pragma unroll
        for (int i = 0; i < 8; ++i) prev[c][i] *= r * g[c][i];
    }
    v4u nx[2], ny[2];
#pragma unroll
    for (int c = 0; c < 2; ++c) { nx[c] = *(const GAS v4u*)(X1 + (size_t)t0 * DM + c * 512 + lane * 8); ny[c] = *(const GAS v4u*)(Y1 + (size_t)t0 * DM + c * 512 + lane * 8); }
#pragma unroll 1
    for (int tt = 0; tt < 8; ++tt) {
      const int t = t0 + tt;
      float v[2][8]; float s = 0.f;
#pragma unroll
      for (int c = 0; c < 2; ++c) { float xa[8], ya[8]; up8(nx[c], xa); up8(ny[c], ya);
#pragma unroll
        for (int i = 0; i < 8; ++i) { v[c][i] = xa[i] + ya[i]; s += v[c][i] * v[c][i]; } }
      if (tt < 7) {
#pragma unroll
        for (int c = 0; c < 2; ++c) { nx[c] = *(const GAS v4u*)(X1 + (size_t)(t + 1) * DM + c * 512 + lane * 8); ny[c] = *(const GAS v4u*)(Y1 + (size_t)(t + 1) * DM + c * 512 + lane * 8); } }
      const float r = rsqrtf(wave_sum_dpp(s) * (1.f / DM) + 1e-6f);
#pragma unroll
      for (int c = 0; c < 2; ++c)
#pragma unroll
        for (int i = 0; i < 8; ++i) v[c][i] *= r * g[c][i];
#pragma unroll
      for (int sl = 0; sl < 6; ++sl) {
        const int mj = (sl == 0) ? 0 : (sl == 1) ? 2 : (sl == 2) ? 3 : (sl == 3) ? 1 : (sl == 4) ? 4 : 5;
        bf16_t* o = (bf16_t*)(p.ws + WS_S0 + (size_t)sl * SLOT) + (size_t)t * DM;
#pragma unroll
        for (int c = 0; c < 2; ++c) {
          const f32x4 ma = *(const GAS f32x4*)(p.rmix + mj * DM + c * 512 + lane * 8), mb = *(const GAS f32x4*)(p.rmix + mj * DM + c * 512 + lane * 8 + 4);
          const float mx[8] = {ma.x, ma.y, ma.z, ma.w, mb.x, mb.y, mb.z, mb.w};
          float q[8];
#pragma unroll
          for (int i = 0; i < 8; ++i) q[i] = v[c][i] + (prev[c][i] - v[c][i]) * mx[i];
          v4u w; w.x = pk2(q[0], q[1]); w.y = pk2(q[2], q[3]); w.z = pk2(q[4], q[5]); w.w = pk2(q[6], q[7]);
          *(GAS v4u*)(o + c * 512 + lane * 8) = w;
        }
      }
#pragma unroll
      for (int c = 0; c < 2; ++c)
#pragma unroll
        for (int i = 0; i < 8; ++i) prev[c][i] = v[c][i];
    }
  }
}

constexpr int RP = 72;
constexpr int RB = 64 * RP * 2;

__device__ __forceinline__ f32x4 mm16(f32x4 acc, const LAS bf16_t* A, int arow0, const LAS bf16_t* Bt, int brow0, int lane) {
  const int r = lane & 15, q = lane >> 4;
#pragma unroll
  for (int ks = 0; ks < 2; ++ks) {
    const bf16x8 a = *(const LAS bf16x8*)(A + (arow0 + r) * RP + ks * 32 + q * 8);
    const bf16x8 b = *(const LAS bf16x8*)(Bt + (brow0 + r) * RP + ks * 32 + q * 8);
    acc = __builtin_amdgcn_mfma_f32_16x16x32_bf16(a, b, acc, 0, 0, 0);
  }
  return acc;
}
__device__ __forceinline__ float sum8(float v) {
  v += __shfl_xor(v, 1, 64); v += __shfl_xor(v, 2, 64); v += __shfl_xor(v, 4, 64); return v;
}
__device__ __forceinline__ void ld8bf(const bf16_t* p, float (&o)[8]) {
  const v4u w = *(const GAS v4u*)p;
  o[0] = __uint_as_float(w.x << 16); o[1] = __uint_as_float(w.x & 0xffff0000u); o[2] = __uint_as_float(w.y << 16); o[3] = __uint_as_float(w.y & 0xffff0000u);
  o[4] = __uint_as_float(w.z << 16); o[5] = __uint_as_float(w.z & 0xffff0000u); o[6] = __uint_as_float(w.w << 16); o[7] = __uint_as_float(w.w & 0xffff0000u);
}
__device__ __forceinline__ v4u pk8(const float (&o)[8]) { v4u w; w.x = pk2(o[0], o[1]); w.y = pk2(o[2], o[3]); w.z = pk2(o[4], o[5]); w.w = pk2(o[6], o[7]); return w; }

#define R1_BAR() do { asm volatile("s_waitcnt lgkmcnt(0)" ::: "memory"); __builtin_amdgcn_s_barrier(); asm volatile("" ::: "memory"); } while (0)
__device__ __forceinline__ void stT(LAS bf16_t* Dst, int x0, int y0, const f32x4& acc, int lane) {
  v2u w; w.x = pk2(acc[0], acc[1]); w.y = pk2(acc[2], acc[3]);
  *(LAS v2u*)(Dst + (x0 + (lane & 15)) * RP + y0 + (lane >> 4) * 4) = w;
}
struct R1In { v4u r, ld, k, v, a; f32x4 kk0, kk1, ka0, ka1, rk0, rk1; };
__device__ __forceinline__ R1In rwkv_r1_load(PREF p, int item, int tid) {
  const int hd = item & 15, c = (item >> 4) & 63, b = item >> 10, ch = b * 16 + hd;
  const size_t off = ((size_t)(b * SEQ + c * 64 + (tid >> 3)) * DM + hd * 64 + (tid & 7) * 8);
  const bf16_t* s0 = (const bf16_t*)(p.ws + WS_S0);
  R1In in;
  in.r = *(const GAS v4u*)(s0 + 3 * (SLOT / 2) + off); in.ld = *(const GAS v4u*)(s0 + off); in.k = *(const GAS v4u*)(s0 + 4 * (SLOT / 2) + off);
  in.v = *(const GAS v4u*)(s0 + 5 * (SLOT / 2) + off); in.a = *(const GAS v4u*)(s0 + (SLOT / 2) + off);
  const int cc0 = hd * 64 + (tid & 7) * 8;
  in.kk0 = *(const GAS f32x4*)(p.k_k + cc0); in.kk1 = *(const GAS f32x4*)(p.k_k + cc0 + 4); in.ka0 = *(const GAS f32x4*)(p.k_a + cc0); in.ka1 = *(const GAS f32x4*)(p.k_a + cc0 + 4);
  in.rk0 = *(const GAS f32x4*)(p.r_k + cc0); in.rk1 = *(const GAS f32x4*)(p.r_k + cc0 + 4);
  return in;
}
__device__ __forceinline__ void un8(const v4u w, float (&o)[8]) {
  o[0] = __uint_as_float(w.x << 16); o[1] = __uint_as_float(w.x & 0xffff0000u); o[2] = __uint_as_float(w.y << 16); o[3] = __uint_as_float(w.y & 0xffff0000u);
  o[4] = __uint_as_float(w.z << 16); o[5] = __uint_as_float(w.z & 0xffff0000u); o[6] = __uint_as_float(w.w << 16); o[7] = __uint_as_float(w.w & 0xffff0000u);
}
__device__ __forceinline__ void rwkv_r1_item(PREF p, Frame& F, int item, const R1In& in) {
  const int tid = F.tid, lane = fresh_lane(), w = F.wave;
  const int hd = item & 15, c = (item >> 4) & 63, b = item >> 10, ch = b * 16 + hd;
  const size_t tile0 = ((size_t)(b * SEQ + c * 64) * DM + hd * 64);
  unsigned char* ws = p.ws;
  bf16_t* SL[6];
#pragma unroll
  for (int s = 0; s < 6; ++s) SL[s] = (bf16_t*)(ws + WS_S0 + (size_t)s * SLOT) + tile0;
  const lbf BtT = (lbf)(F.lds + 0 * RB), KtT = (lbf)(F.lds + 1 * RB), AbT = (lbf)(F.lds + 2 * RB), RbT = (lbf)(F.lds + 3 * RB);
  const lbf Ab = (lbf)(F.lds + 4 * RB), Vc = (lbf)(F.lds + 5 * RB), Bh = (lbf)(F.lds + 6 * RB), Kh = (lbf)(F.lds + 7 * RB);
  const lbf Tk = (lbf)(F.lds + 8 * RB), WbT = (lbf)(F.lds + 9 * RB), WkT = (lbf)(F.lds + 10 * RB);
  const lbf X = BtT, XT = KtT, Pb = AbT;
  const lbf At = X, TNT = XT, U0 = Tk;
  LAS float* Lf = (LAS float*)(F.lds + 11 * RB);
  LAS float* SEG = Lf + 64 * 65;
  LAS float* GC = (LAS float*)(F.lds + 14 * RB);
#if defined(PROBE_PH) && PROBE_PH == 301
  const unsigned long long _sa0 = __builtin_amdgcn_s_memrealtime();
#endif
  const int t = tid >> 3, cg = tid & 7, k0 = cg * 8;
  float r_[8], ld_[8], kx[8], v_[8], a_[8];
  un8(in.r, r_); un8(in.ld, ld_); un8(in.k, kx); un8(in.v, v_); un8(in.a, a_);
  float kk[8], km[8], be[8];
  {
    float ss = 0.f, bo = 0.f;
#pragma unroll
    for (int i = 0; i < 8; ++i) { const float ckk = (i < 4) ? in.kk0[i & 3] : in.kk1[i & 3], cka = (i < 4) ? in.ka0[i & 3] : in.ka1[i & 3], crk = (i < 4) ? in.rk0[i & 3] : in.rk1[i & 3];
      kk[i] = kx[i] * ckk; ss += kk[i] * kk[i]; km[i] = kx[i] * (1.f + (a_[i] - 1.f) * cka); bo += r_[i] * km[i] * crk; }
    ss = sum8(ss); bo = sum8(bo);
    const float inv = 1.f / fmaxf(sqrtf(ss), 1e-12f);
#pragma unroll
    for (int i = 0; i < 8; ++i) { kk[i] *= inv; be[i] = kk[i] * a_[i]; }
    if (cg == 0) ((float*)(ws + WS_TMP))[(size_t)item * 64 + t] = bo;
  }
#pragma unroll
  for (int i = 0; i < 8; ++i) Lf[t * 65 + k0 + i] = ld_[i];
  R1_BAR();
  {
    const int k = tid & 63, sg = tid >> 6;
    float run = 0.f;
#pragma unroll
    for (int i = 0; i < 8; ++i) { run += Lf[(sg * 8 + i) * 65 + k]; Lf[(sg * 8 + i) * 65 + k] = run; }
    SEG[sg * 64 + k] = run;
    R1_BAR();
    float off = 0.f;
    for (int j = 0; j < sg; ++j) off += SEG[j * 64 + k];
#pragma unroll
    for (int i = 0; i < 8; ++i) Lf[(sg * 8 + i) * 65 + k] += off;
  }
  R1_BAR();
  {
    float ab[8], bt[8], kt[8], rb[8], bh[8], kh[8];
#pragma unroll
    for (int i = 0; i < 8; ++i) {
      const float Lt = Lf[t * 65 + k0 + i], Lp = (t > 0) ? Lf[(t - 1) * 65 + k0 + i] : 0.f, LC = Lf[63 * 65 + k0 + i];
      const float et = __expf(Lt), ei = __builtin_amdgcn_rcpf(et), eh = __expf(LC) * ei;
      if (t == 63) GC[k0 + i] = et;
      ab[i] = -kk[i] * __expf(Lp); bt[i] = be[i] * ei; kt[i] = km[i] * ei; rb[i] = r_[i] * et; bh[i] = be[i] * eh; kh[i] = km[i] * eh;
    }
    *(LAS v4u*)(BtT + t * RP + k0) = pk8(bt); *(LAS v4u*)(KtT + t * RP + k0) = pk8(kt); *(LAS v4u*)(AbT + t * RP + k0) = pk8(ab); *(LAS v4u*)(RbT + t * RP + k0) = pk8(rb);
    {
      float ra[8], rv[8], rb[8], rkh[8];
#pragma unroll
      for (int i = 0; i < 8; ++i) { ra[i] = ab[i]; rv[i] = v_[i]; rb[i] = bh[i]; rkh[i] = kh[i]; }
#pragma unroll
      for (int sh = 1; sh < 8; sh <<= 1) {
        const bool on = (cg & sh) != 0;
        float ta[8], tv[8], tb[8], tk[8];
#pragma unroll
        for (int i = 0; i < 8; ++i) { ta[i] = on ? ra[(i + sh) & 7] : ra[i]; tv[i] = on ? rv[(i + sh) & 7] : rv[i]; tb[i] = on ? rb[(i + sh) & 7] : rb[i]; tk[i] = on ? rkh[(i + sh) & 7] : rkh[i]; }
#pragma unroll
        for (int i = 0; i < 8; ++i) { ra[i] = ta[i]; rv[i] = tv[i]; rb[i] = tb[i]; rkh[i] = tk[i]; }
      }
#pragma unroll
      for (int i = 0; i < 8; ++i) { const int row = k0 + ((i + cg) & 7);
        Ab[row * RP + t] = (bf16_t)f2bf(ra[i]); Vc[row * RP + t] = (bf16_t)f2bf(rv[i]); Bh[row * RP + t] = (bf16_t)f2bf(rb[i]); Kh[row * RP + t] = (bf16_t)f2bf(rkh[i]); }
    }
  }
  R1_BAR();
#if defined(PROBE_PH) && PROBE_PH == 301
  F.pr_t1 += __builtin_amdgcn_s_memrealtime() - _sa0;
#endif
  const int ya = (w >> 1) * 16, xb0 = (w & 1) * 32;
  const int cr = lane & 15, q4 = (lane >> 4) * 4;
  const f32x4 Z4 = {0.f, 0.f, 0.f, 0.f};
  const lbf X1 = (lbf)(F.lds + 11 * RB), XT1 = (lbf)(F.lds + 12 * RB), Pb1 = (lbf)(F.lds + 13 * RB);
  f32x4 accP[2];
  {
    f32x4 tabn[2], tabs[2], taks[2], wbr[2], wkr[2];
#pragma unroll
    for (int j = 0; j < 2; ++j) { const int xb = xb0 + 16 * j;
      tabn[j] = mm16(Z4, BtT, ya, AbT, xb, lane);
      tabs[j] = mm16(Z4, AbT, ya, BtT, xb, lane);
      taks[j] = mm16(Z4, AbT, ya, KtT, xb, lane);
      wbr[j] = mm16(Z4, BtT, ya, RbT, xb, lane);
      wkr[j] = mm16(Z4, KtT, ya, RbT, xb, lane); }
#pragma unroll
    for (int j = 0; j < 2; ++j) { const int xb = xb0 + 16 * j;
      f32x4 xt, xr, pr, tk, wb, wk;
#pragma unroll
      for (int i = 0; i < 4; ++i) {
        { const int s = ya + q4 + i, tt = xb + cr; xt[i] = (s < tt) ? tabn[j][i] : 0.f; wb[i] = (s <= tt) ? wbr[j][i] : 0.f; wk[i] = (s <= tt) ? wkr[j][i] : 0.f; }
        { const int tt = ya + q4 + i, s = xb + cr; xr[i] = (s < tt) ? tabs[j][i] : 0.f; pr[i] = xr[i] + ((s == tt) ? 1.f : 0.f); tk[i] = (s < tt) ? taks[j][i] : 0.f; }
      }
      accP[j] = pr;
      stT(XT1, xb, ya, xt, lane); stT(WbT, xb, ya, wb, lane); stT(WkT, xb, ya, wk, lane);
      stT(X1, xb, ya, xr, lane); stT(Pb1, xb, ya, pr, lane); stT(Tk, xb, ya, tk, lane); }
  }
  R1_BAR();
#pragma unroll 1
  for (int st = 0; st < 5; ++st) {
    const lbf Xs = (st & 1) ? X : X1, XTs = (st & 1) ? XT : XT1, Pbs = (st & 1) ? Pb : Pb1;
    const lbf Xd = (st & 1) ? X1 : X, XTd = (st & 1) ? XT1 : XT, Pbd = (st & 1) ? Pb1 : Pb;
    f32x4 xr[2], xt[2];
#pragma unroll
    for (int j = 0; j < 2; ++j) { const int xb = xb0 + 16 * j;
      xr[j] = mm16(Z4, XTs, ya, Xs, xb, lane);
      xt[j] = mm16(Z4, Xs, ya, XTs, xb, lane);
      if (st > 0) accP[j] = mm16(accP[j], XTs, ya, Pbs, xb, lane); }
#pragma unroll
    for (int j = 0; j < 2; ++j) { const int xb = xb0 + 16 * j; stT(Xd, xb, ya, xr[j], lane); stT(XTd, xb, ya, xt[j], lane); stT(Pbd, xb, ya, accP[j], lane); }
    R1_BAR();
  }
  const lbf NT = Pb1;
  {
    f32x4 nt[2];
#pragma unroll
    for (int j = 0; j < 2; ++j) { const int xb = xb0 + 16 * j; nt[j] = mm16(Z4, Pb, ya, XT, xb, lane);
#pragma unroll
      for (int i = 0; i < 4; ++i) nt[j][i] += bf2f(Pb[(ya + q4 + i) * RP + xb + cr]); }
#pragma unroll
    for (int j = 0; j < 2; ++j) stT(NT, xb0 + 16 * j, ya, nt[j], lane);
    R1_BAR();
  }
  {
    f32x4 at[2], tn[2];
#pragma unroll
    for (int j = 0; j < 2; ++j) { const int xb = xb0 + 16 * j; at[j] = mm16(Z4, NT, ya, Ab, xb, lane); tn[j] = mm16(Z4, Tk, ya, NT, xb, lane); }
#pragma unroll
    for (int j = 0; j < 2; ++j) { const int xb = xb0 + 16 * j; stT(At, xb, ya, at[j], lane); stT(TNT, xb, ya, tn[j], lane); }
  }
  R1_BAR();
  const lbf O_RT = (lbf)(F.lds + 11 * RB), O_PM = (lbf)(F.lds + 12 * RB), O_Y0 = (lbf)(F.lds + 13 * RB), O_Q = (lbf)(F.lds + 3 * RB)  ;
  {
    f32x4 u0[2], rt[2], pm[2];
#pragma unroll
    for (int j = 0; j < 2; ++j) { const int xb = xb0 + 16 * j;
      u0[j] = mm16(Z4, TNT, ya, Vc, xb, lane);
      rt[j] = mm16(Z4, At, ya, WbT, xb, lane);
      pm[j] = mm16(Z4, At, ya, Bh, xb, lane);
      const v2u rbw = *(const LAS v2u*)(RbT + (xb + cr) * RP + ya + q4);
      rt[j][0] += __uint_as_float(rbw.x << 16); rt[j][1] += __uint_as_float(rbw.x & 0xffff0000u); rt[j][2] += __uint_as_float(rbw.y << 16); rt[j][3] += __uint_as_float(rbw.y & 0xffff0000u);
#pragma unroll
      for (int i = 0; i < 4; ++i) if (ya + q4 + i == xb + cr) pm[j][i] += GC[xb + cr]; }
#pragma unroll
    for (int j = 0; j < 2; ++j) { const int xb = xb0 + 16 * j; stT(U0, xb, ya, u0[j], lane); stT(O_RT, xb, ya, rt[j], lane); stT(O_PM, xb, ya, pm[j], lane); }
  }
  R1_BAR();
  {
    f32x4 y0[2], qq[2];
#pragma unroll
    for (int j = 0; j < 2; ++j) { const int xb = xb0 + 16 * j;
      y0[j] = mm16(mm16(Z4, U0, ya, WbT, xb, lane), Vc, ya, WkT, xb, lane);
      qq[j] = mm16(mm16(Z4, Bh, ya, U0, xb, lane), Kh, ya, Vc, xb, lane); }
#pragma unroll
    for (int j = 0; j < 2; ++j) { const int xb = xb0 + 16 * j; stT(O_Y0, xb, ya, y0[j], lane); stT(O_Q, xb, ya, qq[j], lane); }
  }
  R1_BAR();
  {
    const int row = tid >> 3, pc = (tid & 7) * 8;
    *(GAS v4u*)(SL[3] + (size_t)row * DM + pc) = *(const LAS v4u*)(O_RT + row * RP + pc);
    *(GAS v4u*)(SL[0] + (size_t)row * DM + pc) = *(const LAS v4u*)(O_PM + row * RP + pc);
    *(GAS v4u*)(SL[4] + (size_t)row * DM + pc) = *(const LAS v4u*)(O_Y0 + row * RP + pc);
    *(GAS v4u*)(SL[1] + (size_t)row * DM + pc) = *(const LAS v4u*)(O_Q + row * RP + pc);
  }
  R1_BAR();
}

__device__ __forceinline__ void phase_rwkv_r1(PREF p, Frame& F) {
  int item = F.vcu;
  if (item >= 4096) return;
  R1In nxt = rwkv_r1_load(p, item, F.tid);
  for (; item < 4096; item += F.G) {
    const R1In cur = nxt;
    if (item + F.G < 4096) nxt = rwkv_r1_load(p, item + F.G, F.tid);
    rwkv_r1_item(p, F, item, cur);
  }
}

__device__ __forceinline__ void phase_rwkv_r2(PREF p, Frame& F) {
  if (F.wave != 0) return;
  const int lane = fresh_lane();
  const lbf Sh = (lbf)(F.lds), Sl = (lbf)(F.lds + 16 * RP * 2);
  const int cr = lane & 15, g = lane >> 4;
  for (int task = F.vcu; task < 256; task += F.G) {
    const int ch = task >> 2, jb = task & 3, b = ch >> 4, hd = ch & 15;
    const bf16_t* PM = (const bf16_t*)(p.ws + WS_S0) + ((size_t)(b * SEQ) * DM + hd * 64);
    bf16_t* QS = (bf16_t*)(p.ws + WS_S0 + SLOT) + ((size_t)(b * SEQ) * DM + hd * 64);
    for (int i = lane; i < 16 * RP; i += 64) { Sh[i] = 0; Sl[i] = 0; }
    const bf16_t* pmp = PM + (size_t)cr * DM + g * 8;
    bf16_t* qsp = QS + (size_t)(16 * jb + cr) * DM + g * 4;
    bf16x8 pa[4][4][2]; v2u qv[4][4];
#pragma unroll
    for (int d = 0; d < 4; ++d)
#pragma unroll
      for (int ct = 0; ct < 4; ++ct) { pa[d][ct][0] = *(const GAS bf16x8*)(pmp + (size_t)(d * 64 + 16 * ct) * DM); pa[d][ct][1] = *(const GAS bf16x8*)(pmp + (size_t)(d * 64 + 16 * ct) * DM + 32);
        qv[d][ct] = *(const GAS v2u*)(qsp + (size_t)d * 64 * DM + 16 * ct); }
    asm volatile("s_waitcnt lgkmcnt(0)" ::: "memory");
#pragma unroll 1
    for (int c4 = 0; c4 < 64; c4 += 4) {
#pragma unroll
      for (int d = 0; d < 4; ++d) {
        const int c = c4 + d;
        const bf16x8 bh0 = *(const LAS bf16x8*)(Sh + cr * RP + g * 8), bh1 = *(const LAS bf16x8*)(Sh + cr * RP + 32 + g * 8);
        const bf16x8 bl0 = *(const LAS bf16x8*)(Sl + cr * RP + g * 8), bl1 = *(const LAS bf16x8*)(Sl + cr * RP + 32 + g * 8);
        f32x4 acc[4];
#pragma unroll
        for (int ct = 0; ct < 4; ++ct) {
          acc[ct] = (f32x4){__uint_as_float(qv[d][ct].x << 16), __uint_as_float(qv[d][ct].x & 0xffff0000u), __uint_as_float(qv[d][ct].y << 16), __uint_as_float(qv[d][ct].y & 0xffff0000u)};
          acc[ct] = __builtin_amdgcn_mfma_f32_16x16x32_bf16(pa[d][ct][0], bh0, acc[ct], 0, 0, 0);
          acc[ct] = __builtin_amdgcn_mfma_f32_16x16x32_bf16(pa[d][ct][1], bh1, acc[ct], 0, 0, 0);
          acc[ct] = __builtin_amdgcn_mfma_f32_16x16x32_bf16(pa[d][ct][0], bl0, acc[ct], 0, 0, 0);
          acc[ct] = __builtin_amdgcn_mfma_f32_16x16x32_bf16(pa[d][ct][1], bl1, acc[ct], 0, 0, 0);
        }
        if (c + 4 < 64) {
#pragma unroll
          for (int ct = 0; ct < 4; ++ct) { pa[d][ct][0] = *(const GAS bf16x8*)(pmp + (size_t)((c + 4) * 64 + 16 * ct) * DM); pa[d][ct][1] = *(const GAS bf16x8*)(pmp + (size_t)((c + 4) * 64 + 16 * ct) * DM + 32);
            qv[d][ct] = *(const GAS v2u*)(qsp + (size_t)(c + 4) * 64 * DM + 16 * ct); }
        }
#pragma unroll
        for (int ct = 0; ct < 4; ++ct) {
          v2u hi; hi.x = pk2(acc[ct][0], acc[ct][1]); hi.y = pk2(acc[ct][2], acc[ct][3]);
          const float l0 = acc[ct][0] - __uint_as_float(hi.x << 16), l1 = acc[ct][1] - __uint_as_float(hi.x & 0xffff0000u), l2 = acc[ct][2] - __uint_as_float(hi.y << 16), l3 = acc[ct][3] - __uint_as_float(hi.y & 0xffff0000u);
          v2u lo; lo.x = pk2(l0, l1); lo.y = pk2(l2, l3);
          *(LAS v2u*)(Sh + cr * RP + 16 * ct + g * 4) = hi; *(LAS v2u*)(Sl + cr * RP + 16 * ct + g * 4) = lo;
          *(GAS v2u*)(qsp + (size_t)c * 64 * DM + 16 * ct) = hi;
        }
        asm volatile("s_waitcnt lgkmcnt(0)" ::: "memory");
      }
    }
  }
}

__device__ __forceinline__ void phase_rwkv_r3(PREF p, Frame& F) {
  const int lane = fresh_lane(), w = F.wave;
  const int cr = lane & 15, q4 = (lane >> 4) * 4, q = lane >> 4;
  const int half = w >> 2, tb = w & 3;
  LAS bf16_t* stg = (LAS bf16_t*)(F.lds) + w * 16 * RP;
  for (int it2 = F.vcu; it2 < 2048; it2 += F.G) {
    const int item = it2 * 2 + half;
    const int hd = item & 15, c = (item >> 4) & 63, b = item >> 10, ch = b * 16 + hd;
    const size_t tile0 = ((size_t)(b * SEQ + c * 64) * DM + hd * 64);
    bf16_t* RT = (bf16_t*)(p.ws + WS_S0 + 3 * SLOT) + tile0;
    const bf16_t* Y0 = (const bf16_t*)(p.ws + WS_S0 + 4 * SLOT) + tile0;
    const bf16_t* VV = (const bf16_t*)(p.ws + WS_S0 + 5 * SLOT) + tile0;
    const bf16_t* GG = (const bf16_t*)(p.ws + WS_S0 + 2 * SLOT) + tile0;
    const bf16_t* SC = (const bf16_t*)(p.ws + WS_S0 + SLOT) + tile0 - (size_t)64 * DM;
    const float* BO = (const float*)(p.ws + WS_TMP) + (size_t)item * 64;
    f32x4 y[4];
#pragma unroll
    for (int j = 0; j < 4; ++j) y[j] = (f32x4){0.f, 0.f, 0.f, 0.f};
    if (c > 0) {
      const bf16_t* ap = RT + (size_t)(16 * tb + cr) * DM + q * 8;
      const bf16x8 a0 = *(const GAS bf16x8*)ap, a1 = *(const GAS bf16x8*)(ap + 32);
#pragma unroll
      for (int j = 0; j < 4; ++j) {
        const bf16_t* bp = SC + (size_t)(16 * j + cr) * DM + q * 8;
        const bf16x8 b0 = *(const GAS bf16x8*)bp, b1 = *(const GAS bf16x8*)(bp + 32);
        y[j] = __builtin_amdgcn_mfma_f32_16x16x32_bf16(a0, b0, y[j], 0, 0, 0);
        y[j] = __builtin_amdgcn_mfma_f32_16x16x32_bf16(a1, b1, y[j], 0, 0, 0);
      }
    }
    float mu[4], rs[4];
#pragma unroll
    for (int i = 0; i < 4; ++i) {
      float s = 0.f;
#pragma unroll
      for (int j = 0; j < 4; ++j) { y[j][i] += bf2f(Y0[(size_t)(16 * tb + q4 + i) * DM + 16 * j + cr]); s += y[j][i]; }
      s += __shfl_xor(s, 1, 64); s += __shfl_xor(s, 2, 64); s += __shfl_xor(s, 4, 64); s += __shfl_xor(s, 8, 64);
      mu[i] = s * (1.f / 64.f);
      float qd = 0.f;
#pragma unroll
      for (int j = 0; j < 4; ++j) { const float d = y[j][i] - mu[i]; qd += d * d; }
      qd += __shfl_xor(qd, 1, 64); qd += __shfl_xor(qd, 2, 64); qd += __shfl_xor(qd, 4, 64); qd += __shfl_xor(qd, 8, 64);
      rs[i] = rsqrtf(qd * (1.f / 64.f) + 64e-5f);
    }
#pragma unroll
    for (int j = 0; j < 4; ++j) {
      const int cc = hd * 64 + 16 * j + cr;
      const float lw = p.ln_w[cc], lb = p.ln_b[cc];
#pragma unroll
      for (int i = 0; i < 4; ++i) {
        const int tt = 16 * tb + q4 + i;
        const float vv = bf2f(VV[(size_t)tt * DM + 16 * j + cr]), gg = bf2f(GG[(size_t)tt * DM + 16 * j + cr]);
        const float z = ((y[j][i] - mu[i]) * rs[i] * lw + lb + BO[tt] * vv) * gg;
        stg[(q4 + i) * RP + 16 * j + cr] = (bf16_t)f2bf(z);
      }
    }
    LDS_WAIT();
#pragma unroll
    for (int i = 0; i < 2; ++i) { const int row = (lane >> 3) + 8 * i, pc = (lane & 7) * 8;
      *(GAS v4u*)(RT + (size_t)(16 * tb + row) * DM + pc) = *(const LAS v4u*)(stg + row * RP + pc); }
    LDS_WAIT();
  }
}


typedef short v4i16_t __attribute__((ext_vector_type(4)));
__device__ __forceinline__ v4i16_t tr16(const LAS bf16_t* p) { return __builtin_amdgcn_ds_read_tr16_b64_v4i16((LAS v4i16_t*)p); }

template <int KS>
__device__ __forceinline__ void qk_tile(f32x4 (&st)[4][2], const LAS bf16_t* Kt, int kc0, const bf16x8 (&qf)[2][KS], int lane) {
  const int r = lane & 15, g = lane >> 4;
#pragma unroll
  for (int kt = 0; kt < 4; ++kt)
#pragma unroll
    for (int ks = 0; ks < KS; ++ks) {
      const bf16x8 a = *(const LAS bf16x8*)(Kt + (kt * 16 + r) * RP + kc0 + ks * 32 + g * 8);
#pragma unroll
      for (int qt = 0; qt < 2; ++qt) st[kt][qt] = __builtin_amdgcn_mfma_f32_16x16x32_bf16(a, qf[qt][ks], st[kt][qt], 0, 0, 0);
    }
}
__device__ __forceinline__ void pack_p(bf16x8 (&pb)[2][2], const f32x4 (&pr)[4][2]) {
#pragma unroll
  for (int kb = 0; kb < 2; ++kb)
#pragma unroll
    for (int qt = 0; qt < 2; ++qt) {
      const v4u w = {pk2(pr[2 * kb][qt][0], pr[2 * kb][qt][1]), pk2(pr[2 * kb][qt][2], pr[2 * kb][qt][3]), pk2(pr[2 * kb + 1][qt][0], pr[2 * kb + 1][qt][1]), pk2(pr[2 * kb + 1][qt][2], pr[2 * kb + 1][qt][3])};
      pb[kb][qt] = __builtin_bit_cast(bf16x8, w);
    }
}
__device__ __forceinline__ void pv_apply(f32x4 (&o)[4][2], f32x4 (&osum)[2], const bf16x8 (&pb)[2][2], const LAS bf16_t* Vt, int lane) {
  const int g = lane >> 4, qq = (lane & 15) >> 2, pp = lane & 3;
  const bf16x8 ones = {0x3F80, 0x3F80, 0x3F80, 0x3F80, 0x3F80, 0x3F80, 0x3F80, 0x3F80};
#pragma unroll
  for (int kb = 0; kb < 2; ++kb)
#pragma unroll
    for (int qt = 0; qt < 2; ++qt) osum[qt] = __builtin_amdgcn_mfma_f32_16x16x32_bf16(ones, pb[kb][qt], osum[qt], 0, 0, 0);
#pragma unroll
  for (int dt = 0; dt < 4; ++dt)
#pragma unroll
    for (int kb = 0; kb < 2; ++kb) {
      const v4i16_t lo = tr16(Vt + (32 * kb + 4 * g + qq) * RP + dt * 16 + 4 * pp);
      const v4i16_t hi = tr16(Vt + (32 * kb + 16 + 4 * g + qq) * RP + dt * 16 + 4 * pp);
      const bf16x8 a = {lo[0], lo[1], lo[2], lo[3], hi[0], hi[1], hi[2], hi[3]};
#pragma unroll
      for (int qt = 0; qt < 2; ++qt) o[dt][qt] = __builtin_amdgcn_mfma_f32_16x16x32_bf16(a, pb[kb][qt], o[dt][qt], 0, 0, 0);
    }
}
__device__ __forceinline__ void pv_apply2(f32x4 (&o1)[4][2], f32x4 (&o2)[4][2], f32x4 (&os1)[2], f32x4 (&os2)[2], const bf16x8 (&pb1)[2][2], const bf16x8 (&pb2)[2][2], const LAS bf16_t* Vt, int lane) {
  const int g = lane >> 4, qq = (lane & 15) >> 2, pp = lane & 3;
  const bf16x8 ones = {0x3F80, 0x3F80, 0x3F80, 0x3F80, 0x3F80, 0x3F80, 0x3F80, 0x3F80};
#pragma unroll
  for (int kb = 0; kb < 2; ++kb)
#pragma unroll
    for (int qt = 0; qt < 2; ++qt) { os1[qt] = __builtin_amdgcn_mfma_f32_16x16x32_bf16(ones, pb1[kb][qt], os1[qt], 0, 0, 0); os2[qt] = __builtin_amdgcn_mfma_f32_16x16x32_bf16(ones, pb2[kb][qt], os2[qt], 0, 0, 0); }
#pragma unroll
  for (int dt = 0; dt < 4; ++dt)
#pragma unroll
    for (int kb = 0; kb < 2; ++kb) {
      const v4i16_t lo = tr16(Vt + (32 * kb + 4 * g + qq) * RP + dt * 16 + 4 * pp);
      const v4i16_t hi = tr16(Vt + (32 * kb + 16 + 4 * g + qq) * RP + dt * 16 + 4 * pp);
      const bf16x8 a = {lo[0], lo[1], lo[2], lo[3], hi[0], hi[1], hi[2], hi[3]};
#pragma unroll
      for (int qt = 0; qt < 2; ++qt) { o1[dt][qt] = __builtin_amdgcn_mfma_f32_16x16x32_bf16(a, pb1[kb][qt], o1[dt][qt], 0, 0, 0); o2[dt][qt] = __builtin_amdgcn_mfma_f32_16x16x32_bf16(a, pb2[kb][qt], o2[dt][qt], 0, 0, 0); }
    }
}
__device__ __forceinline__ void fill42(f32x4 (&a)[4][2], const f32x4 v) {
#pragma unroll
  for (int i = 0; i < 4; ++i)
#pragma unroll
    for (int j = 0; j < 2; ++j) a[i][j] = v;
}
__device__ __forceinline__ void exp42(f32x4 (&a)[4][2]) {
#pragma unroll
  for (int i = 0; i < 4; ++i)
#pragma unroll
    for (int j = 0; j < 2; ++j)
#pragma unroll
      for (int e = 0; e < 4; ++e) a[i][j][e] = __builtin_amdgcn_exp2f(a[i][j][e]);
}
#if defined(PROBE_PH)
#define SECT_B(id) unsigned long long _s##id = 0; if (PROBE_PH == id) _s##id = __builtin_amdgcn_s_memrealtime()
#define SECT_E(id) do { if (PROBE_PH == id) F.pr_t1 += __builtin_amdgcn_s_memrealtime() - _s##id; } while (0)
#else
#define SECT_B(id)
#define SECT_E(id) do {} while (0)
#endif
#if defined(PROBE_PH) && PROBE_PH == 300
#define AT_BAR() do { const unsigned long long _b0 = __builtin_amdgcn_s_memrealtime(); asm volatile("s_waitcnt lgkmcnt(0)" ::: "memory"); __builtin_amdgcn_s_barrier(); asm volatile("" ::: "memory"); F.pr_t1 += __builtin_amdgcn_s_memrealtime() - _b0; } while (0)
#else
#define AT_BAR() do { asm volatile("s_waitcnt lgkmcnt(0)" ::: "memory"); __builtin_amdgcn_s_barrier(); asm volatile("" ::: "memory"); } while (0)
#endif
__device__ __forceinline__ void zero42(f32x4 (&a)[4][2]) {
#pragma unroll
  for (int i = 0; i < 4; ++i)
#pragma unroll
    for (int j = 0; j < 2; ++j) a[i][j] = (f32x4){0.f, 0.f, 0.f, 0.f};
}

__device__ __forceinline__ void phase_compress(PREF p, Frame& F) {
  const int lane = fresh_lane(), w = F.wave, tid = F.tid;
  const int r = lane & 15, g4 = lane >> 4;
  const bf16_t* H = (const bf16_t*)(p.ws + WS_H);
  const bf16_t* W1T = (const bf16_t*)(p.ws + WS_CW1);
  LAS float* part = (LAS float*)F.lds;
  LAS float* hid = part + 8 * 16 * 64;
  LAS float* outv = hid + 16 * 64;
  for (int task = F.vcu; task < 256; task += F.G) {
    const int kv = task >> 7, rb = task & 127;
    int row = rb * 16 + r; if (row > 2039) row = 2039;
    const int gg = row & 1, cc = (row >> 1) % NCMP, bb = (row >> 1) / NCMP;
    const int colbase = OFF_NKV + ((0 * 2 + kv) * 2 + gg) * 64;
    f32x4 acc[4];
#pragma unroll
    for (int nt = 0; nt < 4; ++nt) acc[nt] = (f32x4){0.f, 0.f, 0.f, 0.f};
#pragma unroll 1
    for (int ks = 0; ks < 8; ++ks) {
      const int k = w * 256 + ks * 32 + g4 * 8, l = k >> 6, d0 = k & 63;
      float hv[8]; ld8bf(H + (size_t)(bb * SEQ + 16 * cc + l) * HC + colbase + d0, hv);
      const float* pe = p.cmp_pe + (kv * 32 + l) * 64 + d0;
#pragma unroll
      for (int i = 0; i < 8; ++i) hv[i] += pe[i];
      const bf16x8 a = __builtin_bit_cast(bf16x8, pk8(hv));
#pragma unroll
      for (int nt = 0; nt < 4; ++nt) {
        const bf16x8 bfr = *(const GAS bf16x8*)(W1T + ((size_t)kv * 64 + nt * 16 + r) * 2048 + k);
        acc[nt] = __builtin_amdgcn_mfma_f32_16x16x32_bf16(a, bfr, acc[nt], 0, 0, 0);
      }
    }
#pragma unroll
    for (int nt = 0; nt < 4; ++nt)
#pragma unroll
      for (int i = 0; i < 4; ++i) part[(w * 16 + g4 * 4 + i) * 64 + nt * 16 + r] = acc[nt][i];
    __syncthreads();
    for (int e = tid; e < 1024; e += NWAVES * 64) { float s = 0.f;
#pragma unroll
      for (int ww = 0; ww < 8; ++ww) s += part[ww * 1024 + e];
      hid[e] = gelu_tanh(s); }
    __syncthreads();
    const float* w2 = p.cmp_w2 + kv * 4096;
    for (int e = tid; e < 1024; e += NWAVES * 64) { const int rr = e >> 6, n = e & 63; float s = 0.f;
      for (int j = 0; j < 64; ++j) s += hid[rr * 64 + j] * w2[j * 64 + n];
      outv[e] = s; }
    __syncthreads();
    for (int e = tid; e < 1024; e += NWAVES * 64) { const int rr = e >> 6, n = e & 63;
      const int orow = rb * 16 + rr;
      if (orow < 2040) {
        float v = outv[e];
        if (kv == 0) { float ss = 0.f; for (int j = 0; j < 64; ++j) ss += outv[rr * 64 + j] * outv[rr * 64 + j]; v = v * rsqrtf(ss * (1.f / 64.f) + 1e-6f) * p.nk_norm[n]; }
        const int g2 = orow & 1, c2 = (orow >> 1) % NCMP, b2 = (orow >> 1) / NCMP;
        ((bf16_t*)(p.ws + (kv ? WS_VCMPB : WS_KCMPB)))[((size_t)(b2 * 2 + g2) * 256 + c2) * 64 + n] = (bf16_t)f2bf(v);
      }
    }
    if (task < 16 && tid < 64) { const int kk2 = task >> 3, bg = task & 7; ((bf16_t*)(p.ws + (kk2 ? WS_VCMPB : WS_KCMPB)))[((size_t)bg * 256 + 255) * 64 + tid] = 0; }
    __syncthreads();
  }
}

__device__ __forceinline__ v4u tile_ld(const bf16_t* base, size_t pitch, int tid) { return *(const GAS v4u*)(base + (size_t)(tid >> 3) * pitch + (tid & 7) * 8); }
__device__ __forceinline__ void tile_st(LAS bf16_t* dst, v4u v, int tid) { *(LAS v4u*)(dst + (tid >> 3) * RP + (tid & 7) * 8) = v; }

template <int KS, int MODE>
__device__ __forceinline__ void attn_tile(f32x4 (&o)[4][2], f32x4 (&os)[2], const bf16x8 (&qf)[2][KS], const LAS bf16_t* KBt, int kc0, const LAS bf16_t* VBt, const f32x4 nbv,
                                          const bool (&on)[2], int qq0, int koff, int lane) {
  const int r = lane & 15, g = lane >> 4;
  f32x4 st[4][2]; bf16x8 pb[2][2];
  fill42(st, nbv); qk_tile<KS>(st, KBt, kc0, qf, lane); exp42(st);
  if (MODE != 0) {
#pragma unroll
    for (int kt = 0; kt < 4; ++kt)
#pragma unroll
      for (int qt = 0; qt < 2; ++qt)
#pragma unroll
        for (int i = 0; i < 4; ++i) { const int kk = kt * 16 + g * 4 + i, qq = qq0 + qt * 16 + r;
          bool keep = true;
          if (MODE & 1) keep = keep && on[qt];
          if (MODE & 2) keep = keep && (kk + koff <= qq);
          if (MODE & 4) keep = keep && (kk > qq);
          if (!keep) st[kt][qt][i] = 0.f; }
  }
  pack_p(pb, st);
  pv_apply(o, os, pb, VBt, lane);
}
__device__ __forceinline__ void phase_diffattn(PREF p, Frame& F) {
  const int lane = fresh_lane(), w = F.wave, tid = F.tid;
  const int r = lane & 15, g = lane >> 4;
  const bf16_t* H = (const bf16_t*)(p.ws + WS_H);
  bf16_t* CAT = (bf16_t*)(p.ws + WS_CAT);
  float mq = 0.f, mk = 0.f, l0 = 0.f, l1 = 0.f;
  for (int i = 0; i < 32; i++) { mq = fmaxf(mq, fabsf(p.dq_norm[i])); mk = fmaxf(mk, fabsf(p.dk_norm[i])); l0 += p.dlam[i] * p.dlam[32 + i]; l1 += p.dlam[64 + i] * p.dlam[96 + i]; }
  const float c2 = 0.17677669529663687f * 1.4426950408889634f;
  const float nb = -(32.f * mq * mk) * c2;
  const f32x4 nbv = {nb, nb, nb, nb};
  const float lam = __expf(l0) - __expf(l1) + 0.2f;
  const bool on[2] = {true, true};
  for (int pr = F.vcu; pr < 256; pr += F.G) {
    const int bh = pr >> 3, sp = pr & 7, b = bh >> 3, hd = bh & 7;
#pragma unroll 1
    for (int ui = 0; ui < 2; ++ui) {
      const int qb = ui ? 15 - sp : sp;
      const int NT = 4 * (qb + 1);
      const bf16_t* Kg = H + (size_t)(b * SEQ) * HC + OFF_DK + hd * 64;
      const bf16_t* Vg = H + (size_t)(b * SEQ) * HC + OFF_DV + hd * 64;
      f32x4 o1[4][2];
#pragma unroll 1
      for (int mp = 0; mp < 2; ++mp) {
        bf16x8 qf[2][1];
#pragma unroll
        for (int qt = 0; qt < 2; ++qt) qf[qt][0] = *(const GAS bf16x8*)(H + (size_t)(b * SEQ + qb * 256 + w * 32 + qt * 16 + r) * HC + OFF_DQ + hd * 64 + mp * 32 + g * 8);
        f32x4 o[4][2]; zero42(o);
        f32x4 os[2] = {{0.f, 0.f, 0.f, 0.f}, {0.f, 0.f, 0.f, 0.f}};
        v4u krA = tile_ld(Kg, HC, tid), vrA = tile_ld(Vg, HC, tid);
        v4u krB = tile_ld(Kg + (size_t)64 * HC, HC, tid), vrB = tile_ld(Vg + (size_t)64 * HC, HC, tid);
#pragma unroll 1
        for (int t = 0; t < NT; t += 2) {
#pragma unroll
          for (int hf = 0; hf < 2; ++hf) {
            const int tt = t + hf;
            const lbf KBt = (lbf)(F.lds + hf * 2 * RB), VBt = KBt + 64 * RP;
            tile_st(KBt, hf ? krB : krA, tid); tile_st(VBt, hf ? vrB : vrA, tid);
            AT_BAR();
            if (tt + 2 < NT) { const v4u k2 = tile_ld(Kg + (size_t)(tt + 2) * 64 * HC, HC, tid), v2 = tile_ld(Vg + (size_t)(tt + 2) * 64 * HC, HC, tid);
              if (hf) { krB = k2; vrB = v2; } else { krA = k2; vrA = v2; } }
            const int koff = tt * 64 - (qb * 256 + w * 32);
            if (tt >= NT - 4) attn_tile<1, 2>(o, os, qf, KBt, mp * 32, VBt, nbv, on, 0, koff, lane);
            else attn_tile<1, 0>(o, os, qf, KBt, mp * 32, VBt, nbv, on, 0, koff, lane);
          }
        }
        if (mp == 0) {
#pragma unroll
          for (int qt = 0; qt < 2; ++qt) { const float i1 = 1.f / os[qt][0];
#pragma unroll
            for (int dt = 0; dt < 4; ++dt) o1[dt][qt] = o[dt][qt] * i1; }
        } else {
#pragma unroll
          for (int qt = 0; qt < 2; ++qt) {
            const float i2 = lam / os[qt][0];
            float ss = 0.f;
#pragma unroll
            for (int dt = 0; dt < 4; ++dt)
#pragma unroll
              for (int i = 0; i < 4; ++i) { const float v = o1[dt][qt][i] - o[dt][qt][i] * i2; o1[dt][qt][i] = v; ss += v * v; }
            ss += __shfl_xor(ss, 16, 64); ss += __shfl_xor(ss, 32, 64);
            const float rr = rsqrtf(ss * (1.f / 64.f) + 1e-6f) * 0.8f;
            bf16_t* op = CAT + (size_t)(b * SEQ + qb * 256 + w * 32 + qt * 16 + r) * DM + hd * 64;
#pragma unroll
            for (int dt = 0; dt < 4; ++dt) { const int d0 = dt * 16 + g * 4; const f32x4 sg = *(const f32x4*)(p.dsubln + d0);
              v2u wv; wv.x = pk2(o1[dt][qt][0] * rr * sg[0], o1[dt][qt][1] * rr * sg[1]); wv.y = pk2(o1[dt][qt][2] * rr * sg[2], o1[dt][qt][3] * rr * sg[3]);
              *(GAS v2u*)(op + d0) = wv; }
          }
        }
        AT_BAR();
      }
    }
  }
}

__device__ __forceinline__ void nsa_finish(f32x4 (&comb)[4][2], const f32x4 (&o)[4][2], const f32x4 (&os)[2], const float (&gate)[2], bool normalised) {
#pragma unroll
  for (int qt = 0; qt < 2; ++qt) {
    const float f = normalised ? gate[qt] : gate[qt] / os[qt][0];
#pragma unroll
    for (int dt = 0; dt < 4; ++dt) comb[dt][qt] += o[dt][qt] * f;
  }
}
__device__ __forceinline__ void phase_nsa(PREF p, Frame& F) {
  const int lane = fresh_lane(), w = F.wave, tid = F.tid;
  const int r = lane & 15, g = lane >> 4;
  const bf16_t* H = (const bf16_t*)(p.ws + WS_H);
  const float* GATES = (const float*)(p.ws + WS_GATES);
  bf16_t* CAT = (bf16_t*)(p.ws + WS_CAT);
  float mq = 0.f, mk0 = 0.f, mk1 = 0.f, mk2 = 0.f;
  for (int i = 0; i < 64; i++) { mq = fmaxf(mq, fabsf(p.nq_norm[i])); mk0 = fmaxf(mk0, fabsf(p.nk_norm[i])); mk1 = fmaxf(mk1, fabsf(p.nk_norm[64 + i])); mk2 = fmaxf(mk2, fabsf(p.nk_norm[128 + i])); }
  const float c2 = 0.125f * 1.4426950408889634f;
  const float nb0 = -(64.f * mq * mk0) * c2, nb1 = -(64.f * mq * mk1) * c2, nb2 = -(64.f * mq * mk2) * c2;
  LAS float* IMP = (LAS float*)(F.lds + 12 * RB);
  LAS unsigned char* SELB = (LAS unsigned char*)(F.lds + 12 * RB + 64 * 65 * 4);
  const int hj = w >> 1, th = w & 1;
  for (int pr = F.vcu; pr < 256; pr += F.G) {
    const int bg = pr >> 5, sp = pr & 31, b = bg >> 1, gq = bg & 1;
#pragma unroll 1
    for (int ui = 0; ui < 2; ++ui) {
      const int blk = ui ? 63 - sp : sp;
      const int hh = gq * 4 + hj;
      const int tokw = b * SEQ + blk * 64 + th * 32;
      bf16x8 qf[2][2];
      float gate0[2], gate1[2], gate2[2];
#pragma unroll
      for (int qt = 0; qt < 2; ++qt) { const bf16_t* qp = H + (size_t)(tokw + qt * 16 + r) * HC + OFF_NQ + hh * 64 + g * 8;
        qf[qt][0] = *(const GAS bf16x8*)qp; qf[qt][1] = *(const GAS bf16x8*)(qp + 32);
        const float* gp = GATES + (size_t)(tokw + qt * 16 + r) * 24 + hh * 3; gate0[qt] = gp[0]; gate1[qt] = gp[1]; gate2[qt] = gp[2]; }
      f32x4 comb[4][2]; zero42(comb);
      const int nct = (4 * blk + 3 + 63) >> 6;
      {
        const bf16_t* KC = (const bf16_t*)(p.ws + WS_KCMPB) + (size_t)(b * 2 + gq) * 256 * 64;
        const bf16_t* VC = (const bf16_t*)(p.ws + WS_VCMPB) + (size_t)(b * 2 + gq) * 256 * 64;
        for (int t4 = 0; t4 < nct; ++t4) { tile_st((lbf)(F.lds + t4 * RB), tile_ld(KC + t4 * 4096, 64, tid), tid); tile_st((lbf)(F.lds + (4 + t4) * RB), tile_ld(VC + t4 * 4096, 64, tid), tid); }
        for (int e = tid; e < 64 * 65; e += NWAVES * 64) IMP[e] = 0.f;
        AT_BAR();
        const f32x4 nbv0 = {nb0, nb0, nb0, nb0};
        int cmax[2];
#pragma unroll
        for (int qt = 0; qt < 2; ++qt) { const int pos = blk * 64 + th * 32 + qt * 16 + r; cmax[qt] = (pos >= 31) ? ((pos - 31) >> 4) : -1; }
        float lsum[2] = {0.f, 0.f};
        for (int t4 = 0; t4 < nct; ++t4) {
          f32x4 st[4][2]; fill42(st, nbv0);
          qk_tile<2>(st, (lbf)(F.lds + t4 * RB), 0, qf, lane); exp42(st);
#pragma unroll
          for (int kt = 0; kt < 4; ++kt)
#pragma unroll
            for (int qt = 0; qt < 2; ++qt)
#pragma unroll
              for (int i = 0; i < 4; ++i) { const int c = t4 * 64 + kt * 16 + g * 4 + i; if (c <= cmax[qt]) lsum[qt] += st[kt][qt][i]; }
        }
        float linv[2];
#pragma unroll
        for (int qt = 0; qt < 2; ++qt) { float s = lsum[qt]; s += __shfl_xor(s, 16, 64); s += __shfl_xor(s, 32, 64); linv[qt] = (cmax[qt] >= 0) ? 1.f / s : 0.f; }
        f32x4 o[4][2]; zero42(o);
        f32x4 osd[2] = {{0.f, 0.f, 0.f, 0.f}, {0.f, 0.f, 0.f, 0.f}};
        for (int t4 = 0; t4 < nct; ++t4) {
          f32x4 st[4][2]; fill42(st, nbv0);
          qk_tile<2>(st, (lbf)(F.lds + t4 * RB), 0, qf, lane); exp42(st);
#pragma unroll
          for (int kt = 0; kt < 4; ++kt)
#pragma unroll
            for (int qt = 0; qt < 2; ++qt) {
              float gs = 0.f;
#pragma unroll
              for (int i = 0; i < 4; ++i) { const int c = t4 * 64 + kt * 16 + g * 4 + i;
                const float e = (c <= cmax[qt]) ? st[kt][qt][i] * linv[qt] : 0.f;
                st[kt][qt][i] = e; gs += e; }
              const int ti = th * 32 + qt * 16 + r, j = t4 * 16 + kt * 4 + g;
              if (gs != 0.f) { __hip_atomic_fetch_add(IMP + ti * 65 + j, gs, __ATOMIC_RELAXED, __HIP_MEMORY_SCOPE_WORKGROUP); if (j < 63 && st[kt][qt][3] != 0.f) __hip_atomic_fetch_add(IMP + ti * 65 + j + 1, st[kt][qt][3], __ATOMIC_RELAXED, __HIP_MEMORY_SCOPE_WORKGROUP); }
            }
          bf16x8 pb[2][2]; pack_p(pb, st);
          pv_apply(o, osd, pb, (lbf)(F.lds + (4 + t4) * RB), lane);
        }
        nsa_finish(comb, o, osd, gate0, true);
      }
      AT_BAR();
      {
        const int ti = tid >> 3, jbk = tid & 7, jb = jbk * 8;
        LAS int* IK = (LAS int*)IMP;
        int key[8];
#pragma unroll
        for (int u = 0; u < 8; ++u) { const int j = jb + u; float v = IMP[ti * 65 + j]; if (j == blk || j == 0) v = 1e4f; else if (j > blk) v = -1e30f; key[u] = __float_as_int(v); }
#pragma unroll
        for (int u = 0; u < 8; ++u) IK[ti * 65 + jb + u] = key[u];
        AT_BAR();
        int rank[8];
#pragma unroll
        for (int u = 0; u < 8; ++u) { int c = 0;
#pragma unroll
          for (int u2 = u; u2 < 8; ++u2) c += (key[u2] == key[u]) ? 1 : 0;
          rank[u] = -c; }
#pragma unroll
        for (int ib = 0; ib < 8; ++ib) {
          int th[8];
#pragma unroll
          for (int u = 0; u < 8; ++u) th[u] = key[u] + (ib > jbk ? 1 : 0);
#pragma unroll
          for (int ii = 0; ii < 8; ++ii) { const int k = IK[ti * 65 + ib * 8 + ii];
#pragma unroll
            for (int u = 0; u < 8; ++u) rank[u] += (k >= th[u]) ? 1 : 0; }
        }
        unsigned bits = 0;
#pragma unroll
        for (int u = 0; u < 8; ++u) bits |= (rank[u] < 16 ? 1u : 0u) << u;
        SELB[ti * 8 + jbk] = (unsigned char)bits;
      }
      AT_BAR();
      unsigned long long selm[2];
#pragma unroll
      for (int qt = 0; qt < 2; ++qt) { const int ti = th * 32 + qt * 16 + r; const LAS unsigned* sp2 = (const LAS unsigned*)(SELB + ti * 8); selm[qt] = (unsigned long long)sp2[0] | ((unsigned long long)sp2[1] << 32); }
#pragma unroll 1
      for (int br = 1; br < 3; ++br) {
        const int kcol = OFF_NKV + ((br * 2 + 0) * 2 + gq) * 64, vcol = OFF_NKV + ((br * 2 + 1) * 2 + gq) * 64;
        const float nbb = (br == 1) ? nb1 : nb2;
        const f32x4 nbv = {nbb, nbb, nbb, nbb};
        const int t_lo = (br == 1) ? 0 : (blk > 8 ? blk - 8 : 0);
        const bf16_t* Kg = H + (size_t)(b * SEQ) * HC + kcol;
        const bf16_t* Vg = H + (size_t)(b * SEQ) * HC + vcol;
        f32x4 o[4][2]; zero42(o);
        f32x4 os[2] = {{0.f, 0.f, 0.f, 0.f}, {0.f, 0.f, 0.f, 0.f}};
        v4u krA = tile_ld(Kg + (size_t)t_lo * 64 * HC, HC, tid), vrA = tile_ld(Vg + (size_t)t_lo * 64 * HC, HC, tid);
        v4u krB = krA, vrB = vrA;
        if (t_lo < blk) { krB = tile_ld(Kg + (size_t)(t_lo + 1) * 64 * HC, HC, tid); vrB = tile_ld(Vg + (size_t)(t_lo + 1) * 64 * HC, HC, tid); }
#pragma unroll 1
        for (int t0 = t_lo; t0 <= blk; t0 += 2) {
#pragma unroll
          for (int hf = 0; hf < 2; ++hf) {
            const int t = t0 + hf;
            if (t <= blk) {
              const lbf KBt = (lbf)(F.lds + (8 + hf * 2) * RB), VBt = KBt + 64 * RP;
              tile_st(KBt, hf ? krB : krA, tid); tile_st(VBt, hf ? vrB : vrA, tid);
              AT_BAR();
              if (t + 2 <= blk) { const v4u k2 = tile_ld(Kg + (size_t)(t + 2) * 64 * HC, HC, tid), v2 = tile_ld(Vg + (size_t)(t + 2) * 64 * HC, HC, tid);
                if (hf) { krB = k2; vrB = v2; } else { krA = k2; vrA = v2; } }
              const bool on[2] = {((selm[0] >> t) & 1ull) != 0ull, ((selm[1] >> t) & 1ull) != 0ull};
              const int qq0 = th * 32;
              if (br == 1) {
                if (__any((int)(on[0] || on[1]))) {
                  if (t == blk) attn_tile<2, 3>(o, os, qf, KBt, 0, VBt, nbv, on, qq0, 0, lane);
                  else if (__all((int)(on[0] && on[1]))) attn_tile<2, 0>(o, os, qf, KBt, 0, VBt, nbv, on, qq0, 0, lane);
                  else attn_tile<2, 1>(o, os, qf, KBt, 0, VBt, nbv, on, qq0, 0, lane);
                }
              } else {
                if (t == blk) attn_tile<2, 2>(o, os, qf, KBt, 0, VBt, nbv, on, qq0, 0, lane);
                else if (t == blk - 8) attn_tile<2, 4>(o, os, qf, KBt, 0, VBt, nbv, on, qq0, 0, lane);
                else attn_tile<2, 0>(o, os, qf, KBt, 0, VBt, nbv, on, qq0, 0, lane);
              }
            }
          }
        }
        nsa_finish(comb, o, os, (br == 1) ? gate1 : gate2, false);
        AT_BAR();
      }
#pragma unroll
      for (int qt = 0; qt < 2; ++qt) { bf16_t* op = CAT + (size_t)(tokw + qt * 16 + r) * DM + 512 + hh * 64;
#pragma unroll
        for (int dt = 0; dt < 4; ++dt) { const int d0 = dt * 16 + g * 4; v2u wv; wv.x = pk2(comb[dt][qt][0], comb[dt][qt][1]); wv.y = pk2(comb[dt][qt][2], comb[dt][qt][3]); *(GAS v2u*)(op + d0) = wv; } }
    }
  }
}


__device__ __forceinline__ void phase_lora2(PREF p, Frame& F, const bool skip_store = false, const bool skip_math = false) {
  const int lane = fresh_lane(), w = F.wave, tid = F.tid;
  const int cr = lane & 15, g = lane >> 4;
  constexpr int TP = 392;
  const lbf TM = (lbf)(F.lds);
  const lbf ST = (lbf)(F.lds + 64 * TP * 2) + w * 64 * RP;
  const bf16_t* TMPg = (const bf16_t*)(p.ws + WS_TMP);
  for (int unit = F.vcu; unit < 256; unit += F.G) {
    const int t0 = unit * 64;
    bf16x8 a0[2][4];
    auto wptr = [&](int blk) { const int tensor = blk >> 4, cb = blk & 15, ldw = (tensor == 2) ? 192 : 64;
      return (const bf16_t*)(p.ws + WS_WL2 + (size_t)tensor * 128 * 1024) + (size_t)(cb * 64 + cr) * ldw + g * 8; };
    auto wload = [&](int blk) {
      const int ldw = ((blk >> 4) == 2) ? 192 : 64; const bf16_t* Wp = wptr(blk);
#pragma unroll
      for (int k2 = 0; k2 < 2; ++k2)
#pragma unroll
        for (int ct = 0; ct < 4; ++ct) a0[k2][ct] = *(const GAS bf16x8*)(Wp + (size_t)(16 * ct) * ldw + k2 * 32);
    };
    auto blkof = [&](int j) { return ((j >> 1) << 4) | ((w * 2 + (j & 1) + unit * 3) & 15); };
    wload(blkof(0));
#pragma unroll
    for (int i = 0; i < 6; ++i) { const int idx = tid + i * 512, row = idx / 48, pc = idx - row * 48;
      *(LAS v4u*)(TM + row * TP + pc * 8) = *(const GAS v4u*)(TMPg + (size_t)(t0 + row) * 384 + pc * 8); }
    __syncthreads();
#pragma unroll 1
    for (int j = 0; j < 6; ++j) {
      const int blk = blkof(j);
      const int tensor = blk >> 4, cb = blk & 15, kc0 = tensor * 64;
      f32x4 acc[4][4];
#pragma unroll
      for (int ct = 0; ct < 4; ++ct)
#pragma unroll
        for (int tt = 0; tt < 4; ++tt) acc[ct][tt] = (f32x4){0.f, 0.f, 0.f, 0.f};
      auto kpair = [&](int kp, bf16x8 (&a)[2][4]) {
#pragma unroll
        for (int k2 = 0; k2 < 2; ++k2) {
          bf16x8 b[4];
#pragma unroll
          for (int tt = 0; tt < 4; ++tt) b[tt] = *(const LAS bf16x8*)(TM + (16 * tt + cr) * TP + kc0 + kp * 64 + k2 * 32 + g * 8);
#pragma unroll
          for (int ct = 0; ct < 4; ++ct)
#pragma unroll
            for (int tt = 0; tt < 4; ++tt) acc[ct][tt] = __builtin_amdgcn_mfma_f32_16x16x32_bf16(a[k2][ct], b[tt], acc[ct][tt], 0, 0, 0);
        }
      };
      if (tensor == 2) {
        bf16x8 a1[2][4], a2[2][4]; const bf16_t* Wp = wptr(blk);
#pragma unroll
        for (int k2 = 0; k2 < 2; ++k2)
#pragma unroll
          for (int ct = 0; ct < 4; ++ct) { a1[k2][ct] = *(const GAS bf16x8*)(Wp + (size_t)(16 * ct) * 192 + 64 + k2 * 32); a2[k2][ct] = *(const GAS bf16x8*)(Wp + (size_t)(16 * ct) * 192 + 128 + k2 * 32); }
        kpair(0, a0); kpair(1, a1); kpair(2, a2);
      } else kpair(0, a0);
      if (j < 5) wload(blkof(j + 1));
#pragma unroll
      for (int ct = 0; ct < 4; ++ct) {
        const int n0 = cb * 64 + 16 * ct + 4 * g;
        f32x4 bias = {0.f, 0.f, 0.f, 0.f};
        if (tensor == 0) bias = *(const f32x4*)(p.w0 + n0); else if (tensor == 1) bias = *(const f32x4*)(p.a0 + n0);
#pragma unroll
        for (int tt = 0; tt < 4; ++tt) {
          f32x4 v = acc[ct][tt] + bias;
          if (skip_math) {} else if (tensor == 0) {
#pragma unroll
            for (int i = 0; i < 4; ++i) v[i] = -0.60653066f * sigmoidf_(v[i]);
          } else if (tensor == 1) {
#pragma unroll
            for (int i = 0; i < 4; ++i) v[i] = sigmoidf_(v[i]);
          }
          v2u o; o.x = pk2(v[0], v[1]); o.y = pk2(v[2], v[3]);
          *(LAS v2u*)(ST + (16 * tt + cr) * RP + 16 * ct + 4 * g) = o;
        }
      }
      LDS_WAIT();
      bf16_t* O = (bf16_t*)(p.ws + WS_S0 + (size_t)tensor * SLOT) + (size_t)t0 * DM + cb * 64;
#pragma unroll
      for (int i = 0; i < 8; ++i) { const int row = (lane >> 3) + 8 * i, pc = (lane & 7) * 8;
        const v4u sv = *(const LAS v4u*)(ST + row * RP + pc); if (!skip_store) *(GAS v4u*)(O + (size_t)row * DM + pc) = sv; }
      LDS_WAIT();
    }
    __syncthreads();
  }
}

__global__ void __launch_bounds__(NWAVES * 64, 2) mk_fwd(P p_arg) {
  extern __shared__ __attribute__((aligned(16))) unsigned char lds[];
  Frame F;
  F.lds = (LAS unsigned char*)lds;
  F.MISC = (volatile LAS unsigned*)(F.lds + MISC_OFF);
  F.tid = threadIdx.x; F.lane = F.tid & 63; F.wave = __builtin_amdgcn_readfirstlane(F.tid >> 6);
  F.G = gridDim.x; { const int bx = blockIdx.x; F.vcu = (F.G % 8 == 0) ? (bx % 8) * (F.G / 8) + bx / 8 : bx; }
  unsigned char* const ws = p_arg.ws;
  F.ctl = (gu32*)(ws + WS_CTL);
  for (int u = F.tid; u < (LDS_BYTES - LDSCTL_OFF) / 4; u += NWAVES * 64) ((LAS unsigned*)(F.lds + LDSCTL_OFF))[u] = 0u;
  __syncthreads();
  XcdBarrier bar = xcd_barrier_post((unsigned*)(F.ctl + CW_BAR) + p_arg.pad * XCD_BAR_WORDS, F.MISC + 8);
  const int lo = p_arg.ph_lo, hi = p_arg.ph_hi;
#ifndef PHMASK
#define PHMASK 0xffffffffu
#endif
#define IN(k) (lo <= (k) && (k) < hi && ((PHMASK >> (k)) & 1u))
#define SEAM(k) do { if (IN(k) && IN((k) + 1)) xcd_barrier(bar); } while (0)
#ifdef PROBE_PH
  F.pr_t0 = 0; F.pr_t1 = 0;
#endif

  PROBE_MARK(0); if (IN(0)) { phase_prologue(KP, F); } SEAM(0);
  PROBE_MARK(1); if (IN(1)) {
    pg8::Gemm g{(const bf16_t*)(ws + WS_XN), (const bf16_t*)(ws + WS_WIN), DM, DM};
    pg8::StaticOrder S; S.init(T_TOK, 3072, F.G, (int)blockIdx.x);
    PREF p = KP; EpiInProj E{(bf16_t*)(ws + WS_H), (float*)(ws + WS_GATES), p.dq_norm, p.dk_norm, p.nq_norm, p.nk_norm, p.gate_bias};
    pg8::gemm_phase<EpiInProj, pg8::StaticOrder, true>(F.lds + RING_OFF, g, S, E);
  } SEAM(1);
  PROBE_MARK(2); if (IN(2)) { phase_compress(KP, F); phase_diffattn(KP, F); } SEAM(2);
  PROBE_MARK(3); if (IN(3)) { phase_nsa(KP, F); } SEAM(3);
  PROBE_MARK(4); if (IN(4)) {
    pg8::Gemm g{(const bf16_t*)(ws + WS_CAT), (const bf16_t*)(ws + WS_WOUT), DM, DM};
    pg8::StaticOrder S; S.init(T_TOK, DM, F.G, (int)blockIdx.x);
    PREF p = KP; EpiResid E{p.x, nullptr, (bf16_t*)p.out, nullptr};
    pg8::gemm_phase<EpiResid, pg8::StaticOrder, false>(F.lds + RING_OFF, g, S, E);
  } SEAM(4);
#define MOE_PHASES(layer, pb) do { \
    PROBE_MARK(pb); if (IN(pb)) { phase_router(KP, F, layer); } SEAM(pb); \
    PROBE_MARK(pb + 1); if (IN(pb + 1)) { \
      pg8::Gemm g{layer ? (const bf16_t*)(ws + WS_X3) : (const bf16_t*)KP.out, (const bf16_t*)(ws + WS_EGU), DM, DM}; \
      pg8::moe_order_setup((LAS int*)(F.lds + MISC_OFF + 256), (const unsigned*)(ws + WS_CTL) + CW_CNT + layer * 32 * 64); pg8::MoeOrder<2, true> S{(const LAS int*)(F.lds + MISC_OFF + 256), (const int*)(ws + WS_LIST), F.G, F.vcu}; \
      EpiMoeGU E{(bf16_t*)(ws + WS_HID), (const int*)(ws + WS_LIST), (const float*)(ws + WS_RS)}; \
      pg8::gemm_phase<EpiMoeGU, pg8::MoeOrder<2, true>, true>(F.lds + RING_OFF, g, S, E); \
    } SEAM(pb + 1); \
    PROBE_MARK(pb + 2); if (IN(pb + 2)) { \
      int k256 = 256; asm volatile("" : "+s"(k256)); \
      pg8::Gemm g{(const bf16_t*)(ws + WS_HID), (const bf16_t*)(ws + WS_EDN), k256, 256}; \
      pg8::moe_order_setup((LAS int*)(F.lds + MISC_OFF + 256), (const unsigned*)(ws + WS_CTL) + CW_CNT + layer * 32 * 64); pg8::MoeOrder<4, false> S{(const LAS int*)(F.lds + MISC_OFF + 256), (const int*)(ws + WS_LIST), F.G, F.vcu}; \
      PREF p = KP; EpiMoeDown E{layer ? (bf16_t*)(ws + WS_X3) : (bf16_t*)p.out, (bf16_t*)(ws + WS_Y1), (const int*)(ws + WS_LIST), (const float*)(ws + WS_PGATE), (LAS int*)(F.lds + 132096)}; \
      pg8::gemm_phase<EpiMoeDown, pg8::MoeOrder<4, false>, true>(F.lds + RING_OFF, g, S, E); \
    } SEAM(pb + 2); \
  } while (0)
  MOE_PHASES(0, 5);
  PROBE_MARK(8); if (IN(8)) { phase_rwkv_prep(KP, F); } SEAM(8);
  PROBE_MARK(9); if (IN(9)) {
    pg8::Gemm g{(const bf16_t*)(ws + WS_S0 + 3 * SLOT), (const bf16_t*)(ws + WS_WL1), DM, DM};
    pg8::TallOrder S; S.init(3, 1, F.G, (int)blockIdx.x);
    EpiLora1 E{(bf16_t*)(ws + WS_TMP)};
    pg8::gemm_phase<EpiLora1, pg8::TallOrder, false>(F.lds + RING_OFF, g, S, E);
  } SEAM(9);
  PROBE_MARK(10); if (IN(10)) {
    pg8::Gemm g{(const bf16_t*)(ws + WS_S0), (const bf16_t*)(ws + WS_WRKV), DM, DM};
    pg8::TallOrder S; S.init(3, 4, F.G, (int)blockIdx.x);
    EpiRKV E{ws};
    pg8::gemm_phase<EpiRKV, pg8::TallOrder, true>(F.lds + RING_OFF, g, S, E);
  } SEAM(10);
  PROBE_MARK(11); if (IN(11)) {
#ifdef EXP_A
    phase_lora2(KP, F, KP.ph_lo == 0, false); __syncthreads();
#endif
#ifdef EXP_B
    phase_lora2(KP, F, KP.ph_lo == 0, KP.ph_lo == 0); __syncthreads();
#endif
    phase_lora2(KP, F);
  } SEAM(11);
  PROBE_MARK(12); if (IN(12)) { phase_rwkv_r1(KP, F); } SEAM(12);
  PROBE_MARK(13); if (IN(13)) { phase_rwkv_r2(KP, F); } SEAM(13);
  PROBE_MARK(14); if (IN(14)) { phase_rwkv_r3(KP, F); } SEAM(14);
  PROBE_MARK(15); if (IN(15)) {
    pg8::Gemm g{(const bf16_t*)(ws + WS_S0 + 3 * SLOT), (const bf16_t*)(ws + WS_WO), DM, DM};
    pg8::StaticOrder S; S.init(T_TOK, DM, F.G, (int)blockIdx.x);
    PREF p = KP; EpiResid E{nullptr, (const bf16_t*)p.out, (bf16_t*)(ws + WS_X3), (const bf16_t*)(ws + WS_Y1)};
    pg8::gemm_phase<EpiResid, pg8::StaticOrder, false>(F.lds + RING_OFF, g, S, E);
  } SEAM(15);
  MOE_PHASES(1, 16);
#undef MOE_PHASES
  PROBE_MARK(19); if (IN(19)) { phase_final(KP, F); }
  PROBE_MARK(20);
#ifdef PROBE_PH
  { const unsigned long long dur = (F.pr_t1 - F.pr_t0) * PROBE_MUL, t0 = __builtin_amdgcn_s_memrealtime(); while (__builtin_amdgcn_s_memrealtime() - t0 < dur) __builtin_amdgcn_s_sleep(8); }
#endif
#undef IN
#undef SEAM
}

static void launch_mk(P p, int lo, int hi, int li, int grid, hipStream_t st) {
  p.ph_lo = lo; p.ph_hi = hi; p.pad = li;
  hipLaunchKernelGGL(mk_fwd, dim3(grid), dim3(NWAVES * 64), LDS_BYTES, st, p);
}

extern "C" void kernel_launch(void* const* d_in, const int* in_sizes, int n_in, void* d_out, int out_size, void* d_ws,
                              size_t ws_size, hipStream_t stream) {
  static int grid = 0;
  if (grid == 0) {
    if (n_in != 40 || ws_size < WS_END) { fprintf(stderr, "kernel_launch: bad n_in %d or ws_size %zu (< %zu)\n", n_in, ws_size, (size_t)WS_END); grid = -1; return; }
    int dev = 0, cus = 0;
    if (hipGetDevice(&dev) != hipSuccess || hipDeviceGetAttribute(&cus, hipDeviceAttributeMultiprocessorCount, dev) != hipSuccess) { grid = -1; return; }
    if (hipFuncSetAttribute((const void*)mk_fwd, hipFuncAttributeMaxDynamicSharedMemorySize, LDS_BYTES) != hipSuccess) { grid = -1; return; }
    if (cus < 256) { fprintf(stderr, "kernel_launch: needs 256 CUs (one workgroup per CU), found %d\n", cus); grid = -1; return; }
    grid = 256;
  }
  if (grid < 0) return;
  P p{};
  const float* const* in = (const float* const*)d_in;
  p.x = in[0]; p.mix_norm = in[1]; p.w_in = in[2]; p.gate_bias = in[3]; p.dq_norm = in[4]; p.dk_norm = in[5];
  p.dlam = in[6]; p.dsubln = in[7]; p.nq_norm = in[8]; p.nk_norm = in[9]; p.cmp_pe = in[10]; p.cmp_w1 = in[11];
  p.cmp_w2 = in[12]; p.w_out = in[13]; p.rmix = in[14]; p.w_r = in[15]; p.w_k = in[16]; p.w_v = in[17];
  p.w0 = in[18]; p.w1 = in[19]; p.w2 = in[20]; p.a0 = in[21]; p.a1 = in[22]; p.a2 = in[23]; p.g1 = in[24]; p.g2 = in[25];
  p.k_k = in[26]; p.k_a = in[27]; p.r_k = in[28]; p.ln_w = in[29]; p.ln_b = in[30]; p.w_o = in[31];
  p.ffn_norm = in[32]; p.rg_w = in[33]; p.rg_b = in[34]; p.re_w = in[35]; p.re_b = in[36];
  p.e_gate = in[37]; p.e_up = in[38]; p.e_down = in[39];
  p.out = (float*)d_out;
  p.ws = (unsigned char*)d_ws;
  unsigned char* ws = p.ws;
  (void)hipMemsetAsync(ws + WS_CTL, 0, CTL_ZERO_BYTES, stream);
  launch_mk(p, 0, 20, 0, grid, stream);
}
```

```cpp
#include <hip/hip_runtime.h>
#include <cstdio>
#include <cstdint>

#define T_TOK 16384
#define DM 1024
#define SEQ 4096
#define NBATCH 4
#define INC 2840
#define HC 2816
#define OFF_DQ 0
#define OFF_DK 512
#define OFF_DV 1024
#define OFF_NQ 1536
#define OFF_NKV 2048
#define OFF_NG 2816
#define NCMP 255
#define CAP 16384

#define GAS __attribute__((address_space(1)))
#define LAS __attribute__((address_space(3)))
typedef unsigned short bf16_t;
typedef unsigned v4u __attribute__((ext_vector_type(4)));
typedef unsigned v2u __attribute__((ext_vector_type(2)));
typedef float f32x4 __attribute__((ext_vector_type(4)));
typedef short bf16x8 __attribute__((ext_vector_type(8)));
typedef GAS unsigned gu32;
#define RLX_AGENT __ATOMIC_RELAXED, __HIP_MEMORY_SCOPE_AGENT
#define LDS_WAIT() asm volatile("s_waitcnt lgkmcnt(0)" ::: "memory")
#define VM_WAIT() asm volatile("s_waitcnt vmcnt(0)" ::: "memory")

__device__ __forceinline__ float bf2f(bf16_t v) { return __uint_as_float(((unsigned)v) << 16); }

typedef float f32x2_t __attribute__((ext_vector_type(2))); typedef __bf16 bf16x2_t __attribute__((ext_vector_type(2)));
__device__ __forceinline__ unsigned pk2(float lo, float hi) { const f32x2_t v = {lo, hi}; return __builtin_bit_cast(unsigned, __builtin_convertvector(v, bf16x2_t)); }
__device__ __forceinline__ unsigned f2bf(float f) { return pk2(f, f) & 0xffffu; }
__device__ __forceinline__ float wave_sum(float v) {
#pragma unroll
  for (int o = 32; o >= 1; o >>= 1) v += __shfl_xor(v, o, 64);
  return v;
}
__device__ __forceinline__ float wave_sum_dpp(float v) {
  v += __builtin_bit_cast(float, __builtin_amdgcn_update_dpp(0, __builtin_bit_cast(int, v), 0xB1, 0xf, 0xf, false));
  v += __builtin_bit_cast(float, __builtin_amdgcn_update_dpp(0, __builtin_bit_cast(int, v), 0x4E, 0xf, 0xf, false));
  v += __builtin_bit_cast(float, __builtin_amdgcn_update_dpp(0, __builtin_bit_cast(int, v), 0x141, 0xf, 0xf, false));
  v += __builtin_bit_cast(float, __builtin_amdgcn_update_dpp(0, __builtin_bit_cast(int, v), 0x140, 0xf, 0xf, false));
  const int iv = __builtin_bit_cast(int, v);
  return (__builtin_bit_cast(float, __builtin_amdgcn_readlane(iv, 0)) + __builtin_bit_cast(float, __builtin_amdgcn_readlane(iv, 16))) +
         (__builtin_bit_cast(float, __builtin_amdgcn_readlane(iv, 32)) + __builtin_bit_cast(float, __builtin_amdgcn_readlane(iv, 48)));
}
__device__ __forceinline__ int fresh_lane() { int l; asm volatile("v_mbcnt_lo_u32_b32 %0, -1, 0\n\tv_mbcnt_hi_u32_b32 %0, -1, %0" : "=v"(l)); return l; }
__device__ __forceinline__ float uniformf(float v) { return __builtin_bit_cast(float, __builtin_amdgcn_readfirstlane(__builtin_bit_cast(int, v))); }
__device__ __forceinline__ float sum_x32(float v) { const auto rr = __builtin_amdgcn_permlane32_swap(__float_as_uint(v), __float_as_uint(v), false, false); return __uint_as_float(rr[0]) + __uint_as_float(rr[1]); }
__device__ __forceinline__ float sum_x16(float v) { const auto rr = __builtin_amdgcn_permlane16_swap(__float_as_uint(v), __float_as_uint(v), false, false); return __uint_as_float(rr[0]) + __uint_as_float(rr[1]); }
__device__ __forceinline__ float sum_x16_32(float v) { return sum_x32(sum_x16(v)); }
__device__ __forceinline__ float sigmoidf_(float x) { return __builtin_amdgcn_rcpf(1.f + __builtin_amdgcn_exp2f(-1.44269504f * x)); }
__device__ __forceinline__ float tanhf_(float x) { return 1.f - 2.f * __builtin_amdgcn_rcpf(1.f + __builtin_amdgcn_exp2f(2.88539008f * x)); }
__device__ __forceinline__ float softplusf_(float x) { return fmaxf(x, 0.f) + __logf(1.f + __expf(-fabsf(x))); }
__device__ __forceinline__ float gelu_tanh(float x) {
  float u = 0.7978845608028654f * (x + 0.044715f * x * x * x);
  return 0.5f * x * (1.f + tanhf(u));
}

constexpr size_t MiB = 1u << 20;
constexpr size_t WS_CTL = 0, CTL_ZERO_BYTES = 160 * 1024;
constexpr size_t WS_WIN = 1 * MiB;
constexpr size_t WS_WOUT = 7 * MiB;
constexpr size_t WS_WRKV = 9 * MiB;
constexpr size_t WS_WO = 15 * MiB;
constexpr size_t WS_WL1 = 17 * MiB;
constexpr size_t WS_WL2 = 19 * MiB;
constexpr size_t WS_WR = 20 * MiB;
constexpr size_t WS_RS = 20 * MiB + 640 * 1024;
constexpr size_t WS_EGU = 22 * MiB;
constexpr size_t WS_EDN = 54 * MiB;
constexpr size_t WS_ACT = 70 * MiB;
constexpr size_t WS_XN = WS_ACT;
constexpr size_t WS_H = WS_ACT + 32 * MiB;
constexpr size_t WS_GATES = WS_ACT + 120 * MiB;
constexpr size_t WS_CAT = WS_ACT + 122 * MiB;
constexpr size_t WS_KCMPB = WS_ACT + 154 * MiB;
constexpr size_t WS_VCMPB = WS_ACT + 155 * MiB;
constexpr size_t WS_CW1 = 21 * MiB + 256 * 1024;
constexpr size_t WS_XN2 = WS_ACT;
constexpr size_t WS_HID = WS_ACT + 32 * MiB;
constexpr size_t WS_Y1 = WS_EGU;
constexpr size_t WS_LIST = WS_ACT + 156 * MiB;
constexpr size_t WS_PGATE = WS_ACT + 158 * MiB;
constexpr size_t WS_X3 = WS_ACT + 64 * MiB;
constexpr size_t WS_XN2F = WS_ACT;
constexpr size_t WS_GUF = WS_ACT + 64 * MiB;
constexpr size_t WS_S0 = WS_ACT;
constexpr size_t WS_TMP = WS_ACT + 192 * MiB;
constexpr size_t WS_END = WS_ACT + 204 * MiB;
constexpr size_t SLOT = 32 * MiB;
constexpr int CW_BAR = 4096;
constexpr int CW_CNT = 32768;

namespace pg8 {
#define PG8_LAS __attribute__((address_space(3)))
typedef unsigned u32x4 __attribute__((ext_vector_type(4)));
constexpr int BM = 256, BK = 64, HALF = 128, HTB = HALF * BK * 2  , STAGE_BYTES = 8 * HTB, NXCD = 8, WGM = 8;

__host__ __device__ __forceinline__ int lds_byte(int r, int c) { const int st = (r >> 4) * 2 + (c >> 5), rr = r & 15, cc = c & 31, ob = rr * 64 + cc * 2; return st * 1024 + (ob ^ (((ob >> 9) & 1) << 5)); }
__host__ __device__ __forceinline__ void stage_rc(int b, int& R, int& C) { const int st = b / 1024, sb = b % 1024, swz = sb ^ (((sb >> 9) & 1) << 5); R = (st >> 1) * 16 + swz / 64; C = (st & 1) * 32 + (swz % 64) / 2; }
__host__ __device__ __forceinline__ int perm32(int rho) { const int n = rho >> 4, i = rho & 15; return 8 * (i >> 2) + 4 * n + (i & 3); }

struct Unit { int pm, pn, e, nrows, rt, par; };
struct Gemm { const bf16_t* A; const bf16_t* Bt; int K; int lda; };

__device__ __forceinline__ void static_map(int L, int nM, int nN, int& pm, int& pn) {
    const int nwg = nM * nN;
    int wgid = L; { const int q = nwg / NXCD, r = nwg % NXCD, xcd = wgid % NXCD, off = wgid / NXCD; wgid = (xcd < r ? xcd * (q + 1) : r * (q + 1) + (xcd - r) * q) + off; }
    const int nig = WGM * nN, gid = wgid / nig, fm = gid * WGM, gsz = (nM - fm) < WGM ? (nM - fm) : WGM;
    pm = fm + ((wgid % nig) % gsz); pn = (wgid % nig) / gsz;
}
struct StaticOrder {
    int nM, nN, G, c;
    __device__ void init(int M, int N, int G_, int c_) { nM = M / BM; nN = N / BM; G = G_; c = c_; }
    __device__ __forceinline__ bool next(int i, Unit& u) const {
        const int L = i * G + c; if (L >= nM * nN) return false;
        static_map(L, nM, nN, u.pm, u.pn); u.e = 0; u.nrows = 256; u.rt = 0; return true;
    }
    __device__ __forceinline__ unsigned rowoff(const Unit& u, int r, int C, int K) const { return (unsigned)((u.pm * BM + r) * K + C) * 2u; }
};
struct TallOrder {
    int nM, nN, G, c;
    __device__ void init(int ngemm, int nN_, int G_, int c_) { nM = 64 * ngemm; nN = nN_; G = G_; c = c_; }
    __device__ __forceinline__ bool next(int i, Unit& u) const {
        const int L = i * G + c; if (L >= nM * nN) return false;
        int pn; static_map(L, nM, nN, u.pm, pn); u.pn = (u.pm >> 6) * nN + pn; u.e = 0; u.nrows = 256; u.rt = 0; return true;
    }
    __device__ __forceinline__ unsigned rowoff(const Unit& u, int r, int C, int K) const { return (unsigned)((u.pm * BM + r) * K + C) * 2u; }
};


template <int NCOL, bool GATHER>
struct MoeOrder {
    const PG8_LAS int* tab;
    const int* list; int G, c;
    __device__ __forceinline__ bool next(int i, Unit& u) const {
        const int L = i * G + c; const int R = L / NCOL, j = L - R * NCOL;
        if (R >= tab[32]) return false;
        int e = 0;
#pragma unroll
        for (int s = 16; s >= 1; s >>= 1) { if (tab[e + s] <= R) e += s; }
        const int ce = tab[33 + e];
        u.pm = R; u.rt = R - tab[e]; u.e = e; u.pn = e * NCOL + j; u.nrows = ce - u.rt * 256; return true;
    }
    __device__ __forceinline__ unsigned rowoff(const Unit& u, int r, int C, int K) const {
        if (GATHER) { const int idx = (r < u.nrows) ? u.rt * 256 + r : 0; const int pr = list[(size_t)u.e * CAP + idx]; return (unsigned)((pr >> 1) * K + C) * 2u; }
        return (unsigned)((u.pm * BM + r) * K + C) * 2u;
    }
};
__device__ __forceinline__ void moe_order_setup(PG8_LAS int* tab, const unsigned* cnt) {
    if (threadIdx.x < 32) tab[33 + threadIdx.x] = (int)__hip_atomic_load(cnt + threadIdx.x * 64, __ATOMIC_RELAXED, __HIP_MEMORY_SCOPE_AGENT);
    __syncthreads();
    if (threadIdx.x == 0) { int pre = 0; for (int e = 0; e < 32; ++e) { tab[e] = pre; pre += (tab[33 + e] + 255) >> 8; } tab[32] = pre; }
    __syncthreads();
}

__device__ __forceinline__ unsigned cvt_pk_bf16(float lo, float hi) { unsigned r; asm volatile("v_cvt_pk_bf16_f32 %0, %1, %2" : "=v"(r) : "v"(lo), "v"(hi)); return r; }
__device__ __forceinline__ u32x4 pack8(const f32x4& a, const f32x4& b) { u32x4 w; w.x = cvt_pk_bf16(a[0], a[1]); w.y = cvt_pk_bf16(a[2], a[3]); w.z = cvt_pk_bf16(b[0], b[1]); w.w = cvt_pk_bf16(b[2], b[3]); return w; }

template <class Epi, class Sched, bool ALIGN_EPI>
__device__ __forceinline__ void gemm_phase(PG8_LAS unsigned char* lds, const Gemm g, const Sched& S, const Epi& E) {
    const int tid = threadIdx.x, wid = __builtin_amdgcn_readfirstlane(tid >> 6), lane = tid & 63, wr = wid >> 2, wc = wid & 3, fr = lane & 15, fq = lane >> 4;
    const int K = g.K, nt = K / BK;
    int RA[2], CA[2]; unsigned voffB[2];
#pragma unroll
    for (int i = 0; i < 2; ++i) { int R, C; stage_rc(tid * 16 + i * 8192, R, C); const int Rb = Epi::PERM ? ((R & ~31) + perm32(R & 31)) : R;
        RA[i] = R; CA[i] = C; voffB[i] = (unsigned)(Rb * K + C) * 2u; }
    const size_t kstep = (size_t)(BK * 2);
    const size_t hstep = (size_t)HALF * K * 2;
    const size_t tstep = 2 * hstep;
    const unsigned ldsw = (unsigned)wid * 1024u;
    const int aoff = lds_byte(wr * 64 + fr, fq * 8), boff = lds_byte(wc * 32 + fr, fq * 8);
    const char* const Abase = (const char*)g.A;
#define PG8_SA(b, h) (((b) * 2 + (h)) * HTB)
#define PG8_SB(b, h) ((4 + (b) * 2 + (h)) * HTB)
#define PG8_STAGE(bufoff, gbase, voff) do { _Pragma("unroll") for (int _i = 0; _i < 2; ++_i) \
        __builtin_amdgcn_global_load_lds((const unsigned*)((const char*)(gbase) + (voff)[_i]), (PG8_LAS unsigned*)(lds + (bufoff) + ldsw + _i * 8192), 16, 0, 0); } while (0)
#define PG8_STAGEA(bufoff, kbyte, o0, o1) do { \
        __builtin_amdgcn_global_load_lds((const unsigned*)(Abase + (size_t)(kbyte) + (o0)), (PG8_LAS unsigned*)(lds + (bufoff) + ldsw), 16, 0, 0); \
        __builtin_amdgcn_global_load_lds((const unsigned*)(Abase + (size_t)(kbyte) + (o1)), (PG8_LAS unsigned*)(lds + (bufoff) + ldsw + 8192), 16, 0, 0); } while (0)
#define PG8_LDA(dst, b, h) do { _Pragma("unroll") for (int m = 0; m < 4; ++m) _Pragma("unroll") for (int k = 0; k < 2; ++k) dst[m][k] = *(const PG8_LAS bf16x8*)(lds + PG8_SA(b, h) + aoff + m * 2048 + k * 1024); } while (0)
#define PG8_LDB(dst, b, h) do { _Pragma("unroll") for (int n = 0; n < 2; ++n) _Pragma("unroll") for (int k = 0; k < 2; ++k) dst[n][k] = *(const PG8_LAS bf16x8*)(lds + PG8_SB(b, h) + boff + n * 2048 + k * 1024); } while (0)
#define PG8_MMA(ai, bj, At, Bt) do { __builtin_amdgcn_s_setprio(1); _Pragma("unroll") for (int m = 0; m < 4; ++m) _Pragma("unroll") for (int n = 0; n < 2; ++n) _Pragma("unroll") for (int k = 0; k < 2; ++k) \
        acc[ai][bj][m][n] = __builtin_amdgcn_mfma_f32_16x16x32_bf16(Bt[n][k], At[m][k], acc[ai][bj][m][n], 0, 0, 0); __builtin_amdgcn_s_setprio(0); } while (0)
#define PG8_WAIT_V(n) asm volatile("s_waitcnt vmcnt(" #n ")" ::: "memory")
#define PG8_WAIT_L(n) asm volatile("s_waitcnt lgkmcnt(" #n ")" ::: "memory")
#define PG8_BAR __builtin_amdgcn_s_barrier()
#define PG8_SCHED __builtin_amdgcn_sched_barrier(0)
    Unit cur, nxt; int ui = 0;
    if (!S.next(0, cur)) return;
    cur.par = 0;
    if constexpr (Epi::HAS_PRE) E.pre(cur);
    f32x4 acc[2][2][4][2];
#pragma unroll
    for (int a = 0; a < 2; ++a)
#pragma unroll
        for (int b = 0; b < 2; ++b)
#pragma unroll
            for (int m = 0; m < 4; ++m)
#pragma unroll
                for (int n = 0; n < 2; ++n) acc[a][b][m][n] = (f32x4){0.f, 0.f, 0.f, 0.f};
    bf16x8 At[4][2], B0[2][2], B1[2][2];
    unsigned c00 = S.rowoff(cur, RA[0], CA[0], g.lda), c01 = S.rowoff(cur, RA[1], CA[1], g.lda), c10 = S.rowoff(cur, HALF + RA[0], CA[0], g.lda), c11 = S.rowoff(cur, HALF + RA[1], CA[1], g.lda);
    unsigned n00, n01, n10, n11;
    const char* cB = (const char*)g.Bt + (size_t)cur.pn * tstep;
    PG8_STAGE(PG8_SB(0, 0), cB, voffB); PG8_STAGE(PG8_SB(0, 1), cB + hstep, voffB); PG8_STAGEA(PG8_SA(0, 0), 0, c00, c01); PG8_STAGEA(PG8_SA(0, 1), 0, c10, c11);
    if (wr == 1) PG8_BAR;
    PG8_WAIT_V(2); PG8_BAR;
    PG8_STAGE(PG8_SB(1, 0), cB + kstep, voffB); PG8_STAGEA(PG8_SA(1, 0), kstep, c00, c01); PG8_STAGE(PG8_SB(1, 1), cB + hstep + kstep, voffB);
    PG8_WAIT_V(6); PG8_BAR;
    for (;;) {
        const bool has_next = S.next(ui + 1, nxt);
        const char* nB = has_next ? (const char*)g.Bt + (size_t)nxt.pn * tstep : cB;
        if (has_next) { n00 = S.rowoff(nxt, RA[0], CA[0], g.lda); n01 = S.rowoff(nxt, RA[1], CA[1], g.lda); n10 = S.rowoff(nxt, HALF + RA[0], CA[0], g.lda); n11 = S.rowoff(nxt, HALF + RA[1], CA[1], g.lda); }
        else { n00 = c00; n01 = c01; n10 = c10; n11 = c11; }
        for (int t = 0; t < nt; t += 2) {
            const bool last = (t == nt - 2);
            const size_t k1 = (size_t)(t + 1) * kstep;
            const size_t k2 = last ? 0 : (size_t)(t + 2) * kstep;
            const size_t k3 = k2 + kstep;
            const unsigned a00 = last ? n00 : c00, a01 = last ? n01 : c01, a10 = last ? n10 : c10, a11 = last ? n11 : c11;
            const char* b2 = last ? nB : cB + (size_t)(t + 2) * kstep;
            const char* b3 = b2 + kstep;
            PG8_LDB(B0, 0, 0); PG8_LDB(B1, 0, 1); PG8_SCHED; PG8_LDA(At, 0, 0); PG8_STAGEA(PG8_SA(1, 1), k1, c10, c11);
            PG8_WAIT_V(8); PG8_WAIT_L(0); PG8_BAR; PG8_MMA(0, 0, At, B0); PG8_MMA(0, 1, At, B1); PG8_BAR; PG8_SCHED;
            PG8_LDA(At, 0, 1); PG8_STAGE(PG8_SB(0, 0), b2, voffB); PG8_STAGE(PG8_SB(0, 1), b2 + hstep, voffB); PG8_STAGEA(PG8_SA(0, 0), k2, a00, a01);
            PG8_WAIT_V(8); PG8_WAIT_L(0); PG8_BAR; PG8_MMA(1, 0, At, B0); PG8_MMA(1, 1, At, B1); PG8_BAR; PG8_SCHED;
            PG8_LDB(B0, 1, 0); PG8_LDB(B1, 1, 1); PG8_SCHED; PG8_LDA(At, 1, 0); PG8_STAGEA(PG8_SA(0, 1), k2, a10, a11);
            PG8_WAIT_V(8); PG8_WAIT_L(0); PG8_BAR; PG8_MMA(0, 0, At, B0); PG8_MMA(0, 1, At, B1); PG8_BAR; PG8_SCHED;
            PG8_LDA(At, 1, 1); PG8_STAGE(PG8_SB(1, 0), b3, voffB); PG8_STAGE(PG8_SB(1, 1), b3 + hstep, voffB); PG8_STAGEA(PG8_SA(1, 0), k3, a00, a01);
            PG8_WAIT_V(8); PG8_WAIT_L(0); PG8_BAR; PG8_MMA(1, 0, At, B0); PG8_MMA(1, 1, At, B1); PG8_BAR; PG8_SCHED;
        }
        if constexpr (ALIGN_EPI) { if (wr == 0) PG8_BAR; }
        E(acc, cur, wr, wc, fr, fq);
        if (!has_next) break;
#pragma unroll
        for (int a = 0; a < 2; ++a)
#pragma unroll
            for (int b = 0; b < 2; ++b)
#pragma unroll
                for (int m = 0; m < 4; ++m)
#pragma unroll
                    for (int n = 0; n < 2; ++n) acc[a][b][m][n] = (f32x4){0.f, 0.f, 0.f, 0.f};
        cur = nxt; cB = nB; c00 = n00; c01 = n01; c10 = n10; c11 = n11; ++ui; cur.par = ui & 1;
        if constexpr (Epi::HAS_PRE) E.pre(cur);
        if constexpr (ALIGN_EPI) { if (wr == 1) PG8_BAR; }
    }
    PG8_WAIT_V(0);
    if constexpr (!ALIGN_EPI) { if (wr == 0) PG8_BAR; }
    PG8_BAR;
#undef PG8_SA
#undef PG8_SB
#undef PG8_STAGE
#undef PG8_STAGEA
#undef PG8_LDA
#undef PG8_LDB
#undef PG8_MMA
#undef PG8_WAIT_V
#undef PG8_WAIT_L
#undef PG8_BAR
#undef PG8_SCHED
}
}

#define XB_TMO      128
#define XB_XCNT(j)  (256  + 64 * (j))
#define XB_XSUB(j)  (1280 + 64 * (j))
#define XB_XGEN(j)  (2304 + 64 * (j))
#define XB_TOP      3328
#define XB_TOPGEN   3392
#define XCD_BAR_WORDS 3456
#define XB_SPIN_CAP (1u << 18)

__device__ __forceinline__ unsigned xb_ld(unsigned* p)              { return __hip_atomic_load(p, __ATOMIC_RELAXED, __HIP_MEMORY_SCOPE_AGENT); }
__device__ __forceinline__ unsigned xb_add(unsigned* p, unsigned v) { return __hip_atomic_fetch_add(p, v, __ATOMIC_RELAXED, __HIP_MEMORY_SCOPE_AGENT); }
__device__ __forceinline__ unsigned xb_xcc_id() { return (unsigned)__builtin_amdgcn_s_getreg((3 << 11) | 20) & 0xFu; }
#define XB_SPIN(cond, bar) do { unsigned _sp = 0; while (cond) { __builtin_amdgcn_s_sleep(1); \
    if ((++_sp & 255u) == 0u) { if (xb_ld(&(bar)[XB_TMO])) break; if (_sp > XB_SPIN_CAP) { atomicAdd(&(bar)[XB_TMO], 1u); break; } } } } while (0)

struct XcdBarrier {
    unsigned* bar; unsigned x;
    volatile LAS unsigned* st;
};

__device__ __forceinline__ XcdBarrier xcd_barrier_post(unsigned* bar, volatile LAS unsigned* st) {
    XcdBarrier b; b.bar = bar; b.x = xb_xcc_id(); b.st = st;
    if (threadIdx.x == 0) (void)xb_add(&bar[XB_XCNT(b.x)], 1u);
    return b;
}
__device__ __forceinline__ void xcd_barrier_complete(unsigned* bar, unsigned x, unsigned& nloc, unsigned& nx) {
    const unsigned G = gridDim.x * gridDim.y * gridDim.z;
    unsigned sum, cnt, mine, sp = 0u;
    for (;;) {
        sum = 0u; cnt = 0u; mine = 0u;
#pragma unroll
        for (unsigned j = 0; j < 16; ++j) { const unsigned c = xb_ld(&bar[XB_XCNT(j)]); sum += c; cnt += (c > 0u) ? 1u : 0u; mine = (j == x) ? c : mine; }
        if (sum == G) break;
        __builtin_amdgcn_s_sleep(1);
        if ((++sp & 255u) == 0u) { if (xb_ld(&bar[XB_TMO])) break; if (sp > XB_SPIN_CAP) { atomicAdd(&bar[XB_TMO], 1u); break; } }
    }
    nloc = mine > 0u ? mine : 1u; nx = cnt > 0u ? cnt : 1u;
}

__device__ __forceinline__ void xcd_barrier(const XcdBarrier& b) {
    asm volatile("s_waitcnt vmcnt(0)" ::: "memory");
    __syncthreads();
    if (threadIdx.x == 0) {
        unsigned* bar = b.bar;
        __builtin_amdgcn_s_waitcnt(0);
        unsigned nloc = b.st[0], nx = b.st[1];
        if (nloc == 0u) { xcd_barrier_complete(bar, b.x, nloc, nx); b.st[0] = nloc; b.st[1] = nx; }
        const unsigned old = xb_add(&bar[XB_XSUB(b.x)], 1u);
        const unsigned gen = old / nloc;
        if (old + 1u == (gen + 1u) * nloc) {
            __builtin_amdgcn_fence(__ATOMIC_RELEASE, "agent");
            asm volatile("s_waitcnt vmcnt(0)" ::: "memory");
            const unsigned og = xb_add(&bar[XB_TOP], 1u);
            const unsigned tg = og / nx;
            if (og + 1u == (tg + 1u) * nx) xb_add(&bar[XB_TOPGEN], 1u);
            else XB_SPIN(xb_ld(&bar[XB_TOPGEN]) == tg, bar);
            __builtin_amdgcn_fence(__ATOMIC_ACQUIRE, "agent");
            xb_add(&bar[XB_XGEN(b.x)], 1u);
            asm volatile("s_waitcnt vmcnt(0)" ::: "memory");
        } else {
            XB_SPIN(xb_ld(&bar[XB_XGEN(b.x)]) == gen, bar);
            __builtin_amdgcn_fence(__ATOMIC_ACQUIRE, "agent");
            asm volatile("s_waitcnt vmcnt(0)" ::: "memory");
        }
    }
    __syncthreads();
}
struct P {
  const float* x; const float* mix_norm; const float* w_in; const float* gate_bias;
  const float* dq_norm; const float* dk_norm; const float* dlam; const float* dsubln;
  const float* nq_norm; const float* nk_norm; const float* cmp_pe; const float* cmp_w1; const float* cmp_w2;
  const float* w_out;
  const float* rmix; const float* w_r; const float* w_k; const float* w_v;
  const float* w0; const float* w1; const float* w2; const float* a0; const float* a1; const float* a2;
  const float* g1; const float* g2; const float* k_k; const float* k_a; const float* r_k;
  const float* ln_w; const float* ln_b; const float* w_o;
  const float* ffn_norm; const float* rg_w; const float* rg_b; const float* re_w; const float* re_b;
  const float* e_gate; const float* e_up; const float* e_down;
  float* out;
  unsigned char* ws;
  int ph_lo, ph_hi, layer, pad;
};

#define PREF const __attribute__((address_space(4))) P&
__device__ __forceinline__ const __attribute__((address_space(4))) P* opaque_kernarg() { auto q = __builtin_amdgcn_kernarg_segment_ptr(); asm volatile("" : "+s"(q)); return (const __attribute__((address_space(4))) P*)q; }
#define KP (*opaque_kernarg())

constexpr int RING_OFF = 0, RING_BYTES = 131072;
constexpr int LDSCTL_OFF = RING_BYTES, MISC_OFF = LDSCTL_OFF + 320;
constexpr int LDS_BYTES = 147456;
constexpr int NWAVES = 8;

struct Frame {
  LAS unsigned char* lds;
  volatile LAS unsigned* MISC;
  gu32* ctl;
  int tid, lane, wave, vcu, G;
#ifdef PROBE_PH
  unsigned long long pr_t0, pr_t1;
#endif
};
#ifdef PROBE_PH
#define PROBE_MARK(k) do { if ((k) == PROBE_PH) F.pr_t0 = __builtin_amdgcn_s_memrealtime(); if ((k) == PROBE_PH + PROBE_N) F.pr_t1 = __builtin_amdgcn_s_memrealtime(); } while (0)
#else
#define PROBE_MARK(k) do {} while (0)
#endif

__device__ __forceinline__ void transpose_item(const float* W, int ldsrc, int k0, int c0, int ncols, bf16_t* dst, int ldk, int drow0, LAS float* scr, int lane, const float* kscale = nullptr) {
  const int kr = lane >> 3, c4 = (lane & 7) * 4;
  f32x4 v[8];
#pragma unroll
  for (int i = 0; i < 8; ++i) v[i] = (c4 < ncols) ? *(const GAS f32x4*)(W + (size_t)(k0 + kr + 8 * i) * ldsrc + c0 + c4) : (f32x4){0.f, 0.f, 0.f, 0.f};
  if (kscale) {
#pragma unroll
    for (int i = 0; i < 8; ++i) v[i] = v[i] * kscale[k0 + kr + 8 * i]; }
#pragma unroll
  for (int i = 0; i < 8; ++i) { LAS float* s = scr + (kr + 8 * i) * 33 + c4; s[0] = v[i].x; s[1] = v[i].y; s[2] = v[i].z; s[3] = v[i].w; }
  LDS_WAIT(); asm volatile("" ::: "memory");
  const int c = lane & 7;
#pragma unroll
  for (int j = 0; j < 4; ++j) { const int n = (lane >> 3) + 8 * j; const LAS float* s = scr + (8 * c) * 33 + n;
    v4u o; o.x = pk2(s[0 * 33], s[1 * 33]); o.y = pk2(s[2 * 33], s[3 * 33]); o.z = pk2(s[4 * 33], s[5 * 33]); o.w = pk2(s[6 * 33], s[7 * 33]);
    *(GAS v4u*)(dst + (size_t)(drow0 + n) * ldk + k0 + 8 * c) = o; }
  LDS_WAIT(); asm volatile("" ::: "memory");
}
template <int NR>
__device__ __forceinline__ void rms_rows_to_bf16(const float* x, const float* gain, bf16_t* o, int m0, int stride, int lane) {
  f32x4 v[NR][4];
#pragma unroll
  for (int r = 0; r < NR; ++r) { const GAS f32x4* xr = (const GAS f32x4*)(x + (size_t)(m0 + r * stride) * DM) + lane;
#pragma unroll
    for (int j = 0; j < 4; ++j) v[r][j] = xr[64 * j]; }
  const GAS f32x4* gr = (const GAS f32x4*)gain + lane;
  f32x4 g[4];
#pragma unroll
  for (int j = 0; j < 4; ++j) g[j] = gr[64 * j];
#pragma unroll
  for (int r = 0; r < NR; ++r) {
    float s = 0.f;
#pragma unroll
    for (int j = 0; j < 4; ++j) s += (v[r][j].x * v[r][j].x + v[r][j].y * v[r][j].y) + (v[r][j].z * v[r][j].z + v[r][j].w * v[r][j].w);
    const float rr = rsqrtf(wave_sum_dpp(s) * (1.f / DM) + 1e-6f);
    GAS v2u* o8 = (GAS v2u*)(o + (size_t)(m0 + r * stride) * DM) + lane;
#pragma unroll
    for (int j = 0; j < 4; ++j) { v2u w; w.x = pk2(v[r][j].x * rr * g[j].x, v[r][j].y * rr * g[j].y); w.y = pk2(v[r][j].z * rr * g[j].z, v[r][j].w * rr * g[j].w); o8[64 * j] = w; }
  }
}

__device__ __forceinline__ void conv_win_item(PREF p, int it, LAS float* scr, int lane) {
  const int vg = it >> 4, kb = it & 15;
  const int pn = vg >> 3, bj = (vg >> 2) & 1, wc = vg & 3, s = pn * 4 + wc;
  int c0 = 0, nc = 0;
  if (s < 44) { c0 = 64 * s + 32 * bj; nc = 32; } else if (s == 44 && bj == 0) { c0 = OFF_NG; nc = 24; }
  transpose_item(p.w_in, INC, kb * 64, c0, nc, (bf16_t*)(p.ws + WS_WIN), DM, vg * 32, scr, lane);
}
__device__ __forceinline__ void conv_sq_item(const float* W, bf16_t* dst, int drow_base, int it, LAS float* scr, int lane) {
  const int cg = it >> 4, kb = it & 15;
  transpose_item(W, DM, kb * 64, cg * 32, 32, dst, DM, drow_base + cg * 32, scr, lane);
}
__device__ __forceinline__ void conv_expert_item(PREF p, int layer, int it, LAS float* scr, int lane, bf16_t* egu) {
  const int e = it / 384, r = it % 384;
  if (r < 256) {
    const int up = r >> 7, q = r & 127, cgp = q >> 4, kb = q & 15;
    const int pn = cgp >> 2, qq = cgp & 3;
    const float* W = (up ? p.e_up : p.e_gate) + ((size_t)layer * 32 + e) * DM * 256;
    transpose_item(W, 256, kb * 64, cgp * 32, 32, egu, DM, e * 512 + pn * 256 + up * 128 + qq * 32, scr, lane, p.ffn_norm + layer * DM);
  } else {
    const int q = r - 256, cg = q >> 2, kb = q & 3;
    const float* W = p.e_down + ((size_t)layer * 32 + e) * 256 * DM;
    transpose_item(W, DM, kb * 64, cg * 32, 32, (bf16_t*)(p.ws + WS_EDN), 256, e * 1024 + cg * 32, scr, lane);
  }
}

using pg8::Unit; using pg8::u32x4; using pg8::pack8;
struct EpiInProj {
  static constexpr bool PERM = true, HAS_PRE = false;
  bf16_t* H; float* GATES; const float* dq; const float* dk; const float* nq; const float* nk; const float* gbias;
  __device__ __forceinline__ void operator()(const f32x4 (&acc)[2][2][4][2], const Unit& u, int wr, int wc, int fr, int fq) const {
    const int s = u.pn * 4 + wc;
    if (s > 44) return;
    const int row0 = u.pm * 256 + wr * 64 + fr;
    if (s == 44) {
      if (fq < 3) {
        f32x4 b0 = *(const f32x4*)(gbias + 8 * fq), b1 = *(const f32x4*)(gbias + 8 * fq + 4);
#pragma unroll
        for (int ai = 0; ai < 2; ++ai)
#pragma unroll
          for (int m = 0; m < 4; ++m) { float* gp = GATES + (size_t)(row0 + ai * 128 + m * 16) * 24 + 8 * fq;
            f32x4 v0 = acc[ai][0][m][0] + b0, v1 = acc[ai][0][m][1] + b1;
#pragma unroll
            for (int i = 0; i < 4; ++i) { v0[i] = sigmoidf_(v0[i]); v1[i] = sigmoidf_(v1[i]); }
            *(f32x4*)gp = v0; *(f32x4*)(gp + 4) = v1; }
      }
      return;
    }
    int mode = 0; const float* gain = nullptr;
    if (s < 8) { mode = 1; gain = dq; } else if (s < 16) { mode = 1; gain = dk; }
    else if (s >= 24 && s < 32) { mode = 2; gain = nq; }
    else if (s >= 32) { const int q = s - 32, br = q >> 2, kv = (q >> 1) & 1; if (kv == 0 && br >= 1) { mode = 2; gain = nk + br * 64; } }
    const float qsc = (s < 8) ? 0.17677669529663687f * 1.4426950408889634f : ((s >= 24 && s < 32) ? 0.125f * 1.4426950408889634f : 1.f);
    f32x4 g[2][2];
#pragma unroll
    for (int bj = 0; bj < 2; ++bj)
#pragma unroll
      for (int n = 0; n < 2; ++n) {
        if (mode == 1) g[bj][n] = *(const f32x4*)(gain + 8 * fq + 4 * n);
        else if (mode == 2) g[bj][n] = *(const f32x4*)(gain + 32 * bj + 8 * fq + 4 * n);
        else g[bj][n] = (f32x4){1.f, 1.f, 1.f, 1.f};
      }
#pragma unroll
    for (int ai = 0; ai < 2; ++ai)
#pragma unroll
      for (int m = 0; m < 4; ++m) {
        float sc[2] = {1.f, 1.f};
        if (mode != 0) {
          float ss[2];
#pragma unroll
          for (int bj = 0; bj < 2; ++bj) { const f32x4 a = acc[ai][bj][m][0], b = acc[ai][bj][m][1];
            float t = (a[0] * a[0] + a[1] * a[1]) + (a[2] * a[2] + a[3] * a[3]) + (b[0] * b[0] + b[1] * b[1]) + (b[2] * b[2] + b[3] * b[3]);
            ss[bj] = sum_x16_32(t); }
          if (mode == 1) { sc[0] = rsqrtf(ss[0] * (1.f / 32.f) + 1e-6f) * qsc; sc[1] = rsqrtf(ss[1] * (1.f / 32.f) + 1e-6f) * qsc; }
          else { const float r = rsqrtf((ss[0] + ss[1]) * (1.f / 64.f) + 1e-6f) * qsc; sc[0] = r; sc[1] = r; }
        }
        bf16_t* rowp = H + (size_t)(row0 + ai * 128 + m * 16) * HC + 64 * s + 8 * fq;
#pragma unroll
        for (int bj = 0; bj < 2; ++bj) { const f32x4 v0 = acc[ai][bj][m][0] * sc[bj] * g[bj][0], v1 = acc[ai][bj][m][1] * sc[bj] * g[bj][1];
          *(u32x4*)(rowp + 32 * bj) = pack8(v0, v1); }
      }
  }
};
struct EpiResid {
  static constexpr bool PERM = true, HAS_PRE = false;
  const float* xf; const bf16_t* xb; bf16_t* out; const bf16_t* y1;
  __device__ __forceinline__ void operator()(const f32x4 (&acc)[2][2][4][2], const Unit& u, int wr, int wc, int fr, int fq) const {
    const int row0 = u.pm * 256 + wr * 64 + fr, col0 = u.pn * 256 + wc * 32 + 8 * fq;
#pragma unroll
    for (int ai = 0; ai < 2; ++ai)
#pragma unroll
      for (int m = 0; m < 4; ++m) { const size_t off = (size_t)(row0 + ai * 128 + m * 16) * DM + col0;
#pragma unroll
        for (int bj = 0; bj < 2; ++bj) {
          f32x4 b0, b1;
          if (xf) { b0 = *(const f32x4*)(xf + off + bj * 128); b1 = *(const f32x4*)(xf + off + bj * 128 + 4); }
          else { const v4u w = *(const v4u*)(xb + off + bj * 128);
            b0 = (f32x4){__uint_as_float(w.x << 16), __uint_as_float(w.x & 0xffff0000u), __uint_as_float(w.y << 16), __uint_as_float(w.y & 0xffff0000u)};
            b1 = (f32x4){__uint_as_float(w.z << 16), __uint_as_float(w.z & 0xffff0000u), __uint_as_float(w.w << 16), __uint_as_float(w.w & 0xffff0000u)}; }
          if (y1) { const v4u w = *(const v4u*)(y1 + off + bj * 128);
            b0 += (f32x4){__uint_as_float(w.x << 16), __uint_as_float(w.x & 0xffff0000u), __uint_as_float(w.y << 16), __uint_as_float(w.y & 0xffff0000u)};
            b1 += (f32x4){__uint_as_float(w.z << 16), __uint_as_float(w.z & 0xffff0000u), __uint_as_float(w.w << 16), __uint_as_float(w.w & 0xffff0000u)}; }
          *(u32x4*)(out + off + bj * 128) = pack8(b0 + acc[ai][bj][m][0], b1 + acc[ai][bj][m][1]); asm volatile("" ::: "memory"); } }
  }
};
struct EpiRKV {
  static constexpr bool PERM = true, HAS_PRE = false;
  unsigned char* ws;
  __device__ __forceinline__ void operator()(const f32x4 (&acc)[2][2][4][2], const Unit& u, int wr, int wc, int fr, int fq) const {
    const int gi = u.pm >> 6;
    bf16_t* O = (bf16_t*)(ws + WS_S0 + (size_t)(3 + gi) * SLOT);
    const int row0 = (u.pm & 63) * 256 + wr * 64 + fr, col0 = (u.pn & 3) * 256 + wc * 32 + 8 * fq;
#pragma unroll
    for (int ai = 0; ai < 2; ++ai)
#pragma unroll
      for (int m = 0; m < 4; ++m) { bf16_t* rowp = O + (size_t)(row0 + ai * 128 + m * 16) * DM + col0;
#pragma unroll
        for (int bj = 0; bj < 2; ++bj) *(u32x4*)(rowp + bj * 128) = pack8(acc[ai][bj][m][0], acc[ai][bj][m][1]); }
  }
};
struct EpiLora1 {
  static constexpr bool PERM = true, HAS_PRE = false;
  bf16_t* TMP;
  template <int BJ>
  __device__ __forceinline__ void half(const f32x4 (&acc)[2][2][4][2], int gi, int row0, int wc, int fq) const {
    const int c = BJ * 128 + wc * 32 + 8 * fq;
    const bool skip = (gi < 2) && (c >= 64);
    const int dcol = (gi < 2) ? gi * 64 + c : 128 + c;
    const bool zero = (gi == 2) && (c >= 160);
    if (skip) return;
#pragma unroll
    for (int ai = 0; ai < 2; ++ai)
#pragma unroll
      for (int m = 0; m < 4; ++m) {
        f32x4 v0 = acc[ai][BJ][m][0], v1 = acc[ai][BJ][m][1];
#pragma unroll
        for (int i = 0; i < 4; ++i) {
          if (gi == 0) { v0[i] = tanhf_(v0[i]); v1[i] = tanhf_(v1[i]); }
          else if (gi == 2) { v0[i] = zero ? 0.f : sigmoidf_(v0[i]); v1[i] = zero ? 0.f : sigmoidf_(v1[i]); }
        }
        *(u32x4*)(TMP + (size_t)(row0 + ai * 128 + m * 16) * 384 + dcol) = pack8(v0, v1);
      }
  }
  __device__ __forceinline__ void operator()(const f32x4 (&acc)[2][2][4][2], const Unit& u, int wr, int wc, int fr, int fq) const {
    const int gi = u.pm >> 6;
    const int row0 = (u.pm & 63) * 256 + wr * 64 + fr;
    half<0>(acc, gi, row0, wc, fq);
    half<1>(acc, gi, row0, wc, fq);
  }
};
struct EpiLora2 {
  static constexpr bool PERM = true, HAS_PRE = false;
  unsigned char* ws; const float* w0; const float* a0; int gbase;
  __device__ __forceinline__ void operator()(const f32x4 (&acc)[2][2][4][2], const Unit& u, int wr, int wc, int fr, int fq) const {
    const int gi = gbase + (u.pn >> 2);
    bf16_t* O = (bf16_t*)(ws + WS_S0 + (size_t)gi * SLOT);
    const int row0 = u.pm * 256 + wr * 64 + fr, col0 = (u.pn & 3) * 256 + wc * 32 + 8 * fq;
    f32x4 b[2][2];
#pragma unroll
    for (int bj = 0; bj < 2; ++bj)
#pragma unroll
      for (int n = 0; n < 2; ++n) b[bj][n] = (gi == 0) ? *(const f32x4*)(w0 + col0 + bj * 128 + 4 * n) : (gi == 1 ? *(const f32x4*)(a0 + col0 + bj * 128 + 4 * n) : (f32x4){0.f, 0.f, 0.f, 0.f});
#pragma unroll
    for (int ai = 0; ai < 2; ++ai)
#pragma unroll
      for (int m = 0; m < 4; ++m) { bf16_t* rowp = O + (size_t)(row0 + ai * 128 + m * 16) * DM + col0;
#pragma unroll
        for (int bj = 0; bj < 2; ++bj) { f32x4 v0 = acc[ai][bj][m][0] + b[bj][0], v1 = acc[ai][bj][m][1] + b[bj][1];
          if (gi == 0) {
#pragma unroll
            for (int i = 0; i < 4; ++i) { v0[i] = -__expf(-softplusf_(-v0[i]) - 0.5f); v1[i] = -__expf(-softplusf_(-v1[i]) - 0.5f); }
          } else if (gi == 1) {
#pragma unroll
            for (int i = 0; i < 4; ++i) { v0[i] = sigmoidf_(v0[i]); v1[i] = sigmoidf_(v1[i]); }
          }
          *(u32x4*)(rowp + bj * 128) = pack8(v0, v1); } }
  }
};
struct EpiMoeGU {
  static constexpr bool PERM = true, HAS_PRE = false;
  bf16_t* HID; const int* list; const float* RS;
  __device__ __forceinline__ void operator()(const f32x4 (&acc)[2][2][4][2], const Unit& u, int wr, int wc, int fr, int fq) const {
    const int row0 = u.pm * 256 + wr * 64 + fr, col0 = (u.pn & 1) * 128 + wc * 32 + 8 * fq;
    const int* lp = list + (size_t)u.e * CAP + u.rt * 256;
#pragma unroll
    for (int ai = 0; ai < 2; ++ai)
#pragma unroll
      for (int m = 0; m < 4; ++m) {
        const int r = wr * 64 + fr + ai * 128 + m * 16;
        const float rs = RS[lp[(r < u.nrows) ? r : 0] >> 1];
        f32x4 h[2];
#pragma unroll
        for (int n = 0; n < 2; ++n) { const f32x4 g = acc[ai][0][m][n] * rs, up = acc[ai][1][m][n] * rs;
#pragma unroll
          for (int i = 0; i < 4; ++i) h[n][i] = g[i] * sigmoidf_(g[i]) * up[i]; }
        *(u32x4*)(HID + (size_t)(row0 + ai * 128 + m * 16) * 256 + col0) = pack8(h[0], h[1]);
      }
  }
};
struct EpiMoeDown {
  static constexpr bool PERM = false, HAS_PRE = true;
  bf16_t* out; bf16_t* Y1; const int* list; const float* pgate; LAS int* ept;
  __device__ __forceinline__ void pre(const Unit& u) const {
    const int r = threadIdx.x;
    if (r < 256) { int pr = -1; float gt = 0.f;
      if (r < u.nrows) { pr = list[(size_t)u.e * CAP + u.rt * 256 + r]; gt = pgate[pr]; }
      LAS int* e = ept + (u.par * 256 + r) * 2; e[0] = pr; e[1] = __float_as_int(gt); }
  }
  __device__ __forceinline__ void operator()(const f32x4 (&acc)[2][2][4][2], const Unit& u, int wr, int wc, int fr, int fq) const {
    const int col0 = (u.pn & 3) * 256 + wc * 32 + 4 * fq;
#pragma unroll
    for (int ai = 0; ai < 2; ++ai)
#pragma unroll
      for (int m = 0; m < 4; ++m) {
        const int r = ai * 128 + wr * 64 + m * 16 + fr;
        const LAS int* e = ept + (u.par * 256 + r) * 2;
        const int pr = e[0]; const float gt = __int_as_float(e[1]);
        if (pr >= 0) {
          const int tok = pr >> 1;
          if ((pr & 1) == 0) {
            bf16_t* op = out + (size_t)tok * DM + col0;
#pragma unroll
            for (int bj = 0; bj < 2; ++bj)
#pragma unroll
              for (int n = 0; n < 2; ++n) { const v2u w = *(const v2u*)(op + bj * 128 + n * 16);
                const f32x4 b = {__uint_as_float(w.x << 16), __uint_as_float(w.x & 0xffff0000u), __uint_as_float(w.y << 16), __uint_as_float(w.y & 0xffff0000u)};
                const f32x4 v = b + acc[ai][bj][m][n] * gt; v2u o; o.x = pk2(v[0], v[1]); o.y = pk2(v[2], v[3]); *(v2u*)(op + bj * 128 + n * 16) = o; }
          } else {
            bf16_t* yp = Y1 + (size_t)tok * DM + col0;
#pragma unroll
            for (int bj = 0; bj < 2; ++bj)
#pragma unroll
              for (int n = 0; n < 2; ++n) { const f32x4 v = acc[ai][bj][m][n] * gt; v2u w; w.x = pk2(v[0], v[1]); w.y = pk2(v[2], v[3]); *(v2u*)(yp + bj * 128 + n * 16) = w; }
          }
        }
      }
  }
};

typedef LAS bf16_t* lbf;
__device__ __forceinline__ void phase_prologue(PREF p, Frame& F) {
  const int lane = fresh_lane();
  LAS float* scr = (LAS float*)(F.lds + RING_OFF + F.wave * 16384);
  const int gw = F.vcu * NWAVES + F.wave, NGW = F.G * NWAVES;
  constexpr int I_WIN = 96 * 16, I_SQ = 32 * 16;
  constexpr int NITEMS = I_WIN + 5 * I_SQ + 128;
  for (int it = gw; it < NITEMS; it += NGW) {
    int r = it;
    if (r < I_WIN) { conv_win_item(p, r, scr, fresh_lane()); continue; } r -= I_WIN;
    if (r < I_SQ) { conv_sq_item(p.w_out, (bf16_t*)(p.ws + WS_WOUT), 0, r, scr, fresh_lane()); continue; } r -= I_SQ;
    if (r < I_SQ) { conv_sq_item(p.w_r, (bf16_t*)(p.ws + WS_WRKV), 0, r, scr, fresh_lane()); continue; } r -= I_SQ;
    if (r < I_SQ) { conv_sq_item(p.w_k, (bf16_t*)(p.ws + WS_WRKV), 1024, r, scr, fresh_lane()); continue; } r -= I_SQ;
    if (r < I_SQ) { conv_sq_item(p.w_v, (bf16_t*)(p.ws + WS_WRKV), 2048, r, scr, fresh_lane()); continue; } r -= I_SQ;
    if (r < I_SQ) { conv_sq_item(p.w_o, (bf16_t*)(p.ws + WS_WO), 0, r, scr, fresh_lane()); continue; } r -= I_SQ;
    { const int kv = r >> 6, q = r & 63, kb = q >> 1, cg = q & 1;
      transpose_item(p.cmp_w1 + (size_t)kv * 2048 * 64, 64, kb * 64, cg * 32, 32, (bf16_t*)(p.ws + WS_CW1) + (size_t)kv * 64 * 2048, 2048, cg * 32, scr, fresh_lane()); }
  }
  {
    const int gt = (F.vcu * NWAVES + F.wave) * 64 + fresh_lane(), NGT = NGW * 64;
    bf16_t* WL1 = (bf16_t*)(p.ws + WS_WL1);
    for (int i = gt; i < 768 * 1024; i += NGT) {
      const int n = i >> 10, k = i & 1023, gi = n >> 8, c = n & 255;
      float v = 0.f;
      if (gi == 0) { if (c < 64) v = p.w1[k * 64 + c]; }
      else if (gi == 1) { if (c < 64) v = p.a1[k * 64 + c]; }
      else { if (c < 160) v = p.g1[k * 160 + c]; }
      WL1[i] = (bf16_t)f2bf(v);
    }
    bf16_t* WL2w = (bf16_t*)(p.ws + WS_WL2);
    bf16_t* WL2a = (bf16_t*)(p.ws + WS_WL2 + 128 * 1024);
    bf16_t* WL2g = (bf16_t*)(p.ws + WS_WL2 + 256 * 1024);
    for (int i = gt; i < 1024 * 64; i += NGT) { const int n = i >> 6, k = i & 63; WL2w[i] = (bf16_t)f2bf(p.w2[k * 1024 + n]); WL2a[i] = (bf16_t)f2bf(p.a2[k * 1024 + n]); }
    for (int i = gt; i < 1024 * 192; i += NGT) { const int n = i / 192, k = i - n * 192; WL2g[i] = (bf16_t)f2bf(k < 160 ? p.g2[k * 1024 + n] : 0.f); }
    bf16_t* WR = (bf16_t*)(p.ws + WS_WR);
    for (int i = gt; i < 2 * 48 * 1024; i += NGT) {
      const int layer = i / (48 * 1024), rem = i - layer * 48 * 1024, n = rem >> 10, k = rem & 1023;
      float wv = 0.f;
      if (n < 4) wv = p.rg_w[(size_t)layer * DM * 4 + k * 4 + n]; else if (n < 36) wv = p.re_w[(size_t)layer * DM * 32 + k * 32 + (n - 4)];
      wv *= p.ffn_norm[layer * DM + k];
      const unsigned h = f2bf(wv); const float r1 = wv - __uint_as_float(h << 16);
      const unsigned m = f2bf(r1); const float r2 = r1 - __uint_as_float(m << 16);
      const unsigned l = f2bf(r2);
      bf16_t* o = WR + (size_t)layer * 144 * 1024 + (size_t)n * 1024 + k;
      o[0] = (bf16_t)h; o[48 * 1024] = (bf16_t)m; o[96 * 1024] = (bf16_t)l;
    }
  }
  bf16_t* XN = (bf16_t*)(p.ws + WS_XN);
  for (int m = gw; m < T_TOK; m += 4 * NGW) rms_rows_to_bf16<4>(p.x, p.mix_norm, XN, m, NGW, lane);
}


__device__ __forceinline__ void up8(const v4u w, float (&o)[8]) {
  o[0] = __uint_as_float(w.x << 16); o[1] = __uint_as_float(w.x & 0xffff0000u); o[2] = __uint_as_float(w.y << 16); o[3] = __uint_as_float(w.y & 0xffff0000u);
  o[4] = __uint_as_float(w.z << 16); o[5] = __uint_as_float(w.z & 0xffff0000u); o[6] = __uint_as_float(w.w << 16); o[7] = __uint_as_float(w.w & 0xffff0000u);
}
__device__ __forceinline__ f32x4 bf4(const v2u w) { return (f32x4){__uint_as_float(w.x << 16), __uint_as_float(w.x & 0xffff0000u), __uint_as_float(w.y << 16), __uint_as_float(w.y & 0xffff0000u)}; }
__device__ __forceinline__ void phase_router(PREF p, Frame& F, int layer) {
  const int gw = F.vcu * NWAVES + F.wave, NGW = F.G * NWAVES;
  const int lane = fresh_lane();
  PROBE_MARK(100 + layer * 10);
  {
    LAS float* scr = (LAS float*)(F.lds + RING_OFF + F.wave * 16384);
    for (int it = gw; it < 32 * 384; it += NGW) conv_expert_item(p, layer, it, scr, lane, (bf16_t*)(p.ws + WS_EGU));
  }
  __syncthreads();
  PROBE_MARK(101 + layer * 10);
  constexpr int WQP = 264;
  const lbf WQ = (lbf)(F.lds);
  LAS float* SSP = (LAS float*)(F.lds + 80 * 1024);
  LAS float* LGP = (LAS float*)(F.lds + 81 * 1024);
  const int w = F.wave, par = w & 1, tk = lane & 15, kg = lane >> 4;
  const bf16_t* xres = layer ? (const bf16_t*)(p.ws + WS_X3) : (const bf16_t*)p.out;
  const int tok = F.vcu * 64 + (w >> 1) * 16 + tk;
  bf16x8 xf[4][4];
  { const bf16_t* xr = xres + (size_t)tok * DM + 128 * par + 8 * kg;
#pragma unroll
    for (int j = 0; j < 4; ++j)
#pragma unroll
      for (int s = 0; s < 4; ++s) xf[j][s] = *(const GAS bf16x8*)(xr + 256 * j + 32 * s); }
  {
    float ss = 0.f;
#pragma unroll
    for (int j = 0; j < 4; ++j)
#pragma unroll
      for (int s = 0; s < 4; ++s) { float f[8]; up8(__builtin_bit_cast(v4u, xf[j][s]), f);
#pragma unroll
        for (int i = 0; i < 8; ++i) ss += f[i] * f[i]; }
    ss += __shfl_xor(ss, 16, 64); ss += __shfl_xor(ss, 32, 64);
    if (kg == 0) SSP[w * 16 + tk] = ss;
  }
  PROBE_MARK(102 + layer * 10);
  f32x4 acc[9];
#pragma unroll
  for (int nt = 0; nt < 9; ++nt) acc[nt] = (f32x4){0.f, 0.f, 0.f, 0.f};
  const bf16_t* WRl = (const bf16_t*)(p.ws + WS_WR) + (size_t)layer * 144 * 1024;
  float rs = 0.f;
#pragma unroll
  for (int j = 0; j < 4; ++j) {
    __syncthreads();
#pragma unroll
    for (int i = 0; i < 9; ++i) { const int idx = F.tid + i * 512, row = idx >> 5, pc = idx & 31;
      *(LAS v4u*)(WQ + row * WQP + pc * 8) = *(const GAS v4u*)(WRl + (size_t)row * 1024 + 256 * j + pc * 8); }
    __syncthreads();
    if (j == 0) {
      rs = rsqrtf((SSP[(w & ~1) * 16 + tk] + SSP[(w | 1) * 16 + tk]) * (1.f / DM) + 1e-6f);
      if (par == 0 && kg == 0) ((float*)(p.ws + WS_RS))[tok] = rs;
    }
#pragma unroll
    for (int s = 0; s < 4; ++s)
#pragma unroll
      for (int nt = 0; nt < 9; ++nt) {
        const bf16x8 a = *(const LAS bf16x8*)(WQ + (nt * 16 + tk) * WQP + 128 * par + 32 * s + 8 * kg);
        acc[nt] = __builtin_amdgcn_mfma_f32_16x16x32_bf16(a, xf[j][s], acc[nt], 0, 0, 0);
      }
  }
  PROBE_MARK(103 + layer * 10);
#pragma unroll
  for (int nt = 0; nt < 3; ++nt)
#pragma unroll
    for (int i = 0; i < 4; ++i) { const int n = nt * 16 + 4 * kg + i;
      if (n < 36) LGP[(w * 16 + tk) * 36 + n] = ((acc[6 + nt][i] + acc[3 + nt][i]) + acc[nt][i]) * rs; }
  LAS unsigned* LC = (LAS unsigned*)(F.lds + 118784);
  if (F.tid < 64) LC[F.tid] = 0u;
  __syncthreads();
  int ea = 0, eb = 0; unsigned la = 0, lb = 0; float ga = 0.f, gb = 0.f;
  if (lane < 8) {
    const LAS float* lg0 = LGP + ((w & ~1) * 16 + par * 8 + lane) * 36; const LAS float* lg1 = LGP + ((w | 1) * 16 + par * 8 + lane) * 36;
    const float* bg = p.rg_b + layer * 4;
    const float* be = p.re_b + layer * 32;
    float gl[4]; int gi = 0; float gm = -3.4e38f;
#pragma unroll
    for (int i = 0; i < 4; i++) { gl[i] = (lg0[i] + lg1[i]) + bg[i]; if (gl[i] > gm) { gm = gl[i]; gi = i; } }
    float gs = 0.f;
#pragma unroll
    for (int i = 0; i < 4; i++) gs += __expf(gl[i] - gm);
    const float grp_p = 1.f / gs;
    float v0 = -3.4e38f, v1 = -3.4e38f; int i0 = 0, i1 = 0;
    for (int i = 0; i < 8; i++) {
      const float v = (lg0[4 + gi * 8 + i] + lg1[4 + gi * 8 + i]) + be[gi * 8 + i];
      if (v > v0) { v1 = v0; i1 = i0; v0 = v; i0 = i; }
      else if (v > v1) { v1 = v; i1 = i; }
    }
    const float e1 = __expf(v1 - v0);
    ga = grp_p / (1.f + e1); gb = grp_p * e1 / (1.f + e1);
    ea = gi * 8 + i0; eb = gi * 8 + i1;
    la = __hip_atomic_fetch_add(LC + ea, 1u, __ATOMIC_RELAXED, __HIP_MEMORY_SCOPE_WORKGROUP);
    lb = __hip_atomic_fetch_add(LC + eb, 1u, __ATOMIC_RELAXED, __HIP_MEMORY_SCOPE_WORKGROUP);
  }
  __syncthreads();
  if (F.tid < 32) { const unsigned n = LC[F.tid];
    unsigned* cnt = (unsigned*)(p.ws + WS_CTL) + CW_CNT + (layer * 32 + F.tid) * 64;
    LC[32 + F.tid] = n ? __hip_atomic_fetch_add(cnt, n, __ATOMIC_RELAXED, __HIP_MEMORY_SCOPE_AGENT) : 0u; }
  __syncthreads();
  if (lane < 8) {
    const int t = gw * 8 + lane;
    int* list = (int*)(p.ws + WS_LIST); float* pgate = (float*)(p.ws + WS_PGATE);
    list[(size_t)ea * CAP + LC[32 + ea] + la] = 2 * t; pgate[2 * t] = ga;
    list[(size_t)eb * CAP + LC[32 + eb] + lb] = 2 * t + 1; pgate[2 * t + 1] = gb;
  }
  PROBE_MARK(104 + layer * 10);
}

__device__ __forceinline__ void phase_final(PREF p, Frame& F) {
  const int gw = F.vcu * NWAVES + F.wave, NGW = F.G * NWAVES;
  const int lane = fresh_lane();
  const bf16_t* Y1 = (const bf16_t*)(p.ws + WS_Y1);
  const bf16_t* X3 = (const bf16_t*)(p.ws + WS_X3);
  for (int t = gw; t < T_TOK; t += NGW) {
    GAS f32x4* xo = (GAS f32x4*)(p.out + (size_t)t * DM) + lane;
    const GAS v2u* xr = (const GAS v2u*)(X3 + (size_t)t * DM) + lane;
    const GAS v2u* yr = (const GAS v2u*)(Y1 + (size_t)t * DM) + lane;
#pragma unroll
    for (int j = 0; j < 4; ++j) xo[64 * j] = bf4(xr[64 * j]) + bf4(yr[64 * j]);
  }
}

__device__ __forceinline__ void phase_rwkv_prep(PREF p, Frame& F) {
  const int gw = F.vcu * NWAVES + F.wave, NGW = F.G * NWAVES;
  const int lane = fresh_lane();
  const float* gain = p.mix_norm + DM;
  const bf16_t* X1 = (const bf16_t*)p.out;
  const bf16_t* Y1 = (const bf16_t*)(p.ws + WS_Y1);
  float g[2][8];
#pragma unroll
  for (int c = 0; c < 2; ++c) { const f32x4 a = *(const GAS f32x4*)(gain + c * 512 + lane * 8), b = *(const GAS f32x4*)(gain + c * 512 + lane * 8 + 4);
    g[c][0] = a.x; g[c][1] = a.y; g[c][2] = a.z; g[c][3] = a.w; g[c][4] = b.x; g[c][5] = b.y; g[c][6] = b.z; g[c][7] = b.w; }
  for (int run = gw; run < T_TOK / 8; run += NGW) {
    const int t0 = run * 8;
    float prev[2][8];
    if ((t0 & (SEQ - 1)) == 0) {
#pragma unroll
      for (int c = 0; c < 2; ++c)
#pragma unroll
        for (int i = 0; i < 8; ++i) prev[c][i] = 0.f;
    } else {
      float s = 0.f;
#pragma unroll
      for (int c = 0; c < 2; ++c) { float xa[8], ya[8];
        up8(*(const GAS v4u*)(X1 + (size_t)(t0 - 1) * DM + c * 512 + lane * 8), xa); up8(*(const GAS v4u*)(Y1 + (size_t)(t0 - 1) * DM + c * 512 + lane * 8), ya);
#pragma unroll
        for (int i = 0; i < 8; ++i) { prev[c][i] = xa[i] + ya[i]; s += prev[c][i] * prev[c][i]; } }
      const float r = rsqrtf(wave_sum_dpp(s) * (1.f / DM) + 1e-6f);
#pragma unroll
      for (int c = 0; c < 2; ++c)
#pragma unroll
        for (int i = 0; i < 8; ++i) prev[c][i] *= r * g[c][i];
    }
    v4u nx[2], ny[2];
#pragma unroll
    for (int c = 0; c < 2; ++c) { nx[c] = *(const GAS v4u*)(X1 + (size_t)t0 * DM + c * 512 + lane * 8); ny[c] = *(const GAS v4u*)(Y1 + (size_t)t0 * DM + c * 512 + lane * 8); }
#pragma unroll 1
    for (int tt = 0; tt < 8; ++tt) {
      const int t = t0 + tt;
      float v[2][8]; float s = 0.f;
#pragma unroll
      for (int c = 0; c < 2; ++c) { float xa[8], ya[8]; up8(nx[c], xa); up8(ny[c], ya);
#pragma unroll
        for (int i = 0; i < 8; ++i) { v[c][i] = xa[i] + ya[i]; s += v[c][i] * v[c][i]; } }
      if (tt < 7) {
#pragma unroll
        for (int c = 0; c < 2; ++c) { nx[c] = *(const GAS v4u*)(X1 + (size_t)(t + 1) * DM + c * 512 + lane * 8); ny[c] = *(const GAS v4u*)(Y1 + (size_t)(t + 1) * DM + c * 512 + lane * 8); } }
      const float r = rsqrtf(wave_sum_dpp(s) * (1.f / DM) + 1e-6f);
#pragma unroll
      for (int c = 0; c < 2; ++c)
#pragma unroll
        for (int i = 0; i < 8; ++i) v[c][i] *= r * g[c][i];
#pragma unroll
      for (int sl = 0; sl < 6; ++sl) {
        const int mj = (sl == 0) ? 0 : (sl == 1) ? 2 : (sl == 2) ? 3 : (sl == 3) ? 1 : (sl == 4) ? 4 : 5;
        bf16_t* o = (bf16_t*)(p.ws + WS_S0 + (size_t)sl * SLOT) + (size_t)t * DM;
#pragma unroll
        for (int c = 0; c < 2; ++c) {
          const f32x4 ma = *(const GAS f32x4*)(p.rmix + mj * DM + c * 512 + lane * 8), mb = *(const GAS f32x4*)(p.rmix + mj * DM + c * 512 + lane * 8 + 4);
          const float mx[8] = {ma.x, ma.y, ma.z, ma.w, mb.x, mb.y, mb.z, mb.w};
          float q[8];
#pragma unroll
          for (int i = 0; i < 8; ++i) q[i] = v[c][i] + (prev[c][i] - v[c][i]) * mx[i];
          v4u w; w.x = pk2(q[0], q[1]); w.y = pk2(q[2], q[3]); w.z = pk2(q[4], q[5]); w.w = pk2(q[6], q[7]);
          *(GAS v4u*)(o + c * 512 + lane * 8) = w;
        }
      }
#pragma unroll
      for (int c = 0; c < 2; ++c)
#pragma unroll
        for (int i = 0; i < 8; ++i) prev[c][i] = v[c][i];
    }
  }
}

constexpr int RP = 72;
constexpr int RB = 64 * RP * 2;

__device__ __forceinline__ f32x4 mm16(f32x4 acc, const LAS bf16_t* A, int arow0, const LAS bf16_t* Bt, int brow0, int lane) {
  const int r = lane & 15, q = lane >> 4;
#pragma unroll
  for (int ks = 0; ks < 2; ++ks) {
    const bf16x8 a = *(const LAS bf16x8*)(A + (arow0 + r) * RP + ks * 32 + q * 8);
    const bf16x8 b = *(const LAS bf16x8*)(Bt + (brow0 + r) * RP + ks * 32 + q * 8);
    acc = __builtin_amdgcn_mfma_f32_16x16x32_bf16(a, b, acc, 0, 0, 0);
  }
  return acc;
}
__device__ __forceinline__ float sum8(float v) {
  v += __shfl_xor(v, 1, 64); v += __shfl_xor(v, 2, 64); v += __shfl_xor(v, 4, 64); return v;
}
__device__ __forceinline__ void ld8bf(const bf16_t* p, float (&o)[8]) {
  const v4u w = *(const GAS v4u*)p;
  o[0] = __uint_as_float(w.x << 16); o[1] = __uint_as_float(w.x & 0xffff0000u); o[2] = __uint_as_float(w.y << 16); o[3] = __uint_as_float(w.y & 0xffff0000u);
  o[4] = __uint_as_float(w.z << 16); o[5] = __uint_as_float(w.z & 0xffff0000u); o[6] = __uint_as_float(w.w << 16); o[7] = __uint_as_float(w.w & 0xffff0000u);
}
__device__ __forceinline__ v4u pk8(const float (&o)[8]) { v4u w; w.x = pk2(o[0], o[1]); w.y = pk2(o[2], o[3]); w.z = pk2(o[4], o[5]); w.w = pk2(o[6], o[7]); return w; }

#define R1_BAR() do { asm volatile("s_waitcnt lgkmcnt(0)" ::: "memory"); __builtin_amdgcn_s_barrier(); asm volatile("" ::: "memory"); } while (0)
__device__ __forceinline__ void stT(LAS bf16_t* Dst, int x0, int y0, const f32x4& acc, int lane) {
  v2u w; w.x = pk2(acc[0], acc[1]); w.y = pk2(acc[2], acc[3]);
  *(LAS v2u*)(Dst + (x0 + (lane & 15)) * RP + y0 + (lane >> 4) * 4) = w;
}
struct R1In { v4u r, ld, k, v, a; f32x4 kk0, kk1, ka0, ka1, rk0, rk1; };
__device__ __forceinline__ R1In rwkv_r1_load(PREF p, int item, int tid) {
  const int hd = item & 15, c = (item >> 4) & 63, b = item >> 10, ch = b * 16 + hd;
  const size_t off = ((size_t)(b * SEQ + c * 64 + (tid >> 3)) * DM + hd * 64 + (tid & 7) * 8);
  const bf16_t* s0 = (const bf16_t*)(p.ws + WS_S0);
  R1In in;
  in.r = *(const GAS v4u*)(s0 + 3 * (SLOT / 2) + off); in.ld = *(const GAS v4u*)(s0 + off); in.k = *(const GAS v4u*)(s0 + 4 * (SLOT / 2) + off);
  in.v = *(const GAS v4u*)(s0 + 5 * (SLOT / 2) + off); in.a = *(const GAS v4u*)(s0 + (SLOT / 2) + off);
  const int cc0 = hd * 64 + (tid & 7) * 8;
  in.kk0 = *(const GAS f32x4*)(p.k_k + cc0); in.kk1 = *(const GAS f32x4*)(p.k_k + cc0 + 4); in.ka0 = *(const GAS f32x4*)(p.k_a + cc0); in.ka1 = *(const GAS f32x4*)(p.k_a + cc0 + 4);
  in.rk0 = *(const GAS f32x4*)(p.r_k + cc0); in.rk1 = *(const GAS f32x4*)(p.r_k + cc0 + 4);
  return in;
}
__device__ __forceinline__ void un8(const v4u w, float (&o)[8]) {
  o[0] = __uint_as_float(w.x << 16); o[1] = __uint_as_float(w.x & 0xffff0000u); o[2] = __uint_as_float(w.y << 16); o[3] = __uint_as_float(w.y & 0xffff0000u);
  o[4] = __uint_as_float(w.z << 16); o[5] = __uint_as_float(w.z & 0xffff0000u); o[6] = __uint_as_float(w.w << 16); o[7] = __uint_as_float(w.w & 0xffff0000u);
}
__device__ __forceinline__ void rwkv_r1_item(PREF p, Frame& F, int item, const R1In& in) {
  const int tid = F.tid, lane = fresh_lane(), w = F.wave;
  const int hd = item & 15, c = (item >> 4) & 63, b = item >> 10, ch = b * 16 + hd;
  const size_t tile0 = ((size_t)(b * SEQ + c * 64) * DM + hd * 64);
  unsigned char* ws = p.ws;
  bf16_t* SL[6];
#pragma unroll
  for (int s = 0; s < 6; ++s) SL[s] = (bf16_t*)(ws + WS_S0 + (size_t)s * SLOT) + tile0;
  const lbf BtT = (lbf)(F.lds + 0 * RB), KtT = (lbf)(F.lds + 1 * RB), AbT = (lbf)(F.lds + 2 * RB), RbT = (lbf)(F.lds + 3 * RB);
  const lbf Ab = (lbf)(F.lds + 4 * RB), Vc = (lbf)(F.lds + 5 * RB), Bh = (lbf)(F.lds + 6 * RB), Kh = (lbf)(F.lds + 7 * RB);
  const lbf Tk = (lbf)(F.lds + 8 * RB), WbT = (lbf)(F.lds + 9 * RB), WkT = (lbf)(F.lds + 10 * RB);
  const lbf X = BtT, XT = KtT, Pb = AbT;
  const lbf At = X, TNT = XT, U0 = Tk;
  LAS float* Lf = (LAS float*)(F.lds + 11 * RB);
  LAS float* SEG = Lf + 64 * 65;
  LAS float* GC = (LAS float*)(F.lds + 14 * RB);
#if defined(PROBE_PH) && PROBE_PH == 301
  const unsigned long long _sa0 = __builtin_amdgcn_s_memrealtime();
#endif
  const int t = tid >> 3, cg = tid & 7, k0 = cg * 8;
  float r_[8], ld_[8], kx[8], v_[8], a_[8];
  un8(in.r, r_); un8(in.ld, ld_); un8(in.k, kx); un8(in.v, v_); un8(in.a, a_);
  float kk[8], km[8], be[8];
  {
    float ss = 0.f, bo = 0.f;
#pragma unroll
    for (int i = 0; i < 8; ++i) { const float ckk = (i < 4) ? in.kk0[i & 3] : in.kk1[i & 3], cka = (i < 4) ? in.ka0[i & 3] : in.ka1[i & 3], crk = (i < 4) ? in.rk0[i & 3] : in.rk1[i & 3];
      kk[i] = kx[i] * ckk; ss += kk[i] * kk[i]; km[i] = kx[i] * (1.f + (a_[i] - 1.f) * cka); bo += r_[i] * km[i] * crk; }
    ss = sum8(ss); bo = sum8(bo);
    const float inv = 1.f / fmaxf(sqrtf(ss), 1e-12f);
#pragma unroll
    for (int i = 0; i < 8; ++i) { kk[i] *= inv; be[i] = kk[i] * a_[i]; }
    if (cg == 0) ((float*)(ws + WS_TMP))[(size_t)item * 64 + t] = bo;
  }
#pragma unroll
  for (int i = 0; i < 8; ++i) Lf[t * 65 + k0 + i] = ld_[i];
  R1_BAR();
  {
    const int k = tid & 63, sg = tid >> 6;
    float run = 0.f;
#pragma unroll
    for (int i = 0; i < 8; ++i) { run += Lf[(sg * 8 + i) * 65 + k]; Lf[(sg * 8 + i) * 65 + k] = run; }
    SEG[sg * 64 + k] = run;
    R1_BAR();
    float off = 0.f;
    for (int j = 0; j < sg; ++j) off += SEG[j * 64 + k];
#pragma unroll
    for (int i = 0; i < 8; ++i) Lf[(sg * 8 + i) * 65 + k] += off;
  }
  R1_BAR();
  {
    float ab[8], bt[8], kt[8], rb[8], bh[8], kh[8];
#pragma unroll
    for (int i = 0; i < 8; ++i) {
      const float Lt = Lf[t * 65 + k0 + i], Lp = (t > 0) ? Lf[(t - 1) * 65 + k0 + i] : 0.f, LC = Lf[63 * 65 + k0 + i];
      const float et = __expf(Lt), ei = __builtin_amdgcn_rcpf(et), eh = __expf(LC) * ei;
      if (t == 63) GC[k0 + i] = et;
      ab[i] = -kk[i] * __expf(Lp); bt[i] = be[i] * ei; kt[i] = km[i] * ei; rb[i] = r_[i] * et; bh[i] = be[i] * eh; kh[i] = km[i] * eh;
    }
    *(LAS v4u*)(BtT + t * RP + k0) = pk8(bt); *(LAS v4u*)(KtT + t * RP + k0) = pk8(kt); *(LAS v4u*)(AbT + t * RP + k0) = pk8(ab); *(LAS v4u*)(RbT + t * RP + k0) = pk8(rb);
    {
      float ra[8], rv[8], rb[8], rkh[8];
#pragma unroll
      for (int i = 0; i < 8; ++i) { ra[i] = ab[i]; rv[i] = v_[i]; rb[i] = bh[i]; rkh[i] = kh[i]; }
#pragma unroll
      for (int sh = 1; sh < 8; sh <<= 1) {
        const bool on = (cg & sh) != 0;
        float ta[8], tv[8], tb[8], tk[8];
#pragma unroll
        for (int i = 0; i < 8; ++i) { ta[i] = on ? ra[(i + sh) & 7] : ra[i]; tv[i] = on ? rv[(i + sh) & 7] : rv[i]; tb[i] = on ? rb[(i + sh) & 7] : rb[i]; tk[i] = on ? rkh[(i + sh) & 7] : rkh[i]; }
#pragma unroll
        for (int i = 0; i < 8; ++i) { ra[i] = ta[i]; rv[i] = tv[i]; rb[i] = tb[i]; rkh[i] = tk[i]; }
      }
#pragma unroll
      for (int i = 0; i < 8; ++i) { const int row = k0 + ((i + cg) & 7);
        Ab[row * RP + t] = (bf16_t)f2bf(ra[i]); Vc[row * RP + t] = (bf16_t)f2bf(rv[i]); Bh[row * RP + t] = (bf16_t)f2bf(rb[i]); Kh[row * RP + t] = (bf16_t)f2bf(rkh[i]); }
    }
  }
  R1_BAR();
#if defined(PROBE_PH) && PROBE_PH == 301
  F.pr_t1 += __builtin_amdgcn_s_memrealtime() - _sa0;
#endif
  const int ya = (w >> 1) * 16, xb0 = (w & 1) * 32;
  const int cr = lane & 15, q4 = (lane >> 4) * 4;
  const f32x4 Z4 = {0.f, 0.f, 0.f, 0.f};
  const lbf X1 = (lbf)(F.lds + 11 * RB), XT1 = (lbf)(F.lds + 12 * RB), Pb1 = (lbf)(F.lds + 13 * RB);
  f32x4 accP[2];
  {
    f32x4 tabn[2], tabs[2], taks[2], wbr[2], wkr[2];
#pragma unroll
    for (int j = 0; j < 2; ++j) { const int xb = xb0 + 16 * j;
      tabn[j] = mm16(Z4, BtT, ya, AbT, xb, lane);
      tabs[j] = mm16(Z4, AbT, ya, BtT, xb, lane);
      taks[j] = mm16(Z4, AbT, ya, KtT, xb, lane);
      wbr[j] = mm16(Z4, BtT, ya, RbT, xb, lane);
      wkr[j] = mm16(Z4, KtT, ya, RbT, xb, lane); }
#pragma unroll
    for (int j = 0; j < 2; ++j) { const int xb = xb0 + 16 * j;
      f32x4 xt, xr, pr, tk, wb, wk;
#pragma unroll
      for (int i = 0; i < 4; ++i) {
        { const int s = ya + q4 + i, tt = xb + cr; xt[i] = (s < tt) ? tabn[j][i] : 0.f; wb[i] = (s <= tt) ? wbr[j][i] : 0.f; wk[i] = (s <= tt) ? wkr[j][i] : 0.f; }
        { const int tt = ya + q4 + i, s = xb + cr; xr[i] = (s < tt) ? tabs[j][i] : 0.f; pr[i] = xr[i] + ((s == tt) ? 1.f : 0.f); tk[i] = (s < tt) ? taks[j][i] : 0.f; }
      }
      accP[j] = pr;
      stT(XT1, xb, ya, xt, lane); stT(WbT, xb, ya, wb, lane); stT(WkT, xb, ya, wk, lane);
      stT(X1, xb, ya, xr, lane); stT(Pb1, xb, ya, pr, lane); stT(Tk, xb, ya, tk, lane); }
  }
  R1_BAR();
#pragma unroll 1
  for (int st = 0; st < 5; ++st) {
    const lbf Xs = (st & 1) ? X : X1, XTs = (st & 1) ? XT : XT1, Pbs = (st & 1) ? Pb : Pb1;
    const lbf Xd = (st & 1) ? X1 : X, XTd = (st & 1) ? XT1 : XT, Pbd = (st & 1) ? Pb1 : Pb;
    f32x4 xr[2], xt[2];
#pragma unroll
    for (int j = 0; j < 2; ++j) { const int xb = xb0 + 16 * j;
      xr[j] = mm16(Z4, XTs, ya, Xs, xb, lane);
      xt[j] = mm16(Z4, Xs, ya, XTs, xb, lane);
      if (st > 0) accP[j] = mm16(accP[j], XTs, ya, Pbs, xb, lane); }
#pragma unroll
    for (int j = 0; j < 2; ++j) { const int xb = xb0 + 16 * j; stT(Xd, xb, ya, xr[j], lane); stT(XTd, xb, ya, xt[j], lane); stT(Pbd, xb, ya, accP[j], lane); }
    R1_BAR();
  }
  const lbf NT = Pb1;
  {
    f32x4 nt[2];
#pragma unroll
    for (int j = 0; j < 2; ++j) { const int xb = xb0 + 16 * j; nt[j] = mm16(Z4, Pb, ya, XT, xb, lane);
#pragma unroll
      for (int i = 0; i < 4; ++i) nt[j][i] += bf2f(Pb[(ya + q4 + i) * RP + xb + cr]); }
#pragma unroll
    for (int j = 0; j < 2; ++j) stT(NT, xb0 + 16 * j, ya, nt[j], lane);
    R1_BAR();
  }
  {
    f32x4 at[2], tn[2];
#pragma unroll
    for (int j = 0; j < 2; ++j) { const int xb = xb0 + 16 * j; at[j] = mm16(Z4, NT, ya, Ab, xb, lane); tn[j] = mm16(Z4, Tk, ya, NT, xb, lane); }
#pragma unroll
    for (int j = 0; j < 2; ++j) { const int xb = xb0 + 16 * j; stT(At, xb, ya, at[j], lane); stT(TNT, xb, ya, tn[j], lane); }
  }
  R1_BAR();
  const lbf O_RT = (lbf)(F.lds + 11 * RB), O_PM = (lbf)(F.lds + 12 * RB), O_Y0 = (lbf)(F.lds + 13 * RB), O_Q = (lbf)(F.lds + 3 * RB)  ;
  {
    f32x4 u0[2], rt[2], pm[2];
#pragma unroll
    for (int j = 0; j < 2; ++j) { const int xb = xb0 + 16 * j;
      u0[j] = mm16(Z4, TNT, ya, Vc, xb, lane);
      rt[j] = mm16(Z4, At, ya, WbT, xb, lane);
      pm[j] = mm16(Z4, At, ya, Bh, xb, lane);
      const v2u rbw = *(const LAS v2u*)(RbT + (xb + cr) * RP + ya + q4);
      rt[j][0] += __uint_as_float(rbw.x << 16); rt[j][1] += __uint_as_float(rbw.x & 0xffff0000u); rt[j][2] += __uint_as_float(rbw.y << 16); rt[j][3] += __uint_as_float(rbw.y & 0xffff0000u);
#pragma unroll
      for (int i = 0; i < 4; ++i) if (ya + q4 + i == xb + cr) pm[j][i] += GC[xb + cr]; }
#pragma unroll
    for (int j = 0; j < 2; ++j) { const int xb = xb0 + 16 * j; stT(U0, xb, ya, u0[j], lane); stT(O_RT, xb, ya, rt[j], lane); stT(O_PM, xb, ya, pm[j], lane); }
  }
  R1_BAR();
  {
    f32x4 y0[2], qq[2];
#pragma unroll
    for (int j = 0; j < 2; ++j) { const int xb = xb0 + 16 * j;
      y0[j] = mm16(mm16(Z4, U0, ya, WbT, xb, lane), Vc, ya, WkT, xb, lane);
      qq[j] = mm16(mm16(Z4, Bh, ya, U0, xb, lane), Kh, ya, Vc, xb, lane); }
#pragma unroll
    for (int j = 0; j < 2; ++j) { const int xb = xb0 + 16 * j; stT(O_Y0, xb, ya, y0[j], lane); stT(O_Q, xb, ya, qq[j], lane); }
  }
  R1_BAR();
  {
    const int row = tid >> 3, pc = (tid & 7) * 8;
    *(GAS v4u*)(SL[3] + (size_t)row * DM + pc) = *(const LAS v4u*)(O_RT + row * RP + pc);
    *(GAS v4u*)(SL[0] + (size_t)row * DM + pc) = *(const LAS v4u*)(O_PM + row * RP + pc);
    *(GAS v4u*)(SL[4] + (size_t)row * DM + pc) = *(const LAS v4u*)(O_Y0 + row * RP + pc);
    *(GAS v4u*)(SL[1] + (size_t)row * DM + pc) = *(const LAS v4u*)(O_Q + row * RP + pc);
  }
  R1_BAR();
}

__device__ __forceinline__ void phase_rwkv_r1(PREF p, Frame& F) {
  int item = F.vcu;
  if (item >= 4096) return;
  R1In nxt = rwkv_r1_load(p, item, F.tid);
  for (; item < 4096; item += F.G) {
    const R1In cur = nxt;
    if (item + F.G < 4096) nxt = rwkv_r1_load(p, item + F.G, F.tid);
    rwkv_r1_item(p, F, item, cur);
  }
}

__device__ __forceinline__ void phase_rwkv_r2(PREF p, Frame& F) {
  if (F.wave != 0) return;
  const int lane = fresh_lane();
  const lbf Sh = (lbf)(F.lds), Sl = (lbf)(F.lds + 16 * RP * 2);
  const int cr = lane & 15, g = lane >> 4;
  for (int task = F.vcu; task < 256; task += F.G) {
    const int ch = task >> 2, jb = task & 3, b = ch >> 4, hd = ch & 15;
    const bf16_t* PM = (const bf16_t*)(p.ws + WS_S0) + ((size_t)(b * SEQ) * DM + hd * 64);
    bf16_t* QS = (bf16_t*)(p.ws + WS_S0 + SLOT) + ((size_t)(b * SEQ) * DM + hd * 64);
    for (int i = lane; i < 16 * RP; i += 64) { Sh[i] = 0; Sl[i] = 0; }
    const bf16_t* pmp = PM + (size_t)cr * DM + g * 8;
    bf16_t* qsp = QS + (size_t)(16 * jb + cr) * DM + g * 4;
    bf16x8 pa[4][4][2]; v2u qv[4][4];
#pragma unroll
    for (int d = 0; d < 4; ++d)
#pragma unroll
      for (int ct = 0; ct < 4; ++ct) { pa[d][ct][0] = *(const GAS bf16x8*)(pmp + (size_t)(d * 64 + 16 * ct) * DM); pa[d][ct][1] = *(const GAS bf16x8*)(pmp + (size_t)(d * 64 + 16 * ct) * DM + 32);
        qv[d][ct] = *(const GAS v2u*)(qsp + (size_t)d * 64 * DM + 16 * ct); }
    asm volatile("s_waitcnt lgkmcnt(0)" ::: "memory");
#pragma unroll 1
    for (int c4 = 0; c4 < 64; c4 += 4) {
#pragma unroll
      for (int d = 0; d < 4; ++d) {
        const int c = c4 + d;
        const bf16x8 bh0 = *(const LAS bf16x8*)(Sh + cr * RP + g * 8), bh1 = *(const LAS bf16x8*)(Sh + cr * RP + 32 + g * 8);
        const bf16x8 bl0 = *(const LAS bf16x8*)(Sl + cr * RP + g * 8), bl1 = *(const LAS bf16x8*)(Sl + cr * RP + 32 + g * 8);
        f32x4 acc[4];
#pragma unroll
        for (int ct = 0; ct < 4; ++ct) {
          acc[ct] = (f32x4){__uint_as_float(qv[d][ct].x << 16), __uint_as_float(qv[d][ct].x & 0xffff0000u), __uint_as_float(qv[d][ct].y << 16), __uint_as_float(qv[d][ct].y & 0xffff0000u)};
          acc[ct] = __builtin_amdgcn_mfma_f32_16x16x32_bf16(pa[d][ct][0], bh0, acc[ct], 0, 0, 0);
          acc[ct] = __builtin_amdgcn_mfma_f32_16x16x32_bf16(pa[d][ct][1], bh1, acc[ct], 0, 0, 0);
          acc[ct] = __builtin_amdgcn_mfma_f32_16x16x32_bf16(pa[d][ct][0], bl0, acc[ct], 0, 0, 0);
          acc[ct] = __builtin_amdgcn_mfma_f32_16x16x32_bf16(pa[d][ct][1], bl1, acc[ct], 0, 0, 0);
        }
        if (c + 4 < 64) {
#pragma unroll
          for (int ct = 0; ct < 4; ++ct) { pa[d][ct][0] = *(const GAS bf16x8*)(pmp + (size_t)((c + 4) * 64 + 16 * ct) * DM); pa[d][ct][1] = *(const GAS bf16x8*)(pmp + (size_t)((c + 4) * 64 + 16 * ct) * DM + 32);
            qv[d][ct] = *(const GAS v2u*)(qsp + (size_t)(c + 4) * 64 * DM + 16 * ct); }
        }
#pragma unroll
        for (int ct = 0; ct < 4; ++ct) {
          v2u hi; hi.x = pk2(acc[ct][0], acc[ct][1]); hi.y = pk2(acc[ct][2], acc[ct][3]);
          const float l0 = acc[ct][0] - __uint_as_float(hi.x << 16), l1 = acc[ct][1] - __uint_as_float(hi.x & 0xffff0000u), l2 = acc[ct][2] - __uint_as_float(hi.y << 16), l3 = acc[ct][3] - __uint_as_float(hi.y & 0xffff0000u);
          v2u lo; lo.x = pk2(l0, l1); lo.y = pk2(l2, l3);
          *(LAS v2u*)(Sh + cr * RP + 16 * ct + g * 4) = hi; *(LAS v2u*)(Sl + cr * RP + 16 * ct + g * 4) = lo;
          *(GAS v2u*)(qsp + (size_t)c * 64 * DM + 16 * ct) = hi;
        }
        asm volatile("s_waitcnt lgkmcnt(0)" ::: "memory");
      }
    }
  }
}

__device__ __forceinline__ void phase_rwkv_r3(PREF p, Frame& F) {
  const int lane = fresh_lane(), w = F.wave;
  const int cr = lane & 15, q4 = (lane >> 4) * 4, q = lane >> 4;
  const int half = w >> 2, tb = w & 3;
  LAS bf16_t* stg = (LAS bf16_t*)(F.lds) + w * 16 * RP;
  for (int it2 = F.vcu; it2 < 2048; it2 += F.G) {
    const int item = it2 * 2 + half;
    const int hd = item & 15, c = (item >> 4) & 63, b = item >> 10, ch = b * 16 + hd;
    const size_t tile0 = ((size_t)(b * SEQ + c * 64) * DM + hd * 64);
    bf16_t* RT = (bf16_t*)(p.ws + WS_S0 + 3 * SLOT) + tile0;
    const bf16_t* Y0 = (const bf16_t*)(p.ws + WS_S0 + 4 * SLOT) + tile0;
    const bf16_t* VV = (const bf16_t*)(p.ws + WS_S0 + 5 * SLOT) + tile0;
    const bf16_t* GG = (const bf16_t*)(p.ws + WS_S0 + 2 * SLOT) + tile0;
    const bf16_t* SC = (const bf16_t*)(p.ws + WS_S0 + SLOT) + tile0 - (size_t)64 * DM;
    const float* BO = (const float*)(p.ws + WS_TMP) + (size_t)item * 64;
    f32x4 y[4];
#pragma unroll
    for (int j = 0; j < 4; ++j) y[j] = (f32x4){0.f, 0.f, 0.f, 0.f};
    if (c > 0) {
      const bf16_t* ap = RT + (size_t)(16 * tb + cr) * DM + q * 8;
      const bf16x8 a0 = *(const GAS bf16x8*)ap, a1 = *(const GAS bf16x8*)(ap + 32);
#pragma unroll
      for (int j = 0; j < 4; ++j) {
        const bf16_t* bp = SC + (size_t)(16 * j + cr) * DM + q * 8;
        const bf16x8 b0 = *(const GAS bf16x8*)bp, b1 = *(const GAS bf16x8*)(bp + 32);
        y[j] = __builtin_amdgcn_mfma_f32_16x16x32_bf16(a0, b0, y[j], 0, 0, 0);
        y[j] = __builtin_amdgcn_mfma_f32_16x16x32_bf16(a1, b1, y[j], 0, 0, 0);
      }
    }
    float mu[4], rs[4];
#pragma unroll
    for (int i = 0; i < 4; ++i) {
      float s = 0.f;
#pragma unroll
      for (int j = 0; j < 4; ++j) { y[j][i] += bf2f(Y0[(size_t)(16 * tb + q4 + i) * DM + 16 * j + cr]); s += y[j][i]; }
      s += __shfl_xor(s, 1, 64); s += __shfl_xor(s, 2, 64); s += __shfl_xor(s, 4, 64); s += __shfl_xor(s, 8, 64);
      mu[i] = s * (1.f / 64.f);
      float qd = 0.f;
#pragma unroll
      for (int j = 0; j < 4; ++j) { const float d = y[j][i] - mu[i]; qd += d * d; }
      qd += __shfl_xor(qd, 1, 64); qd += __shfl_xor(qd, 2, 64); qd += __shfl_xor(qd, 4, 64); qd += __shfl_xor(qd, 8, 64);
      rs[i] = rsqrtf(qd * (1.f / 64.f) + 64e-5f);
    }
#pragma unroll
    for (int j = 0; j < 4; ++j) {
      const int cc = hd * 64 + 16 * j + cr;
      const float lw = p.ln_w[cc], lb = p.ln_b[cc];
#pragma unroll
      for (int i = 0; i < 4; ++i) {
        const int tt = 16 * tb + q4 + i;
        const float vv = bf2f(VV[(size_t)tt * DM + 16 * j + cr]), gg = bf2f(GG[(size_t)tt * DM + 16 * j + cr]);
        const float z = ((y[j][i] - mu[i]) * rs[i] * lw + lb + BO[tt] * vv) * gg;
        stg[(q4 + i) * RP + 16 * j + cr] = (bf16_t)f2bf(z);
      }
    }
    LDS_WAIT();
#pragma unroll
    for (int i = 0; i < 2; ++i) { const int row = (lane >> 3) + 8 * i, pc = (lane & 7) * 8;
      *(GAS v4u*)(RT + (size_t)(16 * tb + row) * DM + pc) = *(const LAS v4u*)(stg + row * RP + pc); }
    LDS_WAIT();
  }
}


typedef short v4i16_t __attribute__((ext_vector_type(4)));
__device__ __forceinline__ v4i16_t tr16(const LAS bf16_t* p) { return __builtin_amdgcn_ds_read_tr16_b64_v4i16((LAS v4i16_t*)p); }

template <int KS>
__device__ __forceinline__ void qk_tile(f32x4 (&st)[4][2], const LAS bf16_t* Kt, int kc0, const bf16x8 (&qf)[2][KS], int lane) {
  const int r = lane & 15, g = lane >> 4;
#pragma unroll
  for (int kt = 0; kt < 4; ++kt)
#pragma unroll
    for (int ks = 0; ks < KS; ++ks) {
      const bf16x8 a = *(const LAS bf16x8*)(Kt + (kt * 16 + r) * RP + kc0 + ks * 32 + g * 8);
#pragma unroll
      for (int qt = 0; qt < 2; ++qt) st[kt][qt] = __builtin_amdgcn_mfma_f32_16x16x32_bf16(a, qf[qt][ks], st[kt][qt], 0, 0, 0);
    }
}
__device__ __forceinline__ void pack_p(bf16x8 (&pb)[2][2], const f32x4 (&pr)[4][2]) {
#pragma unroll
  for (int kb = 0; kb < 2; ++kb)
#pragma unroll
    for (int qt = 0; qt < 2; ++qt) {
      const v4u w = {pk2(pr[2 * kb][qt][0], pr[2 * kb][qt][1]), pk2(pr[2 * kb][qt][2], pr[2 * kb][qt][3]), pk2(pr[2 * kb + 1][qt][0], pr[2 * kb + 1][qt][1]), pk2(pr[2 * kb + 1][qt][2], pr[2 * kb + 1][qt][3])};
      pb[kb][qt] = __builtin_bit_cast(bf16x8, w);
    }
}
__device__ __forceinline__ void pv_apply(f32x4 (&o)[4][2], f32x4 (&osum)[2], const bf16x8 (&pb)[2][2], const LAS bf16_t* Vt, int lane) {
  const int g = lane >> 4, qq = (lane & 15) >> 2, pp = lane & 3;
  const bf16x8 ones = {0x3F80, 0x3F80, 0x3F80, 0x3F80, 0x3F80, 0x3F80, 0x3F80, 0x3F80};
#pragma unroll
  for (int kb = 0; kb < 2; ++kb)
#pragma unroll
    for (int qt = 0; qt < 2; ++qt) osum[qt] = __builtin_amdgcn_mfma_f32_16x16x32_bf16(ones, pb[kb][qt], osum[qt], 0, 0, 0);
#pragma unroll
  for (int dt = 0; dt < 4; ++dt)
#pragma unroll
    for (int kb = 0; kb < 2; ++kb) {
      const v4i16_t lo = tr16(Vt + (32 * kb + 4 * g + qq) * RP + dt * 16 + 4 * pp);
      const v4i16_t hi = tr16(Vt + (32 * kb + 16 + 4 * g + qq) * RP + dt * 16 + 4 * pp);
      const bf16x8 a = {lo[0], lo[1], lo[2], lo[3], hi[0], hi[1], hi[2], hi[3]};
#pragma unroll
      for (int qt = 0; qt < 2; ++qt) o[dt][qt] = __builtin_amdgcn_mfma_f32_16x16x32_bf16(a, pb[kb][qt], o[dt][qt], 0, 0, 0);
    }
}
__device__ __forceinline__ void pv_apply2(f32x4 (&o1)[4][2], f32x4 (&o2)[4][2], f32x4 (&os1)[2], f32x4 (&os2)[2], const bf16x8 (&pb1)[2][2], const bf16x8 (&pb2)[2][2], const LAS bf16_t* Vt, int lane) {
  const int g = lane >> 4, qq = (lane & 15) >> 2, pp = lane & 3;
  const bf16x8 ones = {0x3F80, 0x3F80, 0x3F80, 0x3F80, 0x3F80, 0x3F80, 0x3F80, 0x3F80};
#pragma unroll
  for (int kb = 0; kb < 2; ++kb)
#pragma unroll
    for (int qt = 0; qt < 2; ++qt) { os1[qt] = __builtin_amdgcn_mfma_f32_16x16x32_bf16(ones, pb1[kb][qt], os1[qt], 0, 0, 0); os2[qt] = __builtin_amdgcn_mfma_f32_16x16x32_bf16(ones, pb2[kb][qt], os2[qt], 0, 0, 0); }
#pragma unroll
  for (int dt = 0; dt < 4; ++dt)
#pragma unroll
    for (int kb = 0; kb < 2; ++kb) {
      const v4i16_t lo = tr16(Vt + (32 * kb + 4 * g + qq) * RP + dt * 16 + 4 * pp);
      const v4i16_t hi = tr16(Vt + (32 * kb + 16 + 4 * g + qq) * RP + dt * 16 + 4 * pp);
      const bf16x8 a = {lo[0], lo[1], lo[2], lo[3], hi[0], hi[1], hi[2], hi[3]};
#pragma unroll
      for (int qt = 0; qt < 2; ++qt) { o1[dt][qt] = __builtin_amdgcn_mfma_f32_16x16x32_bf16(a, pb1[kb][qt], o1[dt][qt], 0, 0, 0); o2[dt][qt] = __builtin_amdgcn_mfma_f32_16x16x32_bf16(a, pb2[kb][qt], o2[dt][qt], 0, 0, 0); }
    }
}
__device__ __forceinline__ void fill42(f32x4 (&a)[4][2], const f32x4 v) {
#pragma unroll
  for (int i = 0; i < 4; ++i)
#pragma unroll
    for (int j = 0; j < 2; ++j) a[i][j] = v;
}
__device__ __forceinline__ void exp42(f32x4 (&a)[4][2]) {
#pragma unroll
  for (int i = 0; i < 4; ++i)
#pragma unroll
    for (int j = 0; j < 2; ++j)
#pragma unroll
      for (int e = 0; e < 4; ++e) a[i][j][e] = __builtin_amdgcn_exp2f(a[i][j][e]);
}
#if defined(PROBE_PH)
#define SECT_B(id) unsigned long long _s##id = 0; if (PROBE_PH == id) _s##id = __builtin_amdgcn_s_memrealtime()
#define SECT_E(id) do { if (PROBE_PH == id) F.pr_t1 += __builtin_amdgcn_s_memrealtime() - _s##id; } while (0)
#else
#define SECT_B(id)
#define SECT_E(id) do {} while (0)
#endif
#if defined(PROBE_PH) && PROBE_PH == 300
#define AT_BAR() do { const unsigned long long _b0 = __builtin_amdgcn_s_memrealtime(); asm volatile("s_waitcnt lgkmcnt(0)" ::: "memory"); __builtin_amdgcn_s_barrier(); asm volatile("" ::: "memory"); F.pr_t1 += __builtin_amdgcn_s_memrealtime() - _b0; } while (0)
#else
#define AT_BAR() do { asm volatile("s_waitcnt lgkmcnt(0)" ::: "memory"); __builtin_amdgcn_s_barrier(); asm volatile("" ::: "memory"); } while (0)
#endif
__device__ __forceinline__ void zero42(f32x4 (&a)[4][2]) {
#pragma unroll
  for (int i = 0; i < 4; ++i)
#pragma unroll
    for (int j = 0; j < 2; ++j) a[i][j] = (f32x4){0.f, 0.f, 0.f, 0.f};
}

__device__ __forceinline__ void phase_compress(PREF p, Frame& F) {
  const int lane = fresh_lane(), w = F.wave, tid = F.tid;
  const int r = lane & 15, g4 = lane >> 4;
  const bf16_t* H = (const bf16_t*)(p.ws + WS_H);
  const bf16_t* W1T = (const bf16_t*)(p.ws + WS_CW1);
  LAS float* part = (LAS float*)F.lds;
  LAS float* hid = part + 8 * 16 * 64;
  LAS float* outv = hid + 16 * 64;
  for (int task = F.vcu; task < 256; task += F.G) {
    const int kv = task >> 7, rb = task & 127;
    int row = rb * 16 + r; if (row > 2039) row = 2039;
    const int gg = row & 1, cc = (row >> 1) % NCMP, bb = (row >> 1) / NCMP;
    const int colbase = OFF_NKV + ((0 * 2 + kv) * 2 + gg) * 64;
    f32x4 acc[4];
#pragma unroll
    for (int nt = 0; nt < 4; ++nt) acc[nt] = (f32x4){0.f, 0.f, 0.f, 0.f};
#pragma unroll 1
    for (int ks = 0; ks < 8; ++ks) {
      const int k = w * 256 + ks * 32 + g4 * 8, l = k >> 6, d0 = k & 63;
      float hv[8]; ld8bf(H + (size_t)(bb * SEQ + 16 * cc + l) * HC + colbase + d0, hv);
      const float* pe = p.cmp_pe + (kv * 32 + l) * 64 + d0;
#pragma unroll
      for (int i = 0; i < 8; ++i) hv[i] += pe[i];
      const bf16x8 a = __builtin_bit_cast(bf16x8, pk8(hv));
#pragma unroll
      for (int nt = 0; nt < 4; ++nt) {
        const bf16x8 bfr = *(const GAS bf16x8*)(W1T + ((size_t)kv * 64 + nt * 16 + r) * 2048 + k);
        acc[nt] = __builtin_amdgcn_mfma_f32_16x16x32_bf16(a, bfr, acc[nt], 0, 0, 0);
      }
    }
#pragma unroll
    for (int nt = 0; nt < 4; ++nt)
#pragma unroll
      for (int i = 0; i < 4; ++i) part[(w * 16 + g4 * 4 + i) * 64 + nt * 16 + r] = acc[nt][i];
    __syncthreads();
    for (int e = tid; e < 1024; e += NWAVES * 64) { float s = 0.f;
#pragma unroll
      for (int ww = 0; ww < 8; ++ww) s += part[ww * 1024 + e];
      hid[e] = gelu_tanh(s); }
    __syncthreads();
    const float* w2 = p.cmp_w2 + kv * 4096;
    for (int e = tid; e < 1024; e += NWAVES * 64) { const int rr = e >> 6, n = e & 63; float s = 0.f;
      for (int j = 0; j < 64; ++j) s += hid[rr * 64 + j] * w2[j * 64 + n];
      outv[e] = s; }
    __syncthreads();
    for (int e = tid; e < 1024; e += NWAVES * 64) { const int rr = e >> 6, n = e & 63;
      const int orow = rb * 16 + rr;
      if (orow < 2040) {
        float v = outv[e];
        if (kv == 0) { float ss = 0.f; for (int j = 0; j < 64; ++j) ss += outv[rr * 64 + j] * outv[rr * 64 + j]; v = v * rsqrtf(ss * (1.f / 64.f) + 1e-6f) * p.nk_norm[n]; }
        const int g2 = orow & 1, c2 = (orow >> 1) % NCMP, b2 = (orow >> 1) / NCMP;
        ((bf16_t*)(p.ws + (kv ? WS_VCMPB : WS_KCMPB)))[((size_t)(b2 * 2 + g2) * 256 + c2) * 64 + n] = (bf16_t)f2bf(v);
      }
    }
    if (task < 16 && tid < 64) { const int kk2 = task >> 3, bg = task & 7; ((bf16_t*)(p.ws + (kk2 ? WS_VCMPB : WS_KCMPB)))[((size_t)bg * 256 + 255) * 64 + tid] = 0; }
    __syncthreads();
  }
}

__device__ __forceinline__ v4u tile_ld(const bf16_t* base, size_t pitch, int tid) { return *(const GAS v4u*)(base + (size_t)(tid >> 3) * pitch + (tid & 7) * 8); }
__device__ __forceinline__ void tile_st(LAS bf16_t* dst, v4u v, int tid) { *(LAS v4u*)(dst + (tid >> 3) * RP + (tid & 7) * 8) = v; }

template <int KS, int MODE>
__device__ __forceinline__ void attn_tile(f32x4 (&o)[4][2], f32x4 (&os)[2], const bf16x8 (&qf)[2][KS], const LAS bf16_t* KBt, int kc0, const LAS bf16_t* VBt, const f32x4 nbv,
                                          const bool (&on)[2], int qq0, int koff, int lane) {
  const int r = lane & 15, g = lane >> 4;
  f32x4 st[4][2]; bf16x8 pb[2][2];
  fill42(st, nbv); qk_tile<KS>(st, KBt, kc0, qf, lane); exp42(st);
  if (MODE != 0) {
#pragma unroll
    for (int kt = 0; kt < 4; ++kt)
#pragma unroll
      for (int qt = 0; qt < 2; ++qt)
#pragma unroll
        for (int i = 0; i < 4; ++i) { const int kk = kt * 16 + g * 4 + i, qq = qq0 + qt * 16 + r;
          bool keep = true;
          if (MODE & 1) keep = keep && on[qt];
          if (MODE & 2) keep = keep && (kk + koff <= qq);
          if (MODE & 4) keep = keep && (kk > qq);
          if (!keep) st[kt][qt][i] = 0.f; }
  }
  pack_p(pb, st);
  pv_apply(o, os, pb, VBt, lane);
}
__device__ __forceinline__ void phase_diffattn(PREF p, Frame& F) {
  const int lane = fresh_lane(), w = F.wave, tid = F.tid;
  const int r = lane & 15, g = lane >> 4;
  const bf16_t* H = (const bf16_t*)(p.ws + WS_H);
  bf16_t* CAT = (bf16_t*)(p.ws + WS_CAT);
  float mq = 0.f, mk = 0.f, l0 = 0.f, l1 = 0.f;
  for (int i = 0; i < 32; i++) { mq = fmaxf(mq, fabsf(p.dq_norm[i])); mk = fmaxf(mk, fabsf(p.dk_norm[i])); l0 += p.dlam[i] * p.dlam[32 + i]; l1 += p.dlam[64 + i] * p.dlam[96 + i]; }
  const float c2 = 0.17677669529663687f * 1.4426950408889634f;
  const float nb = -(32.f * mq * mk) * c2;
  const f32x4 nbv = {nb, nb, nb, nb};
  const float lam = __expf(l0) - __expf(l1) + 0.2f;
  const bool on[2] = {true, true};
  for (int pr = F.vcu; pr < 256; pr += F.G) {
    const int bh = pr >> 3, sp = pr & 7, b = bh >> 3, hd = bh & 7;
#pragma unroll 1
    for (int ui = 0; ui < 2; ++ui) {
      const int qb = ui ? 15 - sp : sp;
      const int NT = 4 * (qb + 1);
      const bf16_t* Kg = H + (size_t)(b * SEQ) * HC + OFF_DK + hd * 64;
      const bf16_t* Vg = H + (size_t)(b * SEQ) * HC + OFF_DV + hd * 64;
      f32x4 o1[4][2];
#pragma unroll 1
      for (int mp = 0; mp < 2; ++mp) {
        bf16x8 qf[2][1];
#pragma unroll
        for (int qt = 0; qt < 2; ++qt) qf[qt][0] = *(const GAS bf16x8*)(H + (size_t)(b * SEQ + qb * 256 + w * 32 + qt * 16 + r) * HC + OFF_DQ + hd * 64 + mp * 32 + g * 8);
        f32x4 o[4][2]; zero42(o);
        f32x4 os[2] = {{0.f, 0.f, 0.f, 0.f}, {0.f, 0.f, 0.f, 0.f}};
        v4u krA = tile_ld(Kg, HC, tid), vrA = tile_ld(Vg, HC, tid);
        v4u krB = tile_ld(Kg + (size_t)64 * HC, HC, tid), vrB = tile_ld(Vg + (size_t)64 * HC, HC, tid);
#pragma unroll 1
        for (int t = 0; t < NT; t += 2) {
#pragma unroll
          for (int hf = 0; hf < 2; ++hf) {
            const int tt = t + hf;
            const lbf KBt = (lbf)(F.lds + hf * 2 * RB), VBt = KBt + 64 * RP;
            tile_st(KBt, hf ? krB : krA, tid); tile_st(VBt, hf ? vrB : vrA, tid);
            AT_BAR();
            if (tt + 2 < NT) { const v4u k2 = tile_ld(Kg + (size_t)(tt + 2) * 64 * HC, HC, tid), v2 = tile_ld(Vg + (size_t)(tt + 2) * 64 * HC, HC, tid);
              if (hf) { krB = k2; vrB = v2; } else { krA = k2; vrA = v2; } }
            const int koff = tt * 64 - (qb * 256 + w * 32);
            if (tt >= NT - 4) attn_tile<1, 2>(o, os, qf, KBt, mp * 32, VBt, nbv, on, 0, koff, lane);
            else attn_tile<1, 0>(o, os, qf, KBt, mp * 32, VBt, nbv, on, 0, koff, lane);
          }
        }
        if (mp == 0) {
#pragma unroll
          for (int qt = 0; qt < 2; ++qt) { const float i1 = 1.f / os[qt][0];
#pragma unroll
            for (int dt = 0; dt < 4; ++dt) o1[dt][qt] = o[dt][qt] * i1; }
        } else {
#pragma unroll
          for (int qt = 0; qt < 2; ++qt) {
            const float i2 = lam / os[qt][0];
            float ss = 0.f;
#pragma unroll
            for (int dt = 0; dt < 4; ++dt)
#pragma unroll
              for (int i = 0; i < 4; ++i) { const float v = o1[dt][qt][i] - o[dt][qt][i] * i2; o1[dt][qt][i] = v; ss += v * v; }
            ss += __shfl_xor(ss, 16, 64); ss += __shfl_xor(ss, 32, 64);
            const float rr = rsqrtf(ss * (1.f / 64.f) + 1e-6f) * 0.8f;
            bf16_t* op = CAT + (size_t)(b * SEQ + qb * 256 + w * 32 + qt * 16 + r) * DM + hd * 64;
#pragma unroll
            for (int dt = 0; dt < 4; ++dt) { const int d0 = dt * 16 + g * 4; const f32x4 sg = *(const f32x4*)(p.dsubln + d0);
              v2u wv; wv.x = pk2(o1[dt][qt][0] * rr * sg[0], o1[dt][qt][1] * rr * sg[1]); wv.y = pk2(o1[dt][qt][2] * rr * sg[2], o1[dt][qt][3] * rr * sg[3]);
              *(GAS v2u*)(op + d0) = wv; }
          }
        }
        AT_BAR();
      }
    }
  }
}

__device__ __forceinline__ void nsa_finish(f32x4 (&comb)[4][2], const f32x4 (&o)[4][2], const f32x4 (&os)[2], const float (&gate)[2], bool normalised) {
#pragma unroll
  for (int qt = 0; qt < 2; ++qt) {
    const float f = normalised ? gate[qt] : gate[qt] / os[qt][0];
#pragma unroll
    for (int dt = 0; dt < 4; ++dt) comb[dt][qt] += o[dt][qt] * f;
  }
}
__device__ __forceinline__ void phase_nsa(PREF p, Frame& F) {
  const int lane = fresh_lane(), w = F.wave, tid = F.tid;
  const int r = lane & 15, g = lane >> 4;
  const bf16_t* H = (const bf16_t*)(p.ws + WS_H);
  const float* GATES = (const float*)(p.ws + WS_GATES);
  bf16_t* CAT = (bf16_t*)(p.ws + WS_CAT);
  float mq = 0.f, mk0 = 0.f, mk1 = 0.f, mk2 = 0.f;
  for (int i = 0; i < 64; i++) { mq = fmaxf(mq, fabsf(p.nq_norm[i])); mk0 = fmaxf(mk0, fabsf(p.nk_norm[i])); mk1 = fmaxf(mk1, fabsf(p.nk_norm[64 + i])); mk2 = fmaxf(mk2, fabsf(p.nk_norm[128 + i])); }
  const float c2 = 0.125f * 1.4426950408889634f;
  const float nb0 = -(64.f * mq * mk0) * c2, nb1 = -(64.f * mq * mk1) * c2, nb2 = -(64.f * mq * mk2) * c2;
  constexpr int IPT = 68;
  LAS float* IMP = (LAS float*)(F.lds + 12 * RB);
  LAS unsigned char* SELB = (LAS unsigned char*)(F.lds + 12 * RB + 64 * IPT * 4);
  const int hj = w >> 1, th = w & 1;
  for (int pr = F.vcu; pr < 256; pr += F.G) {
    const int bg = pr >> 5, sp = pr & 31, b = bg >> 1, gq = bg & 1;
#pragma unroll 1
    for (int ui = 0; ui < 2; ++ui) {
      const int blk = ui ? 63 - sp : sp;
      const int hh = gq * 4 + hj;
      const int tokw = b * SEQ + blk * 64 + th * 32;
      bf16x8 qf[2][2];
      float gate0[2], gate1[2], gate2[2];
#pragma unroll
      for (int qt = 0; qt < 2; ++qt) { const bf16_t* qp = H + (size_t)(tokw + qt * 16 + r) * HC + OFF_NQ + hh * 64 + g * 8;
        qf[qt][0] = *(const GAS bf16x8*)qp; qf[qt][1] = *(const GAS bf16x8*)(qp + 32);
        const float* gp = GATES + (size_t)(tokw + qt * 16 + r) * 24 + hh * 3; gate0[qt] = gp[0]; gate1[qt] = gp[1]; gate2[qt] = gp[2]; }
      f32x4 comb[4][2]; zero42(comb);
      const int nct = (4 * blk + 3 + 63) >> 6;
      {
        const bf16_t* KC = (const bf16_t*)(p.ws + WS_KCMPB) + (size_t)(b * 2 + gq) * 256 * 64;
        const bf16_t* VC = (const bf16_t*)(p.ws + WS_VCMPB) + (size_t)(b * 2 + gq) * 256 * 64;
        for (int t4 = 0; t4 < nct; ++t4) { tile_st((lbf)(F.lds + t4 * RB), tile_ld(KC + t4 * 4096, 64, tid), tid); tile_st((lbf)(F.lds + (4 + t4) * RB), tile_ld(VC + t4 * 4096, 64, tid), tid); }
        for (int e = tid; e < 64 * IPT; e += NWAVES * 64) IMP[e] = 0.f;
        AT_BAR();
        const f32x4 nbv0 = {nb0, nb0, nb0, nb0};
        int cmax[2];
#pragma unroll
        for (int qt = 0; qt < 2; ++qt) { const int pos = blk * 64 + th * 32 + qt * 16 + r; cmax[qt] = (pos >= 31) ? ((pos - 31) >> 4) : -1; }
        float lsum[2] = {0.f, 0.f};
        for (int t4 = 0; t4 < nct; ++t4) {
          f32x4 st[4][2]; fill42(st, nbv0);
          qk_tile<2>(st, (lbf)(F.lds + t4 * RB), 0, qf, lane); exp42(st);
#pragma unroll
          for (int kt = 0; kt < 4; ++kt)
#pragma unroll
            for (int qt = 0; qt < 2; ++qt)
#pragma unroll
              for (int i = 0; i < 4; ++i) { const int c = t4 * 64 + kt * 16 + g * 4 + i; if (c <= cmax[qt]) lsum[qt] += st[kt][qt][i]; }
        }
        float linv[2];
#pragma unroll
        for (int qt = 0; qt < 2; ++qt) { float s = lsum[qt]; s += __shfl_xor(s, 16, 64); s += __shfl_xor(s, 32, 64); linv[qt] = (cmax[qt] >= 0) ? 1.f / s : 0.f; }
        f32x4 o[4][2]; zero42(o);
        f32x4 osd[2] = {{0.f, 0.f, 0.f, 0.f}, {0.f, 0.f, 0.f, 0.f}};
        float carry[2] = {0.f, 0.f};
        for (int t4 = 0; t4 < nct; ++t4) {
          f32x4 st[4][2]; fill42(st, nbv0);
          qk_tile<2>(st, (lbf)(F.lds + t4 * RB), 0, qf, lane); exp42(st);
#pragma unroll
          for (int qt = 0; qt < 2; ++qt) {
            float gs[4], rot[4];
#pragma unroll
            for (int kt = 0; kt < 4; ++kt) { float s4 = 0.f;
#pragma unroll
              for (int i = 0; i < 4; ++i) { const int c = t4 * 64 + kt * 16 + g * 4 + i;
                const float e = (c <= cmax[qt]) ? st[kt][qt][i] * linv[qt] : 0.f;
                st[kt][qt][i] = e; s4 += e; }
              gs[kt] = s4; rot[kt] = __shfl(st[kt][qt][3], (lane - 16) & 63, 64); }
            const int ti = th * 32 + qt * 16 + r;
#pragma unroll
            for (int kt = 0; kt < 4; ++kt) { const float add = (g > 0) ? rot[kt] : (kt > 0 ? rot[kt > 0 ? kt - 1 : 0] : carry[qt]);
              __hip_atomic_fetch_add(IMP + ti * IPT + t4 * 16 + kt * 4 + g, gs[kt] + add, __ATOMIC_RELAXED, __HIP_MEMORY_SCOPE_WORKGROUP); }
            carry[qt] = rot[3];
          }
          bf16x8 pb[2][2]; pack_p(pb, st);
          pv_apply(o, osd, pb, (lbf)(F.lds + (4 + t4) * RB), lane);
        }
        nsa_finish(comb, o, osd, gate0, true);
      }
      AT_BAR();
      {
        const int ti = tid >> 3, jbk = tid & 7, jb = jbk * 8;
        LAS int* IK = (LAS int*)IMP;
        int key[8];
#pragma unroll
        for (int u = 0; u < 8; ++u) { const int j = jb + u; float v = IMP[ti * IPT + j]; if (j == blk || j == 0) v = 1e4f; else if (j > blk) v = -1e30f; key[u] = __float_as_int(v); }
#pragma unroll
        for (int u = 0; u < 8; ++u) IK[ti * IPT + jb + u] = key[u];
        AT_BAR();
        int rank[8];
#pragma unroll
        for (int u = 0; u < 8; ++u) { int c = 0;
#pragma unroll
          for (int u2 = u; u2 < 8; ++u2) c += (key[u2] == key[u]) ? 1 : 0;
          rank[u] = -c; }
#pragma unroll
        for (int ib = 0; ib < 8; ++ib) {
          int th[8];
#pragma unroll
          for (int u = 0; u < 8; ++u) th[u] = key[u] + (ib > jbk ? 1 : 0);
#pragma unroll
          for (int ii = 0; ii < 8; ++ii) { const int k = IK[ti * IPT + ib * 8 + ii];
#pragma unroll
            for (int u = 0; u < 8; ++u) rank[u] += (k >= th[u]) ? 1 : 0; }
        }
        unsigned bits = 0;
#pragma unroll
        for (int u = 0; u < 8; ++u) bits |= (rank[u] < 16 ? 1u : 0u) << u;
        SELB[ti * 8 + jbk] = (unsigned char)bits;
      }
      AT_BAR();
      unsigned long long selm[2];
#pragma unroll
      for (int qt = 0; qt < 2; ++qt) { const int ti = th * 32 + qt * 16 + r; const LAS unsigned* sp2 = (const LAS unsigned*)(SELB + ti * 8); selm[qt] = (unsigned long long)sp2[0] | ((unsigned long long)sp2[1] << 32); }
#pragma unroll 1
      for (int br = 1; br < 3; ++br) {
        const int kcol = OFF_NKV + ((br * 2 + 0) * 2 + gq) * 64, vcol = OFF_NKV + ((br * 2 + 1) * 2 + gq) * 64;
        const float nbb = (br == 1) ? nb1 : nb2;
        const f32x4 nbv = {nbb, nbb, nbb, nbb};
        const int t_lo = (br == 1) ? 0 : (blk > 8 ? blk - 8 : 0);
        const bf16_t* Kg = H + (size_t)(b * SEQ) * HC + kcol;
        const bf16_t* Vg = H + (size_t)(b * SEQ) * HC + vcol;
        f32x4 o[4][2]; zero42(o);
        f32x4 os[2] = {{0.f, 0.f, 0.f, 0.f}, {0.f, 0.f, 0.f, 0.f}};
        v4u krA = tile_ld(Kg + (size_t)t_lo * 64 * HC, HC, tid), vrA = tile_ld(Vg + (size_t)t_lo * 64 * HC, HC, tid);
        v4u krB = krA, vrB = vrA;
        if (t_lo < blk) { krB = tile_ld(Kg + (size_t)(t_lo + 1) * 64 * HC, HC, tid); vrB = tile_ld(Vg + (size_t)(t_lo + 1) * 64 * HC, HC, tid); }
#pragma unroll 1
        for (int t0 = t_lo; t0 <= blk; t0 += 2) {
#pragma unroll
          for (int hf = 0; hf < 2; ++hf) {
            const int t = t0 + hf;
            if (t <= blk) {
              const lbf KBt = (lbf)(F.lds + (8 + hf * 2) * RB), VBt = KBt + 64 * RP;
              tile_st(KBt, hf ? krB : krA, tid); tile_st(VBt, hf ? vrB : vrA, tid);
              AT_BAR();
              if (t + 2 <= blk) { const v4u k2 = tile_ld(Kg + (size_t)(t + 2) * 64 * HC, HC, tid), v2 = tile_ld(Vg + (size_t)(t + 2) * 64 * HC, HC, tid);
                if (hf) { krB = k2; vrB = v2; } else { krA = k2; vrA = v2; } }
              const bool on[2] = {((selm[0] >> t) & 1ull) != 0ull, ((selm[1] >> t) & 1ull) != 0ull};
              const int qq0 = th * 32;
              if (br == 1) {
                if (__any((int)(on[0] || on[1]))) {
                  if (t == blk) attn_tile<2, 3>(o, os, qf, KBt, 0, VBt, nbv, on, qq0, 0, lane);
                  else if (__all((int)(on[0] && on[1]))) attn_tile<2, 0>(o, os, qf, KBt, 0, VBt, nbv, on, qq0, 0, lane);
                  else attn_tile<2, 1>(o, os, qf, KBt, 0, VBt, nbv, on, qq0, 0, lane);
                }
              } else {
                if (t == blk) attn_tile<2, 2>(o, os, qf, KBt, 0, VBt, nbv, on, qq0, 0, lane);
                else if (t == blk - 8) attn_tile<2, 4>(o, os, qf, KBt, 0, VBt, nbv, on, qq0, 0, lane);
                else attn_tile<2, 0>(o, os, qf, KBt, 0, VBt, nbv, on, qq0, 0, lane);
              }
            }
          }
        }
        nsa_finish(comb, o, os, (br == 1) ? gate1 : gate2, false);
        AT_BAR();
      }
#pragma unroll
      for (int qt = 0; qt < 2; ++qt) { bf16_t* op = CAT + (size_t)(tokw + qt * 16 + r) * DM + 512 + hh * 64;
#pragma unroll
        for (int dt = 0; dt < 4; ++dt) { const int d0 = dt * 16 + g * 4; v2u wv; wv.x = pk2(comb[dt][qt][0], comb[dt][qt][1]); wv.y = pk2(comb[dt][qt][2], comb[dt][qt][3]); *(GAS v2u*)(op + d0) = wv; } }
    }
  }
}


__device__ __forceinline__ void phase_lora2(PREF p, Frame& F, const bool skip_store = false, const bool skip_math = false) {
  const int lane = fresh_lane(), w = F.wave, tid = F.tid;
  const int cr = lane & 15, g = lane >> 4;
  constexpr int TP = 392;
  const lbf TM = (lbf)(F.lds);
  const lbf ST = (lbf)(F.lds + 64 * TP * 2) + w * 64 * RP;
  const bf16_t* TMPg = (const bf16_t*)(p.ws + WS_TMP);
  for (int unit = F.vcu; unit < 256; unit += F.G) {
    const int t0 = unit * 64;
    bf16x8 a0[2][4];
    auto wptr = [&](int blk) { const int tensor = blk >> 4, cb = blk & 15, ldw = (tensor == 2) ? 192 : 64;
      return (const bf16_t*)(p.ws + WS_WL2 + (size_t)tensor * 128 * 1024) + (size_t)(cb * 64 + cr) * ldw + g * 8; };
    auto wload = [&](int blk) {
      const int ldw = ((blk >> 4) == 2) ? 192 : 64; const bf16_t* Wp = wptr(blk);
#pragma unroll
      for (int k2 = 0; k2 < 2; ++k2)
#pragma unroll
        for (int ct = 0; ct < 4; ++ct) a0[k2][ct] = *(const GAS bf16x8*)(Wp + (size_t)(16 * ct) * ldw + k2 * 32);
    };
    auto blkof = [&](int j) { return ((j >> 1) << 4) | ((w * 2 + (j & 1) + unit * 3) & 15); };
    wload(blkof(0));
#pragma unroll
    for (int i = 0; i < 6; ++i) { const int idx = tid + i * 512, row = idx / 48, pc = idx - row * 48;
      *(LAS v4u*)(TM + row * TP + pc * 8) = *(const GAS v4u*)(TMPg + (size_t)(t0 + row) * 384 + pc * 8); }
    __syncthreads();
#pragma unroll 1
    for (int j = 0; j < 6; ++j) {
      const int blk = blkof(j);
      const int tensor = blk >> 4, cb = blk & 15, kc0 = tensor * 64;
      f32x4 acc[4][4];
#pragma unroll
      for (int ct = 0; ct < 4; ++ct)
#pragma unroll
        for (int tt = 0; tt < 4; ++tt) acc[ct][tt] = (f32x4){0.f, 0.f, 0.f, 0.f};
      auto kpair = [&](int kp, bf16x8 (&a)[2][4]) {
#pragma unroll
        for (int k2 = 0; k2 < 2; ++k2) {
          bf16x8 b[4];
#pragma unroll
          for (int tt = 0; tt < 4; ++tt) b[tt] = *(const LAS bf16x8*)(TM + (16 * tt + cr) * TP + kc0 + kp * 64 + k2 * 32 + g * 8);
#pragma unroll
          for (int ct = 0; ct < 4; ++ct)
#pragma unroll
            for (int tt = 0; tt < 4; ++tt) acc[ct][tt] = __builtin_amdgcn_mfma_f32_16x16x32_bf16(a[k2][ct], b[tt], acc[ct][tt], 0, 0, 0);
        }
      };
      if (tensor == 2) {
        bf16x8 a1[2][4], a2[2][4]; const bf16_t* Wp = wptr(blk);
#pragma unroll
        for (int k2 = 0; k2 < 2; ++k2)
#pragma unroll
          for (int ct = 0; ct < 4; ++ct) { a1[k2][ct] = *(const GAS bf16x8*)(Wp + (size_t)(16 * ct) * 192 + 64 + k2 * 32); a2[k2][ct] = *(const GAS bf16x8*)(Wp + (size_t)(16 * ct) * 192 + 128 + k2 * 32); }
        kpair(0, a0); kpair(1, a1); kpair(2, a2);
      } else kpair(0, a0);
      if (j < 5) wload(blkof(j + 1));
#pragma unroll
      for (int ct = 0; ct < 4; ++ct) {
        const int n0 = cb * 64 + 16 * ct + 4 * g;
        f32x4 bias = {0.f, 0.f, 0.f, 0.f};
        if (tensor == 0) bias = *(const f32x4*)(p.w0 + n0); else if (tensor == 1) bias = *(const f32x4*)(p.a0 + n0);
#pragma unroll
        for (int tt = 0; tt < 4; ++tt) {
          f32x4 v = acc[ct][tt] + bias;
          if (skip_math) {} else if (tensor == 0) {
#pragma unroll
            for (int i = 0; i < 4; ++i) v[i] = -0.60653066f * sigmoidf_(v[i]);
          } else if (tensor == 1) {
#pragma unroll
            for (int i = 0; i < 4; ++i) v[i] = sigmoidf_(v[i]);
          }
          v2u o; o.x = pk2(v[0], v[1]); o.y = pk2(v[2], v[3]);
          *(LAS v2u*)(ST + (16 * tt + cr) * RP + 16 * ct + 4 * g) = o;
        }
      }
      LDS_WAIT();
      bf16_t* O = (bf16_t*)(p.ws + WS_S0 + (size_t)tensor * SLOT) + (size_t)t0 * DM + cb * 64;
#pragma unroll
      for (int i = 0; i < 8; ++i) { const int row = (lane >> 3) + 8 * i, pc = (lane & 7) * 8;
        const v4u sv = *(const LAS v4u*)(ST + row * RP + pc); if (!skip_store) *(GAS v4u*)(O + (size_t)row * DM + pc) = sv; }
      LDS_WAIT();
    }
    __syncthreads();
  }
}

__global__ void __launch_bounds__(NWAVES * 64, 2) mk_fwd(P p_arg) {
  extern __shared__ __attribute__((aligned(16))) unsigned char lds[];
  Frame F;
  F.lds = (LAS unsigned char*)lds;
  F.MISC = (volatile LAS unsigned*)(F.lds + MISC_OFF);
  F.tid = threadIdx.x; F.lane = F.tid & 63; F.wave = __builtin_amdgcn_readfirstlane(F.tid >> 6);
  F.G = gridDim.x; { const int bx = blockIdx.x; F.vcu = (F.G % 8 == 0) ? (bx % 8) * (F.G / 8) + bx / 8 : bx; }
  unsigned char* const ws = p_arg.ws;
  F.ctl = (gu32*)(ws + WS_CTL);
  for (int u = F.tid; u < (LDS_BYTES - LDSCTL_OFF) / 4; u += NWAVES * 64) ((LAS unsigned*)(F.lds + LDSCTL_OFF))[u] = 0u;
  __syncthreads();
  XcdBarrier bar = xcd_barrier_post((unsigned*)(F.ctl + CW_BAR) + p_arg.pad * XCD_BAR_WORDS, F.MISC + 8);
  const int lo = p_arg.ph_lo, hi = p_arg.ph_hi;
#ifndef PHMASK
#define PHMASK 0xffffffffu
#endif
#define IN(k) (lo <= (k) && (k) < hi && ((PHMASK >> (k)) & 1u))
#define SEAM(k) do { if (IN(k) && IN((k) + 1)) xcd_barrier(bar); } while (0)
#ifdef PROBE_PH
  F.pr_t0 = 0; F.pr_t1 = 0;
#endif

  PROBE_MARK(0); if (IN(0)) { phase_prologue(KP, F); } SEAM(0);
  PROBE_MARK(1); if (IN(1)) {
    pg8::Gemm g{(const bf16_t*)(ws + WS_XN), (const bf16_t*)(ws + WS_WIN), DM, DM};
    pg8::StaticOrder S; S.init(T_TOK, 3072, F.G, (int)blockIdx.x);
    PREF p = KP; EpiInProj E{(bf16_t*)(ws + WS_H), (float*)(ws + WS_GATES), p.dq_norm, p.dk_norm, p.nq_norm, p.nk_norm, p.gate_bias};
    pg8::gemm_phase<EpiInProj, pg8::StaticOrder, true>(F.lds + RING_OFF, g, S, E);
  } SEAM(1);
  PROBE_MARK(2); if (IN(2)) { phase_compress(KP, F); phase_diffattn(KP, F); } SEAM(2);
  PROBE_MARK(3); if (IN(3)) { phase_nsa(KP, F); } SEAM(3);
  PROBE_MARK(4); if (IN(4)) {
    pg8::Gemm g{(const bf16_t*)(ws + WS_CAT), (const bf16_t*)(ws + WS_WOUT), DM, DM};
    pg8::StaticOrder S; S.init(T_TOK, DM, F.G, (int)blockIdx.x);
    PREF p = KP; EpiResid E{p.x, nullptr, (bf16_t*)p.out, nullptr};
    pg8::gemm_phase<EpiResid, pg8::StaticOrder, false>(F.lds + RING_OFF, g, S, E);
  } SEAM(4);
#define MOE_PHASES(layer, pb) do { \
    PROBE_MARK(pb); if (IN(pb)) { phase_router(KP, F, layer); } SEAM(pb); \
    PROBE_MARK(pb + 1); if (IN(pb + 1)) { \
      pg8::Gemm g{layer ? (const bf16_t*)(ws + WS_X3) : (const bf16_t*)KP.out, (const bf16_t*)(ws + WS_EGU), DM, DM}; \
      pg8::moe_order_setup((LAS int*)(F.lds + MISC_OFF + 256), (const unsigned*)(ws + WS_CTL) + CW_CNT + layer * 32 * 64); pg8::MoeOrder<2, true> S{(const LAS int*)(F.lds + MISC_OFF + 256), (const int*)(ws + WS_LIST), F.G, F.vcu}; \
      EpiMoeGU E{(bf16_t*)(ws + WS_HID), (const int*)(ws + WS_LIST), (const float*)(ws + WS_RS)}; \
      pg8::gemm_phase<EpiMoeGU, pg8::MoeOrder<2, true>, true>(F.lds + RING_OFF, g, S, E); \
    } SEAM(pb + 1); \
    PROBE_MARK(pb + 2); if (IN(pb + 2)) { \
      int k256 = 256; asm volatile("" : "+s"(k256)); \
      pg8::Gemm g{(const bf16_t*)(ws + WS_HID), (const bf16_t*)(ws + WS_EDN), k256, 256}; \
      pg8::moe_order_setup((LAS int*)(F.lds + MISC_OFF + 256), (const unsigned*)(ws + WS_CTL) + CW_CNT + layer * 32 * 64); pg8::MoeOrder<4, false> S{(const LAS int*)(F.lds + MISC_OFF + 256), (const int*)(ws + WS_LIST), F.G, F.vcu}; \
      PREF p = KP; EpiMoeDown E{layer ? (bf16_t*)(ws + WS_X3) : (bf16_t*)p.out, (bf16_t*)(ws + WS_Y1), (const int*)(ws + WS_LIST), (const float*)(ws + WS_PGATE), (LAS int*)(F.lds + 132096)}; \
      pg8::gemm_phase<EpiMoeDown, pg8::MoeOrder<4, false>, true>(F.lds + RING_OFF, g, S, E); \
    } SEAM(pb + 2); \
  } while (0)
  MOE_PHASES(0, 5);
  PROBE_MARK(8); if (IN(8)) { phase_rwkv_prep(KP, F); } SEAM(8);
  PROBE_MARK(9); if (IN(9)) {
    pg8::Gemm g{(const bf16_t*)(ws + WS_S0 + 3 * SLOT), (const bf16_t*)(ws + WS_WL1), DM, DM};
    pg8::TallOrder S; S.init(3, 1, F.G, (int)blockIdx.x);
    EpiLora1 E{(bf16_t*)(ws + WS_TMP)};
    pg8::gemm_phase<EpiLora1, pg8::TallOrder, false>(F.lds + RING_OFF, g, S, E);
  } SEAM(9);
  PROBE_MARK(10); if (IN(10)) {
    pg8::Gemm g{(const bf16_t*)(ws + WS_S0), (const bf16_t*)(ws + WS_WRKV), DM, DM};
    pg8::TallOrder S; S.init(3, 4, F.G, (int)blockIdx.x);
    EpiRKV E{ws};
    pg8::gemm_phase<EpiRKV, pg8::TallOrder, true>(F.lds + RING_OFF, g, S, E);
  } SEAM(10);
  PROBE_MARK(11); if (IN(11)) {
#ifdef EXP_A
    phase_lora2(KP, F, KP.ph_lo == 0, false); __syncthreads();
#endif
#ifdef EXP_B
    phase_lora2(KP, F, KP.ph_lo == 0, KP.ph_lo == 0); __syncthreads();
#endif
    phase_lora2(KP, F);
  } SEAM(11);
  PROBE_MARK(12); if (IN(12)) { phase_rwkv_r1(KP, F); } SEAM(12);
  PROBE_MARK(13); if (IN(13)) { phase_rwkv_r2(KP, F); } SEAM(13);
  PROBE_MARK(14); if (IN(14)) { phase_rwkv_r3(KP, F); } SEAM(14);
  PROBE_MARK(15); if (IN(15)) {
    pg8::Gemm g{(const bf16_t*)(ws + WS_S0 + 3 * SLOT), (const bf16_t*)(ws + WS_WO), DM, DM};
    pg8::StaticOrder S; S.init(T_TOK, DM, F.G, (int)blockIdx.x);
    PREF p = KP; EpiResid E{nullptr, (const bf16_t*)p.out, (bf16_t*)(ws + WS_X3), (const bf16_t*)(ws + WS_Y1)};
    pg8::gemm_phase<EpiResid, pg8::StaticOrder, false>(F.lds + RING_OFF, g, S, E);
  } SEAM(15);
  MOE_PHASES(1, 16);
#undef MOE_PHASES
  PROBE_MARK(19); if (IN(19)) { phase_final(KP, F); }
  PROBE_MARK(20);
#ifdef PROBE_PH
  { const unsigned long long dur = (F.pr_t1 - F.pr_t0) * PROBE_MUL, t0 = __builtin_amdgcn_s_memrealtime(); while (__builtin_amdgcn_s_memrealtime() - t0 < dur) __builtin_amdgcn_s_sleep(8); }
#endif
#undef IN
#undef SEAM
}

static void launch_mk(P p, int lo, int hi, int li, int grid, hipStream_t st) {
  p.ph_lo = lo; p.ph_hi = hi; p.pad = li;
  hipLaunchKernelGGL(mk_fwd, dim3(grid), dim3(NWAVES * 64), LDS_BYTES, st, p);
}

extern "C" void kernel_launch(void* const* d_in, const int* in_sizes, int n_in, void* d_out, int out_size, void* d_ws,
                              size_t ws_size, hipStream_t stream) {
  static int grid = 0;
  if (grid == 0) {
    if (n_in != 40 || ws_size < WS_END) { fprintf(stderr, "kernel_launch: bad n_in %d or ws_size %zu (< %zu)\n", n_in, ws_size, (size_t)WS_END); grid = -1; return; }
    int dev = 0, cus = 0;
    if (hipGetDevice(&dev) != hipSuccess || hipDeviceGetAttribute(&cus, hipDeviceAttributeMultiprocessorCount, dev) != hipSuccess) { grid = -1; return; }
    if (hipFuncSetAttribute((const void*)mk_fwd, hipFuncAttributeMaxDynamicSharedMemorySize, LDS_BYTES) != hipSuccess) { grid = -1; return; }
    if (cus < 256) { fprintf(stderr, "kernel_launch: needs 256 CUs (one workgroup per CU), found %d\n", cus); grid = -1; return; }
    grid = 256;
  }
  if (grid < 0) return;
  P p{};
  const float* const* in = (const float* const*)d_in;
  p.x = in[0]; p.mix_norm = in[1]; p.w_in = in[2]; p.gate_bias = in[3]; p.dq_norm = in[4]; p.dk_norm = in[5];
  p.dlam = in[6]; p.dsubln = in[7]; p.nq_norm = in[8]; p.nk_norm = in[9]; p.cmp_pe = in[10]; p.cmp_w1 = in[11];
  p.cmp_w2 = in[12]; p.w_out = in[13]; p.rmix = in[14]; p.w_r = in[15]; p.w_k = in[16]; p.w_v = in[17];
  p.w0 = in[18]; p.w1 = in[19]; p.w2 = in[20]; p.a0 = in[21]; p.a1 = in[22]; p.a2 = in[23]; p.g1 = in[24]; p.g2 = in[25];
  p.k_k = in[26]; p.k_a = in[27]; p.r_k = in[28]; p.ln_w = in[29]; p.ln_b = in[30]; p.w_o = in[31];
  p.ffn_norm = in[32]; p.rg_w = in[33]; p.rg_b = in[34]; p.re_w = in[35]; p.re_b = in[36];
  p.e_gate = in[37]; p.e_up = in[38]; p.e_down = in[39];
  p.out = (float*)d_out;
  p.ws = (unsigned char*)d_ws;
  unsigned char* ws = p.ws;
  (void)hipMemsetAsync(ws + WS_CTL, 0, CTL_ZERO_BYTES, stream);
  launch_mk(p, 0, 20, 0, grid, stream);
}
```

```cpp
#include <hip/hip_runtime.h>
#include <cstdio>
#include <cstdint>

#define T_TOK 16384
#define DM 1024
#define SEQ 4096
#define NBATCH 4
#define INC 2840
#define HC 2816
#define OFF_DQ 0
#define OFF_DK 512
#define OFF_DV 1024
#define OFF_NQ 1536
#define OFF_NKV 2048
#define OFF_NG 2816
#define NCMP 255
#define CAP 16384

#define GAS __attribute__((address_space(1)))
#define LAS __attribute__((address_space(3)))
typedef unsigned short bf16_t;
typedef unsigned v4u __attribute__((ext_vector_type(4)));
typedef unsigned v2u __attribute__((ext_vector_type(2)));
typedef float f32x4 __attribute__((ext_vector_type(4)));
typedef short bf16x8 __attribute__((ext_vector_type(8)));
typedef GAS unsigned gu32;
#define RLX_AGENT __ATOMIC_RELAXED, __HIP_MEMORY_SCOPE_AGENT
#define LDS_WAIT() asm volatile("s_waitcnt lgkmcnt(0)" ::: "memory")
#define VM_WAIT() asm volatile("s_waitcnt vmcnt(0)" ::: "memory")

__device__ __forceinline__ float bf2f(bf16_t v) { return __uint_as_float(((unsigned)v) << 16); }

typedef float f32x2_t __attribute__((ext_vector_type(2))); typedef __bf16 bf16x2_t __attribute__((ext_vector_type(2)));
__device__ __forceinline__ unsigned pk2(float lo, float hi) { const f32x2_t v = {lo, hi}; return __builtin_bit_cast(unsigned, __builtin_convertvector(v, bf16x2_t)); }
__device__ __forceinline__ unsigned f2bf(float f) { return pk2(f, f) & 0xffffu; }
__device__ __forceinline__ float wave_sum(float v) {
#pragma unroll
  for (int o = 32; o >= 1; o >>= 1) v += __shfl_xor(v, o, 64);
  return v;
}
__device__ __forceinline__ float sum8_dpp(float v) {
  v += __builtin_bit_cast(float, __builtin_amdgcn_update_dpp(0, __builtin_bit_cast(int, v), 0xB1, 0xf, 0xf, false));
  v += __builtin_bit_cast(float, __builtin_amdgcn_update_dpp(0, __builtin_bit_cast(int, v), 0x4E, 0xf, 0xf, false));
  v += __builtin_bit_cast(float, __builtin_amdgcn_update_dpp(0, __builtin_bit_cast(int, v), 0x141, 0xf, 0xf, false));
  return v;
}
__device__ __forceinline__ float sum16_dpp(float v) {
  v = sum8_dpp(v);
  v += __builtin_bit_cast(float, __builtin_amdgcn_update_dpp(0, __builtin_bit_cast(int, v), 0x140, 0xf, 0xf, false));
  return v;
}
__device__ __forceinline__ float wave_sum_dpp(float v) {
  v += __builtin_bit_cast(float, __builtin_amdgcn_update_dpp(0, __builtin_bit_cast(int, v), 0xB1, 0xf, 0xf, false));
  v += __builtin_bit_cast(float, __builtin_amdgcn_update_dpp(0, __builtin_bit_cast(int, v), 0x4E, 0xf, 0xf, false));
  v += __builtin_bit_cast(float, __builtin_amdgcn_update_dpp(0, __builtin_bit_cast(int, v), 0x141, 0xf, 0xf, false));
  v += __builtin_bit_cast(float, __builtin_amdgcn_update_dpp(0, __builtin_bit_cast(int, v), 0x140, 0xf, 0xf, false));
  const int iv = __builtin_bit_cast(int, v);
  return (__builtin_bit_cast(float, __builtin_amdgcn_readlane(iv, 0)) + __builtin_bit_cast(float, __builtin_amdgcn_readlane(iv, 16))) +
         (__builtin_bit_cast(float, __builtin_amdgcn_readlane(iv, 32)) + __builtin_bit_cast(float, __builtin_amdgcn_readlane(iv, 48)));
}
__device__ __forceinline__ int fresh_lane() { int l; asm volatile("v_mbcnt_lo_u32_b32 %0, -1, 0\n\tv_mbcnt_hi_u32_b32 %0, -1, %0" : "=v"(l)); return l; }
__device__ __forceinline__ float uniformf(float v) { return __builtin_bit_cast(float, __builtin_amdgcn_readfirstlane(__builtin_bit_cast(int, v))); }
__device__ __forceinline__ float sum_x32(float v) { const auto rr = __builtin_amdgcn_permlane32_swap(__float_as_uint(v), __float_as_uint(v), false, false); return __uint_as_float(rr[0]) + __uint_as_float(rr[1]); }
__device__ __forceinline__ float sum_x16(float v) { const auto rr = __builtin_amdgcn_permlane16_swap(__float_as_uint(v), __float_as_uint(v), false, false); return __uint_as_float(rr[0]) + __uint_as_float(rr[1]); }
__device__ __forceinline__ float sum_x16_32(float v) { return sum_x32(sum_x16(v)); }
__device__ __forceinline__ float sigmoidf_(float x) { return __builtin_amdgcn_rcpf(1.f + __builtin_amdgcn_exp2f(-1.44269504f * x)); }
__device__ __forceinline__ float tanhf_(float x) { return 1.f - 2.f * __builtin_amdgcn_rcpf(1.f + __builtin_amdgcn_exp2f(2.88539008f * x)); }
__device__ __forceinline__ float softplusf_(float x) { return fmaxf(x, 0.f) + __logf(1.f + __expf(-fabsf(x))); }
__device__ __forceinline__ float gelu_tanh(float x) {
  float u = 0.7978845608028654f * (x + 0.044715f * x * x * x);
  return 0.5f * x * (1.f + tanhf_(u));
}

constexpr size_t MiB = 1u << 20;
constexpr size_t WS_CTL = 0, CTL_ZERO_BYTES = 160 * 1024;
constexpr size_t WS_WIN = 1 * MiB;
constexpr size_t WS_WOUT = 7 * MiB;
constexpr size_t WS_WRKV = 9 * MiB;
constexpr size_t WS_WO = 15 * MiB;
constexpr size_t WS_WL1 = 17 * MiB;
constexpr size_t WS_WL2 = 19 * MiB;
constexpr size_t WS_WR = 20 * MiB;
constexpr size_t WS_RS = 20 * MiB + 640 * 1024;
constexpr size_t WS_EGU = 22 * MiB;
constexpr size_t WS_EDN = 54 * MiB;
constexpr size_t WS_ACT = 70 * MiB;
constexpr size_t WS_XN = WS_ACT;
constexpr size_t WS_H = WS_ACT + 32 * MiB;
constexpr size_t WS_GATES = WS_ACT + 120 * MiB;
constexpr size_t WS_CAT = WS_ACT + 122 * MiB;
constexpr size_t WS_KCMPB = WS_ACT + 154 * MiB;
constexpr size_t WS_VCMPB = WS_ACT + 155 * MiB;
constexpr size_t WS_CW1 = 21 * MiB + 256 * 1024;
constexpr size_t WS_XN2 = WS_ACT;
constexpr size_t WS_HID = WS_ACT + 32 * MiB;
constexpr size_t WS_Y1 = WS_EGU;
constexpr size_t WS_LIST = WS_ACT + 156 * MiB;
constexpr size_t WS_PGATE = WS_ACT + 158 * MiB;
constexpr size_t WS_X3 = WS_ACT + 64 * MiB;
constexpr size_t WS_XN2F = WS_ACT;
constexpr size_t WS_GUF = WS_ACT + 64 * MiB;
constexpr size_t WS_S0 = WS_ACT;
constexpr size_t WS_TMP = WS_ACT + 192 * MiB;
constexpr size_t WS_END = WS_ACT + 204 * MiB;
constexpr size_t SLOT = 32 * MiB;
constexpr int CW_BAR = 4096;
constexpr int CW_CNT = 32768;

namespace pg8 {
#define PG8_LAS __attribute__((address_space(3)))
typedef unsigned u32x4 __attribute__((ext_vector_type(4)));
constexpr int BM = 256, BK = 64, HALF = 128, HTB = HALF * BK * 2  , STAGE_BYTES = 8 * HTB, NXCD = 8, WGM = 8;

__host__ __device__ __forceinline__ int lds_byte(int r, int c) { const int st = (r >> 4) * 2 + (c >> 5), rr = r & 15, cc = c & 31, ob = rr * 64 + cc * 2; return st * 1024 + (ob ^ (((ob >> 9) & 1) << 5)); }
__host__ __device__ __forceinline__ void stage_rc(int b, int& R, int& C) { const int st = b / 1024, sb = b % 1024, swz = sb ^ (((sb >> 9) & 1) << 5); R = (st >> 1) * 16 + swz / 64; C = (st & 1) * 32 + (swz % 64) / 2; }
__host__ __device__ __forceinline__ int perm32(int rho) { const int n = rho >> 4, i = rho & 15; return 8 * (i >> 2) + 4 * n + (i & 3); }

struct Unit { int pm, pn, e, nrows, rt, par; };
struct Gemm { const bf16_t* A; const bf16_t* Bt; int K; int lda; };

__device__ __forceinline__ void static_map(int L, int nM, int nN, int& pm, int& pn) {
    const int nwg = nM * nN;
    int wgid = L; { const int q = nwg / NXCD, r = nwg % NXCD, xcd = wgid % NXCD, off = wgid / NXCD; wgid = (xcd < r ? xcd * (q + 1) : r * (q + 1) + (xcd - r) * q) + off; }
    const int nig = WGM * nN, gid = wgid / nig, fm = gid * WGM, gsz = (nM - fm) < WGM ? (nM - fm) : WGM;
    pm = fm + ((wgid % nig) % gsz); pn = (wgid % nig) / gsz;
}
struct StaticOrder {
    int nM, nN, G, c;
    __device__ void init(int M, int N, int G_, int c_) { nM = M / BM; nN = N / BM; G = G_; c = c_; }
    __device__ __forceinline__ bool next(int i, Unit& u) const {
        const int L = i * G + c; if (L >= nM * nN) return false;
        static_map(L, nM, nN, u.pm, u.pn); u.e = 0; u.nrows = 256; u.rt = 0; return true;
    }
    __device__ __forceinline__ unsigned rowoff(const Unit& u, int r, int C, int K) const { return (unsigned)((u.pm * BM + r) * K + C) * 2u; }
};
struct TallOrder {
    int nM, nN, G, c;
    __device__ void init(int ngemm, int nN_, int G_, int c_) { nM = 64 * ngemm; nN = nN_; G = G_; c = c_; }
    __device__ __forceinline__ bool next(int i, Unit& u) const {
        const int L = i * G + c; if (L >= nM * nN) return false;
        int pn; static_map(L, nM, nN, u.pm, pn); u.pn = (u.pm >> 6) * nN + pn; u.e = 0; u.nrows = 256; u.rt = 0; return true;
    }
    __device__ __forceinline__ unsigned rowoff(const Unit& u, int r, int C, int K) const { return (unsigned)((u.pm * BM + r) * K + C) * 2u; }
};


template <int NCOL, bool GATHER>
struct MoeOrder {
    const PG8_LAS int* tab;
    const int* list; int G, c;
    __device__ __forceinline__ bool next(int i, Unit& u) const {
        const int L = i * G + c; const int R = L / NCOL, j = L - R * NCOL;
        if (R >= tab[32]) return false;
        int e = 0;
#pragma unroll
        for (int s = 16; s >= 1; s >>= 1) { if (tab[e + s] <= R) e += s; }
        const int ce = tab[33 + e];
        u.pm = R; u.rt = R - tab[e]; u.e = e; u.pn = e * NCOL + j; u.nrows = ce - u.rt * 256; return true;
    }
    __device__ __forceinline__ unsigned rowoff(const Unit& u, int r, int C, int K) const {
        if (GATHER) { const int idx = (r < u.nrows) ? u.rt * 256 + r : 0; const int pr = list[(size_t)u.e * CAP + idx]; return (unsigned)((pr >> 1) * K + C) * 2u; }
        return (unsigned)((u.pm * BM + r) * K + C) * 2u;
    }
};
__device__ __forceinline__ void moe_order_setup(PG8_LAS int* tab, const unsigned* cnt) {
    if (threadIdx.x < 32) tab[33 + threadIdx.x] = (int)__hip_atomic_load(cnt + threadIdx.x * 64, __ATOMIC_RELAXED, __HIP_MEMORY_SCOPE_AGENT);
    __syncthreads();
    if (threadIdx.x == 0) { int pre = 0; for (int e = 0; e < 32; ++e) { tab[e] = pre; pre += (tab[33 + e] + 255) >> 8; } tab[32] = pre; }
    __syncthreads();
}

__device__ __forceinline__ unsigned cvt_pk_bf16(float lo, float hi) { unsigned r; asm volatile("v_cvt_pk_bf16_f32 %0, %1, %2" : "=v"(r) : "v"(lo), "v"(hi)); return r; }
__device__ __forceinline__ u32x4 pack8(const f32x4& a, const f32x4& b) { u32x4 w; w.x = cvt_pk_bf16(a[0], a[1]); w.y = cvt_pk_bf16(a[2], a[3]); w.z = cvt_pk_bf16(b[0], b[1]); w.w = cvt_pk_bf16(b[2], b[3]); return w; }

template <class Epi, class Sched, bool ALIGN_EPI>
__device__ __forceinline__ void gemm_phase(PG8_LAS unsigned char* lds, const Gemm g, const Sched& S, const Epi& E) {
    const int tid = threadIdx.x, wid = __builtin_amdgcn_readfirstlane(tid >> 6), lane = tid & 63, wr = wid >> 2, wc = wid & 3, fr = lane & 15, fq = lane >> 4;
    const int K = g.K, nt = K / BK;
    int RA[2], CA[2]; unsigned voffB[2];
#pragma unroll
    for (int i = 0; i < 2; ++i) { int R, C; stage_rc(tid * 16 + i * 8192, R, C); const int Rb = Epi::PERM ? ((R & ~31) + perm32(R & 31)) : R;
        RA[i] = R; CA[i] = C; voffB[i] = (unsigned)(Rb * K + C) * 2u; }
    const size_t kstep = (size_t)(BK * 2);
    const size_t hstep = (size_t)HALF * K * 2;
    const size_t tstep = 2 * hstep;
    const unsigned ldsw = (unsigned)wid * 1024u;
    const int aoff = lds_byte(wr * 64 + fr, fq * 8), boff = lds_byte(wc * 32 + fr, fq * 8);
    const char* const Abase = (const char*)g.A;
#define PG8_SA(b, h) (((b) * 2 + (h)) * HTB)
#define PG8_SB(b, h) ((4 + (b) * 2 + (h)) * HTB)
#define PG8_STAGE(bufoff, gbase, voff) do { _Pragma("unroll") for (int _i = 0; _i < 2; ++_i) \
        __builtin_amdgcn_global_load_lds((const unsigned*)((const char*)(gbase) + (voff)[_i]), (PG8_LAS unsigned*)(lds + (bufoff) + ldsw + _i * 8192), 16, 0, 0); } while (0)
#define PG8_STAGEA(bufoff, kbyte, o0, o1) do { \
        __builtin_amdgcn_global_load_lds((const unsigned*)(Abase + (size_t)(kbyte) + (o0)), (PG8_LAS unsigned*)(lds + (bufoff) + ldsw), 16, 0, 0); \
        __builtin_amdgcn_global_load_lds((const unsigned*)(Abase + (size_t)(kbyte) + (o1)), (PG8_LAS unsigned*)(lds + (bufoff) + ldsw + 8192), 16, 0, 0); } while (0)
#define PG8_LDA(dst, b, h) do { _Pragma("unroll") for (int m = 0; m < 4; ++m) _Pragma("unroll") for (int k = 0; k < 2; ++k) dst[m][k] = *(const PG8_LAS bf16x8*)(lds + PG8_SA(b, h) + aoff + m * 2048 + k * 1024); } while (0)
#define PG8_LDB(dst, b, h) do { _Pragma("unroll") for (int n = 0; n < 2; ++n) _Pragma("unroll") for (int k = 0; k < 2; ++k) dst[n][k] = *(const PG8_LAS bf16x8*)(lds + PG8_SB(b, h) + boff + n * 2048 + k * 1024); } while (0)
#define PG8_MMA(ai, bj, At, Bt) do { __builtin_amdgcn_s_setprio(1); _Pragma("unroll") for (int m = 0; m < 4; ++m) _Pragma("unroll") for (int n = 0; n < 2; ++n) _Pragma("unroll") for (int k = 0; k < 2; ++k) \
        acc[ai][bj][m][n] = __builtin_amdgcn_mfma_f32_16x16x32_bf16(Bt[n][k], At[m][k], acc[ai][bj][m][n], 0, 0, 0); __builtin_amdgcn_s_setprio(0); } while (0)
#define PG8_WAIT_V(n) asm volatile("s_waitcnt vmcnt(" #n ")" ::: "memory")
#define PG8_WAIT_L(n) asm volatile("s_waitcnt lgkmcnt(" #n ")" ::: "memory")
#define PG8_BAR __builtin_amdgcn_s_barrier()
#define PG8_SCHED __builtin_amdgcn_sched_barrier(0)
    Unit cur, nxt; int ui = 0;
    if (!S.next(0, cur)) return;
    cur.par = 0;
    if constexpr (Epi::HAS_PRE) E.pre(cur);
    f32x4 acc[2][2][4][2];
#pragma unroll
    for (int a = 0; a < 2; ++a)
#pragma unroll
        for (int b = 0; b < 2; ++b)
#pragma unroll
            for (int m = 0; m < 4; ++m)
#pragma unroll
                for (int n = 0; n < 2; ++n) acc[a][b][m][n] = (f32x4){0.f, 0.f, 0.f, 0.f};
    bf16x8 At[4][2], B0[2][2], B1[2][2];
    unsigned c00 = S.rowoff(cur, RA[0], CA[0], g.lda), c01 = S.rowoff(cur, RA[1], CA[1], g.lda), c10 = S.rowoff(cur, HALF + RA[0], CA[0], g.lda), c11 = S.rowoff(cur, HALF + RA[1], CA[1], g.lda);
    unsigned n00, n01, n10, n11;
    const char* cB = (const char*)g.Bt + (size_t)cur.pn * tstep;
    PG8_STAGE(PG8_SB(0, 0), cB, voffB); PG8_STAGE(PG8_SB(0, 1), cB + hstep, voffB); PG8_STAGEA(PG8_SA(0, 0), 0, c00, c01); PG8_STAGEA(PG8_SA(0, 1), 0, c10, c11);
    if (wr == 1) PG8_BAR;
    PG8_WAIT_V(2); PG8_BAR;
    PG8_STAGE(PG8_SB(1, 0), cB + kstep, voffB); PG8_STAGEA(PG8_SA(1, 0), kstep, c00, c01); PG8_STAGE(PG8_SB(1, 1), cB + hstep + kstep, voffB);
    PG8_WAIT_V(6); PG8_BAR;
    for (;;) {
        const bool has_next = S.next(ui + 1, nxt);
        const char* nB = has_next ? (const char*)g.Bt + (size_t)nxt.pn * tstep : cB;
        if (has_next) { n00 = S.rowoff(nxt, RA[0], CA[0], g.lda); n01 = S.rowoff(nxt, RA[1], CA[1], g.lda); n10 = S.rowoff(nxt, HALF + RA[0], CA[0], g.lda); n11 = S.rowoff(nxt, HALF + RA[1], CA[1], g.lda); }
        else { n00 = c00; n01 = c01; n10 = c10; n11 = c11; }
        for (int t = 0; t < nt; t += 2) {
            const bool last = (t == nt - 2);
            const size_t k1 = (size_t)(t + 1) * kstep;
            const size_t k2 = last ? 0 : (size_t)(t + 2) * kstep;
            const size_t k3 = k2 + kstep;
            const unsigned a00 = last ? n00 : c00, a01 = last ? n01 : c01, a10 = last ? n10 : c10, a11 = last ? n11 : c11;
            const char* b2 = last ? nB : cB + (size_t)(t + 2) * kstep;
            const char* b3 = b2 + kstep;
            PG8_LDB(B0, 0, 0); PG8_LDB(B1, 0, 1); PG8_SCHED; PG8_LDA(At, 0, 0); PG8_STAGEA(PG8_SA(1, 1), k1, c10, c11);
            PG8_WAIT_V(8); PG8_WAIT_L(0); PG8_BAR; PG8_MMA(0, 0, At, B0); PG8_MMA(0, 1, At, B1); PG8_BAR; PG8_SCHED;
            PG8_LDA(At, 0, 1); PG8_STAGE(PG8_SB(0, 0), b2, voffB); PG8_STAGE(PG8_SB(0, 1), b2 + hstep, voffB); PG8_STAGEA(PG8_SA(0, 0), k2, a00, a01);
            PG8_WAIT_V(8); PG8_WAIT_L(0); PG8_BAR; PG8_MMA(1, 0, At, B0); PG8_MMA(1, 1, At, B1); PG8_BAR; PG8_SCHED;
            PG8_LDB(B0, 1, 0); PG8_LDB(B1, 1, 1); PG8_SCHED; PG8_LDA(At, 1, 0); PG8_STAGEA(PG8_SA(0, 1), k2, a10, a11);
            PG8_WAIT_V(8); PG8_WAIT_L(0); PG8_BAR; PG8_MMA(0, 0, At, B0); PG8_MMA(0, 1, At, B1); PG8_BAR; PG8_SCHED;
            PG8_LDA(At, 1, 1); PG8_STAGE(PG8_SB(1, 0), b3, voffB); PG8_STAGE(PG8_SB(1, 1), b3 + hstep, voffB); PG8_STAGEA(PG8_SA(1, 0), k3, a00, a01);
            PG8_WAIT_V(8); PG8_WAIT_L(0); PG8_BAR; PG8_MMA(1, 0, At, B0); PG8_MMA(1, 1, At, B1); PG8_BAR; PG8_SCHED;
        }
        if constexpr (ALIGN_EPI) { if (wr == 0) PG8_BAR; }
        E(acc, cur, wr, wc, fr, fq);
        if (!has_next) break;
#pragma unroll
        for (int a = 0; a < 2; ++a)
#pragma unroll
            for (int b = 0; b < 2; ++b)
#pragma unroll
                for (int m = 0; m < 4; ++m)
#pragma unroll
                    for (int n = 0; n < 2; ++n) acc[a][b][m][n] = (f32x4){0.f, 0.f, 0.f, 0.f};
        cur = nxt; cB = nB; c00 = n00; c01 = n01; c10 = n10; c11 = n11; ++ui; cur.par = ui & 1;
        if constexpr (Epi::HAS_PRE) E.pre(cur);
        if constexpr (ALIGN_EPI) { if (wr == 1) PG8_BAR; }
    }
    PG8_WAIT_V(0);
    if constexpr (!ALIGN_EPI) { if (wr == 0) PG8_BAR; }
    PG8_BAR;
#undef PG8_SA
#undef PG8_SB
#undef PG8_STAGE
#undef PG8_STAGEA
#undef PG8_LDA
#undef PG8_LDB
#undef PG8_MMA
#undef PG8_WAIT_V
#undef PG8_WAIT_L
#undef PG8_BAR
#undef PG8_SCHED
}
}

#define XB_TMO      128
#define XB_XCNT(j)  (256  + 64 * (j))
#define XB_XSUB(j)  (1280 + 64 * (j))
#define XB_XGEN(j)  (2304 + 64 * (j))
#define XB_TOP      3328
#define XB_TOPGEN   3392
#define XCD_BAR_WORDS 3456
#define XB_SPIN_CAP (1u << 18)

__device__ __forceinline__ unsigned xb_ld(unsigned* p)              { return __hip_atomic_load(p, __ATOMIC_RELAXED, __HIP_MEMORY_SCOPE_AGENT); }
__device__ __forceinline__ unsigned xb_add(unsigned* p, unsigned v) { return __hip_atomic_fetch_add(p, v, __ATOMIC_RELAXED, __HIP_MEMORY_SCOPE_AGENT); }
__device__ __forceinline__ unsigned xb_xcc_id() { return (unsigned)__builtin_amdgcn_s_getreg((3 << 11) | 20) & 0xFu; }
#define XB_SPIN(cond, bar) do { unsigned _sp = 0; while (cond) { __builtin_amdgcn_s_sleep(1); \
    if ((++_sp & 255u) == 0u) { if (xb_ld(&(bar)[XB_TMO])) break; if (_sp > XB_SPIN_CAP) { atomicAdd(&(bar)[XB_TMO], 1u); break; } } } } while (0)

struct XcdBarrier {
    unsigned* bar; unsigned x;
    volatile LAS unsigned* st;
};

__device__ __forceinline__ XcdBarrier xcd_barrier_post(unsigned* bar, volatile LAS unsigned* st) {
    XcdBarrier b; b.bar = bar; b.x = xb_xcc_id(); b.st = st;
    if (threadIdx.x == 0) (void)xb_add(&bar[XB_XCNT(b.x)], 1u);
    return b;
}
__device__ __forceinline__ void xcd_barrier_complete(unsigned* bar, unsigned x, unsigned& nloc, unsigned& nx) {
    const unsigned G = gridDim.x * gridDim.y * gridDim.z;
    unsigned sum, cnt, mine, sp = 0u;
    for (;;) {
        sum = 0u; cnt = 0u; mine = 0u;
#pragma unroll
        for (unsigned j = 0; j < 16; ++j) { const unsigned c = xb_ld(&bar[XB_XCNT(j)]); sum += c; cnt += (c > 0u) ? 1u : 0u; mine = (j == x) ? c : mine; }
        if (sum == G) break;
        __builtin_amdgcn_s_sleep(1);
        if ((++sp & 255u) == 0u) { if (xb_ld(&bar[XB_TMO])) break; if (sp > XB_SPIN_CAP) { atomicAdd(&bar[XB_TMO], 1u); break; } }
    }
    nloc = mine > 0u ? mine : 1u; nx = cnt > 0u ? cnt : 1u;
}

__device__ __forceinline__ void xcd_barrier(const XcdBarrier& b) {
    asm volatile("s_waitcnt vmcnt(0)" ::: "memory");
    __syncthreads();
    if (threadIdx.x == 0) {
        unsigned* bar = b.bar;
        __builtin_amdgcn_s_waitcnt(0);
        unsigned nloc = b.st[0], nx = b.st[1];
        if (nloc == 0u) { xcd_barrier_complete(bar, b.x, nloc, nx); b.st[0] = nloc; b.st[1] = nx; }
        const unsigned old = xb_add(&bar[XB_XSUB(b.x)], 1u);
        const unsigned gen = old / nloc;
        if (old + 1u == (gen + 1u) * nloc) {
            __builtin_amdgcn_fence(__ATOMIC_RELEASE, "agent");
            asm volatile("s_waitcnt vmcnt(0)" ::: "memory");
            const unsigned og = xb_add(&bar[XB_TOP], 1u);
            const unsigned tg = og / nx;
            if (og + 1u == (tg + 1u) * nx) xb_add(&bar[XB_TOPGEN], 1u);
            else XB_SPIN(xb_ld(&bar[XB_TOPGEN]) == tg, bar);
            __builtin_amdgcn_fence(__ATOMIC_ACQUIRE, "agent");
            xb_add(&bar[XB_XGEN(b.x)], 1u);
            asm volatile("s_waitcnt vmcnt(0)" ::: "memory");
        } else {
            XB_SPIN(xb_ld(&bar[XB_XGEN(b.x)]) == gen, bar);
            __builtin_amdgcn_fence(__ATOMIC_ACQUIRE, "agent");
            asm volatile("s_waitcnt vmcnt(0)" ::: "memory");
        }
    }
    __syncthreads();
}
struct P {
  const float* x; const float* mix_norm; const float* w_in; const float* gate_bias;
  const float* dq_norm; const float* dk_norm; const float* dlam; const float* dsubln;
  const float* nq_norm; const float* nk_norm; const float* cmp_pe; const float* cmp_w1; const float* cmp_w2;
  const float* w_out;
  const float* rmix; const float* w_r; const float* w_k; const float* w_v;
  const float* w0; const float* w1; const float* w2; const float* a0; const float* a1; const float* a2;
  const float* g1; const float* g2; const float* k_k; const float* k_a; const float* r_k;
  const float* ln_w; const float* ln_b; const float* w_o;
  const float* ffn_norm; const float* rg_w; const float* rg_b; const float* re_w; const float* re_b;
  const float* e_gate; const float* e_up; const float* e_down;
  float* out;
  unsigned char* ws;
  int ph_lo, ph_hi, layer, pad;
};

#define PREF const __attribute__((address_space(4))) P&
__device__ __forceinline__ const __attribute__((address_space(4))) P* opaque_kernarg() { auto q = __builtin_amdgcn_kernarg_segment_ptr(); asm volatile("" : "+s"(q)); return (const __attribute__((address_space(4))) P*)q; }
#define KP (*opaque_kernarg())

constexpr int RING_OFF = 0, RING_BYTES = 131072;
constexpr int LDSCTL_OFF = RING_BYTES, MISC_OFF = LDSCTL_OFF + 320;
constexpr int LDS_BYTES = 147456;
constexpr int NWAVES = 8;

struct Frame {
  LAS unsigned char* lds;
  volatile LAS unsigned* MISC;
  gu32* ctl;
  int tid, lane, wave, vcu, G;
#ifdef PROBE_PH
  unsigned long long pr_t0, pr_t1;
#endif
};
#ifdef PROBE_PH
#define PROBE_MARK(k) do { if ((k) == PROBE_PH) F.pr_t0 = __builtin_amdgcn_s_memrealtime(); if ((k) == PROBE_PH + PROBE_N) F.pr_t1 = __builtin_amdgcn_s_memrealtime(); } while (0)
#else
#define PROBE_MARK(k) do {} while (0)
#endif

__device__ __forceinline__ void transpose_item(const float* W, int ldsrc, int k0, int c0, int ncols, bf16_t* dst, int ldk, int drow0, LAS float* scr, int lane, const float* kscale = nullptr, int kvalid = 1 << 30) {
  const int kr = lane >> 3, c4 = (lane & 7) * 4;
  f32x4 v[8];
#pragma unroll
  for (int i = 0; i < 8; ++i) v[i] = (c4 < ncols && k0 + kr + 8 * i < kvalid) ? __builtin_nontemporal_load((const f32x4*)(W + (size_t)(k0 + kr + 8 * i) * ldsrc + c0 + c4)) : (f32x4){0.f, 0.f, 0.f, 0.f};
  if (kscale) {
#pragma unroll
    for (int i = 0; i < 8; ++i) v[i] = v[i] * kscale[k0 + kr + 8 * i]; }
#pragma unroll
  for (int i = 0; i < 8; ++i) { LAS float* s = scr + (kr + 8 * i) * 33 + c4; s[0] = v[i].x; s[1] = v[i].y; s[2] = v[i].z; s[3] = v[i].w; }
  LDS_WAIT(); asm volatile("" ::: "memory");
  const int c = lane & 7;
#pragma unroll
  for (int j = 0; j < 4; ++j) { const int n = (lane >> 3) + 8 * j; const LAS float* s = scr + (8 * c) * 33 + n;
    v4u o; o.x = pk2(s[0 * 33], s[1 * 33]); o.y = pk2(s[2 * 33], s[3 * 33]); o.z = pk2(s[4 * 33], s[5 * 33]); o.w = pk2(s[6 * 33], s[7 * 33]);
    *(GAS v4u*)(dst + (size_t)(drow0 + n) * ldk + k0 + 8 * c) = o; }
  LDS_WAIT(); asm volatile("" ::: "memory");
}
template <int NR>
__device__ __forceinline__ void rms_rows_load(f32x4 (&v)[NR][4], const float* x, int m0, int stride, int lane) {
#pragma unroll
  for (int r = 0; r < NR; ++r) { const GAS f32x4* xr = (const GAS f32x4*)(x + (size_t)(m0 + r * stride) * DM) + lane;
#pragma unroll
    for (int j = 0; j < 4; ++j) v[r][j] = __builtin_nontemporal_load((const f32x4*)(xr + 64 * j)); }
}
template <int NR>
__device__ __forceinline__ void rms_rows_finish(const f32x4 (&v)[NR][4], const float* gain, bf16_t* o, int m0, int stride, int lane) {
  const GAS f32x4* gr = (const GAS f32x4*)gain + lane;
  f32x4 g[4];
#pragma unroll
  for (int j = 0; j < 4; ++j) g[j] = gr[64 * j];
#pragma unroll
  for (int r = 0; r < NR; ++r) {
    float s = 0.f;
#pragma unroll
    for (int j = 0; j < 4; ++j) s += (v[r][j].x * v[r][j].x + v[r][j].y * v[r][j].y) + (v[r][j].z * v[r][j].z + v[r][j].w * v[r][j].w);
    const float rr = rsqrtf(wave_sum_dpp(s) * (1.f / DM) + 1e-6f);
    GAS v2u* o8 = (GAS v2u*)(o + (size_t)(m0 + r * stride) * DM) + lane;
#pragma unroll
    for (int j = 0; j < 4; ++j) { v2u w; w.x = pk2(v[r][j].x * rr * g[j].x, v[r][j].y * rr * g[j].y); w.y = pk2(v[r][j].z * rr * g[j].z, v[r][j].w * rr * g[j].w); o8[64 * j] = w; }
  }
}
template <int NR>
__device__ __forceinline__ void rms_rows_to_bf16(const float* x, const float* gain, bf16_t* o, int m0, int stride, int lane) {
  f32x4 v[NR][4]; rms_rows_load<NR>(v, x, m0, stride, lane); rms_rows_finish<NR>(v, gain, o, m0, stride, lane);
}

__device__ __forceinline__ void conv_win_item(PREF p, int it, LAS float* scr, int lane) {
  const int vg = it >> 4, kb = it & 15;
  const int pn = vg >> 3, bj = (vg >> 2) & 1, wc = vg & 3, s = pn * 4 + wc;
  int c0 = 0, nc = 0;
  if (s < 44) { c0 = 64 * s + 32 * bj; nc = 32; } else if (s == 44 && bj == 0) { c0 = OFF_NG; nc = 24; }
  transpose_item(p.w_in, INC, kb * 64, c0, nc, (bf16_t*)(p.ws + WS_WIN), DM, vg * 32, scr, lane);
}
__device__ __forceinline__ void conv_sq_item(const float* W, bf16_t* dst, int drow_base, int it, LAS float* scr, int lane) {
  const int cg = it >> 4, kb = it & 15;
  transpose_item(W, DM, kb * 64, cg * 32, 32, dst, DM, drow_base + cg * 32, scr, lane);
}
__device__ __forceinline__ void conv_expert_item(PREF p, int layer, int it, LAS float* scr, int lane, bf16_t* egu) {
  const int e = it / 384, r = it % 384;
  if (r < 256) {
    const int up = r >> 7, q = r & 127, cgp = q >> 4, kb = q & 15;
    const int pn = cgp >> 2, qq = cgp & 3;
    const float* W = (up ? p.e_up : p.e_gate) + ((size_t)layer * 32 + e) * DM * 256;
    transpose_item(W, 256, kb * 64, cgp * 32, 32, egu, DM, e * 512 + pn * 256 + up * 128 + qq * 32, scr, lane, p.ffn_norm + layer * DM);
  } else {
    const int q = r - 256, cg = q >> 2, kb = q & 3;
    const float* W = p.e_down + ((size_t)layer * 32 + e) * 256 * DM;
    transpose_item(W, DM, kb * 64, cg * 32, 32, (bf16_t*)(p.ws + WS_EDN), 256, e * 1024 + cg * 32, scr, lane);
  }
}

using pg8::Unit; using pg8::u32x4; using pg8::pack8;
struct EpiInProj {
  static constexpr bool PERM = true, HAS_PRE = false;
  bf16_t* H; float* GATES; const float* dq; const float* dk; const float* nq; const float* nk; const float* gbias;
  __device__ __forceinline__ void operator()(const f32x4 (&acc)[2][2][4][2], const Unit& u, int wr, int wc, int fr, int fq) const {
    const int s = u.pn * 4 + wc;
    if (s > 44) return;
    const int row0 = u.pm * 256 + wr * 64 + fr;
    if (s == 44) {
      if (fq < 3) {
        f32x4 b0 = *(const f32x4*)(gbias + 8 * fq), b1 = *(const f32x4*)(gbias + 8 * fq + 4);
#pragma unroll
        for (int ai = 0; ai < 2; ++ai)
#pragma unroll
          for (int m = 0; m < 4; ++m) { float* gp = GATES + (size_t)(row0 + ai * 128 + m * 16) * 24 + 8 * fq;
            f32x4 v0 = acc[ai][0][m][0] + b0, v1 = acc[ai][0][m][1] + b1;
#pragma unroll
            for (int i = 0; i < 4; ++i) { v0[i] = sigmoidf_(v0[i]); v1[i] = sigmoidf_(v1[i]); }
            *(f32x4*)gp = v0; *(f32x4*)(gp + 4) = v1; }
      }
      return;
    }
    int mode = 0; const float* gain = nullptr;
    if (s < 8) { mode = 1; gain = dq; } else if (s < 16) { mode = 1; gain = dk; }
    else if (s >= 24 && s < 32) { mode = 2; gain = nq; }
    else if (s >= 32) { const int q = s - 32, br = q >> 2, kv = (q >> 1) & 1; if (kv == 0 && br >= 1) { mode = 2; gain = nk + br * 64; } }
    const float qsc = (s < 8) ? 0.17677669529663687f * 1.4426950408889634f : ((s >= 24 && s < 32) ? 0.125f * 1.4426950408889634f : 1.f);
    f32x4 g[2][2];
#pragma unroll
    for (int bj = 0; bj < 2; ++bj)
#pragma unroll
      for (int n = 0; n < 2; ++n) {
        if (mode == 1) g[bj][n] = *(const f32x4*)(gain + 8 * fq + 4 * n);
        else if (mode == 2) g[bj][n] = *(const f32x4*)(gain + 32 * bj + 8 * fq + 4 * n);
        else g[bj][n] = (f32x4){1.f, 1.f, 1.f, 1.f};
      }
#pragma unroll
    for (int ai = 0; ai < 2; ++ai)
#pragma unroll
      for (int m = 0; m < 4; ++m) {
        float sc[2] = {1.f, 1.f};
        if (mode != 0) {
          float ss[2];
#pragma unroll
          for (int bj = 0; bj < 2; ++bj) { const f32x4 a = acc[ai][bj][m][0], b = acc[ai][bj][m][1];
            float t = (a[0] * a[0] + a[1] * a[1]) + (a[2] * a[2] + a[3] * a[3]) + (b[0] * b[0] + b[1] * b[1]) + (b[2] * b[2] + b[3] * b[3]);
            ss[bj] = sum_x16_32(t); }
          if (mode == 1) { sc[0] = rsqrtf(ss[0] * (1.f / 32.f) + 1e-6f) * qsc; sc[1] = rsqrtf(ss[1] * (1.f / 32.f) + 1e-6f) * qsc; }
          else { const float r = rsqrtf((ss[0] + ss[1]) * (1.f / 64.f) + 1e-6f) * qsc; sc[0] = r; sc[1] = r; }
        }
        bf16_t* rowp = H + (size_t)(row0 + ai * 128 + m * 16) * HC + 64 * s + 8 * fq;
#pragma unroll
        for (int bj = 0; bj < 2; ++bj) { const f32x4 v0 = acc[ai][bj][m][0] * sc[bj] * g[bj][0], v1 = acc[ai][bj][m][1] * sc[bj] * g[bj][1];
          *(u32x4*)(rowp + 32 * bj) = pack8(v0, v1); }
      }
  }
};
struct EpiResid {
  static constexpr bool PERM = true, HAS_PRE = false;
  const float* xf; const bf16_t* xb; bf16_t* out; const bf16_t* y1;
  __device__ __forceinline__ void operator()(const f32x4 (&acc)[2][2][4][2], const Unit& u, int wr, int wc, int fr, int fq) const {
    const int row0 = u.pm * 256 + wr * 64 + fr, col0 = u.pn * 256 + wc * 32 + 8 * fq;
#pragma unroll
    for (int ai = 0; ai < 2; ++ai)
#pragma unroll
      for (int mp = 0; mp < 2; ++mp) {
        f32x4 b0[2][2], b1[2][2];
#pragma unroll
        for (int mm = 0; mm < 2; ++mm) { const size_t off = (size_t)(row0 + ai * 128 + (2 * mp + mm) * 16) * DM + col0;
#pragma unroll
          for (int bj = 0; bj < 2; ++bj) {
            if (xf) { b0[mm][bj] = __builtin_nontemporal_load((const f32x4*)(xf + off + bj * 128)); b1[mm][bj] = __builtin_nontemporal_load((const f32x4*)(xf + off + bj * 128 + 4)); }
            else { const v4u w = __builtin_nontemporal_load((const v4u*)(xb + off + bj * 128));
              b0[mm][bj] = (f32x4){__uint_as_float(w.x << 16), __uint_as_float(w.x & 0xffff0000u), __uint_as_float(w.y << 16), __uint_as_float(w.y & 0xffff0000u)};
              b1[mm][bj] = (f32x4){__uint_as_float(w.z << 16), __uint_as_float(w.z & 0xffff0000u), __uint_as_float(w.w << 16), __uint_as_float(w.w & 0xffff0000u)}; }
            if (y1) { const v4u w = __builtin_nontemporal_load((const v4u*)(y1 + off + bj * 128));
              b0[mm][bj] += (f32x4){__uint_as_float(w.x << 16), __uint_as_float(w.x & 0xffff0000u), __uint_as_float(w.y << 16), __uint_as_float(w.y & 0xffff0000u)};
              b1[mm][bj] += (f32x4){__uint_as_float(w.z << 16), __uint_as_float(w.z & 0xffff0000u), __uint_as_float(w.w << 16), __uint_as_float(w.w & 0xffff0000u)}; } } }
#pragma unroll
        for (int mm = 0; mm < 2; ++mm) { const int m = 2 * mp + mm; const size_t off = (size_t)(row0 + ai * 128 + m * 16) * DM + col0;
#pragma unroll
          for (int bj = 0; bj < 2; ++bj) *(u32x4*)(out + off + bj * 128) = pack8(b0[mm][bj] + acc[ai][bj][m][0], b1[mm][bj] + acc[ai][bj][m][1]); }
        asm volatile("" ::: "memory");
      }
  }
};
struct EpiRKV {
  static constexpr bool PERM = true, HAS_PRE = false;
  unsigned char* ws;
  __device__ __forceinline__ void operator()(const f32x4 (&acc)[2][2][4][2], const Unit& u, int wr, int wc, int fr, int fq) const {
    const int gi = u.pm >> 6;
    bf16_t* O = (bf16_t*)(ws + WS_S0 + (size_t)(3 + gi) * SLOT);
    const int row0 = (u.pm & 63) * 256 + wr * 64 + fr, col0 = (u.pn & 3) * 256 + wc * 32 + 8 * fq;
#pragma unroll
    for (int ai = 0; ai < 2; ++ai)
#pragma unroll
      for (int m = 0; m < 4; ++m) { bf16_t* rowp = O + (size_t)(row0 + ai * 128 + m * 16) * DM + col0;
#pragma unroll
        for (int bj = 0; bj < 2; ++bj) *(u32x4*)(rowp + bj * 128) = pack8(acc[ai][bj][m][0], acc[ai][bj][m][1]); }
  }
};
struct EpiLora1 {
  static constexpr bool PERM = true, HAS_PRE = false;
  bf16_t* TMP;
  template <int BJ>
  __device__ __forceinline__ void half(const f32x4 (&acc)[2][2][4][2], int gi, int row0, int wc, int fq) const {
    const int c = BJ * 128 + wc * 32 + 8 * fq;
    const bool skip = (gi < 2) && (c >= 64);
    const int dcol = (gi < 2) ? gi * 64 + c : 128 + c;
    const bool zero = (gi == 2) && (c >= 160);
    if (skip) return;
#pragma unroll
    for (int ai = 0; ai < 2; ++ai)
#pragma unroll
      for (int m = 0; m < 4; ++m) {
        f32x4 v0 = acc[ai][BJ][m][0], v1 = acc[ai][BJ][m][1];
#pragma unroll
        for (int i = 0; i < 4; ++i) {
          if (gi == 0) { v0[i] = tanhf_(v0[i]); v1[i] = tanhf_(v1[i]); }
          else if (gi == 2) { v0[i] = zero ? 0.f : sigmoidf_(v0[i]); v1[i] = zero ? 0.f : sigmoidf_(v1[i]); }
        }
        *(u32x4*)(TMP + (size_t)(row0 + ai * 128 + m * 16) * 384 + dcol) = pack8(v0, v1);
      }
  }
  __device__ __forceinline__ void operator()(const f32x4 (&acc)[2][2][4][2], const Unit& u, int wr, int wc, int fr, int fq) const {
    const int gi = u.pm >> 6;
    const int row0 = (u.pm & 63) * 256 + wr * 64 + fr;
    half<0>(acc, gi, row0, wc, fq);
    half<1>(acc, gi, row0, wc, fq);
  }
};
struct EpiLora2 {
  static constexpr bool PERM = true, HAS_PRE = false;
  unsigned char* ws; const float* w0; const float* a0; int gbase;
  __device__ __forceinline__ void operator()(const f32x4 (&acc)[2][2][4][2], const Unit& u, int wr, int wc, int fr, int fq) const {
    const int gi = gbase + (u.pn >> 2);
    bf16_t* O = (bf16_t*)(ws + WS_S0 + (size_t)gi * SLOT);
    const int row0 = u.pm * 256 + wr * 64 + fr, col0 = (u.pn & 3) * 256 + wc * 32 + 8 * fq;
    f32x4 b[2][2];
#pragma unroll
    for (int bj = 0; bj < 2; ++bj)
#pragma unroll
      for (int n = 0; n < 2; ++n) b[bj][n] = (gi == 0) ? *(const f32x4*)(w0 + col0 + bj * 128 + 4 * n) : (gi == 1 ? *(const f32x4*)(a0 + col0 + bj * 128 + 4 * n) : (f32x4){0.f, 0.f, 0.f, 0.f});
#pragma unroll
    for (int ai = 0; ai < 2; ++ai)
#pragma unroll
      for (int m = 0; m < 4; ++m) { bf16_t* rowp = O + (size_t)(row0 + ai * 128 + m * 16) * DM + col0;
#pragma unroll
        for (int bj = 0; bj < 2; ++bj) { f32x4 v0 = acc[ai][bj][m][0] + b[bj][0], v1 = acc[ai][bj][m][1] + b[bj][1];
          if (gi == 0) {
#pragma unroll
            for (int i = 0; i < 4; ++i) { v0[i] = -__expf(-softplusf_(-v0[i]) - 0.5f); v1[i] = -__expf(-softplusf_(-v1[i]) - 0.5f); }
          } else if (gi == 1) {
#pragma unroll
            for (int i = 0; i < 4; ++i) { v0[i] = sigmoidf_(v0[i]); v1[i] = sigmoidf_(v1[i]); }
          }
          *(u32x4*)(rowp + bj * 128) = pack8(v0, v1); } }
  }
};
struct EpiMoeGU {
  static constexpr bool PERM = true, HAS_PRE = true;
  bf16_t* HID; const int* list; const float* RS; LAS float* rsl;
  __device__ __forceinline__ void pre(const Unit& u) const {
    const int r = threadIdx.x;
    if (r < 256) rsl[u.par * 256 + r] = RS[list[(size_t)u.e * CAP + u.rt * 256 + ((r < u.nrows) ? r : 0)] >> 1];
  }
  __device__ __forceinline__ void operator()(const f32x4 (&acc)[2][2][4][2], const Unit& u, int wr, int wc, int fr, int fq) const {
    const int row0 = u.pm * 256 + wr * 64 + fr, col0 = (u.pn & 1) * 128 + wc * 32 + 8 * fq;
#pragma unroll
    for (int ai = 0; ai < 2; ++ai)
#pragma unroll
      for (int m = 0; m < 4; ++m) {
        const float rs = rsl[u.par * 256 + wr * 64 + fr + ai * 128 + m * 16];
        f32x4 h[2];
#pragma unroll
        for (int n = 0; n < 2; ++n) { const f32x4 g = acc[ai][0][m][n] * rs, up = acc[ai][1][m][n] * rs;
#pragma unroll
          for (int i = 0; i < 4; ++i) h[n][i] = g[i] * sigmoidf_(g[i]) * up[i]; }
        *(u32x4*)(HID + (size_t)(row0 + ai * 128 + m * 16) * 256 + col0) = pack8(h[0], h[1]);
      }
  }
};
struct EpiMoeDown {
  static constexpr bool PERM = true, HAS_PRE = true;
  bf16_t* out; bf16_t* Y1; const int* list; const float* pgate; LAS int* ept;
  __device__ __forceinline__ void pre(const Unit& u) const {
    const int r = threadIdx.x;
    if (r < 256) { int pr = -1; float gt = 0.f;
      if (r < u.nrows) { pr = list[(size_t)u.e * CAP + u.rt * 256 + r]; gt = pgate[pr]; }
      LAS int* e = ept + (u.par * 256 + r) * 2; e[0] = pr; e[1] = __float_as_int(gt); }
  }
  __device__ __forceinline__ void operator()(const f32x4 (&acc)[2][2][4][2], const Unit& u, int wr, int wc, int fr, int fq) const {
    const int col0 = (u.pn & 3) * 256 + wc * 32 + 8 * fq;
#pragma unroll
    for (int ai = 0; ai < 2; ++ai)
#pragma unroll
      for (int m = 0; m < 4; ++m) {
        const int r = ai * 128 + wr * 64 + m * 16 + fr;
        const LAS int* e = ept + (u.par * 256 + r) * 2;
        const int pr = e[0]; const float gt = __int_as_float(e[1]);
        if (pr >= 0) {
          const int tok = pr >> 1;
          if ((pr & 1) == 0) {
            bf16_t* op = out + (size_t)tok * DM + col0;
#pragma unroll
            for (int bj = 0; bj < 2; ++bj) { const u32x4 w = *(const u32x4*)(op + bj * 128);
              const f32x4 b0 = {__uint_as_float(w.x << 16), __uint_as_float(w.x & 0xffff0000u), __uint_as_float(w.y << 16), __uint_as_float(w.y & 0xffff0000u)};
              const f32x4 b1 = {__uint_as_float(w.z << 16), __uint_as_float(w.z & 0xffff0000u), __uint_as_float(w.w << 16), __uint_as_float(w.w & 0xffff0000u)};
              *(u32x4*)(op + bj * 128) = pack8(b0 + acc[ai][bj][m][0] * gt, b1 + acc[ai][bj][m][1] * gt); }
          } else {
            bf16_t* yp = Y1 + (size_t)tok * DM + col0;
#pragma unroll
            for (int bj = 0; bj < 2; ++bj) *(u32x4*)(yp + bj * 128) = pack8(acc[ai][bj][m][0] * gt, acc[ai][bj][m][1] * gt);
          }
        }
      }
  }
};

typedef LAS bf16_t* lbf;
__device__ __forceinline__ void phase_prologue(PREF p, Frame& F) {
  const int lane = fresh_lane();
  LAS float* scr = (LAS float*)(F.lds + RING_OFF + F.wave * 16384);
  const int gw = F.vcu * NWAVES + F.wave, NGW = F.G * NWAVES;
  constexpr int I_WIN = 96 * 16, I_SQ = 32 * 16;
  constexpr int I_L1 = 9 * 16, I_L2 = 64, I_L2G = 96;
  constexpr int NITEMS = I_WIN + 5 * I_SQ + 128 + I_L1 + I_L2 + I_L2G;
  for (int it = gw; it < NITEMS; it += NGW) {
    int r = it;
    if (r < I_WIN) { conv_win_item(p, r, scr, fresh_lane()); continue; } r -= I_WIN;
    if (r < I_SQ) { conv_sq_item(p.w_out, (bf16_t*)(p.ws + WS_WOUT), 0, r, scr, fresh_lane()); continue; } r -= I_SQ;
    if (r < I_SQ) { conv_sq_item(p.w_r, (bf16_t*)(p.ws + WS_WRKV), 0, r, scr, fresh_lane()); continue; } r -= I_SQ;
    if (r < I_SQ) { conv_sq_item(p.w_k, (bf16_t*)(p.ws + WS_WRKV), 1024, r, scr, fresh_lane()); continue; } r -= I_SQ;
    if (r < I_SQ) { conv_sq_item(p.w_v, (bf16_t*)(p.ws + WS_WRKV), 2048, r, scr, fresh_lane()); continue; } r -= I_SQ;
    if (r < I_SQ) { conv_sq_item(p.w_o, (bf16_t*)(p.ws + WS_WO), 0, r, scr, fresh_lane()); continue; } r -= I_SQ;
    if (r < 128) { const int kv = r >> 6, q = r & 63, kb = q >> 1, cg = q & 1;
      transpose_item(p.cmp_w1 + (size_t)kv * 2048 * 64, 64, kb * 64, cg * 32, 32, (bf16_t*)(p.ws + WS_CW1) + (size_t)kv * 64 * 2048, 2048, cg * 32, scr, fresh_lane()); continue; } r -= 128;
    if (r < I_L1) { const int cgid = r >> 4, kb = r & 15;
      const float* W = (cgid < 2) ? p.w1 : (cgid < 4) ? p.a1 : p.g1; const int ld = (cgid < 4) ? 64 : 160;
      const int c0 = (cgid < 2) ? 32 * cgid : (cgid < 4) ? 32 * (cgid - 2) : 32 * (cgid - 4), drow = ((cgid < 2) ? 0 : (cgid < 4) ? 256 : 512) + c0;
      transpose_item(W, ld, kb * 64, c0, 32, (bf16_t*)(p.ws + WS_WL1), DM, drow, scr, fresh_lane()); continue; } r -= I_L1;
    if (r < I_L2) { const int tsel = r >> 5, cg = r & 31;
      transpose_item(tsel ? p.a2 : p.w2, 1024, 0, cg * 32, 32, (bf16_t*)(p.ws + WS_WL2 + (size_t)tsel * 128 * 1024), 64, cg * 32, scr, fresh_lane()); continue; } r -= I_L2;
    { const int cg = r / 3, kb = r - cg * 3;
      transpose_item(p.g2, 1024, kb * 64, cg * 32, 32, (bf16_t*)(p.ws + WS_WL2 + 256 * 1024), 192, cg * 32, scr, fresh_lane(), nullptr, 160); }
  }
  {
    const int gt = (F.vcu * NWAVES + F.wave) * 64 + fresh_lane(), NGT = NGW * 64;
    { v4u* WL1z = (v4u*)(p.ws + WS_WL1);
      for (int i = gt; i < 768 * 128; i += NGT) { const int row = i >> 7, gi = row >> 8, c = row & 255; if (c >= ((gi < 2) ? 64 : 160)) WL1z[i] = (v4u){0u, 0u, 0u, 0u}; } }
    bf16_t* WR = (bf16_t*)(p.ws + WS_WR);
    for (int i = gt; i < 2 * 48 * 1024; i += NGT) {
      const int layer = i / (48 * 1024), rem = i - layer * 48 * 1024, n = rem >> 10, k = rem & 1023;
      float wv = 0.f;
      if (n < 4) wv = p.rg_w[(size_t)layer * DM * 4 + k * 4 + n]; else if (n < 36) wv = p.re_w[(size_t)layer * DM * 32 + k * 32 + (n - 4)];
      wv *= p.ffn_norm[layer * DM + k];
      const unsigned h = f2bf(wv); const float r1 = wv - __uint_as_float(h << 16);
      const unsigned m = f2bf(r1); const float r2 = r1 - __uint_as_float(m << 16);
      const unsigned l = f2bf(r2);
      bf16_t* o = WR + (size_t)layer * 144 * 1024 + (size_t)n * 1024 + k;
      o[0] = (bf16_t)h; o[48 * 1024] = (bf16_t)m; o[96 * 1024] = (bf16_t)l;
    }
  }
  bf16_t* XN = (bf16_t*)(p.ws + WS_XN);
  for (int m = gw; m < T_TOK; m += 4 * NGW) rms_rows_to_bf16<4>(p.x, p.mix_norm, XN, m, NGW, lane);
}


__device__ __forceinline__ void up8(const v4u w, float (&o)[8]) {
  o[0] = __uint_as_float(w.x << 16); o[1] = __uint_as_float(w.x & 0xffff0000u); o[2] = __uint_as_float(w.y << 16); o[3] = __uint_as_float(w.y & 0xffff0000u);
  o[4] = __uint_as_float(w.z << 16); o[5] = __uint_as_float(w.z & 0xffff0000u); o[6] = __uint_as_float(w.w << 16); o[7] = __uint_as_float(w.w & 0xffff0000u);
}
__device__ __forceinline__ f32x4 bf4(const v2u w) { return (f32x4){__uint_as_float(w.x << 16), __uint_as_float(w.x & 0xffff0000u), __uint_as_float(w.y << 16), __uint_as_float(w.y & 0xffff0000u)}; }
__device__ __forceinline__ void phase_router(PREF p, Frame& F, int layer) {
  const int gw = F.vcu * NWAVES + F.wave, NGW = F.G * NWAVES;
  const int lane = fresh_lane();
  PROBE_MARK(100 + layer * 10);
  {
    LAS float* scr = (LAS float*)(F.lds + RING_OFF + F.wave * 16384);
    for (int it = gw; it < 32 * 384; it += NGW) conv_expert_item(p, layer, it, scr, lane, (bf16_t*)(p.ws + WS_EGU));
  }
  __syncthreads();
  PROBE_MARK(101 + layer * 10);
  constexpr int WQP = 264;
  const lbf WQ = (lbf)(F.lds);
  LAS float* SSP = (LAS float*)(F.lds + 80 * 1024);
  LAS float* LGP = (LAS float*)(F.lds + 81 * 1024);
  const int w = F.wave, par = w & 1, tk = lane & 15, kg = lane >> 4;
  const bf16_t* xres = layer ? (const bf16_t*)(p.ws + WS_X3) : (const bf16_t*)p.out;
  const int tok = F.vcu * 64 + (w >> 1) * 16 + tk;
  bf16x8 xf[4][4];
  { const bf16_t* xr = xres + (size_t)tok * DM + 128 * par + 8 * kg;
#pragma unroll
    for (int j = 0; j < 4; ++j)
#pragma unroll
      for (int s = 0; s < 4; ++s) xf[j][s] = *(const GAS bf16x8*)(xr + 256 * j + 32 * s); }
  {
    float ss = 0.f;
#pragma unroll
    for (int j = 0; j < 4; ++j)
#pragma unroll
      for (int s = 0; s < 4; ++s) { float f[8]; up8(__builtin_bit_cast(v4u, xf[j][s]), f);
#pragma unroll
        for (int i = 0; i < 8; ++i) ss += f[i] * f[i]; }
    ss += __shfl_xor(ss, 16, 64); ss += __shfl_xor(ss, 32, 64);
    if (kg == 0) SSP[w * 16 + tk] = ss;
  }
  PROBE_MARK(102 + layer * 10);
  f32x4 acc[9];
#pragma unroll
  for (int nt = 0; nt < 9; ++nt) acc[nt] = (f32x4){0.f, 0.f, 0.f, 0.f};
  const bf16_t* WRl = (const bf16_t*)(p.ws + WS_WR) + (size_t)layer * 144 * 1024;
  float rs = 0.f;
#pragma unroll
  for (int j = 0; j < 4; ++j) {
    __syncthreads();
#pragma unroll
    for (int i = 0; i < 9; ++i) { const int idx = F.tid + i * 512, row = idx >> 5, pc = idx & 31;
      *(LAS v4u*)(WQ + row * WQP + pc * 8) = *(const GAS v4u*)(WRl + (size_t)row * 1024 + 256 * j + pc * 8); }
    __syncthreads();
    if (j == 0) {
      rs = rsqrtf((SSP[(w & ~1) * 16 + tk] + SSP[(w | 1) * 16 + tk]) * (1.f / DM) + 1e-6f);
      if (par == 0 && kg == 0) ((float*)(p.ws + WS_RS))[tok] = rs;
    }
#pragma unroll
    for (int s = 0; s < 4; ++s)
#pragma unroll
      for (int nt = 0; nt < 9; ++nt) {
        const bf16x8 a = *(const LAS bf16x8*)(WQ + (nt * 16 + tk) * WQP + 128 * par + 32 * s + 8 * kg);
        acc[nt] = __builtin_amdgcn_mfma_f32_16x16x32_bf16(a, xf[j][s], acc[nt], 0, 0, 0);
      }
  }
  PROBE_MARK(103 + layer * 10);
#pragma unroll
  for (int nt = 0; nt < 3; ++nt)
#pragma unroll
    for (int i = 0; i < 4; ++i) { const int n = nt * 16 + 4 * kg + i;
      if (n < 36) LGP[(w * 16 + tk) * 36 + n] = ((acc[6 + nt][i] + acc[3 + nt][i]) + acc[nt][i]) * rs; }
  LAS unsigned* LC = (LAS unsigned*)(F.lds + 118784);
  if (F.tid < 64) LC[F.tid] = 0u;
  __syncthreads();
  int ea = 0, eb = 0; unsigned la = 0, lb = 0; float ga = 0.f, gb = 0.f;
  if (lane < 8) {
    const LAS float* lg0 = LGP + ((w & ~1) * 16 + par * 8 + lane) * 36; const LAS float* lg1 = LGP + ((w | 1) * 16 + par * 8 + lane) * 36;
    const float* bg = p.rg_b + layer * 4;
    const float* be = p.re_b + layer * 32;
    float gl[4]; int gi = 0; float gm = -3.4e38f;
#pragma unroll
    for (int i = 0; i < 4; i++) { gl[i] = (lg0[i] + lg1[i]) + bg[i]; if (gl[i] > gm) { gm = gl[i]; gi = i; } }
    float gs = 0.f;
#pragma unroll
    for (int i = 0; i < 4; i++) gs += __expf(gl[i] - gm);
    const float grp_p = 1.f / gs;
    float v0 = -3.4e38f, v1 = -3.4e38f; int i0 = 0, i1 = 0;
    for (int i = 0; i < 8; i++) {
      const float v = (lg0[4 + gi * 8 + i] + lg1[4 + gi * 8 + i]) + be[gi * 8 + i];
      if (v > v0) { v1 = v0; i1 = i0; v0 = v; i0 = i; }
      else if (v > v1) { v1 = v; i1 = i; }
    }
    const float e1 = __expf(v1 - v0);
    ga = grp_p / (1.f + e1); gb = grp_p * e1 / (1.f + e1);
    ea = gi * 8 + i0; eb = gi * 8 + i1;
    la = __hip_atomic_fetch_add(LC + ea, 1u, __ATOMIC_RELAXED, __HIP_MEMORY_SCOPE_WORKGROUP);
    lb = __hip_atomic_fetch_add(LC + eb, 1u, __ATOMIC_RELAXED, __HIP_MEMORY_SCOPE_WORKGROUP);
  }
  __syncthreads();
  if (F.tid < 32) { const unsigned n = LC[F.tid];
    unsigned* cnt = (unsigned*)(p.ws + WS_CTL) + CW_CNT + (layer * 32 + F.tid) * 64;
    LC[32 + F.tid] = n ? __hip_atomic_fetch_add(cnt, n, __ATOMIC_RELAXED, __HIP_MEMORY_SCOPE_AGENT) : 0u; }
  __syncthreads();
  if (lane < 8) {
    const int t = gw * 8 + lane;
    int* list = (int*)(p.ws + WS_LIST); float* pgate = (float*)(p.ws + WS_PGATE);
    list[(size_t)ea * CAP + LC[32 + ea] + la] = 2 * t; pgate[2 * t] = ga;
    list[(size_t)eb * CAP + LC[32 + eb] + lb] = 2 * t + 1; pgate[2 * t + 1] = gb;
  }
  PROBE_MARK(104 + layer * 10);
}

__device__ __forceinline__ void phase_final(PREF p, Frame& F) {
  const int gw = F.vcu * NWAVES + F.wave, NGW = F.G * NWAVES;
  const int lane = fresh_lane();
  const bf16_t* Y1 = (const bf16_t*)(p.ws + WS_Y1);
  const bf16_t* X3 = (const bf16_t*)(p.ws + WS_X3);
  for (int t = gw; t < T_TOK; t += NGW) {
    GAS f32x4* xo = (GAS f32x4*)(p.out + (size_t)t * DM) + lane;
    const GAS v2u* xr = (const GAS v2u*)(X3 + (size_t)t * DM) + lane;
    const GAS v2u* yr = (const GAS v2u*)(Y1 + (size_t)t * DM) + lane;
#pragma unroll
    for (int j = 0; j < 4; ++j) xo[64 * j] = bf4(__builtin_nontemporal_load((const v2u*)(xr + 64 * j))) + bf4(__builtin_nontemporal_load((const v2u*)(yr + 64 * j)));
  }
}

__device__ __forceinline__ void phase_rwkv_prep(PREF p, Frame& F) {
  const int gw = F.vcu * NWAVES + F.wave, NGW = F.G * NWAVES;
  const int lane = fresh_lane();
  const float* gain = p.mix_norm + DM;
  const bf16_t* X1 = (const bf16_t*)p.out;
  const bf16_t* Y1 = (const bf16_t*)(p.ws + WS_Y1);
  float g[2][8];
#pragma unroll
  for (int c = 0; c < 2; ++c) { const f32x4 a = *(const GAS f32x4*)(gain + c * 512 + lane * 8), b = *(const GAS f32x4*)(gain + c * 512 + lane * 8 + 4);
    g[c][0] = a.x; g[c][1] = a.y; g[c][2] = a.z; g[c][3] = a.w; g[c][4] = b.x; g[c][5] = b.y; g[c][6] = b.z; g[c][7] = b.w; }
  for (int run = gw; run < T_TOK / 8; run += NGW) {
    const int t0 = run * 8;
    float prev[2][8];
    if ((t0 & (SEQ - 1)) == 0) {
#pragma unroll
      for (int c = 0; c < 2; ++c)
#pragma unroll
        for (int i = 0; i < 8; ++i) prev[c][i] = 0.f;
    } else {
      float s = 0.f;
#pragma unroll
      for (int c = 0; c < 2; ++c) { float xa[8], ya[8];
        up8(__builtin_nontemporal_load((const v4u*)(X1 + (size_t)(t0 - 1) * DM + c * 512 + lane * 8)), xa); up8(__builtin_nontemporal_load((const v4u*)(Y1 + (size_t)(t0 - 1) * DM + c * 512 + lane * 8)), ya);
#pragma unroll
        for (int i = 0; i < 8; ++i) { prev[c][i] = xa[i] + ya[i]; s += prev[c][i] * prev[c][i]; } }
      const float r = rsqrtf(wave_sum_dpp(s) * (1.f / DM) + 1e-6f);
#pragma unroll
      for (int c = 0; c < 2; ++c)
#pragma unroll
        for (int i = 0; i < 8; ++i) prev[c][i] *= r * g[c][i];
    }
    v4u nx[2], ny[2];
#pragma unroll
    for (int c = 0; c < 2; ++c) { nx[c] = __builtin_nontemporal_load((const v4u*)(X1 + (size_t)t0 * DM + c * 512 + lane * 8)); ny[c] = __builtin_nontemporal_load((const v4u*)(Y1 + (size_t)t0 * DM + c * 512 + lane * 8)); }
#pragma unroll 1
    for (int tt = 0; tt < 8; ++tt) {
      const int t = t0 + tt;
      float v[2][8]; float s = 0.f;
#pragma unroll
      for (int c = 0; c < 2; ++c) { float xa[8], ya[8]; up8(nx[c], xa); up8(ny[c], ya);
#pragma unroll
        for (int i = 0; i < 8; ++i) { v[c][i] = xa[i] + ya[i]; s += v[c][i] * v[c][i]; } }
      if (tt < 7) {
#pragma unroll
        for (int c = 0; c < 2; ++c) { nx[c] = __builtin_nontemporal_load((const v4u*)(X1 + (size_t)(t + 1) * DM + c * 512 + lane * 8)); ny[c] = __builtin_nontemporal_load((const v4u*)(Y1 + (size_t)(t + 1) * DM + c * 512 + lane * 8)); } }
      const float r = rsqrtf(wave_sum_dpp(s) * (1.f / DM) + 1e-6f);
#pragma unroll
      for (int c = 0; c < 2; ++c)
#pragma unroll
        for (int i = 0; i < 8; ++i) v[c][i] *= r * g[c][i];
#pragma unroll
      for (int sl = 0; sl < 6; ++sl) {
        const int mj = (sl == 0) ? 0 : (sl == 1) ? 2 : (sl == 2) ? 3 : (sl == 3) ? 1 : (sl == 4) ? 4 : 5;
        bf16_t* o = (bf16_t*)(p.ws + WS_S0 + (size_t)sl * SLOT) + (size_t)t * DM;
#pragma unroll
        for (int c = 0; c < 2; ++c) {
          const f32x4 ma = *(const GAS f32x4*)(p.rmix + mj * DM + c * 512 + lane * 8), mb = *(const GAS f32x4*)(p.rmix + mj * DM + c * 512 + lane * 8 + 4);
          const float mx[8] = {ma.x, ma.y, ma.z, ma.w, mb.x, mb.y, mb.z, mb.w};
          float q[8];
#pragma unroll
          for (int i = 0; i < 8; ++i) q[i] = v[c][i] + (prev[c][i] - v[c][i]) * mx[i];
          v4u w; w.x = pk2(q[0], q[1]); w.y = pk2(q[2], q[3]); w.z = pk2(q[4], q[5]); w.w = pk2(q[6], q[7]);
          *(GAS v4u*)(o + c * 512 + lane * 8) = w;
        }
      }
#pragma unroll
      for (int c = 0; c < 2; ++c)
#pragma unroll
        for (int i = 0; i < 8; ++i) prev[c][i] = v[c][i];
    }
  }
}

constexpr int RP = 72;
constexpr int RB = 64 * RP * 2;

__device__ __forceinline__ f32x4 mm16(f32x4 acc, const LAS bf16_t* A, int arow0, const LAS bf16_t* Bt, int brow0, int lane) {
  const int r = lane & 15, q = lane >> 4;
#pragma unroll
  for (int ks = 0; ks < 2; ++ks) {
    const bf16x8 a = *(const LAS bf16x8*)(A + (arow0 + r) * RP + ks * 32 + q * 8);
    const bf16x8 b = *(const LAS bf16x8*)(Bt + (brow0 + r) * RP + ks * 32 + q * 8);
    acc = __builtin_amdgcn_mfma_f32_16x16x32_bf16(a, b, acc, 0, 0, 0);
  }
  return acc;
}
__device__ __forceinline__ float sum8(float v) { return sum8_dpp(v); }
__device__ __forceinline__ void ld8bf(const bf16_t* p, float (&o)[8]) {
  const v4u w = *(const GAS v4u*)p;
  o[0] = __uint_as_float(w.x << 16); o[1] = __uint_as_float(w.x & 0xffff0000u); o[2] = __uint_as_float(w.y << 16); o[3] = __uint_as_float(w.y & 0xffff0000u);
  o[4] = __uint_as_float(w.z << 16); o[5] = __uint_as_float(w.z & 0xffff0000u); o[6] = __uint_as_float(w.w << 16); o[7] = __uint_as_float(w.w & 0xffff0000u);
}
__device__ __forceinline__ v4u pk8(const float (&o)[8]) { v4u w; w.x = pk2(o[0], o[1]); w.y = pk2(o[2], o[3]); w.z = pk2(o[4], o[5]); w.w = pk2(o[6], o[7]); return w; }

#define R1_BAR() do { asm volatile("s_waitcnt lgkmcnt(0)" ::: "memory"); __builtin_amdgcn_s_barrier(); asm volatile("" ::: "memory"); } while (0)
__device__ __forceinline__ void stT(LAS bf16_t* Dst, int x0, int y0, const f32x4& acc, int lane) {
  v2u w; w.x = pk2(acc[0], acc[1]); w.y = pk2(acc[2], acc[3]);
  *(LAS v2u*)(Dst + (x0 + (lane & 15)) * RP + y0 + (lane >> 4) * 4) = w;
}
struct R1In { v4u r, k, v; bf16x8 tw[2], ta[2]; };
struct R1W { bf16x8 ww[2][2], wa[2][2]; float bw[2], ba[2]; f32x4 kk0, kk1, ka0, ka1, rk0, rk1; };
__device__ __forceinline__ R1In rwkv_r1_load(PREF p, int item, int tid) {
  const int hd = item & 15, c = (item >> 4) & 63, b = item >> 10, ch = b * 16 + hd;
  const size_t off = ((size_t)(b * SEQ + c * 64 + (tid >> 3)) * DM + hd * 64 + (tid & 7) * 8);
  const bf16_t* s0 = (const bf16_t*)(p.ws + WS_S0);
  R1In in;
  in.r = *(const GAS v4u*)(s0 + 3 * (SLOT / 2) + off); in.k = *(const GAS v4u*)(s0 + 4 * (SLOT / 2) + off); in.v = *(const GAS v4u*)(s0 + 5 * (SLOT / 2) + off);
  { const int lane = tid & 63, wv = tid >> 6;
    const bf16_t* tg = (const bf16_t*)(p.ws + WS_TMP) + (size_t)(b * SEQ + c * 64 + 16 * (wv & 3) + (lane & 15)) * 384 + (lane >> 4) * 8;
#pragma unroll
    for (int ks = 0; ks < 2; ++ks) { in.tw[ks] = *(const GAS bf16x8*)(tg + ks * 32); in.ta[ks] = *(const GAS bf16x8*)(tg + 64 + ks * 32); } }
  return in;
}
__device__ __forceinline__ void un8(const v4u w, float (&o)[8]) {
  o[0] = __uint_as_float(w.x << 16); o[1] = __uint_as_float(w.x & 0xffff0000u); o[2] = __uint_as_float(w.y << 16); o[3] = __uint_as_float(w.y & 0xffff0000u);
  o[4] = __uint_as_float(w.z << 16); o[5] = __uint_as_float(w.z & 0xffff0000u); o[6] = __uint_as_float(w.w << 16); o[7] = __uint_as_float(w.w & 0xffff0000u);
}
__device__ __forceinline__ void rwkv_r1_item(PREF p, Frame& F, int item, const R1In& in, const R1W& W2) {
  const int tid = F.tid, lane = fresh_lane(), w = F.wave;
  const int hd = item & 15, c = (item >> 4) & 63, b = item >> 10, ch = b * 16 + hd;
  const size_t tile0 = ((size_t)(b * SEQ + c * 64) * DM + hd * 64);
  unsigned char* ws = p.ws;
  bf16_t* SL[6];
#pragma unroll
  for (int s = 0; s < 6; ++s) SL[s] = (bf16_t*)(ws + WS_S0 + (size_t)s * SLOT) + tile0;
  const lbf BtT = (lbf)(F.lds + 0 * RB), KtT = (lbf)(F.lds + 1 * RB), AbT = (lbf)(F.lds + 2 * RB), RbT = (lbf)(F.lds + 3 * RB);
  const lbf Ab = (lbf)(F.lds + 4 * RB), Vc = (lbf)(F.lds + 5 * RB), Bh = (lbf)(F.lds + 6 * RB), Kh = (lbf)(F.lds + 7 * RB);
  const lbf Tk = (lbf)(F.lds + 8 * RB), WbT = (lbf)(F.lds + 9 * RB), WkT = (lbf)(F.lds + 10 * RB);
  const lbf X = BtT, XT = KtT, Pb = AbT;
  const lbf At = X, TNT = XT, U0 = Tk;
  LAS float* Lf = (LAS float*)(F.lds + 11 * RB);
  LAS float* SEG = Lf + 64 * 65;
  LAS float* GC = (LAS float*)(F.lds + 14 * RB);
#if defined(PROBE_PH) && PROBE_PH == 301
  const unsigned long long _sa0 = __builtin_amdgcn_s_memrealtime();
#endif
  const int t = tid >> 3, cg = tid & 7, k0 = cg * 8;
  LAS float* AF = (LAS float*)(F.lds + 8 * RB);
  {
    const int tt16 = 16 * (w & 3), cr_ = lane & 15, q_ = lane >> 4;
#pragma unroll
    for (int ci = 0; ci < 2; ++ci) {
      f32x4 cw = {0.f, 0.f, 0.f, 0.f}, ca = {0.f, 0.f, 0.f, 0.f};
#pragma unroll
      for (int ks = 0; ks < 2; ++ks) { cw = __builtin_amdgcn_mfma_f32_16x16x32_bf16(in.tw[ks], W2.ww[ci][ks], cw, 0, 0, 0); ca = __builtin_amdgcn_mfma_f32_16x16x32_bf16(in.ta[ks], W2.wa[ci][ks], ca, 0, 0, 0); }
      const int col = 16 * (2 * (w >> 2) + ci) + cr_;
#pragma unroll
      for (int i = 0; i < 4; ++i) { const int tok = tt16 + 4 * q_ + i;
        Lf[tok * 65 + col] = (-0.60653066f * 1.44269504f) * sigmoidf_(cw[i] + W2.bw[ci]);     AF[tok * 65 + col] = sigmoidf_(ca[i] + W2.ba[ci]); }
    }
  }
  float r_[8], kx[8], v_[8], a_[8];
  un8(in.r, r_); un8(in.k, kx); un8(in.v, v_);
  R1_BAR();
#pragma unroll
  for (int i = 0; i < 8; ++i) a_[i] = AF[t * 65 + k0 + i];
  float kk[8], km[8], be[8];
  {
    float ss = 0.f, bo = 0.f;
#pragma unroll
    for (int i = 0; i < 8; ++i) { const float ckk = (i < 4) ? W2.kk0[i & 3] : W2.kk1[i & 3], cka = (i < 4) ? W2.ka0[i & 3] : W2.ka1[i & 3], crk = (i < 4) ? W2.rk0[i & 3] : W2.rk1[i & 3];
      kk[i] = kx[i] * ckk; ss += kk[i] * kk[i]; km[i] = kx[i] * (1.f + (a_[i] - 1.f) * cka); bo += r_[i] * km[i] * crk; }
    ss = sum8(ss); bo = sum8(bo);
    const float inv = rsqrtf(fmaxf(ss, 1e-24f));
#pragma unroll
    for (int i = 0; i < 8; ++i) { kk[i] *= inv; be[i] = kk[i] * a_[i]; }
    if (cg == 0) ((float*)(ws + WS_EDN))[(size_t)item * 64 + t] = bo;
  }
  {
    const int k = tid & 63, sg = tid >> 6;
    float run = 0.f;
#pragma unroll
    for (int i = 0; i < 8; ++i) { run += Lf[(sg * 8 + i) * 65 + k]; Lf[(sg * 8 + i) * 65 + k] = run; }
    SEG[sg * 64 + k] = run;
    R1_BAR();
    float off = 0.f;
    for (int j = 0; j < sg; ++j) off += SEG[j * 64 + k];
#pragma unroll
    for (int i = 0; i < 8; ++i) Lf[(sg * 8 + i) * 65 + k] += off;
  }
  R1_BAR();
  {
    float ab[8], bt[8], kt[8], rb[8], bh[8], kh[8];
#pragma unroll
    for (int i = 0; i < 8; ++i) {
      const float Lt = Lf[t * 65 + k0 + i], Lp = (t > 0) ? Lf[(t - 1) * 65 + k0 + i] : 0.f, LC = Lf[63 * 65 + k0 + i];
      const float et = __builtin_amdgcn_exp2f(Lt), ei = __builtin_amdgcn_rcpf(et), eh = __builtin_amdgcn_exp2f(LC) * ei;
      if (t == 63) GC[k0 + i] = et;
      ab[i] = -kk[i] * __builtin_amdgcn_exp2f(Lp); bt[i] = be[i] * ei; kt[i] = km[i] * ei; rb[i] = r_[i] * et; bh[i] = be[i] * eh; kh[i] = km[i] * eh;
    }
    *(LAS v4u*)(BtT + t * RP + k0) = pk8(bt); *(LAS v4u*)(KtT + t * RP + k0) = pk8(kt); *(LAS v4u*)(AbT + t * RP + k0) = pk8(ab); *(LAS v4u*)(RbT + t * RP + k0) = pk8(rb);
    {
      float ra[8], rv[8], rb[8], rkh[8];
#pragma unroll
      for (int i = 0; i < 8; ++i) { ra[i] = ab[i]; rv[i] = v_[i]; rb[i] = bh[i]; rkh[i] = kh[i]; }
#pragma unroll
      for (int sh = 1; sh < 8; sh <<= 1) {
        const bool on = (cg & sh) != 0;
        float ta[8], tv[8], tb[8], tk[8];
#pragma unroll
        for (int i = 0; i < 8; ++i) { ta[i] = on ? ra[(i + sh) & 7] : ra[i]; tv[i] = on ? rv[(i + sh) & 7] : rv[i]; tb[i] = on ? rb[(i + sh) & 7] : rb[i]; tk[i] = on ? rkh[(i + sh) & 7] : rkh[i]; }
#pragma unroll
        for (int i = 0; i < 8; ++i) { ra[i] = ta[i]; rv[i] = tv[i]; rb[i] = tb[i]; rkh[i] = tk[i]; }
      }
#pragma unroll
      for (int i = 0; i < 8; ++i) { const int row = k0 + ((i + cg) & 7);
        Ab[row * RP + t] = (bf16_t)f2bf(ra[i]); Vc[row * RP + t] = (bf16_t)f2bf(rv[i]); Bh[row * RP + t] = (bf16_t)f2bf(rb[i]); Kh[row * RP + t] = (bf16_t)f2bf(rkh[i]); }
    }
  }
  R1_BAR();
#if defined(PROBE_PH) && PROBE_PH == 301
  F.pr_t1 += __builtin_amdgcn_s_memrealtime() - _sa0;
#endif
  const int ya = (w >> 1) * 16, xb0 = (w & 1) * 32;
  const int cr = lane & 15, q4 = (lane >> 4) * 4;
  const f32x4 Z4 = {0.f, 0.f, 0.f, 0.f};
  const lbf X1 = (lbf)(F.lds + 11 * RB), XT1 = (lbf)(F.lds + 12 * RB), Pb1 = (lbf)(F.lds + 13 * RB);
  f32x4 accP[2];
  {
    f32x4 tabn[2], tabs[2], taks[2], wbr[2], wkr[2];
#pragma unroll
    for (int j = 0; j < 2; ++j) { const int xb = xb0 + 16 * j;
      tabn[j] = mm16(Z4, BtT, ya, AbT, xb, lane);
      tabs[j] = mm16(Z4, AbT, ya, BtT, xb, lane);
      taks[j] = mm16(Z4, AbT, ya, KtT, xb, lane);
      wbr[j] = mm16(Z4, BtT, ya, RbT, xb, lane);
      wkr[j] = mm16(Z4, KtT, ya, RbT, xb, lane); }
#pragma unroll
    for (int j = 0; j < 2; ++j) { const int xb = xb0 + 16 * j;
      f32x4 xt, xr, pr, tk, wb, wk;
#pragma unroll
      for (int i = 0; i < 4; ++i) {
        { const int s = ya + q4 + i, tt = xb + cr; xt[i] = (s < tt) ? tabn[j][i] : 0.f; wb[i] = (s <= tt) ? wbr[j][i] : 0.f; wk[i] = (s <= tt) ? wkr[j][i] : 0.f; }
        { const int tt = ya + q4 + i, s = xb + cr; xr[i] = (s < tt) ? tabs[j][i] : 0.f; pr[i] = xr[i] + ((s == tt) ? 1.f : 0.f); tk[i] = (s < tt) ? taks[j][i] : 0.f; }
      }
      accP[j] = pr;
      stT(XT1, xb, ya, xt, lane); stT(WbT, xb, ya, wb, lane); stT(WkT, xb, ya, wk, lane);
      stT(X1, xb, ya, xr, lane); stT(Pb1, xb, ya, pr, lane); stT(Tk, xb, ya, tk, lane); }
  }
  R1_BAR();
#pragma unroll 1
  for (int st = 0; st < 5; ++st) {
    const lbf Xs = (st & 1) ? X : X1, XTs = (st & 1) ? XT : XT1, Pbs = (st & 1) ? Pb : Pb1;
    const lbf Xd = (st & 1) ? X1 : X, XTd = (st & 1) ? XT1 : XT, Pbd = (st & 1) ? Pb1 : Pb;
    f32x4 xr[2], xt[2];
#pragma unroll
    for (int j = 0; j < 2; ++j) { const int xb = xb0 + 16 * j;
      xr[j] = mm16(Z4, XTs, ya, Xs, xb, lane);
      xt[j] = mm16(Z4, Xs, ya, XTs, xb, lane);
      if (st > 0) accP[j] = mm16(accP[j], XTs, ya, Pbs, xb, lane); }
#pragma unroll
    for (int j = 0; j < 2; ++j) { const int xb = xb0 + 16 * j; stT(Xd, xb, ya, xr[j], lane); stT(XTd, xb, ya, xt[j], lane); stT(Pbd, xb, ya, accP[j], lane); }
    R1_BAR();
  }
  const lbf NT = Pb1;
  {
    f32x4 nt[2];
#pragma unroll
    for (int j = 0; j < 2; ++j) { const int xb = xb0 + 16 * j; nt[j] = mm16(Z4, Pb, ya, XT, xb, lane);
#pragma unroll
      for (int i = 0; i < 4; ++i) nt[j][i] += bf2f(Pb[(ya + q4 + i) * RP + xb + cr]); }
#pragma unroll
    for (int j = 0; j < 2; ++j) stT(NT, xb0 + 16 * j, ya, nt[j], lane);
    R1_BAR();
  }
  {
    f32x4 at[2], tn[2];
#pragma unroll
    for (int j = 0; j < 2; ++j) { const int xb = xb0 + 16 * j; at[j] = mm16(Z4, NT, ya, Ab, xb, lane); tn[j] = mm16(Z4, Tk, ya, NT, xb, lane); }
#pragma unroll
    for (int j = 0; j < 2; ++j) { const int xb = xb0 + 16 * j; stT(At, xb, ya, at[j], lane); stT(TNT, xb, ya, tn[j], lane); }
  }
  R1_BAR();
  const lbf O_RT = (lbf)(F.lds + 11 * RB), O_PM = (lbf)(F.lds + 12 * RB), O_Y0 = (lbf)(F.lds + 13 * RB), O_Q = (lbf)(F.lds + 3 * RB)  ;
  {
    f32x4 u0[2], rt[2], pm[2];
#pragma unroll
    for (int j = 0; j < 2; ++j) { const int xb = xb0 + 16 * j;
      u0[j] = mm16(Z4, TNT, ya, Vc, xb, lane);
      rt[j] = mm16(Z4, At, ya, WbT, xb, lane);
      pm[j] = mm16(Z4, At, ya, Bh, xb, lane);
      const v2u rbw = *(const LAS v2u*)(RbT + (xb + cr) * RP + ya + q4);
      rt[j][0] += __uint_as_float(rbw.x << 16); rt[j][1] += __uint_as_float(rbw.x & 0xffff0000u); rt[j][2] += __uint_as_float(rbw.y << 16); rt[j][3] += __uint_as_float(rbw.y & 0xffff0000u);
#pragma unroll
      for (int i = 0; i < 4; ++i) if (ya + q4 + i == xb + cr) pm[j][i] += GC[xb + cr]; }
#pragma unroll
    for (int j = 0; j < 2; ++j) { const int xb = xb0 + 16 * j; stT(U0, xb, ya, u0[j], lane); stT(O_RT, xb, ya, rt[j], lane); stT(O_PM, xb, ya, pm[j], lane); }
  }
  R1_BAR();
  {
    f32x4 y0[2], qq[2];
#pragma unroll
    for (int j = 0; j < 2; ++j) { const int xb = xb0 + 16 * j;
      y0[j] = mm16(mm16(Z4, U0, ya, WbT, xb, lane), Vc, ya, WkT, xb, lane);
      qq[j] = mm16(mm16(Z4, Bh, ya, U0, xb, lane), Kh, ya, Vc, xb, lane); }
#pragma unroll
    for (int j = 0; j < 2; ++j) { const int xb = xb0 + 16 * j; stT(O_Y0, xb, ya, y0[j], lane); stT(O_Q, xb, ya, qq[j], lane); }
  }
  R1_BAR();
  {
    const int row = tid >> 3, pc = (tid & 7) * 8;
    *(GAS v4u*)(SL[3] + (size_t)row * DM + pc) = *(const LAS v4u*)(O_RT + row * RP + pc);
    *(GAS v4u*)(SL[0] + (size_t)row * DM + pc) = *(const LAS v4u*)(O_PM + row * RP + pc);
    *(GAS v4u*)(SL[4] + (size_t)row * DM + pc) = *(const LAS v4u*)(O_Y0 + row * RP + pc);
    *(GAS v4u*)(SL[1] + (size_t)row * DM + pc) = *(const LAS v4u*)(O_Q + row * RP + pc);
  }
  R1_BAR();
}

__device__ __forceinline__ void phase_rwkv_r1(PREF p, Frame& F) {
  int item = F.vcu;
  if (item >= 4096) return;
  R1W W2;
  { const int lane = fresh_lane(), hd = item & 15, cr = lane & 15, q = lane >> 4;
#pragma unroll
    for (int ci = 0; ci < 2; ++ci) { const int ch = hd * 64 + 16 * (2 * (F.wave >> 2) + ci) + cr;
      const bf16_t* ww = (const bf16_t*)(p.ws + WS_WL2) + (size_t)ch * 64 + q * 8; const bf16_t* wa = (const bf16_t*)(p.ws + WS_WL2 + 128 * 1024) + (size_t)ch * 64 + q * 8;
#pragma unroll
      for (int ks = 0; ks < 2; ++ks) { W2.ww[ci][ks] = *(const GAS bf16x8*)(ww + ks * 32); W2.wa[ci][ks] = *(const GAS bf16x8*)(wa + ks * 32); }
      W2.bw[ci] = p.w0[ch]; W2.ba[ci] = p.a0[ch]; }
    const int cc0 = hd * 64 + (F.tid & 7) * 8;
    W2.kk0 = *(const GAS f32x4*)(p.k_k + cc0); W2.kk1 = *(const GAS f32x4*)(p.k_k + cc0 + 4); W2.ka0 = *(const GAS f32x4*)(p.k_a + cc0); W2.ka1 = *(const GAS f32x4*)(p.k_a + cc0 + 4);
    W2.rk0 = *(const GAS f32x4*)(p.r_k + cc0); W2.rk1 = *(const GAS f32x4*)(p.r_k + cc0 + 4); }
  R1In nxt = rwkv_r1_load(p, item, F.tid);
  for (; item < 4096; item += F.G) {
    const R1In cur = nxt;
    if (item + F.G < 4096) nxt = rwkv_r1_load(p, item + F.G, F.tid);
    rwkv_r1_item(p, F, item, cur, W2);
  }
}

__device__ __forceinline__ void phase_rwkv_r2(PREF p, Frame& F) {
  if (F.wave != 0) return;
  const int lane = fresh_lane();
  const lbf Sh = (lbf)(F.lds), Sl = (lbf)(F.lds + 16 * RP * 2);
  const int cr = lane & 15, g = lane >> 4;
  for (int task = F.vcu; task < 256; task += F.G) {
    const int ch = task >> 2, jb = task & 3, b = ch >> 4, hd = ch & 15;
    const bf16_t* PM = (const bf16_t*)(p.ws + WS_S0) + ((size_t)(b * SEQ) * DM + hd * 64);
    bf16_t* QS = (bf16_t*)(p.ws + WS_S0 + SLOT) + ((size_t)(b * SEQ) * DM + hd * 64);
    for (int i = lane; i < 16 * RP; i += 64) { Sh[i] = 0; Sl[i] = 0; }
    const bf16_t* pmp = PM + (size_t)cr * DM + g * 8;
    bf16_t* qsp = QS + (size_t)(16 * jb + cr) * DM + g * 4;
    bf16x8 pa[4][4][2]; v2u qv[4][4];
#pragma unroll
    for (int d = 0; d < 4; ++d)
#pragma unroll
      for (int ct = 0; ct < 4; ++ct) { pa[d][ct][0] = *(const GAS bf16x8*)(pmp + (size_t)(d * 64 + 16 * ct) * DM); pa[d][ct][1] = *(const GAS bf16x8*)(pmp + (size_t)(d * 64 + 16 * ct) * DM + 32);
        qv[d][ct] = *(const GAS v2u*)(qsp + (size_t)d * 64 * DM + 16 * ct); }
    asm volatile("s_waitcnt lgkmcnt(0)" ::: "memory");
#pragma unroll 1
    for (int c4 = 0; c4 < 64; c4 += 4) {
#pragma unroll
      for (int d = 0; d < 4; ++d) {
        const int c = c4 + d;
        const bf16x8 bh0 = *(const LAS bf16x8*)(Sh + cr * RP + g * 8), bh1 = *(const LAS bf16x8*)(Sh + cr * RP + 32 + g * 8);
        const bf16x8 bl0 = *(const LAS bf16x8*)(Sl + cr * RP + g * 8), bl1 = *(const LAS bf16x8*)(Sl + cr * RP + 32 + g * 8);
        f32x4 acc[4];
#pragma unroll
        for (int ct = 0; ct < 4; ++ct) {
          acc[ct] = (f32x4){__uint_as_float(qv[d][ct].x << 16), __uint_as_float(qv[d][ct].x & 0xffff0000u), __uint_as_float(qv[d][ct].y << 16), __uint_as_float(qv[d][ct].y & 0xffff0000u)};
          f32x4 al = {0.f, 0.f, 0.f, 0.f};
          acc[ct] = __builtin_amdgcn_mfma_f32_16x16x32_bf16(pa[d][ct][0], bh0, acc[ct], 0, 0, 0);
          al = __builtin_amdgcn_mfma_f32_16x16x32_bf16(pa[d][ct][0], bl0, al, 0, 0, 0);
          acc[ct] = __builtin_amdgcn_mfma_f32_16x16x32_bf16(pa[d][ct][1], bh1, acc[ct], 0, 0, 0);
          al = __builtin_amdgcn_mfma_f32_16x16x32_bf16(pa[d][ct][1], bl1, al, 0, 0, 0);
          acc[ct] += al;
        }
        if (c + 4 < 64) {
#pragma unroll
          for (int ct = 0; ct < 4; ++ct) { pa[d][ct][0] = *(const GAS bf16x8*)(pmp + (size_t)((c + 4) * 64 + 16 * ct) * DM); pa[d][ct][1] = *(const GAS bf16x8*)(pmp + (size_t)((c + 4) * 64 + 16 * ct) * DM + 32);
            qv[d][ct] = *(const GAS v2u*)(qsp + (size_t)(c + 4) * 64 * DM + 16 * ct); }
        }
#pragma unroll
        for (int ct = 0; ct < 4; ++ct) {
          v2u hi; hi.x = pk2(acc[ct][0], acc[ct][1]); hi.y = pk2(acc[ct][2], acc[ct][3]);
          const float l0 = acc[ct][0] - __uint_as_float(hi.x << 16), l1 = acc[ct][1] - __uint_as_float(hi.x & 0xffff0000u), l2 = acc[ct][2] - __uint_as_float(hi.y << 16), l3 = acc[ct][3] - __uint_as_float(hi.y & 0xffff0000u);
          v2u lo; lo.x = pk2(l0, l1); lo.y = pk2(l2, l3);
          *(LAS v2u*)(Sh + cr * RP + 16 * ct + g * 4) = hi; *(LAS v2u*)(Sl + cr * RP + 16 * ct + g * 4) = lo;
          *(GAS v2u*)(qsp + (size_t)c * 64 * DM + 16 * ct) = hi;
        }
        asm volatile("" ::: "memory");
      }
    }
  }
}

__device__ __forceinline__ void phase_rwkv_r3(PREF p, Frame& F) {
  const int lane = fresh_lane(), w = F.wave;
  const int cr = lane & 15, q4 = (lane >> 4) * 4, q = lane >> 4;
  const int half = w >> 2, tb = w & 3;
  LAS bf16_t* stg = (LAS bf16_t*)(F.lds) + w * 16 * RP;
  bf16x8 gb[4][6];
  { const int hd0 = (F.vcu * 2 + half) & 15;
#pragma unroll
    for (int j = 0; j < 4; ++j) { const bf16_t* wg = (const bf16_t*)(p.ws + WS_WL2 + 256 * 1024) + (size_t)(hd0 * 64 + 16 * j + cr) * 192 + q * 8;
#pragma unroll
      for (int ks = 0; ks < 6; ++ks) gb[j][ks] = *(const GAS bf16x8*)(wg + ks * 32); } }
  float lnw[4], lnb[4];
#pragma unroll
  for (int j = 0; j < 4; ++j) { const int cc = ((F.vcu * 2 + half) & 15) * 64 + 16 * j + cr; lnw[j] = p.ln_w[cc]; lnb[j] = p.ln_b[cc]; }
  for (int it2 = F.vcu; it2 < 2048; it2 += F.G) {
    const int item = it2 * 2 + half;
    const int hd = item & 15, c = (item >> 4) & 63, b = item >> 10, ch = b * 16 + hd;
    const size_t tile0 = ((size_t)(b * SEQ + c * 64) * DM + hd * 64);
    bf16_t* RT = (bf16_t*)(p.ws + WS_S0 + 3 * SLOT) + tile0;
    const bf16_t* Y0 = (const bf16_t*)(p.ws + WS_S0 + 4 * SLOT) + tile0;
    const bf16_t* VV = (const bf16_t*)(p.ws + WS_S0 + 5 * SLOT) + tile0;
    const bf16_t* SC = (const bf16_t*)(p.ws + WS_S0 + SLOT) + tile0 - (size_t)64 * DM;
    const float* BO = (const float*)(p.ws + WS_EDN) + (size_t)item * 64;
    f32x4 y[4];
#pragma unroll
    for (int j = 0; j < 4; ++j) y[j] = (f32x4){0.f, 0.f, 0.f, 0.f};
    if (c > 0) {
      const bf16_t* ap = RT + (size_t)(16 * tb + cr) * DM + q * 8;
      const bf16x8 a0 = *(const GAS bf16x8*)ap, a1 = *(const GAS bf16x8*)(ap + 32);
#pragma unroll
      for (int j = 0; j < 4; ++j) {
        const bf16_t* bp = SC + (size_t)(16 * j + cr) * DM + q * 8;
        const bf16x8 b0 = *(const GAS bf16x8*)bp, b1 = *(const GAS bf16x8*)(bp + 32);
        y[j] = __builtin_amdgcn_mfma_f32_16x16x32_bf16(a0, b0, y[j], 0, 0, 0);
        y[j] = __builtin_amdgcn_mfma_f32_16x16x32_bf16(a1, b1, y[j], 0, 0, 0);
      }
    }
    float mu[4], rs[4];
#pragma unroll
    for (int i = 0; i < 4; ++i) {
      float s = 0.f;
#pragma unroll
      for (int j = 0; j < 4; ++j) { y[j][i] += bf2f(Y0[(size_t)(16 * tb + q4 + i) * DM + 16 * j + cr]); s += y[j][i]; }
      s = sum16_dpp(s);
      mu[i] = s * (1.f / 64.f);
      float qd = 0.f;
#pragma unroll
      for (int j = 0; j < 4; ++j) { const float d = y[j][i] - mu[i]; qd += d * d; }
      qd = sum16_dpp(qd);
      rs[i] = rsqrtf(qd * (1.f / 64.f) + 64e-5f);
    }
    f32x4 gacc[4];
    {
      const bf16_t* tg = (const bf16_t*)(p.ws + WS_TMP) + (size_t)(b * SEQ + c * 64 + 16 * tb + cr) * 384 + 128 + q * 8;
      bf16x8 ga[6];
#pragma unroll
      for (int ks = 0; ks < 6; ++ks) ga[ks] = *(const GAS bf16x8*)(tg + ks * 32);
#pragma unroll
      for (int j = 0; j < 4; ++j) {
        f32x4 a = {0.f, 0.f, 0.f, 0.f};
#pragma unroll
        for (int ks = 0; ks < 6; ++ks) a = __builtin_amdgcn_mfma_f32_16x16x32_bf16(ga[ks], gb[j][ks], a, 0, 0, 0);
        gacc[j] = a;
      }
    }
#pragma unroll
    for (int j = 0; j < 4; ++j) {
      const float lw = lnw[j], lb = lnb[j];
#pragma unroll
      for (int i = 0; i < 4; ++i) {
        const int tt = 16 * tb + q4 + i;
        const float vv = bf2f(VV[(size_t)tt * DM + 16 * j + cr]), gg = gacc[j][i];
        const float z = ((y[j][i] - mu[i]) * rs[i] * lw + lb + BO[tt] * vv) * gg;
        stg[(q4 + i) * RP + 16 * j + cr] = (bf16_t)f2bf(z);
      }
    }
    LDS_WAIT();
#pragma unroll
    for (int i = 0; i < 2; ++i) { const int row = (lane >> 3) + 8 * i, pc = (lane & 7) * 8;
      *(GAS v4u*)(RT + (size_t)(16 * tb + row) * DM + pc) = *(const LAS v4u*)(stg + row * RP + pc); }
    LDS_WAIT();
  }
}


typedef short v4i16_t __attribute__((ext_vector_type(4)));
__device__ __forceinline__ v4i16_t tr16(const LAS bf16_t* p) { return __builtin_amdgcn_ds_read_tr16_b64_v4i16((LAS v4i16_t*)p); }

template <int KS>
__device__ __forceinline__ void qk_tile(f32x4 (&st)[4][2], const LAS bf16_t* Kt, int kc0, const bf16x8 (&qf)[2][KS], int lane) {
  const int r = lane & 15, g = lane >> 4;
#pragma unroll
  for (int kt = 0; kt < 4; ++kt)
#pragma unroll
    for (int ks = 0; ks < KS; ++ks) {
      const bf16x8 a = *(const LAS bf16x8*)(Kt + (kt * 16 + r) * RP + kc0 + ks * 32 + g * 8);
#pragma unroll
      for (int qt = 0; qt < 2; ++qt) st[kt][qt] = __builtin_amdgcn_mfma_f32_16x16x32_bf16(a, qf[qt][ks], st[kt][qt], 0, 0, 0);
    }
}
__device__ __forceinline__ void pack_p(bf16x8 (&pb)[2][2], const f32x4 (&pr)[4][2]) {
#pragma unroll
  for (int kb = 0; kb < 2; ++kb)
#pragma unroll
    for (int qt = 0; qt < 2; ++qt) {
      const v4u w = {pk2(pr[2 * kb][qt][0], pr[2 * kb][qt][1]), pk2(pr[2 * kb][qt][2], pr[2 * kb][qt][3]), pk2(pr[2 * kb + 1][qt][0], pr[2 * kb + 1][qt][1]), pk2(pr[2 * kb + 1][qt][2], pr[2 * kb + 1][qt][3])};
      pb[kb][qt] = __builtin_bit_cast(bf16x8, w);
    }
}
__device__ __forceinline__ void pv_apply(f32x4 (&o)[4][2], f32x4 (&osum)[2], const bf16x8 (&pb)[2][2], const LAS bf16_t* Vt, int lane) {
  const int g = lane >> 4, qq = (lane & 15) >> 2, pp = lane & 3;
  const bf16x8 ones = {0x3F80, 0x3F80, 0x3F80, 0x3F80, 0x3F80, 0x3F80, 0x3F80, 0x3F80};
#pragma unroll
  for (int kb = 0; kb < 2; ++kb)
#pragma unroll
    for (int qt = 0; qt < 2; ++qt) osum[qt] = __builtin_amdgcn_mfma_f32_16x16x32_bf16(ones, pb[kb][qt], osum[qt], 0, 0, 0);
#pragma unroll
  for (int dt = 0; dt < 4; ++dt)
#pragma unroll
    for (int kb = 0; kb < 2; ++kb) {
      const v4i16_t lo = tr16(Vt + (32 * kb + 4 * g + qq) * RP + dt * 16 + 4 * pp);
      const v4i16_t hi = tr16(Vt + (32 * kb + 16 + 4 * g + qq) * RP + dt * 16 + 4 * pp);
      const bf16x8 a = {lo[0], lo[1], lo[2], lo[3], hi[0], hi[1], hi[2], hi[3]};
#pragma unroll
      for (int qt = 0; qt < 2; ++qt) o[dt][qt] = __builtin_amdgcn_mfma_f32_16x16x32_bf16(a, pb[kb][qt], o[dt][qt], 0, 0, 0);
    }
}
__device__ __forceinline__ void pv_apply2(f32x4 (&o1)[4][2], f32x4 (&o2)[4][2], f32x4 (&os1)[2], f32x4 (&os2)[2], const bf16x8 (&pb1)[2][2], const bf16x8 (&pb2)[2][2], const LAS bf16_t* Vt, int lane) {
  const int g = lane >> 4, qq = (lane & 15) >> 2, pp = lane & 3;
  const bf16x8 ones = {0x3F80, 0x3F80, 0x3F80, 0x3F80, 0x3F80, 0x3F80, 0x3F80, 0x3F80};
#pragma unroll
  for (int kb = 0; kb < 2; ++kb)
#pragma unroll
    for (int qt = 0; qt < 2; ++qt) { os1[qt] = __builtin_amdgcn_mfma_f32_16x16x32_bf16(ones, pb1[kb][qt], os1[qt], 0, 0, 0); os2[qt] = __builtin_amdgcn_mfma_f32_16x16x32_bf16(ones, pb2[kb][qt], os2[qt], 0, 0, 0); }
#pragma unroll
  for (int dt = 0; dt < 4; ++dt)
#pragma unroll
    for (int kb = 0; kb < 2; ++kb) {
      const v4i16_t lo = tr16(Vt + (32 * kb + 4 * g + qq) * RP + dt * 16 + 4 * pp);
      const v4i16_t hi = tr16(Vt + (32 * kb + 16 + 4 * g + qq) * RP + dt * 16 + 4 * pp);
      const bf16x8 a = {lo[0], lo[1], lo[2], lo[3], hi[0], hi[1], hi[2], hi[3]};
#pragma unroll
      for (int qt = 0; qt < 2; ++qt) { o1[dt][qt] = __builtin_amdgcn_mfma_f32_16x16x32_bf16(a, pb1[kb][qt], o1[dt][qt], 0, 0, 0); o2[dt][qt] = __builtin_amdgcn_mfma_f32_16x16x32_bf16(a, pb2[kb][qt], o2[dt][qt], 0, 0, 0); }
    }
}
__device__ __forceinline__ void fill42(f32x4 (&a)[4][2], const f32x4 v) {
#pragma unroll
  for (int i = 0; i < 4; ++i)
#pragma unroll
    for (int j = 0; j < 2; ++j) a[i][j] = v;
}
__device__ __forceinline__ void exp42(f32x4 (&a)[4][2]) {
#pragma unroll
  for (int i = 0; i < 4; ++i)
#pragma unroll
    for (int j = 0; j < 2; ++j)
#pragma unroll
      for (int e = 0; e < 4; ++e) a[i][j][e] = __builtin_amdgcn_exp2f(a[i][j][e]);
}
#if defined(PROBE_PH)
#define SECT_B(id) unsigned long long _s##id = 0; if (PROBE_PH == id) _s##id = __builtin_amdgcn_s_memrealtime()
#define SECT_E(id) do { if (PROBE_PH == id) F.pr_t1 += __builtin_amdgcn_s_memrealtime() - _s##id; } while (0)
#else
#define SECT_B(id)
#define SECT_E(id) do {} while (0)
#endif
#if defined(PROBE_PH) && PROBE_PH == 300
#define AT_BAR() do { const unsigned long long _b0 = __builtin_amdgcn_s_memrealtime(); asm volatile("s_waitcnt lgkmcnt(0)" ::: "memory"); __builtin_amdgcn_s_barrier(); asm volatile("" ::: "memory"); F.pr_t1 += __builtin_amdgcn_s_memrealtime() - _b0; } while (0)
#else
#define AT_BAR() do { asm volatile("s_waitcnt lgkmcnt(0)" ::: "memory"); __builtin_amdgcn_s_barrier(); asm volatile("" ::: "memory"); } while (0)
#endif
__device__ __forceinline__ void zero42(f32x4 (&a)[4][2]) {
#pragma unroll
  for (int i = 0; i < 4; ++i)
#pragma unroll
    for (int j = 0; j < 2; ++j) a[i][j] = (f32x4){0.f, 0.f, 0.f, 0.f};
}

__device__ __forceinline__ void phase_compress(PREF p, Frame& F) {
  const int lane = fresh_lane(), w = F.wave, tid = F.tid;
  const int r = lane & 15, g4 = lane >> 4;
  const bf16_t* H = (const bf16_t*)(p.ws + WS_H);
  const bf16_t* W1T = (const bf16_t*)(p.ws + WS_CW1);
  LAS float* part = (LAS float*)F.lds;
  LAS float* hid = part + 8 * 16 * 64;
  LAS float* outv = hid + 16 * 64;
  for (int task = F.vcu; task < 256; task += F.G) {
    const int kv = task >> 7, rb = task & 127;
    int row = rb * 16 + r; if (row > 2039) row = 2039;
    const int gg = row & 1, cc = (row >> 1) % NCMP, bb = (row >> 1) / NCMP;
    const int colbase = OFF_NKV + ((0 * 2 + kv) * 2 + gg) * 64;
    f32x4 acc[4];
#pragma unroll
    for (int nt = 0; nt < 4; ++nt) acc[nt] = (f32x4){0.f, 0.f, 0.f, 0.f};
#pragma unroll 4
    for (int ks0 = 0; ks0 < 8; ++ks0) { const int ks = (ks0 + rb) & 7;
      const int k = w * 256 + ks * 32 + g4 * 8, l = k >> 6, d0 = k & 63;
      float hv[8]; ld8bf(H + (size_t)(bb * SEQ + 16 * cc + l) * HC + colbase + d0, hv);
      const float* pe = p.cmp_pe + (kv * 32 + l) * 64 + d0;
#pragma unroll
      for (int i = 0; i < 8; ++i) hv[i] += pe[i];
      const bf16x8 a = __builtin_bit_cast(bf16x8, pk8(hv));
#pragma unroll
      for (int nt = 0; nt < 4; ++nt) {
        const bf16x8 bfr = *(const GAS bf16x8*)(W1T + ((size_t)kv * 64 + nt * 16 + r) * 2048 + k);
        acc[nt] = __builtin_amdgcn_mfma_f32_16x16x32_bf16(a, bfr, acc[nt], 0, 0, 0);
      }
    }
#pragma unroll
    for (int nt = 0; nt < 4; ++nt)
#pragma unroll
      for (int i = 0; i < 4; ++i) part[(w * 16 + g4 * 4 + i) * 64 + nt * 16 + r] = acc[nt][i];
    __syncthreads();
    for (int e = tid; e < 1024; e += NWAVES * 64) { float s = 0.f;
#pragma unroll
      for (int ww = 0; ww < 8; ++ww) s += part[ww * 1024 + e];
      hid[e] = gelu_tanh(s); }
    __syncthreads();
    const float* w2 = p.cmp_w2 + kv * 4096;
    for (int e = tid; e < 1024; e += NWAVES * 64) { const int rr = e >> 6, n = e & 63; float s = 0.f;
#pragma unroll 16
      for (int j = 0; j < 64; ++j) s += hid[rr * 64 + j] * w2[j * 64 + n];
      outv[e] = s; }
    __syncthreads();
    for (int e = tid; e < 1024; e += NWAVES * 64) { const int rr = e >> 6, n = e & 63;
      const int orow = rb * 16 + rr;
      if (orow < 2040) {
        float v = outv[e];
        if (kv == 0) { float ss = 0.f; for (int j = 0; j < 64; ++j) ss += outv[rr * 64 + j] * outv[rr * 64 + j]; v = v * rsqrtf(ss * (1.f / 64.f) + 1e-6f) * p.nk_norm[n]; }
        const int g2 = orow & 1, c2 = (orow >> 1) % NCMP, b2 = (orow >> 1) / NCMP;
        ((bf16_t*)(p.ws + (kv ? WS_VCMPB : WS_KCMPB)))[((size_t)(b2 * 2 + g2) * 256 + c2) * 64 + n] = (bf16_t)f2bf(v);
      }
    }
    if (task < 16 && tid < 64) { const int kk2 = task >> 3, bg = task & 7; ((bf16_t*)(p.ws + (kk2 ? WS_VCMPB : WS_KCMPB)))[((size_t)bg * 256 + 255) * 64 + tid] = 0; }
    __syncthreads();
  }
}

__device__ __forceinline__ v4u tile_ld(const bf16_t* base, size_t pitch, int tid) { return *(const GAS v4u*)(base + (size_t)(tid >> 3) * pitch + (tid & 7) * 8); }
__device__ __forceinline__ void tile_st(LAS bf16_t* dst, v4u v, int tid) { *(LAS v4u*)(dst + (tid >> 3) * RP + (tid & 7) * 8) = v; }

template <int KS, int MODE>
__device__ __forceinline__ void attn_tile(f32x4 (&o)[4][2], f32x4 (&os)[2], const bf16x8 (&qf)[2][KS], const LAS bf16_t* KBt, int kc0, const LAS bf16_t* VBt, const f32x4 nbv,
                                          const bool (&on)[2], int qq0, int koff, int lane) {
  const int r = lane & 15, g = lane >> 4;
  f32x4 st[4][2]; bf16x8 pb[2][2];
  if (MODE & 1) {
    const f32x4 off = {-1e30f, -1e30f, -1e30f, -1e30f};
#pragma unroll
    for (int kt = 0; kt < 4; ++kt) { st[kt][0] = on[0] ? nbv : off; st[kt][1] = on[1] ? nbv : off; }
  } else fill42(st, nbv);
  qk_tile<KS>(st, KBt, kc0, qf, lane); exp42(st);
  if ((MODE & 6) != 0) {
#pragma unroll
    for (int kt = 0; kt < 4; ++kt)
#pragma unroll
      for (int qt = 0; qt < 2; ++qt)
#pragma unroll
        for (int i = 0; i < 4; ++i) { const int kk = kt * 16 + g * 4 + i, qq = qq0 + qt * 16 + r;
          bool keep = true;
          if (MODE & 2) keep = keep && (kk + koff <= qq);
          if (MODE & 4) keep = keep && (kk > qq);
          if (!keep) st[kt][qt][i] = 0.f; }
  }
  pack_p(pb, st);
  pv_apply(o, os, pb, VBt, lane);
}
__device__ __forceinline__ void phase_diffattn(PREF p, Frame& F) {
  const int lane = fresh_lane(), w = F.wave, tid = F.tid;
  const int r = lane & 15, g = lane >> 4;
  const bf16_t* H = (const bf16_t*)(p.ws + WS_H);
  bf16_t* CAT = (bf16_t*)(p.ws + WS_CAT);
  float mq = 0.f, mk = 0.f, l0 = 0.f, l1 = 0.f;
  for (int i = 0; i < 32; i++) { mq = fmaxf(mq, fabsf(p.dq_norm[i])); mk = fmaxf(mk, fabsf(p.dk_norm[i])); l0 += p.dlam[i] * p.dlam[32 + i]; l1 += p.dlam[64 + i] * p.dlam[96 + i]; }
  const float c2 = 0.17677669529663687f * 1.4426950408889634f;
  const float nb = -(32.f * mq * mk) * c2;
  const f32x4 nbv = {nb, nb, nb, nb};
  const float lam = __expf(l0) - __expf(l1) + 0.2f;
  const bool on[2] = {true, true};
  for (int pr = F.vcu; pr < 256; pr += F.G) {
    const int bh = pr >> 3, sp = pr & 7, b = bh >> 3, hd = bh & 7;
#pragma unroll 1
    for (int ui = 0; ui < 2; ++ui) {
      const int qb = ui ? 15 - sp : sp;
      const int NT = 4 * (qb + 1);
      const bf16_t* Kg = H + (size_t)(b * SEQ) * HC + OFF_DK + hd * 64;
      const bf16_t* Vg = H + (size_t)(b * SEQ) * HC + OFF_DV + hd * 64;
      f32x4 o1[4][2];
#pragma unroll 1
      for (int mp = 0; mp < 2; ++mp) {
        bf16x8 qf[2][1];
#pragma unroll
        for (int qt = 0; qt < 2; ++qt) qf[qt][0] = *(const GAS bf16x8*)(H + (size_t)(b * SEQ + qb * 256 + w * 32 + qt * 16 + r) * HC + OFF_DQ + hd * 64 + mp * 32 + g * 8);
        f32x4 o[4][2]; zero42(o);
        f32x4 os[2] = {{0.f, 0.f, 0.f, 0.f}, {0.f, 0.f, 0.f, 0.f}};
        v4u krA = tile_ld(Kg, HC, tid), vrA = tile_ld(Vg, HC, tid);
        v4u krB = tile_ld(Kg + (size_t)64 * HC, HC, tid), vrB = tile_ld(Vg + (size_t)64 * HC, HC, tid);
#pragma unroll 1
        for (int t = 0; t < NT; t += 2) {
#pragma unroll
          for (int hf = 0; hf < 2; ++hf) {
            const int tt = t + hf;
            const lbf KBt = (lbf)(F.lds + hf * 2 * RB), VBt = KBt + 64 * RP;
            tile_st(KBt, hf ? krB : krA, tid); tile_st(VBt, hf ? vrB : vrA, tid);
            AT_BAR();
            if (tt + 2 < NT) { const v4u k2 = tile_ld(Kg + (size_t)(tt + 2) * 64 * HC, HC, tid), v2 = tile_ld(Vg + (size_t)(tt + 2) * 64 * HC, HC, tid);
              if (hf) { krB = k2; vrB = v2; } else { krA = k2; vrA = v2; } }
            const int koff = tt * 64 - (qb * 256 + w * 32);
            if (tt >= NT - 4) attn_tile<1, 2>(o, os, qf, KBt, mp * 32, VBt, nbv, on, 0, koff, lane);
            else attn_tile<1, 0>(o, os, qf, KBt, mp * 32, VBt, nbv, on, 0, koff, lane);
          }
        }
        if (mp == 0) {
#pragma unroll
          for (int qt = 0; qt < 2; ++qt) { const float i1 = 1.f / os[qt][0];
#pragma unroll
            for (int dt = 0; dt < 4; ++dt) o1[dt][qt] = o[dt][qt] * i1; }
        } else {
#pragma unroll
          for (int qt = 0; qt < 2; ++qt) {
            const float i2 = lam / os[qt][0];
            float ss = 0.f;
#pragma unroll
            for (int dt = 0; dt < 4; ++dt)
#pragma unroll
              for (int i = 0; i < 4; ++i) { const float v = o1[dt][qt][i] - o[dt][qt][i] * i2; o1[dt][qt][i] = v; ss += v * v; }
            ss += __shfl_xor(ss, 16, 64); ss += __shfl_xor(ss, 32, 64);
            const float rr = rsqrtf(ss * (1.f / 64.f) + 1e-6f) * 0.8f;
            bf16_t* op = CAT + (size_t)(b * SEQ + qb * 256 + w * 32 + qt * 16 + r) * DM + hd * 64;
#pragma unroll
            for (int dt = 0; dt < 4; ++dt) { const int d0 = dt * 16 + g * 4; const f32x4 sg = *(const f32x4*)(p.dsubln + d0);
              v2u wv; wv.x = pk2(o1[dt][qt][0] * rr * sg[0], o1[dt][qt][1] * rr * sg[1]); wv.y = pk2(o1[dt][qt][2] * rr * sg[2], o1[dt][qt][3] * rr * sg[3]);
              *(GAS v2u*)(op + d0) = wv; }
          }
        }
        AT_BAR();
      }
    }
  }
}

__device__ __forceinline__ void nsa_finish(f32x4 (&comb)[4][2], const f32x4 (&o)[4][2], const f32x4 (&os)[2], const float (&gate)[2], bool normalised) {
#pragma unroll
  for (int qt = 0; qt < 2; ++qt) {
    const float f = normalised ? gate[qt] : gate[qt] / os[qt][0];
#pragma unroll
    for (int dt = 0; dt < 4; ++dt) comb[dt][qt] += o[dt][qt] * f;
  }
}
__device__ __forceinline__ void phase_nsa(PREF p, Frame& F) {
  const int lane = fresh_lane(), w = F.wave, tid = F.tid;
  const int r = lane & 15, g = lane >> 4;
  const bf16_t* H = (const bf16_t*)(p.ws + WS_H);
  const float* GATES = (const float*)(p.ws + WS_GATES);
  bf16_t* CAT = (bf16_t*)(p.ws + WS_CAT);
  float mq = 0.f, mk0 = 0.f, mk1 = 0.f, mk2 = 0.f;
  for (int i = 0; i < 64; i++) { mq = fmaxf(mq, fabsf(p.nq_norm[i])); mk0 = fmaxf(mk0, fabsf(p.nk_norm[i])); mk1 = fmaxf(mk1, fabsf(p.nk_norm[64 + i])); mk2 = fmaxf(mk2, fabsf(p.nk_norm[128 + i])); }
  const float c2 = 0.125f * 1.4426950408889634f;
  const float nb0 = -(64.f * mq * mk0) * c2, nb1 = -(64.f * mq * mk1) * c2, nb2 = -(64.f * mq * mk2) * c2;
  constexpr int IPT = 68;
  LAS float* IMP = (LAS float*)(F.lds + 12 * RB);
  LAS unsigned char* SELB = (LAS unsigned char*)(F.lds + 12 * RB + 64 * IPT * 4);
  const int hj = w >> 1, th = w & 1;
  for (int pr = F.vcu; pr < 256; pr += F.G) {
    const int bg = pr >> 5, sp = pr & 31, b = bg >> 1, gq = bg & 1;
#pragma unroll 1
    for (int ui = 0; ui < 2; ++ui) {
      const int blk = ui ? 63 - sp : sp;
      const int hh = gq * 4 + hj;
      const int tokw = b * SEQ + blk * 64 + th * 32;
      bf16x8 qf[2][2];
      float gate0[2], gate1[2], gate2[2];
#pragma unroll
      for (int qt = 0; qt < 2; ++qt) { const bf16_t* qp = H + (size_t)(tokw + qt * 16 + r) * HC + OFF_NQ + hh * 64 + g * 8;
        qf[qt][0] = *(const GAS bf16x8*)qp; qf[qt][1] = *(const GAS bf16x8*)(qp + 32);
        const float* gp = GATES + (size_t)(tokw + qt * 16 + r) * 24 + hh * 3; gate0[qt] = gp[0]; gate1[qt] = gp[1]; gate2[qt] = gp[2]; }
      f32x4 comb[4][2]; zero42(comb);
      const int nct = (4 * blk + 3 + 63) >> 6;
      {
        const bf16_t* KC = (const bf16_t*)(p.ws + WS_KCMPB) + (size_t)(b * 2 + gq) * 256 * 64;
        const bf16_t* VC = (const bf16_t*)(p.ws + WS_VCMPB) + (size_t)(b * 2 + gq) * 256 * 64;
        for (int t4 = 0; t4 < nct; ++t4) { tile_st((lbf)(F.lds + t4 * RB), tile_ld(KC + t4 * 4096, 64, tid), tid); tile_st((lbf)(F.lds + (4 + t4) * RB), tile_ld(VC + t4 * 4096, 64, tid), tid); }
        for (int e = tid; e < 64 * IPT; e += NWAVES * 64) IMP[e] = 0.f;
        AT_BAR();
        const f32x4 nbv0 = {nb0, nb0, nb0, nb0};
        int cmax[2];
#pragma unroll
        for (int qt = 0; qt < 2; ++qt) { const int pos = blk * 64 + th * 32 + qt * 16 + r; cmax[qt] = (pos >= 31) ? ((pos - 31) >> 4) : -1; }
        float lsum[2] = {0.f, 0.f};
        for (int t4 = 0; t4 < nct; ++t4) {
          f32x4 st[4][2]; fill42(st, nbv0);
          qk_tile<2>(st, (lbf)(F.lds + t4 * RB), 0, qf, lane); exp42(st);
#pragma unroll
          for (int kt = 0; kt < 4; ++kt)
#pragma unroll
            for (int qt = 0; qt < 2; ++qt)
#pragma unroll
              for (int i = 0; i < 4; ++i) { const int c = t4 * 64 + kt * 16 + g * 4 + i; if (c <= cmax[qt]) lsum[qt] += st[kt][qt][i]; }
        }
        float linv[2];
#pragma unroll
        for (int qt = 0; qt < 2; ++qt) { float s = lsum[qt]; s += __shfl_xor(s, 16, 64); s += __shfl_xor(s, 32, 64); linv[qt] = (cmax[qt] >= 0) ? 1.f / s : 0.f; }
        f32x4 o[4][2]; zero42(o);
        f32x4 osd[2] = {{0.f, 0.f, 0.f, 0.f}, {0.f, 0.f, 0.f, 0.f}};
        float carry[2] = {0.f, 0.f};
        for (int t4 = 0; t4 < nct; ++t4) {
          f32x4 st[4][2]; fill42(st, nbv0);
          qk_tile<2>(st, (lbf)(F.lds + t4 * RB), 0, qf, lane); exp42(st);
#pragma unroll
          for (int qt = 0; qt < 2; ++qt) {
            float gs[4], rot[4];
#pragma unroll
            for (int kt = 0; kt < 4; ++kt) { float s4 = 0.f;
#pragma unroll
              for (int i = 0; i < 4; ++i) { const int c = t4 * 64 + kt * 16 + g * 4 + i;
                const float e = (c <= cmax[qt]) ? st[kt][qt][i] * linv[qt] : 0.f;
                st[kt][qt][i] = e; s4 += e; }
              gs[kt] = s4; rot[kt] = __shfl(st[kt][qt][3], (lane - 16) & 63, 64); }
            const int ti = th * 32 + qt * 16 + r;
#pragma unroll
            for (int kt = 0; kt < 4; ++kt) { const float add = (g > 0) ? rot[kt] : (kt > 0 ? rot[kt > 0 ? kt - 1 : 0] : carry[qt]);
              __hip_atomic_fetch_add(IMP + ti * IPT + t4 * 16 + kt * 4 + g, gs[kt] + add, __ATOMIC_RELAXED, __HIP_MEMORY_SCOPE_WORKGROUP); }
            carry[qt] = rot[3];
          }
          bf16x8 pb[2][2]; pack_p(pb, st);
          pv_apply(o, osd, pb, (lbf)(F.lds + (4 + t4) * RB), lane);
        }
        nsa_finish(comb, o, osd, gate0, true);
      }
      AT_BAR();
      {
        const int ti = tid >> 3, jbk = tid & 7, jb = jbk * 8;
        LAS int* IK = (LAS int*)IMP;
        int key[8];
#pragma unroll
        for (int u = 0; u < 8; ++u) { const int j = jb + u; float v = IMP[ti * IPT + j]; if (j == blk || j == 0) v = 1e4f; else if (j > blk) v = -1e30f; key[u] = __float_as_int(v); }
#pragma unroll
        for (int u = 0; u < 8; ++u) IK[ti * IPT + jb + u] = key[u];
        AT_BAR();
        int rank[8];
#pragma unroll
        for (int u = 0; u < 8; ++u) { int c = 0;
#pragma unroll
          for (int u2 = u; u2 < 8; ++u2) c += (key[u2] == key[u]) ? 1 : 0;
          rank[u] = -c; }
#pragma unroll
        for (int ib = 0; ib < 8; ++ib) if (ib * 8 <= blk) {
          int th[8];
#pragma unroll
          for (int u = 0; u < 8; ++u) th[u] = key[u] + (ib > jbk ? 1 : 0);
          const v4u ka = *(const LAS v4u*)(IK + ti * IPT + ib * 8), kb4 = *(const LAS v4u*)(IK + ti * IPT + ib * 8 + 4);
#pragma unroll
          for (int ii = 0; ii < 8; ++ii) { const int k = (int)((ii < 4) ? ka[ii & 3] : kb4[ii & 3]);
#pragma unroll
            for (int u = 0; u < 8; ++u) rank[u] += (k >= th[u]) ? 1 : 0; }
        }
        unsigned bits = 0;
#pragma unroll
        for (int u = 0; u < 8; ++u) bits |= (rank[u] < 16 ? 1u : 0u) << u;
        SELB[ti * 8 + jbk] = (unsigned char)bits;
      }
      AT_BAR();
      unsigned long long selm[2];
#pragma unroll
      for (int qt = 0; qt < 2; ++qt) { const int ti = th * 32 + qt * 16 + r; const LAS unsigned* sp2 = (const LAS unsigned*)(SELB + ti * 8); selm[qt] = (unsigned long long)sp2[0] | ((unsigned long long)sp2[1] << 32); }
#pragma unroll 1
      for (int br = 1; br < 3; ++br) {
        const int kcol = OFF_NKV + ((br * 2 + 0) * 2 + gq) * 64, vcol = OFF_NKV + ((br * 2 + 1) * 2 + gq) * 64;
        const float nbb = (br == 1) ? nb1 : nb2;
        const f32x4 nbv = {nbb, nbb, nbb, nbb};
        const int t_lo = (br == 1) ? 0 : (blk > 8 ? blk - 8 : 0);
        const bf16_t* Kg = H + (size_t)(b * SEQ) * HC + kcol;
        const bf16_t* Vg = H + (size_t)(b * SEQ) * HC + vcol;
        f32x4 o[4][2]; zero42(o);
        f32x4 os[2] = {{0.f, 0.f, 0.f, 0.f}, {0.f, 0.f, 0.f, 0.f}};
        v4u krA = tile_ld(Kg + (size_t)t_lo * 64 * HC, HC, tid), vrA = tile_ld(Vg + (size_t)t_lo * 64 * HC, HC, tid);
        v4u krB = krA, vrB = vrA;
        if (t_lo < blk) { krB = tile_ld(Kg + (size_t)(t_lo + 1) * 64 * HC, HC, tid); vrB = tile_ld(Vg + (size_t)(t_lo + 1) * 64 * HC, HC, tid); }
#pragma unroll 1
        for (int t0 = t_lo; t0 <= blk; t0 += 2) {
#pragma unroll
          for (int hf = 0; hf < 2; ++hf) {
            const int t = t0 + hf;
            if (t <= blk) {
              const lbf KBt = (lbf)(F.lds + (8 + hf * 2) * RB), VBt = KBt + 64 * RP;
              tile_st(KBt, hf ? krB : krA, tid); tile_st(VBt, hf ? vrB : vrA, tid);
              AT_BAR();
              if (t + 2 <= blk) { const v4u k2 = tile_ld(Kg + (size_t)(t + 2) * 64 * HC, HC, tid), v2 = tile_ld(Vg + (size_t)(t + 2) * 64 * HC, HC, tid);
                if (hf) { krB = k2; vrB = v2; } else { krA = k2; vrA = v2; } }
              const bool on[2] = {((selm[0] >> t) & 1ull) != 0ull, ((selm[1] >> t) & 1ull) != 0ull};
              const int qq0 = th * 32;
              if (br == 1) {
                if (__any((int)(on[0] || on[1]))) {
                  if (t == blk) attn_tile<2, 3>(o, os, qf, KBt, 0, VBt, nbv, on, qq0, 0, lane);
                  else if (__all((int)(on[0] && on[1]))) attn_tile<2, 0>(o, os, qf, KBt, 0, VBt, nbv, on, qq0, 0, lane);
                  else attn_tile<2, 1>(o, os, qf, KBt, 0, VBt, nbv, on, qq0, 0, lane);
                }
              } else {
                if (t == blk) attn_tile<2, 2>(o, os, qf, KBt, 0, VBt, nbv, on, qq0, 0, lane);
                else if (t == blk - 8) attn_tile<2, 4>(o, os, qf, KBt, 0, VBt, nbv, on, qq0, 0, lane);
                else attn_tile<2, 0>(o, os, qf, KBt, 0, VBt, nbv, on, qq0, 0, lane);
              }
            }
          }
        }
        nsa_finish(comb, o, os, (br == 1) ? gate1 : gate2, false);
        AT_BAR();
      }
#pragma unroll
      for (int qt = 0; qt < 2; ++qt) { bf16_t* op = CAT + (size_t)(tokw + qt * 16 + r) * DM + 512 + hh * 64;
#pragma unroll
        for (int dt = 0; dt < 4; ++dt) { const int d0 = dt * 16 + g * 4; v2u wv; wv.x = pk2(comb[dt][qt][0], comb[dt][qt][1]); wv.y = pk2(comb[dt][qt][2], comb[dt][qt][3]); *(GAS v2u*)(op + d0) = wv; } }
    }
  }
}


__device__ __forceinline__ void phase_lora2(PREF p, Frame& F, const bool skip_store = false, const bool skip_math = false) {
  const int lane = fresh_lane(), w = F.wave, tid = F.tid;
  const int cr = lane & 15, g = lane >> 4;
  constexpr int TP = 392;
  const lbf TM = (lbf)(F.lds);
  const lbf ST = (lbf)(F.lds + 64 * TP * 2) + w * 64 * RP;
  const bf16_t* TMPg = (const bf16_t*)(p.ws + WS_TMP);
  for (int unit = F.vcu; unit < 256; unit += F.G) {
    const int t0 = unit * 64;
    bf16x8 a0[2][4];
    auto wptr = [&](int blk) { const int tensor = blk >> 4, cb = blk & 15, ldw = (tensor == 2) ? 192 : 64;
      return (const bf16_t*)(p.ws + WS_WL2 + (size_t)tensor * 128 * 1024) + (size_t)(cb * 64 + cr) * ldw + g * 8; };
    auto wload = [&](int blk) {
      const int ldw = ((blk >> 4) == 2) ? 192 : 64; const bf16_t* Wp = wptr(blk);
#pragma unroll
      for (int k2 = 0; k2 < 2; ++k2)
#pragma unroll
        for (int ct = 0; ct < 4; ++ct) a0[k2][ct] = *(const GAS bf16x8*)(Wp + (size_t)(16 * ct) * ldw + k2 * 32);
    };
    auto blkof = [&](int j) { return ((j >> 1) << 4) | ((w * 2 + (j & 1) + unit * 3) & 15); };
    wload(blkof(0));
#pragma unroll
    for (int i = 0; i < 6; ++i) { const int idx = tid + i * 512, row = idx / 48, pc = idx - row * 48;
      *(LAS v4u*)(TM + row * TP + pc * 8) = *(const GAS v4u*)(TMPg + (size_t)(t0 + row) * 384 + pc * 8); }
    __syncthreads();
#pragma unroll 1
    for (int j = 0; j < 4; ++j) {
      const int blk = blkof(j);
      const int tensor = blk >> 4, cb = blk & 15, kc0 = tensor * 64;
      f32x4 acc[4][4];
#pragma unroll
      for (int ct = 0; ct < 4; ++ct)
#pragma unroll
        for (int tt = 0; tt < 4; ++tt) acc[ct][tt] = (f32x4){0.f, 0.f, 0.f, 0.f};
      auto kpair = [&](int kp, bf16x8 (&a)[2][4]) {
#pragma unroll
        for (int k2 = 0; k2 < 2; ++k2) {
          bf16x8 b[4];
#pragma unroll
          for (int tt = 0; tt < 4; ++tt) b[tt] = *(const LAS bf16x8*)(TM + (16 * tt + cr) * TP + kc0 + kp * 64 + k2 * 32 + g * 8);
#pragma unroll
          for (int ct = 0; ct < 4; ++ct)
#pragma unroll
            for (int tt = 0; tt < 4; ++tt) acc[ct][tt] = __builtin_amdgcn_mfma_f32_16x16x32_bf16(a[k2][ct], b[tt], acc[ct][tt], 0, 0, 0);
        }
      };
      if (tensor == 2) {
        bf16x8 a1[2][4], a2[2][4]; const bf16_t* Wp = wptr(blk);
#pragma unroll
        for (int k2 = 0; k2 < 2; ++k2)
#pragma unroll
          for (int ct = 0; ct < 4; ++ct) { a1[k2][ct] = *(const GAS bf16x8*)(Wp + (size_t)(16 * ct) * 192 + 64 + k2 * 32); a2[k2][ct] = *(const GAS bf16x8*)(Wp + (size_t)(16 * ct) * 192 + 128 + k2 * 32); }
        kpair(0, a0); kpair(1, a1); kpair(2, a2);
      } else kpair(0, a0);
      if (j < 3) wload(blkof(j + 1));
#pragma unroll
      for (int ct = 0; ct < 4; ++ct) {
        const int n0 = cb * 64 + 16 * ct + 4 * g;
        f32x4 bias = {0.f, 0.f, 0.f, 0.f};
        if (tensor == 0) bias = *(const f32x4*)(p.w0 + n0); else if (tensor == 1) bias = *(const f32x4*)(p.a0 + n0);
#pragma unroll
        for (int tt = 0; tt < 4; ++tt) {
          f32x4 v = acc[ct][tt] + bias;
          if (skip_math) {} else if (tensor == 0) {
#pragma unroll
            for (int i = 0; i < 4; ++i) v[i] = -0.60653066f * sigmoidf_(v[i]);
          } else if (tensor == 1) {
#pragma unroll
            for (int i = 0; i < 4; ++i) v[i] = sigmoidf_(v[i]);
          }
          v2u o; o.x = pk2(v[0], v[1]); o.y = pk2(v[2], v[3]);
          *(LAS v2u*)(ST + (16 * tt + cr) * RP + 16 * ct + 4 * g) = o;
        }
      }
      LDS_WAIT();
      bf16_t* O = (bf16_t*)(p.ws + WS_S0 + (size_t)tensor * SLOT) + (size_t)t0 * DM + cb * 64;
#pragma unroll
      for (int i = 0; i < 8; ++i) { const int row = (lane >> 3) + 8 * i, pc = (lane & 7) * 8;
        const v4u sv = *(const LAS v4u*)(ST + row * RP + pc); if (!skip_store) *(GAS v4u*)(O + (size_t)row * DM + pc) = sv; }
      LDS_WAIT();
    }
    __syncthreads();
  }
}


__device__ __forceinline__ void phase_lora1(PREF p, Frame& F) {
  const int lane = fresh_lane(), w = F.wave, tid = F.tid, cr = lane & 15, g = lane >> 4;
  constexpr int XP = 136;
  constexpr int SLB = 64 * XP;
  const lbf XB = (lbf)(F.lds);
  const bf16_t* WL1 = (const bf16_t*)(p.ws + WS_WL1);
  bf16_t* TMP = (bf16_t*)(p.ws + WS_TMP);
  const int nt = (w < 2) ? 3 : 2;
  int wrow[3], slot[3], dcol[3];
#pragma unroll
  for (int q = 0; q < 3; ++q) { const int tau = w + 8 * q;
    const int gi = (tau < 4) ? 0 : (tau < 8) ? 1 : 2, c = (tau < 4) ? 16 * tau : (tau < 8) ? 16 * (tau - 4) : 16 * (tau - 8);
    wrow[q] = gi * 256 + c; slot[q] = gi; dcol[q] = (gi < 2) ? gi * 64 + c : 128 + c; }
  for (int unit = F.vcu; unit < 256; unit += F.G) {
    const int t0 = unit * 64;
    const int rot = unit & 7;
    auto xload = [&](v4u (&xs)[6], int chs) { const int ch = (chs + rot) & 7;
#pragma unroll
      for (int i = 0; i < 6; ++i) { const int idx = tid + 512 * i, sl = idx >> 10, row = (idx & 1023) >> 4, pc = idx & 15;
        xs[i] = *(const GAS v4u*)((const bf16_t*)(p.ws + WS_S0 + (size_t)(3 + sl) * SLOT) + (size_t)(t0 + row) * DM + ch * 128 + pc * 8); } };
    auto xstore = [&](const v4u (&xs)[6], int buf) {
#pragma unroll
      for (int i = 0; i < 6; ++i) { const int idx = tid + 512 * i, sl = idx >> 10, row = (idx & 1023) >> 4, pc = idx & 15;
        *(LAS v4u*)(XB + (buf * 3 + sl) * SLB + row * XP + pc * 8) = xs[i]; } };
    auto wload = [&](bf16x8 (&wa)[2][3], int hcs) { const int hc = ((((hcs >> 1) + rot) & 7) << 1) | (hcs & 1);
#pragma unroll
      for (int ks = 0; ks < 2; ++ks)
#pragma unroll
        for (int q = 0; q < 3; ++q) if (q < nt) wa[ks][q] = *(const GAS bf16x8*)(WL1 + (size_t)(wrow[q] + cr) * DM + hc * 64 + ks * 32 + g * 8); };
    v4u xs[6]; bf16x8 wq[3][2][3];
    xload(xs, 0); wload(wq[0], 0); wload(wq[1], 1);
    f32x4 acc[3][4];
#pragma unroll
    for (int q = 0; q < 3; ++q)
#pragma unroll
      for (int tt = 0; tt < 4; ++tt) acc[q][tt] = (f32x4){0.f, 0.f, 0.f, 0.f};
    xstore(xs, 0); xload(xs, 1);
    __syncthreads();
    auto half = [&](const bf16x8 (&wc)[2][3], int buf, int hh) {
#pragma unroll
      for (int ks = 0; ks < 2; ++ks)
#pragma unroll
        for (int q = 0; q < 3; ++q) if (q < nt) {
#pragma unroll
          for (int tt = 0; tt < 4; ++tt) { const bf16x8 b = *(const LAS bf16x8*)(XB + (buf * 3 + slot[q]) * SLB + (16 * tt + cr) * XP + hh * 64 + ks * 32 + g * 8);
            acc[q][tt] = __builtin_amdgcn_mfma_f32_16x16x32_bf16(wc[ks][q], b, acc[q][tt], 0, 0, 0); } } };
#pragma unroll
    for (int h = 0; h < 16; ++h) {
      if (h + 2 < 16) wload(wq[(h + 2) % 3], h + 2);
      half(wq[h % 3], (h >> 1) & 1, h & 1);
      if (h & 1) {
        const int ch = h >> 1;
        if (ch + 1 < 8) { xstore(xs, (ch + 1) & 1); if (ch + 2 < 8) xload(xs, ch + 2); }
        __syncthreads();
      }
    }
#pragma unroll
    for (int q = 0; q < 3; ++q) if (q < nt) {
#pragma unroll
      for (int tt = 0; tt < 4; ++tt) { f32x4 v = acc[q][tt];
        if (slot[q] == 0) {
#pragma unroll
          for (int i = 0; i < 4; ++i) v[i] = tanhf_(v[i]);
        } else if (slot[q] == 2) {
#pragma unroll
          for (int i = 0; i < 4; ++i) v[i] = sigmoidf_(v[i]);
        }
        v2u o; o.x = pk2(v[0], v[1]); o.y = pk2(v[2], v[3]);
        *(GAS v2u*)(TMP + (size_t)(t0 + 16 * tt + cr) * 384 + dcol[q] + 4 * g) = o; } }
    if (w >= 6) {
      const int row = (w - 6) * 32 + (lane >> 1), half2 = lane & 1;
#pragma unroll
      for (int i = 0; i < 6; ++i) *(GAS v4u*)(TMP + (size_t)(t0 + row) * 384 + 288 + half2 * 48 + i * 8) = (v4u){0u, 0u, 0u, 0u};
    }
  }
}

__global__ void __launch_bounds__(NWAVES * 64, 2) mk_fwd(P p_arg) {
  extern __shared__ __attribute__((aligned(16))) unsigned char lds[];
  Frame F;
  F.lds = (LAS unsigned char*)lds;
  F.MISC = (volatile LAS unsigned*)(F.lds + MISC_OFF);
  F.tid = threadIdx.x; F.lane = F.tid & 63; F.wave = __builtin_amdgcn_readfirstlane(F.tid >> 6);
  F.G = gridDim.x; { const int bx = blockIdx.x; F.vcu = (F.G % 8 == 0) ? (bx % 8) * (F.G / 8) + bx / 8 : bx; }
  unsigned char* const ws = p_arg.ws;
  F.ctl = (gu32*)(ws + WS_CTL);
  for (int u = F.tid; u < (LDS_BYTES - LDSCTL_OFF) / 4; u += NWAVES * 64) ((LAS unsigned*)(F.lds + LDSCTL_OFF))[u] = 0u;
  __syncthreads();
  XcdBarrier bar = xcd_barrier_post((unsigned*)(F.ctl + CW_BAR) + p_arg.pad * XCD_BAR_WORDS, F.MISC + 8);
  const int lo = p_arg.ph_lo, hi = p_arg.ph_hi;
#ifndef PHMASK
#define PHMASK 0xffffffffu
#endif
#define IN(k) (lo <= (k) && (k) < hi && ((PHMASK >> (k)) & 1u))
#define SEAM(k) do { if (IN(k) && IN((k) + 1)) xcd_barrier(bar); } while (0)
#ifdef PROBE_PH
  F.pr_t0 = 0; F.pr_t1 = 0;
#endif

  PROBE_MARK(0); if (IN(0)) { phase_prologue(KP, F); } SEAM(0);
  PROBE_MARK(1); if (IN(1)) {
    pg8::Gemm g{(const bf16_t*)(ws + WS_XN), (const bf16_t*)(ws + WS_WIN), DM, DM};
    pg8::StaticOrder S; S.init(T_TOK, 3072, F.G, (int)blockIdx.x);
    PREF p = KP; EpiInProj E{(bf16_t*)(ws + WS_H), (float*)(ws + WS_GATES), p.dq_norm, p.dk_norm, p.nq_norm, p.nk_norm, p.gate_bias};
    pg8::gemm_phase<EpiInProj, pg8::StaticOrder, true>(F.lds + RING_OFF, g, S, E);
  } SEAM(1);
  PROBE_MARK(2); if (IN(2)) { phase_compress(KP, F); phase_diffattn(KP, F); } SEAM(2);
  PROBE_MARK(3); if (IN(3)) { phase_nsa(KP, F); } SEAM(3);
  PROBE_MARK(4); if (IN(4)) {
    pg8::Gemm g{(const bf16_t*)(ws + WS_CAT), (const bf16_t*)(ws + WS_WOUT), DM, DM};
    pg8::StaticOrder S; S.init(T_TOK, DM, F.G, (int)blockIdx.x);
    PREF p = KP; EpiResid E{p.x, nullptr, (bf16_t*)p.out, nullptr};
    pg8::gemm_phase<EpiResid, pg8::StaticOrder, true>(F.lds + RING_OFF, g, S, E);
  } SEAM(4);
#define MOE_PHASES(layer, pb) do { \
    PROBE_MARK(pb); if (IN(pb)) { phase_router(KP, F, layer); } SEAM(pb); \
    PROBE_MARK(pb + 1); if (IN(pb + 1)) { \
      pg8::Gemm g{layer ? (const bf16_t*)(ws + WS_X3) : (const bf16_t*)KP.out, (const bf16_t*)(ws + WS_EGU), DM, DM}; \
      pg8::moe_order_setup((LAS int*)(F.lds + MISC_OFF + 256), (const unsigned*)(ws + WS_CTL) + CW_CNT + layer * 32 * 64); pg8::MoeOrder<2, true> S{(const LAS int*)(F.lds + MISC_OFF + 256), (const int*)(ws + WS_LIST), F.G, F.vcu}; \
      EpiMoeGU E{(bf16_t*)(ws + WS_HID), (const int*)(ws + WS_LIST), (const float*)(ws + WS_RS), (LAS float*)(F.lds + 132096)}; \
      pg8::gemm_phase<EpiMoeGU, pg8::MoeOrder<2, true>, true>(F.lds + RING_OFF, g, S, E); \
    } SEAM(pb + 1); \
    PROBE_MARK(pb + 2); if (IN(pb + 2)) { \
      int k256 = 256; asm volatile("" : "+s"(k256)); \
      pg8::Gemm g{(const bf16_t*)(ws + WS_HID), (const bf16_t*)(ws + WS_EDN), k256, 256}; \
        pg8::MoeOrder<4, false> S{(const LAS int*)(F.lds + MISC_OFF + 256), (const int*)(ws + WS_LIST), F.G, F.vcu}; \
      PREF p = KP; EpiMoeDown E{layer ? (bf16_t*)(ws + WS_X3) : (bf16_t*)p.out, (bf16_t*)(ws + WS_Y1), (const int*)(ws + WS_LIST), (const float*)(ws + WS_PGATE), (LAS int*)(F.lds + 132096)}; \
      pg8::gemm_phase<EpiMoeDown, pg8::MoeOrder<4, false>, true>(F.lds + RING_OFF, g, S, E); \
    } SEAM(pb + 2); \
  } while (0)
  MOE_PHASES(0, 5);
  PROBE_MARK(8); if (IN(8)) {
    phase_rwkv_prep(KP, F);
    asm volatile("s_waitcnt vmcnt(0)" ::: "memory"); __syncthreads();
    phase_lora1(KP, F);
  } SEAM(8);
  PROBE_MARK(9);
  PROBE_MARK(10); if (IN(10)) {
    pg8::Gemm g{(const bf16_t*)(ws + WS_S0), (const bf16_t*)(ws + WS_WRKV), DM, DM};
    pg8::TallOrder S; S.init(3, 4, F.G, (int)blockIdx.x);
    EpiRKV E{ws};
    pg8::gemm_phase<EpiRKV, pg8::TallOrder, true>(F.lds + RING_OFF, g, S, E);
  } SEAM(10);
  PROBE_MARK(11);
  PROBE_MARK(12); if (IN(12)) { phase_rwkv_r1(KP, F); } SEAM(12);
  PROBE_MARK(13); if (IN(13)) { phase_rwkv_r2(KP, F); } SEAM(13);
  PROBE_MARK(14); if (IN(14)) { phase_rwkv_r3(KP, F); } SEAM(14);
  PROBE_MARK(15); if (IN(15)) {
    pg8::Gemm g{(const bf16_t*)(ws + WS_S0 + 3 * SLOT), (const bf16_t*)(ws + WS_WO), DM, DM};
    pg8::StaticOrder S; S.init(T_TOK, DM, F.G, (int)blockIdx.x);
    PREF p = KP; EpiResid E{nullptr, (const bf16_t*)p.out, (bf16_t*)(ws + WS_X3), (const bf16_t*)(ws + WS_Y1)};
    pg8::gemm_phase<EpiResid, pg8::StaticOrder, true>(F.lds + RING_OFF, g, S, E);
  } SEAM(15);
  MOE_PHASES(1, 16);
#undef MOE_PHASES
  PROBE_MARK(19); if (IN(19)) { phase_final(KP, F); }
  PROBE_MARK(20);
#ifdef PROBE_PH
  { const unsigned long long dur = (F.pr_t1 - F.pr_t0) * PROBE_MUL, t0 = __builtin_amdgcn_s_memrealtime(); while (__builtin_amdgcn_s_memrealtime() - t0 < dur) __builtin_amdgcn_s_sleep(8); }
#endif
#undef IN
#undef SEAM
}

static void launch_mk(P p, int lo, int hi, int li, int grid, hipStream_t st) {
  p.ph_lo = lo; p.ph_hi = hi; p.pad = li;
  hipLaunchKernelGGL(mk_fwd, dim3(grid), dim3(NWAVES * 64), LDS_BYTES, st, p);
}

extern "C" void kernel_launch(void* const* d_in, const int* in_sizes, int n_in, void* d_out, int out_size, void* d_ws,
                              size_t ws_size, hipStream_t stream) {
  static int grid = 0;
  if (grid == 0) {
    if (n_in != 40 || ws_size < WS_END) { fprintf(stderr, "kernel_launch: bad n_in %d or ws_size %zu (< %zu)\n", n_in, ws_size, (size_t)WS_END); grid = -1; return; }
    int dev = 0, cus = 0;
    if (hipGetDevice(&dev) != hipSuccess || hipDeviceGetAttribute(&cus, hipDeviceAttributeMultiprocessorCount, dev) != hipSuccess) { grid = -1; return; }
    if (hipFuncSetAttribute((const void*)mk_fwd, hipFuncAttributeMaxDynamicSharedMemorySize, LDS_BYTES) != hipSuccess) { grid = -1; return; }
    if (cus < 256) { fprintf(stderr, "kernel_launch: needs 256 CUs (one workgroup per CU), found %d\n", cus); grid = -1; return; }
    grid = 256;
  }
  if (grid < 0) return;
  P p{};
  const float* const* in = (const float* const*)d_in;
  p.x = in[0]; p.mix_norm = in[1]; p.w_in = in[2]; p.gate_bias = in[3]; p.dq_norm = in[4]; p.dk_norm = in[5];
  p.dlam = in[6]; p.dsubln = in[7]; p.nq_norm = in[8]; p.nk_norm = in[9]; p.cmp_pe = in[10]; p.cmp_w1 = in[11];
  p.cmp_w2 = in[12]; p.w_out = in[13]; p.rmix = in[14]; p.w_r = in[15]; p.w_k = in[16]; p.w_v = in[17];
  p.w0 = in[18]; p.w1 = in[19]; p.w2 = in[20]; p.a0 = in[21]; p.a1 = in[22]; p.a2 = in[23]; p.g1 = in[24]; p.g2 = in[25];
  p.k_k = in[26]; p.k_a = in[27]; p.r_k = in[28]; p.ln_w = in[29]; p.ln_b = in[30]; p.w_o = in[31];
  p.ffn_norm = in[32]; p.rg_w = in[33]; p.rg_b = in[34]; p.re_w = in[35]; p.re_b = in[36];
  p.e_gate = in[37]; p.e_up = in[38]; p.e_down = in[39];
  p.out = (float*)d_out;
  p.ws = (unsigned char*)d_ws;
  unsigned char* ws = p.ws;
  (void)hipMemsetAsync(ws + WS_CTL, 0, CTL_ZERO_BYTES, stream);
  launch_mk(p, 0, 20, 0, grid, stream);
}
```
